# Optimizing an MI355X kernel written in HIP

```python
import jax, jax.numpy as jnp
from jax import lax
import numpy as np

D_MODEL = 1024
BATCH = 4
SEQ = 8192
DEPTH = 1

CHUNK = 64
N_META = 16

A_HEADS = 8
A_HEAD_DIM = 64
A_WIDTH = A_HEADS * A_HEAD_DIM
Q_RANK = 256
KV_RANK = 128
IDX_HEADS = 8
IDX_DIM = 64
INDEX_TOPK = 256
Q_BLOCK = 128

B_HEADS = 8
B_HEAD_DIM = 64
B_WIDTH = B_HEADS * B_HEAD_DIM
DECAY_LORA = 64
AAA_LORA = 64
GATE_LORA = 128
GN_EPS = 64e-5

D_FF = 2816
CONV_W = 3

LN_EPS = 1e-5
ALPHA = (2 * DEPTH) ** 0.25
BETA = (8 * DEPTH) ** -0.25

A_COLS = Q_RANK + KV_RANK + IDX_DIM + IDX_HEADS
B_COLS = 3 * B_WIDTH + DECAY_LORA + AAA_LORA + GATE_LORA
IN_COLS = A_COLS + B_COLS

kernel_name = "hymba_dsa_rwkv7_convffn_deepnorm"


def layer_norm(x, g, b, eps=LN_EPS):
    xf = x.astype(jnp.float32)
    mu = jnp.mean(xf, -1, keepdims=True)
    var = jnp.mean(jnp.square(xf - mu), -1, keepdims=True)
    return ((xf - mu) * lax.rsqrt(var + eps) * g + b).astype(x.dtype)


def rms_norm(x, g, eps=1e-6):
    xf = x.astype(jnp.float32)
    y = xf * lax.rsqrt(jnp.mean(jnp.square(xf), -1, keepdims=True) + eps) * g
    return y.astype(x.dtype)


def chunk_ids(pos):
    return (pos - N_META) // CHUNK + 1


def alibi_slopes(n_heads):
    return jnp.asarray([2.0 ** (-8.0 * (h + 1) / n_heads) for h in range(n_heads)], jnp.float32)


def sparse_indexed_attention(pa, q_norm_g, w_uq, kv_norm_g, w_ukv, w_iq, idx_ln_g, idx_ln_b):
    bsz, T, _ = pa.shape
    c_q = pa[..., :Q_RANK]
    c_kv = pa[..., Q_RANK:Q_RANK + KV_RANK]
    k_idx_raw = pa[..., Q_RANK + KV_RANK:Q_RANK + KV_RANK + IDX_DIM]
    w_idx = pa[..., Q_RANK + KV_RANK + IDX_DIM:]
    c_q = rms_norm(c_q, q_norm_g)
    q = (c_q @ w_uq).reshape(bsz, T, A_HEADS, A_HEAD_DIM)
    q_idx = (c_q @ w_iq).reshape(bsz, T, IDX_HEADS, IDX_DIM)
    kv = (rms_norm(c_kv, kv_norm_g) @ w_ukv).reshape(bsz, T, A_HEADS, 2 * A_HEAD_DIM)
    k, v = kv[..., :A_HEAD_DIM], kv[..., A_HEAD_DIM:]
    k_idx = layer_norm(k_idx_raw, idx_ln_g, idx_ln_b)
    w_idx = w_idx * (IDX_HEADS ** -0.5 * IDX_DIM ** -0.5)

    topk = min(INDEX_TOPK, T // 4)
    n_blk = -(-T // Q_BLOCK)
    t_pad = n_blk * Q_BLOCK

    def to_blocks(a):
        a = jnp.pad(a, [(0, 0), (0, t_pad - T)] + [(0, 0)] * (a.ndim - 2))
        return jnp.moveaxis(a.reshape((bsz, n_blk, Q_BLOCK) + a.shape[2:]), 1, 0)

    key_pos = jnp.arange(T, dtype=jnp.int32)
    key_chunk = chunk_ids(key_pos)
    slopes = alibi_slopes(A_HEADS)
    scale = A_HEAD_DIM ** -0.5

    def block(args):
        q_b, qi_b, wi_b, pos_b = args
        qc = chunk_ids(pos_b)
        visible = key_chunk[None, :] <= qc[:, None]
        rel = jax.nn.relu(jnp.einsum('bqhd,bsd->bqhs', qi_b, k_idx,
                                     preferred_element_type=jnp.float32))
        score = jnp.einsum('bqhs,bqh->bqs', rel, wi_b.astype(jnp.float32))
        score = jnp.where(visible[None], score, -jnp.inf)
        _, sel = lax.top_k(score, topk)
        k_sel = jax.vmap(lambda kb, ib: kb[ib])(k, sel)
        v_sel = jax.vmap(lambda vb, ib: vb[ib])(v, sel)
        sel_ok = key_chunk[sel] <= qc[None, :, None]
        dist = jnp.abs(pos_b[None, :, None] - sel).astype(jnp.float32)
        logits = jnp.einsum('bqhd,bqkhd->bqhk', q_b, k_sel,
                            preferred_element_type=jnp.float32) * scale
        logits = logits - slopes[None, None, :, None] * dist[:, :, None, :]
        logits = jnp.where(sel_ok[:, :, None, :], logits, -jnp.inf)
        p = jax.nn.softmax(logits, axis=-1)
        return jnp.einsum('bqhk,bqkhd->bqhd', p.astype(v_sel.dtype), v_sel)

    pos_blocks = jnp.arange(t_pad, dtype=jnp.int32).reshape(n_blk, Q_BLOCK)
    out = lax.map(block, (to_blocks(q), to_blocks(q_idx), to_blocks(w_idx), pos_blocks))
    out = jnp.moveaxis(out, 0, 1).reshape(bsz, t_pad, A_WIDTH)[:, :T]
    return out.astype(pa.dtype)


def token_shift(p):
    return jnp.pad(p, [(0, 0), (1, 0), (0, 0)])[:, :-1]


def rwkv7_time_mix(pb, mu_shift, w0, w_decay_up, a0, w_aaa_up, w_gate_up, k_k, k_a, r_k, gn_g, gn_b):
    bsz, T, _ = pb.shape
    pb = pb + (token_shift(pb) - pb) * mu_shift
    s1, s2, s3 = B_WIDTH, 2 * B_WIDTH, 3 * B_WIDTH
    s4, s5 = s3 + DECAY_LORA, s3 + DECAY_LORA + AAA_LORA
    r, k, v = pb[..., :s1], pb[..., s1:s2], pb[..., s2:s3]
    wd, ad, gd = pb[..., s3:s4], pb[..., s4:s5], pb[..., s5:]
    w_log = -jax.nn.softplus(-(w0 + jnp.tanh(wd) @ w_decay_up)) - 0.5
    decay = jnp.exp(-jnp.exp(w_log.astype(jnp.float32)))
    a = jax.nn.sigmoid(a0 + ad @ w_aaa_up)
    g = jax.nn.sigmoid(gd) @ w_gate_up

    def heads(t):
        return t.astype(jnp.float32).reshape(bsz, T, B_HEADS, B_HEAD_DIM)

    kk = heads(k * k_k)
    kk = kk / jnp.maximum(jnp.sqrt(jnp.sum(jnp.square(kk), -1, keepdims=True)), 1e-12)
    k = k * (1 + (a - 1) * k_a)
    r_h, k_h, v_h, a_h, w_h = heads(r), heads(k), heads(v), heads(a), heads(decay)
    a_vec = -kk
    b_vec = kk * a_h

    def step(S, inp):
        r_t, w_t, k_t, v_t, av_t, bv_t = inp
        sa = jnp.einsum('bhvk,bhk->bhv', S, av_t)
        S = S * w_t[:, :, None, :] + sa[..., None] * bv_t[:, :, None, :] + v_t[..., None] * k_t[:, :, None, :]
        return S, jnp.einsum('bhvk,bhk->bhv', S, r_t)

    xs = tuple(jnp.moveaxis(t, 1, 0) for t in (r_h, w_h, k_h, v_h, a_vec, b_vec))
    S0 = jnp.zeros((bsz, B_HEADS, B_HEAD_DIM, B_HEAD_DIM), jnp.float32)
    _, y = lax.scan(step, S0, xs)
    y = jnp.moveaxis(y, 0, 1)
    mu = jnp.mean(y, -1, keepdims=True)
    var = jnp.mean(jnp.square(y - mu), -1, keepdims=True)
    y = ((y - mu) * lax.rsqrt(var + GN_EPS)).reshape(bsz, T, B_WIDTH) * gn_g + gn_b
    bonus = jnp.sum(r_h * k_h * r_k, -1, keepdims=True) * v_h
    y = (y + bonus.reshape(bsz, T, B_WIDTH)) * g
    return y.astype(pb.dtype)


def conv_ffn(x, w_ffn_up, conv_w, conv_b, w_ffn_down):
    up = x @ w_ffn_up
    gate, val = up[..., :D_FF], up[..., D_FF:]
    gate = lax.conv_general_dilated(gate, conv_w[:, None, :], window_strides=(1,),
                                    padding=[(CONV_W - 1, 0)],
                                    dimension_numbers=('NWC', 'WIO', 'NWC'),
                                    feature_group_count=D_FF) + conv_b
    return (jax.nn.gelu(gate) * val) @ w_ffn_down


def setup_inputs(seed: int = 0) -> dict:
    key = jax.random.key(seed)
    ks = jax.random.split(key, 32)
    f32 = jnp.float32

    def nrm(k, shape, scale):
        return jax.random.normal(k, shape, f32) * scale

    def gain(k, shape):
        return 1.0 + 0.02 * jax.random.normal(k, shape, f32)

    def bias(k, shape):
        return 0.02 * jax.random.normal(k, shape, f32)

    L = DEPTH
    return {
        'x': nrm(ks[0], (BATCH, SEQ, D_MODEL), 1.0),
        'meta': nrm(ks[1], (N_META, D_MODEL), 1.0),
        'ln_in_g': gain(ks[2], (D_MODEL,)),
        'ln_in_b': bias(ks[3], (D_MODEL,)),
        'w_in': nrm(ks[4], (L, D_MODEL, IN_COLS), D_MODEL ** -0.5),
        'q_norm_g': gain(ks[5], (L, Q_RANK)),
        'w_uq': nrm(ks[6], (L, Q_RANK, A_WIDTH), Q_RANK ** -0.5),
        'kv_norm_g': gain(ks[7], (L, KV_RANK)),
        'w_ukv': nrm(ks[8], (L, KV_RANK, 2 * A_WIDTH), KV_RANK ** -0.5),
        'w_iq': nrm(ks[9], (L, Q_RANK, IDX_HEADS * IDX_DIM), Q_RANK ** -0.5),
        'idx_ln_g': gain(ks[10], (L, IDX_DIM)),
        'idx_ln_b': bias(ks[11], (L, IDX_DIM)),
        'mu_shift': jax.random.uniform(ks[12], (L, B_COLS), f32),
        'w0': jax.random.uniform(ks[13], (L, B_WIDTH), f32, -6.0, -1.0),
        'w_decay_up': nrm(ks[14], (L, DECAY_LORA, B_WIDTH), 0.1 * DECAY_LORA ** -0.5),
        'a0': nrm(ks[15], (L, B_WIDTH), 0.1),
        'w_aaa_up': nrm(ks[16], (L, AAA_LORA, B_WIDTH), 0.1 * AAA_LORA ** -0.5),
        'w_gate_up': nrm(ks[17], (L, GATE_LORA, B_WIDTH), GATE_LORA ** -0.5),
        'k_k': 0.85 + 0.02 * jax.random.normal(ks[18], (L, B_WIDTH), f32),
        'k_a': gain(ks[19], (L, B_WIDTH)),
        'r_k': nrm(ks[20], (L, B_HEADS, B_HEAD_DIM), 0.1),
        'gn_g': gain(ks[21], (L, B_WIDTH)),
        'gn_b': bias(ks[22], (L, B_WIDTH)),
        'w_out': nrm(ks[23], (L, A_WIDTH + B_WIDTH, D_MODEL), BETA * (A_WIDTH + B_WIDTH) ** -0.5),
        'ln1_g': gain(ks[24], (L, D_MODEL)),
        'ln1_b': bias(ks[25], (L, D_MODEL)),
        'w_ffn_up': nrm(ks[26], (L, D_MODEL, 2 * D_FF), D_MODEL ** -0.5),
        'conv_w': nrm(ks[27], (L, CONV_W, D_FF), CONV_W ** -0.5),
        'conv_b': bias(ks[28], (L, D_FF)),
        'w_ffn_down': nrm(ks[29], (L, D_FF, D_MODEL), BETA * D_FF ** -0.5),
        'ln2_g': gain(ks[30], (L, D_MODEL)),
        'ln2_b': bias(ks[31], (L, D_MODEL)),
    }


def reference(x, meta, ln_in_g, ln_in_b, w_in, q_norm_g, w_uq, kv_norm_g, w_ukv, w_iq,
              idx_ln_g, idx_ln_b, mu_shift, w0, w_decay_up, a0, w_aaa_up, w_gate_up,
              k_k, k_a, r_k, gn_g, gn_b, w_out, ln1_g, ln1_b, w_ffn_up, conv_w, conv_b,
              w_ffn_down, ln2_g, ln2_b):
    bsz = x.shape[0]
    meta_b = jnp.broadcast_to(meta[None].astype(x.dtype), (bsz, N_META, x.shape[-1]))
    h = jnp.concatenate([meta_b, x], axis=1)
    h = layer_norm(h, ln_in_g, ln_in_b)
    for l in range(DEPTH):
        p = h @ w_in[l]
        ya = sparse_indexed_attention(p[..., :A_COLS], q_norm_g[l], w_uq[l], kv_norm_g[l],
                                      w_ukv[l], w_iq[l], idx_ln_g[l], idx_ln_b[l])
        yb = rwkv7_time_mix(p[..., A_COLS:], mu_shift[l], w0[l], w_decay_up[l], a0[l],
                            w_aaa_up[l], w_gate_up[l], k_k[l], k_a[l], r_k[l], gn_g[l], gn_b[l])
        mix = jnp.concatenate([ya, yb], axis=-1) @ w_out[l]
        h = layer_norm(ALPHA * h + mix, ln1_g[l], ln1_b[l])
        ffn = conv_ffn(h, w_ffn_up[l], conv_w[l], conv_b[l], w_ffn_down[l])
        h = layer_norm(ALPHA * h + ffn, ln2_g[l], ln2_b[l])
    return h[:, N_META:]
```

```cpp
#include <hip/hip_runtime.h>
#include <cstdio>
#include <cstdint>
#define ONE_LAUNCH 1
namespace pg8 {
#define PG8_LAS __attribute__((address_space(3)))
typedef unsigned short bf16_t;
typedef short bf16x8 __attribute__((ext_vector_type(8)));
typedef float f32x4 __attribute__((ext_vector_type(4)));
typedef unsigned u32x4 __attribute__((ext_vector_type(4)));
constexpr int BM = 256, BK = 64, HALF = 128, HTB = HALF * BK * 2  , STAGE_BYTES = 8 * HTB, NXCD = 8, WGM = 8;

__host__ __device__ __forceinline__ int lds_byte(int r, int c) { const int st = (r >> 4) * 2 + (c >> 5), rr = r & 15, cc = c & 31, ob = rr * 64 + cc * 2; return st * 1024 + (ob ^ (((ob >> 9) & 1) << 5)); }
__host__ __device__ __forceinline__ void stage_rc(int b, int& R, int& C) { const int st = b / 1024, sb = b % 1024, swz = sb ^ (((sb >> 9) & 1) << 5); R = (st >> 1) * 16 + swz / 64; C = (st & 1) * 32 + (swz % 64) / 2; }
__host__ __device__ __forceinline__ int perm32(int rho) { const int n = rho >> 4, i = rho & 15; return 8 * (i >> 2) + 4 * n + (i & 3); }

struct Unit { int pm, pn; };
struct Gemm { const bf16_t* A; const bf16_t* Bt; int M, N, K, lda; };

struct StaticOrder {
    int nM, nN, nwg, G, c;
    __host__ __device__ void init(int M, int N, int G_, int c_) { nM = M / BM; nN = N / BM; nwg = nM * nN; G = G_; c = c_; }
    __host__ __device__ bool next(int i, Unit& u) const {
        const long L = (long)i * G + c; if (L >= nwg) return false;
        int wgid = (int)L; { const int q = nwg / NXCD, r = nwg % NXCD, xcd = wgid % NXCD, off = wgid / NXCD; wgid = (xcd < r ? xcd * (q + 1) : r * (q + 1) + (xcd - r) * q) + off; }
        const int nig = WGM * nN, gid = wgid / nig, fm = gid * WGM, gsz = (nM - fm) < WGM ? (nM - fm) : WGM;
        u.pm = fm + ((wgid % nig) % gsz); u.pn = (wgid % nig) / gsz; return true;
    }
    __device__ __forceinline__ void a_ready(const Unit&) const {}
    __device__ __forceinline__ void done(const Unit&) const {}
};


template <class F> struct EpiFn {
    static constexpr bool PERM = false, AFTER_DRAIN = false;
    F f;
    __device__ __forceinline__ void operator()(const f32x4 (&acc)[2][2][4][2], const Unit& u, int wr, int wc, int fr, int fq) const {
        const int row0 = u.pm * BM + wr * 64 + fr, col0 = u.pn * BM + wc * 32 + 4 * fq;
#pragma unroll
        for (int ai = 0; ai < 2; ++ai)
#pragma unroll
            for (int m = 0; m < 4; ++m) {
                const int row = row0 + ai * HALF + m * 16;
#pragma unroll
                for (int bj = 0; bj < 2; ++bj)
#pragma unroll
                    for (int n = 0; n < 2; ++n) f(row, col0 + bj * HALF + n * 16, acc[ai][bj][m][n]);
            }
    }
};
template <class Epi, class Sched, bool ALIGN_EPI = false, bool SP2 = false>
__device__ __forceinline__ void gemm_phase(PG8_LAS unsigned char* lds, const Gemm g, const Sched& S, const Epi& E) {
    const int tid = threadIdx.x, wid = __builtin_amdgcn_readfirstlane(tid >> 6), lane = tid & 63, wr = wid >> 2, wc = wid & 3, fr = lane & 15, fq = lane >> 4;
    const int K = g.K, nt = K / BK;
    unsigned voffA[2], voffB[2];
#pragma unroll
    for (int i = 0; i < 2; ++i) { int R, C; stage_rc(tid * 16 + i * 8192, R, C); const int Rb = Epi::PERM ? ((R & ~31) + perm32(R & 31)) : R;
        voffA[i] = (unsigned)(R * g.lda + C) * 2u; voffB[i] = (unsigned)(Rb * K + C) * 2u; }
    const size_t kstep = (size_t)(BK * 2);
    const size_t hA = (size_t)HALF * g.lda * 2, hB = (size_t)HALF * K * 2;
    const size_t tA = 2 * hA, tB = 2 * hB;
    const unsigned ldsw = (unsigned)wid * 1024u;
    const int aoff = lds_byte(wr * 64 + fr, fq * 8), boff = lds_byte(wc * 32 + fr, fq * 8);
#define PG8_SA(b, h) (((b) * 2 + (h)) * HTB)
#define PG8_SB(b, h) ((4 + (b) * 2 + (h)) * HTB)
#define PG8_STAGE(bufoff, gbase, voff) do { _Pragma("unroll") for (int _i = 0; _i < 2; ++_i) \
        __builtin_amdgcn_global_load_lds((const unsigned*)((const char*)(gbase) + (voff)[_i]), (PG8_LAS unsigned*)(lds + (bufoff) + ldsw + _i * 8192), 16, 0, 0); } while (0)
#define PG8_LDA(dst, b, h) do { _Pragma("unroll") for (int m = 0; m < 4; ++m) _Pragma("unroll") for (int k = 0; k < 2; ++k) dst[m][k] = *(const PG8_LAS bf16x8*)(lds + PG8_SA(b, h) + aoff + m * 2048 + k * 1024); } while (0)
#define PG8_LDB(dst, b, h) do { _Pragma("unroll") for (int n = 0; n < 2; ++n) _Pragma("unroll") for (int k = 0; k < 2; ++k) dst[n][k] = *(const PG8_LAS bf16x8*)(lds + PG8_SB(b, h) + boff + n * 2048 + k * 1024); } while (0)
#define PG8_MMA(ai, bj, At, Bt) do { __builtin_amdgcn_s_setprio(1); _Pragma("unroll") for (int m = 0; m < 4; ++m) _Pragma("unroll") for (int n = 0; n < 2; ++n) _Pragma("unroll") for (int k = 0; k < 2; ++k) \
        acc[ai][bj][m][n] = __builtin_amdgcn_mfma_f32_16x16x32_bf16(Bt[n][k], At[m][k], acc[ai][bj][m][n], 0, 0, 0); __builtin_amdgcn_s_setprio(0); } while (0)
#define PG8_WAIT_V(n) asm volatile("s_waitcnt vmcnt(" #n ")" ::: "memory")
#define PG8_WAIT_L(n) asm volatile("s_waitcnt lgkmcnt(" #n ")" ::: "memory")
#define PG8_BAR __builtin_amdgcn_s_barrier()
#define PG8_SCHED __builtin_amdgcn_sched_barrier(0)
    Unit cur, nxt; int ui = 0;
    if (!S.next(0, cur)) return;
    f32x4 acc[2][2][4][2];
#pragma unroll
    for (int a = 0; a < 2; ++a)
#pragma unroll
        for (int b = 0; b < 2; ++b)
#pragma unroll
            for (int m = 0; m < 4; ++m)
#pragma unroll
                for (int n = 0; n < 2; ++n) acc[a][b][m][n] = (f32x4){0.f, 0.f, 0.f, 0.f};
    bf16x8 At[4][2], B0[2][2], B1[2][2];
    const char* cA = (const char*)g.A + (size_t)cur.pm * tA; const char* cB = (const char*)g.Bt + (size_t)cur.pn * tB;
    S.a_ready(cur);
    if constexpr (SP2) {
        PG8_STAGE(PG8_SB(0, 0), cB, voffB); PG8_STAGE(PG8_SB(0, 1), cB + hB, voffB); PG8_STAGE(PG8_SA(0, 0), cA, voffA); PG8_STAGE(PG8_SA(0, 1), cA + hA, voffA);
        if (wr == 1) PG8_BAR;
        PG8_WAIT_V(2); PG8_BAR;
        PG8_STAGE(PG8_SB(1, 0), cB + kstep, voffB); PG8_STAGE(PG8_SA(1, 0), cA + kstep, voffA); PG8_STAGE(PG8_SB(1, 1), cB + hB + kstep, voffB);
        PG8_WAIT_V(6); PG8_BAR;
    } else {
        PG8_STAGE(PG8_SB(0, 0), cB, voffB); PG8_STAGE(PG8_SA(0, 0), cA, voffA); PG8_STAGE(PG8_SB(0, 1), cB + hB, voffB); PG8_STAGE(PG8_SA(0, 1), cA + hA, voffA);
        if (wr == 1) PG8_BAR;
        PG8_WAIT_V(4); PG8_BAR;
        PG8_STAGE(PG8_SB(1, 0), cB + kstep, voffB); PG8_STAGE(PG8_SA(1, 0), cA + kstep, voffA); PG8_STAGE(PG8_SB(1, 1), cB + hB + kstep, voffB);
        PG8_WAIT_V(6); PG8_BAR;
    }
    for (;;) {
        const bool has_next = S.next(ui + 1, nxt);
        const char* nA = has_next ? (const char*)g.A + (size_t)nxt.pm * tA : cA; const char* nB = has_next ? (const char*)g.Bt + (size_t)nxt.pn * tB : cB;
        for (int t = 0; t < nt; t += 2) {
            const bool last = (t == nt - 2);
            const char* a1 = cA + (size_t)(t + 1) * kstep;
            const char* a2 = last ? nA : cA + (size_t)(t + 2) * kstep; const char* b2 = last ? nB : cB + (size_t)(t + 2) * kstep;
            const char* a3 = a2 + kstep; const char* b3 = b2 + kstep;
            if (last && has_next) S.a_ready(nxt);
            if constexpr (SP2) {
            PG8_LDB(B0, 0, 0); PG8_LDB(B1, 0, 1); PG8_SCHED; PG8_LDA(At, 0, 0); PG8_STAGE(PG8_SA(1, 1), a1 + hA, voffA);
            PG8_WAIT_V(8); PG8_WAIT_L(0); PG8_BAR; PG8_MMA(0, 0, At, B0); PG8_MMA(0, 1, At, B1); PG8_BAR; PG8_SCHED;
            PG8_LDA(At, 0, 1); PG8_STAGE(PG8_SB(0, 0), b2, voffB); PG8_STAGE(PG8_SB(0, 1), b2 + hB, voffB); PG8_STAGE(PG8_SA(0, 0), a2, voffA);
            PG8_WAIT_V(8); PG8_WAIT_L(0); PG8_BAR; PG8_MMA(1, 0, At, B0); PG8_MMA(1, 1, At, B1); PG8_BAR; PG8_SCHED;
            PG8_LDB(B0, 1, 0); PG8_LDB(B1, 1, 1); PG8_SCHED; PG8_LDA(At, 1, 0); PG8_STAGE(PG8_SA(0, 1), a2 + hA, voffA);
            PG8_WAIT_V(8); PG8_WAIT_L(0); PG8_BAR; PG8_MMA(0, 0, At, B0); PG8_MMA(0, 1, At, B1); PG8_BAR; PG8_SCHED;
            PG8_LDA(At, 1, 1); PG8_STAGE(PG8_SB(1, 0), b3, voffB); PG8_STAGE(PG8_SB(1, 1), b3 + hB, voffB); PG8_STAGE(PG8_SA(1, 0), a3, voffA);
            PG8_WAIT_V(8); PG8_WAIT_L(0); PG8_BAR; PG8_MMA(1, 0, At, B0); PG8_MMA(1, 1, At, B1); PG8_BAR; PG8_SCHED;
            } else {
            PG8_LDB(B0, 0, 0); PG8_SCHED; PG8_LDA(At, 0, 0); PG8_STAGE(PG8_SA(1, 1), a1 + hA, voffA);
            PG8_WAIT_L(8); PG8_BAR; PG8_WAIT_L(0); PG8_MMA(0, 0, At, B0); PG8_BAR; PG8_SCHED;
            PG8_LDB(B1, 0, 1); PG8_STAGE(PG8_SB(0, 0), b2, voffB);
            PG8_BAR; PG8_WAIT_L(0); PG8_MMA(0, 1, At, B1); PG8_BAR;
            PG8_LDA(At, 0, 1); PG8_STAGE(PG8_SA(0, 0), a2, voffA);
            PG8_BAR; PG8_WAIT_L(0); PG8_MMA(1, 0, At, B0); PG8_BAR; PG8_SCHED;
            PG8_STAGE(PG8_SB(0, 1), b2 + hB, voffB);
            PG8_WAIT_V(6); PG8_BAR; PG8_MMA(1, 1, At, B1); PG8_BAR;
            PG8_LDB(B0, 1, 0); PG8_SCHED; PG8_LDA(At, 1, 0); PG8_STAGE(PG8_SA(0, 1), a2 + hA, voffA);
            PG8_WAIT_L(8); PG8_BAR; PG8_WAIT_L(0); PG8_MMA(0, 0, At, B0); PG8_BAR; PG8_SCHED;
            PG8_LDB(B1, 1, 1); PG8_STAGE(PG8_SB(1, 0), b3, voffB);
            PG8_BAR; PG8_WAIT_L(0); PG8_MMA(0, 1, At, B1); PG8_BAR;
            PG8_LDA(At, 1, 1); PG8_STAGE(PG8_SA(1, 0), a3, voffA);
            PG8_BAR; PG8_WAIT_L(0); PG8_MMA(1, 0, At, B0); PG8_BAR; PG8_SCHED;
            PG8_STAGE(PG8_SB(1, 1), b3 + hB, voffB);
            PG8_WAIT_V(6); PG8_BAR; PG8_MMA(1, 1, At, B1); PG8_BAR;
            }
        }
        if constexpr (ALIGN_EPI) { if (wr == 0) PG8_BAR; }
        if constexpr (!Epi::AFTER_DRAIN) { E(acc, cur, wr, wc, fr, fq); S.done(cur); }
        if (!has_next) break;
#pragma unroll
        for (int a = 0; a < 2; ++a)
#pragma unroll
            for (int b = 0; b < 2; ++b)
#pragma unroll
                for (int m = 0; m < 4; ++m)
#pragma unroll
                    for (int n = 0; n < 2; ++n) acc[a][b][m][n] = (f32x4){0.f, 0.f, 0.f, 0.f};
        cur = nxt; cA = nA; cB = nB; ++ui;
        if constexpr (ALIGN_EPI) { if (wr == 1) PG8_BAR; }
    }
    PG8_WAIT_V(0);
    if constexpr (!ALIGN_EPI) { if (wr == 0) PG8_BAR; }
    PG8_BAR;
    if constexpr (Epi::AFTER_DRAIN) { E.fused(acc, cur, wr, wc, fr, fq, lds, wid, lane); S.done(cur); }
#undef PG8_SA
#undef PG8_SB
#undef PG8_STAGE
#undef PG8_LDA
#undef PG8_LDB
#undef PG8_MMA
#undef PG8_WAIT_V
#undef PG8_WAIT_L
#undef PG8_BAR
#undef PG8_SCHED
}
}

#ifndef ONE_LAUNCH
#define ONE_LAUNCH 0
#endif
constexpr int NWAVES = 8, NTHR = 512;
constexpr int D = 1024, BATCH = 4, SEQ = 8192, NMETA = 16, TT = SEQ + NMETA;
constexpr int NREAL = BATCH * SEQ;
constexpr int NROWS = NREAL + NMETA;
constexpr int R = 33024;
constexpr int PW = 2304;
constexpr int PC_CQ = 0, PC_CKV = 256, PC_KIDX = 384, PC_WIDX = 448, PC_R = 512, PC_K = 1024, PC_V = 1536, PC_WD = 2048, PC_AD = 2112, PC_GD = 2176;
constexpr int QAW = 1536;
constexpr int DFF = 2816, UPW = 5632;
constexpr int TOPK = 256;
constexpr float LN_EPS = 1e-5f, GN_EPS = 64e-5f, ALPHA = 1.18920711500272f;

constexpr size_t MiB = 1u << 20;
constexpr size_t WS_CTL = 0, CTL_ZERO_BYTES = 1 * MiB;
constexpr size_t WS_WT_IN = 1 * MiB, WS_WT_QA = 6 * MiB, WS_WT_MIX = 7 * MiB, WS_WT_UP = 10 * MiB, WS_WT_DN = 21 * MiB;
constexpr size_t WS_META1 = 27 * MiB, WS_NSEL = 28 * MiB, WS_WIDX = 29 * MiB;
constexpr size_t WS_H = 33 * MiB;
constexpr size_t WS_P = 98 * MiB, WS_QA = 244 * MiB, WS_CQN = 341 * MiB, WS_SEL = 341 * MiB, WS_CKV = 358 * MiB, WS_KIDX = 367 * MiB;
constexpr size_t WS_DEC = 372 * MiB, WS_AB = 437 * MiB, WS_GB = 470 * MiB;
constexpr size_t WS_UP = 98 * MiB;
constexpr size_t WS_END = 512 * MiB;
static_assert(WS_P + (size_t)R * PW * 2 <= WS_QA && WS_QA + (size_t)R * QAW * 2 <= WS_CQN && WS_CQN + (size_t)R * 256 * 2 <= WS_CKV && WS_CKV + (size_t)R * 128 * 2 <= WS_KIDX
              && WS_KIDX + (size_t)R * 64 * 2 <= WS_DEC && WS_DEC + (size_t)R * 512 * 4 <= WS_AB && WS_AB + (size_t)R * 512 * 2 <= WS_GB && WS_GB + (size_t)R * 512 * 2 <= WS_END
              && WS_UP + (size_t)R * UPW * 2 <= WS_END && WS_H + (size_t)R * D * 2 <= WS_P && WS_WIDX + (size_t)R * 8 * 4 <= WS_H && WS_NSEL + (size_t)R * 4 <= WS_WIDX, "ws map");
constexpr int CW_BAR = 4096;

constexpr int RING_OFF = 0, RING_BYTES = 131072;
constexpr int LDSCTL_OFF = RING_BYTES, MISC_OFF = LDSCTL_OFF + 320;
constexpr int LDS_BYTES = 147456;

#define GAS __attribute__((address_space(1)))
#define LAS __attribute__((address_space(3)))
typedef unsigned short bf16;
typedef unsigned v4u __attribute__((ext_vector_type(4)));
typedef unsigned v2u __attribute__((ext_vector_type(2)));
typedef float f32x4 __attribute__((ext_vector_type(4)));
typedef GAS unsigned gu32;
__device__ __forceinline__ unsigned f2bf(float f) { unsigned u = __builtin_bit_cast(unsigned, f); return (u + 0x7fffu + ((u >> 16) & 1u)) >> 16; }
__device__ __forceinline__ unsigned pk2(float lo, float hi) { return f2bf(lo) | (f2bf(hi) << 16); }
__device__ __forceinline__ float bf2f(unsigned short b) { return __uint_as_float(((unsigned)b) << 16); }
__device__ __forceinline__ float bflo(unsigned w) { return __uint_as_float(w << 16); }
__device__ __forceinline__ float bfhi(unsigned w) { return __uint_as_float(w & 0xffff0000u); }
__device__ __forceinline__ float wave_sum(float v) {
#pragma unroll
    for (int o = 1; o < 64; o <<= 1) v += __shfl_xor(v, o);
    return v;
}
__device__ __forceinline__ float wave_max(float v) {
#pragma unroll
    for (int o = 1; o < 64; o <<= 1) v = fmaxf(v, __shfl_xor(v, o));
    return v;
}
__device__ __forceinline__ float sigmoidf_(float x) { return 1.0f / (1.0f + __expf(-x)); }
#define XB_TMO      128
#define XB_XCNT(j)  (256  + 64 * (j))
#define XB_XSUB(j)  (1280 + 64 * (j))
#define XB_XGEN(j)  (2304 + 64 * (j))
#define XB_TOP      3328
#define XB_TOPGEN   3392
#define XCD_BAR_WORDS 3456
#define XB_SPIN_CAP (1u << 18)

__device__ __forceinline__ unsigned xb_ld(unsigned* p)              { return __hip_atomic_load(p, __ATOMIC_RELAXED, __HIP_MEMORY_SCOPE_AGENT); }
__device__ __forceinline__ unsigned xb_add(unsigned* p, unsigned v) { return __hip_atomic_fetch_add(p, v, __ATOMIC_RELAXED, __HIP_MEMORY_SCOPE_AGENT); }
__device__ __forceinline__ unsigned xb_xcc_id() { return (unsigned)__builtin_amdgcn_s_getreg((3 << 11) | 20) & 0xFu; }
#define XB_SPIN(cond, bar) do { unsigned _sp = 0; while (cond) { __builtin_amdgcn_s_sleep(1); \
    if ((++_sp & 255u) == 0u) { if (xb_ld(&(bar)[XB_TMO])) break; if (_sp > XB_SPIN_CAP) { atomicAdd(&(bar)[XB_TMO], 1u); break; } } } } while (0)

struct XcdBarrier {
    unsigned* bar; unsigned x;
    volatile LAS unsigned* st;
};

__device__ __forceinline__ XcdBarrier xcd_barrier_post(unsigned* bar, volatile LAS unsigned* st) {
    XcdBarrier b; b.bar = bar; b.x = xb_xcc_id(); b.st = st;
    if (threadIdx.x == 0) (void)xb_add(&bar[XB_XCNT(b.x)], 1u);
    return b;
}
__device__ __forceinline__ void xcd_barrier_complete(unsigned* bar, unsigned x, unsigned& nloc, unsigned& nx) {
    const unsigned G = gridDim.x * gridDim.y * gridDim.z;
    unsigned sum, cnt, mine, sp = 0u;
    for (;;) {
        sum = 0u; cnt = 0u; mine = 0u;
#pragma unroll
        for (unsigned j = 0; j < 16; ++j) { const unsigned c = xb_ld(&bar[XB_XCNT(j)]); sum += c; cnt += (c > 0u) ? 1u : 0u; mine = (j == x) ? c : mine; }
        if (sum == G) break;
        __builtin_amdgcn_s_sleep(1);
        if ((++sp & 255u) == 0u) { if (xb_ld(&bar[XB_TMO])) break; if (sp > XB_SPIN_CAP) { atomicAdd(&bar[XB_TMO], 1u); break; } }
    }
    nloc = mine > 0u ? mine : 1u; nx = cnt > 0u ? cnt : 1u;
}

__device__ __forceinline__ void xcd_barrier(const XcdBarrier& b) {
    asm volatile("s_waitcnt vmcnt(0)" ::: "memory");
    __syncthreads();
    if (threadIdx.x == 0) {
        unsigned* bar = b.bar;
        __builtin_amdgcn_s_waitcnt(0);
        unsigned nloc = b.st[0], nx = b.st[1];
        if (nloc == 0u) { xcd_barrier_complete(bar, b.x, nloc, nx); b.st[0] = nloc; b.st[1] = nx; }
        const unsigned old = xb_add(&bar[XB_XSUB(b.x)], 1u);
        const unsigned gen = old / nloc;
        if (old + 1u == (gen + 1u) * nloc) {
            __builtin_amdgcn_fence(__ATOMIC_RELEASE, "agent");
            asm volatile("s_waitcnt vmcnt(0)" ::: "memory");
            const unsigned og = xb_add(&bar[XB_TOP], 1u);
            const unsigned tg = og / nx;
            if (og + 1u == (tg + 1u) * nx) xb_add(&bar[XB_TOPGEN], 1u);
            else XB_SPIN(xb_ld(&bar[XB_TOPGEN]) == tg, bar);
            __builtin_amdgcn_fence(__ATOMIC_ACQUIRE, "agent");
            xb_add(&bar[XB_XGEN(b.x)], 1u);
            asm volatile("s_waitcnt vmcnt(0)" ::: "memory");
        } else {
            XB_SPIN(xb_ld(&bar[XB_XGEN(b.x)]) == gen, bar);
            __builtin_amdgcn_fence(__ATOMIC_ACQUIRE, "agent");
            asm volatile("s_waitcnt vmcnt(0)" ::: "memory");
        }
    }
    __syncthreads();
}

struct Frame {
    LAS unsigned char* lds;
    volatile LAS unsigned* MISC;
    gu32* ctl;
    int tid, lane, wave, G;
    const float* in[32];
    float* out;
    unsigned char* ws;
};
#define IN_X 0
#define IN_META 1
#define IN_LNIN_G 2
#define IN_LNIN_B 3
#define IN_W_IN 4
#define IN_QNORM_G 5
#define IN_W_UQ 6
#define IN_KVNORM_G 7
#define IN_W_UKV 8
#define IN_W_IQ 9
#define IN_IDXLN_G 10
#define IN_IDXLN_B 11
#define IN_MU 12
#define IN_W0 13
#define IN_W_DEC 14
#define IN_A0 15
#define IN_W_AAA 16
#define IN_W_GATE 17
#define IN_KK 18
#define IN_KA 19
#define IN_RK 20
#define IN_GN_G 21
#define IN_GN_B 22
#define IN_W_OUT 23
#define IN_LN1_G 24
#define IN_LN1_B 25
#define IN_W_UP 26
#define IN_CONV_W 27
#define IN_CONV_B 28
#define IN_W_DN 29
#define IN_LN2_G 30
#define IN_LN2_B 31

#define WSP(T, off) ((T*)(F.ws + (off)))

__device__ __forceinline__ int key_row(int b, int j) { return j < NMETA ? NREAL + j : b * SEQ + (j - NMETA); }

__device__ __forceinline__ void tr_items(Frame& F, const float* src, int src_ld, int src_r0, bf16* dst, int dst_ld, int dst_c0, int Nn, int K, int cut0, int cut1, int shift) {
    const int total = Nn * (K / 8);
    for (int it = blockIdx.x * NTHR + F.tid; it < total; it += F.G * NTHR) {
        const int n = it % Nn, kc = it / Nn;
        const int col = n < cut0 ? n : (n < cut1 ? -1 : n - shift);
        float v[8];
#pragma unroll
        for (int e = 0; e < 8; ++e) v[e] = col >= 0 ? src[(size_t)(src_r0 + 8 * kc + e) * src_ld + col] : 0.f;
        v4u o; o.x = pk2(v[0], v[1]); o.y = pk2(v[2], v[3]); o.z = pk2(v[4], v[5]); o.w = pk2(v[6], v[7]);
        *(v4u*)(dst + (size_t)n * dst_ld + dst_c0 + 8 * kc) = o;
    }
}
__device__ __forceinline__ void p0_weights(Frame& F) {
    bf16* WT_IN = WSP(bf16, WS_WT_IN); bf16* WT_QA = WSP(bf16, WS_WT_QA); bf16* WT_MIX = WSP(bf16, WS_WT_MIX); bf16* WT_UP = WSP(bf16, WS_WT_UP); bf16* WT_DN = WSP(bf16, WS_WT_DN);
    tr_items(F, F.in[IN_W_IN], 2248, 0, WT_IN, D, 0, PW, D, 456, 512, 56);
    tr_items(F, F.in[IN_W_UP], UPW, 0, WT_UP, D, 0, UPW, D, UPW, UPW, 0);
    tr_items(F, F.in[IN_W_DN], D, 0, WT_DN, DFF, 0, D, DFF, D, D, 0);
    tr_items(F, F.in[IN_W_IQ], 512, 0, WT_QA + (size_t)1024 * 256, 256, 0, 512, 256, 512, 512, 0);
    tr_items(F, F.in[IN_W_OUT], D, 512, WT_MIX, 1536, 1024, D, 512, D, D, 0);
    const float* w_uq = F.in[IN_W_UQ]; const float* w_ukv = F.in[IN_W_UKV]; const float* w_out = F.in[IN_W_OUT];
    for (int it = blockIdx.x * NTHR + F.tid; it < 1024 * 256; it += F.G * NTHR) {
        const int c = it & 255, n = it >> 8, h = n >> 7, j = n & 127;
        float s = 0.f;
        for (int d = 0; d < 64; ++d) s += w_uq[(size_t)c * 512 + h * 64 + d] * w_ukv[(size_t)j * 1024 + h * 128 + d];
        WT_QA[(size_t)n * 256 + c] = (bf16)f2bf(0.125f * s);
    }
    for (int it = blockIdx.x * NTHR + F.tid; it < 1024 * 1024; it += F.G * NTHR) {
        const int n = it & 1023, k = it >> 10, h = k >> 7, j = k & 127;
        float s = 0.f;
        for (int d = 0; d < 64; ++d) s += w_ukv[(size_t)j * 1024 + h * 128 + 64 + d] * w_out[(size_t)(h * 64 + d) * D + n];
        WT_MIX[(size_t)n * 1536 + k] = (bf16)f2bf(s);
    }
}

__device__ __forceinline__ void ln_row_bf16(Frame& F, const float* src, const float* g, const float* b, bf16* dst) {
    v2u* o8 = (v2u*)dst + F.lane;
    if (!src) {
#pragma unroll
        for (int j = 0; j < 4; ++j) o8[64 * j] = (v2u){0u, 0u};
        return;
    }
    const f32x4* xr = (const f32x4*)src + F.lane;
    f32x4 v[4]; float s = 0.f;
#pragma unroll
    for (int j = 0; j < 4; ++j) { v[j] = xr[64 * j]; s += (v[j].x + v[j].y) + (v[j].z + v[j].w); }
    const float mean = wave_sum(s) * (1.f / D); float s2 = 0.f;
#pragma unroll
    for (int j = 0; j < 4; ++j) { v[j] = v[j] - mean; s2 += (v[j].x * v[j].x + v[j].y * v[j].y) + (v[j].z * v[j].z + v[j].w * v[j].w); }
    const float rstd = 1.f / sqrtf(wave_sum(s2) * (1.f / D) + LN_EPS);
#pragma unroll
    for (int j = 0; j < 4; ++j) {
        const f32x4 gg = ((const f32x4*)g)[F.lane + 64 * j], bb = ((const f32x4*)b)[F.lane + 64 * j];
        const f32x4 y = v[j] * rstd * gg + bb;
        o8[64 * j] = (v2u){pk2(y.x, y.y), pk2(y.z, y.w)};
    }
}
__device__ __forceinline__ void p1_ln_in(Frame& F) {
    bf16* H0 = WSP(bf16, WS_H);
    const int gw = blockIdx.x * NWAVES + F.wave, NGW = F.G * NWAVES;
    for (int r = gw; r < R; r += NGW) {
        const float* src = r < NREAL ? F.in[IN_X] + (size_t)r * D : (r < NROWS ? F.in[IN_META] + (size_t)(r - NREAL) * D : nullptr);
        ln_row_bf16(F, src, F.in[IN_LNIN_G], F.in[IN_LNIN_B], H0 + (size_t)r * D);
    }
}

__device__ __forceinline__ void p3_prep(Frame& F) {
    const bf16* P = WSP(bf16, WS_P); bf16* CQN = WSP(bf16, WS_CQN); bf16* CKV = WSP(bf16, WS_CKV); bf16* KIDX = WSP(bf16, WS_KIDX); float* WIDX = WSP(float, WS_WIDX);
    const int gw = blockIdx.x * NWAVES + F.wave, NGW = F.G * NWAVES, l = F.lane;
    for (int r = gw; r < R; r += NGW) {
        const bf16* pr = P + (size_t)r * PW;
        if (r >= NROWS) {
            *(v2u*)(CQN + (size_t)r * 256 + 4 * l) = (v2u){0u, 0u};
            continue;
        }
        {
            const v2u w = *(const v2u*)(pr + PC_CQ + 4 * l);
            const float a0 = bflo(w.x), a1 = bfhi(w.x), a2 = bflo(w.y), a3 = bfhi(w.y);
            const float ss = wave_sum(a0 * a0 + a1 * a1 + a2 * a2 + a3 * a3);
            const float rs = 1.0f / sqrtf(ss * (1.f / 256.f) + 1e-6f);
            const f32x4 g = ((const f32x4*)F.in[IN_QNORM_G])[l];
            *(v2u*)(CQN + (size_t)r * 256 + 4 * l) = (v2u){pk2(a0 * rs * g.x, a1 * rs * g.y), pk2(a2 * rs * g.z, a3 * rs * g.w)};
        }
        {
            const unsigned w = *(const unsigned*)(pr + PC_CKV + 2 * l);
            const float a0 = bflo(w), a1 = bfhi(w);
            const float ss = wave_sum(a0 * a0 + a1 * a1);
            const float rs = 1.0f / sqrtf(ss * (1.f / 128.f) + 1e-6f);
            const float g0 = F.in[IN_KVNORM_G][2 * l], g1 = F.in[IN_KVNORM_G][2 * l + 1];
            *(unsigned*)(CKV + (size_t)r * 128 + 2 * l) = pk2(a0 * rs * g0, a1 * rs * g1);
        }
        {
            const float a = bf2f(pr[PC_KIDX + l]);
            const float mean = wave_sum(a) * (1.f / 64.f);
            const float dlt = a - mean;
            const float var = wave_sum(dlt * dlt) * (1.f / 64.f);
            const float y = dlt * (1.0f / sqrtf(var + LN_EPS)) * F.in[IN_IDXLN_G][l] + F.in[IN_IDXLN_B][l];
            KIDX[(size_t)r * 64 + l] = (bf16)f2bf(y);
        }
        if (l < 8) WIDX[(size_t)r * 8 + l] = bf2f(pr[PC_WIDX + l]) * 0.04419417382415922f;
    }
}

#ifndef REFSEL
#define REFSEL 0
#endif
__device__ __forceinline__ void refsel_rows(Frame& F) {
    float* QIDX32 = F.out; float* KIDX32 = F.out + (size_t)R * 512; float* WIDX = WSP(float, WS_WIDX);
    const float* w_in = F.in[IN_W_IN]; const float* w_iq = F.in[IN_W_IQ];
    LAS float* hrow = (LAS float*)(F.lds + F.wave * 8192);
    LAS float* cqn = hrow + 1024;
    const int l = F.lane;
    const int gw = blockIdx.x * NWAVES + F.wave, NGW = F.G * NWAVES;
    for (int r = gw; r < NROWS; r += NGW) {
        const float* src = r < NREAL ? F.in[IN_X] + (size_t)r * D : F.in[IN_META] + (size_t)(r - NREAL) * D;
        {
            const f32x4* xr = (const f32x4*)src + l;
            f32x4 v[4]; float s = 0.f;
#pragma unroll
            for (int j = 0; j < 4; ++j) { v[j] = xr[64 * j]; s += (v[j].x + v[j].y) + (v[j].z + v[j].w); }
            const float mean = wave_sum(s) * (1.f / D); float s2 = 0.f;
#pragma unroll
            for (int j = 0; j < 4; ++j) { v[j] = v[j] - mean; s2 += (v[j].x * v[j].x + v[j].y * v[j].y) + (v[j].z * v[j].z + v[j].w * v[j].w); }
            const float rstd = 1.f / sqrtf(wave_sum(s2) * (1.f / D) + LN_EPS);
#pragma unroll
            for (int j = 0; j < 4; ++j) {
                const f32x4 gg = ((const f32x4*)F.in[IN_LNIN_G])[l + 64 * j], bb = ((const f32x4*)F.in[IN_LNIN_B])[l + 64 * j];
                *(LAS f32x4*)(hrow + 4 * (l + 64 * j)) = v[j] * rstd * gg + bb;
            }
        }
        __builtin_amdgcn_wave_barrier();
        float a[6];
#pragma unroll
        for (int i = 0; i < 6; ++i) a[i] = 0.f;
        for (int k = 0; k < D; ++k) {
            const float hk = hrow[k]; const float* wr = w_in + (size_t)k * 2248;
#pragma unroll
            for (int i = 0; i < 4; ++i) a[i] += hk * wr[l + 64 * i];
            a[4] += hk * wr[384 + l];
            a[5] += hk * wr[448 + (l & 7)];
        }
        const float ss = wave_sum(a[0] * a[0] + a[1] * a[1] + a[2] * a[2] + a[3] * a[3]);
        const float rs = 1.0f / sqrtf(ss * (1.f / 256.f) + 1e-6f);
#pragma unroll
        for (int i = 0; i < 4; ++i) cqn[l + 64 * i] = a[i] * rs * F.in[IN_QNORM_G][l + 64 * i];
        {
            const float mean = wave_sum(a[4]) * (1.f / 64.f); const float dlt = a[4] - mean;
            const float var = wave_sum(dlt * dlt) * (1.f / 64.f);
            KIDX32[(size_t)r * 64 + l] = dlt * (1.0f / sqrtf(var + LN_EPS)) * F.in[IN_IDXLN_G][l] + F.in[IN_IDXLN_B][l];
        }
        if (l < 8) WIDX[(size_t)r * 8 + l] = a[5] * 0.04419417382415922f;
        __builtin_amdgcn_wave_barrier();
        float q[8];
#pragma unroll
        for (int i = 0; i < 8; ++i) q[i] = 0.f;
        for (int c = 0; c < 256; ++c) {
            const float cq = cqn[c]; const float* wr = w_iq + (size_t)c * 512;
#pragma unroll
            for (int i = 0; i < 8; ++i) q[i] += cq * wr[l + 64 * i];
        }
#pragma unroll
        for (int i = 0; i < 8; ++i) QIDX32[(size_t)r * 512 + l + 64 * i] = q[i];
        __builtin_amdgcn_wave_barrier();
    }
}

__device__ __forceinline__ unsigned sortable(float f) { const unsigned u = __float_as_uint(f); return (u & 0x80000000u) ? ~u : (u | 0x80000000u); }
__device__ __forceinline__ void p5_index_naive(Frame& F) {
    const bf16* QA = WSP(bf16, WS_QA); const bf16* KIDX = WSP(bf16, WS_KIDX); const float* WIDX = WSP(float, WS_WIDX);
    unsigned short* SEL = WSP(unsigned short, WS_SEL); int* NSEL = WSP(int, WS_NSEL);
    LAS float* sc = (LAS float*)(F.lds);
    LAS float* qf = (LAS float*)(F.lds + 33024);
    LAS unsigned* hist = (LAS unsigned*)(F.lds + 33024 + 2048);
    LAS unsigned* cw = hist + 256;
    const int tid = F.tid;
    for (int q = blockIdx.x; q < NROWS; q += F.G) {
        int b, pos; if (q < NREAL) { b = q >> 13; pos = NMETA + (q & (SEQ - 1)); } else { b = 0; pos = q - NREAL; }
        const int nvis = pos < NMETA ? NMETA : NMETA + 64 * ((pos - NMETA) / 64 + 1);
#if REFSEL
        qf[tid] = F.out[(size_t)q * 512 + tid];
#else
        qf[tid] = bf2f(QA[(size_t)q * QAW + 1024 + tid]);
#endif
        float w[8];
#pragma unroll
        for (int h = 0; h < 8; ++h) w[h] = WIDX[(size_t)q * 8 + h];
        __syncthreads();
        for (int j = tid; j < nvis; j += NTHR) {
            const v4u* kp = (const v4u*)(KIDX + (size_t)key_row(b, j) * 64);
#if REFSEL
            const f32x4* kp32 = (const f32x4*)(F.out + (size_t)R * 512 + (size_t)key_row(b, j) * 64);
#endif
            float d[8];
#pragma unroll
            for (int h = 0; h < 8; ++h) d[h] = 0.f;
#pragma unroll 2
            for (int c = 0; c < 8; ++c) {
#if REFSEL
                const f32x4 ta = kp32[2 * c], tb = kp32[2 * c + 1];
                const float k0 = ta.x, k1 = ta.y, k2 = ta.z, k3 = ta.w, k4 = tb.x, k5 = tb.y, k6 = tb.z, k7 = tb.w;
#else
                const v4u t = kp[c];
                const float k0 = bflo(t.x), k1 = bfhi(t.x), k2 = bflo(t.y), k3 = bfhi(t.y), k4 = bflo(t.z), k5 = bfhi(t.z), k6 = bflo(t.w), k7 = bfhi(t.w);
#endif
#pragma unroll
                for (int h = 0; h < 8; ++h) {
                    const f32x4 qa = *(const LAS f32x4*)(qf + h * 64 + 8 * c), qb = *(const LAS f32x4*)(qf + h * 64 + 8 * c + 4);
                    d[h] += qa.x * k0 + qa.y * k1 + qa.z * k2 + qa.w * k3 + qb.x * k4 + qb.y * k5 + qb.z * k6 + qb.w * k7;
                }
            }
            float s = 0.f;
#pragma unroll
            for (int h = 0; h < 8; ++h) s += w[h] * fmaxf(d[h], 0.f);
            sc[j] = s + 0.0f;
        }
        __syncthreads();
        unsigned short* selq = SEL + (size_t)q * TOPK;
        if (nvis <= TOPK) {
            for (int j = tid; j < nvis; j += NTHR) selq[j] = (unsigned short)j;
        } else {
            unsigned prefix = 0u, mask = 0u, need = TOPK;
            for (int pass = 0; pass < 4; ++pass) {
                const int shift = 24 - 8 * pass;
                if (tid < 256) hist[tid] = 0u;
                __syncthreads();
                for (int j = tid; j < nvis; j += NTHR) { const unsigned key = sortable(sc[j]); if ((key & mask) == prefix) atomicAdd((unsigned*)&hist[(key >> shift) & 255u], 1u); }
                __syncthreads();
                if (tid < 256) {
                    unsigned above = 0u; for (int bb = tid + 1; bb < 256; ++bb) above += hist[bb];
                    const unsigned c = hist[tid];
                    if (above < need && need <= above + c) { cw[0] = prefix | ((unsigned)tid << shift); cw[1] = need - above; }
                }
                __syncthreads();
                prefix = cw[0]; need = cw[1]; mask |= 0xFFu << shift;
                __syncthreads();
            }
            if (tid == 0) cw[2] = 0u;
            __syncthreads();
            for (int j = tid; j < nvis; j += NTHR) { if (sortable(sc[j]) > prefix) { const unsigned p = atomicAdd((unsigned*)&cw[2], 1u); selq[p] = (unsigned short)j; } }
            __syncthreads();
            if (F.wave == 0) {
                const unsigned base = cw[2]; unsigned taken = 0u;
                for (int j0 = 0; j0 < nvis && taken < need; j0 += 64) {
                    const int j = j0 + F.lane; const bool eq = j < nvis && sortable(sc[j]) == prefix;
                    const unsigned long long m = __ballot(eq);
                    const unsigned rank = (unsigned)__popcll(m & ((1ull << F.lane) - 1ull));
                    if (eq && taken + rank < need) selq[base + taken + rank] = (unsigned short)j;
                    taken += (unsigned)__popcll(m);
                }
            }
        }
        if (tid == 0) NSEL[q] = nvis < TOPK ? nvis : TOPK;
        __syncthreads();
    }
}

__device__ __forceinline__ void p6_attn_naive(Frame& F) {
    bf16* QA = WSP(bf16, WS_QA); const bf16* CKV = WSP(bf16, WS_CKV); const unsigned short* SEL = WSP(unsigned short, WS_SEL); const int* NSEL = WSP(int, WS_NSEL);
    LAS float* qf = (LAS float*)(F.lds + F.wave * 16384);
    LAS float* ps = qf + 1024;
    LAS int* srow = (LAS int*)(ps + 2048);
    const int l = F.lane;
    const int gw = blockIdx.x * NWAVES + F.wave, NGW = F.G * NWAVES;
    for (int q = gw; q < R; q += NGW) {
        bf16* qrow = QA + (size_t)q * QAW;
        if (q >= NROWS) {
            for (int c = l; c < QAW / 8; c += 64) *(v4u*)(qrow + 8 * c) = (v4u){0u, 0u, 0u, 0u};
            continue;
        }
        int b, pos; if (q < NREAL) { b = q >> 13; pos = NMETA + (q & (SEQ - 1)); } else { b = 0; pos = q - NREAL; }
        const int nsel = NSEL[q];
        {
            const v4u t0 = *(const v4u*)(qrow + 16 * l), t1 = *(const v4u*)(qrow + 16 * l + 8);
            LAS float* d = qf + 16 * l;
            d[0] = bflo(t0.x); d[1] = bfhi(t0.x); d[2] = bflo(t0.y); d[3] = bfhi(t0.y); d[4] = bflo(t0.z); d[5] = bfhi(t0.z); d[6] = bflo(t0.w); d[7] = bfhi(t0.w);
            d[8] = bflo(t1.x); d[9] = bfhi(t1.x); d[10] = bflo(t1.y); d[11] = bfhi(t1.y); d[12] = bflo(t1.z); d[13] = bfhi(t1.z); d[14] = bflo(t1.w); d[15] = bfhi(t1.w);
        }
        __builtin_amdgcn_wave_barrier();
        for (int kk = 0; kk < 4; ++kk) {
            const int s = kk * 64 + l; const bool valid = s < nsel;
            const int j = valid ? (int)SEL[(size_t)q * TOPK + s] : 0;
            const int row = key_row(b, j);
            srow[s] = row;
            float acc[8];
#pragma unroll
            for (int h = 0; h < 8; ++h) acc[h] = 0.f;
            const v4u* kp = (const v4u*)(CKV + (size_t)row * 128);
            for (int c8 = 0; c8 < 16; ++c8) {
                const v4u t = kp[c8];
                const float k0 = bflo(t.x), k1 = bfhi(t.x), k2 = bflo(t.y), k3 = bfhi(t.y), k4 = bflo(t.z), k5 = bfhi(t.z), k6 = bflo(t.w), k7 = bfhi(t.w);
#pragma unroll
                for (int h = 0; h < 8; ++h) {
                    const f32x4 qa = *(const LAS f32x4*)(qf + h * 128 + 8 * c8), qb = *(const LAS f32x4*)(qf + h * 128 + 8 * c8 + 4);
                    acc[h] += qa.x * k0 + qa.y * k1 + qa.z * k2 + qa.w * k3 + qb.x * k4 + qb.y * k5 + qb.z * k6 + qb.w * k7;
                }
            }
            const float dist = fabsf((float)(pos - j));
#pragma unroll
            for (int h = 0; h < 8; ++h) { const float slope = __uint_as_float((unsigned)(127 - (h + 1)) << 23); ps[s * 8 + h] = valid ? acc[h] - slope * dist : -INFINITY; }
        }
        __builtin_amdgcn_wave_barrier();
#pragma unroll
        for (int h = 0; h < 8; ++h) {
            float v0 = ps[(l) * 8 + h], v1 = ps[(l + 64) * 8 + h], v2 = ps[(l + 128) * 8 + h], v3 = ps[(l + 192) * 8 + h];
            const float mx = wave_max(fmaxf(fmaxf(v0, v1), fmaxf(v2, v3)));
            v0 = __expf(v0 - mx); v1 = __expf(v1 - mx); v2 = __expf(v2 - mx); v3 = __expf(v3 - mx);
            const float inv = 1.0f / wave_sum((v0 + v1) + (v2 + v3));
            ps[(l) * 8 + h] = v0 * inv; ps[(l + 64) * 8 + h] = v1 * inv; ps[(l + 128) * 8 + h] = v2 * inv; ps[(l + 192) * 8 + h] = v3 * inv;
        }
        __builtin_amdgcn_wave_barrier();
        float o0[8], o1[8];
#pragma unroll
        for (int h = 0; h < 8; ++h) { o0[h] = 0.f; o1[h] = 0.f; }
        for (int s = 0; s < nsel; ++s) {
            const int row = srow[s];
            const unsigned w = *(const unsigned*)(CKV + (size_t)row * 128 + 2 * l);
            const float c0 = bflo(w), c1 = bfhi(w);
            const f32x4 pa = *(const LAS f32x4*)(ps + s * 8), pb = *(const LAS f32x4*)(ps + s * 8 + 4);
            o0[0] += pa.x * c0; o1[0] += pa.x * c1; o0[1] += pa.y * c0; o1[1] += pa.y * c1; o0[2] += pa.z * c0; o1[2] += pa.z * c1; o0[3] += pa.w * c0; o1[3] += pa.w * c1;
            o0[4] += pb.x * c0; o1[4] += pb.x * c1; o0[5] += pb.y * c0; o1[5] += pb.y * c1; o0[6] += pb.z * c0; o1[6] += pb.z * c1; o0[7] += pb.w * c0; o1[7] += pb.w * c1;
        }
#pragma unroll
        for (int h = 0; h < 8; ++h) *(unsigned*)(qrow + h * 128 + 2 * l) = pk2(o0[h], o1[h]);
        __builtin_amdgcn_wave_barrier();
    }
}

__device__ __forceinline__ void p7_rwkv_prep_naive(Frame& F) {
    const bf16* P = WSP(bf16, WS_P); float* DEC = WSP(float, WS_DEC); bf16* AB = WSP(bf16, WS_AB); bf16* GB = WSP(bf16, WS_GB);
    const float* mu = F.in[IN_MU]; const float* Wd = F.in[IN_W_DEC]; const float* Wa = F.in[IN_W_AAA]; const float* Wg = F.in[IN_W_GATE];
    const int l = F.lane;
    const int gw = blockIdx.x * NWAVES + F.wave, NGW = F.G * NWAVES;
    for (int r = gw; r < NROWS; r += NGW) {
        int prev; if (r < NREAL) { prev = (r & (SEQ - 1)) ? r - 1 : NREAL + NMETA - 1; } else { prev = r > NREAL ? r - 1 : -1; }
        const bf16* pr = P + (size_t)r * PW; const bf16* pp = prev >= 0 ? P + (size_t)prev * PW : nullptr;
#define SHIFTED(pc, mc) (bf2f(pr[pc]) + ((pp ? bf2f(pp[pc]) : 0.f) - bf2f(pr[pc])) * mu[mc])
        const float tw = tanhf(SHIFTED(PC_WD + l, 1536 + l));
        const float ta = SHIFTED(PC_AD + l, 1600 + l);
        const float tg0 = sigmoidf_(SHIFTED(PC_GD + l, 1664 + l)), tg1 = sigmoidf_(SHIFTED(PC_GD + 64 + l, 1728 + l));
#undef SHIFTED
        float aw[8], aa[8], ag[8];
#pragma unroll
        for (int i = 0; i < 8; ++i) { aw[i] = F.in[IN_W0][l + 64 * i]; aa[i] = F.in[IN_A0][l + 64 * i]; ag[i] = 0.f; }
        for (int j = 0; j < 64; ++j) {
            const float xw = __shfl(tw, j), xa = __shfl(ta, j), xg0 = __shfl(tg0, j), xg1 = __shfl(tg1, j);
#pragma unroll
            for (int i = 0; i < 8; ++i) {
                aw[i] += xw * Wd[(size_t)j * 512 + l + 64 * i];
                aa[i] += xa * Wa[(size_t)j * 512 + l + 64 * i];
                ag[i] += xg0 * Wg[(size_t)j * 512 + l + 64 * i] + xg1 * Wg[(size_t)(j + 64) * 512 + l + 64 * i];
            }
        }
#pragma unroll
        for (int i = 0; i < 8; ++i) {
            const float x = -aw[i];
            const float sp = x > 20.f ? x : log1pf(__expf(x));
            const float wlog = -sp - 0.5f;
            DEC[(size_t)r * 512 + l + 64 * i] = __expf(-__expf(wlog));
            AB[(size_t)r * 512 + l + 64 * i] = (bf16)f2bf(sigmoidf_(aa[i]));
            GB[(size_t)r * 512 + l + 64 * i] = (bf16)f2bf(ag[i]);
        }
    }
}

__device__ __forceinline__ void p8_rwkv_scan_naive(Frame& F) {
    if (F.wave != 0 || blockIdx.x >= 32) return;
    const bf16* P = WSP(bf16, WS_P); const float* DEC = WSP(float, WS_DEC); const bf16* AB = WSP(bf16, WS_AB); const bf16* GB = WSP(bf16, WS_GB); bf16* QA = WSP(bf16, WS_QA);
    const int b = blockIdx.x >> 3, h = blockIdx.x & 7, l = F.lane, ch = h * 64 + l;
    LAS float* vec = (LAS float*)F.lds;
    const float mu_r = F.in[IN_MU][ch], mu_k = F.in[IN_MU][512 + ch], mu_v = F.in[IN_MU][1024 + ch];
    const float kk_c = F.in[IN_KK][ch], ka_c = F.in[IN_KA][ch], rk_c = F.in[IN_RK][ch], gng = F.in[IN_GN_G][ch], gnb = F.in[IN_GN_B][ch];
    float S[64];
#pragma unroll
    for (int k = 0; k < 64; ++k) S[k] = 0.f;
    float pr_p = 0.f, pk_p = 0.f, pv_p = 0.f;
    int row = key_row(b, 0);
    float n_pr = bf2f(P[(size_t)row * PW + PC_R + ch]), n_pk = bf2f(P[(size_t)row * PW + PC_K + ch]), n_pv = bf2f(P[(size_t)row * PW + PC_V + ch]);
    float n_w = DEC[(size_t)row * 512 + ch], n_a = bf2f(AB[(size_t)row * 512 + ch]), n_g = bf2f(GB[(size_t)row * 512 + ch]);
    for (int pos = 0; pos < TT; ++pos) {
        const int crow = row;
        const float c_pr = n_pr, c_pk = n_pk, c_pv = n_pv, c_w = n_w, c_a = n_a, c_g = n_g;
        if (pos + 1 < TT) {
            row = key_row(b, pos + 1);
            n_pr = bf2f(P[(size_t)row * PW + PC_R + ch]); n_pk = bf2f(P[(size_t)row * PW + PC_K + ch]); n_pv = bf2f(P[(size_t)row * PW + PC_V + ch]);
            n_w = DEC[(size_t)row * 512 + ch]; n_a = bf2f(AB[(size_t)row * 512 + ch]); n_g = bf2f(GB[(size_t)row * 512 + ch]);
        }
        const float r_s = c_pr + (pr_p - c_pr) * mu_r, k_s = c_pk + (pk_p - c_pk) * mu_k, v_s = c_pv + (pv_p - c_pv) * mu_v;
        pr_p = c_pr; pk_p = c_pk; pv_p = c_pv;
        const float kkr = k_s * kk_c;
        const float nrm = sqrtf(wave_sum(kkr * kkr));
        const float kk = kkr / fmaxf(nrm, 1e-12f);
        const float k2 = k_s * (1.f + (c_a - 1.f) * ka_c);
        vec[l] = -kk; vec[64 + l] = kk * c_a; vec[128 + l] = c_w; vec[192 + l] = k2; vec[256 + l] = r_s;
        __builtin_amdgcn_wave_barrier();
        float sa = 0.f;
#pragma unroll
        for (int k4 = 0; k4 < 16; ++k4) { const f32x4 a = *(const LAS f32x4*)(vec + 4 * k4); sa += S[4 * k4] * a.x + S[4 * k4 + 1] * a.y + S[4 * k4 + 2] * a.z + S[4 * k4 + 3] * a.w; }
        float y = 0.f;
#pragma unroll
        for (int k4 = 0; k4 < 16; ++k4) {
            const f32x4 bv = *(const LAS f32x4*)(vec + 64 + 4 * k4), w = *(const LAS f32x4*)(vec + 128 + 4 * k4), kv = *(const LAS f32x4*)(vec + 192 + 4 * k4), rv = *(const LAS f32x4*)(vec + 256 + 4 * k4);
            S[4 * k4] = S[4 * k4] * w.x + sa * bv.x + v_s * kv.x; S[4 * k4 + 1] = S[4 * k4 + 1] * w.y + sa * bv.y + v_s * kv.y;
            S[4 * k4 + 2] = S[4 * k4 + 2] * w.z + sa * bv.z + v_s * kv.z; S[4 * k4 + 3] = S[4 * k4 + 3] * w.w + sa * bv.w + v_s * kv.w;
            y += S[4 * k4] * rv.x + S[4 * k4 + 1] * rv.y + S[4 * k4 + 2] * rv.z + S[4 * k4 + 3] * rv.w;
        }
        __builtin_amdgcn_wave_barrier();
        const float mean = wave_sum(y) * (1.f / 64.f);
        const float dlt = y - mean;
        const float var = wave_sum(dlt * dlt) * (1.f / 64.f);
        const float yn = dlt * (1.0f / sqrtf(var + GN_EPS)) * gng + gnb;
        const float bonus = wave_sum(r_s * k2 * rk_c) * v_s;
        const float o = (yn + bonus) * c_g;
        if (pos >= NMETA || b == 0) QA[(size_t)crow * QAW + 1024 + ch] = (bf16)f2bf(o);
    }
}

__device__ __forceinline__ void p10_ln1(Frame& F) {
    bf16* H1 = WSP(bf16, WS_H); const float* META1 = WSP(float, WS_META1);
    const int gw = blockIdx.x * NWAVES + F.wave, NGW = F.G * NWAVES;
    for (int r = gw; r < NROWS; r += NGW) {
        const float* src = r < NREAL ? F.out + (size_t)r * D : META1 + (size_t)(r - NREAL) * D;
        ln_row_bf16(F, src, F.in[IN_LN1_G], F.in[IN_LN1_B], H1 + (size_t)r * D);
    }
}
__device__ __forceinline__ void p14_ln2(Frame& F) {
    const int gw = blockIdx.x * NWAVES + F.wave, NGW = F.G * NWAVES;
    const float* g = F.in[IN_LN2_G]; const float* b = F.in[IN_LN2_B];
    for (int r = gw; r < NREAL; r += NGW) {
        f32x4* xr = (f32x4*)(F.out + (size_t)r * D) + F.lane;
        f32x4 v[4]; float s = 0.f;
#pragma unroll
        for (int j = 0; j < 4; ++j) { v[j] = xr[64 * j]; s += (v[j].x + v[j].y) + (v[j].z + v[j].w); }
        const float mean = wave_sum(s) * (1.f / D); float s2 = 0.f;
#pragma unroll
        for (int j = 0; j < 4; ++j) { v[j] = v[j] - mean; s2 += (v[j].x * v[j].x + v[j].y * v[j].y) + (v[j].z * v[j].z + v[j].w * v[j].w); }
        const float rstd = 1.f / sqrtf(wave_sum(s2) * (1.f / D) + LN_EPS);
#pragma unroll
        for (int j = 0; j < 4; ++j) { const f32x4 gg = ((const f32x4*)g)[F.lane + 64 * j], bb = ((const f32x4*)b)[F.lane + 64 * j]; xr[64 * j] = v[j] * rstd * gg + bb; }
    }
}

__device__ __forceinline__ float gelu_tanh(float x) { const float u = 0.7978845608028654f * (x + 0.044715f * x * x * x); return 0.5f * x * (1.f + tanhf(u)); }
__device__ __forceinline__ void p12_conv_act(Frame& F) {
    bf16* UP = WSP(bf16, WS_UP); const float* cw = F.in[IN_CONV_W]; const float* cb = F.in[IN_CONV_B];
    const size_t total = (size_t)NREAL * (DFF / 8);
    for (size_t it = (size_t)blockIdx.x * NTHR + F.tid; it < total; it += (size_t)F.G * NTHR) {
        const int r = (int)(it / (DFF / 8)), c = (int)(it % (DFF / 8)) * 8, s = r & (SEQ - 1);
        const int r1 = s >= 1 ? r - 1 : NREAL + 15, r2 = s >= 2 ? r - 2 : NREAL + 14 + s;
        const v4u g0 = *(const v4u*)(UP + (size_t)r * UPW + c), g1 = *(const v4u*)(UP + (size_t)r1 * UPW + c), g2 = *(const v4u*)(UP + (size_t)r2 * UPW + c);
        const v4u vv = *(const v4u*)(UP + (size_t)r * UPW + DFF + c);
        const unsigned a0[4] = {g0.x, g0.y, g0.z, g0.w}, a1[4] = {g1.x, g1.y, g1.z, g1.w}, a2[4] = {g2.x, g2.y, g2.z, g2.w}, av[4] = {vv.x, vv.y, vv.z, vv.w};
        unsigned o[4];
#pragma unroll
        for (int e = 0; e < 4; ++e) {
            const int c0 = c + 2 * e, c1 = c0 + 1;
            const float x0 = cw[c0] * bflo(a2[e]) + cw[DFF + c0] * bflo(a1[e]) + cw[2 * DFF + c0] * bflo(a0[e]) + cb[c0];
            const float x1 = cw[c1] * bfhi(a2[e]) + cw[DFF + c1] * bfhi(a1[e]) + cw[2 * DFF + c1] * bfhi(a0[e]) + cb[c1];
            o[e] = pk2(gelu_tanh(x0) * bflo(av[e]), gelu_tanh(x1) * bfhi(av[e]));
        }
        *(v4u*)(UP + (size_t)r * UPW + DFF + c) = (v4u){o[0], o[1], o[2], o[3]};
    }
}

struct StoreBf16 { bf16* O; int ld; __device__ __forceinline__ void operator()(int row, int col, const f32x4& v) const { *(v2u*)(O + (size_t)row * ld + col) = (v2u){pk2(v.x, v.y), pk2(v.z, v.w)}; } };
struct StoreRes1 { const bf16* H; float* out; float* meta; __device__ __forceinline__ void operator()(int row, int col, const f32x4& v) const {
        if (row >= NROWS) return;
        const v2u hw = *(const v2u*)(H + (size_t)row * D + col);
        const f32x4 o = (f32x4){ALPHA * bflo(hw.x) + v.x, ALPHA * bfhi(hw.x) + v.y, ALPHA * bflo(hw.y) + v.z, ALPHA * bfhi(hw.y) + v.w};
        float* dst = row < NREAL ? out + (size_t)row * D + col : meta + (size_t)(row - NREAL) * D + col;
        *(f32x4*)dst = o; } };
struct StoreRes2 { const bf16* H; float* out; __device__ __forceinline__ void operator()(int row, int col, const f32x4& v) const {
        if (row >= NREAL) return;
        const v2u hw = *(const v2u*)(H + (size_t)row * D + col);
        *(f32x4*)(out + (size_t)row * D + col) = (f32x4){ALPHA * bflo(hw.x) + v.x, ALPHA * bfhi(hw.x) + v.y, ALPHA * bflo(hw.y) + v.z, ALPHA * bfhi(hw.y) + v.w}; } };

template <class Fn>
__device__ __forceinline__ void run_gemm(Frame& F, const bf16* A, int lda, const bf16* Bt, int N, int K, const Fn& fn) {
    pg8::Gemm g{A, Bt, R, N, K, lda}; pg8::StaticOrder S; S.init(R, N, F.G, (int)blockIdx.x);
    pg8::EpiFn<Fn> E{fn};
    pg8::gemm_phase<pg8::EpiFn<Fn>, pg8::StaticOrder, true, true>(F.lds + RING_OFF, g, S, E);
}

constexpr int NPHASES = 14;
struct Args { const float* in[32]; float* out; unsigned char* ws; int ph_lo, ph_hi; };
__global__ void __launch_bounds__(NTHR, 2) fwd(Args args) {
    extern __shared__ __attribute__((aligned(16))) unsigned char lds[];
    Frame F;
    F.lds = (LAS unsigned char*)lds;
    F.MISC = (volatile LAS unsigned*)(F.lds + MISC_OFF);
    F.tid = threadIdx.x; F.lane = F.tid & 63; F.wave = __builtin_amdgcn_readfirstlane(F.tid >> 6);
    F.G = gridDim.x;
#pragma unroll
    for (int i = 0; i < 32; ++i) F.in[i] = args.in[i];
    F.out = args.out; F.ws = args.ws;
    F.ctl = (gu32*)(args.ws + WS_CTL);
    for (int u = F.tid; u < (LDS_BYTES - LDSCTL_OFF) / 4; u += NTHR) ((LAS unsigned*)(F.lds + LDSCTL_OFF))[u] = 0u;
    __syncthreads();
    const int lo = args.ph_lo, hi = args.ph_hi;
    XcdBarrier bar; bar.bar = (unsigned*)(F.ctl + CW_BAR); bar.x = 0; bar.st = nullptr;
    if (hi - lo > 1) bar = xcd_barrier_post((unsigned*)(F.ctl + CW_BAR), F.MISC + 8);
#define IN(k) (lo <= (k) && (k) < hi)
#define SEAM(k) do { if (IN(k) && IN((k) + 1)) xcd_barrier(bar); } while (0)

#ifndef SKIP0
    if (IN(0)) { p0_weights(F); p1_ln_in(F); } SEAM(0);
#endif
#ifndef SKIP1
    if (IN(1)) { run_gemm(F, WSP(bf16, WS_H), D, WSP(bf16, WS_WT_IN), PW, D, StoreBf16{WSP(bf16, WS_P), PW}); } SEAM(1);
#endif
#ifndef SKIP2
    if (IN(2)) { p3_prep(F); } SEAM(2);
#endif
#ifndef SKIP3
    if (IN(3)) { run_gemm(F, WSP(bf16, WS_CQN), 256, WSP(bf16, WS_WT_QA), QAW, 256, StoreBf16{WSP(bf16, WS_QA), QAW});
#if REFSEL
        refsel_rows(F);
#endif
    } SEAM(3);
#endif
#ifndef SKIP4
    if (IN(4)) { p5_index_naive(F); } SEAM(4);
#endif
#ifndef SKIP5
    if (IN(5)) { p6_attn_naive(F); } SEAM(5);
#endif
#ifndef SKIP6
    if (IN(6)) { p7_rwkv_prep_naive(F); } SEAM(6);
#endif
#ifndef SKIP7
    if (IN(7)) { p8_rwkv_scan_naive(F); } SEAM(7);
#endif
#ifndef SKIP8
    if (IN(8)) { run_gemm(F, WSP(bf16, WS_QA), QAW, WSP(bf16, WS_WT_MIX), D, QAW, StoreRes1{WSP(bf16, WS_H), F.out, WSP(float, WS_META1)}); } SEAM(8);
#endif
#ifndef SKIP9
    if (IN(9)) { p10_ln1(F); } SEAM(9);
#endif
#ifndef SKIP10
    if (IN(10)) { run_gemm(F, WSP(bf16, WS_H), D, WSP(bf16, WS_WT_UP), UPW, D, StoreBf16{WSP(bf16, WS_UP), UPW}); } SEAM(10);
#endif
#ifndef SKIP11
    if (IN(11)) { p12_conv_act(F); } SEAM(11);
#endif
#ifndef SKIP12
    if (IN(12)) { run_gemm(F, WSP(bf16, WS_UP) + DFF, UPW, WSP(bf16, WS_WT_DN), D, DFF, StoreRes2{WSP(bf16, WS_H), F.out}); } SEAM(12);
#endif
#ifndef SKIP13
    if (IN(13)) { p14_ln2(F); }
#endif
#undef IN
#undef SEAM
}

extern "C" void kernel_launch(void* const* d_in, const int* in_sizes, int n_in, void* d_out, int out_size, void* d_ws, size_t ws_size, hipStream_t stream) {
    static int grid = 0;
    if (grid == 0) {
        if (n_in != 32 || out_size != NREAL * D || ws_size < WS_END) { fprintf(stderr, "kernel_launch: unexpected shapes: n_in %d out %d ws %zu\n", n_in, out_size, ws_size); grid = -1; return; }
        int dev = 0, cus = 0, per_cu = 0;
        if (hipGetDevice(&dev) != hipSuccess || hipDeviceGetAttribute(&cus, hipDeviceAttributeMultiprocessorCount, dev) != hipSuccess) { grid = -1; return; }
        if (hipFuncSetAttribute((const void*)fwd, hipFuncAttributeMaxDynamicSharedMemorySize, LDS_BYTES) != hipSuccess) { fprintf(stderr, "kernel_launch: hipFuncSetAttribute failed\n"); grid = -1; return; }
        if (hipOccupancyMaxActiveBlocksPerMultiprocessor(&per_cu, (const void*)fwd, NTHR, LDS_BYTES) != hipSuccess || per_cu < 1) fprintf(stderr, "kernel_launch: occupancy query says %d\n", per_cu);
        (void)hipGetLastError();
        grid = cus;
    }
    if (grid < 0) return;
    (void)hipMemsetAsync((char*)d_ws + WS_CTL, 0, CTL_ZERO_BYTES, stream);
    Args a{};
    for (int i = 0; i < 32; ++i) a.in[i] = (const float*)d_in[i];
    a.out = (float*)d_out; a.ws = (unsigned char*)d_ws;
#if ONE_LAUNCH
    a.ph_lo = 0; a.ph_hi = NPHASES;
    hipLaunchKernelGGL(fwd, dim3(grid), dim3(NTHR), LDS_BYTES, stream, a);
#else
    for (int p = 0; p < NPHASES; ++p) { a.ph_lo = p; a.ph_hi = p + 1; hipLaunchKernelGGL(fwd, dim3(grid), dim3(NTHR), LDS_BYTES, stream, a); }
#endif
}
```

```cpp
#include <hip/hip_runtime.h>
#include <cstdio>
#include <cstdint>
#define ONE_LAUNCH 1
namespace pg8 {
#define PG8_LAS __attribute__((address_space(3)))
typedef unsigned short bf16_t;
typedef short bf16x8 __attribute__((ext_vector_type(8)));
typedef float f32x4 __attribute__((ext_vector_type(4)));
typedef unsigned u32x4 __attribute__((ext_vector_type(4)));
constexpr int BM = 256, BK = 64, HALF = 128, HTB = HALF * BK * 2  , STAGE_BYTES = 8 * HTB, NXCD = 8, WGM = 8;

__host__ __device__ __forceinline__ int lds_byte(int r, int c) { const int st = (r >> 4) * 2 + (c >> 5), rr = r & 15, cc = c & 31, ob = rr * 64 + cc * 2; return st * 1024 + (ob ^ (((ob >> 9) & 1) << 5)); }
__host__ __device__ __forceinline__ void stage_rc(int b, int& R, int& C) { const int st = b / 1024, sb = b % 1024, swz = sb ^ (((sb >> 9) & 1) << 5); R = (st >> 1) * 16 + swz / 64; C = (st & 1) * 32 + (swz % 64) / 2; }
__host__ __device__ __forceinline__ int perm32(int rho) { const int n = rho >> 4, i = rho & 15; return 8 * (i >> 2) + 4 * n + (i & 3); }

struct Unit { int pm, pn; };
struct Gemm { const bf16_t* A; const bf16_t* Bt; int M, N, K, lda; };

struct StaticOrder {
    int nM, nN, nwg, G, c;
    __host__ __device__ void init(int M, int N, int G_, int c_) { nM = M / BM; nN = N / BM; nwg = nM * nN; G = G_; c = c_; }
    __host__ __device__ bool next(int i, Unit& u) const {
        const long L = (long)i * G + c; if (L >= nwg) return false;
        int wgid = (int)L; { const int q = nwg / NXCD, r = nwg % NXCD, xcd = wgid % NXCD, off = wgid / NXCD; wgid = (xcd < r ? xcd * (q + 1) : r * (q + 1) + (xcd - r) * q) + off; }
        const int nig = WGM * nN, gid = wgid / nig, fm = gid * WGM, gsz = (nM - fm) < WGM ? (nM - fm) : WGM;
        u.pm = fm + ((wgid % nig) % gsz); u.pn = (wgid % nig) / gsz; return true;
    }
    __device__ __forceinline__ void a_ready(const Unit&) const {}
    __device__ __forceinline__ void done(const Unit&) const {}
};


template <class F> struct EpiFn {
    static constexpr bool PERM = false, AFTER_DRAIN = false;
    F f;
    __device__ __forceinline__ void operator()(const f32x4 (&acc)[2][2][4][2], const Unit& u, int wr, int wc, int fr, int fq) const {
        const int row0 = u.pm * BM + wr * 64 + fr, col0 = u.pn * BM + wc * 32 + 4 * fq;
#pragma unroll
        for (int ai = 0; ai < 2; ++ai)
#pragma unroll
            for (int m = 0; m < 4; ++m) {
                const int row = row0 + ai * HALF + m * 16;
#pragma unroll
                for (int bj = 0; bj < 2; ++bj)
#pragma unroll
                    for (int n = 0; n < 2; ++n) f(row, col0 + bj * HALF + n * 16, acc[ai][bj][m][n]);
            }
    }
};
template <class Epi, class Sched, bool ALIGN_EPI = false, bool SP2 = false>
__device__ __forceinline__ void gemm_phase(PG8_LAS unsigned char* lds, const Gemm g, const Sched& S, const Epi& E) {
    const int tid = threadIdx.x, wid = __builtin_amdgcn_readfirstlane(tid >> 6), lane = tid & 63, wr = wid >> 2, wc = wid & 3, fr = lane & 15, fq = lane >> 4;
    const int K = g.K, nt = K / BK;
    unsigned voffA[2], voffB[2];
#pragma unroll
    for (int i = 0; i < 2; ++i) { int R, C; stage_rc(tid * 16 + i * 8192, R, C); const int Rb = Epi::PERM ? ((R & ~31) + perm32(R & 31)) : R;
        voffA[i] = (unsigned)(R * g.lda + C) * 2u; voffB[i] = (unsigned)(Rb * K + C) * 2u; }
    const size_t kstep = (size_t)(BK * 2);
    const size_t hA = (size_t)HALF * g.lda * 2, hB = (size_t)HALF * K * 2;
    const size_t tA = 2 * hA, tB = 2 * hB;
    const unsigned ldsw = (unsigned)wid * 1024u;
    const int aoff = lds_byte(wr * 64 + fr, fq * 8), boff = lds_byte(wc * 32 + fr, fq * 8);
#define PG8_SA(b, h) (((b) * 2 + (h)) * HTB)
#define PG8_SB(b, h) ((4 + (b) * 2 + (h)) * HTB)
#define PG8_STAGE(bufoff, gbase, voff) do { _Pragma("unroll") for (int _i = 0; _i < 2; ++_i) \
        __builtin_amdgcn_global_load_lds((const unsigned*)((const char*)(gbase) + (voff)[_i]), (PG8_LAS unsigned*)(lds + (bufoff) + ldsw + _i * 8192), 16, 0, 0); } while (0)
#define PG8_LDA(dst, b, h) do { _Pragma("unroll") for (int m = 0; m < 4; ++m) _Pragma("unroll") for (int k = 0; k < 2; ++k) dst[m][k] = *(const PG8_LAS bf16x8*)(lds + PG8_SA(b, h) + aoff + m * 2048 + k * 1024); } while (0)
#define PG8_LDB(dst, b, h) do { _Pragma("unroll") for (int n = 0; n < 2; ++n) _Pragma("unroll") for (int k = 0; k < 2; ++k) dst[n][k] = *(const PG8_LAS bf16x8*)(lds + PG8_SB(b, h) + boff + n * 2048 + k * 1024); } while (0)
#define PG8_MMA(ai, bj, At, Bt) do { __builtin_amdgcn_s_setprio(1); _Pragma("unroll") for (int m = 0; m < 4; ++m) _Pragma("unroll") for (int n = 0; n < 2; ++n) _Pragma("unroll") for (int k = 0; k < 2; ++k) \
        acc[ai][bj][m][n] = __builtin_amdgcn_mfma_f32_16x16x32_bf16(Bt[n][k], At[m][k], acc[ai][bj][m][n], 0, 0, 0); __builtin_amdgcn_s_setprio(0); } while (0)
#define PG8_WAIT_V(n) asm volatile("s_waitcnt vmcnt(" #n ")" ::: "memory")
#define PG8_WAIT_L(n) asm volatile("s_waitcnt lgkmcnt(" #n ")" ::: "memory")
#define PG8_BAR __builtin_amdgcn_s_barrier()
#define PG8_SCHED __builtin_amdgcn_sched_barrier(0)
    Unit cur, nxt; int ui = 0;
    if (!S.next(0, cur)) return;
    f32x4 acc[2][2][4][2];
#pragma unroll
    for (int a = 0; a < 2; ++a)
#pragma unroll
        for (int b = 0; b < 2; ++b)
#pragma unroll
            for (int m = 0; m < 4; ++m)
#pragma unroll
                for (int n = 0; n < 2; ++n) acc[a][b][m][n] = (f32x4){0.f, 0.f, 0.f, 0.f};
    bf16x8 At[4][2], B0[2][2], B1[2][2];
    const char* cA = (const char*)g.A + (size_t)cur.pm * tA; const char* cB = (const char*)g.Bt + (size_t)cur.pn * tB;
    S.a_ready(cur);
    if constexpr (SP2) {
        PG8_STAGE(PG8_SB(0, 0), cB, voffB); PG8_STAGE(PG8_SB(0, 1), cB + hB, voffB); PG8_STAGE(PG8_SA(0, 0), cA, voffA); PG8_STAGE(PG8_SA(0, 1), cA + hA, voffA);
        if (wr == 1) PG8_BAR;
        PG8_WAIT_V(2); PG8_BAR;
        PG8_STAGE(PG8_SB(1, 0), cB + kstep, voffB); PG8_STAGE(PG8_SA(1, 0), cA + kstep, voffA); PG8_STAGE(PG8_SB(1, 1), cB + hB + kstep, voffB);
        PG8_WAIT_V(6); PG8_BAR;
    } else {
        PG8_STAGE(PG8_SB(0, 0), cB, voffB); PG8_STAGE(PG8_SA(0, 0), cA, voffA); PG8_STAGE(PG8_SB(0, 1), cB + hB, voffB); PG8_STAGE(PG8_SA(0, 1), cA + hA, voffA);
        if (wr == 1) PG8_BAR;
        PG8_WAIT_V(4); PG8_BAR;
        PG8_STAGE(PG8_SB(1, 0), cB + kstep, voffB); PG8_STAGE(PG8_SA(1, 0), cA + kstep, voffA); PG8_STAGE(PG8_SB(1, 1), cB + hB + kstep, voffB);
        PG8_WAIT_V(6); PG8_BAR;
    }
    for (;;) {
        const bool has_next = S.next(ui + 1, nxt);
        const char* nA = has_next ? (const char*)g.A + (size_t)nxt.pm * tA : cA; const char* nB = has_next ? (const char*)g.Bt + (size_t)nxt.pn * tB : cB;
        for (int t = 0; t < nt; t += 2) {
            const bool last = (t == nt - 2);
            const char* a1 = cA + (size_t)(t + 1) * kstep;
            const char* a2 = last ? nA : cA + (size_t)(t + 2) * kstep; const char* b2 = last ? nB : cB + (size_t)(t + 2) * kstep;
            const char* a3 = a2 + kstep; const char* b3 = b2 + kstep;
            if (last && has_next) S.a_ready(nxt);
            if constexpr (SP2) {
            PG8_LDB(B0, 0, 0); PG8_LDB(B1, 0, 1); PG8_SCHED; PG8_LDA(At, 0, 0); PG8_STAGE(PG8_SA(1, 1), a1 + hA, voffA);
            PG8_WAIT_V(8); PG8_WAIT_L(0); PG8_BAR; PG8_MMA(0, 0, At, B0); PG8_MMA(0, 1, At, B1); PG8_BAR; PG8_SCHED;
            PG8_LDA(At, 0, 1); PG8_STAGE(PG8_SB(0, 0), b2, voffB); PG8_STAGE(PG8_SB(0, 1), b2 + hB, voffB); PG8_STAGE(PG8_SA(0, 0), a2, voffA);
            PG8_WAIT_V(8); PG8_WAIT_L(0); PG8_BAR; PG8_MMA(1, 0, At, B0); PG8_MMA(1, 1, At, B1); PG8_BAR; PG8_SCHED;
            PG8_LDB(B0, 1, 0); PG8_LDB(B1, 1, 1); PG8_SCHED; PG8_LDA(At, 1, 0); PG8_STAGE(PG8_SA(0, 1), a2 + hA, voffA);
            PG8_WAIT_V(8); PG8_WAIT_L(0); PG8_BAR; PG8_MMA(0, 0, At, B0); PG8_MMA(0, 1, At, B1); PG8_BAR; PG8_SCHED;
            PG8_LDA(At, 1, 1); PG8_STAGE(PG8_SB(1, 0), b3, voffB); PG8_STAGE(PG8_SB(1, 1), b3 + hB, voffB); PG8_STAGE(PG8_SA(1, 0), a3, voffA);
            PG8_WAIT_V(8); PG8_WAIT_L(0); PG8_BAR; PG8_MMA(1, 0, At, B0); PG8_MMA(1, 1, At, B1); PG8_BAR; PG8_SCHED;
            } else {
            PG8_LDB(B0, 0, 0); PG8_SCHED; PG8_LDA(At, 0, 0); PG8_STAGE(PG8_SA(1, 1), a1 + hA, voffA);
            PG8_WAIT_L(8); PG8_BAR; PG8_WAIT_L(0); PG8_MMA(0, 0, At, B0); PG8_BAR; PG8_SCHED;
            PG8_LDB(B1, 0, 1); PG8_STAGE(PG8_SB(0, 0), b2, voffB);
            PG8_BAR; PG8_WAIT_L(0); PG8_MMA(0, 1, At, B1); PG8_BAR;
            PG8_LDA(At, 0, 1); PG8_STAGE(PG8_SA(0, 0), a2, voffA);
            PG8_BAR; PG8_WAIT_L(0); PG8_MMA(1, 0, At, B0); PG8_BAR; PG8_SCHED;
            PG8_STAGE(PG8_SB(0, 1), b2 + hB, voffB);
            PG8_WAIT_V(6); PG8_BAR; PG8_MMA(1, 1, At, B1); PG8_BAR;
            PG8_LDB(B0, 1, 0); PG8_SCHED; PG8_LDA(At, 1, 0); PG8_STAGE(PG8_SA(0, 1), a2 + hA, voffA);
            PG8_WAIT_L(8); PG8_BAR; PG8_WAIT_L(0); PG8_MMA(0, 0, At, B0); PG8_BAR; PG8_SCHED;
            PG8_LDB(B1, 1, 1); PG8_STAGE(PG8_SB(1, 0), b3, voffB);
            PG8_BAR; PG8_WAIT_L(0); PG8_MMA(0, 1, At, B1); PG8_BAR;
            PG8_LDA(At, 1, 1); PG8_STAGE(PG8_SA(1, 0), a3, voffA);
            PG8_BAR; PG8_WAIT_L(0); PG8_MMA(1, 0, At, B0); PG8_BAR; PG8_SCHED;
            PG8_STAGE(PG8_SB(1, 1), b3 + hB, voffB);
            PG8_WAIT_V(6); PG8_BAR; PG8_MMA(1, 1, At, B1); PG8_BAR;
            }
        }
        if constexpr (ALIGN_EPI) { if (wr == 0) PG8_BAR; }
        if constexpr (!Epi::AFTER_DRAIN) { E(acc, cur, wr, wc, fr, fq); S.done(cur); }
        if (!has_next) break;
#pragma unroll
        for (int a = 0; a < 2; ++a)
#pragma unroll
            for (int b = 0; b < 2; ++b)
#pragma unroll
                for (int m = 0; m < 4; ++m)
#pragma unroll
                    for (int n = 0; n < 2; ++n) acc[a][b][m][n] = (f32x4){0.f, 0.f, 0.f, 0.f};
        cur = nxt; cA = nA; cB = nB; ++ui;
        if constexpr (ALIGN_EPI) { if (wr == 1) PG8_BAR; }
    }
    PG8_WAIT_V(0);
    if constexpr (!ALIGN_EPI) { if (wr == 0) PG8_BAR; }
    PG8_BAR;
    if constexpr (Epi::AFTER_DRAIN) { E.fused(acc, cur, wr, wc, fr, fq, lds, wid, lane); S.done(cur); }
#undef PG8_SA
#undef PG8_SB
#undef PG8_STAGE
#undef PG8_LDA
#undef PG8_LDB
#undef PG8_MMA
#undef PG8_WAIT_V
#undef PG8_WAIT_L
#undef PG8_BAR
#undef PG8_SCHED
}
}

#ifndef ONE_LAUNCH
#define ONE_LAUNCH 0
#endif
constexpr int NWAVES = 8, NTHR = 512;
constexpr int D = 1024, BATCH = 4, SEQ = 8192, NMETA = 16, TT = SEQ + NMETA;
constexpr int NREAL = BATCH * SEQ;
constexpr int NROWS = NREAL + NMETA;
constexpr int R = 33024;
constexpr int PW = 2304;
constexpr int PC_CQ = 0, PC_CKV = 256, PC_KIDX = 384, PC_WIDX = 448, PC_R = 512, PC_K = 1024, PC_V = 1536, PC_WD = 2048, PC_AD = 2112, PC_GD = 2176;
constexpr int QAW = 1536;
constexpr int DFF = 2816, UPW = 5632;
constexpr int TOPK = 256;
constexpr float LN_EPS = 1e-5f, GN_EPS = 64e-5f, ALPHA = 1.18920711500272f;

constexpr size_t MiB = 1u << 20;
constexpr size_t WS_CTL = 0, CTL_ZERO_BYTES = 1 * MiB;
constexpr size_t WS_WT_IN = 1 * MiB, WS_WT_QA = 6 * MiB, WS_WT_MIX = 7 * MiB, WS_WT_UP = 10 * MiB, WS_WT_DN = 21 * MiB;
constexpr size_t WS_META1 = 27 * MiB, WS_NSEL = 28 * MiB, WS_WIDX = 29 * MiB;
constexpr size_t WS_H = 33 * MiB;
constexpr size_t WS_P = 98 * MiB, WS_QA = 244 * MiB, WS_CQN = 341 * MiB, WS_SEL = 341 * MiB, WS_CKV = 358 * MiB, WS_KIDX = 367 * MiB;
constexpr size_t WS_DEC = 372 * MiB, WS_AB = 437 * MiB, WS_GB = 470 * MiB;
constexpr size_t WS_WT_LORA = 26 * MiB + 512 * 1024;
constexpr size_t WS_RWM = 372 * MiB, WS_RWN = 405 * MiB, WS_RWQ = 438 * MiB, WS_RWY = 471 * MiB;
constexpr size_t OUT_RWS = 80 * MiB, OUT_BONUS = 116 * MiB;
constexpr size_t WS_UP = 98 * MiB;
constexpr size_t WS_END = 512 * MiB;
static_assert(WS_P + (size_t)R * PW * 2 <= WS_QA && WS_QA + (size_t)R * QAW * 2 <= WS_CQN && WS_CQN + (size_t)R * 256 * 2 <= WS_CKV && WS_CKV + (size_t)R * 128 * 2 <= WS_KIDX
              && WS_KIDX + (size_t)R * 64 * 2 <= WS_DEC && WS_DEC + (size_t)R * 512 * 4 <= WS_AB && WS_AB + (size_t)R * 512 * 2 <= WS_GB && WS_GB + (size_t)R * 512 * 2 <= WS_END
              && WS_UP + (size_t)R * UPW * 2 <= WS_END && WS_H + (size_t)R * D * 2 <= WS_P && WS_WIDX + (size_t)R * 8 * 4 <= WS_H && WS_NSEL + (size_t)R * 4 <= WS_WIDX, "ws map");
constexpr int CW_BAR = 4096;

constexpr int RING_OFF = 0, RING_BYTES = 131072;
constexpr int LDSCTL_OFF = RING_BYTES, MISC_OFF = LDSCTL_OFF + 320;
constexpr int LDS_BYTES = 147456;

#define GAS __attribute__((address_space(1)))
#define LAS __attribute__((address_space(3)))
typedef unsigned short bf16;
typedef unsigned v4u __attribute__((ext_vector_type(4)));
typedef unsigned v2u __attribute__((ext_vector_type(2)));
typedef float f32x4 __attribute__((ext_vector_type(4)));
typedef GAS unsigned gu32;
__device__ __forceinline__ unsigned f2bf(float f) { unsigned u = __builtin_bit_cast(unsigned, f); return (u + 0x7fffu + ((u >> 16) & 1u)) >> 16; }
__device__ __forceinline__ unsigned pk2(float lo, float hi) { return f2bf(lo) | (f2bf(hi) << 16); }
__device__ __forceinline__ float bf2f(unsigned short b) { return __uint_as_float(((unsigned)b) << 16); }
__device__ __forceinline__ float bflo(unsigned w) { return __uint_as_float(w << 16); }
__device__ __forceinline__ float bfhi(unsigned w) { return __uint_as_float(w & 0xffff0000u); }
__device__ __forceinline__ float wave_sum(float v) {
#pragma unroll
    for (int o = 1; o < 64; o <<= 1) v += __shfl_xor(v, o);
    return v;
}
__device__ __forceinline__ float wave_max(float v) {
#pragma unroll
    for (int o = 1; o < 64; o <<= 1) v = fmaxf(v, __shfl_xor(v, o));
    return v;
}
__device__ __forceinline__ float sigmoidf_(float x) { return 1.0f / (1.0f + __expf(-x)); }
#define XB_TMO      128
#define XB_XCNT(j)  (256  + 64 * (j))
#define XB_XSUB(j)  (1280 + 64 * (j))
#define XB_XGEN(j)  (2304 + 64 * (j))
#define XB_TOP      3328
#define XB_TOPGEN   3392
#define XCD_BAR_WORDS 3456
#define XB_SPIN_CAP (1u << 18)

__device__ __forceinline__ unsigned xb_ld(unsigned* p)              { return __hip_atomic_load(p, __ATOMIC_RELAXED, __HIP_MEMORY_SCOPE_AGENT); }
__device__ __forceinline__ unsigned xb_add(unsigned* p, unsigned v) { return __hip_atomic_fetch_add(p, v, __ATOMIC_RELAXED, __HIP_MEMORY_SCOPE_AGENT); }
__device__ __forceinline__ unsigned xb_xcc_id() { return (unsigned)__builtin_amdgcn_s_getreg((3 << 11) | 20) & 0xFu; }
#define XB_SPIN(cond, bar) do { unsigned _sp = 0; while (cond) { __builtin_amdgcn_s_sleep(1); \
    if ((++_sp & 255u) == 0u) { if (xb_ld(&(bar)[XB_TMO])) break; if (_sp > XB_SPIN_CAP) { atomicAdd(&(bar)[XB_TMO], 1u); break; } } } } while (0)

struct XcdBarrier {
    unsigned* bar; unsigned x;
    volatile LAS unsigned* st;
};

__device__ __forceinline__ XcdBarrier xcd_barrier_post(unsigned* bar, volatile LAS unsigned* st) {
    XcdBarrier b; b.bar = bar; b.x = xb_xcc_id(); b.st = st;
    if (threadIdx.x == 0) (void)xb_add(&bar[XB_XCNT(b.x)], 1u);
    return b;
}
__device__ __forceinline__ void xcd_barrier_complete(unsigned* bar, unsigned x, unsigned& nloc, unsigned& nx) {
    const unsigned G = gridDim.x * gridDim.y * gridDim.z;
    unsigned sum, cnt, mine, sp = 0u;
    for (;;) {
        sum = 0u; cnt = 0u; mine = 0u;
#pragma unroll
        for (unsigned j = 0; j < 16; ++j) { const unsigned c = xb_ld(&bar[XB_XCNT(j)]); sum += c; cnt += (c > 0u) ? 1u : 0u; mine = (j == x) ? c : mine; }
        if (sum == G) break;
        __builtin_amdgcn_s_sleep(1);
        if ((++sp & 255u) == 0u) { if (xb_ld(&bar[XB_TMO])) break; if (sp > XB_SPIN_CAP) { atomicAdd(&bar[XB_TMO], 1u); break; } }
    }
    nloc = mine > 0u ? mine : 1u; nx = cnt > 0u ? cnt : 1u;
}

__device__ __forceinline__ void xcd_barrier(const XcdBarrier& b) {
    asm volatile("s_waitcnt vmcnt(0)" ::: "memory");
    __syncthreads();
    if (threadIdx.x == 0) {
        unsigned* bar = b.bar;
        __builtin_amdgcn_s_waitcnt(0);
        unsigned nloc = b.st[0], nx = b.st[1];
        if (nloc == 0u) { xcd_barrier_complete(bar, b.x, nloc, nx); b.st[0] = nloc; b.st[1] = nx; }
        const unsigned old = xb_add(&bar[XB_XSUB(b.x)], 1u);
        const unsigned gen = old / nloc;
        if (old + 1u == (gen + 1u) * nloc) {
            __builtin_amdgcn_fence(__ATOMIC_RELEASE, "agent");
            asm volatile("s_waitcnt vmcnt(0)" ::: "memory");
            const unsigned og = xb_add(&bar[XB_TOP], 1u);
            const unsigned tg = og / nx;
            if (og + 1u == (tg + 1u) * nx) xb_add(&bar[XB_TOPGEN], 1u);
            else XB_SPIN(xb_ld(&bar[XB_TOPGEN]) == tg, bar);
            __builtin_amdgcn_fence(__ATOMIC_ACQUIRE, "agent");
            xb_add(&bar[XB_XGEN(b.x)], 1u);
            asm volatile("s_waitcnt vmcnt(0)" ::: "memory");
        } else {
            XB_SPIN(xb_ld(&bar[XB_XGEN(b.x)]) == gen, bar);
            __builtin_amdgcn_fence(__ATOMIC_ACQUIRE, "agent");
            asm volatile("s_waitcnt vmcnt(0)" ::: "memory");
        }
    }
    __syncthreads();
}

struct Frame {
    LAS unsigned char* lds;
    volatile LAS unsigned* MISC;
    gu32* ctl;
    int tid, lane, wave, G;
    const float* in[32];
    float* out;
    unsigned char* ws;
};
#define IN_X 0
#define IN_META 1
#define IN_LNIN_G 2
#define IN_LNIN_B 3
#define IN_W_IN 4
#define IN_QNORM_G 5
#define IN_W_UQ 6
#define IN_KVNORM_G 7
#define IN_W_UKV 8
#define IN_W_IQ 9
#define IN_IDXLN_G 10
#define IN_IDXLN_B 11
#define IN_MU 12
#define IN_W0 13
#define IN_W_DEC 14
#define IN_A0 15
#define IN_W_AAA 16
#define IN_W_GATE 17
#define IN_KK 18
#define IN_KA 19
#define IN_RK 20
#define IN_GN_G 21
#define IN_GN_B 22
#define IN_W_OUT 23
#define IN_LN1_G 24
#define IN_LN1_B 25
#define IN_W_UP 26
#define IN_CONV_W 27
#define IN_CONV_B 28
#define IN_W_DN 29
#define IN_LN2_G 30
#define IN_LN2_B 31

#define WSP(T, off) ((T*)(F.ws + (off)))

__device__ __forceinline__ int key_row(int b, int j) { return j < NMETA ? NREAL + j : b * SEQ + (j - NMETA); }

__device__ __forceinline__ void tr_items(Frame& F, const float* src, int src_ld, int src_r0, bf16* dst, int dst_ld, int dst_c0, int Nn, int K, int cut0, int cut1, int shift) {
    const int total = Nn * (K / 8);
    for (int it = blockIdx.x * NTHR + F.tid; it < total; it += F.G * NTHR) {
        const int n = it % Nn, kc = it / Nn;
        const int col = n < cut0 ? n : (n < cut1 ? -1 : n - shift);
        float v[8];
#pragma unroll
        for (int e = 0; e < 8; ++e) v[e] = col >= 0 ? src[(size_t)(src_r0 + 8 * kc + e) * src_ld + col] : 0.f;
        v4u o; o.x = pk2(v[0], v[1]); o.y = pk2(v[2], v[3]); o.z = pk2(v[4], v[5]); o.w = pk2(v[6], v[7]);
        *(v4u*)(dst + (size_t)n * dst_ld + dst_c0 + 8 * kc) = o;
    }
}
__device__ __forceinline__ void p0_weights(Frame& F) {
    bf16* WT_IN = WSP(bf16, WS_WT_IN); bf16* WT_QA = WSP(bf16, WS_WT_QA); bf16* WT_MIX = WSP(bf16, WS_WT_MIX); bf16* WT_UP = WSP(bf16, WS_WT_UP); bf16* WT_DN = WSP(bf16, WS_WT_DN);
    tr_items(F, F.in[IN_W_IN], 2248, 0, WT_IN, D, 0, PW, D, 456, 512, 56);
    tr_items(F, F.in[IN_W_UP], UPW, 0, WT_UP, D, 0, UPW, D, UPW, UPW, 0);
    tr_items(F, F.in[IN_W_DN], D, 0, WT_DN, DFF, 0, D, DFF, D, D, 0);
    tr_items(F, F.in[IN_W_IQ], 512, 0, WT_QA + (size_t)1024 * 256, 256, 0, 512, 256, 512, 512, 0);
    tr_items(F, F.in[IN_W_OUT], D, 512, WT_MIX, 1536, 1024, D, 512, D, D, 0);
    {
        bf16* WdT = WSP(bf16, WS_WT_LORA);
        tr_items(F, F.in[IN_W_DEC], 512, 0, WdT, 64, 0, 512, 64, 512, 512, 0);
        tr_items(F, F.in[IN_W_AAA], 512, 0, WdT + 512 * 64, 64, 0, 512, 64, 512, 512, 0);
        tr_items(F, F.in[IN_W_GATE], 512, 0, WdT + 2 * 512 * 64, 128, 0, 512, 128, 512, 512, 0);
    }
    const float* w_uq = F.in[IN_W_UQ]; const float* w_ukv = F.in[IN_W_UKV]; const float* w_out = F.in[IN_W_OUT];
    for (int it = blockIdx.x * NTHR + F.tid; it < 1024 * 256; it += F.G * NTHR) {
        const int c = it & 255, n = it >> 8, h = n >> 7, j = n & 127;
        float s = 0.f;
        for (int d = 0; d < 64; ++d) s += w_uq[(size_t)c * 512 + h * 64 + d] * w_ukv[(size_t)j * 1024 + h * 128 + d];
        WT_QA[(size_t)n * 256 + c] = (bf16)f2bf(0.125f * s);
    }
    for (int it = blockIdx.x * NTHR + F.tid; it < 1024 * 1024; it += F.G * NTHR) {
        const int n = it & 1023, k = it >> 10, h = k >> 7, j = k & 127;
        float s = 0.f;
        for (int d = 0; d < 64; ++d) s += w_ukv[(size_t)j * 1024 + h * 128 + 64 + d] * w_out[(size_t)(h * 64 + d) * D + n];
        WT_MIX[(size_t)n * 1536 + k] = (bf16)f2bf(s);
    }
}

__device__ __forceinline__ void ln_row_bf16(Frame& F, const float* src, const float* g, const float* b, bf16* dst) {
    v2u* o8 = (v2u*)dst + F.lane;
    if (!src) {
#pragma unroll
        for (int j = 0; j < 4; ++j) o8[64 * j] = (v2u){0u, 0u};
        return;
    }
    const f32x4* xr = (const f32x4*)src + F.lane;
    f32x4 v[4]; float s = 0.f;
#pragma unroll
    for (int j = 0; j < 4; ++j) { v[j] = xr[64 * j]; s += (v[j].x + v[j].y) + (v[j].z + v[j].w); }
    const float mean = wave_sum(s) * (1.f / D); float s2 = 0.f;
#pragma unroll
    for (int j = 0; j < 4; ++j) { v[j] = v[j] - mean; s2 += (v[j].x * v[j].x + v[j].y * v[j].y) + (v[j].z * v[j].z + v[j].w * v[j].w); }
    const float rstd = 1.f / sqrtf(wave_sum(s2) * (1.f / D) + LN_EPS);
#pragma unroll
    for (int j = 0; j < 4; ++j) {
        const f32x4 gg = ((const f32x4*)g)[F.lane + 64 * j], bb = ((const f32x4*)b)[F.lane + 64 * j];
        const f32x4 y = v[j] * rstd * gg + bb;
        o8[64 * j] = (v2u){pk2(y.x, y.y), pk2(y.z, y.w)};
    }
}
__device__ __forceinline__ void p1_ln_in(Frame& F) {
    bf16* H0 = WSP(bf16, WS_H);
    const int gw = blockIdx.x * NWAVES + F.wave, NGW = F.G * NWAVES;
    for (int r = gw; r < R; r += NGW) {
        const float* src = r < NREAL ? F.in[IN_X] + (size_t)r * D : (r < NROWS ? F.in[IN_META] + (size_t)(r - NREAL) * D : nullptr);
        ln_row_bf16(F, src, F.in[IN_LNIN_G], F.in[IN_LNIN_B], H0 + (size_t)r * D);
    }
}

__device__ __forceinline__ void p3_prep(Frame& F) {
    const bf16* P = WSP(bf16, WS_P); bf16* CQN = WSP(bf16, WS_CQN); bf16* CKV = WSP(bf16, WS_CKV); bf16* KIDX = WSP(bf16, WS_KIDX); float* WIDX = WSP(float, WS_WIDX);
    const int gw = blockIdx.x * NWAVES + F.wave, NGW = F.G * NWAVES, l = F.lane;
    for (int r = gw; r < R; r += NGW) {
        const bf16* pr = P + (size_t)r * PW;
        if (r >= NROWS) {
            *(v2u*)(CQN + (size_t)r * 256 + 4 * l) = (v2u){0u, 0u};
            continue;
        }
        {
            const v2u w = *(const v2u*)(pr + PC_CQ + 4 * l);
            const float a0 = bflo(w.x), a1 = bfhi(w.x), a2 = bflo(w.y), a3 = bfhi(w.y);
            const float ss = wave_sum(a0 * a0 + a1 * a1 + a2 * a2 + a3 * a3);
            const float rs = 1.0f / sqrtf(ss * (1.f / 256.f) + 1e-6f);
            const f32x4 g = ((const f32x4*)F.in[IN_QNORM_G])[l];
            *(v2u*)(CQN + (size_t)r * 256 + 4 * l) = (v2u){pk2(a0 * rs * g.x, a1 * rs * g.y), pk2(a2 * rs * g.z, a3 * rs * g.w)};
        }
        {
            const unsigned w = *(const unsigned*)(pr + PC_CKV + 2 * l);
            const float a0 = bflo(w), a1 = bfhi(w);
            const float ss = wave_sum(a0 * a0 + a1 * a1);
            const float rs = 1.0f / sqrtf(ss * (1.f / 128.f) + 1e-6f);
            const float g0 = F.in[IN_KVNORM_G][2 * l], g1 = F.in[IN_KVNORM_G][2 * l + 1];
            *(unsigned*)(CKV + (size_t)r * 128 + 2 * l) = pk2(a0 * rs * g0, a1 * rs * g1);
        }
        {
            const float a = bf2f(pr[PC_KIDX + l]);
            const float mean = wave_sum(a) * (1.f / 64.f);
            const float dlt = a - mean;
            const float var = wave_sum(dlt * dlt) * (1.f / 64.f);
            const float y = dlt * (1.0f / sqrtf(var + LN_EPS)) * F.in[IN_IDXLN_G][l] + F.in[IN_IDXLN_B][l];
            KIDX[(size_t)r * 64 + l] = (bf16)f2bf(y);
        }
        if (l < 8) WIDX[(size_t)r * 8 + l] = bf2f(pr[PC_WIDX + l]) * 0.04419417382415922f;
    }
}

#ifndef REFSEL
#define REFSEL 0
#endif
__device__ __forceinline__ void refsel_rows(Frame& F) {
    float* QIDX32 = F.out; float* KIDX32 = F.out + (size_t)R * 512; float* WIDX = WSP(float, WS_WIDX);
    const float* w_in = F.in[IN_W_IN]; const float* w_iq = F.in[IN_W_IQ];
    LAS float* hrow = (LAS float*)(F.lds + F.wave * 8192);
    LAS float* cqn = hrow + 1024;
    const int l = F.lane;
    const int gw = blockIdx.x * NWAVES + F.wave, NGW = F.G * NWAVES;
    for (int r = gw; r < NROWS; r += NGW) {
        const float* src = r < NREAL ? F.in[IN_X] + (size_t)r * D : F.in[IN_META] + (size_t)(r - NREAL) * D;
        {
            const f32x4* xr = (const f32x4*)src + l;
            f32x4 v[4]; float s = 0.f;
#pragma unroll
            for (int j = 0; j < 4; ++j) { v[j] = xr[64 * j]; s += (v[j].x + v[j].y) + (v[j].z + v[j].w); }
            const float mean = wave_sum(s) * (1.f / D); float s2 = 0.f;
#pragma unroll
            for (int j = 0; j < 4; ++j) { v[j] = v[j] - mean; s2 += (v[j].x * v[j].x + v[j].y * v[j].y) + (v[j].z * v[j].z + v[j].w * v[j].w); }
            const float rstd = 1.f / sqrtf(wave_sum(s2) * (1.f / D) + LN_EPS);
#pragma unroll
            for (int j = 0; j < 4; ++j) {
                const f32x4 gg = ((const f32x4*)F.in[IN_LNIN_G])[l + 64 * j], bb = ((const f32x4*)F.in[IN_LNIN_B])[l + 64 * j];
                *(LAS f32x4*)(hrow + 4 * (l + 64 * j)) = v[j] * rstd * gg + bb;
            }
        }
        __builtin_amdgcn_wave_barrier();
        float a[6];
#pragma unroll
        for (int i = 0; i < 6; ++i) a[i] = 0.f;
        for (int k = 0; k < D; ++k) {
            const float hk = hrow[k]; const float* wr = w_in + (size_t)k * 2248;
#pragma unroll
            for (int i = 0; i < 4; ++i) a[i] += hk * wr[l + 64 * i];
            a[4] += hk * wr[384 + l];
            a[5] += hk * wr[448 + (l & 7)];
        }
        const float ss = wave_sum(a[0] * a[0] + a[1] * a[1] + a[2] * a[2] + a[3] * a[3]);
        const float rs = 1.0f / sqrtf(ss * (1.f / 256.f) + 1e-6f);
#pragma unroll
        for (int i = 0; i < 4; ++i) cqn[l + 64 * i] = a[i] * rs * F.in[IN_QNORM_G][l + 64 * i];
        {
            const float mean = wave_sum(a[4]) * (1.f / 64.f); const float dlt = a[4] - mean;
            const float var = wave_sum(dlt * dlt) * (1.f / 64.f);
            KIDX32[(size_t)r * 64 + l] = dlt * (1.0f / sqrtf(var + LN_EPS)) * F.in[IN_IDXLN_G][l] + F.in[IN_IDXLN_B][l];
        }
        if (l < 8) WIDX[(size_t)r * 8 + l] = a[5] * 0.04419417382415922f;
        __builtin_amdgcn_wave_barrier();
        float q[8];
#pragma unroll
        for (int i = 0; i < 8; ++i) q[i] = 0.f;
        for (int c = 0; c < 256; ++c) {
            const float cq = cqn[c]; const float* wr = w_iq + (size_t)c * 512;
#pragma unroll
            for (int i = 0; i < 8; ++i) q[i] += cq * wr[l + 64 * i];
        }
#pragma unroll
        for (int i = 0; i < 8; ++i) QIDX32[(size_t)r * 512 + l + 64 * i] = q[i];
        __builtin_amdgcn_wave_barrier();
    }
}

__device__ __forceinline__ unsigned sortable(float f) { const unsigned u = __float_as_uint(f); return (u & 0x80000000u) ? ~u : (u | 0x80000000u); }
__device__ __forceinline__ void p5_index_naive(Frame& F) {
    const bf16* QA = WSP(bf16, WS_QA); const bf16* KIDX = WSP(bf16, WS_KIDX); const float* WIDX = WSP(float, WS_WIDX);
    unsigned short* SEL = WSP(unsigned short, WS_SEL); int* NSEL = WSP(int, WS_NSEL);
    LAS float* sc = (LAS float*)(F.lds);
    LAS float* qf = (LAS float*)(F.lds + 33024);
    LAS unsigned* hist = (LAS unsigned*)(F.lds + 33024 + 2048);
    LAS unsigned* cw = hist + 256;
    const int tid = F.tid;
    for (int q = blockIdx.x; q < NROWS; q += F.G) {
        int b, pos; if (q < NREAL) { b = q >> 13; pos = NMETA + (q & (SEQ - 1)); } else { b = 0; pos = q - NREAL; }
        const int nvis = pos < NMETA ? NMETA : NMETA + 64 * ((pos - NMETA) / 64 + 1);
#if REFSEL
        qf[tid] = F.out[(size_t)q * 512 + tid];
#else
        qf[tid] = bf2f(QA[(size_t)q * QAW + 1024 + tid]);
#endif
        float w[8];
#pragma unroll
        for (int h = 0; h < 8; ++h) w[h] = WIDX[(size_t)q * 8 + h];
        __syncthreads();
        for (int j = tid; j < nvis; j += NTHR) {
            const v4u* kp = (const v4u*)(KIDX + (size_t)key_row(b, j) * 64);
#if REFSEL
            const f32x4* kp32 = (const f32x4*)(F.out + (size_t)R * 512 + (size_t)key_row(b, j) * 64);
#endif
            float d[8];
#pragma unroll
            for (int h = 0; h < 8; ++h) d[h] = 0.f;
#pragma unroll 2
            for (int c = 0; c < 8; ++c) {
#if REFSEL
                const f32x4 ta = kp32[2 * c], tb = kp32[2 * c + 1];
                const float k0 = ta.x, k1 = ta.y, k2 = ta.z, k3 = ta.w, k4 = tb.x, k5 = tb.y, k6 = tb.z, k7 = tb.w;
#else
                const v4u t = kp[c];
                const float k0 = bflo(t.x), k1 = bfhi(t.x), k2 = bflo(t.y), k3 = bfhi(t.y), k4 = bflo(t.z), k5 = bfhi(t.z), k6 = bflo(t.w), k7 = bfhi(t.w);
#endif
#pragma unroll
                for (int h = 0; h < 8; ++h) {
                    const f32x4 qa = *(const LAS f32x4*)(qf + h * 64 + 8 * c), qb = *(const LAS f32x4*)(qf + h * 64 + 8 * c + 4);
                    d[h] += qa.x * k0 + qa.y * k1 + qa.z * k2 + qa.w * k3 + qb.x * k4 + qb.y * k5 + qb.z * k6 + qb.w * k7;
                }
            }
            float s = 0.f;
#pragma unroll
            for (int h = 0; h < 8; ++h) s += w[h] * fmaxf(d[h], 0.f);
            sc[j] = s + 0.0f;
        }
        __syncthreads();
        unsigned short* selq = SEL + (size_t)q * TOPK;
        if (nvis <= TOPK) {
            for (int j = tid; j < nvis; j += NTHR) selq[j] = (unsigned short)j;
        } else {
            unsigned prefix = 0u, mask = 0u, need = TOPK;
            for (int pass = 0; pass < 4; ++pass) {
                const int shift = 24 - 8 * pass;
                if (tid < 256) hist[tid] = 0u;
                __syncthreads();
                for (int j = tid; j < nvis; j += NTHR) { const unsigned key = sortable(sc[j]); if ((key & mask) == prefix) atomicAdd((unsigned*)&hist[(key >> shift) & 255u], 1u); }
                __syncthreads();
                if (tid < 256) {
                    unsigned above = 0u; for (int bb = tid + 1; bb < 256; ++bb) above += hist[bb];
                    const unsigned c = hist[tid];
                    if (above < need && need <= above + c) { cw[0] = prefix | ((unsigned)tid << shift); cw[1] = need - above; }
                }
                __syncthreads();
                prefix = cw[0]; need = cw[1]; mask |= 0xFFu << shift;
                __syncthreads();
            }
            if (tid == 0) cw[2] = 0u;
            __syncthreads();
            for (int j = tid; j < nvis; j += NTHR) { if (sortable(sc[j]) > prefix) { const unsigned p = atomicAdd((unsigned*)&cw[2], 1u); selq[p] = (unsigned short)j; } }
            __syncthreads();
            if (F.wave == 0) {
                const unsigned base = cw[2]; unsigned taken = 0u;
                for (int j0 = 0; j0 < nvis && taken < need; j0 += 64) {
                    const int j = j0 + F.lane; const bool eq = j < nvis && sortable(sc[j]) == prefix;
                    const unsigned long long m = __ballot(eq);
                    const unsigned rank = (unsigned)__popcll(m & ((1ull << F.lane) - 1ull));
                    if (eq && taken + rank < need) selq[base + taken + rank] = (unsigned short)j;
                    taken += (unsigned)__popcll(m);
                }
            }
        }
        if (tid == 0) NSEL[q] = nvis < TOPK ? nvis : TOPK;
        __syncthreads();
    }
}

__device__ __forceinline__ void p6_attn_naive(Frame& F) {
    bf16* QA = WSP(bf16, WS_QA); const bf16* CKV = WSP(bf16, WS_CKV); const unsigned short* SEL = WSP(unsigned short, WS_SEL); const int* NSEL = WSP(int, WS_NSEL);
    LAS float* qf = (LAS float*)(F.lds + F.wave * 16384);
    LAS float* ps = qf + 1024;
    LAS int* srow = (LAS int*)(ps + 2048);
    const int l = F.lane;
    const int gw = blockIdx.x * NWAVES + F.wave, NGW = F.G * NWAVES;
    for (int q = gw; q < R; q += NGW) {
        bf16* qrow = QA + (size_t)q * QAW;
        if (q >= NROWS) {
            for (int c = l; c < QAW / 8; c += 64) *(v4u*)(qrow + 8 * c) = (v4u){0u, 0u, 0u, 0u};
            continue;
        }
        int b, pos; if (q < NREAL) { b = q >> 13; pos = NMETA + (q & (SEQ - 1)); } else { b = 0; pos = q - NREAL; }
        const int nsel = NSEL[q];
        {
            const v4u t0 = *(const v4u*)(qrow + 16 * l), t1 = *(const v4u*)(qrow + 16 * l + 8);
            LAS float* d = qf + 16 * l;
            d[0] = bflo(t0.x); d[1] = bfhi(t0.x); d[2] = bflo(t0.y); d[3] = bfhi(t0.y); d[4] = bflo(t0.z); d[5] = bfhi(t0.z); d[6] = bflo(t0.w); d[7] = bfhi(t0.w);
            d[8] = bflo(t1.x); d[9] = bfhi(t1.x); d[10] = bflo(t1.y); d[11] = bfhi(t1.y); d[12] = bflo(t1.z); d[13] = bfhi(t1.z); d[14] = bflo(t1.w); d[15] = bfhi(t1.w);
        }
        __builtin_amdgcn_wave_barrier();
        for (int kk = 0; kk < 4; ++kk) {
            const int s = kk * 64 + l; const bool valid = s < nsel;
            const int j = valid ? (int)SEL[(size_t)q * TOPK + s] : 0;
            const int row = key_row(b, j);
            srow[s] = row;
            float acc[8];
#pragma unroll
            for (int h = 0; h < 8; ++h) acc[h] = 0.f;
            const v4u* kp = (const v4u*)(CKV + (size_t)row * 128);
            for (int c8 = 0; c8 < 16; ++c8) {
                const v4u t = kp[c8];
                const float k0 = bflo(t.x), k1 = bfhi(t.x), k2 = bflo(t.y), k3 = bfhi(t.y), k4 = bflo(t.z), k5 = bfhi(t.z), k6 = bflo(t.w), k7 = bfhi(t.w);
#pragma unroll
                for (int h = 0; h < 8; ++h) {
                    const f32x4 qa = *(const LAS f32x4*)(qf + h * 128 + 8 * c8), qb = *(const LAS f32x4*)(qf + h * 128 + 8 * c8 + 4);
                    acc[h] += qa.x * k0 + qa.y * k1 + qa.z * k2 + qa.w * k3 + qb.x * k4 + qb.y * k5 + qb.z * k6 + qb.w * k7;
                }
            }
            const float dist = fabsf((float)(pos - j));
#pragma unroll
            for (int h = 0; h < 8; ++h) { const float slope = __uint_as_float((unsigned)(127 - (h + 1)) << 23); ps[s * 8 + h] = valid ? acc[h] - slope * dist : -INFINITY; }
        }
        __builtin_amdgcn_wave_barrier();
#pragma unroll
        for (int h = 0; h < 8; ++h) {
            float v0 = ps[(l) * 8 + h], v1 = ps[(l + 64) * 8 + h], v2 = ps[(l + 128) * 8 + h], v3 = ps[(l + 192) * 8 + h];
            const float mx = wave_max(fmaxf(fmaxf(v0, v1), fmaxf(v2, v3)));
            v0 = __expf(v0 - mx); v1 = __expf(v1 - mx); v2 = __expf(v2 - mx); v3 = __expf(v3 - mx);
            const float inv = 1.0f / wave_sum((v0 + v1) + (v2 + v3));
            ps[(l) * 8 + h] = v0 * inv; ps[(l + 64) * 8 + h] = v1 * inv; ps[(l + 128) * 8 + h] = v2 * inv; ps[(l + 192) * 8 + h] = v3 * inv;
        }
        __builtin_amdgcn_wave_barrier();
        float o0[8], o1[8];
#pragma unroll
        for (int h = 0; h < 8; ++h) { o0[h] = 0.f; o1[h] = 0.f; }
        for (int s = 0; s < nsel; ++s) {
            const int row = srow[s];
            const unsigned w = *(const unsigned*)(CKV + (size_t)row * 128 + 2 * l);
            const float c0 = bflo(w), c1 = bfhi(w);
            const f32x4 pa = *(const LAS f32x4*)(ps + s * 8), pb = *(const LAS f32x4*)(ps + s * 8 + 4);
            o0[0] += pa.x * c0; o1[0] += pa.x * c1; o0[1] += pa.y * c0; o1[1] += pa.y * c1; o0[2] += pa.z * c0; o1[2] += pa.z * c1; o0[3] += pa.w * c0; o1[3] += pa.w * c1;
            o0[4] += pb.x * c0; o1[4] += pb.x * c1; o0[5] += pb.y * c0; o1[5] += pb.y * c1; o0[6] += pb.z * c0; o1[6] += pb.z * c1; o0[7] += pb.w * c0; o1[7] += pb.w * c1;
        }
#pragma unroll
        for (int h = 0; h < 8; ++h) *(unsigned*)(qrow + h * 128 + 2 * l) = pk2(o0[h], o1[h]);
        __builtin_amdgcn_wave_barrier();
    }
}

__device__ __forceinline__ void p7_rwkv_prep_naive(Frame& F) {
    const bf16* P = WSP(bf16, WS_P); float* DEC = WSP(float, WS_DEC); bf16* AB = WSP(bf16, WS_AB); bf16* GB = WSP(bf16, WS_GB);
    const float* mu = F.in[IN_MU]; const float* Wd = F.in[IN_W_DEC]; const float* Wa = F.in[IN_W_AAA]; const float* Wg = F.in[IN_W_GATE];
    const int l = F.lane;
    const int gw = blockIdx.x * NWAVES + F.wave, NGW = F.G * NWAVES;
    for (int r = gw; r < NROWS; r += NGW) {
        int prev; if (r < NREAL) { prev = (r & (SEQ - 1)) ? r - 1 : NREAL + NMETA - 1; } else { prev = r > NREAL ? r - 1 : -1; }
        const bf16* pr = P + (size_t)r * PW; const bf16* pp = prev >= 0 ? P + (size_t)prev * PW : nullptr;
#define SHIFTED(pc, mc) (bf2f(pr[pc]) + ((pp ? bf2f(pp[pc]) : 0.f) - bf2f(pr[pc])) * mu[mc])
        const float tw = tanhf(SHIFTED(PC_WD + l, 1536 + l));
        const float ta = SHIFTED(PC_AD + l, 1600 + l);
        const float tg0 = sigmoidf_(SHIFTED(PC_GD + l, 1664 + l)), tg1 = sigmoidf_(SHIFTED(PC_GD + 64 + l, 1728 + l));
#undef SHIFTED
        float aw[8], aa[8], ag[8];
#pragma unroll
        for (int i = 0; i < 8; ++i) { aw[i] = F.in[IN_W0][l + 64 * i]; aa[i] = F.in[IN_A0][l + 64 * i]; ag[i] = 0.f; }
        for (int j = 0; j < 64; ++j) {
            const float xw = __shfl(tw, j), xa = __shfl(ta, j), xg0 = __shfl(tg0, j), xg1 = __shfl(tg1, j);
#pragma unroll
            for (int i = 0; i < 8; ++i) {
                aw[i] += xw * Wd[(size_t)j * 512 + l + 64 * i];
                aa[i] += xa * Wa[(size_t)j * 512 + l + 64 * i];
                ag[i] += xg0 * Wg[(size_t)j * 512 + l + 64 * i] + xg1 * Wg[(size_t)(j + 64) * 512 + l + 64 * i];
            }
        }
#pragma unroll
        for (int i = 0; i < 8; ++i) {
            const float x = -aw[i];
            const float sp = x > 20.f ? x : log1pf(__expf(x));
            const float wlog = -sp - 0.5f;
            DEC[(size_t)r * 512 + l + 64 * i] = __expf(-__expf(wlog));
            AB[(size_t)r * 512 + l + 64 * i] = (bf16)f2bf(sigmoidf_(aa[i]));
            GB[(size_t)r * 512 + l + 64 * i] = (bf16)f2bf(ag[i]);
        }
    }
}

__device__ __forceinline__ void p8_rwkv_scan_naive(Frame& F) {
    if (F.wave != 0 || blockIdx.x >= 32) return;
    const bf16* P = WSP(bf16, WS_P); const float* DEC = WSP(float, WS_DEC); const bf16* AB = WSP(bf16, WS_AB); const bf16* GB = WSP(bf16, WS_GB); bf16* QA = WSP(bf16, WS_QA);
    const int b = blockIdx.x >> 3, h = blockIdx.x & 7, l = F.lane, ch = h * 64 + l;
    LAS float* vec = (LAS float*)F.lds;
    const float mu_r = F.in[IN_MU][ch], mu_k = F.in[IN_MU][512 + ch], mu_v = F.in[IN_MU][1024 + ch];
    const float kk_c = F.in[IN_KK][ch], ka_c = F.in[IN_KA][ch], rk_c = F.in[IN_RK][ch], gng = F.in[IN_GN_G][ch], gnb = F.in[IN_GN_B][ch];
    float S[64];
#pragma unroll
    for (int k = 0; k < 64; ++k) S[k] = 0.f;
    float pr_p = 0.f, pk_p = 0.f, pv_p = 0.f;
    int row = key_row(b, 0);
    float n_pr = bf2f(P[(size_t)row * PW + PC_R + ch]), n_pk = bf2f(P[(size_t)row * PW + PC_K + ch]), n_pv = bf2f(P[(size_t)row * PW + PC_V + ch]);
    float n_w = DEC[(size_t)row * 512 + ch], n_a = bf2f(AB[(size_t)row * 512 + ch]), n_g = bf2f(GB[(size_t)row * 512 + ch]);
    for (int pos = 0; pos < TT; ++pos) {
        const int crow = row;
        const float c_pr = n_pr, c_pk = n_pk, c_pv = n_pv, c_w = n_w, c_a = n_a, c_g = n_g;
        if (pos + 1 < TT) {
            row = key_row(b, pos + 1);
            n_pr = bf2f(P[(size_t)row * PW + PC_R + ch]); n_pk = bf2f(P[(size_t)row * PW + PC_K + ch]); n_pv = bf2f(P[(size_t)row * PW + PC_V + ch]);
            n_w = DEC[(size_t)row * 512 + ch]; n_a = bf2f(AB[(size_t)row * 512 + ch]); n_g = bf2f(GB[(size_t)row * 512 + ch]);
        }
        const float r_s = c_pr + (pr_p - c_pr) * mu_r, k_s = c_pk + (pk_p - c_pk) * mu_k, v_s = c_pv + (pv_p - c_pv) * mu_v;
        pr_p = c_pr; pk_p = c_pk; pv_p = c_pv;
        const float kkr = k_s * kk_c;
        const float nrm = sqrtf(wave_sum(kkr * kkr));
        const float kk = kkr / fmaxf(nrm, 1e-12f);
        const float k2 = k_s * (1.f + (c_a - 1.f) * ka_c);
        vec[l] = -kk; vec[64 + l] = kk * c_a; vec[128 + l] = c_w; vec[192 + l] = k2; vec[256 + l] = r_s;
        __builtin_amdgcn_wave_barrier();
        float sa = 0.f;
#pragma unroll
        for (int k4 = 0; k4 < 16; ++k4) { const f32x4 a = *(const LAS f32x4*)(vec + 4 * k4); sa += S[4 * k4] * a.x + S[4 * k4 + 1] * a.y + S[4 * k4 + 2] * a.z + S[4 * k4 + 3] * a.w; }
        float y = 0.f;
#pragma unroll
        for (int k4 = 0; k4 < 16; ++k4) {
            const f32x4 bv = *(const LAS f32x4*)(vec + 64 + 4 * k4), w = *(const LAS f32x4*)(vec + 128 + 4 * k4), kv = *(const LAS f32x4*)(vec + 192 + 4 * k4), rv = *(const LAS f32x4*)(vec + 256 + 4 * k4);
            S[4 * k4] = S[4 * k4] * w.x + sa * bv.x + v_s * kv.x; S[4 * k4 + 1] = S[4 * k4 + 1] * w.y + sa * bv.y + v_s * kv.y;
            S[4 * k4 + 2] = S[4 * k4 + 2] * w.z + sa * bv.z + v_s * kv.z; S[4 * k4 + 3] = S[4 * k4 + 3] * w.w + sa * bv.w + v_s * kv.w;
            y += S[4 * k4] * rv.x + S[4 * k4 + 1] * rv.y + S[4 * k4 + 2] * rv.z + S[4 * k4 + 3] * rv.w;
        }
        __builtin_amdgcn_wave_barrier();
        const float mean = wave_sum(y) * (1.f / 64.f);
        const float dlt = y - mean;
        const float var = wave_sum(dlt * dlt) * (1.f / 64.f);
        const float yn = dlt * (1.0f / sqrtf(var + GN_EPS)) * gng + gnb;
        const float bonus = wave_sum(r_s * k2 * rk_c) * v_s;
        const float o = (yn + bonus) * c_g;
        if (pos >= NMETA || b == 0) QA[(size_t)crow * QAW + 1024 + ch] = (bf16)f2bf(o);
    }
}

__device__ __forceinline__ void p10_ln1(Frame& F) {
    bf16* H1 = WSP(bf16, WS_H); const float* META1 = WSP(float, WS_META1);
    const int gw = blockIdx.x * NWAVES + F.wave, NGW = F.G * NWAVES;
    for (int r = gw; r < NROWS; r += NGW) {
        const float* src = r < NREAL ? F.out + (size_t)r * D : META1 + (size_t)(r - NREAL) * D;
        ln_row_bf16(F, src, F.in[IN_LN1_G], F.in[IN_LN1_B], H1 + (size_t)r * D);
    }
}
__device__ __forceinline__ void p14_ln2(Frame& F) {
    const int gw = blockIdx.x * NWAVES + F.wave, NGW = F.G * NWAVES;
    const float* g = F.in[IN_LN2_G]; const float* b = F.in[IN_LN2_B];
    for (int r = gw; r < NREAL; r += NGW) {
        f32x4* xr = (f32x4*)(F.out + (size_t)r * D) + F.lane;
        f32x4 v[4]; float s = 0.f;
#pragma unroll
        for (int j = 0; j < 4; ++j) { v[j] = xr[64 * j]; s += (v[j].x + v[j].y) + (v[j].z + v[j].w); }
        const float mean = wave_sum(s) * (1.f / D); float s2 = 0.f;
#pragma unroll
        for (int j = 0; j < 4; ++j) { v[j] = v[j] - mean; s2 += (v[j].x * v[j].x + v[j].y * v[j].y) + (v[j].z * v[j].z + v[j].w * v[j].w); }
        const float rstd = 1.f / sqrtf(wave_sum(s2) * (1.f / D) + LN_EPS);
#pragma unroll
        for (int j = 0; j < 4; ++j) { const f32x4 gg = ((const f32x4*)g)[F.lane + 64 * j], bb = ((const f32x4*)b)[F.lane + 64 * j]; xr[64 * j] = v[j] * rstd * gg + bb; }
    }
}

__device__ __forceinline__ float gelu_tanh(float x) { const float u = 0.7978845608028654f * (x + 0.044715f * x * x * x); return 0.5f * x * (1.f + tanhf(u)); }
__device__ __forceinline__ void p12_conv_act(Frame& F) {
    bf16* UP = WSP(bf16, WS_UP); const float* cw = F.in[IN_CONV_W]; const float* cb = F.in[IN_CONV_B];
    const size_t total = (size_t)NREAL * (DFF / 8);
    for (size_t it = (size_t)blockIdx.x * NTHR + F.tid; it < total; it += (size_t)F.G * NTHR) {
        const int r = (int)(it / (DFF / 8)), c = (int)(it % (DFF / 8)) * 8, s = r & (SEQ - 1);
        const int r1 = s >= 1 ? r - 1 : NREAL + 15, r2 = s >= 2 ? r - 2 : NREAL + 14 + s;
        const v4u g0 = *(const v4u*)(UP + (size_t)r * UPW + c), g1 = *(const v4u*)(UP + (size_t)r1 * UPW + c), g2 = *(const v4u*)(UP + (size_t)r2 * UPW + c);
        const v4u vv = *(const v4u*)(UP + (size_t)r * UPW + DFF + c);
        const unsigned a0[4] = {g0.x, g0.y, g0.z, g0.w}, a1[4] = {g1.x, g1.y, g1.z, g1.w}, a2[4] = {g2.x, g2.y, g2.z, g2.w}, av[4] = {vv.x, vv.y, vv.z, vv.w};
        unsigned o[4];
#pragma unroll
        for (int e = 0; e < 4; ++e) {
            const int c0 = c + 2 * e, c1 = c0 + 1;
            const float x0 = cw[c0] * bflo(a2[e]) + cw[DFF + c0] * bflo(a1[e]) + cw[2 * DFF + c0] * bflo(a0[e]) + cb[c0];
            const float x1 = cw[c1] * bfhi(a2[e]) + cw[DFF + c1] * bfhi(a1[e]) + cw[2 * DFF + c1] * bfhi(a0[e]) + cb[c1];
            o[e] = pk2(gelu_tanh(x0) * bflo(av[e]), gelu_tanh(x1) * bfhi(av[e]));
        }
        *(v4u*)(UP + (size_t)r * UPW + DFF + c) = (v4u){o[0], o[1], o[2], o[3]};
    }
}


constexpr int NUNITS = 4096 + 8;
constexpr int RP = 72;
constexpr int SLOT = 64 * RP * 2;
constexpr int FP = 68;
typedef short bf16x8 __attribute__((ext_vector_type(8)));
typedef float f32x16 __attribute__((ext_vector_type(16)));
constexpr size_t RW_MAT = (size_t)NUNITS * 4096;

__device__ __forceinline__ void quad_mma(f32x16& acc, const LAS bf16* Aop, const LAS bf16* Bop, int qr, int qc, int lane) {
    const int r = lane & 31, hf = lane >> 5;
    const LAS bf16* ap = Aop + (32 * qr + r) * RP + 8 * hf; const LAS bf16* bp = Bop + (32 * qc + r) * RP + 8 * hf;
#pragma unroll
    for (int ks = 0; ks < 4; ++ks) {
        const bf16x8 a = *(const LAS bf16x8*)(ap + 16 * ks), b = *(const LAS bf16x8*)(bp + 16 * ks);
        acc = __builtin_amdgcn_mfma_f32_32x32x16_bf16(a, b, acc, 0, 0, 0);
    }
}
#define ACC_M(qr, j, hf) (32 * (qr) + ((j) & 3) + 8 * ((j) >> 2) + 4 * (hf))
__device__ __forceinline__ void store_T(const f32x16& acc, LAS bf16* Z, int qr, int qc, int lane) {
    const int r = lane & 31, hf = lane >> 5;
#pragma unroll
    for (int jj = 0; jj < 4; ++jj)
        *(LAS v2u*)(Z + (32 * qc + r) * RP + 32 * qr + 8 * jj + 4 * hf) = (v2u){pk2(acc[4 * jj], acc[4 * jj + 1]), pk2(acc[4 * jj + 2], acc[4 * jj + 3])};
}
__device__ __forceinline__ void add_T(f32x16& acc, const LAS bf16* Z, int qr, int qc, int lane) {
    const int r = lane & 31, hf = lane >> 5;
#pragma unroll
    for (int jj = 0; jj < 4; ++jj) {
        const v2u w = *(const LAS v2u*)(Z + (32 * qc + r) * RP + 32 * qr + 8 * jj + 4 * hf);
        acc[4 * jj] += bflo(w.x); acc[4 * jj + 1] += bfhi(w.x); acc[4 * jj + 2] += bflo(w.y); acc[4 * jj + 3] += bfhi(w.y);
    }
}
__device__ __forceinline__ void store_T_global(const f32x16& acc, bf16* Z, int qr, int qc, int lane) {
    const int r = lane & 31, hf = lane >> 5;
#pragma unroll
    for (int jj = 0; jj < 4; ++jj)
        *(v2u*)(Z + (32 * qc + r) * 64 + 32 * qr + 8 * jj + 4 * hf) = (v2u){pk2(acc[4 * jj], acc[4 * jj + 1]), pk2(acc[4 * jj + 2], acc[4 * jj + 3])};
}
__device__ __forceinline__ f32x16 zero16() { f32x16 z;
#pragma unroll
    for (int j = 0; j < 16; ++j) z[j] = 0.f;
    return z; }

__device__ __forceinline__ void rw_b1(Frame& F) {
    const bf16* P = WSP(bf16, WS_P);
    bf16* RWM = WSP(bf16, WS_RWM); bf16* RWN = WSP(bf16, WS_RWN); bf16* RWQ = WSP(bf16, WS_RWQ); bf16* RWY = WSP(bf16, WS_RWY);
    float* BONUS = (float*)((char*)F.out + OUT_BONUS);
    const bf16* WdT = WSP(bf16, WS_WT_LORA); const bf16* WaT = WdT + 512 * 64;
    const float* mu = F.in[IN_MU];
    const int w = F.wave, l = F.lane, tid = F.tid;
    LAS unsigned char* L = F.lds;
#define SL(s) ((LAS bf16*)(L + (s) * SLOT))
    LAS float* WL = (LAS float*)(L + 12 * SLOT);
    LAS float* AL = (LAS float*)(L + 0 * SLOT);
    LAS float* OT = (LAS float*)(L + RING_BYTES + 1024);
    LAS float* GL = OT + 512;
    for (int u = blockIdx.x; u < NUNITS; u += F.G) {
        const bool meta = u >= 4096;
        int b = 0, h, c = 0; if (meta) h = u - 4096; else { b = u >> 10; h = (u >> 7) & 7; c = u & 127; }
        const int ch = h * 64 + l;
        const int row0 = meta ? NREAL : b * SEQ + c * 64;
        __syncthreads();
        float r_s[8], k_s[8], v_s[8], xw[8], xa[8];
        {
            float pr, pk, pv, pw, pa;
            const int t0 = 8 * w;
            int prow = -1;
            if (t0 > 0) prow = row0 + t0 - 1; else if (!meta) prow = (c == 0) ? NREAL + NMETA - 1 : row0 - 1;
            if (prow >= 0) { const bf16* pp = P + (size_t)prow * PW; pr = bf2f(pp[PC_R + ch]); pk = bf2f(pp[PC_K + ch]); pv = bf2f(pp[PC_V + ch]); pw = bf2f(pp[PC_WD + l]); pa = bf2f(pp[PC_AD + l]); }
            else { pr = pk = pv = pw = pa = 0.f; }
            const float mr = mu[ch], mk = mu[512 + ch], mv = mu[1024 + ch], mw = mu[1536 + l], ma = mu[1600 + l];
#pragma unroll
            for (int i = 0; i < 8; ++i) {
                const int t = t0 + i; const bool valid = !meta || t < NMETA;
                float cr = 0.f, ck = 0.f, cv = 0.f, cw = 0.f, ca = 0.f;
                if (valid) { const bf16* pp = P + (size_t)(row0 + t) * PW; cr = bf2f(pp[PC_R + ch]); ck = bf2f(pp[PC_K + ch]); cv = bf2f(pp[PC_V + ch]); cw = bf2f(pp[PC_WD + l]); ca = bf2f(pp[PC_AD + l]); }
                r_s[i] = valid ? cr + (pr - cr) * mr : 0.f; k_s[i] = valid ? ck + (pk - ck) * mk : 0.f; v_s[i] = valid ? cv + (pv - cv) * mv : 0.f;
                xw[i] = tanhf(cw + (pw - cw) * mw); xa[i] = ca + (pa - ca) * ma;
                pr = cr; pk = ck; pv = cv; pw = cw; pa = ca;
            }
#pragma unroll
            for (int i = 0; i < 8; ++i) { SL(8)[(t0 + i) * RP + l] = (bf16)f2bf(xw[i]); SL(9)[(t0 + i) * RP + l] = (bf16)f2bf(xa[i]); }
            {
                const int k = tid >> 3, pc = tid & 7;
                *(LAS v4u*)(SL(10) + k * RP + 8 * pc) = *(const v4u*)(WdT + (size_t)(h * 64 + k) * 64 + 8 * pc);
                *(LAS v4u*)(SL(11) + k * RP + 8 * pc) = *(const v4u*)(WaT + (size_t)(h * 64 + k) * 64 + 8 * pc);
            }
        }
        __syncthreads();
        {
            const int pid = w >> 2, q = w & 3, qr = q >> 1, qc = q & 1;
            f32x16 acc = zero16();
            quad_mma(acc, SL(10 + pid), SL(8 + pid), qr, qc, l);
            LAS float* Zf = pid ? AL : WL;
            const int r = l & 31, hf = l >> 5;
#pragma unroll
            for (int jj = 0; jj < 4; ++jj) *(LAS f32x4*)(Zf + (32 * qc + r) * FP + 32 * qr + 8 * jj + 4 * hf) = (f32x4){acc[4 * jj], acc[4 * jj + 1], acc[4 * jj + 2], acc[4 * jj + 3]};
        }
        __syncthreads();
        float lw[8], asg[8];
        {
            const float w0c = F.in[IN_W0][ch], a0c = F.in[IN_A0][ch];
            float run = 0.f;
#pragma unroll
            for (int i = 0; i < 8; ++i) {
                const int t = 8 * w + i; const bool valid = !meta || t < NMETA;
                const float x = -(WL[t * FP + l] + w0c);
                const float sp = x > 20.f ? x : log1pf(__expf(x));
                const float e = -__expf(-sp - 0.5f);
                run += valid ? e : 0.f; lw[i] = run;
                asg[i] = sigmoidf_(AL[t * FP + l] + a0c);
            }
            OT[w * 64 + l] = run;
        }
        __syncthreads();
        {
            float off = 0.f, tot = 0.f;
#pragma unroll
            for (int ww = 0; ww < 8; ++ww) { const float o = OT[ww * 64 + l]; tot += o; off += ww < w ? o : 0.f; }
            if (w == 0) GL[l] = __expf(tot);
            const float kkc = F.in[IN_KK][ch], kac = F.in[IN_KA][ch], rkc = F.in[IN_RK][ch];
            unsigned atc[4], vc[4], bhc[4], khc[4];
            float prevlg = off;
#pragma unroll
            for (int i = 0; i < 8; ++i) {
                const int t = 8 * w + i;
                const float lg = off + lw[i];
                const float g = __expf(lg), gp = __expf(prevlg), gi = __expf(-lg), gh = __expf(tot - lg);
                prevlg = lg;
                const float kkr = k_s[i] * kkc;
                const float nrm = sqrtf(wave_sum(kkr * kkr));
                const float kk = kkr / fmaxf(nrm, 1e-12f);
                const float k2 = k_s[i] * (1.f + (asg[i] - 1.f) * kac);
                const float bon = wave_sum(r_s[i] * k2 * rkc);
                if (l == 0) BONUS[(size_t)u * 64 + t] = bon;
                const float at = -kk * gp, rt = r_s[i] * g, bt = kk * asg[i] * gi, kt = k2 * gi, bh = kk * asg[i] * gh, kh = k2 * gh;
                SL(0)[t * RP + l] = (bf16)f2bf(at); SL(1)[t * RP + l] = (bf16)f2bf(rt); SL(2)[t * RP + l] = (bf16)f2bf(bt); SL(3)[t * RP + l] = (bf16)f2bf(kt);
                const unsigned ua = f2bf(at), uv = f2bf(v_s[i]), ub = f2bf(bh), uk = f2bf(kh);
                if (i & 1) { atc[i >> 1] |= ua << 16; vc[i >> 1] |= uv << 16; bhc[i >> 1] |= ub << 16; khc[i >> 1] |= uk << 16; }
                else { atc[i >> 1] = ua; vc[i >> 1] = uv; bhc[i >> 1] = ub; khc[i >> 1] = uk; }
            }
            *(LAS v4u*)(SL(4) + l * RP + 8 * w) = (v4u){atc[0], atc[1], atc[2], atc[3]};
            *(LAS v4u*)(SL(5) + l * RP + 8 * w) = (v4u){vc[0], vc[1], vc[2], vc[3]};
            *(LAS v4u*)(SL(6) + l * RP + 8 * w) = (v4u){bhc[0], bhc[1], bhc[2], bhc[3]};
            *(LAS v4u*)(SL(7) + l * RP + 8 * w) = (v4u){khc[0], khc[1], khc[2], khc[3]};
        }
        __syncthreads();
        for (int task = w; task < 20; task += 8) {
            const int pid = task >> 2, q = task & 3, qr = q >> 1, qc = q & 1;
            const int bop = pid == 0 ? 0 : pid == 1 ? 2 : pid == 2 ? 0 : 1;
            const int aop = pid == 0 ? 2 : pid == 1 ? 0 : pid == 2 ? 3 : pid == 3 ? 2 : 3;
            f32x16 acc = zero16();
            quad_mma(acc, SL(aop), SL(bop), qr, qc, l);
            const int n = 32 * qc + (l & 31), hf = l >> 5;
#pragma unroll
            for (int j = 0; j < 16; ++j) {
                const int m = ACC_M(qr, j, hf);
                const bool keep = pid == 1 ? (m > n) : (pid <= 2 ? (n > m) : (n >= m));
                acc[j] = keep ? acc[j] : 0.f;
            }
            store_T(acc, SL(8 + pid), qr, qc, l);
        }
        __syncthreads();
        const int nq = w & 3, nqr = nq >> 1, nqc = nq & 1;
        f32x16 nacc = zero16();
        if (w < 4) { add_T(nacc, SL(8), nqr, nqc, l); }
        for (int task = w; task < 12; task += 8) {
            const int pid = task >> 2, q = task & 3, qr = q >> 1, qc = q & 1;
            f32x16 acc = zero16();
            if (pid == 0) { quad_mma(acc, SL(9), SL(8), qr, qc, l); store_T(acc, SL(0), qr, qc, l); }
            else if (pid == 1) { quad_mma(acc, SL(8), SL(9), qr, qc, l); store_T(acc, SL(2), qr, qc, l); }
            else { quad_mma(acc, SL(10), SL(5), qr, qc, l); store_T(acc, SL(3), qr, qc, l); }
        }
        __syncthreads();
#pragma unroll
        for (int st = 0; st < 4; ++st) {
            const int pr = (st & 1) ? 10 : 0, pc = (st & 1) ? 13 : 2, pr2 = (st & 1) ? 0 : 10, pc2 = (st & 1) ? 2 : 13, nr = (st & 1) ? 9 : 8, nr2 = (st & 1) ? 8 : 9;
            if (w < 4) {
                add_T(nacc, SL(pr), nqr, nqc, l);
                quad_mma(nacc, SL(pc), SL(nr), nqr, nqc, l);
                store_T(nacc, SL(nr2), nqr, nqc, l);
                f32x16 acc = zero16();
                quad_mma(acc, SL(pc), SL(pr), nqr, nqc, l); store_T(acc, SL(pr2), nqr, nqc, l);
            } else {
                f32x16 acc = zero16();
                quad_mma(acc, SL(pr), SL(pc), nqr, nqc, l); store_T(acc, SL(pc2), nqr, nqc, l);
            }
            __syncthreads();
        }
        if (w < 4) { add_T(nacc, SL(0), nqr, nqc, l); quad_mma(nacc, SL(2), SL(8), nqr, nqc, l); store_T(nacc, SL(9), nqr, nqc, l); }
        __syncthreads();
        {
            const int pid = w >> 2;
            f32x16 acc = zero16();
            add_T(acc, SL(pid ? 3 : 4), nqr, nqc, l);
            quad_mma(acc, SL(9), SL(pid ? 3 : 4), nqr, nqc, l);
            store_T(acc, SL(pid ? 2 : 0), nqr, nqc, l);
        }
        __syncthreads();
        for (int task = w; task < 16; task += 8) {
            const int pid = task >> 2, q = task & 3, qr = q >> 1, qc = q & 1;
            f32x16 acc = zero16();
            if (pid == 0) { add_T(acc, SL(1), qr, qc, l); quad_mma(acc, SL(0), SL(11), qr, qc, l); store_T_global(acc, RWQ + (size_t)u * 4096, qr, qc, l); }
            else if (pid == 1) { quad_mma(acc, SL(2), SL(11), qr, qc, l); quad_mma(acc, SL(5), SL(12), qr, qc, l); store_T_global(acc, RWY + (size_t)u * 4096, qr, qc, l); }
            else if (pid == 2) {
                quad_mma(acc, SL(0), SL(6), qr, qc, l);
                const int n = 32 * qc + (l & 31), hf = l >> 5; const float gl = GL[n];
#pragma unroll
                for (int j = 0; j < 16; ++j) acc[j] += (ACC_M(qr, j, hf) == n) ? gl : 0.f;
                store_T_global(acc, RWM + (size_t)u * 4096, qr, qc, l);
            } else { quad_mma(acc, SL(6), SL(2), qr, qc, l); quad_mma(acc, SL(7), SL(5), qr, qc, l); store_T_global(acc, RWN + (size_t)u * 4096, qr, qc, l); }
        }
    }
#undef SL
}

__device__ __forceinline__ void rw_b2(Frame& F) {
    if (blockIdx.x >= 32) return;
    const bf16* RWM = WSP(bf16, WS_RWM); const bf16* RWN = WSP(bf16, WS_RWN);
    bf16* RWS = (bf16*)((char*)F.out + OUT_RWS);
    const int b = blockIdx.x >> 3, h = blockIdx.x & 7, w = F.wave, l = F.lane;
    LAS unsigned char* L = F.lds;
#define SS(buf, part) ((LAS bf16*)(L + ((buf) * 2 + (part)) * SLOT))
    const int q = w & 3, qr = q >> 1, qc = q & 1, r = l & 31, hf = l >> 5;
    if (w < 4) {
        const bf16* Nm = RWN + (size_t)(4096 + h) * 4096;
#pragma unroll
        for (int jj = 0; jj < 4; ++jj) {
            const v2u wv = *(const v2u*)(Nm + (32 * qc + r) * 64 + 32 * qr + 8 * jj + 4 * hf);
            *(LAS v2u*)(SS(0, 0) + (32 * qc + r) * RP + 32 * qr + 8 * jj + 4 * hf) = wv;
            *(LAS v2u*)(SS(0, 1) + (32 * qc + r) * RP + 32 * qr + 8 * jj + 4 * hf) = (v2u){0u, 0u};
        }
    }
    __syncthreads();
    bf16x8 a_cur[4]; v2u n_cur[4];
    {
        const size_t u0 = (size_t)(b * 8 + h) * 128;
#pragma unroll
        for (int ks = 0; ks < 4; ++ks) a_cur[ks] = *(const bf16x8*)(RWM + u0 * 4096 + (32 * qr + r) * 64 + 8 * hf + 16 * ks);
#pragma unroll
        for (int jj = 0; jj < 4; ++jj) n_cur[jj] = *(const v2u*)(RWN + u0 * 4096 + (32 * qc + r) * 64 + 32 * qr + 8 * jj + 4 * hf);
    }
    for (int c = 0; c < 128; ++c) {
        const int u = (b * 8 + h) * 128 + c, cur = c & 1;
        if (w < 4) {
            bf16x8 a_nxt[4]; v2u n_nxt[4];
            const size_t un = (size_t)(c + 1 < 128 ? u + 1 : u);
#pragma unroll
            for (int ks = 0; ks < 4; ++ks) a_nxt[ks] = *(const bf16x8*)(RWM + un * 4096 + (32 * qr + r) * 64 + 8 * hf + 16 * ks);
#pragma unroll
            for (int jj = 0; jj < 4; ++jj) n_nxt[jj] = *(const v2u*)(RWN + un * 4096 + (32 * qc + r) * 64 + 32 * qr + 8 * jj + 4 * hf);
            f32x16 acc;
#pragma unroll
            for (int jj = 0; jj < 4; ++jj) { acc[4 * jj] = bflo(n_cur[jj].x); acc[4 * jj + 1] = bfhi(n_cur[jj].x); acc[4 * jj + 2] = bflo(n_cur[jj].y); acc[4 * jj + 3] = bfhi(n_cur[jj].y); }
#pragma unroll
            for (int jj = 0; jj < 4; ++jj)
                *(v2u*)(RWS + (size_t)u * 4096 + (32 * qc + r) * 64 + 32 * qr + 8 * jj + 4 * hf) = *(const LAS v2u*)(SS(cur, 0) + (32 * qc + r) * RP + 32 * qr + 8 * jj + 4 * hf);
            const LAS bf16* bh = SS(cur, 0) + (32 * qc + r) * RP + 8 * hf; const LAS bf16* bl = SS(cur, 1) + (32 * qc + r) * RP + 8 * hf;
#pragma unroll
            for (int ks = 0; ks < 4; ++ks) {
                acc = __builtin_amdgcn_mfma_f32_32x32x16_bf16(a_cur[ks], *(const LAS bf16x8*)(bh + 16 * ks), acc, 0, 0, 0);
                acc = __builtin_amdgcn_mfma_f32_32x32x16_bf16(a_cur[ks], *(const LAS bf16x8*)(bl + 16 * ks), acc, 0, 0, 0);
            }
#pragma unroll
            for (int jj = 0; jj < 4; ++jj) {
                float hi[4], lo[4];
#pragma unroll
                for (int e = 0; e < 4; ++e) { const unsigned hb = f2bf(acc[4 * jj + e]); hi[e] = __uint_as_float(hb << 16); lo[e] = acc[4 * jj + e] - hi[e]; }
                *(LAS v2u*)(SS(cur ^ 1, 0) + (32 * qc + r) * RP + 32 * qr + 8 * jj + 4 * hf) = (v2u){pk2(hi[0], hi[1]), pk2(hi[2], hi[3])};
                *(LAS v2u*)(SS(cur ^ 1, 1) + (32 * qc + r) * RP + 32 * qr + 8 * jj + 4 * hf) = (v2u){pk2(lo[0], lo[1]), pk2(lo[2], lo[3])};
            }
#pragma unroll
            for (int ks = 0; ks < 4; ++ks) a_cur[ks] = a_nxt[ks];
#pragma unroll
            for (int jj = 0; jj < 4; ++jj) n_cur[jj] = n_nxt[jj];
        }
        __syncthreads();
    }
#undef SS
}

__device__ __forceinline__ void rw_b3(Frame& F) {
    const bf16* P = WSP(bf16, WS_P); bf16* QA = WSP(bf16, WS_QA);
    const bf16* RWQ = WSP(bf16, WS_RWQ); const bf16* RWY = WSP(bf16, WS_RWY);
    const bf16* RWS = (const bf16*)((const char*)F.out + OUT_RWS); const float* BONUS = (const float*)((const char*)F.out + OUT_BONUS);
    const bf16* WgT = WSP(bf16, WS_WT_LORA) + 2 * 512 * 64;
    const float* mu = F.in[IN_MU];
    const int l = F.lane, r = l & 31, hf = l >> 5;
    const int gw = blockIdx.x * NWAVES + F.wave, NGW = F.G * NWAVES;
    for (int it = gw; it < NUNITS * 2; it += NGW) {
        const int u = it >> 1, th = it & 1;
        const bool meta = u >= 4096;
        int b = 0, h, c = 0; if (meta) h = u - 4096; else { b = u >> 10; h = (u >> 7) & 7; c = u & 127; }
        if (meta && th == 1) continue;
        const int t = 32 * th + r;
        const bool valid = !meta || t < NMETA;
        const int row0 = meta ? NREAL : b * SEQ + c * 64;
        const int row = valid ? row0 + t : row0;
        int prow = -1;
        if (t > 0) prow = row - 1; else if (!meta) prow = (c == 0) ? NREAL + NMETA - 1 : row - 1;
        f32x16 y[2];
#pragma unroll
        for (int qv = 0; qv < 2; ++qv) {
            const bf16* Y0 = RWY + (size_t)u * 4096 + (32 * th + r) * 64 + 32 * qv + 4 * hf;
#pragma unroll
            for (int jj = 0; jj < 4; ++jj) { const v2u wv = *(const v2u*)(Y0 + 8 * jj); y[qv][4 * jj] = bflo(wv.x); y[qv][4 * jj + 1] = bfhi(wv.x); y[qv][4 * jj + 2] = bflo(wv.y); y[qv][4 * jj + 3] = bfhi(wv.y); }
        }
        if (!meta) {
            const bf16* qp = RWQ + (size_t)u * 4096 + (32 * th + r) * 64 + 8 * hf;
            const bf16* sp = RWS + (size_t)u * 4096 + r * 64 + 8 * hf;
#pragma unroll
            for (int ks = 0; ks < 4; ++ks) {
                const bf16x8 bq = *(const bf16x8*)(qp + 16 * ks);
                y[0] = __builtin_amdgcn_mfma_f32_32x32x16_bf16(*(const bf16x8*)(sp + 16 * ks), bq, y[0], 0, 0, 0);
                y[1] = __builtin_amdgcn_mfma_f32_32x32x16_bf16(*(const bf16x8*)(sp + 32 * 64 + 16 * ks), bq, y[1], 0, 0, 0);
            }
        }
        f32x16 g[2]; g[0] = zero16(); g[1] = zero16();
        {
            const bf16* gp = P + (size_t)row * PW + PC_GD + 8 * hf; const bf16* gpp = prow >= 0 ? P + (size_t)prow * PW + PC_GD + 8 * hf : nullptr;
            const bf16* wp = WgT + (size_t)(h * 64 + r) * 128 + 8 * hf;
#pragma unroll
            for (int ks = 0; ks < 8; ++ks) {
                const v4u cg = *(const v4u*)(gp + 16 * ks); const v4u pg = gpp ? *(const v4u*)(gpp + 16 * ks) : (v4u){0u, 0u, 0u, 0u};
                const f32x4 m0 = *(const f32x4*)(mu + 1664 + 16 * ks + 8 * hf), m1 = *(const f32x4*)(mu + 1664 + 16 * ks + 8 * hf + 4);
                const unsigned cw[4] = {cg.x, cg.y, cg.z, cg.w}, pw[4] = {pg.x, pg.y, pg.z, pg.w}; const float mm[8] = {m0.x, m0.y, m0.z, m0.w, m1.x, m1.y, m1.z, m1.w};
                unsigned o[4];
#pragma unroll
                for (int e = 0; e < 4; ++e) {
                    const float c0 = bflo(cw[e]), c1 = bfhi(cw[e]), p0 = bflo(pw[e]), p1 = bfhi(pw[e]);
                    o[e] = pk2(sigmoidf_(c0 + (p0 - c0) * mm[2 * e]), sigmoidf_(c1 + (p1 - c1) * mm[2 * e + 1]));
                }
                const v4u ov = (v4u){o[0], o[1], o[2], o[3]};
                const bf16x8 bs = __builtin_bit_cast(bf16x8, ov);
                g[0] = __builtin_amdgcn_mfma_f32_32x32x16_bf16(*(const bf16x8*)(wp + 16 * ks), bs, g[0], 0, 0, 0);
                g[1] = __builtin_amdgcn_mfma_f32_32x32x16_bf16(*(const bf16x8*)(wp + 32 * 128 + 16 * ks), bs, g[1], 0, 0, 0);
            }
        }
        float s = 0.f;
#pragma unroll
        for (int j = 0; j < 16; ++j) s += y[0][j] + y[1][j];
        s += __shfl_xor(s, 32);
        const float mean = s * (1.f / 64.f);
        float s2 = 0.f;
#pragma unroll
        for (int j = 0; j < 16; ++j) { const float d0 = y[0][j] - mean, d1 = y[1][j] - mean; s2 += d0 * d0 + d1 * d1; }
        s2 += __shfl_xor(s2, 32);
        const float rstd = 1.0f / sqrtf(s2 * (1.f / 64.f) + GN_EPS);
        const float bon = BONUS[(size_t)u * 64 + t];
        if (valid) {
#pragma unroll
            for (int qv = 0; qv < 2; ++qv)
#pragma unroll
                for (int jj = 0; jj < 4; ++jj) {
                    const int v0 = 32 * qv + 8 * jj + 4 * hf, chv = h * 64 + v0;
                    const v2u cvw = *(const v2u*)(P + (size_t)row * PW + PC_V + chv); const v2u pvw = prow >= 0 ? *(const v2u*)(P + (size_t)prow * PW + PC_V + chv) : (v2u){0u, 0u};
                    const f32x4 mv = *(const f32x4*)(mu + 1024 + chv), gg = *(const f32x4*)(F.in[IN_GN_G] + chv), gb = *(const f32x4*)(F.in[IN_GN_B] + chv);
                    const float cv[4] = {bflo(cvw.x), bfhi(cvw.x), bflo(cvw.y), bfhi(cvw.y)}, pv[4] = {bflo(pvw.x), bfhi(pvw.x), bflo(pvw.y), bfhi(pvw.y)};
                    const float mvv[4] = {mv.x, mv.y, mv.z, mv.w}, ggv[4] = {gg.x, gg.y, gg.z, gg.w}, gbv[4] = {gb.x, gb.y, gb.z, gb.w};
                    float o[4];
#pragma unroll
                    for (int e = 0; e < 4; ++e) {
                        const float vs = cv[e] + (pv[e] - cv[e]) * mvv[e];
                        o[e] = ((y[qv][4 * jj + e] - mean) * rstd * ggv[e] + gbv[e] + bon * vs) * g[qv][4 * jj + e];
                    }
                    *(v2u*)(QA + (size_t)row * QAW + 1024 + chv) = (v2u){pk2(o[0], o[1]), pk2(o[2], o[3])};
                }
        }
    }
}
struct StoreBf16 { bf16* O; int ld; __device__ __forceinline__ void operator()(int row, int col, const f32x4& v) const { *(v2u*)(O + (size_t)row * ld + col) = (v2u){pk2(v.x, v.y), pk2(v.z, v.w)}; } };
struct StoreRes1 { const bf16* H; float* out; float* meta; __device__ __forceinline__ void operator()(int row, int col, const f32x4& v) const {
        if (row >= NROWS) return;
        const v2u hw = *(const v2u*)(H + (size_t)row * D + col);
        const f32x4 o = (f32x4){ALPHA * bflo(hw.x) + v.x, ALPHA * bfhi(hw.x) + v.y, ALPHA * bflo(hw.y) + v.z, ALPHA * bfhi(hw.y) + v.w};
        float* dst = row < NREAL ? out + (size_t)row * D + col : meta + (size_t)(row - NREAL) * D + col;
        *(f32x4*)dst = o; } };
struct StoreRes2 { const bf16* H; float* out; __device__ __forceinline__ void operator()(int row, int col, const f32x4& v) const {
        if (row >= NREAL) return;
        const v2u hw = *(const v2u*)(H + (size_t)row * D + col);
        *(f32x4*)(out + (size_t)row * D + col) = (f32x4){ALPHA * bflo(hw.x) + v.x, ALPHA * bfhi(hw.x) + v.y, ALPHA * bflo(hw.y) + v.z, ALPHA * bfhi(hw.y) + v.w}; } };

template <class Fn>
__device__ __forceinline__ void run_gemm(Frame& F, const bf16* A, int lda, const bf16* Bt, int N, int K, const Fn& fn) {
    pg8::Gemm g{A, Bt, R, N, K, lda}; pg8::StaticOrder S; S.init(R, N, F.G, (int)blockIdx.x);
    pg8::EpiFn<Fn> E{fn};
    pg8::gemm_phase<pg8::EpiFn<Fn>, pg8::StaticOrder, true, true>(F.lds + RING_OFF, g, S, E);
}

constexpr int NPHASES = 15;
struct Args { const float* in[32]; float* out; unsigned char* ws; int ph_lo, ph_hi; };
__global__ void __launch_bounds__(NTHR, 2) fwd(Args args) {
    extern __shared__ __attribute__((aligned(16))) unsigned char lds[];
    Frame F;
    F.lds = (LAS unsigned char*)lds;
    F.MISC = (volatile LAS unsigned*)(F.lds + MISC_OFF);
    F.tid = threadIdx.x; F.lane = F.tid & 63; F.wave = __builtin_amdgcn_readfirstlane(F.tid >> 6);
    F.G = gridDim.x;
#pragma unroll
    for (int i = 0; i < 32; ++i) F.in[i] = args.in[i];
    F.out = args.out; F.ws = args.ws;
    F.ctl = (gu32*)(args.ws + WS_CTL);
    for (int u = F.tid; u < (LDS_BYTES - LDSCTL_OFF) / 4; u += NTHR) ((LAS unsigned*)(F.lds + LDSCTL_OFF))[u] = 0u;
    __syncthreads();
    const int lo = args.ph_lo, hi = args.ph_hi;
    XcdBarrier bar; bar.bar = (unsigned*)(F.ctl + CW_BAR); bar.x = 0; bar.st = nullptr;
    if (hi - lo > 1) bar = xcd_barrier_post((unsigned*)(F.ctl + CW_BAR), F.MISC + 8);
#define IN(k) (lo <= (k) && (k) < hi)
#define SEAM(k) do { if (IN(k) && IN((k) + 1)) xcd_barrier(bar); } while (0)

#ifndef SKIP0
    if (IN(0)) { p0_weights(F); p1_ln_in(F); } SEAM(0);
#endif
#ifndef SKIP1
    if (IN(1)) { run_gemm(F, WSP(bf16, WS_H), D, WSP(bf16, WS_WT_IN), PW, D, StoreBf16{WSP(bf16, WS_P), PW}); } SEAM(1);
#endif
#ifndef SKIP2
    if (IN(2)) { p3_prep(F); } SEAM(2);
#endif
#ifndef SKIP3
    if (IN(3)) { run_gemm(F, WSP(bf16, WS_CQN), 256, WSP(bf16, WS_WT_QA), QAW, 256, StoreBf16{WSP(bf16, WS_QA), QAW});
#if REFSEL
        refsel_rows(F);
#endif
    } SEAM(3);
#endif
#ifndef SKIP4
    if (IN(4)) { p5_index_naive(F); } SEAM(4);
#endif
#ifndef SKIP5
    if (IN(5)) { p6_attn_naive(F); } SEAM(5);
#endif
#ifndef RWKV_NAIVE
#define RWKV_NAIVE 0
#endif
#if RWKV_NAIVE
    if (IN(6)) { p7_rwkv_prep_naive(F); } SEAM(6);
    if (IN(7)) { p8_rwkv_scan_naive(F); } SEAM(7);
    SEAM(8);
#else
    if (IN(6)) { rw_b1(F); } SEAM(6);
    if (IN(7)) { rw_b2(F); } SEAM(7);
    if (IN(8)) { rw_b3(F); } SEAM(8);
#endif
    if (IN(9)) { run_gemm(F, WSP(bf16, WS_QA), QAW, WSP(bf16, WS_WT_MIX), D, QAW, StoreRes1{WSP(bf16, WS_H), F.out, WSP(float, WS_META1)}); } SEAM(9);
    if (IN(10)) { p10_ln1(F); } SEAM(10);
    if (IN(11)) { run_gemm(F, WSP(bf16, WS_H), D, WSP(bf16, WS_WT_UP), UPW, D, StoreBf16{WSP(bf16, WS_UP), UPW}); } SEAM(11);
    if (IN(12)) { p12_conv_act(F); } SEAM(12);
    if (IN(13)) { run_gemm(F, WSP(bf16, WS_UP) + DFF, UPW, WSP(bf16, WS_WT_DN), D, DFF, StoreRes2{WSP(bf16, WS_H), F.out}); } SEAM(13);
    if (IN(14)) { p14_ln2(F); }
#undef IN
#undef SEAM
}

extern "C" void kernel_launch(void* const* d_in, const int* in_sizes, int n_in, void* d_out, int out_size, void* d_ws, size_t ws_size, hipStream_t stream) {
    static int grid = 0;
    if (grid == 0) {
        if (n_in != 32 || out_size != NREAL * D || ws_size < WS_END) { fprintf(stderr, "kernel_launch: unexpected shapes: n_in %d out %d ws %zu\n", n_in, out_size, ws_size); grid = -1; return; }
        int dev = 0, cus = 0, per_cu = 0;
        if (hipGetDevice(&dev) != hipSuccess || hipDeviceGetAttribute(&cus, hipDeviceAttributeMultiprocessorCount, dev) != hipSuccess) { grid = -1; return; }
        if (hipFuncSetAttribute((const void*)fwd, hipFuncAttributeMaxDynamicSharedMemorySize, LDS_BYTES) != hipSuccess) { fprintf(stderr, "kernel_launch: hipFuncSetAttribute failed\n"); grid = -1; return; }
        if (hipOccupancyMaxActiveBlocksPerMultiprocessor(&per_cu, (const void*)fwd, NTHR, LDS_BYTES) != hipSuccess || per_cu < 1) fprintf(stderr, "kernel_launch: occupancy query says %d\n", per_cu);
        (void)hipGetLastError();
        grid = cus;
    }
    if (grid < 0) return;
    (void)hipMemsetAsync((char*)d_ws + WS_CTL, 0, CTL_ZERO_BYTES, stream);
    Args a{};
    for (int i = 0; i < 32; ++i) a.in[i] = (const float*)d_in[i];
    a.out = (float*)d_out; a.ws = (unsigned char*)d_ws;
#if ONE_LAUNCH
    a.ph_lo = 0; a.ph_hi = NPHASES;
    hipLaunchKernelGGL(fwd, dim3(grid), dim3(NTHR), LDS_BYTES, stream, a);
#else
    for (int p = 0; p < NPHASES; ++p) { a.ph_lo = p; a.ph_hi = p + 1; hipLaunchKernelGGL(fwd, dim3(grid), dim3(NTHR), LDS_BYTES, stream, a); }
#endif
}
```

```cpp
#include <hip/hip_runtime.h>
#include <cstdio>
#include <cstdint>
#define ONE_LAUNCH 1
namespace pg8 {
#define PG8_LAS __attribute__((address_space(3)))
typedef unsigned short bf16_t;
typedef short bf16x8 __attribute__((ext_vector_type(8)));
typedef float f32x4 __attribute__((ext_vector_type(4)));
typedef unsigned u32x4 __attribute__((ext_vector_type(4)));
constexpr int BM = 256, BK = 64, HALF = 128, HTB = HALF * BK * 2  , STAGE_BYTES = 8 * HTB, NXCD = 8, WGM = 8;

__host__ __device__ __forceinline__ int lds_byte(int r, int c) { const int st = (r >> 4) * 2 + (c >> 5), rr = r & 15, cc = c & 31, ob = rr * 64 + cc * 2; return st * 1024 + (ob ^ (((ob >> 9) & 1) << 5)); }
__host__ __device__ __forceinline__ void stage_rc(int b, int& R, int& C) { const int st = b / 1024, sb = b % 1024, swz = sb ^ (((sb >> 9) & 1) << 5); R = (st >> 1) * 16 + swz / 64; C = (st & 1) * 32 + (swz % 64) / 2; }
__host__ __device__ __forceinline__ int perm32(int rho) { const int n = rho >> 4, i = rho & 15; return 8 * (i >> 2) + 4 * n + (i & 3); }

struct Unit { int pm, pn; };
struct Gemm { const bf16_t* A; const bf16_t* Bt; int M, N, K, lda; };

struct StaticOrder {
    int nM, nN, nwg, G, c;
    __host__ __device__ void init(int M, int N, int G_, int c_) { nM = M / BM; nN = N / BM; nwg = nM * nN; G = G_; c = c_; }
    __host__ __device__ bool next(int i, Unit& u) const {
        const long L = (long)i * G + c; if (L >= nwg) return false;
        int wgid = (int)L; { const int q = nwg / NXCD, r = nwg % NXCD, xcd = wgid % NXCD, off = wgid / NXCD; wgid = (xcd < r ? xcd * (q + 1) : r * (q + 1) + (xcd - r) * q) + off; }
        const int nig = WGM * nN, gid = wgid / nig, fm = gid * WGM, gsz = (nM - fm) < WGM ? (nM - fm) : WGM;
        u.pm = fm + ((wgid % nig) % gsz); u.pn = (wgid % nig) / gsz; return true;
    }
    __device__ __forceinline__ void a_ready(const Unit&) const {}
    __device__ __forceinline__ void done(const Unit&) const {}
};


template <class F> struct EpiFn {
    static constexpr bool PERM = false, AFTER_DRAIN = false;
    F f;
    __device__ __forceinline__ void operator()(const f32x4 (&acc)[2][2][4][2], const Unit& u, int wr, int wc, int fr, int fq) const {
        const int row0 = u.pm * BM + wr * 64 + fr, col0 = u.pn * BM + wc * 32 + 4 * fq;
#pragma unroll
        for (int ai = 0; ai < 2; ++ai)
#pragma unroll
            for (int m = 0; m < 4; ++m) {
                const int row = row0 + ai * HALF + m * 16;
#pragma unroll
                for (int bj = 0; bj < 2; ++bj)
#pragma unroll
                    for (int n = 0; n < 2; ++n) f(row, col0 + bj * HALF + n * 16, acc[ai][bj][m][n]);
            }
    }
};
template <class Epi, class Sched, bool ALIGN_EPI = false, bool SP2 = false>
__device__ __forceinline__ void gemm_phase(PG8_LAS unsigned char* lds, const Gemm g, const Sched& S, const Epi& E) {
    const int tid = threadIdx.x, wid = __builtin_amdgcn_readfirstlane(tid >> 6), lane = tid & 63, wr = wid >> 2, wc = wid & 3, fr = lane & 15, fq = lane >> 4;
    const int K = g.K, nt = K / BK;
    unsigned voffA[2], voffB[2];
#pragma unroll
    for (int i = 0; i < 2; ++i) { int R, C; stage_rc(tid * 16 + i * 8192, R, C); const int Rb = Epi::PERM ? ((R & ~31) + perm32(R & 31)) : R;
        voffA[i] = (unsigned)(R * g.lda + C) * 2u; voffB[i] = (unsigned)(Rb * K + C) * 2u; }
    const size_t kstep = (size_t)(BK * 2);
    const size_t hA = (size_t)HALF * g.lda * 2, hB = (size_t)HALF * K * 2;
    const size_t tA = 2 * hA, tB = 2 * hB;
    const unsigned ldsw = (unsigned)wid * 1024u;
    const int aoff = lds_byte(wr * 64 + fr, fq * 8), boff = lds_byte(wc * 32 + fr, fq * 8);
#define PG8_SA(b, h) (((b) * 2 + (h)) * HTB)
#define PG8_SB(b, h) ((4 + (b) * 2 + (h)) * HTB)
#define PG8_STAGE(bufoff, gbase, voff) do { _Pragma("unroll") for (int _i = 0; _i < 2; ++_i) \
        __builtin_amdgcn_global_load_lds((const unsigned*)((const char*)(gbase) + (voff)[_i]), (PG8_LAS unsigned*)(lds + (bufoff) + ldsw + _i * 8192), 16, 0, 0); } while (0)
#define PG8_LDA(dst, b, h) do { _Pragma("unroll") for (int m = 0; m < 4; ++m) _Pragma("unroll") for (int k = 0; k < 2; ++k) dst[m][k] = *(const PG8_LAS bf16x8*)(lds + PG8_SA(b, h) + aoff + m * 2048 + k * 1024); } while (0)
#define PG8_LDB(dst, b, h) do { _Pragma("unroll") for (int n = 0; n < 2; ++n) _Pragma("unroll") for (int k = 0; k < 2; ++k) dst[n][k] = *(const PG8_LAS bf16x8*)(lds + PG8_SB(b, h) + boff + n * 2048 + k * 1024); } while (0)
#define PG8_MMA(ai, bj, At, Bt) do { __builtin_amdgcn_s_setprio(1); _Pragma("unroll") for (int m = 0; m < 4; ++m) _Pragma("unroll") for (int n = 0; n < 2; ++n) _Pragma("unroll") for (int k = 0; k < 2; ++k) \
        acc[ai][bj][m][n] = __builtin_amdgcn_mfma_f32_16x16x32_bf16(Bt[n][k], At[m][k], acc[ai][bj][m][n], 0, 0, 0); __builtin_amdgcn_s_setprio(0); } while (0)
#define PG8_WAIT_V(n) asm volatile("s_waitcnt vmcnt(" #n ")" ::: "memory")
#define PG8_WAIT_L(n) asm volatile("s_waitcnt lgkmcnt(" #n ")" ::: "memory")
#define PG8_BAR __builtin_amdgcn_s_barrier()
#define PG8_SCHED __builtin_amdgcn_sched_barrier(0)
    Unit cur, nxt; int ui = 0;
    if (!S.next(0, cur)) return;
    f32x4 acc[2][2][4][2];
#pragma unroll
    for (int a = 0; a < 2; ++a)
#pragma unroll
        for (int b = 0; b < 2; ++b)
#pragma unroll
            for (int m = 0; m < 4; ++m)
#pragma unroll
                for (int n = 0; n < 2; ++n) acc[a][b][m][n] = (f32x4){0.f, 0.f, 0.f, 0.f};
    bf16x8 At[4][2], B0[2][2], B1[2][2];
    const char* cA = (const char*)g.A + (size_t)cur.pm * tA; const char* cB = (const char*)g.Bt + (size_t)cur.pn * tB;
    S.a_ready(cur);
    if constexpr (SP2) {
        PG8_STAGE(PG8_SB(0, 0), cB, voffB); PG8_STAGE(PG8_SB(0, 1), cB + hB, voffB); PG8_STAGE(PG8_SA(0, 0), cA, voffA); PG8_STAGE(PG8_SA(0, 1), cA + hA, voffA);
        if (wr == 1) PG8_BAR;
        PG8_WAIT_V(2); PG8_BAR;
        PG8_STAGE(PG8_SB(1, 0), cB + kstep, voffB); PG8_STAGE(PG8_SA(1, 0), cA + kstep, voffA); PG8_STAGE(PG8_SB(1, 1), cB + hB + kstep, voffB);
        PG8_WAIT_V(6); PG8_BAR;
    } else {
        PG8_STAGE(PG8_SB(0, 0), cB, voffB); PG8_STAGE(PG8_SA(0, 0), cA, voffA); PG8_STAGE(PG8_SB(0, 1), cB + hB, voffB); PG8_STAGE(PG8_SA(0, 1), cA + hA, voffA);
        if (wr == 1) PG8_BAR;
        PG8_WAIT_V(4); PG8_BAR;
        PG8_STAGE(PG8_SB(1, 0), cB + kstep, voffB); PG8_STAGE(PG8_SA(1, 0), cA + kstep, voffA); PG8_STAGE(PG8_SB(1, 1), cB + hB + kstep, voffB);
        PG8_WAIT_V(6); PG8_BAR;
    }
    for (;;) {
        const bool has_next = S.next(ui + 1, nxt);
        const char* nA = has_next ? (const char*)g.A + (size_t)nxt.pm * tA : cA; const char* nB = has_next ? (const char*)g.Bt + (size_t)nxt.pn * tB : cB;
        for (int t = 0; t < nt; t += 2) {
            const bool last = (t == nt - 2);
            const char* a1 = cA + (size_t)(t + 1) * kstep;
            const char* a2 = last ? nA : cA + (size_t)(t + 2) * kstep; const char* b2 = last ? nB : cB + (size_t)(t + 2) * kstep;
            const char* a3 = a2 + kstep; const char* b3 = b2 + kstep;
            if (last && has_next) S.a_ready(nxt);
            if constexpr (SP2) {
            PG8_LDB(B0, 0, 0); PG8_LDB(B1, 0, 1); PG8_SCHED; PG8_LDA(At, 0, 0); PG8_STAGE(PG8_SA(1, 1), a1 + hA, voffA);
            PG8_WAIT_V(8); PG8_WAIT_L(0); PG8_BAR; PG8_MMA(0, 0, At, B0); PG8_MMA(0, 1, At, B1); PG8_BAR; PG8_SCHED;
            PG8_LDA(At, 0, 1); PG8_STAGE(PG8_SB(0, 0), b2, voffB); PG8_STAGE(PG8_SB(0, 1), b2 + hB, voffB); PG8_STAGE(PG8_SA(0, 0), a2, voffA);
            PG8_WAIT_V(8); PG8_WAIT_L(0); PG8_BAR; PG8_MMA(1, 0, At, B0); PG8_MMA(1, 1, At, B1); PG8_BAR; PG8_SCHED;
            PG8_LDB(B0, 1, 0); PG8_LDB(B1, 1, 1); PG8_SCHED; PG8_LDA(At, 1, 0); PG8_STAGE(PG8_SA(0, 1), a2 + hA, voffA);
            PG8_WAIT_V(8); PG8_WAIT_L(0); PG8_BAR; PG8_MMA(0, 0, At, B0); PG8_MMA(0, 1, At, B1); PG8_BAR; PG8_SCHED;
            PG8_LDA(At, 1, 1); PG8_STAGE(PG8_SB(1, 0), b3, voffB); PG8_STAGE(PG8_SB(1, 1), b3 + hB, voffB); PG8_STAGE(PG8_SA(1, 0), a3, voffA);
            PG8_WAIT_V(8); PG8_WAIT_L(0); PG8_BAR; PG8_MMA(1, 0, At, B0); PG8_MMA(1, 1, At, B1); PG8_BAR; PG8_SCHED;
            } else {
            PG8_LDB(B0, 0, 0); PG8_SCHED; PG8_LDA(At, 0, 0); PG8_STAGE(PG8_SA(1, 1), a1 + hA, voffA);
            PG8_WAIT_L(8); PG8_BAR; PG8_WAIT_L(0); PG8_MMA(0, 0, At, B0); PG8_BAR; PG8_SCHED;
            PG8_LDB(B1, 0, 1); PG8_STAGE(PG8_SB(0, 0), b2, voffB);
            PG8_BAR; PG8_WAIT_L(0); PG8_MMA(0, 1, At, B1); PG8_BAR;
            PG8_LDA(At, 0, 1); PG8_STAGE(PG8_SA(0, 0), a2, voffA);
            PG8_BAR; PG8_WAIT_L(0); PG8_MMA(1, 0, At, B0); PG8_BAR; PG8_SCHED;
            PG8_STAGE(PG8_SB(0, 1), b2 + hB, voffB);
            PG8_WAIT_V(6); PG8_BAR; PG8_MMA(1, 1, At, B1); PG8_BAR;
            PG8_LDB(B0, 1, 0); PG8_SCHED; PG8_LDA(At, 1, 0); PG8_STAGE(PG8_SA(0, 1), a2 + hA, voffA);
            PG8_WAIT_L(8); PG8_BAR; PG8_WAIT_L(0); PG8_MMA(0, 0, At, B0); PG8_BAR; PG8_SCHED;
            PG8_LDB(B1, 1, 1); PG8_STAGE(PG8_SB(1, 0), b3, voffB);
            PG8_BAR; PG8_WAIT_L(0); PG8_MMA(0, 1, At, B1); PG8_BAR;
            PG8_LDA(At, 1, 1); PG8_STAGE(PG8_SA(1, 0), a3, voffA);
            PG8_BAR; PG8_WAIT_L(0); PG8_MMA(1, 0, At, B0); PG8_BAR; PG8_SCHED;
            PG8_STAGE(PG8_SB(1, 1), b3 + hB, voffB);
            PG8_WAIT_V(6); PG8_BAR; PG8_MMA(1, 1, At, B1); PG8_BAR;
            }
        }
        if constexpr (ALIGN_EPI) { if (wr == 0) PG8_BAR; }
        if constexpr (!Epi::AFTER_DRAIN) { E(acc, cur, wr, wc, fr, fq); S.done(cur); }
        if (!has_next) break;
#pragma unroll
        for (int a = 0; a < 2; ++a)
#pragma unroll
            for (int b = 0; b < 2; ++b)
#pragma unroll
                for (int m = 0; m < 4; ++m)
#pragma unroll
                    for (int n = 0; n < 2; ++n) acc[a][b][m][n] = (f32x4){0.f, 0.f, 0.f, 0.f};
        cur = nxt; cA = nA; cB = nB; ++ui;
        if constexpr (ALIGN_EPI) { if (wr == 1) PG8_BAR; }
    }
    PG8_WAIT_V(0);
    if constexpr (!ALIGN_EPI) { if (wr == 0) PG8_BAR; }
    PG8_BAR;
    if constexpr (Epi::AFTER_DRAIN) { E.fused(acc, cur, wr, wc, fr, fq, lds, wid, lane); S.done(cur); }
#undef PG8_SA
#undef PG8_SB
#undef PG8_STAGE
#undef PG8_LDA
#undef PG8_LDB
#undef PG8_MMA
#undef PG8_WAIT_V
#undef PG8_WAIT_L
#undef PG8_BAR
#undef PG8_SCHED
}
}

#ifndef ONE_LAUNCH
#define ONE_LAUNCH 0
#endif
constexpr int NWAVES = 8, NTHR = 512;
constexpr int D = 1024, BATCH = 4, SEQ = 8192, NMETA = 16, TT = SEQ + NMETA;
constexpr int NREAL = BATCH * SEQ;
constexpr int NROWS = NREAL + NMETA;
constexpr int R = 33024;
constexpr int PW = 2304;
constexpr int PC_CQ = 0, PC_CKV = 256, PC_KIDX = 384, PC_WIDX = 448, PC_R = 512, PC_K = 1024, PC_V = 1536, PC_WD = 2048, PC_AD = 2112, PC_GD = 2176;
constexpr int QAW = 1536;
constexpr int DFF = 2816, UPW = 5632;
constexpr int TOPK = 256;
constexpr float LN_EPS = 1e-5f, GN_EPS = 64e-5f, ALPHA = 1.18920711500272f;

constexpr size_t MiB = 1u << 20;
constexpr size_t WS_CTL = 0, CTL_ZERO_BYTES = 1 * MiB;
constexpr size_t WS_WT_IN = 1 * MiB, WS_WT_QA = 6 * MiB, WS_WT_MIX = 7 * MiB, WS_WT_UP = 10 * MiB, WS_WT_DN = 21 * MiB;
constexpr size_t WS_META1 = 27 * MiB, WS_NSEL = 28 * MiB, WS_WIDX = 29 * MiB;
constexpr size_t WS_H = 33 * MiB;
constexpr size_t WS_P = 98 * MiB, WS_QA = 244 * MiB, WS_CQN = 341 * MiB, WS_SEL = 341 * MiB, WS_CKV = 358 * MiB, WS_KIDX = 367 * MiB;
constexpr size_t WS_DEC = 372 * MiB, WS_AB = 437 * MiB, WS_GB = 470 * MiB;
constexpr size_t WS_WT_LORA = 26 * MiB + 512 * 1024;
constexpr size_t WS_RWM = 372 * MiB, WS_RWN = 405 * MiB, WS_RWQ = 438 * MiB, WS_RWY = 471 * MiB;
constexpr size_t OUT_RWS = 80 * MiB, OUT_BONUS = 116 * MiB;
constexpr size_t WS_UP = 98 * MiB;
constexpr size_t WS_END = 512 * MiB;
static_assert(WS_P + (size_t)R * PW * 2 <= WS_QA && WS_QA + (size_t)R * QAW * 2 <= WS_CQN && WS_CQN + (size_t)R * 256 * 2 <= WS_CKV && WS_CKV + (size_t)R * 128 * 2 <= WS_KIDX
              && WS_KIDX + (size_t)R * 64 * 2 <= WS_DEC && WS_DEC + (size_t)R * 512 * 4 <= WS_AB && WS_AB + (size_t)R * 512 * 2 <= WS_GB && WS_GB + (size_t)R * 512 * 2 <= WS_END
              && WS_UP + (size_t)R * UPW * 2 <= WS_END && WS_H + (size_t)R * D * 2 <= WS_P && WS_WIDX + (size_t)R * 8 * 4 <= WS_H && WS_NSEL + (size_t)R * 4 <= WS_WIDX, "ws map");
constexpr int CW_BAR = 4096;

constexpr int RING_OFF = 0, RING_BYTES = 131072;
constexpr int LDSCTL_OFF = RING_BYTES, MISC_OFF = LDSCTL_OFF + 320;
constexpr int LDS_BYTES = 147456;

#define GAS __attribute__((address_space(1)))
#define LAS __attribute__((address_space(3)))
typedef unsigned short bf16;
typedef unsigned v4u __attribute__((ext_vector_type(4)));
typedef unsigned v2u __attribute__((ext_vector_type(2)));
typedef float f32x4 __attribute__((ext_vector_type(4)));
typedef GAS unsigned gu32;
__device__ __forceinline__ unsigned f2bf(float f) { unsigned u = __builtin_bit_cast(unsigned, f); return (u + 0x7fffu + ((u >> 16) & 1u)) >> 16; }
__device__ __forceinline__ unsigned pk2(float lo, float hi) { return f2bf(lo) | (f2bf(hi) << 16); }
__device__ __forceinline__ float bf2f(unsigned short b) { return __uint_as_float(((unsigned)b) << 16); }
__device__ __forceinline__ float bflo(unsigned w) { return __uint_as_float(w << 16); }
__device__ __forceinline__ float bfhi(unsigned w) { return __uint_as_float(w & 0xffff0000u); }
__device__ __forceinline__ float wave_sum(float v) {
#pragma unroll
    for (int o = 1; o < 64; o <<= 1) v += __shfl_xor(v, o);
    return v;
}
__device__ __forceinline__ float wave_max(float v) {
#pragma unroll
    for (int o = 1; o < 64; o <<= 1) v = fmaxf(v, __shfl_xor(v, o));
    return v;
}
__device__ __forceinline__ float sigmoidf_(float x) { return 1.0f / (1.0f + __expf(-x)); }
#define XB_TMO      128
#define XB_XCNT(j)  (256  + 64 * (j))
#define XB_XSUB(j)  (1280 + 64 * (j))
#define XB_XGEN(j)  (2304 + 64 * (j))
#define XB_TOP      3328
#define XB_TOPGEN   3392
#define XCD_BAR_WORDS 3456
#define XB_SPIN_CAP (1u << 18)

__device__ __forceinline__ unsigned xb_ld(unsigned* p)              { return __hip_atomic_load(p, __ATOMIC_RELAXED, __HIP_MEMORY_SCOPE_AGENT); }
__device__ __forceinline__ unsigned xb_add(unsigned* p, unsigned v) { return __hip_atomic_fetch_add(p, v, __ATOMIC_RELAXED, __HIP_MEMORY_SCOPE_AGENT); }
__device__ __forceinline__ unsigned xb_xcc_id() { return (unsigned)__builtin_amdgcn_s_getreg((3 << 11) | 20) & 0xFu; }
#define XB_SPIN(cond, bar) do { unsigned _sp = 0; while (cond) { __builtin_amdgcn_s_sleep(1); \
    if ((++_sp & 255u) == 0u) { if (xb_ld(&(bar)[XB_TMO])) break; if (_sp > XB_SPIN_CAP) { atomicAdd(&(bar)[XB_TMO], 1u); break; } } } } while (0)

struct XcdBarrier {
    unsigned* bar; unsigned x;
    volatile LAS unsigned* st;
};

__device__ __forceinline__ XcdBarrier xcd_barrier_post(unsigned* bar, volatile LAS unsigned* st) {
    XcdBarrier b; b.bar = bar; b.x = xb_xcc_id(); b.st = st;
    if (threadIdx.x == 0) (void)xb_add(&bar[XB_XCNT(b.x)], 1u);
    return b;
}
__device__ __forceinline__ void xcd_barrier_complete(unsigned* bar, unsigned x, unsigned& nloc, unsigned& nx) {
    const unsigned G = gridDim.x * gridDim.y * gridDim.z;
    unsigned sum, cnt, mine, sp = 0u;
    for (;;) {
        sum = 0u; cnt = 0u; mine = 0u;
#pragma unroll
        for (unsigned j = 0; j < 16; ++j) { const unsigned c = xb_ld(&bar[XB_XCNT(j)]); sum += c; cnt += (c > 0u) ? 1u : 0u; mine = (j == x) ? c : mine; }
        if (sum == G) break;
        __builtin_amdgcn_s_sleep(1);
        if ((++sp & 255u) == 0u) { if (xb_ld(&bar[XB_TMO])) break; if (sp > XB_SPIN_CAP) { atomicAdd(&bar[XB_TMO], 1u); break; } }
    }
    nloc = mine > 0u ? mine : 1u; nx = cnt > 0u ? cnt : 1u;
}

__device__ __forceinline__ void xcd_barrier(const XcdBarrier& b) {
    asm volatile("s_waitcnt vmcnt(0)" ::: "memory");
    __syncthreads();
    if (threadIdx.x == 0) {
        unsigned* bar = b.bar;
        __builtin_amdgcn_s_waitcnt(0);
        unsigned nloc = b.st[0], nx = b.st[1];
        if (nloc == 0u) { xcd_barrier_complete(bar, b.x, nloc, nx); b.st[0] = nloc; b.st[1] = nx; }
        const unsigned old = xb_add(&bar[XB_XSUB(b.x)], 1u);
        const unsigned gen = old / nloc;
        if (old + 1u == (gen + 1u) * nloc) {
            __builtin_amdgcn_fence(__ATOMIC_RELEASE, "agent");
            asm volatile("s_waitcnt vmcnt(0)" ::: "memory");
            const unsigned og = xb_add(&bar[XB_TOP], 1u);
            const unsigned tg = og / nx;
            if (og + 1u == (tg + 1u) * nx) xb_add(&bar[XB_TOPGEN], 1u);
            else XB_SPIN(xb_ld(&bar[XB_TOPGEN]) == tg, bar);
            __builtin_amdgcn_fence(__ATOMIC_ACQUIRE, "agent");
            xb_add(&bar[XB_XGEN(b.x)], 1u);
            asm volatile("s_waitcnt vmcnt(0)" ::: "memory");
        } else {
            XB_SPIN(xb_ld(&bar[XB_XGEN(b.x)]) == gen, bar);
            __builtin_amdgcn_fence(__ATOMIC_ACQUIRE, "agent");
            asm volatile("s_waitcnt vmcnt(0)" ::: "memory");
        }
    }
    __syncthreads();
}

struct Frame {
    LAS unsigned char* lds;
    volatile LAS unsigned* MISC;
    gu32* ctl;
    int tid, lane, wave, G;
    const float* in[32];
    float* out;
    unsigned char* ws;
};
#define IN_X 0
#define IN_META 1
#define IN_LNIN_G 2
#define IN_LNIN_B 3
#define IN_W_IN 4
#define IN_QNORM_G 5
#define IN_W_UQ 6
#define IN_KVNORM_G 7
#define IN_W_UKV 8
#define IN_W_IQ 9
#define IN_IDXLN_G 10
#define IN_IDXLN_B 11
#define IN_MU 12
#define IN_W0 13
#define IN_W_DEC 14
#define IN_A0 15
#define IN_W_AAA 16
#define IN_W_GATE 17
#define IN_KK 18
#define IN_KA 19
#define IN_RK 20
#define IN_GN_G 21
#define IN_GN_B 22
#define IN_W_OUT 23
#define IN_LN1_G 24
#define IN_LN1_B 25
#define IN_W_UP 26
#define IN_CONV_W 27
#define IN_CONV_B 28
#define IN_W_DN 29
#define IN_LN2_G 30
#define IN_LN2_B 31

#define WSP(T, off) ((T*)(F.ws + (off)))

__device__ __forceinline__ int key_row(int b, int j) { return j < NMETA ? NREAL + j : b * SEQ + (j - NMETA); }

__device__ __forceinline__ void tr_items(Frame& F, const float* src, int src_ld, int src_r0, bf16* dst, int dst_ld, int dst_c0, int Nn, int K, int cut0, int cut1, int shift) {
    const int total = Nn * (K / 8);
    for (int it = blockIdx.x * NTHR + F.tid; it < total; it += F.G * NTHR) {
        const int n = it % Nn, kc = it / Nn;
        const int col = n < cut0 ? n : (n < cut1 ? -1 : n - shift);
        float v[8];
#pragma unroll
        for (int e = 0; e < 8; ++e) v[e] = col >= 0 ? src[(size_t)(src_r0 + 8 * kc + e) * src_ld + col] : 0.f;
        v4u o; o.x = pk2(v[0], v[1]); o.y = pk2(v[2], v[3]); o.z = pk2(v[4], v[5]); o.w = pk2(v[6], v[7]);
        *(v4u*)(dst + (size_t)n * dst_ld + dst_c0 + 8 * kc) = o;
    }
}
__device__ __forceinline__ void p0_weights(Frame& F) {
    bf16* WT_IN = WSP(bf16, WS_WT_IN); bf16* WT_QA = WSP(bf16, WS_WT_QA); bf16* WT_MIX = WSP(bf16, WS_WT_MIX); bf16* WT_UP = WSP(bf16, WS_WT_UP); bf16* WT_DN = WSP(bf16, WS_WT_DN);
    tr_items(F, F.in[IN_W_IN], 2248, 0, WT_IN, D, 0, PW, D, 456, 512, 56);
    tr_items(F, F.in[IN_W_UP], UPW, 0, WT_UP, D, 0, UPW, D, UPW, UPW, 0);
    tr_items(F, F.in[IN_W_DN], D, 0, WT_DN, DFF, 0, D, DFF, D, D, 0);
    tr_items(F, F.in[IN_W_IQ], 512, 0, WT_QA + (size_t)1024 * 256, 256, 0, 512, 256, 512, 512, 0);
    tr_items(F, F.in[IN_W_OUT], D, 512, WT_MIX, 1536, 1024, D, 512, D, D, 0);
    {
        bf16* WdT = WSP(bf16, WS_WT_LORA);
        tr_items(F, F.in[IN_W_DEC], 512, 0, WdT, 64, 0, 512, 64, 512, 512, 0);
        tr_items(F, F.in[IN_W_AAA], 512, 0, WdT + 512 * 64, 64, 0, 512, 64, 512, 512, 0);
        tr_items(F, F.in[IN_W_GATE], 512, 0, WdT + 2 * 512 * 64, 128, 0, 512, 128, 512, 512, 0);
    }
    const float* w_uq = F.in[IN_W_UQ]; const float* w_ukv = F.in[IN_W_UKV]; const float* w_out = F.in[IN_W_OUT];
    for (int it = blockIdx.x * NTHR + F.tid; it < 1024 * 256; it += F.G * NTHR) {
        const int c = it & 255, n = it >> 8, h = n >> 7, j = n & 127;
        float s = 0.f;
        for (int d = 0; d < 64; ++d) s += w_uq[(size_t)c * 512 + h * 64 + d] * w_ukv[(size_t)j * 1024 + h * 128 + d];
        WT_QA[(size_t)n * 256 + c] = (bf16)f2bf(0.125f * s);
    }
    for (int it = blockIdx.x * NTHR + F.tid; it < 1024 * 1024; it += F.G * NTHR) {
        const int n = it & 1023, k = it >> 10, h = k >> 7, j = k & 127;
        float s = 0.f;
        for (int d = 0; d < 64; ++d) s += w_ukv[(size_t)j * 1024 + h * 128 + 64 + d] * w_out[(size_t)(h * 64 + d) * D + n];
        WT_MIX[(size_t)n * 1536 + k] = (bf16)f2bf(s);
    }
}

__device__ __forceinline__ void ln_row_bf16(Frame& F, const float* src, const float* g, const float* b, bf16* dst) {
    v2u* o8 = (v2u*)dst + F.lane;
    if (!src) {
#pragma unroll
        for (int j = 0; j < 4; ++j) o8[64 * j] = (v2u){0u, 0u};
        return;
    }
    const f32x4* xr = (const f32x4*)src + F.lane;
    f32x4 v[4]; float s = 0.f;
#pragma unroll
    for (int j = 0; j < 4; ++j) { v[j] = xr[64 * j]; s += (v[j].x + v[j].y) + (v[j].z + v[j].w); }
    const float mean = wave_sum(s) * (1.f / D); float s2 = 0.f;
#pragma unroll
    for (int j = 0; j < 4; ++j) { v[j] = v[j] - mean; s2 += (v[j].x * v[j].x + v[j].y * v[j].y) + (v[j].z * v[j].z + v[j].w * v[j].w); }
    const float rstd = 1.f / sqrtf(wave_sum(s2) * (1.f / D) + LN_EPS);
#pragma unroll
    for (int j = 0; j < 4; ++j) {
        const f32x4 gg = ((const f32x4*)g)[F.lane + 64 * j], bb = ((const f32x4*)b)[F.lane + 64 * j];
        const f32x4 y = v[j] * rstd * gg + bb;
        o8[64 * j] = (v2u){pk2(y.x, y.y), pk2(y.z, y.w)};
    }
}
__device__ __forceinline__ void p1_ln_in(Frame& F) {
    bf16* H0 = WSP(bf16, WS_H);
    const int gw = blockIdx.x * NWAVES + F.wave, NGW = F.G * NWAVES;
    for (int r = gw; r < R; r += NGW) {
        const float* src = r < NREAL ? F.in[IN_X] + (size_t)r * D : (r < NROWS ? F.in[IN_META] + (size_t)(r - NREAL) * D : nullptr);
        ln_row_bf16(F, src, F.in[IN_LNIN_G], F.in[IN_LNIN_B], H0 + (size_t)r * D);
    }
}

__device__ __forceinline__ void p3_prep(Frame& F) {
    const bf16* P = WSP(bf16, WS_P); bf16* CQN = WSP(bf16, WS_CQN); bf16* CKV = WSP(bf16, WS_CKV); bf16* KIDX = WSP(bf16, WS_KIDX); float* WIDX = WSP(float, WS_WIDX);
    const int gw = blockIdx.x * NWAVES + F.wave, NGW = F.G * NWAVES, l = F.lane;
    for (int r = gw; r < R; r += NGW) {
        const bf16* pr = P + (size_t)r * PW;
        if (r >= NROWS) {
            *(v2u*)(CQN + (size_t)r * 256 + 4 * l) = (v2u){0u, 0u};
            continue;
        }
        {
            const v2u w = *(const v2u*)(pr + PC_CQ + 4 * l);
            const float a0 = bflo(w.x), a1 = bfhi(w.x), a2 = bflo(w.y), a3 = bfhi(w.y);
            const float ss = wave_sum(a0 * a0 + a1 * a1 + a2 * a2 + a3 * a3);
            const float rs = 1.0f / sqrtf(ss * (1.f / 256.f) + 1e-6f);
            const f32x4 g = ((const f32x4*)F.in[IN_QNORM_G])[l];
            *(v2u*)(CQN + (size_t)r * 256 + 4 * l) = (v2u){pk2(a0 * rs * g.x, a1 * rs * g.y), pk2(a2 * rs * g.z, a3 * rs * g.w)};
        }
        {
            const unsigned w = *(const unsigned*)(pr + PC_CKV + 2 * l);
            const float a0 = bflo(w), a1 = bfhi(w);
            const float ss = wave_sum(a0 * a0 + a1 * a1);
            const float rs = 1.0f / sqrtf(ss * (1.f / 128.f) + 1e-6f);
            const float g0 = F.in[IN_KVNORM_G][2 * l], g1 = F.in[IN_KVNORM_G][2 * l + 1];
            *(unsigned*)(CKV + (size_t)r * 128 + 2 * l) = pk2(a0 * rs * g0, a1 * rs * g1);
        }
        {
            const float a = bf2f(pr[PC_KIDX + l]);
            const float mean = wave_sum(a) * (1.f / 64.f);
            const float dlt = a - mean;
            const float var = wave_sum(dlt * dlt) * (1.f / 64.f);
            const float y = dlt * (1.0f / sqrtf(var + LN_EPS)) * F.in[IN_IDXLN_G][l] + F.in[IN_IDXLN_B][l];
            KIDX[(size_t)r * 64 + l] = (bf16)f2bf(y);
        }
        if (l < 8) WIDX[(size_t)r * 8 + l] = bf2f(pr[PC_WIDX + l]) * 0.04419417382415922f;
    }
}

#ifndef REFSEL
#define REFSEL 0
#endif
__device__ __forceinline__ void refsel_rows(Frame& F) {
    float* QIDX32 = F.out; float* KIDX32 = F.out + (size_t)R * 512; float* WIDX = WSP(float, WS_WIDX);
    const float* w_in = F.in[IN_W_IN]; const float* w_iq = F.in[IN_W_IQ];
    LAS float* hrow = (LAS float*)(F.lds + F.wave * 8192);
    LAS float* cqn = hrow + 1024;
    const int l = F.lane;
    const int gw = blockIdx.x * NWAVES + F.wave, NGW = F.G * NWAVES;
    for (int r = gw; r < NROWS; r += NGW) {
        const float* src = r < NREAL ? F.in[IN_X] + (size_t)r * D : F.in[IN_META] + (size_t)(r - NREAL) * D;
        {
            const f32x4* xr = (const f32x4*)src + l;
            f32x4 v[4]; float s = 0.f;
#pragma unroll
            for (int j = 0; j < 4; ++j) { v[j] = xr[64 * j]; s += (v[j].x + v[j].y) + (v[j].z + v[j].w); }
            const float mean = wave_sum(s) * (1.f / D); float s2 = 0.f;
#pragma unroll
            for (int j = 0; j < 4; ++j) { v[j] = v[j] - mean; s2 += (v[j].x * v[j].x + v[j].y * v[j].y) + (v[j].z * v[j].z + v[j].w * v[j].w); }
            const float rstd = 1.f / sqrtf(wave_sum(s2) * (1.f / D) + LN_EPS);
#pragma unroll
            for (int j = 0; j < 4; ++j) {
                const f32x4 gg = ((const f32x4*)F.in[IN_LNIN_G])[l + 64 * j], bb = ((const f32x4*)F.in[IN_LNIN_B])[l + 64 * j];
                *(LAS f32x4*)(hrow + 4 * (l + 64 * j)) = v[j] * rstd * gg + bb;
            }
        }
        __builtin_amdgcn_wave_barrier();
        float a[6];
#pragma unroll
        for (int i = 0; i < 6; ++i) a[i] = 0.f;
        for (int k = 0; k < D; ++k) {
            const float hk = hrow[k]; const float* wr = w_in + (size_t)k * 2248;
#pragma unroll
            for (int i = 0; i < 4; ++i) a[i] += hk * wr[l + 64 * i];
            a[4] += hk * wr[384 + l];
            a[5] += hk * wr[448 + (l & 7)];
        }
        const float ss = wave_sum(a[0] * a[0] + a[1] * a[1] + a[2] * a[2] + a[3] * a[3]);
        const float rs = 1.0f / sqrtf(ss * (1.f / 256.f) + 1e-6f);
#pragma unroll
        for (int i = 0; i < 4; ++i) cqn[l + 64 * i] = a[i] * rs * F.in[IN_QNORM_G][l + 64 * i];
        {
            const float mean = wave_sum(a[4]) * (1.f / 64.f); const float dlt = a[4] - mean;
            const float var = wave_sum(dlt * dlt) * (1.f / 64.f);
            KIDX32[(size_t)r * 64 + l] = dlt * (1.0f / sqrtf(var + LN_EPS)) * F.in[IN_IDXLN_G][l] + F.in[IN_IDXLN_B][l];
        }
        if (l < 8) WIDX[(size_t)r * 8 + l] = a[5] * 0.04419417382415922f;
        __builtin_amdgcn_wave_barrier();
        float q[8];
#pragma unroll
        for (int i = 0; i < 8; ++i) q[i] = 0.f;
        for (int c = 0; c < 256; ++c) {
            const float cq = cqn[c]; const float* wr = w_iq + (size_t)c * 512;
#pragma unroll
            for (int i = 0; i < 8; ++i) q[i] += cq * wr[l + 64 * i];
        }
#pragma unroll
        for (int i = 0; i < 8; ++i) QIDX32[(size_t)r * 512 + l + 64 * i] = q[i];
        __builtin_amdgcn_wave_barrier();
    }
}

__device__ __forceinline__ unsigned sortable(float f) { const unsigned u = __float_as_uint(f); return (u & 0x80000000u) ? ~u : (u | 0x80000000u); }
__device__ __forceinline__ void p5_index_naive(Frame& F) {
    const bf16* QA = WSP(bf16, WS_QA); const bf16* KIDX = WSP(bf16, WS_KIDX); const float* WIDX = WSP(float, WS_WIDX);
    unsigned short* SEL = WSP(unsigned short, WS_SEL); int* NSEL = WSP(int, WS_NSEL);
    LAS float* sc = (LAS float*)(F.lds);
    LAS float* qf = (LAS float*)(F.lds + 33024);
    LAS unsigned* hist = (LAS unsigned*)(F.lds + 33024 + 2048);
    LAS unsigned* cw = hist + 256;
    const int tid = F.tid;
    for (int q = blockIdx.x; q < NROWS; q += F.G) {
        int b, pos; if (q < NREAL) { b = q >> 13; pos = NMETA + (q & (SEQ - 1)); } else { b = 0; pos = q - NREAL; }
        const int nvis = pos < NMETA ? NMETA : NMETA + 64 * ((pos - NMETA) / 64 + 1);
#if REFSEL
        qf[tid] = F.out[(size_t)q * 512 + tid];
#else
        qf[tid] = bf2f(QA[(size_t)q * QAW + 1024 + tid]);
#endif
        float w[8];
#pragma unroll
        for (int h = 0; h < 8; ++h) w[h] = WIDX[(size_t)q * 8 + h];
        __syncthreads();
        for (int j = tid; j < nvis; j += NTHR) {
            const v4u* kp = (const v4u*)(KIDX + (size_t)key_row(b, j) * 64);
#if REFSEL
            const f32x4* kp32 = (const f32x4*)(F.out + (size_t)R * 512 + (size_t)key_row(b, j) * 64);
#endif
            float d[8];
#pragma unroll
            for (int h = 0; h < 8; ++h) d[h] = 0.f;
#pragma unroll 2
            for (int c = 0; c < 8; ++c) {
#if REFSEL
                const f32x4 ta = kp32[2 * c], tb = kp32[2 * c + 1];
                const float k0 = ta.x, k1 = ta.y, k2 = ta.z, k3 = ta.w, k4 = tb.x, k5 = tb.y, k6 = tb.z, k7 = tb.w;
#else
                const v4u t = kp[c];
                const float k0 = bflo(t.x), k1 = bfhi(t.x), k2 = bflo(t.y), k3 = bfhi(t.y), k4 = bflo(t.z), k5 = bfhi(t.z), k6 = bflo(t.w), k7 = bfhi(t.w);
#endif
#pragma unroll
                for (int h = 0; h < 8; ++h) {
                    const f32x4 qa = *(const LAS f32x4*)(qf + h * 64 + 8 * c), qb = *(const LAS f32x4*)(qf + h * 64 + 8 * c + 4);
                    d[h] += qa.x * k0 + qa.y * k1 + qa.z * k2 + qa.w * k3 + qb.x * k4 + qb.y * k5 + qb.z * k6 + qb.w * k7;
                }
            }
            float s = 0.f;
#pragma unroll
            for (int h = 0; h < 8; ++h) s += w[h] * fmaxf(d[h], 0.f);
            sc[j] = s + 0.0f;
        }
        __syncthreads();
        unsigned short* selq = SEL + (size_t)q * TOPK;
        if (nvis <= TOPK) {
            for (int j = tid; j < nvis; j += NTHR) selq[j] = (unsigned short)j;
        } else {
            unsigned prefix = 0u, mask = 0u, need = TOPK;
            for (int pass = 0; pass < 4; ++pass) {
                const int shift = 24 - 8 * pass;
                if (tid < 256) hist[tid] = 0u;
                __syncthreads();
                for (int j = tid; j < nvis; j += NTHR) { const unsigned key = sortable(sc[j]); if ((key & mask) == prefix) atomicAdd((unsigned*)&hist[(key >> shift) & 255u], 1u); }
                __syncthreads();
                if (tid < 256) {
                    unsigned above = 0u; for (int bb = tid + 1; bb < 256; ++bb) above += hist[bb];
                    const unsigned c = hist[tid];
                    if (above < need && need <= above + c) { cw[0] = prefix | ((unsigned)tid << shift); cw[1] = need - above; }
                }
                __syncthreads();
                prefix = cw[0]; need = cw[1]; mask |= 0xFFu << shift;
                __syncthreads();
            }
            if (tid == 0) cw[2] = 0u;
            __syncthreads();
            for (int j = tid; j < nvis; j += NTHR) { if (sortable(sc[j]) > prefix) { const unsigned p = atomicAdd((unsigned*)&cw[2], 1u); selq[p] = (unsigned short)j; } }
            __syncthreads();
            if (F.wave == 0) {
                const unsigned base = cw[2]; unsigned taken = 0u;
                for (int j0 = 0; j0 < nvis && taken < need; j0 += 64) {
                    const int j = j0 + F.lane; const bool eq = j < nvis && sortable(sc[j]) == prefix;
                    const unsigned long long m = __ballot(eq);
                    const unsigned rank = (unsigned)__popcll(m & ((1ull << F.lane) - 1ull));
                    if (eq && taken + rank < need) selq[base + taken + rank] = (unsigned short)j;
                    taken += (unsigned)__popcll(m);
                }
            }
        }
        if (tid == 0) NSEL[q] = nvis < TOPK ? nvis : TOPK;
        __syncthreads();
    }
}

__device__ __forceinline__ void p6_attn_naive(Frame& F) {
    bf16* QA = WSP(bf16, WS_QA); const bf16* CKV = WSP(bf16, WS_CKV); const unsigned short* SEL = WSP(unsigned short, WS_SEL); const int* NSEL = WSP(int, WS_NSEL);
    LAS float* qf = (LAS float*)(F.lds + F.wave * 16384);
    LAS float* ps = qf + 1024;
    LAS int* srow = (LAS int*)(ps + 2048);
    const int l = F.lane;
    const int gw = blockIdx.x * NWAVES + F.wave, NGW = F.G * NWAVES;
    for (int q = gw; q < R; q += NGW) {
        bf16* qrow = QA + (size_t)q * QAW;
        if (q >= NROWS) {
            for (int c = l; c < QAW / 8; c += 64) *(v4u*)(qrow + 8 * c) = (v4u){0u, 0u, 0u, 0u};
            continue;
        }
        int b, pos; if (q < NREAL) { b = q >> 13; pos = NMETA + (q & (SEQ - 1)); } else { b = 0; pos = q - NREAL; }
        const int nsel = NSEL[q];
        {
            const v4u t0 = *(const v4u*)(qrow + 16 * l), t1 = *(const v4u*)(qrow + 16 * l + 8);
            LAS float* d = qf + 16 * l;
            d[0] = bflo(t0.x); d[1] = bfhi(t0.x); d[2] = bflo(t0.y); d[3] = bfhi(t0.y); d[4] = bflo(t0.z); d[5] = bfhi(t0.z); d[6] = bflo(t0.w); d[7] = bfhi(t0.w);
            d[8] = bflo(t1.x); d[9] = bfhi(t1.x); d[10] = bflo(t1.y); d[11] = bfhi(t1.y); d[12] = bflo(t1.z); d[13] = bfhi(t1.z); d[14] = bflo(t1.w); d[15] = bfhi(t1.w);
        }
        __builtin_amdgcn_wave_barrier();
        for (int kk = 0; kk < 4; ++kk) {
            const int s = kk * 64 + l; const bool valid = s < nsel;
            const int j = valid ? (int)SEL[(size_t)q * TOPK + s] : 0;
            const int row = key_row(b, j);
            srow[s] = row;
            float acc[8];
#pragma unroll
            for (int h = 0; h < 8; ++h) acc[h] = 0.f;
            const v4u* kp = (const v4u*)(CKV + (size_t)row * 128);
            for (int c8 = 0; c8 < 16; ++c8) {
                const v4u t = kp[c8];
                const float k0 = bflo(t.x), k1 = bfhi(t.x), k2 = bflo(t.y), k3 = bfhi(t.y), k4 = bflo(t.z), k5 = bfhi(t.z), k6 = bflo(t.w), k7 = bfhi(t.w);
#pragma unroll
                for (int h = 0; h < 8; ++h) {
                    const f32x4 qa = *(const LAS f32x4*)(qf + h * 128 + 8 * c8), qb = *(const LAS f32x4*)(qf + h * 128 + 8 * c8 + 4);
                    acc[h] += qa.x * k0 + qa.y * k1 + qa.z * k2 + qa.w * k3 + qb.x * k4 + qb.y * k5 + qb.z * k6 + qb.w * k7;
                }
            }
            const float dist = fabsf((float)(pos - j));
#pragma unroll
            for (int h = 0; h < 8; ++h) { const float slope = __uint_as_float((unsigned)(127 - (h + 1)) << 23); ps[s * 8 + h] = valid ? acc[h] - slope * dist : -INFINITY; }
        }
        __builtin_amdgcn_wave_barrier();
#pragma unroll
        for (int h = 0; h < 8; ++h) {
            float v0 = ps[(l) * 8 + h], v1 = ps[(l + 64) * 8 + h], v2 = ps[(l + 128) * 8 + h], v3 = ps[(l + 192) * 8 + h];
            const float mx = wave_max(fmaxf(fmaxf(v0, v1), fmaxf(v2, v3)));
            v0 = __expf(v0 - mx); v1 = __expf(v1 - mx); v2 = __expf(v2 - mx); v3 = __expf(v3 - mx);
            const float inv = 1.0f / wave_sum((v0 + v1) + (v2 + v3));
            ps[(l) * 8 + h] = v0 * inv; ps[(l + 64) * 8 + h] = v1 * inv; ps[(l + 128) * 8 + h] = v2 * inv; ps[(l + 192) * 8 + h] = v3 * inv;
        }
        __builtin_amdgcn_wave_barrier();
        float o0[8], o1[8];
#pragma unroll
        for (int h = 0; h < 8; ++h) { o0[h] = 0.f; o1[h] = 0.f; }
        for (int s = 0; s < nsel; ++s) {
            const int row = srow[s];
            const unsigned w = *(const unsigned*)(CKV + (size_t)row * 128 + 2 * l);
            const float c0 = bflo(w), c1 = bfhi(w);
            const f32x4 pa = *(const LAS f32x4*)(ps + s * 8), pb = *(const LAS f32x4*)(ps + s * 8 + 4);
            o0[0] += pa.x * c0; o1[0] += pa.x * c1; o0[1] += pa.y * c0; o1[1] += pa.y * c1; o0[2] += pa.z * c0; o1[2] += pa.z * c1; o0[3] += pa.w * c0; o1[3] += pa.w * c1;
            o0[4] += pb.x * c0; o1[4] += pb.x * c1; o0[5] += pb.y * c0; o1[5] += pb.y * c1; o0[6] += pb.z * c0; o1[6] += pb.z * c1; o0[7] += pb.w * c0; o1[7] += pb.w * c1;
        }
#pragma unroll
        for (int h = 0; h < 8; ++h) *(unsigned*)(qrow + h * 128 + 2 * l) = pk2(o0[h], o1[h]);
        __builtin_amdgcn_wave_barrier();
    }
}

__device__ __forceinline__ void p7_rwkv_prep_naive(Frame& F) {
    const bf16* P = WSP(bf16, WS_P); float* DEC = WSP(float, WS_DEC); bf16* AB = WSP(bf16, WS_AB); bf16* GB = WSP(bf16, WS_GB);
    const float* mu = F.in[IN_MU]; const float* Wd = F.in[IN_W_DEC]; const float* Wa = F.in[IN_W_AAA]; const float* Wg = F.in[IN_W_GATE];
    const int l = F.lane;
    const int gw = blockIdx.x * NWAVES + F.wave, NGW = F.G * NWAVES;
    for (int r = gw; r < NROWS; r += NGW) {
        int prev; if (r < NREAL) { prev = (r & (SEQ - 1)) ? r - 1 : NREAL + NMETA - 1; } else { prev = r > NREAL ? r - 1 : -1; }
        const bf16* pr = P + (size_t)r * PW; const bf16* pp = prev >= 0 ? P + (size_t)prev * PW : nullptr;
#define SHIFTED(pc, mc) (bf2f(pr[pc]) + ((pp ? bf2f(pp[pc]) : 0.f) - bf2f(pr[pc])) * mu[mc])
        const float tw = tanhf(SHIFTED(PC_WD + l, 1536 + l));
        const float ta = SHIFTED(PC_AD + l, 1600 + l);
        const float tg0 = sigmoidf_(SHIFTED(PC_GD + l, 1664 + l)), tg1 = sigmoidf_(SHIFTED(PC_GD + 64 + l, 1728 + l));
#undef SHIFTED
        float aw[8], aa[8], ag[8];
#pragma unroll
        for (int i = 0; i < 8; ++i) { aw[i] = F.in[IN_W0][l + 64 * i]; aa[i] = F.in[IN_A0][l + 64 * i]; ag[i] = 0.f; }
        for (int j = 0; j < 64; ++j) {
            const float xw = __shfl(tw, j), xa = __shfl(ta, j), xg0 = __shfl(tg0, j), xg1 = __shfl(tg1, j);
#pragma unroll
            for (int i = 0; i < 8; ++i) {
                aw[i] += xw * Wd[(size_t)j * 512 + l + 64 * i];
                aa[i] += xa * Wa[(size_t)j * 512 + l + 64 * i];
                ag[i] += xg0 * Wg[(size_t)j * 512 + l + 64 * i] + xg1 * Wg[(size_t)(j + 64) * 512 + l + 64 * i];
            }
        }
#pragma unroll
        for (int i = 0; i < 8; ++i) {
            const float x = -aw[i];
            const float sp = x > 20.f ? x : log1pf(__expf(x));
            const float wlog = -sp - 0.5f;
            DEC[(size_t)r * 512 + l + 64 * i] = __expf(-__expf(wlog));
            AB[(size_t)r * 512 + l + 64 * i] = (bf16)f2bf(sigmoidf_(aa[i]));
            GB[(size_t)r * 512 + l + 64 * i] = (bf16)f2bf(ag[i]);
        }
    }
}

__device__ __forceinline__ void p8_rwkv_scan_naive(Frame& F) {
    if (F.wave != 0 || blockIdx.x >= 32) return;
    const bf16* P = WSP(bf16, WS_P); const float* DEC = WSP(float, WS_DEC); const bf16* AB = WSP(bf16, WS_AB); const bf16* GB = WSP(bf16, WS_GB); bf16* QA = WSP(bf16, WS_QA);
    const int b = blockIdx.x >> 3, h = blockIdx.x & 7, l = F.lane, ch = h * 64 + l;
    LAS float* vec = (LAS float*)F.lds;
    const float mu_r = F.in[IN_MU][ch], mu_k = F.in[IN_MU][512 + ch], mu_v = F.in[IN_MU][1024 + ch];
    const float kk_c = F.in[IN_KK][ch], ka_c = F.in[IN_KA][ch], rk_c = F.in[IN_RK][ch], gng = F.in[IN_GN_G][ch], gnb = F.in[IN_GN_B][ch];
    float S[64];
#pragma unroll
    for (int k = 0; k < 64; ++k) S[k] = 0.f;
    float pr_p = 0.f, pk_p = 0.f, pv_p = 0.f;
    int row = key_row(b, 0);
    float n_pr = bf2f(P[(size_t)row * PW + PC_R + ch]), n_pk = bf2f(P[(size_t)row * PW + PC_K + ch]), n_pv = bf2f(P[(size_t)row * PW + PC_V + ch]);
    float n_w = DEC[(size_t)row * 512 + ch], n_a = bf2f(AB[(size_t)row * 512 + ch]), n_g = bf2f(GB[(size_t)row * 512 + ch]);
    for (int pos = 0; pos < TT; ++pos) {
        const int crow = row;
        const float c_pr = n_pr, c_pk = n_pk, c_pv = n_pv, c_w = n_w, c_a = n_a, c_g = n_g;
        if (pos + 1 < TT) {
            row = key_row(b, pos + 1);
            n_pr = bf2f(P[(size_t)row * PW + PC_R + ch]); n_pk = bf2f(P[(size_t)row * PW + PC_K + ch]); n_pv = bf2f(P[(size_t)row * PW + PC_V + ch]);
            n_w = DEC[(size_t)row * 512 + ch]; n_a = bf2f(AB[(size_t)row * 512 + ch]); n_g = bf2f(GB[(size_t)row * 512 + ch]);
        }
        const float r_s = c_pr + (pr_p - c_pr) * mu_r, k_s = c_pk + (pk_p - c_pk) * mu_k, v_s = c_pv + (pv_p - c_pv) * mu_v;
        pr_p = c_pr; pk_p = c_pk; pv_p = c_pv;
        const float kkr = k_s * kk_c;
        const float nrm = sqrtf(wave_sum(kkr * kkr));
        const float kk = kkr / fmaxf(nrm, 1e-12f);
        const float k2 = k_s * (1.f + (c_a - 1.f) * ka_c);
        vec[l] = -kk; vec[64 + l] = kk * c_a; vec[128 + l] = c_w; vec[192 + l] = k2; vec[256 + l] = r_s;
        __builtin_amdgcn_wave_barrier();
        float sa = 0.f;
#pragma unroll
        for (int k4 = 0; k4 < 16; ++k4) { const f32x4 a = *(const LAS f32x4*)(vec + 4 * k4); sa += S[4 * k4] * a.x + S[4 * k4 + 1] * a.y + S[4 * k4 + 2] * a.z + S[4 * k4 + 3] * a.w; }
        float y = 0.f;
#pragma unroll
        for (int k4 = 0; k4 < 16; ++k4) {
            const f32x4 bv = *(const LAS f32x4*)(vec + 64 + 4 * k4), w = *(const LAS f32x4*)(vec + 128 + 4 * k4), kv = *(const LAS f32x4*)(vec + 192 + 4 * k4), rv = *(const LAS f32x4*)(vec + 256 + 4 * k4);
            S[4 * k4] = S[4 * k4] * w.x + sa * bv.x + v_s * kv.x; S[4 * k4 + 1] = S[4 * k4 + 1] * w.y + sa * bv.y + v_s * kv.y;
            S[4 * k4 + 2] = S[4 * k4 + 2] * w.z + sa * bv.z + v_s * kv.z; S[4 * k4 + 3] = S[4 * k4 + 3] * w.w + sa * bv.w + v_s * kv.w;
            y += S[4 * k4] * rv.x + S[4 * k4 + 1] * rv.y + S[4 * k4 + 2] * rv.z + S[4 * k4 + 3] * rv.w;
        }
        __builtin_amdgcn_wave_barrier();
        const float mean = wave_sum(y) * (1.f / 64.f);
        const float dlt = y - mean;
        const float var = wave_sum(dlt * dlt) * (1.f / 64.f);
        const float yn = dlt * (1.0f / sqrtf(var + GN_EPS)) * gng + gnb;
        const float bonus = wave_sum(r_s * k2 * rk_c) * v_s;
        const float o = (yn + bonus) * c_g;
        if (pos >= NMETA || b == 0) QA[(size_t)crow * QAW + 1024 + ch] = (bf16)f2bf(o);
    }
}

__device__ __forceinline__ void p10_ln1(Frame& F) {
    bf16* H1 = WSP(bf16, WS_H); const float* META1 = WSP(float, WS_META1);
    const int gw = blockIdx.x * NWAVES + F.wave, NGW = F.G * NWAVES;
    for (int r = gw; r < NROWS; r += NGW) {
        const float* src = r < NREAL ? F.out + (size_t)r * D : META1 + (size_t)(r - NREAL) * D;
        ln_row_bf16(F, src, F.in[IN_LN1_G], F.in[IN_LN1_B], H1 + (size_t)r * D);
    }
}
__device__ __forceinline__ void p14_ln2(Frame& F) {
    const int gw = blockIdx.x * NWAVES + F.wave, NGW = F.G * NWAVES;
    const float* g = F.in[IN_LN2_G]; const float* b = F.in[IN_LN2_B];
    for (int r = gw; r < NREAL; r += NGW) {
        f32x4* xr = (f32x4*)(F.out + (size_t)r * D) + F.lane;
        f32x4 v[4]; float s = 0.f;
#pragma unroll
        for (int j = 0; j < 4; ++j) { v[j] = xr[64 * j]; s += (v[j].x + v[j].y) + (v[j].z + v[j].w); }
        const float mean = wave_sum(s) * (1.f / D); float s2 = 0.f;
#pragma unroll
        for (int j = 0; j < 4; ++j) { v[j] = v[j] - mean; s2 += (v[j].x * v[j].x + v[j].y * v[j].y) + (v[j].z * v[j].z + v[j].w * v[j].w); }
        const float rstd = 1.f / sqrtf(wave_sum(s2) * (1.f / D) + LN_EPS);
#pragma unroll
        for (int j = 0; j < 4; ++j) { const f32x4 gg = ((const f32x4*)g)[F.lane + 64 * j], bb = ((const f32x4*)b)[F.lane + 64 * j]; xr[64 * j] = v[j] * rstd * gg + bb; }
    }
}

__device__ __forceinline__ float gelu_tanh(float x) { const float u = 0.7978845608028654f * (x + 0.044715f * x * x * x); return 0.5f * x * (1.f + tanhf(u)); }
__device__ __forceinline__ void p12_conv_act(Frame& F) {
    bf16* UP = WSP(bf16, WS_UP); const float* cw = F.in[IN_CONV_W]; const float* cb = F.in[IN_CONV_B];
    const size_t total = (size_t)NREAL * (DFF / 8);
    for (size_t it = (size_t)blockIdx.x * NTHR + F.tid; it < total; it += (size_t)F.G * NTHR) {
        const int r = (int)(it / (DFF / 8)), c = (int)(it % (DFF / 8)) * 8, s = r & (SEQ - 1);
        const int r1 = s >= 1 ? r - 1 : NREAL + 15, r2 = s >= 2 ? r - 2 : NREAL + 14 + s;
        const v4u g0 = *(const v4u*)(UP + (size_t)r * UPW + c), g1 = *(const v4u*)(UP + (size_t)r1 * UPW + c), g2 = *(const v4u*)(UP + (size_t)r2 * UPW + c);
        const v4u vv = *(const v4u*)(UP + (size_t)r * UPW + DFF + c);
        const unsigned a0[4] = {g0.x, g0.y, g0.z, g0.w}, a1[4] = {g1.x, g1.y, g1.z, g1.w}, a2[4] = {g2.x, g2.y, g2.z, g2.w}, av[4] = {vv.x, vv.y, vv.z, vv.w};
        unsigned o[4];
#pragma unroll
        for (int e = 0; e < 4; ++e) {
            const int c0 = c + 2 * e, c1 = c0 + 1;
            const float x0 = cw[c0] * bflo(a2[e]) + cw[DFF + c0] * bflo(a1[e]) + cw[2 * DFF + c0] * bflo(a0[e]) + cb[c0];
            const float x1 = cw[c1] * bfhi(a2[e]) + cw[DFF + c1] * bfhi(a1[e]) + cw[2 * DFF + c1] * bfhi(a0[e]) + cb[c1];
            o[e] = pk2(gelu_tanh(x0) * bflo(av[e]), gelu_tanh(x1) * bfhi(av[e]));
        }
        *(v4u*)(UP + (size_t)r * UPW + DFF + c) = (v4u){o[0], o[1], o[2], o[3]};
    }
}


constexpr int NUNITS = 4096 + 8;
constexpr int RP = 72;
constexpr int SLOT = 64 * RP * 2;
constexpr int FP = 68;
typedef short bf16x8 __attribute__((ext_vector_type(8)));
typedef float f32x16 __attribute__((ext_vector_type(16)));
constexpr size_t RW_MAT = (size_t)NUNITS * 4096;

__device__ __forceinline__ void quad_mma(f32x16& acc, const LAS bf16* Aop, const LAS bf16* Bop, int qr, int qc, int lane) {
    const int r = lane & 31, hf = lane >> 5;
    const LAS bf16* ap = Aop + (32 * qr + r) * RP + 8 * hf; const LAS bf16* bp = Bop + (32 * qc + r) * RP + 8 * hf;
#pragma unroll
    for (int ks = 0; ks < 4; ++ks) {
        const bf16x8 a = *(const LAS bf16x8*)(ap + 16 * ks), b = *(const LAS bf16x8*)(bp + 16 * ks);
        acc = __builtin_amdgcn_mfma_f32_32x32x16_bf16(a, b, acc, 0, 0, 0);
    }
}
#define ACC_M(qr, j, hf) (32 * (qr) + ((j) & 3) + 8 * ((j) >> 2) + 4 * (hf))
__device__ __forceinline__ void store_T(const f32x16& acc, LAS bf16* Z, int qr, int qc, int lane) {
    const int r = lane & 31, hf = lane >> 5;
#pragma unroll
    for (int jj = 0; jj < 4; ++jj)
        *(LAS v2u*)(Z + (32 * qc + r) * RP + 32 * qr + 8 * jj + 4 * hf) = (v2u){pk2(acc[4 * jj], acc[4 * jj + 1]), pk2(acc[4 * jj + 2], acc[4 * jj + 3])};
}
__device__ __forceinline__ void add_T(f32x16& acc, const LAS bf16* Z, int qr, int qc, int lane) {
    const int r = lane & 31, hf = lane >> 5;
#pragma unroll
    for (int jj = 0; jj < 4; ++jj) {
        const v2u w = *(const LAS v2u*)(Z + (32 * qc + r) * RP + 32 * qr + 8 * jj + 4 * hf);
        acc[4 * jj] += bflo(w.x); acc[4 * jj + 1] += bfhi(w.x); acc[4 * jj + 2] += bflo(w.y); acc[4 * jj + 3] += bfhi(w.y);
    }
}
__device__ __forceinline__ void store_T_global(const f32x16& acc, bf16* Z, int qr, int qc, int lane) {
    const int r = lane & 31, hf = lane >> 5;
#pragma unroll
    for (int jj = 0; jj < 4; ++jj)
        *(v2u*)(Z + (32 * qc + r) * 64 + 32 * qr + 8 * jj + 4 * hf) = (v2u){pk2(acc[4 * jj], acc[4 * jj + 1]), pk2(acc[4 * jj + 2], acc[4 * jj + 3])};
}
__device__ __forceinline__ f32x16 zero16() { f32x16 z;
#pragma unroll
    for (int j = 0; j < 16; ++j) z[j] = 0.f;
    return z; }

__device__ __forceinline__ void rw_b1(Frame& F) {
    const bf16* P = WSP(bf16, WS_P);
    bf16* RWM = WSP(bf16, WS_RWM); bf16* RWN = WSP(bf16, WS_RWN); bf16* RWQ = WSP(bf16, WS_RWQ); bf16* RWY = WSP(bf16, WS_RWY);
    float* BONUS = (float*)((char*)F.out + OUT_BONUS);
    const bf16* WdT = WSP(bf16, WS_WT_LORA); const bf16* WaT = WdT + 512 * 64;
    const float* mu = F.in[IN_MU];
    const int w = F.wave, l = F.lane, tid = F.tid;
    LAS unsigned char* L = F.lds;
#define SL(s) ((LAS bf16*)(L + (s) * SLOT))
    LAS float* WL = (LAS float*)(L + 12 * SLOT);
    LAS float* AL = (LAS float*)(L + 0 * SLOT);
    LAS float* OT = (LAS float*)(L + RING_BYTES + 1024);
    LAS float* GL = OT + 512;
    for (int u = blockIdx.x; u < NUNITS; u += F.G) {
        const bool meta = u >= 4096;
        int b = 0, h, c = 0; if (meta) h = u - 4096; else { b = u >> 10; h = (u >> 7) & 7; c = u & 127; }
        const int ch = h * 64 + l;
        const int row0 = meta ? NREAL : b * SEQ + c * 64;
        __syncthreads();
        float r_s[8], k_s[8], v_s[8], xw[8], xa[8];
        {
            float pr, pk, pv, pw, pa;
            const int t0 = 8 * w;
            int prow = -1;
            if (t0 > 0) prow = row0 + t0 - 1; else if (!meta) prow = (c == 0) ? NREAL + NMETA - 1 : row0 - 1;
            if (prow >= 0) { const bf16* pp = P + (size_t)prow * PW; pr = bf2f(pp[PC_R + ch]); pk = bf2f(pp[PC_K + ch]); pv = bf2f(pp[PC_V + ch]); pw = bf2f(pp[PC_WD + l]); pa = bf2f(pp[PC_AD + l]); }
            else { pr = pk = pv = pw = pa = 0.f; }
            const float mr = mu[ch], mk = mu[512 + ch], mv = mu[1024 + ch], mw = mu[1536 + l], ma = mu[1600 + l];
#pragma unroll
            for (int i = 0; i < 8; ++i) {
                const int t = t0 + i; const bool valid = !meta || t < NMETA;
                float cr = 0.f, ck = 0.f, cv = 0.f, cw = 0.f, ca = 0.f;
                if (valid) { const bf16* pp = P + (size_t)(row0 + t) * PW; cr = bf2f(pp[PC_R + ch]); ck = bf2f(pp[PC_K + ch]); cv = bf2f(pp[PC_V + ch]); cw = bf2f(pp[PC_WD + l]); ca = bf2f(pp[PC_AD + l]); }
                r_s[i] = valid ? cr + (pr - cr) * mr : 0.f; k_s[i] = valid ? ck + (pk - ck) * mk : 0.f; v_s[i] = valid ? cv + (pv - cv) * mv : 0.f;
                xw[i] = tanhf(cw + (pw - cw) * mw); xa[i] = ca + (pa - ca) * ma;
                pr = cr; pk = ck; pv = cv; pw = cw; pa = ca;
            }
#pragma unroll
            for (int i = 0; i < 8; ++i) { SL(8)[(t0 + i) * RP + l] = (bf16)f2bf(xw[i]); SL(9)[(t0 + i) * RP + l] = (bf16)f2bf(xa[i]); }
            {
                const int k = tid >> 3, pc = tid & 7;
                *(LAS v4u*)(SL(10) + k * RP + 8 * pc) = *(const v4u*)(WdT + (size_t)(h * 64 + k) * 64 + 8 * pc);
                *(LAS v4u*)(SL(11) + k * RP + 8 * pc) = *(const v4u*)(WaT + (size_t)(h * 64 + k) * 64 + 8 * pc);
            }
        }
        __syncthreads();
        {
            const int pid = w >> 2, q = w & 3, qr = q >> 1, qc = q & 1;
            f32x16 acc = zero16();
            quad_mma(acc, SL(10 + pid), SL(8 + pid), qr, qc, l);
            LAS float* Zf = pid ? AL : WL;
            const int r = l & 31, hf = l >> 5;
#pragma unroll
            for (int jj = 0; jj < 4; ++jj) *(LAS f32x4*)(Zf + (32 * qc + r) * FP + 32 * qr + 8 * jj + 4 * hf) = (f32x4){acc[4 * jj], acc[4 * jj + 1], acc[4 * jj + 2], acc[4 * jj + 3]};
        }
        __syncthreads();
        float lw[8], asg[8];
        {
            const float w0c = F.in[IN_W0][ch], a0c = F.in[IN_A0][ch];
            float run = 0.f;
#pragma unroll
            for (int i = 0; i < 8; ++i) {
                const int t = 8 * w + i; const bool valid = !meta || t < NMETA;
                const float x = -(WL[t * FP + l] + w0c);
                const float sp = x > 20.f ? x : log1pf(__expf(x));
                const float e = -__expf(-sp - 0.5f);
                run += valid ? e : 0.f; lw[i] = run;
                asg[i] = sigmoidf_(AL[t * FP + l] + a0c);
            }
            OT[w * 64 + l] = run;
        }
        __syncthreads();
        {
            float off = 0.f, tot = 0.f;
#pragma unroll
            for (int ww = 0; ww < 8; ++ww) { const float o = OT[ww * 64 + l]; tot += o; off += ww < w ? o : 0.f; }
            if (w == 0) GL[l] = __expf(tot);
            const float kkc = F.in[IN_KK][ch], kac = F.in[IN_KA][ch], rkc = F.in[IN_RK][ch];
            unsigned atc[4], vc[4], bhc[4], khc[4];
            float prevlg = off;
#pragma unroll
            for (int i = 0; i < 8; ++i) {
                const int t = 8 * w + i;
                const float lg = off + lw[i];
                const float g = __expf(lg), gp = __expf(prevlg), gi = __expf(-lg), gh = __expf(tot - lg);
                prevlg = lg;
                const float kkr = k_s[i] * kkc;
                const float nrm = sqrtf(wave_sum(kkr * kkr));
                const float kk = kkr / fmaxf(nrm, 1e-12f);
                const float k2 = k_s[i] * (1.f + (asg[i] - 1.f) * kac);
                const float bon = wave_sum(r_s[i] * k2 * rkc);
                if (l == 0) BONUS[(size_t)u * 64 + t] = bon;
                const float at = -kk * gp, rt = r_s[i] * g, bt = kk * asg[i] * gi, kt = k2 * gi, bh = kk * asg[i] * gh, kh = k2 * gh;
                SL(0)[t * RP + l] = (bf16)f2bf(at); SL(1)[t * RP + l] = (bf16)f2bf(rt); SL(2)[t * RP + l] = (bf16)f2bf(bt); SL(3)[t * RP + l] = (bf16)f2bf(kt);
                const unsigned ua = f2bf(at), uv = f2bf(v_s[i]), ub = f2bf(bh), uk = f2bf(kh);
                if (i & 1) { atc[i >> 1] |= ua << 16; vc[i >> 1] |= uv << 16; bhc[i >> 1] |= ub << 16; khc[i >> 1] |= uk << 16; }
                else { atc[i >> 1] = ua; vc[i >> 1] = uv; bhc[i >> 1] = ub; khc[i >> 1] = uk; }
            }
            *(LAS v4u*)(SL(4) + l * RP + 8 * w) = (v4u){atc[0], atc[1], atc[2], atc[3]};
            *(LAS v4u*)(SL(5) + l * RP + 8 * w) = (v4u){vc[0], vc[1], vc[2], vc[3]};
            *(LAS v4u*)(SL(6) + l * RP + 8 * w) = (v4u){bhc[0], bhc[1], bhc[2], bhc[3]};
            *(LAS v4u*)(SL(7) + l * RP + 8 * w) = (v4u){khc[0], khc[1], khc[2], khc[3]};
        }
        __syncthreads();
        for (int task = w; task < 20; task += 8) {
            const int pid = task >> 2, q = task & 3, qr = q >> 1, qc = q & 1;
            const int bop = pid == 0 ? 0 : pid == 1 ? 2 : pid == 2 ? 0 : 1;
            const int aop = pid == 0 ? 2 : pid == 1 ? 0 : pid == 2 ? 3 : pid == 3 ? 2 : 3;
            f32x16 acc = zero16();
            quad_mma(acc, SL(aop), SL(bop), qr, qc, l);
            const int n = 32 * qc + (l & 31), hf = l >> 5;
#pragma unroll
            for (int j = 0; j < 16; ++j) {
                const int m = ACC_M(qr, j, hf);
                const bool keep = pid == 1 ? (m > n) : (pid <= 2 ? (n > m) : (n >= m));
                acc[j] = keep ? acc[j] : 0.f;
            }
            store_T(acc, SL(8 + pid), qr, qc, l);
        }
        __syncthreads();
        const int nq = w & 3, nqr = nq >> 1, nqc = nq & 1;
        f32x16 nacc = zero16();
        if (w < 4) { add_T(nacc, SL(8), nqr, nqc, l); }
        for (int task = w; task < 12; task += 8) {
            const int pid = task >> 2, q = task & 3, qr = q >> 1, qc = q & 1;
            f32x16 acc = zero16();
            if (pid == 0) { quad_mma(acc, SL(9), SL(8), qr, qc, l); store_T(acc, SL(0), qr, qc, l); }
            else if (pid == 1) { quad_mma(acc, SL(8), SL(9), qr, qc, l); store_T(acc, SL(2), qr, qc, l); }
            else { quad_mma(acc, SL(10), SL(5), qr, qc, l); store_T(acc, SL(3), qr, qc, l); }
        }
        __syncthreads();
#pragma unroll
        for (int st = 0; st < 4; ++st) {
            const int pr = (st & 1) ? 10 : 0, pc = (st & 1) ? 13 : 2, pr2 = (st & 1) ? 0 : 10, pc2 = (st & 1) ? 2 : 13, nr = (st & 1) ? 9 : 8, nr2 = (st & 1) ? 8 : 9;
            if (w < 4) {
                add_T(nacc, SL(pr), nqr, nqc, l);
                quad_mma(nacc, SL(pc), SL(nr), nqr, nqc, l);
                store_T(nacc, SL(nr2), nqr, nqc, l);
                f32x16 acc = zero16();
                quad_mma(acc, SL(pc), SL(pr), nqr, nqc, l); store_T(acc, SL(pr2), nqr, nqc, l);
            } else {
                f32x16 acc = zero16();
                quad_mma(acc, SL(pr), SL(pc), nqr, nqc, l); store_T(acc, SL(pc2), nqr, nqc, l);
            }
            __syncthreads();
        }
        if (w < 4) { add_T(nacc, SL(0), nqr, nqc, l); quad_mma(nacc, SL(2), SL(8), nqr, nqc, l); store_T(nacc, SL(9), nqr, nqc, l); }
        __syncthreads();
        {
            const int pid = w >> 2;
            f32x16 acc = zero16();
            add_T(acc, SL(pid ? 3 : 4), nqr, nqc, l);
            quad_mma(acc, SL(9), SL(pid ? 3 : 4), nqr, nqc, l);
            store_T(acc, SL(pid ? 2 : 0), nqr, nqc, l);
        }
        __syncthreads();
        for (int task = w; task < 16; task += 8) {
            const int pid = task >> 2, q = task & 3, qr = q >> 1, qc = q & 1;
            f32x16 acc = zero16();
            if (pid == 0) { add_T(acc, SL(1), qr, qc, l); quad_mma(acc, SL(0), SL(11), qr, qc, l); store_T_global(acc, RWQ + (size_t)u * 4096, qr, qc, l); }
            else if (pid == 1) { quad_mma(acc, SL(2), SL(11), qr, qc, l); quad_mma(acc, SL(5), SL(12), qr, qc, l); store_T_global(acc, RWY + (size_t)u * 4096, qr, qc, l); }
            else if (pid == 2) {
                quad_mma(acc, SL(0), SL(6), qr, qc, l);
                const int n = 32 * qc + (l & 31), hf = l >> 5; const float gl = GL[n];
#pragma unroll
                for (int j = 0; j < 16; ++j) acc[j] += (ACC_M(qr, j, hf) == n) ? gl : 0.f;
                store_T_global(acc, RWM + (size_t)u * 4096, qr, qc, l);
            } else { quad_mma(acc, SL(6), SL(2), qr, qc, l); quad_mma(acc, SL(7), SL(5), qr, qc, l); store_T_global(acc, RWN + (size_t)u * 4096, qr, qc, l); }
        }
    }
#undef SL
}

__device__ __forceinline__ void rw_b2(Frame& F) {
    if (blockIdx.x >= 32) return;
    const bf16* RWM = WSP(bf16, WS_RWM); const bf16* RWN = WSP(bf16, WS_RWN);
    bf16* RWS = (bf16*)((char*)F.out + OUT_RWS);
    const int b = blockIdx.x >> 3, h = blockIdx.x & 7, w = F.wave, l = F.lane;
    LAS unsigned char* L = F.lds;
#define SS(buf, part) ((LAS bf16*)(L + ((buf) * 2 + (part)) * SLOT))
    const int q = w & 3, qr = q >> 1, qc = q & 1, r = l & 31, hf = l >> 5;
    if (w < 4) {
        const bf16* Nm = RWN + (size_t)(4096 + h) * 4096;
#pragma unroll
        for (int jj = 0; jj < 4; ++jj) {
            const v2u wv = *(const v2u*)(Nm + (32 * qc + r) * 64 + 32 * qr + 8 * jj + 4 * hf);
            *(LAS v2u*)(SS(0, 0) + (32 * qc + r) * RP + 32 * qr + 8 * jj + 4 * hf) = wv;
            *(LAS v2u*)(SS(0, 1) + (32 * qc + r) * RP + 32 * qr + 8 * jj + 4 * hf) = (v2u){0u, 0u};
        }
    }
    __syncthreads();
    bf16x8 a_cur[4]; v2u n_cur[4];
    {
        const size_t u0 = (size_t)(b * 8 + h) * 128;
#pragma unroll
        for (int ks = 0; ks < 4; ++ks) a_cur[ks] = *(const bf16x8*)(RWM + u0 * 4096 + (32 * qr + r) * 64 + 8 * hf + 16 * ks);
#pragma unroll
        for (int jj = 0; jj < 4; ++jj) n_cur[jj] = *(const v2u*)(RWN + u0 * 4096 + (32 * qc + r) * 64 + 32 * qr + 8 * jj + 4 * hf);
    }
    for (int c = 0; c < 128; ++c) {
        const int u = (b * 8 + h) * 128 + c, cur = c & 1;
        if (w < 4) {
            bf16x8 a_nxt[4]; v2u n_nxt[4];
            const size_t un = (size_t)(c + 1 < 128 ? u + 1 : u);
#pragma unroll
            for (int ks = 0; ks < 4; ++ks) a_nxt[ks] = *(const bf16x8*)(RWM + un * 4096 + (32 * qr + r) * 64 + 8 * hf + 16 * ks);
#pragma unroll
            for (int jj = 0; jj < 4; ++jj) n_nxt[jj] = *(const v2u*)(RWN + un * 4096 + (32 * qc + r) * 64 + 32 * qr + 8 * jj + 4 * hf);
            f32x16 acc;
#pragma unroll
            for (int jj = 0; jj < 4; ++jj) { acc[4 * jj] = bflo(n_cur[jj].x); acc[4 * jj + 1] = bfhi(n_cur[jj].x); acc[4 * jj + 2] = bflo(n_cur[jj].y); acc[4 * jj + 3] = bfhi(n_cur[jj].y); }
#pragma unroll
            for (int jj = 0; jj < 4; ++jj)
                *(v2u*)(RWS + (size_t)u * 4096 + (32 * qc + r) * 64 + 32 * qr + 8 * jj + 4 * hf) = *(const LAS v2u*)(SS(cur, 0) + (32 * qc + r) * RP + 32 * qr + 8 * jj + 4 * hf);
            const LAS bf16* bh = SS(cur, 0) + (32 * qc + r) * RP + 8 * hf; const LAS bf16* bl = SS(cur, 1) + (32 * qc + r) * RP + 8 * hf;
#pragma unroll
            for (int ks = 0; ks < 4; ++ks) {
                acc = __builtin_amdgcn_mfma_f32_32x32x16_bf16(a_cur[ks], *(const LAS bf16x8*)(bh + 16 * ks), acc, 0, 0, 0);
                acc = __builtin_amdgcn_mfma_f32_32x32x16_bf16(a_cur[ks], *(const LAS bf16x8*)(bl + 16 * ks), acc, 0, 0, 0);
            }
#pragma unroll
            for (int jj = 0; jj < 4; ++jj) {
                float hi[4], lo[4];
#pragma unroll
                for (int e = 0; e < 4; ++e) { const unsigned hb = f2bf(acc[4 * jj + e]); hi[e] = __uint_as_float(hb << 16); lo[e] = acc[4 * jj + e] - hi[e]; }
                *(LAS v2u*)(SS(cur ^ 1, 0) + (32 * qc + r) * RP + 32 * qr + 8 * jj + 4 * hf) = (v2u){pk2(hi[0], hi[1]), pk2(hi[2], hi[3])};
                *(LAS v2u*)(SS(cur ^ 1, 1) + (32 * qc + r) * RP + 32 * qr + 8 * jj + 4 * hf) = (v2u){pk2(lo[0], lo[1]), pk2(lo[2], lo[3])};
            }
#pragma unroll
            for (int ks = 0; ks < 4; ++ks) a_cur[ks] = a_nxt[ks];
#pragma unroll
            for (int jj = 0; jj < 4; ++jj) n_cur[jj] = n_nxt[jj];
        }
        __syncthreads();
    }
#undef SS
}

__device__ __forceinline__ void rw_b3(Frame& F) {
    const bf16* P = WSP(bf16, WS_P); bf16* QA = WSP(bf16, WS_QA);
    const bf16* RWQ = WSP(bf16, WS_RWQ); const bf16* RWY = WSP(bf16, WS_RWY);
    const bf16* RWS = (const bf16*)((const char*)F.out + OUT_RWS); const float* BONUS = (const float*)((const char*)F.out + OUT_BONUS);
    const bf16* WgT = WSP(bf16, WS_WT_LORA) + 2 * 512 * 64;
    const float* mu = F.in[IN_MU];
    const int l = F.lane, r = l & 31, hf = l >> 5;
    const int gw = blockIdx.x * NWAVES + F.wave, NGW = F.G * NWAVES;
    for (int it = gw; it < NUNITS * 2; it += NGW) {
        const int u = it >> 1, th = it & 1;
        const bool meta = u >= 4096;
        int b = 0, h, c = 0; if (meta) h = u - 4096; else { b = u >> 10; h = (u >> 7) & 7; c = u & 127; }
        if (meta && th == 1) continue;
        const int t = 32 * th + r;
        const bool valid = !meta || t < NMETA;
        const int row0 = meta ? NREAL : b * SEQ + c * 64;
        const int row = valid ? row0 + t : row0;
        int prow = -1;
        if (t > 0) prow = row - 1; else if (!meta) prow = (c == 0) ? NREAL + NMETA - 1 : row - 1;
        f32x16 y[2];
#pragma unroll
        for (int qv = 0; qv < 2; ++qv) {
            const bf16* Y0 = RWY + (size_t)u * 4096 + (32 * th + r) * 64 + 32 * qv + 4 * hf;
#pragma unroll
            for (int jj = 0; jj < 4; ++jj) { const v2u wv = *(const v2u*)(Y0 + 8 * jj); y[qv][4 * jj] = bflo(wv.x); y[qv][4 * jj + 1] = bfhi(wv.x); y[qv][4 * jj + 2] = bflo(wv.y); y[qv][4 * jj + 3] = bfhi(wv.y); }
        }
        if (!meta) {
            const bf16* qp = RWQ + (size_t)u * 4096 + (32 * th + r) * 64 + 8 * hf;
            const bf16* sp = RWS + (size_t)u * 4096 + r * 64 + 8 * hf;
#pragma unroll
            for (int ks = 0; ks < 4; ++ks) {
                const bf16x8 bq = *(const bf16x8*)(qp + 16 * ks);
                y[0] = __builtin_amdgcn_mfma_f32_32x32x16_bf16(*(const bf16x8*)(sp + 16 * ks), bq, y[0], 0, 0, 0);
                y[1] = __builtin_amdgcn_mfma_f32_32x32x16_bf16(*(const bf16x8*)(sp + 32 * 64 + 16 * ks), bq, y[1], 0, 0, 0);
            }
        }
        f32x16 g[2]; g[0] = zero16(); g[1] = zero16();
        {
            const bf16* gp = P + (size_t)row * PW + PC_GD + 8 * hf; const bf16* gpp = prow >= 0 ? P + (size_t)prow * PW + PC_GD + 8 * hf : nullptr;
            const bf16* wp = WgT + (size_t)(h * 64 + r) * 128 + 8 * hf;
#pragma unroll
            for (int ks = 0; ks < 8; ++ks) {
                const v4u cg = *(const v4u*)(gp + 16 * ks); const v4u pg = gpp ? *(const v4u*)(gpp + 16 * ks) : (v4u){0u, 0u, 0u, 0u};
                const f32x4 m0 = *(const f32x4*)(mu + 1664 + 16 * ks + 8 * hf), m1 = *(const f32x4*)(mu + 1664 + 16 * ks + 8 * hf + 4);
                const unsigned cw[4] = {cg.x, cg.y, cg.z, cg.w}, pw[4] = {pg.x, pg.y, pg.z, pg.w}; const float mm[8] = {m0.x, m0.y, m0.z, m0.w, m1.x, m1.y, m1.z, m1.w};
                unsigned o[4];
#pragma unroll
                for (int e = 0; e < 4; ++e) {
                    const float c0 = bflo(cw[e]), c1 = bfhi(cw[e]), p0 = bflo(pw[e]), p1 = bfhi(pw[e]);
                    o[e] = pk2(sigmoidf_(c0 + (p0 - c0) * mm[2 * e]), sigmoidf_(c1 + (p1 - c1) * mm[2 * e + 1]));
                }
                const v4u ov = (v4u){o[0], o[1], o[2], o[3]};
                const bf16x8 bs = __builtin_bit_cast(bf16x8, ov);
                g[0] = __builtin_amdgcn_mfma_f32_32x32x16_bf16(*(const bf16x8*)(wp + 16 * ks), bs, g[0], 0, 0, 0);
                g[1] = __builtin_amdgcn_mfma_f32_32x32x16_bf16(*(const bf16x8*)(wp + 32 * 128 + 16 * ks), bs, g[1], 0, 0, 0);
            }
        }
        float s = 0.f;
#pragma unroll
        for (int j = 0; j < 16; ++j) s += y[0][j] + y[1][j];
        s += __shfl_xor(s, 32);
        const float mean = s * (1.f / 64.f);
        float s2 = 0.f;
#pragma unroll
        for (int j = 0; j < 16; ++j) { const float d0 = y[0][j] - mean, d1 = y[1][j] - mean; s2 += d0 * d0 + d1 * d1; }
        s2 += __shfl_xor(s2, 32);
        const float rstd = 1.0f / sqrtf(s2 * (1.f / 64.f) + GN_EPS);
        const float bon = BONUS[(size_t)u * 64 + t];
        if (valid) {
#pragma unroll
            for (int qv = 0; qv < 2; ++qv)
#pragma unroll
                for (int jj = 0; jj < 4; ++jj) {
                    const int v0 = 32 * qv + 8 * jj + 4 * hf, chv = h * 64 + v0;
                    const v2u cvw = *(const v2u*)(P + (size_t)row * PW + PC_V + chv); const v2u pvw = prow >= 0 ? *(const v2u*)(P + (size_t)prow * PW + PC_V + chv) : (v2u){0u, 0u};
                    const f32x4 mv = *(const f32x4*)(mu + 1024 + chv), gg = *(const f32x4*)(F.in[IN_GN_G] + chv), gb = *(const f32x4*)(F.in[IN_GN_B] + chv);
                    const float cv[4] = {bflo(cvw.x), bfhi(cvw.x), bflo(cvw.y), bfhi(cvw.y)}, pv[4] = {bflo(pvw.x), bfhi(pvw.x), bflo(pvw.y), bfhi(pvw.y)};
                    const float mvv[4] = {mv.x, mv.y, mv.z, mv.w}, ggv[4] = {gg.x, gg.y, gg.z, gg.w}, gbv[4] = {gb.x, gb.y, gb.z, gb.w};
                    float o[4];
#pragma unroll
                    for (int e = 0; e < 4; ++e) {
                        const float vs = cv[e] + (pv[e] - cv[e]) * mvv[e];
                        o[e] = ((y[qv][4 * jj + e] - mean) * rstd * ggv[e] + gbv[e] + bon * vs) * g[qv][4 * jj + e];
                    }
                    *(v2u*)(QA + (size_t)row * QAW + 1024 + chv) = (v2u){pk2(o[0], o[1]), pk2(o[2], o[3])};
                }
        }
    }
}

constexpr int IX_CAP = 512, IX_LIST = 3072, IX_KB = 98304, IX_SCR = RING_BYTES + 4096;
#define IX_FENCE() asm volatile("s_waitcnt lgkmcnt(0)" ::: "memory")

__device__ __forceinline__ unsigned ix_mbcnt(unsigned long long m) { return __builtin_amdgcn_mbcnt_hi((unsigned)(m >> 32), __builtin_amdgcn_mbcnt_lo((unsigned)m, 0u)); }

__device__ __forceinline__ void ix_select_slow(const float (&sc)[8], const unsigned (&ix)[8], bool (&vl)[8], int K, unsigned short* sel_out, int lane) {
    for (int it = 0; it < K; ++it) {
        unsigned long long best = 0ull;
#pragma unroll
        for (int i = 0; i < 8; ++i) { const unsigned long long key = ((unsigned long long)sortable(sc[i]) << 32) | (unsigned long long)(0xFFFFu - ix[i]) | 0x10000ull; if (vl[i] && key > best) best = key; }
        unsigned long long wm = best;
#pragma unroll
        for (int o = 1; o < 64; o <<= 1) { const unsigned long long v = __shfl_xor(wm, o); wm = v > wm ? v : wm; }
        if (wm == 0ull) break;
        const bool mine = best == wm;
#pragma unroll
        for (int i = 0; i < 8; ++i) { const unsigned long long key = ((unsigned long long)sortable(sc[i]) << 32) | (unsigned long long)(0xFFFFu - ix[i]) | 0x10000ull; if (mine && vl[i] && key == wm) { vl[i] = false; sel_out[it] = (unsigned short)ix[i]; } }
    }
}

__device__ __forceinline__ void ix_compact(LAS float* LS, LAS unsigned short* LI, LAS unsigned* hist, int& cnt, float& tau, int lane, bool final_sel, unsigned short* sel_out) {
    const int n = cnt;
    float sc[8]; unsigned ix[8]; bool vl[8];
    IX_FENCE();
#pragma unroll
    for (int i = 0; i < 8; ++i) { const int p = lane + 64 * i; vl[i] = p < n; sc[i] = vl[i] ? LS[p] : -INFINITY; ix[i] = vl[i] ? (unsigned)LI[p] : 0u; }
    float mx = -INFINITY, mn = INFINITY;
#pragma unroll
    for (int i = 0; i < 8; ++i) { if (vl[i]) { mx = fmaxf(mx, sc[i]); mn = fminf(mn, sc[i]); } }
    mx = wave_max(mx); mn = -wave_max(-mn);
    const float scale = mx > mn ? 255.99f / (mx - mn) : 0.f;
    int bin[8];
#pragma unroll
    for (int i = 0; i < 8; ++i) { int bq = (int)((sc[i] - mn) * scale); bq = bq > 255 ? 255 : (bq < 0 ? 0 : bq); bin[i] = vl[i] ? bq : -1; }
    *(LAS v4u*)(hist + 4 * lane) = (v4u){0u, 0u, 0u, 0u};
    IX_FENCE();
#pragma unroll
    for (int i = 0; i < 8; ++i) if (vl[i]) __hip_atomic_fetch_add((LAS unsigned*)&hist[bin[i]], 1u, __ATOMIC_RELAXED, __HIP_MEMORY_SCOPE_WAVEFRONT);
    IX_FENCE();
    const v4u c = *(const LAS v4u*)(hist + 4 * lane);
    unsigned Pp = c.x + c.y + c.z + c.w;
#pragma unroll
    for (int o = 1; o < 64; o <<= 1) { const unsigned v = __shfl_up(Pp, o); if (lane >= o) Pp += v; }
    const unsigned total = __shfl(Pp, 63);
    const unsigned K = TOPK;
    const unsigned a3 = total - Pp, a2 = a3 + c.w, a1 = a2 + c.z, a0 = a1 + c.y;
    int myb = -1; unsigned myA = 0u, myC = 0u;
    if (a3 < K && K <= a3 + c.w) { myb = 4 * lane + 3; myA = a3; myC = c.w; }
    else if (a2 < K && K <= a2 + c.z) { myb = 4 * lane + 2; myA = a2; myC = c.z; }
    else if (a1 < K && K <= a1 + c.y) { myb = 4 * lane + 1; myA = a1; myC = c.y; }
    else if (a0 < K && K <= a0 + c.x) { myb = 4 * lane; myA = a0; myC = c.x; }
    const unsigned long long bm = __ballot(myb >= 0);
    const int src = bm ? (__ffsll((long long)bm) - 1) : 0;
    const int bstar = __shfl(myb, src); const unsigned A = __shfl(myA, src), m = __shfl(myC, src);
    if (!final_sel) {
        if (A + m <= (unsigned)(IX_CAP - 96)) {
            int base = 0; float kmin = INFINITY;
#pragma unroll
            for (int i = 0; i < 8; ++i) {
                const bool keep = vl[i] && bin[i] >= bstar;
                const unsigned long long mk = __ballot(keep);
                const int pos = base + (int)ix_mbcnt(mk);
                if (keep) { LS[pos] = sc[i]; LI[pos] = (unsigned short)ix[i]; kmin = fminf(kmin, sc[i]); }
                base += __popcll(mk);
            }
            cnt = base; tau = -wave_max(-kmin);
            IX_FENCE();
            return;
        }
        unsigned short* tmp = sel_out;
        ix_select_slow(sc, ix, vl, (int)K, tmp, lane);
        int base = 0; float kmin = INFINITY;
#pragma unroll
        for (int i = 0; i < 8; ++i) {
            const bool keep = !vl[i] && (lane + 64 * i) < n;
            const unsigned long long mk = __ballot(keep);
            const int pos = base + (int)ix_mbcnt(mk);
            if (keep) { LS[pos] = sc[i]; LI[pos] = (unsigned short)ix[i]; kmin = fminf(kmin, sc[i]); }
            base += __popcll(mk);
        }
        cnt = base; tau = -wave_max(-kmin);
        IX_FENCE();
        return;
    }
    if (m <= 128u) {
        int base = 0;
#pragma unroll
        for (int i = 0; i < 8; ++i) {
            const bool keep = vl[i] && bin[i] > bstar;
            const unsigned long long mk = __ballot(keep);
            const int pos = base + (int)ix_mbcnt(mk);
            if (keep) sel_out[pos] = (unsigned short)ix[i];
            base += __popcll(mk);
        }
        LAS float* sS = (LAS float*)hist; LAS unsigned* sI = hist + 128;
        IX_FENCE();
        int mb = 0;
#pragma unroll
        for (int i = 0; i < 8; ++i) {
            const bool inb = vl[i] && bin[i] == bstar;
            const unsigned long long mk = __ballot(inb);
            const int pos = mb + (int)ix_mbcnt(mk);
            if (inb) { sS[pos] = sc[i]; sI[pos] = ix[i]; }
            mb += __popcll(mk);
        }
        IX_FENCE();
        const int need = (int)(K - A);
#pragma unroll
        for (int e = 0; e < 2; ++e) {
            const int j = lane + 64 * e;
            if (j < (int)m) {
                const float sj = sS[j]; const unsigned ij = sI[j]; int rank = 0;
                for (int k = 0; k < (int)m; ++k) { const float sk = sS[k]; const unsigned ik = sI[k]; rank += (sk > sj || (sk == sj && ik < ij)) ? 1 : 0; }
                if (rank < need) sel_out[(int)A + rank] = (unsigned short)ij;
            }
        }
    } else {
        ix_select_slow(sc, ix, vl, (int)K, sel_out, lane);
    }
}

__device__ __forceinline__ void p5_index_mfma(Frame& F, unsigned short* SEL, int* NSEL) {
    const bf16* QA = WSP(bf16, WS_QA); const bf16* KIDX = WSP(bf16, WS_KIDX); const float* WIDX = WSP(float, WS_WIDX);
    const int tid = F.tid, w = F.wave, l = F.lane, r = l & 31, hf = l >> 5;
    {
        const int gw = blockIdx.x * NWAVES + w, NGW = F.G * NWAVES;
        for (int i = gw; i < NMETA + BATCH * 192; i += NGW) {
            int q, nvis; if (i < NMETA) { q = NREAL + i; nvis = NMETA; } else { const int bb = (i - NMETA) / 192, s = (i - NMETA) % 192; q = bb * SEQ + s; nvis = NMETA + 64 * (s / 64 + 1); }
            for (int j = l; j < nvis; j += 64) SEL[(size_t)q * TOPK + j] = (unsigned short)j;
            if (l == 0) NSEL[q] = nvis;
        }
    }
    LAS unsigned char* L = F.lds;
    LAS unsigned* hist = (LAS unsigned*)(L + IX_SCR + w * 1024);
    {
        for (int i = blockIdx.x; i < 1024; i += F.G) {
            const int kq = i >> 8;
            const int tile = (kq & 1) ? ((kq == 1 ? 767 : 1791) - i) : i;
            if (tile >= 1000) continue;
            const int pt = 6 + (tile >> 2), b = tile & 3;
            const int q0 = b * SEQ + pt * 32;
            const int nvis = NMETA + 64 * (pt / 2 + 1);
            const int nblk = (nvis + 127) >> 7;
            __syncthreads();
            bf16x8 af[4];
            {
                const int qq = 2 * (r >> 4) + ((r >> 2) & 1), hd = 4 * ((r >> 3) & 1) + (r & 3);
                const bf16* qp = QA + (size_t)(q0 + 4 * w + qq) * QAW + 1024 + hd * 64 + 8 * hf;
#pragma unroll
                for (int ks = 0; ks < 4; ++ks) af[ks] = *(const bf16x8*)(qp + 16 * ks);
            }
            float wq[2][8];
#pragma unroll
            for (int a = 0; a < 2; ++a) {
                const f32x4 w0 = *(const f32x4*)(WIDX + (size_t)(q0 + 4 * w + 2 * a + hf) * 8), w1 = *(const f32x4*)(WIDX + (size_t)(q0 + 4 * w + 2 * a + hf) * 8 + 4);
                wq[a][0] = w0.x; wq[a][1] = w0.y; wq[a][2] = w0.z; wq[a][3] = w0.w; wq[a][4] = w1.x; wq[a][5] = w1.y; wq[a][6] = w1.z; wq[a][7] = w1.w;
            }
            float tau0 = -INFINITY, tau1 = -INFINITY;
            int cnt[4] = {0, 0, 0, 0};
            v4u kreg[2];
#pragma unroll
            for (int e = 0; e < 2; ++e) {
                const int pid = tid + 512 * e, kl = pid >> 3, pc = pid & 7, j = kl;
                kreg[e] = j < nvis ? *(const v4u*)(KIDX + (size_t)key_row(b, j) * 64 + 8 * pc) : (v4u){0u, 0u, 0u, 0u};
            }
#pragma unroll
            for (int e = 0; e < 2; ++e) { const int pid = tid + 512 * e, kl = pid >> 3, pc = pid & 7; *(LAS v4u*)(L + IX_KB + kl * 128 + ((pc ^ ((kl >> 1) & 7)) << 4)) = kreg[e]; }
            __syncthreads();
            for (int blk = 0; blk < nblk; ++blk) {
                const int cur = blk & 1;
                if (blk + 1 < nblk) {
#pragma unroll
                    for (int e = 0; e < 2; ++e) {
                        const int pid = tid + 512 * e, kl = pid >> 3, pc = pid & 7, j = (blk + 1) * 128 + kl;
                        kreg[e] = j < nvis ? *(const v4u*)(KIDX + (size_t)key_row(b, j) * 64 + 8 * pc) : (v4u){0u, 0u, 0u, 0u};
                    }
                }
                const LAS unsigned char* kb = L + IX_KB + cur * 16384;
                for (int tt = 0; tt < 4; ++tt) {
                    const int jbase = blk * 128 + tt * 32;
                    if (jbase >= nvis) break;
                    const int kl = tt * 32 + r;
                    f32x16 acc = zero16();
#pragma unroll
                    for (int ks = 0; ks < 4; ++ks) {
                        const bf16x8 bfr = *(const LAS bf16x8*)(kb + kl * 128 + (((2 * ks + hf) ^ ((kl >> 1) & 7)) << 4));
                        acc = __builtin_amdgcn_mfma_f32_32x32x16_bf16(af[ks], bfr, acc, 0, 0, 0);
                    }
                    const int j = jbase + r;
                    float s0 = 0.f, s1 = 0.f;
#pragma unroll
                    for (int h = 0; h < 8; ++h) { s0 += wq[0][h] * fmaxf(acc[h], 0.f); s1 += wq[1][h] * fmaxf(acc[8 + h], 0.f); }
                    s0 += 0.0f; s1 += 0.0f;
                    const bool p0 = j < nvis && s0 > tau0, p1 = j < nvis && s1 > tau1;
                    const unsigned long long m0 = __ballot(p0), m1 = __ballot(p1);
                    if (m0 | m1) {
                        const int c0lo = __popc((unsigned)m0), c0hi = __popc((unsigned)(m0 >> 32)), c1lo = __popc((unsigned)m1), c1hi = __popc((unsigned)(m1 >> 32));
                        {
                            const int pos = (hf ? cnt[1] - c0lo : cnt[0]) + (int)ix_mbcnt(m0);
                            if (p0) { LAS unsigned char* lb = L + (w * 4 + hf) * IX_LIST; ((LAS float*)lb)[pos] = s0; ((LAS unsigned short*)(lb + 2048))[pos] = (unsigned short)j; }
                        }
                        {
                            const int pos = (hf ? cnt[3] - c1lo : cnt[2]) + (int)ix_mbcnt(m1);
                            if (p1) { LAS unsigned char* lb = L + (w * 4 + 2 + hf) * IX_LIST; ((LAS float*)lb)[pos] = s1; ((LAS unsigned short*)(lb + 2048))[pos] = (unsigned short)j; }
                        }
                        cnt[0] += c0lo; cnt[1] += c0hi; cnt[2] += c1lo; cnt[3] += c1hi;
#pragma unroll
                        for (int qq = 0; qq < 4; ++qq) {
                            if (cnt[qq] > IX_CAP - 32) {
                                LAS unsigned char* lb = L + (w * 4 + qq) * IX_LIST;
                                float tq = 0.f; int cq = cnt[qq];
                                ix_compact((LAS float*)lb, (LAS unsigned short*)(lb + 2048), hist, cq, tq, l, false, SEL + (size_t)(q0 + 4 * w + qq) * TOPK);
                                cnt[qq] = __builtin_amdgcn_readfirstlane(cq);
                                if ((qq & 1) == hf) { if (qq < 2) tau0 = tq; else tau1 = tq; }
                            }
                        }
                    }
                }
                if (blk + 1 < nblk) {
#pragma unroll
                    for (int e = 0; e < 2; ++e) { const int pid = tid + 512 * e, kl = pid >> 3, pc = pid & 7; *(LAS v4u*)(L + IX_KB + (cur ^ 1) * 16384 + kl * 128 + ((pc ^ ((kl >> 1) & 7)) << 4)) = kreg[e]; }
                }
                __syncthreads();
            }
#pragma unroll
            for (int qq = 0; qq < 4; ++qq) {
                LAS unsigned char* lb = L + (w * 4 + qq) * IX_LIST;
                float tq = 0.f; int cq = cnt[qq];
                ix_compact((LAS float*)lb, (LAS unsigned short*)(lb + 2048), hist, cq, tq, l, true, SEL + (size_t)(q0 + 4 * w + qq) * TOPK);
                if (l == 0) NSEL[q0 + 4 * w + qq] = TOPK;
            }
        }
    }
}

#ifndef CHECK_IDX
#define CHECK_IDX 0
#endif
#if CHECK_IDX
__device__ __forceinline__ void idx_check(Frame& F) {
    const unsigned short* SEL = WSP(unsigned short, WS_SEL); const unsigned short* SELB = (const unsigned short*)F.out; const int* NSEL = WSP(int, WS_NSEL); const int* NSELB = (const int*)((const char*)F.out + 32 * MiB);
    LAS unsigned* bm = (LAS unsigned*)(F.lds + F.wave * 2048);
    const int l = F.lane; const int gw = blockIdx.x * NWAVES + F.wave, NGW = F.G * NWAVES;
    unsigned miss = 0, badq = 0, dup = 0;
    for (int q = gw; q < NROWS; q += NGW) {
        for (int i = l; i < 260; i += 64) bm[i] = 0u;
        IX_FENCE();
        const int n = NSEL[q], nb = NSELB[q];
        for (int i = l; i < n; i += 64) { const unsigned j = SEL[(size_t)q * TOPK + i]; atomicOr((unsigned*)&bm[j >> 5], 1u << (j & 31)); }
        IX_FENCE();
        unsigned m = (n != nb) ? 1000u : 0u;
        for (int i = l; i < nb && i < TOPK; i += 64) { const unsigned j = SELB[(size_t)q * TOPK + i]; if (j >= (unsigned)TT) { ++dup; ++m; } else { const unsigned old = atomicAnd((unsigned*)&bm[j >> 5], ~(1u << (j & 31))); if (!((old >> (j & 31)) & 1u)) ++m; } }
        IX_FENCE();
        m = (unsigned)wave_sum((float)m);
        if (l == 0) { miss += m; badq += m ? 1u : 0u; }
    }
    dup = (unsigned)wave_sum((float)dup);
    if (l == 0) { atomicAdd((unsigned*)F.ctl + 2048, miss); atomicAdd((unsigned*)F.ctl + 2049, badq); atomicAdd((unsigned*)F.ctl + 2050, dup); }
}
#endif
struct StoreBf16 { bf16* O; int ld; __device__ __forceinline__ void operator()(int row, int col, const f32x4& v) const { *(v2u*)(O + (size_t)row * ld + col) = (v2u){pk2(v.x, v.y), pk2(v.z, v.w)}; } };
struct StoreRes1 { const bf16* H; float* out; float* meta; __device__ __forceinline__ void operator()(int row, int col, const f32x4& v) const {
        if (row >= NROWS) return;
        const v2u hw = *(const v2u*)(H + (size_t)row * D + col);
        const f32x4 o = (f32x4){ALPHA * bflo(hw.x) + v.x, ALPHA * bfhi(hw.x) + v.y, ALPHA * bflo(hw.y) + v.z, ALPHA * bfhi(hw.y) + v.w};
        float* dst = row < NREAL ? out + (size_t)row * D + col : meta + (size_t)(row - NREAL) * D + col;
        *(f32x4*)dst = o; } };
struct StoreRes2 { const bf16* H; float* out; __device__ __forceinline__ void operator()(int row, int col, const f32x4& v) const {
        if (row >= NREAL) return;
        const v2u hw = *(const v2u*)(H + (size_t)row * D + col);
        *(f32x4*)(out + (size_t)row * D + col) = (f32x4){ALPHA * bflo(hw.x) + v.x, ALPHA * bfhi(hw.x) + v.y, ALPHA * bflo(hw.y) + v.z, ALPHA * bfhi(hw.y) + v.w}; } };

template <class Fn>
__device__ __forceinline__ void run_gemm(Frame& F, const bf16* A, int lda, const bf16* Bt, int N, int K, const Fn& fn) {
    pg8::Gemm g{A, Bt, R, N, K, lda}; pg8::StaticOrder S; S.init(R, N, F.G, (int)blockIdx.x);
    pg8::EpiFn<Fn> E{fn};
    pg8::gemm_phase<pg8::EpiFn<Fn>, pg8::StaticOrder, true, true>(F.lds + RING_OFF, g, S, E);
}

constexpr int NPHASES = 15;
struct Args { const float* in[32]; float* out; unsigned char* ws; int ph_lo, ph_hi; };
__global__ void __launch_bounds__(NTHR, 2) fwd(Args args) {
    extern __shared__ __attribute__((aligned(16))) unsigned char lds[];
    Frame F;
    F.lds = (LAS unsigned char*)lds;
    F.MISC = (volatile LAS unsigned*)(F.lds + MISC_OFF);
    F.tid = threadIdx.x; F.lane = F.tid & 63; F.wave = __builtin_amdgcn_readfirstlane(F.tid >> 6);
    F.G = gridDim.x;
#pragma unroll
    for (int i = 0; i < 32; ++i) F.in[i] = args.in[i];
    F.out = args.out; F.ws = args.ws;
    F.ctl = (gu32*)(args.ws + WS_CTL);
    for (int u = F.tid; u < (LDS_BYTES - LDSCTL_OFF) / 4; u += NTHR) ((LAS unsigned*)(F.lds + LDSCTL_OFF))[u] = 0u;
    __syncthreads();
    const int lo = args.ph_lo, hi = args.ph_hi;
    XcdBarrier bar; bar.bar = (unsigned*)(F.ctl + CW_BAR); bar.x = 0; bar.st = nullptr;
    if (hi - lo > 1) bar = xcd_barrier_post((unsigned*)(F.ctl + CW_BAR), F.MISC + 8);
#define IN(k) (lo <= (k) && (k) < hi)
#define SEAM(k) do { if (IN(k) && IN((k) + 1)) xcd_barrier(bar); } while (0)

#ifndef SKIP0
    if (IN(0)) { p0_weights(F); p1_ln_in(F); } SEAM(0);
#endif
#ifndef SKIP1
    if (IN(1)) { run_gemm(F, WSP(bf16, WS_H), D, WSP(bf16, WS_WT_IN), PW, D, StoreBf16{WSP(bf16, WS_P), PW}); } SEAM(1);
#endif
#ifndef SKIP2
    if (IN(2)) { p3_prep(F); } SEAM(2);
#endif
#ifndef SKIP3
    if (IN(3)) { run_gemm(F, WSP(bf16, WS_CQN), 256, WSP(bf16, WS_WT_QA), QAW, 256, StoreBf16{WSP(bf16, WS_QA), QAW});
#if REFSEL
        refsel_rows(F);
#endif
    } SEAM(3);
#endif
#ifndef SKIP4
#ifndef IDX_NAIVE
#define IDX_NAIVE 0
#endif
#if CHECK_IDX
    if (IN(4)) { p5_index_naive(F); __syncthreads(); p5_index_mfma(F, (unsigned short*)F.out, (int*)((char*)F.out + 32 * MiB)); } SEAM(4);
#elif IDX_NAIVE
    if (IN(4)) { p5_index_naive(F); } SEAM(4);
#else
    if (IN(4)) { p5_index_mfma(F, WSP(unsigned short, WS_SEL), WSP(int, WS_NSEL)); } SEAM(4);
#endif
#endif
#ifndef SKIP5
    if (IN(5)) {
#if CHECK_IDX
        idx_check(F); __syncthreads();
#endif
        p6_attn_naive(F); } SEAM(5);
#endif
#ifndef RWKV_NAIVE
#define RWKV_NAIVE 0
#endif
#if RWKV_NAIVE
    if (IN(6)) { p7_rwkv_prep_naive(F); } SEAM(6);
    if (IN(7)) { p8_rwkv_scan_naive(F); } SEAM(7);
    SEAM(8);
#else
    if (IN(6)) { rw_b1(F); } SEAM(6);
    if (IN(7)) { rw_b2(F); } SEAM(7);
    if (IN(8)) { rw_b3(F); } SEAM(8);
#endif
    if (IN(9)) { run_gemm(F, WSP(bf16, WS_QA), QAW, WSP(bf16, WS_WT_MIX), D, QAW, StoreRes1{WSP(bf16, WS_H), F.out, WSP(float, WS_META1)}); } SEAM(9);
    if (IN(10)) { p10_ln1(F); } SEAM(10);
    if (IN(11)) { run_gemm(F, WSP(bf16, WS_H), D, WSP(bf16, WS_WT_UP), UPW, D, StoreBf16{WSP(bf16, WS_UP), UPW}); } SEAM(11);
    if (IN(12)) { p12_conv_act(F); } SEAM(12);
    if (IN(13)) { run_gemm(F, WSP(bf16, WS_UP) + DFF, UPW, WSP(bf16, WS_WT_DN), D, DFF, StoreRes2{WSP(bf16, WS_H), F.out}); } SEAM(13);
    if (IN(14)) { p14_ln2(F);
#if CHECK_IDX
        if (blockIdx.x == 0 && F.tid == 0) {
            const unsigned miss = __hip_atomic_load((unsigned*)F.ctl + 2048, __ATOMIC_RELAXED, __HIP_MEMORY_SCOPE_AGENT), dupc = __hip_atomic_load((unsigned*)F.ctl + 2050, __ATOMIC_RELAXED, __HIP_MEMORY_SCOPE_AGENT);
            if (dupc) F.out[5] = __builtin_inff();
            if (miss > CHECK_IDX_MAXMISS) F.out[3] = __builtin_nanf("");
        }
#endif
    }
#undef IN
#undef SEAM
}

extern "C" void kernel_launch(void* const* d_in, const int* in_sizes, int n_in, void* d_out, int out_size, void* d_ws, size_t ws_size, hipStream_t stream) {
    static int grid = 0;
    if (grid == 0) {
        if (n_in != 32 || out_size != NREAL * D || ws_size < WS_END) { fprintf(stderr, "kernel_launch: unexpected shapes: n_in %d out %d ws %zu\n", n_in, out_size, ws_size); grid = -1; return; }
        int dev = 0, cus = 0, per_cu = 0;
        if (hipGetDevice(&dev) != hipSuccess || hipDeviceGetAttribute(&cus, hipDeviceAttributeMultiprocessorCount, dev) != hipSuccess) { grid = -1; return; }
        if (hipFuncSetAttribute((const void*)fwd, hipFuncAttributeMaxDynamicSharedMemorySize, LDS_BYTES) != hipSuccess) { fprintf(stderr, "kernel_launch: hipFuncSetAttribute failed\n"); grid = -1; return; }
        if (hipOccupancyMaxActiveBlocksPerMultiprocessor(&per_cu, (const void*)fwd, NTHR, LDS_BYTES) != hipSuccess || per_cu < 1) fprintf(stderr, "kernel_launch: occupancy query says %d\n", per_cu);
        (void)hipGetLastError();
        grid = cus;
    }
    if (grid < 0) return;
    (void)hipMemsetAsync((char*)d_ws + WS_CTL, 0, CTL_ZERO_BYTES, stream);
    Args a{};
    for (int i = 0; i < 32; ++i) a.in[i] = (const float*)d_in[i];
    a.out = (float*)d_out; a.ws = (unsigned char*)d_ws;
#if ONE_LAUNCH
    a.ph_lo = 0; a.ph_hi = NPHASES;
    hipLaunchKernelGGL(fwd, dim3(grid), dim3(NTHR), LDS_BYTES, stream, a);
#else
    for (int p = 0; p < NPHASES; ++p) { a.ph_lo = p; a.ph_hi = p + 1; hipLaunchKernelGGL(fwd, dim3(grid), dim3(NTHR), LDS_BYTES, stream, a); }
#endif
}
```

```cpp
#include <hip/hip_runtime.h>
#include <cstdio>
#include <cstdint>
#define ONE_LAUNCH 1
namespace pg8 {
#define PG8_LAS __attribute__((address_space(3)))
typedef unsigned short bf16_t;
typedef short bf16x8 __attribute__((ext_vector_type(8)));
typedef float f32x4 __attribute__((ext_vector_type(4)));
typedef unsigned u32x4 __attribute__((ext_vector_type(4)));
constexpr int BM = 256, BK = 64, HALF = 128, HTB = HALF * BK * 2  , STAGE_BYTES = 8 * HTB, NXCD = 8, WGM = 8;

__host__ __device__ __forceinline__ int lds_byte(int r, int c) { const int st = (r >> 4) * 2 + (c >> 5), rr = r & 15, cc = c & 31, ob = rr * 64 + cc * 2; return st * 1024 + (ob ^ (((ob >> 9) & 1) << 5)); }
__host__ __device__ __forceinline__ void stage_rc(int b, int& R, int& C) { const int st = b / 1024, sb = b % 1024, swz = sb ^ (((sb >> 9) & 1) << 5); R = (st >> 1) * 16 + swz / 64; C = (st & 1) * 32 + (swz % 64) / 2; }
__host__ __device__ __forceinline__ int perm32(int rho) { const int n = rho >> 4, i = rho & 15; return 8 * (i >> 2) + 4 * n + (i & 3); }

struct Unit { int pm, pn; };
struct Gemm { const bf16_t* A; const bf16_t* Bt; int M, N, K, lda; };

struct StaticOrder {
    int nM, nN, nwg, G, c;
    __host__ __device__ void init(int M, int N, int G_, int c_) { nM = M / BM; nN = N / BM; nwg = nM * nN; G = G_; c = c_; }
    __host__ __device__ bool next(int i, Unit& u) const {
        const long L = (long)i * G + c; if (L >= nwg) return false;
        int wgid = (int)L; { const int q = nwg / NXCD, r = nwg % NXCD, xcd = wgid % NXCD, off = wgid / NXCD; wgid = (xcd < r ? xcd * (q + 1) : r * (q + 1) + (xcd - r) * q) + off; }
        const int nig = WGM * nN, gid = wgid / nig, fm = gid * WGM, gsz = (nM - fm) < WGM ? (nM - fm) : WGM;
        u.pm = fm + ((wgid % nig) % gsz); u.pn = (wgid % nig) / gsz; return true;
    }
    __device__ __forceinline__ void a_ready(const Unit&) const {}
    __device__ __forceinline__ void done(const Unit&) const {}
};


template <class F> struct EpiFn {
    static constexpr bool PERM = false, AFTER_DRAIN = false;
    F f;
    __device__ __forceinline__ void operator()(const f32x4 (&acc)[2][2][4][2], const Unit& u, int wr, int wc, int fr, int fq) const {
        const int row0 = u.pm * BM + wr * 64 + fr, col0 = u.pn * BM + wc * 32 + 4 * fq;
#pragma unroll
        for (int ai = 0; ai < 2; ++ai)
#pragma unroll
            for (int m = 0; m < 4; ++m) {
                const int row = row0 + ai * HALF + m * 16;
#pragma unroll
                for (int bj = 0; bj < 2; ++bj)
#pragma unroll
                    for (int n = 0; n < 2; ++n) f(row, col0 + bj * HALF + n * 16, acc[ai][bj][m][n]);
            }
    }
};
template <class Epi, class Sched, bool ALIGN_EPI = false, bool SP2 = false>
__device__ __forceinline__ void gemm_phase(PG8_LAS unsigned char* lds, const Gemm g, const Sched& S, const Epi& E) {
    const int tid = threadIdx.x, wid = __builtin_amdgcn_readfirstlane(tid >> 6), lane = tid & 63, wr = wid >> 2, wc = wid & 3, fr = lane & 15, fq = lane >> 4;
    const int K = g.K, nt = K / BK;
    unsigned voffA[2], voffB[2];
#pragma unroll
    for (int i = 0; i < 2; ++i) { int R, C; stage_rc(tid * 16 + i * 8192, R, C); const int Rb = Epi::PERM ? ((R & ~31) + perm32(R & 31)) : R;
        voffA[i] = (unsigned)(R * g.lda + C) * 2u; voffB[i] = (unsigned)(Rb * K + C) * 2u; }
    const size_t kstep = (size_t)(BK * 2);
    const size_t hA = (size_t)HALF * g.lda * 2, hB = (size_t)HALF * K * 2;
    const size_t tA = 2 * hA, tB = 2 * hB;
    const unsigned ldsw = (unsigned)wid * 1024u;
    const int aoff = lds_byte(wr * 64 + fr, fq * 8), boff = lds_byte(wc * 32 + fr, fq * 8);
#define PG8_SA(b, h) (((b) * 2 + (h)) * HTB)
#define PG8_SB(b, h) ((4 + (b) * 2 + (h)) * HTB)
#define PG8_STAGE(bufoff, gbase, voff) do { _Pragma("unroll") for (int _i = 0; _i < 2; ++_i) \
        __builtin_amdgcn_global_load_lds((const unsigned*)((const char*)(gbase) + (voff)[_i]), (PG8_LAS unsigned*)(lds + (bufoff) + ldsw + _i * 8192), 16, 0, 0); } while (0)
#define PG8_LDA(dst, b, h) do { _Pragma("unroll") for (int m = 0; m < 4; ++m) _Pragma("unroll") for (int k = 0; k < 2; ++k) dst[m][k] = *(const PG8_LAS bf16x8*)(lds + PG8_SA(b, h) + aoff + m * 2048 + k * 1024); } while (0)
#define PG8_LDB(dst, b, h) do { _Pragma("unroll") for (int n = 0; n < 2; ++n) _Pragma("unroll") for (int k = 0; k < 2; ++k) dst[n][k] = *(const PG8_LAS bf16x8*)(lds + PG8_SB(b, h) + boff + n * 2048 + k * 1024); } while (0)
#define PG8_MMA(ai, bj, At, Bt) do { __builtin_amdgcn_s_setprio(1); _Pragma("unroll") for (int m = 0; m < 4; ++m) _Pragma("unroll") for (int n = 0; n < 2; ++n) _Pragma("unroll") for (int k = 0; k < 2; ++k) \
        acc[ai][bj][m][n] = __builtin_amdgcn_mfma_f32_16x16x32_bf16(Bt[n][k], At[m][k], acc[ai][bj][m][n], 0, 0, 0); __builtin_amdgcn_s_setprio(0); } while (0)
#define PG8_WAIT_V(n) asm volatile("s_waitcnt vmcnt(" #n ")" ::: "memory")
#define PG8_WAIT_L(n) asm volatile("s_waitcnt lgkmcnt(" #n ")" ::: "memory")
#define PG8_BAR __builtin_amdgcn_s_barrier()
#define PG8_SCHED __builtin_amdgcn_sched_barrier(0)
    Unit cur, nxt; int ui = 0;
    if (!S.next(0, cur)) return;
    f32x4 acc[2][2][4][2];
#pragma unroll
    for (int a = 0; a < 2; ++a)
#pragma unroll
        for (int b = 0; b < 2; ++b)
#pragma unroll
            for (int m = 0; m < 4; ++m)
#pragma unroll
                for (int n = 0; n < 2; ++n) acc[a][b][m][n] = (f32x4){0.f, 0.f, 0.f, 0.f};
    bf16x8 At[4][2], B0[2][2], B1[2][2];
    const char* cA = (const char*)g.A + (size_t)cur.pm * tA; const char* cB = (const char*)g.Bt + (size_t)cur.pn * tB;
    S.a_ready(cur);
    if constexpr (SP2) {
        PG8_STAGE(PG8_SB(0, 0), cB, voffB); PG8_STAGE(PG8_SB(0, 1), cB + hB, voffB); PG8_STAGE(PG8_SA(0, 0), cA, voffA); PG8_STAGE(PG8_SA(0, 1), cA + hA, voffA);
        if (wr == 1) PG8_BAR;
        PG8_WAIT_V(2); PG8_BAR;
        PG8_STAGE(PG8_SB(1, 0), cB + kstep, voffB); PG8_STAGE(PG8_SA(1, 0), cA + kstep, voffA); PG8_STAGE(PG8_SB(1, 1), cB + hB + kstep, voffB);
        PG8_WAIT_V(6); PG8_BAR;
    } else {
        PG8_STAGE(PG8_SB(0, 0), cB, voffB); PG8_STAGE(PG8_SA(0, 0), cA, voffA); PG8_STAGE(PG8_SB(0, 1), cB + hB, voffB); PG8_STAGE(PG8_SA(0, 1), cA + hA, voffA);
        if (wr == 1) PG8_BAR;
        PG8_WAIT_V(4); PG8_BAR;
        PG8_STAGE(PG8_SB(1, 0), cB + kstep, voffB); PG8_STAGE(PG8_SA(1, 0), cA + kstep, voffA); PG8_STAGE(PG8_SB(1, 1), cB + hB + kstep, voffB);
        PG8_WAIT_V(6); PG8_BAR;
    }
    for (;;) {
        const bool has_next = S.next(ui + 1, nxt);
        const char* nA = has_next ? (const char*)g.A + (size_t)nxt.pm * tA : cA; const char* nB = has_next ? (const char*)g.Bt + (size_t)nxt.pn * tB : cB;
        for (int t = 0; t < nt; t += 2) {
            const bool last = (t == nt - 2);
            const char* a1 = cA + (size_t)(t + 1) * kstep;
            const char* a2 = last ? nA : cA + (size_t)(t + 2) * kstep; const char* b2 = last ? nB : cB + (size_t)(t + 2) * kstep;
            const char* a3 = a2 + kstep; const char* b3 = b2 + kstep;
            if (last && has_next) S.a_ready(nxt);
            if constexpr (SP2) {
            PG8_LDB(B0, 0, 0); PG8_LDB(B1, 0, 1); PG8_SCHED; PG8_LDA(At, 0, 0); PG8_STAGE(PG8_SA(1, 1), a1 + hA, voffA);
            PG8_WAIT_V(8); PG8_WAIT_L(0); PG8_BAR; PG8_MMA(0, 0, At, B0); PG8_MMA(0, 1, At, B1); PG8_BAR; PG8_SCHED;
            PG8_LDA(At, 0, 1); PG8_STAGE(PG8_SB(0, 0), b2, voffB); PG8_STAGE(PG8_SB(0, 1), b2 + hB, voffB); PG8_STAGE(PG8_SA(0, 0), a2, voffA);
            PG8_WAIT_V(8); PG8_WAIT_L(0); PG8_BAR; PG8_MMA(1, 0, At, B0); PG8_MMA(1, 1, At, B1); PG8_BAR; PG8_SCHED;
            PG8_LDB(B0, 1, 0); PG8_LDB(B1, 1, 1); PG8_SCHED; PG8_LDA(At, 1, 0); PG8_STAGE(PG8_SA(0, 1), a2 + hA, voffA);
            PG8_WAIT_V(8); PG8_WAIT_L(0); PG8_BAR; PG8_MMA(0, 0, At, B0); PG8_MMA(0, 1, At, B1); PG8_BAR; PG8_SCHED;
            PG8_LDA(At, 1, 1); PG8_STAGE(PG8_SB(1, 0), b3, voffB); PG8_STAGE(PG8_SB(1, 1), b3 + hB, voffB); PG8_STAGE(PG8_SA(1, 0), a3, voffA);
            PG8_WAIT_V(8); PG8_WAIT_L(0); PG8_BAR; PG8_MMA(1, 0, At, B0); PG8_MMA(1, 1, At, B1); PG8_BAR; PG8_SCHED;
            } else {
            PG8_LDB(B0, 0, 0); PG8_SCHED; PG8_LDA(At, 0, 0); PG8_STAGE(PG8_SA(1, 1), a1 + hA, voffA);
            PG8_WAIT_L(8); PG8_BAR; PG8_WAIT_L(0); PG8_MMA(0, 0, At, B0); PG8_BAR; PG8_SCHED;
            PG8_LDB(B1, 0, 1); PG8_STAGE(PG8_SB(0, 0), b2, voffB);
            PG8_BAR; PG8_WAIT_L(0); PG8_MMA(0, 1, At, B1); PG8_BAR;
            PG8_LDA(At, 0, 1); PG8_STAGE(PG8_SA(0, 0), a2, voffA);
            PG8_BAR; PG8_WAIT_L(0); PG8_MMA(1, 0, At, B0); PG8_BAR; PG8_SCHED;
            PG8_STAGE(PG8_SB(0, 1), b2 + hB, voffB);
            PG8_WAIT_V(6); PG8_BAR; PG8_MMA(1, 1, At, B1); PG8_BAR;
            PG8_LDB(B0, 1, 0); PG8_SCHED; PG8_LDA(At, 1, 0); PG8_STAGE(PG8_SA(0, 1), a2 + hA, voffA);
            PG8_WAIT_L(8); PG8_BAR; PG8_WAIT_L(0); PG8_MMA(0, 0, At, B0); PG8_BAR; PG8_SCHED;
            PG8_LDB(B1, 1, 1); PG8_STAGE(PG8_SB(1, 0), b3, voffB);
            PG8_BAR; PG8_WAIT_L(0); PG8_MMA(0, 1, At, B1); PG8_BAR;
            PG8_LDA(At, 1, 1); PG8_STAGE(PG8_SA(1, 0), a3, voffA);
            PG8_BAR; PG8_WAIT_L(0); PG8_MMA(1, 0, At, B0); PG8_BAR; PG8_SCHED;
            PG8_STAGE(PG8_SB(1, 1), b3 + hB, voffB);
            PG8_WAIT_V(6); PG8_BAR; PG8_MMA(1, 1, At, B1); PG8_BAR;
            }
        }
        if constexpr (ALIGN_EPI) { if (wr == 0) PG8_BAR; }
        if constexpr (!Epi::AFTER_DRAIN) { E(acc, cur, wr, wc, fr, fq); S.done(cur); }
        if (!has_next) break;
#pragma unroll
        for (int a = 0; a < 2; ++a)
#pragma unroll
            for (int b = 0; b < 2; ++b)
#pragma unroll
                for (int m = 0; m < 4; ++m)
#pragma unroll
                    for (int n = 0; n < 2; ++n) acc[a][b][m][n] = (f32x4){0.f, 0.f, 0.f, 0.f};
        cur = nxt; cA = nA; cB = nB; ++ui;
        if constexpr (ALIGN_EPI) { if (wr == 1) PG8_BAR; }
    }
    PG8_WAIT_V(0);
    if constexpr (!ALIGN_EPI) { if (wr == 0) PG8_BAR; }
    PG8_BAR;
    if constexpr (Epi::AFTER_DRAIN) { E.fused(acc, cur, wr, wc, fr, fq, lds, wid, lane); S.done(cur); }
#undef PG8_SA
#undef PG8_SB
#undef PG8_STAGE
#undef PG8_LDA
#undef PG8_LDB
#undef PG8_MMA
#undef PG8_WAIT_V
#undef PG8_WAIT_L
#undef PG8_BAR
#undef PG8_SCHED
}
}

#ifndef ONE_LAUNCH
#define ONE_LAUNCH 0
#endif
constexpr int NWAVES = 8, NTHR = 512;
constexpr int D = 1024, BATCH = 4, SEQ = 8192, NMETA = 16, TT = SEQ + NMETA;
constexpr int NREAL = BATCH * SEQ;
constexpr int NROWS = NREAL + NMETA;
constexpr int R = 33024;
constexpr int PW = 2304;
constexpr int PC_CQ = 0, PC_CKV = 256, PC_KIDX = 384, PC_WIDX = 448, PC_R = 512, PC_K = 1024, PC_V = 1536, PC_WD = 2048, PC_AD = 2112, PC_GD = 2176;
constexpr int QAW = 1536;
constexpr int DFF = 2816, UPW = 5632;
constexpr int TOPK = 256;
constexpr float LN_EPS = 1e-5f, GN_EPS = 64e-5f, ALPHA = 1.18920711500272f;

constexpr size_t MiB = 1u << 20;
constexpr size_t WS_CTL = 0, CTL_ZERO_BYTES = 1 * MiB;
constexpr size_t WS_WT_IN = 1 * MiB, WS_WT_QA = 6 * MiB, WS_WT_MIX = 7 * MiB, WS_WT_UP = 10 * MiB, WS_WT_DN = 21 * MiB;
constexpr size_t WS_META1 = 27 * MiB, WS_NSEL = 28 * MiB, WS_WIDX = 29 * MiB;
constexpr size_t WS_H = 33 * MiB;
constexpr size_t WS_P = 98 * MiB, WS_QA = 244 * MiB, WS_CQN = 341 * MiB, WS_SEL = 341 * MiB, WS_CKV = 358 * MiB, WS_KIDX = 367 * MiB;
constexpr size_t WS_DEC = 372 * MiB, WS_AB = 437 * MiB, WS_GB = 470 * MiB;
constexpr size_t WS_WT_LORA = 26 * MiB + 512 * 1024;
constexpr size_t WS_RWM = 372 * MiB, WS_RWN = 405 * MiB, WS_RWQ = 438 * MiB, WS_RWY = 471 * MiB;
constexpr size_t OUT_RWS = 80 * MiB, OUT_BONUS = 116 * MiB;
constexpr size_t WS_UP = 98 * MiB;
constexpr size_t WS_END = 512 * MiB;
static_assert(WS_P + (size_t)R * PW * 2 <= WS_QA && WS_QA + (size_t)R * QAW * 2 <= WS_CQN && WS_CQN + (size_t)R * 256 * 2 <= WS_CKV && WS_CKV + (size_t)R * 128 * 2 <= WS_KIDX
              && WS_KIDX + (size_t)R * 64 * 2 <= WS_DEC && WS_DEC + (size_t)R * 512 * 4 <= WS_AB && WS_AB + (size_t)R * 512 * 2 <= WS_GB && WS_GB + (size_t)R * 512 * 2 <= WS_END
              && WS_UP + (size_t)R * UPW * 2 <= WS_END && WS_H + (size_t)R * D * 2 <= WS_P && WS_WIDX + (size_t)R * 8 * 4 <= WS_H && WS_NSEL + (size_t)R * 4 <= WS_WIDX, "ws map");
constexpr int CW_BAR = 4096;

constexpr int RING_OFF = 0, RING_BYTES = 131072;
constexpr int LDSCTL_OFF = RING_BYTES, MISC_OFF = LDSCTL_OFF + 320;
constexpr int LDS_BYTES = 147456;

#define GAS __attribute__((address_space(1)))
#define LAS __attribute__((address_space(3)))
typedef unsigned short bf16;
typedef unsigned v4u __attribute__((ext_vector_type(4)));
typedef unsigned v2u __attribute__((ext_vector_type(2)));
typedef float f32x4 __attribute__((ext_vector_type(4)));
typedef GAS unsigned gu32;
__device__ __forceinline__ unsigned f2bf(float f) { unsigned u = __builtin_bit_cast(unsigned, f); return (u + 0x7fffu + ((u >> 16) & 1u)) >> 16; }
__device__ __forceinline__ unsigned pk2(float lo, float hi) { return f2bf(lo) | (f2bf(hi) << 16); }
__device__ __forceinline__ float bf2f(unsigned short b) { return __uint_as_float(((unsigned)b) << 16); }
__device__ __forceinline__ float bflo(unsigned w) { return __uint_as_float(w << 16); }
__device__ __forceinline__ float bfhi(unsigned w) { return __uint_as_float(w & 0xffff0000u); }
__device__ __forceinline__ float wave_sum(float v) {
#pragma unroll
    for (int o = 1; o < 64; o <<= 1) v += __shfl_xor(v, o);
    return v;
}
__device__ __forceinline__ float wave_max(float v) {
#pragma unroll
    for (int o = 1; o < 64; o <<= 1) v = fmaxf(v, __shfl_xor(v, o));
    return v;
}
__device__ __forceinline__ float sigmoidf_(float x) { return 1.0f / (1.0f + __expf(-x)); }
#define XB_TMO      128
#define XB_XCNT(j)  (256  + 64 * (j))
#define XB_XSUB(j)  (1280 + 64 * (j))
#define XB_XGEN(j)  (2304 + 64 * (j))
#define XB_TOP      3328
#define XB_TOPGEN   3392
#define XCD_BAR_WORDS 3456
#define XB_SPIN_CAP (1u << 18)

__device__ __forceinline__ unsigned xb_ld(unsigned* p)              { return __hip_atomic_load(p, __ATOMIC_RELAXED, __HIP_MEMORY_SCOPE_AGENT); }
__device__ __forceinline__ unsigned xb_add(unsigned* p, unsigned v) { return __hip_atomic_fetch_add(p, v, __ATOMIC_RELAXED, __HIP_MEMORY_SCOPE_AGENT); }
__device__ __forceinline__ unsigned xb_xcc_id() { return (unsigned)__builtin_amdgcn_s_getreg((3 << 11) | 20) & 0xFu; }
#define XB_SPIN(cond, bar) do { unsigned _sp = 0; while (cond) { __builtin_amdgcn_s_sleep(1); \
    if ((++_sp & 255u) == 0u) { if (xb_ld(&(bar)[XB_TMO])) break; if (_sp > XB_SPIN_CAP) { atomicAdd(&(bar)[XB_TMO], 1u); break; } } } } while (0)

struct XcdBarrier {
    unsigned* bar; unsigned x;
    volatile LAS unsigned* st;
};

__device__ __forceinline__ XcdBarrier xcd_barrier_post(unsigned* bar, volatile LAS unsigned* st) {
    XcdBarrier b; b.bar = bar; b.x = xb_xcc_id(); b.st = st;
    if (threadIdx.x == 0) (void)xb_add(&bar[XB_XCNT(b.x)], 1u);
    return b;
}
__device__ __forceinline__ void xcd_barrier_complete(unsigned* bar, unsigned x, unsigned& nloc, unsigned& nx) {
    const unsigned G = gridDim.x * gridDim.y * gridDim.z;
    unsigned sum, cnt, mine, sp = 0u;
    for (;;) {
        sum = 0u; cnt = 0u; mine = 0u;
#pragma unroll
        for (unsigned j = 0; j < 16; ++j) { const unsigned c = xb_ld(&bar[XB_XCNT(j)]); sum += c; cnt += (c > 0u) ? 1u : 0u; mine = (j == x) ? c : mine; }
        if (sum == G) break;
        __builtin_amdgcn_s_sleep(1);
        if ((++sp & 255u) == 0u) { if (xb_ld(&bar[XB_TMO])) break; if (sp > XB_SPIN_CAP) { atomicAdd(&bar[XB_TMO], 1u); break; } }
    }
    nloc = mine > 0u ? mine : 1u; nx = cnt > 0u ? cnt : 1u;
}

__device__ __forceinline__ void xcd_barrier(const XcdBarrier& b) {
    asm volatile("s_waitcnt vmcnt(0)" ::: "memory");
    __syncthreads();
    if (threadIdx.x == 0) {
        unsigned* bar = b.bar;
        __builtin_amdgcn_s_waitcnt(0);
        unsigned nloc = b.st[0], nx = b.st[1];
        if (nloc == 0u) { xcd_barrier_complete(bar, b.x, nloc, nx); b.st[0] = nloc; b.st[1] = nx; }
        const unsigned old = xb_add(&bar[XB_XSUB(b.x)], 1u);
        const unsigned gen = old / nloc;
        if (old + 1u == (gen + 1u) * nloc) {
            __builtin_amdgcn_fence(__ATOMIC_RELEASE, "agent");
            asm volatile("s_waitcnt vmcnt(0)" ::: "memory");
            const unsigned og = xb_add(&bar[XB_TOP], 1u);
            const unsigned tg = og / nx;
            if (og + 1u == (tg + 1u) * nx) xb_add(&bar[XB_TOPGEN], 1u);
            else XB_SPIN(xb_ld(&bar[XB_TOPGEN]) == tg, bar);
            __builtin_amdgcn_fence(__ATOMIC_ACQUIRE, "agent");
            xb_add(&bar[XB_XGEN(b.x)], 1u);
            asm volatile("s_waitcnt vmcnt(0)" ::: "memory");
        } else {
            XB_SPIN(xb_ld(&bar[XB_XGEN(b.x)]) == gen, bar);
            __builtin_amdgcn_fence(__ATOMIC_ACQUIRE, "agent");
            asm volatile("s_waitcnt vmcnt(0)" ::: "memory");
        }
    }
    __syncthreads();
}

struct Frame {
    LAS unsigned char* lds;
    volatile LAS unsigned* MISC;
    gu32* ctl;
    int tid, lane, wave, G;
    const float* in[32];
    float* out;
    unsigned char* ws;
};
#define IN_X 0
#define IN_META 1
#define IN_LNIN_G 2
#define IN_LNIN_B 3
#define IN_W_IN 4
#define IN_QNORM_G 5
#define IN_W_UQ 6
#define IN_KVNORM_G 7
#define IN_W_UKV 8
#define IN_W_IQ 9
#define IN_IDXLN_G 10
#define IN_IDXLN_B 11
#define IN_MU 12
#define IN_W0 13
#define IN_W_DEC 14
#define IN_A0 15
#define IN_W_AAA 16
#define IN_W_GATE 17
#define IN_KK 18
#define IN_KA 19
#define IN_RK 20
#define IN_GN_G 21
#define IN_GN_B 22
#define IN_W_OUT 23
#define IN_LN1_G 24
#define IN_LN1_B 25
#define IN_W_UP 26
#define IN_CONV_W 27
#define IN_CONV_B 28
#define IN_W_DN 29
#define IN_LN2_G 30
#define IN_LN2_B 31

#define WSP(T, off) ((T*)(F.ws + (off)))

__device__ __forceinline__ int key_row(int b, int j) { return j < NMETA ? NREAL + j : b * SEQ + (j - NMETA); }

__device__ __forceinline__ void tr_items(Frame& F, const float* src, int src_ld, int src_r0, bf16* dst, int dst_ld, int dst_c0, int Nn, int K, int cut0, int cut1, int shift) {
    const int total = Nn * (K / 8);
    for (int it = blockIdx.x * NTHR + F.tid; it < total; it += F.G * NTHR) {
        const int n = it % Nn, kc = it / Nn;
        const int col = n < cut0 ? n : (n < cut1 ? -1 : n - shift);
        float v[8];
#pragma unroll
        for (int e = 0; e < 8; ++e) v[e] = col >= 0 ? src[(size_t)(src_r0 + 8 * kc + e) * src_ld + col] : 0.f;
        v4u o; o.x = pk2(v[0], v[1]); o.y = pk2(v[2], v[3]); o.z = pk2(v[4], v[5]); o.w = pk2(v[6], v[7]);
        *(v4u*)(dst + (size_t)n * dst_ld + dst_c0 + 8 * kc) = o;
    }
}
__device__ __forceinline__ void p0_weights(Frame& F) {
    bf16* WT_IN = WSP(bf16, WS_WT_IN); bf16* WT_QA = WSP(bf16, WS_WT_QA); bf16* WT_MIX = WSP(bf16, WS_WT_MIX); bf16* WT_UP = WSP(bf16, WS_WT_UP); bf16* WT_DN = WSP(bf16, WS_WT_DN);
    tr_items(F, F.in[IN_W_IN], 2248, 0, WT_IN, D, 0, PW, D, 456, 512, 56);
    tr_items(F, F.in[IN_W_UP], UPW, 0, WT_UP, D, 0, UPW, D, UPW, UPW, 0);
    tr_items(F, F.in[IN_W_DN], D, 0, WT_DN, DFF, 0, D, DFF, D, D, 0);
    tr_items(F, F.in[IN_W_IQ], 512, 0, WT_QA + (size_t)1024 * 256, 256, 0, 512, 256, 512, 512, 0);
    tr_items(F, F.in[IN_W_OUT], D, 512, WT_MIX, 1536, 1024, D, 512, D, D, 0);
    {
        bf16* WdT = WSP(bf16, WS_WT_LORA);
        tr_items(F, F.in[IN_W_DEC], 512, 0, WdT, 64, 0, 512, 64, 512, 512, 0);
        tr_items(F, F.in[IN_W_AAA], 512, 0, WdT + 512 * 64, 64, 0, 512, 64, 512, 512, 0);
        tr_items(F, F.in[IN_W_GATE], 512, 0, WdT + 2 * 512 * 64, 128, 0, 512, 128, 512, 512, 0);
    }
    const float* w_uq = F.in[IN_W_UQ]; const float* w_ukv = F.in[IN_W_UKV]; const float* w_out = F.in[IN_W_OUT];
    for (int it = blockIdx.x * NTHR + F.tid; it < 1024 * 256; it += F.G * NTHR) {
        const int c = it & 255, n = it >> 8, h = n >> 7, j = n & 127;
        float s = 0.f;
        for (int d = 0; d < 64; ++d) s += w_uq[(size_t)c * 512 + h * 64 + d] * w_ukv[(size_t)j * 1024 + h * 128 + d];
        WT_QA[(size_t)n * 256 + c] = (bf16)f2bf(0.125f * s);
    }
    for (int it = blockIdx.x * NTHR + F.tid; it < 1024 * 1024; it += F.G * NTHR) {
        const int n = it & 1023, k = it >> 10, h = k >> 7, j = k & 127;
        float s = 0.f;
        for (int d = 0; d < 64; ++d) s += w_ukv[(size_t)j * 1024 + h * 128 + 64 + d] * w_out[(size_t)(h * 64 + d) * D + n];
        WT_MIX[(size_t)n * 1536 + k] = (bf16)f2bf(s);
    }
}

__device__ __forceinline__ void ln_row_bf16(Frame& F, const float* src, const float* g, const float* b, bf16* dst) {
    v2u* o8 = (v2u*)dst + F.lane;
    if (!src) {
#pragma unroll
        for (int j = 0; j < 4; ++j) o8[64 * j] = (v2u){0u, 0u};
        return;
    }
    const f32x4* xr = (const f32x4*)src + F.lane;
    f32x4 v[4]; float s = 0.f;
#pragma unroll
    for (int j = 0; j < 4; ++j) { v[j] = xr[64 * j]; s += (v[j].x + v[j].y) + (v[j].z + v[j].w); }
    const float mean = wave_sum(s) * (1.f / D); float s2 = 0.f;
#pragma unroll
    for (int j = 0; j < 4; ++j) { v[j] = v[j] - mean; s2 += (v[j].x * v[j].x + v[j].y * v[j].y) + (v[j].z * v[j].z + v[j].w * v[j].w); }
    const float rstd = 1.f / sqrtf(wave_sum(s2) * (1.f / D) + LN_EPS);
#pragma unroll
    for (int j = 0; j < 4; ++j) {
        const f32x4 gg = ((const f32x4*)g)[F.lane + 64 * j], bb = ((const f32x4*)b)[F.lane + 64 * j];
        const f32x4 y = v[j] * rstd * gg + bb;
        o8[64 * j] = (v2u){pk2(y.x, y.y), pk2(y.z, y.w)};
    }
}
__device__ __forceinline__ void p1_ln_in(Frame& F) {
    bf16* H0 = WSP(bf16, WS_H);
    const int gw = blockIdx.x * NWAVES + F.wave, NGW = F.G * NWAVES;
    for (int r = gw; r < R; r += NGW) {
        const float* src = r < NREAL ? F.in[IN_X] + (size_t)r * D : (r < NROWS ? F.in[IN_META] + (size_t)(r - NREAL) * D : nullptr);
        ln_row_bf16(F, src, F.in[IN_LNIN_G], F.in[IN_LNIN_B], H0 + (size_t)r * D);
    }
}

__device__ __forceinline__ void p3_prep(Frame& F) {
    const bf16* P = WSP(bf16, WS_P); bf16* CQN = WSP(bf16, WS_CQN); bf16* CKV = WSP(bf16, WS_CKV); bf16* KIDX = WSP(bf16, WS_KIDX); float* WIDX = WSP(float, WS_WIDX);
    const int gw = blockIdx.x * NWAVES + F.wave, NGW = F.G * NWAVES, l = F.lane;
    for (int r = gw; r < R; r += NGW) {
        const bf16* pr = P + (size_t)r * PW;
        if (r >= NROWS) {
            *(v2u*)(CQN + (size_t)r * 256 + 4 * l) = (v2u){0u, 0u};
            continue;
        }
        {
            const v2u w = *(const v2u*)(pr + PC_CQ + 4 * l);
            const float a0 = bflo(w.x), a1 = bfhi(w.x), a2 = bflo(w.y), a3 = bfhi(w.y);
            const float ss = wave_sum(a0 * a0 + a1 * a1 + a2 * a2 + a3 * a3);
            const float rs = 1.0f / sqrtf(ss * (1.f / 256.f) + 1e-6f);
            const f32x4 g = ((const f32x4*)F.in[IN_QNORM_G])[l];
            *(v2u*)(CQN + (size_t)r * 256 + 4 * l) = (v2u){pk2(a0 * rs * g.x, a1 * rs * g.y), pk2(a2 * rs * g.z, a3 * rs * g.w)};
        }
        {
            const unsigned w = *(const unsigned*)(pr + PC_CKV + 2 * l);
            const float a0 = bflo(w), a1 = bfhi(w);
            const float ss = wave_sum(a0 * a0 + a1 * a1);
            const float rs = 1.0f / sqrtf(ss * (1.f / 128.f) + 1e-6f);
            const float g0 = F.in[IN_KVNORM_G][2 * l], g1 = F.in[IN_KVNORM_G][2 * l + 1];
            *(unsigned*)(CKV + (size_t)r * 128 + 2 * l) = pk2(a0 * rs * g0, a1 * rs * g1);
        }
        {
            const float a = bf2f(pr[PC_KIDX + l]);
            const float mean = wave_sum(a) * (1.f / 64.f);
            const float dlt = a - mean;
            const float var = wave_sum(dlt * dlt) * (1.f / 64.f);
            const float y = dlt * (1.0f / sqrtf(var + LN_EPS)) * F.in[IN_IDXLN_G][l] + F.in[IN_IDXLN_B][l];
            KIDX[(size_t)r * 64 + l] = (bf16)f2bf(y);
        }
        if (l < 8) WIDX[(size_t)r * 8 + l] = bf2f(pr[PC_WIDX + l]) * 0.04419417382415922f;
    }
}

#ifndef REFSEL
#define REFSEL 0
#endif
__device__ __forceinline__ void refsel_rows(Frame& F) {
    float* QIDX32 = F.out; float* KIDX32 = F.out + (size_t)R * 512; float* WIDX = WSP(float, WS_WIDX);
    const float* w_in = F.in[IN_W_IN]; const float* w_iq = F.in[IN_W_IQ];
    LAS float* hrow = (LAS float*)(F.lds + F.wave * 8192);
    LAS float* cqn = hrow + 1024;
    const int l = F.lane;
    const int gw = blockIdx.x * NWAVES + F.wave, NGW = F.G * NWAVES;
    for (int r = gw; r < NROWS; r += NGW) {
        const float* src = r < NREAL ? F.in[IN_X] + (size_t)r * D : F.in[IN_META] + (size_t)(r - NREAL) * D;
        {
            const f32x4* xr = (const f32x4*)src + l;
            f32x4 v[4]; float s = 0.f;
#pragma unroll
            for (int j = 0; j < 4; ++j) { v[j] = xr[64 * j]; s += (v[j].x + v[j].y) + (v[j].z + v[j].w); }
            const float mean = wave_sum(s) * (1.f / D); float s2 = 0.f;
#pragma unroll
            for (int j = 0; j < 4; ++j) { v[j] = v[j] - mean; s2 += (v[j].x * v[j].x + v[j].y * v[j].y) + (v[j].z * v[j].z + v[j].w * v[j].w); }
            const float rstd = 1.f / sqrtf(wave_sum(s2) * (1.f / D) + LN_EPS);
#pragma unroll
            for (int j = 0; j < 4; ++j) {
                const f32x4 gg = ((const f32x4*)F.in[IN_LNIN_G])[l + 64 * j], bb = ((const f32x4*)F.in[IN_LNIN_B])[l + 64 * j];
                *(LAS f32x4*)(hrow + 4 * (l + 64 * j)) = v[j] * rstd * gg + bb;
            }
        }
        __builtin_amdgcn_wave_barrier();
        float a[6];
#pragma unroll
        for (int i = 0; i < 6; ++i) a[i] = 0.f;
        for (int k = 0; k < D; ++k) {
            const float hk = hrow[k]; const float* wr = w_in + (size_t)k * 2248;
#pragma unroll
            for (int i = 0; i < 4; ++i) a[i] += hk * wr[l + 64 * i];
            a[4] += hk * wr[384 + l];
            a[5] += hk * wr[448 + (l & 7)];
        }
        const float ss = wave_sum(a[0] * a[0] + a[1] * a[1] + a[2] * a[2] + a[3] * a[3]);
        const float rs = 1.0f / sqrtf(ss * (1.f / 256.f) + 1e-6f);
#pragma unroll
        for (int i = 0; i < 4; ++i) cqn[l + 64 * i] = a[i] * rs * F.in[IN_QNORM_G][l + 64 * i];
        {
            const float mean = wave_sum(a[4]) * (1.f / 64.f); const float dlt = a[4] - mean;
            const float var = wave_sum(dlt * dlt) * (1.f / 64.f);
            KIDX32[(size_t)r * 64 + l] = dlt * (1.0f / sqrtf(var + LN_EPS)) * F.in[IN_IDXLN_G][l] + F.in[IN_IDXLN_B][l];
        }
        if (l < 8) WIDX[(size_t)r * 8 + l] = a[5] * 0.04419417382415922f;
        __builtin_amdgcn_wave_barrier();
        float q[8];
#pragma unroll
        for (int i = 0; i < 8; ++i) q[i] = 0.f;
        for (int c = 0; c < 256; ++c) {
            const float cq = cqn[c]; const float* wr = w_iq + (size_t)c * 512;
#pragma unroll
            for (int i = 0; i < 8; ++i) q[i] += cq * wr[l + 64 * i];
        }
#pragma unroll
        for (int i = 0; i < 8; ++i) QIDX32[(size_t)r * 512 + l + 64 * i] = q[i];
        __builtin_amdgcn_wave_barrier();
    }
}

__device__ __forceinline__ unsigned sortable(float f) { const unsigned u = __float_as_uint(f); return (u & 0x80000000u) ? ~u : (u | 0x80000000u); }
__device__ __forceinline__ void p5_index_naive(Frame& F) {
    const bf16* QA = WSP(bf16, WS_QA); const bf16* KIDX = WSP(bf16, WS_KIDX); const float* WIDX = WSP(float, WS_WIDX);
    unsigned short* SEL = WSP(unsigned short, WS_SEL); int* NSEL = WSP(int, WS_NSEL);
    LAS float* sc = (LAS float*)(F.lds);
    LAS float* qf = (LAS float*)(F.lds + 33024);
    LAS unsigned* hist = (LAS unsigned*)(F.lds + 33024 + 2048);
    LAS unsigned* cw = hist + 256;
    const int tid = F.tid;
    for (int q = blockIdx.x; q < NROWS; q += F.G) {
        int b, pos; if (q < NREAL) { b = q >> 13; pos = NMETA + (q & (SEQ - 1)); } else { b = 0; pos = q - NREAL; }
        const int nvis = pos < NMETA ? NMETA : NMETA + 64 * ((pos - NMETA) / 64 + 1);
#if REFSEL
        qf[tid] = F.out[(size_t)q * 512 + tid];
#else
        qf[tid] = bf2f(QA[(size_t)q * QAW + 1024 + tid]);
#endif
        float w[8];
#pragma unroll
        for (int h = 0; h < 8; ++h) w[h] = WIDX[(size_t)q * 8 + h];
        __syncthreads();
        for (int j = tid; j < nvis; j += NTHR) {
            const v4u* kp = (const v4u*)(KIDX + (size_t)key_row(b, j) * 64);
#if REFSEL
            const f32x4* kp32 = (const f32x4*)(F.out + (size_t)R * 512 + (size_t)key_row(b, j) * 64);
#endif
            float d[8];
#pragma unroll
            for (int h = 0; h < 8; ++h) d[h] = 0.f;
#pragma unroll 2
            for (int c = 0; c < 8; ++c) {
#if REFSEL
                const f32x4 ta = kp32[2 * c], tb = kp32[2 * c + 1];
                const float k0 = ta.x, k1 = ta.y, k2 = ta.z, k3 = ta.w, k4 = tb.x, k5 = tb.y, k6 = tb.z, k7 = tb.w;
#else
                const v4u t = kp[c];
                const float k0 = bflo(t.x), k1 = bfhi(t.x), k2 = bflo(t.y), k3 = bfhi(t.y), k4 = bflo(t.z), k5 = bfhi(t.z), k6 = bflo(t.w), k7 = bfhi(t.w);
#endif
#pragma unroll
                for (int h = 0; h < 8; ++h) {
                    const f32x4 qa = *(const LAS f32x4*)(qf + h * 64 + 8 * c), qb = *(const LAS f32x4*)(qf + h * 64 + 8 * c + 4);
                    d[h] += qa.x * k0 + qa.y * k1 + qa.z * k2 + qa.w * k3 + qb.x * k4 + qb.y * k5 + qb.z * k6 + qb.w * k7;
                }
            }
            float s = 0.f;
#pragma unroll
            for (int h = 0; h < 8; ++h) s += w[h] * fmaxf(d[h], 0.f);
            sc[j] = s + 0.0f;
        }
        __syncthreads();
        unsigned short* selq = SEL + (size_t)q * TOPK;
        if (nvis <= TOPK) {
            for (int j = tid; j < nvis; j += NTHR) selq[j] = (unsigned short)j;
        } else {
            unsigned prefix = 0u, mask = 0u, need = TOPK;
            for (int pass = 0; pass < 4; ++pass) {
                const int shift = 24 - 8 * pass;
                if (tid < 256) hist[tid] = 0u;
                __syncthreads();
                for (int j = tid; j < nvis; j += NTHR) { const unsigned key = sortable(sc[j]); if ((key & mask) == prefix) atomicAdd((unsigned*)&hist[(key >> shift) & 255u], 1u); }
                __syncthreads();
                if (tid < 256) {
                    unsigned above = 0u; for (int bb = tid + 1; bb < 256; ++bb) above += hist[bb];
                    const unsigned c = hist[tid];
                    if (above < need && need <= above + c) { cw[0] = prefix | ((unsigned)tid << shift); cw[1] = need - above; }
                }
                __syncthreads();
                prefix = cw[0]; need = cw[1]; mask |= 0xFFu << shift;
                __syncthreads();
            }
            if (tid == 0) cw[2] = 0u;
            __syncthreads();
            for (int j = tid; j < nvis; j += NTHR) { if (sortable(sc[j]) > prefix) { const unsigned p = atomicAdd((unsigned*)&cw[2], 1u); selq[p] = (unsigned short)j; } }
            __syncthreads();
            if (F.wave == 0) {
                const unsigned base = cw[2]; unsigned taken = 0u;
                for (int j0 = 0; j0 < nvis && taken < need; j0 += 64) {
                    const int j = j0 + F.lane; const bool eq = j < nvis && sortable(sc[j]) == prefix;
                    const unsigned long long m = __ballot(eq);
                    const unsigned rank = (unsigned)__popcll(m & ((1ull << F.lane) - 1ull));
                    if (eq && taken + rank < need) selq[base + taken + rank] = (unsigned short)j;
                    taken += (unsigned)__popcll(m);
                }
            }
        }
        if (tid == 0) NSEL[q] = nvis < TOPK ? nvis : TOPK;
        __syncthreads();
    }
}

__device__ __forceinline__ void p6_attn_naive(Frame& F) {
    bf16* QA = WSP(bf16, WS_QA); const bf16* CKV = WSP(bf16, WS_CKV); const unsigned short* SEL = WSP(unsigned short, WS_SEL); const int* NSEL = WSP(int, WS_NSEL);
    LAS float* qf = (LAS float*)(F.lds + F.wave * 16384);
    LAS float* ps = qf + 1024;
    LAS int* srow = (LAS int*)(ps + 2048);
    const int l = F.lane;
    const int gw = blockIdx.x * NWAVES + F.wave, NGW = F.G * NWAVES;
    for (int q = gw; q < R; q += NGW) {
        bf16* qrow = QA + (size_t)q * QAW;
        if (q >= NROWS) {
            for (int c = l; c < QAW / 8; c += 64) *(v4u*)(qrow + 8 * c) = (v4u){0u, 0u, 0u, 0u};
            continue;
        }
        int b, pos; if (q < NREAL) { b = q >> 13; pos = NMETA + (q & (SEQ - 1)); } else { b = 0; pos = q - NREAL; }
        const int nsel = NSEL[q];
        {
            const v4u t0 = *(const v4u*)(qrow + 16 * l), t1 = *(const v4u*)(qrow + 16 * l + 8);
            LAS float* d = qf + 16 * l;
            d[0] = bflo(t0.x); d[1] = bfhi(t0.x); d[2] = bflo(t0.y); d[3] = bfhi(t0.y); d[4] = bflo(t0.z); d[5] = bfhi(t0.z); d[6] = bflo(t0.w); d[7] = bfhi(t0.w);
            d[8] = bflo(t1.x); d[9] = bfhi(t1.x); d[10] = bflo(t1.y); d[11] = bfhi(t1.y); d[12] = bflo(t1.z); d[13] = bfhi(t1.z); d[14] = bflo(t1.w); d[15] = bfhi(t1.w);
        }
        __builtin_amdgcn_wave_barrier();
        for (int kk = 0; kk < 4; ++kk) {
            const int s = kk * 64 + l; const bool valid = s < nsel;
            const int j = valid ? (int)SEL[(size_t)q * TOPK + s] : 0;
            const int row = key_row(b, j);
            srow[s] = row;
            float acc[8];
#pragma unroll
            for (int h = 0; h < 8; ++h) acc[h] = 0.f;
            const v4u* kp = (const v4u*)(CKV + (size_t)row * 128);
            for (int c8 = 0; c8 < 16; ++c8) {
                const v4u t = kp[c8];
                const float k0 = bflo(t.x), k1 = bfhi(t.x), k2 = bflo(t.y), k3 = bfhi(t.y), k4 = bflo(t.z), k5 = bfhi(t.z), k6 = bflo(t.w), k7 = bfhi(t.w);
#pragma unroll
                for (int h = 0; h < 8; ++h) {
                    const f32x4 qa = *(const LAS f32x4*)(qf + h * 128 + 8 * c8), qb = *(const LAS f32x4*)(qf + h * 128 + 8 * c8 + 4);
                    acc[h] += qa.x * k0 + qa.y * k1 + qa.z * k2 + qa.w * k3 + qb.x * k4 + qb.y * k5 + qb.z * k6 + qb.w * k7;
                }
            }
            const float dist = fabsf((float)(pos - j));
#pragma unroll
            for (int h = 0; h < 8; ++h) { const float slope = __uint_as_float((unsigned)(127 - (h + 1)) << 23); ps[s * 8 + h] = valid ? acc[h] - slope * dist : -INFINITY; }
        }
        __builtin_amdgcn_wave_barrier();
#pragma unroll
        for (int h = 0; h < 8; ++h) {
            float v0 = ps[(l) * 8 + h], v1 = ps[(l + 64) * 8 + h], v2 = ps[(l + 128) * 8 + h], v3 = ps[(l + 192) * 8 + h];
            const float mx = wave_max(fmaxf(fmaxf(v0, v1), fmaxf(v2, v3)));
            v0 = __expf(v0 - mx); v1 = __expf(v1 - mx); v2 = __expf(v2 - mx); v3 = __expf(v3 - mx);
            const float inv = 1.0f / wave_sum((v0 + v1) + (v2 + v3));
            ps[(l) * 8 + h] = v0 * inv; ps[(l + 64) * 8 + h] = v1 * inv; ps[(l + 128) * 8 + h] = v2 * inv; ps[(l + 192) * 8 + h] = v3 * inv;
        }
        __builtin_amdgcn_wave_barrier();
        float o0[8], o1[8];
#pragma unroll
        for (int h = 0; h < 8; ++h) { o0[h] = 0.f; o1[h] = 0.f; }
        for (int s = 0; s < nsel; ++s) {
            const int row = srow[s];
            const unsigned w = *(const unsigned*)(CKV + (size_t)row * 128 + 2 * l);
            const float c0 = bflo(w), c1 = bfhi(w);
            const f32x4 pa = *(const LAS f32x4*)(ps + s * 8), pb = *(const LAS f32x4*)(ps + s * 8 + 4);
            o0[0] += pa.x * c0; o1[0] += pa.x * c1; o0[1] += pa.y * c0; o1[1] += pa.y * c1; o0[2] += pa.z * c0; o1[2] += pa.z * c1; o0[3] += pa.w * c0; o1[3] += pa.w * c1;
            o0[4] += pb.x * c0; o1[4] += pb.x * c1; o0[5] += pb.y * c0; o1[5] += pb.y * c1; o0[6] += pb.z * c0; o1[6] += pb.z * c1; o0[7] += pb.w * c0; o1[7] += pb.w * c1;
        }
#pragma unroll
        for (int h = 0; h < 8; ++h) *(unsigned*)(qrow + h * 128 + 2 * l) = pk2(o0[h], o1[h]);
        __builtin_amdgcn_wave_barrier();
    }
}

__device__ __forceinline__ void p7_rwkv_prep_naive(Frame& F) {
    const bf16* P = WSP(bf16, WS_P); float* DEC = WSP(float, WS_DEC); bf16* AB = WSP(bf16, WS_AB); bf16* GB = WSP(bf16, WS_GB);
    const float* mu = F.in[IN_MU]; const float* Wd = F.in[IN_W_DEC]; const float* Wa = F.in[IN_W_AAA]; const float* Wg = F.in[IN_W_GATE];
    const int l = F.lane;
    const int gw = blockIdx.x * NWAVES + F.wave, NGW = F.G * NWAVES;
    for (int r = gw; r < NROWS; r += NGW) {
        int prev; if (r < NREAL) { prev = (r & (SEQ - 1)) ? r - 1 : NREAL + NMETA - 1; } else { prev = r > NREAL ? r - 1 : -1; }
        const bf16* pr = P + (size_t)r * PW; const bf16* pp = prev >= 0 ? P + (size_t)prev * PW : nullptr;
#define SHIFTED(pc, mc) (bf2f(pr[pc]) + ((pp ? bf2f(pp[pc]) : 0.f) - bf2f(pr[pc])) * mu[mc])
        const float tw = tanhf(SHIFTED(PC_WD + l, 1536 + l));
        const float ta = SHIFTED(PC_AD + l, 1600 + l);
        const float tg0 = sigmoidf_(SHIFTED(PC_GD + l, 1664 + l)), tg1 = sigmoidf_(SHIFTED(PC_GD + 64 + l, 1728 + l));
#undef SHIFTED
        float aw[8], aa[8], ag[8];
#pragma unroll
        for (int i = 0; i < 8; ++i) { aw[i] = F.in[IN_W0][l + 64 * i]; aa[i] = F.in[IN_A0][l + 64 * i]; ag[i] = 0.f; }
        for (int j = 0; j < 64; ++j) {
            const float xw = __shfl(tw, j), xa = __shfl(ta, j), xg0 = __shfl(tg0, j), xg1 = __shfl(tg1, j);
#pragma unroll
            for (int i = 0; i < 8; ++i) {
                aw[i] += xw * Wd[(size_t)j * 512 + l + 64 * i];
                aa[i] += xa * Wa[(size_t)j * 512 + l + 64 * i];
                ag[i] += xg0 * Wg[(size_t)j * 512 + l + 64 * i] + xg1 * Wg[(size_t)(j + 64) * 512 + l + 64 * i];
            }
        }
#pragma unroll
        for (int i = 0; i < 8; ++i) {
            const float x = -aw[i];
            const float sp = x > 20.f ? x : log1pf(__expf(x));
            const float wlog = -sp - 0.5f;
            DEC[(size_t)r * 512 + l + 64 * i] = __expf(-__expf(wlog));
            AB[(size_t)r * 512 + l + 64 * i] = (bf16)f2bf(sigmoidf_(aa[i]));
            GB[(size_t)r * 512 + l + 64 * i] = (bf16)f2bf(ag[i]);
        }
    }
}

__device__ __forceinline__ void p8_rwkv_scan_naive(Frame& F) {
    if (F.wave != 0 || blockIdx.x >= 32) return;
    const bf16* P = WSP(bf16, WS_P); const float* DEC = WSP(float, WS_DEC); const bf16* AB = WSP(bf16, WS_AB); const bf16* GB = WSP(bf16, WS_GB); bf16* QA = WSP(bf16, WS_QA);
    const int b = blockIdx.x >> 3, h = blockIdx.x & 7, l = F.lane, ch = h * 64 + l;
    LAS float* vec = (LAS float*)F.lds;
    const float mu_r = F.in[IN_MU][ch], mu_k = F.in[IN_MU][512 + ch], mu_v = F.in[IN_MU][1024 + ch];
    const float kk_c = F.in[IN_KK][ch], ka_c = F.in[IN_KA][ch], rk_c = F.in[IN_RK][ch], gng = F.in[IN_GN_G][ch], gnb = F.in[IN_GN_B][ch];
    float S[64];
#pragma unroll
    for (int k = 0; k < 64; ++k) S[k] = 0.f;
    float pr_p = 0.f, pk_p = 0.f, pv_p = 0.f;
    int row = key_row(b, 0);
    float n_pr = bf2f(P[(size_t)row * PW + PC_R + ch]), n_pk = bf2f(P[(size_t)row * PW + PC_K + ch]), n_pv = bf2f(P[(size_t)row * PW + PC_V + ch]);
    float n_w = DEC[(size_t)row * 512 + ch], n_a = bf2f(AB[(size_t)row * 512 + ch]), n_g = bf2f(GB[(size_t)row * 512 + ch]);
    for (int pos = 0; pos < TT; ++pos) {
        const int crow = row;
        const float c_pr = n_pr, c_pk = n_pk, c_pv = n_pv, c_w = n_w, c_a = n_a, c_g = n_g;
        if (pos + 1 < TT) {
            row = key_row(b, pos + 1);
            n_pr = bf2f(P[(size_t)row * PW + PC_R + ch]); n_pk = bf2f(P[(size_t)row * PW + PC_K + ch]); n_pv = bf2f(P[(size_t)row * PW + PC_V + ch]);
            n_w = DEC[(size_t)row * 512 + ch]; n_a = bf2f(AB[(size_t)row * 512 + ch]); n_g = bf2f(GB[(size_t)row * 512 + ch]);
        }
        const float r_s = c_pr + (pr_p - c_pr) * mu_r, k_s = c_pk + (pk_p - c_pk) * mu_k, v_s = c_pv + (pv_p - c_pv) * mu_v;
        pr_p = c_pr; pk_p = c_pk; pv_p = c_pv;
        const float kkr = k_s * kk_c;
        const float nrm = sqrtf(wave_sum(kkr * kkr));
        const float kk = kkr / fmaxf(nrm, 1e-12f);
        const float k2 = k_s * (1.f + (c_a - 1.f) * ka_c);
        vec[l] = -kk; vec[64 + l] = kk * c_a; vec[128 + l] = c_w; vec[192 + l] = k2; vec[256 + l] = r_s;
        __builtin_amdgcn_wave_barrier();
        float sa = 0.f;
#pragma unroll
        for (int k4 = 0; k4 < 16; ++k4) { const f32x4 a = *(const LAS f32x4*)(vec + 4 * k4); sa += S[4 * k4] * a.x + S[4 * k4 + 1] * a.y + S[4 * k4 + 2] * a.z + S[4 * k4 + 3] * a.w; }
        float y = 0.f;
#pragma unroll
        for (int k4 = 0; k4 < 16; ++k4) {
            const f32x4 bv = *(const LAS f32x4*)(vec + 64 + 4 * k4), w = *(const LAS f32x4*)(vec + 128 + 4 * k4), kv = *(const LAS f32x4*)(vec + 192 + 4 * k4), rv = *(const LAS f32x4*)(vec + 256 + 4 * k4);
            S[4 * k4] = S[4 * k4] * w.x + sa * bv.x + v_s * kv.x; S[4 * k4 + 1] = S[4 * k4 + 1] * w.y + sa * bv.y + v_s * kv.y;
            S[4 * k4 + 2] = S[4 * k4 + 2] * w.z + sa * bv.z + v_s * kv.z; S[4 * k4 + 3] = S[4 * k4 + 3] * w.w + sa * bv.w + v_s * kv.w;
            y += S[4 * k4] * rv.x + S[4 * k4 + 1] * rv.y + S[4 * k4 + 2] * rv.z + S[4 * k4 + 3] * rv.w;
        }
        __builtin_amdgcn_wave_barrier();
        const float mean = wave_sum(y) * (1.f / 64.f);
        const float dlt = y - mean;
        const float var = wave_sum(dlt * dlt) * (1.f / 64.f);
        const float yn = dlt * (1.0f / sqrtf(var + GN_EPS)) * gng + gnb;
        const float bonus = wave_sum(r_s * k2 * rk_c) * v_s;
        const float o = (yn + bonus) * c_g;
        if (pos >= NMETA || b == 0) QA[(size_t)crow * QAW + 1024 + ch] = (bf16)f2bf(o);
    }
}

__device__ __forceinline__ void p10_ln1(Frame& F) {
    bf16* H1 = WSP(bf16, WS_H); const float* META1 = WSP(float, WS_META1);
    const int gw = blockIdx.x * NWAVES + F.wave, NGW = F.G * NWAVES;
    for (int r = gw; r < NROWS; r += NGW) {
        const float* src = r < NREAL ? F.out + (size_t)r * D : META1 + (size_t)(r - NREAL) * D;
        ln_row_bf16(F, src, F.in[IN_LN1_G], F.in[IN_LN1_B], H1 + (size_t)r * D);
    }
}
__device__ __forceinline__ void p14_ln2(Frame& F) {
    const int gw = blockIdx.x * NWAVES + F.wave, NGW = F.G * NWAVES;
    const float* g = F.in[IN_LN2_G]; const float* b = F.in[IN_LN2_B];
    for (int r = gw; r < NREAL; r += NGW) {
        f32x4* xr = (f32x4*)(F.out + (size_t)r * D) + F.lane;
        f32x4 v[4]; float s = 0.f;
#pragma unroll
        for (int j = 0; j < 4; ++j) { v[j] = xr[64 * j]; s += (v[j].x + v[j].y) + (v[j].z + v[j].w); }
        const float mean = wave_sum(s) * (1.f / D); float s2 = 0.f;
#pragma unroll
        for (int j = 0; j < 4; ++j) { v[j] = v[j] - mean; s2 += (v[j].x * v[j].x + v[j].y * v[j].y) + (v[j].z * v[j].z + v[j].w * v[j].w); }
        const float rstd = 1.f / sqrtf(wave_sum(s2) * (1.f / D) + LN_EPS);
#pragma unroll
        for (int j = 0; j < 4; ++j) { const f32x4 gg = ((const f32x4*)g)[F.lane + 64 * j], bb = ((const f32x4*)b)[F.lane + 64 * j]; xr[64 * j] = v[j] * rstd * gg + bb; }
    }
}

__device__ __forceinline__ float gelu_tanh(float x) { const float u = 0.7978845608028654f * (x + 0.044715f * x * x * x); return 0.5f * x * (1.f + tanhf(u)); }
__device__ __forceinline__ void p12_conv_act(Frame& F) {
    bf16* UP = WSP(bf16, WS_UP); const float* cw = F.in[IN_CONV_W]; const float* cb = F.in[IN_CONV_B];
    const size_t total = (size_t)NREAL * (DFF / 8);
    for (size_t it = (size_t)blockIdx.x * NTHR + F.tid; it < total; it += (size_t)F.G * NTHR) {
        const int r = (int)(it / (DFF / 8)), c = (int)(it % (DFF / 8)) * 8, s = r & (SEQ - 1);
        const int r1 = s >= 1 ? r - 1 : NREAL + 15, r2 = s >= 2 ? r - 2 : NREAL + 14 + s;
        const v4u g0 = *(const v4u*)(UP + (size_t)r * UPW + c), g1 = *(const v4u*)(UP + (size_t)r1 * UPW + c), g2 = *(const v4u*)(UP + (size_t)r2 * UPW + c);
        const v4u vv = *(const v4u*)(UP + (size_t)r * UPW + DFF + c);
        const unsigned a0[4] = {g0.x, g0.y, g0.z, g0.w}, a1[4] = {g1.x, g1.y, g1.z, g1.w}, a2[4] = {g2.x, g2.y, g2.z, g2.w}, av[4] = {vv.x, vv.y, vv.z, vv.w};
        unsigned o[4];
#pragma unroll
        for (int e = 0; e < 4; ++e) {
            const int c0 = c + 2 * e, c1 = c0 + 1;
            const float x0 = cw[c0] * bflo(a2[e]) + cw[DFF + c0] * bflo(a1[e]) + cw[2 * DFF + c0] * bflo(a0[e]) + cb[c0];
            const float x1 = cw[c1] * bfhi(a2[e]) + cw[DFF + c1] * bfhi(a1[e]) + cw[2 * DFF + c1] * bfhi(a0[e]) + cb[c1];
            o[e] = pk2(gelu_tanh(x0) * bflo(av[e]), gelu_tanh(x1) * bfhi(av[e]));
        }
        *(v4u*)(UP + (size_t)r * UPW + DFF + c) = (v4u){o[0], o[1], o[2], o[3]};
    }
}


constexpr int NUNITS = 4096 + 8;
constexpr int RP = 72;
constexpr int SLOT = 64 * RP * 2;
constexpr int FP = 68;
typedef short bf16x8 __attribute__((ext_vector_type(8)));
typedef float f32x16 __attribute__((ext_vector_type(16)));
constexpr size_t RW_MAT = (size_t)NUNITS * 4096;

__device__ __forceinline__ void quad_mma(f32x16& acc, const LAS bf16* Aop, const LAS bf16* Bop, int qr, int qc, int lane) {
    const int r = lane & 31, hf = lane >> 5;
    const LAS bf16* ap = Aop + (32 * qr + r) * RP + 8 * hf; const LAS bf16* bp = Bop + (32 * qc + r) * RP + 8 * hf;
#pragma unroll
    for (int ks = 0; ks < 4; ++ks) {
        const bf16x8 a = *(const LAS bf16x8*)(ap + 16 * ks), b = *(const LAS bf16x8*)(bp + 16 * ks);
        acc = __builtin_amdgcn_mfma_f32_32x32x16_bf16(a, b, acc, 0, 0, 0);
    }
}
#define ACC_M(qr, j, hf) (32 * (qr) + ((j) & 3) + 8 * ((j) >> 2) + 4 * (hf))
__device__ __forceinline__ void store_T(const f32x16& acc, LAS bf16* Z, int qr, int qc, int lane) {
    const int r = lane & 31, hf = lane >> 5;
#pragma unroll
    for (int jj = 0; jj < 4; ++jj)
        *(LAS v2u*)(Z + (32 * qc + r) * RP + 32 * qr + 8 * jj + 4 * hf) = (v2u){pk2(acc[4 * jj], acc[4 * jj + 1]), pk2(acc[4 * jj + 2], acc[4 * jj + 3])};
}
__device__ __forceinline__ void add_T(f32x16& acc, const LAS bf16* Z, int qr, int qc, int lane) {
    const int r = lane & 31, hf = lane >> 5;
#pragma unroll
    for (int jj = 0; jj < 4; ++jj) {
        const v2u w = *(const LAS v2u*)(Z + (32 * qc + r) * RP + 32 * qr + 8 * jj + 4 * hf);
        acc[4 * jj] += bflo(w.x); acc[4 * jj + 1] += bfhi(w.x); acc[4 * jj + 2] += bflo(w.y); acc[4 * jj + 3] += bfhi(w.y);
    }
}
__device__ __forceinline__ void store_T_global(const f32x16& acc, bf16* Z, int qr, int qc, int lane) {
    const int r = lane & 31, hf = lane >> 5;
#pragma unroll
    for (int jj = 0; jj < 4; ++jj)
        *(v2u*)(Z + (32 * qc + r) * 64 + 32 * qr + 8 * jj + 4 * hf) = (v2u){pk2(acc[4 * jj], acc[4 * jj + 1]), pk2(acc[4 * jj + 2], acc[4 * jj + 3])};
}
__device__ __forceinline__ f32x16 zero16() { f32x16 z;
#pragma unroll
    for (int j = 0; j < 16; ++j) z[j] = 0.f;
    return z; }

__device__ __forceinline__ void rw_b1(Frame& F) {
    const bf16* P = WSP(bf16, WS_P);
    bf16* RWM = WSP(bf16, WS_RWM); bf16* RWN = WSP(bf16, WS_RWN); bf16* RWQ = WSP(bf16, WS_RWQ); bf16* RWY = WSP(bf16, WS_RWY);
    float* BONUS = (float*)((char*)F.out + OUT_BONUS);
    const bf16* WdT = WSP(bf16, WS_WT_LORA); const bf16* WaT = WdT + 512 * 64;
    const float* mu = F.in[IN_MU];
    const int w = F.wave, l = F.lane, tid = F.tid;
    LAS unsigned char* L = F.lds;
#define SL(s) ((LAS bf16*)(L + (s) * SLOT))
    LAS float* WL = (LAS float*)(L + 12 * SLOT);
    LAS float* AL = (LAS float*)(L + 0 * SLOT);
    LAS float* OT = (LAS float*)(L + RING_BYTES + 1024);
    LAS float* GL = OT + 512;
    for (int u = blockIdx.x; u < NUNITS; u += F.G) {
        const bool meta = u >= 4096;
        int b = 0, h, c = 0; if (meta) h = u - 4096; else { b = u >> 10; h = (u >> 7) & 7; c = u & 127; }
        const int ch = h * 64 + l;
        const int row0 = meta ? NREAL : b * SEQ + c * 64;
        __syncthreads();
        float r_s[8], k_s[8], v_s[8], xw[8], xa[8];
        {
            float pr, pk, pv, pw, pa;
            const int t0 = 8 * w;
            int prow = -1;
            if (t0 > 0) prow = row0 + t0 - 1; else if (!meta) prow = (c == 0) ? NREAL + NMETA - 1 : row0 - 1;
            if (prow >= 0) { const bf16* pp = P + (size_t)prow * PW; pr = bf2f(pp[PC_R + ch]); pk = bf2f(pp[PC_K + ch]); pv = bf2f(pp[PC_V + ch]); pw = bf2f(pp[PC_WD + l]); pa = bf2f(pp[PC_AD + l]); }
            else { pr = pk = pv = pw = pa = 0.f; }
            const float mr = mu[ch], mk = mu[512 + ch], mv = mu[1024 + ch], mw = mu[1536 + l], ma = mu[1600 + l];
#pragma unroll
            for (int i = 0; i < 8; ++i) {
                const int t = t0 + i; const bool valid = !meta || t < NMETA;
                float cr = 0.f, ck = 0.f, cv = 0.f, cw = 0.f, ca = 0.f;
                if (valid) { const bf16* pp = P + (size_t)(row0 + t) * PW; cr = bf2f(pp[PC_R + ch]); ck = bf2f(pp[PC_K + ch]); cv = bf2f(pp[PC_V + ch]); cw = bf2f(pp[PC_WD + l]); ca = bf2f(pp[PC_AD + l]); }
                r_s[i] = valid ? cr + (pr - cr) * mr : 0.f; k_s[i] = valid ? ck + (pk - ck) * mk : 0.f; v_s[i] = valid ? cv + (pv - cv) * mv : 0.f;
                xw[i] = tanhf(cw + (pw - cw) * mw); xa[i] = ca + (pa - ca) * ma;
                pr = cr; pk = ck; pv = cv; pw = cw; pa = ca;
            }
#pragma unroll
            for (int i = 0; i < 8; ++i) { SL(8)[(t0 + i) * RP + l] = (bf16)f2bf(xw[i]); SL(9)[(t0 + i) * RP + l] = (bf16)f2bf(xa[i]); }
            {
                const int k = tid >> 3, pc = tid & 7;
                *(LAS v4u*)(SL(10) + k * RP + 8 * pc) = *(const v4u*)(WdT + (size_t)(h * 64 + k) * 64 + 8 * pc);
                *(LAS v4u*)(SL(11) + k * RP + 8 * pc) = *(const v4u*)(WaT + (size_t)(h * 64 + k) * 64 + 8 * pc);
            }
        }
        __syncthreads();
        {
            const int pid = w >> 2, q = w & 3, qr = q >> 1, qc = q & 1;
            f32x16 acc = zero16();
            quad_mma(acc, SL(10 + pid), SL(8 + pid), qr, qc, l);
            LAS float* Zf = pid ? AL : WL;
            const int r = l & 31, hf = l >> 5;
#pragma unroll
            for (int jj = 0; jj < 4; ++jj) *(LAS f32x4*)(Zf + (32 * qc + r) * FP + 32 * qr + 8 * jj + 4 * hf) = (f32x4){acc[4 * jj], acc[4 * jj + 1], acc[4 * jj + 2], acc[4 * jj + 3]};
        }
        __syncthreads();
        float lw[8], asg[8];
        {
            const float w0c = F.in[IN_W0][ch], a0c = F.in[IN_A0][ch];
            float run = 0.f;
#pragma unroll
            for (int i = 0; i < 8; ++i) {
                const int t = 8 * w + i; const bool valid = !meta || t < NMETA;
                const float x = -(WL[t * FP + l] + w0c);
                const float sp = x > 20.f ? x : log1pf(__expf(x));
                const float e = -__expf(-sp - 0.5f);
                run += valid ? e : 0.f; lw[i] = run;
                asg[i] = sigmoidf_(AL[t * FP + l] + a0c);
            }
            OT[w * 64 + l] = run;
        }
        __syncthreads();
        {
            float off = 0.f, tot = 0.f;
#pragma unroll
            for (int ww = 0; ww < 8; ++ww) { const float o = OT[ww * 64 + l]; tot += o; off += ww < w ? o : 0.f; }
            if (w == 0) GL[l] = __expf(tot);
            const float kkc = F.in[IN_KK][ch], kac = F.in[IN_KA][ch], rkc = F.in[IN_RK][ch];
            unsigned atc[4], vc[4], bhc[4], khc[4];
            float prevlg = off;
#pragma unroll
            for (int i = 0; i < 8; ++i) {
                const int t = 8 * w + i;
                const float lg = off + lw[i];
                const float g = __expf(lg), gp = __expf(prevlg), gi = __expf(-lg), gh = __expf(tot - lg);
                prevlg = lg;
                const float kkr = k_s[i] * kkc;
                const float nrm = sqrtf(wave_sum(kkr * kkr));
                const float kk = kkr / fmaxf(nrm, 1e-12f);
                const float k2 = k_s[i] * (1.f + (asg[i] - 1.f) * kac);
                const float bon = wave_sum(r_s[i] * k2 * rkc);
                if (l == 0) BONUS[(size_t)u * 64 + t] = bon;
                const float at = -kk * gp, rt = r_s[i] * g, bt = kk * asg[i] * gi, kt = k2 * gi, bh = kk * asg[i] * gh, kh = k2 * gh;
                SL(0)[t * RP + l] = (bf16)f2bf(at); SL(1)[t * RP + l] = (bf16)f2bf(rt); SL(2)[t * RP + l] = (bf16)f2bf(bt); SL(3)[t * RP + l] = (bf16)f2bf(kt);
                const unsigned ua = f2bf(at), uv = f2bf(v_s[i]), ub = f2bf(bh), uk = f2bf(kh);
                if (i & 1) { atc[i >> 1] |= ua << 16; vc[i >> 1] |= uv << 16; bhc[i >> 1] |= ub << 16; khc[i >> 1] |= uk << 16; }
                else { atc[i >> 1] = ua; vc[i >> 1] = uv; bhc[i >> 1] = ub; khc[i >> 1] = uk; }
            }
            *(LAS v4u*)(SL(4) + l * RP + 8 * w) = (v4u){atc[0], atc[1], atc[2], atc[3]};
            *(LAS v4u*)(SL(5) + l * RP + 8 * w) = (v4u){vc[0], vc[1], vc[2], vc[3]};
            *(LAS v4u*)(SL(6) + l * RP + 8 * w) = (v4u){bhc[0], bhc[1], bhc[2], bhc[3]};
            *(LAS v4u*)(SL(7) + l * RP + 8 * w) = (v4u){khc[0], khc[1], khc[2], khc[3]};
        }
        __syncthreads();
        for (int task = w; task < 20; task += 8) {
            const int pid = task >> 2, q = task & 3, qr = q >> 1, qc = q & 1;
            const int bop = pid == 0 ? 0 : pid == 1 ? 2 : pid == 2 ? 0 : 1;
            const int aop = pid == 0 ? 2 : pid == 1 ? 0 : pid == 2 ? 3 : pid == 3 ? 2 : 3;
            f32x16 acc = zero16();
            quad_mma(acc, SL(aop), SL(bop), qr, qc, l);
            const int n = 32 * qc + (l & 31), hf = l >> 5;
#pragma unroll
            for (int j = 0; j < 16; ++j) {
                const int m = ACC_M(qr, j, hf);
                const bool keep = pid == 1 ? (m > n) : (pid <= 2 ? (n > m) : (n >= m));
                acc[j] = keep ? acc[j] : 0.f;
            }
            store_T(acc, SL(8 + pid), qr, qc, l);
        }
        __syncthreads();
        const int nq = w & 3, nqr = nq >> 1, nqc = nq & 1;
        f32x16 nacc = zero16();
        if (w < 4) { add_T(nacc, SL(8), nqr, nqc, l); }
        for (int task = w; task < 12; task += 8) {
            const int pid = task >> 2, q = task & 3, qr = q >> 1, qc = q & 1;
            f32x16 acc = zero16();
            if (pid == 0) { quad_mma(acc, SL(9), SL(8), qr, qc, l); store_T(acc, SL(0), qr, qc, l); }
            else if (pid == 1) { quad_mma(acc, SL(8), SL(9), qr, qc, l); store_T(acc, SL(2), qr, qc, l); }
            else { quad_mma(acc, SL(10), SL(5), qr, qc, l); store_T(acc, SL(3), qr, qc, l); }
        }
        __syncthreads();
#pragma unroll
        for (int st = 0; st < 4; ++st) {
            const int pr = (st & 1) ? 10 : 0, pc = (st & 1) ? 13 : 2, pr2 = (st & 1) ? 0 : 10, pc2 = (st & 1) ? 2 : 13, nr = (st & 1) ? 9 : 8, nr2 = (st & 1) ? 8 : 9;
            if (w < 4) {
                add_T(nacc, SL(pr), nqr, nqc, l);
                quad_mma(nacc, SL(pc), SL(nr), nqr, nqc, l);
                store_T(nacc, SL(nr2), nqr, nqc, l);
                f32x16 acc = zero16();
                quad_mma(acc, SL(pc), SL(pr), nqr, nqc, l); store_T(acc, SL(pr2), nqr, nqc, l);
            } else {
                f32x16 acc = zero16();
                quad_mma(acc, SL(pr), SL(pc), nqr, nqc, l); store_T(acc, SL(pc2), nqr, nqc, l);
            }
            __syncthreads();
        }
        if (w < 4) { add_T(nacc, SL(0), nqr, nqc, l); quad_mma(nacc, SL(2), SL(8), nqr, nqc, l); store_T(nacc, SL(9), nqr, nqc, l); }
        __syncthreads();
        {
            const int pid = w >> 2;
            f32x16 acc = zero16();
            add_T(acc, SL(pid ? 3 : 4), nqr, nqc, l);
            quad_mma(acc, SL(9), SL(pid ? 3 : 4), nqr, nqc, l);
            store_T(acc, SL(pid ? 2 : 0), nqr, nqc, l);
        }
        __syncthreads();
        for (int task = w; task < 16; task += 8) {
            const int pid = task >> 2, q = task & 3, qr = q >> 1, qc = q & 1;
            f32x16 acc = zero16();
            if (pid == 0) { add_T(acc, SL(1), qr, qc, l); quad_mma(acc, SL(0), SL(11), qr, qc, l); store_T_global(acc, RWQ + (size_t)u * 4096, qr, qc, l); }
            else if (pid == 1) { quad_mma(acc, SL(2), SL(11), qr, qc, l); quad_mma(acc, SL(5), SL(12), qr, qc, l); store_T_global(acc, RWY + (size_t)u * 4096, qr, qc, l); }
            else if (pid == 2) {
                quad_mma(acc, SL(0), SL(6), qr, qc, l);
                const int n = 32 * qc + (l & 31), hf = l >> 5; const float gl = GL[n];
#pragma unroll
                for (int j = 0; j < 16; ++j) acc[j] += (ACC_M(qr, j, hf) == n) ? gl : 0.f;
                store_T_global(acc, RWM + (size_t)u * 4096, qr, qc, l);
            } else { quad_mma(acc, SL(6), SL(2), qr, qc, l); quad_mma(acc, SL(7), SL(5), qr, qc, l); store_T_global(acc, RWN + (size_t)u * 4096, qr, qc, l); }
        }
    }
#undef SL
}

__device__ __forceinline__ void rw_b2(Frame& F) {
    if (blockIdx.x >= 32) return;
    const bf16* RWM = WSP(bf16, WS_RWM); const bf16* RWN = WSP(bf16, WS_RWN);
    bf16* RWS = (bf16*)((char*)F.out + OUT_RWS);
    const int b = blockIdx.x >> 3, h = blockIdx.x & 7, w = F.wave, l = F.lane;
    LAS unsigned char* L = F.lds;
#define SS(buf, part) ((LAS bf16*)(L + ((buf) * 2 + (part)) * SLOT))
    const int q = w & 3, qr = q >> 1, qc = q & 1, r = l & 31, hf = l >> 5;
    if (w < 4) {
        const bf16* Nm = RWN + (size_t)(4096 + h) * 4096;
#pragma unroll
        for (int jj = 0; jj < 4; ++jj) {
            const v2u wv = *(const v2u*)(Nm + (32 * qc + r) * 64 + 32 * qr + 8 * jj + 4 * hf);
            *(LAS v2u*)(SS(0, 0) + (32 * qc + r) * RP + 32 * qr + 8 * jj + 4 * hf) = wv;
            *(LAS v2u*)(SS(0, 1) + (32 * qc + r) * RP + 32 * qr + 8 * jj + 4 * hf) = (v2u){0u, 0u};
        }
    }
    __syncthreads();
    bf16x8 a_cur[4]; v2u n_cur[4];
    {
        const size_t u0 = (size_t)(b * 8 + h) * 128;
#pragma unroll
        for (int ks = 0; ks < 4; ++ks) a_cur[ks] = *(const bf16x8*)(RWM + u0 * 4096 + (32 * qr + r) * 64 + 8 * hf + 16 * ks);
#pragma unroll
        for (int jj = 0; jj < 4; ++jj) n_cur[jj] = *(const v2u*)(RWN + u0 * 4096 + (32 * qc + r) * 64 + 32 * qr + 8 * jj + 4 * hf);
    }
    for (int c = 0; c < 128; ++c) {
        const int u = (b * 8 + h) * 128 + c, cur = c & 1;
        if (w < 4) {
            bf16x8 a_nxt[4]; v2u n_nxt[4];
            const size_t un = (size_t)(c + 1 < 128 ? u + 1 : u);
#pragma unroll
            for (int ks = 0; ks < 4; ++ks) a_nxt[ks] = *(const bf16x8*)(RWM + un * 4096 + (32 * qr + r) * 64 + 8 * hf + 16 * ks);
#pragma unroll
            for (int jj = 0; jj < 4; ++jj) n_nxt[jj] = *(const v2u*)(RWN + un * 4096 + (32 * qc + r) * 64 + 32 * qr + 8 * jj + 4 * hf);
            f32x16 acc;
#pragma unroll
            for (int jj = 0; jj < 4; ++jj) { acc[4 * jj] = bflo(n_cur[jj].x); acc[4 * jj + 1] = bfhi(n_cur[jj].x); acc[4 * jj + 2] = bflo(n_cur[jj].y); acc[4 * jj + 3] = bfhi(n_cur[jj].y); }
#pragma unroll
            for (int jj = 0; jj < 4; ++jj)
                *(v2u*)(RWS + (size_t)u * 4096 + (32 * qc + r) * 64 + 32 * qr + 8 * jj + 4 * hf) = *(const LAS v2u*)(SS(cur, 0) + (32 * qc + r) * RP + 32 * qr + 8 * jj + 4 * hf);
            const LAS bf16* bh = SS(cur, 0) + (32 * qc + r) * RP + 8 * hf; const LAS bf16* bl = SS(cur, 1) + (32 * qc + r) * RP + 8 * hf;
#pragma unroll
            for (int ks = 0; ks < 4; ++ks) {
                acc = __builtin_amdgcn_mfma_f32_32x32x16_bf16(a_cur[ks], *(const LAS bf16x8*)(bh + 16 * ks), acc, 0, 0, 0);
                acc = __builtin_amdgcn_mfma_f32_32x32x16_bf16(a_cur[ks], *(const LAS bf16x8*)(bl + 16 * ks), acc, 0, 0, 0);
            }
#pragma unroll
            for (int jj = 0; jj < 4; ++jj) {
                float hi[4], lo[4];
#pragma unroll
                for (int e = 0; e < 4; ++e) { const unsigned hb = f2bf(acc[4 * jj + e]); hi[e] = __uint_as_float(hb << 16); lo[e] = acc[4 * jj + e] - hi[e]; }
                *(LAS v2u*)(SS(cur ^ 1, 0) + (32 * qc + r) * RP + 32 * qr + 8 * jj + 4 * hf) = (v2u){pk2(hi[0], hi[1]), pk2(hi[2], hi[3])};
                *(LAS v2u*)(SS(cur ^ 1, 1) + (32 * qc + r) * RP + 32 * qr + 8 * jj + 4 * hf) = (v2u){pk2(lo[0], lo[1]), pk2(lo[2], lo[3])};
            }
#pragma unroll
            for (int ks = 0; ks < 4; ++ks) a_cur[ks] = a_nxt[ks];
#pragma unroll
            for (int jj = 0; jj < 4; ++jj) n_cur[jj] = n_nxt[jj];
        }
        __syncthreads();
    }
#undef SS
}

__device__ __forceinline__ void rw_b3(Frame& F) {
    const bf16* P = WSP(bf16, WS_P); bf16* QA = WSP(bf16, WS_QA);
    const bf16* RWQ = WSP(bf16, WS_RWQ); const bf16* RWY = WSP(bf16, WS_RWY);
    const bf16* RWS = (const bf16*)((const char*)F.out + OUT_RWS); const float* BONUS = (const float*)((const char*)F.out + OUT_BONUS);
    const bf16* WgT = WSP(bf16, WS_WT_LORA) + 2 * 512 * 64;
    const float* mu = F.in[IN_MU];
    const int l = F.lane, r = l & 31, hf = l >> 5;
    const int gw = blockIdx.x * NWAVES + F.wave, NGW = F.G * NWAVES;
    for (int it = gw; it < NUNITS * 2; it += NGW) {
        const int u = it >> 1, th = it & 1;
        const bool meta = u >= 4096;
        int b = 0, h, c = 0; if (meta) h = u - 4096; else { b = u >> 10; h = (u >> 7) & 7; c = u & 127; }
        if (meta && th == 1) continue;
        const int t = 32 * th + r;
        const bool valid = !meta || t < NMETA;
        const int row0 = meta ? NREAL : b * SEQ + c * 64;
        const int row = valid ? row0 + t : row0;
        int prow = -1;
        if (t > 0) prow = row - 1; else if (!meta) prow = (c == 0) ? NREAL + NMETA - 1 : row - 1;
        f32x16 y[2];
#pragma unroll
        for (int qv = 0; qv < 2; ++qv) {
            const bf16* Y0 = RWY + (size_t)u * 4096 + (32 * th + r) * 64 + 32 * qv + 4 * hf;
#pragma unroll
            for (int jj = 0; jj < 4; ++jj) { const v2u wv = *(const v2u*)(Y0 + 8 * jj); y[qv][4 * jj] = bflo(wv.x); y[qv][4 * jj + 1] = bfhi(wv.x); y[qv][4 * jj + 2] = bflo(wv.y); y[qv][4 * jj + 3] = bfhi(wv.y); }
        }
        if (!meta) {
            const bf16* qp = RWQ + (size_t)u * 4096 + (32 * th + r) * 64 + 8 * hf;
            const bf16* sp = RWS + (size_t)u * 4096 + r * 64 + 8 * hf;
#pragma unroll
            for (int ks = 0; ks < 4; ++ks) {
                const bf16x8 bq = *(const bf16x8*)(qp + 16 * ks);
                y[0] = __builtin_amdgcn_mfma_f32_32x32x16_bf16(*(const bf16x8*)(sp + 16 * ks), bq, y[0], 0, 0, 0);
                y[1] = __builtin_amdgcn_mfma_f32_32x32x16_bf16(*(const bf16x8*)(sp + 32 * 64 + 16 * ks), bq, y[1], 0, 0, 0);
            }
        }
        f32x16 g[2]; g[0] = zero16(); g[1] = zero16();
        {
            const bf16* gp = P + (size_t)row * PW + PC_GD + 8 * hf; const bf16* gpp = prow >= 0 ? P + (size_t)prow * PW + PC_GD + 8 * hf : nullptr;
            const bf16* wp = WgT + (size_t)(h * 64 + r) * 128 + 8 * hf;
#pragma unroll
            for (int ks = 0; ks < 8; ++ks) {
                const v4u cg = *(const v4u*)(gp + 16 * ks); const v4u pg = gpp ? *(const v4u*)(gpp + 16 * ks) : (v4u){0u, 0u, 0u, 0u};
                const f32x4 m0 = *(const f32x4*)(mu + 1664 + 16 * ks + 8 * hf), m1 = *(const f32x4*)(mu + 1664 + 16 * ks + 8 * hf + 4);
                const unsigned cw[4] = {cg.x, cg.y, cg.z, cg.w}, pw[4] = {pg.x, pg.y, pg.z, pg.w}; const float mm[8] = {m0.x, m0.y, m0.z, m0.w, m1.x, m1.y, m1.z, m1.w};
                unsigned o[4];
#pragma unroll
                for (int e = 0; e < 4; ++e) {
                    const float c0 = bflo(cw[e]), c1 = bfhi(cw[e]), p0 = bflo(pw[e]), p1 = bfhi(pw[e]);
                    o[e] = pk2(sigmoidf_(c0 + (p0 - c0) * mm[2 * e]), sigmoidf_(c1 + (p1 - c1) * mm[2 * e + 1]));
                }
                const v4u ov = (v4u){o[0], o[1], o[2], o[3]};
                const bf16x8 bs = __builtin_bit_cast(bf16x8, ov);
                g[0] = __builtin_amdgcn_mfma_f32_32x32x16_bf16(*(const bf16x8*)(wp + 16 * ks), bs, g[0], 0, 0, 0);
                g[1] = __builtin_amdgcn_mfma_f32_32x32x16_bf16(*(const bf16x8*)(wp + 32 * 128 + 16 * ks), bs, g[1], 0, 0, 0);
            }
        }
        float s = 0.f;
#pragma unroll
        for (int j = 0; j < 16; ++j) s += y[0][j] + y[1][j];
        s += __shfl_xor(s, 32);
        const float mean = s * (1.f / 64.f);
        float s2 = 0.f;
#pragma unroll
        for (int j = 0; j < 16; ++j) { const float d0 = y[0][j] - mean, d1 = y[1][j] - mean; s2 += d0 * d0 + d1 * d1; }
        s2 += __shfl_xor(s2, 32);
        const float rstd = 1.0f / sqrtf(s2 * (1.f / 64.f) + GN_EPS);
        const float bon = BONUS[(size_t)u * 64 + t];
        if (valid) {
#pragma unroll
            for (int qv = 0; qv < 2; ++qv)
#pragma unroll
                for (int jj = 0; jj < 4; ++jj) {
                    const int v0 = 32 * qv + 8 * jj + 4 * hf, chv = h * 64 + v0;
                    const v2u cvw = *(const v2u*)(P + (size_t)row * PW + PC_V + chv); const v2u pvw = prow >= 0 ? *(const v2u*)(P + (size_t)prow * PW + PC_V + chv) : (v2u){0u, 0u};
                    const f32x4 mv = *(const f32x4*)(mu + 1024 + chv), gg = *(const f32x4*)(F.in[IN_GN_G] + chv), gb = *(const f32x4*)(F.in[IN_GN_B] + chv);
                    const float cv[4] = {bflo(cvw.x), bfhi(cvw.x), bflo(cvw.y), bfhi(cvw.y)}, pv[4] = {bflo(pvw.x), bfhi(pvw.x), bflo(pvw.y), bfhi(pvw.y)};
                    const float mvv[4] = {mv.x, mv.y, mv.z, mv.w}, ggv[4] = {gg.x, gg.y, gg.z, gg.w}, gbv[4] = {gb.x, gb.y, gb.z, gb.w};
                    float o[4];
#pragma unroll
                    for (int e = 0; e < 4; ++e) {
                        const float vs = cv[e] + (pv[e] - cv[e]) * mvv[e];
                        o[e] = ((y[qv][4 * jj + e] - mean) * rstd * ggv[e] + gbv[e] + bon * vs) * g[qv][4 * jj + e];
                    }
                    *(v2u*)(QA + (size_t)row * QAW + 1024 + chv) = (v2u){pk2(o[0], o[1]), pk2(o[2], o[3])};
                }
        }
    }
}

constexpr int IX_CAP = 512, IX_LIST = 3072, IX_KB = 98304, IX_SCR = RING_BYTES + 4096;
#define IX_FENCE() asm volatile("s_waitcnt lgkmcnt(0)" ::: "memory")

__device__ __forceinline__ unsigned ix_mbcnt(unsigned long long m) { return __builtin_amdgcn_mbcnt_hi((unsigned)(m >> 32), __builtin_amdgcn_mbcnt_lo((unsigned)m, 0u)); }

__device__ __forceinline__ void ix_select_slow(const float (&sc)[8], const unsigned (&ix)[8], bool (&vl)[8], int K, unsigned short* sel_out, int lane) {
    for (int it = 0; it < K; ++it) {
        unsigned long long best = 0ull;
#pragma unroll
        for (int i = 0; i < 8; ++i) { const unsigned long long key = ((unsigned long long)sortable(sc[i]) << 32) | (unsigned long long)(0xFFFFu - ix[i]) | 0x10000ull; if (vl[i] && key > best) best = key; }
        unsigned long long wm = best;
#pragma unroll
        for (int o = 1; o < 64; o <<= 1) { const unsigned long long v = __shfl_xor(wm, o); wm = v > wm ? v : wm; }
        if (wm == 0ull) break;
        const bool mine = best == wm;
#pragma unroll
        for (int i = 0; i < 8; ++i) { const unsigned long long key = ((unsigned long long)sortable(sc[i]) << 32) | (unsigned long long)(0xFFFFu - ix[i]) | 0x10000ull; if (mine && vl[i] && key == wm) { vl[i] = false; sel_out[it] = (unsigned short)ix[i]; } }
    }
}

__device__ __forceinline__ void ix_compact(LAS float* LS, LAS unsigned short* LI, LAS unsigned* hist, int& cnt, float& tau, int lane, bool final_sel, unsigned short* sel_out) {
    const int n = cnt;
    float sc[8]; unsigned ix[8]; bool vl[8];
    IX_FENCE();
#pragma unroll
    for (int i = 0; i < 8; ++i) { const int p = lane + 64 * i; vl[i] = p < n; sc[i] = vl[i] ? LS[p] : -INFINITY; ix[i] = vl[i] ? (unsigned)LI[p] : 0u; }
    float mx = -INFINITY, mn = INFINITY;
#pragma unroll
    for (int i = 0; i < 8; ++i) { if (vl[i]) { mx = fmaxf(mx, sc[i]); mn = fminf(mn, sc[i]); } }
    mx = wave_max(mx); mn = -wave_max(-mn);
    const float scale = mx > mn ? 255.99f / (mx - mn) : 0.f;
    int bin[8];
#pragma unroll
    for (int i = 0; i < 8; ++i) { int bq = (int)((sc[i] - mn) * scale); bq = bq > 255 ? 255 : (bq < 0 ? 0 : bq); bin[i] = vl[i] ? bq : -1; }
    *(LAS v4u*)(hist + 4 * lane) = (v4u){0u, 0u, 0u, 0u};
    IX_FENCE();
#pragma unroll
    for (int i = 0; i < 8; ++i) if (vl[i]) __hip_atomic_fetch_add((LAS unsigned*)&hist[bin[i]], 1u, __ATOMIC_RELAXED, __HIP_MEMORY_SCOPE_WAVEFRONT);
    IX_FENCE();
    const v4u c = *(const LAS v4u*)(hist + 4 * lane);
    unsigned Pp = c.x + c.y + c.z + c.w;
#pragma unroll
    for (int o = 1; o < 64; o <<= 1) { const unsigned v = __shfl_up(Pp, o); if (lane >= o) Pp += v; }
    const unsigned total = __shfl(Pp, 63);
    const unsigned K = TOPK;
    const unsigned a3 = total - Pp, a2 = a3 + c.w, a1 = a2 + c.z, a0 = a1 + c.y;
    int myb = -1; unsigned myA = 0u, myC = 0u;
    if (a3 < K && K <= a3 + c.w) { myb = 4 * lane + 3; myA = a3; myC = c.w; }
    else if (a2 < K && K <= a2 + c.z) { myb = 4 * lane + 2; myA = a2; myC = c.z; }
    else if (a1 < K && K <= a1 + c.y) { myb = 4 * lane + 1; myA = a1; myC = c.y; }
    else if (a0 < K && K <= a0 + c.x) { myb = 4 * lane; myA = a0; myC = c.x; }
    const unsigned long long bm = __ballot(myb >= 0);
    const int src = bm ? (__ffsll((long long)bm) - 1) : 0;
    const int bstar = __shfl(myb, src); const unsigned A = __shfl(myA, src), m = __shfl(myC, src);
    if (!final_sel) {
        if (A + m <= (unsigned)(IX_CAP - 96)) {
            int base = 0; float kmin = INFINITY;
#pragma unroll
            for (int i = 0; i < 8; ++i) {
                const bool keep = vl[i] && bin[i] >= bstar;
                const unsigned long long mk = __ballot(keep);
                const int pos = base + (int)ix_mbcnt(mk);
                if (keep) { LS[pos] = sc[i]; LI[pos] = (unsigned short)ix[i]; kmin = fminf(kmin, sc[i]); }
                base += __popcll(mk);
            }
            cnt = base; tau = -wave_max(-kmin);
            IX_FENCE();
            return;
        }
        unsigned short* tmp = sel_out;
        ix_select_slow(sc, ix, vl, (int)K, tmp, lane);
        int base = 0; float kmin = INFINITY;
#pragma unroll
        for (int i = 0; i < 8; ++i) {
            const bool keep = !vl[i] && (lane + 64 * i) < n;
            const unsigned long long mk = __ballot(keep);
            const int pos = base + (int)ix_mbcnt(mk);
            if (keep) { LS[pos] = sc[i]; LI[pos] = (unsigned short)ix[i]; kmin = fminf(kmin, sc[i]); }
            base += __popcll(mk);
        }
        cnt = base; tau = -wave_max(-kmin);
        IX_FENCE();
        return;
    }
    if (m <= 128u) {
        int base = 0;
#pragma unroll
        for (int i = 0; i < 8; ++i) {
            const bool keep = vl[i] && bin[i] > bstar;
            const unsigned long long mk = __ballot(keep);
            const int pos = base + (int)ix_mbcnt(mk);
            if (keep) sel_out[pos] = (unsigned short)ix[i];
            base += __popcll(mk);
        }
        LAS float* sS = (LAS float*)hist; LAS unsigned* sI = hist + 128;
        IX_FENCE();
        int mb = 0;
#pragma unroll
        for (int i = 0; i < 8; ++i) {
            const bool inb = vl[i] && bin[i] == bstar;
            const unsigned long long mk = __ballot(inb);
            const int pos = mb + (int)ix_mbcnt(mk);
            if (inb) { sS[pos] = sc[i]; sI[pos] = ix[i]; }
            mb += __popcll(mk);
        }
        IX_FENCE();
        const int need = (int)(K - A);
#pragma unroll
        for (int e = 0; e < 2; ++e) {
            const int j = lane + 64 * e;
            if (j < (int)m) {
                const float sj = sS[j]; const unsigned ij = sI[j]; int rank = 0;
                for (int k = 0; k < (int)m; ++k) { const float sk = sS[k]; const unsigned ik = sI[k]; rank += (sk > sj || (sk == sj && ik < ij)) ? 1 : 0; }
                if (rank < need) sel_out[(int)A + rank] = (unsigned short)ij;
            }
        }
    } else {
        ix_select_slow(sc, ix, vl, (int)K, sel_out, lane);
    }
}

__device__ __forceinline__ void p5_index_mfma(Frame& F, unsigned short* SEL, int* NSEL) {
    const bf16* QA = WSP(bf16, WS_QA); const bf16* KIDX = WSP(bf16, WS_KIDX); const float* WIDX = WSP(float, WS_WIDX);
    const int tid = F.tid, w = F.wave, l = F.lane, r = l & 31, hf = l >> 5;
    {
        const int gw = blockIdx.x * NWAVES + w, NGW = F.G * NWAVES;
        for (int i = gw; i < NMETA + BATCH * 192; i += NGW) {
            int q, nvis; if (i < NMETA) { q = NREAL + i; nvis = NMETA; } else { const int bb = (i - NMETA) / 192, s = (i - NMETA) % 192; q = bb * SEQ + s; nvis = NMETA + 64 * (s / 64 + 1); }
            for (int j = l; j < nvis; j += 64) SEL[(size_t)q * TOPK + j] = (unsigned short)j;
            if (l == 0) NSEL[q] = nvis;
        }
    }
    LAS unsigned char* L = F.lds;
    LAS unsigned* hist = (LAS unsigned*)(L + IX_SCR + w * 1024);
    {
        for (int i = blockIdx.x; i < 1024; i += F.G) {
            const int kq = i >> 8;
            const int tile = (kq & 1) ? ((kq == 1 ? 767 : 1791) - i) : i;
            if (tile >= 1000) continue;
            const int pt = 6 + (tile >> 2), b = tile & 3;
            const int q0 = b * SEQ + pt * 32;
            const int nvis = NMETA + 64 * (pt / 2 + 1);
            const int nblk = (nvis + 127) >> 7;
            __syncthreads();
            bf16x8 af[4];
            {
                const int qq = 2 * (r >> 4) + ((r >> 2) & 1), hd = 4 * ((r >> 3) & 1) + (r & 3);
                const bf16* qp = QA + (size_t)(q0 + 4 * w + qq) * QAW + 1024 + hd * 64 + 8 * hf;
#pragma unroll
                for (int ks = 0; ks < 4; ++ks) af[ks] = *(const bf16x8*)(qp + 16 * ks);
            }
            float wq[2][8];
#pragma unroll
            for (int a = 0; a < 2; ++a) {
                const f32x4 w0 = *(const f32x4*)(WIDX + (size_t)(q0 + 4 * w + 2 * a + hf) * 8), w1 = *(const f32x4*)(WIDX + (size_t)(q0 + 4 * w + 2 * a + hf) * 8 + 4);
                wq[a][0] = w0.x; wq[a][1] = w0.y; wq[a][2] = w0.z; wq[a][3] = w0.w; wq[a][4] = w1.x; wq[a][5] = w1.y; wq[a][6] = w1.z; wq[a][7] = w1.w;
            }
            float tau0 = -INFINITY, tau1 = -INFINITY;
            int cnt[4] = {0, 0, 0, 0};
            v4u kreg[2];
#pragma unroll
            for (int e = 0; e < 2; ++e) {
                const int pid = tid + 512 * e, kl = pid >> 3, pc = pid & 7, j = kl;
                kreg[e] = j < nvis ? *(const v4u*)(KIDX + (size_t)key_row(b, j) * 64 + 8 * pc) : (v4u){0u, 0u, 0u, 0u};
            }
#pragma unroll
            for (int e = 0; e < 2; ++e) { const int pid = tid + 512 * e, kl = pid >> 3, pc = pid & 7; *(LAS v4u*)(L + IX_KB + kl * 128 + ((pc ^ ((kl >> 1) & 7)) << 4)) = kreg[e]; }
            __syncthreads();
            for (int blk = 0; blk < nblk; ++blk) {
                const int cur = blk & 1;
                if (blk + 1 < nblk) {
#pragma unroll
                    for (int e = 0; e < 2; ++e) {
                        const int pid = tid + 512 * e, kl = pid >> 3, pc = pid & 7, j = (blk + 1) * 128 + kl;
                        kreg[e] = j < nvis ? *(const v4u*)(KIDX + (size_t)key_row(b, j) * 64 + 8 * pc) : (v4u){0u, 0u, 0u, 0u};
                    }
                }
                const LAS unsigned char* kb = L + IX_KB + cur * 16384;
                for (int tt = 0; tt < 4; ++tt) {
                    const int jbase = blk * 128 + tt * 32;
                    if (jbase >= nvis) break;
                    const int kl = tt * 32 + r;
                    f32x16 acc = zero16();
#pragma unroll
                    for (int ks = 0; ks < 4; ++ks) {
                        const bf16x8 bfr = *(const LAS bf16x8*)(kb + kl * 128 + (((2 * ks + hf) ^ ((kl >> 1) & 7)) << 4));
                        acc = __builtin_amdgcn_mfma_f32_32x32x16_bf16(af[ks], bfr, acc, 0, 0, 0);
                    }
                    const int j = jbase + r;
                    float s0 = 0.f, s1 = 0.f;
#pragma unroll
                    for (int h = 0; h < 8; ++h) { s0 += wq[0][h] * fmaxf(acc[h], 0.f); s1 += wq[1][h] * fmaxf(acc[8 + h], 0.f); }
                    s0 += 0.0f; s1 += 0.0f;
                    const bool p0 = j < nvis && s0 > tau0, p1 = j < nvis && s1 > tau1;
                    const unsigned long long m0 = __ballot(p0), m1 = __ballot(p1);
                    if (m0 | m1) {
                        const int c0lo = __popc((unsigned)m0), c0hi = __popc((unsigned)(m0 >> 32)), c1lo = __popc((unsigned)m1), c1hi = __popc((unsigned)(m1 >> 32));
                        {
                            const int pos = (hf ? cnt[1] - c0lo : cnt[0]) + (int)ix_mbcnt(m0);
                            if (p0) { LAS unsigned char* lb = L + (w * 4 + hf) * IX_LIST; ((LAS float*)lb)[pos] = s0; ((LAS unsigned short*)(lb + 2048))[pos] = (unsigned short)j; }
                        }
                        {
                            const int pos = (hf ? cnt[3] - c1lo : cnt[2]) + (int)ix_mbcnt(m1);
                            if (p1) { LAS unsigned char* lb = L + (w * 4 + 2 + hf) * IX_LIST; ((LAS float*)lb)[pos] = s1; ((LAS unsigned short*)(lb + 2048))[pos] = (unsigned short)j; }
                        }
                        cnt[0] += c0lo; cnt[1] += c0hi; cnt[2] += c1lo; cnt[3] += c1hi;
#pragma unroll
                        for (int qq = 0; qq < 4; ++qq) {
                            if (cnt[qq] > IX_CAP - 32) {
                                LAS unsigned char* lb = L + (w * 4 + qq) * IX_LIST;
                                float tq = 0.f; int cq = cnt[qq];
                                ix_compact((LAS float*)lb, (LAS unsigned short*)(lb + 2048), hist, cq, tq, l, false, SEL + (size_t)(q0 + 4 * w + qq) * TOPK);
                                cnt[qq] = __builtin_amdgcn_readfirstlane(cq);
                                if ((qq & 1) == hf) { if (qq < 2) tau0 = tq; else tau1 = tq; }
                            }
                        }
                    }
                }
                if (blk + 1 < nblk) {
#pragma unroll
                    for (int e = 0; e < 2; ++e) { const int pid = tid + 512 * e, kl = pid >> 3, pc = pid & 7; *(LAS v4u*)(L + IX_KB + (cur ^ 1) * 16384 + kl * 128 + ((pc ^ ((kl >> 1) & 7)) << 4)) = kreg[e]; }
                }
                __syncthreads();
            }
#pragma unroll
            for (int qq = 0; qq < 4; ++qq) {
                LAS unsigned char* lb = L + (w * 4 + qq) * IX_LIST;
                float tq = 0.f; int cq = cnt[qq];
                ix_compact((LAS float*)lb, (LAS unsigned short*)(lb + 2048), hist, cq, tq, l, true, SEL + (size_t)(q0 + 4 * w + qq) * TOPK);
                if (l == 0) NSEL[q0 + 4 * w + qq] = TOPK;
            }
        }
    }
}

#ifndef CHECK_IDX
#define CHECK_IDX 0
#endif
#if CHECK_IDX
__device__ __forceinline__ void idx_check(Frame& F) {
    const unsigned short* SEL = WSP(unsigned short, WS_SEL); const unsigned short* SELB = (const unsigned short*)F.out; const int* NSEL = WSP(int, WS_NSEL); const int* NSELB = (const int*)((const char*)F.out + 32 * MiB);
    LAS unsigned* bm = (LAS unsigned*)(F.lds + F.wave * 2048);
    const int l = F.lane; const int gw = blockIdx.x * NWAVES + F.wave, NGW = F.G * NWAVES;
    unsigned miss = 0, badq = 0, dup = 0;
    for (int q = gw; q < NROWS; q += NGW) {
        for (int i = l; i < 260; i += 64) bm[i] = 0u;
        IX_FENCE();
        const int n = NSEL[q], nb = NSELB[q];
        for (int i = l; i < n; i += 64) { const unsigned j = SEL[(size_t)q * TOPK + i]; atomicOr((unsigned*)&bm[j >> 5], 1u << (j & 31)); }
        IX_FENCE();
        unsigned m = (n != nb) ? 1000u : 0u;
        for (int i = l; i < nb && i < TOPK; i += 64) { const unsigned j = SELB[(size_t)q * TOPK + i]; if (j >= (unsigned)TT) { ++dup; ++m; } else { const unsigned old = atomicAnd((unsigned*)&bm[j >> 5], ~(1u << (j & 31))); if (!((old >> (j & 31)) & 1u)) ++m; } }
        IX_FENCE();
        m = (unsigned)wave_sum((float)m);
        if (l == 0) { miss += m; badq += m ? 1u : 0u; }
    }
    dup = (unsigned)wave_sum((float)dup);
    if (l == 0) { atomicAdd((unsigned*)F.ctl + 2048, miss); atomicAdd((unsigned*)F.ctl + 2049, badq); atomicAdd((unsigned*)F.ctl + 2050, dup); }
}
#endif

typedef short v4i16_t __attribute__((ext_vector_type(4)));
__device__ __forceinline__ unsigned at_off(unsigned row, unsigned ch) { return 256u * row + 16u * (ch ^ (((row & 3u) << 2) | ((row >> 2) & 3u))); }

__device__ __forceinline__ void p6_attn_mfma(Frame& F) {
    bf16* QA = WSP(bf16, WS_QA); const bf16* CKV = WSP(bf16, WS_CKV); const unsigned short* SEL = WSP(unsigned short, WS_SEL); const int* NSEL = WSP(int, WS_NSEL);
    const int l = F.lane, w = F.wave, h16 = l & 15, g = l >> 4;
    LAS unsigned char* tile = F.lds + w * 8192;
    const float slope = h16 < 8 ? __uint_as_float((unsigned)(127 - (h16 + 1)) << 23) : 0.f;
    {
        const int gw = blockIdx.x * NWAVES + w, NGW = F.G * NWAVES;
        for (int q = NROWS + gw; q < R; q += NGW) { bf16* qrow = QA + (size_t)q * QAW; for (int c = l; c < QAW / 8; c += 64) *(v4u*)(qrow + 8 * c) = (v4u){0u, 0u, 0u, 0u}; }
    }
    const int G = F.G;
    int nq_tot, qbase_b, wib, wpb;
    if ((G & 7) == 0) { const int b = (blockIdx.x & 7) >> 1; qbase_b = b * SEQ; nq_tot = SEQ + (b == 0 ? NMETA : 0); wib = (((blockIdx.x >> 3) * 2) + (blockIdx.x & 1)) * NWAVES + w; wpb = (G / 4) * NWAVES; }
    else { qbase_b = 0; nq_tot = NROWS; wib = blockIdx.x * NWAVES + w; wpb = G * NWAVES; }
    for (int qi = wib; qi < nq_tot; qi += wpb) {
        int q, b, pos;
        if ((G & 7) == 0) { if (qi < SEQ) { q = qbase_b + qi; b = q >> 13; pos = NMETA + qi; } else { q = NREAL + (qi - SEQ); b = 0; pos = qi - SEQ; } }
        else { q = qi; if (q < NREAL) { b = q >> 13; pos = NMETA + (q & (SEQ - 1)); } else { b = 0; pos = q - NREAL; } }
        bf16* qrow = QA + (size_t)q * QAW;
        const int nsel = NSEL[q];
        const int nch = (nsel + 31) >> 5;
        const unsigned short* selq = SEL + (size_t)q * TOPK;
        bf16x8 qf[4];
#pragma unroll
        for (int s = 0; s < 4; ++s) { const v4u t = h16 < 8 ? *(const v4u*)(qrow + h16 * 128 + 32 * s + 8 * g) : (v4u){0u, 0u, 0u, 0u}; qf[s] = __builtin_bit_cast(bf16x8, t); }
        float m = -INFINITY, lsum = 0.f;
        f32x4 O[8];
#pragma unroll
        for (int c = 0; c < 8; ++c) O[c] = (f32x4){0.f, 0.f, 0.f, 0.f};
        v4u gr[8];
#pragma unroll
        for (int i = 0; i < 8; ++i) { const int s = g + 4 * i; const int kj = s < nsel ? (int)selq[s] : (int)selq[0]; gr[i] = *(const v4u*)(CKV + (size_t)key_row(b, kj) * 128 + 8 * h16); }
        for (int ck = 0; ck < nch; ++ck) {
            IX_FENCE();
#pragma unroll
            for (int i = 0; i < 8; ++i) *(LAS v4u*)(tile + at_off((unsigned)(g + 4 * i), (unsigned)h16)) = gr[i];
            const v4u kv = *(const v4u*)(selq + 32 * ck + 8 * g);
            if (ck + 1 < nch) {
#pragma unroll
                for (int i = 0; i < 8; ++i) { const int s = 32 * (ck + 1) + g + 4 * i; const int kj = s < nsel ? (int)selq[s] : (int)selq[0]; gr[i] = *(const v4u*)(CKV + (size_t)key_row(b, kj) * 128 + 8 * h16); }
            }
            IX_FENCE();
            f32x4 a0 = (f32x4){0.f, 0.f, 0.f, 0.f}, a1 = a0;
#pragma unroll
            for (int s = 0; s < 4; ++s) {
                const bf16x8 k0 = *(const LAS bf16x8*)(tile + at_off((unsigned)(8 * (h16 >> 2) + (h16 & 3)), (unsigned)(4 * s + g)));
                const bf16x8 k1 = *(const LAS bf16x8*)(tile + at_off((unsigned)(8 * (h16 >> 2) + 4 + (h16 & 3)), (unsigned)(4 * s + g)));
                a0 = __builtin_amdgcn_mfma_f32_16x16x32_bf16(k0, qf[s], a0, 0, 0, 0);
                a1 = __builtin_amdgcn_mfma_f32_16x16x32_bf16(k1, qf[s], a1, 0, 0, 0);
            }
            const unsigned kw[4] = {kv.x, kv.y, kv.z, kv.w};
            float x[8];
#pragma unroll
            for (int j = 0; j < 8; ++j) {
                const int kj = (int)((kw[j >> 1] >> (16 * (j & 1))) & 0xffffu);
                const float lg = (j < 4 ? a0[j & 3] : a1[j & 3]) - slope * fabsf((float)(pos - kj));
                x[j] = (32 * ck + 8 * g + j) < nsel ? lg : -INFINITY;
            }
            float cm = fmaxf(fmaxf(fmaxf(x[0], x[1]), fmaxf(x[2], x[3])), fmaxf(fmaxf(x[4], x[5]), fmaxf(x[6], x[7])));
            cm = fmaxf(cm, __shfl_xor(cm, 16)); cm = fmaxf(cm, __shfl_xor(cm, 32));
            const float mn = fmaxf(m, cm);
            const float alpha = __expf(m - mn);
            float p[8], ps = 0.f;
#pragma unroll
            for (int j = 0; j < 8; ++j) { p[j] = __expf(x[j] - mn); ps += p[j]; }
            ps += __shfl_xor(ps, 16); ps += __shfl_xor(ps, 32);
            lsum = lsum * alpha + ps; m = mn;
            if (__any(alpha != 1.0f)) {
#pragma unroll
                for (int rr = 0; rr < 4; ++rr) { const float sc = __shfl(alpha, 4 * g + rr);
#pragma unroll
                    for (int c = 0; c < 8; ++c) O[c][rr] *= sc; }
            }
            const v4u pw = (v4u){pk2(p[0], p[1]), pk2(p[2], p[3]), pk2(p[4], p[5]), pk2(p[6], p[7])};
            const bf16x8 pf = __builtin_bit_cast(bf16x8, pw);
#pragma unroll
            for (int c = 0; c < 8; ++c) {
                const unsigned qd = (unsigned)(h16 >> 2), pp = (unsigned)(h16 & 3);
                const v4i16_t t0 = __builtin_amdgcn_ds_read_tr16_b64_v4i16((LAS v4i16_t*)(tile + at_off(8u * g + qd, 2u * c + (pp >> 1)) + 8u * (pp & 1u)));
                const v4i16_t t1 = __builtin_amdgcn_ds_read_tr16_b64_v4i16((LAS v4i16_t*)(tile + at_off(8u * g + 4u + qd, 2u * c + (pp >> 1)) + 8u * (pp & 1u)));
                bf16x8 vf; vf[0] = t0[0]; vf[1] = t0[1]; vf[2] = t0[2]; vf[3] = t0[3]; vf[4] = t1[0]; vf[5] = t1[1]; vf[6] = t1[2]; vf[7] = t1[3];
                O[c] = __builtin_amdgcn_mfma_f32_16x16x32_bf16(pf, vf, O[c], 0, 0, 0);
            }
        }
        const float inv = 1.0f / lsum;
#pragma unroll
        for (int rr = 0; rr < 4; ++rr) {
            const float sc = __shfl(inv, 4 * g + rr);
            if (g < 2) {
#pragma unroll
                for (int c = 0; c < 8; ++c) qrow[(4 * g + rr) * 128 + 16 * c + h16] = (bf16)f2bf(O[c][rr] * sc);
            }
        }
    }
}
struct StoreBf16 { bf16* O; int ld; __device__ __forceinline__ void operator()(int row, int col, const f32x4& v) const { *(v2u*)(O + (size_t)row * ld + col) = (v2u){pk2(v.x, v.y), pk2(v.z, v.w)}; } };
struct StoreRes1 { const bf16* H; float* out; float* meta; __device__ __forceinline__ void operator()(int row, int col, const f32x4& v) const {
        if (row >= NROWS) return;
        const v2u hw = *(const v2u*)(H + (size_t)row * D + col);
        const f32x4 o = (f32x4){ALPHA * bflo(hw.x) + v.x, ALPHA * bfhi(hw.x) + v.y, ALPHA * bflo(hw.y) + v.z, ALPHA * bfhi(hw.y) + v.w};
        float* dst = row < NREAL ? out + (size_t)row * D + col : meta + (size_t)(row - NREAL) * D + col;
        *(f32x4*)dst = o; } };
struct StoreRes2 { const bf16* H; float* out; __device__ __forceinline__ void operator()(int row, int col, const f32x4& v) const {
        if (row >= NREAL) return;
        const v2u hw = *(const v2u*)(H + (size_t)row * D + col);
        *(f32x4*)(out + (size_t)row * D + col) = (f32x4){ALPHA * bflo(hw.x) + v.x, ALPHA * bfhi(hw.x) + v.y, ALPHA * bflo(hw.y) + v.z, ALPHA * bfhi(hw.y) + v.w}; } };

template <class Fn>
__device__ __forceinline__ void run_gemm(Frame& F, const bf16* A, int lda, const bf16* Bt, int N, int K, const Fn& fn) {
    pg8::Gemm g{A, Bt, R, N, K, lda}; pg8::StaticOrder S; S.init(R, N, F.G, (int)blockIdx.x);
    pg8::EpiFn<Fn> E{fn};
    pg8::gemm_phase<pg8::EpiFn<Fn>, pg8::StaticOrder, true, true>(F.lds + RING_OFF, g, S, E);
}

constexpr int NPHASES = 15;
struct Args { const float* in[32]; float* out; unsigned char* ws; int ph_lo, ph_hi; };
__global__ void __launch_bounds__(NTHR, 2) fwd(Args args) {
    extern __shared__ __attribute__((aligned(16))) unsigned char lds[];
    Frame F;
    F.lds = (LAS unsigned char*)lds;
    F.MISC = (volatile LAS unsigned*)(F.lds + MISC_OFF);
    F.tid = threadIdx.x; F.lane = F.tid & 63; F.wave = __builtin_amdgcn_readfirstlane(F.tid >> 6);
    F.G = gridDim.x;
#pragma unroll
    for (int i = 0; i < 32; ++i) F.in[i] = args.in[i];
    F.out = args.out; F.ws = args.ws;
    F.ctl = (gu32*)(args.ws + WS_CTL);
    for (int u = F.tid; u < (LDS_BYTES - LDSCTL_OFF) / 4; u += NTHR) ((LAS unsigned*)(F.lds + LDSCTL_OFF))[u] = 0u;
    __syncthreads();
    const int lo = args.ph_lo, hi = args.ph_hi;
    XcdBarrier bar; bar.bar = (unsigned*)(F.ctl + CW_BAR); bar.x = 0; bar.st = nullptr;
    if (hi - lo > 1) bar = xcd_barrier_post((unsigned*)(F.ctl + CW_BAR), F.MISC + 8);
#define IN(k) (lo <= (k) && (k) < hi)
#define SEAM(k) do { if (IN(k) && IN((k) + 1)) xcd_barrier(bar); } while (0)
#ifndef PROBE_PH
#define PROBE_PH -1
#endif
#define REP(k) for (int rep_ = 0; rep_ < ((PROBE_PH == (k)) ? 2 : 1); ++rep_)

#ifndef SKIP0
    if (IN(0)) REP(0) { if (rep_) __syncthreads(); p0_weights(F); p1_ln_in(F); } SEAM(0);
#endif
#ifndef SKIP1
    if (IN(1)) REP(1) { if (rep_) __syncthreads(); run_gemm(F, WSP(bf16, WS_H), D, WSP(bf16, WS_WT_IN), PW, D, StoreBf16{WSP(bf16, WS_P), PW}); } SEAM(1);
#endif
#ifndef SKIP2
    if (IN(2)) REP(2) { if (rep_) __syncthreads(); p3_prep(F); } SEAM(2);
#endif
#ifndef SKIP3
    if (IN(3)) REP(3) { if (rep_) __syncthreads(); run_gemm(F, WSP(bf16, WS_CQN), 256, WSP(bf16, WS_WT_QA), QAW, 256, StoreBf16{WSP(bf16, WS_QA), QAW});
#if REFSEL
        refsel_rows(F);
#endif
    } SEAM(3);
#endif
#ifndef SKIP4
#ifndef IDX_NAIVE
#define IDX_NAIVE 0
#endif
#ifndef ATTN_NAIVE
#define ATTN_NAIVE 0
#endif
#if CHECK_IDX
    if (IN(4)) { p5_index_naive(F); __syncthreads(); p5_index_mfma(F, (unsigned short*)F.out, (int*)((char*)F.out + 32 * MiB)); } SEAM(4);
#elif IDX_NAIVE
    if (IN(4)) { p5_index_naive(F); } SEAM(4);
#else
    if (IN(4)) { p5_index_mfma(F, WSP(unsigned short, WS_SEL), WSP(int, WS_NSEL)); } SEAM(4);
#endif
#endif
#ifndef SKIP5
    if (IN(5)) {
#if CHECK_IDX
        idx_check(F); __syncthreads();
#endif
#if ATTN_NAIVE
        p6_attn_naive(F);
#else
        p6_attn_mfma(F);
#endif
    } SEAM(5);
#endif
#ifndef RWKV_NAIVE
#define RWKV_NAIVE 0
#endif
#if RWKV_NAIVE
    if (IN(6)) REP(6) { if (rep_) __syncthreads(); p7_rwkv_prep_naive(F); } SEAM(6);
    if (IN(7)) REP(7) { if (rep_) __syncthreads(); p8_rwkv_scan_naive(F); } SEAM(7);
    SEAM(8);
#else
    if (IN(6)) REP(6) { if (rep_) __syncthreads(); rw_b1(F); } SEAM(6);
    if (IN(7)) REP(7) { if (rep_) __syncthreads(); rw_b2(F); } SEAM(7);
    if (IN(8)) REP(8) { if (rep_) __syncthreads(); rw_b3(F); } SEAM(8);
#endif
    if (IN(9)) REP(9) { if (rep_) __syncthreads(); run_gemm(F, WSP(bf16, WS_QA), QAW, WSP(bf16, WS_WT_MIX), D, QAW, StoreRes1{WSP(bf16, WS_H), F.out, WSP(float, WS_META1)}); } SEAM(9);
    if (IN(10)) REP(10) { if (rep_) __syncthreads(); p10_ln1(F); } SEAM(10);
    if (IN(11)) REP(11) { if (rep_) __syncthreads(); run_gemm(F, WSP(bf16, WS_H), D, WSP(bf16, WS_WT_UP), UPW, D, StoreBf16{WSP(bf16, WS_UP), UPW}); } SEAM(11);
    if (IN(12)) { p12_conv_act(F); } SEAM(12);
    if (IN(13)) REP(13) { if (rep_) __syncthreads(); run_gemm(F, WSP(bf16, WS_UP) + DFF, UPW, WSP(bf16, WS_WT_DN), D, DFF, StoreRes2{WSP(bf16, WS_H), F.out}); } SEAM(13);
    if (IN(14)) { p14_ln2(F);
#if CHECK_IDX
        if (blockIdx.x == 0 && F.tid == 0) {
            const unsigned miss = __hip_atomic_load((unsigned*)F.ctl + 2048, __ATOMIC_RELAXED, __HIP_MEMORY_SCOPE_AGENT), dupc = __hip_atomic_load((unsigned*)F.ctl + 2050, __ATOMIC_RELAXED, __HIP_MEMORY_SCOPE_AGENT);
            if (dupc) F.out[5] = __builtin_inff();
            if (miss > CHECK_IDX_MAXMISS) F.out[3] = __builtin_nanf("");
        }
#endif
    }
#undef IN
#undef SEAM
}

extern "C" void kernel_launch(void* const* d_in, const int* in_sizes, int n_in, void* d_out, int out_size, void* d_ws, size_t ws_size, hipStream_t stream) {
    static int grid = 0;
    if (grid == 0) {
        if (n_in != 32 || out_size != NREAL * D || ws_size < WS_END) { fprintf(stderr, "kernel_launch: unexpected shapes: n_in %d out %d ws %zu\n", n_in, out_size, ws_size); grid = -1; return; }
        int dev = 0, cus = 0, per_cu = 0;
        if (hipGetDevice(&dev) != hipSuccess || hipDeviceGetAttribute(&cus, hipDeviceAttributeMultiprocessorCount, dev) != hipSuccess) { grid = -1; return; }
        if (hipFuncSetAttribute((const void*)fwd, hipFuncAttributeMaxDynamicSharedMemorySize, LDS_BYTES) != hipSuccess) { fprintf(stderr, "kernel_launch: hipFuncSetAttribute failed\n"); grid = -1; return; }
        if (hipOccupancyMaxActiveBlocksPerMultiprocessor(&per_cu, (const void*)fwd, NTHR, LDS_BYTES) != hipSuccess || per_cu < 1) fprintf(stderr, "kernel_launch: occupancy query says %d\n", per_cu);
        (void)hipGetLastError();
        grid = cus;
    }
    if (grid < 0) return;
    (void)hipMemsetAsync((char*)d_ws + WS_CTL, 0, CTL_ZERO_BYTES, stream);
    Args a{};
    for (int i = 0; i < 32; ++i) a.in[i] = (const float*)d_in[i];
    a.out = (float*)d_out; a.ws = (unsigned char*)d_ws;
#if ONE_LAUNCH
    a.ph_lo = 0; a.ph_hi = NPHASES;
    hipLaunchKernelGGL(fwd, dim3(grid), dim3(NTHR), LDS_BYTES, stream, a);
#else
    for (int p = 0; p < NPHASES; ++p) { a.ph_lo = p; a.ph_hi = p + 1; hipLaunchKernelGGL(fwd, dim3(grid), dim3(NTHR), LDS_BYTES, stream, a); }
#endif
}
```

```cpp
#include <hip/hip_runtime.h>
#include <cstdio>
#include <cstdint>
#define ONE_LAUNCH 1
namespace pg8 {
#define PG8_LAS __attribute__((address_space(3)))
typedef unsigned short bf16_t;
typedef short bf16x8 __attribute__((ext_vector_type(8)));
typedef float f32x4 __attribute__((ext_vector_type(4)));
typedef unsigned u32x4 __attribute__((ext_vector_type(4)));
constexpr int BM = 256, BK = 64, HALF = 128, HTB = HALF * BK * 2  , STAGE_BYTES = 8 * HTB, NXCD = 8, WGM = 8;

__host__ __device__ __forceinline__ int lds_byte(int r, int c) { const int st = (r >> 4) * 2 + (c >> 5), rr = r & 15, cc = c & 31, ob = rr * 64 + cc * 2; return st * 1024 + (ob ^ (((ob >> 9) & 1) << 5)); }
__host__ __device__ __forceinline__ void stage_rc(int b, int& R, int& C) { const int st = b / 1024, sb = b % 1024, swz = sb ^ (((sb >> 9) & 1) << 5); R = (st >> 1) * 16 + swz / 64; C = (st & 1) * 32 + (swz % 64) / 2; }
__host__ __device__ __forceinline__ int perm32(int rho) { const int n = rho >> 4, i = rho & 15; return 8 * (i >> 2) + 4 * n + (i & 3); }

struct Unit { int pm, pn; };
struct Gemm { const bf16_t* A; const bf16_t* Bt; int M, N, K, lda; };

struct StaticOrder {
    int nM, nN, nwg, G, c;
    __host__ __device__ void init(int M, int N, int G_, int c_) { nM = M / BM; nN = N / BM; nwg = nM * nN; G = G_; c = c_; }
    __host__ __device__ bool next(int i, Unit& u) const {
        const long L = (long)i * G + c; if (L >= nwg) return false;
        int wgid = (int)L; { const int q = nwg / NXCD, r = nwg % NXCD, xcd = wgid % NXCD, off = wgid / NXCD; wgid = (xcd < r ? xcd * (q + 1) : r * (q + 1) + (xcd - r) * q) + off; }
        const int nig = WGM * nN, gid = wgid / nig, fm = gid * WGM, gsz = (nM - fm) < WGM ? (nM - fm) : WGM;
        u.pm = fm + ((wgid % nig) % gsz); u.pn = (wgid % nig) / gsz; return true;
    }
    __device__ __forceinline__ void a_ready(const Unit&) const {}
    __device__ __forceinline__ void done(const Unit&) const {}
};


template <class F> struct EpiFn {
    static constexpr bool PERM = false, AFTER_DRAIN = false;
    F f;
    __device__ __forceinline__ void operator()(const f32x4 (&acc)[2][2][4][2], const Unit& u, int wr, int wc, int fr, int fq) const {
        const int row0 = u.pm * BM + wr * 64 + fr, col0 = u.pn * BM + wc * 32 + 4 * fq;
#pragma unroll
        for (int ai = 0; ai < 2; ++ai)
#pragma unroll
            for (int m = 0; m < 4; ++m) {
                const int row = row0 + ai * HALF + m * 16;
#pragma unroll
                for (int bj = 0; bj < 2; ++bj)
#pragma unroll
                    for (int n = 0; n < 2; ++n) f(row, col0 + bj * HALF + n * 16, acc[ai][bj][m][n]);
            }
    }
};
template <class Epi, class Sched, bool ALIGN_EPI = false, bool SP2 = false>
__device__ __forceinline__ void gemm_phase(PG8_LAS unsigned char* lds, const Gemm g, const Sched& S, const Epi& E) {
    const int tid = threadIdx.x, wid = __builtin_amdgcn_readfirstlane(tid >> 6), lane = tid & 63, wr = wid >> 2, wc = wid & 3, fr = lane & 15, fq = lane >> 4;
    const int K = g.K, nt = K / BK;
    unsigned voffA[2], voffB[2];
#pragma unroll
    for (int i = 0; i < 2; ++i) { int R, C; stage_rc(tid * 16 + i * 8192, R, C); const int Rb = Epi::PERM ? ((R & ~31) + perm32(R & 31)) : R;
        voffA[i] = (unsigned)(R * g.lda + C) * 2u; voffB[i] = (unsigned)(Rb * K + C) * 2u; }
    const size_t kstep = (size_t)(BK * 2);
    const size_t hA = (size_t)HALF * g.lda * 2, hB = (size_t)HALF * K * 2;
    const size_t tA = 2 * hA, tB = 2 * hB;
    const unsigned ldsw = (unsigned)wid * 1024u;
    const int aoff = lds_byte(wr * 64 + fr, fq * 8), boff = lds_byte(wc * 32 + fr, fq * 8);
#define PG8_SA(b, h) (((b) * 2 + (h)) * HTB)
#define PG8_SB(b, h) ((4 + (b) * 2 + (h)) * HTB)
#define PG8_STAGE(bufoff, gbase, voff) do { _Pragma("unroll") for (int _i = 0; _i < 2; ++_i) \
        __builtin_amdgcn_global_load_lds((const unsigned*)((const char*)(gbase) + (voff)[_i]), (PG8_LAS unsigned*)(lds + (bufoff) + ldsw + _i * 8192), 16, 0, 0); } while (0)
#define PG8_LDA(dst, b, h) do { _Pragma("unroll") for (int m = 0; m < 4; ++m) _Pragma("unroll") for (int k = 0; k < 2; ++k) dst[m][k] = *(const PG8_LAS bf16x8*)(lds + PG8_SA(b, h) + aoff + m * 2048 + k * 1024); } while (0)
#define PG8_LDB(dst, b, h) do { _Pragma("unroll") for (int n = 0; n < 2; ++n) _Pragma("unroll") for (int k = 0; k < 2; ++k) dst[n][k] = *(const PG8_LAS bf16x8*)(lds + PG8_SB(b, h) + boff + n * 2048 + k * 1024); } while (0)
#define PG8_MMA(ai, bj, At, Bt) do { __builtin_amdgcn_s_setprio(1); _Pragma("unroll") for (int m = 0; m < 4; ++m) _Pragma("unroll") for (int n = 0; n < 2; ++n) _Pragma("unroll") for (int k = 0; k < 2; ++k) \
        acc[ai][bj][m][n] = __builtin_amdgcn_mfma_f32_16x16x32_bf16(Bt[n][k], At[m][k], acc[ai][bj][m][n], 0, 0, 0); __builtin_amdgcn_s_setprio(0); } while (0)
#define PG8_WAIT_V(n) asm volatile("s_waitcnt vmcnt(" #n ")" ::: "memory")
#define PG8_WAIT_L(n) asm volatile("s_waitcnt lgkmcnt(" #n ")" ::: "memory")
#define PG8_BAR __builtin_amdgcn_s_barrier()
#define PG8_SCHED __builtin_amdgcn_sched_barrier(0)
    Unit cur, nxt; int ui = 0;
    if (!S.next(0, cur)) return;
    f32x4 acc[2][2][4][2];
#pragma unroll
    for (int a = 0; a < 2; ++a)
#pragma unroll
        for (int b = 0; b < 2; ++b)
#pragma unroll
            for (int m = 0; m < 4; ++m)
#pragma unroll
                for (int n = 0; n < 2; ++n) acc[a][b][m][n] = (f32x4){0.f, 0.f, 0.f, 0.f};
    bf16x8 At[4][2], B0[2][2], B1[2][2];
    const char* cA = (const char*)g.A + (size_t)cur.pm * tA; const char* cB = (const char*)g.Bt + (size_t)cur.pn * tB;
    S.a_ready(cur);
    if constexpr (SP2) {
        PG8_STAGE(PG8_SB(0, 0), cB, voffB); PG8_STAGE(PG8_SB(0, 1), cB + hB, voffB); PG8_STAGE(PG8_SA(0, 0), cA, voffA); PG8_STAGE(PG8_SA(0, 1), cA + hA, voffA);
        if (wr == 1) PG8_BAR;
        PG8_WAIT_V(2); PG8_BAR;
        PG8_STAGE(PG8_SB(1, 0), cB + kstep, voffB); PG8_STAGE(PG8_SA(1, 0), cA + kstep, voffA); PG8_STAGE(PG8_SB(1, 1), cB + hB + kstep, voffB);
        PG8_WAIT_V(6); PG8_BAR;
    } else {
        PG8_STAGE(PG8_SB(0, 0), cB, voffB); PG8_STAGE(PG8_SA(0, 0), cA, voffA); PG8_STAGE(PG8_SB(0, 1), cB + hB, voffB); PG8_STAGE(PG8_SA(0, 1), cA + hA, voffA);
        if (wr == 1) PG8_BAR;
        PG8_WAIT_V(4); PG8_BAR;
        PG8_STAGE(PG8_SB(1, 0), cB + kstep, voffB); PG8_STAGE(PG8_SA(1, 0), cA + kstep, voffA); PG8_STAGE(PG8_SB(1, 1), cB + hB + kstep, voffB);
        PG8_WAIT_V(6); PG8_BAR;
    }
    for (;;) {
        const bool has_next = S.next(ui + 1, nxt);
        const char* nA = has_next ? (const char*)g.A + (size_t)nxt.pm * tA : cA; const char* nB = has_next ? (const char*)g.Bt + (size_t)nxt.pn * tB : cB;
        for (int t = 0; t < nt; t += 2) {
            const bool last = (t == nt - 2);
            const char* a1 = cA + (size_t)(t + 1) * kstep;
            const char* a2 = last ? nA : cA + (size_t)(t + 2) * kstep; const char* b2 = last ? nB : cB + (size_t)(t + 2) * kstep;
            const char* a3 = a2 + kstep; const char* b3 = b2 + kstep;
            if (last && has_next) S.a_ready(nxt);
            if constexpr (SP2) {
            PG8_LDB(B0, 0, 0); PG8_LDB(B1, 0, 1); PG8_SCHED; PG8_LDA(At, 0, 0); PG8_STAGE(PG8_SA(1, 1), a1 + hA, voffA);
            PG8_WAIT_V(8); PG8_WAIT_L(0); PG8_BAR; PG8_MMA(0, 0, At, B0); PG8_MMA(0, 1, At, B1); PG8_BAR; PG8_SCHED;
            PG8_LDA(At, 0, 1); PG8_STAGE(PG8_SB(0, 0), b2, voffB); PG8_STAGE(PG8_SB(0, 1), b2 + hB, voffB); PG8_STAGE(PG8_SA(0, 0), a2, voffA);
            PG8_WAIT_V(8); PG8_WAIT_L(0); PG8_BAR; PG8_MMA(1, 0, At, B0); PG8_MMA(1, 1, At, B1); PG8_BAR; PG8_SCHED;
            PG8_LDB(B0, 1, 0); PG8_LDB(B1, 1, 1); PG8_SCHED; PG8_LDA(At, 1, 0); PG8_STAGE(PG8_SA(0, 1), a2 + hA, voffA);
            PG8_WAIT_V(8); PG8_WAIT_L(0); PG8_BAR; PG8_MMA(0, 0, At, B0); PG8_MMA(0, 1, At, B1); PG8_BAR; PG8_SCHED;
            PG8_LDA(At, 1, 1); PG8_STAGE(PG8_SB(1, 0), b3, voffB); PG8_STAGE(PG8_SB(1, 1), b3 + hB, voffB); PG8_STAGE(PG8_SA(1, 0), a3, voffA);
            PG8_WAIT_V(8); PG8_WAIT_L(0); PG8_BAR; PG8_MMA(1, 0, At, B0); PG8_MMA(1, 1, At, B1); PG8_BAR; PG8_SCHED;
            } else {
            PG8_LDB(B0, 0, 0); PG8_SCHED; PG8_LDA(At, 0, 0); PG8_STAGE(PG8_SA(1, 1), a1 + hA, voffA);
            PG8_WAIT_L(8); PG8_BAR; PG8_WAIT_L(0); PG8_MMA(0, 0, At, B0); PG8_BAR; PG8_SCHED;
            PG8_LDB(B1, 0, 1); PG8_STAGE(PG8_SB(0, 0), b2, voffB);
            PG8_BAR; PG8_WAIT_L(0); PG8_MMA(0, 1, At, B1); PG8_BAR;
            PG8_LDA(At, 0, 1); PG8_STAGE(PG8_SA(0, 0), a2, voffA);
            PG8_BAR; PG8_WAIT_L(0); PG8_MMA(1, 0, At, B0); PG8_BAR; PG8_SCHED;
            PG8_STAGE(PG8_SB(0, 1), b2 + hB, voffB);
            PG8_WAIT_V(6); PG8_BAR; PG8_MMA(1, 1, At, B1); PG8_BAR;
            PG8_LDB(B0, 1, 0); PG8_SCHED; PG8_LDA(At, 1, 0); PG8_STAGE(PG8_SA(0, 1), a2 + hA, voffA);
            PG8_WAIT_L(8); PG8_BAR; PG8_WAIT_L(0); PG8_MMA(0, 0, At, B0); PG8_BAR; PG8_SCHED;
            PG8_LDB(B1, 1, 1); PG8_STAGE(PG8_SB(1, 0), b3, voffB);
            PG8_BAR; PG8_WAIT_L(0); PG8_MMA(0, 1, At, B1); PG8_BAR;
            PG8_LDA(At, 1, 1); PG8_STAGE(PG8_SA(1, 0), a3, voffA);
            PG8_BAR; PG8_WAIT_L(0); PG8_MMA(1, 0, At, B0); PG8_BAR; PG8_SCHED;
            PG8_STAGE(PG8_SB(1, 1), b3 + hB, voffB);
            PG8_WAIT_V(6); PG8_BAR; PG8_MMA(1, 1, At, B1); PG8_BAR;
            }
        }
        if constexpr (ALIGN_EPI) { if (wr == 0) PG8_BAR; }
        if constexpr (!Epi::AFTER_DRAIN) { E(acc, cur, wr, wc, fr, fq); S.done(cur); }
        if (!has_next) break;
#pragma unroll
        for (int a = 0; a < 2; ++a)
#pragma unroll
            for (int b = 0; b < 2; ++b)
#pragma unroll
                for (int m = 0; m < 4; ++m)
#pragma unroll
                    for (int n = 0; n < 2; ++n) acc[a][b][m][n] = (f32x4){0.f, 0.f, 0.f, 0.f};
        cur = nxt; cA = nA; cB = nB; ++ui;
        if constexpr (ALIGN_EPI) { if (wr == 1) PG8_BAR; }
    }
    PG8_WAIT_V(0);
    if constexpr (!ALIGN_EPI) { if (wr == 0) PG8_BAR; }
    PG8_BAR;
    if constexpr (Epi::AFTER_DRAIN) { E.fused(acc, cur, wr, wc, fr, fq, lds, wid, lane); S.done(cur); }
#undef PG8_SA
#undef PG8_SB
#undef PG8_STAGE
#undef PG8_LDA
#undef PG8_LDB
#undef PG8_MMA
#undef PG8_WAIT_V
#undef PG8_WAIT_L
#undef PG8_BAR
#undef PG8_SCHED
}
}

#ifndef ONE_LAUNCH
#define ONE_LAUNCH 0
#endif
constexpr int NWAVES = 8, NTHR = 512;
constexpr int D = 1024, BATCH = 4, SEQ = 8192, NMETA = 16, TT = SEQ + NMETA;
constexpr int NREAL = BATCH * SEQ;
constexpr int NROWS = NREAL + NMETA;
constexpr int R = 33024;
constexpr int PW = 2304;
constexpr int PC_CQ = 0, PC_CKV = 256, PC_KIDX = 384, PC_WIDX = 448, PC_R = 512, PC_K = 1024, PC_V = 1536, PC_WD = 2048, PC_AD = 2112, PC_GD = 2176;
constexpr int QAW = 1536;
constexpr int DFF = 2816, UPW = 5632;
constexpr int TOPK = 256;
constexpr float LN_EPS = 1e-5f, GN_EPS = 64e-5f, ALPHA = 1.18920711500272f;

constexpr size_t MiB = 1u << 20;
constexpr size_t WS_CTL = 0, CTL_ZERO_BYTES = 1 * MiB;
constexpr size_t WS_WT_IN = 1 * MiB, WS_WT_QA = 6 * MiB, WS_WT_MIX = 7 * MiB, WS_WT_UP = 10 * MiB, WS_WT_DN = 21 * MiB;
constexpr size_t WS_META1 = 27 * MiB, WS_NSEL = 28 * MiB, WS_WIDX = 29 * MiB;
constexpr size_t WS_H = 33 * MiB;
constexpr size_t WS_P = 98 * MiB, WS_QA = 244 * MiB, WS_CQN = 341 * MiB, WS_SEL = 341 * MiB, WS_CKV = 358 * MiB, WS_KIDX = 367 * MiB;
constexpr size_t WS_DEC = 372 * MiB, WS_AB = 437 * MiB, WS_GB = 470 * MiB;
constexpr size_t WS_WT_LORA = 26 * MiB + 512 * 1024;
constexpr size_t WS_RWM = 372 * MiB, WS_RWN = 405 * MiB, WS_RWQ = 438 * MiB, WS_RWY = 471 * MiB;
constexpr size_t OUT_RWS = 80 * MiB, OUT_BONUS = 116 * MiB;
constexpr size_t WS_UP = 98 * MiB;
constexpr size_t WS_END = 512 * MiB;
static_assert(WS_P + (size_t)R * PW * 2 <= WS_QA && WS_QA + (size_t)R * QAW * 2 <= WS_CQN && WS_CQN + (size_t)R * 256 * 2 <= WS_CKV && WS_CKV + (size_t)R * 128 * 2 <= WS_KIDX
              && WS_KIDX + (size_t)R * 64 * 2 <= WS_DEC && WS_DEC + (size_t)R * 512 * 4 <= WS_AB && WS_AB + (size_t)R * 512 * 2 <= WS_GB && WS_GB + (size_t)R * 512 * 2 <= WS_END
              && WS_UP + (size_t)R * UPW * 2 <= WS_END && WS_H + (size_t)R * D * 2 <= WS_P && WS_WIDX + (size_t)R * 8 * 4 <= WS_H && WS_NSEL + (size_t)R * 4 <= WS_WIDX, "ws map");
constexpr int CW_BAR = 4096;

constexpr int RING_OFF = 0, RING_BYTES = 131072;
constexpr int LDSCTL_OFF = RING_BYTES, MISC_OFF = LDSCTL_OFF + 320;
constexpr int LDS_BYTES = 147456;

#define GAS __attribute__((address_space(1)))
#define LAS __attribute__((address_space(3)))
typedef unsigned short bf16;
typedef unsigned v4u __attribute__((ext_vector_type(4)));
typedef unsigned v2u __attribute__((ext_vector_type(2)));
typedef float f32x4 __attribute__((ext_vector_type(4)));
typedef GAS unsigned gu32;
__device__ __forceinline__ unsigned f2bf(float f) { unsigned u = __builtin_bit_cast(unsigned, f); return (u + 0x7fffu + ((u >> 16) & 1u)) >> 16; }
__device__ __forceinline__ unsigned pk2(float lo, float hi) { return f2bf(lo) | (f2bf(hi) << 16); }
__device__ __forceinline__ float bf2f(unsigned short b) { return __uint_as_float(((unsigned)b) << 16); }
__device__ __forceinline__ float bflo(unsigned w) { return __uint_as_float(w << 16); }
__device__ __forceinline__ float bfhi(unsigned w) { return __uint_as_float(w & 0xffff0000u); }
__device__ __forceinline__ float wave_sum(float v) {
#pragma unroll
    for (int o = 1; o < 64; o <<= 1) v += __shfl_xor(v, o);
    return v;
}
__device__ __forceinline__ float wave_max(float v) {
#pragma unroll
    for (int o = 1; o < 64; o <<= 1) v = fmaxf(v, __shfl_xor(v, o));
    return v;
}
__device__ __forceinline__ float sigmoidf_(float x) { return 1.0f / (1.0f + __expf(-x)); }
#define XB_TMO      128
#define XB_XCNT(j)  (256  + 64 * (j))
#define XB_XSUB(j)  (1280 + 64 * (j))
#define XB_XGEN(j)  (2304 + 64 * (j))
#define XB_TOP      3328
#define XB_TOPGEN   3392
#define XCD_BAR_WORDS 3456
#define XB_SPIN_CAP (1u << 18)

__device__ __forceinline__ unsigned xb_ld(unsigned* p)              { return __hip_atomic_load(p, __ATOMIC_RELAXED, __HIP_MEMORY_SCOPE_AGENT); }
__device__ __forceinline__ unsigned xb_add(unsigned* p, unsigned v) { return __hip_atomic_fetch_add(p, v, __ATOMIC_RELAXED, __HIP_MEMORY_SCOPE_AGENT); }
__device__ __forceinline__ unsigned xb_xcc_id() { return (unsigned)__builtin_amdgcn_s_getreg((3 << 11) | 20) & 0xFu; }
#define XB_SPIN(cond, bar) do { unsigned _sp = 0; while (cond) { __builtin_amdgcn_s_sleep(1); \
    if ((++_sp & 255u) == 0u) { if (xb_ld(&(bar)[XB_TMO])) break; if (_sp > XB_SPIN_CAP) { atomicAdd(&(bar)[XB_TMO], 1u); break; } } } } while (0)

struct XcdBarrier {
    unsigned* bar; unsigned x;
    volatile LAS unsigned* st;
};

__device__ __forceinline__ XcdBarrier xcd_barrier_post(unsigned* bar, volatile LAS unsigned* st) {
    XcdBarrier b; b.bar = bar; b.x = xb_xcc_id(); b.st = st;
    if (threadIdx.x == 0) (void)xb_add(&bar[XB_XCNT(b.x)], 1u);
    return b;
}
__device__ __forceinline__ void xcd_barrier_complete(unsigned* bar, unsigned x, unsigned& nloc, unsigned& nx) {
    const unsigned G = gridDim.x * gridDim.y * gridDim.z;
    unsigned sum, cnt, mine, sp = 0u;
    for (;;) {
        sum = 0u; cnt = 0u; mine = 0u;
#pragma unroll
        for (unsigned j = 0; j < 16; ++j) { const unsigned c = xb_ld(&bar[XB_XCNT(j)]); sum += c; cnt += (c > 0u) ? 1u : 0u; mine = (j == x) ? c : mine; }
        if (sum == G) break;
        __builtin_amdgcn_s_sleep(1);
        if ((++sp & 255u) == 0u) { if (xb_ld(&bar[XB_TMO])) break; if (sp > XB_SPIN_CAP) { atomicAdd(&bar[XB_TMO], 1u); break; } }
    }
    nloc = mine > 0u ? mine : 1u; nx = cnt > 0u ? cnt : 1u;
}

__device__ __forceinline__ void xcd_barrier(const XcdBarrier& b) {
    asm volatile("s_waitcnt vmcnt(0)" ::: "memory");
    __syncthreads();
    if (threadIdx.x == 0) {
        unsigned* bar = b.bar;
        __builtin_amdgcn_s_waitcnt(0);
        unsigned nloc = b.st[0], nx = b.st[1];
        if (nloc == 0u) { xcd_barrier_complete(bar, b.x, nloc, nx); b.st[0] = nloc; b.st[1] = nx; }
        const unsigned old = xb_add(&bar[XB_XSUB(b.x)], 1u);
        const unsigned gen = old / nloc;
        if (old + 1u == (gen + 1u) * nloc) {
            __builtin_amdgcn_fence(__ATOMIC_RELEASE, "agent");
            asm volatile("s_waitcnt vmcnt(0)" ::: "memory");
            const unsigned og = xb_add(&bar[XB_TOP], 1u);
            const unsigned tg = og / nx;
            if (og + 1u == (tg + 1u) * nx) xb_add(&bar[XB_TOPGEN], 1u);
            else XB_SPIN(xb_ld(&bar[XB_TOPGEN]) == tg, bar);
            __builtin_amdgcn_fence(__ATOMIC_ACQUIRE, "agent");
            xb_add(&bar[XB_XGEN(b.x)], 1u);
            asm volatile("s_waitcnt vmcnt(0)" ::: "memory");
        } else {
            XB_SPIN(xb_ld(&bar[XB_XGEN(b.x)]) == gen, bar);
            __builtin_amdgcn_fence(__ATOMIC_ACQUIRE, "agent");
            asm volatile("s_waitcnt vmcnt(0)" ::: "memory");
        }
    }
    __syncthreads();
}

struct Frame {
    LAS unsigned char* lds;
    volatile LAS unsigned* MISC;
    gu32* ctl;
    int tid, lane, wave, G;
    const float* in[32];
    float* out;
    unsigned char* ws;
};
#define IN_X 0
#define IN_META 1
#define IN_LNIN_G 2
#define IN_LNIN_B 3
#define IN_W_IN 4
#define IN_QNORM_G 5
#define IN_W_UQ 6
#define IN_KVNORM_G 7
#define IN_W_UKV 8
#define IN_W_IQ 9
#define IN_IDXLN_G 10
#define IN_IDXLN_B 11
#define IN_MU 12
#define IN_W0 13
#define IN_W_DEC 14
#define IN_A0 15
#define IN_W_AAA 16
#define IN_W_GATE 17
#define IN_KK 18
#define IN_KA 19
#define IN_RK 20
#define IN_GN_G 21
#define IN_GN_B 22
#define IN_W_OUT 23
#define IN_LN1_G 24
#define IN_LN1_B 25
#define IN_W_UP 26
#define IN_CONV_W 27
#define IN_CONV_B 28
#define IN_W_DN 29
#define IN_LN2_G 30
#define IN_LN2_B 31

#define WSP(T, off) ((T*)(F.ws + (off)))

__device__ __forceinline__ int key_row(int b, int j) { return j < NMETA ? NREAL + j : b * SEQ + (j - NMETA); }

__device__ __forceinline__ void tr_items(Frame& F, const float* src, int src_ld, int src_r0, bf16* dst, int dst_ld, int dst_c0, int Nn, int K, int cut0, int cut1, int shift) {
    const int total = Nn * (K / 8);
    for (int it = blockIdx.x * NTHR + F.tid; it < total; it += F.G * NTHR) {
        const int n = it % Nn, kc = it / Nn;
        const int col = n < cut0 ? n : (n < cut1 ? -1 : n - shift);
        float v[8];
#pragma unroll
        for (int e = 0; e < 8; ++e) v[e] = col >= 0 ? src[(size_t)(src_r0 + 8 * kc + e) * src_ld + col] : 0.f;
        v4u o; o.x = pk2(v[0], v[1]); o.y = pk2(v[2], v[3]); o.z = pk2(v[4], v[5]); o.w = pk2(v[6], v[7]);
        *(v4u*)(dst + (size_t)n * dst_ld + dst_c0 + 8 * kc) = o;
    }
}
__device__ __forceinline__ void p0_weights(Frame& F) {
    bf16* WT_IN = WSP(bf16, WS_WT_IN); bf16* WT_QA = WSP(bf16, WS_WT_QA); bf16* WT_MIX = WSP(bf16, WS_WT_MIX); bf16* WT_UP = WSP(bf16, WS_WT_UP); bf16* WT_DN = WSP(bf16, WS_WT_DN);
    tr_items(F, F.in[IN_W_IN], 2248, 0, WT_IN, D, 0, PW, D, 456, 512, 56);
    tr_items(F, F.in[IN_W_UP], UPW, 0, WT_UP, D, 0, UPW, D, UPW, UPW, 0);
    tr_items(F, F.in[IN_W_DN], D, 0, WT_DN, DFF, 0, D, DFF, D, D, 0);
    tr_items(F, F.in[IN_W_IQ], 512, 0, WT_QA + (size_t)1024 * 256, 256, 0, 512, 256, 512, 512, 0);
    tr_items(F, F.in[IN_W_OUT], D, 512, WT_MIX, 1536, 1024, D, 512, D, D, 0);
    {
        bf16* WdT = WSP(bf16, WS_WT_LORA);
        tr_items(F, F.in[IN_W_DEC], 512, 0, WdT, 64, 0, 512, 64, 512, 512, 0);
        tr_items(F, F.in[IN_W_AAA], 512, 0, WdT + 512 * 64, 64, 0, 512, 64, 512, 512, 0);
        tr_items(F, F.in[IN_W_GATE], 512, 0, WdT + 2 * 512 * 64, 128, 0, 512, 128, 512, 512, 0);
    }
    const float* w_uq = F.in[IN_W_UQ]; const float* w_ukv = F.in[IN_W_UKV]; const float* w_out = F.in[IN_W_OUT];
    for (int it = blockIdx.x * NTHR + F.tid; it < 1024 * 256; it += F.G * NTHR) {
        const int c = it & 255, n = it >> 8, h = n >> 7, j = n & 127;
        float s = 0.f;
        for (int d = 0; d < 64; ++d) s += w_uq[(size_t)c * 512 + h * 64 + d] * w_ukv[(size_t)j * 1024 + h * 128 + d];
        WT_QA[(size_t)n * 256 + c] = (bf16)f2bf(0.125f * s);
    }
    for (int it = blockIdx.x * NTHR + F.tid; it < 1024 * 1024; it += F.G * NTHR) {
        const int n = it & 1023, k = it >> 10, h = k >> 7, j = k & 127;
        float s = 0.f;
        for (int d = 0; d < 64; ++d) s += w_ukv[(size_t)j * 1024 + h * 128 + 64 + d] * w_out[(size_t)(h * 64 + d) * D + n];
        WT_MIX[(size_t)n * 1536 + k] = (bf16)f2bf(s);
    }
}

__device__ __forceinline__ void ln_row_bf16(Frame& F, const float* src, const float* g, const float* b, bf16* dst) {
    v2u* o8 = (v2u*)dst + F.lane;
    if (!src) {
#pragma unroll
        for (int j = 0; j < 4; ++j) o8[64 * j] = (v2u){0u, 0u};
        return;
    }
    const f32x4* xr = (const f32x4*)src + F.lane;
    f32x4 v[4]; float s = 0.f;
#pragma unroll
    for (int j = 0; j < 4; ++j) { v[j] = xr[64 * j]; s += (v[j].x + v[j].y) + (v[j].z + v[j].w); }
    const float mean = wave_sum(s) * (1.f / D); float s2 = 0.f;
#pragma unroll
    for (int j = 0; j < 4; ++j) { v[j] = v[j] - mean; s2 += (v[j].x * v[j].x + v[j].y * v[j].y) + (v[j].z * v[j].z + v[j].w * v[j].w); }
    const float rstd = 1.f / sqrtf(wave_sum(s2) * (1.f / D) + LN_EPS);
#pragma unroll
    for (int j = 0; j < 4; ++j) {
        const f32x4 gg = ((const f32x4*)g)[F.lane + 64 * j], bb = ((const f32x4*)b)[F.lane + 64 * j];
        const f32x4 y = v[j] * rstd * gg + bb;
        o8[64 * j] = (v2u){pk2(y.x, y.y), pk2(y.z, y.w)};
    }
}
__device__ __forceinline__ void p1_ln_in(Frame& F) {
    bf16* H0 = WSP(bf16, WS_H);
    const int gw = blockIdx.x * NWAVES + F.wave, NGW = F.G * NWAVES;
    for (int r = gw; r < R; r += NGW) {
        const float* src = r < NREAL ? F.in[IN_X] + (size_t)r * D : (r < NROWS ? F.in[IN_META] + (size_t)(r - NREAL) * D : nullptr);
        ln_row_bf16(F, src, F.in[IN_LNIN_G], F.in[IN_LNIN_B], H0 + (size_t)r * D);
    }
}

__device__ __forceinline__ void p3_prep(Frame& F) {
    const bf16* P = WSP(bf16, WS_P); bf16* CQN = WSP(bf16, WS_CQN); bf16* CKV = WSP(bf16, WS_CKV); bf16* KIDX = WSP(bf16, WS_KIDX); float* WIDX = WSP(float, WS_WIDX);
    const int gw = blockIdx.x * NWAVES + F.wave, NGW = F.G * NWAVES, l = F.lane;
    for (int r = gw; r < R; r += NGW) {
        const bf16* pr = P + (size_t)r * PW;
        if (r >= NROWS) {
            *(v2u*)(CQN + (size_t)r * 256 + 4 * l) = (v2u){0u, 0u};
            continue;
        }
        {
            const v2u w = *(const v2u*)(pr + PC_CQ + 4 * l);
            const float a0 = bflo(w.x), a1 = bfhi(w.x), a2 = bflo(w.y), a3 = bfhi(w.y);
            const float ss = wave_sum(a0 * a0 + a1 * a1 + a2 * a2 + a3 * a3);
            const float rs = 1.0f / sqrtf(ss * (1.f / 256.f) + 1e-6f);
            const f32x4 g = ((const f32x4*)F.in[IN_QNORM_G])[l];
            *(v2u*)(CQN + (size_t)r * 256 + 4 * l) = (v2u){pk2(a0 * rs * g.x, a1 * rs * g.y), pk2(a2 * rs * g.z, a3 * rs * g.w)};
        }
        {
            const unsigned w = *(const unsigned*)(pr + PC_CKV + 2 * l);
            const float a0 = bflo(w), a1 = bfhi(w);
            const float ss = wave_sum(a0 * a0 + a1 * a1);
            const float rs = 1.0f / sqrtf(ss * (1.f / 128.f) + 1e-6f);
            const float g0 = F.in[IN_KVNORM_G][2 * l], g1 = F.in[IN_KVNORM_G][2 * l + 1];
            *(unsigned*)(CKV + (size_t)r * 128 + 2 * l) = pk2(a0 * rs * g0, a1 * rs * g1);
        }
        {
            const float a = bf2f(pr[PC_KIDX + l]);
            const float mean = wave_sum(a) * (1.f / 64.f);
            const float dlt = a - mean;
            const float var = wave_sum(dlt * dlt) * (1.f / 64.f);
            const float y = dlt * (1.0f / sqrtf(var + LN_EPS)) * F.in[IN_IDXLN_G][l] + F.in[IN_IDXLN_B][l];
            KIDX[(size_t)r * 64 + l] = (bf16)f2bf(y);
        }
        if (l < 8) WIDX[(size_t)r * 8 + l] = bf2f(pr[PC_WIDX + l]) * 0.04419417382415922f;
    }
}

#ifndef REFSEL
#define REFSEL 0
#endif
__device__ __forceinline__ void refsel_rows(Frame& F) {
    float* QIDX32 = F.out; float* KIDX32 = F.out + (size_t)R * 512; float* WIDX = WSP(float, WS_WIDX);
    const float* w_in = F.in[IN_W_IN]; const float* w_iq = F.in[IN_W_IQ];
    LAS float* hrow = (LAS float*)(F.lds + F.wave * 8192);
    LAS float* cqn = hrow + 1024;
    const int l = F.lane;
    const int gw = blockIdx.x * NWAVES + F.wave, NGW = F.G * NWAVES;
    for (int r = gw; r < NROWS; r += NGW) {
        const float* src = r < NREAL ? F.in[IN_X] + (size_t)r * D : F.in[IN_META] + (size_t)(r - NREAL) * D;
        {
            const f32x4* xr = (const f32x4*)src + l;
            f32x4 v[4]; float s = 0.f;
#pragma unroll
            for (int j = 0; j < 4; ++j) { v[j] = xr[64 * j]; s += (v[j].x + v[j].y) + (v[j].z + v[j].w); }
            const float mean = wave_sum(s) * (1.f / D); float s2 = 0.f;
#pragma unroll
            for (int j = 0; j < 4; ++j) { v[j] = v[j] - mean; s2 += (v[j].x * v[j].x + v[j].y * v[j].y) + (v[j].z * v[j].z + v[j].w * v[j].w); }
            const float rstd = 1.f / sqrtf(wave_sum(s2) * (1.f / D) + LN_EPS);
#pragma unroll
            for (int j = 0; j < 4; ++j) {
                const f32x4 gg = ((const f32x4*)F.in[IN_LNIN_G])[l + 64 * j], bb = ((const f32x4*)F.in[IN_LNIN_B])[l + 64 * j];
                *(LAS f32x4*)(hrow + 4 * (l + 64 * j)) = v[j] * rstd * gg + bb;
            }
        }
        __builtin_amdgcn_wave_barrier();
        float a[6];
#pragma unroll
        for (int i = 0; i < 6; ++i) a[i] = 0.f;
        for (int k = 0; k < D; ++k) {
            const float hk = hrow[k]; const float* wr = w_in + (size_t)k * 2248;
#pragma unroll
            for (int i = 0; i < 4; ++i) a[i] += hk * wr[l + 64 * i];
            a[4] += hk * wr[384 + l];
            a[5] += hk * wr[448 + (l & 7)];
        }
        const float ss = wave_sum(a[0] * a[0] + a[1] * a[1] + a[2] * a[2] + a[3] * a[3]);
        const float rs = 1.0f / sqrtf(ss * (1.f / 256.f) + 1e-6f);
#pragma unroll
        for (int i = 0; i < 4; ++i) cqn[l + 64 * i] = a[i] * rs * F.in[IN_QNORM_G][l + 64 * i];
        {
            const float mean = wave_sum(a[4]) * (1.f / 64.f); const float dlt = a[4] - mean;
            const float var = wave_sum(dlt * dlt) * (1.f / 64.f);
            KIDX32[(size_t)r * 64 + l] = dlt * (1.0f / sqrtf(var + LN_EPS)) * F.in[IN_IDXLN_G][l] + F.in[IN_IDXLN_B][l];
        }
        if (l < 8) WIDX[(size_t)r * 8 + l] = a[5] * 0.04419417382415922f;
        __builtin_amdgcn_wave_barrier();
        float q[8];
#pragma unroll
        for (int i = 0; i < 8; ++i) q[i] = 0.f;
        for (int c = 0; c < 256; ++c) {
            const float cq = cqn[c]; const float* wr = w_iq + (size_t)c * 512;
#pragma unroll
            for (int i = 0; i < 8; ++i) q[i] += cq * wr[l + 64 * i];
        }
#pragma unroll
        for (int i = 0; i < 8; ++i) QIDX32[(size_t)r * 512 + l + 64 * i] = q[i];
        __builtin_amdgcn_wave_barrier();
    }
}

__device__ __forceinline__ unsigned sortable(float f) { const unsigned u = __float_as_uint(f); return (u & 0x80000000u) ? ~u : (u | 0x80000000u); }
__device__ __forceinline__ void p5_index_naive(Frame& F) {
    const bf16* QA = WSP(bf16, WS_QA); const bf16* KIDX = WSP(bf16, WS_KIDX); const float* WIDX = WSP(float, WS_WIDX);
    unsigned short* SEL = WSP(unsigned short, WS_SEL); int* NSEL = WSP(int, WS_NSEL);
    LAS float* sc = (LAS float*)(F.lds);
    LAS float* qf = (LAS float*)(F.lds + 33024);
    LAS unsigned* hist = (LAS unsigned*)(F.lds + 33024 + 2048);
    LAS unsigned* cw = hist + 256;
    const int tid = F.tid;
    for (int q = blockIdx.x; q < NROWS; q += F.G) {
        int b, pos; if (q < NREAL) { b = q >> 13; pos = NMETA + (q & (SEQ - 1)); } else { b = 0; pos = q - NREAL; }
        const int nvis = pos < NMETA ? NMETA : NMETA + 64 * ((pos - NMETA) / 64 + 1);
#if REFSEL
        qf[tid] = F.out[(size_t)q * 512 + tid];
#else
        qf[tid] = bf2f(QA[(size_t)q * QAW + 1024 + tid]);
#endif
        float w[8];
#pragma unroll
        for (int h = 0; h < 8; ++h) w[h] = WIDX[(size_t)q * 8 + h];
        __syncthreads();
        for (int j = tid; j < nvis; j += NTHR) {
            const v4u* kp = (const v4u*)(KIDX + (size_t)key_row(b, j) * 64);
#if REFSEL
            const f32x4* kp32 = (const f32x4*)(F.out + (size_t)R * 512 + (size_t)key_row(b, j) * 64);
#endif
            float d[8];
#pragma unroll
            for (int h = 0; h < 8; ++h) d[h] = 0.f;
#pragma unroll 2
            for (int c = 0; c < 8; ++c) {
#if REFSEL
                const f32x4 ta = kp32[2 * c], tb = kp32[2 * c + 1];
                const float k0 = ta.x, k1 = ta.y, k2 = ta.z, k3 = ta.w, k4 = tb.x, k5 = tb.y, k6 = tb.z, k7 = tb.w;
#else
                const v4u t = kp[c];
                const float k0 = bflo(t.x), k1 = bfhi(t.x), k2 = bflo(t.y), k3 = bfhi(t.y), k4 = bflo(t.z), k5 = bfhi(t.z), k6 = bflo(t.w), k7 = bfhi(t.w);
#endif
#pragma unroll
                for (int h = 0; h < 8; ++h) {
                    const f32x4 qa = *(const LAS f32x4*)(qf + h * 64 + 8 * c), qb = *(const LAS f32x4*)(qf + h * 64 + 8 * c + 4);
                    d[h] += qa.x * k0 + qa.y * k1 + qa.z * k2 + qa.w * k3 + qb.x * k4 + qb.y * k5 + qb.z * k6 + qb.w * k7;
                }
            }
            float s = 0.f;
#pragma unroll
            for (int h = 0; h < 8; ++h) s += w[h] * fmaxf(d[h], 0.f);
            sc[j] = s + 0.0f;
        }
        __syncthreads();
        unsigned short* selq = SEL + (size_t)q * TOPK;
        if (nvis <= TOPK) {
            for (int j = tid; j < nvis; j += NTHR) selq[j] = (unsigned short)j;
        } else {
            unsigned prefix = 0u, mask = 0u, need = TOPK;
            for (int pass = 0; pass < 4; ++pass) {
                const int shift = 24 - 8 * pass;
                if (tid < 256) hist[tid] = 0u;
                __syncthreads();
                for (int j = tid; j < nvis; j += NTHR) { const unsigned key = sortable(sc[j]); if ((key & mask) == prefix) atomicAdd((unsigned*)&hist[(key >> shift) & 255u], 1u); }
                __syncthreads();
                if (tid < 256) {
                    unsigned above = 0u; for (int bb = tid + 1; bb < 256; ++bb) above += hist[bb];
                    const unsigned c = hist[tid];
                    if (above < need && need <= above + c) { cw[0] = prefix | ((unsigned)tid << shift); cw[1] = need - above; }
                }
                __syncthreads();
                prefix = cw[0]; need = cw[1]; mask |= 0xFFu << shift;
                __syncthreads();
            }
            if (tid == 0) cw[2] = 0u;
            __syncthreads();
            for (int j = tid; j < nvis; j += NTHR) { if (sortable(sc[j]) > prefix) { const unsigned p = atomicAdd((unsigned*)&cw[2], 1u); selq[p] = (unsigned short)j; } }
            __syncthreads();
            if (F.wave == 0) {
                const unsigned base = cw[2]; unsigned taken = 0u;
                for (int j0 = 0; j0 < nvis && taken < need; j0 += 64) {
                    const int j = j0 + F.lane; const bool eq = j < nvis && sortable(sc[j]) == prefix;
                    const unsigned long long m = __ballot(eq);
                    const unsigned rank = (unsigned)__popcll(m & ((1ull << F.lane) - 1ull));
                    if (eq && taken + rank < need) selq[base + taken + rank] = (unsigned short)j;
                    taken += (unsigned)__popcll(m);
                }
            }
        }
        if (tid == 0) NSEL[q] = nvis < TOPK ? nvis : TOPK;
        __syncthreads();
    }
}

__device__ __forceinline__ void p6_attn_naive(Frame& F) {
    bf16* QA = WSP(bf16, WS_QA); const bf16* CKV = WSP(bf16, WS_CKV); const unsigned short* SEL = WSP(unsigned short, WS_SEL); const int* NSEL = WSP(int, WS_NSEL);
    LAS float* qf = (LAS float*)(F.lds + F.wave * 16384);
    LAS float* ps = qf + 1024;
    LAS int* srow = (LAS int*)(ps + 2048);
    const int l = F.lane;
    const int gw = blockIdx.x * NWAVES + F.wave, NGW = F.G * NWAVES;
    for (int q = gw; q < R; q += NGW) {
        bf16* qrow = QA + (size_t)q * QAW;
        if (q >= NROWS) {
            for (int c = l; c < QAW / 8; c += 64) *(v4u*)(qrow + 8 * c) = (v4u){0u, 0u, 0u, 0u};
            continue;
        }
        int b, pos; if (q < NREAL) { b = q >> 13; pos = NMETA + (q & (SEQ - 1)); } else { b = 0; pos = q - NREAL; }
        const int nsel = NSEL[q];
        {
            const v4u t0 = *(const v4u*)(qrow + 16 * l), t1 = *(const v4u*)(qrow + 16 * l + 8);
            LAS float* d = qf + 16 * l;
            d[0] = bflo(t0.x); d[1] = bfhi(t0.x); d[2] = bflo(t0.y); d[3] = bfhi(t0.y); d[4] = bflo(t0.z); d[5] = bfhi(t0.z); d[6] = bflo(t0.w); d[7] = bfhi(t0.w);
            d[8] = bflo(t1.x); d[9] = bfhi(t1.x); d[10] = bflo(t1.y); d[11] = bfhi(t1.y); d[12] = bflo(t1.z); d[13] = bfhi(t1.z); d[14] = bflo(t1.w); d[15] = bfhi(t1.w);
        }
        __builtin_amdgcn_wave_barrier();
        for (int kk = 0; kk < 4; ++kk) {
            const int s = kk * 64 + l; const bool valid = s < nsel;
            const int j = valid ? (int)SEL[(size_t)q * TOPK + s] : 0;
            const int row = key_row(b, j);
            srow[s] = row;
            float acc[8];
#pragma unroll
            for (int h = 0; h < 8; ++h) acc[h] = 0.f;
            const v4u* kp = (const v4u*)(CKV + (size_t)row * 128);
            for (int c8 = 0; c8 < 16; ++c8) {
                const v4u t = kp[c8];
                const float k0 = bflo(t.x), k1 = bfhi(t.x), k2 = bflo(t.y), k3 = bfhi(t.y), k4 = bflo(t.z), k5 = bfhi(t.z), k6 = bflo(t.w), k7 = bfhi(t.w);
#pragma unroll
                for (int h = 0; h < 8; ++h) {
                    const f32x4 qa = *(const LAS f32x4*)(qf + h * 128 + 8 * c8), qb = *(const LAS f32x4*)(qf + h * 128 + 8 * c8 + 4);
                    acc[h] += qa.x * k0 + qa.y * k1 + qa.z * k2 + qa.w * k3 + qb.x * k4 + qb.y * k5 + qb.z * k6 + qb.w * k7;
                }
            }
            const float dist = fabsf((float)(pos - j));
#pragma unroll
            for (int h = 0; h < 8; ++h) { const float slope = __uint_as_float((unsigned)(127 - (h + 1)) << 23); ps[s * 8 + h] = valid ? acc[h] - slope * dist : -INFINITY; }
        }
        __builtin_amdgcn_wave_barrier();
#pragma unroll
        for (int h = 0; h < 8; ++h) {
            float v0 = ps[(l) * 8 + h], v1 = ps[(l + 64) * 8 + h], v2 = ps[(l + 128) * 8 + h], v3 = ps[(l + 192) * 8 + h];
            const float mx = wave_max(fmaxf(fmaxf(v0, v1), fmaxf(v2, v3)));
            v0 = __expf(v0 - mx); v1 = __expf(v1 - mx); v2 = __expf(v2 - mx); v3 = __expf(v3 - mx);
            const float inv = 1.0f / wave_sum((v0 + v1) + (v2 + v3));
            ps[(l) * 8 + h] = v0 * inv; ps[(l + 64) * 8 + h] = v1 * inv; ps[(l + 128) * 8 + h] = v2 * inv; ps[(l + 192) * 8 + h] = v3 * inv;
        }
        __builtin_amdgcn_wave_barrier();
        float o0[8], o1[8];
#pragma unroll
        for (int h = 0; h < 8; ++h) { o0[h] = 0.f; o1[h] = 0.f; }
        for (int s = 0; s < nsel; ++s) {
            const int row = srow[s];
            const unsigned w = *(const unsigned*)(CKV + (size_t)row * 128 + 2 * l);
            const float c0 = bflo(w), c1 = bfhi(w);
            const f32x4 pa = *(const LAS f32x4*)(ps + s * 8), pb = *(const LAS f32x4*)(ps + s * 8 + 4);
            o0[0] += pa.x * c0; o1[0] += pa.x * c1; o0[1] += pa.y * c0; o1[1] += pa.y * c1; o0[2] += pa.z * c0; o1[2] += pa.z * c1; o0[3] += pa.w * c0; o1[3] += pa.w * c1;
            o0[4] += pb.x * c0; o1[4] += pb.x * c1; o0[5] += pb.y * c0; o1[5] += pb.y * c1; o0[6] += pb.z * c0; o1[6] += pb.z * c1; o0[7] += pb.w * c0; o1[7] += pb.w * c1;
        }
#pragma unroll
        for (int h = 0; h < 8; ++h) *(unsigned*)(qrow + h * 128 + 2 * l) = pk2(o0[h], o1[h]);
        __builtin_amdgcn_wave_barrier();
    }
}

__device__ __forceinline__ void p7_rwkv_prep_naive(Frame& F) {
    const bf16* P = WSP(bf16, WS_P); float* DEC = WSP(float, WS_DEC); bf16* AB = WSP(bf16, WS_AB); bf16* GB = WSP(bf16, WS_GB);
    const float* mu = F.in[IN_MU]; const float* Wd = F.in[IN_W_DEC]; const float* Wa = F.in[IN_W_AAA]; const float* Wg = F.in[IN_W_GATE];
    const int l = F.lane;
    const int gw = blockIdx.x * NWAVES + F.wave, NGW = F.G * NWAVES;
    for (int r = gw; r < NROWS; r += NGW) {
        int prev; if (r < NREAL) { prev = (r & (SEQ - 1)) ? r - 1 : NREAL + NMETA - 1; } else { prev = r > NREAL ? r - 1 : -1; }
        const bf16* pr = P + (size_t)r * PW; const bf16* pp = prev >= 0 ? P + (size_t)prev * PW : nullptr;
#define SHIFTED(pc, mc) (bf2f(pr[pc]) + ((pp ? bf2f(pp[pc]) : 0.f) - bf2f(pr[pc])) * mu[mc])
        const float tw = tanhf(SHIFTED(PC_WD + l, 1536 + l));
        const float ta = SHIFTED(PC_AD + l, 1600 + l);
        const float tg0 = sigmoidf_(SHIFTED(PC_GD + l, 1664 + l)), tg1 = sigmoidf_(SHIFTED(PC_GD + 64 + l, 1728 + l));
#undef SHIFTED
        float aw[8], aa[8], ag[8];
#pragma unroll
        for (int i = 0; i < 8; ++i) { aw[i] = F.in[IN_W0][l + 64 * i]; aa[i] = F.in[IN_A0][l + 64 * i]; ag[i] = 0.f; }
        for (int j = 0; j < 64; ++j) {
            const float xw = __shfl(tw, j), xa = __shfl(ta, j), xg0 = __shfl(tg0, j), xg1 = __shfl(tg1, j);
#pragma unroll
            for (int i = 0; i < 8; ++i) {
                aw[i] += xw * Wd[(size_t)j * 512 + l + 64 * i];
                aa[i] += xa * Wa[(size_t)j * 512 + l + 64 * i];
                ag[i] += xg0 * Wg[(size_t)j * 512 + l + 64 * i] + xg1 * Wg[(size_t)(j + 64) * 512 + l + 64 * i];
            }
        }
#pragma unroll
        for (int i = 0; i < 8; ++i) {
            const float x = -aw[i];
            const float sp = x > 20.f ? x : log1pf(__expf(x));
            const float wlog = -sp - 0.5f;
            DEC[(size_t)r * 512 + l + 64 * i] = __expf(-__expf(wlog));
            AB[(size_t)r * 512 + l + 64 * i] = (bf16)f2bf(sigmoidf_(aa[i]));
            GB[(size_t)r * 512 + l + 64 * i] = (bf16)f2bf(ag[i]);
        }
    }
}

__device__ __forceinline__ void p8_rwkv_scan_naive(Frame& F) {
    if (F.wave != 0 || blockIdx.x >= 32) return;
    const bf16* P = WSP(bf16, WS_P); const float* DEC = WSP(float, WS_DEC); const bf16* AB = WSP(bf16, WS_AB); const bf16* GB = WSP(bf16, WS_GB); bf16* QA = WSP(bf16, WS_QA);
    const int b = blockIdx.x >> 3, h = blockIdx.x & 7, l = F.lane, ch = h * 64 + l;
    LAS float* vec = (LAS float*)F.lds;
    const float mu_r = F.in[IN_MU][ch], mu_k = F.in[IN_MU][512 + ch], mu_v = F.in[IN_MU][1024 + ch];
    const float kk_c = F.in[IN_KK][ch], ka_c = F.in[IN_KA][ch], rk_c = F.in[IN_RK][ch], gng = F.in[IN_GN_G][ch], gnb = F.in[IN_GN_B][ch];
    float S[64];
#pragma unroll
    for (int k = 0; k < 64; ++k) S[k] = 0.f;
    float pr_p = 0.f, pk_p = 0.f, pv_p = 0.f;
    int row = key_row(b, 0);
    float n_pr = bf2f(P[(size_t)row * PW + PC_R + ch]), n_pk = bf2f(P[(size_t)row * PW + PC_K + ch]), n_pv = bf2f(P[(size_t)row * PW + PC_V + ch]);
    float n_w = DEC[(size_t)row * 512 + ch], n_a = bf2f(AB[(size_t)row * 512 + ch]), n_g = bf2f(GB[(size_t)row * 512 + ch]);
    for (int pos = 0; pos < TT; ++pos) {
        const int crow = row;
        const float c_pr = n_pr, c_pk = n_pk, c_pv = n_pv, c_w = n_w, c_a = n_a, c_g = n_g;
        if (pos + 1 < TT) {
            row = key_row(b, pos + 1);
            n_pr = bf2f(P[(size_t)row * PW + PC_R + ch]); n_pk = bf2f(P[(size_t)row * PW + PC_K + ch]); n_pv = bf2f(P[(size_t)row * PW + PC_V + ch]);
            n_w = DEC[(size_t)row * 512 + ch]; n_a = bf2f(AB[(size_t)row * 512 + ch]); n_g = bf2f(GB[(size_t)row * 512 + ch]);
        }
        const float r_s = c_pr + (pr_p - c_pr) * mu_r, k_s = c_pk + (pk_p - c_pk) * mu_k, v_s = c_pv + (pv_p - c_pv) * mu_v;
        pr_p = c_pr; pk_p = c_pk; pv_p = c_pv;
        const float kkr = k_s * kk_c;
        const float nrm = sqrtf(wave_sum(kkr * kkr));
        const float kk = kkr / fmaxf(nrm, 1e-12f);
        const float k2 = k_s * (1.f + (c_a - 1.f) * ka_c);
        vec[l] = -kk; vec[64 + l] = kk * c_a; vec[128 + l] = c_w; vec[192 + l] = k2; vec[256 + l] = r_s;
        __builtin_amdgcn_wave_barrier();
        float sa = 0.f;
#pragma unroll
        for (int k4 = 0; k4 < 16; ++k4) { const f32x4 a = *(const LAS f32x4*)(vec + 4 * k4); sa += S[4 * k4] * a.x + S[4 * k4 + 1] * a.y + S[4 * k4 + 2] * a.z + S[4 * k4 + 3] * a.w; }
        float y = 0.f;
#pragma unroll
        for (int k4 = 0; k4 < 16; ++k4) {
            const f32x4 bv = *(const LAS f32x4*)(vec + 64 + 4 * k4), w = *(const LAS f32x4*)(vec + 128 + 4 * k4), kv = *(const LAS f32x4*)(vec + 192 + 4 * k4), rv = *(const LAS f32x4*)(vec + 256 + 4 * k4);
            S[4 * k4] = S[4 * k4] * w.x + sa * bv.x + v_s * kv.x; S[4 * k4 + 1] = S[4 * k4 + 1] * w.y + sa * bv.y + v_s * kv.y;
            S[4 * k4 + 2] = S[4 * k4 + 2] * w.z + sa * bv.z + v_s * kv.z; S[4 * k4 + 3] = S[4 * k4 + 3] * w.w + sa * bv.w + v_s * kv.w;
            y += S[4 * k4] * rv.x + S[4 * k4 + 1] * rv.y + S[4 * k4 + 2] * rv.z + S[4 * k4 + 3] * rv.w;
        }
        __builtin_amdgcn_wave_barrier();
        const float mean = wave_sum(y) * (1.f / 64.f);
        const float dlt = y - mean;
        const float var = wave_sum(dlt * dlt) * (1.f / 64.f);
        const float yn = dlt * (1.0f / sqrtf(var + GN_EPS)) * gng + gnb;
        const float bonus = wave_sum(r_s * k2 * rk_c) * v_s;
        const float o = (yn + bonus) * c_g;
        if (pos >= NMETA || b == 0) QA[(size_t)crow * QAW + 1024 + ch] = (bf16)f2bf(o);
    }
}

__device__ __forceinline__ void p10_ln1(Frame& F) {
    bf16* H1 = WSP(bf16, WS_H); const float* META1 = WSP(float, WS_META1);
    const int gw = blockIdx.x * NWAVES + F.wave, NGW = F.G * NWAVES;
    for (int r = gw; r < NROWS; r += NGW) {
        const float* src = r < NREAL ? F.out + (size_t)r * D : META1 + (size_t)(r - NREAL) * D;
        ln_row_bf16(F, src, F.in[IN_LN1_G], F.in[IN_LN1_B], H1 + (size_t)r * D);
    }
}
__device__ __forceinline__ void p14_ln2(Frame& F) {
    const int gw = blockIdx.x * NWAVES + F.wave, NGW = F.G * NWAVES;
    const float* g = F.in[IN_LN2_G]; const float* b = F.in[IN_LN2_B];
    for (int r = gw; r < NREAL; r += NGW) {
        f32x4* xr = (f32x4*)(F.out + (size_t)r * D) + F.lane;
        f32x4 v[4]; float s = 0.f;
#pragma unroll
        for (int j = 0; j < 4; ++j) { v[j] = xr[64 * j]; s += (v[j].x + v[j].y) + (v[j].z + v[j].w); }
        const float mean = wave_sum(s) * (1.f / D); float s2 = 0.f;
#pragma unroll
        for (int j = 0; j < 4; ++j) { v[j] = v[j] - mean; s2 += (v[j].x * v[j].x + v[j].y * v[j].y) + (v[j].z * v[j].z + v[j].w * v[j].w); }
        const float rstd = 1.f / sqrtf(wave_sum(s2) * (1.f / D) + LN_EPS);
#pragma unroll
        for (int j = 0; j < 4; ++j) { const f32x4 gg = ((const f32x4*)g)[F.lane + 64 * j], bb = ((const f32x4*)b)[F.lane + 64 * j]; xr[64 * j] = v[j] * rstd * gg + bb; }
    }
}

__device__ __forceinline__ float gelu_fast(float x) {
    const float u2 = x * (1.5957691216057308f + 0.07135481627260025f * x * x);
    return x * __builtin_amdgcn_rcpf(1.0f + __builtin_amdgcn_exp2f(-1.4426950408889634f * u2));
}
__device__ __forceinline__ void p12_conv_act(Frame& F) {
    bf16* UP = WSP(bf16, WS_UP); const float* cw = F.in[IN_CONV_W]; const float* cb = F.in[IN_CONV_B];
    constexpr int NCG = DFF / 8, STRIP = 32, NSTRIP = NREAL / STRIP;
    for (int it = blockIdx.x * NTHR + F.tid; it < NSTRIP * NCG; it += F.G * NTHR) {
        const int cg = it % NCG, st = it / NCG, c = cg * 8, r0 = st * STRIP, s0 = r0 & (SEQ - 1);
        float w0[8], w1[8], w2[8], bb[8];
#pragma unroll
        for (int e = 0; e < 2; ++e) {
            const f32x4 a = *(const f32x4*)(cw + c + 4 * e), b = *(const f32x4*)(cw + DFF + c + 4 * e), d = *(const f32x4*)(cw + 2 * DFF + c + 4 * e), g = *(const f32x4*)(cb + c + 4 * e);
            w0[4 * e] = a.x; w0[4 * e + 1] = a.y; w0[4 * e + 2] = a.z; w0[4 * e + 3] = a.w; w1[4 * e] = b.x; w1[4 * e + 1] = b.y; w1[4 * e + 2] = b.z; w1[4 * e + 3] = b.w;
            w2[4 * e] = d.x; w2[4 * e + 1] = d.y; w2[4 * e + 2] = d.z; w2[4 * e + 3] = d.w; bb[4 * e] = g.x; bb[4 * e + 1] = g.y; bb[4 * e + 2] = g.z; bb[4 * e + 3] = g.w;
        }
        const int rm2 = s0 >= 2 ? r0 - 2 : NREAL + 14, rm1 = s0 >= 1 ? r0 - 1 : NREAL + 15;
        v4u gm2 = *(const v4u*)(UP + (size_t)rm2 * UPW + c), gm1 = *(const v4u*)(UP + (size_t)rm1 * UPW + c);
#pragma unroll 4
        for (int i = 0; i < STRIP; ++i) {
            const size_t ro = (size_t)(r0 + i) * UPW;
            const v4u g0 = *(const v4u*)(UP + ro + c); const v4u vv = *(const v4u*)(UP + ro + DFF + c);
            const unsigned a0[4] = {g0.x, g0.y, g0.z, g0.w}, a1[4] = {gm1.x, gm1.y, gm1.z, gm1.w}, a2[4] = {gm2.x, gm2.y, gm2.z, gm2.w}, av[4] = {vv.x, vv.y, vv.z, vv.w};
            unsigned o[4];
#pragma unroll
            for (int e = 0; e < 4; ++e) {
                const float x0 = w0[2 * e] * bflo(a2[e]) + w1[2 * e] * bflo(a1[e]) + w2[2 * e] * bflo(a0[e]) + bb[2 * e];
                const float x1 = w0[2 * e + 1] * bfhi(a2[e]) + w1[2 * e + 1] * bfhi(a1[e]) + w2[2 * e + 1] * bfhi(a0[e]) + bb[2 * e + 1];
                o[e] = pk2(gelu_fast(x0) * bflo(av[e]), gelu_fast(x1) * bfhi(av[e]));
            }
            *(v4u*)(UP + ro + DFF + c) = (v4u){o[0], o[1], o[2], o[3]};
            gm2 = gm1; gm1 = g0;
        }
    }
}


constexpr int NUNITS = 4096 + 8;
constexpr int RP = 72;
constexpr int SLOT = 64 * RP * 2;
constexpr int FP = 68;
typedef short bf16x8 __attribute__((ext_vector_type(8)));
typedef float f32x16 __attribute__((ext_vector_type(16)));
constexpr size_t RW_MAT = (size_t)NUNITS * 4096;

__device__ __forceinline__ void quad_mma(f32x16& acc, const LAS bf16* Aop, const LAS bf16* Bop, int qr, int qc, int lane) {
    const int r = lane & 31, hf = lane >> 5;
    const LAS bf16* ap = Aop + (32 * qr + r) * RP + 8 * hf; const LAS bf16* bp = Bop + (32 * qc + r) * RP + 8 * hf;
#pragma unroll
    for (int ks = 0; ks < 4; ++ks) {
        const bf16x8 a = *(const LAS bf16x8*)(ap + 16 * ks), b = *(const LAS bf16x8*)(bp + 16 * ks);
        acc = __builtin_amdgcn_mfma_f32_32x32x16_bf16(a, b, acc, 0, 0, 0);
    }
}
#define ACC_M(qr, j, hf) (32 * (qr) + ((j) & 3) + 8 * ((j) >> 2) + 4 * (hf))
__device__ __forceinline__ void store_T(const f32x16& acc, LAS bf16* Z, int qr, int qc, int lane) {
    const int r = lane & 31, hf = lane >> 5;
#pragma unroll
    for (int jj = 0; jj < 4; ++jj)
        *(LAS v2u*)(Z + (32 * qc + r) * RP + 32 * qr + 8 * jj + 4 * hf) = (v2u){pk2(acc[4 * jj], acc[4 * jj + 1]), pk2(acc[4 * jj + 2], acc[4 * jj + 3])};
}
__device__ __forceinline__ void add_T(f32x16& acc, const LAS bf16* Z, int qr, int qc, int lane) {
    const int r = lane & 31, hf = lane >> 5;
#pragma unroll
    for (int jj = 0; jj < 4; ++jj) {
        const v2u w = *(const LAS v2u*)(Z + (32 * qc + r) * RP + 32 * qr + 8 * jj + 4 * hf);
        acc[4 * jj] += bflo(w.x); acc[4 * jj + 1] += bfhi(w.x); acc[4 * jj + 2] += bflo(w.y); acc[4 * jj + 3] += bfhi(w.y);
    }
}
__device__ __forceinline__ void store_T_global(const f32x16& acc, bf16* Z, int qr, int qc, int lane) {
    const int r = lane & 31, hf = lane >> 5;
#pragma unroll
    for (int jj = 0; jj < 4; ++jj)
        *(v2u*)(Z + (32 * qc + r) * 64 + 32 * qr + 8 * jj + 4 * hf) = (v2u){pk2(acc[4 * jj], acc[4 * jj + 1]), pk2(acc[4 * jj + 2], acc[4 * jj + 3])};
}
__device__ __forceinline__ f32x16 zero16() { f32x16 z;
#pragma unroll
    for (int j = 0; j < 16; ++j) z[j] = 0.f;
    return z; }

__device__ __forceinline__ void rw_b1(Frame& F) {
    const bf16* P = WSP(bf16, WS_P);
    bf16* RWM = WSP(bf16, WS_RWM); bf16* RWN = WSP(bf16, WS_RWN); bf16* RWQ = WSP(bf16, WS_RWQ); bf16* RWY = WSP(bf16, WS_RWY);
    float* BONUS = (float*)((char*)F.out + OUT_BONUS);
    const bf16* WdT = WSP(bf16, WS_WT_LORA); const bf16* WaT = WdT + 512 * 64;
    const float* mu = F.in[IN_MU];
    const int w = F.wave, l = F.lane, tid = F.tid;
    LAS unsigned char* L = F.lds;
#define SL(s) ((LAS bf16*)(L + (s) * SLOT))
    LAS float* WL = (LAS float*)(L + 12 * SLOT);
    LAS float* AL = (LAS float*)(L + 0 * SLOT);
    LAS float* OT = (LAS float*)(L + RING_BYTES + 1024);
    LAS float* GL = OT + 512;
    for (int u = blockIdx.x; u < NUNITS; u += F.G) {
        const bool meta = u >= 4096;
        int b = 0, h, c = 0; if (meta) h = u - 4096; else { b = u >> 10; h = (u >> 7) & 7; c = u & 127; }
        const int ch = h * 64 + l;
        const int row0 = meta ? NREAL : b * SEQ + c * 64;
        __syncthreads();
        float r_s[8], k_s[8], v_s[8], xw[8], xa[8];
        {
            float pr, pk, pv, pw, pa;
            const int t0 = 8 * w;
            int prow = -1;
            if (t0 > 0) prow = row0 + t0 - 1; else if (!meta) prow = (c == 0) ? NREAL + NMETA - 1 : row0 - 1;
            if (prow >= 0) { const bf16* pp = P + (size_t)prow * PW; pr = bf2f(pp[PC_R + ch]); pk = bf2f(pp[PC_K + ch]); pv = bf2f(pp[PC_V + ch]); pw = bf2f(pp[PC_WD + l]); pa = bf2f(pp[PC_AD + l]); }
            else { pr = pk = pv = pw = pa = 0.f; }
            const float mr = mu[ch], mk = mu[512 + ch], mv = mu[1024 + ch], mw = mu[1536 + l], ma = mu[1600 + l];
#pragma unroll
            for (int i = 0; i < 8; ++i) {
                const int t = t0 + i; const bool valid = !meta || t < NMETA;
                float cr = 0.f, ck = 0.f, cv = 0.f, cw = 0.f, ca = 0.f;
                if (valid) { const bf16* pp = P + (size_t)(row0 + t) * PW; cr = bf2f(pp[PC_R + ch]); ck = bf2f(pp[PC_K + ch]); cv = bf2f(pp[PC_V + ch]); cw = bf2f(pp[PC_WD + l]); ca = bf2f(pp[PC_AD + l]); }
                r_s[i] = valid ? cr + (pr - cr) * mr : 0.f; k_s[i] = valid ? ck + (pk - ck) * mk : 0.f; v_s[i] = valid ? cv + (pv - cv) * mv : 0.f;
                xw[i] = tanhf(cw + (pw - cw) * mw); xa[i] = ca + (pa - ca) * ma;
                pr = cr; pk = ck; pv = cv; pw = cw; pa = ca;
            }
#pragma unroll
            for (int i = 0; i < 8; ++i) { SL(8)[(t0 + i) * RP + l] = (bf16)f2bf(xw[i]); SL(9)[(t0 + i) * RP + l] = (bf16)f2bf(xa[i]); }
            {
                const int k = tid >> 3, pc = tid & 7;
                *(LAS v4u*)(SL(10) + k * RP + 8 * pc) = *(const v4u*)(WdT + (size_t)(h * 64 + k) * 64 + 8 * pc);
                *(LAS v4u*)(SL(11) + k * RP + 8 * pc) = *(const v4u*)(WaT + (size_t)(h * 64 + k) * 64 + 8 * pc);
            }
        }
        __syncthreads();
        {
            const int pid = w >> 2, q = w & 3, qr = q >> 1, qc = q & 1;
            f32x16 acc = zero16();
            quad_mma(acc, SL(10 + pid), SL(8 + pid), qr, qc, l);
            LAS float* Zf = pid ? AL : WL;
            const int r = l & 31, hf = l >> 5;
#pragma unroll
            for (int jj = 0; jj < 4; ++jj) *(LAS f32x4*)(Zf + (32 * qc + r) * FP + 32 * qr + 8 * jj + 4 * hf) = (f32x4){acc[4 * jj], acc[4 * jj + 1], acc[4 * jj + 2], acc[4 * jj + 3]};
        }
        __syncthreads();
        float lw[8], asg[8];
        {
            const float w0c = F.in[IN_W0][ch], a0c = F.in[IN_A0][ch];
            float run = 0.f;
#pragma unroll
            for (int i = 0; i < 8; ++i) {
                const int t = 8 * w + i; const bool valid = !meta || t < NMETA;
                const float x = -(WL[t * FP + l] + w0c);
                const float sp = x > 20.f ? x : log1pf(__expf(x));
                const float e = -__expf(-sp - 0.5f);
                run += valid ? e : 0.f; lw[i] = run;
                asg[i] = sigmoidf_(AL[t * FP + l] + a0c);
            }
            OT[w * 64 + l] = run;
        }
        __syncthreads();
        {
            float off = 0.f, tot = 0.f;
#pragma unroll
            for (int ww = 0; ww < 8; ++ww) { const float o = OT[ww * 64 + l]; tot += o; off += ww < w ? o : 0.f; }
            if (w == 0) GL[l] = __expf(tot);
            const float kkc = F.in[IN_KK][ch], kac = F.in[IN_KA][ch], rkc = F.in[IN_RK][ch];
            unsigned atc[4], vc[4], bhc[4], khc[4];
            float prevlg = off;
#pragma unroll
            for (int i = 0; i < 8; ++i) {
                const int t = 8 * w + i;
                const float lg = off + lw[i];
                const float g = __expf(lg), gp = __expf(prevlg), gi = __expf(-lg), gh = __expf(tot - lg);
                prevlg = lg;
                const float kkr = k_s[i] * kkc;
                const float nrm = sqrtf(wave_sum(kkr * kkr));
                const float kk = kkr / fmaxf(nrm, 1e-12f);
                const float k2 = k_s[i] * (1.f + (asg[i] - 1.f) * kac);
                const float bon = wave_sum(r_s[i] * k2 * rkc);
                if (l == 0) BONUS[(size_t)u * 64 + t] = bon;
                const float at = -kk * gp, rt = r_s[i] * g, bt = kk * asg[i] * gi, kt = k2 * gi, bh = kk * asg[i] * gh, kh = k2 * gh;
                SL(0)[t * RP + l] = (bf16)f2bf(at); SL(1)[t * RP + l] = (bf16)f2bf(rt); SL(2)[t * RP + l] = (bf16)f2bf(bt); SL(3)[t * RP + l] = (bf16)f2bf(kt);
                const unsigned ua = f2bf(at), uv = f2bf(v_s[i]), ub = f2bf(bh), uk = f2bf(kh);
                if (i & 1) { atc[i >> 1] |= ua << 16; vc[i >> 1] |= uv << 16; bhc[i >> 1] |= ub << 16; khc[i >> 1] |= uk << 16; }
                else { atc[i >> 1] = ua; vc[i >> 1] = uv; bhc[i >> 1] = ub; khc[i >> 1] = uk; }
            }
            *(LAS v4u*)(SL(4) + l * RP + 8 * w) = (v4u){atc[0], atc[1], atc[2], atc[3]};
            *(LAS v4u*)(SL(5) + l * RP + 8 * w) = (v4u){vc[0], vc[1], vc[2], vc[3]};
            *(LAS v4u*)(SL(6) + l * RP + 8 * w) = (v4u){bhc[0], bhc[1], bhc[2], bhc[3]};
            *(LAS v4u*)(SL(7) + l * RP + 8 * w) = (v4u){khc[0], khc[1], khc[2], khc[3]};
        }
        __syncthreads();
        for (int task = w; task < 20; task += 8) {
            const int pid = task >> 2, q = task & 3, qr = q >> 1, qc = q & 1;
            const int bop = pid == 0 ? 0 : pid == 1 ? 2 : pid == 2 ? 0 : 1;
            const int aop = pid == 0 ? 2 : pid == 1 ? 0 : pid == 2 ? 3 : pid == 3 ? 2 : 3;
            f32x16 acc = zero16();
            quad_mma(acc, SL(aop), SL(bop), qr, qc, l);
            const int n = 32 * qc + (l & 31), hf = l >> 5;
#pragma unroll
            for (int j = 0; j < 16; ++j) {
                const int m = ACC_M(qr, j, hf);
                const bool keep = pid == 1 ? (m > n) : (pid <= 2 ? (n > m) : (n >= m));
                acc[j] = keep ? acc[j] : 0.f;
            }
            store_T(acc, SL(8 + pid), qr, qc, l);
        }
        __syncthreads();
        const int nq = w & 3, nqr = nq >> 1, nqc = nq & 1;
        f32x16 nacc = zero16();
        if (w < 4) { add_T(nacc, SL(8), nqr, nqc, l); }
        for (int task = w; task < 12; task += 8) {
            const int pid = task >> 2, q = task & 3, qr = q >> 1, qc = q & 1;
            f32x16 acc = zero16();
            if (pid == 0) { quad_mma(acc, SL(9), SL(8), qr, qc, l); store_T(acc, SL(0), qr, qc, l); }
            else if (pid == 1) { quad_mma(acc, SL(8), SL(9), qr, qc, l); store_T(acc, SL(2), qr, qc, l); }
            else { quad_mma(acc, SL(10), SL(5), qr, qc, l); store_T(acc, SL(3), qr, qc, l); }
        }
        __syncthreads();
#pragma unroll
        for (int st = 0; st < 4; ++st) {
            const int pr = (st & 1) ? 10 : 0, pc = (st & 1) ? 13 : 2, pr2 = (st & 1) ? 0 : 10, pc2 = (st & 1) ? 2 : 13, nr = (st & 1) ? 9 : 8, nr2 = (st & 1) ? 8 : 9;
            if (w < 4) {
                add_T(nacc, SL(pr), nqr, nqc, l);
                quad_mma(nacc, SL(pc), SL(nr), nqr, nqc, l);
                store_T(nacc, SL(nr2), nqr, nqc, l);
                f32x16 acc = zero16();
                quad_mma(acc, SL(pc), SL(pr), nqr, nqc, l); store_T(acc, SL(pr2), nqr, nqc, l);
            } else {
                f32x16 acc = zero16();
                quad_mma(acc, SL(pr), SL(pc), nqr, nqc, l); store_T(acc, SL(pc2), nqr, nqc, l);
            }
            __syncthreads();
        }
        if (w < 4) { add_T(nacc, SL(0), nqr, nqc, l); quad_mma(nacc, SL(2), SL(8), nqr, nqc, l); store_T(nacc, SL(9), nqr, nqc, l); }
        __syncthreads();
        {
            const int pid = w >> 2;
            f32x16 acc = zero16();
            add_T(acc, SL(pid ? 3 : 4), nqr, nqc, l);
            quad_mma(acc, SL(9), SL(pid ? 3 : 4), nqr, nqc, l);
            store_T(acc, SL(pid ? 2 : 0), nqr, nqc, l);
        }
        __syncthreads();
        for (int task = w; task < 16; task += 8) {
            const int pid = task >> 2, q = task & 3, qr = q >> 1, qc = q & 1;
            f32x16 acc = zero16();
            if (pid == 0) { add_T(acc, SL(1), qr, qc, l); quad_mma(acc, SL(0), SL(11), qr, qc, l); store_T_global(acc, RWQ + (size_t)u * 4096, qr, qc, l); }
            else if (pid == 1) { quad_mma(acc, SL(2), SL(11), qr, qc, l); quad_mma(acc, SL(5), SL(12), qr, qc, l); store_T_global(acc, RWY + (size_t)u * 4096, qr, qc, l); }
            else if (pid == 2) {
                quad_mma(acc, SL(0), SL(6), qr, qc, l);
                const int n = 32 * qc + (l & 31), hf = l >> 5; const float gl = GL[n];
#pragma unroll
                for (int j = 0; j < 16; ++j) acc[j] += (ACC_M(qr, j, hf) == n) ? gl : 0.f;
                store_T_global(acc, RWM + (size_t)u * 4096, qr, qc, l);
            } else { quad_mma(acc, SL(6), SL(2), qr, qc, l); quad_mma(acc, SL(7), SL(5), qr, qc, l); store_T_global(acc, RWN + (size_t)u * 4096, qr, qc, l); }
        }
    }
#undef SL
}

__device__ __forceinline__ void rw_b2(Frame& F) {
    if (blockIdx.x >= 32) return;
    const bf16* RWM = WSP(bf16, WS_RWM); const bf16* RWN = WSP(bf16, WS_RWN);
    bf16* RWS = (bf16*)((char*)F.out + OUT_RWS);
    const int b = blockIdx.x >> 3, h = blockIdx.x & 7, w = F.wave, l = F.lane;
    LAS unsigned char* L = F.lds;
#define SS(buf, part) ((LAS bf16*)(L + ((buf) * 2 + (part)) * SLOT))
    const int q = w & 3, qr = q >> 1, qc = q & 1, r = l & 31, hf = l >> 5;
    if (w < 4) {
        const bf16* Nm = RWN + (size_t)(4096 + h) * 4096;
#pragma unroll
        for (int jj = 0; jj < 4; ++jj) {
            const v2u wv = *(const v2u*)(Nm + (32 * qc + r) * 64 + 32 * qr + 8 * jj + 4 * hf);
            *(LAS v2u*)(SS(0, 0) + (32 * qc + r) * RP + 32 * qr + 8 * jj + 4 * hf) = wv;
            *(LAS v2u*)(SS(0, 1) + (32 * qc + r) * RP + 32 * qr + 8 * jj + 4 * hf) = (v2u){0u, 0u};
        }
    }
    __syncthreads();
    bf16x8 a_cur[4]; v2u n_cur[4];
    {
        const size_t u0 = (size_t)(b * 8 + h) * 128;
#pragma unroll
        for (int ks = 0; ks < 4; ++ks) a_cur[ks] = *(const bf16x8*)(RWM + u0 * 4096 + (32 * qr + r) * 64 + 8 * hf + 16 * ks);
#pragma unroll
        for (int jj = 0; jj < 4; ++jj) n_cur[jj] = *(const v2u*)(RWN + u0 * 4096 + (32 * qc + r) * 64 + 32 * qr + 8 * jj + 4 * hf);
    }
    for (int c = 0; c < 128; ++c) {
        const int u = (b * 8 + h) * 128 + c, cur = c & 1;
        if (w < 4) {
            bf16x8 a_nxt[4]; v2u n_nxt[4];
            const size_t un = (size_t)(c + 1 < 128 ? u + 1 : u);
#pragma unroll
            for (int ks = 0; ks < 4; ++ks) a_nxt[ks] = *(const bf16x8*)(RWM + un * 4096 + (32 * qr + r) * 64 + 8 * hf + 16 * ks);
#pragma unroll
            for (int jj = 0; jj < 4; ++jj) n_nxt[jj] = *(const v2u*)(RWN + un * 4096 + (32 * qc + r) * 64 + 32 * qr + 8 * jj + 4 * hf);
            f32x16 acc;
#pragma unroll
            for (int jj = 0; jj < 4; ++jj) { acc[4 * jj] = bflo(n_cur[jj].x); acc[4 * jj + 1] = bfhi(n_cur[jj].x); acc[4 * jj + 2] = bflo(n_cur[jj].y); acc[4 * jj + 3] = bfhi(n_cur[jj].y); }
#pragma unroll
            for (int jj = 0; jj < 4; ++jj)
                *(v2u*)(RWS + (size_t)u * 4096 + (32 * qc + r) * 64 + 32 * qr + 8 * jj + 4 * hf) = *(const LAS v2u*)(SS(cur, 0) + (32 * qc + r) * RP + 32 * qr + 8 * jj + 4 * hf);
            const LAS bf16* bh = SS(cur, 0) + (32 * qc + r) * RP + 8 * hf; const LAS bf16* bl = SS(cur, 1) + (32 * qc + r) * RP + 8 * hf;
#pragma unroll
            for (int ks = 0; ks < 4; ++ks) {
                acc = __builtin_amdgcn_mfma_f32_32x32x16_bf16(a_cur[ks], *(const LAS bf16x8*)(bh + 16 * ks), acc, 0, 0, 0);
                acc = __builtin_amdgcn_mfma_f32_32x32x16_bf16(a_cur[ks], *(const LAS bf16x8*)(bl + 16 * ks), acc, 0, 0, 0);
            }
#pragma unroll
            for (int jj = 0; jj < 4; ++jj) {
                float hi[4], lo[4];
#pragma unroll
                for (int e = 0; e < 4; ++e) { const unsigned hb = f2bf(acc[4 * jj + e]); hi[e] = __uint_as_float(hb << 16); lo[e] = acc[4 * jj + e] - hi[e]; }
                *(LAS v2u*)(SS(cur ^ 1, 0) + (32 * qc + r) * RP + 32 * qr + 8 * jj + 4 * hf) = (v2u){pk2(hi[0], hi[1]), pk2(hi[2], hi[3])};
                *(LAS v2u*)(SS(cur ^ 1, 1) + (32 * qc + r) * RP + 32 * qr + 8 * jj + 4 * hf) = (v2u){pk2(lo[0], lo[1]), pk2(lo[2], lo[3])};
            }
#pragma unroll
            for (int ks = 0; ks < 4; ++ks) a_cur[ks] = a_nxt[ks];
#pragma unroll
            for (int jj = 0; jj < 4; ++jj) n_cur[jj] = n_nxt[jj];
        }
        __syncthreads();
    }
#undef SS
}

__device__ __forceinline__ void rw_b3(Frame& F) {
    const bf16* P = WSP(bf16, WS_P); bf16* QA = WSP(bf16, WS_QA);
    const bf16* RWQ = WSP(bf16, WS_RWQ); const bf16* RWY = WSP(bf16, WS_RWY);
    const bf16* RWS = (const bf16*)((const char*)F.out + OUT_RWS); const float* BONUS = (const float*)((const char*)F.out + OUT_BONUS);
    const bf16* WgT = WSP(bf16, WS_WT_LORA) + 2 * 512 * 64;
    const float* mu = F.in[IN_MU];
    const int l = F.lane, r = l & 31, hf = l >> 5;
    const int gw = blockIdx.x * NWAVES + F.wave, NGW = F.G * NWAVES;
    for (int it = gw; it < NUNITS * 2; it += NGW) {
        const int u = it >> 1, th = it & 1;
        const bool meta = u >= 4096;
        int b = 0, h, c = 0; if (meta) h = u - 4096; else { b = u >> 10; h = (u >> 7) & 7; c = u & 127; }
        if (meta && th == 1) continue;
        const int t = 32 * th + r;
        const bool valid = !meta || t < NMETA;
        const int row0 = meta ? NREAL : b * SEQ + c * 64;
        const int row = valid ? row0 + t : row0;
        int prow = -1;
        if (t > 0) prow = row - 1; else if (!meta) prow = (c == 0) ? NREAL + NMETA - 1 : row - 1;
        f32x16 y[2];
#pragma unroll
        for (int qv = 0; qv < 2; ++qv) {
            const bf16* Y0 = RWY + (size_t)u * 4096 + (32 * th + r) * 64 + 32 * qv + 4 * hf;
#pragma unroll
            for (int jj = 0; jj < 4; ++jj) { const v2u wv = *(const v2u*)(Y0 + 8 * jj); y[qv][4 * jj] = bflo(wv.x); y[qv][4 * jj + 1] = bfhi(wv.x); y[qv][4 * jj + 2] = bflo(wv.y); y[qv][4 * jj + 3] = bfhi(wv.y); }
        }
        if (!meta) {
            const bf16* qp = RWQ + (size_t)u * 4096 + (32 * th + r) * 64 + 8 * hf;
            const bf16* sp = RWS + (size_t)u * 4096 + r * 64 + 8 * hf;
#pragma unroll
            for (int ks = 0; ks < 4; ++ks) {
                const bf16x8 bq = *(const bf16x8*)(qp + 16 * ks);
                y[0] = __builtin_amdgcn_mfma_f32_32x32x16_bf16(*(const bf16x8*)(sp + 16 * ks), bq, y[0], 0, 0, 0);
                y[1] = __builtin_amdgcn_mfma_f32_32x32x16_bf16(*(const bf16x8*)(sp + 32 * 64 + 16 * ks), bq, y[1], 0, 0, 0);
            }
        }
        f32x16 g[2]; g[0] = zero16(); g[1] = zero16();
        {
            const bf16* gp = P + (size_t)row * PW + PC_GD + 8 * hf; const bf16* gpp = prow >= 0 ? P + (size_t)prow * PW + PC_GD + 8 * hf : nullptr;
            const bf16* wp = WgT + (size_t)(h * 64 + r) * 128 + 8 * hf;
#pragma unroll
            for (int ks = 0; ks < 8; ++ks) {
                const v4u cg = *(const v4u*)(gp + 16 * ks); const v4u pg = gpp ? *(const v4u*)(gpp + 16 * ks) : (v4u){0u, 0u, 0u, 0u};
                const f32x4 m0 = *(const f32x4*)(mu + 1664 + 16 * ks + 8 * hf), m1 = *(const f32x4*)(mu + 1664 + 16 * ks + 8 * hf + 4);
                const unsigned cw[4] = {cg.x, cg.y, cg.z, cg.w}, pw[4] = {pg.x, pg.y, pg.z, pg.w}; const float mm[8] = {m0.x, m0.y, m0.z, m0.w, m1.x, m1.y, m1.z, m1.w};
                unsigned o[4];
#pragma unroll
                for (int e = 0; e < 4; ++e) {
                    const float c0 = bflo(cw[e]), c1 = bfhi(cw[e]), p0 = bflo(pw[e]), p1 = bfhi(pw[e]);
                    o[e] = pk2(sigmoidf_(c0 + (p0 - c0) * mm[2 * e]), sigmoidf_(c1 + (p1 - c1) * mm[2 * e + 1]));
                }
                const v4u ov = (v4u){o[0], o[1], o[2], o[3]};
                const bf16x8 bs = __builtin_bit_cast(bf16x8, ov);
                g[0] = __builtin_amdgcn_mfma_f32_32x32x16_bf16(*(const bf16x8*)(wp + 16 * ks), bs, g[0], 0, 0, 0);
                g[1] = __builtin_amdgcn_mfma_f32_32x32x16_bf16(*(const bf16x8*)(wp + 32 * 128 + 16 * ks), bs, g[1], 0, 0, 0);
            }
        }
        float s = 0.f;
#pragma unroll
        for (int j = 0; j < 16; ++j) s += y[0][j] + y[1][j];
        s += __shfl_xor(s, 32);
        const float mean = s * (1.f / 64.f);
        float s2 = 0.f;
#pragma unroll
        for (int j = 0; j < 16; ++j) { const float d0 = y[0][j] - mean, d1 = y[1][j] - mean; s2 += d0 * d0 + d1 * d1; }
        s2 += __shfl_xor(s2, 32);
        const float rstd = 1.0f / sqrtf(s2 * (1.f / 64.f) + GN_EPS);
        const float bon = BONUS[(size_t)u * 64 + t];
        if (valid) {
#pragma unroll
            for (int qv = 0; qv < 2; ++qv)
#pragma unroll
                for (int jj = 0; jj < 4; ++jj) {
                    const int v0 = 32 * qv + 8 * jj + 4 * hf, chv = h * 64 + v0;
                    const v2u cvw = *(const v2u*)(P + (size_t)row * PW + PC_V + chv); const v2u pvw = prow >= 0 ? *(const v2u*)(P + (size_t)prow * PW + PC_V + chv) : (v2u){0u, 0u};
                    const f32x4 mv = *(const f32x4*)(mu + 1024 + chv), gg = *(const f32x4*)(F.in[IN_GN_G] + chv), gb = *(const f32x4*)(F.in[IN_GN_B] + chv);
                    const float cv[4] = {bflo(cvw.x), bfhi(cvw.x), bflo(cvw.y), bfhi(cvw.y)}, pv[4] = {bflo(pvw.x), bfhi(pvw.x), bflo(pvw.y), bfhi(pvw.y)};
                    const float mvv[4] = {mv.x, mv.y, mv.z, mv.w}, ggv[4] = {gg.x, gg.y, gg.z, gg.w}, gbv[4] = {gb.x, gb.y, gb.z, gb.w};
                    float o[4];
#pragma unroll
                    for (int e = 0; e < 4; ++e) {
                        const float vs = cv[e] + (pv[e] - cv[e]) * mvv[e];
                        o[e] = ((y[qv][4 * jj + e] - mean) * rstd * ggv[e] + gbv[e] + bon * vs) * g[qv][4 * jj + e];
                    }
                    *(v2u*)(QA + (size_t)row * QAW + 1024 + chv) = (v2u){pk2(o[0], o[1]), pk2(o[2], o[3])};
                }
        }
    }
}

constexpr int IX_CAP = 512, IX_LIST = 3072, IX_KB = 98304, IX_SCR = RING_BYTES + 4096;
#define IX_FENCE() asm volatile("s_waitcnt lgkmcnt(0)" ::: "memory")

__device__ __forceinline__ unsigned ix_mbcnt(unsigned long long m) { return __builtin_amdgcn_mbcnt_hi((unsigned)(m >> 32), __builtin_amdgcn_mbcnt_lo((unsigned)m, 0u)); }

__device__ __forceinline__ void ix_select_slow(const float (&sc)[8], const unsigned (&ix)[8], bool (&vl)[8], int K, unsigned short* sel_out, int lane) {
    for (int it = 0; it < K; ++it) {
        unsigned long long best = 0ull;
#pragma unroll
        for (int i = 0; i < 8; ++i) { const unsigned long long key = ((unsigned long long)sortable(sc[i]) << 32) | (unsigned long long)(0xFFFFu - ix[i]) | 0x10000ull; if (vl[i] && key > best) best = key; }
        unsigned long long wm = best;
#pragma unroll
        for (int o = 1; o < 64; o <<= 1) { const unsigned long long v = __shfl_xor(wm, o); wm = v > wm ? v : wm; }
        if (wm == 0ull) break;
        const bool mine = best == wm;
#pragma unroll
        for (int i = 0; i < 8; ++i) { const unsigned long long key = ((unsigned long long)sortable(sc[i]) << 32) | (unsigned long long)(0xFFFFu - ix[i]) | 0x10000ull; if (mine && vl[i] && key == wm) { vl[i] = false; sel_out[it] = (unsigned short)ix[i]; } }
    }
}

__device__ __forceinline__ void ix_compact(LAS float* LS, LAS unsigned short* LI, LAS unsigned* hist, int& cnt, float& tau, int lane, bool final_sel, unsigned short* sel_out) {
    const int n = cnt;
    float sc[8]; unsigned ix[8]; bool vl[8];
    IX_FENCE();
#pragma unroll
    for (int i = 0; i < 8; ++i) { const int p = lane + 64 * i; vl[i] = p < n; sc[i] = vl[i] ? LS[p] : -INFINITY; ix[i] = vl[i] ? (unsigned)LI[p] : 0u; }
    float mx = -INFINITY, mn = INFINITY;
#pragma unroll
    for (int i = 0; i < 8; ++i) { if (vl[i]) { mx = fmaxf(mx, sc[i]); mn = fminf(mn, sc[i]); } }
    mx = wave_max(mx); mn = -wave_max(-mn);
    const float scale = mx > mn ? 255.99f / (mx - mn) : 0.f;
    int bin[8];
#pragma unroll
    for (int i = 0; i < 8; ++i) { int bq = (int)((sc[i] - mn) * scale); bq = bq > 255 ? 255 : (bq < 0 ? 0 : bq); bin[i] = vl[i] ? bq : -1; }
    *(LAS v4u*)(hist + 4 * lane) = (v4u){0u, 0u, 0u, 0u};
    IX_FENCE();
#pragma unroll
    for (int i = 0; i < 8; ++i) if (vl[i]) __hip_atomic_fetch_add((LAS unsigned*)&hist[bin[i]], 1u, __ATOMIC_RELAXED, __HIP_MEMORY_SCOPE_WAVEFRONT);
    IX_FENCE();
    const v4u c = *(const LAS v4u*)(hist + 4 * lane);
    unsigned Pp = c.x + c.y + c.z + c.w;
#pragma unroll
    for (int o = 1; o < 64; o <<= 1) { const unsigned v = __shfl_up(Pp, o); if (lane >= o) Pp += v; }
    const unsigned total = __shfl(Pp, 63);
    const unsigned K = TOPK;
    const unsigned a3 = total - Pp, a2 = a3 + c.w, a1 = a2 + c.z, a0 = a1 + c.y;
    int myb = -1; unsigned myA = 0u, myC = 0u;
    if (a3 < K && K <= a3 + c.w) { myb = 4 * lane + 3; myA = a3; myC = c.w; }
    else if (a2 < K && K <= a2 + c.z) { myb = 4 * lane + 2; myA = a2; myC = c.z; }
    else if (a1 < K && K <= a1 + c.y) { myb = 4 * lane + 1; myA = a1; myC = c.y; }
    else if (a0 < K && K <= a0 + c.x) { myb = 4 * lane; myA = a0; myC = c.x; }
    const unsigned long long bm = __ballot(myb >= 0);
    const int src = bm ? (__ffsll((long long)bm) - 1) : 0;
    const int bstar = __shfl(myb, src); const unsigned A = __shfl(myA, src), m = __shfl(myC, src);
    if (!final_sel) {
        if (A + m <= (unsigned)(IX_CAP - 96)) {
            int base = 0; float kmin = INFINITY;
#pragma unroll
            for (int i = 0; i < 8; ++i) {
                const bool keep = vl[i] && bin[i] >= bstar;
                const unsigned long long mk = __ballot(keep);
                const int pos = base + (int)ix_mbcnt(mk);
                if (keep) { LS[pos] = sc[i]; LI[pos] = (unsigned short)ix[i]; kmin = fminf(kmin, sc[i]); }
                base += __popcll(mk);
            }
            cnt = base; tau = -wave_max(-kmin);
            IX_FENCE();
            return;
        }
        unsigned short* tmp = sel_out;
        ix_select_slow(sc, ix, vl, (int)K, tmp, lane);
        int base = 0; float kmin = INFINITY;
#pragma unroll
        for (int i = 0; i < 8; ++i) {
            const bool keep = !vl[i] && (lane + 64 * i) < n;
            const unsigned long long mk = __ballot(keep);
            const int pos = base + (int)ix_mbcnt(mk);
            if (keep) { LS[pos] = sc[i]; LI[pos] = (unsigned short)ix[i]; kmin = fminf(kmin, sc[i]); }
            base += __popcll(mk);
        }
        cnt = base; tau = -wave_max(-kmin);
        IX_FENCE();
        return;
    }
    if (m <= 128u) {
        int base = 0;
#pragma unroll
        for (int i = 0; i < 8; ++i) {
            const bool keep = vl[i] && bin[i] > bstar;
            const unsigned long long mk = __ballot(keep);
            const int pos = base + (int)ix_mbcnt(mk);
            if (keep) sel_out[pos] = (unsigned short)ix[i];
            base += __popcll(mk);
        }
        LAS float* sS = (LAS float*)hist; LAS unsigned* sI = hist + 128;
        IX_FENCE();
        int mb = 0;
#pragma unroll
        for (int i = 0; i < 8; ++i) {
            const bool inb = vl[i] && bin[i] == bstar;
            const unsigned long long mk = __ballot(inb);
            const int pos = mb + (int)ix_mbcnt(mk);
            if (inb) { sS[pos] = sc[i]; sI[pos] = ix[i]; }
            mb += __popcll(mk);
        }
        IX_FENCE();
        const int need = (int)(K - A);
#pragma unroll
        for (int e = 0; e < 2; ++e) {
            const int j = lane + 64 * e;
            if (j < (int)m) {
                const float sj = sS[j]; const unsigned ij = sI[j]; int rank = 0;
                for (int k = 0; k < (int)m; ++k) { const float sk = sS[k]; const unsigned ik = sI[k]; rank += (sk > sj || (sk == sj && ik < ij)) ? 1 : 0; }
                if (rank < need) sel_out[(int)A + rank] = (unsigned short)ij;
            }
        }
    } else {
        ix_select_slow(sc, ix, vl, (int)K, sel_out, lane);
    }
}

__device__ __forceinline__ void p5_index_mfma(Frame& F, unsigned short* SEL, int* NSEL) {
    const bf16* QA = WSP(bf16, WS_QA); const bf16* KIDX = WSP(bf16, WS_KIDX); const float* WIDX = WSP(float, WS_WIDX);
    const int tid = F.tid, w = F.wave, l = F.lane, r = l & 31, hf = l >> 5;
    {
        const int gw = blockIdx.x * NWAVES + w, NGW = F.G * NWAVES;
        for (int i = gw; i < NMETA + BATCH * 192; i += NGW) {
            int q, nvis; if (i < NMETA) { q = NREAL + i; nvis = NMETA; } else { const int bb = (i - NMETA) / 192, s = (i - NMETA) % 192; q = bb * SEQ + s; nvis = NMETA + 64 * (s / 64 + 1); }
            for (int j = l; j < nvis; j += 64) SEL[(size_t)q * TOPK + j] = (unsigned short)j;
            if (l == 0) NSEL[q] = nvis;
        }
    }
    LAS unsigned char* L = F.lds;
    LAS unsigned* hist = (LAS unsigned*)(L + IX_SCR + w * 1024);
    {
        for (int i = blockIdx.x; i < 1024; i += F.G) {
            const int kq = i >> 8;
            const int tile = (kq & 1) ? ((kq == 1 ? 767 : 1791) - i) : i;
            if (tile >= 1000) continue;
            const int pt = 6 + (tile >> 2), b = tile & 3;
            const int q0 = b * SEQ + pt * 32;
            const int nvis = NMETA + 64 * (pt / 2 + 1);
            const int nblk = (nvis + 127) >> 7;
            __syncthreads();
            bf16x8 af[4];
            {
                const int qq = 2 * (r >> 4) + ((r >> 2) & 1), hd = 4 * ((r >> 3) & 1) + (r & 3);
                const bf16* qp = QA + (size_t)(q0 + 4 * w + qq) * QAW + 1024 + hd * 64 + 8 * hf;
#pragma unroll
                for (int ks = 0; ks < 4; ++ks) af[ks] = *(const bf16x8*)(qp + 16 * ks);
            }
            float wq[2][8];
#pragma unroll
            for (int a = 0; a < 2; ++a) {
                const f32x4 w0 = *(const f32x4*)(WIDX + (size_t)(q0 + 4 * w + 2 * a + hf) * 8), w1 = *(const f32x4*)(WIDX + (size_t)(q0 + 4 * w + 2 * a + hf) * 8 + 4);
                wq[a][0] = w0.x; wq[a][1] = w0.y; wq[a][2] = w0.z; wq[a][3] = w0.w; wq[a][4] = w1.x; wq[a][5] = w1.y; wq[a][6] = w1.z; wq[a][7] = w1.w;
            }
            float tau0 = -INFINITY, tau1 = -INFINITY;
            int cnt[4] = {0, 0, 0, 0};
            v4u kreg[2];
#pragma unroll
            for (int e = 0; e < 2; ++e) {
                const int pid = tid + 512 * e, kl = pid >> 3, pc = pid & 7, j = kl;
                kreg[e] = j < nvis ? *(const v4u*)(KIDX + (size_t)key_row(b, j) * 64 + 8 * pc) : (v4u){0u, 0u, 0u, 0u};
            }
#pragma unroll
            for (int e = 0; e < 2; ++e) { const int pid = tid + 512 * e, kl = pid >> 3, pc = pid & 7; *(LAS v4u*)(L + IX_KB + kl * 128 + ((pc ^ ((kl >> 1) & 7)) << 4)) = kreg[e]; }
            __syncthreads();
            for (int blk = 0; blk < nblk; ++blk) {
                const int cur = blk & 1;
                if (blk + 1 < nblk) {
#pragma unroll
                    for (int e = 0; e < 2; ++e) {
                        const int pid = tid + 512 * e, kl = pid >> 3, pc = pid & 7, j = (blk + 1) * 128 + kl;
                        kreg[e] = j < nvis ? *(const v4u*)(KIDX + (size_t)key_row(b, j) * 64 + 8 * pc) : (v4u){0u, 0u, 0u, 0u};
                    }
                }
                const LAS unsigned char* kb = L + IX_KB + cur * 16384;
                for (int tt = 0; tt < 4; ++tt) {
                    const int jbase = blk * 128 + tt * 32;
                    if (jbase >= nvis) break;
                    const int kl = tt * 32 + r;
                    f32x16 acc = zero16();
#pragma unroll
                    for (int ks = 0; ks < 4; ++ks) {
                        const bf16x8 bfr = *(const LAS bf16x8*)(kb + kl * 128 + (((2 * ks + hf) ^ ((kl >> 1) & 7)) << 4));
                        acc = __builtin_amdgcn_mfma_f32_32x32x16_bf16(af[ks], bfr, acc, 0, 0, 0);
                    }
                    const int j = jbase + r;
                    float s0 = 0.f, s1 = 0.f;
#pragma unroll
                    for (int h = 0; h < 8; ++h) { s0 += wq[0][h] * fmaxf(acc[h], 0.f); s1 += wq[1][h] * fmaxf(acc[8 + h], 0.f); }
                    s0 += 0.0f; s1 += 0.0f;
                    const bool p0 = j < nvis && s0 > tau0, p1 = j < nvis && s1 > tau1;
                    const unsigned long long m0 = __ballot(p0), m1 = __ballot(p1);
                    if (m0 | m1) {
                        const int c0lo = __popc((unsigned)m0), c0hi = __popc((unsigned)(m0 >> 32)), c1lo = __popc((unsigned)m1), c1hi = __popc((unsigned)(m1 >> 32));
                        {
                            const int pos = (hf ? cnt[1] - c0lo : cnt[0]) + (int)ix_mbcnt(m0);
                            if (p0) { LAS unsigned char* lb = L + (w * 4 + hf) * IX_LIST; ((LAS float*)lb)[pos] = s0; ((LAS unsigned short*)(lb + 2048))[pos] = (unsigned short)j; }
                        }
                        {
                            const int pos = (hf ? cnt[3] - c1lo : cnt[2]) + (int)ix_mbcnt(m1);
                            if (p1) { LAS unsigned char* lb = L + (w * 4 + 2 + hf) * IX_LIST; ((LAS float*)lb)[pos] = s1; ((LAS unsigned short*)(lb + 2048))[pos] = (unsigned short)j; }
                        }
                        cnt[0] += c0lo; cnt[1] += c0hi; cnt[2] += c1lo; cnt[3] += c1hi;
#pragma unroll
                        for (int qq = 0; qq < 4; ++qq) {
                            if (cnt[qq] > IX_CAP - 32) {
                                LAS unsigned char* lb = L + (w * 4 + qq) * IX_LIST;
                                float tq = 0.f; int cq = cnt[qq];
                                ix_compact((LAS float*)lb, (LAS unsigned short*)(lb + 2048), hist, cq, tq, l, false, SEL + (size_t)(q0 + 4 * w + qq) * TOPK);
                                cnt[qq] = __builtin_amdgcn_readfirstlane(cq);
                                if ((qq & 1) == hf) { if (qq < 2) tau0 = tq; else tau1 = tq; }
                            }
                        }
                    }
                }
                if (blk + 1 < nblk) {
#pragma unroll
                    for (int e = 0; e < 2; ++e) { const int pid = tid + 512 * e, kl = pid >> 3, pc = pid & 7; *(LAS v4u*)(L + IX_KB + (cur ^ 1) * 16384 + kl * 128 + ((pc ^ ((kl >> 1) & 7)) << 4)) = kreg[e]; }
                }
                __syncthreads();
            }
#pragma unroll
            for (int qq = 0; qq < 4; ++qq) {
                LAS unsigned char* lb = L + (w * 4 + qq) * IX_LIST;
                float tq = 0.f; int cq = cnt[qq];
                ix_compact((LAS float*)lb, (LAS unsigned short*)(lb + 2048), hist, cq, tq, l, true, SEL + (size_t)(q0 + 4 * w + qq) * TOPK);
                if (l == 0) NSEL[q0 + 4 * w + qq] = TOPK;
            }
        }
    }
}

#ifndef CHECK_IDX
#define CHECK_IDX 0
#endif
#if CHECK_IDX
__device__ __forceinline__ void idx_check(Frame& F) {
    const unsigned short* SEL = WSP(unsigned short, WS_SEL); const unsigned short* SELB = (const unsigned short*)F.out; const int* NSEL = WSP(int, WS_NSEL); const int* NSELB = (const int*)((const char*)F.out + 32 * MiB);
    LAS unsigned* bm = (LAS unsigned*)(F.lds + F.wave * 2048);
    const int l = F.lane; const int gw = blockIdx.x * NWAVES + F.wave, NGW = F.G * NWAVES;
    unsigned miss = 0, badq = 0, dup = 0;
    for (int q = gw; q < NROWS; q += NGW) {
        for (int i = l; i < 260; i += 64) bm[i] = 0u;
        IX_FENCE();
        const int n = NSEL[q], nb = NSELB[q];
        for (int i = l; i < n; i += 64) { const unsigned j = SEL[(size_t)q * TOPK + i]; atomicOr((unsigned*)&bm[j >> 5], 1u << (j & 31)); }
        IX_FENCE();
        unsigned m = (n != nb) ? 1000u : 0u;
        for (int i = l; i < nb && i < TOPK; i += 64) { const unsigned j = SELB[(size_t)q * TOPK + i]; if (j >= (unsigned)TT) { ++dup; ++m; } else { const unsigned old = atomicAnd((unsigned*)&bm[j >> 5], ~(1u << (j & 31))); if (!((old >> (j & 31)) & 1u)) ++m; } }
        IX_FENCE();
        m = (unsigned)wave_sum((float)m);
        if (l == 0) { miss += m; badq += m ? 1u : 0u; }
    }
    dup = (unsigned)wave_sum((float)dup);
    if (l == 0) { atomicAdd((unsigned*)F.ctl + 2048, miss); atomicAdd((unsigned*)F.ctl + 2049, badq); atomicAdd((unsigned*)F.ctl + 2050, dup); }
}
#endif

typedef short v4i16_t __attribute__((ext_vector_type(4)));
__device__ __forceinline__ unsigned at_off(unsigned row, unsigned ch) { return 256u * row + 16u * (ch ^ (((row & 3u) << 2) | ((row >> 2) & 3u))); }

__device__ __forceinline__ void p6_attn_mfma(Frame& F, bf16* OUTB) {
    bf16* QA = WSP(bf16, WS_QA); const bf16* CKV = WSP(bf16, WS_CKV); const unsigned short* SEL = WSP(unsigned short, WS_SEL); const int* NSEL = WSP(int, WS_NSEL);
    const int l = F.lane, w = F.wave, h16 = l & 15, g = l >> 4;
    LAS unsigned char* tile = F.lds + w * 8192;
    const float slope = h16 < 8 ? __uint_as_float((unsigned)(127 - (h16 + 1)) << 23) : 0.f;
    {
        const int gw = blockIdx.x * NWAVES + w, NGW = F.G * NWAVES;
        for (int q = NROWS + gw; q < R; q += NGW) { bf16* qrow = QA + (size_t)q * QAW; for (int c = l; c < QAW / 8; c += 64) *(v4u*)(qrow + 8 * c) = (v4u){0u, 0u, 0u, 0u}; }
    }
    const int G = F.G;
    int nq_tot, qbase_b, wib, wpb;
    if ((G & 7) == 0) { const int b = (blockIdx.x & 7) >> 1; qbase_b = b * SEQ; nq_tot = SEQ + (b == 0 ? NMETA : 0); wib = (((blockIdx.x >> 3) * 2) + (blockIdx.x & 1)) * NWAVES + w; wpb = (G / 4) * NWAVES; }
    else { qbase_b = 0; nq_tot = NROWS; wib = blockIdx.x * NWAVES + w; wpb = G * NWAVES; }
    for (int qi = wib; qi < nq_tot; qi += wpb) {
        int q, b, pos;
        if ((G & 7) == 0) { if (qi < SEQ) { q = qbase_b + qi; b = q >> 13; pos = NMETA + qi; } else { q = NREAL + (qi - SEQ); b = 0; pos = qi - SEQ; } }
        else { q = qi; if (q < NREAL) { b = q >> 13; pos = NMETA + (q & (SEQ - 1)); } else { b = 0; pos = q - NREAL; } }
        bf16* qrow = QA + (size_t)q * QAW;
        const int nsel = NSEL[q];
        const int nch = (nsel + 31) >> 5;
        const unsigned short* selq = SEL + (size_t)q * TOPK;
        bf16x8 qf[4];
#pragma unroll
        for (int s = 0; s < 4; ++s) { const v4u t = h16 < 8 ? *(const v4u*)(qrow + h16 * 128 + 32 * s + 8 * g) : (v4u){0u, 0u, 0u, 0u}; qf[s] = __builtin_bit_cast(bf16x8, t); }
        float m = -INFINITY, lsum = 0.f;
        f32x4 O[8];
#pragma unroll
        for (int c = 0; c < 8; ++c) O[c] = (f32x4){0.f, 0.f, 0.f, 0.f};
        v4u gr[8];
#pragma unroll
        for (int i = 0; i < 8; ++i) { const int s = g + 4 * i; const int kj = s < nsel ? (int)selq[s] : (int)selq[0]; gr[i] = *(const v4u*)(CKV + (size_t)key_row(b, kj) * 128 + 8 * h16); }
        for (int ck = 0; ck < nch; ++ck) {
            IX_FENCE();
#pragma unroll
            for (int i = 0; i < 8; ++i) *(LAS v4u*)(tile + at_off((unsigned)(g + 4 * i), (unsigned)h16)) = gr[i];
            const v4u kv = *(const v4u*)(selq + 32 * ck + 8 * g);
            if (ck + 1 < nch) {
#pragma unroll
                for (int i = 0; i < 8; ++i) { const int s = 32 * (ck + 1) + g + 4 * i; const int kj = s < nsel ? (int)selq[s] : (int)selq[0]; gr[i] = *(const v4u*)(CKV + (size_t)key_row(b, kj) * 128 + 8 * h16); }
            }
            IX_FENCE();
            f32x4 a0 = (f32x4){0.f, 0.f, 0.f, 0.f}, a1 = a0;
#pragma unroll
            for (int s = 0; s < 4; ++s) {
                const bf16x8 k0 = *(const LAS bf16x8*)(tile + at_off((unsigned)(8 * (h16 >> 2) + (h16 & 3)), (unsigned)(4 * s + g)));
                const bf16x8 k1 = *(const LAS bf16x8*)(tile + at_off((unsigned)(8 * (h16 >> 2) + 4 + (h16 & 3)), (unsigned)(4 * s + g)));
                a0 = __builtin_amdgcn_mfma_f32_16x16x32_bf16(k0, qf[s], a0, 0, 0, 0);
                a1 = __builtin_amdgcn_mfma_f32_16x16x32_bf16(k1, qf[s], a1, 0, 0, 0);
            }
            const unsigned kw[4] = {kv.x, kv.y, kv.z, kv.w};
            float x[8];
#pragma unroll
            for (int j = 0; j < 8; ++j) {
                const int kj = (int)((kw[j >> 1] >> (16 * (j & 1))) & 0xffffu);
                const float lg = (j < 4 ? a0[j & 3] : a1[j & 3]) - slope * fabsf((float)(pos - kj));
                x[j] = (32 * ck + 8 * g + j) < nsel ? lg : -INFINITY;
            }
            float cm = fmaxf(fmaxf(fmaxf(x[0], x[1]), fmaxf(x[2], x[3])), fmaxf(fmaxf(x[4], x[5]), fmaxf(x[6], x[7])));
            cm = fmaxf(cm, __shfl_xor(cm, 16)); cm = fmaxf(cm, __shfl_xor(cm, 32));
            const float mn = fmaxf(m, cm);
            const float alpha = __expf(m - mn);
            float p[8], ps = 0.f;
#pragma unroll
            for (int j = 0; j < 8; ++j) { p[j] = __expf(x[j] - mn); ps += p[j]; }
            ps += __shfl_xor(ps, 16); ps += __shfl_xor(ps, 32);
            lsum = lsum * alpha + ps; m = mn;
            if (__any(alpha != 1.0f)) {
#pragma unroll
                for (int rr = 0; rr < 4; ++rr) { const float sc = __shfl(alpha, 4 * g + rr);
#pragma unroll
                    for (int c = 0; c < 8; ++c) O[c][rr] *= sc; }
            }
            const v4u pw = (v4u){pk2(p[0], p[1]), pk2(p[2], p[3]), pk2(p[4], p[5]), pk2(p[6], p[7])};
            const bf16x8 pf = __builtin_bit_cast(bf16x8, pw);
#pragma unroll
            for (int c = 0; c < 8; ++c) {
                const unsigned qd = (unsigned)(h16 >> 2), pp = (unsigned)(h16 & 3);
                const v4i16_t t0 = __builtin_amdgcn_ds_read_tr16_b64_v4i16((LAS v4i16_t*)(tile + at_off(8u * g + qd, 2u * c + (pp >> 1)) + 8u * (pp & 1u)));
                const v4i16_t t1 = __builtin_amdgcn_ds_read_tr16_b64_v4i16((LAS v4i16_t*)(tile + at_off(8u * g + 4u + qd, 2u * c + (pp >> 1)) + 8u * (pp & 1u)));
                bf16x8 vf; vf[0] = t0[0]; vf[1] = t0[1]; vf[2] = t0[2]; vf[3] = t0[3]; vf[4] = t1[0]; vf[5] = t1[1]; vf[6] = t1[2]; vf[7] = t1[3];
                O[c] = __builtin_amdgcn_mfma_f32_16x16x32_bf16(pf, vf, O[c], 0, 0, 0);
            }
        }
        const float inv = 1.0f / lsum;
#pragma unroll
        for (int rr = 0; rr < 4; ++rr) {
            const float sc = __shfl(inv, 4 * g + rr);
            if (g < 2) {
#pragma unroll
                for (int c = 0; c < 8; ++c) (OUTB + (size_t)q * QAW)[(4 * g + rr) * 128 + 16 * c + h16] = (bf16)f2bf(O[c][rr] * sc);
            }
        }
    }
}
struct StoreBf16 { bf16* O; int ld; __device__ __forceinline__ void operator()(int row, int col, const f32x4& v) const { *(v2u*)(O + (size_t)row * ld + col) = (v2u){pk2(v.x, v.y), pk2(v.z, v.w)}; } };
struct StoreRes1 { const bf16* H; float* out; float* meta; __device__ __forceinline__ void operator()(int row, int col, const f32x4& v) const {
        if (row >= NROWS) return;
        const v2u hw = *(const v2u*)(H + (size_t)row * D + col);
        const f32x4 o = (f32x4){ALPHA * bflo(hw.x) + v.x, ALPHA * bfhi(hw.x) + v.y, ALPHA * bflo(hw.y) + v.z, ALPHA * bfhi(hw.y) + v.w};
        float* dst = row < NREAL ? out + (size_t)row * D + col : meta + (size_t)(row - NREAL) * D + col;
        *(f32x4*)dst = o; } };
struct StoreRes2 { const bf16* H; float* out; __device__ __forceinline__ void operator()(int row, int col, const f32x4& v) const {
        if (row >= NREAL) return;
        const v2u hw = *(const v2u*)(H + (size_t)row * D + col);
        *(f32x4*)(out + (size_t)row * D + col) = (f32x4){ALPHA * bflo(hw.x) + v.x, ALPHA * bfhi(hw.x) + v.y, ALPHA * bflo(hw.y) + v.z, ALPHA * bfhi(hw.y) + v.w}; } };

template <class Fn>
__device__ __forceinline__ void run_gemm(Frame& F, const bf16* A, int lda, const bf16* Bt, int N, int K, const Fn& fn) {
    pg8::Gemm g{A, Bt, R, N, K, lda}; pg8::StaticOrder S; S.init(R, N, F.G, (int)blockIdx.x);
    pg8::EpiFn<Fn> E{fn};
    pg8::gemm_phase<pg8::EpiFn<Fn>, pg8::StaticOrder, true, true>(F.lds + RING_OFF, g, S, E);
}

constexpr int NPHASES = 15;
struct Args { const float* in[32]; float* out; unsigned char* ws; int ph_lo, ph_hi; };
__global__ void __launch_bounds__(NTHR, 2) fwd(Args args) {
    extern __shared__ __attribute__((aligned(16))) unsigned char lds[];
    Frame F;
    F.lds = (LAS unsigned char*)lds;
    F.MISC = (volatile LAS unsigned*)(F.lds + MISC_OFF);
    F.tid = threadIdx.x; F.lane = F.tid & 63; F.wave = __builtin_amdgcn_readfirstlane(F.tid >> 6);
    F.G = gridDim.x;
#pragma unroll
    for (int i = 0; i < 32; ++i) F.in[i] = args.in[i];
    F.out = args.out; F.ws = args.ws;
    F.ctl = (gu32*)(args.ws + WS_CTL);
    for (int u = F.tid; u < (LDS_BYTES - LDSCTL_OFF) / 4; u += NTHR) ((LAS unsigned*)(F.lds + LDSCTL_OFF))[u] = 0u;
    __syncthreads();
    const int lo = args.ph_lo, hi = args.ph_hi;
    XcdBarrier bar; bar.bar = (unsigned*)(F.ctl + CW_BAR); bar.x = 0; bar.st = nullptr;
    if (hi - lo > 1) bar = xcd_barrier_post((unsigned*)(F.ctl + CW_BAR), F.MISC + 8);
#define IN(k) (lo <= (k) && (k) < hi)
#define SEAM(k) do { if (IN(k) && IN((k) + 1)) xcd_barrier(bar); } while (0)
#ifndef PROBE_PH
#define PROBE_PH -1
#endif
#define REP(k) for (int rep_ = 0; rep_ < ((PROBE_PH == (k)) ? 2 : 1); ++rep_)

#ifndef SKIP0
    if (IN(0)) REP(0) { if (rep_) __syncthreads(); p0_weights(F); p1_ln_in(F); } SEAM(0);
#endif
#ifndef SKIP1
    if (IN(1)) REP(1) { if (rep_) __syncthreads(); run_gemm(F, WSP(bf16, WS_H), D, WSP(bf16, WS_WT_IN), PW, D, StoreBf16{WSP(bf16, WS_P), PW}); } SEAM(1);
#endif
#ifndef SKIP2
    if (IN(2)) REP(2) { if (rep_) __syncthreads(); p3_prep(F); } SEAM(2);
#endif
#ifndef SKIP3
    if (IN(3)) REP(3) { if (rep_) __syncthreads(); run_gemm(F, WSP(bf16, WS_CQN), 256, WSP(bf16, WS_WT_QA), QAW, 256, StoreBf16{WSP(bf16, WS_QA), QAW});
#if REFSEL
        refsel_rows(F);
#endif
    } SEAM(3);
#endif
#ifndef SKIP4
#ifndef IDX_NAIVE
#define IDX_NAIVE 0
#endif
#ifndef ATTN_NAIVE
#define ATTN_NAIVE 0
#endif
#if CHECK_IDX
    if (IN(4)) { p5_index_naive(F); __syncthreads(); p5_index_mfma(F, (unsigned short*)F.out, (int*)((char*)F.out + 32 * MiB)); } SEAM(4);
#elif IDX_NAIVE
    if (IN(4)) { p5_index_naive(F); } SEAM(4);
#else
    if (IN(4)) { p5_index_mfma(F, WSP(unsigned short, WS_SEL), WSP(int, WS_NSEL)); } SEAM(4);
#endif
#endif
#ifndef SKIP5
    if (IN(5)) {
#if CHECK_IDX
        idx_check(F); __syncthreads();
#endif
#if ATTN_NAIVE
        p6_attn_naive(F);
#else
#ifdef PROBE_ATTN
        p6_attn_mfma(F, WSP(bf16, WS_RWM)); __syncthreads();
#endif
        p6_attn_mfma(F, WSP(bf16, WS_QA));
#endif
    } SEAM(5);
#endif
#ifndef RWKV_NAIVE
#define RWKV_NAIVE 0
#endif
#if RWKV_NAIVE
    if (IN(6)) REP(6) { if (rep_) __syncthreads(); p7_rwkv_prep_naive(F); } SEAM(6);
    if (IN(7)) REP(7) { if (rep_) __syncthreads(); p8_rwkv_scan_naive(F); } SEAM(7);
    SEAM(8);
#else
    if (IN(6)) REP(6) { if (rep_) __syncthreads(); rw_b1(F); } SEAM(6);
    if (IN(7)) REP(7) { if (rep_) __syncthreads(); rw_b2(F); } SEAM(7);
    if (IN(8)) REP(8) { if (rep_) __syncthreads(); rw_b3(F); } SEAM(8);
#endif
    if (IN(9)) REP(9) { if (rep_) __syncthreads(); run_gemm(F, WSP(bf16, WS_QA), QAW, WSP(bf16, WS_WT_MIX), D, QAW, StoreRes1{WSP(bf16, WS_H), F.out, WSP(float, WS_META1)}); } SEAM(9);
    if (IN(10)) REP(10) { if (rep_) __syncthreads(); p10_ln1(F); } SEAM(10);
    if (IN(11)) REP(11) { if (rep_) __syncthreads(); run_gemm(F, WSP(bf16, WS_H), D, WSP(bf16, WS_WT_UP), UPW, D, StoreBf16{WSP(bf16, WS_UP), UPW}); } SEAM(11);
    if (IN(12)) { p12_conv_act(F); } SEAM(12);
    if (IN(13)) REP(13) { if (rep_) __syncthreads(); run_gemm(F, WSP(bf16, WS_UP) + DFF, UPW, WSP(bf16, WS_WT_DN), D, DFF, StoreRes2{WSP(bf16, WS_H), F.out}); } SEAM(13);
    if (IN(14)) { p14_ln2(F);
#if CHECK_IDX
        if (blockIdx.x == 0 && F.tid == 0) {
            const unsigned miss = __hip_atomic_load((unsigned*)F.ctl + 2048, __ATOMIC_RELAXED, __HIP_MEMORY_SCOPE_AGENT), dupc = __hip_atomic_load((unsigned*)F.ctl + 2050, __ATOMIC_RELAXED, __HIP_MEMORY_SCOPE_AGENT);
            if (dupc) F.out[5] = __builtin_inff();
            if (miss > CHECK_IDX_MAXMISS) F.out[3] = __builtin_nanf("");
        }
#endif
    }
#undef IN
#undef SEAM
}

extern "C" void kernel_launch(void* const* d_in, const int* in_sizes, int n_in, void* d_out, int out_size, void* d_ws, size_t ws_size, hipStream_t stream) {
    static int grid = 0;
    if (grid == 0) {
        if (n_in != 32 || out_size != NREAL * D || ws_size < WS_END) { fprintf(stderr, "kernel_launch: unexpected shapes: n_in %d out %d ws %zu\n", n_in, out_size, ws_size); grid = -1; return; }
        int dev = 0, cus = 0, per_cu = 0;
        if (hipGetDevice(&dev) != hipSuccess || hipDeviceGetAttribute(&cus, hipDeviceAttributeMultiprocessorCount, dev) != hipSuccess) { grid = -1; return; }
        if (hipFuncSetAttribute((const void*)fwd, hipFuncAttributeMaxDynamicSharedMemorySize, LDS_BYTES) != hipSuccess) { fprintf(stderr, "kernel_launch: hipFuncSetAttribute failed\n"); grid = -1; return; }
        if (hipOccupancyMaxActiveBlocksPerMultiprocessor(&per_cu, (const void*)fwd, NTHR, LDS_BYTES) != hipSuccess || per_cu < 1) fprintf(stderr, "kernel_launch: occupancy query says %d\n", per_cu);
        (void)hipGetLastError();
        grid = cus;
    }
    if (grid < 0) return;
    (void)hipMemsetAsync((char*)d_ws + WS_CTL, 0, CTL_ZERO_BYTES, stream);
    Args a{};
    for (int i = 0; i < 32; ++i) a.in[i] = (const float*)d_in[i];
    a.out = (float*)d_out; a.ws = (unsigned char*)d_ws;
#if ONE_LAUNCH
    a.ph_lo = 0; a.ph_hi = NPHASES;
    hipLaunchKernelGGL(fwd, dim3(grid), dim3(NTHR), LDS_BYTES, stream, a);
#else
    for (int p = 0; p < NPHASES; ++p) { a.ph_lo = p; a.ph_hi = p + 1; hipLaunchKernelGGL(fwd, dim3(grid), dim3(NTHR), LDS_BYTES, stream, a); }
#endif
}
```

```cpp
#include <hip/hip_runtime.h>
#include <cstdio>
#include <cstdint>
#define ONE_LAUNCH 1
namespace pg8 {
#define PG8_LAS __attribute__((address_space(3)))
typedef unsigned short bf16_t;
typedef short bf16x8 __attribute__((ext_vector_type(8)));
typedef float f32x4 __attribute__((ext_vector_type(4)));
typedef unsigned u32x4 __attribute__((ext_vector_type(4)));
constexpr int BM = 256, BK = 64, HALF = 128, HTB = HALF * BK * 2  , STAGE_BYTES = 8 * HTB, NXCD = 8, WGM = 8;

__host__ __device__ __forceinline__ int lds_byte(int r, int c) { const int st = (r >> 4) * 2 + (c >> 5), rr = r & 15, cc = c & 31, ob = rr * 64 + cc * 2; return st * 1024 + (ob ^ (((ob >> 9) & 1) << 5)); }
__host__ __device__ __forceinline__ void stage_rc(int b, int& R, int& C) { const int st = b / 1024, sb = b % 1024, swz = sb ^ (((sb >> 9) & 1) << 5); R = (st >> 1) * 16 + swz / 64; C = (st & 1) * 32 + (swz % 64) / 2; }
__host__ __device__ __forceinline__ int perm32(int rho) { const int n = rho >> 4, i = rho & 15; return 8 * (i >> 2) + 4 * n + (i & 3); }

struct Unit { int pm, pn; };
struct Gemm { const bf16_t* A; const bf16_t* Bt; int M, N, K, lda; };

struct StaticOrder {
    int nM, nN, nwg, G, c;
    __host__ __device__ void init(int M, int N, int G_, int c_) { nM = M / BM; nN = N / BM; nwg = nM * nN; G = G_; c = c_; }
    __host__ __device__ bool next(int i, Unit& u) const {
        const long L = (long)i * G + c; if (L >= nwg) return false;
        int wgid = (int)L; { const int q = nwg / NXCD, r = nwg % NXCD, xcd = wgid % NXCD, off = wgid / NXCD; wgid = (xcd < r ? xcd * (q + 1) : r * (q + 1) + (xcd - r) * q) + off; }
        const int nig = WGM * nN, gid = wgid / nig, fm = gid * WGM, gsz = (nM - fm) < WGM ? (nM - fm) : WGM;
        u.pm = fm + ((wgid % nig) % gsz); u.pn = (wgid % nig) / gsz; return true;
    }
    __device__ __forceinline__ void a_ready(const Unit&) const {}
    __device__ __forceinline__ void done(const Unit&) const {}
};


template <class F> struct EpiFn {
    static constexpr bool PERM = false, AFTER_DRAIN = false;
    F f;
    __device__ __forceinline__ void operator()(const f32x4 (&acc)[2][2][4][2], const Unit& u, int wr, int wc, int fr, int fq) const {
        const int row0 = u.pm * BM + wr * 64 + fr, col0 = u.pn * BM + wc * 32 + 4 * fq;
#pragma unroll
        for (int ai = 0; ai < 2; ++ai)
#pragma unroll
            for (int m = 0; m < 4; ++m) {
                const int row = row0 + ai * HALF + m * 16;
#pragma unroll
                for (int bj = 0; bj < 2; ++bj)
#pragma unroll
                    for (int n = 0; n < 2; ++n) f(row, col0 + bj * HALF + n * 16, acc[ai][bj][m][n]);
            }
    }
};
template <class Epi, class Sched, bool ALIGN_EPI = false, bool SP2 = false>
__device__ __forceinline__ void gemm_phase(PG8_LAS unsigned char* lds, const Gemm g, const Sched& S, const Epi& E) {
    const int tid = threadIdx.x, wid = __builtin_amdgcn_readfirstlane(tid >> 6), lane = tid & 63, wr = wid >> 2, wc = wid & 3, fr = lane & 15, fq = lane >> 4;
    const int K = g.K, nt = K / BK;
    unsigned voffA[2], voffB[2];
#pragma unroll
    for (int i = 0; i < 2; ++i) { int R, C; stage_rc(tid * 16 + i * 8192, R, C); const int Rb = Epi::PERM ? ((R & ~31) + perm32(R & 31)) : R;
        voffA[i] = (unsigned)(R * g.lda + C) * 2u; voffB[i] = (unsigned)(Rb * K + C) * 2u; }
    const size_t kstep = (size_t)(BK * 2);
    const size_t hA = (size_t)HALF * g.lda * 2, hB = (size_t)HALF * K * 2;
    const size_t tA = 2 * hA, tB = 2 * hB;
    const unsigned ldsw = (unsigned)wid * 1024u;
    const int aoff = lds_byte(wr * 64 + fr, fq * 8), boff = lds_byte(wc * 32 + fr, fq * 8);
#define PG8_SA(b, h) (((b) * 2 + (h)) * HTB)
#define PG8_SB(b, h) ((4 + (b) * 2 + (h)) * HTB)
#define PG8_STAGE(bufoff, gbase, voff) do { _Pragma("unroll") for (int _i = 0; _i < 2; ++_i) \
        __builtin_amdgcn_global_load_lds((const unsigned*)((const char*)(gbase) + (voff)[_i]), (PG8_LAS unsigned*)(lds + (bufoff) + ldsw + _i * 8192), 16, 0, 0); } while (0)
#define PG8_LDA(dst, b, h) do { _Pragma("unroll") for (int m = 0; m < 4; ++m) _Pragma("unroll") for (int k = 0; k < 2; ++k) dst[m][k] = *(const PG8_LAS bf16x8*)(lds + PG8_SA(b, h) + aoff + m * 2048 + k * 1024); } while (0)
#define PG8_LDB(dst, b, h) do { _Pragma("unroll") for (int n = 0; n < 2; ++n) _Pragma("unroll") for (int k = 0; k < 2; ++k) dst[n][k] = *(const PG8_LAS bf16x8*)(lds + PG8_SB(b, h) + boff + n * 2048 + k * 1024); } while (0)
#define PG8_MMA(ai, bj, At, Bt) do { __builtin_amdgcn_s_setprio(1); _Pragma("unroll") for (int m = 0; m < 4; ++m) _Pragma("unroll") for (int n = 0; n < 2; ++n) _Pragma("unroll") for (int k = 0; k < 2; ++k) \
        acc[ai][bj][m][n] = __builtin_amdgcn_mfma_f32_16x16x32_bf16(Bt[n][k], At[m][k], acc[ai][bj][m][n], 0, 0, 0); __builtin_amdgcn_s_setprio(0); } while (0)
#define PG8_WAIT_V(n) asm volatile("s_waitcnt vmcnt(" #n ")" ::: "memory")
#define PG8_WAIT_L(n) asm volatile("s_waitcnt lgkmcnt(" #n ")" ::: "memory")
#define PG8_BAR __builtin_amdgcn_s_barrier()
#define PG8_SCHED __builtin_amdgcn_sched_barrier(0)
    Unit cur, nxt; int ui = 0;
    if (!S.next(0, cur)) return;
    f32x4 acc[2][2][4][2];
#pragma unroll
    for (int a = 0; a < 2; ++a)
#pragma unroll
        for (int b = 0; b < 2; ++b)
#pragma unroll
            for (int m = 0; m < 4; ++m)
#pragma unroll
                for (int n = 0; n < 2; ++n) acc[a][b][m][n] = (f32x4){0.f, 0.f, 0.f, 0.f};
    bf16x8 At[4][2], B0[2][2], B1[2][2];
    const char* cA = (const char*)g.A + (size_t)cur.pm * tA; const char* cB = (const char*)g.Bt + (size_t)cur.pn * tB;
    S.a_ready(cur);
    if constexpr (SP2) {
        PG8_STAGE(PG8_SB(0, 0), cB, voffB); PG8_STAGE(PG8_SB(0, 1), cB + hB, voffB); PG8_STAGE(PG8_SA(0, 0), cA, voffA); PG8_STAGE(PG8_SA(0, 1), cA + hA, voffA);
        if (wr == 1) PG8_BAR;
        PG8_WAIT_V(2); PG8_BAR;
        PG8_STAGE(PG8_SB(1, 0), cB + kstep, voffB); PG8_STAGE(PG8_SA(1, 0), cA + kstep, voffA); PG8_STAGE(PG8_SB(1, 1), cB + hB + kstep, voffB);
        PG8_WAIT_V(6); PG8_BAR;
    } else {
        PG8_STAGE(PG8_SB(0, 0), cB, voffB); PG8_STAGE(PG8_SA(0, 0), cA, voffA); PG8_STAGE(PG8_SB(0, 1), cB + hB, voffB); PG8_STAGE(PG8_SA(0, 1), cA + hA, voffA);
        if (wr == 1) PG8_BAR;
        PG8_WAIT_V(4); PG8_BAR;
        PG8_STAGE(PG8_SB(1, 0), cB + kstep, voffB); PG8_STAGE(PG8_SA(1, 0), cA + kstep, voffA); PG8_STAGE(PG8_SB(1, 1), cB + hB + kstep, voffB);
        PG8_WAIT_V(6); PG8_BAR;
    }
    for (;;) {
        const bool has_next = S.next(ui + 1, nxt);
        const char* nA = has_next ? (const char*)g.A + (size_t)nxt.pm * tA : cA; const char* nB = has_next ? (const char*)g.Bt + (size_t)nxt.pn * tB : cB;
        for (int t = 0; t < nt; t += 2) {
            const bool last = (t == nt - 2);
            const char* a1 = cA + (size_t)(t + 1) * kstep;
            const char* a2 = last ? nA : cA + (size_t)(t + 2) * kstep; const char* b2 = last ? nB : cB + (size_t)(t + 2) * kstep;
            const char* a3 = a2 + kstep; const char* b3 = b2 + kstep;
            if (last && has_next) S.a_ready(nxt);
            if constexpr (SP2) {
            PG8_LDB(B0, 0, 0); PG8_LDB(B1, 0, 1); PG8_SCHED; PG8_LDA(At, 0, 0); PG8_STAGE(PG8_SA(1, 1), a1 + hA, voffA);
            PG8_WAIT_V(8); PG8_WAIT_L(0); PG8_BAR; PG8_MMA(0, 0, At, B0); PG8_MMA(0, 1, At, B1); PG8_BAR; PG8_SCHED;
            PG8_LDA(At, 0, 1); PG8_STAGE(PG8_SB(0, 0), b2, voffB); PG8_STAGE(PG8_SB(0, 1), b2 + hB, voffB); PG8_STAGE(PG8_SA(0, 0), a2, voffA);
            PG8_WAIT_V(8); PG8_WAIT_L(0); PG8_BAR; PG8_MMA(1, 0, At, B0); PG8_MMA(1, 1, At, B1); PG8_BAR; PG8_SCHED;
            PG8_LDB(B0, 1, 0); PG8_LDB(B1, 1, 1); PG8_SCHED; PG8_LDA(At, 1, 0); PG8_STAGE(PG8_SA(0, 1), a2 + hA, voffA);
            PG8_WAIT_V(8); PG8_WAIT_L(0); PG8_BAR; PG8_MMA(0, 0, At, B0); PG8_MMA(0, 1, At, B1); PG8_BAR; PG8_SCHED;
            PG8_LDA(At, 1, 1); PG8_STAGE(PG8_SB(1, 0), b3, voffB); PG8_STAGE(PG8_SB(1, 1), b3 + hB, voffB); PG8_STAGE(PG8_SA(1, 0), a3, voffA);
            PG8_WAIT_V(8); PG8_WAIT_L(0); PG8_BAR; PG8_MMA(1, 0, At, B0); PG8_MMA(1, 1, At, B1); PG8_BAR; PG8_SCHED;
            } else {
            PG8_LDB(B0, 0, 0); PG8_SCHED; PG8_LDA(At, 0, 0); PG8_STAGE(PG8_SA(1, 1), a1 + hA, voffA);
            PG8_WAIT_L(8); PG8_BAR; PG8_WAIT_L(0); PG8_MMA(0, 0, At, B0); PG8_BAR; PG8_SCHED;
            PG8_LDB(B1, 0, 1); PG8_STAGE(PG8_SB(0, 0), b2, voffB);
            PG8_BAR; PG8_WAIT_L(0); PG8_MMA(0, 1, At, B1); PG8_BAR;
            PG8_LDA(At, 0, 1); PG8_STAGE(PG8_SA(0, 0), a2, voffA);
            PG8_BAR; PG8_WAIT_L(0); PG8_MMA(1, 0, At, B0); PG8_BAR; PG8_SCHED;
            PG8_STAGE(PG8_SB(0, 1), b2 + hB, voffB);
            PG8_WAIT_V(6); PG8_BAR; PG8_MMA(1, 1, At, B1); PG8_BAR;
            PG8_LDB(B0, 1, 0); PG8_SCHED; PG8_LDA(At, 1, 0); PG8_STAGE(PG8_SA(0, 1), a2 + hA, voffA);
            PG8_WAIT_L(8); PG8_BAR; PG8_WAIT_L(0); PG8_MMA(0, 0, At, B0); PG8_BAR; PG8_SCHED;
            PG8_LDB(B1, 1, 1); PG8_STAGE(PG8_SB(1, 0), b3, voffB);
            PG8_BAR; PG8_WAIT_L(0); PG8_MMA(0, 1, At, B1); PG8_BAR;
            PG8_LDA(At, 1, 1); PG8_STAGE(PG8_SA(1, 0), a3, voffA);
            PG8_BAR; PG8_WAIT_L(0); PG8_MMA(1, 0, At, B0); PG8_BAR; PG8_SCHED;
            PG8_STAGE(PG8_SB(1, 1), b3 + hB, voffB);
            PG8_WAIT_V(6); PG8_BAR; PG8_MMA(1, 1, At, B1); PG8_BAR;
            }
        }
        if constexpr (ALIGN_EPI) { if (wr == 0) PG8_BAR; }
        if constexpr (!Epi::AFTER_DRAIN) { E(acc, cur, wr, wc, fr, fq); S.done(cur); }
        if (!has_next) break;
#pragma unroll
        for (int a = 0; a < 2; ++a)
#pragma unroll
            for (int b = 0; b < 2; ++b)
#pragma unroll
                for (int m = 0; m < 4; ++m)
#pragma unroll
                    for (int n = 0; n < 2; ++n) acc[a][b][m][n] = (f32x4){0.f, 0.f, 0.f, 0.f};
        cur = nxt; cA = nA; cB = nB; ++ui;
        if constexpr (ALIGN_EPI) { if (wr == 1) PG8_BAR; }
    }
    PG8_WAIT_V(0);
    if constexpr (!ALIGN_EPI) { if (wr == 0) PG8_BAR; }
    PG8_BAR;
    if constexpr (Epi::AFTER_DRAIN) { E.fused(acc, cur, wr, wc, fr, fq, lds, wid, lane); S.done(cur); }
#undef PG8_SA
#undef PG8_SB
#undef PG8_STAGE
#undef PG8_LDA
#undef PG8_LDB
#undef PG8_MMA
#undef PG8_WAIT_V
#undef PG8_WAIT_L
#undef PG8_BAR
#undef PG8_SCHED
}
}

#ifndef ONE_LAUNCH
#define ONE_LAUNCH 0
#endif
constexpr int NWAVES = 8, NTHR = 512;
constexpr int D = 1024, BATCH = 4, SEQ = 8192, NMETA = 16, TT = SEQ + NMETA;
constexpr int NREAL = BATCH * SEQ;
constexpr int NROWS = NREAL + NMETA;
constexpr int R = 33024;
constexpr int PW = 2304;
constexpr int PC_CQ = 0, PC_CKV = 256, PC_KIDX = 384, PC_WIDX = 448, PC_R = 512, PC_K = 1024, PC_V = 1536, PC_WD = 2048, PC_AD = 2112, PC_GD = 2176;
constexpr int QAW = 1536;
constexpr int DFF = 2816, UPW = 5632;
constexpr int TOPK = 256;
constexpr float LN_EPS = 1e-5f, GN_EPS = 64e-5f, ALPHA = 1.18920711500272f;

constexpr size_t MiB = 1u << 20;
constexpr size_t WS_CTL = 0, CTL_ZERO_BYTES = 1 * MiB;
constexpr size_t WS_WT_IN = 1 * MiB, WS_WT_QA = 6 * MiB, WS_WT_MIX = 7 * MiB, WS_WT_UP = 10 * MiB, WS_WT_DN = 21 * MiB;
constexpr size_t WS_META1 = 27 * MiB, WS_NSEL = 28 * MiB, WS_WIDX = 29 * MiB;
constexpr size_t WS_H = 33 * MiB;
constexpr size_t WS_P = 98 * MiB, WS_QA = 244 * MiB, WS_CQN = 341 * MiB, WS_SEL = 341 * MiB, WS_CKV = 358 * MiB, WS_KIDX = 367 * MiB;
constexpr size_t WS_DEC = 372 * MiB, WS_AB = 437 * MiB, WS_GB = 470 * MiB;
constexpr size_t WS_WT_LORA = 26 * MiB + 512 * 1024;
constexpr size_t WS_RWM = 372 * MiB, WS_RWN = 405 * MiB, WS_RWQ = 438 * MiB, WS_RWY = 471 * MiB;
constexpr size_t OUT_RWS = 80 * MiB, OUT_BONUS = 116 * MiB;
constexpr size_t WS_UP = 98 * MiB;
constexpr size_t WS_END = 512 * MiB;
static_assert(WS_P + (size_t)R * PW * 2 <= WS_QA && WS_QA + (size_t)R * QAW * 2 <= WS_CQN && WS_CQN + (size_t)R * 256 * 2 <= WS_CKV && WS_CKV + (size_t)R * 128 * 2 <= WS_KIDX
              && WS_KIDX + (size_t)R * 64 * 2 <= WS_DEC && WS_DEC + (size_t)R * 512 * 4 <= WS_AB && WS_AB + (size_t)R * 512 * 2 <= WS_GB && WS_GB + (size_t)R * 512 * 2 <= WS_END
              && WS_UP + (size_t)R * UPW * 2 <= WS_END && WS_H + (size_t)R * D * 2 <= WS_P && WS_WIDX + (size_t)R * 8 * 4 <= WS_H && WS_NSEL + (size_t)R * 4 <= WS_WIDX, "ws map");
constexpr int CW_BAR = 4096;

constexpr int RING_OFF = 0, RING_BYTES = 131072;
constexpr int LDSCTL_OFF = RING_BYTES, MISC_OFF = LDSCTL_OFF + 320;
constexpr int LDS_BYTES = 147456;

#define GAS __attribute__((address_space(1)))
#define LAS __attribute__((address_space(3)))
typedef unsigned short bf16;
typedef unsigned v4u __attribute__((ext_vector_type(4)));
typedef unsigned v2u __attribute__((ext_vector_type(2)));
typedef float f32x4 __attribute__((ext_vector_type(4)));
typedef GAS unsigned gu32;
__device__ __forceinline__ unsigned f2bf(float f) { unsigned u = __builtin_bit_cast(unsigned, f); return (u + 0x7fffu + ((u >> 16) & 1u)) >> 16; }
__device__ __forceinline__ unsigned pk2(float lo, float hi) { return f2bf(lo) | (f2bf(hi) << 16); }
__device__ __forceinline__ float bf2f(unsigned short b) { return __uint_as_float(((unsigned)b) << 16); }
__device__ __forceinline__ float bflo(unsigned w) { return __uint_as_float(w << 16); }
__device__ __forceinline__ float bfhi(unsigned w) { return __uint_as_float(w & 0xffff0000u); }
#define DPP_F(v, ctrl) __builtin_bit_cast(float, __builtin_amdgcn_update_dpp(0, __builtin_bit_cast(int, (v)), (ctrl), 0xf, 0xf, false))
__device__ __forceinline__ float rdlane_f(float v, int lane) { return __builtin_bit_cast(float, __builtin_amdgcn_readlane(__builtin_bit_cast(int, v), lane)); }
__device__ __forceinline__ float wave_sum(float v) {
    v += DPP_F(v, 0xB1); v += DPP_F(v, 0x4E); v += DPP_F(v, 0x141); v += DPP_F(v, 0x140);
    return (rdlane_f(v, 0) + rdlane_f(v, 16)) + (rdlane_f(v, 32) + rdlane_f(v, 48));
}
__device__ __forceinline__ float wave_max(float v) {
    v = fmaxf(v, DPP_F(v, 0xB1)); v = fmaxf(v, DPP_F(v, 0x4E)); v = fmaxf(v, DPP_F(v, 0x141)); v = fmaxf(v, DPP_F(v, 0x140));
    return fmaxf(fmaxf(rdlane_f(v, 0), rdlane_f(v, 16)), fmaxf(rdlane_f(v, 32), rdlane_f(v, 48)));
}
#define DPP_U0(v, ctrl) ((unsigned)__builtin_amdgcn_update_dpp(0, (int)(v), (ctrl), 0xf, 0xf, true))
__device__ __forceinline__ unsigned wave_scan_incl(unsigned v, int lane) {
    v += DPP_U0(v, 0x111); v += DPP_U0(v, 0x112); v += DPP_U0(v, 0x114); v += DPP_U0(v, 0x118);
    const unsigned r0 = (unsigned)__builtin_amdgcn_readlane((int)v, 15), r1 = (unsigned)__builtin_amdgcn_readlane((int)v, 31), r2 = (unsigned)__builtin_amdgcn_readlane((int)v, 47);
    const int row = lane >> 4;
    return v + (row >= 1 ? r0 : 0u) + (row >= 2 ? r1 : 0u) + (row >= 3 ? r2 : 0u);
}
__device__ __forceinline__ float sigmoidf_(float x) { return 1.0f / (1.0f + __expf(-x)); }
#define XB_TMO      128
#define XB_XCNT(j)  (256  + 64 * (j))
#define XB_XSUB(j)  (1280 + 64 * (j))
#define XB_XGEN(j)  (2304 + 64 * (j))
#define XB_TOP      3328
#define XB_TOPGEN   3392
#define XCD_BAR_WORDS 3456
#define XB_SPIN_CAP (1u << 18)

__device__ __forceinline__ unsigned xb_ld(unsigned* p)              { return __hip_atomic_load(p, __ATOMIC_RELAXED, __HIP_MEMORY_SCOPE_AGENT); }
__device__ __forceinline__ unsigned xb_add(unsigned* p, unsigned v) { return __hip_atomic_fetch_add(p, v, __ATOMIC_RELAXED, __HIP_MEMORY_SCOPE_AGENT); }
__device__ __forceinline__ unsigned xb_xcc_id() { return (unsigned)__builtin_amdgcn_s_getreg((3 << 11) | 20) & 0xFu; }
#define XB_SPIN(cond, bar) do { unsigned _sp = 0; while (cond) { __builtin_amdgcn_s_sleep(1); \
    if ((++_sp & 255u) == 0u) { if (xb_ld(&(bar)[XB_TMO])) break; if (_sp > XB_SPIN_CAP) { atomicAdd(&(bar)[XB_TMO], 1u); break; } } } } while (0)

struct XcdBarrier {
    unsigned* bar; unsigned x;
    volatile LAS unsigned* st;
};

__device__ __forceinline__ XcdBarrier xcd_barrier_post(unsigned* bar, volatile LAS unsigned* st) {
    XcdBarrier b; b.bar = bar; b.x = xb_xcc_id(); b.st = st;
    if (threadIdx.x == 0) (void)xb_add(&bar[XB_XCNT(b.x)], 1u);
    return b;
}
__device__ __forceinline__ void xcd_barrier_complete(unsigned* bar, unsigned x, unsigned& nloc, unsigned& nx) {
    const unsigned G = gridDim.x * gridDim.y * gridDim.z;
    unsigned sum, cnt, mine, sp = 0u;
    for (;;) {
        sum = 0u; cnt = 0u; mine = 0u;
#pragma unroll
        for (unsigned j = 0; j < 16; ++j) { const unsigned c = xb_ld(&bar[XB_XCNT(j)]); sum += c; cnt += (c > 0u) ? 1u : 0u; mine = (j == x) ? c : mine; }
        if (sum == G) break;
        __builtin_amdgcn_s_sleep(1);
        if ((++sp & 255u) == 0u) { if (xb_ld(&bar[XB_TMO])) break; if (sp > XB_SPIN_CAP) { atomicAdd(&bar[XB_TMO], 1u); break; } }
    }
    nloc = mine > 0u ? mine : 1u; nx = cnt > 0u ? cnt : 1u;
}

__device__ __forceinline__ void xcd_barrier(const XcdBarrier& b) {
    asm volatile("s_waitcnt vmcnt(0)" ::: "memory");
    __syncthreads();
    if (threadIdx.x == 0) {
        unsigned* bar = b.bar;
        __builtin_amdgcn_s_waitcnt(0);
        unsigned nloc = b.st[0], nx = b.st[1];
        if (nloc == 0u) { xcd_barrier_complete(bar, b.x, nloc, nx); b.st[0] = nloc; b.st[1] = nx; }
        const unsigned old = xb_add(&bar[XB_XSUB(b.x)], 1u);
        const unsigned gen = old / nloc;
        if (old + 1u == (gen + 1u) * nloc) {
            __builtin_amdgcn_fence(__ATOMIC_RELEASE, "agent");
            asm volatile("s_waitcnt vmcnt(0)" ::: "memory");
            const unsigned og = xb_add(&bar[XB_TOP], 1u);
            const unsigned tg = og / nx;
            if (og + 1u == (tg + 1u) * nx) xb_add(&bar[XB_TOPGEN], 1u);
            else XB_SPIN(xb_ld(&bar[XB_TOPGEN]) == tg, bar);
            __builtin_amdgcn_fence(__ATOMIC_ACQUIRE, "agent");
            xb_add(&bar[XB_XGEN(b.x)], 1u);
            asm volatile("s_waitcnt vmcnt(0)" ::: "memory");
        } else {
            XB_SPIN(xb_ld(&bar[XB_XGEN(b.x)]) == gen, bar);
            __builtin_amdgcn_fence(__ATOMIC_ACQUIRE, "agent");
            asm volatile("s_waitcnt vmcnt(0)" ::: "memory");
        }
    }
    __syncthreads();
}

struct Frame {
    LAS unsigned char* lds;
    volatile LAS unsigned* MISC;
    gu32* ctl;
    int tid, lane, wave, G;
    const float* in[32];
    float* out;
    unsigned char* ws;
};
#define IN_X 0
#define IN_META 1
#define IN_LNIN_G 2
#define IN_LNIN_B 3
#define IN_W_IN 4
#define IN_QNORM_G 5
#define IN_W_UQ 6
#define IN_KVNORM_G 7
#define IN_W_UKV 8
#define IN_W_IQ 9
#define IN_IDXLN_G 10
#define IN_IDXLN_B 11
#define IN_MU 12
#define IN_W0 13
#define IN_W_DEC 14
#define IN_A0 15
#define IN_W_AAA 16
#define IN_W_GATE 17
#define IN_KK 18
#define IN_KA 19
#define IN_RK 20
#define IN_GN_G 21
#define IN_GN_B 22
#define IN_W_OUT 23
#define IN_LN1_G 24
#define IN_LN1_B 25
#define IN_W_UP 26
#define IN_CONV_W 27
#define IN_CONV_B 28
#define IN_W_DN 29
#define IN_LN2_G 30
#define IN_LN2_B 31

#define WSP(T, off) ((T*)(F.ws + (off)))

__device__ __forceinline__ int key_row(int b, int j) { return j < NMETA ? NREAL + j : b * SEQ + (j - NMETA); }

__device__ __forceinline__ void tr_items(Frame& F, const float* src, int src_ld, int src_r0, bf16* dst, int dst_ld, int dst_c0, int Nn, int K, int cut0, int cut1, int shift) {
    const int total = Nn * (K / 8);
    for (int it = blockIdx.x * NTHR + F.tid; it < total; it += F.G * NTHR) {
        const int n = it % Nn, kc = it / Nn;
        const int col = n < cut0 ? n : (n < cut1 ? -1 : n - shift);
        float v[8];
#pragma unroll
        for (int e = 0; e < 8; ++e) v[e] = col >= 0 ? src[(size_t)(src_r0 + 8 * kc + e) * src_ld + col] : 0.f;
        v4u o; o.x = pk2(v[0], v[1]); o.y = pk2(v[2], v[3]); o.z = pk2(v[4], v[5]); o.w = pk2(v[6], v[7]);
        *(v4u*)(dst + (size_t)n * dst_ld + dst_c0 + 8 * kc) = o;
    }
}
__device__ __forceinline__ void p0_weights(Frame& F) {
    bf16* WT_IN = WSP(bf16, WS_WT_IN); bf16* WT_QA = WSP(bf16, WS_WT_QA); bf16* WT_MIX = WSP(bf16, WS_WT_MIX); bf16* WT_UP = WSP(bf16, WS_WT_UP); bf16* WT_DN = WSP(bf16, WS_WT_DN);
    tr_items(F, F.in[IN_W_IN], 2248, 0, WT_IN, D, 0, PW, D, 456, 512, 56);
    tr_items(F, F.in[IN_W_UP], UPW, 0, WT_UP, D, 0, UPW, D, UPW, UPW, 0);
    tr_items(F, F.in[IN_W_DN], D, 0, WT_DN, DFF, 0, D, DFF, D, D, 0);
    tr_items(F, F.in[IN_W_IQ], 512, 0, WT_QA + (size_t)1024 * 256, 256, 0, 512, 256, 512, 512, 0);
    tr_items(F, F.in[IN_W_OUT], D, 512, WT_MIX, 1536, 1024, D, 512, D, D, 0);
    {
        bf16* WdT = WSP(bf16, WS_WT_LORA);
        tr_items(F, F.in[IN_W_DEC], 512, 0, WdT, 64, 0, 512, 64, 512, 512, 0);
        tr_items(F, F.in[IN_W_AAA], 512, 0, WdT + 512 * 64, 64, 0, 512, 64, 512, 512, 0);
        tr_items(F, F.in[IN_W_GATE], 512, 0, WdT + 2 * 512 * 64, 128, 0, 512, 128, 512, 512, 0);
    }
    const float* w_uq = F.in[IN_W_UQ]; const float* w_ukv = F.in[IN_W_UKV]; const float* w_out = F.in[IN_W_OUT];
    for (int it = blockIdx.x * NTHR + F.tid; it < 1024 * 256; it += F.G * NTHR) {
        const int c = it & 255, n = it >> 8, h = n >> 7, j = n & 127;
        float s = 0.f;
        for (int d = 0; d < 64; ++d) s += w_uq[(size_t)c * 512 + h * 64 + d] * w_ukv[(size_t)j * 1024 + h * 128 + d];
        WT_QA[(size_t)n * 256 + c] = (bf16)f2bf(0.125f * s);
    }
    for (int it = blockIdx.x * NTHR + F.tid; it < 1024 * 1024; it += F.G * NTHR) {
        const int n = it & 1023, k = it >> 10, h = k >> 7, j = k & 127;
        float s = 0.f;
        for (int d = 0; d < 64; ++d) s += w_ukv[(size_t)j * 1024 + h * 128 + 64 + d] * w_out[(size_t)(h * 64 + d) * D + n];
        WT_MIX[(size_t)n * 1536 + k] = (bf16)f2bf(s);
    }
}

__device__ __forceinline__ void ln_row_bf16(Frame& F, const float* src, const float* g, const float* b, bf16* dst) {
    v2u* o8 = (v2u*)dst + F.lane;
    if (!src) {
#pragma unroll
        for (int j = 0; j < 4; ++j) o8[64 * j] = (v2u){0u, 0u};
        return;
    }
    const f32x4* xr = (const f32x4*)src + F.lane;
    f32x4 v[4]; float s = 0.f;
#pragma unroll
    for (int j = 0; j < 4; ++j) { v[j] = xr[64 * j]; s += (v[j].x + v[j].y) + (v[j].z + v[j].w); }
    const float mean = wave_sum(s) * (1.f / D); float s2 = 0.f;
#pragma unroll
    for (int j = 0; j < 4; ++j) { v[j] = v[j] - mean; s2 += (v[j].x * v[j].x + v[j].y * v[j].y) + (v[j].z * v[j].z + v[j].w * v[j].w); }
    const float rstd = 1.f / sqrtf(wave_sum(s2) * (1.f / D) + LN_EPS);
#pragma unroll
    for (int j = 0; j < 4; ++j) {
        const f32x4 gg = ((const f32x4*)g)[F.lane + 64 * j], bb = ((const f32x4*)b)[F.lane + 64 * j];
        const f32x4 y = v[j] * rstd * gg + bb;
        o8[64 * j] = (v2u){pk2(y.x, y.y), pk2(y.z, y.w)};
    }
}
__device__ __forceinline__ void p1_ln_in(Frame& F) {
    bf16* H0 = WSP(bf16, WS_H);
    const int gw = blockIdx.x * NWAVES + F.wave, NGW = F.G * NWAVES;
    for (int r = gw; r < R; r += NGW) {
        const float* src = r < NREAL ? F.in[IN_X] + (size_t)r * D : (r < NROWS ? F.in[IN_META] + (size_t)(r - NREAL) * D : nullptr);
        ln_row_bf16(F, src, F.in[IN_LNIN_G], F.in[IN_LNIN_B], H0 + (size_t)r * D);
    }
}

__device__ __forceinline__ void p3_prep(Frame& F) {
    const bf16* P = WSP(bf16, WS_P); bf16* CQN = WSP(bf16, WS_CQN); bf16* CKV = WSP(bf16, WS_CKV); bf16* KIDX = WSP(bf16, WS_KIDX); float* WIDX = WSP(float, WS_WIDX);
    const int gw = blockIdx.x * NWAVES + F.wave, NGW = F.G * NWAVES, l = F.lane;
    for (int r = gw; r < R; r += NGW) {
        const bf16* pr = P + (size_t)r * PW;
        if (r >= NROWS) {
            *(v2u*)(CQN + (size_t)r * 256 + 4 * l) = (v2u){0u, 0u};
            continue;
        }
        {
            const v2u w = *(const v2u*)(pr + PC_CQ + 4 * l);
            const float a0 = bflo(w.x), a1 = bfhi(w.x), a2 = bflo(w.y), a3 = bfhi(w.y);
            const float ss = wave_sum(a0 * a0 + a1 * a1 + a2 * a2 + a3 * a3);
            const float rs = 1.0f / sqrtf(ss * (1.f / 256.f) + 1e-6f);
            const f32x4 g = ((const f32x4*)F.in[IN_QNORM_G])[l];
            *(v2u*)(CQN + (size_t)r * 256 + 4 * l) = (v2u){pk2(a0 * rs * g.x, a1 * rs * g.y), pk2(a2 * rs * g.z, a3 * rs * g.w)};
        }
        {
            const unsigned w = *(const unsigned*)(pr + PC_CKV + 2 * l);
            const float a0 = bflo(w), a1 = bfhi(w);
            const float ss = wave_sum(a0 * a0 + a1 * a1);
            const float rs = 1.0f / sqrtf(ss * (1.f / 128.f) + 1e-6f);
            const float g0 = F.in[IN_KVNORM_G][2 * l], g1 = F.in[IN_KVNORM_G][2 * l + 1];
            *(unsigned*)(CKV + (size_t)r * 128 + 2 * l) = pk2(a0 * rs * g0, a1 * rs * g1);
        }
        {
            const float a = bf2f(pr[PC_KIDX + l]);
            const float mean = wave_sum(a) * (1.f / 64.f);
            const float dlt = a - mean;
            const float var = wave_sum(dlt * dlt) * (1.f / 64.f);
            const float y = dlt * (1.0f / sqrtf(var + LN_EPS)) * F.in[IN_IDXLN_G][l] + F.in[IN_IDXLN_B][l];
            KIDX[(size_t)r * 64 + l] = (bf16)f2bf(y);
        }
        if (l < 8) WIDX[(size_t)r * 8 + l] = bf2f(pr[PC_WIDX + l]) * 0.04419417382415922f;
    }
}

#ifndef REFSEL
#define REFSEL 0
#endif
__device__ __forceinline__ void refsel_rows(Frame& F) {
    float* QIDX32 = F.out; float* KIDX32 = F.out + (size_t)R * 512; float* WIDX = WSP(float, WS_WIDX);
    const float* w_in = F.in[IN_W_IN]; const float* w_iq = F.in[IN_W_IQ];
    LAS float* hrow = (LAS float*)(F.lds + F.wave * 8192);
    LAS float* cqn = hrow + 1024;
    const int l = F.lane;
    const int gw = blockIdx.x * NWAVES + F.wave, NGW = F.G * NWAVES;
    for (int r = gw; r < NROWS; r += NGW) {
        const float* src = r < NREAL ? F.in[IN_X] + (size_t)r * D : F.in[IN_META] + (size_t)(r - NREAL) * D;
        {
            const f32x4* xr = (const f32x4*)src + l;
            f32x4 v[4]; float s = 0.f;
#pragma unroll
            for (int j = 0; j < 4; ++j) { v[j] = xr[64 * j]; s += (v[j].x + v[j].y) + (v[j].z + v[j].w); }
            const float mean = wave_sum(s) * (1.f / D); float s2 = 0.f;
#pragma unroll
            for (int j = 0; j < 4; ++j) { v[j] = v[j] - mean; s2 += (v[j].x * v[j].x + v[j].y * v[j].y) + (v[j].z * v[j].z + v[j].w * v[j].w); }
            const float rstd = 1.f / sqrtf(wave_sum(s2) * (1.f / D) + LN_EPS);
#pragma unroll
            for (int j = 0; j < 4; ++j) {
                const f32x4 gg = ((const f32x4*)F.in[IN_LNIN_G])[l + 64 * j], bb = ((const f32x4*)F.in[IN_LNIN_B])[l + 64 * j];
                *(LAS f32x4*)(hrow + 4 * (l + 64 * j)) = v[j] * rstd * gg + bb;
            }
        }
        __builtin_amdgcn_wave_barrier();
        float a[6];
#pragma unroll
        for (int i = 0; i < 6; ++i) a[i] = 0.f;
        for (int k = 0; k < D; ++k) {
            const float hk = hrow[k]; const float* wr = w_in + (size_t)k * 2248;
#pragma unroll
            for (int i = 0; i < 4; ++i) a[i] += hk * wr[l + 64 * i];
            a[4] += hk * wr[384 + l];
            a[5] += hk * wr[448 + (l & 7)];
        }
        const float ss = wave_sum(a[0] * a[0] + a[1] * a[1] + a[2] * a[2] + a[3] * a[3]);
        const float rs = 1.0f / sqrtf(ss * (1.f / 256.f) + 1e-6f);
#pragma unroll
        for (int i = 0; i < 4; ++i) cqn[l + 64 * i] = a[i] * rs * F.in[IN_QNORM_G][l + 64 * i];
        {
            const float mean = wave_sum(a[4]) * (1.f / 64.f); const float dlt = a[4] - mean;
            const float var = wave_sum(dlt * dlt) * (1.f / 64.f);
            KIDX32[(size_t)r * 64 + l] = dlt * (1.0f / sqrtf(var + LN_EPS)) * F.in[IN_IDXLN_G][l] + F.in[IN_IDXLN_B][l];
        }
        if (l < 8) WIDX[(size_t)r * 8 + l] = a[5] * 0.04419417382415922f;
        __builtin_amdgcn_wave_barrier();
        float q[8];
#pragma unroll
        for (int i = 0; i < 8; ++i) q[i] = 0.f;
        for (int c = 0; c < 256; ++c) {
            const float cq = cqn[c]; const float* wr = w_iq + (size_t)c * 512;
#pragma unroll
            for (int i = 0; i < 8; ++i) q[i] += cq * wr[l + 64 * i];
        }
#pragma unroll
        for (int i = 0; i < 8; ++i) QIDX32[(size_t)r * 512 + l + 64 * i] = q[i];
        __builtin_amdgcn_wave_barrier();
    }
}

__device__ __forceinline__ unsigned sortable(float f) { const unsigned u = __float_as_uint(f); return (u & 0x80000000u) ? ~u : (u | 0x80000000u); }
__device__ __forceinline__ void p5_index_naive(Frame& F) {
    const bf16* QA = WSP(bf16, WS_QA); const bf16* KIDX = WSP(bf16, WS_KIDX); const float* WIDX = WSP(float, WS_WIDX);
    unsigned short* SEL = WSP(unsigned short, WS_SEL); int* NSEL = WSP(int, WS_NSEL);
    LAS float* sc = (LAS float*)(F.lds);
    LAS float* qf = (LAS float*)(F.lds + 33024);
    LAS unsigned* hist = (LAS unsigned*)(F.lds + 33024 + 2048);
    LAS unsigned* cw = hist + 256;
    const int tid = F.tid;
    for (int q = blockIdx.x; q < NROWS; q += F.G) {
        int b, pos; if (q < NREAL) { b = q >> 13; pos = NMETA + (q & (SEQ - 1)); } else { b = 0; pos = q - NREAL; }
        const int nvis = pos < NMETA ? NMETA : NMETA + 64 * ((pos - NMETA) / 64 + 1);
#if REFSEL
        qf[tid] = F.out[(size_t)q * 512 + tid];
#else
        qf[tid] = bf2f(QA[(size_t)q * QAW + 1024 + tid]);
#endif
        float w[8];
#pragma unroll
        for (int h = 0; h < 8; ++h) w[h] = WIDX[(size_t)q * 8 + h];
        __syncthreads();
        for (int j = tid; j < nvis; j += NTHR) {
            const v4u* kp = (const v4u*)(KIDX + (size_t)key_row(b, j) * 64);
#if REFSEL
            const f32x4* kp32 = (const f32x4*)(F.out + (size_t)R * 512 + (size_t)key_row(b, j) * 64);
#endif
            float d[8];
#pragma unroll
            for (int h = 0; h < 8; ++h) d[h] = 0.f;
#pragma unroll 2
            for (int c = 0; c < 8; ++c) {
#if REFSEL
                const f32x4 ta = kp32[2 * c], tb = kp32[2 * c + 1];
                const float k0 = ta.x, k1 = ta.y, k2 = ta.z, k3 = ta.w, k4 = tb.x, k5 = tb.y, k6 = tb.z, k7 = tb.w;
#else
                const v4u t = kp[c];
                const float k0 = bflo(t.x), k1 = bfhi(t.x), k2 = bflo(t.y), k3 = bfhi(t.y), k4 = bflo(t.z), k5 = bfhi(t.z), k6 = bflo(t.w), k7 = bfhi(t.w);
#endif
#pragma unroll
                for (int h = 0; h < 8; ++h) {
                    const f32x4 qa = *(const LAS f32x4*)(qf + h * 64 + 8 * c), qb = *(const LAS f32x4*)(qf + h * 64 + 8 * c + 4);
                    d[h] += qa.x * k0 + qa.y * k1 + qa.z * k2 + qa.w * k3 + qb.x * k4 + qb.y * k5 + qb.z * k6 + qb.w * k7;
                }
            }
            float s = 0.f;
#pragma unroll
            for (int h = 0; h < 8; ++h) s += w[h] * fmaxf(d[h], 0.f);
            sc[j] = s + 0.0f;
        }
        __syncthreads();
        unsigned short* selq = SEL + (size_t)q * TOPK;
        if (nvis <= TOPK) {
            for (int j = tid; j < nvis; j += NTHR) selq[j] = (unsigned short)j;
        } else {
            unsigned prefix = 0u, mask = 0u, need = TOPK;
            for (int pass = 0; pass < 4; ++pass) {
                const int shift = 24 - 8 * pass;
                if (tid < 256) hist[tid] = 0u;
                __syncthreads();
                for (int j = tid; j < nvis; j += NTHR) { const unsigned key = sortable(sc[j]); if ((key & mask) == prefix) atomicAdd((unsigned*)&hist[(key >> shift) & 255u], 1u); }
                __syncthreads();
                if (tid < 256) {
                    unsigned above = 0u; for (int bb = tid + 1; bb < 256; ++bb) above += hist[bb];
                    const unsigned c = hist[tid];
                    if (above < need && need <= above + c) { cw[0] = prefix | ((unsigned)tid << shift); cw[1] = need - above; }
                }
                __syncthreads();
                prefix = cw[0]; need = cw[1]; mask |= 0xFFu << shift;
                __syncthreads();
            }
            if (tid == 0) cw[2] = 0u;
            __syncthreads();
            for (int j = tid; j < nvis; j += NTHR) { if (sortable(sc[j]) > prefix) { const unsigned p = atomicAdd((unsigned*)&cw[2], 1u); selq[p] = (unsigned short)j; } }
            __syncthreads();
            if (F.wave == 0) {
                const unsigned base = cw[2]; unsigned taken = 0u;
                for (int j0 = 0; j0 < nvis && taken < need; j0 += 64) {
                    const int j = j0 + F.lane; const bool eq = j < nvis && sortable(sc[j]) == prefix;
                    const unsigned long long m = __ballot(eq);
                    const unsigned rank = (unsigned)__popcll(m & ((1ull << F.lane) - 1ull));
                    if (eq && taken + rank < need) selq[base + taken + rank] = (unsigned short)j;
                    taken += (unsigned)__popcll(m);
                }
            }
        }
        if (tid == 0) NSEL[q] = nvis < TOPK ? nvis : TOPK;
        __syncthreads();
    }
}

__device__ __forceinline__ void p6_attn_naive(Frame& F) {
    bf16* QA = WSP(bf16, WS_QA); const bf16* CKV = WSP(bf16, WS_CKV); const unsigned short* SEL = WSP(unsigned short, WS_SEL); const int* NSEL = WSP(int, WS_NSEL);
    LAS float* qf = (LAS float*)(F.lds + F.wave * 16384);
    LAS float* ps = qf + 1024;
    LAS int* srow = (LAS int*)(ps + 2048);
    const int l = F.lane;
    const int gw = blockIdx.x * NWAVES + F.wave, NGW = F.G * NWAVES;
    for (int q = gw; q < R; q += NGW) {
        bf16* qrow = QA + (size_t)q * QAW;
        if (q >= NROWS) {
            for (int c = l; c < QAW / 8; c += 64) *(v4u*)(qrow + 8 * c) = (v4u){0u, 0u, 0u, 0u};
            continue;
        }
        int b, pos; if (q < NREAL) { b = q >> 13; pos = NMETA + (q & (SEQ - 1)); } else { b = 0; pos = q - NREAL; }
        const int nsel = NSEL[q];
        {
            const v4u t0 = *(const v4u*)(qrow + 16 * l), t1 = *(const v4u*)(qrow + 16 * l + 8);
            LAS float* d = qf + 16 * l;
            d[0] = bflo(t0.x); d[1] = bfhi(t0.x); d[2] = bflo(t0.y); d[3] = bfhi(t0.y); d[4] = bflo(t0.z); d[5] = bfhi(t0.z); d[6] = bflo(t0.w); d[7] = bfhi(t0.w);
            d[8] = bflo(t1.x); d[9] = bfhi(t1.x); d[10] = bflo(t1.y); d[11] = bfhi(t1.y); d[12] = bflo(t1.z); d[13] = bfhi(t1.z); d[14] = bflo(t1.w); d[15] = bfhi(t1.w);
        }
        __builtin_amdgcn_wave_barrier();
        for (int kk = 0; kk < 4; ++kk) {
            const int s = kk * 64 + l; const bool valid = s < nsel;
            const int j = valid ? (int)SEL[(size_t)q * TOPK + s] : 0;
            const int row = key_row(b, j);
            srow[s] = row;
            float acc[8];
#pragma unroll
            for (int h = 0; h < 8; ++h) acc[h] = 0.f;
            const v4u* kp = (const v4u*)(CKV + (size_t)row * 128);
            for (int c8 = 0; c8 < 16; ++c8) {
                const v4u t = kp[c8];
                const float k0 = bflo(t.x), k1 = bfhi(t.x), k2 = bflo(t.y), k3 = bfhi(t.y), k4 = bflo(t.z), k5 = bfhi(t.z), k6 = bflo(t.w), k7 = bfhi(t.w);
#pragma unroll
                for (int h = 0; h < 8; ++h) {
                    const f32x4 qa = *(const LAS f32x4*)(qf + h * 128 + 8 * c8), qb = *(const LAS f32x4*)(qf + h * 128 + 8 * c8 + 4);
                    acc[h] += qa.x * k0 + qa.y * k1 + qa.z * k2 + qa.w * k3 + qb.x * k4 + qb.y * k5 + qb.z * k6 + qb.w * k7;
                }
            }
            const float dist = fabsf((float)(pos - j));
#pragma unroll
            for (int h = 0; h < 8; ++h) { const float slope = __uint_as_float((unsigned)(127 - (h + 1)) << 23); ps[s * 8 + h] = valid ? acc[h] - slope * dist : -INFINITY; }
        }
        __builtin_amdgcn_wave_barrier();
#pragma unroll
        for (int h = 0; h < 8; ++h) {
            float v0 = ps[(l) * 8 + h], v1 = ps[(l + 64) * 8 + h], v2 = ps[(l + 128) * 8 + h], v3 = ps[(l + 192) * 8 + h];
            const float mx = wave_max(fmaxf(fmaxf(v0, v1), fmaxf(v2, v3)));
            v0 = __expf(v0 - mx); v1 = __expf(v1 - mx); v2 = __expf(v2 - mx); v3 = __expf(v3 - mx);
            const float inv = 1.0f / wave_sum((v0 + v1) + (v2 + v3));
            ps[(l) * 8 + h] = v0 * inv; ps[(l + 64) * 8 + h] = v1 * inv; ps[(l + 128) * 8 + h] = v2 * inv; ps[(l + 192) * 8 + h] = v3 * inv;
        }
        __builtin_amdgcn_wave_barrier();
        float o0[8], o1[8];
#pragma unroll
        for (int h = 0; h < 8; ++h) { o0[h] = 0.f; o1[h] = 0.f; }
        for (int s = 0; s < nsel; ++s) {
            const int row = srow[s];
            const unsigned w = *(const unsigned*)(CKV + (size_t)row * 128 + 2 * l);
            const float c0 = bflo(w), c1 = bfhi(w);
            const f32x4 pa = *(const LAS f32x4*)(ps + s * 8), pb = *(const LAS f32x4*)(ps + s * 8 + 4);
            o0[0] += pa.x * c0; o1[0] += pa.x * c1; o0[1] += pa.y * c0; o1[1] += pa.y * c1; o0[2] += pa.z * c0; o1[2] += pa.z * c1; o0[3] += pa.w * c0; o1[3] += pa.w * c1;
            o0[4] += pb.x * c0; o1[4] += pb.x * c1; o0[5] += pb.y * c0; o1[5] += pb.y * c1; o0[6] += pb.z * c0; o1[6] += pb.z * c1; o0[7] += pb.w * c0; o1[7] += pb.w * c1;
        }
#pragma unroll
        for (int h = 0; h < 8; ++h) *(unsigned*)(qrow + h * 128 + 2 * l) = pk2(o0[h], o1[h]);
        __builtin_amdgcn_wave_barrier();
    }
}

__device__ __forceinline__ void p7_rwkv_prep_naive(Frame& F) {
    const bf16* P = WSP(bf16, WS_P); float* DEC = WSP(float, WS_DEC); bf16* AB = WSP(bf16, WS_AB); bf16* GB = WSP(bf16, WS_GB);
    const float* mu = F.in[IN_MU]; const float* Wd = F.in[IN_W_DEC]; const float* Wa = F.in[IN_W_AAA]; const float* Wg = F.in[IN_W_GATE];
    const int l = F.lane;
    const int gw = blockIdx.x * NWAVES + F.wave, NGW = F.G * NWAVES;
    for (int r = gw; r < NROWS; r += NGW) {
        int prev; if (r < NREAL) { prev = (r & (SEQ - 1)) ? r - 1 : NREAL + NMETA - 1; } else { prev = r > NREAL ? r - 1 : -1; }
        const bf16* pr = P + (size_t)r * PW; const bf16* pp = prev >= 0 ? P + (size_t)prev * PW : nullptr;
#define SHIFTED(pc, mc) (bf2f(pr[pc]) + ((pp ? bf2f(pp[pc]) : 0.f) - bf2f(pr[pc])) * mu[mc])
        const float tw = tanhf(SHIFTED(PC_WD + l, 1536 + l));
        const float ta = SHIFTED(PC_AD + l, 1600 + l);
        const float tg0 = sigmoidf_(SHIFTED(PC_GD + l, 1664 + l)), tg1 = sigmoidf_(SHIFTED(PC_GD + 64 + l, 1728 + l));
#undef SHIFTED
        float aw[8], aa[8], ag[8];
#pragma unroll
        for (int i = 0; i < 8; ++i) { aw[i] = F.in[IN_W0][l + 64 * i]; aa[i] = F.in[IN_A0][l + 64 * i]; ag[i] = 0.f; }
        for (int j = 0; j < 64; ++j) {
            const float xw = __shfl(tw, j), xa = __shfl(ta, j), xg0 = __shfl(tg0, j), xg1 = __shfl(tg1, j);
#pragma unroll
            for (int i = 0; i < 8; ++i) {
                aw[i] += xw * Wd[(size_t)j * 512 + l + 64 * i];
                aa[i] += xa * Wa[(size_t)j * 512 + l + 64 * i];
                ag[i] += xg0 * Wg[(size_t)j * 512 + l + 64 * i] + xg1 * Wg[(size_t)(j + 64) * 512 + l + 64 * i];
            }
        }
#pragma unroll
        for (int i = 0; i < 8; ++i) {
            const float x = -aw[i];
            const float sp = x > 20.f ? x : log1pf(__expf(x));
            const float wlog = -sp - 0.5f;
            DEC[(size_t)r * 512 + l + 64 * i] = __expf(-__expf(wlog));
            AB[(size_t)r * 512 + l + 64 * i] = (bf16)f2bf(sigmoidf_(aa[i]));
            GB[(size_t)r * 512 + l + 64 * i] = (bf16)f2bf(ag[i]);
        }
    }
}

__device__ __forceinline__ void p8_rwkv_scan_naive(Frame& F) {
    if (F.wave != 0 || blockIdx.x >= 32) return;
    const bf16* P = WSP(bf16, WS_P); const float* DEC = WSP(float, WS_DEC); const bf16* AB = WSP(bf16, WS_AB); const bf16* GB = WSP(bf16, WS_GB); bf16* QA = WSP(bf16, WS_QA);
    const int b = blockIdx.x >> 3, h = blockIdx.x & 7, l = F.lane, ch = h * 64 + l;
    LAS float* vec = (LAS float*)F.lds;
    const float mu_r = F.in[IN_MU][ch], mu_k = F.in[IN_MU][512 + ch], mu_v = F.in[IN_MU][1024 + ch];
    const float kk_c = F.in[IN_KK][ch], ka_c = F.in[IN_KA][ch], rk_c = F.in[IN_RK][ch], gng = F.in[IN_GN_G][ch], gnb = F.in[IN_GN_B][ch];
    float S[64];
#pragma unroll
    for (int k = 0; k < 64; ++k) S[k] = 0.f;
    float pr_p = 0.f, pk_p = 0.f, pv_p = 0.f;
    int row = key_row(b, 0);
    float n_pr = bf2f(P[(size_t)row * PW + PC_R + ch]), n_pk = bf2f(P[(size_t)row * PW + PC_K + ch]), n_pv = bf2f(P[(size_t)row * PW + PC_V + ch]);
    float n_w = DEC[(size_t)row * 512 + ch], n_a = bf2f(AB[(size_t)row * 512 + ch]), n_g = bf2f(GB[(size_t)row * 512 + ch]);
    for (int pos = 0; pos < TT; ++pos) {
        const int crow = row;
        const float c_pr = n_pr, c_pk = n_pk, c_pv = n_pv, c_w = n_w, c_a = n_a, c_g = n_g;
        if (pos + 1 < TT) {
            row = key_row(b, pos + 1);
            n_pr = bf2f(P[(size_t)row * PW + PC_R + ch]); n_pk = bf2f(P[(size_t)row * PW + PC_K + ch]); n_pv = bf2f(P[(size_t)row * PW + PC_V + ch]);
            n_w = DEC[(size_t)row * 512 + ch]; n_a = bf2f(AB[(size_t)row * 512 + ch]); n_g = bf2f(GB[(size_t)row * 512 + ch]);
        }
        const float r_s = c_pr + (pr_p - c_pr) * mu_r, k_s = c_pk + (pk_p - c_pk) * mu_k, v_s = c_pv + (pv_p - c_pv) * mu_v;
        pr_p = c_pr; pk_p = c_pk; pv_p = c_pv;
        const float kkr = k_s * kk_c;
        const float nrm = sqrtf(wave_sum(kkr * kkr));
        const float kk = kkr / fmaxf(nrm, 1e-12f);
        const float k2 = k_s * (1.f + (c_a - 1.f) * ka_c);
        vec[l] = -kk; vec[64 + l] = kk * c_a; vec[128 + l] = c_w; vec[192 + l] = k2; vec[256 + l] = r_s;
        __builtin_amdgcn_wave_barrier();
        float sa = 0.f;
#pragma unroll
        for (int k4 = 0; k4 < 16; ++k4) { const f32x4 a = *(const LAS f32x4*)(vec + 4 * k4); sa += S[4 * k4] * a.x + S[4 * k4 + 1] * a.y + S[4 * k4 + 2] * a.z + S[4 * k4 + 3] * a.w; }
        float y = 0.f;
#pragma unroll
        for (int k4 = 0; k4 < 16; ++k4) {
            const f32x4 bv = *(const LAS f32x4*)(vec + 64 + 4 * k4), w = *(const LAS f32x4*)(vec + 128 + 4 * k4), kv = *(const LAS f32x4*)(vec + 192 + 4 * k4), rv = *(const LAS f32x4*)(vec + 256 + 4 * k4);
            S[4 * k4] = S[4 * k4] * w.x + sa * bv.x + v_s * kv.x; S[4 * k4 + 1] = S[4 * k4 + 1] * w.y + sa * bv.y + v_s * kv.y;
            S[4 * k4 + 2] = S[4 * k4 + 2] * w.z + sa * bv.z + v_s * kv.z; S[4 * k4 + 3] = S[4 * k4 + 3] * w.w + sa * bv.w + v_s * kv.w;
            y += S[4 * k4] * rv.x + S[4 * k4 + 1] * rv.y + S[4 * k4 + 2] * rv.z + S[4 * k4 + 3] * rv.w;
        }
        __builtin_amdgcn_wave_barrier();
        const float mean = wave_sum(y) * (1.f / 64.f);
        const float dlt = y - mean;
        const float var = wave_sum(dlt * dlt) * (1.f / 64.f);
        const float yn = dlt * (1.0f / sqrtf(var + GN_EPS)) * gng + gnb;
        const float bonus = wave_sum(r_s * k2 * rk_c) * v_s;
        const float o = (yn + bonus) * c_g;
        if (pos >= NMETA || b == 0) QA[(size_t)crow * QAW + 1024 + ch] = (bf16)f2bf(o);
    }
}

__device__ __forceinline__ void p10_ln1(Frame& F) {
    bf16* H1 = WSP(bf16, WS_H); const float* META1 = WSP(float, WS_META1);
    const int gw = blockIdx.x * NWAVES + F.wave, NGW = F.G * NWAVES;
    for (int r = gw; r < NROWS; r += NGW) {
        const float* src = r < NREAL ? F.out + (size_t)r * D : META1 + (size_t)(r - NREAL) * D;
        ln_row_bf16(F, src, F.in[IN_LN1_G], F.in[IN_LN1_B], H1 + (size_t)r * D);
    }
}
__device__ __forceinline__ void p14_ln2(Frame& F) {
    const int gw = blockIdx.x * NWAVES + F.wave, NGW = F.G * NWAVES;
    const float* g = F.in[IN_LN2_G]; const float* b = F.in[IN_LN2_B];
    for (int r = gw; r < NREAL; r += NGW) {
        f32x4* xr = (f32x4*)(F.out + (size_t)r * D) + F.lane;
        f32x4 v[4]; float s = 0.f;
#pragma unroll
        for (int j = 0; j < 4; ++j) { v[j] = xr[64 * j]; s += (v[j].x + v[j].y) + (v[j].z + v[j].w); }
        const float mean = wave_sum(s) * (1.f / D); float s2 = 0.f;
#pragma unroll
        for (int j = 0; j < 4; ++j) { v[j] = v[j] - mean; s2 += (v[j].x * v[j].x + v[j].y * v[j].y) + (v[j].z * v[j].z + v[j].w * v[j].w); }
        const float rstd = 1.f / sqrtf(wave_sum(s2) * (1.f / D) + LN_EPS);
#pragma unroll
        for (int j = 0; j < 4; ++j) { const f32x4 gg = ((const f32x4*)g)[F.lane + 64 * j], bb = ((const f32x4*)b)[F.lane + 64 * j]; xr[64 * j] = v[j] * rstd * gg + bb; }
    }
}

__device__ __forceinline__ float gelu_fast(float x) {
    const float u2 = x * (1.5957691216057308f + 0.07135481627260025f * x * x);
    return x * __builtin_amdgcn_rcpf(1.0f + __builtin_amdgcn_exp2f(-1.4426950408889634f * u2));
}
__device__ __forceinline__ void p12_conv_act(Frame& F) {
    bf16* UP = WSP(bf16, WS_UP); const float* cw = F.in[IN_CONV_W]; const float* cb = F.in[IN_CONV_B];
    constexpr int NCG = DFF / 8, STRIP = 32, NSTRIP = NREAL / STRIP;
    for (int it = blockIdx.x * NTHR + F.tid; it < NSTRIP * NCG; it += F.G * NTHR) {
        const int cg = it % NCG, st = it / NCG, c = cg * 8, r0 = st * STRIP, s0 = r0 & (SEQ - 1);
        float w0[8], w1[8], w2[8], bb[8];
#pragma unroll
        for (int e = 0; e < 2; ++e) {
            const f32x4 a = *(const f32x4*)(cw + c + 4 * e), b = *(const f32x4*)(cw + DFF + c + 4 * e), d = *(const f32x4*)(cw + 2 * DFF + c + 4 * e), g = *(const f32x4*)(cb + c + 4 * e);
            w0[4 * e] = a.x; w0[4 * e + 1] = a.y; w0[4 * e + 2] = a.z; w0[4 * e + 3] = a.w; w1[4 * e] = b.x; w1[4 * e + 1] = b.y; w1[4 * e + 2] = b.z; w1[4 * e + 3] = b.w;
            w2[4 * e] = d.x; w2[4 * e + 1] = d.y; w2[4 * e + 2] = d.z; w2[4 * e + 3] = d.w; bb[4 * e] = g.x; bb[4 * e + 1] = g.y; bb[4 * e + 2] = g.z; bb[4 * e + 3] = g.w;
        }
        const int rm2 = s0 >= 2 ? r0 - 2 : NREAL + 14, rm1 = s0 >= 1 ? r0 - 1 : NREAL + 15;
        v4u gm2 = *(const v4u*)(UP + (size_t)rm2 * UPW + c), gm1 = *(const v4u*)(UP + (size_t)rm1 * UPW + c);
#pragma unroll 4
        for (int i = 0; i < STRIP; ++i) {
            const size_t ro = (size_t)(r0 + i) * UPW;
            const v4u g0 = *(const v4u*)(UP + ro + c); const v4u vv = *(const v4u*)(UP + ro + DFF + c);
            const unsigned a0[4] = {g0.x, g0.y, g0.z, g0.w}, a1[4] = {gm1.x, gm1.y, gm1.z, gm1.w}, a2[4] = {gm2.x, gm2.y, gm2.z, gm2.w}, av[4] = {vv.x, vv.y, vv.z, vv.w};
            unsigned o[4];
#pragma unroll
            for (int e = 0; e < 4; ++e) {
                const float x0 = w0[2 * e] * bflo(a2[e]) + w1[2 * e] * bflo(a1[e]) + w2[2 * e] * bflo(a0[e]) + bb[2 * e];
                const float x1 = w0[2 * e + 1] * bfhi(a2[e]) + w1[2 * e + 1] * bfhi(a1[e]) + w2[2 * e + 1] * bfhi(a0[e]) + bb[2 * e + 1];
                o[e] = pk2(gelu_fast(x0) * bflo(av[e]), gelu_fast(x1) * bfhi(av[e]));
            }
            *(v4u*)(UP + ro + DFF + c) = (v4u){o[0], o[1], o[2], o[3]};
            gm2 = gm1; gm1 = g0;
        }
    }
}


constexpr int NUNITS = 4096 + 8;
constexpr int RP = 72;
constexpr int SLOT = 64 * RP * 2;
constexpr int FP = 68;
typedef short bf16x8 __attribute__((ext_vector_type(8)));
typedef float f32x16 __attribute__((ext_vector_type(16)));
constexpr size_t RW_MAT = (size_t)NUNITS * 4096;

__device__ __forceinline__ void quad_mma(f32x16& acc, const LAS bf16* Aop, const LAS bf16* Bop, int qr, int qc, int lane) {
    const int r = lane & 31, hf = lane >> 5;
    const LAS bf16* ap = Aop + (32 * qr + r) * RP + 8 * hf; const LAS bf16* bp = Bop + (32 * qc + r) * RP + 8 * hf;
#pragma unroll
    for (int ks = 0; ks < 4; ++ks) {
        const bf16x8 a = *(const LAS bf16x8*)(ap + 16 * ks), b = *(const LAS bf16x8*)(bp + 16 * ks);
        acc = __builtin_amdgcn_mfma_f32_32x32x16_bf16(a, b, acc, 0, 0, 0);
    }
}
#define ACC_M(qr, j, hf) (32 * (qr) + ((j) & 3) + 8 * ((j) >> 2) + 4 * (hf))
__device__ __forceinline__ void store_T(const f32x16& acc, LAS bf16* Z, int qr, int qc, int lane) {
    const int r = lane & 31, hf = lane >> 5;
#pragma unroll
    for (int jj = 0; jj < 4; ++jj)
        *(LAS v2u*)(Z + (32 * qc + r) * RP + 32 * qr + 8 * jj + 4 * hf) = (v2u){pk2(acc[4 * jj], acc[4 * jj + 1]), pk2(acc[4 * jj + 2], acc[4 * jj + 3])};
}
__device__ __forceinline__ void add_T(f32x16& acc, const LAS bf16* Z, int qr, int qc, int lane) {
    const int r = lane & 31, hf = lane >> 5;
#pragma unroll
    for (int jj = 0; jj < 4; ++jj) {
        const v2u w = *(const LAS v2u*)(Z + (32 * qc + r) * RP + 32 * qr + 8 * jj + 4 * hf);
        acc[4 * jj] += bflo(w.x); acc[4 * jj + 1] += bfhi(w.x); acc[4 * jj + 2] += bflo(w.y); acc[4 * jj + 3] += bfhi(w.y);
    }
}
__device__ __forceinline__ void store_T_global(const f32x16& acc, bf16* Z, int qr, int qc, int lane) {
    const int r = lane & 31, hf = lane >> 5;
#pragma unroll
    for (int jj = 0; jj < 4; ++jj)
        *(v2u*)(Z + (32 * qc + r) * 64 + 32 * qr + 8 * jj + 4 * hf) = (v2u){pk2(acc[4 * jj], acc[4 * jj + 1]), pk2(acc[4 * jj + 2], acc[4 * jj + 3])};
}
__device__ __forceinline__ f32x16 zero16() { f32x16 z;
#pragma unroll
    for (int j = 0; j < 16; ++j) z[j] = 0.f;
    return z; }

__device__ __forceinline__ void rw_b1(Frame& F) {
    const bf16* P = WSP(bf16, WS_P);
    bf16* RWM = WSP(bf16, WS_RWM); bf16* RWN = WSP(bf16, WS_RWN); bf16* RWQ = WSP(bf16, WS_RWQ); bf16* RWY = WSP(bf16, WS_RWY);
    float* BONUS = (float*)((char*)F.out + OUT_BONUS);
    const bf16* WdT = WSP(bf16, WS_WT_LORA); const bf16* WaT = WdT + 512 * 64;
    const float* mu = F.in[IN_MU];
    const int w = F.wave, l = F.lane, tid = F.tid;
    LAS unsigned char* L = F.lds;
#define SL(s) ((LAS bf16*)(L + (s) * SLOT))
    LAS float* WL = (LAS float*)(L + 12 * SLOT);
    LAS float* AL = (LAS float*)(L + 0 * SLOT);
    LAS float* OT = (LAS float*)(L + RING_BYTES + 1024);
    LAS float* GL = OT + 512;
    for (int u = blockIdx.x; u < NUNITS; u += F.G) {
        const bool meta = u >= 4096;
        int b = 0, h, c = 0; if (meta) h = u - 4096; else { b = u >> 10; h = (u >> 7) & 7; c = u & 127; }
        const int ch = h * 64 + l;
        const int row0 = meta ? NREAL : b * SEQ + c * 64;
        __syncthreads();
        float r_s[8], k_s[8], v_s[8], xw[8], xa[8];
        {
            float pr, pk, pv, pw, pa;
            const int t0 = 8 * w;
            int prow = -1;
            if (t0 > 0) prow = row0 + t0 - 1; else if (!meta) prow = (c == 0) ? NREAL + NMETA - 1 : row0 - 1;
            if (prow >= 0) { const bf16* pp = P + (size_t)prow * PW; pr = bf2f(pp[PC_R + ch]); pk = bf2f(pp[PC_K + ch]); pv = bf2f(pp[PC_V + ch]); pw = bf2f(pp[PC_WD + l]); pa = bf2f(pp[PC_AD + l]); }
            else { pr = pk = pv = pw = pa = 0.f; }
            const float mr = mu[ch], mk = mu[512 + ch], mv = mu[1024 + ch], mw = mu[1536 + l], ma = mu[1600 + l];
#pragma unroll
            for (int i = 0; i < 8; ++i) {
                const int t = t0 + i; const bool valid = !meta || t < NMETA;
                float cr = 0.f, ck = 0.f, cv = 0.f, cw = 0.f, ca = 0.f;
                if (valid) { const bf16* pp = P + (size_t)(row0 + t) * PW; cr = bf2f(pp[PC_R + ch]); ck = bf2f(pp[PC_K + ch]); cv = bf2f(pp[PC_V + ch]); cw = bf2f(pp[PC_WD + l]); ca = bf2f(pp[PC_AD + l]); }
                r_s[i] = valid ? cr + (pr - cr) * mr : 0.f; k_s[i] = valid ? ck + (pk - ck) * mk : 0.f; v_s[i] = valid ? cv + (pv - cv) * mv : 0.f;
                xw[i] = tanhf(cw + (pw - cw) * mw); xa[i] = ca + (pa - ca) * ma;
                pr = cr; pk = ck; pv = cv; pw = cw; pa = ca;
            }
#pragma unroll
            for (int i = 0; i < 8; ++i) { SL(8)[(t0 + i) * RP + l] = (bf16)f2bf(xw[i]); SL(9)[(t0 + i) * RP + l] = (bf16)f2bf(xa[i]); }
            {
                const int k = tid >> 3, pc = tid & 7;
                *(LAS v4u*)(SL(10) + k * RP + 8 * pc) = *(const v4u*)(WdT + (size_t)(h * 64 + k) * 64 + 8 * pc);
                *(LAS v4u*)(SL(11) + k * RP + 8 * pc) = *(const v4u*)(WaT + (size_t)(h * 64 + k) * 64 + 8 * pc);
            }
        }
        __syncthreads();
        {
            const int pid = w >> 2, q = w & 3, qr = q >> 1, qc = q & 1;
            f32x16 acc = zero16();
            quad_mma(acc, SL(10 + pid), SL(8 + pid), qr, qc, l);
            LAS float* Zf = pid ? AL : WL;
            const int r = l & 31, hf = l >> 5;
#pragma unroll
            for (int jj = 0; jj < 4; ++jj) *(LAS f32x4*)(Zf + (32 * qc + r) * FP + 32 * qr + 8 * jj + 4 * hf) = (f32x4){acc[4 * jj], acc[4 * jj + 1], acc[4 * jj + 2], acc[4 * jj + 3]};
        }
        __syncthreads();
        float lw[8], asg[8];
        {
            const float w0c = F.in[IN_W0][ch], a0c = F.in[IN_A0][ch];
            float run = 0.f;
#pragma unroll
            for (int i = 0; i < 8; ++i) {
                const int t = 8 * w + i; const bool valid = !meta || t < NMETA;
                const float x = -(WL[t * FP + l] + w0c);
                const float sp = x > 20.f ? x : log1pf(__expf(x));
                const float e = -__expf(-sp - 0.5f);
                run += valid ? e : 0.f; lw[i] = run;
                asg[i] = sigmoidf_(AL[t * FP + l] + a0c);
            }
            OT[w * 64 + l] = run;
        }
        __syncthreads();
        {
            float off = 0.f, tot = 0.f;
#pragma unroll
            for (int ww = 0; ww < 8; ++ww) { const float o = OT[ww * 64 + l]; tot += o; off += ww < w ? o : 0.f; }
            if (w == 0) GL[l] = __expf(tot);
            const float kkc = F.in[IN_KK][ch], kac = F.in[IN_KA][ch], rkc = F.in[IN_RK][ch];
            unsigned atc[4], vc[4], bhc[4], khc[4];
            float prevlg = off;
#pragma unroll
            for (int i = 0; i < 8; ++i) {
                const int t = 8 * w + i;
                const float lg = off + lw[i];
                const float g = __expf(lg), gp = __expf(prevlg), gi = __expf(-lg), gh = __expf(tot - lg);
                prevlg = lg;
                const float kkr = k_s[i] * kkc;
                const float nrm = sqrtf(wave_sum(kkr * kkr));
                const float kk = kkr / fmaxf(nrm, 1e-12f);
                const float k2 = k_s[i] * (1.f + (asg[i] - 1.f) * kac);
                const float bon = wave_sum(r_s[i] * k2 * rkc);
                if (l == 0) BONUS[(size_t)u * 64 + t] = bon;
                const float at = -kk * gp, rt = r_s[i] * g, bt = kk * asg[i] * gi, kt = k2 * gi, bh = kk * asg[i] * gh, kh = k2 * gh;
                SL(0)[t * RP + l] = (bf16)f2bf(at); SL(1)[t * RP + l] = (bf16)f2bf(rt); SL(2)[t * RP + l] = (bf16)f2bf(bt); SL(3)[t * RP + l] = (bf16)f2bf(kt);
                const unsigned ua = f2bf(at), uv = f2bf(v_s[i]), ub = f2bf(bh), uk = f2bf(kh);
                if (i & 1) { atc[i >> 1] |= ua << 16; vc[i >> 1] |= uv << 16; bhc[i >> 1] |= ub << 16; khc[i >> 1] |= uk << 16; }
                else { atc[i >> 1] = ua; vc[i >> 1] = uv; bhc[i >> 1] = ub; khc[i >> 1] = uk; }
            }
            *(LAS v4u*)(SL(4) + l * RP + 8 * w) = (v4u){atc[0], atc[1], atc[2], atc[3]};
            *(LAS v4u*)(SL(5) + l * RP + 8 * w) = (v4u){vc[0], vc[1], vc[2], vc[3]};
            *(LAS v4u*)(SL(6) + l * RP + 8 * w) = (v4u){bhc[0], bhc[1], bhc[2], bhc[3]};
            *(LAS v4u*)(SL(7) + l * RP + 8 * w) = (v4u){khc[0], khc[1], khc[2], khc[3]};
        }
        __syncthreads();
        for (int task = w; task < 20; task += 8) {
            const int pid = task >> 2, q = task & 3, qr = q >> 1, qc = q & 1;
            const int bop = pid == 0 ? 0 : pid == 1 ? 2 : pid == 2 ? 0 : 1;
            const int aop = pid == 0 ? 2 : pid == 1 ? 0 : pid == 2 ? 3 : pid == 3 ? 2 : 3;
            f32x16 acc = zero16();
            quad_mma(acc, SL(aop), SL(bop), qr, qc, l);
            const int n = 32 * qc + (l & 31), hf = l >> 5;
#pragma unroll
            for (int j = 0; j < 16; ++j) {
                const int m = ACC_M(qr, j, hf);
                const bool keep = pid == 1 ? (m > n) : (pid <= 2 ? (n > m) : (n >= m));
                acc[j] = keep ? acc[j] : 0.f;
            }
            store_T(acc, SL(8 + pid), qr, qc, l);
        }
        __syncthreads();
        const int nq = w & 3, nqr = nq >> 1, nqc = nq & 1;
        f32x16 nacc = zero16();
        if (w < 4) { add_T(nacc, SL(8), nqr, nqc, l); }
        for (int task = w; task < 12; task += 8) {
            const int pid = task >> 2, q = task & 3, qr = q >> 1, qc = q & 1;
            f32x16 acc = zero16();
            if (pid == 0) { quad_mma(acc, SL(9), SL(8), qr, qc, l); store_T(acc, SL(0), qr, qc, l); }
            else if (pid == 1) { quad_mma(acc, SL(8), SL(9), qr, qc, l); store_T(acc, SL(2), qr, qc, l); }
            else { quad_mma(acc, SL(10), SL(5), qr, qc, l); store_T(acc, SL(3), qr, qc, l); }
        }
        __syncthreads();
#pragma unroll
        for (int st = 0; st < 4; ++st) {
            const int pr = (st & 1) ? 10 : 0, pc = (st & 1) ? 13 : 2, pr2 = (st & 1) ? 0 : 10, pc2 = (st & 1) ? 2 : 13, nr = (st & 1) ? 9 : 8, nr2 = (st & 1) ? 8 : 9;
            if (w < 4) {
                add_T(nacc, SL(pr), nqr, nqc, l);
                quad_mma(nacc, SL(pc), SL(nr), nqr, nqc, l);
                store_T(nacc, SL(nr2), nqr, nqc, l);
                f32x16 acc = zero16();
                quad_mma(acc, SL(pc), SL(pr), nqr, nqc, l); store_T(acc, SL(pr2), nqr, nqc, l);
            } else {
                f32x16 acc = zero16();
                quad_mma(acc, SL(pr), SL(pc), nqr, nqc, l); store_T(acc, SL(pc2), nqr, nqc, l);
            }
            __syncthreads();
        }
        if (w < 4) { add_T(nacc, SL(0), nqr, nqc, l); quad_mma(nacc, SL(2), SL(8), nqr, nqc, l); store_T(nacc, SL(9), nqr, nqc, l); }
        __syncthreads();
        {
            const int pid = w >> 2;
            f32x16 acc = zero16();
            add_T(acc, SL(pid ? 3 : 4), nqr, nqc, l);
            quad_mma(acc, SL(9), SL(pid ? 3 : 4), nqr, nqc, l);
            store_T(acc, SL(pid ? 2 : 0), nqr, nqc, l);
        }
        __syncthreads();
        for (int task = w; task < 16; task += 8) {
            const int pid = task >> 2, q = task & 3, qr = q >> 1, qc = q & 1;
            f32x16 acc = zero16();
            if (pid == 0) { add_T(acc, SL(1), qr, qc, l); quad_mma(acc, SL(0), SL(11), qr, qc, l); store_T_global(acc, RWQ + (size_t)u * 4096, qr, qc, l); }
            else if (pid == 1) { quad_mma(acc, SL(2), SL(11), qr, qc, l); quad_mma(acc, SL(5), SL(12), qr, qc, l); store_T_global(acc, RWY + (size_t)u * 4096, qr, qc, l); }
            else if (pid == 2) {
                quad_mma(acc, SL(0), SL(6), qr, qc, l);
                const int n = 32 * qc + (l & 31), hf = l >> 5; const float gl = GL[n];
#pragma unroll
                for (int j = 0; j < 16; ++j) acc[j] += (ACC_M(qr, j, hf) == n) ? gl : 0.f;
                store_T_global(acc, RWM + (size_t)u * 4096, qr, qc, l);
            } else { quad_mma(acc, SL(6), SL(2), qr, qc, l); quad_mma(acc, SL(7), SL(5), qr, qc, l); store_T_global(acc, RWN + (size_t)u * 4096, qr, qc, l); }
        }
    }
#undef SL
}

__device__ __forceinline__ void rw_b2(Frame& F) {
    if (blockIdx.x >= 32) return;
    const bf16* RWM = WSP(bf16, WS_RWM); const bf16* RWN = WSP(bf16, WS_RWN);
    bf16* RWS = (bf16*)((char*)F.out + OUT_RWS);
    const int b = blockIdx.x >> 3, h = blockIdx.x & 7, w = F.wave, l = F.lane;
    LAS unsigned char* L = F.lds;
#define SS(buf, part) ((LAS bf16*)(L + ((buf) * 2 + (part)) * SLOT))
    const int q = w & 3, qr = q >> 1, qc = q & 1, r = l & 31, hf = l >> 5;
    if (w < 4) {
        const bf16* Nm = RWN + (size_t)(4096 + h) * 4096;
#pragma unroll
        for (int jj = 0; jj < 4; ++jj) {
            const v2u wv = *(const v2u*)(Nm + (32 * qc + r) * 64 + 32 * qr + 8 * jj + 4 * hf);
            *(LAS v2u*)(SS(0, 0) + (32 * qc + r) * RP + 32 * qr + 8 * jj + 4 * hf) = wv;
            *(LAS v2u*)(SS(0, 1) + (32 * qc + r) * RP + 32 * qr + 8 * jj + 4 * hf) = (v2u){0u, 0u};
        }
    }
    __syncthreads();
    bf16x8 a_cur[4]; v2u n_cur[4];
    {
        const size_t u0 = (size_t)(b * 8 + h) * 128;
#pragma unroll
        for (int ks = 0; ks < 4; ++ks) a_cur[ks] = *(const bf16x8*)(RWM + u0 * 4096 + (32 * qr + r) * 64 + 8 * hf + 16 * ks);
#pragma unroll
        for (int jj = 0; jj < 4; ++jj) n_cur[jj] = *(const v2u*)(RWN + u0 * 4096 + (32 * qc + r) * 64 + 32 * qr + 8 * jj + 4 * hf);
    }
    for (int c = 0; c < 128; ++c) {
        const int u = (b * 8 + h) * 128 + c, cur = c & 1;
        if (w < 4) {
            bf16x8 a_nxt[4]; v2u n_nxt[4];
            const size_t un = (size_t)(c + 1 < 128 ? u + 1 : u);
#pragma unroll
            for (int ks = 0; ks < 4; ++ks) a_nxt[ks] = *(const bf16x8*)(RWM + un * 4096 + (32 * qr + r) * 64 + 8 * hf + 16 * ks);
#pragma unroll
            for (int jj = 0; jj < 4; ++jj) n_nxt[jj] = *(const v2u*)(RWN + un * 4096 + (32 * qc + r) * 64 + 32 * qr + 8 * jj + 4 * hf);
            f32x16 acc;
#pragma unroll
            for (int jj = 0; jj < 4; ++jj) { acc[4 * jj] = bflo(n_cur[jj].x); acc[4 * jj + 1] = bfhi(n_cur[jj].x); acc[4 * jj + 2] = bflo(n_cur[jj].y); acc[4 * jj + 3] = bfhi(n_cur[jj].y); }
#pragma unroll
            for (int jj = 0; jj < 4; ++jj)
                *(v2u*)(RWS + (size_t)u * 4096 + (32 * qc + r) * 64 + 32 * qr + 8 * jj + 4 * hf) = *(const LAS v2u*)(SS(cur, 0) + (32 * qc + r) * RP + 32 * qr + 8 * jj + 4 * hf);
            const LAS bf16* bh = SS(cur, 0) + (32 * qc + r) * RP + 8 * hf; const LAS bf16* bl = SS(cur, 1) + (32 * qc + r) * RP + 8 * hf;
#pragma unroll
            for (int ks = 0; ks < 4; ++ks) {
                acc = __builtin_amdgcn_mfma_f32_32x32x16_bf16(a_cur[ks], *(const LAS bf16x8*)(bh + 16 * ks), acc, 0, 0, 0);
                acc = __builtin_amdgcn_mfma_f32_32x32x16_bf16(a_cur[ks], *(const LAS bf16x8*)(bl + 16 * ks), acc, 0, 0, 0);
            }
#pragma unroll
            for (int jj = 0; jj < 4; ++jj) {
                float hi[4], lo[4];
#pragma unroll
                for (int e = 0; e < 4; ++e) { const unsigned hb = f2bf(acc[4 * jj + e]); hi[e] = __uint_as_float(hb << 16); lo[e] = acc[4 * jj + e] - hi[e]; }
                *(LAS v2u*)(SS(cur ^ 1, 0) + (32 * qc + r) * RP + 32 * qr + 8 * jj + 4 * hf) = (v2u){pk2(hi[0], hi[1]), pk2(hi[2], hi[3])};
                *(LAS v2u*)(SS(cur ^ 1, 1) + (32 * qc + r) * RP + 32 * qr + 8 * jj + 4 * hf) = (v2u){pk2(lo[0], lo[1]), pk2(lo[2], lo[3])};
            }
#pragma unroll
            for (int ks = 0; ks < 4; ++ks) a_cur[ks] = a_nxt[ks];
#pragma unroll
            for (int jj = 0; jj < 4; ++jj) n_cur[jj] = n_nxt[jj];
        }
        __syncthreads();
    }
#undef SS
}

__device__ __forceinline__ void rw_b3(Frame& F) {
    const bf16* P = WSP(bf16, WS_P); bf16* QA = WSP(bf16, WS_QA);
    const bf16* RWQ = WSP(bf16, WS_RWQ); const bf16* RWY = WSP(bf16, WS_RWY);
    const bf16* RWS = (const bf16*)((const char*)F.out + OUT_RWS); const float* BONUS = (const float*)((const char*)F.out + OUT_BONUS);
    const bf16* WgT = WSP(bf16, WS_WT_LORA) + 2 * 512 * 64;
    const float* mu = F.in[IN_MU];
    const int l = F.lane, r = l & 31, hf = l >> 5;
    const int gw = blockIdx.x * NWAVES + F.wave, NGW = F.G * NWAVES;
    for (int it = gw; it < NUNITS * 2; it += NGW) {
        const int u = it >> 1, th = it & 1;
        const bool meta = u >= 4096;
        int b = 0, h, c = 0; if (meta) h = u - 4096; else { b = u >> 10; h = (u >> 7) & 7; c = u & 127; }
        if (meta && th == 1) continue;
        const int t = 32 * th + r;
        const bool valid = !meta || t < NMETA;
        const int row0 = meta ? NREAL : b * SEQ + c * 64;
        const int row = valid ? row0 + t : row0;
        int prow = -1;
        if (t > 0) prow = row - 1; else if (!meta) prow = (c == 0) ? NREAL + NMETA - 1 : row - 1;
        f32x16 y[2];
#pragma unroll
        for (int qv = 0; qv < 2; ++qv) {
            const bf16* Y0 = RWY + (size_t)u * 4096 + (32 * th + r) * 64 + 32 * qv + 4 * hf;
#pragma unroll
            for (int jj = 0; jj < 4; ++jj) { const v2u wv = *(const v2u*)(Y0 + 8 * jj); y[qv][4 * jj] = bflo(wv.x); y[qv][4 * jj + 1] = bfhi(wv.x); y[qv][4 * jj + 2] = bflo(wv.y); y[qv][4 * jj + 3] = bfhi(wv.y); }
        }
        if (!meta) {
            const bf16* qp = RWQ + (size_t)u * 4096 + (32 * th + r) * 64 + 8 * hf;
            const bf16* sp = RWS + (size_t)u * 4096 + r * 64 + 8 * hf;
#pragma unroll
            for (int ks = 0; ks < 4; ++ks) {
                const bf16x8 bq = *(const bf16x8*)(qp + 16 * ks);
                y[0] = __builtin_amdgcn_mfma_f32_32x32x16_bf16(*(const bf16x8*)(sp + 16 * ks), bq, y[0], 0, 0, 0);
                y[1] = __builtin_amdgcn_mfma_f32_32x32x16_bf16(*(const bf16x8*)(sp + 32 * 64 + 16 * ks), bq, y[1], 0, 0, 0);
            }
        }
        f32x16 g[2]; g[0] = zero16(); g[1] = zero16();
        {
            const bf16* gp = P + (size_t)row * PW + PC_GD + 8 * hf; const bf16* gpp = prow >= 0 ? P + (size_t)prow * PW + PC_GD + 8 * hf : nullptr;
            const bf16* wp = WgT + (size_t)(h * 64 + r) * 128 + 8 * hf;
#pragma unroll
            for (int ks = 0; ks < 8; ++ks) {
                const v4u cg = *(const v4u*)(gp + 16 * ks); const v4u pg = gpp ? *(const v4u*)(gpp + 16 * ks) : (v4u){0u, 0u, 0u, 0u};
                const f32x4 m0 = *(const f32x4*)(mu + 1664 + 16 * ks + 8 * hf), m1 = *(const f32x4*)(mu + 1664 + 16 * ks + 8 * hf + 4);
                const unsigned cw[4] = {cg.x, cg.y, cg.z, cg.w}, pw[4] = {pg.x, pg.y, pg.z, pg.w}; const float mm[8] = {m0.x, m0.y, m0.z, m0.w, m1.x, m1.y, m1.z, m1.w};
                unsigned o[4];
#pragma unroll
                for (int e = 0; e < 4; ++e) {
                    const float c0 = bflo(cw[e]), c1 = bfhi(cw[e]), p0 = bflo(pw[e]), p1 = bfhi(pw[e]);
                    o[e] = pk2(sigmoidf_(c0 + (p0 - c0) * mm[2 * e]), sigmoidf_(c1 + (p1 - c1) * mm[2 * e + 1]));
                }
                const v4u ov = (v4u){o[0], o[1], o[2], o[3]};
                const bf16x8 bs = __builtin_bit_cast(bf16x8, ov);
                g[0] = __builtin_amdgcn_mfma_f32_32x32x16_bf16(*(const bf16x8*)(wp + 16 * ks), bs, g[0], 0, 0, 0);
                g[1] = __builtin_amdgcn_mfma_f32_32x32x16_bf16(*(const bf16x8*)(wp + 32 * 128 + 16 * ks), bs, g[1], 0, 0, 0);
            }
        }
        float s = 0.f;
#pragma unroll
        for (int j = 0; j < 16; ++j) s += y[0][j] + y[1][j];
        s += __shfl_xor(s, 32);
        const float mean = s * (1.f / 64.f);
        float s2 = 0.f;
#pragma unroll
        for (int j = 0; j < 16; ++j) { const float d0 = y[0][j] - mean, d1 = y[1][j] - mean; s2 += d0 * d0 + d1 * d1; }
        s2 += __shfl_xor(s2, 32);
        const float rstd = 1.0f / sqrtf(s2 * (1.f / 64.f) + GN_EPS);
        const float bon = BONUS[(size_t)u * 64 + t];
        if (valid) {
#pragma unroll
            for (int qv = 0; qv < 2; ++qv)
#pragma unroll
                for (int jj = 0; jj < 4; ++jj) {
                    const int v0 = 32 * qv + 8 * jj + 4 * hf, chv = h * 64 + v0;
                    const v2u cvw = *(const v2u*)(P + (size_t)row * PW + PC_V + chv); const v2u pvw = prow >= 0 ? *(const v2u*)(P + (size_t)prow * PW + PC_V + chv) : (v2u){0u, 0u};
                    const f32x4 mv = *(const f32x4*)(mu + 1024 + chv), gg = *(const f32x4*)(F.in[IN_GN_G] + chv), gb = *(const f32x4*)(F.in[IN_GN_B] + chv);
                    const float cv[4] = {bflo(cvw.x), bfhi(cvw.x), bflo(cvw.y), bfhi(cvw.y)}, pv[4] = {bflo(pvw.x), bfhi(pvw.x), bflo(pvw.y), bfhi(pvw.y)};
                    const float mvv[4] = {mv.x, mv.y, mv.z, mv.w}, ggv[4] = {gg.x, gg.y, gg.z, gg.w}, gbv[4] = {gb.x, gb.y, gb.z, gb.w};
                    float o[4];
#pragma unroll
                    for (int e = 0; e < 4; ++e) {
                        const float vs = cv[e] + (pv[e] - cv[e]) * mvv[e];
                        o[e] = ((y[qv][4 * jj + e] - mean) * rstd * ggv[e] + gbv[e] + bon * vs) * g[qv][4 * jj + e];
                    }
                    *(v2u*)(QA + (size_t)row * QAW + 1024 + chv) = (v2u){pk2(o[0], o[1]), pk2(o[2], o[3])};
                }
        }
    }
}

constexpr int IX_CAP = 512, IX_LIST = 3072, IX_KB = 98304, IX_SCR = RING_BYTES + 4096;
#define IX_FENCE() asm volatile("s_waitcnt lgkmcnt(0)" ::: "memory")

__device__ __forceinline__ unsigned ix_mbcnt(unsigned long long m) { return __builtin_amdgcn_mbcnt_hi((unsigned)(m >> 32), __builtin_amdgcn_mbcnt_lo((unsigned)m, 0u)); }

__device__ __forceinline__ void ix_select_slow(const float (&sc)[8], const unsigned (&ix)[8], bool (&vl)[8], int K, unsigned short* sel_out, int lane) {
    for (int it = 0; it < K; ++it) {
        unsigned long long best = 0ull;
#pragma unroll
        for (int i = 0; i < 8; ++i) { const unsigned long long key = ((unsigned long long)sortable(sc[i]) << 32) | (unsigned long long)(0xFFFFu - ix[i]) | 0x10000ull; if (vl[i] && key > best) best = key; }
        unsigned long long wm = best;
#pragma unroll
        for (int o = 1; o < 64; o <<= 1) { const unsigned long long v = __shfl_xor(wm, o); wm = v > wm ? v : wm; }
        if (wm == 0ull) break;
        const bool mine = best == wm;
#pragma unroll
        for (int i = 0; i < 8; ++i) { const unsigned long long key = ((unsigned long long)sortable(sc[i]) << 32) | (unsigned long long)(0xFFFFu - ix[i]) | 0x10000ull; if (mine && vl[i] && key == wm) { vl[i] = false; sel_out[it] = (unsigned short)ix[i]; } }
    }
}

__device__ __forceinline__ void ix_compact(LAS float* LS, LAS unsigned short* LI, LAS unsigned* hist, int& cnt, float& tau, int lane, bool final_sel, unsigned short* sel_out) {
    const int n = cnt;
    float sc[8]; unsigned ix[8]; bool vl[8];
    IX_FENCE();
#pragma unroll
    for (int i = 0; i < 8; ++i) { const int p = lane + 64 * i; vl[i] = p < n; sc[i] = vl[i] ? LS[p] : -INFINITY; ix[i] = vl[i] ? (unsigned)LI[p] : 0u; }
    float mx = -INFINITY, mn = INFINITY;
#pragma unroll
    for (int i = 0; i < 8; ++i) { if (vl[i]) { mx = fmaxf(mx, sc[i]); mn = fminf(mn, sc[i]); } }
    mx = wave_max(mx); mn = -wave_max(-mn);
    const float scale = mx > mn ? 255.99f / (mx - mn) : 0.f;
    int bin[8];
#pragma unroll
    for (int i = 0; i < 8; ++i) { int bq = (int)((sc[i] - mn) * scale); bq = bq > 255 ? 255 : (bq < 0 ? 0 : bq); bin[i] = vl[i] ? bq : -1; }
    *(LAS v4u*)(hist + 4 * lane) = (v4u){0u, 0u, 0u, 0u};
    IX_FENCE();
#pragma unroll
    for (int i = 0; i < 8; ++i) if (vl[i]) __hip_atomic_fetch_add((LAS unsigned*)&hist[bin[i]], 1u, __ATOMIC_RELAXED, __HIP_MEMORY_SCOPE_WAVEFRONT);
    IX_FENCE();
    const v4u c = *(const LAS v4u*)(hist + 4 * lane);
    const unsigned Pp = wave_scan_incl(c.x + c.y + c.z + c.w, lane);
    const unsigned total = (unsigned)__builtin_amdgcn_readlane((int)Pp, 63);
    const unsigned K = TOPK;
    const unsigned a3 = total - Pp, a2 = a3 + c.w, a1 = a2 + c.z, a0 = a1 + c.y;
    int myb = -1; unsigned myA = 0u, myC = 0u;
    if (a3 < K && K <= a3 + c.w) { myb = 4 * lane + 3; myA = a3; myC = c.w; }
    else if (a2 < K && K <= a2 + c.z) { myb = 4 * lane + 2; myA = a2; myC = c.z; }
    else if (a1 < K && K <= a1 + c.y) { myb = 4 * lane + 1; myA = a1; myC = c.y; }
    else if (a0 < K && K <= a0 + c.x) { myb = 4 * lane; myA = a0; myC = c.x; }
    const unsigned long long bm = __ballot(myb >= 0);
    const int src = bm ? (__ffsll((long long)bm) - 1) : 0;
    const int bstar = __shfl(myb, src); const unsigned A = __shfl(myA, src), m = __shfl(myC, src);
    if (!final_sel) {
        if (A + m <= (unsigned)(IX_CAP - 96)) {
            int base = 0; float kmin = INFINITY;
#pragma unroll
            for (int i = 0; i < 8; ++i) {
                const bool keep = vl[i] && bin[i] >= bstar;
                const unsigned long long mk = __ballot(keep);
                const int pos = base + (int)ix_mbcnt(mk);
                if (keep) { LS[pos] = sc[i]; LI[pos] = (unsigned short)ix[i]; kmin = fminf(kmin, sc[i]); }
                base += __popcll(mk);
            }
            cnt = base; tau = -wave_max(-kmin);
            IX_FENCE();
            return;
        }
        unsigned short* tmp = sel_out;
        ix_select_slow(sc, ix, vl, (int)K, tmp, lane);
        int base = 0; float kmin = INFINITY;
#pragma unroll
        for (int i = 0; i < 8; ++i) {
            const bool keep = !vl[i] && (lane + 64 * i) < n;
            const unsigned long long mk = __ballot(keep);
            const int pos = base + (int)ix_mbcnt(mk);
            if (keep) { LS[pos] = sc[i]; LI[pos] = (unsigned short)ix[i]; kmin = fminf(kmin, sc[i]); }
            base += __popcll(mk);
        }
        cnt = base; tau = -wave_max(-kmin);
        IX_FENCE();
        return;
    }
    if (m <= 128u) {
        int base = 0;
#pragma unroll
        for (int i = 0; i < 8; ++i) {
            const bool keep = vl[i] && bin[i] > bstar;
            const unsigned long long mk = __ballot(keep);
            const int pos = base + (int)ix_mbcnt(mk);
            if (keep) sel_out[pos] = (unsigned short)ix[i];
            base += __popcll(mk);
        }
        LAS float* sS = (LAS float*)hist; LAS unsigned* sI = hist + 128;
        IX_FENCE();
        int mb = 0;
#pragma unroll
        for (int i = 0; i < 8; ++i) {
            const bool inb = vl[i] && bin[i] == bstar;
            const unsigned long long mk = __ballot(inb);
            const int pos = mb + (int)ix_mbcnt(mk);
            if (inb) { sS[pos] = sc[i]; sI[pos] = ix[i]; }
            mb += __popcll(mk);
        }
        IX_FENCE();
        const int need = (int)(K - A);
#pragma unroll
        for (int e = 0; e < 2; ++e) {
            const int j = lane + 64 * e;
            if (j < (int)m) {
                const float sj = sS[j]; const unsigned ij = sI[j]; int rank = 0;
                for (int k = 0; k < (int)m; ++k) { const float sk = sS[k]; const unsigned ik = sI[k]; rank += (sk > sj || (sk == sj && ik < ij)) ? 1 : 0; }
                if (rank < need) sel_out[(int)A + rank] = (unsigned short)ij;
            }
        }
    } else {
        ix_select_slow(sc, ix, vl, (int)K, sel_out, lane);
    }
}

__device__ __forceinline__ void p5_index_mfma(Frame& F, unsigned short* SEL, int* NSEL) {
    const bf16* QA = WSP(bf16, WS_QA); const bf16* KIDX = WSP(bf16, WS_KIDX); const float* WIDX = WSP(float, WS_WIDX);
    const int tid = F.tid, w = F.wave, l = F.lane, r = l & 31, hf = l >> 5;
    {
        const int gw = blockIdx.x * NWAVES + w, NGW = F.G * NWAVES;
        for (int i = gw; i < NMETA + BATCH * 192; i += NGW) {
            int q, nvis; if (i < NMETA) { q = NREAL + i; nvis = NMETA; } else { const int bb = (i - NMETA) / 192, s = (i - NMETA) % 192; q = bb * SEQ + s; nvis = NMETA + 64 * (s / 64 + 1); }
            for (int j = l; j < nvis; j += 64) SEL[(size_t)q * TOPK + j] = (unsigned short)j;
            if (l == 0) NSEL[q] = nvis;
        }
    }
    LAS unsigned char* L = F.lds;
    LAS unsigned* hist = (LAS unsigned*)(L + IX_SCR + w * 1024);
    {
        for (;;) {
            __syncthreads();
            if (tid == 0) F.MISC[16] = __hip_atomic_fetch_add((unsigned*)F.ctl + 3072, 1u, __ATOMIC_RELAXED, __HIP_MEMORY_SCOPE_AGENT);
            __syncthreads();
            const int qi_ = (int)F.MISC[16];
            if (qi_ >= 1000) break;
            const int tile = 999 - qi_;
            const int pt = 6 + (tile >> 2), b = tile & 3;
            const int q0 = b * SEQ + pt * 32;
            const int nvis = NMETA + 64 * (pt / 2 + 1);
            const int nblk = (nvis + 127) >> 7;
            __syncthreads();
            bf16x8 af[4];
            {
                const int qq = 2 * (r >> 4) + ((r >> 2) & 1), hd = 4 * ((r >> 3) & 1) + (r & 3);
                const bf16* qp = QA + (size_t)(q0 + 4 * w + qq) * QAW + 1024 + hd * 64 + 8 * hf;
#pragma unroll
                for (int ks = 0; ks < 4; ++ks) af[ks] = *(const bf16x8*)(qp + 16 * ks);
            }
            float wq[2][8];
#pragma unroll
            for (int a = 0; a < 2; ++a) {
                const f32x4 w0 = *(const f32x4*)(WIDX + (size_t)(q0 + 4 * w + 2 * a + hf) * 8), w1 = *(const f32x4*)(WIDX + (size_t)(q0 + 4 * w + 2 * a + hf) * 8 + 4);
                wq[a][0] = w0.x; wq[a][1] = w0.y; wq[a][2] = w0.z; wq[a][3] = w0.w; wq[a][4] = w1.x; wq[a][5] = w1.y; wq[a][6] = w1.z; wq[a][7] = w1.w;
            }
            float tau0 = -INFINITY, tau1 = -INFINITY;
            int cnt[4] = {0, 0, 0, 0};
            v4u kreg[2];
#pragma unroll
            for (int e = 0; e < 2; ++e) {
                const int pid = tid + 512 * e, kl = pid >> 3, pc = pid & 7, j = kl;
                kreg[e] = j < nvis ? *(const v4u*)(KIDX + (size_t)key_row(b, j) * 64 + 8 * pc) : (v4u){0u, 0u, 0u, 0u};
            }
#pragma unroll
            for (int e = 0; e < 2; ++e) { const int pid = tid + 512 * e, kl = pid >> 3, pc = pid & 7; *(LAS v4u*)(L + IX_KB + kl * 128 + ((pc ^ ((kl >> 1) & 7)) << 4)) = kreg[e]; }
            __syncthreads();
            for (int blk = 0; blk < nblk; ++blk) {
                const int cur = blk & 1;
                if (blk + 1 < nblk) {
#pragma unroll
                    for (int e = 0; e < 2; ++e) {
                        const int pid = tid + 512 * e, kl = pid >> 3, pc = pid & 7, j = (blk + 1) * 128 + kl;
                        kreg[e] = j < nvis ? *(const v4u*)(KIDX + (size_t)key_row(b, j) * 64 + 8 * pc) : (v4u){0u, 0u, 0u, 0u};
                    }
                }
                const LAS unsigned char* kb = L + IX_KB + cur * 16384;
                for (int tt = 0; tt < 4; ++tt) {
                    const int jbase = blk * 128 + tt * 32;
                    if (jbase >= nvis) break;
                    const int kl = tt * 32 + r;
                    f32x16 acc = zero16();
#pragma unroll
                    for (int ks = 0; ks < 4; ++ks) {
                        const bf16x8 bfr = *(const LAS bf16x8*)(kb + kl * 128 + (((2 * ks + hf) ^ ((kl >> 1) & 7)) << 4));
                        acc = __builtin_amdgcn_mfma_f32_32x32x16_bf16(af[ks], bfr, acc, 0, 0, 0);
                    }
                    const int j = jbase + r;
                    float s0 = 0.f, s1 = 0.f;
#pragma unroll
                    for (int h = 0; h < 8; ++h) { s0 += wq[0][h] * fmaxf(acc[h], 0.f); s1 += wq[1][h] * fmaxf(acc[8 + h], 0.f); }
                    s0 += 0.0f; s1 += 0.0f;
                    const bool p0 = j < nvis && s0 > tau0, p1 = j < nvis && s1 > tau1;
                    const unsigned long long m0 = __ballot(p0), m1 = __ballot(p1);
                    if (m0 | m1) {
                        const int c0lo = __popc((unsigned)m0), c0hi = __popc((unsigned)(m0 >> 32)), c1lo = __popc((unsigned)m1), c1hi = __popc((unsigned)(m1 >> 32));
                        {
                            const int pos = (hf ? cnt[1] - c0lo : cnt[0]) + (int)ix_mbcnt(m0);
                            if (p0) { LAS unsigned char* lb = L + (w * 4 + hf) * IX_LIST; ((LAS float*)lb)[pos] = s0; ((LAS unsigned short*)(lb + 2048))[pos] = (unsigned short)j; }
                        }
                        {
                            const int pos = (hf ? cnt[3] - c1lo : cnt[2]) + (int)ix_mbcnt(m1);
                            if (p1) { LAS unsigned char* lb = L + (w * 4 + 2 + hf) * IX_LIST; ((LAS float*)lb)[pos] = s1; ((LAS unsigned short*)(lb + 2048))[pos] = (unsigned short)j; }
                        }
                        cnt[0] += c0lo; cnt[1] += c0hi; cnt[2] += c1lo; cnt[3] += c1hi;
#pragma unroll
                        for (int qq = 0; qq < 4; ++qq) {
                            if (cnt[qq] > IX_CAP - 32) {
                                LAS unsigned char* lb = L + (w * 4 + qq) * IX_LIST;
                                float tq = 0.f; int cq = cnt[qq];
                                ix_compact((LAS float*)lb, (LAS unsigned short*)(lb + 2048), hist, cq, tq, l, false, SEL + (size_t)(q0 + 4 * w + qq) * TOPK);
                                cnt[qq] = __builtin_amdgcn_readfirstlane(cq);
                                if ((qq & 1) == hf) { if (qq < 2) tau0 = tq; else tau1 = tq; }
                            }
                        }
                    }
                }
                if (blk + 1 < nblk) {
#pragma unroll
                    for (int e = 0; e < 2; ++e) { const int pid = tid + 512 * e, kl = pid >> 3, pc = pid & 7; *(LAS v4u*)(L + IX_KB + (cur ^ 1) * 16384 + kl * 128 + ((pc ^ ((kl >> 1) & 7)) << 4)) = kreg[e]; }
                }
                __syncthreads();
            }
#pragma unroll
            for (int qq = 0; qq < 4; ++qq) {
                LAS unsigned char* lb = L + (w * 4 + qq) * IX_LIST;
                float tq = 0.f; int cq = cnt[qq];
                ix_compact((LAS float*)lb, (LAS unsigned short*)(lb + 2048), hist, cq, tq, l, true, SEL + (size_t)(q0 + 4 * w + qq) * TOPK);
                if (l == 0) NSEL[q0 + 4 * w + qq] = TOPK;
            }
        }
    }
}

#ifndef CHECK_IDX
#define CHECK_IDX 0
#endif
#if CHECK_IDX
__device__ __forceinline__ void idx_check(Frame& F) {
    const unsigned short* SEL = WSP(unsigned short, WS_SEL); const unsigned short* SELB = (const unsigned short*)F.out; const int* NSEL = WSP(int, WS_NSEL); const int* NSELB = (const int*)((const char*)F.out + 32 * MiB);
    LAS unsigned* bm = (LAS unsigned*)(F.lds + F.wave * 2048);
    const int l = F.lane; const int gw = blockIdx.x * NWAVES + F.wave, NGW = F.G * NWAVES;
    unsigned miss = 0, badq = 0, dup = 0;
    for (int q = gw; q < NROWS; q += NGW) {
        for (int i = l; i < 260; i += 64) bm[i] = 0u;
        IX_FENCE();
        const int n = NSEL[q], nb = NSELB[q];
        for (int i = l; i < n; i += 64) { const unsigned j = SEL[(size_t)q * TOPK + i]; atomicOr((unsigned*)&bm[j >> 5], 1u << (j & 31)); }
        IX_FENCE();
        unsigned m = (n != nb) ? 1000u : 0u;
        for (int i = l; i < nb && i < TOPK; i += 64) { const unsigned j = SELB[(size_t)q * TOPK + i]; if (j >= (unsigned)TT) { ++dup; ++m; } else { const unsigned old = atomicAnd((unsigned*)&bm[j >> 5], ~(1u << (j & 31))); if (!((old >> (j & 31)) & 1u)) ++m; } }
        IX_FENCE();
        m = (unsigned)wave_sum((float)m);
        if (l == 0) { miss += m; badq += m ? 1u : 0u; }
    }
    dup = (unsigned)wave_sum((float)dup);
    if (l == 0) { atomicAdd((unsigned*)F.ctl + 2048, miss); atomicAdd((unsigned*)F.ctl + 2049, badq); atomicAdd((unsigned*)F.ctl + 2050, dup); }
}
#endif

typedef short v4i16_t __attribute__((ext_vector_type(4)));
__device__ __forceinline__ unsigned at_off(unsigned row, unsigned ch) { return 256u * row + 16u * (ch ^ (((row & 3u) << 2) | ((row >> 2) & 3u))); }

__device__ __forceinline__ void p6_attn_mfma(Frame& F, bf16* OUTB) {
    bf16* QA = WSP(bf16, WS_QA); const bf16* CKV = WSP(bf16, WS_CKV); const unsigned short* SEL = WSP(unsigned short, WS_SEL); const int* NSEL = WSP(int, WS_NSEL);
    const int l = F.lane, w = F.wave, h16 = l & 15, g = l >> 4;
    LAS unsigned char* tile = F.lds + w * 8192;
    const float slope = h16 < 8 ? __uint_as_float((unsigned)(127 - (h16 + 1)) << 23) : 0.f;
    {
        const int gw = blockIdx.x * NWAVES + w, NGW = F.G * NWAVES;
        for (int q = NROWS + gw; q < R; q += NGW) { bf16* qrow = QA + (size_t)q * QAW; for (int c = l; c < QAW / 8; c += 64) *(v4u*)(qrow + 8 * c) = (v4u){0u, 0u, 0u, 0u}; }
    }
    const int G = F.G;
    int nq_tot, qbase_b, wib, wpb;
    if ((G & 7) == 0) { const int b = (blockIdx.x & 7) >> 1; qbase_b = b * SEQ; nq_tot = SEQ + (b == 0 ? NMETA : 0); wib = (((blockIdx.x >> 3) * 2) + (blockIdx.x & 1)) * NWAVES + w; wpb = (G / 4) * NWAVES; }
    else { qbase_b = 0; nq_tot = NROWS; wib = blockIdx.x * NWAVES + w; wpb = G * NWAVES; }
    for (int qi = wib; qi < nq_tot; qi += wpb) {
        int q, b, pos;
        if ((G & 7) == 0) { if (qi < SEQ) { q = qbase_b + qi; b = q >> 13; pos = NMETA + qi; } else { q = NREAL + (qi - SEQ); b = 0; pos = qi - SEQ; } }
        else { q = qi; if (q < NREAL) { b = q >> 13; pos = NMETA + (q & (SEQ - 1)); } else { b = 0; pos = q - NREAL; } }
        bf16* qrow = QA + (size_t)q * QAW;
        const int nsel = NSEL[q];
        const int nch = (nsel + 31) >> 5;
        const unsigned short* selq = SEL + (size_t)q * TOPK;
        bf16x8 qf[4];
#pragma unroll
        for (int s = 0; s < 4; ++s) { const v4u t = h16 < 8 ? *(const v4u*)(qrow + h16 * 128 + 32 * s + 8 * g) : (v4u){0u, 0u, 0u, 0u}; qf[s] = __builtin_bit_cast(bf16x8, t); }
        float m = -INFINITY, lsum = 0.f;
        f32x4 O[8];
#pragma unroll
        for (int c = 0; c < 8; ++c) O[c] = (f32x4){0.f, 0.f, 0.f, 0.f};
        v4u gr[8];
#pragma unroll
        for (int i = 0; i < 8; ++i) { const int s = g + 4 * i; const int kj = s < nsel ? (int)selq[s] : (int)selq[0]; gr[i] = *(const v4u*)(CKV + (size_t)key_row(b, kj) * 128 + 8 * h16); }
        for (int ck = 0; ck < nch; ++ck) {
            IX_FENCE();
#pragma unroll
            for (int i = 0; i < 8; ++i) *(LAS v4u*)(tile + at_off((unsigned)(g + 4 * i), (unsigned)h16)) = gr[i];
            const v4u kv = *(const v4u*)(selq + 32 * ck + 8 * g);
            if (ck + 1 < nch) {
#pragma unroll
                for (int i = 0; i < 8; ++i) { const int s = 32 * (ck + 1) + g + 4 * i; const int kj = s < nsel ? (int)selq[s] : (int)selq[0]; gr[i] = *(const v4u*)(CKV + (size_t)key_row(b, kj) * 128 + 8 * h16); }
            }
            IX_FENCE();
            f32x4 a0 = (f32x4){0.f, 0.f, 0.f, 0.f}, a1 = a0;
#pragma unroll
            for (int s = 0; s < 4; ++s) {
                const bf16x8 k0 = *(const LAS bf16x8*)(tile + at_off((unsigned)(8 * (h16 >> 2) + (h16 & 3)), (unsigned)(4 * s + g)));
                const bf16x8 k1 = *(const LAS bf16x8*)(tile + at_off((unsigned)(8 * (h16 >> 2) + 4 + (h16 & 3)), (unsigned)(4 * s + g)));
                a0 = __builtin_amdgcn_mfma_f32_16x16x32_bf16(k0, qf[s], a0, 0, 0, 0);
                a1 = __builtin_amdgcn_mfma_f32_16x16x32_bf16(k1, qf[s], a1, 0, 0, 0);
            }
            const unsigned kw[4] = {kv.x, kv.y, kv.z, kv.w};
            float x[8];
#pragma unroll
            for (int j = 0; j < 8; ++j) {
                const int kj = (int)((kw[j >> 1] >> (16 * (j & 1))) & 0xffffu);
                const float lg = (j < 4 ? a0[j & 3] : a1[j & 3]) - slope * fabsf((float)(pos - kj));
                x[j] = (32 * ck + 8 * g + j) < nsel ? lg : -INFINITY;
            }
            float cm = fmaxf(fmaxf(fmaxf(x[0], x[1]), fmaxf(x[2], x[3])), fmaxf(fmaxf(x[4], x[5]), fmaxf(x[6], x[7])));
            cm = fmaxf(cm, __shfl_xor(cm, 16)); cm = fmaxf(cm, __shfl_xor(cm, 32));
            const float mn = fmaxf(m, cm);
            const float alpha = __expf(m - mn);
            float p[8], ps = 0.f;
#pragma unroll
            for (int j = 0; j < 8; ++j) { p[j] = __expf(x[j] - mn); ps += p[j]; }
            ps += __shfl_xor(ps, 16); ps += __shfl_xor(ps, 32);
            lsum = lsum * alpha + ps; m = mn;
            if (__any(alpha != 1.0f)) {
#pragma unroll
                for (int rr = 0; rr < 4; ++rr) { const float sc = __shfl(alpha, 4 * g + rr);
#pragma unroll
                    for (int c = 0; c < 8; ++c) O[c][rr] *= sc; }
            }
            const v4u pw = (v4u){pk2(p[0], p[1]), pk2(p[2], p[3]), pk2(p[4], p[5]), pk2(p[6], p[7])};
            const bf16x8 pf = __builtin_bit_cast(bf16x8, pw);
#pragma unroll
            for (int c = 0; c < 8; ++c) {
                const unsigned qd = (unsigned)(h16 >> 2), pp = (unsigned)(h16 & 3);
                const v4i16_t t0 = __builtin_amdgcn_ds_read_tr16_b64_v4i16((LAS v4i16_t*)(tile + at_off(8u * g + qd, 2u * c + (pp >> 1)) + 8u * (pp & 1u)));
                const v4i16_t t1 = __builtin_amdgcn_ds_read_tr16_b64_v4i16((LAS v4i16_t*)(tile + at_off(8u * g + 4u + qd, 2u * c + (pp >> 1)) + 8u * (pp & 1u)));
                bf16x8 vf; vf[0] = t0[0]; vf[1] = t0[1]; vf[2] = t0[2]; vf[3] = t0[3]; vf[4] = t1[0]; vf[5] = t1[1]; vf[6] = t1[2]; vf[7] = t1[3];
                O[c] = __builtin_amdgcn_mfma_f32_16x16x32_bf16(pf, vf, O[c], 0, 0, 0);
            }
        }
        const float inv = 1.0f / lsum;
#pragma unroll
        for (int rr = 0; rr < 4; ++rr) {
            const float sc = __shfl(inv, 4 * g + rr);
            if (g < 2) {
#pragma unroll
                for (int c = 0; c < 8; ++c) (OUTB + (size_t)q * QAW)[(4 * g + rr) * 128 + 16 * c + h16] = (bf16)f2bf(O[c][rr] * sc);
            }
        }
    }
}
struct StoreBf16 { bf16* O; int ld; __device__ __forceinline__ void operator()(int row, int col, const f32x4& v) const { *(v2u*)(O + (size_t)row * ld + col) = (v2u){pk2(v.x, v.y), pk2(v.z, v.w)}; } };
struct StoreRes1 { const bf16* H; float* out; float* meta; __device__ __forceinline__ void operator()(int row, int col, const f32x4& v) const {
        if (row >= NROWS) return;
        const v2u hw = *(const v2u*)(H + (size_t)row * D + col);
        const f32x4 o = (f32x4){ALPHA * bflo(hw.x) + v.x, ALPHA * bfhi(hw.x) + v.y, ALPHA * bflo(hw.y) + v.z, ALPHA * bfhi(hw.y) + v.w};
        float* dst = row < NREAL ? out + (size_t)row * D + col : meta + (size_t)(row - NREAL) * D + col;
        *(f32x4*)dst = o; } };
struct StoreRes2 { const bf16* H; float* out; __device__ __forceinline__ void operator()(int row, int col, const f32x4& v) const {
        if (row >= NREAL) return;
        const v2u hw = *(const v2u*)(H + (size_t)row * D + col);
        *(f32x4*)(out + (size_t)row * D + col) = (f32x4){ALPHA * bflo(hw.x) + v.x, ALPHA * bfhi(hw.x) + v.y, ALPHA * bflo(hw.y) + v.z, ALPHA * bfhi(hw.y) + v.w}; } };

template <class Fn>
__device__ __forceinline__ void run_gemm(Frame& F, const bf16* A, int lda, const bf16* Bt, int N, int K, const Fn& fn) {
    pg8::Gemm g{A, Bt, R, N, K, lda}; pg8::StaticOrder S; S.init(R, N, F.G, (int)blockIdx.x);
    pg8::EpiFn<Fn> E{fn};
    pg8::gemm_phase<pg8::EpiFn<Fn>, pg8::StaticOrder, true, true>(F.lds + RING_OFF, g, S, E);
}

constexpr int NPHASES = 13;
struct Args { const float* in[32]; float* out; unsigned char* ws; int ph_lo, ph_hi; };
__global__ void __launch_bounds__(NTHR, 2) fwd(Args args) {
    extern __shared__ __attribute__((aligned(16))) unsigned char lds[];
    Frame F;
    F.lds = (LAS unsigned char*)lds;
    F.MISC = (volatile LAS unsigned*)(F.lds + MISC_OFF);
    F.tid = threadIdx.x; F.lane = F.tid & 63; F.wave = __builtin_amdgcn_readfirstlane(F.tid >> 6);
    F.G = gridDim.x;
#pragma unroll
    for (int i = 0; i < 32; ++i) F.in[i] = args.in[i];
    F.out = args.out; F.ws = args.ws;
    F.ctl = (gu32*)(args.ws + WS_CTL);
    for (int u = F.tid; u < (LDS_BYTES - LDSCTL_OFF) / 4; u += NTHR) ((LAS unsigned*)(F.lds + LDSCTL_OFF))[u] = 0u;
    __syncthreads();
    const int lo = args.ph_lo, hi = args.ph_hi;
    XcdBarrier bar; bar.bar = (unsigned*)(F.ctl + CW_BAR); bar.x = 0; bar.st = nullptr;
    if (hi - lo > 1) bar = xcd_barrier_post((unsigned*)(F.ctl + CW_BAR), F.MISC + 8);
#define IN(k) (lo <= (k) && (k) < hi)
#define SEAM(k) do { if (IN(k) && IN((k) + 1)) xcd_barrier(bar); } while (0)
#ifndef PROBE_PH
#define PROBE_PH -1
#endif
#define REP(k) for (int rep_ = 0; rep_ < ((PROBE_PH == (k)) ? 2 : 1); ++rep_)

#ifndef IDX_NAIVE
#define IDX_NAIVE 0
#endif
#ifndef ATTN_NAIVE
#define ATTN_NAIVE 0
#endif
    if (IN(0)) REP(0) { if (rep_) __syncthreads(); p0_weights(F); p1_ln_in(F); } SEAM(0);
    if (IN(1)) REP(1) { if (rep_) __syncthreads(); run_gemm(F, WSP(bf16, WS_H), D, WSP(bf16, WS_WT_IN), PW, D, StoreBf16{WSP(bf16, WS_P), PW}); } SEAM(1);
    if (IN(2)) REP(2) { if (rep_) __syncthreads(); p3_prep(F); } SEAM(2);
    if (IN(3)) REP(3) { if (rep_) __syncthreads(); run_gemm(F, WSP(bf16, WS_CQN), 256, WSP(bf16, WS_WT_QA), QAW, 256, StoreBf16{WSP(bf16, WS_QA), QAW});
#if REFSEL
        refsel_rows(F);
#endif
    } SEAM(3);
    if (IN(4)) REP(4) { if (rep_) __syncthreads(); rw_b1(F); } SEAM(4);
    if (IN(5)) {
        rw_b2(F); __syncthreads();
#if CHECK_IDX
        p5_index_naive(F); __syncthreads(); p5_index_mfma(F, (unsigned short*)F.out, (int*)((char*)F.out + 32 * MiB));
#elif IDX_NAIVE
        p5_index_naive(F);
#else
        p5_index_mfma(F, WSP(unsigned short, WS_SEL), WSP(int, WS_NSEL));
#endif
    } SEAM(5);
    if (IN(6)) {
#if CHECK_IDX
        idx_check(F); __syncthreads();
#endif
#if ATTN_NAIVE
        p6_attn_naive(F);
#else
        p6_attn_mfma(F, WSP(bf16, WS_QA));
#endif
        __syncthreads();
        rw_b3(F);
    } SEAM(6);
    if (IN(7)) REP(7) { if (rep_) __syncthreads(); run_gemm(F, WSP(bf16, WS_QA), QAW, WSP(bf16, WS_WT_MIX), D, QAW, StoreRes1{WSP(bf16, WS_H), F.out, WSP(float, WS_META1)}); } SEAM(7);
    if (IN(8)) REP(8) { if (rep_) __syncthreads(); p10_ln1(F); } SEAM(8);
    if (IN(9)) REP(9) { if (rep_) __syncthreads(); run_gemm(F, WSP(bf16, WS_H), D, WSP(bf16, WS_WT_UP), UPW, D, StoreBf16{WSP(bf16, WS_UP), UPW}); } SEAM(9);
    if (IN(10)) { p12_conv_act(F); } SEAM(10);
    if (IN(11)) REP(11) { if (rep_) __syncthreads(); run_gemm(F, WSP(bf16, WS_UP) + DFF, UPW, WSP(bf16, WS_WT_DN), D, DFF, StoreRes2{WSP(bf16, WS_H), F.out}); } SEAM(11);
    if (IN(12)) { p14_ln2(F);
#if CHECK_IDX
        if (blockIdx.x == 0 && F.tid == 0) {
            const unsigned miss = __hip_atomic_load((unsigned*)F.ctl + 2048, __ATOMIC_RELAXED, __HIP_MEMORY_SCOPE_AGENT), dupc = __hip_atomic_load((unsigned*)F.ctl + 2050, __ATOMIC_RELAXED, __HIP_MEMORY_SCOPE_AGENT);
            if (dupc) F.out[5] = __builtin_inff();
            if (miss > CHECK_IDX_MAXMISS) F.out[3] = __builtin_nanf("");
        }
#endif
    }
#undef IN
#undef SEAM
}

extern "C" void kernel_launch(void* const* d_in, const int* in_sizes, int n_in, void* d_out, int out_size, void* d_ws, size_t ws_size, hipStream_t stream) {
    static int grid = 0;
    if (grid == 0) {
        if (n_in != 32 || out_size != NREAL * D || ws_size < WS_END) { fprintf(stderr, "kernel_launch: unexpected shapes: n_in %d out %d ws %zu\n", n_in, out_size, ws_size); grid = -1; return; }
        int dev = 0, cus = 0, per_cu = 0;
        if (hipGetDevice(&dev) != hipSuccess || hipDeviceGetAttribute(&cus, hipDeviceAttributeMultiprocessorCount, dev) != hipSuccess) { grid = -1; return; }
        if (hipFuncSetAttribute((const void*)fwd, hipFuncAttributeMaxDynamicSharedMemorySize, LDS_BYTES) != hipSuccess) { fprintf(stderr, "kernel_launch: hipFuncSetAttribute failed\n"); grid = -1; return; }
        if (hipOccupancyMaxActiveBlocksPerMultiprocessor(&per_cu, (const void*)fwd, NTHR, LDS_BYTES) != hipSuccess || per_cu < 1) fprintf(stderr, "kernel_launch: occupancy query says %d\n", per_cu);
        (void)hipGetLastError();
        grid = cus;
    }
    if (grid < 0) return;
    (void)hipMemsetAsync((char*)d_ws + WS_CTL, 0, CTL_ZERO_BYTES, stream);
    Args a{};
    for (int i = 0; i < 32; ++i) a.in[i] = (const float*)d_in[i];
    a.out = (float*)d_out; a.ws = (unsigned char*)d_ws;
#if ONE_LAUNCH
    a.ph_lo = 0; a.ph_hi = NPHASES;
    hipLaunchKernelGGL(fwd, dim3(grid), dim3(NTHR), LDS_BYTES, stream, a);
#else
    for (int p = 0; p < NPHASES; ++p) { a.ph_lo = p; a.ph_hi = p + 1; hipLaunchKernelGGL(fwd, dim3(grid), dim3(NTHR), LDS_BYTES, stream, a); }
#endif
}
```

```cpp
#include <hip/hip_runtime.h>
#include <cstdio>
#include <cstdint>
#define ONE_LAUNCH 1
namespace pg8 {
#define PG8_LAS __attribute__((address_space(3)))
typedef unsigned short bf16_t;
typedef short bf16x8 __attribute__((ext_vector_type(8)));
typedef float f32x4 __attribute__((ext_vector_type(4)));
typedef unsigned u32x4 __attribute__((ext_vector_type(4)));
constexpr int BM = 256, BK = 64, HALF = 128, HTB = HALF * BK * 2  , STAGE_BYTES = 8 * HTB, NXCD = 8, WGM = 8;

__host__ __device__ __forceinline__ int lds_byte(int r, int c) { const int st = (r >> 4) * 2 + (c >> 5), rr = r & 15, cc = c & 31, ob = rr * 64 + cc * 2; return st * 1024 + (ob ^ (((ob >> 9) & 1) << 5)); }
__host__ __device__ __forceinline__ void stage_rc(int b, int& R, int& C) { const int st = b / 1024, sb = b % 1024, swz = sb ^ (((sb >> 9) & 1) << 5); R = (st >> 1) * 16 + swz / 64; C = (st & 1) * 32 + (swz % 64) / 2; }
__host__ __device__ __forceinline__ int perm32(int rho) { const int n = rho >> 4, i = rho & 15; return 8 * (i >> 2) + 4 * n + (i & 3); }

struct Unit { int pm, pn; };
struct Gemm { const bf16_t* A; const bf16_t* Bt; int M, N, K, lda; };

struct StaticOrder {
    int nM, nN, nwg, G, c;
    __host__ __device__ void init(int M, int N, int G_, int c_) { nM = M / BM; nN = N / BM; nwg = nM * nN; G = G_; c = c_; }
    __host__ __device__ bool next(int i, Unit& u) const {
        const long L = (long)i * G + c; if (L >= nwg) return false;
        int wgid = (int)L; { const int q = nwg / NXCD, r = nwg % NXCD, xcd = wgid % NXCD, off = wgid / NXCD; wgid = (xcd < r ? xcd * (q + 1) : r * (q + 1) + (xcd - r) * q) + off; }
        const int nig = WGM * nN, gid = wgid / nig, fm = gid * WGM, gsz = (nM - fm) < WGM ? (nM - fm) : WGM;
        u.pm = fm + ((wgid % nig) % gsz); u.pn = (wgid % nig) / gsz; return true;
    }
    __device__ __forceinline__ void a_ready(const Unit&) const {}
    __device__ __forceinline__ void done(const Unit&) const {}
};


template <class F> struct EpiFn {
    static constexpr bool PERM = false, AFTER_DRAIN = false;
    F f;
    __device__ __forceinline__ void operator()(const f32x4 (&acc)[2][2][4][2], const Unit& u, int wr, int wc, int fr, int fq) const {
        const int row0 = u.pm * BM + wr * 64 + fr, col0 = u.pn * BM + wc * 32 + 4 * fq;
#pragma unroll
        for (int ai = 0; ai < 2; ++ai)
#pragma unroll
            for (int m = 0; m < 4; ++m) {
                const int row = row0 + ai * HALF + m * 16;
#pragma unroll
                for (int bj = 0; bj < 2; ++bj)
#pragma unroll
                    for (int n = 0; n < 2; ++n) f(row, col0 + bj * HALF + n * 16, acc[ai][bj][m][n]);
            }
    }
};
template <class Epi, class Sched, bool ALIGN_EPI = false, bool SP2 = false>
__device__ __forceinline__ void gemm_phase(PG8_LAS unsigned char* lds, const Gemm g, const Sched& S, const Epi& E) {
    const int tid = threadIdx.x, wid = __builtin_amdgcn_readfirstlane(tid >> 6), lane = tid & 63, wr = wid >> 2, wc = wid & 3, fr = lane & 15, fq = lane >> 4;
    const int K = g.K, nt = K / BK;
    unsigned voffA[2], voffB[2];
#pragma unroll
    for (int i = 0; i < 2; ++i) { int R, C; stage_rc(tid * 16 + i * 8192, R, C); const int Rb = Epi::PERM ? ((R & ~31) + perm32(R & 31)) : R;
        voffA[i] = (unsigned)(R * g.lda + C) * 2u; voffB[i] = (unsigned)(Rb * K + C) * 2u; }
    const size_t kstep = (size_t)(BK * 2);
    const size_t hA = (size_t)HALF * g.lda * 2, hB = (size_t)HALF * K * 2;
    const size_t tA = 2 * hA, tB = 2 * hB;
    const unsigned ldsw = (unsigned)wid * 1024u;
    const int aoff = lds_byte(wr * 64 + fr, fq * 8), boff = lds_byte(wc * 32 + fr, fq * 8);
#define PG8_SA(b, h) (((b) * 2 + (h)) * HTB)
#define PG8_SB(b, h) ((4 + (b) * 2 + (h)) * HTB)
#define PG8_STAGE(bufoff, gbase, voff) do { _Pragma("unroll") for (int _i = 0; _i < 2; ++_i) \
        __builtin_amdgcn_global_load_lds((const unsigned*)((const char*)(gbase) + (voff)[_i]), (PG8_LAS unsigned*)(lds + (bufoff) + ldsw + _i * 8192), 16, 0, 0); } while (0)
#define PG8_LDA(dst, b, h) do { _Pragma("unroll") for (int m = 0; m < 4; ++m) _Pragma("unroll") for (int k = 0; k < 2; ++k) dst[m][k] = *(const PG8_LAS bf16x8*)(lds + PG8_SA(b, h) + aoff + m * 2048 + k * 1024); } while (0)
#define PG8_LDB(dst, b, h) do { _Pragma("unroll") for (int n = 0; n < 2; ++n) _Pragma("unroll") for (int k = 0; k < 2; ++k) dst[n][k] = *(const PG8_LAS bf16x8*)(lds + PG8_SB(b, h) + boff + n * 2048 + k * 1024); } while (0)
#define PG8_MMA(ai, bj, At, Bt) do { __builtin_amdgcn_s_setprio(1); _Pragma("unroll") for (int m = 0; m < 4; ++m) _Pragma("unroll") for (int n = 0; n < 2; ++n) _Pragma("unroll") for (int k = 0; k < 2; ++k) \
        acc[ai][bj][m][n] = __builtin_amdgcn_mfma_f32_16x16x32_bf16(Bt[n][k], At[m][k], acc[ai][bj][m][n], 0, 0, 0); __builtin_amdgcn_s_setprio(0); } while (0)
#define PG8_WAIT_V(n) asm volatile("s_waitcnt vmcnt(" #n ")" ::: "memory")
#define PG8_WAIT_L(n) asm volatile("s_waitcnt lgkmcnt(" #n ")" ::: "memory")
#define PG8_BAR __builtin_amdgcn_s_barrier()
#define PG8_SCHED __builtin_amdgcn_sched_barrier(0)
    Unit cur, nxt; int ui = 0;
    if (!S.next(0, cur)) return;
    f32x4 acc[2][2][4][2];
#pragma unroll
    for (int a = 0; a < 2; ++a)
#pragma unroll
        for (int b = 0; b < 2; ++b)
#pragma unroll
            for (int m = 0; m < 4; ++m)
#pragma unroll
                for (int n = 0; n < 2; ++n) acc[a][b][m][n] = (f32x4){0.f, 0.f, 0.f, 0.f};
    bf16x8 At[4][2], B0[2][2], B1[2][2];
    const char* cA = (const char*)g.A + (size_t)cur.pm * tA; const char* cB = (const char*)g.Bt + (size_t)cur.pn * tB;
    S.a_ready(cur);
    if constexpr (SP2) {
        PG8_STAGE(PG8_SB(0, 0), cB, voffB); PG8_STAGE(PG8_SB(0, 1), cB + hB, voffB); PG8_STAGE(PG8_SA(0, 0), cA, voffA); PG8_STAGE(PG8_SA(0, 1), cA + hA, voffA);
        if (wr == 1) PG8_BAR;
        PG8_WAIT_V(2); PG8_BAR;
        PG8_STAGE(PG8_SB(1, 0), cB + kstep, voffB); PG8_STAGE(PG8_SA(1, 0), cA + kstep, voffA); PG8_STAGE(PG8_SB(1, 1), cB + hB + kstep, voffB);
        PG8_WAIT_V(6); PG8_BAR;
    } else {
        PG8_STAGE(PG8_SB(0, 0), cB, voffB); PG8_STAGE(PG8_SA(0, 0), cA, voffA); PG8_STAGE(PG8_SB(0, 1), cB + hB, voffB); PG8_STAGE(PG8_SA(0, 1), cA + hA, voffA);
        if (wr == 1) PG8_BAR;
        PG8_WAIT_V(4); PG8_BAR;
        PG8_STAGE(PG8_SB(1, 0), cB + kstep, voffB); PG8_STAGE(PG8_SA(1, 0), cA + kstep, voffA); PG8_STAGE(PG8_SB(1, 1), cB + hB + kstep, voffB);
        PG8_WAIT_V(6); PG8_BAR;
    }
    for (;;) {
        const bool has_next = S.next(ui + 1, nxt);
        const char* nA = has_next ? (const char*)g.A + (size_t)nxt.pm * tA : cA; const char* nB = has_next ? (const char*)g.Bt + (size_t)nxt.pn * tB : cB;
        for (int t = 0; t < nt; t += 2) {
            const bool last = (t == nt - 2);
            const char* a1 = cA + (size_t)(t + 1) * kstep;
            const char* a2 = last ? nA : cA + (size_t)(t + 2) * kstep; const char* b2 = last ? nB : cB + (size_t)(t + 2) * kstep;
            const char* a3 = a2 + kstep; const char* b3 = b2 + kstep;
            if (last && has_next) S.a_ready(nxt);
            if constexpr (SP2) {
            PG8_LDB(B0, 0, 0); PG8_LDB(B1, 0, 1); PG8_SCHED; PG8_LDA(At, 0, 0); PG8_STAGE(PG8_SA(1, 1), a1 + hA, voffA);
            PG8_WAIT_V(8); PG8_WAIT_L(0); PG8_BAR; PG8_MMA(0, 0, At, B0); PG8_MMA(0, 1, At, B1); PG8_BAR; PG8_SCHED;
            PG8_LDA(At, 0, 1); PG8_STAGE(PG8_SB(0, 0), b2, voffB); PG8_STAGE(PG8_SB(0, 1), b2 + hB, voffB); PG8_STAGE(PG8_SA(0, 0), a2, voffA);
            PG8_WAIT_V(8); PG8_WAIT_L(0); PG8_BAR; PG8_MMA(1, 0, At, B0); PG8_MMA(1, 1, At, B1); PG8_BAR; PG8_SCHED;
            PG8_LDB(B0, 1, 0); PG8_LDB(B1, 1, 1); PG8_SCHED; PG8_LDA(At, 1, 0); PG8_STAGE(PG8_SA(0, 1), a2 + hA, voffA);
            PG8_WAIT_V(8); PG8_WAIT_L(0); PG8_BAR; PG8_MMA(0, 0, At, B0); PG8_MMA(0, 1, At, B1); PG8_BAR; PG8_SCHED;
            PG8_LDA(At, 1, 1); PG8_STAGE(PG8_SB(1, 0), b3, voffB); PG8_STAGE(PG8_SB(1, 1), b3 + hB, voffB); PG8_STAGE(PG8_SA(1, 0), a3, voffA);
            PG8_WAIT_V(8); PG8_WAIT_L(0); PG8_BAR; PG8_MMA(1, 0, At, B0); PG8_MMA(1, 1, At, B1); PG8_BAR; PG8_SCHED;
            } else {
            PG8_LDB(B0, 0, 0); PG8_SCHED; PG8_LDA(At, 0, 0); PG8_STAGE(PG8_SA(1, 1), a1 + hA, voffA);
            PG8_WAIT_L(8); PG8_BAR; PG8_WAIT_L(0); PG8_MMA(0, 0, At, B0); PG8_BAR; PG8_SCHED;
            PG8_LDB(B1, 0, 1); PG8_STAGE(PG8_SB(0, 0), b2, voffB);
            PG8_BAR; PG8_WAIT_L(0); PG8_MMA(0, 1, At, B1); PG8_BAR;
            PG8_LDA(At, 0, 1); PG8_STAGE(PG8_SA(0, 0), a2, voffA);
            PG8_BAR; PG8_WAIT_L(0); PG8_MMA(1, 0, At, B0); PG8_BAR; PG8_SCHED;
            PG8_STAGE(PG8_SB(0, 1), b2 + hB, voffB);
            PG8_WAIT_V(6); PG8_BAR; PG8_MMA(1, 1, At, B1); PG8_BAR;
            PG8_LDB(B0, 1, 0); PG8_SCHED; PG8_LDA(At, 1, 0); PG8_STAGE(PG8_SA(0, 1), a2 + hA, voffA);
            PG8_WAIT_L(8); PG8_BAR; PG8_WAIT_L(0); PG8_MMA(0, 0, At, B0); PG8_BAR; PG8_SCHED;
            PG8_LDB(B1, 1, 1); PG8_STAGE(PG8_SB(1, 0), b3, voffB);
            PG8_BAR; PG8_WAIT_L(0); PG8_MMA(0, 1, At, B1); PG8_BAR;
            PG8_LDA(At, 1, 1); PG8_STAGE(PG8_SA(1, 0), a3, voffA);
            PG8_BAR; PG8_WAIT_L(0); PG8_MMA(1, 0, At, B0); PG8_BAR; PG8_SCHED;
            PG8_STAGE(PG8_SB(1, 1), b3 + hB, voffB);
            PG8_WAIT_V(6); PG8_BAR; PG8_MMA(1, 1, At, B1); PG8_BAR;
            }
        }
        if constexpr (ALIGN_EPI) { if (wr == 0) PG8_BAR; }
        if constexpr (!Epi::AFTER_DRAIN) { E(acc, cur, wr, wc, fr, fq); S.done(cur); }
        if (!has_next) break;
#pragma unroll
        for (int a = 0; a < 2; ++a)
#pragma unroll
            for (int b = 0; b < 2; ++b)
#pragma unroll
                for (int m = 0; m < 4; ++m)
#pragma unroll
                    for (int n = 0; n < 2; ++n) acc[a][b][m][n] = (f32x4){0.f, 0.f, 0.f, 0.f};
        cur = nxt; cA = nA; cB = nB; ++ui;
        if constexpr (ALIGN_EPI) { if (wr == 1) PG8_BAR; }
    }
    PG8_WAIT_V(0);
    if constexpr (!ALIGN_EPI) { if (wr == 0) PG8_BAR; }
    PG8_BAR;
    if constexpr (Epi::AFTER_DRAIN) { E.fused(acc, cur, wr, wc, fr, fq, lds, wid, lane); S.done(cur); }
#undef PG8_SA
#undef PG8_SB
#undef PG8_STAGE
#undef PG8_LDA
#undef PG8_LDB
#undef PG8_MMA
#undef PG8_WAIT_V
#undef PG8_WAIT_L
#undef PG8_BAR
#undef PG8_SCHED
}
}

#ifndef ONE_LAUNCH
#define ONE_LAUNCH 0
#endif
constexpr int NWAVES = 8, NTHR = 512;
constexpr int D = 1024, BATCH = 4, SEQ = 8192, NMETA = 16, TT = SEQ + NMETA;
constexpr int NREAL = BATCH * SEQ;
constexpr int NROWS = NREAL + NMETA;
constexpr int R = 33024;
constexpr int PW = 2304;
constexpr int PC_CQ = 0, PC_CKV = 256, PC_KIDX = 384, PC_WIDX = 448, PC_R = 512, PC_K = 1024, PC_V = 1536, PC_WD = 2048, PC_AD = 2112, PC_GD = 2176;
constexpr int QAW = 1536;
constexpr int DFF = 2816, UPW = 5632;
constexpr int TOPK = 256;
constexpr float LN_EPS = 1e-5f, GN_EPS = 64e-5f, ALPHA = 1.18920711500272f;

constexpr size_t MiB = 1u << 20;
constexpr size_t WS_CTL = 0, CTL_ZERO_BYTES = 1 * MiB;
constexpr size_t WS_WT_IN = 1 * MiB, WS_WT_QA = 6 * MiB, WS_WT_MIX = 7 * MiB, WS_WT_UP = 10 * MiB, WS_WT_DN = 21 * MiB;
constexpr size_t WS_META1 = 27 * MiB, WS_NSEL = 28 * MiB, WS_WIDX = 29 * MiB;
constexpr size_t WS_H = 33 * MiB;
constexpr size_t WS_P = 98 * MiB, WS_QA = 244 * MiB, WS_CQN = 341 * MiB, WS_SEL = 341 * MiB, WS_CKV = 358 * MiB, WS_KIDX = 367 * MiB;
constexpr size_t WS_DEC = 372 * MiB, WS_AB = 437 * MiB, WS_GB = 470 * MiB;
constexpr size_t WS_WT_LORA = 26 * MiB + 512 * 1024;
constexpr size_t WS_RWM = 372 * MiB, WS_RWN = 405 * MiB, WS_RWQ = 438 * MiB, WS_RWY = 471 * MiB;
constexpr size_t OUT_RWS = 80 * MiB, OUT_BONUS = 116 * MiB;
constexpr size_t WS_UP = 98 * MiB;
constexpr size_t WS_END = 512 * MiB;
static_assert(WS_P + (size_t)R * PW * 2 <= WS_QA && WS_QA + (size_t)R * QAW * 2 <= WS_CQN && WS_CQN + (size_t)R * 256 * 2 <= WS_CKV && WS_CKV + (size_t)R * 128 * 2 <= WS_KIDX
              && WS_KIDX + (size_t)R * 64 * 2 <= WS_DEC && WS_DEC + (size_t)R * 512 * 4 <= WS_AB && WS_AB + (size_t)R * 512 * 2 <= WS_GB && WS_GB + (size_t)R * 512 * 2 <= WS_END
              && WS_UP + (size_t)R * UPW * 2 <= WS_END && WS_H + (size_t)R * D * 2 <= WS_P && WS_WIDX + (size_t)R * 8 * 4 <= WS_H && WS_NSEL + (size_t)R * 4 <= WS_WIDX, "ws map");
constexpr int CW_BAR = 4096;

constexpr int RING_OFF = 0, RING_BYTES = 131072;
constexpr int LDSCTL_OFF = RING_BYTES, MISC_OFF = LDSCTL_OFF + 320;
constexpr int LDS_BYTES = 147456;

#define GAS __attribute__((address_space(1)))
#define LAS __attribute__((address_space(3)))
typedef unsigned short bf16;
typedef unsigned v4u __attribute__((ext_vector_type(4)));
typedef unsigned v2u __attribute__((ext_vector_type(2)));
typedef float f32x4 __attribute__((ext_vector_type(4)));
typedef GAS unsigned gu32;
typedef __bf16 bf16x2_t __attribute__((ext_vector_type(2)));
__device__ __forceinline__ unsigned f2bf(float f) { return (unsigned)__builtin_bit_cast(unsigned short, (__bf16)f); }
__device__ __forceinline__ unsigned pk2(float lo, float hi) { const bf16x2_t v = {(__bf16)lo, (__bf16)hi}; return __builtin_bit_cast(unsigned, v); }
__device__ __forceinline__ float fast_rcp(float x) { return __builtin_amdgcn_rcpf(x); }
__device__ __forceinline__ float fast_tanh(float x) { return 1.0f - 2.0f * __builtin_amdgcn_rcpf(1.0f + __expf(2.0f * x)); }
__device__ __forceinline__ float bf2f(unsigned short b) { return __uint_as_float(((unsigned)b) << 16); }
__device__ __forceinline__ float bflo(unsigned w) { return __uint_as_float(w << 16); }
__device__ __forceinline__ float bfhi(unsigned w) { return __uint_as_float(w & 0xffff0000u); }
#define DPP_F(v, ctrl) __builtin_bit_cast(float, __builtin_amdgcn_update_dpp(0, __builtin_bit_cast(int, (v)), (ctrl), 0xf, 0xf, false))
__device__ __forceinline__ float rdlane_f(float v, int lane) { return __builtin_bit_cast(float, __builtin_amdgcn_readlane(__builtin_bit_cast(int, v), lane)); }
__device__ __forceinline__ float wave_sum(float v) {
    v += DPP_F(v, 0xB1); v += DPP_F(v, 0x4E); v += DPP_F(v, 0x141); v += DPP_F(v, 0x140);
    return (rdlane_f(v, 0) + rdlane_f(v, 16)) + (rdlane_f(v, 32) + rdlane_f(v, 48));
}
__device__ __forceinline__ float wave_max(float v) {
    v = fmaxf(v, DPP_F(v, 0xB1)); v = fmaxf(v, DPP_F(v, 0x4E)); v = fmaxf(v, DPP_F(v, 0x141)); v = fmaxf(v, DPP_F(v, 0x140));
    return fmaxf(fmaxf(rdlane_f(v, 0), rdlane_f(v, 16)), fmaxf(rdlane_f(v, 32), rdlane_f(v, 48)));
}
#define DPP_U0(v, ctrl) ((unsigned)__builtin_amdgcn_update_dpp(0, (int)(v), (ctrl), 0xf, 0xf, true))
__device__ __forceinline__ unsigned wave_scan_incl(unsigned v, int lane) {
    v += DPP_U0(v, 0x111); v += DPP_U0(v, 0x112); v += DPP_U0(v, 0x114); v += DPP_U0(v, 0x118);
    const unsigned r0 = (unsigned)__builtin_amdgcn_readlane((int)v, 15), r1 = (unsigned)__builtin_amdgcn_readlane((int)v, 31), r2 = (unsigned)__builtin_amdgcn_readlane((int)v, 47);
    const int row = lane >> 4;
    return v + (row >= 1 ? r0 : 0u) + (row >= 2 ? r1 : 0u) + (row >= 3 ? r2 : 0u);
}
__device__ __forceinline__ float sigmoidf_(float x) { return __builtin_amdgcn_rcpf(1.0f + __expf(-x)); }
#define XB_TMO      128
#define XB_XCNT(j)  (256  + 64 * (j))
#define XB_XSUB(j)  (1280 + 64 * (j))
#define XB_XGEN(j)  (2304 + 64 * (j))
#define XB_TOP      3328
#define XB_TOPGEN   3392
#define XCD_BAR_WORDS 3456
#define XB_SPIN_CAP (1u << 18)

__device__ __forceinline__ unsigned xb_ld(unsigned* p)              { return __hip_atomic_load(p, __ATOMIC_RELAXED, __HIP_MEMORY_SCOPE_AGENT); }
__device__ __forceinline__ unsigned xb_add(unsigned* p, unsigned v) { return __hip_atomic_fetch_add(p, v, __ATOMIC_RELAXED, __HIP_MEMORY_SCOPE_AGENT); }
__device__ __forceinline__ unsigned xb_xcc_id() { return (unsigned)__builtin_amdgcn_s_getreg((3 << 11) | 20) & 0xFu; }
#define XB_SPIN(cond, bar) do { unsigned _sp = 0; while (cond) { __builtin_amdgcn_s_sleep(1); \
    if ((++_sp & 255u) == 0u) { if (xb_ld(&(bar)[XB_TMO])) break; if (_sp > XB_SPIN_CAP) { atomicAdd(&(bar)[XB_TMO], 1u); break; } } } } while (0)

struct XcdBarrier {
    unsigned* bar; unsigned x;
    volatile LAS unsigned* st;
};

__device__ __forceinline__ XcdBarrier xcd_barrier_post(unsigned* bar, volatile LAS unsigned* st) {
    XcdBarrier b; b.bar = bar; b.x = xb_xcc_id(); b.st = st;
    if (threadIdx.x == 0) (void)xb_add(&bar[XB_XCNT(b.x)], 1u);
    return b;
}
__device__ __forceinline__ void xcd_barrier_complete(unsigned* bar, unsigned x, unsigned& nloc, unsigned& nx) {
    const unsigned G = gridDim.x * gridDim.y * gridDim.z;
    unsigned sum, cnt, mine, sp = 0u;
    for (;;) {
        sum = 0u; cnt = 0u; mine = 0u;
#pragma unroll
        for (unsigned j = 0; j < 16; ++j) { const unsigned c = xb_ld(&bar[XB_XCNT(j)]); sum += c; cnt += (c > 0u) ? 1u : 0u; mine = (j == x) ? c : mine; }
        if (sum == G) break;
        __builtin_amdgcn_s_sleep(1);
        if ((++sp & 255u) == 0u) { if (xb_ld(&bar[XB_TMO])) break; if (sp > XB_SPIN_CAP) { atomicAdd(&bar[XB_TMO], 1u); break; } }
    }
    nloc = mine > 0u ? mine : 1u; nx = cnt > 0u ? cnt : 1u;
}

__device__ __forceinline__ void xcd_barrier(const XcdBarrier& b) {
    asm volatile("s_waitcnt vmcnt(0)" ::: "memory");
    __syncthreads();
    if (threadIdx.x == 0) {
        unsigned* bar = b.bar;
        __builtin_amdgcn_s_waitcnt(0);
        unsigned nloc = b.st[0], nx = b.st[1];
        if (nloc == 0u) { xcd_barrier_complete(bar, b.x, nloc, nx); b.st[0] = nloc; b.st[1] = nx; }
        const unsigned old = xb_add(&bar[XB_XSUB(b.x)], 1u);
        const unsigned gen = old / nloc;
        if (old + 1u == (gen + 1u) * nloc) {
            __builtin_amdgcn_fence(__ATOMIC_RELEASE, "agent");
            asm volatile("s_waitcnt vmcnt(0)" ::: "memory");
            const unsigned og = xb_add(&bar[XB_TOP], 1u);
            const unsigned tg = og / nx;
            if (og + 1u == (tg + 1u) * nx) xb_add(&bar[XB_TOPGEN], 1u);
            else XB_SPIN(xb_ld(&bar[XB_TOPGEN]) == tg, bar);
            __builtin_amdgcn_fence(__ATOMIC_ACQUIRE, "agent");
            xb_add(&bar[XB_XGEN(b.x)], 1u);
            asm volatile("s_waitcnt vmcnt(0)" ::: "memory");
        } else {
            XB_SPIN(xb_ld(&bar[XB_XGEN(b.x)]) == gen, bar);
            __builtin_amdgcn_fence(__ATOMIC_ACQUIRE, "agent");
            asm volatile("s_waitcnt vmcnt(0)" ::: "memory");
        }
    }
    __syncthreads();
}

struct Frame {
    LAS unsigned char* lds;
    volatile LAS unsigned* MISC;
    gu32* ctl;
    int tid, lane, wave, G;
    const float* in[32];
    float* out;
    unsigned char* ws;
};
#define IN_X 0
#define IN_META 1
#define IN_LNIN_G 2
#define IN_LNIN_B 3
#define IN_W_IN 4
#define IN_QNORM_G 5
#define IN_W_UQ 6
#define IN_KVNORM_G 7
#define IN_W_UKV 8
#define IN_W_IQ 9
#define IN_IDXLN_G 10
#define IN_IDXLN_B 11
#define IN_MU 12
#define IN_W0 13
#define IN_W_DEC 14
#define IN_A0 15
#define IN_W_AAA 16
#define IN_W_GATE 17
#define IN_KK 18
#define IN_KA 19
#define IN_RK 20
#define IN_GN_G 21
#define IN_GN_B 22
#define IN_W_OUT 23
#define IN_LN1_G 24
#define IN_LN1_B 25
#define IN_W_UP 26
#define IN_CONV_W 27
#define IN_CONV_B 28
#define IN_W_DN 29
#define IN_LN2_G 30
#define IN_LN2_B 31

#define WSP(T, off) ((T*)(F.ws + (off)))

__device__ __forceinline__ int key_row(int b, int j) { return j < NMETA ? NREAL + j : b * SEQ + (j - NMETA); }

__device__ __forceinline__ void tr_items(Frame& F, const float* src, int src_ld, int src_r0, bf16* dst, int dst_ld, int dst_c0, int Nn, int K, int cut0, int cut1, int shift) {
    const int total = Nn * (K / 8);
    for (int it = blockIdx.x * NTHR + F.tid; it < total; it += F.G * NTHR) {
        const int n = it % Nn, kc = it / Nn;
        const int col = n < cut0 ? n : (n < cut1 ? -1 : n - shift);
        float v[8];
#pragma unroll
        for (int e = 0; e < 8; ++e) v[e] = col >= 0 ? src[(size_t)(src_r0 + 8 * kc + e) * src_ld + col] : 0.f;
        v4u o; o.x = pk2(v[0], v[1]); o.y = pk2(v[2], v[3]); o.z = pk2(v[4], v[5]); o.w = pk2(v[6], v[7]);
        *(v4u*)(dst + (size_t)n * dst_ld + dst_c0 + 8 * kc) = o;
    }
}
__device__ __forceinline__ void p0_weights(Frame& F) {
    bf16* WT_IN = WSP(bf16, WS_WT_IN); bf16* WT_QA = WSP(bf16, WS_WT_QA); bf16* WT_MIX = WSP(bf16, WS_WT_MIX); bf16* WT_UP = WSP(bf16, WS_WT_UP); bf16* WT_DN = WSP(bf16, WS_WT_DN);
    tr_items(F, F.in[IN_W_IN], 2248, 0, WT_IN, D, 0, PW, D, 456, 512, 56);
    tr_items(F, F.in[IN_W_UP], UPW, 0, WT_UP, D, 0, UPW, D, UPW, UPW, 0);
    tr_items(F, F.in[IN_W_DN], D, 0, WT_DN, DFF, 0, D, DFF, D, D, 0);
    tr_items(F, F.in[IN_W_IQ], 512, 0, WT_QA + (size_t)1024 * 256, 256, 0, 512, 256, 512, 512, 0);
    tr_items(F, F.in[IN_W_OUT], D, 512, WT_MIX, 1536, 1024, D, 512, D, D, 0);
    {
        bf16* WdT = WSP(bf16, WS_WT_LORA);
        tr_items(F, F.in[IN_W_DEC], 512, 0, WdT, 64, 0, 512, 64, 512, 512, 0);
        tr_items(F, F.in[IN_W_AAA], 512, 0, WdT + 512 * 64, 64, 0, 512, 64, 512, 512, 0);
        tr_items(F, F.in[IN_W_GATE], 512, 0, WdT + 2 * 512 * 64, 128, 0, 512, 128, 512, 512, 0);
    }
    const float* w_uq = F.in[IN_W_UQ]; const float* w_ukv = F.in[IN_W_UKV]; const float* w_out = F.in[IN_W_OUT];
    for (int it = blockIdx.x * NTHR + F.tid; it < 1024 * 256; it += F.G * NTHR) {
        const int c = it & 255, n = it >> 8, h = n >> 7, j = n & 127;
        float s = 0.f;
        for (int d = 0; d < 64; ++d) s += w_uq[(size_t)c * 512 + h * 64 + d] * w_ukv[(size_t)j * 1024 + h * 128 + d];
        WT_QA[(size_t)n * 256 + c] = (bf16)f2bf(0.125f * s);
    }
    for (int it = blockIdx.x * NTHR + F.tid; it < 1024 * 1024; it += F.G * NTHR) {
        const int n = it & 1023, k = it >> 10, h = k >> 7, j = k & 127;
        float s = 0.f;
        for (int d = 0; d < 64; ++d) s += w_ukv[(size_t)j * 1024 + h * 128 + 64 + d] * w_out[(size_t)(h * 64 + d) * D + n];
        WT_MIX[(size_t)n * 1536 + k] = (bf16)f2bf(s);
    }
}

__device__ __forceinline__ void ln_row_bf16(Frame& F, const float* src, const float* g, const float* b, bf16* dst) {
    v2u* o8 = (v2u*)dst + F.lane;
    if (!src) {
#pragma unroll
        for (int j = 0; j < 4; ++j) o8[64 * j] = (v2u){0u, 0u};
        return;
    }
    const f32x4* xr = (const f32x4*)src + F.lane;
    f32x4 v[4]; float s = 0.f;
#pragma unroll
    for (int j = 0; j < 4; ++j) { v[j] = xr[64 * j]; s += (v[j].x + v[j].y) + (v[j].z + v[j].w); }
    const float mean = wave_sum(s) * (1.f / D); float s2 = 0.f;
#pragma unroll
    for (int j = 0; j < 4; ++j) { v[j] = v[j] - mean; s2 += (v[j].x * v[j].x + v[j].y * v[j].y) + (v[j].z * v[j].z + v[j].w * v[j].w); }
    const float rstd = 1.f / sqrtf(wave_sum(s2) * (1.f / D) + LN_EPS);
#pragma unroll
    for (int j = 0; j < 4; ++j) {
        const f32x4 gg = ((const f32x4*)g)[F.lane + 64 * j], bb = ((const f32x4*)b)[F.lane + 64 * j];
        const f32x4 y = v[j] * rstd * gg + bb;
        o8[64 * j] = (v2u){pk2(y.x, y.y), pk2(y.z, y.w)};
    }
}
__device__ __forceinline__ void p1_ln_in(Frame& F) {
    bf16* H0 = WSP(bf16, WS_H);
    const int gw = blockIdx.x * NWAVES + F.wave, NGW = F.G * NWAVES;
    for (int r = gw; r < R; r += NGW) {
        const float* src = r < NREAL ? F.in[IN_X] + (size_t)r * D : (r < NROWS ? F.in[IN_META] + (size_t)(r - NREAL) * D : nullptr);
        ln_row_bf16(F, src, F.in[IN_LNIN_G], F.in[IN_LNIN_B], H0 + (size_t)r * D);
    }
}

__device__ __forceinline__ void p3_prep(Frame& F) {
    const bf16* P = WSP(bf16, WS_P); bf16* CQN = WSP(bf16, WS_CQN); bf16* CKV = WSP(bf16, WS_CKV); bf16* KIDX = WSP(bf16, WS_KIDX); float* WIDX = WSP(float, WS_WIDX);
    const int gw = blockIdx.x * NWAVES + F.wave, NGW = F.G * NWAVES, l = F.lane;
    for (int r = gw; r < R; r += NGW) {
        const bf16* pr = P + (size_t)r * PW;
        if (r >= NROWS) {
            *(v2u*)(CQN + (size_t)r * 256 + 4 * l) = (v2u){0u, 0u};
            continue;
        }
        {
            const v2u w = *(const v2u*)(pr + PC_CQ + 4 * l);
            const float a0 = bflo(w.x), a1 = bfhi(w.x), a2 = bflo(w.y), a3 = bfhi(w.y);
            const float ss = wave_sum(a0 * a0 + a1 * a1 + a2 * a2 + a3 * a3);
            const float rs = 1.0f / sqrtf(ss * (1.f / 256.f) + 1e-6f);
            const f32x4 g = ((const f32x4*)F.in[IN_QNORM_G])[l];
            *(v2u*)(CQN + (size_t)r * 256 + 4 * l) = (v2u){pk2(a0 * rs * g.x, a1 * rs * g.y), pk2(a2 * rs * g.z, a3 * rs * g.w)};
        }
        {
            const unsigned w = *(const unsigned*)(pr + PC_CKV + 2 * l);
            const float a0 = bflo(w), a1 = bfhi(w);
            const float ss = wave_sum(a0 * a0 + a1 * a1);
            const float rs = 1.0f / sqrtf(ss * (1.f / 128.f) + 1e-6f);
            const float g0 = F.in[IN_KVNORM_G][2 * l], g1 = F.in[IN_KVNORM_G][2 * l + 1];
            *(unsigned*)(CKV + (size_t)r * 128 + 2 * l) = pk2(a0 * rs * g0, a1 * rs * g1);
        }
        {
            const float a = bf2f(pr[PC_KIDX + l]);
            const float mean = wave_sum(a) * (1.f / 64.f);
            const float dlt = a - mean;
            const float var = wave_sum(dlt * dlt) * (1.f / 64.f);
            const float y = dlt * (1.0f / sqrtf(var + LN_EPS)) * F.in[IN_IDXLN_G][l] + F.in[IN_IDXLN_B][l];
            KIDX[(size_t)r * 64 + l] = (bf16)f2bf(y);
        }
        if (l < 8) WIDX[(size_t)r * 8 + l] = bf2f(pr[PC_WIDX + l]) * 0.04419417382415922f;
    }
}

#ifndef REFSEL
#define REFSEL 0
#endif
__device__ __forceinline__ void refsel_rows(Frame& F) {
    float* QIDX32 = F.out; float* KIDX32 = F.out + (size_t)R * 512; float* WIDX = WSP(float, WS_WIDX);
    const float* w_in = F.in[IN_W_IN]; const float* w_iq = F.in[IN_W_IQ];
    LAS float* hrow = (LAS float*)(F.lds + F.wave * 8192);
    LAS float* cqn = hrow + 1024;
    const int l = F.lane;
    const int gw = blockIdx.x * NWAVES + F.wave, NGW = F.G * NWAVES;
    for (int r = gw; r < NROWS; r += NGW) {
        const float* src = r < NREAL ? F.in[IN_X] + (size_t)r * D : F.in[IN_META] + (size_t)(r - NREAL) * D;
        {
            const f32x4* xr = (const f32x4*)src + l;
            f32x4 v[4]; float s = 0.f;
#pragma unroll
            for (int j = 0; j < 4; ++j) { v[j] = xr[64 * j]; s += (v[j].x + v[j].y) + (v[j].z + v[j].w); }
            const float mean = wave_sum(s) * (1.f / D); float s2 = 0.f;
#pragma unroll
            for (int j = 0; j < 4; ++j) { v[j] = v[j] - mean; s2 += (v[j].x * v[j].x + v[j].y * v[j].y) + (v[j].z * v[j].z + v[j].w * v[j].w); }
            const float rstd = 1.f / sqrtf(wave_sum(s2) * (1.f / D) + LN_EPS);
#pragma unroll
            for (int j = 0; j < 4; ++j) {
                const f32x4 gg = ((const f32x4*)F.in[IN_LNIN_G])[l + 64 * j], bb = ((const f32x4*)F.in[IN_LNIN_B])[l + 64 * j];
                *(LAS f32x4*)(hrow + 4 * (l + 64 * j)) = v[j] * rstd * gg + bb;
            }
        }
        __builtin_amdgcn_wave_barrier();
        float a[6];
#pragma unroll
        for (int i = 0; i < 6; ++i) a[i] = 0.f;
        for (int k = 0; k < D; ++k) {
            const float hk = hrow[k]; const float* wr = w_in + (size_t)k * 2248;
#pragma unroll
            for (int i = 0; i < 4; ++i) a[i] += hk * wr[l + 64 * i];
            a[4] += hk * wr[384 + l];
            a[5] += hk * wr[448 + (l & 7)];
        }
        const float ss = wave_sum(a[0] * a[0] + a[1] * a[1] + a[2] * a[2] + a[3] * a[3]);
        const float rs = 1.0f / sqrtf(ss * (1.f / 256.f) + 1e-6f);
#pragma unroll
        for (int i = 0; i < 4; ++i) cqn[l + 64 * i] = a[i] * rs * F.in[IN_QNORM_G][l + 64 * i];
        {
            const float mean = wave_sum(a[4]) * (1.f / 64.f); const float dlt = a[4] - mean;
            const float var = wave_sum(dlt * dlt) * (1.f / 64.f);
            KIDX32[(size_t)r * 64 + l] = dlt * (1.0f / sqrtf(var + LN_EPS)) * F.in[IN_IDXLN_G][l] + F.in[IN_IDXLN_B][l];
        }
        if (l < 8) WIDX[(size_t)r * 8 + l] = a[5] * 0.04419417382415922f;
        __builtin_amdgcn_wave_barrier();
        float q[8];
#pragma unroll
        for (int i = 0; i < 8; ++i) q[i] = 0.f;
        for (int c = 0; c < 256; ++c) {
            const float cq = cqn[c]; const float* wr = w_iq + (size_t)c * 512;
#pragma unroll
            for (int i = 0; i < 8; ++i) q[i] += cq * wr[l + 64 * i];
        }
#pragma unroll
        for (int i = 0; i < 8; ++i) QIDX32[(size_t)r * 512 + l + 64 * i] = q[i];
        __builtin_amdgcn_wave_barrier();
    }
}

__device__ __forceinline__ unsigned sortable(float f) { const unsigned u = __float_as_uint(f); return (u & 0x80000000u) ? ~u : (u | 0x80000000u); }
__device__ __forceinline__ void p5_index_naive(Frame& F) {
    const bf16* QA = WSP(bf16, WS_QA); const bf16* KIDX = WSP(bf16, WS_KIDX); const float* WIDX = WSP(float, WS_WIDX);
    unsigned short* SEL = WSP(unsigned short, WS_SEL); int* NSEL = WSP(int, WS_NSEL);
    LAS float* sc = (LAS float*)(F.lds);
    LAS float* qf = (LAS float*)(F.lds + 33024);
    LAS unsigned* hist = (LAS unsigned*)(F.lds + 33024 + 2048);
    LAS unsigned* cw = hist + 256;
    const int tid = F.tid;
    for (int q = blockIdx.x; q < NROWS; q += F.G) {
        int b, pos; if (q < NREAL) { b = q >> 13; pos = NMETA + (q & (SEQ - 1)); } else { b = 0; pos = q - NREAL; }
        const int nvis = pos < NMETA ? NMETA : NMETA + 64 * ((pos - NMETA) / 64 + 1);
#if REFSEL
        qf[tid] = F.out[(size_t)q * 512 + tid];
#else
        qf[tid] = bf2f(QA[(size_t)q * QAW + 1024 + tid]);
#endif
        float w[8];
#pragma unroll
        for (int h = 0; h < 8; ++h) w[h] = WIDX[(size_t)q * 8 + h];
        __syncthreads();
        for (int j = tid; j < nvis; j += NTHR) {
            const v4u* kp = (const v4u*)(KIDX + (size_t)key_row(b, j) * 64);
#if REFSEL
            const f32x4* kp32 = (const f32x4*)(F.out + (size_t)R * 512 + (size_t)key_row(b, j) * 64);
#endif
            float d[8];
#pragma unroll
            for (int h = 0; h < 8; ++h) d[h] = 0.f;
#pragma unroll 2
            for (int c = 0; c < 8; ++c) {
#if REFSEL
                const f32x4 ta = kp32[2 * c], tb = kp32[2 * c + 1];
                const float k0 = ta.x, k1 = ta.y, k2 = ta.z, k3 = ta.w, k4 = tb.x, k5 = tb.y, k6 = tb.z, k7 = tb.w;
#else
                const v4u t = kp[c];
                const float k0 = bflo(t.x), k1 = bfhi(t.x), k2 = bflo(t.y), k3 = bfhi(t.y), k4 = bflo(t.z), k5 = bfhi(t.z), k6 = bflo(t.w), k7 = bfhi(t.w);
#endif
#pragma unroll
                for (int h = 0; h < 8; ++h) {
                    const f32x4 qa = *(const LAS f32x4*)(qf + h * 64 + 8 * c), qb = *(const LAS f32x4*)(qf + h * 64 + 8 * c + 4);
                    d[h] += qa.x * k0 + qa.y * k1 + qa.z * k2 + qa.w * k3 + qb.x * k4 + qb.y * k5 + qb.z * k6 + qb.w * k7;
                }
            }
            float s = 0.f;
#pragma unroll
            for (int h = 0; h < 8; ++h) s += w[h] * fmaxf(d[h], 0.f);
            sc[j] = s + 0.0f;
        }
        __syncthreads();
        unsigned short* selq = SEL + (size_t)q * TOPK;
        if (nvis <= TOPK) {
            for (int j = tid; j < nvis; j += NTHR) selq[j] = (unsigned short)j;
        } else {
            unsigned prefix = 0u, mask = 0u, need = TOPK;
            for (int pass = 0; pass < 4; ++pass) {
                const int shift = 24 - 8 * pass;
                if (tid < 256) hist[tid] = 0u;
                __syncthreads();
                for (int j = tid; j < nvis; j += NTHR) { const unsigned key = sortable(sc[j]); if ((key & mask) == prefix) atomicAdd((unsigned*)&hist[(key >> shift) & 255u], 1u); }
                __syncthreads();
                if (tid < 256) {
                    unsigned above = 0u; for (int bb = tid + 1; bb < 256; ++bb) above += hist[bb];
                    const unsigned c = hist[tid];
                    if (above < need && need <= above + c) { cw[0] = prefix | ((unsigned)tid << shift); cw[1] = need - above; }
                }
                __syncthreads();
                prefix = cw[0]; need = cw[1]; mask |= 0xFFu << shift;
                __syncthreads();
            }
            if (tid == 0) cw[2] = 0u;
            __syncthreads();
            for (int j = tid; j < nvis; j += NTHR) { if (sortable(sc[j]) > prefix) { const unsigned p = atomicAdd((unsigned*)&cw[2], 1u); selq[p] = (unsigned short)j; } }
            __syncthreads();
            if (F.wave == 0) {
                const unsigned base = cw[2]; unsigned taken = 0u;
                for (int j0 = 0; j0 < nvis && taken < need; j0 += 64) {
                    const int j = j0 + F.lane; const bool eq = j < nvis && sortable(sc[j]) == prefix;
                    const unsigned long long m = __ballot(eq);
                    const unsigned rank = (unsigned)__popcll(m & ((1ull << F.lane) - 1ull));
                    if (eq && taken + rank < need) selq[base + taken + rank] = (unsigned short)j;
                    taken += (unsigned)__popcll(m);
                }
            }
        }
        if (tid == 0) NSEL[q] = nvis < TOPK ? nvis : TOPK;
        __syncthreads();
    }
}

__device__ __forceinline__ void p6_attn_naive(Frame& F) {
    bf16* QA = WSP(bf16, WS_QA); const bf16* CKV = WSP(bf16, WS_CKV); const unsigned short* SEL = WSP(unsigned short, WS_SEL); const int* NSEL = WSP(int, WS_NSEL);
    LAS float* qf = (LAS float*)(F.lds + F.wave * 16384);
    LAS float* ps = qf + 1024;
    LAS int* srow = (LAS int*)(ps + 2048);
    const int l = F.lane;
    const int gw = blockIdx.x * NWAVES + F.wave, NGW = F.G * NWAVES;
    for (int q = gw; q < R; q += NGW) {
        bf16* qrow = QA + (size_t)q * QAW;
        if (q >= NROWS) {
            for (int c = l; c < QAW / 8; c += 64) *(v4u*)(qrow + 8 * c) = (v4u){0u, 0u, 0u, 0u};
            continue;
        }
        int b, pos; if (q < NREAL) { b = q >> 13; pos = NMETA + (q & (SEQ - 1)); } else { b = 0; pos = q - NREAL; }
        const int nsel = NSEL[q];
        {
            const v4u t0 = *(const v4u*)(qrow + 16 * l), t1 = *(const v4u*)(qrow + 16 * l + 8);
            LAS float* d = qf + 16 * l;
            d[0] = bflo(t0.x); d[1] = bfhi(t0.x); d[2] = bflo(t0.y); d[3] = bfhi(t0.y); d[4] = bflo(t0.z); d[5] = bfhi(t0.z); d[6] = bflo(t0.w); d[7] = bfhi(t0.w);
            d[8] = bflo(t1.x); d[9] = bfhi(t1.x); d[10] = bflo(t1.y); d[11] = bfhi(t1.y); d[12] = bflo(t1.z); d[13] = bfhi(t1.z); d[14] = bflo(t1.w); d[15] = bfhi(t1.w);
        }
        __builtin_amdgcn_wave_barrier();
        for (int kk = 0; kk < 4; ++kk) {
            const int s = kk * 64 + l; const bool valid = s < nsel;
            const int j = valid ? (int)SEL[(size_t)q * TOPK + s] : 0;
            const int row = key_row(b, j);
            srow[s] = row;
            float acc[8];
#pragma unroll
            for (int h = 0; h < 8; ++h) acc[h] = 0.f;
            const v4u* kp = (const v4u*)(CKV + (size_t)row * 128);
            for (int c8 = 0; c8 < 16; ++c8) {
                const v4u t = kp[c8];
                const float k0 = bflo(t.x), k1 = bfhi(t.x), k2 = bflo(t.y), k3 = bfhi(t.y), k4 = bflo(t.z), k5 = bfhi(t.z), k6 = bflo(t.w), k7 = bfhi(t.w);
#pragma unroll
                for (int h = 0; h < 8; ++h) {
                    const f32x4 qa = *(const LAS f32x4*)(qf + h * 128 + 8 * c8), qb = *(const LAS f32x4*)(qf + h * 128 + 8 * c8 + 4);
                    acc[h] += qa.x * k0 + qa.y * k1 + qa.z * k2 + qa.w * k3 + qb.x * k4 + qb.y * k5 + qb.z * k6 + qb.w * k7;
                }
            }
            const float dist = fabsf((float)(pos - j));
#pragma unroll
            for (int h = 0; h < 8; ++h) { const float slope = __uint_as_float((unsigned)(127 - (h + 1)) << 23); ps[s * 8 + h] = valid ? acc[h] - slope * dist : -INFINITY; }
        }
        __builtin_amdgcn_wave_barrier();
#pragma unroll
        for (int h = 0; h < 8; ++h) {
            float v0 = ps[(l) * 8 + h], v1 = ps[(l + 64) * 8 + h], v2 = ps[(l + 128) * 8 + h], v3 = ps[(l + 192) * 8 + h];
            const float mx = wave_max(fmaxf(fmaxf(v0, v1), fmaxf(v2, v3)));
            v0 = __expf(v0 - mx); v1 = __expf(v1 - mx); v2 = __expf(v2 - mx); v3 = __expf(v3 - mx);
            const float inv = 1.0f / wave_sum((v0 + v1) + (v2 + v3));
            ps[(l) * 8 + h] = v0 * inv; ps[(l + 64) * 8 + h] = v1 * inv; ps[(l + 128) * 8 + h] = v2 * inv; ps[(l + 192) * 8 + h] = v3 * inv;
        }
        __builtin_amdgcn_wave_barrier();
        float o0[8], o1[8];
#pragma unroll
        for (int h = 0; h < 8; ++h) { o0[h] = 0.f; o1[h] = 0.f; }
        for (int s = 0; s < nsel; ++s) {
            const int row = srow[s];
            const unsigned w = *(const unsigned*)(CKV + (size_t)row * 128 + 2 * l);
            const float c0 = bflo(w), c1 = bfhi(w);
            const f32x4 pa = *(const LAS f32x4*)(ps + s * 8), pb = *(const LAS f32x4*)(ps + s * 8 + 4);
            o0[0] += pa.x * c0; o1[0] += pa.x * c1; o0[1] += pa.y * c0; o1[1] += pa.y * c1; o0[2] += pa.z * c0; o1[2] += pa.z * c1; o0[3] += pa.w * c0; o1[3] += pa.w * c1;
            o0[4] += pb.x * c0; o1[4] += pb.x * c1; o0[5] += pb.y * c0; o1[5] += pb.y * c1; o0[6] += pb.z * c0; o1[6] += pb.z * c1; o0[7] += pb.w * c0; o1[7] += pb.w * c1;
        }
#pragma unroll
        for (int h = 0; h < 8; ++h) *(unsigned*)(qrow + h * 128 + 2 * l) = pk2(o0[h], o1[h]);
        __builtin_amdgcn_wave_barrier();
    }
}

__device__ __forceinline__ void p7_rwkv_prep_naive(Frame& F) {
    const bf16* P = WSP(bf16, WS_P); float* DEC = WSP(float, WS_DEC); bf16* AB = WSP(bf16, WS_AB); bf16* GB = WSP(bf16, WS_GB);
    const float* mu = F.in[IN_MU]; const float* Wd = F.in[IN_W_DEC]; const float* Wa = F.in[IN_W_AAA]; const float* Wg = F.in[IN_W_GATE];
    const int l = F.lane;
    const int gw = blockIdx.x * NWAVES + F.wave, NGW = F.G * NWAVES;
    for (int r = gw; r < NROWS; r += NGW) {
        int prev; if (r < NREAL) { prev = (r & (SEQ - 1)) ? r - 1 : NREAL + NMETA - 1; } else { prev = r > NREAL ? r - 1 : -1; }
        const bf16* pr = P + (size_t)r * PW; const bf16* pp = prev >= 0 ? P + (size_t)prev * PW : nullptr;
#define SHIFTED(pc, mc) (bf2f(pr[pc]) + ((pp ? bf2f(pp[pc]) : 0.f) - bf2f(pr[pc])) * mu[mc])
        const float tw = tanhf(SHIFTED(PC_WD + l, 1536 + l));
        const float ta = SHIFTED(PC_AD + l, 1600 + l);
        const float tg0 = sigmoidf_(SHIFTED(PC_GD + l, 1664 + l)), tg1 = sigmoidf_(SHIFTED(PC_GD + 64 + l, 1728 + l));
#undef SHIFTED
        float aw[8], aa[8], ag[8];
#pragma unroll
        for (int i = 0; i < 8; ++i) { aw[i] = F.in[IN_W0][l + 64 * i]; aa[i] = F.in[IN_A0][l + 64 * i]; ag[i] = 0.f; }
        for (int j = 0; j < 64; ++j) {
            const float xw = __shfl(tw, j), xa = __shfl(ta, j), xg0 = __shfl(tg0, j), xg1 = __shfl(tg1, j);
#pragma unroll
            for (int i = 0; i < 8; ++i) {
                aw[i] += xw * Wd[(size_t)j * 512 + l + 64 * i];
                aa[i] += xa * Wa[(size_t)j * 512 + l + 64 * i];
                ag[i] += xg0 * Wg[(size_t)j * 512 + l + 64 * i] + xg1 * Wg[(size_t)(j + 64) * 512 + l + 64 * i];
            }
        }
#pragma unroll
        for (int i = 0; i < 8; ++i) {
            const float x = -aw[i];
            const float sp = x > 20.f ? x : log1pf(__expf(x));
            const float wlog = -sp - 0.5f;
            DEC[(size_t)r * 512 + l + 64 * i] = __expf(-__expf(wlog));
            AB[(size_t)r * 512 + l + 64 * i] = (bf16)f2bf(sigmoidf_(aa[i]));
            GB[(size_t)r * 512 + l + 64 * i] = (bf16)f2bf(ag[i]);
        }
    }
}

__device__ __forceinline__ void p8_rwkv_scan_naive(Frame& F) {
    if (F.wave != 0 || blockIdx.x >= 32) return;
    const bf16* P = WSP(bf16, WS_P); const float* DEC = WSP(float, WS_DEC); const bf16* AB = WSP(bf16, WS_AB); const bf16* GB = WSP(bf16, WS_GB); bf16* QA = WSP(bf16, WS_QA);
    const int b = blockIdx.x >> 3, h = blockIdx.x & 7, l = F.lane, ch = h * 64 + l;
    LAS float* vec = (LAS float*)F.lds;
    const float mu_r = F.in[IN_MU][ch], mu_k = F.in[IN_MU][512 + ch], mu_v = F.in[IN_MU][1024 + ch];
    const float kk_c = F.in[IN_KK][ch], ka_c = F.in[IN_KA][ch], rk_c = F.in[IN_RK][ch], gng = F.in[IN_GN_G][ch], gnb = F.in[IN_GN_B][ch];
    float S[64];
#pragma unroll
    for (int k = 0; k < 64; ++k) S[k] = 0.f;
    float pr_p = 0.f, pk_p = 0.f, pv_p = 0.f;
    int row = key_row(b, 0);
    float n_pr = bf2f(P[(size_t)row * PW + PC_R + ch]), n_pk = bf2f(P[(size_t)row * PW + PC_K + ch]), n_pv = bf2f(P[(size_t)row * PW + PC_V + ch]);
    float n_w = DEC[(size_t)row * 512 + ch], n_a = bf2f(AB[(size_t)row * 512 + ch]), n_g = bf2f(GB[(size_t)row * 512 + ch]);
    for (int pos = 0; pos < TT; ++pos) {
        const int crow = row;
        const float c_pr = n_pr, c_pk = n_pk, c_pv = n_pv, c_w = n_w, c_a = n_a, c_g = n_g;
        if (pos + 1 < TT) {
            row = key_row(b, pos + 1);
            n_pr = bf2f(P[(size_t)row * PW + PC_R + ch]); n_pk = bf2f(P[(size_t)row * PW + PC_K + ch]); n_pv = bf2f(P[(size_t)row * PW + PC_V + ch]);
            n_w = DEC[(size_t)row * 512 + ch]; n_a = bf2f(AB[(size_t)row * 512 + ch]); n_g = bf2f(GB[(size_t)row * 512 + ch]);
        }
        const float r_s = c_pr + (pr_p - c_pr) * mu_r, k_s = c_pk + (pk_p - c_pk) * mu_k, v_s = c_pv + (pv_p - c_pv) * mu_v;
        pr_p = c_pr; pk_p = c_pk; pv_p = c_pv;
        const float kkr = k_s * kk_c;
        const float nrm = sqrtf(wave_sum(kkr * kkr));
        const float kk = kkr / fmaxf(nrm, 1e-12f);
        const float k2 = k_s * (1.f + (c_a - 1.f) * ka_c);
        vec[l] = -kk; vec[64 + l] = kk * c_a; vec[128 + l] = c_w; vec[192 + l] = k2; vec[256 + l] = r_s;
        __builtin_amdgcn_wave_barrier();
        float sa = 0.f;
#pragma unroll
        for (int k4 = 0; k4 < 16; ++k4) { const f32x4 a = *(const LAS f32x4*)(vec + 4 * k4); sa += S[4 * k4] * a.x + S[4 * k4 + 1] * a.y + S[4 * k4 + 2] * a.z + S[4 * k4 + 3] * a.w; }
        float y = 0.f;
#pragma unroll
        for (int k4 = 0; k4 < 16; ++k4) {
            const f32x4 bv = *(const LAS f32x4*)(vec + 64 + 4 * k4), w = *(const LAS f32x4*)(vec + 128 + 4 * k4), kv = *(const LAS f32x4*)(vec + 192 + 4 * k4), rv = *(const LAS f32x4*)(vec + 256 + 4 * k4);
            S[4 * k4] = S[4 * k4] * w.x + sa * bv.x + v_s * kv.x; S[4 * k4 + 1] = S[4 * k4 + 1] * w.y + sa * bv.y + v_s * kv.y;
            S[4 * k4 + 2] = S[4 * k4 + 2] * w.z + sa * bv.z + v_s * kv.z; S[4 * k4 + 3] = S[4 * k4 + 3] * w.w + sa * bv.w + v_s * kv.w;
            y += S[4 * k4] * rv.x + S[4 * k4 + 1] * rv.y + S[4 * k4 + 2] * rv.z + S[4 * k4 + 3] * rv.w;
        }
        __builtin_amdgcn_wave_barrier();
        const float mean = wave_sum(y) * (1.f / 64.f);
        const float dlt = y - mean;
        const float var = wave_sum(dlt * dlt) * (1.f / 64.f);
        const float yn = dlt * (1.0f / sqrtf(var + GN_EPS)) * gng + gnb;
        const float bonus = wave_sum(r_s * k2 * rk_c) * v_s;
        const float o = (yn + bonus) * c_g;
        if (pos >= NMETA || b == 0) QA[(size_t)crow * QAW + 1024 + ch] = (bf16)f2bf(o);
    }
}

__device__ __forceinline__ void p10_ln1(Frame& F) {
    bf16* H1 = WSP(bf16, WS_H); const float* META1 = WSP(float, WS_META1);
    const int gw = blockIdx.x * NWAVES + F.wave, NGW = F.G * NWAVES;
    for (int r = gw; r < NROWS; r += NGW) {
        const float* src = r < NREAL ? F.out + (size_t)r * D : META1 + (size_t)(r - NREAL) * D;
        ln_row_bf16(F, src, F.in[IN_LN1_G], F.in[IN_LN1_B], H1 + (size_t)r * D);
    }
}
__device__ __forceinline__ void p14_ln2(Frame& F) {
    const int gw = blockIdx.x * NWAVES + F.wave, NGW = F.G * NWAVES;
    const float* g = F.in[IN_LN2_G]; const float* b = F.in[IN_LN2_B];
    for (int r = gw; r < NREAL; r += NGW) {
        f32x4* xr = (f32x4*)(F.out + (size_t)r * D) + F.lane;
        f32x4 v[4]; float s = 0.f;
#pragma unroll
        for (int j = 0; j < 4; ++j) { v[j] = xr[64 * j]; s += (v[j].x + v[j].y) + (v[j].z + v[j].w); }
        const float mean = wave_sum(s) * (1.f / D); float s2 = 0.f;
#pragma unroll
        for (int j = 0; j < 4; ++j) { v[j] = v[j] - mean; s2 += (v[j].x * v[j].x + v[j].y * v[j].y) + (v[j].z * v[j].z + v[j].w * v[j].w); }
        const float rstd = 1.f / sqrtf(wave_sum(s2) * (1.f / D) + LN_EPS);
#pragma unroll
        for (int j = 0; j < 4; ++j) { const f32x4 gg = ((const f32x4*)g)[F.lane + 64 * j], bb = ((const f32x4*)b)[F.lane + 64 * j]; xr[64 * j] = v[j] * rstd * gg + bb; }
    }
}

__device__ __forceinline__ float gelu_fast(float x) {
    const float u2 = x * (1.5957691216057308f + 0.07135481627260025f * x * x);
    return x * __builtin_amdgcn_rcpf(1.0f + __builtin_amdgcn_exp2f(-1.4426950408889634f * u2));
}
__device__ __forceinline__ void p12_conv_act(Frame& F) {
    bf16* UP = WSP(bf16, WS_UP); const float* cw = F.in[IN_CONV_W]; const float* cb = F.in[IN_CONV_B];
    constexpr int NCG = DFF / 8, STRIP = 32, NSTRIP = NREAL / STRIP;
    for (int it = blockIdx.x * NTHR + F.tid; it < NSTRIP * NCG; it += F.G * NTHR) {
        const int cg = it % NCG, st = it / NCG, c = cg * 8, r0 = st * STRIP, s0 = r0 & (SEQ - 1);
        float w0[8], w1[8], w2[8], bb[8];
#pragma unroll
        for (int e = 0; e < 2; ++e) {
            const f32x4 a = *(const f32x4*)(cw + c + 4 * e), b = *(const f32x4*)(cw + DFF + c + 4 * e), d = *(const f32x4*)(cw + 2 * DFF + c + 4 * e), g = *(const f32x4*)(cb + c + 4 * e);
            w0[4 * e] = a.x; w0[4 * e + 1] = a.y; w0[4 * e + 2] = a.z; w0[4 * e + 3] = a.w; w1[4 * e] = b.x; w1[4 * e + 1] = b.y; w1[4 * e + 2] = b.z; w1[4 * e + 3] = b.w;
            w2[4 * e] = d.x; w2[4 * e + 1] = d.y; w2[4 * e + 2] = d.z; w2[4 * e + 3] = d.w; bb[4 * e] = g.x; bb[4 * e + 1] = g.y; bb[4 * e + 2] = g.z; bb[4 * e + 3] = g.w;
        }
        const int rm2 = s0 >= 2 ? r0 - 2 : NREAL + 14, rm1 = s0 >= 1 ? r0 - 1 : NREAL + 15;
        v4u gm2 = *(const v4u*)(UP + (size_t)rm2 * UPW + c), gm1 = *(const v4u*)(UP + (size_t)rm1 * UPW + c);
#pragma unroll 4
        for (int i = 0; i < STRIP; ++i) {
            const size_t ro = (size_t)(r0 + i) * UPW;
            const v4u g0 = *(const v4u*)(UP + ro + c); const v4u vv = *(const v4u*)(UP + ro + DFF + c);
            const unsigned a0[4] = {g0.x, g0.y, g0.z, g0.w}, a1[4] = {gm1.x, gm1.y, gm1.z, gm1.w}, a2[4] = {gm2.x, gm2.y, gm2.z, gm2.w}, av[4] = {vv.x, vv.y, vv.z, vv.w};
            unsigned o[4];
#pragma unroll
            for (int e = 0; e < 4; ++e) {
                const float x0 = w0[2 * e] * bflo(a2[e]) + w1[2 * e] * bflo(a1[e]) + w2[2 * e] * bflo(a0[e]) + bb[2 * e];
                const float x1 = w0[2 * e + 1] * bfhi(a2[e]) + w1[2 * e + 1] * bfhi(a1[e]) + w2[2 * e + 1] * bfhi(a0[e]) + bb[2 * e + 1];
                o[e] = pk2(gelu_fast(x0) * bflo(av[e]), gelu_fast(x1) * bfhi(av[e]));
            }
            *(v4u*)(UP + ro + DFF + c) = (v4u){o[0], o[1], o[2], o[3]};
            gm2 = gm1; gm1 = g0;
        }
    }
}


constexpr int NUNITS = 4096 + 8;
constexpr int RP = 72;
constexpr int SLOT = 64 * RP * 2;
constexpr int FP = 68;
typedef short bf16x8 __attribute__((ext_vector_type(8)));
typedef float f32x16 __attribute__((ext_vector_type(16)));
constexpr size_t RW_MAT = (size_t)NUNITS * 4096;

__device__ __forceinline__ void quad_mma(f32x16& acc, const LAS bf16* Aop, const LAS bf16* Bop, int qr, int qc, int lane) {
    const int r = lane & 31, hf = lane >> 5;
    const LAS bf16* ap = Aop + (32 * qr + r) * RP + 8 * hf; const LAS bf16* bp = Bop + (32 * qc + r) * RP + 8 * hf;
#pragma unroll
    for (int ks = 0; ks < 4; ++ks) {
        const bf16x8 a = *(const LAS bf16x8*)(ap + 16 * ks), b = *(const LAS bf16x8*)(bp + 16 * ks);
        acc = __builtin_amdgcn_mfma_f32_32x32x16_bf16(a, b, acc, 0, 0, 0);
    }
}
#define ACC_M(qr, j, hf) (32 * (qr) + ((j) & 3) + 8 * ((j) >> 2) + 4 * (hf))
__device__ __forceinline__ void store_T(const f32x16& acc, LAS bf16* Z, int qr, int qc, int lane) {
    const int r = lane & 31, hf = lane >> 5;
#pragma unroll
    for (int jj = 0; jj < 4; ++jj)
        *(LAS v2u*)(Z + (32 * qc + r) * RP + 32 * qr + 8 * jj + 4 * hf) = (v2u){pk2(acc[4 * jj], acc[4 * jj + 1]), pk2(acc[4 * jj + 2], acc[4 * jj + 3])};
}
__device__ __forceinline__ void add_T(f32x16& acc, const LAS bf16* Z, int qr, int qc, int lane) {
    const int r = lane & 31, hf = lane >> 5;
#pragma unroll
    for (int jj = 0; jj < 4; ++jj) {
        const v2u w = *(const LAS v2u*)(Z + (32 * qc + r) * RP + 32 * qr + 8 * jj + 4 * hf);
        acc[4 * jj] += bflo(w.x); acc[4 * jj + 1] += bfhi(w.x); acc[4 * jj + 2] += bflo(w.y); acc[4 * jj + 3] += bfhi(w.y);
    }
}
__device__ __forceinline__ void store_T_global(const f32x16& acc, bf16* Z, int qr, int qc, int lane) {
    const int r = lane & 31, hf = lane >> 5;
#pragma unroll
    for (int jj = 0; jj < 4; ++jj)
        *(v2u*)(Z + (32 * qc + r) * 64 + 32 * qr + 8 * jj + 4 * hf) = (v2u){pk2(acc[4 * jj], acc[4 * jj + 1]), pk2(acc[4 * jj + 2], acc[4 * jj + 3])};
}
__device__ __forceinline__ f32x16 zero16() { f32x16 z;
#pragma unroll
    for (int j = 0; j < 16; ++j) z[j] = 0.f;
    return z; }

__device__ __forceinline__ void rw_b1(Frame& F) {
    const bf16* P = WSP(bf16, WS_P);
    bf16* RWM = WSP(bf16, WS_RWM); bf16* RWN = WSP(bf16, WS_RWN); bf16* RWQ = WSP(bf16, WS_RWQ); bf16* RWY = WSP(bf16, WS_RWY);
    float* BONUS = (float*)((char*)F.out + OUT_BONUS);
    const bf16* WdT = WSP(bf16, WS_WT_LORA); const bf16* WaT = WdT + 512 * 64;
    const float* mu = F.in[IN_MU];
    const int w = F.wave, l = F.lane, tid = F.tid;
    LAS unsigned char* L = F.lds;
#define SL(s) ((LAS bf16*)(L + (s) * SLOT))
    LAS float* WL = (LAS float*)(L + 12 * SLOT);
    LAS float* AL = (LAS float*)(L + 0 * SLOT);
    LAS float* OT = (LAS float*)(L + RING_BYTES + 1024);
    LAS float* GL = OT + 512;
    for (int u = blockIdx.x; u < NUNITS; u += F.G) {
        const bool meta = u >= 4096;
        int b = 0, h, c = 0; if (meta) h = u - 4096; else { b = u >> 10; h = (u >> 7) & 7; c = u & 127; }
        const int ch = h * 64 + l;
        const int row0 = meta ? NREAL : b * SEQ + c * 64;
        __syncthreads();
        float r_s[8], k_s[8], v_s[8], xw[8], xa[8];
        {
            float pr, pk, pv, pw, pa;
            const int t0 = 8 * w;
            int prow = -1;
            if (t0 > 0) prow = row0 + t0 - 1; else if (!meta) prow = (c == 0) ? NREAL + NMETA - 1 : row0 - 1;
            if (prow >= 0) { const bf16* pp = P + (size_t)prow * PW; pr = bf2f(pp[PC_R + ch]); pk = bf2f(pp[PC_K + ch]); pv = bf2f(pp[PC_V + ch]); pw = bf2f(pp[PC_WD + l]); pa = bf2f(pp[PC_AD + l]); }
            else { pr = pk = pv = pw = pa = 0.f; }
            const float mr = mu[ch], mk = mu[512 + ch], mv = mu[1024 + ch], mw = mu[1536 + l], ma = mu[1600 + l];
#pragma unroll
            for (int i = 0; i < 8; ++i) {
                const int t = t0 + i; const bool valid = !meta || t < NMETA;
                float cr = 0.f, ck = 0.f, cv = 0.f, cw = 0.f, ca = 0.f;
                if (valid) { const bf16* pp = P + (size_t)(row0 + t) * PW; cr = bf2f(pp[PC_R + ch]); ck = bf2f(pp[PC_K + ch]); cv = bf2f(pp[PC_V + ch]); cw = bf2f(pp[PC_WD + l]); ca = bf2f(pp[PC_AD + l]); }
                r_s[i] = valid ? cr + (pr - cr) * mr : 0.f; k_s[i] = valid ? ck + (pk - ck) * mk : 0.f; v_s[i] = valid ? cv + (pv - cv) * mv : 0.f;
                xw[i] = fast_tanh(cw + (pw - cw) * mw); xa[i] = ca + (pa - ca) * ma;
                pr = cr; pk = ck; pv = cv; pw = cw; pa = ca;
            }
#pragma unroll
            for (int i = 0; i < 8; ++i) { SL(8)[(t0 + i) * RP + l] = (bf16)f2bf(xw[i]); SL(9)[(t0 + i) * RP + l] = (bf16)f2bf(xa[i]); }
            {
                const int k = tid >> 3, pc = tid & 7;
                *(LAS v4u*)(SL(10) + k * RP + 8 * pc) = *(const v4u*)(WdT + (size_t)(h * 64 + k) * 64 + 8 * pc);
                *(LAS v4u*)(SL(11) + k * RP + 8 * pc) = *(const v4u*)(WaT + (size_t)(h * 64 + k) * 64 + 8 * pc);
            }
        }
        __syncthreads();
        {
            const int pid = w >> 2, q = w & 3, qr = q >> 1, qc = q & 1;
            f32x16 acc = zero16();
            quad_mma(acc, SL(10 + pid), SL(8 + pid), qr, qc, l);
            LAS float* Zf = pid ? AL : WL;
            const int r = l & 31, hf = l >> 5;
#pragma unroll
            for (int jj = 0; jj < 4; ++jj) *(LAS f32x4*)(Zf + (32 * qc + r) * FP + 32 * qr + 8 * jj + 4 * hf) = (f32x4){acc[4 * jj], acc[4 * jj + 1], acc[4 * jj + 2], acc[4 * jj + 3]};
        }
        __syncthreads();
        float lw[8], asg[8];
        {
            const float w0c = F.in[IN_W0][ch], a0c = F.in[IN_A0][ch];
            float run = 0.f;
#pragma unroll
            for (int i = 0; i < 8; ++i) {
                const int t = 8 * w + i; const bool valid = !meta || t < NMETA;
                const float x = -(WL[t * FP + l] + w0c);
                const float sp = x > 20.f ? x : __logf(1.0f + __expf(x));
                const float e = -__expf(-sp - 0.5f);
                run += valid ? e : 0.f; lw[i] = run;
                asg[i] = sigmoidf_(AL[t * FP + l] + a0c);
            }
            OT[w * 64 + l] = run;
        }
        __syncthreads();
        {
            float off = 0.f, tot = 0.f;
#pragma unroll
            for (int ww = 0; ww < 8; ++ww) { const float o = OT[ww * 64 + l]; tot += o; off += ww < w ? o : 0.f; }
            if (w == 0) GL[l] = __expf(tot);
            const float kkc = F.in[IN_KK][ch], kac = F.in[IN_KA][ch], rkc = F.in[IN_RK][ch];
            unsigned atc[4], vc[4], bhc[4], khc[4];
            float prevlg = off;
#pragma unroll
            for (int i = 0; i < 8; ++i) {
                const int t = 8 * w + i;
                const float lg = off + lw[i];
                const float g = __expf(lg), gp = __expf(prevlg), gi = __expf(-lg), gh = __expf(tot - lg);
                prevlg = lg;
                const float kkr = k_s[i] * kkc;
                const float kk = kkr * __builtin_amdgcn_rsqf(fmaxf(wave_sum(kkr * kkr), 1e-24f));
                const float k2 = k_s[i] * (1.f + (asg[i] - 1.f) * kac);
                const float bon = wave_sum(r_s[i] * k2 * rkc);
                if (l == 0) BONUS[(size_t)u * 64 + t] = bon;
                const float at = -kk * gp, rt = r_s[i] * g, bt = kk * asg[i] * gi, kt = k2 * gi, bh = kk * asg[i] * gh, kh = k2 * gh;
                SL(0)[t * RP + l] = (bf16)f2bf(at); SL(1)[t * RP + l] = (bf16)f2bf(rt); SL(2)[t * RP + l] = (bf16)f2bf(bt); SL(3)[t * RP + l] = (bf16)f2bf(kt);
                const unsigned ua = f2bf(at), uv = f2bf(v_s[i]), ub = f2bf(bh), uk = f2bf(kh);
                if (i & 1) { atc[i >> 1] |= ua << 16; vc[i >> 1] |= uv << 16; bhc[i >> 1] |= ub << 16; khc[i >> 1] |= uk << 16; }
                else { atc[i >> 1] = ua; vc[i >> 1] = uv; bhc[i >> 1] = ub; khc[i >> 1] = uk; }
            }
            *(LAS v4u*)(SL(4) + l * RP + 8 * w) = (v4u){atc[0], atc[1], atc[2], atc[3]};
            *(LAS v4u*)(SL(5) + l * RP + 8 * w) = (v4u){vc[0], vc[1], vc[2], vc[3]};
            *(LAS v4u*)(SL(6) + l * RP + 8 * w) = (v4u){bhc[0], bhc[1], bhc[2], bhc[3]};
            *(LAS v4u*)(SL(7) + l * RP + 8 * w) = (v4u){khc[0], khc[1], khc[2], khc[3]};
        }
        __syncthreads();
        for (int task = w; task < 20; task += 8) {
            const int pid = task >> 2, q = task & 3, qr = q >> 1, qc = q & 1;
            const int bop = pid == 0 ? 0 : pid == 1 ? 2 : pid == 2 ? 0 : 1;
            const int aop = pid == 0 ? 2 : pid == 1 ? 0 : pid == 2 ? 3 : pid == 3 ? 2 : 3;
            f32x16 acc = zero16();
            quad_mma(acc, SL(aop), SL(bop), qr, qc, l);
            const int n = 32 * qc + (l & 31), hf = l >> 5;
#pragma unroll
            for (int j = 0; j < 16; ++j) {
                const int m = ACC_M(qr, j, hf);
                const bool keep = pid == 1 ? (m > n) : (pid <= 2 ? (n > m) : (n >= m));
                acc[j] = keep ? acc[j] : 0.f;
            }
            store_T(acc, SL(8 + pid), qr, qc, l);
        }
        __syncthreads();
        const int nq = w & 3, nqr = nq >> 1, nqc = nq & 1;
        f32x16 nacc = zero16();
        if (w < 4) { add_T(nacc, SL(8), nqr, nqc, l); }
        for (int task = w; task < 12; task += 8) {
            const int pid = task >> 2, q = task & 3, qr = q >> 1, qc = q & 1;
            f32x16 acc = zero16();
            if (pid == 0) { quad_mma(acc, SL(9), SL(8), qr, qc, l); store_T(acc, SL(0), qr, qc, l); }
            else if (pid == 1) { quad_mma(acc, SL(8), SL(9), qr, qc, l); store_T(acc, SL(2), qr, qc, l); }
            else { quad_mma(acc, SL(10), SL(5), qr, qc, l); store_T(acc, SL(3), qr, qc, l); }
        }
        __syncthreads();
#pragma unroll
        for (int st = 0; st < 4; ++st) {
            const int pr = (st & 1) ? 10 : 0, pc = (st & 1) ? 13 : 2, pr2 = (st & 1) ? 0 : 10, pc2 = (st & 1) ? 2 : 13, nr = (st & 1) ? 9 : 8, nr2 = (st & 1) ? 8 : 9;
            if (w < 4) {
                add_T(nacc, SL(pr), nqr, nqc, l);
                quad_mma(nacc, SL(pc), SL(nr), nqr, nqc, l);
                store_T(nacc, SL(nr2), nqr, nqc, l);
                f32x16 acc = zero16();
                quad_mma(acc, SL(pc), SL(pr), nqr, nqc, l); store_T(acc, SL(pr2), nqr, nqc, l);
            } else {
                f32x16 acc = zero16();
                quad_mma(acc, SL(pr), SL(pc), nqr, nqc, l); store_T(acc, SL(pc2), nqr, nqc, l);
            }
            __syncthreads();
        }
        if (w < 4) { add_T(nacc, SL(0), nqr, nqc, l); quad_mma(nacc, SL(2), SL(8), nqr, nqc, l); store_T(nacc, SL(9), nqr, nqc, l); }
        __syncthreads();
        {
            const int pid = w >> 2;
            f32x16 acc = zero16();
            add_T(acc, SL(pid ? 3 : 4), nqr, nqc, l);
            quad_mma(acc, SL(9), SL(pid ? 3 : 4), nqr, nqc, l);
            store_T(acc, SL(pid ? 2 : 0), nqr, nqc, l);
        }
        __syncthreads();
        for (int task = w; task < 16; task += 8) {
            const int pid = task >> 2, q = task & 3, qr = q >> 1, qc = q & 1;
            f32x16 acc = zero16();
            if (pid == 0) { add_T(acc, SL(1), qr, qc, l); quad_mma(acc, SL(0), SL(11), qr, qc, l); store_T_global(acc, RWQ + (size_t)u * 4096, qr, qc, l); }
            else if (pid == 1) { quad_mma(acc, SL(2), SL(11), qr, qc, l); quad_mma(acc, SL(5), SL(12), qr, qc, l); store_T_global(acc, RWY + (size_t)u * 4096, qr, qc, l); }
            else if (pid == 2) {
                quad_mma(acc, SL(0), SL(6), qr, qc, l);
                const int n = 32 * qc + (l & 31), hf = l >> 5; const float gl = GL[n];
#pragma unroll
                for (int j = 0; j < 16; ++j) acc[j] += (ACC_M(qr, j, hf) == n) ? gl : 0.f;
                store_T_global(acc, RWM + (size_t)u * 4096, qr, qc, l);
            } else { quad_mma(acc, SL(6), SL(2), qr, qc, l); quad_mma(acc, SL(7), SL(5), qr, qc, l); store_T_global(acc, RWN + (size_t)u * 4096, qr, qc, l); }
        }
    }
#undef SL
}

__device__ __forceinline__ void rw_b2(Frame& F) {
    if (blockIdx.x >= 32) return;
    const bf16* RWM = WSP(bf16, WS_RWM); const bf16* RWN = WSP(bf16, WS_RWN);
    bf16* RWS = (bf16*)((char*)F.out + OUT_RWS);
    const int b = blockIdx.x >> 3, h = blockIdx.x & 7, w = F.wave, l = F.lane;
    LAS unsigned char* L = F.lds;
#define SS(buf, part) ((LAS bf16*)(L + ((buf) * 2 + (part)) * SLOT))
    const int q = w & 3, qr = q >> 1, qc = q & 1, r = l & 31, hf = l >> 5;
    if (w < 4) {
        const bf16* Nm = RWN + (size_t)(4096 + h) * 4096;
#pragma unroll
        for (int jj = 0; jj < 4; ++jj) {
            const v2u wv = *(const v2u*)(Nm + (32 * qc + r) * 64 + 32 * qr + 8 * jj + 4 * hf);
            *(LAS v2u*)(SS(0, 0) + (32 * qc + r) * RP + 32 * qr + 8 * jj + 4 * hf) = wv;
            *(LAS v2u*)(SS(0, 1) + (32 * qc + r) * RP + 32 * qr + 8 * jj + 4 * hf) = (v2u){0u, 0u};
        }
    }
    __syncthreads();
    bf16x8 a_cur[4]; v2u n_cur[4];
    {
        const size_t u0 = (size_t)(b * 8 + h) * 128;
#pragma unroll
        for (int ks = 0; ks < 4; ++ks) a_cur[ks] = *(const bf16x8*)(RWM + u0 * 4096 + (32 * qr + r) * 64 + 8 * hf + 16 * ks);
#pragma unroll
        for (int jj = 0; jj < 4; ++jj) n_cur[jj] = *(const v2u*)(RWN + u0 * 4096 + (32 * qc + r) * 64 + 32 * qr + 8 * jj + 4 * hf);
    }
    for (int c = 0; c < 128; ++c) {
        const int u = (b * 8 + h) * 128 + c, cur = c & 1;
        if (w < 4) {
            bf16x8 a_nxt[4]; v2u n_nxt[4];
            const size_t un = (size_t)(c + 1 < 128 ? u + 1 : u);
#pragma unroll
            for (int ks = 0; ks < 4; ++ks) a_nxt[ks] = *(const bf16x8*)(RWM + un * 4096 + (32 * qr + r) * 64 + 8 * hf + 16 * ks);
#pragma unroll
            for (int jj = 0; jj < 4; ++jj) n_nxt[jj] = *(const v2u*)(RWN + un * 4096 + (32 * qc + r) * 64 + 32 * qr + 8 * jj + 4 * hf);
            f32x16 acc;
#pragma unroll
            for (int jj = 0; jj < 4; ++jj) { acc[4 * jj] = bflo(n_cur[jj].x); acc[4 * jj + 1] = bfhi(n_cur[jj].x); acc[4 * jj + 2] = bflo(n_cur[jj].y); acc[4 * jj + 3] = bfhi(n_cur[jj].y); }
#pragma unroll
            for (int jj = 0; jj < 4; ++jj)
                *(v2u*)(RWS + (size_t)u * 4096 + (32 * qc + r) * 64 + 32 * qr + 8 * jj + 4 * hf) = *(const LAS v2u*)(SS(cur, 0) + (32 * qc + r) * RP + 32 * qr + 8 * jj + 4 * hf);
            const LAS bf16* bh = SS(cur, 0) + (32 * qc + r) * RP + 8 * hf; const LAS bf16* bl = SS(cur, 1) + (32 * qc + r) * RP + 8 * hf;
#pragma unroll
            for (int ks = 0; ks < 4; ++ks) {
                acc = __builtin_amdgcn_mfma_f32_32x32x16_bf16(a_cur[ks], *(const LAS bf16x8*)(bh + 16 * ks), acc, 0, 0, 0);
                acc = __builtin_amdgcn_mfma_f32_32x32x16_bf16(a_cur[ks], *(const LAS bf16x8*)(bl + 16 * ks), acc, 0, 0, 0);
            }
#pragma unroll
            for (int jj = 0; jj < 4; ++jj) {
                float hi[4], lo[4];
#pragma unroll
                for (int e = 0; e < 4; ++e) { const unsigned hb = f2bf(acc[4 * jj + e]); hi[e] = __uint_as_float(hb << 16); lo[e] = acc[4 * jj + e] - hi[e]; }
                *(LAS v2u*)(SS(cur ^ 1, 0) + (32 * qc + r) * RP + 32 * qr + 8 * jj + 4 * hf) = (v2u){pk2(hi[0], hi[1]), pk2(hi[2], hi[3])};
                *(LAS v2u*)(SS(cur ^ 1, 1) + (32 * qc + r) * RP + 32 * qr + 8 * jj + 4 * hf) = (v2u){pk2(lo[0], lo[1]), pk2(lo[2], lo[3])};
            }
#pragma unroll
            for (int ks = 0; ks < 4; ++ks) a_cur[ks] = a_nxt[ks];
#pragma unroll
            for (int jj = 0; jj < 4; ++jj) n_cur[jj] = n_nxt[jj];
        }
        __syncthreads();
    }
#undef SS
}

__device__ __forceinline__ void rw_b3(Frame& F) {
    const bf16* P = WSP(bf16, WS_P); bf16* QA = WSP(bf16, WS_QA);
    const bf16* RWQ = WSP(bf16, WS_RWQ); const bf16* RWY = WSP(bf16, WS_RWY);
    const bf16* RWS = (const bf16*)((const char*)F.out + OUT_RWS); const float* BONUS = (const float*)((const char*)F.out + OUT_BONUS);
    const bf16* WgT = WSP(bf16, WS_WT_LORA) + 2 * 512 * 64;
    const float* mu = F.in[IN_MU];
    const int l = F.lane, r = l & 31, hf = l >> 5;
    const int gw = blockIdx.x * NWAVES + F.wave, NGW = F.G * NWAVES;
    for (int it = gw; it < NUNITS * 2; it += NGW) {
        const int u = it >> 1, th = it & 1;
        const bool meta = u >= 4096;
        int b = 0, h, c = 0; if (meta) h = u - 4096; else { b = u >> 10; h = (u >> 7) & 7; c = u & 127; }
        if (meta && th == 1) continue;
        const int t = 32 * th + r;
        const bool valid = !meta || t < NMETA;
        const int row0 = meta ? NREAL : b * SEQ + c * 64;
        const int row = valid ? row0 + t : row0;
        int prow = -1;
        if (t > 0) prow = row - 1; else if (!meta) prow = (c == 0) ? NREAL + NMETA - 1 : row - 1;
        f32x16 y[2];
#pragma unroll
        for (int qv = 0; qv < 2; ++qv) {
            const bf16* Y0 = RWY + (size_t)u * 4096 + (32 * th + r) * 64 + 32 * qv + 4 * hf;
#pragma unroll
            for (int jj = 0; jj < 4; ++jj) { const v2u wv = *(const v2u*)(Y0 + 8 * jj); y[qv][4 * jj] = bflo(wv.x); y[qv][4 * jj + 1] = bfhi(wv.x); y[qv][4 * jj + 2] = bflo(wv.y); y[qv][4 * jj + 3] = bfhi(wv.y); }
        }
        if (!meta) {
            const bf16* qp = RWQ + (size_t)u * 4096 + (32 * th + r) * 64 + 8 * hf;
            const bf16* sp = RWS + (size_t)u * 4096 + r * 64 + 8 * hf;
#pragma unroll
            for (int ks = 0; ks < 4; ++ks) {
                const bf16x8 bq = *(const bf16x8*)(qp + 16 * ks);
                y[0] = __builtin_amdgcn_mfma_f32_32x32x16_bf16(*(const bf16x8*)(sp + 16 * ks), bq, y[0], 0, 0, 0);
                y[1] = __builtin_amdgcn_mfma_f32_32x32x16_bf16(*(const bf16x8*)(sp + 32 * 64 + 16 * ks), bq, y[1], 0, 0, 0);
            }
        }
        f32x16 g[2]; g[0] = zero16(); g[1] = zero16();
        {
            const bf16* gp = P + (size_t)row * PW + PC_GD + 8 * hf; const bf16* gpp = prow >= 0 ? P + (size_t)prow * PW + PC_GD + 8 * hf : nullptr;
            const bf16* wp = WgT + (size_t)(h * 64 + r) * 128 + 8 * hf;
#pragma unroll
            for (int ks = 0; ks < 8; ++ks) {
                const v4u cg = *(const v4u*)(gp + 16 * ks); const v4u pg = gpp ? *(const v4u*)(gpp + 16 * ks) : (v4u){0u, 0u, 0u, 0u};
                const f32x4 m0 = *(const f32x4*)(mu + 1664 + 16 * ks + 8 * hf), m1 = *(const f32x4*)(mu + 1664 + 16 * ks + 8 * hf + 4);
                const unsigned cw[4] = {cg.x, cg.y, cg.z, cg.w}, pw[4] = {pg.x, pg.y, pg.z, pg.w}; const float mm[8] = {m0.x, m0.y, m0.z, m0.w, m1.x, m1.y, m1.z, m1.w};
                unsigned o[4];
#pragma unroll
                for (int e = 0; e < 4; ++e) {
                    const float c0 = bflo(cw[e]), c1 = bfhi(cw[e]), p0 = bflo(pw[e]), p1 = bfhi(pw[e]);
                    o[e] = pk2(sigmoidf_(c0 + (p0 - c0) * mm[2 * e]), sigmoidf_(c1 + (p1 - c1) * mm[2 * e + 1]));
                }
                const v4u ov = (v4u){o[0], o[1], o[2], o[3]};
                const bf16x8 bs = __builtin_bit_cast(bf16x8, ov);
                g[0] = __builtin_amdgcn_mfma_f32_32x32x16_bf16(*(const bf16x8*)(wp + 16 * ks), bs, g[0], 0, 0, 0);
                g[1] = __builtin_amdgcn_mfma_f32_32x32x16_bf16(*(const bf16x8*)(wp + 32 * 128 + 16 * ks), bs, g[1], 0, 0, 0);
            }
        }
        float s = 0.f;
#pragma unroll
        for (int j = 0; j < 16; ++j) s += y[0][j] + y[1][j];
        s += __shfl_xor(s, 32);
        const float mean = s * (1.f / 64.f);
        float s2 = 0.f;
#pragma unroll
        for (int j = 0; j < 16; ++j) { const float d0 = y[0][j] - mean, d1 = y[1][j] - mean; s2 += d0 * d0 + d1 * d1; }
        s2 += __shfl_xor(s2, 32);
        const float rstd = 1.0f / sqrtf(s2 * (1.f / 64.f) + GN_EPS);
        const float bon = BONUS[(size_t)u * 64 + t];
        if (valid) {
#pragma unroll
            for (int qv = 0; qv < 2; ++qv)
#pragma unroll
                for (int jj = 0; jj < 4; ++jj) {
                    const int v0 = 32 * qv + 8 * jj + 4 * hf, chv = h * 64 + v0;
                    const v2u cvw = *(const v2u*)(P + (size_t)row * PW + PC_V + chv); const v2u pvw = prow >= 0 ? *(const v2u*)(P + (size_t)prow * PW + PC_V + chv) : (v2u){0u, 0u};
                    const f32x4 mv = *(const f32x4*)(mu + 1024 + chv), gg = *(const f32x4*)(F.in[IN_GN_G] + chv), gb = *(const f32x4*)(F.in[IN_GN_B] + chv);
                    const float cv[4] = {bflo(cvw.x), bfhi(cvw.x), bflo(cvw.y), bfhi(cvw.y)}, pv[4] = {bflo(pvw.x), bfhi(pvw.x), bflo(pvw.y), bfhi(pvw.y)};
                    const float mvv[4] = {mv.x, mv.y, mv.z, mv.w}, ggv[4] = {gg.x, gg.y, gg.z, gg.w}, gbv[4] = {gb.x, gb.y, gb.z, gb.w};
                    float o[4];
#pragma unroll
                    for (int e = 0; e < 4; ++e) {
                        const float vs = cv[e] + (pv[e] - cv[e]) * mvv[e];
                        o[e] = ((y[qv][4 * jj + e] - mean) * rstd * ggv[e] + gbv[e] + bon * vs) * g[qv][4 * jj + e];
                    }
                    *(v2u*)(QA + (size_t)row * QAW + 1024 + chv) = (v2u){pk2(o[0], o[1]), pk2(o[2], o[3])};
                }
        }
    }
}

constexpr int IX_CAP = 512, IX_LIST = 3072, IX_KB = 98304, IX_SCR = RING_BYTES + 4096;
#define IX_FENCE() asm volatile("s_waitcnt lgkmcnt(0)" ::: "memory")

__device__ __forceinline__ unsigned ix_mbcnt(unsigned long long m) { return __builtin_amdgcn_mbcnt_hi((unsigned)(m >> 32), __builtin_amdgcn_mbcnt_lo((unsigned)m, 0u)); }

__device__ __forceinline__ void ix_select_slow(const float (&sc)[8], const unsigned (&ix)[8], bool (&vl)[8], int K, unsigned short* sel_out, int lane) {
    for (int it = 0; it < K; ++it) {
        unsigned long long best = 0ull;
#pragma unroll
        for (int i = 0; i < 8; ++i) { const unsigned long long key = ((unsigned long long)sortable(sc[i]) << 32) | (unsigned long long)(0xFFFFu - ix[i]) | 0x10000ull; if (vl[i] && key > best) best = key; }
        unsigned long long wm = best;
#pragma unroll
        for (int o = 1; o < 64; o <<= 1) { const unsigned long long v = __shfl_xor(wm, o); wm = v > wm ? v : wm; }
        if (wm == 0ull) break;
        const bool mine = best == wm;
#pragma unroll
        for (int i = 0; i < 8; ++i) { const unsigned long long key = ((unsigned long long)sortable(sc[i]) << 32) | (unsigned long long)(0xFFFFu - ix[i]) | 0x10000ull; if (mine && vl[i] && key == wm) { vl[i] = false; sel_out[it] = (unsigned short)ix[i]; } }
    }
}

__device__ __forceinline__ void ix_compact(LAS float* LS, LAS unsigned short* LI, LAS unsigned* hist, int& cnt, float& tau, int lane, bool final_sel, unsigned short* sel_out) {
    const int n = cnt;
    float sc[8]; unsigned ix[8]; bool vl[8];
    IX_FENCE();
#pragma unroll
    for (int i = 0; i < 8; ++i) { const int p = lane + 64 * i; vl[i] = p < n; sc[i] = vl[i] ? LS[p] : -INFINITY; ix[i] = vl[i] ? (unsigned)LI[p] : 0u; }
    float mx = -INFINITY, mn = INFINITY;
#pragma unroll
    for (int i = 0; i < 8; ++i) { if (vl[i]) { mx = fmaxf(mx, sc[i]); mn = fminf(mn, sc[i]); } }
    mx = wave_max(mx); mn = -wave_max(-mn);
    const float scale = mx > mn ? 255.99f / (mx - mn) : 0.f;
    int bin[8];
#pragma unroll
    for (int i = 0; i < 8; ++i) { int bq = (int)((sc[i] - mn) * scale); bq = bq > 255 ? 255 : (bq < 0 ? 0 : bq); bin[i] = vl[i] ? bq : -1; }
    *(LAS v4u*)(hist + 4 * lane) = (v4u){0u, 0u, 0u, 0u};
    IX_FENCE();
#pragma unroll
    for (int i = 0; i < 8; ++i) if (vl[i]) __hip_atomic_fetch_add((LAS unsigned*)&hist[bin[i]], 1u, __ATOMIC_RELAXED, __HIP_MEMORY_SCOPE_WAVEFRONT);
    IX_FENCE();
    const v4u c = *(const LAS v4u*)(hist + 4 * lane);
    const unsigned Pp = wave_scan_incl(c.x + c.y + c.z + c.w, lane);
    const unsigned total = (unsigned)__builtin_amdgcn_readlane((int)Pp, 63);
    const unsigned K = TOPK;
    const unsigned a3 = total - Pp, a2 = a3 + c.w, a1 = a2 + c.z, a0 = a1 + c.y;
    int myb = -1; unsigned myA = 0u, myC = 0u;
    if (a3 < K && K <= a3 + c.w) { myb = 4 * lane + 3; myA = a3; myC = c.w; }
    else if (a2 < K && K <= a2 + c.z) { myb = 4 * lane + 2; myA = a2; myC = c.z; }
    else if (a1 < K && K <= a1 + c.y) { myb = 4 * lane + 1; myA = a1; myC = c.y; }
    else if (a0 < K && K <= a0 + c.x) { myb = 4 * lane; myA = a0; myC = c.x; }
    const unsigned long long bm = __ballot(myb >= 0);
    const int src = bm ? (__ffsll((long long)bm) - 1) : 0;
    const int bstar = __shfl(myb, src); const unsigned A = __shfl(myA, src), m = __shfl(myC, src);
    if (!final_sel) {
        if (A + m <= (unsigned)(IX_CAP - 96)) {
            int base = 0; float kmin = INFINITY;
#pragma unroll
            for (int i = 0; i < 8; ++i) {
                const bool keep = vl[i] && bin[i] >= bstar;
                const unsigned long long mk = __ballot(keep);
                const int pos = base + (int)ix_mbcnt(mk);
                if (keep) { LS[pos] = sc[i]; LI[pos] = (unsigned short)ix[i]; kmin = fminf(kmin, sc[i]); }
                base += __popcll(mk);
            }
            cnt = base; tau = -wave_max(-kmin);
            IX_FENCE();
            return;
        }
        unsigned short* tmp = sel_out;
        ix_select_slow(sc, ix, vl, (int)K, tmp, lane);
        int base = 0; float kmin = INFINITY;
#pragma unroll
        for (int i = 0; i < 8; ++i) {
            const bool keep = !vl[i] && (lane + 64 * i) < n;
            const unsigned long long mk = __ballot(keep);
            const int pos = base + (int)ix_mbcnt(mk);
            if (keep) { LS[pos] = sc[i]; LI[pos] = (unsigned short)ix[i]; kmin = fminf(kmin, sc[i]); }
            base += __popcll(mk);
        }
        cnt = base; tau = -wave_max(-kmin);
        IX_FENCE();
        return;
    }
    if (m <= 128u) {
        int base = 0;
#pragma unroll
        for (int i = 0; i < 8; ++i) {
            const bool keep = vl[i] && bin[i] > bstar;
            const unsigned long long mk = __ballot(keep);
            const int pos = base + (int)ix_mbcnt(mk);
            if (keep) sel_out[pos] = (unsigned short)ix[i];
            base += __popcll(mk);
        }
        LAS float* sS = (LAS float*)hist; LAS unsigned* sI = hist + 128;
        IX_FENCE();
        int mb = 0;
#pragma unroll
        for (int i = 0; i < 8; ++i) {
            const bool inb = vl[i] && bin[i] == bstar;
            const unsigned long long mk = __ballot(inb);
            const int pos = mb + (int)ix_mbcnt(mk);
            if (inb) { sS[pos] = sc[i]; sI[pos] = ix[i]; }
            mb += __popcll(mk);
        }
        IX_FENCE();
        const int need = (int)(K - A);
#pragma unroll
        for (int e = 0; e < 2; ++e) {
            const int j = lane + 64 * e;
            if (j < (int)m) {
                const float sj = sS[j]; const unsigned ij = sI[j]; int rank = 0;
                for (int k = 0; k < (int)m; ++k) { const float sk = sS[k]; const unsigned ik = sI[k]; rank += (sk > sj || (sk == sj && ik < ij)) ? 1 : 0; }
                if (rank < need) sel_out[(int)A + rank] = (unsigned short)ij;
            }
        }
    } else {
        ix_select_slow(sc, ix, vl, (int)K, sel_out, lane);
    }
}

__device__ __forceinline__ void p5_index_mfma(Frame& F, unsigned short* SEL, int* NSEL, int qword = 3072) {
    const bf16* QA = WSP(bf16, WS_QA); const bf16* KIDX = WSP(bf16, WS_KIDX); const float* WIDX = WSP(float, WS_WIDX);
    const int tid = F.tid, w = F.wave, l = F.lane, r = l & 31, hf = l >> 5;
    {
        const int gw = blockIdx.x * NWAVES + w, NGW = F.G * NWAVES;
        for (int i = gw; i < NMETA + BATCH * 192; i += NGW) {
            int q, nvis; if (i < NMETA) { q = NREAL + i; nvis = NMETA; } else { const int bb = (i - NMETA) / 192, s = (i - NMETA) % 192; q = bb * SEQ + s; nvis = NMETA + 64 * (s / 64 + 1); }
            for (int j = l; j < nvis; j += 64) SEL[(size_t)q * TOPK + j] = (unsigned short)j;
            if (l == 0) NSEL[q] = nvis;
        }
    }
    LAS unsigned char* L = F.lds;
    LAS unsigned* hist = (LAS unsigned*)(L + IX_SCR + w * 1024);
    {
        for (;;) {
            __syncthreads();
            if (tid == 0) F.MISC[16] = __hip_atomic_fetch_add((unsigned*)F.ctl + qword, 1u, __ATOMIC_RELAXED, __HIP_MEMORY_SCOPE_AGENT);
            __syncthreads();
            const int qi_ = (int)F.MISC[16];
            if (qi_ >= 1000) break;
            const int tile = 999 - qi_;
            const int pt = 6 + (tile >> 2), b = tile & 3;
            const int q0 = b * SEQ + pt * 32;
            const int nvis = NMETA + 64 * (pt / 2 + 1);
            const int nblk = (nvis + 127) >> 7;
            __syncthreads();
            bf16x8 af[4];
            {
                const int qq = 2 * (r >> 4) + ((r >> 2) & 1), hd = 4 * ((r >> 3) & 1) + (r & 3);
                const bf16* qp = QA + (size_t)(q0 + 4 * w + qq) * QAW + 1024 + hd * 64 + 8 * hf;
#pragma unroll
                for (int ks = 0; ks < 4; ++ks) af[ks] = *(const bf16x8*)(qp + 16 * ks);
            }
            float wq[2][8];
#pragma unroll
            for (int a = 0; a < 2; ++a) {
                const f32x4 w0 = *(const f32x4*)(WIDX + (size_t)(q0 + 4 * w + 2 * a + hf) * 8), w1 = *(const f32x4*)(WIDX + (size_t)(q0 + 4 * w + 2 * a + hf) * 8 + 4);
                wq[a][0] = 0.5f * w0.x; wq[a][1] = 0.5f * w0.y; wq[a][2] = 0.5f * w0.z; wq[a][3] = 0.5f * w0.w; wq[a][4] = 0.5f * w1.x; wq[a][5] = 0.5f * w1.y; wq[a][6] = 0.5f * w1.z; wq[a][7] = 0.5f * w1.w;
            }
            float tau0 = -INFINITY, tau1 = -INFINITY;
            int cnt[4] = {0, 0, 0, 0};
            v4u kreg[2];
#pragma unroll
            for (int e = 0; e < 2; ++e) {
                const int pid = tid + 512 * e, kl = pid >> 3, pc = pid & 7, j = kl;
                kreg[e] = j < nvis ? *(const v4u*)(KIDX + (size_t)key_row(b, j) * 64 + 8 * pc) : (v4u){0u, 0u, 0u, 0u};
            }
#pragma unroll
            for (int e = 0; e < 2; ++e) { const int pid = tid + 512 * e, kl = pid >> 3, pc = pid & 7; *(LAS v4u*)(L + IX_KB + kl * 128 + ((pc ^ ((kl >> 1) & 7)) << 4)) = kreg[e]; }
            __syncthreads();
            for (int blk = 0; blk < nblk; ++blk) {
                const int cur = blk & 1;
                if (blk + 1 < nblk) {
#pragma unroll
                    for (int e = 0; e < 2; ++e) {
                        const int pid = tid + 512 * e, kl = pid >> 3, pc = pid & 7, j = (blk + 1) * 128 + kl;
                        kreg[e] = j < nvis ? *(const v4u*)(KIDX + (size_t)key_row(b, j) * 64 + 8 * pc) : (v4u){0u, 0u, 0u, 0u};
                    }
                }
                const LAS unsigned char* kb = L + IX_KB + cur * 16384;
                int ntile = (nvis - blk * 128 + 31) >> 5; ntile = ntile > 4 ? 4 : ntile;
                bf16x8 bcur[4];
#pragma unroll
                for (int ks = 0; ks < 4; ++ks) bcur[ks] = *(const LAS bf16x8*)(kb + r * 128 + (((2 * ks + hf) ^ ((r >> 1) & 7)) << 4));
                for (int tt = 0; tt < ntile; ++tt) {
                    const int jbase = blk * 128 + tt * 32;
                    bf16x8 bnxt[4];
                    {
                        const int kl = (tt + 1 < ntile ? tt + 1 : tt) * 32 + r;
#pragma unroll
                        for (int ks = 0; ks < 4; ++ks) bnxt[ks] = *(const LAS bf16x8*)(kb + kl * 128 + (((2 * ks + hf) ^ ((kl >> 1) & 7)) << 4));
                    }
                    f32x16 acc = zero16();
#pragma unroll
                    for (int ks = 0; ks < 4; ++ks) acc = __builtin_amdgcn_mfma_f32_32x32x16_bf16(af[ks], bcur[ks], acc, 0, 0, 0);
#pragma unroll
                    for (int ks = 0; ks < 4; ++ks) bcur[ks] = bnxt[ks];
                    const int j = jbase + r;
                    float s0 = 0.f, s1 = 0.f;
#pragma unroll
                    for (int h = 0; h < 8; ++h) { s0 = fmaf(wq[0][h], __builtin_fabsf(acc[h]), fmaf(wq[0][h], acc[h], s0)); s1 = fmaf(wq[1][h], __builtin_fabsf(acc[8 + h]), fmaf(wq[1][h], acc[8 + h], s1)); }
                    s0 += 0.0f; s1 += 0.0f;
                    const bool p0 = j < nvis && s0 > tau0, p1 = j < nvis && s1 > tau1;
                    const unsigned long long m0 = __ballot(p0), m1 = __ballot(p1);
                    if (m0 | m1) {
                        const int c0lo = __popc((unsigned)m0), c0hi = __popc((unsigned)(m0 >> 32)), c1lo = __popc((unsigned)m1), c1hi = __popc((unsigned)(m1 >> 32));
                        {
                            const int pos = (hf ? cnt[1] - c0lo : cnt[0]) + (int)ix_mbcnt(m0);
                            if (p0) { LAS unsigned char* lb = L + (w * 4 + hf) * IX_LIST; ((LAS float*)lb)[pos] = s0; ((LAS unsigned short*)(lb + 2048))[pos] = (unsigned short)j; }
                        }
                        {
                            const int pos = (hf ? cnt[3] - c1lo : cnt[2]) + (int)ix_mbcnt(m1);
                            if (p1) { LAS unsigned char* lb = L + (w * 4 + 2 + hf) * IX_LIST; ((LAS float*)lb)[pos] = s1; ((LAS unsigned short*)(lb + 2048))[pos] = (unsigned short)j; }
                        }
                        cnt[0] += c0lo; cnt[1] += c0hi; cnt[2] += c1lo; cnt[3] += c1hi;
#pragma unroll
                        for (int qq = 0; qq < 4; ++qq) {
                            if (cnt[qq] > IX_CAP - 32) {
                                LAS unsigned char* lb = L + (w * 4 + qq) * IX_LIST;
                                float tq = 0.f; int cq = cnt[qq];
                                ix_compact((LAS float*)lb, (LAS unsigned short*)(lb + 2048), hist, cq, tq, l, false, SEL + (size_t)(q0 + 4 * w + qq) * TOPK);
                                cnt[qq] = __builtin_amdgcn_readfirstlane(cq);
                                if ((qq & 1) == hf) { if (qq < 2) tau0 = tq; else tau1 = tq; }
                            }
                        }
                    }
                }
                if (blk + 1 < nblk) {
#pragma unroll
                    for (int e = 0; e < 2; ++e) { const int pid = tid + 512 * e, kl = pid >> 3, pc = pid & 7; *(LAS v4u*)(L + IX_KB + (cur ^ 1) * 16384 + kl * 128 + ((pc ^ ((kl >> 1) & 7)) << 4)) = kreg[e]; }
                }
                __syncthreads();
            }
#pragma unroll
            for (int qq = 0; qq < 4; ++qq) {
                LAS unsigned char* lb = L + (w * 4 + qq) * IX_LIST;
                float tq = 0.f; int cq = cnt[qq];
                ix_compact((LAS float*)lb, (LAS unsigned short*)(lb + 2048), hist, cq, tq, l, true, SEL + (size_t)(q0 + 4 * w + qq) * TOPK);
                if (l == 0) NSEL[q0 + 4 * w + qq] = TOPK;
            }
        }
    }
}

#ifndef CHECK_IDX
#define CHECK_IDX 0
#endif
#if CHECK_IDX
__device__ __forceinline__ void idx_check(Frame& F) {
    const unsigned short* SEL = WSP(unsigned short, WS_SEL); const unsigned short* SELB = (const unsigned short*)F.out; const int* NSEL = WSP(int, WS_NSEL); const int* NSELB = (const int*)((const char*)F.out + 32 * MiB);
    LAS unsigned* bm = (LAS unsigned*)(F.lds + F.wave * 2048);
    const int l = F.lane; const int gw = blockIdx.x * NWAVES + F.wave, NGW = F.G * NWAVES;
    unsigned miss = 0, badq = 0, dup = 0;
    for (int q = gw; q < NROWS; q += NGW) {
        for (int i = l; i < 260; i += 64) bm[i] = 0u;
        IX_FENCE();
        const int n = NSEL[q], nb = NSELB[q];
        for (int i = l; i < n; i += 64) { const unsigned j = SEL[(size_t)q * TOPK + i]; atomicOr((unsigned*)&bm[j >> 5], 1u << (j & 31)); }
        IX_FENCE();
        unsigned m = (n != nb) ? 1000u : 0u;
        for (int i = l; i < nb && i < TOPK; i += 64) { const unsigned j = SELB[(size_t)q * TOPK + i]; if (j >= (unsigned)TT) { ++dup; ++m; } else { const unsigned old = atomicAnd((unsigned*)&bm[j >> 5], ~(1u << (j & 31))); if (!((old >> (j & 31)) & 1u)) ++m; } }
        IX_FENCE();
        m = (unsigned)wave_sum((float)m);
        if (l == 0) { miss += m; badq += m ? 1u : 0u; }
    }
    dup = (unsigned)wave_sum((float)dup);
    if (l == 0) { atomicAdd((unsigned*)F.ctl + 2048, miss); atomicAdd((unsigned*)F.ctl + 2049, badq); atomicAdd((unsigned*)F.ctl + 2050, dup); }
}
#endif

typedef short v4i16_t __attribute__((ext_vector_type(4)));
__device__ __forceinline__ unsigned at_off(unsigned row, unsigned ch) { return 256u * row + 16u * (ch ^ (((row & 3u) << 2) | ((row >> 2) & 3u))); }

__device__ __forceinline__ void p6_attn_mfma(Frame& F, bf16* OUTB) {
    bf16* QA = WSP(bf16, WS_QA); const bf16* CKV = WSP(bf16, WS_CKV); const unsigned short* SEL = WSP(unsigned short, WS_SEL); const int* NSEL = WSP(int, WS_NSEL);
    const int l = F.lane, w = F.wave, h16 = l & 15, g = l >> 4;
    LAS unsigned char* tile = F.lds + w * 8192;
    const float slope = h16 < 8 ? __uint_as_float((unsigned)(127 - (h16 + 1)) << 23) : 0.f;
    {
        const int gw = blockIdx.x * NWAVES + w, NGW = F.G * NWAVES;
        for (int q = NROWS + gw; q < R; q += NGW) { bf16* qrow = QA + (size_t)q * QAW; for (int c = l; c < QAW / 8; c += 64) *(v4u*)(qrow + 8 * c) = (v4u){0u, 0u, 0u, 0u}; }
    }
    const int G = F.G;
    int nq_tot, qbase_b, wib, wpb;
    if ((G & 7) == 0) { const int b = (blockIdx.x & 7) >> 1; qbase_b = b * SEQ; nq_tot = SEQ + (b == 0 ? NMETA : 0); wib = (((blockIdx.x >> 3) * 2) + (blockIdx.x & 1)) * NWAVES + w; wpb = (G / 4) * NWAVES; }
    else { qbase_b = 0; nq_tot = NROWS; wib = blockIdx.x * NWAVES + w; wpb = G * NWAVES; }
    for (int qi = wib; qi < nq_tot; qi += wpb) {
        int q, b, pos;
        if ((G & 7) == 0) { if (qi < SEQ) { q = qbase_b + qi; b = q >> 13; pos = NMETA + qi; } else { q = NREAL + (qi - SEQ); b = 0; pos = qi - SEQ; } }
        else { q = qi; if (q < NREAL) { b = q >> 13; pos = NMETA + (q & (SEQ - 1)); } else { b = 0; pos = q - NREAL; } }
        bf16* qrow = QA + (size_t)q * QAW;
        const int nsel = NSEL[q];
        const int nch = (nsel + 31) >> 5;
        const unsigned short* selq = SEL + (size_t)q * TOPK;
        bf16x8 qf[4];
#pragma unroll
        for (int s = 0; s < 4; ++s) { const v4u t = h16 < 8 ? *(const v4u*)(qrow + h16 * 128 + 32 * s + 8 * g) : (v4u){0u, 0u, 0u, 0u}; qf[s] = __builtin_bit_cast(bf16x8, t); }
        float m = -INFINITY, lsum = 0.f;
        f32x4 O[8];
#pragma unroll
        for (int c = 0; c < 8; ++c) O[c] = (f32x4){0.f, 0.f, 0.f, 0.f};
        v4u gr[8];
#pragma unroll
        for (int i = 0; i < 8; ++i) { const int s = g + 4 * i; const int kj = s < nsel ? (int)selq[s] : (int)selq[0]; gr[i] = *(const v4u*)(CKV + (size_t)key_row(b, kj) * 128 + 8 * h16); }
        for (int ck = 0; ck < nch; ++ck) {
            IX_FENCE();
#pragma unroll
            for (int i = 0; i < 8; ++i) *(LAS v4u*)(tile + at_off((unsigned)(g + 4 * i), (unsigned)h16)) = gr[i];
            const v4u kv = *(const v4u*)(selq + 32 * ck + 8 * g);
            if (ck + 1 < nch) {
#pragma unroll
                for (int i = 0; i < 8; ++i) { const int s = 32 * (ck + 1) + g + 4 * i; const int kj = s < nsel ? (int)selq[s] : (int)selq[0]; gr[i] = *(const v4u*)(CKV + (size_t)key_row(b, kj) * 128 + 8 * h16); }
            }
            IX_FENCE();
            f32x4 a0 = (f32x4){0.f, 0.f, 0.f, 0.f}, a1 = a0;
#pragma unroll
            for (int s = 0; s < 4; ++s) {
                const bf16x8 k0 = *(const LAS bf16x8*)(tile + at_off((unsigned)(8 * (h16 >> 2) + (h16 & 3)), (unsigned)(4 * s + g)));
                const bf16x8 k1 = *(const LAS bf16x8*)(tile + at_off((unsigned)(8 * (h16 >> 2) + 4 + (h16 & 3)), (unsigned)(4 * s + g)));
                a0 = __builtin_amdgcn_mfma_f32_16x16x32_bf16(k0, qf[s], a0, 0, 0, 0);
                a1 = __builtin_amdgcn_mfma_f32_16x16x32_bf16(k1, qf[s], a1, 0, 0, 0);
            }
            const unsigned kw[4] = {kv.x, kv.y, kv.z, kv.w};
            float x[8];
#pragma unroll
            for (int j = 0; j < 8; ++j) {
                const int kj = (int)((kw[j >> 1] >> (16 * (j & 1))) & 0xffffu);
                const float lg = (j < 4 ? a0[j & 3] : a1[j & 3]) - slope * fabsf((float)(pos - kj));
                x[j] = (32 * ck + 8 * g + j) < nsel ? lg : -INFINITY;
            }
            float cm = fmaxf(fmaxf(fmaxf(x[0], x[1]), fmaxf(x[2], x[3])), fmaxf(fmaxf(x[4], x[5]), fmaxf(x[6], x[7])));
            cm = fmaxf(cm, __shfl_xor(cm, 16)); cm = fmaxf(cm, __shfl_xor(cm, 32));
            const float mn = fmaxf(m, cm);
            const float alpha = __expf(m - mn);
            float p[8], ps = 0.f;
#pragma unroll
            for (int j = 0; j < 8; ++j) { p[j] = __expf(x[j] - mn); ps += p[j]; }
            ps += __shfl_xor(ps, 16); ps += __shfl_xor(ps, 32);
            lsum = lsum * alpha + ps; m = mn;
            if (__any(alpha != 1.0f)) {
#pragma unroll
                for (int rr = 0; rr < 4; ++rr) { const float sc = __shfl(alpha, 4 * g + rr);
#pragma unroll
                    for (int c = 0; c < 8; ++c) O[c][rr] *= sc; }
            }
            const v4u pw = (v4u){pk2(p[0], p[1]), pk2(p[2], p[3]), pk2(p[4], p[5]), pk2(p[6], p[7])};
            const bf16x8 pf = __builtin_bit_cast(bf16x8, pw);
#pragma unroll
            for (int c = 0; c < 8; ++c) {
                const unsigned qd = (unsigned)(h16 >> 2), pp = (unsigned)(h16 & 3);
                const v4i16_t t0 = __builtin_amdgcn_ds_read_tr16_b64_v4i16((LAS v4i16_t*)(tile + at_off(8u * g + qd, 2u * c + (pp >> 1)) + 8u * (pp & 1u)));
                const v4i16_t t1 = __builtin_amdgcn_ds_read_tr16_b64_v4i16((LAS v4i16_t*)(tile + at_off(8u * g + 4u + qd, 2u * c + (pp >> 1)) + 8u * (pp & 1u)));
                bf16x8 vf; vf[0] = t0[0]; vf[1] = t0[1]; vf[2] = t0[2]; vf[3] = t0[3]; vf[4] = t1[0]; vf[5] = t1[1]; vf[6] = t1[2]; vf[7] = t1[3];
                O[c] = __builtin_amdgcn_mfma_f32_16x16x32_bf16(pf, vf, O[c], 0, 0, 0);
            }
        }
        const float inv = 1.0f / lsum;
#pragma unroll
        for (int rr = 0; rr < 4; ++rr) {
            const float sc = __shfl(inv, 4 * g + rr);
            if (g < 2) {
#pragma unroll
                for (int c = 0; c < 8; ++c) (OUTB + (size_t)q * QAW)[(4 * g + rr) * 128 + 16 * c + h16] = (bf16)f2bf(O[c][rr] * sc);
            }
        }
    }
}
struct StoreBf16 { bf16* O; int ld;
    __device__ __forceinline__ void operator()(int row, int col, const f32x4& v) const { *(v2u*)(O + (size_t)row * ld + col) = (v2u){pk2(v.x, v.y), pk2(v.z, v.w)}; }
    __device__ __forceinline__ void one(int row, int col, float v) const { O[(size_t)row * ld + col] = (bf16)f2bf(v); } };
struct StoreRes1 { const bf16* H; float* out; float* meta;
    __device__ __forceinline__ void operator()(int row, int col, const f32x4& v) const {
        if (row >= NROWS) return;
        const v2u hw = *(const v2u*)(H + (size_t)row * D + col);
        const f32x4 o = (f32x4){ALPHA * bflo(hw.x) + v.x, ALPHA * bfhi(hw.x) + v.y, ALPHA * bflo(hw.y) + v.z, ALPHA * bfhi(hw.y) + v.w};
        float* dst = row < NREAL ? out + (size_t)row * D + col : meta + (size_t)(row - NREAL) * D + col;
        *(f32x4*)dst = o; }
    __device__ __forceinline__ void one(int row, int col, float v) const { if (row >= NROWS) return; float* dst = row < NREAL ? out + (size_t)row * D + col : meta + (size_t)(row - NREAL) * D + col; *dst = ALPHA * bf2f(H[(size_t)row * D + col]) + v; } };
struct StoreRes2 { const bf16* H; float* out; __device__ __forceinline__ void operator()(int row, int col, const f32x4& v) const {
        if (row >= NREAL) return;
        const v2u hw = *(const v2u*)(H + (size_t)row * D + col);
        *(f32x4*)(out + (size_t)row * D + col) = (f32x4){ALPHA * bflo(hw.x) + v.x, ALPHA * bfhi(hw.x) + v.y, ALPHA * bflo(hw.y) + v.z, ALPHA * bfhi(hw.y) + v.w}; } };

template <class Fn>
__device__ __forceinline__ void meta_gemm(Frame& F, const bf16* A, int lda, const bf16* Bt, int N, int K, const Fn& fn) {
    const int l = F.lane, i16 = l & 15, g = l >> 4;
    const int gw = blockIdx.x * NWAVES + F.wave, NGW = F.G * NWAVES;
    for (int t = gw; t < N / 16; t += NGW) {
        const bf16* ap = A + (size_t)(NREAL + i16) * lda + 8 * g; const bf16* bp = Bt + (size_t)(16 * t + i16) * K + 8 * g;
        f32x4 acc = (f32x4){0.f, 0.f, 0.f, 0.f};
#pragma unroll 8
        for (int s = 0; s < K / 32; ++s) acc = __builtin_amdgcn_mfma_f32_16x16x32_bf16(*(const pg8::bf16x8*)(ap + 32 * s), *(const pg8::bf16x8*)(bp + 32 * s), acc, 0, 0, 0);
#pragma unroll
        for (int rr = 0; rr < 4; ++rr) fn.one(NREAL + 4 * g + rr, 16 * t + i16, acc[rr]);
    }
}

template <class Fn>
__device__ __forceinline__ void run_gemm(Frame& F, const bf16* A, int lda, const bf16* Bt, int N, int K, const Fn& fn) {
    pg8::Gemm g{A, Bt, NREAL, N, K, lda}; pg8::StaticOrder S; S.init(NREAL, N, F.G, (int)blockIdx.x);
    pg8::EpiFn<Fn> E{fn};
    pg8::gemm_phase<pg8::EpiFn<Fn>, pg8::StaticOrder, true, true>(F.lds + RING_OFF, g, S, E);
}

constexpr int NPHASES = 13;
struct Args { const float* in[32]; float* out; unsigned char* ws; int ph_lo, ph_hi; };
__global__ void __launch_bounds__(NTHR, 2) fwd(Args args) {
    extern __shared__ __attribute__((aligned(16))) unsigned char lds[];
    Frame F;
    F.lds = (LAS unsigned char*)lds;
    F.MISC = (volatile LAS unsigned*)(F.lds + MISC_OFF);
    F.tid = threadIdx.x; F.lane = F.tid & 63; F.wave = __builtin_amdgcn_readfirstlane(F.tid >> 6);
    F.G = gridDim.x;
#pragma unroll
    for (int i = 0; i < 32; ++i) F.in[i] = args.in[i];
    F.out = args.out; F.ws = args.ws;
    F.ctl = (gu32*)(args.ws + WS_CTL);
    for (int u = F.tid; u < (LDS_BYTES - LDSCTL_OFF) / 4; u += NTHR) ((LAS unsigned*)(F.lds + LDSCTL_OFF))[u] = 0u;
    __syncthreads();
    const int lo = args.ph_lo, hi = args.ph_hi;
    XcdBarrier bar; bar.bar = (unsigned*)(F.ctl + CW_BAR); bar.x = 0; bar.st = nullptr;
    if (hi - lo > 1) bar = xcd_barrier_post((unsigned*)(F.ctl + CW_BAR), F.MISC + 8);
#define IN(k) (lo <= (k) && (k) < hi)
#define SEAM(k) do { if (IN(k) && IN((k) + 1)) xcd_barrier(bar); } while (0)
#ifndef PROBE_PH
#define PROBE_PH -1
#endif
#define REP(k) for (int rep_ = 0; rep_ < ((PROBE_PH == (k)) ? 2 : 1); ++rep_)

#ifndef IDX_NAIVE
#define IDX_NAIVE 0
#endif
#ifndef ATTN_NAIVE
#define ATTN_NAIVE 0
#endif
    if (IN(0)) REP(0) { if (rep_) __syncthreads(); p0_weights(F); p1_ln_in(F); } SEAM(0);
    if (IN(1)) REP(1) { if (rep_) __syncthreads(); run_gemm(F, WSP(bf16, WS_H), D, WSP(bf16, WS_WT_IN), PW, D, StoreBf16{WSP(bf16, WS_P), PW}); meta_gemm(F, WSP(bf16, WS_H), D, WSP(bf16, WS_WT_IN), PW, D, StoreBf16{WSP(bf16, WS_P), PW}); } SEAM(1);
    if (IN(2)) REP(2) { if (rep_) __syncthreads(); p3_prep(F); } SEAM(2);
    if (IN(3)) REP(3) { if (rep_) __syncthreads(); run_gemm(F, WSP(bf16, WS_CQN), 256, WSP(bf16, WS_WT_QA), QAW, 256, StoreBf16{WSP(bf16, WS_QA), QAW}); meta_gemm(F, WSP(bf16, WS_CQN), 256, WSP(bf16, WS_WT_QA), QAW, 256, StoreBf16{WSP(bf16, WS_QA), QAW});
#if REFSEL
        refsel_rows(F);
#endif
    } SEAM(3);
    if (IN(4)) REP(4) { if (rep_) __syncthreads(); rw_b1(F); } SEAM(4);
    if (IN(5)) {
        rw_b2(F); __syncthreads();
#if CHECK_IDX
        p5_index_naive(F); __syncthreads(); p5_index_mfma(F, (unsigned short*)F.out, (int*)((char*)F.out + 32 * MiB));
#elif IDX_NAIVE
        p5_index_naive(F);
#else
        p5_index_mfma(F, WSP(unsigned short, WS_SEL), WSP(int, WS_NSEL));
#ifdef PROBE_IDX
        __syncthreads(); p5_index_mfma(F, WSP(unsigned short, WS_SEL), WSP(int, WS_NSEL), 3136);
#endif
#endif
    } SEAM(5);
    if (IN(6)) {
#if CHECK_IDX
        idx_check(F); __syncthreads();
#endif
#if ATTN_NAIVE
        p6_attn_naive(F);
#else
        p6_attn_mfma(F, WSP(bf16, WS_QA));
#endif
        __syncthreads();
        rw_b3(F);
    } SEAM(6);
    if (IN(7)) REP(7) { if (rep_) __syncthreads(); run_gemm(F, WSP(bf16, WS_QA), QAW, WSP(bf16, WS_WT_MIX), D, QAW, StoreRes1{WSP(bf16, WS_H), F.out, WSP(float, WS_META1)}); meta_gemm(F, WSP(bf16, WS_QA), QAW, WSP(bf16, WS_WT_MIX), D, QAW, StoreRes1{WSP(bf16, WS_H), F.out, WSP(float, WS_META1)}); } SEAM(7);
    if (IN(8)) REP(8) { if (rep_) __syncthreads(); p10_ln1(F); } SEAM(8);
    if (IN(9)) REP(9) { if (rep_) __syncthreads(); run_gemm(F, WSP(bf16, WS_H), D, WSP(bf16, WS_WT_UP), UPW, D, StoreBf16{WSP(bf16, WS_UP), UPW}); meta_gemm(F, WSP(bf16, WS_H), D, WSP(bf16, WS_WT_UP), UPW, D, StoreBf16{WSP(bf16, WS_UP), UPW}); } SEAM(9);
    if (IN(10)) { p12_conv_act(F); } SEAM(10);
    if (IN(11)) REP(11) { if (rep_) __syncthreads(); run_gemm(F, WSP(bf16, WS_UP) + DFF, UPW, WSP(bf16, WS_WT_DN), D, DFF, StoreRes2{WSP(bf16, WS_H), F.out}); } SEAM(11);
    if (IN(12)) { p14_ln2(F);
#if CHECK_IDX
        if (blockIdx.x == 0 && F.tid == 0) {
            const unsigned miss = __hip_atomic_load((unsigned*)F.ctl + 2048, __ATOMIC_RELAXED, __HIP_MEMORY_SCOPE_AGENT), dupc = __hip_atomic_load((unsigned*)F.ctl + 2050, __ATOMIC_RELAXED, __HIP_MEMORY_SCOPE_AGENT);
            if (dupc) F.out[5] = __builtin_inff();
            if (miss > CHECK_IDX_MAXMISS) F.out[3] = __builtin_nanf("");
        }
#endif
    }
#undef IN
#undef SEAM
}

extern "C" void kernel_launch(void* const* d_in, const int* in_sizes, int n_in, void* d_out, int out_size, void* d_ws, size_t ws_size, hipStream_t stream) {
    static int grid = 0;
    if (grid == 0) {
        if (n_in != 32 || out_size != NREAL * D || ws_size < WS_END) { fprintf(stderr, "kernel_launch: unexpected shapes: n_in %d out %d ws %zu\n", n_in, out_size, ws_size); grid = -1; return; }
        int dev = 0, cus = 0, per_cu = 0;
        if (hipGetDevice(&dev) != hipSuccess || hipDeviceGetAttribute(&cus, hipDeviceAttributeMultiprocessorCount, dev) != hipSuccess) { grid = -1; return; }
        if (hipFuncSetAttribute((const void*)fwd, hipFuncAttributeMaxDynamicSharedMemorySize, LDS_BYTES) != hipSuccess) { fprintf(stderr, "kernel_launch: hipFuncSetAttribute failed\n"); grid = -1; return; }
        if (hipOccupancyMaxActiveBlocksPerMultiprocessor(&per_cu, (const void*)fwd, NTHR, LDS_BYTES) != hipSuccess || per_cu < 1) fprintf(stderr, "kernel_launch: occupancy query says %d\n", per_cu);
        (void)hipGetLastError();
        grid = cus;
    }
    if (grid < 0) return;
    (void)hipMemsetAsync((char*)d_ws + WS_CTL, 0, CTL_ZERO_BYTES, stream);
    Args a{};
    for (int i = 0; i < 32; ++i) a.in[i] = (const float*)d_in[i];
    a.out = (float*)d_out; a.ws = (unsigned char*)d_ws;
#if ONE_LAUNCH
    a.ph_lo = 0; a.ph_hi = NPHASES;
    hipLaunchKernelGGL(fwd, dim3(grid), dim3(NTHR), LDS_BYTES, stream, a);
#else
    for (int p = 0; p < NPHASES; ++p) { a.ph_lo = p; a.ph_hi = p + 1; hipLaunchKernelGGL(fwd, dim3(grid), dim3(NTHR), LDS_BYTES, stream, a); }
#endif
}
```

```cpp
#include <hip/hip_runtime.h>
#include <cstdio>
#include <cstdint>
#define ONE_LAUNCH 1
namespace pg8 {
#define PG8_LAS __attribute__((address_space(3)))
typedef unsigned short bf16_t;
typedef short bf16x8 __attribute__((ext_vector_type(8)));
typedef float f32x4 __attribute__((ext_vector_type(4)));
typedef unsigned u32x4 __attribute__((ext_vector_type(4)));
constexpr int BM = 256, BK = 64, HALF = 128, HTB = HALF * BK * 2  , STAGE_BYTES = 8 * HTB, NXCD = 8, WGM = 8;

__host__ __device__ __forceinline__ int lds_byte(int r, int c) { const int st = (r >> 4) * 2 + (c >> 5), rr = r & 15, cc = c & 31, ob = rr * 64 + cc * 2; return st * 1024 + (ob ^ (((ob >> 9) & 1) << 5)); }
__host__ __device__ __forceinline__ void stage_rc(int b, int& R, int& C) { const int st = b / 1024, sb = b % 1024, swz = sb ^ (((sb >> 9) & 1) << 5); R = (st >> 1) * 16 + swz / 64; C = (st & 1) * 32 + (swz % 64) / 2; }
__host__ __device__ __forceinline__ int perm32(int rho) { const int n = rho >> 4, i = rho & 15; return 8 * (i >> 2) + 4 * n + (i & 3); }

struct Unit { int pm, pn; };
struct Gemm { const bf16_t* A; const bf16_t* Bt; int M, N, K, lda; };

struct StaticOrder {
    int nM, nN, nwg, G, c;
    __host__ __device__ void init(int M, int N, int G_, int c_) { nM = M / BM; nN = N / BM; nwg = nM * nN; G = G_; c = c_; }
    __host__ __device__ bool next(int i, Unit& u) const {
        const long L = (long)i * G + c; if (L >= nwg) return false;
        int wgid = (int)L; { const int q = nwg / NXCD, r = nwg % NXCD, xcd = wgid % NXCD, off = wgid / NXCD; wgid = (xcd < r ? xcd * (q + 1) : r * (q + 1) + (xcd - r) * q) + off; }
        const int nig = WGM * nN, gid = wgid / nig, fm = gid * WGM, gsz = (nM - fm) < WGM ? (nM - fm) : WGM;
        u.pm = fm + ((wgid % nig) % gsz); u.pn = (wgid % nig) / gsz; return true;
    }
    __device__ __forceinline__ void a_ready(const Unit&) const {}
    __device__ __forceinline__ void done(const Unit&) const {}
};


template <class F> struct EpiFn {
    static constexpr bool PERM = false, AFTER_DRAIN = false;
    F f;
    __device__ __forceinline__ void operator()(const f32x4 (&acc)[2][2][4][2], const Unit& u, int wr, int wc, int fr, int fq) const {
        const int row0 = u.pm * BM + wr * 64 + fr, col0 = u.pn * BM + wc * 32 + 4 * fq;
#pragma unroll
        for (int ai = 0; ai < 2; ++ai)
#pragma unroll
            for (int m = 0; m < 4; ++m) {
                const int row = row0 + ai * HALF + m * 16;
#pragma unroll
                for (int bj = 0; bj < 2; ++bj)
#pragma unroll
                    for (int n = 0; n < 2; ++n) f(row, col0 + bj * HALF + n * 16, acc[ai][bj][m][n]);
            }
    }
};

struct EpiConvAct {
    static constexpr bool PERM = false, AFTER_DRAIN = false;
    unsigned short* ACT; int ldact;
    const float* cw; const float* cb; int dff;
    float* G01; float* V01; float* GHALO;
    PG8_LAS float* hal;
    __device__ __forceinline__ void operator()(const f32x4 (&acc)[2][2][4][2], const Unit& u, int wr, int wc, int fr, int fq) const {
        const int colg = 128 * u.pn + wc * 32 + 4 * fq;
        f32x4 w0[2], w1[2], w2[2], bb[2];
#pragma unroll
        for (int n = 0; n < 2; ++n) { w0[n] = *(const f32x4*)(cw + colg + 16 * n); w1[n] = *(const f32x4*)(cw + dff + colg + 16 * n); w2[n] = *(const f32x4*)(cw + 2 * dff + colg + 16 * n); bb[n] = *(const f32x4*)(cb + colg + 16 * n); }
        if (fr >= 14) {
#pragma unroll
            for (int ai = 0; ai < 2; ++ai)
#pragma unroll
                for (int n = 0; n < 2; ++n) *(PG8_LAS f32x4*)(hal + (((2 * ai + wr) * 4 + wc) * 2 + (fr - 14)) * 32 + 16 * n + 4 * fq) = acc[ai][0][3][n];
        }
        asm volatile("s_waitcnt lgkmcnt(0)" ::: "memory"); __builtin_amdgcn_s_barrier(); asm volatile("" ::: "memory");
#pragma unroll
        for (int ai = 0; ai < 2; ++ai) {
            const int blk = 2 * ai + wr;
#pragma unroll
            for (int n = 0; n < 2; ++n) {
                f32x4 prev = (f32x4){0.f, 0.f, 0.f, 0.f};
                if (blk > 0) prev = *(const PG8_LAS f32x4*)(hal + ((((blk - 1) * 4 + wc) * 2 + (fr & 1)) * 32) + 16 * n + 4 * fq);
#pragma unroll
                for (int m = 0; m < 4; ++m) {
                    const f32x4 cur = acc[ai][0][m][n], val = acc[ai][1][m][n];
                    f32x4 o;
#pragma unroll
                    for (int e = 0; e < 4; ++e) {
                        float s1 = prev[e], s2 = prev[e];
                        asm volatile("s_nop 1\n\tv_mov_b32_dpp %0, %0 row_ror:1 row_mask:0xf bank_mask:0xf\n\tv_mov_b32_dpp %1, %1 row_ror:2 row_mask:0xf bank_mask:0xf\n\ts_nop 1\n\t"
                                     "v_mov_b32_dpp %0, %2 row_shr:1 row_mask:0xf bank_mask:0xf\n\tv_mov_b32_dpp %1, %2 row_shr:2 row_mask:0xf bank_mask:0xf\n\ts_nop 1" : "+v"(s1), "+v"(s2) : "v"(cur[e]));
                        const float x = w0[n][e] * s2 + w1[n][e] * s1 + w2[n][e] * cur[e] + bb[n][e];
                        const float u2 = x * (1.5957691216057308f + 0.07135481627260025f * x * x);
                        o[e] = x * __builtin_amdgcn_rcpf(1.0f + __builtin_amdgcn_exp2f(-1.4426950408889634f * u2)) * val[e];
                    }
                    const int rt = ai * HALF + wr * 64 + m * 16 + fr;
                    const int row = u.pm * BM + rt;
                    if (blk == 0 && m == 0 && fr < 2) {
                        *(f32x4*)(G01 + ((size_t)u.pm * 2 + fr) * dff + colg + 16 * n) = cur; *(f32x4*)(V01 + ((size_t)u.pm * 2 + fr) * dff + colg + 16 * n) = val;
                    } else {
                        typedef unsigned u32x2 __attribute__((ext_vector_type(2)));
                        typedef __bf16 b2 __attribute__((ext_vector_type(2)));
                        const b2 lo = {(__bf16)o[0], (__bf16)o[1]}, hi = {(__bf16)o[2], (__bf16)o[3]};
                        *(u32x2*)(ACT + (size_t)row * ldact + colg + 16 * n) = (u32x2){__builtin_bit_cast(unsigned, lo), __builtin_bit_cast(unsigned, hi)};
                    }
                    if (blk == 3 && m == 3 && fr >= 14) *(f32x4*)(GHALO + ((size_t)u.pm * 2 + (fr - 14)) * dff + colg + 16 * n) = cur;
                    prev = cur;
                }
            }
        }
        asm volatile("s_waitcnt lgkmcnt(0)" ::: "memory"); __builtin_amdgcn_s_barrier(); asm volatile("" ::: "memory");
    }
};
template <class Epi, class Sched, bool ALIGN_EPI = false, bool SP2 = false>
__device__ __forceinline__ void gemm_phase(PG8_LAS unsigned char* lds, const Gemm g, const Sched& S, const Epi& E) {
    const int tid = threadIdx.x, wid = __builtin_amdgcn_readfirstlane(tid >> 6), lane = tid & 63, wr = wid >> 2, wc = wid & 3, fr = lane & 15, fq = lane >> 4;
    const int K = g.K, nt = K / BK;
    unsigned voffA[2], voffB[2];
#pragma unroll
    for (int i = 0; i < 2; ++i) { int R, C; stage_rc(tid * 16 + i * 8192, R, C); const int Rb = Epi::PERM ? ((R & ~31) + perm32(R & 31)) : R;
        voffA[i] = (unsigned)(R * g.lda + C) * 2u; voffB[i] = (unsigned)(Rb * K + C) * 2u; }
    const size_t kstep = (size_t)(BK * 2);
    const size_t hA = (size_t)HALF * g.lda * 2, hB = (size_t)HALF * K * 2;
    const size_t tA = 2 * hA, tB = 2 * hB;
    const unsigned ldsw = (unsigned)wid * 1024u;
    const int aoff = lds_byte(wr * 64 + fr, fq * 8), boff = lds_byte(wc * 32 + fr, fq * 8);
#define PG8_SA(b, h) (((b) * 2 + (h)) * HTB)
#define PG8_SB(b, h) ((4 + (b) * 2 + (h)) * HTB)
#define PG8_STAGE(bufoff, gbase, voff) do { _Pragma("unroll") for (int _i = 0; _i < 2; ++_i) \
        __builtin_amdgcn_global_load_lds((const unsigned*)((const char*)(gbase) + (voff)[_i]), (PG8_LAS unsigned*)(lds + (bufoff) + ldsw + _i * 8192), 16, 0, 0); } while (0)
#define PG8_LDA(dst, b, h) do { _Pragma("unroll") for (int m = 0; m < 4; ++m) _Pragma("unroll") for (int k = 0; k < 2; ++k) dst[m][k] = *(const PG8_LAS bf16x8*)(lds + PG8_SA(b, h) + aoff + m * 2048 + k * 1024); } while (0)
#define PG8_LDB(dst, b, h) do { _Pragma("unroll") for (int n = 0; n < 2; ++n) _Pragma("unroll") for (int k = 0; k < 2; ++k) dst[n][k] = *(const PG8_LAS bf16x8*)(lds + PG8_SB(b, h) + boff + n * 2048 + k * 1024); } while (0)
#define PG8_MMA(ai, bj, At, Bt) do { __builtin_amdgcn_s_setprio(1); _Pragma("unroll") for (int m = 0; m < 4; ++m) _Pragma("unroll") for (int n = 0; n < 2; ++n) _Pragma("unroll") for (int k = 0; k < 2; ++k) \
        acc[ai][bj][m][n] = __builtin_amdgcn_mfma_f32_16x16x32_bf16(Bt[n][k], At[m][k], acc[ai][bj][m][n], 0, 0, 0); __builtin_amdgcn_s_setprio(0); } while (0)
#define PG8_WAIT_V(n) asm volatile("s_waitcnt vmcnt(" #n ")" ::: "memory")
#define PG8_WAIT_L(n) asm volatile("s_waitcnt lgkmcnt(" #n ")" ::: "memory")
#define PG8_BAR __builtin_amdgcn_s_barrier()
#define PG8_SCHED __builtin_amdgcn_sched_barrier(0)
    Unit cur, nxt; int ui = 0;
    if (!S.next(0, cur)) return;
    f32x4 acc[2][2][4][2];
#pragma unroll
    for (int a = 0; a < 2; ++a)
#pragma unroll
        for (int b = 0; b < 2; ++b)
#pragma unroll
            for (int m = 0; m < 4; ++m)
#pragma unroll
                for (int n = 0; n < 2; ++n) acc[a][b][m][n] = (f32x4){0.f, 0.f, 0.f, 0.f};
    bf16x8 At[4][2], B0[2][2], B1[2][2];
    const char* cA = (const char*)g.A + (size_t)cur.pm * tA; const char* cB = (const char*)g.Bt + (size_t)cur.pn * tB;
    S.a_ready(cur);
    if constexpr (SP2) {
        PG8_STAGE(PG8_SB(0, 0), cB, voffB); PG8_STAGE(PG8_SB(0, 1), cB + hB, voffB); PG8_STAGE(PG8_SA(0, 0), cA, voffA); PG8_STAGE(PG8_SA(0, 1), cA + hA, voffA);
        if (wr == 1) PG8_BAR;
        PG8_WAIT_V(2); PG8_BAR;
        PG8_STAGE(PG8_SB(1, 0), cB + kstep, voffB); PG8_STAGE(PG8_SA(1, 0), cA + kstep, voffA); PG8_STAGE(PG8_SB(1, 1), cB + hB + kstep, voffB);
        PG8_WAIT_V(6); PG8_BAR;
    } else {
        PG8_STAGE(PG8_SB(0, 0), cB, voffB); PG8_STAGE(PG8_SA(0, 0), cA, voffA); PG8_STAGE(PG8_SB(0, 1), cB + hB, voffB); PG8_STAGE(PG8_SA(0, 1), cA + hA, voffA);
        if (wr == 1) PG8_BAR;
        PG8_WAIT_V(4); PG8_BAR;
        PG8_STAGE(PG8_SB(1, 0), cB + kstep, voffB); PG8_STAGE(PG8_SA(1, 0), cA + kstep, voffA); PG8_STAGE(PG8_SB(1, 1), cB + hB + kstep, voffB);
        PG8_WAIT_V(6); PG8_BAR;
    }
    for (;;) {
        const bool has_next = S.next(ui + 1, nxt);
        const char* nA = has_next ? (const char*)g.A + (size_t)nxt.pm * tA : cA; const char* nB = has_next ? (const char*)g.Bt + (size_t)nxt.pn * tB : cB;
        for (int t = 0; t < nt; t += 2) {
            const bool last = (t == nt - 2);
            const char* a1 = cA + (size_t)(t + 1) * kstep;
            const char* a2 = last ? nA : cA + (size_t)(t + 2) * kstep; const char* b2 = last ? nB : cB + (size_t)(t + 2) * kstep;
            const char* a3 = a2 + kstep; const char* b3 = b2 + kstep;
            if (last && has_next) S.a_ready(nxt);
            if constexpr (SP2) {
            PG8_LDB(B0, 0, 0); PG8_LDB(B1, 0, 1); PG8_SCHED; PG8_LDA(At, 0, 0); PG8_STAGE(PG8_SA(1, 1), a1 + hA, voffA);
            PG8_WAIT_V(8); PG8_WAIT_L(0); PG8_BAR; PG8_MMA(0, 0, At, B0); PG8_MMA(0, 1, At, B1); PG8_BAR; PG8_SCHED;
            PG8_LDA(At, 0, 1); PG8_STAGE(PG8_SB(0, 0), b2, voffB); PG8_STAGE(PG8_SB(0, 1), b2 + hB, voffB); PG8_STAGE(PG8_SA(0, 0), a2, voffA);
            PG8_WAIT_V(8); PG8_WAIT_L(0); PG8_BAR; PG8_MMA(1, 0, At, B0); PG8_MMA(1, 1, At, B1); PG8_BAR; PG8_SCHED;
            PG8_LDB(B0, 1, 0); PG8_LDB(B1, 1, 1); PG8_SCHED; PG8_LDA(At, 1, 0); PG8_STAGE(PG8_SA(0, 1), a2 + hA, voffA);
            PG8_WAIT_V(8); PG8_WAIT_L(0); PG8_BAR; PG8_MMA(0, 0, At, B0); PG8_MMA(0, 1, At, B1); PG8_BAR; PG8_SCHED;
            PG8_LDA(At, 1, 1); PG8_STAGE(PG8_SB(1, 0), b3, voffB); PG8_STAGE(PG8_SB(1, 1), b3 + hB, voffB); PG8_STAGE(PG8_SA(1, 0), a3, voffA);
            PG8_WAIT_V(8); PG8_WAIT_L(0); PG8_BAR; PG8_MMA(1, 0, At, B0); PG8_MMA(1, 1, At, B1); PG8_BAR; PG8_SCHED;
            } else {
            PG8_LDB(B0, 0, 0); PG8_SCHED; PG8_LDA(At, 0, 0); PG8_STAGE(PG8_SA(1, 1), a1 + hA, voffA);
            PG8_WAIT_L(8); PG8_BAR; PG8_WAIT_L(0); PG8_MMA(0, 0, At, B0); PG8_BAR; PG8_SCHED;
            PG8_LDB(B1, 0, 1); PG8_STAGE(PG8_SB(0, 0), b2, voffB);
            PG8_BAR; PG8_WAIT_L(0); PG8_MMA(0, 1, At, B1); PG8_BAR;
            PG8_LDA(At, 0, 1); PG8_STAGE(PG8_SA(0, 0), a2, voffA);
            PG8_BAR; PG8_WAIT_L(0); PG8_MMA(1, 0, At, B0); PG8_BAR; PG8_SCHED;
            PG8_STAGE(PG8_SB(0, 1), b2 + hB, voffB);
            PG8_WAIT_V(6); PG8_BAR; PG8_MMA(1, 1, At, B1); PG8_BAR;
            PG8_LDB(B0, 1, 0); PG8_SCHED; PG8_LDA(At, 1, 0); PG8_STAGE(PG8_SA(0, 1), a2 + hA, voffA);
            PG8_WAIT_L(8); PG8_BAR; PG8_WAIT_L(0); PG8_MMA(0, 0, At, B0); PG8_BAR; PG8_SCHED;
            PG8_LDB(B1, 1, 1); PG8_STAGE(PG8_SB(1, 0), b3, voffB);
            PG8_BAR; PG8_WAIT_L(0); PG8_MMA(0, 1, At, B1); PG8_BAR;
            PG8_LDA(At, 1, 1); PG8_STAGE(PG8_SA(1, 0), a3, voffA);
            PG8_BAR; PG8_WAIT_L(0); PG8_MMA(1, 0, At, B0); PG8_BAR; PG8_SCHED;
            PG8_STAGE(PG8_SB(1, 1), b3 + hB, voffB);
            PG8_WAIT_V(6); PG8_BAR; PG8_MMA(1, 1, At, B1); PG8_BAR;
            }
        }
        if constexpr (ALIGN_EPI) { if (wr == 0) PG8_BAR; }
        if constexpr (!Epi::AFTER_DRAIN) { E(acc, cur, wr, wc, fr, fq); S.done(cur); }
        if (!has_next) break;
#pragma unroll
        for (int a = 0; a < 2; ++a)
#pragma unroll
            for (int b = 0; b < 2; ++b)
#pragma unroll
                for (int m = 0; m < 4; ++m)
#pragma unroll
                    for (int n = 0; n < 2; ++n) acc[a][b][m][n] = (f32x4){0.f, 0.f, 0.f, 0.f};
        cur = nxt; cA = nA; cB = nB; ++ui;
        if constexpr (ALIGN_EPI) { if (wr == 1) PG8_BAR; }
    }
    PG8_WAIT_V(0);
    if constexpr (!ALIGN_EPI) { if (wr == 0) PG8_BAR; }
    PG8_BAR;
    if constexpr (Epi::AFTER_DRAIN) { E.fused(acc, cur, wr, wc, fr, fq, lds, wid, lane); S.done(cur); }
#undef PG8_SA
#undef PG8_SB
#undef PG8_STAGE
#undef PG8_LDA
#undef PG8_LDB
#undef PG8_MMA
#undef PG8_WAIT_V
#undef PG8_WAIT_L
#undef PG8_BAR
#undef PG8_SCHED
}
}

#ifndef ONE_LAUNCH
#define ONE_LAUNCH 0
#endif
constexpr int NWAVES = 8, NTHR = 512;
constexpr int D = 1024, BATCH = 4, SEQ = 8192, NMETA = 16, TT = SEQ + NMETA;
constexpr int NREAL = BATCH * SEQ;
constexpr int NROWS = NREAL + NMETA;
constexpr int R = 33024;
constexpr int PW = 2304;
constexpr int PC_CQ = 0, PC_CKV = 256, PC_KIDX = 384, PC_WIDX = 448, PC_R = 512, PC_K = 1024, PC_V = 1536, PC_WD = 2048, PC_AD = 2112, PC_GD = 2176;
constexpr int QAW = 1536;
constexpr int DFF = 2816, UPW = 5632;
constexpr int TOPK = 256;
constexpr float LN_EPS = 1e-5f, GN_EPS = 64e-5f, ALPHA = 1.18920711500272f;

constexpr size_t MiB = 1u << 20;
constexpr size_t WS_CTL = 0, CTL_ZERO_BYTES = 1 * MiB;
constexpr size_t WS_WT_IN = 1 * MiB, WS_WT_QA = 6 * MiB, WS_WT_MIX = 7 * MiB, WS_WT_UP = 10 * MiB, WS_WT_DN = 21 * MiB;
constexpr size_t WS_META1 = 27 * MiB, WS_NSEL = 28 * MiB, WS_WIDX = 29 * MiB;
constexpr size_t WS_H = 33 * MiB;
constexpr size_t WS_P = 98 * MiB, WS_QA = 244 * MiB, WS_CQN = 341 * MiB, WS_SEL = 341 * MiB, WS_CKV = 358 * MiB, WS_KIDX = 367 * MiB;
constexpr size_t WS_DEC = 372 * MiB, WS_AB = 437 * MiB, WS_GB = 470 * MiB;
constexpr size_t WS_WT_LORA = 26 * MiB + 512 * 1024;
constexpr size_t WS_RWM = 372 * MiB, WS_RWN = 405 * MiB, WS_RWQ = 438 * MiB, WS_RWY = 471 * MiB;
constexpr size_t OUT_RWS = 80 * MiB, OUT_BONUS = 116 * MiB;
constexpr size_t WS_G01 = 480 * MiB, WS_V01 = 484 * MiB, WS_GHALO = 488 * MiB, WS_GMETA = 492 * MiB;
constexpr size_t WS_UP = 98 * MiB;
constexpr size_t WS_END = 512 * MiB;
static_assert(WS_P + (size_t)R * PW * 2 <= WS_QA && WS_QA + (size_t)R * QAW * 2 <= WS_CQN && WS_CQN + (size_t)R * 256 * 2 <= WS_CKV && WS_CKV + (size_t)R * 128 * 2 <= WS_KIDX
              && WS_KIDX + (size_t)R * 64 * 2 <= WS_DEC && WS_DEC + (size_t)R * 512 * 4 <= WS_AB && WS_AB + (size_t)R * 512 * 2 <= WS_GB && WS_GB + (size_t)R * 512 * 2 <= WS_END
              && WS_UP + (size_t)R * UPW * 2 <= WS_END && WS_H + (size_t)R * D * 2 <= WS_P && WS_WIDX + (size_t)R * 8 * 4 <= WS_H && WS_NSEL + (size_t)R * 4 <= WS_WIDX, "ws map");
constexpr int CW_BAR = 4096;

constexpr int RING_OFF = 0, RING_BYTES = 131072;
constexpr int LDSCTL_OFF = RING_BYTES, MISC_OFF = LDSCTL_OFF + 320;
constexpr int LDS_BYTES = 147456;

#define GAS __attribute__((address_space(1)))
#define LAS __attribute__((address_space(3)))
typedef unsigned short bf16;
typedef unsigned v4u __attribute__((ext_vector_type(4)));
typedef unsigned v2u __attribute__((ext_vector_type(2)));
typedef float f32x4 __attribute__((ext_vector_type(4)));
typedef GAS unsigned gu32;
typedef __bf16 bf16x2_t __attribute__((ext_vector_type(2)));
__device__ __forceinline__ unsigned f2bf(float f) { return (unsigned)__builtin_bit_cast(unsigned short, (__bf16)f); }
__device__ __forceinline__ unsigned pk2(float lo, float hi) { const bf16x2_t v = {(__bf16)lo, (__bf16)hi}; return __builtin_bit_cast(unsigned, v); }
__device__ __forceinline__ float fast_rcp(float x) { return __builtin_amdgcn_rcpf(x); }
__device__ __forceinline__ float fast_tanh(float x) { return 1.0f - 2.0f * __builtin_amdgcn_rcpf(1.0f + __expf(2.0f * x)); }
__device__ __forceinline__ float bf2f(unsigned short b) { return __uint_as_float(((unsigned)b) << 16); }
__device__ __forceinline__ float bflo(unsigned w) { return __uint_as_float(w << 16); }
__device__ __forceinline__ float bfhi(unsigned w) { return __uint_as_float(w & 0xffff0000u); }
#define DPP_F(v, ctrl) __builtin_bit_cast(float, __builtin_amdgcn_update_dpp(0, __builtin_bit_cast(int, (v)), (ctrl), 0xf, 0xf, false))
__device__ __forceinline__ float rdlane_f(float v, int lane) { return __builtin_bit_cast(float, __builtin_amdgcn_readlane(__builtin_bit_cast(int, v), lane)); }
__device__ __forceinline__ float wave_sum(float v) {
    v += DPP_F(v, 0xB1); v += DPP_F(v, 0x4E); v += DPP_F(v, 0x141); v += DPP_F(v, 0x140);
    return (rdlane_f(v, 0) + rdlane_f(v, 16)) + (rdlane_f(v, 32) + rdlane_f(v, 48));
}
__device__ __forceinline__ float wave_max(float v) {
    v = fmaxf(v, DPP_F(v, 0xB1)); v = fmaxf(v, DPP_F(v, 0x4E)); v = fmaxf(v, DPP_F(v, 0x141)); v = fmaxf(v, DPP_F(v, 0x140));
    return fmaxf(fmaxf(rdlane_f(v, 0), rdlane_f(v, 16)), fmaxf(rdlane_f(v, 32), rdlane_f(v, 48)));
}
#define DPP_U0(v, ctrl) ((unsigned)__builtin_amdgcn_update_dpp(0, (int)(v), (ctrl), 0xf, 0xf, true))
__device__ __forceinline__ unsigned wave_scan_incl(unsigned v, int lane) {
    v += DPP_U0(v, 0x111); v += DPP_U0(v, 0x112); v += DPP_U0(v, 0x114); v += DPP_U0(v, 0x118);
    const unsigned r0 = (unsigned)__builtin_amdgcn_readlane((int)v, 15), r1 = (unsigned)__builtin_amdgcn_readlane((int)v, 31), r2 = (unsigned)__builtin_amdgcn_readlane((int)v, 47);
    const int row = lane >> 4;
    return v + (row >= 1 ? r0 : 0u) + (row >= 2 ? r1 : 0u) + (row >= 3 ? r2 : 0u);
}
__device__ __forceinline__ float sigmoidf_(float x) { return __builtin_amdgcn_rcpf(1.0f + __expf(-x)); }
#define XB_TMO      128
#define XB_XCNT(j)  (256  + 64 * (j))
#define XB_XSUB(j)  (1280 + 64 * (j))
#define XB_XGEN(j)  (2304 + 64 * (j))
#define XB_TOP      3328
#define XB_TOPGEN   3392
#define XCD_BAR_WORDS 3456
#define XB_SPIN_CAP (1u << 18)

__device__ __forceinline__ unsigned xb_ld(unsigned* p)              { return __hip_atomic_load(p, __ATOMIC_RELAXED, __HIP_MEMORY_SCOPE_AGENT); }
__device__ __forceinline__ unsigned xb_add(unsigned* p, unsigned v) { return __hip_atomic_fetch_add(p, v, __ATOMIC_RELAXED, __HIP_MEMORY_SCOPE_AGENT); }
__device__ __forceinline__ unsigned xb_xcc_id() { return (unsigned)__builtin_amdgcn_s_getreg((3 << 11) | 20) & 0xFu; }
#define XB_SPIN(cond, bar) do { unsigned _sp = 0; while (cond) { __builtin_amdgcn_s_sleep(1); \
    if ((++_sp & 255u) == 0u) { if (xb_ld(&(bar)[XB_TMO])) break; if (_sp > XB_SPIN_CAP) { atomicAdd(&(bar)[XB_TMO], 1u); break; } } } } while (0)

struct XcdBarrier {
    unsigned* bar; unsigned x;
    volatile LAS unsigned* st;
};

__device__ __forceinline__ XcdBarrier xcd_barrier_post(unsigned* bar, volatile LAS unsigned* st) {
    XcdBarrier b; b.bar = bar; b.x = xb_xcc_id(); b.st = st;
    if (threadIdx.x == 0) (void)xb_add(&bar[XB_XCNT(b.x)], 1u);
    return b;
}
__device__ __forceinline__ void xcd_barrier_complete(unsigned* bar, unsigned x, unsigned& nloc, unsigned& nx) {
    const unsigned G = gridDim.x * gridDim.y * gridDim.z;
    unsigned sum, cnt, mine, sp = 0u;
    for (;;) {
        sum = 0u; cnt = 0u; mine = 0u;
#pragma unroll
        for (unsigned j = 0; j < 16; ++j) { const unsigned c = xb_ld(&bar[XB_XCNT(j)]); sum += c; cnt += (c > 0u) ? 1u : 0u; mine = (j == x) ? c : mine; }
        if (sum == G) break;
        __builtin_amdgcn_s_sleep(1);
        if ((++sp & 255u) == 0u) { if (xb_ld(&bar[XB_TMO])) break; if (sp > XB_SPIN_CAP) { atomicAdd(&bar[XB_TMO], 1u); break; } }
    }
    nloc = mine > 0u ? mine : 1u; nx = cnt > 0u ? cnt : 1u;
}

__device__ __forceinline__ void xcd_barrier(const XcdBarrier& b) {
    asm volatile("s_waitcnt vmcnt(0)" ::: "memory");
    __syncthreads();
    if (threadIdx.x == 0) {
        unsigned* bar = b.bar;
        __builtin_amdgcn_s_waitcnt(0);
        unsigned nloc = b.st[0], nx = b.st[1];
        if (nloc == 0u) { xcd_barrier_complete(bar, b.x, nloc, nx); b.st[0] = nloc; b.st[1] = nx; }
        const unsigned old = xb_add(&bar[XB_XSUB(b.x)], 1u);
        const unsigned gen = old / nloc;
        if (old + 1u == (gen + 1u) * nloc) {
            __builtin_amdgcn_fence(__ATOMIC_RELEASE, "agent");
            asm volatile("s_waitcnt vmcnt(0)" ::: "memory");
            const unsigned og = xb_add(&bar[XB_TOP], 1u);
            const unsigned tg = og / nx;
            if (og + 1u == (tg + 1u) * nx) xb_add(&bar[XB_TOPGEN], 1u);
            else XB_SPIN(xb_ld(&bar[XB_TOPGEN]) == tg, bar);
            __builtin_amdgcn_fence(__ATOMIC_ACQUIRE, "agent");
            xb_add(&bar[XB_XGEN(b.x)], 1u);
            asm volatile("s_waitcnt vmcnt(0)" ::: "memory");
        } else {
            XB_SPIN(xb_ld(&bar[XB_XGEN(b.x)]) == gen, bar);
            __builtin_amdgcn_fence(__ATOMIC_ACQUIRE, "agent");
            asm volatile("s_waitcnt vmcnt(0)" ::: "memory");
        }
    }
    __syncthreads();
}

struct Frame {
    LAS unsigned char* lds;
    volatile LAS unsigned* MISC;
    gu32* ctl;
    int tid, lane, wave, G;
    const float* in[32];
    float* out;
    unsigned char* ws;
};
#define IN_X 0
#define IN_META 1
#define IN_LNIN_G 2
#define IN_LNIN_B 3
#define IN_W_IN 4
#define IN_QNORM_G 5
#define IN_W_UQ 6
#define IN_KVNORM_G 7
#define IN_W_UKV 8
#define IN_W_IQ 9
#define IN_IDXLN_G 10
#define IN_IDXLN_B 11
#define IN_MU 12
#define IN_W0 13
#define IN_W_DEC 14
#define IN_A0 15
#define IN_W_AAA 16
#define IN_W_GATE 17
#define IN_KK 18
#define IN_KA 19
#define IN_RK 20
#define IN_GN_G 21
#define IN_GN_B 22
#define IN_W_OUT 23
#define IN_LN1_G 24
#define IN_LN1_B 25
#define IN_W_UP 26
#define IN_CONV_W 27
#define IN_CONV_B 28
#define IN_W_DN 29
#define IN_LN2_G 30
#define IN_LN2_B 31

#define WSP(T, off) ((T*)(F.ws + (off)))

__device__ __forceinline__ int key_row(int b, int j) { return j < NMETA ? NREAL + j : b * SEQ + (j - NMETA); }

__device__ __forceinline__ void tr_items(Frame& F, const float* src, int src_ld, int src_r0, bf16* dst, int dst_ld, int dst_c0, int Nn, int K, int cut0, int cut1, int shift) {
    const int total = Nn * (K / 8);
    for (int it = blockIdx.x * NTHR + F.tid; it < total; it += F.G * NTHR) {
        const int n = it % Nn, kc = it / Nn;
        const int col = n < cut0 ? n : (n < cut1 ? -1 : n - shift);
        float v[8];
#pragma unroll
        for (int e = 0; e < 8; ++e) v[e] = col >= 0 ? src[(size_t)(src_r0 + 8 * kc + e) * src_ld + col] : 0.f;
        v4u o; o.x = pk2(v[0], v[1]); o.y = pk2(v[2], v[3]); o.z = pk2(v[4], v[5]); o.w = pk2(v[6], v[7]);
        *(v4u*)(dst + (size_t)n * dst_ld + dst_c0 + 8 * kc) = o;
    }
}
__device__ __forceinline__ void p0_weights(Frame& F) {
    bf16* WT_IN = WSP(bf16, WS_WT_IN); bf16* WT_QA = WSP(bf16, WS_WT_QA); bf16* WT_MIX = WSP(bf16, WS_WT_MIX); bf16* WT_UP = WSP(bf16, WS_WT_UP); bf16* WT_DN = WSP(bf16, WS_WT_DN);
    tr_items(F, F.in[IN_W_IN], 2248, 0, WT_IN, D, 0, PW, D, 456, 512, 56);
    {
        const float* src = F.in[IN_W_UP];
        for (int it = blockIdx.x * NTHR + F.tid; it < UPW * (D / 8); it += F.G * NTHR) {
            const int n = it % UPW, kc = it / UPW, pn = n >> 8, x = n & 255;
            const int col = x < 128 ? 128 * pn + x : DFF + 128 * pn + (x - 128);
            float v[8];
#pragma unroll
            for (int e = 0; e < 8; ++e) v[e] = src[(size_t)(8 * kc + e) * UPW + col];
            *(v4u*)(WT_UP + (size_t)n * D + 8 * kc) = (v4u){pk2(v[0], v[1]), pk2(v[2], v[3]), pk2(v[4], v[5]), pk2(v[6], v[7])};
        }
    }
    tr_items(F, F.in[IN_W_DN], D, 0, WT_DN, DFF, 0, D, DFF, D, D, 0);
    tr_items(F, F.in[IN_W_IQ], 512, 0, WT_QA + (size_t)1024 * 256, 256, 0, 512, 256, 512, 512, 0);
    tr_items(F, F.in[IN_W_OUT], D, 512, WT_MIX, 1536, 1024, D, 512, D, D, 0);
    {
        bf16* WdT = WSP(bf16, WS_WT_LORA);
        tr_items(F, F.in[IN_W_DEC], 512, 0, WdT, 64, 0, 512, 64, 512, 512, 0);
        tr_items(F, F.in[IN_W_AAA], 512, 0, WdT + 512 * 64, 64, 0, 512, 64, 512, 512, 0);
        tr_items(F, F.in[IN_W_GATE], 512, 0, WdT + 2 * 512 * 64, 128, 0, 512, 128, 512, 512, 0);
    }
    const float* w_uq = F.in[IN_W_UQ]; const float* w_ukv = F.in[IN_W_UKV]; const float* w_out = F.in[IN_W_OUT];
    for (int it = blockIdx.x * NTHR + F.tid; it < 1024 * 256; it += F.G * NTHR) {
        const int c = it & 255, n = it >> 8, h = n >> 7, j = n & 127;
        float s = 0.f;
        for (int d = 0; d < 64; ++d) s += w_uq[(size_t)c * 512 + h * 64 + d] * w_ukv[(size_t)j * 1024 + h * 128 + d];
        WT_QA[(size_t)n * 256 + c] = (bf16)f2bf(0.125f * s);
    }
    for (int it = blockIdx.x * NTHR + F.tid; it < 1024 * 1024; it += F.G * NTHR) {
        const int n = it & 1023, k = it >> 10, h = k >> 7, j = k & 127;
        float s = 0.f;
        for (int d = 0; d < 64; ++d) s += w_ukv[(size_t)j * 1024 + h * 128 + 64 + d] * w_out[(size_t)(h * 64 + d) * D + n];
        WT_MIX[(size_t)n * 1536 + k] = (bf16)f2bf(s);
    }
}

__device__ __forceinline__ void ln_row_bf16(Frame& F, const float* src, const float* g, const float* b, bf16* dst) {
    v2u* o8 = (v2u*)dst + F.lane;
    if (!src) {
#pragma unroll
        for (int j = 0; j < 4; ++j) o8[64 * j] = (v2u){0u, 0u};
        return;
    }
    const f32x4* xr = (const f32x4*)src + F.lane;
    f32x4 v[4]; float s = 0.f;
#pragma unroll
    for (int j = 0; j < 4; ++j) { v[j] = xr[64 * j]; s += (v[j].x + v[j].y) + (v[j].z + v[j].w); }
    const float mean = wave_sum(s) * (1.f / D); float s2 = 0.f;
#pragma unroll
    for (int j = 0; j < 4; ++j) { v[j] = v[j] - mean; s2 += (v[j].x * v[j].x + v[j].y * v[j].y) + (v[j].z * v[j].z + v[j].w * v[j].w); }
    const float rstd = 1.f / sqrtf(wave_sum(s2) * (1.f / D) + LN_EPS);
#pragma unroll
    for (int j = 0; j < 4; ++j) {
        const f32x4 gg = ((const f32x4*)g)[F.lane + 64 * j], bb = ((const f32x4*)b)[F.lane + 64 * j];
        const f32x4 y = v[j] * rstd * gg + bb;
        o8[64 * j] = (v2u){pk2(y.x, y.y), pk2(y.z, y.w)};
    }
}
__device__ __forceinline__ void p1_ln_in(Frame& F) {
    bf16* H0 = WSP(bf16, WS_H);
    const int gw = blockIdx.x * NWAVES + F.wave, NGW = F.G * NWAVES;
    for (int r = gw; r < R; r += NGW) {
        const float* src = r < NREAL ? F.in[IN_X] + (size_t)r * D : (r < NROWS ? F.in[IN_META] + (size_t)(r - NREAL) * D : nullptr);
        ln_row_bf16(F, src, F.in[IN_LNIN_G], F.in[IN_LNIN_B], H0 + (size_t)r * D);
    }
}

__device__ __forceinline__ void p3_prep(Frame& F) {
    const bf16* P = WSP(bf16, WS_P); bf16* CQN = WSP(bf16, WS_CQN); bf16* CKV = WSP(bf16, WS_CKV); bf16* KIDX = WSP(bf16, WS_KIDX); float* WIDX = WSP(float, WS_WIDX);
    const int gw = blockIdx.x * NWAVES + F.wave, NGW = F.G * NWAVES, l = F.lane;
    for (int r = gw; r < R; r += NGW) {
        const bf16* pr = P + (size_t)r * PW;
        if (r >= NROWS) {
            *(v2u*)(CQN + (size_t)r * 256 + 4 * l) = (v2u){0u, 0u};
            continue;
        }
        {
            const v2u w = *(const v2u*)(pr + PC_CQ + 4 * l);
            const float a0 = bflo(w.x), a1 = bfhi(w.x), a2 = bflo(w.y), a3 = bfhi(w.y);
            const float ss = wave_sum(a0 * a0 + a1 * a1 + a2 * a2 + a3 * a3);
            const float rs = 1.0f / sqrtf(ss * (1.f / 256.f) + 1e-6f);
            const f32x4 g = ((const f32x4*)F.in[IN_QNORM_G])[l];
            *(v2u*)(CQN + (size_t)r * 256 + 4 * l) = (v2u){pk2(a0 * rs * g.x, a1 * rs * g.y), pk2(a2 * rs * g.z, a3 * rs * g.w)};
        }
        {
            const unsigned w = *(const unsigned*)(pr + PC_CKV + 2 * l);
            const float a0 = bflo(w), a1 = bfhi(w);
            const float ss = wave_sum(a0 * a0 + a1 * a1);
            const float rs = 1.0f / sqrtf(ss * (1.f / 128.f) + 1e-6f);
            const float g0 = F.in[IN_KVNORM_G][2 * l], g1 = F.in[IN_KVNORM_G][2 * l + 1];
            *(unsigned*)(CKV + (size_t)r * 128 + 2 * l) = pk2(a0 * rs * g0, a1 * rs * g1);
        }
        {
            const float a = bf2f(pr[PC_KIDX + l]);
            const float mean = wave_sum(a) * (1.f / 64.f);
            const float dlt = a - mean;
            const float var = wave_sum(dlt * dlt) * (1.f / 64.f);
            const float y = dlt * (1.0f / sqrtf(var + LN_EPS)) * F.in[IN_IDXLN_G][l] + F.in[IN_IDXLN_B][l];
            KIDX[(size_t)r * 64 + l] = (bf16)f2bf(y);
        }
        if (l < 8) WIDX[(size_t)r * 8 + l] = bf2f(pr[PC_WIDX + l]) * 0.04419417382415922f;
    }
}

#ifndef REFSEL
#define REFSEL 0
#endif
__device__ __forceinline__ void refsel_rows(Frame& F) {
    float* QIDX32 = F.out; float* KIDX32 = F.out + (size_t)R * 512; float* WIDX = WSP(float, WS_WIDX);
    const float* w_in = F.in[IN_W_IN]; const float* w_iq = F.in[IN_W_IQ];
    LAS float* hrow = (LAS float*)(F.lds + F.wave * 8192);
    LAS float* cqn = hrow + 1024;
    const int l = F.lane;
    const int gw = blockIdx.x * NWAVES + F.wave, NGW = F.G * NWAVES;
    for (int r = gw; r < NROWS; r += NGW) {
        const float* src = r < NREAL ? F.in[IN_X] + (size_t)r * D : F.in[IN_META] + (size_t)(r - NREAL) * D;
        {
            const f32x4* xr = (const f32x4*)src + l;
            f32x4 v[4]; float s = 0.f;
#pragma unroll
            for (int j = 0; j < 4; ++j) { v[j] = xr[64 * j]; s += (v[j].x + v[j].y) + (v[j].z + v[j].w); }
            const float mean = wave_sum(s) * (1.f / D); float s2 = 0.f;
#pragma unroll
            for (int j = 0; j < 4; ++j) { v[j] = v[j] - mean; s2 += (v[j].x * v[j].x + v[j].y * v[j].y) + (v[j].z * v[j].z + v[j].w * v[j].w); }
            const float rstd = 1.f / sqrtf(wave_sum(s2) * (1.f / D) + LN_EPS);
#pragma unroll
            for (int j = 0; j < 4; ++j) {
                const f32x4 gg = ((const f32x4*)F.in[IN_LNIN_G])[l + 64 * j], bb = ((const f32x4*)F.in[IN_LNIN_B])[l + 64 * j];
                *(LAS f32x4*)(hrow + 4 * (l + 64 * j)) = v[j] * rstd * gg + bb;
            }
        }
        __builtin_amdgcn_wave_barrier();
        float a[6];
#pragma unroll
        for (int i = 0; i < 6; ++i) a[i] = 0.f;
        for (int k = 0; k < D; ++k) {
            const float hk = hrow[k]; const float* wr = w_in + (size_t)k * 2248;
#pragma unroll
            for (int i = 0; i < 4; ++i) a[i] += hk * wr[l + 64 * i];
            a[4] += hk * wr[384 + l];
            a[5] += hk * wr[448 + (l & 7)];
        }
        const float ss = wave_sum(a[0] * a[0] + a[1] * a[1] + a[2] * a[2] + a[3] * a[3]);
        const float rs = 1.0f / sqrtf(ss * (1.f / 256.f) + 1e-6f);
#pragma unroll
        for (int i = 0; i < 4; ++i) cqn[l + 64 * i] = a[i] * rs * F.in[IN_QNORM_G][l + 64 * i];
        {
            const float mean = wave_sum(a[4]) * (1.f / 64.f); const float dlt = a[4] - mean;
            const float var = wave_sum(dlt * dlt) * (1.f / 64.f);
            KIDX32[(size_t)r * 64 + l] = dlt * (1.0f / sqrtf(var + LN_EPS)) * F.in[IN_IDXLN_G][l] + F.in[IN_IDXLN_B][l];
        }
        if (l < 8) WIDX[(size_t)r * 8 + l] = a[5] * 0.04419417382415922f;
        __builtin_amdgcn_wave_barrier();
        float q[8];
#pragma unroll
        for (int i = 0; i < 8; ++i) q[i] = 0.f;
        for (int c = 0; c < 256; ++c) {
            const float cq = cqn[c]; const float* wr = w_iq + (size_t)c * 512;
#pragma unroll
            for (int i = 0; i < 8; ++i) q[i] += cq * wr[l + 64 * i];
        }
#pragma unroll
        for (int i = 0; i < 8; ++i) QIDX32[(size_t)r * 512 + l + 64 * i] = q[i];
        __builtin_amdgcn_wave_barrier();
    }
}

__device__ __forceinline__ unsigned sortable(float f) { const unsigned u = __float_as_uint(f); return (u & 0x80000000u) ? ~u : (u | 0x80000000u); }
__device__ __forceinline__ void p5_index_naive(Frame& F) {
    const bf16* QA = WSP(bf16, WS_QA); const bf16* KIDX = WSP(bf16, WS_KIDX); const float* WIDX = WSP(float, WS_WIDX);
    unsigned short* SEL = WSP(unsigned short, WS_SEL); int* NSEL = WSP(int, WS_NSEL);
    LAS float* sc = (LAS float*)(F.lds);
    LAS float* qf = (LAS float*)(F.lds + 33024);
    LAS unsigned* hist = (LAS unsigned*)(F.lds + 33024 + 2048);
    LAS unsigned* cw = hist + 256;
    const int tid = F.tid;
    for (int q = blockIdx.x; q < NROWS; q += F.G) {
        int b, pos; if (q < NREAL) { b = q >> 13; pos = NMETA + (q & (SEQ - 1)); } else { b = 0; pos = q - NREAL; }
        const int nvis = pos < NMETA ? NMETA : NMETA + 64 * ((pos - NMETA) / 64 + 1);
#if REFSEL
        qf[tid] = F.out[(size_t)q * 512 + tid];
#else
        qf[tid] = bf2f(QA[(size_t)q * QAW + 1024 + tid]);
#endif
        float w[8];
#pragma unroll
        for (int h = 0; h < 8; ++h) w[h] = WIDX[(size_t)q * 8 + h];
        __syncthreads();
        for (int j = tid; j < nvis; j += NTHR) {
            const v4u* kp = (const v4u*)(KIDX + (size_t)key_row(b, j) * 64);
#if REFSEL
            const f32x4* kp32 = (const f32x4*)(F.out + (size_t)R * 512 + (size_t)key_row(b, j) * 64);
#endif
            float d[8];
#pragma unroll
            for (int h = 0; h < 8; ++h) d[h] = 0.f;
#pragma unroll 2
            for (int c = 0; c < 8; ++c) {
#if REFSEL
                const f32x4 ta = kp32[2 * c], tb = kp32[2 * c + 1];
                const float k0 = ta.x, k1 = ta.y, k2 = ta.z, k3 = ta.w, k4 = tb.x, k5 = tb.y, k6 = tb.z, k7 = tb.w;
#else
                const v4u t = kp[c];
                const float k0 = bflo(t.x), k1 = bfhi(t.x), k2 = bflo(t.y), k3 = bfhi(t.y), k4 = bflo(t.z), k5 = bfhi(t.z), k6 = bflo(t.w), k7 = bfhi(t.w);
#endif
#pragma unroll
                for (int h = 0; h < 8; ++h) {
                    const f32x4 qa = *(const LAS f32x4*)(qf + h * 64 + 8 * c), qb = *(const LAS f32x4*)(qf + h * 64 + 8 * c + 4);
                    d[h] += qa.x * k0 + qa.y * k1 + qa.z * k2 + qa.w * k3 + qb.x * k4 + qb.y * k5 + qb.z * k6 + qb.w * k7;
                }
            }
            float s = 0.f;
#pragma unroll
            for (int h = 0; h < 8; ++h) s += w[h] * fmaxf(d[h], 0.f);
            sc[j] = s + 0.0f;
        }
        __syncthreads();
        unsigned short* selq = SEL + (size_t)q * TOPK;
        if (nvis <= TOPK) {
            for (int j = tid; j < nvis; j += NTHR) selq[j] = (unsigned short)j;
        } else {
            unsigned prefix = 0u, mask = 0u, need = TOPK;
            for (int pass = 0; pass < 4; ++pass) {
                const int shift = 24 - 8 * pass;
                if (tid < 256) hist[tid] = 0u;
                __syncthreads();
                for (int j = tid; j < nvis; j += NTHR) { const unsigned key = sortable(sc[j]); if ((key & mask) == prefix) atomicAdd((unsigned*)&hist[(key >> shift) & 255u], 1u); }
                __syncthreads();
                if (tid < 256) {
                    unsigned above = 0u; for (int bb = tid + 1; bb < 256; ++bb) above += hist[bb];
                    const unsigned c = hist[tid];
                    if (above < need && need <= above + c) { cw[0] = prefix | ((unsigned)tid << shift); cw[1] = need - above; }
                }
                __syncthreads();
                prefix = cw[0]; need = cw[1]; mask |= 0xFFu << shift;
                __syncthreads();
            }
            if (tid == 0) cw[2] = 0u;
            __syncthreads();
            for (int j = tid; j < nvis; j += NTHR) { if (sortable(sc[j]) > prefix) { const unsigned p = atomicAdd((unsigned*)&cw[2], 1u); selq[p] = (unsigned short)j; } }
            __syncthreads();
            if (F.wave == 0) {
                const unsigned base = cw[2]; unsigned taken = 0u;
                for (int j0 = 0; j0 < nvis && taken < need; j0 += 64) {
                    const int j = j0 + F.lane; const bool eq = j < nvis && sortable(sc[j]) == prefix;
                    const unsigned long long m = __ballot(eq);
                    const unsigned rank = (unsigned)__popcll(m & ((1ull << F.lane) - 1ull));
                    if (eq && taken + rank < need) selq[base + taken + rank] = (unsigned short)j;
                    taken += (unsigned)__popcll(m);
                }
            }
        }
        if (tid == 0) NSEL[q] = nvis < TOPK ? nvis : TOPK;
        __syncthreads();
    }
}

__device__ __forceinline__ void p6_attn_naive(Frame& F) {
    bf16* QA = WSP(bf16, WS_QA); const bf16* CKV = WSP(bf16, WS_CKV); const unsigned short* SEL = WSP(unsigned short, WS_SEL); const int* NSEL = WSP(int, WS_NSEL);
    LAS float* qf = (LAS float*)(F.lds + F.wave * 16384);
    LAS float* ps = qf + 1024;
    LAS int* srow = (LAS int*)(ps + 2048);
    const int l = F.lane;
    const int gw = blockIdx.x * NWAVES + F.wave, NGW = F.G * NWAVES;
    for (int q = gw; q < R; q += NGW) {
        bf16* qrow = QA + (size_t)q * QAW;
        if (q >= NROWS) {
            for (int c = l; c < QAW / 8; c += 64) *(v4u*)(qrow + 8 * c) = (v4u){0u, 0u, 0u, 0u};
            continue;
        }
        int b, pos; if (q < NREAL) { b = q >> 13; pos = NMETA + (q & (SEQ - 1)); } else { b = 0; pos = q - NREAL; }
        const int nsel = NSEL[q];
        {
            const v4u t0 = *(const v4u*)(qrow + 16 * l), t1 = *(const v4u*)(qrow + 16 * l + 8);
            LAS float* d = qf + 16 * l;
            d[0] = bflo(t0.x); d[1] = bfhi(t0.x); d[2] = bflo(t0.y); d[3] = bfhi(t0.y); d[4] = bflo(t0.z); d[5] = bfhi(t0.z); d[6] = bflo(t0.w); d[7] = bfhi(t0.w);
            d[8] = bflo(t1.x); d[9] = bfhi(t1.x); d[10] = bflo(t1.y); d[11] = bfhi(t1.y); d[12] = bflo(t1.z); d[13] = bfhi(t1.z); d[14] = bflo(t1.w); d[15] = bfhi(t1.w);
        }
        __builtin_amdgcn_wave_barrier();
        for (int kk = 0; kk < 4; ++kk) {
            const int s = kk * 64 + l; const bool valid = s < nsel;
            const int j = valid ? (int)SEL[(size_t)q * TOPK + s] : 0;
            const int row = key_row(b, j);
            srow[s] = row;
            float acc[8];
#pragma unroll
            for (int h = 0; h < 8; ++h) acc[h] = 0.f;
            const v4u* kp = (const v4u*)(CKV + (size_t)row * 128);
            for (int c8 = 0; c8 < 16; ++c8) {
                const v4u t = kp[c8];
                const float k0 = bflo(t.x), k1 = bfhi(t.x), k2 = bflo(t.y), k3 = bfhi(t.y), k4 = bflo(t.z), k5 = bfhi(t.z), k6 = bflo(t.w), k7 = bfhi(t.w);
#pragma unroll
                for (int h = 0; h < 8; ++h) {
                    const f32x4 qa = *(const LAS f32x4*)(qf + h * 128 + 8 * c8), qb = *(const LAS f32x4*)(qf + h * 128 + 8 * c8 + 4);
                    acc[h] += qa.x * k0 + qa.y * k1 + qa.z * k2 + qa.w * k3 + qb.x * k4 + qb.y * k5 + qb.z * k6 + qb.w * k7;
                }
            }
            const float dist = fabsf((float)(pos - j));
#pragma unroll
            for (int h = 0; h < 8; ++h) { const float slope = __uint_as_float((unsigned)(127 - (h + 1)) << 23); ps[s * 8 + h] = valid ? acc[h] - slope * dist : -INFINITY; }
        }
        __builtin_amdgcn_wave_barrier();
#pragma unroll
        for (int h = 0; h < 8; ++h) {
            float v0 = ps[(l) * 8 + h], v1 = ps[(l + 64) * 8 + h], v2 = ps[(l + 128) * 8 + h], v3 = ps[(l + 192) * 8 + h];
            const float mx = wave_max(fmaxf(fmaxf(v0, v1), fmaxf(v2, v3)));
            v0 = __expf(v0 - mx); v1 = __expf(v1 - mx); v2 = __expf(v2 - mx); v3 = __expf(v3 - mx);
            const float inv = 1.0f / wave_sum((v0 + v1) + (v2 + v3));
            ps[(l) * 8 + h] = v0 * inv; ps[(l + 64) * 8 + h] = v1 * inv; ps[(l + 128) * 8 + h] = v2 * inv; ps[(l + 192) * 8 + h] = v3 * inv;
        }
        __builtin_amdgcn_wave_barrier();
        float o0[8], o1[8];
#pragma unroll
        for (int h = 0; h < 8; ++h) { o0[h] = 0.f; o1[h] = 0.f; }
        for (int s = 0; s < nsel; ++s) {
            const int row = srow[s];
            const unsigned w = *(const unsigned*)(CKV + (size_t)row * 128 + 2 * l);
            const float c0 = bflo(w), c1 = bfhi(w);
            const f32x4 pa = *(const LAS f32x4*)(ps + s * 8), pb = *(const LAS f32x4*)(ps + s * 8 + 4);
            o0[0] += pa.x * c0; o1[0] += pa.x * c1; o0[1] += pa.y * c0; o1[1] += pa.y * c1; o0[2] += pa.z * c0; o1[2] += pa.z * c1; o0[3] += pa.w * c0; o1[3] += pa.w * c1;
            o0[4] += pb.x * c0; o1[4] += pb.x * c1; o0[5] += pb.y * c0; o1[5] += pb.y * c1; o0[6] += pb.z * c0; o1[6] += pb.z * c1; o0[7] += pb.w * c0; o1[7] += pb.w * c1;
        }
#pragma unroll
        for (int h = 0; h < 8; ++h) *(unsigned*)(qrow + h * 128 + 2 * l) = pk2(o0[h], o1[h]);
        __builtin_amdgcn_wave_barrier();
    }
}

__device__ __forceinline__ void p7_rwkv_prep_naive(Frame& F) {
    const bf16* P = WSP(bf16, WS_P); float* DEC = WSP(float, WS_DEC); bf16* AB = WSP(bf16, WS_AB); bf16* GB = WSP(bf16, WS_GB);
    const float* mu = F.in[IN_MU]; const float* Wd = F.in[IN_W_DEC]; const float* Wa = F.in[IN_W_AAA]; const float* Wg = F.in[IN_W_GATE];
    const int l = F.lane;
    const int gw = blockIdx.x * NWAVES + F.wave, NGW = F.G * NWAVES;
    for (int r = gw; r < NROWS; r += NGW) {
        int prev; if (r < NREAL) { prev = (r & (SEQ - 1)) ? r - 1 : NREAL + NMETA - 1; } else { prev = r > NREAL ? r - 1 : -1; }
        const bf16* pr = P + (size_t)r * PW; const bf16* pp = prev >= 0 ? P + (size_t)prev * PW : nullptr;
#define SHIFTED(pc, mc) (bf2f(pr[pc]) + ((pp ? bf2f(pp[pc]) : 0.f) - bf2f(pr[pc])) * mu[mc])
        const float tw = tanhf(SHIFTED(PC_WD + l, 1536 + l));
        const float ta = SHIFTED(PC_AD + l, 1600 + l);
        const float tg0 = sigmoidf_(SHIFTED(PC_GD + l, 1664 + l)), tg1 = sigmoidf_(SHIFTED(PC_GD + 64 + l, 1728 + l));
#undef SHIFTED
        float aw[8], aa[8], ag[8];
#pragma unroll
        for (int i = 0; i < 8; ++i) { aw[i] = F.in[IN_W0][l + 64 * i]; aa[i] = F.in[IN_A0][l + 64 * i]; ag[i] = 0.f; }
        for (int j = 0; j < 64; ++j) {
            const float xw = __shfl(tw, j), xa = __shfl(ta, j), xg0 = __shfl(tg0, j), xg1 = __shfl(tg1, j);
#pragma unroll
            for (int i = 0; i < 8; ++i) {
                aw[i] += xw * Wd[(size_t)j * 512 + l + 64 * i];
                aa[i] += xa * Wa[(size_t)j * 512 + l + 64 * i];
                ag[i] += xg0 * Wg[(size_t)j * 512 + l + 64 * i] + xg1 * Wg[(size_t)(j + 64) * 512 + l + 64 * i];
            }
        }
#pragma unroll
        for (int i = 0; i < 8; ++i) {
            const float x = -aw[i];
            const float sp = x > 20.f ? x : log1pf(__expf(x));
            const float wlog = -sp - 0.5f;
            DEC[(size_t)r * 512 + l + 64 * i] = __expf(-__expf(wlog));
            AB[(size_t)r * 512 + l + 64 * i] = (bf16)f2bf(sigmoidf_(aa[i]));
            GB[(size_t)r * 512 + l + 64 * i] = (bf16)f2bf(ag[i]);
        }
    }
}

__device__ __forceinline__ void p8_rwkv_scan_naive(Frame& F) {
    if (F.wave != 0 || blockIdx.x >= 32) return;
    const bf16* P = WSP(bf16, WS_P); const float* DEC = WSP(float, WS_DEC); const bf16* AB = WSP(bf16, WS_AB); const bf16* GB = WSP(bf16, WS_GB); bf16* QA = WSP(bf16, WS_QA);
    const int b = blockIdx.x >> 3, h = blockIdx.x & 7, l = F.lane, ch = h * 64 + l;
    LAS float* vec = (LAS float*)F.lds;
    const float mu_r = F.in[IN_MU][ch], mu_k = F.in[IN_MU][512 + ch], mu_v = F.in[IN_MU][1024 + ch];
    const float kk_c = F.in[IN_KK][ch], ka_c = F.in[IN_KA][ch], rk_c = F.in[IN_RK][ch], gng = F.in[IN_GN_G][ch], gnb = F.in[IN_GN_B][ch];
    float S[64];
#pragma unroll
    for (int k = 0; k < 64; ++k) S[k] = 0.f;
    float pr_p = 0.f, pk_p = 0.f, pv_p = 0.f;
    int row = key_row(b, 0);
    float n_pr = bf2f(P[(size_t)row * PW + PC_R + ch]), n_pk = bf2f(P[(size_t)row * PW + PC_K + ch]), n_pv = bf2f(P[(size_t)row * PW + PC_V + ch]);
    float n_w = DEC[(size_t)row * 512 + ch], n_a = bf2f(AB[(size_t)row * 512 + ch]), n_g = bf2f(GB[(size_t)row * 512 + ch]);
    for (int pos = 0; pos < TT; ++pos) {
        const int crow = row;
        const float c_pr = n_pr, c_pk = n_pk, c_pv = n_pv, c_w = n_w, c_a = n_a, c_g = n_g;
        if (pos + 1 < TT) {
            row = key_row(b, pos + 1);
            n_pr = bf2f(P[(size_t)row * PW + PC_R + ch]); n_pk = bf2f(P[(size_t)row * PW + PC_K + ch]); n_pv = bf2f(P[(size_t)row * PW + PC_V + ch]);
            n_w = DEC[(size_t)row * 512 + ch]; n_a = bf2f(AB[(size_t)row * 512 + ch]); n_g = bf2f(GB[(size_t)row * 512 + ch]);
        }
        const float r_s = c_pr + (pr_p - c_pr) * mu_r, k_s = c_pk + (pk_p - c_pk) * mu_k, v_s = c_pv + (pv_p - c_pv) * mu_v;
        pr_p = c_pr; pk_p = c_pk; pv_p = c_pv;
        const float kkr = k_s * kk_c;
        const float nrm = sqrtf(wave_sum(kkr * kkr));
        const float kk = kkr / fmaxf(nrm, 1e-12f);
        const float k2 = k_s * (1.f + (c_a - 1.f) * ka_c);
        vec[l] = -kk; vec[64 + l] = kk * c_a; vec[128 + l] = c_w; vec[192 + l] = k2; vec[256 + l] = r_s;
        __builtin_amdgcn_wave_barrier();
        float sa = 0.f;
#pragma unroll
        for (int k4 = 0; k4 < 16; ++k4) { const f32x4 a = *(const LAS f32x4*)(vec + 4 * k4); sa += S[4 * k4] * a.x + S[4 * k4 + 1] * a.y + S[4 * k4 + 2] * a.z + S[4 * k4 + 3] * a.w; }
        float y = 0.f;
#pragma unroll
        for (int k4 = 0; k4 < 16; ++k4) {
            const f32x4 bv = *(const LAS f32x4*)(vec + 64 + 4 * k4), w = *(const LAS f32x4*)(vec + 128 + 4 * k4), kv = *(const LAS f32x4*)(vec + 192 + 4 * k4), rv = *(const LAS f32x4*)(vec + 256 + 4 * k4);
            S[4 * k4] = S[4 * k4] * w.x + sa * bv.x + v_s * kv.x; S[4 * k4 + 1] = S[4 * k4 + 1] * w.y + sa * bv.y + v_s * kv.y;
            S[4 * k4 + 2] = S[4 * k4 + 2] * w.z + sa * bv.z + v_s * kv.z; S[4 * k4 + 3] = S[4 * k4 + 3] * w.w + sa * bv.w + v_s * kv.w;
            y += S[4 * k4] * rv.x + S[4 * k4 + 1] * rv.y + S[4 * k4 + 2] * rv.z + S[4 * k4 + 3] * rv.w;
        }
        __builtin_amdgcn_wave_barrier();
        const float mean = wave_sum(y) * (1.f / 64.f);
        const float dlt = y - mean;
        const float var = wave_sum(dlt * dlt) * (1.f / 64.f);
        const float yn = dlt * (1.0f / sqrtf(var + GN_EPS)) * gng + gnb;
        const float bonus = wave_sum(r_s * k2 * rk_c) * v_s;
        const float o = (yn + bonus) * c_g;
        if (pos >= NMETA || b == 0) QA[(size_t)crow * QAW + 1024 + ch] = (bf16)f2bf(o);
    }
}

__device__ __forceinline__ void p10_ln1(Frame& F) {
    bf16* H1 = WSP(bf16, WS_H); const float* META1 = WSP(float, WS_META1);
    const int gw = blockIdx.x * NWAVES + F.wave, NGW = F.G * NWAVES;
    for (int r = gw; r < NROWS; r += NGW) {
        const float* src = r < NREAL ? F.out + (size_t)r * D : META1 + (size_t)(r - NREAL) * D;
        ln_row_bf16(F, src, F.in[IN_LN1_G], F.in[IN_LN1_B], H1 + (size_t)r * D);
    }
}
__device__ __forceinline__ void p14_ln2(Frame& F) {
    const int gw = blockIdx.x * NWAVES + F.wave, NGW = F.G * NWAVES;
    const float* g = F.in[IN_LN2_G]; const float* b = F.in[IN_LN2_B];
    for (int r = gw; r < NREAL; r += NGW) {
        f32x4* xr = (f32x4*)(F.out + (size_t)r * D) + F.lane;
        f32x4 v[4]; float s = 0.f;
#pragma unroll
        for (int j = 0; j < 4; ++j) { v[j] = xr[64 * j]; s += (v[j].x + v[j].y) + (v[j].z + v[j].w); }
        const float mean = wave_sum(s) * (1.f / D); float s2 = 0.f;
#pragma unroll
        for (int j = 0; j < 4; ++j) { v[j] = v[j] - mean; s2 += (v[j].x * v[j].x + v[j].y * v[j].y) + (v[j].z * v[j].z + v[j].w * v[j].w); }
        const float rstd = 1.f / sqrtf(wave_sum(s2) * (1.f / D) + LN_EPS);
#pragma unroll
        for (int j = 0; j < 4; ++j) { const f32x4 gg = ((const f32x4*)g)[F.lane + 64 * j], bb = ((const f32x4*)b)[F.lane + 64 * j]; xr[64 * j] = v[j] * rstd * gg + bb; }
    }
}

__device__ __forceinline__ float gelu_fast(float x) {
    const float u2 = x * (1.5957691216057308f + 0.07135481627260025f * x * x);
    return x * __builtin_amdgcn_rcpf(1.0f + __builtin_amdgcn_exp2f(-1.4426950408889634f * u2));
}
__device__ __forceinline__ void p12_conv_fix(Frame& F) {
    bf16* ACT = WSP(bf16, WS_UP); const float* cw = F.in[IN_CONV_W]; const float* cb = F.in[IN_CONV_B];
    const float* G01 = WSP(float, WS_G01); const float* V01 = WSP(float, WS_V01); const float* GHALO = WSP(float, WS_GHALO); const float* GMETA = WSP(float, WS_GMETA);
    for (int it = blockIdx.x * NTHR + F.tid; it < 128 * 2 * DFF; it += F.G * NTHR) {
        const int j = it % DFF, rr = (it / DFF) & 1, pm = it / (2 * DFF);
        const float* ph = (pm & 31) ? GHALO + (size_t)(pm - 1) * 2 * DFF : GMETA;
        const float g0 = G01[((size_t)pm * 2 + rr) * DFF + j];
        const float g1 = rr ? G01[((size_t)pm * 2) * DFF + j] : ph[DFF + j];
        const float g2 = rr ? ph[DFF + j] : ph[j];
        const float x = cw[j] * g2 + cw[DFF + j] * g1 + cw[2 * DFF + j] * g0 + cb[j];
        ACT[(size_t)(pm * 256 + rr) * DFF + j] = (bf16)f2bf(gelu_fast(x) * V01[((size_t)pm * 2 + rr) * DFF + j]);
    }
}


constexpr int NUNITS = 4096 + 8;
constexpr int RP = 72;
constexpr int SLOT = 64 * RP * 2;
constexpr int FP = 68;
typedef short bf16x8 __attribute__((ext_vector_type(8)));
typedef float f32x16 __attribute__((ext_vector_type(16)));
constexpr size_t RW_MAT = (size_t)NUNITS * 4096;

__device__ __forceinline__ void quad_mma(f32x16& acc, const LAS bf16* Aop, const LAS bf16* Bop, int qr, int qc, int lane) {
    const int r = lane & 31, hf = lane >> 5;
    const LAS bf16* ap = Aop + (32 * qr + r) * RP + 8 * hf; const LAS bf16* bp = Bop + (32 * qc + r) * RP + 8 * hf;
#pragma unroll
    for (int ks = 0; ks < 4; ++ks) {
        const bf16x8 a = *(const LAS bf16x8*)(ap + 16 * ks), b = *(const LAS bf16x8*)(bp + 16 * ks);
        acc = __builtin_amdgcn_mfma_f32_32x32x16_bf16(a, b, acc, 0, 0, 0);
    }
}
#define ACC_M(qr, j, hf) (32 * (qr) + ((j) & 3) + 8 * ((j) >> 2) + 4 * (hf))
__device__ __forceinline__ void store_T(const f32x16& acc, LAS bf16* Z, int qr, int qc, int lane) {
    const int r = lane & 31, hf = lane >> 5;
#pragma unroll
    for (int jj = 0; jj < 4; ++jj)
        *(LAS v2u*)(Z + (32 * qc + r) * RP + 32 * qr + 8 * jj + 4 * hf) = (v2u){pk2(acc[4 * jj], acc[4 * jj + 1]), pk2(acc[4 * jj + 2], acc[4 * jj + 3])};
}
__device__ __forceinline__ void add_T(f32x16& acc, const LAS bf16* Z, int qr, int qc, int lane) {
    const int r = lane & 31, hf = lane >> 5;
#pragma unroll
    for (int jj = 0; jj < 4; ++jj) {
        const v2u w = *(const LAS v2u*)(Z + (32 * qc + r) * RP + 32 * qr + 8 * jj + 4 * hf);
        acc[4 * jj] += bflo(w.x); acc[4 * jj + 1] += bfhi(w.x); acc[4 * jj + 2] += bflo(w.y); acc[4 * jj + 3] += bfhi(w.y);
    }
}
__device__ __forceinline__ void store_T_global(const f32x16& acc, bf16* Z, int qr, int qc, int lane) {
    const int r = lane & 31, hf = lane >> 5;
#pragma unroll
    for (int jj = 0; jj < 4; ++jj)
        *(v2u*)(Z + (32 * qc + r) * 64 + 32 * qr + 8 * jj + 4 * hf) = (v2u){pk2(acc[4 * jj], acc[4 * jj + 1]), pk2(acc[4 * jj + 2], acc[4 * jj + 3])};
}
__device__ __forceinline__ f32x16 zero16() { f32x16 z;
#pragma unroll
    for (int j = 0; j < 16; ++j) z[j] = 0.f;
    return z; }

__device__ __forceinline__ void rw_b1(Frame& F) {
    const bf16* P = WSP(bf16, WS_P);
    bf16* RWM = WSP(bf16, WS_RWM); bf16* RWN = WSP(bf16, WS_RWN); bf16* RWQ = WSP(bf16, WS_RWQ); bf16* RWY = WSP(bf16, WS_RWY);
    float* BONUS = (float*)((char*)F.out + OUT_BONUS);
    const bf16* WdT = WSP(bf16, WS_WT_LORA); const bf16* WaT = WdT + 512 * 64;
    const float* mu = F.in[IN_MU];
    const int w = F.wave, l = F.lane, tid = F.tid;
    LAS unsigned char* L = F.lds;
#define SL(s) ((LAS bf16*)(L + (s) * SLOT))
    LAS float* WL = (LAS float*)(L + 12 * SLOT);
    LAS float* AL = (LAS float*)(L + 0 * SLOT);
    LAS float* OT = (LAS float*)(L + RING_BYTES + 1024);
    LAS float* GL = OT + 512;
    for (int u = blockIdx.x; u < NUNITS; u += F.G) {
        const bool meta = u >= 4096;
        int b = 0, h, c = 0; if (meta) h = u - 4096; else { b = u >> 10; h = (u >> 7) & 7; c = u & 127; }
        const int ch = h * 64 + l;
        const int row0 = meta ? NREAL : b * SEQ + c * 64;
        __syncthreads();
        float r_s[8], k_s[8], v_s[8], xw[8], xa[8];
        {
            float pr, pk, pv, pw, pa;
            const int t0 = 8 * w;
            int prow = -1;
            if (t0 > 0) prow = row0 + t0 - 1; else if (!meta) prow = (c == 0) ? NREAL + NMETA - 1 : row0 - 1;
            if (prow >= 0) { const bf16* pp = P + (size_t)prow * PW; pr = bf2f(pp[PC_R + ch]); pk = bf2f(pp[PC_K + ch]); pv = bf2f(pp[PC_V + ch]); pw = bf2f(pp[PC_WD + l]); pa = bf2f(pp[PC_AD + l]); }
            else { pr = pk = pv = pw = pa = 0.f; }
            const float mr = mu[ch], mk = mu[512 + ch], mv = mu[1024 + ch], mw = mu[1536 + l], ma = mu[1600 + l];
#pragma unroll
            for (int i = 0; i < 8; ++i) {
                const int t = t0 + i; const bool valid = !meta || t < NMETA;
                float cr = 0.f, ck = 0.f, cv = 0.f, cw = 0.f, ca = 0.f;
                if (valid) { const bf16* pp = P + (size_t)(row0 + t) * PW; cr = bf2f(pp[PC_R + ch]); ck = bf2f(pp[PC_K + ch]); cv = bf2f(pp[PC_V + ch]); cw = bf2f(pp[PC_WD + l]); ca = bf2f(pp[PC_AD + l]); }
                r_s[i] = valid ? cr + (pr - cr) * mr : 0.f; k_s[i] = valid ? ck + (pk - ck) * mk : 0.f; v_s[i] = valid ? cv + (pv - cv) * mv : 0.f;
                xw[i] = fast_tanh(cw + (pw - cw) * mw); xa[i] = ca + (pa - ca) * ma;
                pr = cr; pk = ck; pv = cv; pw = cw; pa = ca;
            }
#pragma unroll
            for (int i = 0; i < 8; ++i) { SL(8)[(t0 + i) * RP + l] = (bf16)f2bf(xw[i]); SL(9)[(t0 + i) * RP + l] = (bf16)f2bf(xa[i]); }
            {
                const int k = tid >> 3, pc = tid & 7;
                *(LAS v4u*)(SL(10) + k * RP + 8 * pc) = *(const v4u*)(WdT + (size_t)(h * 64 + k) * 64 + 8 * pc);
                *(LAS v4u*)(SL(11) + k * RP + 8 * pc) = *(const v4u*)(WaT + (size_t)(h * 64 + k) * 64 + 8 * pc);
            }
        }
        __syncthreads();
        {
            const int pid = w >> 2, q = w & 3, qr = q >> 1, qc = q & 1;
            f32x16 acc = zero16();
            quad_mma(acc, SL(10 + pid), SL(8 + pid), qr, qc, l);
            LAS float* Zf = pid ? AL : WL;
            const int r = l & 31, hf = l >> 5;
#pragma unroll
            for (int jj = 0; jj < 4; ++jj) *(LAS f32x4*)(Zf + (32 * qc + r) * FP + 32 * qr + 8 * jj + 4 * hf) = (f32x4){acc[4 * jj], acc[4 * jj + 1], acc[4 * jj + 2], acc[4 * jj + 3]};
        }
        __syncthreads();
        float lw[8], asg[8];
        {
            const float w0c = F.in[IN_W0][ch], a0c = F.in[IN_A0][ch];
            float run = 0.f;
#pragma unroll
            for (int i = 0; i < 8; ++i) {
                const int t = 8 * w + i; const bool valid = !meta || t < NMETA;
                const float x = -(WL[t * FP + l] + w0c);
                const float sp = x > 20.f ? x : __logf(1.0f + __expf(x));
                const float e = -__expf(-sp - 0.5f);
                run += valid ? e : 0.f; lw[i] = run;
                asg[i] = sigmoidf_(AL[t * FP + l] + a0c);
            }
            OT[w * 64 + l] = run;
        }
        __syncthreads();
        {
            float off = 0.f, tot = 0.f;
#pragma unroll
            for (int ww = 0; ww < 8; ++ww) { const float o = OT[ww * 64 + l]; tot += o; off += ww < w ? o : 0.f; }
            if (w == 0) GL[l] = __expf(tot);
            const float kkc = F.in[IN_KK][ch], kac = F.in[IN_KA][ch], rkc = F.in[IN_RK][ch];
            unsigned atc[4], vc[4], bhc[4], khc[4];
            float prevlg = off;
#pragma unroll
            for (int i = 0; i < 8; ++i) {
                const int t = 8 * w + i;
                const float lg = off + lw[i];
                const float g = __expf(lg), gp = __expf(prevlg), gi = __expf(-lg), gh = __expf(tot - lg);
                prevlg = lg;
                const float kkr = k_s[i] * kkc;
                const float kk = kkr * __builtin_amdgcn_rsqf(fmaxf(wave_sum(kkr * kkr), 1e-24f));
                const float k2 = k_s[i] * (1.f + (asg[i] - 1.f) * kac);
                const float bon = wave_sum(r_s[i] * k2 * rkc);
                if (l == 0) BONUS[(size_t)u * 64 + t] = bon;
                const float at = -kk * gp, rt = r_s[i] * g, bt = kk * asg[i] * gi, kt = k2 * gi, bh = kk * asg[i] * gh, kh = k2 * gh;
                SL(0)[t * RP + l] = (bf16)f2bf(at); SL(1)[t * RP + l] = (bf16)f2bf(rt); SL(2)[t * RP + l] = (bf16)f2bf(bt); SL(3)[t * RP + l] = (bf16)f2bf(kt);
                const unsigned ua = f2bf(at), uv = f2bf(v_s[i]), ub = f2bf(bh), uk = f2bf(kh);
                if (i & 1) { atc[i >> 1] |= ua << 16; vc[i >> 1] |= uv << 16; bhc[i >> 1] |= ub << 16; khc[i >> 1] |= uk << 16; }
                else { atc[i >> 1] = ua; vc[i >> 1] = uv; bhc[i >> 1] = ub; khc[i >> 1] = uk; }
            }
            *(LAS v4u*)(SL(4) + l * RP + 8 * w) = (v4u){atc[0], atc[1], atc[2], atc[3]};
            *(LAS v4u*)(SL(5) + l * RP + 8 * w) = (v4u){vc[0], vc[1], vc[2], vc[3]};
            *(LAS v4u*)(SL(6) + l * RP + 8 * w) = (v4u){bhc[0], bhc[1], bhc[2], bhc[3]};
            *(LAS v4u*)(SL(7) + l * RP + 8 * w) = (v4u){khc[0], khc[1], khc[2], khc[3]};
        }
        __syncthreads();
        for (int task = w; task < 20; task += 8) {
            const int pid = task >> 2, q = task & 3, qr = q >> 1, qc = q & 1;
            const int bop = pid == 0 ? 0 : pid == 1 ? 2 : pid == 2 ? 0 : 1;
            const int aop = pid == 0 ? 2 : pid == 1 ? 0 : pid == 2 ? 3 : pid == 3 ? 2 : 3;
            f32x16 acc = zero16();
            quad_mma(acc, SL(aop), SL(bop), qr, qc, l);
            const int n = 32 * qc + (l & 31), hf = l >> 5;
#pragma unroll
            for (int j = 0; j < 16; ++j) {
                const int m = ACC_M(qr, j, hf);
                const bool keep = pid == 1 ? (m > n) : (pid <= 2 ? (n > m) : (n >= m));
                acc[j] = keep ? acc[j] : 0.f;
            }
            store_T(acc, SL(8 + pid), qr, qc, l);
        }
        __syncthreads();
        const int nq = w & 3, nqr = nq >> 1, nqc = nq & 1;
        f32x16 nacc = zero16();
        if (w < 4) { add_T(nacc, SL(8), nqr, nqc, l); }
        for (int task = w; task < 12; task += 8) {
            const int pid = task >> 2, q = task & 3, qr = q >> 1, qc = q & 1;
            f32x16 acc = zero16();
            if (pid == 0) { quad_mma(acc, SL(9), SL(8), qr, qc, l); store_T(acc, SL(0), qr, qc, l); }
            else if (pid == 1) { quad_mma(acc, SL(8), SL(9), qr, qc, l); store_T(acc, SL(2), qr, qc, l); }
            else { quad_mma(acc, SL(10), SL(5), qr, qc, l); store_T(acc, SL(3), qr, qc, l); }
        }
        __syncthreads();
#pragma unroll
        for (int st = 0; st < 4; ++st) {
            const int pr = (st & 1) ? 10 : 0, pc = (st & 1) ? 13 : 2, pr2 = (st & 1) ? 0 : 10, pc2 = (st & 1) ? 2 : 13, nr = (st & 1) ? 9 : 8, nr2 = (st & 1) ? 8 : 9;
            if (w < 4) {
                add_T(nacc, SL(pr), nqr, nqc, l);
                quad_mma(nacc, SL(pc), SL(nr), nqr, nqc, l);
                store_T(nacc, SL(nr2), nqr, nqc, l);
                f32x16 acc = zero16();
                quad_mma(acc, SL(pc), SL(pr), nqr, nqc, l); store_T(acc, SL(pr2), nqr, nqc, l);
            } else {
                f32x16 acc = zero16();
                quad_mma(acc, SL(pr), SL(pc), nqr, nqc, l); store_T(acc, SL(pc2), nqr, nqc, l);
            }
            __syncthreads();
        }
        if (w < 4) { add_T(nacc, SL(0), nqr, nqc, l); quad_mma(nacc, SL(2), SL(8), nqr, nqc, l); store_T(nacc, SL(9), nqr, nqc, l); }
        __syncthreads();
        {
            const int pid = w >> 2;
            f32x16 acc = zero16();
            add_T(acc, SL(pid ? 3 : 4), nqr, nqc, l);
            quad_mma(acc, SL(9), SL(pid ? 3 : 4), nqr, nqc, l);
            store_T(acc, SL(pid ? 2 : 0), nqr, nqc, l);
        }
        __syncthreads();
        for (int task = w; task < 16; task += 8) {
            const int pid = task >> 2, q = task & 3, qr = q >> 1, qc = q & 1;
            f32x16 acc = zero16();
            if (pid == 0) { add_T(acc, SL(1), qr, qc, l); quad_mma(acc, SL(0), SL(11), qr, qc, l); store_T_global(acc, RWQ + (size_t)u * 4096, qr, qc, l); }
            else if (pid == 1) { quad_mma(acc, SL(2), SL(11), qr, qc, l); quad_mma(acc, SL(5), SL(12), qr, qc, l); store_T_global(acc, RWY + (size_t)u * 4096, qr, qc, l); }
            else if (pid == 2) {
                quad_mma(acc, SL(0), SL(6), qr, qc, l);
                const int n = 32 * qc + (l & 31), hf = l >> 5; const float gl = GL[n];
#pragma unroll
                for (int j = 0; j < 16; ++j) acc[j] += (ACC_M(qr, j, hf) == n) ? gl : 0.f;
                store_T_global(acc, RWM + (size_t)u * 4096, qr, qc, l);
            } else { quad_mma(acc, SL(6), SL(2), qr, qc, l); quad_mma(acc, SL(7), SL(5), qr, qc, l); store_T_global(acc, RWN + (size_t)u * 4096, qr, qc, l); }
        }
    }
#undef SL
}

__device__ __forceinline__ void rw_b2(Frame& F) {
    if (blockIdx.x >= 32) return;
    const bf16* RWM = WSP(bf16, WS_RWM); const bf16* RWN = WSP(bf16, WS_RWN);
    bf16* RWS = (bf16*)((char*)F.out + OUT_RWS);
    const int b = blockIdx.x >> 3, h = blockIdx.x & 7, w = F.wave, l = F.lane;
    LAS unsigned char* L = F.lds;
#define SS(buf, part) ((LAS bf16*)(L + ((buf) * 2 + (part)) * SLOT))
    const int q = w & 3, qr = q >> 1, qc = q & 1, r = l & 31, hf = l >> 5;
    if (w < 4) {
        const bf16* Nm = RWN + (size_t)(4096 + h) * 4096;
#pragma unroll
        for (int jj = 0; jj < 4; ++jj) {
            const v2u wv = *(const v2u*)(Nm + (32 * qc + r) * 64 + 32 * qr + 8 * jj + 4 * hf);
            *(LAS v2u*)(SS(0, 0) + (32 * qc + r) * RP + 32 * qr + 8 * jj + 4 * hf) = wv;
            *(LAS v2u*)(SS(0, 1) + (32 * qc + r) * RP + 32 * qr + 8 * jj + 4 * hf) = (v2u){0u, 0u};
        }
    }
    __syncthreads();
    bf16x8 a_cur[4]; v2u n_cur[4];
    {
        const size_t u0 = (size_t)(b * 8 + h) * 128;
#pragma unroll
        for (int ks = 0; ks < 4; ++ks) a_cur[ks] = *(const bf16x8*)(RWM + u0 * 4096 + (32 * qr + r) * 64 + 8 * hf + 16 * ks);
#pragma unroll
        for (int jj = 0; jj < 4; ++jj) n_cur[jj] = *(const v2u*)(RWN + u0 * 4096 + (32 * qc + r) * 64 + 32 * qr + 8 * jj + 4 * hf);
    }
    for (int c = 0; c < 128; ++c) {
        const int u = (b * 8 + h) * 128 + c, cur = c & 1;
        if (w < 4) {
            bf16x8 a_nxt[4]; v2u n_nxt[4];
            const size_t un = (size_t)(c + 1 < 128 ? u + 1 : u);
#pragma unroll
            for (int ks = 0; ks < 4; ++ks) a_nxt[ks] = *(const bf16x8*)(RWM + un * 4096 + (32 * qr + r) * 64 + 8 * hf + 16 * ks);
#pragma unroll
            for (int jj = 0; jj < 4; ++jj) n_nxt[jj] = *(const v2u*)(RWN + un * 4096 + (32 * qc + r) * 64 + 32 * qr + 8 * jj + 4 * hf);
            f32x16 acc;
#pragma unroll
            for (int jj = 0; jj < 4; ++jj) { acc[4 * jj] = bflo(n_cur[jj].x); acc[4 * jj + 1] = bfhi(n_cur[jj].x); acc[4 * jj + 2] = bflo(n_cur[jj].y); acc[4 * jj + 3] = bfhi(n_cur[jj].y); }
#pragma unroll
            for (int jj = 0; jj < 4; ++jj)
                *(v2u*)(RWS + (size_t)u * 4096 + (32 * qc + r) * 64 + 32 * qr + 8 * jj + 4 * hf) = *(const LAS v2u*)(SS(cur, 0) + (32 * qc + r) * RP + 32 * qr + 8 * jj + 4 * hf);
            const LAS bf16* bh = SS(cur, 0) + (32 * qc + r) * RP + 8 * hf; const LAS bf16* bl = SS(cur, 1) + (32 * qc + r) * RP + 8 * hf;
#pragma unroll
            for (int ks = 0; ks < 4; ++ks) {
                acc = __builtin_amdgcn_mfma_f32_32x32x16_bf16(a_cur[ks], *(const LAS bf16x8*)(bh + 16 * ks), acc, 0, 0, 0);
                acc = __builtin_amdgcn_mfma_f32_32x32x16_bf16(a_cur[ks], *(const LAS bf16x8*)(bl + 16 * ks), acc, 0, 0, 0);
            }
#pragma unroll
            for (int jj = 0; jj < 4; ++jj) {
                float hi[4], lo[4];
#pragma unroll
                for (int e = 0; e < 4; ++e) { const unsigned hb = f2bf(acc[4 * jj + e]); hi[e] = __uint_as_float(hb << 16); lo[e] = acc[4 * jj + e] - hi[e]; }
                *(LAS v2u*)(SS(cur ^ 1, 0) + (32 * qc + r) * RP + 32 * qr + 8 * jj + 4 * hf) = (v2u){pk2(hi[0], hi[1]), pk2(hi[2], hi[3])};
                *(LAS v2u*)(SS(cur ^ 1, 1) + (32 * qc + r) * RP + 32 * qr + 8 * jj + 4 * hf) = (v2u){pk2(lo[0], lo[1]), pk2(lo[2], lo[3])};
            }
#pragma unroll
            for (int ks = 0; ks < 4; ++ks) a_cur[ks] = a_nxt[ks];
#pragma unroll
            for (int jj = 0; jj < 4; ++jj) n_cur[jj] = n_nxt[jj];
        }
        __syncthreads();
    }
#undef SS
}

__device__ __forceinline__ void rw_b3(Frame& F) {
    const bf16* P = WSP(bf16, WS_P); bf16* QA = WSP(bf16, WS_QA);
    const bf16* RWQ = WSP(bf16, WS_RWQ); const bf16* RWY = WSP(bf16, WS_RWY);
    const bf16* RWS = (const bf16*)((const char*)F.out + OUT_RWS); const float* BONUS = (const float*)((const char*)F.out + OUT_BONUS);
    const bf16* WgT = WSP(bf16, WS_WT_LORA) + 2 * 512 * 64;
    const float* mu = F.in[IN_MU];
    const int l = F.lane, r = l & 31, hf = l >> 5;
    const int gw = blockIdx.x * NWAVES + F.wave, NGW = F.G * NWAVES;
    for (int it = gw; it < NUNITS * 2; it += NGW) {
        const int u = it >> 1, th = it & 1;
        const bool meta = u >= 4096;
        int b = 0, h, c = 0; if (meta) h = u - 4096; else { b = u >> 10; h = (u >> 7) & 7; c = u & 127; }
        if (meta && th == 1) continue;
        const int t = 32 * th + r;
        const bool valid = !meta || t < NMETA;
        const int row0 = meta ? NREAL : b * SEQ + c * 64;
        const int row = valid ? row0 + t : row0;
        int prow = -1;
        if (t > 0) prow = row - 1; else if (!meta) prow = (c == 0) ? NREAL + NMETA - 1 : row - 1;
        f32x16 y[2];
#pragma unroll
        for (int qv = 0; qv < 2; ++qv) {
            const bf16* Y0 = RWY + (size_t)u * 4096 + (32 * th + r) * 64 + 32 * qv + 4 * hf;
#pragma unroll
            for (int jj = 0; jj < 4; ++jj) { const v2u wv = *(const v2u*)(Y0 + 8 * jj); y[qv][4 * jj] = bflo(wv.x); y[qv][4 * jj + 1] = bfhi(wv.x); y[qv][4 * jj + 2] = bflo(wv.y); y[qv][4 * jj + 3] = bfhi(wv.y); }
        }
        if (!meta) {
            const bf16* qp = RWQ + (size_t)u * 4096 + (32 * th + r) * 64 + 8 * hf;
            const bf16* sp = RWS + (size_t)u * 4096 + r * 64 + 8 * hf;
#pragma unroll
            for (int ks = 0; ks < 4; ++ks) {
                const bf16x8 bq = *(const bf16x8*)(qp + 16 * ks);
                y[0] = __builtin_amdgcn_mfma_f32_32x32x16_bf16(*(const bf16x8*)(sp + 16 * ks), bq, y[0], 0, 0, 0);
                y[1] = __builtin_amdgcn_mfma_f32_32x32x16_bf16(*(const bf16x8*)(sp + 32 * 64 + 16 * ks), bq, y[1], 0, 0, 0);
            }
        }
        f32x16 g[2]; g[0] = zero16(); g[1] = zero16();
        {
            const bf16* gp = P + (size_t)row * PW + PC_GD + 8 * hf; const bf16* gpp = prow >= 0 ? P + (size_t)prow * PW + PC_GD + 8 * hf : nullptr;
            const bf16* wp = WgT + (size_t)(h * 64 + r) * 128 + 8 * hf;
#pragma unroll
            for (int ks = 0; ks < 8; ++ks) {
                const v4u cg = *(const v4u*)(gp + 16 * ks); const v4u pg = gpp ? *(const v4u*)(gpp + 16 * ks) : (v4u){0u, 0u, 0u, 0u};
                const f32x4 m0 = *(const f32x4*)(mu + 1664 + 16 * ks + 8 * hf), m1 = *(const f32x4*)(mu + 1664 + 16 * ks + 8 * hf + 4);
                const unsigned cw[4] = {cg.x, cg.y, cg.z, cg.w}, pw[4] = {pg.x, pg.y, pg.z, pg.w}; const float mm[8] = {m0.x, m0.y, m0.z, m0.w, m1.x, m1.y, m1.z, m1.w};
                unsigned o[4];
#pragma unroll
                for (int e = 0; e < 4; ++e) {
                    const float c0 = bflo(cw[e]), c1 = bfhi(cw[e]), p0 = bflo(pw[e]), p1 = bfhi(pw[e]);
                    o[e] = pk2(sigmoidf_(c0 + (p0 - c0) * mm[2 * e]), sigmoidf_(c1 + (p1 - c1) * mm[2 * e + 1]));
                }
                const v4u ov = (v4u){o[0], o[1], o[2], o[3]};
                const bf16x8 bs = __builtin_bit_cast(bf16x8, ov);
                g[0] = __builtin_amdgcn_mfma_f32_32x32x16_bf16(*(const bf16x8*)(wp + 16 * ks), bs, g[0], 0, 0, 0);
                g[1] = __builtin_amdgcn_mfma_f32_32x32x16_bf16(*(const bf16x8*)(wp + 32 * 128 + 16 * ks), bs, g[1], 0, 0, 0);
            }
        }
        float s = 0.f;
#pragma unroll
        for (int j = 0; j < 16; ++j) s += y[0][j] + y[1][j];
        s += __shfl_xor(s, 32);
        const float mean = s * (1.f / 64.f);
        float s2 = 0.f;
#pragma unroll
        for (int j = 0; j < 16; ++j) { const float d0 = y[0][j] - mean, d1 = y[1][j] - mean; s2 += d0 * d0 + d1 * d1; }
        s2 += __shfl_xor(s2, 32);
        const float rstd = 1.0f / sqrtf(s2 * (1.f / 64.f) + GN_EPS);
        const float bon = BONUS[(size_t)u * 64 + t];
        if (valid) {
#pragma unroll
            for (int qv = 0; qv < 2; ++qv)
#pragma unroll
                for (int jj = 0; jj < 4; ++jj) {
                    const int v0 = 32 * qv + 8 * jj + 4 * hf, chv = h * 64 + v0;
                    const v2u cvw = *(const v2u*)(P + (size_t)row * PW + PC_V + chv); const v2u pvw = prow >= 0 ? *(const v2u*)(P + (size_t)prow * PW + PC_V + chv) : (v2u){0u, 0u};
                    const f32x4 mv = *(const f32x4*)(mu + 1024 + chv), gg = *(const f32x4*)(F.in[IN_GN_G] + chv), gb = *(const f32x4*)(F.in[IN_GN_B] + chv);
                    const float cv[4] = {bflo(cvw.x), bfhi(cvw.x), bflo(cvw.y), bfhi(cvw.y)}, pv[4] = {bflo(pvw.x), bfhi(pvw.x), bflo(pvw.y), bfhi(pvw.y)};
                    const float mvv[4] = {mv.x, mv.y, mv.z, mv.w}, ggv[4] = {gg.x, gg.y, gg.z, gg.w}, gbv[4] = {gb.x, gb.y, gb.z, gb.w};
                    float o[4];
#pragma unroll
                    for (int e = 0; e < 4; ++e) {
                        const float vs = cv[e] + (pv[e] - cv[e]) * mvv[e];
                        o[e] = ((y[qv][4 * jj + e] - mean) * rstd * ggv[e] + gbv[e] + bon * vs) * g[qv][4 * jj + e];
                    }
                    *(v2u*)(QA + (size_t)row * QAW + 1024 + chv) = (v2u){pk2(o[0], o[1]), pk2(o[2], o[3])};
                }
        }
    }
}

constexpr int IX_CAP = 512, IX_LIST = 3072, IX_KB = 98304, IX_SCR = RING_BYTES + 4096;
#define IX_FENCE() asm volatile("s_waitcnt lgkmcnt(0)" ::: "memory")

__device__ __forceinline__ unsigned ix_mbcnt(unsigned long long m) { return __builtin_amdgcn_mbcnt_hi((unsigned)(m >> 32), __builtin_amdgcn_mbcnt_lo((unsigned)m, 0u)); }

__device__ __forceinline__ void ix_select_slow(const float (&sc)[8], const unsigned (&ix)[8], bool (&vl)[8], int K, unsigned short* sel_out, int lane) {
    for (int it = 0; it < K; ++it) {
        unsigned long long best = 0ull;
#pragma unroll
        for (int i = 0; i < 8; ++i) { const unsigned long long key = ((unsigned long long)sortable(sc[i]) << 32) | (unsigned long long)(0xFFFFu - ix[i]) | 0x10000ull; if (vl[i] && key > best) best = key; }
        unsigned long long wm = best;
#pragma unroll
        for (int o = 1; o < 64; o <<= 1) { const unsigned long long v = __shfl_xor(wm, o); wm = v > wm ? v : wm; }
        if (wm == 0ull) break;
        const bool mine = best == wm;
#pragma unroll
        for (int i = 0; i < 8; ++i) { const unsigned long long key = ((unsigned long long)sortable(sc[i]) << 32) | (unsigned long long)(0xFFFFu - ix[i]) | 0x10000ull; if (mine && vl[i] && key == wm) { vl[i] = false; sel_out[it] = (unsigned short)ix[i]; } }
    }
}

__device__ __forceinline__ void ix_compact(LAS float* LS, LAS unsigned short* LI, LAS unsigned* hist, int& cnt, float& tau, int lane, bool final_sel, unsigned short* sel_out) {
    const int n = cnt;
    float sc[8]; unsigned ix[8]; bool vl[8];
    IX_FENCE();
#pragma unroll
    for (int i = 0; i < 8; ++i) { const int p = lane + 64 * i; vl[i] = p < n; sc[i] = vl[i] ? LS[p] : -INFINITY; ix[i] = vl[i] ? (unsigned)LI[p] : 0u; }
    float mx = -INFINITY, mn = INFINITY;
#pragma unroll
    for (int i = 0; i < 8; ++i) { if (vl[i]) { mx = fmaxf(mx, sc[i]); mn = fminf(mn, sc[i]); } }
    mx = wave_max(mx); mn = -wave_max(-mn);
    const float scale = mx > mn ? 255.99f / (mx - mn) : 0.f;
    int bin[8];
#pragma unroll
    for (int i = 0; i < 8; ++i) { int bq = (int)((sc[i] - mn) * scale); bq = bq > 255 ? 255 : (bq < 0 ? 0 : bq); bin[i] = vl[i] ? bq : -1; }
    *(LAS v4u*)(hist + 4 * lane) = (v4u){0u, 0u, 0u, 0u};
    IX_FENCE();
#pragma unroll
    for (int i = 0; i < 8; ++i) if (vl[i]) __hip_atomic_fetch_add((LAS unsigned*)&hist[bin[i]], 1u, __ATOMIC_RELAXED, __HIP_MEMORY_SCOPE_WAVEFRONT);
    IX_FENCE();
    const v4u c = *(const LAS v4u*)(hist + 4 * lane);
    const unsigned Pp = wave_scan_incl(c.x + c.y + c.z + c.w, lane);
    const unsigned total = (unsigned)__builtin_amdgcn_readlane((int)Pp, 63);
    const unsigned K = TOPK;
    const unsigned a3 = total - Pp, a2 = a3 + c.w, a1 = a2 + c.z, a0 = a1 + c.y;
    int myb = -1; unsigned myA = 0u, myC = 0u;
    if (a3 < K && K <= a3 + c.w) { myb = 4 * lane + 3; myA = a3; myC = c.w; }
    else if (a2 < K && K <= a2 + c.z) { myb = 4 * lane + 2; myA = a2; myC = c.z; }
    else if (a1 < K && K <= a1 + c.y) { myb = 4 * lane + 1; myA = a1; myC = c.y; }
    else if (a0 < K && K <= a0 + c.x) { myb = 4 * lane; myA = a0; myC = c.x; }
    const unsigned long long bm = __ballot(myb >= 0);
    const int src = bm ? (__ffsll((long long)bm) - 1) : 0;
    const int bstar = __shfl(myb, src); const unsigned A = __shfl(myA, src), m = __shfl(myC, src);
    if (!final_sel) {
        if (A + m <= (unsigned)(IX_CAP - 128)) {
            int base = 0; float kmin = INFINITY;
#pragma unroll
            for (int i = 0; i < 8; ++i) {
                const bool keep = vl[i] && bin[i] >= bstar;
                const unsigned long long mk = __ballot(keep);
                const int pos = base + (int)ix_mbcnt(mk);
                if (keep) { LS[pos] = sc[i]; LI[pos] = (unsigned short)ix[i]; kmin = fminf(kmin, sc[i]); }
                base += __popcll(mk);
            }
            cnt = base; tau = -wave_max(-kmin);
            IX_FENCE();
            return;
        }
        unsigned short* tmp = sel_out;
        ix_select_slow(sc, ix, vl, (int)K, tmp, lane);
        int base = 0; float kmin = INFINITY;
#pragma unroll
        for (int i = 0; i < 8; ++i) {
            const bool keep = !vl[i] && (lane + 64 * i) < n;
            const unsigned long long mk = __ballot(keep);
            const int pos = base + (int)ix_mbcnt(mk);
            if (keep) { LS[pos] = sc[i]; LI[pos] = (unsigned short)ix[i]; kmin = fminf(kmin, sc[i]); }
            base += __popcll(mk);
        }
        cnt = base; tau = -wave_max(-kmin);
        IX_FENCE();
        return;
    }
    if (m <= 128u) {
        int base = 0;
#pragma unroll
        for (int i = 0; i < 8; ++i) {
            const bool keep = vl[i] && bin[i] > bstar;
            const unsigned long long mk = __ballot(keep);
            const int pos = base + (int)ix_mbcnt(mk);
            if (keep) sel_out[pos] = (unsigned short)ix[i];
            base += __popcll(mk);
        }
        LAS float* sS = (LAS float*)hist; LAS unsigned* sI = hist + 128;
        IX_FENCE();
        int mb = 0;
#pragma unroll
        for (int i = 0; i < 8; ++i) {
            const bool inb = vl[i] && bin[i] == bstar;
            const unsigned long long mk = __ballot(inb);
            const int pos = mb + (int)ix_mbcnt(mk);
            if (inb) { sS[pos] = sc[i]; sI[pos] = ix[i]; }
            mb += __popcll(mk);
        }
        IX_FENCE();
        const int need = (int)(K - A);
#pragma unroll
        for (int e = 0; e < 2; ++e) {
            const int j = lane + 64 * e;
            if (j < (int)m) {
                const float sj = sS[j]; const unsigned ij = sI[j]; int rank = 0;
                for (int k = 0; k < (int)m; ++k) { const float sk = sS[k]; const unsigned ik = sI[k]; rank += (sk > sj || (sk == sj && ik < ij)) ? 1 : 0; }
                if (rank < need) sel_out[(int)A + rank] = (unsigned short)ij;
            }
        }
    } else {
        ix_select_slow(sc, ix, vl, (int)K, sel_out, lane);
    }
}

__device__ __forceinline__ void p5_index_mfma(Frame& F, unsigned short* SEL, int* NSEL, int qword = 3072, bool probe_noappend = false) {
    const bf16* QA = WSP(bf16, WS_QA); const bf16* KIDX = WSP(bf16, WS_KIDX); const float* WIDX = WSP(float, WS_WIDX);
    const int tid = F.tid, w = F.wave, l = F.lane, r = l & 31, hf = l >> 5;
    {
        const int gw = blockIdx.x * NWAVES + w, NGW = F.G * NWAVES;
        for (int i = gw; i < NMETA + BATCH * 192; i += NGW) {
            int q, nvis; if (i < NMETA) { q = NREAL + i; nvis = NMETA; } else { const int bb = (i - NMETA) / 192, s = (i - NMETA) % 192; q = bb * SEQ + s; nvis = NMETA + 64 * (s / 64 + 1); }
            for (int j = l; j < nvis; j += 64) SEL[(size_t)q * TOPK + j] = (unsigned short)j;
            if (l == 0) NSEL[q] = nvis;
        }
    }
    LAS unsigned char* L = F.lds;
    LAS unsigned* hist = (LAS unsigned*)(L + IX_SCR + w * 1024);
    {
        for (;;) {
            __syncthreads();
            if (tid == 0) F.MISC[16] = __hip_atomic_fetch_add((unsigned*)F.ctl + qword, 1u, __ATOMIC_RELAXED, __HIP_MEMORY_SCOPE_AGENT);
            __syncthreads();
            const int qi_ = (int)F.MISC[16];
            if (qi_ >= 1000) break;
            const int tile = 999 - qi_;
            const int pt = 6 + (tile >> 2), b = tile & 3;
            const int q0 = b * SEQ + pt * 32;
            const int nvis = NMETA + 64 * (pt / 2 + 1);
            __syncthreads();
            bf16x8 af[4];
            {
                const int qq = 2 * (r >> 4) + ((r >> 2) & 1), hd = 4 * ((r >> 3) & 1) + (r & 3);
                const bf16* qp = QA + (size_t)(q0 + 4 * w + qq) * QAW + 1024 + hd * 64 + 8 * hf;
#pragma unroll
                for (int ks = 0; ks < 4; ++ks) af[ks] = *(const bf16x8*)(qp + 16 * ks);
            }
            float wq[2][8];
#pragma unroll
            for (int a = 0; a < 2; ++a) {
                const f32x4 w0 = *(const f32x4*)(WIDX + (size_t)(q0 + 4 * w + 2 * a + hf) * 8), w1 = *(const f32x4*)(WIDX + (size_t)(q0 + 4 * w + 2 * a + hf) * 8 + 4);
                wq[a][0] = 0.5f * w0.x; wq[a][1] = 0.5f * w0.y; wq[a][2] = 0.5f * w0.z; wq[a][3] = 0.5f * w0.w; wq[a][4] = 0.5f * w1.x; wq[a][5] = 0.5f * w1.y; wq[a][6] = 0.5f * w1.z; wq[a][7] = 0.5f * w1.w;
            }
            float tau0 = -INFINITY, tau1 = -INFINITY;
            int cnt[4] = {0, 0, 0, 0};
            const int nblk = (nvis + 255) >> 8;
            v4u kreg[4];
#pragma unroll
            for (int e = 0; e < 4; ++e) {
                const int pid = tid + 512 * e, kl = pid >> 3, pc = pid & 7, j = kl;
                kreg[e] = j < nvis ? *(const v4u*)(KIDX + (size_t)key_row(b, j) * 64 + 8 * pc) : (v4u){0u, 0u, 0u, 0u};
            }
#pragma unroll
            for (int e = 0; e < 4; ++e) { const int pid = tid + 512 * e, kl = pid >> 3, pc = pid & 7; *(LAS v4u*)(L + IX_KB + kl * 128 + ((pc ^ ((kl >> 1) & 7)) << 4)) = kreg[e]; }
            __syncthreads();
            const LAS unsigned char* kb = L + IX_KB;
            for (int blk = 0; blk < nblk; ++blk) {
                if (blk + 1 < nblk) {
#pragma unroll
                    for (int e = 0; e < 4; ++e) {
                        const int pid = tid + 512 * e, kl = pid >> 3, pc = pid & 7, j = (blk + 1) * 256 + kl;
                        kreg[e] = j < nvis ? *(const v4u*)(KIDX + (size_t)key_row(b, j) * 64 + 8 * pc) : (v4u){0u, 0u, 0u, 0u};
                    }
                }
                int npair = (nvis - blk * 256 + 63) >> 6; npair = npair > 4 ? 4 : npair;
                bf16x8 bc0[4], bc1[4];
#pragma unroll
                for (int ks = 0; ks < 4; ++ks) { const int k0 = r, k1 = 32 + r;
                    bc0[ks] = *(const LAS bf16x8*)(kb + k0 * 128 + (((2 * ks + hf) ^ ((k0 >> 1) & 7)) << 4));
                    bc1[ks] = *(const LAS bf16x8*)(kb + k1 * 128 + (((2 * ks + hf) ^ ((k1 >> 1) & 7)) << 4)); }
                for (int pp = 0; pp < npair; ++pp) {
                    const int jbase = blk * 256 + pp * 64;
                    bf16x8 bn0[4], bn1[4];
                    {
                        const int pn = pp + 1 < npair ? pp + 1 : pp; const int k0 = pn * 64 + r, k1 = k0 + 32;
#pragma unroll
                        for (int ks = 0; ks < 4; ++ks) {
                            bn0[ks] = *(const LAS bf16x8*)(kb + k0 * 128 + (((2 * ks + hf) ^ ((k0 >> 1) & 7)) << 4));
                            bn1[ks] = *(const LAS bf16x8*)(kb + k1 * 128 + (((2 * ks + hf) ^ ((k1 >> 1) & 7)) << 4)); }
                    }
                    f32x16 accA = zero16(), accB = zero16();
#pragma unroll
                    for (int ks = 0; ks < 4; ++ks) { accA = __builtin_amdgcn_mfma_f32_32x32x16_bf16(af[ks], bc0[ks], accA, 0, 0, 0); accB = __builtin_amdgcn_mfma_f32_32x32x16_bf16(af[ks], bc1[ks], accB, 0, 0, 0); }
#pragma unroll
                    for (int ks = 0; ks < 4; ++ks) { bc0[ks] = bn0[ks]; bc1[ks] = bn1[ks]; }
                    float sA0 = 0.f, sA0b = 0.f, sA1 = 0.f, sA1b = 0.f, sB0 = 0.f, sB0b = 0.f, sB1 = 0.f, sB1b = 0.f;
#pragma unroll
                    for (int h = 0; h < 8; h += 2) {
                        sA0 = fmaf(wq[0][h], __builtin_fabsf(accA[h]), fmaf(wq[0][h], accA[h], sA0)); sA0b = fmaf(wq[0][h + 1], __builtin_fabsf(accA[h + 1]), fmaf(wq[0][h + 1], accA[h + 1], sA0b));
                        sA1 = fmaf(wq[1][h], __builtin_fabsf(accA[8 + h]), fmaf(wq[1][h], accA[8 + h], sA1)); sA1b = fmaf(wq[1][h + 1], __builtin_fabsf(accA[9 + h]), fmaf(wq[1][h + 1], accA[9 + h], sA1b));
                        sB0 = fmaf(wq[0][h], __builtin_fabsf(accB[h]), fmaf(wq[0][h], accB[h], sB0)); sB0b = fmaf(wq[0][h + 1], __builtin_fabsf(accB[h + 1]), fmaf(wq[0][h + 1], accB[h + 1], sB0b));
                        sB1 = fmaf(wq[1][h], __builtin_fabsf(accB[8 + h]), fmaf(wq[1][h], accB[8 + h], sB1)); sB1b = fmaf(wq[1][h + 1], __builtin_fabsf(accB[9 + h]), fmaf(wq[1][h + 1], accB[9 + h], sB1b));
                    }
                    const float s0A = (sA0 + sA0b) + 0.0f, s1A = (sA1 + sA1b) + 0.0f, s0B = (sB0 + sB0b) + 0.0f, s1B = (sB1 + sB1b) + 0.0f;
                    const int jA = jbase + r, jB = jA + 32;
                    const bool p0A = jA < nvis && s0A > tau0, p1A = jA < nvis && s1A > tau1, p0B = jB < nvis && s0B > tau0, p1B = jB < nvis && s1B > tau1;
                    const unsigned long long m0A = __ballot(p0A), m1A = __ballot(p1A), m0B = __ballot(p0B), m1B = __ballot(p1B);
                    if (m0A | m1A | m0B | m1B) {
                        const int a0lo = __popc((unsigned)m0A), a0hi = __popc((unsigned)(m0A >> 32)), a1lo = __popc((unsigned)m1A), a1hi = __popc((unsigned)(m1A >> 32));
                        const int b0lo = __popc((unsigned)m0B), b0hi = __popc((unsigned)(m0B >> 32)), b1lo = __popc((unsigned)m1B), b1hi = __popc((unsigned)(m1B >> 32));
                        {
                            LAS unsigned char* lb = L + (w * 4 + hf) * IX_LIST;
                            const int base = hf ? cnt[1] : cnt[0];
                            const int posA = base + (int)ix_mbcnt(m0A) - (hf ? a0lo : 0);
                            const int posB = base + (hf ? a0hi : a0lo) + (int)ix_mbcnt(m0B) - (hf ? b0lo : 0);
                            if (p0A) { ((LAS float*)lb)[posA] = s0A; ((LAS unsigned short*)(lb + 2048))[posA] = (unsigned short)jA; }
                            if (p0B) { ((LAS float*)lb)[posB] = s0B; ((LAS unsigned short*)(lb + 2048))[posB] = (unsigned short)jB; }
                        }
                        {
                            LAS unsigned char* lb = L + (w * 4 + 2 + hf) * IX_LIST;
                            const int base = hf ? cnt[3] : cnt[2];
                            const int posA = base + (int)ix_mbcnt(m1A) - (hf ? a1lo : 0);
                            const int posB = base + (hf ? a1hi : a1lo) + (int)ix_mbcnt(m1B) - (hf ? b1lo : 0);
                            if (p1A) { ((LAS float*)lb)[posA] = s1A; ((LAS unsigned short*)(lb + 2048))[posA] = (unsigned short)jA; }
                            if (p1B) { ((LAS float*)lb)[posB] = s1B; ((LAS unsigned short*)(lb + 2048))[posB] = (unsigned short)jB; }
                        }
                        cnt[0] += a0lo + b0lo; cnt[1] += a0hi + b0hi; cnt[2] += a1lo + b1lo; cnt[3] += a1hi + b1hi;
                        if (probe_noappend) { if (cnt[0] >= 256 && hf == 0) tau0 = INFINITY; if (cnt[1] >= 256 && hf == 1) tau0 = INFINITY; if (cnt[2] >= 256 && hf == 0) tau1 = INFINITY; if (cnt[3] >= 256 && hf == 1) tau1 = INFINITY; }
#pragma unroll
                        for (int qq = 0; qq < 4; ++qq) {
                            if (cnt[qq] > IX_CAP - 64) {
                                LAS unsigned char* lb = L + (w * 4 + qq) * IX_LIST;
                                float tq = 0.f; int cq = cnt[qq];
                                ix_compact((LAS float*)lb, (LAS unsigned short*)(lb + 2048), hist, cq, tq, l, false, SEL + (size_t)(q0 + 4 * w + qq) * TOPK);
                                cnt[qq] = __builtin_amdgcn_readfirstlane(cq);
                                if ((qq & 1) == hf) { if (qq < 2) tau0 = tq; else tau1 = tq; }
                            }
                        }
                    }
                }
                __syncthreads();
                if (blk + 1 < nblk) {
#pragma unroll
                    for (int e = 0; e < 4; ++e) { const int pid = tid + 512 * e, kl = pid >> 3, pc = pid & 7; *(LAS v4u*)(L + IX_KB + kl * 128 + ((pc ^ ((kl >> 1) & 7)) << 4)) = kreg[e]; }
                    __syncthreads();
                }
            }
#pragma unroll
            for (int qq = 0; qq < 4; ++qq) {
                LAS unsigned char* lb = L + (w * 4 + qq) * IX_LIST;
                float tq = 0.f; int cq = cnt[qq];
                ix_compact((LAS float*)lb, (LAS unsigned short*)(lb + 2048), hist, cq, tq, l, true, SEL + (size_t)(q0 + 4 * w + qq) * TOPK);
                if (l == 0) NSEL[q0 + 4 * w + qq] = TOPK;
            }
        }
    }
}

#ifndef CHECK_IDX
#define CHECK_IDX 0
#endif
#if CHECK_IDX
__device__ __forceinline__ void idx_check(Frame& F) {
    const unsigned short* SEL = WSP(unsigned short, WS_SEL); const unsigned short* SELB = (const unsigned short*)F.out; const int* NSEL = WSP(int, WS_NSEL); const int* NSELB = (const int*)((const char*)F.out + 32 * MiB);
    LAS unsigned* bm = (LAS unsigned*)(F.lds + F.wave * 2048);
    const int l = F.lane; const int gw = blockIdx.x * NWAVES + F.wave, NGW = F.G * NWAVES;
    unsigned miss = 0, badq = 0, dup = 0;
    for (int q = gw; q < NROWS; q += NGW) {
        for (int i = l; i < 260; i += 64) bm[i] = 0u;
        IX_FENCE();
        const int n = NSEL[q], nb = NSELB[q];
        for (int i = l; i < n; i += 64) { const unsigned j = SEL[(size_t)q * TOPK + i]; atomicOr((unsigned*)&bm[j >> 5], 1u << (j & 31)); }
        IX_FENCE();
        unsigned m = (n != nb) ? 1000u : 0u;
        for (int i = l; i < nb && i < TOPK; i += 64) { const unsigned j = SELB[(size_t)q * TOPK + i]; if (j >= (unsigned)TT) { ++dup; ++m; } else { const unsigned old = atomicAnd((unsigned*)&bm[j >> 5], ~(1u << (j & 31))); if (!((old >> (j & 31)) & 1u)) ++m; } }
        IX_FENCE();
        m = (unsigned)wave_sum((float)m);
        if (l == 0) { miss += m; badq += m ? 1u : 0u; }
    }
    dup = (unsigned)wave_sum((float)dup);
    if (l == 0) { atomicAdd((unsigned*)F.ctl + 2048, miss); atomicAdd((unsigned*)F.ctl + 2049, badq); atomicAdd((unsigned*)F.ctl + 2050, dup); }
}
#endif

typedef short v4i16_t __attribute__((ext_vector_type(4)));
__device__ __forceinline__ unsigned at_off(unsigned row, unsigned ch) { return 256u * row + 16u * (ch ^ (((row & 3u) << 2) | ((row >> 2) & 3u))); }

__device__ __forceinline__ void p6_attn_mfma(Frame& F, bf16* OUTB) {
    bf16* QA = WSP(bf16, WS_QA); const bf16* CKV = WSP(bf16, WS_CKV); const unsigned short* SEL = WSP(unsigned short, WS_SEL); const int* NSEL = WSP(int, WS_NSEL);
    const int l = F.lane, w = F.wave, h16 = l & 15, g = l >> 4;
    LAS unsigned char* tile = F.lds + w * 8192;
    const float slope = h16 < 8 ? __uint_as_float((unsigned)(127 - (h16 + 1)) << 23) : 0.f;
    {
        const int gw = blockIdx.x * NWAVES + w, NGW = F.G * NWAVES;
        for (int q = NROWS + gw; q < R; q += NGW) { bf16* qrow = QA + (size_t)q * QAW; for (int c = l; c < QAW / 8; c += 64) *(v4u*)(qrow + 8 * c) = (v4u){0u, 0u, 0u, 0u}; }
    }
    const int G = F.G;
    int nq_tot, qbase_b, wib, wpb;
    if ((G & 7) == 0) { const int b = (blockIdx.x & 7) >> 1; qbase_b = b * SEQ; nq_tot = SEQ + (b == 0 ? NMETA : 0); wib = (((blockIdx.x >> 3) * 2) + (blockIdx.x & 1)) * NWAVES + w; wpb = (G / 4) * NWAVES; }
    else { qbase_b = 0; nq_tot = NROWS; wib = blockIdx.x * NWAVES + w; wpb = G * NWAVES; }
    for (int qi = wib; qi < nq_tot; qi += wpb) {
        int q, b, pos;
        if ((G & 7) == 0) { if (qi < SEQ) { q = qbase_b + qi; b = q >> 13; pos = NMETA + qi; } else { q = NREAL + (qi - SEQ); b = 0; pos = qi - SEQ; } }
        else { q = qi; if (q < NREAL) { b = q >> 13; pos = NMETA + (q & (SEQ - 1)); } else { b = 0; pos = q - NREAL; } }
        bf16* qrow = QA + (size_t)q * QAW;
        const int nsel = NSEL[q];
        const int nch = (nsel + 31) >> 5;
        const unsigned short* selq = SEL + (size_t)q * TOPK;
        bf16x8 qf[4];
#pragma unroll
        for (int s = 0; s < 4; ++s) { const v4u t = h16 < 8 ? *(const v4u*)(qrow + h16 * 128 + 32 * s + 8 * g) : (v4u){0u, 0u, 0u, 0u}; qf[s] = __builtin_bit_cast(bf16x8, t); }
        float m = -INFINITY, lsum = 0.f;
        f32x4 O[8];
#pragma unroll
        for (int c = 0; c < 8; ++c) O[c] = (f32x4){0.f, 0.f, 0.f, 0.f};
        v4u gr[8];
#pragma unroll
        for (int i = 0; i < 8; ++i) { const int s = g + 4 * i; const int kj = s < nsel ? (int)selq[s] : (int)selq[0]; gr[i] = *(const v4u*)(CKV + (size_t)key_row(b, kj) * 128 + 8 * h16); }
        for (int ck = 0; ck < nch; ++ck) {
            IX_FENCE();
#pragma unroll
            for (int i = 0; i < 8; ++i) *(LAS v4u*)(tile + at_off((unsigned)(g + 4 * i), (unsigned)h16)) = gr[i];
            const v4u kv = *(const v4u*)(selq + 32 * ck + 8 * g);
            if (ck + 1 < nch) {
#pragma unroll
                for (int i = 0; i < 8; ++i) { const int s = 32 * (ck + 1) + g + 4 * i; const int kj = s < nsel ? (int)selq[s] : (int)selq[0]; gr[i] = *(const v4u*)(CKV + (size_t)key_row(b, kj) * 128 + 8 * h16); }
            }
            IX_FENCE();
            f32x4 a0 = (f32x4){0.f, 0.f, 0.f, 0.f}, a1 = a0;
#pragma unroll
            for (int s = 0; s < 4; ++s) {
                const bf16x8 k0 = *(const LAS bf16x8*)(tile + at_off((unsigned)(8 * (h16 >> 2) + (h16 & 3)), (unsigned)(4 * s + g)));
                const bf16x8 k1 = *(const LAS bf16x8*)(tile + at_off((unsigned)(8 * (h16 >> 2) + 4 + (h16 & 3)), (unsigned)(4 * s + g)));
                a0 = __builtin_amdgcn_mfma_f32_16x16x32_bf16(k0, qf[s], a0, 0, 0, 0);
                a1 = __builtin_amdgcn_mfma_f32_16x16x32_bf16(k1, qf[s], a1, 0, 0, 0);
            }
            const unsigned kw[4] = {kv.x, kv.y, kv.z, kv.w};
            float x[8];
#pragma unroll
            for (int j = 0; j < 8; ++j) {
                const int kj = (int)((kw[j >> 1] >> (16 * (j & 1))) & 0xffffu);
                const float lg = (j < 4 ? a0[j & 3] : a1[j & 3]) - slope * fabsf((float)(pos - kj));
                x[j] = (32 * ck + 8 * g + j) < nsel ? lg : -INFINITY;
            }
            float cm = fmaxf(fmaxf(fmaxf(x[0], x[1]), fmaxf(x[2], x[3])), fmaxf(fmaxf(x[4], x[5]), fmaxf(x[6], x[7])));
            cm = fmaxf(cm, __shfl_xor(cm, 16)); cm = fmaxf(cm, __shfl_xor(cm, 32));
            const float mn = fmaxf(m, cm);
            const float alpha = __expf(m - mn);
            float p[8], ps = 0.f;
#pragma unroll
            for (int j = 0; j < 8; ++j) { p[j] = __expf(x[j] - mn); ps += p[j]; }
            ps += __shfl_xor(ps, 16); ps += __shfl_xor(ps, 32);
            lsum = lsum * alpha + ps; m = mn;
            if (__any(alpha != 1.0f)) {
#pragma unroll
                for (int rr = 0; rr < 4; ++rr) { const float sc = __shfl(alpha, 4 * g + rr);
#pragma unroll
                    for (int c = 0; c < 8; ++c) O[c][rr] *= sc; }
            }
            const v4u pw = (v4u){pk2(p[0], p[1]), pk2(p[2], p[3]), pk2(p[4], p[5]), pk2(p[6], p[7])};
            const bf16x8 pf = __builtin_bit_cast(bf16x8, pw);
#pragma unroll
            for (int c = 0; c < 8; ++c) {
                const unsigned qd = (unsigned)(h16 >> 2), pp = (unsigned)(h16 & 3);
                const v4i16_t t0 = __builtin_amdgcn_ds_read_tr16_b64_v4i16((LAS v4i16_t*)(tile + at_off(8u * g + qd, 2u * c + (pp >> 1)) + 8u * (pp & 1u)));
                const v4i16_t t1 = __builtin_amdgcn_ds_read_tr16_b64_v4i16((LAS v4i16_t*)(tile + at_off(8u * g + 4u + qd, 2u * c + (pp >> 1)) + 8u * (pp & 1u)));
                bf16x8 vf; vf[0] = t0[0]; vf[1] = t0[1]; vf[2] = t0[2]; vf[3] = t0[3]; vf[4] = t1[0]; vf[5] = t1[1]; vf[6] = t1[2]; vf[7] = t1[3];
                O[c] = __builtin_amdgcn_mfma_f32_16x16x32_bf16(pf, vf, O[c], 0, 0, 0);
            }
        }
        const float inv = 1.0f / lsum;
#pragma unroll
        for (int rr = 0; rr < 4; ++rr) {
            const float sc = __shfl(inv, 4 * g + rr);
            if (g < 2) {
#pragma unroll
                for (int c = 0; c < 8; ++c) (OUTB + (size_t)q * QAW)[(4 * g + rr) * 128 + 16 * c + h16] = (bf16)f2bf(O[c][rr] * sc);
            }
        }
    }
}
struct StoreBf16 { bf16* O; int ld;
    __device__ __forceinline__ void operator()(int row, int col, const f32x4& v) const { *(v2u*)(O + (size_t)row * ld + col) = (v2u){pk2(v.x, v.y), pk2(v.z, v.w)}; }
    __device__ __forceinline__ void one(int row, int col, float v) const { O[(size_t)row * ld + col] = (bf16)f2bf(v); } };
struct StoreRes1 { const bf16* H; float* out; float* meta;
    __device__ __forceinline__ void operator()(int row, int col, const f32x4& v) const {
        if (row >= NROWS) return;
        const v2u hw = *(const v2u*)(H + (size_t)row * D + col);
        const f32x4 o = (f32x4){ALPHA * bflo(hw.x) + v.x, ALPHA * bfhi(hw.x) + v.y, ALPHA * bflo(hw.y) + v.z, ALPHA * bfhi(hw.y) + v.w};
        float* dst = row < NREAL ? out + (size_t)row * D + col : meta + (size_t)(row - NREAL) * D + col;
        *(f32x4*)dst = o; }
    __device__ __forceinline__ void one(int row, int col, float v) const { if (row >= NROWS) return; float* dst = row < NREAL ? out + (size_t)row * D + col : meta + (size_t)(row - NREAL) * D + col; *dst = ALPHA * bf2f(H[(size_t)row * D + col]) + v; } };
struct StoreRes2 { const bf16* H; float* out; __device__ __forceinline__ void operator()(int row, int col, const f32x4& v) const {
        if (row >= NREAL) return;
        const v2u hw = *(const v2u*)(H + (size_t)row * D + col);
        *(f32x4*)(out + (size_t)row * D + col) = (f32x4){ALPHA * bflo(hw.x) + v.x, ALPHA * bfhi(hw.x) + v.y, ALPHA * bflo(hw.y) + v.z, ALPHA * bfhi(hw.y) + v.w}; } };

struct StoreMetaGate { float* GM; __device__ __forceinline__ void one(int row, int col, float v) const { const int m = row - NREAL, x = col & 255; if (m >= 14 && x < 128) GM[(size_t)(m - 14) * DFF + 128 * (col >> 8) + x] = v; } };
template <class Fn>
__device__ __forceinline__ void meta_gemm(Frame& F, const bf16* A, int lda, const bf16* Bt, int N, int K, const Fn& fn) {
    const int l = F.lane, i16 = l & 15, g = l >> 4;
    const int gw = blockIdx.x * NWAVES + F.wave, NGW = F.G * NWAVES;
    for (int t = gw; t < N / 16; t += NGW) {
        const bf16* ap = A + (size_t)(NREAL + i16) * lda + 8 * g; const bf16* bp = Bt + (size_t)(16 * t + i16) * K + 8 * g;
        f32x4 acc = (f32x4){0.f, 0.f, 0.f, 0.f};
#pragma unroll 8
        for (int s = 0; s < K / 32; ++s) acc = __builtin_amdgcn_mfma_f32_16x16x32_bf16(*(const pg8::bf16x8*)(ap + 32 * s), *(const pg8::bf16x8*)(bp + 32 * s), acc, 0, 0, 0);
#pragma unroll
        for (int rr = 0; rr < 4; ++rr) fn.one(NREAL + 4 * g + rr, 16 * t + i16, acc[rr]);
    }
}

template <class Fn>
__device__ __forceinline__ void run_gemm(Frame& F, const bf16* A, int lda, const bf16* Bt, int N, int K, const Fn& fn) {
    pg8::Gemm g{A, Bt, NREAL, N, K, lda}; pg8::StaticOrder S; S.init(NREAL, N, F.G, (int)blockIdx.x);
    pg8::EpiFn<Fn> E{fn};
    pg8::gemm_phase<pg8::EpiFn<Fn>, pg8::StaticOrder, true, true>(F.lds + RING_OFF, g, S, E);
}

constexpr int NPHASES = 13;
struct Args { const float* in[32]; float* out; unsigned char* ws; int ph_lo, ph_hi; };
__global__ void __launch_bounds__(NTHR, 2) fwd(Args args) {
    extern __shared__ __attribute__((aligned(16))) unsigned char lds[];
    Frame F;
    F.lds = (LAS unsigned char*)lds;
    F.MISC = (volatile LAS unsigned*)(F.lds + MISC_OFF);
    F.tid = threadIdx.x; F.lane = F.tid & 63; F.wave = __builtin_amdgcn_readfirstlane(F.tid >> 6);
    F.G = gridDim.x;
#pragma unroll
    for (int i = 0; i < 32; ++i) F.in[i] = args.in[i];
    F.out = args.out; F.ws = args.ws;
    F.ctl = (gu32*)(args.ws + WS_CTL);
    for (int u = F.tid; u < (LDS_BYTES - LDSCTL_OFF) / 4; u += NTHR) ((LAS unsigned*)(F.lds + LDSCTL_OFF))[u] = 0u;
    __syncthreads();
    const int lo = args.ph_lo, hi = args.ph_hi;
    XcdBarrier bar; bar.bar = (unsigned*)(F.ctl + CW_BAR); bar.x = 0; bar.st = nullptr;
    if (hi - lo > 1) bar = xcd_barrier_post((unsigned*)(F.ctl + CW_BAR), F.MISC + 8);
#define IN(k) (lo <= (k) && (k) < hi)
#define SEAM(k) do { if (IN(k) && IN((k) + 1)) xcd_barrier(bar); } while (0)
#ifndef PROBE_PH
#define PROBE_PH -1
#endif
#define REP(k) for (int rep_ = 0; rep_ < ((PROBE_PH == (k)) ? 2 : 1); ++rep_)

#ifndef IDX_NAIVE
#define IDX_NAIVE 0
#endif
#ifndef ATTN_NAIVE
#define ATTN_NAIVE 0
#endif
    if (IN(0)) REP(0) { if (rep_) __syncthreads(); p0_weights(F); p1_ln_in(F); } SEAM(0);
    if (IN(1)) REP(1) { if (rep_) __syncthreads(); run_gemm(F, WSP(bf16, WS_H), D, WSP(bf16, WS_WT_IN), PW, D, StoreBf16{WSP(bf16, WS_P), PW}); meta_gemm(F, WSP(bf16, WS_H), D, WSP(bf16, WS_WT_IN), PW, D, StoreBf16{WSP(bf16, WS_P), PW}); } SEAM(1);
    if (IN(2)) REP(2) { if (rep_) __syncthreads(); p3_prep(F); } SEAM(2);
    if (IN(3)) REP(3) { if (rep_) __syncthreads(); run_gemm(F, WSP(bf16, WS_CQN), 256, WSP(bf16, WS_WT_QA), QAW, 256, StoreBf16{WSP(bf16, WS_QA), QAW}); meta_gemm(F, WSP(bf16, WS_CQN), 256, WSP(bf16, WS_WT_QA), QAW, 256, StoreBf16{WSP(bf16, WS_QA), QAW});
#if REFSEL
        refsel_rows(F);
#endif
    } SEAM(3);
    if (IN(4)) REP(4) { if (rep_) __syncthreads(); rw_b1(F); } SEAM(4);
    if (IN(5)) {
        rw_b2(F); __syncthreads();
#if CHECK_IDX
        p5_index_naive(F); __syncthreads(); p5_index_mfma(F, (unsigned short*)F.out, (int*)((char*)F.out + 32 * MiB));
#elif IDX_NAIVE
        p5_index_naive(F);
#else
        p5_index_mfma(F, WSP(unsigned short, WS_SEL), WSP(int, WS_NSEL));
#ifdef PROBE_IDX
        __syncthreads(); p5_index_mfma(F, WSP(unsigned short, WS_SEL), WSP(int, WS_NSEL), 3136);
#endif
#ifdef PROBE_IDX_SCORE
        __syncthreads(); p5_index_mfma(F, (unsigned short*)F.out, (int*)((char*)F.out + 32 * MiB), 3136, true);
#endif
#endif
    } SEAM(5);
    if (IN(6)) {
#if CHECK_IDX
        idx_check(F); __syncthreads();
#endif
#if ATTN_NAIVE
        p6_attn_naive(F);
#else
        p6_attn_mfma(F, WSP(bf16, WS_QA));
#endif
        __syncthreads();
        rw_b3(F);
    } SEAM(6);
    if (IN(7)) REP(7) { if (rep_) __syncthreads(); run_gemm(F, WSP(bf16, WS_QA), QAW, WSP(bf16, WS_WT_MIX), D, QAW, StoreRes1{WSP(bf16, WS_H), F.out, WSP(float, WS_META1)}); meta_gemm(F, WSP(bf16, WS_QA), QAW, WSP(bf16, WS_WT_MIX), D, QAW, StoreRes1{WSP(bf16, WS_H), F.out, WSP(float, WS_META1)}); } SEAM(7);
    if (IN(8)) REP(8) { if (rep_) __syncthreads(); p10_ln1(F); } SEAM(8);
    if (IN(9)) {
        pg8::Gemm g{WSP(bf16, WS_H), WSP(bf16, WS_WT_UP), NREAL, UPW, D, D}; pg8::StaticOrder S; S.init(NREAL, UPW, F.G, (int)blockIdx.x);
        pg8::EpiConvAct E{WSP(unsigned short, WS_UP), DFF, F.in[IN_CONV_W], F.in[IN_CONV_B], DFF, WSP(float, WS_G01), WSP(float, WS_V01), WSP(float, WS_GHALO), (PG8_LAS float*)(F.lds + RING_BYTES + 4096)};
        pg8::gemm_phase<pg8::EpiConvAct, pg8::StaticOrder, true, true>(F.lds + RING_OFF, g, S, E);
        meta_gemm(F, WSP(bf16, WS_H), D, WSP(bf16, WS_WT_UP), UPW, D, StoreMetaGate{WSP(float, WS_GMETA)});
    } SEAM(9);
    if (IN(10)) { p12_conv_fix(F); } SEAM(10);
    if (IN(11)) REP(11) { if (rep_) __syncthreads(); run_gemm(F, WSP(bf16, WS_UP), DFF, WSP(bf16, WS_WT_DN), D, DFF, StoreRes2{WSP(bf16, WS_H), F.out}); } SEAM(11);
    if (IN(12)) { p14_ln2(F);
#if CHECK_IDX
        if (blockIdx.x == 0 && F.tid == 0) {
            const unsigned miss = __hip_atomic_load((unsigned*)F.ctl + 2048, __ATOMIC_RELAXED, __HIP_MEMORY_SCOPE_AGENT), dupc = __hip_atomic_load((unsigned*)F.ctl + 2050, __ATOMIC_RELAXED, __HIP_MEMORY_SCOPE_AGENT);
            if (dupc) F.out[5] = __builtin_inff();
            if (miss > CHECK_IDX_MAXMISS) F.out[3] = __builtin_nanf("");
        }
#endif
    }
#undef IN
#undef SEAM
}

extern "C" void kernel_launch(void* const* d_in, const int* in_sizes, int n_in, void* d_out, int out_size, void* d_ws, size_t ws_size, hipStream_t stream) {
    static int grid = 0;
    if (grid == 0) {
        if (n_in != 32 || out_size != NREAL * D || ws_size < WS_END) { fprintf(stderr, "kernel_launch: unexpected shapes: n_in %d out %d ws %zu\n", n_in, out_size, ws_size); grid = -1; return; }
        int dev = 0, cus = 0, per_cu = 0;
        if (hipGetDevice(&dev) != hipSuccess || hipDeviceGetAttribute(&cus, hipDeviceAttributeMultiprocessorCount, dev) != hipSuccess) { grid = -1; return; }
        if (hipFuncSetAttribute((const void*)fwd, hipFuncAttributeMaxDynamicSharedMemorySize, LDS_BYTES) != hipSuccess) { fprintf(stderr, "kernel_launch: hipFuncSetAttribute failed\n"); grid = -1; return; }
        if (hipOccupancyMaxActiveBlocksPerMultiprocessor(&per_cu, (const void*)fwd, NTHR, LDS_BYTES) != hipSuccess || per_cu < 1) fprintf(stderr, "kernel_launch: occupancy query says %d\n", per_cu);
        (void)hipGetLastError();
        grid = cus;
    }
    if (grid < 0) return;
    (void)hipMemsetAsync((char*)d_ws + WS_CTL, 0, CTL_ZERO_BYTES, stream);
    Args a{};
    for (int i = 0; i < 32; ++i) a.in[i] = (const float*)d_in[i];
    a.out = (float*)d_out; a.ws = (unsigned char*)d_ws;
#if ONE_LAUNCH
    a.ph_lo = 0; a.ph_hi = NPHASES;
    hipLaunchKernelGGL(fwd, dim3(grid), dim3(NTHR), LDS_BYTES, stream, a);
#else
    for (int p = 0; p < NPHASES; ++p) { a.ph_lo = p; a.ph_hi = p + 1; hipLaunchKernelGGL(fwd, dim3(grid), dim3(NTHR), LDS_BYTES, stream, a); }
#endif
}
```

```cpp
#include <hip/hip_runtime.h>
#include <cstdio>
#include <cstdint>
#define ONE_LAUNCH 1
namespace pg8 {
#define PG8_LAS __attribute__((address_space(3)))
typedef unsigned short bf16_t;
typedef short bf16x8 __attribute__((ext_vector_type(8)));
typedef float f32x4 __attribute__((ext_vector_type(4)));
typedef unsigned u32x4 __attribute__((ext_vector_type(4)));
constexpr int BM = 256, BK = 64, HALF = 128, HTB = HALF * BK * 2  , STAGE_BYTES = 8 * HTB, NXCD = 8, WGM = 8;

__host__ __device__ __forceinline__ int lds_byte(int r, int c) { const int st = (r >> 4) * 2 + (c >> 5), rr = r & 15, cc = c & 31, ob = rr * 64 + cc * 2; return st * 1024 + (ob ^ (((ob >> 9) & 1) << 5)); }
__host__ __device__ __forceinline__ void stage_rc(int b, int& R, int& C) { const int st = b / 1024, sb = b % 1024, swz = sb ^ (((sb >> 9) & 1) << 5); R = (st >> 1) * 16 + swz / 64; C = (st & 1) * 32 + (swz % 64) / 2; }
__host__ __device__ __forceinline__ int perm32(int rho) { const int n = rho >> 4, i = rho & 15; return 8 * (i >> 2) + 4 * n + (i & 3); }

struct Unit { int pm, pn; };
struct Gemm { const bf16_t* A; const bf16_t* Bt; int M, N, K, lda; };

struct StaticOrder {
    int nM, nN, nwg, G, c;
    __host__ __device__ void init(int M, int N, int G_, int c_) { nM = M / BM; nN = N / BM; nwg = nM * nN; G = G_; c = c_; }
    __host__ __device__ bool next(int i, Unit& u) const {
        const long L = (long)i * G + c; if (L >= nwg) return false;
        int wgid = (int)L; { const int q = nwg / NXCD, r = nwg % NXCD, xcd = wgid % NXCD, off = wgid / NXCD; wgid = (xcd < r ? xcd * (q + 1) : r * (q + 1) + (xcd - r) * q) + off; }
        const int nig = WGM * nN, gid = wgid / nig, fm = gid * WGM, gsz = (nM - fm) < WGM ? (nM - fm) : WGM;
        u.pm = fm + ((wgid % nig) % gsz); u.pn = (wgid % nig) / gsz; return true;
    }
    __device__ __forceinline__ void a_ready(const Unit&) const {}
    __device__ __forceinline__ void done(const Unit&) const {}
};


template <class F> struct EpiFn {
    static constexpr bool PERM = false, AFTER_DRAIN = false;
    F f;
    __device__ __forceinline__ void operator()(const f32x4 (&acc)[2][2][4][2], const Unit& u, int wr, int wc, int fr, int fq) const {
        const int row0 = u.pm * BM + wr * 64 + fr, col0 = u.pn * BM + wc * 32 + 4 * fq;
#pragma unroll
        for (int ai = 0; ai < 2; ++ai)
#pragma unroll
            for (int m = 0; m < 4; ++m) {
                const int row = row0 + ai * HALF + m * 16;
#pragma unroll
                for (int bj = 0; bj < 2; ++bj)
#pragma unroll
                    for (int n = 0; n < 2; ++n) f(row, col0 + bj * HALF + n * 16, acc[ai][bj][m][n]);
            }
    }
};

struct EpiConvAct {
    static constexpr bool PERM = false, AFTER_DRAIN = false;
    unsigned short* ACT; int ldact;
    const float* cw; const float* cb; int dff;
    float* G01; float* V01; float* GHALO;
    PG8_LAS float* hal;
    __device__ __forceinline__ void operator()(const f32x4 (&acc)[2][2][4][2], const Unit& u, int wr, int wc, int fr, int fq) const {
        const int colg = 128 * u.pn + wc * 32 + 4 * fq;
        f32x4 w0[2], w1[2], w2[2], bb[2];
#pragma unroll
        for (int n = 0; n < 2; ++n) { w0[n] = *(const f32x4*)(cw + colg + 16 * n); w1[n] = *(const f32x4*)(cw + dff + colg + 16 * n); w2[n] = *(const f32x4*)(cw + 2 * dff + colg + 16 * n); bb[n] = *(const f32x4*)(cb + colg + 16 * n); }
        if (fr >= 14) {
#pragma unroll
            for (int ai = 0; ai < 2; ++ai)
#pragma unroll
                for (int n = 0; n < 2; ++n) *(PG8_LAS f32x4*)(hal + (((2 * ai + wr) * 4 + wc) * 2 + (fr - 14)) * 32 + 16 * n + 4 * fq) = acc[ai][0][3][n];
        }
        asm volatile("s_waitcnt lgkmcnt(0)" ::: "memory"); __builtin_amdgcn_s_barrier(); asm volatile("" ::: "memory");
#pragma unroll
        for (int ai = 0; ai < 2; ++ai) {
            const int blk = 2 * ai + wr;
#pragma unroll
            for (int n = 0; n < 2; ++n) {
                f32x4 prev = (f32x4){0.f, 0.f, 0.f, 0.f};
                if (blk > 0) prev = *(const PG8_LAS f32x4*)(hal + ((((blk - 1) * 4 + wc) * 2 + (fr & 1)) * 32) + 16 * n + 4 * fq);
#pragma unroll
                for (int m = 0; m < 4; ++m) {
                    const f32x4 cur = acc[ai][0][m][n], val = acc[ai][1][m][n];
                    f32x4 o;
#pragma unroll
                    for (int e = 0; e < 4; ++e) {
                        float s1 = prev[e], s2 = prev[e];
                        asm volatile("s_nop 1\n\tv_mov_b32_dpp %0, %0 row_ror:1 row_mask:0xf bank_mask:0xf\n\tv_mov_b32_dpp %1, %1 row_ror:2 row_mask:0xf bank_mask:0xf\n\ts_nop 1\n\t"
                                     "v_mov_b32_dpp %0, %2 row_shr:1 row_mask:0xf bank_mask:0xf\n\tv_mov_b32_dpp %1, %2 row_shr:2 row_mask:0xf bank_mask:0xf\n\ts_nop 1" : "+v"(s1), "+v"(s2) : "v"(cur[e]));
                        const float x = w0[n][e] * s2 + w1[n][e] * s1 + w2[n][e] * cur[e] + bb[n][e];
                        const float u2 = x * (1.5957691216057308f + 0.07135481627260025f * x * x);
                        o[e] = x * __builtin_amdgcn_rcpf(1.0f + __builtin_amdgcn_exp2f(-1.4426950408889634f * u2)) * val[e];
                    }
                    const int rt = ai * HALF + wr * 64 + m * 16 + fr;
                    const int row = u.pm * BM + rt;
                    if (blk == 0 && m == 0 && fr < 2) {
                        *(f32x4*)(G01 + ((size_t)u.pm * 2 + fr) * dff + colg + 16 * n) = cur; *(f32x4*)(V01 + ((size_t)u.pm * 2 + fr) * dff + colg + 16 * n) = val;
                    } else {
                        typedef unsigned u32x2 __attribute__((ext_vector_type(2)));
                        typedef __bf16 b2 __attribute__((ext_vector_type(2)));
                        const b2 lo = {(__bf16)o[0], (__bf16)o[1]}, hi = {(__bf16)o[2], (__bf16)o[3]};
                        *(u32x2*)(ACT + (size_t)row * ldact + colg + 16 * n) = (u32x2){__builtin_bit_cast(unsigned, lo), __builtin_bit_cast(unsigned, hi)};
                    }
                    if (blk == 3 && m == 3 && fr >= 14) *(f32x4*)(GHALO + ((size_t)u.pm * 2 + (fr - 14)) * dff + colg + 16 * n) = cur;
                    prev = cur;
                }
            }
        }
        asm volatile("s_waitcnt lgkmcnt(0)" ::: "memory"); __builtin_amdgcn_s_barrier(); asm volatile("" ::: "memory");
    }
};
template <class Epi, class Sched, bool ALIGN_EPI = false, bool SP2 = false>
__device__ __forceinline__ void gemm_phase(PG8_LAS unsigned char* lds, const Gemm g, const Sched& S, const Epi& E) {
    const int tid = threadIdx.x, wid = __builtin_amdgcn_readfirstlane(tid >> 6), lane = tid & 63, wr = wid >> 2, wc = wid & 3, fr = lane & 15, fq = lane >> 4;
    const int K = g.K, nt = K / BK;
    unsigned voffA[2], voffB[2];
#pragma unroll
    for (int i = 0; i < 2; ++i) { int R, C; stage_rc(tid * 16 + i * 8192, R, C); const int Rb = Epi::PERM ? ((R & ~31) + perm32(R & 31)) : R;
        voffA[i] = (unsigned)(R * g.lda + C) * 2u; voffB[i] = (unsigned)(Rb * K + C) * 2u; }
    const size_t kstep = (size_t)(BK * 2);
    const size_t hA = (size_t)HALF * g.lda * 2, hB = (size_t)HALF * K * 2;
    const size_t tA = 2 * hA, tB = 2 * hB;
    const unsigned ldsw = (unsigned)wid * 1024u;
    const int aoff = lds_byte(wr * 64 + fr, fq * 8), boff = lds_byte(wc * 32 + fr, fq * 8);
#define PG8_SA(b, h) (((b) * 2 + (h)) * HTB)
#define PG8_SB(b, h) ((4 + (b) * 2 + (h)) * HTB)
#define PG8_STAGE(bufoff, gbase, voff) do { _Pragma("unroll") for (int _i = 0; _i < 2; ++_i) \
        __builtin_amdgcn_global_load_lds((const unsigned*)((const char*)(gbase) + (voff)[_i]), (PG8_LAS unsigned*)(lds + (bufoff) + ldsw + _i * 8192), 16, 0, 0); } while (0)
#define PG8_LDA(dst, b, h) do { _Pragma("unroll") for (int m = 0; m < 4; ++m) _Pragma("unroll") for (int k = 0; k < 2; ++k) dst[m][k] = *(const PG8_LAS bf16x8*)(lds + PG8_SA(b, h) + aoff + m * 2048 + k * 1024); } while (0)
#define PG8_LDB(dst, b, h) do { _Pragma("unroll") for (int n = 0; n < 2; ++n) _Pragma("unroll") for (int k = 0; k < 2; ++k) dst[n][k] = *(const PG8_LAS bf16x8*)(lds + PG8_SB(b, h) + boff + n * 2048 + k * 1024); } while (0)
#define PG8_MMA(ai, bj, At, Bt) do { __builtin_amdgcn_s_setprio(1); _Pragma("unroll") for (int m = 0; m < 4; ++m) _Pragma("unroll") for (int n = 0; n < 2; ++n) _Pragma("unroll") for (int k = 0; k < 2; ++k) \
        acc[ai][bj][m][n] = __builtin_amdgcn_mfma_f32_16x16x32_bf16(Bt[n][k], At[m][k], acc[ai][bj][m][n], 0, 0, 0); __builtin_amdgcn_s_setprio(0); } while (0)
#define PG8_WAIT_V(n) asm volatile("s_waitcnt vmcnt(" #n ")" ::: "memory")
#define PG8_WAIT_L(n) asm volatile("s_waitcnt lgkmcnt(" #n ")" ::: "memory")
#define PG8_BAR __builtin_amdgcn_s_barrier()
#define PG8_SCHED __builtin_amdgcn_sched_barrier(0)
    Unit cur, nxt; int ui = 0;
    if (!S.next(0, cur)) return;
    f32x4 acc[2][2][4][2];
#pragma unroll
    for (int a = 0; a < 2; ++a)
#pragma unroll
        for (int b = 0; b < 2; ++b)
#pragma unroll
            for (int m = 0; m < 4; ++m)
#pragma unroll
                for (int n = 0; n < 2; ++n) acc[a][b][m][n] = (f32x4){0.f, 0.f, 0.f, 0.f};
    bf16x8 At[4][2], B0[2][2], B1[2][2];
    const char* cA = (const char*)g.A + (size_t)cur.pm * tA; const char* cB = (const char*)g.Bt + (size_t)cur.pn * tB;
    S.a_ready(cur);
    if constexpr (SP2) {
        PG8_STAGE(PG8_SB(0, 0), cB, voffB); PG8_STAGE(PG8_SB(0, 1), cB + hB, voffB); PG8_STAGE(PG8_SA(0, 0), cA, voffA); PG8_STAGE(PG8_SA(0, 1), cA + hA, voffA);
        if (wr == 1) PG8_BAR;
        PG8_WAIT_V(2); PG8_BAR;
        PG8_STAGE(PG8_SB(1, 0), cB + kstep, voffB); PG8_STAGE(PG8_SA(1, 0), cA + kstep, voffA); PG8_STAGE(PG8_SB(1, 1), cB + hB + kstep, voffB);
        PG8_WAIT_V(6); PG8_BAR;
    } else {
        PG8_STAGE(PG8_SB(0, 0), cB, voffB); PG8_STAGE(PG8_SA(0, 0), cA, voffA); PG8_STAGE(PG8_SB(0, 1), cB + hB, voffB); PG8_STAGE(PG8_SA(0, 1), cA + hA, voffA);
        if (wr == 1) PG8_BAR;
        PG8_WAIT_V(4); PG8_BAR;
        PG8_STAGE(PG8_SB(1, 0), cB + kstep, voffB); PG8_STAGE(PG8_SA(1, 0), cA + kstep, voffA); PG8_STAGE(PG8_SB(1, 1), cB + hB + kstep, voffB);
        PG8_WAIT_V(6); PG8_BAR;
    }
    for (;;) {
        const bool has_next = S.next(ui + 1, nxt);
        const char* nA = has_next ? (const char*)g.A + (size_t)nxt.pm * tA : cA; const char* nB = has_next ? (const char*)g.Bt + (size_t)nxt.pn * tB : cB;
        for (int t = 0; t < nt; t += 2) {
            const bool last = (t == nt - 2);
            const char* a1 = cA + (size_t)(t + 1) * kstep;
            const char* a2 = last ? nA : cA + (size_t)(t + 2) * kstep; const char* b2 = last ? nB : cB + (size_t)(t + 2) * kstep;
            const char* a3 = a2 + kstep; const char* b3 = b2 + kstep;
            if (last && has_next) S.a_ready(nxt);
            if constexpr (SP2) {
            PG8_LDB(B0, 0, 0); PG8_LDB(B1, 0, 1); PG8_SCHED; PG8_LDA(At, 0, 0); PG8_STAGE(PG8_SA(1, 1), a1 + hA, voffA);
            PG8_WAIT_V(8); PG8_WAIT_L(0); PG8_BAR; PG8_MMA(0, 0, At, B0); PG8_MMA(0, 1, At, B1); PG8_BAR; PG8_SCHED;
            PG8_LDA(At, 0, 1); PG8_STAGE(PG8_SB(0, 0), b2, voffB); PG8_STAGE(PG8_SB(0, 1), b2 + hB, voffB); PG8_STAGE(PG8_SA(0, 0), a2, voffA);
            PG8_WAIT_V(8); PG8_WAIT_L(0); PG8_BAR; PG8_MMA(1, 0, At, B0); PG8_MMA(1, 1, At, B1); PG8_BAR; PG8_SCHED;
            PG8_LDB(B0, 1, 0); PG8_LDB(B1, 1, 1); PG8_SCHED; PG8_LDA(At, 1, 0); PG8_STAGE(PG8_SA(0, 1), a2 + hA, voffA);
            PG8_WAIT_V(8); PG8_WAIT_L(0); PG8_BAR; PG8_MMA(0, 0, At, B0); PG8_MMA(0, 1, At, B1); PG8_BAR; PG8_SCHED;
            PG8_LDA(At, 1, 1); PG8_STAGE(PG8_SB(1, 0), b3, voffB); PG8_STAGE(PG8_SB(1, 1), b3 + hB, voffB); PG8_STAGE(PG8_SA(1, 0), a3, voffA);
            PG8_WAIT_V(8); PG8_WAIT_L(0); PG8_BAR; PG8_MMA(1, 0, At, B0); PG8_MMA(1, 1, At, B1); PG8_BAR; PG8_SCHED;
            } else {
            PG8_LDB(B0, 0, 0); PG8_SCHED; PG8_LDA(At, 0, 0); PG8_STAGE(PG8_SA(1, 1), a1 + hA, voffA);
            PG8_WAIT_L(8); PG8_BAR; PG8_WAIT_L(0); PG8_MMA(0, 0, At, B0); PG8_BAR; PG8_SCHED;
            PG8_LDB(B1, 0, 1); PG8_STAGE(PG8_SB(0, 0), b2, voffB);
            PG8_BAR; PG8_WAIT_L(0); PG8_MMA(0, 1, At, B1); PG8_BAR;
            PG8_LDA(At, 0, 1); PG8_STAGE(PG8_SA(0, 0), a2, voffA);
            PG8_BAR; PG8_WAIT_L(0); PG8_MMA(1, 0, At, B0); PG8_BAR; PG8_SCHED;
            PG8_STAGE(PG8_SB(0, 1), b2 + hB, voffB);
            PG8_WAIT_V(6); PG8_BAR; PG8_MMA(1, 1, At, B1); PG8_BAR;
            PG8_LDB(B0, 1, 0); PG8_SCHED; PG8_LDA(At, 1, 0); PG8_STAGE(PG8_SA(0, 1), a2 + hA, voffA);
            PG8_WAIT_L(8); PG8_BAR; PG8_WAIT_L(0); PG8_MMA(0, 0, At, B0); PG8_BAR; PG8_SCHED;
            PG8_LDB(B1, 1, 1); PG8_STAGE(PG8_SB(1, 0), b3, voffB);
            PG8_BAR; PG8_WAIT_L(0); PG8_MMA(0, 1, At, B1); PG8_BAR;
            PG8_LDA(At, 1, 1); PG8_STAGE(PG8_SA(1, 0), a3, voffA);
            PG8_BAR; PG8_WAIT_L(0); PG8_MMA(1, 0, At, B0); PG8_BAR; PG8_SCHED;
            PG8_STAGE(PG8_SB(1, 1), b3 + hB, voffB);
            PG8_WAIT_V(6); PG8_BAR; PG8_MMA(1, 1, At, B1); PG8_BAR;
            }
        }
        if constexpr (ALIGN_EPI) { if (wr == 0) PG8_BAR; }
        if constexpr (!Epi::AFTER_DRAIN) { E(acc, cur, wr, wc, fr, fq); S.done(cur); }
        if (!has_next) break;
#pragma unroll
        for (int a = 0; a < 2; ++a)
#pragma unroll
            for (int b = 0; b < 2; ++b)
#pragma unroll
                for (int m = 0; m < 4; ++m)
#pragma unroll
                    for (int n = 0; n < 2; ++n) acc[a][b][m][n] = (f32x4){0.f, 0.f, 0.f, 0.f};
        cur = nxt; cA = nA; cB = nB; ++ui;
        if constexpr (ALIGN_EPI) { if (wr == 1) PG8_BAR; }
    }
    PG8_WAIT_V(0);
    if constexpr (!ALIGN_EPI) { if (wr == 0) PG8_BAR; }
    PG8_BAR;
    if constexpr (Epi::AFTER_DRAIN) { E.fused(acc, cur, wr, wc, fr, fq, lds, wid, lane); S.done(cur); }
#undef PG8_SA
#undef PG8_SB
#undef PG8_STAGE
#undef PG8_LDA
#undef PG8_LDB
#undef PG8_MMA
#undef PG8_WAIT_V
#undef PG8_WAIT_L
#undef PG8_BAR
#undef PG8_SCHED
}
}

#ifndef ONE_LAUNCH
#define ONE_LAUNCH 0
#endif
constexpr int NWAVES = 8, NTHR = 512;
constexpr int D = 1024, BATCH = 4, SEQ = 8192, NMETA = 16, TT = SEQ + NMETA;
constexpr int NREAL = BATCH * SEQ;
constexpr int NROWS = NREAL + NMETA;
constexpr int R = 33024;
constexpr int PW = 2304;
constexpr int PC_CQ = 0, PC_CKV = 256, PC_KIDX = 384, PC_WIDX = 448, PC_R = 512, PC_K = 1024, PC_V = 1536, PC_WD = 2048, PC_AD = 2112, PC_GD = 2176;
constexpr int QAW = 1536;
constexpr int DFF = 2816, UPW = 5632;
constexpr int TOPK = 256;
constexpr float LN_EPS = 1e-5f, GN_EPS = 64e-5f, ALPHA = 1.18920711500272f;

constexpr size_t MiB = 1u << 20;
constexpr size_t WS_CTL = 0, CTL_ZERO_BYTES = 1 * MiB;
constexpr size_t WS_WT_IN = 1 * MiB, WS_WT_QA = 6 * MiB, WS_WT_MIX = 7 * MiB, WS_WT_UP = 10 * MiB, WS_WT_DN = 21 * MiB;
constexpr size_t WS_META1 = 27 * MiB, WS_NSEL = 28 * MiB, WS_WIDX = 29 * MiB;
constexpr size_t WS_H = 33 * MiB;
constexpr size_t WS_P = 98 * MiB, WS_QA = 244 * MiB, WS_CQN = 341 * MiB, WS_SEL = 341 * MiB, WS_CKV = 358 * MiB, WS_KIDX = 367 * MiB;
constexpr size_t WS_DEC = 372 * MiB, WS_AB = 437 * MiB, WS_GB = 470 * MiB;
constexpr size_t WS_WT_LORA = 26 * MiB + 512 * 1024;
constexpr size_t WS_RWM = 372 * MiB, WS_RWN = 405 * MiB, WS_RWQ = 438 * MiB, WS_RWY = 471 * MiB;
constexpr size_t OUT_RWS = 80 * MiB, OUT_BONUS = 116 * MiB;
constexpr size_t WS_G01 = 480 * MiB, WS_V01 = 484 * MiB, WS_GHALO = 488 * MiB, WS_GMETA = 492 * MiB;
constexpr size_t WS_UP = 98 * MiB;
constexpr size_t WS_END = 512 * MiB;
static_assert(WS_P + (size_t)R * PW * 2 <= WS_QA && WS_QA + (size_t)R * QAW * 2 <= WS_CQN && WS_CQN + (size_t)R * 256 * 2 <= WS_CKV && WS_CKV + (size_t)R * 128 * 2 <= WS_KIDX
              && WS_KIDX + (size_t)R * 64 * 2 <= WS_DEC && WS_DEC + (size_t)R * 512 * 4 <= WS_AB && WS_AB + (size_t)R * 512 * 2 <= WS_GB && WS_GB + (size_t)R * 512 * 2 <= WS_END
              && WS_UP + (size_t)R * UPW * 2 <= WS_END && WS_H + (size_t)R * D * 2 <= WS_P && WS_WIDX + (size_t)R * 8 * 4 <= WS_H && WS_NSEL + (size_t)R * 4 <= WS_WIDX, "ws map");
constexpr int CW_BAR = 4096;

constexpr int RING_OFF = 0, RING_BYTES = 131072;
constexpr int LDSCTL_OFF = RING_BYTES, MISC_OFF = LDSCTL_OFF + 320;
constexpr int LDS_BYTES = 147456;

#define GAS __attribute__((address_space(1)))
#define LAS __attribute__((address_space(3)))
typedef unsigned short bf16;
typedef unsigned v4u __attribute__((ext_vector_type(4)));
typedef unsigned v2u __attribute__((ext_vector_type(2)));
typedef float f32x4 __attribute__((ext_vector_type(4)));
typedef GAS unsigned gu32;
typedef __bf16 bf16x2_t __attribute__((ext_vector_type(2)));
__device__ __forceinline__ unsigned f2bf(float f) { return (unsigned)__builtin_bit_cast(unsigned short, (__bf16)f); }
__device__ __forceinline__ unsigned pk2(float lo, float hi) { const bf16x2_t v = {(__bf16)lo, (__bf16)hi}; return __builtin_bit_cast(unsigned, v); }
__device__ __forceinline__ float fast_rcp(float x) { return __builtin_amdgcn_rcpf(x); }
__device__ __forceinline__ float fast_tanh(float x) { return 1.0f - 2.0f * __builtin_amdgcn_rcpf(1.0f + __expf(2.0f * x)); }
__device__ __forceinline__ float bf2f(unsigned short b) { return __uint_as_float(((unsigned)b) << 16); }
__device__ __forceinline__ float bflo(unsigned w) { return __uint_as_float(w << 16); }
__device__ __forceinline__ float bfhi(unsigned w) { return __uint_as_float(w & 0xffff0000u); }
#define DPP_F(v, ctrl) __builtin_bit_cast(float, __builtin_amdgcn_update_dpp(0, __builtin_bit_cast(int, (v)), (ctrl), 0xf, 0xf, false))
__device__ __forceinline__ float rdlane_f(float v, int lane) { return __builtin_bit_cast(float, __builtin_amdgcn_readlane(__builtin_bit_cast(int, v), lane)); }
__device__ __forceinline__ float wave_sum(float v) {
    v += DPP_F(v, 0xB1); v += DPP_F(v, 0x4E); v += DPP_F(v, 0x141); v += DPP_F(v, 0x140);
    return (rdlane_f(v, 0) + rdlane_f(v, 16)) + (rdlane_f(v, 32) + rdlane_f(v, 48));
}
__device__ __forceinline__ float wave_max(float v) {
    v = fmaxf(v, DPP_F(v, 0xB1)); v = fmaxf(v, DPP_F(v, 0x4E)); v = fmaxf(v, DPP_F(v, 0x141)); v = fmaxf(v, DPP_F(v, 0x140));
    return fmaxf(fmaxf(rdlane_f(v, 0), rdlane_f(v, 16)), fmaxf(rdlane_f(v, 32), rdlane_f(v, 48)));
}
#define DPP_U0(v, ctrl) ((unsigned)__builtin_amdgcn_update_dpp(0, (int)(v), (ctrl), 0xf, 0xf, true))
__device__ __forceinline__ unsigned wave_scan_incl(unsigned v, int lane) {
    v += DPP_U0(v, 0x111); v += DPP_U0(v, 0x112); v += DPP_U0(v, 0x114); v += DPP_U0(v, 0x118);
    const unsigned r0 = (unsigned)__builtin_amdgcn_readlane((int)v, 15), r1 = (unsigned)__builtin_amdgcn_readlane((int)v, 31), r2 = (unsigned)__builtin_amdgcn_readlane((int)v, 47);
    const int row = lane >> 4;
    return v + (row >= 1 ? r0 : 0u) + (row >= 2 ? r1 : 0u) + (row >= 3 ? r2 : 0u);
}
__device__ __forceinline__ float sigmoidf_(float x) { return __builtin_amdgcn_rcpf(1.0f + __expf(-x)); }
#define XB_TMO      128
#define XB_XCNT(j)  (256  + 64 * (j))
#define XB_XSUB(j)  (1280 + 64 * (j))
#define XB_XGEN(j)  (2304 + 64 * (j))
#define XB_TOP      3328
#define XB_TOPGEN   3392
#define XCD_BAR_WORDS 3456
#define XB_SPIN_CAP (1u << 18)

__device__ __forceinline__ unsigned xb_ld(unsigned* p)              { return __hip_atomic_load(p, __ATOMIC_RELAXED, __HIP_MEMORY_SCOPE_AGENT); }
__device__ __forceinline__ unsigned xb_add(unsigned* p, unsigned v) { return __hip_atomic_fetch_add(p, v, __ATOMIC_RELAXED, __HIP_MEMORY_SCOPE_AGENT); }
__device__ __forceinline__ unsigned xb_xcc_id() { return (unsigned)__builtin_amdgcn_s_getreg((3 << 11) | 20) & 0xFu; }
#define XB_SPIN(cond, bar) do { unsigned _sp = 0; while (cond) { __builtin_amdgcn_s_sleep(1); \
    if ((++_sp & 255u) == 0u) { if (xb_ld(&(bar)[XB_TMO])) break; if (_sp > XB_SPIN_CAP) { atomicAdd(&(bar)[XB_TMO], 1u); break; } } } } while (0)

struct XcdBarrier {
    unsigned* bar; unsigned x;
    volatile LAS unsigned* st;
};

__device__ __forceinline__ XcdBarrier xcd_barrier_post(unsigned* bar, volatile LAS unsigned* st) {
    XcdBarrier b; b.bar = bar; b.x = xb_xcc_id(); b.st = st;
    if (threadIdx.x == 0) (void)xb_add(&bar[XB_XCNT(b.x)], 1u);
    return b;
}
__device__ __forceinline__ void xcd_barrier_complete(unsigned* bar, unsigned x, unsigned& nloc, unsigned& nx) {
    const unsigned G = gridDim.x * gridDim.y * gridDim.z;
    unsigned sum, cnt, mine, sp = 0u;
    for (;;) {
        sum = 0u; cnt = 0u; mine = 0u;
#pragma unroll
        for (unsigned j = 0; j < 16; ++j) { const unsigned c = xb_ld(&bar[XB_XCNT(j)]); sum += c; cnt += (c > 0u) ? 1u : 0u; mine = (j == x) ? c : mine; }
        if (sum == G) break;
        __builtin_amdgcn_s_sleep(1);
        if ((++sp & 255u) == 0u) { if (xb_ld(&bar[XB_TMO])) break; if (sp > XB_SPIN_CAP) { atomicAdd(&bar[XB_TMO], 1u); break; } }
    }
    nloc = mine > 0u ? mine : 1u; nx = cnt > 0u ? cnt : 1u;
}

__device__ __forceinline__ void xcd_barrier(const XcdBarrier& b) {
    asm volatile("s_waitcnt vmcnt(0)" ::: "memory");
    __syncthreads();
    if (threadIdx.x == 0) {
        unsigned* bar = b.bar;
        __builtin_amdgcn_s_waitcnt(0);
        unsigned nloc = b.st[0], nx = b.st[1];
        if (nloc == 0u) { xcd_barrier_complete(bar, b.x, nloc, nx); b.st[0] = nloc; b.st[1] = nx; }
        const unsigned old = xb_add(&bar[XB_XSUB(b.x)], 1u);
        const unsigned gen = old / nloc;
        if (old + 1u == (gen + 1u) * nloc) {
            __builtin_amdgcn_fence(__ATOMIC_RELEASE, "agent");
            asm volatile("s_waitcnt vmcnt(0)" ::: "memory");
            const unsigned og = xb_add(&bar[XB_TOP], 1u);
            const unsigned tg = og / nx;
            if (og + 1u == (tg + 1u) * nx) xb_add(&bar[XB_TOPGEN], 1u);
            else XB_SPIN(xb_ld(&bar[XB_TOPGEN]) == tg, bar);
            __builtin_amdgcn_fence(__ATOMIC_ACQUIRE, "agent");
            xb_add(&bar[XB_XGEN(b.x)], 1u);
            asm volatile("s_waitcnt vmcnt(0)" ::: "memory");
        } else {
            XB_SPIN(xb_ld(&bar[XB_XGEN(b.x)]) == gen, bar);
            __builtin_amdgcn_fence(__ATOMIC_ACQUIRE, "agent");
            asm volatile("s_waitcnt vmcnt(0)" ::: "memory");
        }
    }
    __syncthreads();
}

struct Frame {
    LAS unsigned char* lds;
    volatile LAS unsigned* MISC;
    gu32* ctl;
    int tid, lane, wave, G;
    const float* in[32];
    float* out;
    unsigned char* ws;
};
#define IN_X 0
#define IN_META 1
#define IN_LNIN_G 2
#define IN_LNIN_B 3
#define IN_W_IN 4
#define IN_QNORM_G 5
#define IN_W_UQ 6
#define IN_KVNORM_G 7
#define IN_W_UKV 8
#define IN_W_IQ 9
#define IN_IDXLN_G 10
#define IN_IDXLN_B 11
#define IN_MU 12
#define IN_W0 13
#define IN_W_DEC 14
#define IN_A0 15
#define IN_W_AAA 16
#define IN_W_GATE 17
#define IN_KK 18
#define IN_KA 19
#define IN_RK 20
#define IN_GN_G 21
#define IN_GN_B 22
#define IN_W_OUT 23
#define IN_LN1_G 24
#define IN_LN1_B 25
#define IN_W_UP 26
#define IN_CONV_W 27
#define IN_CONV_B 28
#define IN_W_DN 29
#define IN_LN2_G 30
#define IN_LN2_B 31

#define WSP(T, off) ((T*)(F.ws + (off)))

__device__ __forceinline__ int key_row(int b, int j) { return j < NMETA ? NREAL + j : b * SEQ + (j - NMETA); }

__device__ __forceinline__ void tr_items(Frame& F, const float* src, int src_ld, int src_r0, bf16* dst, int dst_ld, int dst_c0, int Nn, int K, int cut0, int cut1, int shift) {
    const int total = Nn * (K / 8);
    for (int it = blockIdx.x * NTHR + F.tid; it < total; it += F.G * NTHR) {
        const int n = it % Nn, kc = it / Nn;
        const int col = n < cut0 ? n : (n < cut1 ? -1 : n - shift);
        float v[8];
#pragma unroll
        for (int e = 0; e < 8; ++e) v[e] = col >= 0 ? src[(size_t)(src_r0 + 8 * kc + e) * src_ld + col] : 0.f;
        v4u o; o.x = pk2(v[0], v[1]); o.y = pk2(v[2], v[3]); o.z = pk2(v[4], v[5]); o.w = pk2(v[6], v[7]);
        *(v4u*)(dst + (size_t)n * dst_ld + dst_c0 + 8 * kc) = o;
    }
}
__device__ __forceinline__ void p0_weights(Frame& F) {
    bf16* WT_IN = WSP(bf16, WS_WT_IN); bf16* WT_QA = WSP(bf16, WS_WT_QA); bf16* WT_MIX = WSP(bf16, WS_WT_MIX); bf16* WT_UP = WSP(bf16, WS_WT_UP); bf16* WT_DN = WSP(bf16, WS_WT_DN);
    tr_items(F, F.in[IN_W_IN], 2248, 0, WT_IN, D, 0, PW, D, 456, 512, 56);
    {
        const float* src = F.in[IN_W_UP];
        for (int it = blockIdx.x * NTHR + F.tid; it < UPW * (D / 8); it += F.G * NTHR) {
            const int n = it % UPW, kc = it / UPW, pn = n >> 8, x = n & 255;
            const int col = x < 128 ? 128 * pn + x : DFF + 128 * pn + (x - 128);
            float v[8];
#pragma unroll
            for (int e = 0; e < 8; ++e) v[e] = src[(size_t)(8 * kc + e) * UPW + col];
            *(v4u*)(WT_UP + (size_t)n * D + 8 * kc) = (v4u){pk2(v[0], v[1]), pk2(v[2], v[3]), pk2(v[4], v[5]), pk2(v[6], v[7])};
        }
    }
    tr_items(F, F.in[IN_W_DN], D, 0, WT_DN, DFF, 0, D, DFF, D, D, 0);
    tr_items(F, F.in[IN_W_IQ], 512, 0, WT_QA + (size_t)1024 * 256, 256, 0, 512, 256, 512, 512, 0);
    tr_items(F, F.in[IN_W_OUT], D, 512, WT_MIX, 1536, 1024, D, 512, D, D, 0);
    {
        bf16* WdT = WSP(bf16, WS_WT_LORA);
        tr_items(F, F.in[IN_W_DEC], 512, 0, WdT, 64, 0, 512, 64, 512, 512, 0);
        tr_items(F, F.in[IN_W_AAA], 512, 0, WdT + 512 * 64, 64, 0, 512, 64, 512, 512, 0);
        tr_items(F, F.in[IN_W_GATE], 512, 0, WdT + 2 * 512 * 64, 128, 0, 512, 128, 512, 512, 0);
    }
    const float* w_uq = F.in[IN_W_UQ]; const float* w_ukv = F.in[IN_W_UKV]; const float* w_out = F.in[IN_W_OUT];
    for (int it = blockIdx.x * NTHR + F.tid; it < 256 * 8 * 8; it += F.G * NTHR) {
        const int c = it & 255, hb = __builtin_amdgcn_readfirstlane(it >> 8), h = hb >> 3, j0 = (hb & 7) * 16;
        float acc[16];
#pragma unroll
        for (int jj = 0; jj < 16; ++jj) acc[jj] = 0.f;
        for (int d = 0; d < 64; ++d) {
            const float a = w_uq[(size_t)c * 512 + h * 64 + d];
#pragma unroll
            for (int jj = 0; jj < 16; ++jj) acc[jj] += a * w_ukv[(size_t)(j0 + jj) * 1024 + h * 128 + d];
        }
#pragma unroll
        for (int jj = 0; jj < 16; ++jj) WT_QA[(size_t)(h * 128 + j0 + jj) * 256 + c] = (bf16)f2bf(0.125f * acc[jj]);
    }
    for (int it = blockIdx.x * NTHR + F.tid; it < 1024 * 8 * 8; it += F.G * NTHR) {
        const int n = it & 1023, hb = __builtin_amdgcn_readfirstlane(it >> 10), h = hb >> 3, j0 = (hb & 7) * 16;
        float acc[16];
#pragma unroll
        for (int jj = 0; jj < 16; ++jj) acc[jj] = 0.f;
        for (int d = 0; d < 64; ++d) {
            const float a = w_out[(size_t)(h * 64 + d) * D + n];
#pragma unroll
            for (int jj = 0; jj < 16; ++jj) acc[jj] += a * w_ukv[(size_t)(j0 + jj) * 1024 + h * 128 + 64 + d];
        }
        v4u o0, o1;
        o0.x = pk2(acc[0], acc[1]); o0.y = pk2(acc[2], acc[3]); o0.z = pk2(acc[4], acc[5]); o0.w = pk2(acc[6], acc[7]);
        o1.x = pk2(acc[8], acc[9]); o1.y = pk2(acc[10], acc[11]); o1.z = pk2(acc[12], acc[13]); o1.w = pk2(acc[14], acc[15]);
        *(v4u*)(WT_MIX + (size_t)n * 1536 + h * 128 + j0) = o0; *(v4u*)(WT_MIX + (size_t)n * 1536 + h * 128 + j0 + 8) = o1;
    }
}

__device__ __forceinline__ void ln_row_bf16(Frame& F, const float* src, const float* g, const float* b, bf16* dst) {
    v2u* o8 = (v2u*)dst + F.lane;
    if (!src) {
#pragma unroll
        for (int j = 0; j < 4; ++j) o8[64 * j] = (v2u){0u, 0u};
        return;
    }
    const f32x4* xr = (const f32x4*)src + F.lane;
    f32x4 v[4]; float s = 0.f;
#pragma unroll
    for (int j = 0; j < 4; ++j) { v[j] = xr[64 * j]; s += (v[j].x + v[j].y) + (v[j].z + v[j].w); }
    const float mean = wave_sum(s) * (1.f / D); float s2 = 0.f;
#pragma unroll
    for (int j = 0; j < 4; ++j) { v[j] = v[j] - mean; s2 += (v[j].x * v[j].x + v[j].y * v[j].y) + (v[j].z * v[j].z + v[j].w * v[j].w); }
    const float rstd = 1.f / sqrtf(wave_sum(s2) * (1.f / D) + LN_EPS);
#pragma unroll
    for (int j = 0; j < 4; ++j) {
        const f32x4 gg = ((const f32x4*)g)[F.lane + 64 * j], bb = ((const f32x4*)b)[F.lane + 64 * j];
        const f32x4 y = v[j] * rstd * gg + bb;
        o8[64 * j] = (v2u){pk2(y.x, y.y), pk2(y.z, y.w)};
    }
}
__device__ __forceinline__ void p1_ln_in(Frame& F) {
    bf16* H0 = WSP(bf16, WS_H);
    const int gw = blockIdx.x * NWAVES + F.wave, NGW = F.G * NWAVES;
    for (int r = gw; r < R; r += NGW) {
        const float* src = r < NREAL ? F.in[IN_X] + (size_t)r * D : (r < NROWS ? F.in[IN_META] + (size_t)(r - NREAL) * D : nullptr);
        ln_row_bf16(F, src, F.in[IN_LNIN_G], F.in[IN_LNIN_B], H0 + (size_t)r * D);
    }
}

__device__ __forceinline__ void p3_prep(Frame& F) {
    const bf16* P = WSP(bf16, WS_P); bf16* CQN = WSP(bf16, WS_CQN); bf16* CKV = WSP(bf16, WS_CKV); bf16* KIDX = WSP(bf16, WS_KIDX); float* WIDX = WSP(float, WS_WIDX);
    const int gw = blockIdx.x * NWAVES + F.wave, NGW = F.G * NWAVES, l = F.lane;
    for (int r = gw; r < R; r += NGW) {
        const bf16* pr = P + (size_t)r * PW;
        if (r >= NROWS) {
            *(v2u*)(CQN + (size_t)r * 256 + 4 * l) = (v2u){0u, 0u};
            continue;
        }
        {
            const v2u w = *(const v2u*)(pr + PC_CQ + 4 * l);
            const float a0 = bflo(w.x), a1 = bfhi(w.x), a2 = bflo(w.y), a3 = bfhi(w.y);
            const float ss = wave_sum(a0 * a0 + a1 * a1 + a2 * a2 + a3 * a3);
            const float rs = 1.0f / sqrtf(ss * (1.f / 256.f) + 1e-6f);
            const f32x4 g = ((const f32x4*)F.in[IN_QNORM_G])[l];
            *(v2u*)(CQN + (size_t)r * 256 + 4 * l) = (v2u){pk2(a0 * rs * g.x, a1 * rs * g.y), pk2(a2 * rs * g.z, a3 * rs * g.w)};
        }
        {
            const unsigned w = *(const unsigned*)(pr + PC_CKV + 2 * l);
            const float a0 = bflo(w), a1 = bfhi(w);
            const float ss = wave_sum(a0 * a0 + a1 * a1);
            const float rs = 1.0f / sqrtf(ss * (1.f / 128.f) + 1e-6f);
            const float g0 = F.in[IN_KVNORM_G][2 * l], g1 = F.in[IN_KVNORM_G][2 * l + 1];
            *(unsigned*)(CKV + (size_t)r * 128 + 2 * l) = pk2(a0 * rs * g0, a1 * rs * g1);
        }
        {
            const float a = bf2f(pr[PC_KIDX + l]);
            const float mean = wave_sum(a) * (1.f / 64.f);
            const float dlt = a - mean;
            const float var = wave_sum(dlt * dlt) * (1.f / 64.f);
            const float y = dlt * (1.0f / sqrtf(var + LN_EPS)) * F.in[IN_IDXLN_G][l] + F.in[IN_IDXLN_B][l];
            KIDX[(size_t)r * 64 + l] = (bf16)f2bf(y);
        }
        if (l < 8) WIDX[(size_t)r * 8 + l] = bf2f(pr[PC_WIDX + l]) * 0.04419417382415922f;
    }
}

#ifndef REFSEL
#define REFSEL 0
#endif
__device__ __forceinline__ void refsel_rows(Frame& F) {
    float* QIDX32 = F.out; float* KIDX32 = F.out + (size_t)R * 512; float* WIDX = WSP(float, WS_WIDX);
    const float* w_in = F.in[IN_W_IN]; const float* w_iq = F.in[IN_W_IQ];
    LAS float* hrow = (LAS float*)(F.lds + F.wave * 8192);
    LAS float* cqn = hrow + 1024;
    const int l = F.lane;
    const int gw = blockIdx.x * NWAVES + F.wave, NGW = F.G * NWAVES;
    for (int r = gw; r < NROWS; r += NGW) {
        const float* src = r < NREAL ? F.in[IN_X] + (size_t)r * D : F.in[IN_META] + (size_t)(r - NREAL) * D;
        {
            const f32x4* xr = (const f32x4*)src + l;
            f32x4 v[4]; float s = 0.f;
#pragma unroll
            for (int j = 0; j < 4; ++j) { v[j] = xr[64 * j]; s += (v[j].x + v[j].y) + (v[j].z + v[j].w); }
            const float mean = wave_sum(s) * (1.f / D); float s2 = 0.f;
#pragma unroll
            for (int j = 0; j < 4; ++j) { v[j] = v[j] - mean; s2 += (v[j].x * v[j].x + v[j].y * v[j].y) + (v[j].z * v[j].z + v[j].w * v[j].w); }
            const float rstd = 1.f / sqrtf(wave_sum(s2) * (1.f / D) + LN_EPS);
#pragma unroll
            for (int j = 0; j < 4; ++j) {
                const f32x4 gg = ((const f32x4*)F.in[IN_LNIN_G])[l + 64 * j], bb = ((const f32x4*)F.in[IN_LNIN_B])[l + 64 * j];
                *(LAS f32x4*)(hrow + 4 * (l + 64 * j)) = v[j] * rstd * gg + bb;
            }
        }
        __builtin_amdgcn_wave_barrier();
        float a[6];
#pragma unroll
        for (int i = 0; i < 6; ++i) a[i] = 0.f;
        for (int k = 0; k < D; ++k) {
            const float hk = hrow[k]; const float* wr = w_in + (size_t)k * 2248;
#pragma unroll
            for (int i = 0; i < 4; ++i) a[i] += hk * wr[l + 64 * i];
            a[4] += hk * wr[384 + l];
            a[5] += hk * wr[448 + (l & 7)];
        }
        const float ss = wave_sum(a[0] * a[0] + a[1] * a[1] + a[2] * a[2] + a[3] * a[3]);
        const float rs = 1.0f / sqrtf(ss * (1.f / 256.f) + 1e-6f);
#pragma unroll
        for (int i = 0; i < 4; ++i) cqn[l + 64 * i] = a[i] * rs * F.in[IN_QNORM_G][l + 64 * i];
        {
            const float mean = wave_sum(a[4]) * (1.f / 64.f); const float dlt = a[4] - mean;
            const float var = wave_sum(dlt * dlt) * (1.f / 64.f);
            KIDX32[(size_t)r * 64 + l] = dlt * (1.0f / sqrtf(var + LN_EPS)) * F.in[IN_IDXLN_G][l] + F.in[IN_IDXLN_B][l];
        }
        if (l < 8) WIDX[(size_t)r * 8 + l] = a[5] * 0.04419417382415922f;
        __builtin_amdgcn_wave_barrier();
        float q[8];
#pragma unroll
        for (int i = 0; i < 8; ++i) q[i] = 0.f;
        for (int c = 0; c < 256; ++c) {
            const float cq = cqn[c]; const float* wr = w_iq + (size_t)c * 512;
#pragma unroll
            for (int i = 0; i < 8; ++i) q[i] += cq * wr[l + 64 * i];
        }
#pragma unroll
        for (int i = 0; i < 8; ++i) QIDX32[(size_t)r * 512 + l + 64 * i] = q[i];
        __builtin_amdgcn_wave_barrier();
    }
}

__device__ __forceinline__ unsigned sortable(float f) { const unsigned u = __float_as_uint(f); return (u & 0x80000000u) ? ~u : (u | 0x80000000u); }
__device__ __forceinline__ void p5_index_naive(Frame& F) {
    const bf16* QA = WSP(bf16, WS_QA); const bf16* KIDX = WSP(bf16, WS_KIDX); const float* WIDX = WSP(float, WS_WIDX);
    unsigned short* SEL = WSP(unsigned short, WS_SEL); int* NSEL = WSP(int, WS_NSEL);
    LAS float* sc = (LAS float*)(F.lds);
    LAS float* qf = (LAS float*)(F.lds + 33024);
    LAS unsigned* hist = (LAS unsigned*)(F.lds + 33024 + 2048);
    LAS unsigned* cw = hist + 256;
    const int tid = F.tid;
    for (int q = blockIdx.x; q < NROWS; q += F.G) {
        int b, pos; if (q < NREAL) { b = q >> 13; pos = NMETA + (q & (SEQ - 1)); } else { b = 0; pos = q - NREAL; }
        const int nvis = pos < NMETA ? NMETA : NMETA + 64 * ((pos - NMETA) / 64 + 1);
#if REFSEL
        qf[tid] = F.out[(size_t)q * 512 + tid];
#else
        qf[tid] = bf2f(QA[(size_t)q * QAW + 1024 + tid]);
#endif
        float w[8];
#pragma unroll
        for (int h = 0; h < 8; ++h) w[h] = WIDX[(size_t)q * 8 + h];
        __syncthreads();
        for (int j = tid; j < nvis; j += NTHR) {
            const v4u* kp = (const v4u*)(KIDX + (size_t)key_row(b, j) * 64);
#if REFSEL
            const f32x4* kp32 = (const f32x4*)(F.out + (size_t)R * 512 + (size_t)key_row(b, j) * 64);
#endif
            float d[8];
#pragma unroll
            for (int h = 0; h < 8; ++h) d[h] = 0.f;
#pragma unroll 2
            for (int c = 0; c < 8; ++c) {
#if REFSEL
                const f32x4 ta = kp32[2 * c], tb = kp32[2 * c + 1];
                const float k0 = ta.x, k1 = ta.y, k2 = ta.z, k3 = ta.w, k4 = tb.x, k5 = tb.y, k6 = tb.z, k7 = tb.w;
#else
                const v4u t = kp[c];
                const float k0 = bflo(t.x), k1 = bfhi(t.x), k2 = bflo(t.y), k3 = bfhi(t.y), k4 = bflo(t.z), k5 = bfhi(t.z), k6 = bflo(t.w), k7 = bfhi(t.w);
#endif
#pragma unroll
                for (int h = 0; h < 8; ++h) {
                    const f32x4 qa = *(const LAS f32x4*)(qf + h * 64 + 8 * c), qb = *(const LAS f32x4*)(qf + h * 64 + 8 * c + 4);
                    d[h] += qa.x * k0 + qa.y * k1 + qa.z * k2 + qa.w * k3 + qb.x * k4 + qb.y * k5 + qb.z * k6 + qb.w * k7;
                }
            }
            float s = 0.f;
#pragma unroll
            for (int h = 0; h < 8; ++h) s += w[h] * fmaxf(d[h], 0.f);
            sc[j] = s + 0.0f;
        }
        __syncthreads();
        unsigned short* selq = SEL + (size_t)q * TOPK;
        if (nvis <= TOPK) {
            for (int j = tid; j < nvis; j += NTHR) selq[j] = (unsigned short)j;
        } else {
            unsigned prefix = 0u, mask = 0u, need = TOPK;
            for (int pass = 0; pass < 4; ++pass) {
                const int shift = 24 - 8 * pass;
                if (tid < 256) hist[tid] = 0u;
                __syncthreads();
                for (int j = tid; j < nvis; j += NTHR) { const unsigned key = sortable(sc[j]); if ((key & mask) == prefix) atomicAdd((unsigned*)&hist[(key >> shift) & 255u], 1u); }
                __syncthreads();
                if (tid < 256) {
                    unsigned above = 0u; for (int bb = tid + 1; bb < 256; ++bb) above += hist[bb];
                    const unsigned c = hist[tid];
                    if (above < need && need <= above + c) { cw[0] = prefix | ((unsigned)tid << shift); cw[1] = need - above; }
                }
                __syncthreads();
                prefix = cw[0]; need = cw[1]; mask |= 0xFFu << shift;
                __syncthreads();
            }
            if (tid == 0) cw[2] = 0u;
            __syncthreads();
            for (int j = tid; j < nvis; j += NTHR) { if (sortable(sc[j]) > prefix) { const unsigned p = atomicAdd((unsigned*)&cw[2], 1u); selq[p] = (unsigned short)j; } }
            __syncthreads();
            if (F.wave == 0) {
                const unsigned base = cw[2]; unsigned taken = 0u;
                for (int j0 = 0; j0 < nvis && taken < need; j0 += 64) {
                    const int j = j0 + F.lane; const bool eq = j < nvis && sortable(sc[j]) == prefix;
                    const unsigned long long m = __ballot(eq);
                    const unsigned rank = (unsigned)__popcll(m & ((1ull << F.lane) - 1ull));
                    if (eq && taken + rank < need) selq[base + taken + rank] = (unsigned short)j;
                    taken += (unsigned)__popcll(m);
                }
            }
        }
        if (tid == 0) NSEL[q] = nvis < TOPK ? nvis : TOPK;
        __syncthreads();
    }
}

__device__ __forceinline__ void p6_attn_naive(Frame& F) {
    bf16* QA = WSP(bf16, WS_QA); const bf16* CKV = WSP(bf16, WS_CKV); const unsigned short* SEL = WSP(unsigned short, WS_SEL); const int* NSEL = WSP(int, WS_NSEL);
    LAS float* qf = (LAS float*)(F.lds + F.wave * 16384);
    LAS float* ps = qf + 1024;
    LAS int* srow = (LAS int*)(ps + 2048);
    const int l = F.lane;
    const int gw = blockIdx.x * NWAVES + F.wave, NGW = F.G * NWAVES;
    for (int q = gw; q < R; q += NGW) {
        bf16* qrow = QA + (size_t)q * QAW;
        if (q >= NROWS) {
            for (int c = l; c < QAW / 8; c += 64) *(v4u*)(qrow + 8 * c) = (v4u){0u, 0u, 0u, 0u};
            continue;
        }
        int b, pos; if (q < NREAL) { b = q >> 13; pos = NMETA + (q & (SEQ - 1)); } else { b = 0; pos = q - NREAL; }
        const int nsel = NSEL[q];
        {
            const v4u t0 = *(const v4u*)(qrow + 16 * l), t1 = *(const v4u*)(qrow + 16 * l + 8);
            LAS float* d = qf + 16 * l;
            d[0] = bflo(t0.x); d[1] = bfhi(t0.x); d[2] = bflo(t0.y); d[3] = bfhi(t0.y); d[4] = bflo(t0.z); d[5] = bfhi(t0.z); d[6] = bflo(t0.w); d[7] = bfhi(t0.w);
            d[8] = bflo(t1.x); d[9] = bfhi(t1.x); d[10] = bflo(t1.y); d[11] = bfhi(t1.y); d[12] = bflo(t1.z); d[13] = bfhi(t1.z); d[14] = bflo(t1.w); d[15] = bfhi(t1.w);
        }
        __builtin_amdgcn_wave_barrier();
        for (int kk = 0; kk < 4; ++kk) {
            const int s = kk * 64 + l; const bool valid = s < nsel;
            const int j = valid ? (int)SEL[(size_t)q * TOPK + s] : 0;
            const int row = key_row(b, j);
            srow[s] = row;
            float acc[8];
#pragma unroll
            for (int h = 0; h < 8; ++h) acc[h] = 0.f;
            const v4u* kp = (const v4u*)(CKV + (size_t)row * 128);
            for (int c8 = 0; c8 < 16; ++c8) {
                const v4u t = kp[c8];
                const float k0 = bflo(t.x), k1 = bfhi(t.x), k2 = bflo(t.y), k3 = bfhi(t.y), k4 = bflo(t.z), k5 = bfhi(t.z), k6 = bflo(t.w), k7 = bfhi(t.w);
#pragma unroll
                for (int h = 0; h < 8; ++h) {
                    const f32x4 qa = *(const LAS f32x4*)(qf + h * 128 + 8 * c8), qb = *(const LAS f32x4*)(qf + h * 128 + 8 * c8 + 4);
                    acc[h] += qa.x * k0 + qa.y * k1 + qa.z * k2 + qa.w * k3 + qb.x * k4 + qb.y * k5 + qb.z * k6 + qb.w * k7;
                }
            }
            const float dist = fabsf((float)(pos - j));
#pragma unroll
            for (int h = 0; h < 8; ++h) { const float slope = __uint_as_float((unsigned)(127 - (h + 1)) << 23); ps[s * 8 + h] = valid ? acc[h] - slope * dist : -INFINITY; }
        }
        __builtin_amdgcn_wave_barrier();
#pragma unroll
        for (int h = 0; h < 8; ++h) {
            float v0 = ps[(l) * 8 + h], v1 = ps[(l + 64) * 8 + h], v2 = ps[(l + 128) * 8 + h], v3 = ps[(l + 192) * 8 + h];
            const float mx = wave_max(fmaxf(fmaxf(v0, v1), fmaxf(v2, v3)));
            v0 = __expf(v0 - mx); v1 = __expf(v1 - mx); v2 = __expf(v2 - mx); v3 = __expf(v3 - mx);
            const float inv = 1.0f / wave_sum((v0 + v1) + (v2 + v3));
            ps[(l) * 8 + h] = v0 * inv; ps[(l + 64) * 8 + h] = v1 * inv; ps[(l + 128) * 8 + h] = v2 * inv; ps[(l + 192) * 8 + h] = v3 * inv;
        }
        __builtin_amdgcn_wave_barrier();
        float o0[8], o1[8];
#pragma unroll
        for (int h = 0; h < 8; ++h) { o0[h] = 0.f; o1[h] = 0.f; }
        for (int s = 0; s < nsel; ++s) {
            const int row = srow[s];
            const unsigned w = *(const unsigned*)(CKV + (size_t)row * 128 + 2 * l);
            const float c0 = bflo(w), c1 = bfhi(w);
            const f32x4 pa = *(const LAS f32x4*)(ps + s * 8), pb = *(const LAS f32x4*)(ps + s * 8 + 4);
            o0[0] += pa.x * c0; o1[0] += pa.x * c1; o0[1] += pa.y * c0; o1[1] += pa.y * c1; o0[2] += pa.z * c0; o1[2] += pa.z * c1; o0[3] += pa.w * c0; o1[3] += pa.w * c1;
            o0[4] += pb.x * c0; o1[4] += pb.x * c1; o0[5] += pb.y * c0; o1[5] += pb.y * c1; o0[6] += pb.z * c0; o1[6] += pb.z * c1; o0[7] += pb.w * c0; o1[7] += pb.w * c1;
        }
#pragma unroll
        for (int h = 0; h < 8; ++h) *(unsigned*)(qrow + h * 128 + 2 * l) = pk2(o0[h], o1[h]);
        __builtin_amdgcn_wave_barrier();
    }
}

__device__ __forceinline__ void p7_rwkv_prep_naive(Frame& F) {
    const bf16* P = WSP(bf16, WS_P); float* DEC = WSP(float, WS_DEC); bf16* AB = WSP(bf16, WS_AB); bf16* GB = WSP(bf16, WS_GB);
    const float* mu = F.in[IN_MU]; const float* Wd = F.in[IN_W_DEC]; const float* Wa = F.in[IN_W_AAA]; const float* Wg = F.in[IN_W_GATE];
    const int l = F.lane;
    const int gw = blockIdx.x * NWAVES + F.wave, NGW = F.G * NWAVES;
    for (int r = gw; r < NROWS; r += NGW) {
        int prev; if (r < NREAL) { prev = (r & (SEQ - 1)) ? r - 1 : NREAL + NMETA - 1; } else { prev = r > NREAL ? r - 1 : -1; }
        const bf16* pr = P + (size_t)r * PW; const bf16* pp = prev >= 0 ? P + (size_t)prev * PW : nullptr;
#define SHIFTED(pc, mc) (bf2f(pr[pc]) + ((pp ? bf2f(pp[pc]) : 0.f) - bf2f(pr[pc])) * mu[mc])
        const float tw = tanhf(SHIFTED(PC_WD + l, 1536 + l));
        const float ta = SHIFTED(PC_AD + l, 1600 + l);
        const float tg0 = sigmoidf_(SHIFTED(PC_GD + l, 1664 + l)), tg1 = sigmoidf_(SHIFTED(PC_GD + 64 + l, 1728 + l));
#undef SHIFTED
        float aw[8], aa[8], ag[8];
#pragma unroll
        for (int i = 0; i < 8; ++i) { aw[i] = F.in[IN_W0][l + 64 * i]; aa[i] = F.in[IN_A0][l + 64 * i]; ag[i] = 0.f; }
        for (int j = 0; j < 64; ++j) {
            const float xw = __shfl(tw, j), xa = __shfl(ta, j), xg0 = __shfl(tg0, j), xg1 = __shfl(tg1, j);
#pragma unroll
            for (int i = 0; i < 8; ++i) {
                aw[i] += xw * Wd[(size_t)j * 512 + l + 64 * i];
                aa[i] += xa * Wa[(size_t)j * 512 + l + 64 * i];
                ag[i] += xg0 * Wg[(size_t)j * 512 + l + 64 * i] + xg1 * Wg[(size_t)(j + 64) * 512 + l + 64 * i];
            }
        }
#pragma unroll
        for (int i = 0; i < 8; ++i) {
            const float x = -aw[i];
            const float sp = x > 20.f ? x : log1pf(__expf(x));
            const float wlog = -sp - 0.5f;
            DEC[(size_t)r * 512 + l + 64 * i] = __expf(-__expf(wlog));
            AB[(size_t)r * 512 + l + 64 * i] = (bf16)f2bf(sigmoidf_(aa[i]));
            GB[(size_t)r * 512 + l + 64 * i] = (bf16)f2bf(ag[i]);
        }
    }
}

__device__ __forceinline__ void p8_rwkv_scan_naive(Frame& F) {
    if (F.wave != 0 || blockIdx.x >= 32) return;
    const bf16* P = WSP(bf16, WS_P); const float* DEC = WSP(float, WS_DEC); const bf16* AB = WSP(bf16, WS_AB); const bf16* GB = WSP(bf16, WS_GB); bf16* QA = WSP(bf16, WS_QA);
    const int b = blockIdx.x >> 3, h = blockIdx.x & 7, l = F.lane, ch = h * 64 + l;
    LAS float* vec = (LAS float*)F.lds;
    const float mu_r = F.in[IN_MU][ch], mu_k = F.in[IN_MU][512 + ch], mu_v = F.in[IN_MU][1024 + ch];
    const float kk_c = F.in[IN_KK][ch], ka_c = F.in[IN_KA][ch], rk_c = F.in[IN_RK][ch], gng = F.in[IN_GN_G][ch], gnb = F.in[IN_GN_B][ch];
    float S[64];
#pragma unroll
    for (int k = 0; k < 64; ++k) S[k] = 0.f;
    float pr_p = 0.f, pk_p = 0.f, pv_p = 0.f;
    int row = key_row(b, 0);
    float n_pr = bf2f(P[(size_t)row * PW + PC_R + ch]), n_pk = bf2f(P[(size_t)row * PW + PC_K + ch]), n_pv = bf2f(P[(size_t)row * PW + PC_V + ch]);
    float n_w = DEC[(size_t)row * 512 + ch], n_a = bf2f(AB[(size_t)row * 512 + ch]), n_g = bf2f(GB[(size_t)row * 512 + ch]);
    for (int pos = 0; pos < TT; ++pos) {
        const int crow = row;
        const float c_pr = n_pr, c_pk = n_pk, c_pv = n_pv, c_w = n_w, c_a = n_a, c_g = n_g;
        if (pos + 1 < TT) {
            row = key_row(b, pos + 1);
            n_pr = bf2f(P[(size_t)row * PW + PC_R + ch]); n_pk = bf2f(P[(size_t)row * PW + PC_K + ch]); n_pv = bf2f(P[(size_t)row * PW + PC_V + ch]);
            n_w = DEC[(size_t)row * 512 + ch]; n_a = bf2f(AB[(size_t)row * 512 + ch]); n_g = bf2f(GB[(size_t)row * 512 + ch]);
        }
        const float r_s = c_pr + (pr_p - c_pr) * mu_r, k_s = c_pk + (pk_p - c_pk) * mu_k, v_s = c_pv + (pv_p - c_pv) * mu_v;
        pr_p = c_pr; pk_p = c_pk; pv_p = c_pv;
        const float kkr = k_s * kk_c;
        const float nrm = sqrtf(wave_sum(kkr * kkr));
        const float kk = kkr / fmaxf(nrm, 1e-12f);
        const float k2 = k_s * (1.f + (c_a - 1.f) * ka_c);
        vec[l] = -kk; vec[64 + l] = kk * c_a; vec[128 + l] = c_w; vec[192 + l] = k2; vec[256 + l] = r_s;
        __builtin_amdgcn_wave_barrier();
        float sa = 0.f;
#pragma unroll
        for (int k4 = 0; k4 < 16; ++k4) { const f32x4 a = *(const LAS f32x4*)(vec + 4 * k4); sa += S[4 * k4] * a.x + S[4 * k4 + 1] * a.y + S[4 * k4 + 2] * a.z + S[4 * k4 + 3] * a.w; }
        float y = 0.f;
#pragma unroll
        for (int k4 = 0; k4 < 16; ++k4) {
            const f32x4 bv = *(const LAS f32x4*)(vec + 64 + 4 * k4), w = *(const LAS f32x4*)(vec + 128 + 4 * k4), kv = *(const LAS f32x4*)(vec + 192 + 4 * k4), rv = *(const LAS f32x4*)(vec + 256 + 4 * k4);
            S[4 * k4] = S[4 * k4] * w.x + sa * bv.x + v_s * kv.x; S[4 * k4 + 1] = S[4 * k4 + 1] * w.y + sa * bv.y + v_s * kv.y;
            S[4 * k4 + 2] = S[4 * k4 + 2] * w.z + sa * bv.z + v_s * kv.z; S[4 * k4 + 3] = S[4 * k4 + 3] * w.w + sa * bv.w + v_s * kv.w;
            y += S[4 * k4] * rv.x + S[4 * k4 + 1] * rv.y + S[4 * k4 + 2] * rv.z + S[4 * k4 + 3] * rv.w;
        }
        __builtin_amdgcn_wave_barrier();
        const float mean = wave_sum(y) * (1.f / 64.f);
        const float dlt = y - mean;
        const float var = wave_sum(dlt * dlt) * (1.f / 64.f);
        const float yn = dlt * (1.0f / sqrtf(var + GN_EPS)) * gng + gnb;
        const float bonus = wave_sum(r_s * k2 * rk_c) * v_s;
        const float o = (yn + bonus) * c_g;
        if (pos >= NMETA || b == 0) QA[(size_t)crow * QAW + 1024 + ch] = (bf16)f2bf(o);
    }
}

__device__ __forceinline__ void p10_ln1(Frame& F) {
    bf16* H1 = WSP(bf16, WS_H); const float* META1 = WSP(float, WS_META1);
    const int gw = blockIdx.x * NWAVES + F.wave, NGW = F.G * NWAVES;
    for (int r = gw; r < NROWS; r += NGW) {
        const float* src = r < NREAL ? F.out + (size_t)r * D : META1 + (size_t)(r - NREAL) * D;
        ln_row_bf16(F, src, F.in[IN_LN1_G], F.in[IN_LN1_B], H1 + (size_t)r * D);
    }
}
__device__ __forceinline__ void p14_ln2(Frame& F) {
    const int gw = blockIdx.x * NWAVES + F.wave, NGW = F.G * NWAVES;
    const float* g = F.in[IN_LN2_G]; const float* b = F.in[IN_LN2_B];
    for (int r = gw; r < NREAL; r += NGW) {
        f32x4* xr = (f32x4*)(F.out + (size_t)r * D) + F.lane;
        f32x4 v[4]; float s = 0.f;
#pragma unroll
        for (int j = 0; j < 4; ++j) { v[j] = xr[64 * j]; s += (v[j].x + v[j].y) + (v[j].z + v[j].w); }
        const float mean = wave_sum(s) * (1.f / D); float s2 = 0.f;
#pragma unroll
        for (int j = 0; j < 4; ++j) { v[j] = v[j] - mean; s2 += (v[j].x * v[j].x + v[j].y * v[j].y) + (v[j].z * v[j].z + v[j].w * v[j].w); }
        const float rstd = 1.f / sqrtf(wave_sum(s2) * (1.f / D) + LN_EPS);
#pragma unroll
        for (int j = 0; j < 4; ++j) { const f32x4 gg = ((const f32x4*)g)[F.lane + 64 * j], bb = ((const f32x4*)b)[F.lane + 64 * j]; xr[64 * j] = v[j] * rstd * gg + bb; }
    }
}

__device__ __forceinline__ float gelu_fast(float x) {
    const float u2 = x * (1.5957691216057308f + 0.07135481627260025f * x * x);
    return x * __builtin_amdgcn_rcpf(1.0f + __builtin_amdgcn_exp2f(-1.4426950408889634f * u2));
}
__device__ __forceinline__ void p12_conv_fix(Frame& F) {
    bf16* ACT = WSP(bf16, WS_UP); const float* cw = F.in[IN_CONV_W]; const float* cb = F.in[IN_CONV_B];
    const float* G01 = WSP(float, WS_G01); const float* V01 = WSP(float, WS_V01); const float* GHALO = WSP(float, WS_GHALO); const float* GMETA = WSP(float, WS_GMETA);
    for (int it = blockIdx.x * NTHR + F.tid; it < 128 * 2 * DFF; it += F.G * NTHR) {
        const int j = it % DFF, rr = (it / DFF) & 1, pm = it / (2 * DFF);
        const float* ph = (pm & 31) ? GHALO + (size_t)(pm - 1) * 2 * DFF : GMETA;
        const float g0 = G01[((size_t)pm * 2 + rr) * DFF + j];
        const float g1 = rr ? G01[((size_t)pm * 2) * DFF + j] : ph[DFF + j];
        const float g2 = rr ? ph[DFF + j] : ph[j];
        const float x = cw[j] * g2 + cw[DFF + j] * g1 + cw[2 * DFF + j] * g0 + cb[j];
        ACT[(size_t)(pm * 256 + rr) * DFF + j] = (bf16)f2bf(gelu_fast(x) * V01[((size_t)pm * 2 + rr) * DFF + j]);
    }
}


constexpr int NUNITS = 4096 + 8;
constexpr int RP = 72;
constexpr int SLOT = 64 * RP * 2;
constexpr int FP = 68;
typedef short bf16x8 __attribute__((ext_vector_type(8)));
typedef float f32x16 __attribute__((ext_vector_type(16)));
constexpr size_t RW_MAT = (size_t)NUNITS * 4096;

__device__ __forceinline__ void quad_mma(f32x16& acc, const LAS bf16* Aop, const LAS bf16* Bop, int qr, int qc, int lane) {
    const int r = lane & 31, hf = lane >> 5;
    const LAS bf16* ap = Aop + (32 * qr + r) * RP + 8 * hf; const LAS bf16* bp = Bop + (32 * qc + r) * RP + 8 * hf;
#pragma unroll
    for (int ks = 0; ks < 4; ++ks) {
        const bf16x8 a = *(const LAS bf16x8*)(ap + 16 * ks), b = *(const LAS bf16x8*)(bp + 16 * ks);
        acc = __builtin_amdgcn_mfma_f32_32x32x16_bf16(a, b, acc, 0, 0, 0);
    }
}
#define ACC_M(qr, j, hf) (32 * (qr) + ((j) & 3) + 8 * ((j) >> 2) + 4 * (hf))
__device__ __forceinline__ void store_T(const f32x16& acc, LAS bf16* Z, int qr, int qc, int lane) {
    const int r = lane & 31, hf = lane >> 5;
#pragma unroll
    for (int jj = 0; jj < 4; ++jj)
        *(LAS v2u*)(Z + (32 * qc + r) * RP + 32 * qr + 8 * jj + 4 * hf) = (v2u){pk2(acc[4 * jj], acc[4 * jj + 1]), pk2(acc[4 * jj + 2], acc[4 * jj + 3])};
}
__device__ __forceinline__ void add_T(f32x16& acc, const LAS bf16* Z, int qr, int qc, int lane) {
    const int r = lane & 31, hf = lane >> 5;
#pragma unroll
    for (int jj = 0; jj < 4; ++jj) {
        const v2u w = *(const LAS v2u*)(Z + (32 * qc + r) * RP + 32 * qr + 8 * jj + 4 * hf);
        acc[4 * jj] += bflo(w.x); acc[4 * jj + 1] += bfhi(w.x); acc[4 * jj + 2] += bflo(w.y); acc[4 * jj + 3] += bfhi(w.y);
    }
}
__device__ __forceinline__ void store_T_global(const f32x16& acc, bf16* Z, int qr, int qc, int lane) {
    const int r = lane & 31, hf = lane >> 5;
#pragma unroll
    for (int jj = 0; jj < 4; ++jj)
        *(v2u*)(Z + (32 * qc + r) * 64 + 32 * qr + 8 * jj + 4 * hf) = (v2u){pk2(acc[4 * jj], acc[4 * jj + 1]), pk2(acc[4 * jj + 2], acc[4 * jj + 3])};
}
__device__ __forceinline__ f32x16 zero16() { f32x16 z;
#pragma unroll
    for (int j = 0; j < 16; ++j) z[j] = 0.f;
    return z; }

__device__ __forceinline__ void b1_load_raw(const bf16* P, int u, int w, int l, unsigned short (&rv)[45]) {
    const bool meta = u >= 4096;
    int b = 0, h, c = 0; if (meta) h = u - 4096; else { b = u >> 10; h = (u >> 7) & 7; c = u & 127; }
    const int ch = h * 64 + l, row0 = meta ? NREAL : b * SEQ + c * 64, t0 = 8 * w;
    int prow = -1;
    if (t0 > 0) prow = row0 + t0 - 1; else if (!meta) prow = (c == 0) ? NREAL + NMETA - 1 : row0 - 1;
#pragma unroll
    for (int i = 0; i < 9; ++i) {
        const int t = t0 - 1 + i;
        const int row = i == 0 ? prow : ((!meta || t < NMETA) ? row0 + t : -1);
        const bf16* pp = P + (size_t)(row >= 0 ? row : 0) * PW;
        const unsigned short a0 = pp[PC_R + ch], a1 = pp[PC_K + ch], a2 = pp[PC_V + ch], a3 = pp[PC_WD + l], a4 = pp[PC_AD + l];
        const bool ok = row >= 0;
        rv[5 * i] = ok ? a0 : (unsigned short)0; rv[5 * i + 1] = ok ? a1 : (unsigned short)0; rv[5 * i + 2] = ok ? a2 : (unsigned short)0; rv[5 * i + 3] = ok ? a3 : (unsigned short)0; rv[5 * i + 4] = ok ? a4 : (unsigned short)0;
    }
}

#ifdef PROBE_B1SEC
#define B1T(k) do { if (blockIdx.x == 0 && F.tid == 0) { const unsigned long long t_ = __builtin_amdgcn_s_memrealtime(); if ((k) == PROBE_B1SEC + 1) b1acc += t_ - b1t0; b1t0 = t_; } } while (0)
#else
#define B1T(k) do {} while (0)
#endif
__device__ __forceinline__ void rw_b1(Frame& F) {
    const bf16* P = WSP(bf16, WS_P);
    bf16* RWM = WSP(bf16, WS_RWM); bf16* RWN = WSP(bf16, WS_RWN); bf16* RWQ = WSP(bf16, WS_RWQ); bf16* RWY = WSP(bf16, WS_RWY);
    float* BONUS = (float*)((char*)F.out + OUT_BONUS);
    const bf16* WdT = WSP(bf16, WS_WT_LORA); const bf16* WaT = WdT + 512 * 64;
    const float* mu = F.in[IN_MU];
    const int w = F.wave, l = F.lane, tid = F.tid;
    LAS unsigned char* L = F.lds;
#define SL(s) ((LAS bf16*)(L + (s) * SLOT))
    LAS float* WL = (LAS float*)(L + 12 * SLOT);
    LAS float* AL = (LAS float*)(L + 0 * SLOT);
    LAS float* OT = (LAS float*)(L + RING_BYTES + 1024);
    LAS float* GL = OT + 512;
    unsigned long long b1acc = 0ull, b1t0 = 0ull; (void)b1acc; (void)b1t0;
    unsigned short rnx[45];
    b1_load_raw(P, (int)blockIdx.x < NUNITS ? (int)blockIdx.x : 0, w, l, rnx);
    for (int u = blockIdx.x; u < NUNITS; u += F.G) {
        const bool meta = u >= 4096;
        int b = 0, h, c = 0; if (meta) h = u - 4096; else { b = u >> 10; h = (u >> 7) & 7; c = u & 127; }
        const int ch = h * 64 + l;
        const int row0 = meta ? NREAL : b * SEQ + c * 64;
        __syncthreads();
        B1T(0);
        float r_s[8], k_s[8], v_s[8], xw[8], xa[8];
        {
            const int t0 = 8 * w;
            unsigned short rc[45];
#pragma unroll
            for (int i = 0; i < 45; ++i) rc[i] = rnx[i];
            float pr = bf2f(rc[0]), pk = bf2f(rc[1]), pv = bf2f(rc[2]), pw = bf2f(rc[3]), pa = bf2f(rc[4]);
            const float mr = mu[ch], mk = mu[512 + ch], mv = mu[1024 + ch], mw = mu[1536 + l], ma = mu[1600 + l];
#pragma unroll
            for (int i = 0; i < 8; ++i) {
                const int t = t0 + i; const bool valid = !meta || t < NMETA;
                const float cr = bf2f(rc[5 * i + 5]), ck = bf2f(rc[5 * i + 6]), cv = bf2f(rc[5 * i + 7]), cw = bf2f(rc[5 * i + 8]), ca = bf2f(rc[5 * i + 9]);
                r_s[i] = valid ? cr + (pr - cr) * mr : 0.f; k_s[i] = valid ? ck + (pk - ck) * mk : 0.f; v_s[i] = valid ? cv + (pv - cv) * mv : 0.f;
                xw[i] = fast_tanh(cw + (pw - cw) * mw); xa[i] = ca + (pa - ca) * ma;
                pr = cr; pk = ck; pv = cv; pw = cw; pa = ca;
            }
#pragma unroll
            for (int i = 0; i < 8; ++i) { SL(8)[(t0 + i) * RP + l] = (bf16)f2bf(xw[i]); SL(9)[(t0 + i) * RP + l] = (bf16)f2bf(xa[i]); }
            {
                const int k = tid >> 3, pc = tid & 7;
                *(LAS v4u*)(SL(10) + k * RP + 8 * pc) = *(const v4u*)(WdT + (size_t)(h * 64 + k) * 64 + 8 * pc);
                *(LAS v4u*)(SL(11) + k * RP + 8 * pc) = *(const v4u*)(WaT + (size_t)(h * 64 + k) * 64 + 8 * pc);
            }
        }
        __syncthreads();
        B1T(1);
        {
            const int pid = w >> 2, q = w & 3, qr = q >> 1, qc = q & 1;
            f32x16 acc = zero16();
            quad_mma(acc, SL(10 + pid), SL(8 + pid), qr, qc, l);
            LAS float* Zf = pid ? AL : WL;
            const int r = l & 31, hf = l >> 5;
#pragma unroll
            for (int jj = 0; jj < 4; ++jj) *(LAS f32x4*)(Zf + (32 * qc + r) * FP + 32 * qr + 8 * jj + 4 * hf) = (f32x4){acc[4 * jj], acc[4 * jj + 1], acc[4 * jj + 2], acc[4 * jj + 3]};
        }
        __syncthreads();
        B1T(2);
        float lw[8], asg[8];
        {
            const float w0c = F.in[IN_W0][ch], a0c = F.in[IN_A0][ch];
            float run = 0.f;
#pragma unroll
            for (int i = 0; i < 8; ++i) {
                const int t = 8 * w + i; const bool valid = !meta || t < NMETA;
                const float x = -(WL[t * FP + l] + w0c);
                const float sp = x > 20.f ? x : __logf(1.0f + __expf(x));
                const float e = -__expf(-sp - 0.5f);
                run += valid ? e : 0.f; lw[i] = run;
                asg[i] = sigmoidf_(AL[t * FP + l] + a0c);
            }
            OT[w * 64 + l] = run;
        }
        __syncthreads();
        {
            float off = 0.f, tot = 0.f;
#pragma unroll
            for (int ww = 0; ww < 8; ++ww) { const float o = OT[ww * 64 + l]; tot += o; off += ww < w ? o : 0.f; }
            if (w == 0) GL[l] = __expf(tot);
            const float kkc = F.in[IN_KK][ch], kac = F.in[IN_KA][ch], rkc = F.in[IN_RK][ch];
            unsigned atc[4], vc[4], bhc[4], khc[4];
            float prevlg = off;
#pragma unroll
            for (int i = 0; i < 8; ++i) {
                const int t = 8 * w + i;
                const float lg = off + lw[i];
                const float g = __expf(lg), gp = __expf(prevlg), gi = __expf(-lg), gh = __expf(tot - lg);
                prevlg = lg;
                const float kkr = k_s[i] * kkc;
                const float kk = kkr * __builtin_amdgcn_rsqf(fmaxf(wave_sum(kkr * kkr), 1e-24f));
                const float k2 = k_s[i] * (1.f + (asg[i] - 1.f) * kac);
                const float bon = wave_sum(r_s[i] * k2 * rkc);
                if (l == 0) BONUS[(size_t)u * 64 + t] = bon;
                const float at = -kk * gp, rt = r_s[i] * g, bt = kk * asg[i] * gi, kt = k2 * gi, bh = kk * asg[i] * gh, kh = k2 * gh;
                SL(0)[t * RP + l] = (bf16)f2bf(at); SL(1)[t * RP + l] = (bf16)f2bf(rt); SL(2)[t * RP + l] = (bf16)f2bf(bt); SL(3)[t * RP + l] = (bf16)f2bf(kt);
                const unsigned ua = f2bf(at), uv = f2bf(v_s[i]), ub = f2bf(bh), uk = f2bf(kh);
                if (i & 1) { atc[i >> 1] |= ua << 16; vc[i >> 1] |= uv << 16; bhc[i >> 1] |= ub << 16; khc[i >> 1] |= uk << 16; }
                else { atc[i >> 1] = ua; vc[i >> 1] = uv; bhc[i >> 1] = ub; khc[i >> 1] = uk; }
            }
            *(LAS v4u*)(SL(4) + l * RP + 8 * w) = (v4u){atc[0], atc[1], atc[2], atc[3]};
            *(LAS v4u*)(SL(5) + l * RP + 8 * w) = (v4u){vc[0], vc[1], vc[2], vc[3]};
            *(LAS v4u*)(SL(6) + l * RP + 8 * w) = (v4u){bhc[0], bhc[1], bhc[2], bhc[3]};
            *(LAS v4u*)(SL(7) + l * RP + 8 * w) = (v4u){khc[0], khc[1], khc[2], khc[3]};
        }
        __syncthreads();
        B1T(3);
        for (int task = w; task < 20; task += 8) {
            const int pid = task >> 2, q = task & 3, qr = q >> 1, qc = q & 1;
            const int bop = pid == 0 ? 0 : pid == 1 ? 2 : pid == 2 ? 0 : 1;
            const int aop = pid == 0 ? 2 : pid == 1 ? 0 : pid == 2 ? 3 : pid == 3 ? 2 : 3;
            f32x16 acc = zero16();
            quad_mma(acc, SL(aop), SL(bop), qr, qc, l);
            const int n = 32 * qc + (l & 31), hf = l >> 5;
#pragma unroll
            for (int j = 0; j < 16; ++j) {
                const int m = ACC_M(qr, j, hf);
                const bool keep = pid == 1 ? (m > n) : (pid <= 2 ? (n > m) : (n >= m));
                acc[j] = keep ? acc[j] : 0.f;
            }
            store_T(acc, SL(8 + pid), qr, qc, l);
        }
        __syncthreads();
        B1T(4);
        const int nq = w & 3, nqr = nq >> 1, nqc = nq & 1;
        f32x16 nacc = zero16();
        if (w < 4) { add_T(nacc, SL(8), nqr, nqc, l); }
        for (int task = w; task < 12; task += 8) {
            const int pid = task >> 2, q = task & 3, qr = q >> 1, qc = q & 1;
            f32x16 acc = zero16();
            if (pid == 0) { quad_mma(acc, SL(9), SL(8), qr, qc, l); store_T(acc, SL(0), qr, qc, l); }
            else if (pid == 1) { quad_mma(acc, SL(8), SL(9), qr, qc, l); store_T(acc, SL(2), qr, qc, l); }
            else { quad_mma(acc, SL(10), SL(5), qr, qc, l); store_T(acc, SL(3), qr, qc, l); }
        }
        __syncthreads();
#pragma unroll
        for (int st = 0; st < 4; ++st) {
            const int pr = (st & 1) ? 10 : 0, pc = (st & 1) ? 13 : 2, pr2 = (st & 1) ? 0 : 10, pc2 = (st & 1) ? 2 : 13, nr = (st & 1) ? 9 : 8, nr2 = (st & 1) ? 8 : 9;
            if (w < 4) {
                add_T(nacc, SL(pr), nqr, nqc, l);
                quad_mma(nacc, SL(pc), SL(nr), nqr, nqc, l);
                store_T(nacc, SL(nr2), nqr, nqc, l);
                f32x16 acc = zero16();
                quad_mma(acc, SL(pc), SL(pr), nqr, nqc, l); store_T(acc, SL(pr2), nqr, nqc, l);
            } else {
                f32x16 acc = zero16();
                quad_mma(acc, SL(pr), SL(pc), nqr, nqc, l); store_T(acc, SL(pc2), nqr, nqc, l);
            }
            __syncthreads();
        }
        if (w < 4) { add_T(nacc, SL(0), nqr, nqc, l); quad_mma(nacc, SL(2), SL(8), nqr, nqc, l); store_T(nacc, SL(9), nqr, nqc, l); }
        __syncthreads();
        B1T(5);
        b1_load_raw(P, u + F.G < NUNITS ? u + F.G : u, w, l, rnx);
        {
            const int pid = w >> 2;
            f32x16 acc = zero16();
            add_T(acc, SL(pid ? 3 : 4), nqr, nqc, l);
            quad_mma(acc, SL(9), SL(pid ? 3 : 4), nqr, nqc, l);
            store_T(acc, SL(pid ? 2 : 0), nqr, nqc, l);
        }
        __syncthreads();
        for (int task = w; task < 16; task += 8) {
            const int pid = task >> 2, q = task & 3, qr = q >> 1, qc = q & 1;
            f32x16 acc = zero16();
            if (pid == 0) { add_T(acc, SL(1), qr, qc, l); quad_mma(acc, SL(0), SL(11), qr, qc, l); store_T_global(acc, RWQ + (size_t)u * 4096, qr, qc, l); }
            else if (pid == 1) { quad_mma(acc, SL(2), SL(11), qr, qc, l); quad_mma(acc, SL(5), SL(12), qr, qc, l); store_T_global(acc, RWY + (size_t)u * 4096, qr, qc, l); }
            else if (pid == 2) {
                quad_mma(acc, SL(0), SL(6), qr, qc, l);
                const int n = 32 * qc + (l & 31), hf = l >> 5; const float gl = GL[n];
#pragma unroll
                for (int j = 0; j < 16; ++j) acc[j] += (ACC_M(qr, j, hf) == n) ? gl : 0.f;
                store_T_global(acc, RWM + (size_t)u * 4096, qr, qc, l);
            } else { quad_mma(acc, SL(6), SL(2), qr, qc, l); quad_mma(acc, SL(7), SL(5), qr, qc, l); store_T_global(acc, RWN + (size_t)u * 4096, qr, qc, l); }
        }
        B1T(6);
    }
#ifdef PROBE_B1SEC
    if (blockIdx.x == 0 && F.tid == 0) { F.MISC[20] = (unsigned)b1acc; }
#endif
#undef SL
}

__device__ __forceinline__ void rw_b2(Frame& F) {
    if (blockIdx.x >= 32) return;
    const bf16* RWM = WSP(bf16, WS_RWM); const bf16* RWN = WSP(bf16, WS_RWN);
    bf16* RWS = (bf16*)((char*)F.out + OUT_RWS);
    const int b = blockIdx.x >> 3, h = blockIdx.x & 7, w = F.wave, l = F.lane;
    LAS unsigned char* L = F.lds;
#define SS(buf, part) ((LAS bf16*)(L + ((buf) * 2 + (part)) * SLOT))
    const int q = w & 3, qr = q >> 1, qc = q & 1, r = l & 31, hf = l >> 5;
    if (w < 4) {
        const bf16* Nm = RWN + (size_t)(4096 + h) * 4096;
#pragma unroll
        for (int jj = 0; jj < 4; ++jj) {
            const v2u wv = *(const v2u*)(Nm + (32 * qc + r) * 64 + 32 * qr + 8 * jj + 4 * hf);
            *(LAS v2u*)(SS(0, 0) + (32 * qc + r) * RP + 32 * qr + 8 * jj + 4 * hf) = wv;
            *(LAS v2u*)(SS(0, 1) + (32 * qc + r) * RP + 32 * qr + 8 * jj + 4 * hf) = (v2u){0u, 0u};
        }
    }
    __syncthreads();
    bf16x8 a_cur[4]; v2u n_cur[4];
    {
        const size_t u0 = (size_t)(b * 8 + h) * 128;
#pragma unroll
        for (int ks = 0; ks < 4; ++ks) a_cur[ks] = *(const bf16x8*)(RWM + u0 * 4096 + (32 * qr + r) * 64 + 8 * hf + 16 * ks);
#pragma unroll
        for (int jj = 0; jj < 4; ++jj) n_cur[jj] = *(const v2u*)(RWN + u0 * 4096 + (32 * qc + r) * 64 + 32 * qr + 8 * jj + 4 * hf);
    }
    for (int c = 0; c < 128; ++c) {
        const int u = (b * 8 + h) * 128 + c, cur = c & 1;
        if (w < 4) {
            bf16x8 a_nxt[4]; v2u n_nxt[4];
            const size_t un = (size_t)(c + 1 < 128 ? u + 1 : u);
#pragma unroll
            for (int ks = 0; ks < 4; ++ks) a_nxt[ks] = *(const bf16x8*)(RWM + un * 4096 + (32 * qr + r) * 64 + 8 * hf + 16 * ks);
#pragma unroll
            for (int jj = 0; jj < 4; ++jj) n_nxt[jj] = *(const v2u*)(RWN + un * 4096 + (32 * qc + r) * 64 + 32 * qr + 8 * jj + 4 * hf);
            f32x16 acc;
#pragma unroll
            for (int jj = 0; jj < 4; ++jj) { acc[4 * jj] = bflo(n_cur[jj].x); acc[4 * jj + 1] = bfhi(n_cur[jj].x); acc[4 * jj + 2] = bflo(n_cur[jj].y); acc[4 * jj + 3] = bfhi(n_cur[jj].y); }
#pragma unroll
            for (int jj = 0; jj < 4; ++jj)
                *(v2u*)(RWS + (size_t)u * 4096 + (32 * qc + r) * 64 + 32 * qr + 8 * jj + 4 * hf) = *(const LAS v2u*)(SS(cur, 0) + (32 * qc + r) * RP + 32 * qr + 8 * jj + 4 * hf);
            const LAS bf16* bh = SS(cur, 0) + (32 * qc + r) * RP + 8 * hf; const LAS bf16* bl = SS(cur, 1) + (32 * qc + r) * RP + 8 * hf;
#pragma unroll
            for (int ks = 0; ks < 4; ++ks) {
                acc = __builtin_amdgcn_mfma_f32_32x32x16_bf16(a_cur[ks], *(const LAS bf16x8*)(bh + 16 * ks), acc, 0, 0, 0);
                acc = __builtin_amdgcn_mfma_f32_32x32x16_bf16(a_cur[ks], *(const LAS bf16x8*)(bl + 16 * ks), acc, 0, 0, 0);
            }
#pragma unroll
            for (int jj = 0; jj < 4; ++jj) {
                float hi[4], lo[4];
#pragma unroll
                for (int e = 0; e < 4; ++e) { const unsigned hb = f2bf(acc[4 * jj + e]); hi[e] = __uint_as_float(hb << 16); lo[e] = acc[4 * jj + e] - hi[e]; }
                *(LAS v2u*)(SS(cur ^ 1, 0) + (32 * qc + r) * RP + 32 * qr + 8 * jj + 4 * hf) = (v2u){pk2(hi[0], hi[1]), pk2(hi[2], hi[3])};
                *(LAS v2u*)(SS(cur ^ 1, 1) + (32 * qc + r) * RP + 32 * qr + 8 * jj + 4 * hf) = (v2u){pk2(lo[0], lo[1]), pk2(lo[2], lo[3])};
            }
#pragma unroll
            for (int ks = 0; ks < 4; ++ks) a_cur[ks] = a_nxt[ks];
#pragma unroll
            for (int jj = 0; jj < 4; ++jj) n_cur[jj] = n_nxt[jj];
        }
        __syncthreads();
    }
#undef SS
}

__device__ __forceinline__ void rw_b3(Frame& F) {
    const bf16* P = WSP(bf16, WS_P); bf16* QA = WSP(bf16, WS_QA);
    const bf16* RWQ = WSP(bf16, WS_RWQ); const bf16* RWY = WSP(bf16, WS_RWY);
    const bf16* RWS = (const bf16*)((const char*)F.out + OUT_RWS); const float* BONUS = (const float*)((const char*)F.out + OUT_BONUS);
    const bf16* WgT = WSP(bf16, WS_WT_LORA) + 2 * 512 * 64;
    const float* mu = F.in[IN_MU];
    const int l = F.lane, r = l & 31, hf = l >> 5;
    const int gw = blockIdx.x * NWAVES + F.wave, NGW = F.G * NWAVES;
    for (int it = gw; it < NUNITS * 2; it += NGW) {
        const int u = it >> 1, th = it & 1;
        const bool meta = u >= 4096;
        int b = 0, h, c = 0; if (meta) h = u - 4096; else { b = u >> 10; h = (u >> 7) & 7; c = u & 127; }
        if (meta && th == 1) continue;
        const int t = 32 * th + r;
        const bool valid = !meta || t < NMETA;
        const int row0 = meta ? NREAL : b * SEQ + c * 64;
        const int row = valid ? row0 + t : row0;
        int prow = -1;
        if (t > 0) prow = row - 1; else if (!meta) prow = (c == 0) ? NREAL + NMETA - 1 : row - 1;
        f32x16 y[2];
#pragma unroll
        for (int qv = 0; qv < 2; ++qv) {
            const bf16* Y0 = RWY + (size_t)u * 4096 + (32 * th + r) * 64 + 32 * qv + 4 * hf;
#pragma unroll
            for (int jj = 0; jj < 4; ++jj) { const v2u wv = *(const v2u*)(Y0 + 8 * jj); y[qv][4 * jj] = bflo(wv.x); y[qv][4 * jj + 1] = bfhi(wv.x); y[qv][4 * jj + 2] = bflo(wv.y); y[qv][4 * jj + 3] = bfhi(wv.y); }
        }
        if (!meta) {
            const bf16* qp = RWQ + (size_t)u * 4096 + (32 * th + r) * 64 + 8 * hf;
            const bf16* sp = RWS + (size_t)u * 4096 + r * 64 + 8 * hf;
#pragma unroll
            for (int ks = 0; ks < 4; ++ks) {
                const bf16x8 bq = *(const bf16x8*)(qp + 16 * ks);
                y[0] = __builtin_amdgcn_mfma_f32_32x32x16_bf16(*(const bf16x8*)(sp + 16 * ks), bq, y[0], 0, 0, 0);
                y[1] = __builtin_amdgcn_mfma_f32_32x32x16_bf16(*(const bf16x8*)(sp + 32 * 64 + 16 * ks), bq, y[1], 0, 0, 0);
            }
        }
        f32x16 g[2]; g[0] = zero16(); g[1] = zero16();
        {
            const bf16* gp = P + (size_t)row * PW + PC_GD + 8 * hf; const bf16* gpp = prow >= 0 ? P + (size_t)prow * PW + PC_GD + 8 * hf : nullptr;
            const bf16* wp = WgT + (size_t)(h * 64 + r) * 128 + 8 * hf;
#pragma unroll
            for (int ks = 0; ks < 8; ++ks) {
                const v4u cg = *(const v4u*)(gp + 16 * ks); const v4u pg = gpp ? *(const v4u*)(gpp + 16 * ks) : (v4u){0u, 0u, 0u, 0u};
                const f32x4 m0 = *(const f32x4*)(mu + 1664 + 16 * ks + 8 * hf), m1 = *(const f32x4*)(mu + 1664 + 16 * ks + 8 * hf + 4);
                const unsigned cw[4] = {cg.x, cg.y, cg.z, cg.w}, pw[4] = {pg.x, pg.y, pg.z, pg.w}; const float mm[8] = {m0.x, m0.y, m0.z, m0.w, m1.x, m1.y, m1.z, m1.w};
                unsigned o[4];
#pragma unroll
                for (int e = 0; e < 4; ++e) {
                    const float c0 = bflo(cw[e]), c1 = bfhi(cw[e]), p0 = bflo(pw[e]), p1 = bfhi(pw[e]);
                    o[e] = pk2(sigmoidf_(c0 + (p0 - c0) * mm[2 * e]), sigmoidf_(c1 + (p1 - c1) * mm[2 * e + 1]));
                }
                const v4u ov = (v4u){o[0], o[1], o[2], o[3]};
                const bf16x8 bs = __builtin_bit_cast(bf16x8, ov);
                g[0] = __builtin_amdgcn_mfma_f32_32x32x16_bf16(*(const bf16x8*)(wp + 16 * ks), bs, g[0], 0, 0, 0);
                g[1] = __builtin_amdgcn_mfma_f32_32x32x16_bf16(*(const bf16x8*)(wp + 32 * 128 + 16 * ks), bs, g[1], 0, 0, 0);
            }
        }
        float s = 0.f;
#pragma unroll
        for (int j = 0; j < 16; ++j) s += y[0][j] + y[1][j];
        s += __shfl_xor(s, 32);
        const float mean = s * (1.f / 64.f);
        float s2 = 0.f;
#pragma unroll
        for (int j = 0; j < 16; ++j) { const float d0 = y[0][j] - mean, d1 = y[1][j] - mean; s2 += d0 * d0 + d1 * d1; }
        s2 += __shfl_xor(s2, 32);
        const float rstd = 1.0f / sqrtf(s2 * (1.f / 64.f) + GN_EPS);
        const float bon = BONUS[(size_t)u * 64 + t];
        if (valid) {
#pragma unroll
            for (int qv = 0; qv < 2; ++qv)
#pragma unroll
                for (int jj = 0; jj < 4; ++jj) {
                    const int v0 = 32 * qv + 8 * jj + 4 * hf, chv = h * 64 + v0;
                    const v2u cvw = *(const v2u*)(P + (size_t)row * PW + PC_V + chv); const v2u pvw = prow >= 0 ? *(const v2u*)(P + (size_t)prow * PW + PC_V + chv) : (v2u){0u, 0u};
                    const f32x4 mv = *(const f32x4*)(mu + 1024 + chv), gg = *(const f32x4*)(F.in[IN_GN_G] + chv), gb = *(const f32x4*)(F.in[IN_GN_B] + chv);
                    const float cv[4] = {bflo(cvw.x), bfhi(cvw.x), bflo(cvw.y), bfhi(cvw.y)}, pv[4] = {bflo(pvw.x), bfhi(pvw.x), bflo(pvw.y), bfhi(pvw.y)};
                    const float mvv[4] = {mv.x, mv.y, mv.z, mv.w}, ggv[4] = {gg.x, gg.y, gg.z, gg.w}, gbv[4] = {gb.x, gb.y, gb.z, gb.w};
                    float o[4];
#pragma unroll
                    for (int e = 0; e < 4; ++e) {
                        const float vs = cv[e] + (pv[e] - cv[e]) * mvv[e];
                        o[e] = ((y[qv][4 * jj + e] - mean) * rstd * ggv[e] + gbv[e] + bon * vs) * g[qv][4 * jj + e];
                    }
                    *(v2u*)(QA + (size_t)row * QAW + 1024 + chv) = (v2u){pk2(o[0], o[1]), pk2(o[2], o[3])};
                }
        }
    }
}

constexpr int IX_CAP = 512, IX_LIST = 3072, IX_KB = 98304, IX_SCR = RING_BYTES + 4096;
#define IX_FENCE() asm volatile("s_waitcnt lgkmcnt(0)" ::: "memory")

__device__ __forceinline__ unsigned ix_mbcnt(unsigned long long m) { return __builtin_amdgcn_mbcnt_hi((unsigned)(m >> 32), __builtin_amdgcn_mbcnt_lo((unsigned)m, 0u)); }

__device__ __forceinline__ void ix_select_slow(const float (&sc)[8], const unsigned (&ix)[8], bool (&vl)[8], int K, unsigned short* sel_out, int lane) {
    for (int it = 0; it < K; ++it) {
        unsigned long long best = 0ull;
#pragma unroll
        for (int i = 0; i < 8; ++i) { const unsigned long long key = ((unsigned long long)sortable(sc[i]) << 32) | (unsigned long long)(0xFFFFu - ix[i]) | 0x10000ull; if (vl[i] && key > best) best = key; }
        unsigned long long wm = best;
#pragma unroll
        for (int o = 1; o < 64; o <<= 1) { const unsigned long long v = __shfl_xor(wm, o); wm = v > wm ? v : wm; }
        if (wm == 0ull) break;
        const bool mine = best == wm;
#pragma unroll
        for (int i = 0; i < 8; ++i) { const unsigned long long key = ((unsigned long long)sortable(sc[i]) << 32) | (unsigned long long)(0xFFFFu - ix[i]) | 0x10000ull; if (mine && vl[i] && key == wm) { vl[i] = false; sel_out[it] = (unsigned short)ix[i]; } }
    }
}

__device__ __forceinline__ void ix_compact(LAS float* LS, LAS unsigned short* LI, LAS unsigned* hist, int& cnt, float& tau, int lane, bool final_sel, unsigned short* sel_out) {
    const int n = cnt;
    float sc[8]; unsigned ix[8]; bool vl[8];
    IX_FENCE();
#pragma unroll
    for (int i = 0; i < 8; ++i) { const int p = lane + 64 * i; vl[i] = p < n; sc[i] = vl[i] ? LS[p] : -INFINITY; ix[i] = vl[i] ? (unsigned)LI[p] : 0u; }
    float mx = -INFINITY, mn = INFINITY;
#pragma unroll
    for (int i = 0; i < 8; ++i) { if (vl[i]) { mx = fmaxf(mx, sc[i]); mn = fminf(mn, sc[i]); } }
    mx = wave_max(mx); mn = -wave_max(-mn);
    const float scale = mx > mn ? 255.99f / (mx - mn) : 0.f;
    int bin[8];
#pragma unroll
    for (int i = 0; i < 8; ++i) { int bq = (int)((sc[i] - mn) * scale); bq = bq > 255 ? 255 : (bq < 0 ? 0 : bq); bin[i] = vl[i] ? bq : -1; }
    *(LAS v4u*)(hist + 4 * lane) = (v4u){0u, 0u, 0u, 0u};
    IX_FENCE();
#pragma unroll
    for (int i = 0; i < 8; ++i) if (vl[i]) __hip_atomic_fetch_add((LAS unsigned*)&hist[bin[i]], 1u, __ATOMIC_RELAXED, __HIP_MEMORY_SCOPE_WAVEFRONT);
    IX_FENCE();
    const v4u c = *(const LAS v4u*)(hist + 4 * lane);
    const unsigned Pp = wave_scan_incl(c.x + c.y + c.z + c.w, lane);
    const unsigned total = (unsigned)__builtin_amdgcn_readlane((int)Pp, 63);
    const unsigned K = TOPK;
    const unsigned a3 = total - Pp, a2 = a3 + c.w, a1 = a2 + c.z, a0 = a1 + c.y;
    int myb = -1; unsigned myA = 0u, myC = 0u;
    if (a3 < K && K <= a3 + c.w) { myb = 4 * lane + 3; myA = a3; myC = c.w; }
    else if (a2 < K && K <= a2 + c.z) { myb = 4 * lane + 2; myA = a2; myC = c.z; }
    else if (a1 < K && K <= a1 + c.y) { myb = 4 * lane + 1; myA = a1; myC = c.y; }
    else if (a0 < K && K <= a0 + c.x) { myb = 4 * lane; myA = a0; myC = c.x; }
    const unsigned long long bm = __ballot(myb >= 0);
    const int src = bm ? (__ffsll((long long)bm) - 1) : 0;
    const int bstar = __shfl(myb, src); const unsigned A = __shfl(myA, src), m = __shfl(myC, src);
    if (!final_sel) {
        if (A + m <= (unsigned)(IX_CAP - 128)) {
            int base = 0; float kmin = INFINITY;
#pragma unroll
            for (int i = 0; i < 8; ++i) {
                const bool keep = vl[i] && bin[i] >= bstar;
                const unsigned long long mk = __ballot(keep);
                const int pos = base + (int)ix_mbcnt(mk);
                if (keep) { LS[pos] = sc[i]; LI[pos] = (unsigned short)ix[i]; kmin = fminf(kmin, sc[i]); }
                base += __popcll(mk);
            }
            cnt = base; tau = -wave_max(-kmin);
            IX_FENCE();
            return;
        }
        unsigned short* tmp = sel_out;
        ix_select_slow(sc, ix, vl, (int)K, tmp, lane);
        int base = 0; float kmin = INFINITY;
#pragma unroll
        for (int i = 0; i < 8; ++i) {
            const bool keep = !vl[i] && (lane + 64 * i) < n;
            const unsigned long long mk = __ballot(keep);
            const int pos = base + (int)ix_mbcnt(mk);
            if (keep) { LS[pos] = sc[i]; LI[pos] = (unsigned short)ix[i]; kmin = fminf(kmin, sc[i]); }
            base += __popcll(mk);
        }
        cnt = base; tau = -wave_max(-kmin);
        IX_FENCE();
        return;
    }
    if (m <= 128u) {
        int base = 0;
#pragma unroll
        for (int i = 0; i < 8; ++i) {
            const bool keep = vl[i] && bin[i] > bstar;
            const unsigned long long mk = __ballot(keep);
            const int pos = base + (int)ix_mbcnt(mk);
            if (keep) sel_out[pos] = (unsigned short)ix[i];
            base += __popcll(mk);
        }
        LAS float* sS = (LAS float*)hist; LAS unsigned* sI = hist + 128;
        IX_FENCE();
        int mb = 0;
#pragma unroll
        for (int i = 0; i < 8; ++i) {
            const bool inb = vl[i] && bin[i] == bstar;
            const unsigned long long mk = __ballot(inb);
            const int pos = mb + (int)ix_mbcnt(mk);
            if (inb) { sS[pos] = sc[i]; sI[pos] = ix[i]; }
            mb += __popcll(mk);
        }
        IX_FENCE();
        const int need = (int)(K - A);
#pragma unroll
        for (int e = 0; e < 2; ++e) {
            const int j = lane + 64 * e;
            if (j < (int)m) {
                const float sj = sS[j]; const unsigned ij = sI[j]; int rank = 0;
                for (int k = 0; k < (int)m; ++k) { const float sk = sS[k]; const unsigned ik = sI[k]; rank += (sk > sj || (sk == sj && ik < ij)) ? 1 : 0; }
                if (rank < need) sel_out[(int)A + rank] = (unsigned short)ij;
            }
        }
    } else {
        ix_select_slow(sc, ix, vl, (int)K, sel_out, lane);
    }
}

__device__ __forceinline__ void p5_index_mfma(Frame& F, unsigned short* SEL, int* NSEL, int qword = 3072, bool probe_noappend = false) {
    const bf16* QA = WSP(bf16, WS_QA); const bf16* KIDX = WSP(bf16, WS_KIDX); const float* WIDX = WSP(float, WS_WIDX);
    const int tid = F.tid, w = F.wave, l = F.lane, r = l & 31, hf = l >> 5;
    {
        const int gw = blockIdx.x * NWAVES + w, NGW = F.G * NWAVES;
        for (int i = gw; i < NMETA + BATCH * 192; i += NGW) {
            int q, nvis; if (i < NMETA) { q = NREAL + i; nvis = NMETA; } else { const int bb = (i - NMETA) / 192, s = (i - NMETA) % 192; q = bb * SEQ + s; nvis = NMETA + 64 * (s / 64 + 1); }
            for (int j = l; j < nvis; j += 64) SEL[(size_t)q * TOPK + j] = (unsigned short)j;
            if (l == 0) NSEL[q] = nvis;
        }
    }
    LAS unsigned char* L = F.lds;
    LAS unsigned* hist = (LAS unsigned*)(L + IX_SCR + w * 1024);
    {
        for (;;) {
            __syncthreads();
            if (tid == 0) F.MISC[16] = __hip_atomic_fetch_add((unsigned*)F.ctl + qword, 1u, __ATOMIC_RELAXED, __HIP_MEMORY_SCOPE_AGENT);
            __syncthreads();
            const int qi_ = (int)F.MISC[16];
            if (qi_ >= 1000) break;
            const int tile = 999 - qi_;
            const int pt = 6 + (tile >> 2), b = tile & 3;
            const int q0 = b * SEQ + pt * 32;
            const int nvis = NMETA + 64 * (pt / 2 + 1);
            __syncthreads();
            bf16x8 af[4];
            {
                const int qq = 2 * (r >> 4) + ((r >> 2) & 1), hd = 4 * ((r >> 3) & 1) + (r & 3);
                const bf16* qp = QA + (size_t)(q0 + 4 * w + qq) * QAW + 1024 + hd * 64 + 8 * hf;
#pragma unroll
                for (int ks = 0; ks < 4; ++ks) af[ks] = *(const bf16x8*)(qp + 16 * ks);
            }
            float wq[2][8];
#pragma unroll
            for (int a = 0; a < 2; ++a) {
                const f32x4 w0 = *(const f32x4*)(WIDX + (size_t)(q0 + 4 * w + 2 * a + hf) * 8), w1 = *(const f32x4*)(WIDX + (size_t)(q0 + 4 * w + 2 * a + hf) * 8 + 4);
                wq[a][0] = 0.5f * w0.x; wq[a][1] = 0.5f * w0.y; wq[a][2] = 0.5f * w0.z; wq[a][3] = 0.5f * w0.w; wq[a][4] = 0.5f * w1.x; wq[a][5] = 0.5f * w1.y; wq[a][6] = 0.5f * w1.z; wq[a][7] = 0.5f * w1.w;
            }
            float tau0 = -INFINITY, tau1 = -INFINITY;
            int cnt[4] = {0, 0, 0, 0};
            const int nblk = (nvis + 255) >> 8;
            v4u kreg[4];
#pragma unroll
            for (int e = 0; e < 4; ++e) {
                const int pid = tid + 512 * e, kl = pid >> 3, pc = pid & 7, j = kl;
                kreg[e] = j < nvis ? *(const v4u*)(KIDX + (size_t)key_row(b, j) * 64 + 8 * pc) : (v4u){0u, 0u, 0u, 0u};
            }
#pragma unroll
            for (int e = 0; e < 4; ++e) { const int pid = tid + 512 * e, kl = pid >> 3, pc = pid & 7; *(LAS v4u*)(L + IX_KB + kl * 128 + ((pc ^ ((kl >> 1) & 7)) << 4)) = kreg[e]; }
            __syncthreads();
            const LAS unsigned char* kb = L + IX_KB;
            for (int blk = 0; blk < nblk; ++blk) {
                if (blk + 1 < nblk) {
#pragma unroll
                    for (int e = 0; e < 4; ++e) {
                        const int pid = tid + 512 * e, kl = pid >> 3, pc = pid & 7, j = (blk + 1) * 256 + kl;
                        kreg[e] = j < nvis ? *(const v4u*)(KIDX + (size_t)key_row(b, j) * 64 + 8 * pc) : (v4u){0u, 0u, 0u, 0u};
                    }
                }
                int npair = (nvis - blk * 256 + 63) >> 6; npair = npair > 4 ? 4 : npair;
                bf16x8 bc0[4], bc1[4];
#pragma unroll
                for (int ks = 0; ks < 4; ++ks) { const int k0 = r, k1 = 32 + r;
                    bc0[ks] = *(const LAS bf16x8*)(kb + k0 * 128 + (((2 * ks + hf) ^ ((k0 >> 1) & 7)) << 4));
                    bc1[ks] = *(const LAS bf16x8*)(kb + k1 * 128 + (((2 * ks + hf) ^ ((k1 >> 1) & 7)) << 4)); }
                for (int pp = 0; pp < npair; ++pp) {
                    const int jbase = blk * 256 + pp * 64;
                    bf16x8 bn0[4], bn1[4];
                    {
                        const int pn = pp + 1 < npair ? pp + 1 : pp; const int k0 = pn * 64 + r, k1 = k0 + 32;
#pragma unroll
                        for (int ks = 0; ks < 4; ++ks) {
                            bn0[ks] = *(const LAS bf16x8*)(kb + k0 * 128 + (((2 * ks + hf) ^ ((k0 >> 1) & 7)) << 4));
                            bn1[ks] = *(const LAS bf16x8*)(kb + k1 * 128 + (((2 * ks + hf) ^ ((k1 >> 1) & 7)) << 4)); }
                    }
                    f32x16 accA = zero16(), accB = zero16();
#pragma unroll
                    for (int ks = 0; ks < 4; ++ks) { accA = __builtin_amdgcn_mfma_f32_32x32x16_bf16(af[ks], bc0[ks], accA, 0, 0, 0); accB = __builtin_amdgcn_mfma_f32_32x32x16_bf16(af[ks], bc1[ks], accB, 0, 0, 0); }
#pragma unroll
                    for (int ks = 0; ks < 4; ++ks) { bc0[ks] = bn0[ks]; bc1[ks] = bn1[ks]; }
                    float sA0 = 0.f, sA0b = 0.f, sA1 = 0.f, sA1b = 0.f, sB0 = 0.f, sB0b = 0.f, sB1 = 0.f, sB1b = 0.f;
#pragma unroll
                    for (int h = 0; h < 8; h += 2) {
                        sA0 = fmaf(wq[0][h], __builtin_fabsf(accA[h]), fmaf(wq[0][h], accA[h], sA0)); sA0b = fmaf(wq[0][h + 1], __builtin_fabsf(accA[h + 1]), fmaf(wq[0][h + 1], accA[h + 1], sA0b));
                        sA1 = fmaf(wq[1][h], __builtin_fabsf(accA[8 + h]), fmaf(wq[1][h], accA[8 + h], sA1)); sA1b = fmaf(wq[1][h + 1], __builtin_fabsf(accA[9 + h]), fmaf(wq[1][h + 1], accA[9 + h], sA1b));
                        sB0 = fmaf(wq[0][h], __builtin_fabsf(accB[h]), fmaf(wq[0][h], accB[h], sB0)); sB0b = fmaf(wq[0][h + 1], __builtin_fabsf(accB[h + 1]), fmaf(wq[0][h + 1], accB[h + 1], sB0b));
                        sB1 = fmaf(wq[1][h], __builtin_fabsf(accB[8 + h]), fmaf(wq[1][h], accB[8 + h], sB1)); sB1b = fmaf(wq[1][h + 1], __builtin_fabsf(accB[9 + h]), fmaf(wq[1][h + 1], accB[9 + h], sB1b));
                    }
                    const float s0A = (sA0 + sA0b) + 0.0f, s1A = (sA1 + sA1b) + 0.0f, s0B = (sB0 + sB0b) + 0.0f, s1B = (sB1 + sB1b) + 0.0f;
                    const int jA = jbase + r, jB = jA + 32;
                    const bool p0A = jA < nvis && s0A > tau0, p1A = jA < nvis && s1A > tau1, p0B = jB < nvis && s0B > tau0, p1B = jB < nvis && s1B > tau1;
                    const unsigned long long m0A = __ballot(p0A), m1A = __ballot(p1A), m0B = __ballot(p0B), m1B = __ballot(p1B);
                    if (m0A | m1A | m0B | m1B) {
                        const int a0lo = __popc((unsigned)m0A), a0hi = __popc((unsigned)(m0A >> 32)), a1lo = __popc((unsigned)m1A), a1hi = __popc((unsigned)(m1A >> 32));
                        const int b0lo = __popc((unsigned)m0B), b0hi = __popc((unsigned)(m0B >> 32)), b1lo = __popc((unsigned)m1B), b1hi = __popc((unsigned)(m1B >> 32));
                        {
                            LAS unsigned char* lb = L + (w * 4 + hf) * IX_LIST;
                            const int base = hf ? cnt[1] : cnt[0];
                            const int posA = base + (int)ix_mbcnt(m0A) - (hf ? a0lo : 0);
                            const int posB = base + (hf ? a0hi : a0lo) + (int)ix_mbcnt(m0B) - (hf ? b0lo : 0);
                            if (p0A) { ((LAS float*)lb)[posA] = s0A; ((LAS unsigned short*)(lb + 2048))[posA] = (unsigned short)jA; }
                            if (p0B) { ((LAS float*)lb)[posB] = s0B; ((LAS unsigned short*)(lb + 2048))[posB] = (unsigned short)jB; }
                        }
                        {
                            LAS unsigned char* lb = L + (w * 4 + 2 + hf) * IX_LIST;
                            const int base = hf ? cnt[3] : cnt[2];
                            const int posA = base + (int)ix_mbcnt(m1A) - (hf ? a1lo : 0);
                            const int posB = base + (hf ? a1hi : a1lo) + (int)ix_mbcnt(m1B) - (hf ? b1lo : 0);
                            if (p1A) { ((LAS float*)lb)[posA] = s1A; ((LAS unsigned short*)(lb + 2048))[posA] = (unsigned short)jA; }
                            if (p1B) { ((LAS float*)lb)[posB] = s1B; ((LAS unsigned short*)(lb + 2048))[posB] = (unsigned short)jB; }
                        }
                        cnt[0] += a0lo + b0lo; cnt[1] += a0hi + b0hi; cnt[2] += a1lo + b1lo; cnt[3] += a1hi + b1hi;
                        if (probe_noappend) { if (cnt[0] >= 256 && hf == 0) tau0 = INFINITY; if (cnt[1] >= 256 && hf == 1) tau0 = INFINITY; if (cnt[2] >= 256 && hf == 0) tau1 = INFINITY; if (cnt[3] >= 256 && hf == 1) tau1 = INFINITY; }
#pragma unroll
                        for (int qq = 0; qq < 4; ++qq) {
                            if (cnt[qq] > IX_CAP - 64) {
                                LAS unsigned char* lb = L + (w * 4 + qq) * IX_LIST;
                                float tq = 0.f; int cq = cnt[qq];
                                ix_compact((LAS float*)lb, (LAS unsigned short*)(lb + 2048), hist, cq, tq, l, false, SEL + (size_t)(q0 + 4 * w + qq) * TOPK);
                                cnt[qq] = __builtin_amdgcn_readfirstlane(cq);
                                if ((qq & 1) == hf) { if (qq < 2) tau0 = tq; else tau1 = tq; }
                            }
                        }
                    }
                }
                __syncthreads();
                if (blk + 1 < nblk) {
#pragma unroll
                    for (int e = 0; e < 4; ++e) { const int pid = tid + 512 * e, kl = pid >> 3, pc = pid & 7; *(LAS v4u*)(L + IX_KB + kl * 128 + ((pc ^ ((kl >> 1) & 7)) << 4)) = kreg[e]; }
                    __syncthreads();
                }
            }
#pragma unroll
            for (int qq = 0; qq < 4; ++qq) {
                LAS unsigned char* lb = L + (w * 4 + qq) * IX_LIST;
                float tq = 0.f; int cq = cnt[qq];
                ix_compact((LAS float*)lb, (LAS unsigned short*)(lb + 2048), hist, cq, tq, l, true, SEL + (size_t)(q0 + 4 * w + qq) * TOPK);
                if (l == 0) NSEL[q0 + 4 * w + qq] = TOPK;
            }
        }
    }
}

#ifndef CHECK_IDX
#define CHECK_IDX 0
#endif
#if CHECK_IDX
__device__ __forceinline__ void idx_check(Frame& F) {
    const unsigned short* SEL = WSP(unsigned short, WS_SEL); const unsigned short* SELB = (const unsigned short*)F.out; const int* NSEL = WSP(int, WS_NSEL); const int* NSELB = (const int*)((const char*)F.out + 32 * MiB);
    LAS unsigned* bm = (LAS unsigned*)(F.lds + F.wave * 2048);
    const int l = F.lane; const int gw = blockIdx.x * NWAVES + F.wave, NGW = F.G * NWAVES;
    unsigned miss = 0, badq = 0, dup = 0;
    for (int q = gw; q < NROWS; q += NGW) {
        for (int i = l; i < 260; i += 64) bm[i] = 0u;
        IX_FENCE();
        const int n = NSEL[q], nb = NSELB[q];
        for (int i = l; i < n; i += 64) { const unsigned j = SEL[(size_t)q * TOPK + i]; atomicOr((unsigned*)&bm[j >> 5], 1u << (j & 31)); }
        IX_FENCE();
        unsigned m = (n != nb) ? 1000u : 0u;
        for (int i = l; i < nb && i < TOPK; i += 64) { const unsigned j = SELB[(size_t)q * TOPK + i]; if (j >= (unsigned)TT) { ++dup; ++m; } else { const unsigned old = atomicAnd((unsigned*)&bm[j >> 5], ~(1u << (j & 31))); if (!((old >> (j & 31)) & 1u)) ++m; } }
        IX_FENCE();
        m = (unsigned)wave_sum((float)m);
        if (l == 0) { miss += m; badq += m ? 1u : 0u; }
    }
    dup = (unsigned)wave_sum((float)dup);
    if (l == 0) { atomicAdd((unsigned*)F.ctl + 2048, miss); atomicAdd((unsigned*)F.ctl + 2049, badq); atomicAdd((unsigned*)F.ctl + 2050, dup); }
}
#endif

typedef short v4i16_t __attribute__((ext_vector_type(4)));
__device__ __forceinline__ unsigned at_off(unsigned row, unsigned ch) { return 256u * row + 16u * (ch ^ (((row & 3u) << 2) | ((row >> 2) & 3u))); }

__device__ __forceinline__ void p6_attn_mfma(Frame& F, bf16* OUTB) {
    bf16* QA = WSP(bf16, WS_QA); const bf16* CKV = WSP(bf16, WS_CKV); const unsigned short* SEL = WSP(unsigned short, WS_SEL); const int* NSEL = WSP(int, WS_NSEL);
    const int l = F.lane, w = F.wave, h16 = l & 15, g = l >> 4;
    LAS unsigned char* tile = F.lds + w * 8192;
    LAS unsigned short* selb = (LAS unsigned short*)(F.lds + 65536 + w * 512);
    const float slope = h16 < 8 ? __uint_as_float((unsigned)(127 - (h16 + 1)) << 23) : 0.f;
    {
        const int gw = blockIdx.x * NWAVES + w, NGW = F.G * NWAVES;
        for (int q = NROWS + gw; q < R; q += NGW) { bf16* qrow = QA + (size_t)q * QAW; for (int c = l; c < QAW / 8; c += 64) *(v4u*)(qrow + 8 * c) = (v4u){0u, 0u, 0u, 0u}; }
    }
    const int G = F.G;
    int nq_tot, qbase_b, wib, wpb;
    if ((G & 7) == 0) { const int b = (blockIdx.x & 7) >> 1; qbase_b = b * SEQ; nq_tot = SEQ + (b == 0 ? NMETA : 0); wib = (((blockIdx.x >> 3) * 2) + (blockIdx.x & 1)) * NWAVES + w; wpb = (G / 4) * NWAVES; }
    else { qbase_b = 0; nq_tot = NROWS; wib = blockIdx.x * NWAVES + w; wpb = G * NWAVES; }
    for (int qi = wib; qi < nq_tot; qi += wpb) {
        int q, b, pos;
        if ((G & 7) == 0) { if (qi < SEQ) { q = qbase_b + qi; b = q >> 13; pos = NMETA + qi; } else { q = NREAL + (qi - SEQ); b = 0; pos = qi - SEQ; } }
        else { q = qi; if (q < NREAL) { b = q >> 13; pos = NMETA + (q & (SEQ - 1)); } else { b = 0; pos = q - NREAL; } }
        bf16* qrow = QA + (size_t)q * QAW;
        const int nsel = NSEL[q];
        const int nch = (nsel + 31) >> 5;
        const unsigned short* selq = SEL + (size_t)q * TOPK;
        IX_FENCE();
        if (l < 32) *(LAS v4u*)(selb + 8 * l) = *(const v4u*)(selq + 8 * l);
        IX_FENCE();
        bf16x8 qf[4];
#pragma unroll
        for (int s = 0; s < 4; ++s) { const v4u t = h16 < 8 ? *(const v4u*)(qrow + h16 * 128 + 32 * s + 8 * g) : (v4u){0u, 0u, 0u, 0u}; qf[s] = __builtin_bit_cast(bf16x8, t); }
        float m = -INFINITY, lsum = 0.f;
        f32x4 O[8];
#pragma unroll
        for (int c = 0; c < 8; ++c) O[c] = (f32x4){0.f, 0.f, 0.f, 0.f};
        v4u gr[8];
#pragma unroll
        for (int i = 0; i < 8; ++i) { const int s = g + 4 * i; const int kj = s < nsel ? (int)selb[s] : (int)selb[0]; gr[i] = *(const v4u*)(CKV + (size_t)key_row(b, kj) * 128 + 8 * h16); }
        for (int ck = 0; ck < nch; ++ck) {
            IX_FENCE();
#pragma unroll
            for (int i = 0; i < 8; ++i) *(LAS v4u*)(tile + at_off((unsigned)(g + 4 * i), (unsigned)h16)) = gr[i];
            const v4u kv = *(const LAS v4u*)(selb + 32 * ck + 8 * g);
            if (ck + 1 < nch) {
#pragma unroll
                for (int i = 0; i < 8; ++i) { const int s = 32 * (ck + 1) + g + 4 * i; const int kj = s < nsel ? (int)selb[s] : (int)selb[0]; gr[i] = *(const v4u*)(CKV + (size_t)key_row(b, kj) * 128 + 8 * h16); }
            }
            IX_FENCE();
            f32x4 a0 = (f32x4){0.f, 0.f, 0.f, 0.f}, a1 = a0;
#pragma unroll
            for (int s = 0; s < 4; ++s) {
                const bf16x8 k0 = *(const LAS bf16x8*)(tile + at_off((unsigned)(8 * (h16 >> 2) + (h16 & 3)), (unsigned)(4 * s + g)));
                const bf16x8 k1 = *(const LAS bf16x8*)(tile + at_off((unsigned)(8 * (h16 >> 2) + 4 + (h16 & 3)), (unsigned)(4 * s + g)));
                a0 = __builtin_amdgcn_mfma_f32_16x16x32_bf16(k0, qf[s], a0, 0, 0, 0);
                a1 = __builtin_amdgcn_mfma_f32_16x16x32_bf16(k1, qf[s], a1, 0, 0, 0);
            }
            const unsigned kw[4] = {kv.x, kv.y, kv.z, kv.w};
            float x[8];
#pragma unroll
            for (int j = 0; j < 8; ++j) {
                const int kj = (int)((kw[j >> 1] >> (16 * (j & 1))) & 0xffffu);
                const float lg = (j < 4 ? a0[j & 3] : a1[j & 3]) - slope * fabsf((float)(pos - kj));
                x[j] = (32 * ck + 8 * g + j) < nsel ? lg : -INFINITY;
            }
            float cm = fmaxf(fmaxf(fmaxf(x[0], x[1]), fmaxf(x[2], x[3])), fmaxf(fmaxf(x[4], x[5]), fmaxf(x[6], x[7])));
            cm = fmaxf(cm, __shfl_xor(cm, 16)); cm = fmaxf(cm, __shfl_xor(cm, 32));
            const float mn = fmaxf(m, cm);
            const float alpha = __expf(m - mn);
            float p[8], ps = 0.f;
#pragma unroll
            for (int j = 0; j < 8; ++j) { p[j] = __expf(x[j] - mn); ps += p[j]; }
            ps += __shfl_xor(ps, 16); ps += __shfl_xor(ps, 32);
            lsum = lsum * alpha + ps; m = mn;
            if (__any(alpha != 1.0f)) {
#pragma unroll
                for (int rr = 0; rr < 4; ++rr) { const float sc = __shfl(alpha, 4 * g + rr);
#pragma unroll
                    for (int c = 0; c < 8; ++c) O[c][rr] *= sc; }
            }
            const v4u pw = (v4u){pk2(p[0], p[1]), pk2(p[2], p[3]), pk2(p[4], p[5]), pk2(p[6], p[7])};
            const bf16x8 pf = __builtin_bit_cast(bf16x8, pw);
#pragma unroll
            for (int c = 0; c < 8; ++c) {
                const unsigned qd = (unsigned)(h16 >> 2), pp = (unsigned)(h16 & 3);
                const v4i16_t t0 = __builtin_amdgcn_ds_read_tr16_b64_v4i16((LAS v4i16_t*)(tile + at_off(8u * g + qd, 2u * c + (pp >> 1)) + 8u * (pp & 1u)));
                const v4i16_t t1 = __builtin_amdgcn_ds_read_tr16_b64_v4i16((LAS v4i16_t*)(tile + at_off(8u * g + 4u + qd, 2u * c + (pp >> 1)) + 8u * (pp & 1u)));
                bf16x8 vf; vf[0] = t0[0]; vf[1] = t0[1]; vf[2] = t0[2]; vf[3] = t0[3]; vf[4] = t1[0]; vf[5] = t1[1]; vf[6] = t1[2]; vf[7] = t1[3];
                O[c] = __builtin_amdgcn_mfma_f32_16x16x32_bf16(pf, vf, O[c], 0, 0, 0);
            }
        }
        const float inv = 1.0f / lsum;
#pragma unroll
        for (int rr = 0; rr < 4; ++rr) {
            const float sc = __shfl(inv, 4 * g + rr);
            if (g < 2) {
#pragma unroll
                for (int c = 0; c < 8; ++c) (OUTB + (size_t)q * QAW)[(4 * g + rr) * 128 + 16 * c + h16] = (bf16)f2bf(O[c][rr] * sc);
            }
        }
    }
}
struct StoreBf16 { bf16* O; int ld;
    __device__ __forceinline__ void operator()(int row, int col, const f32x4& v) const { *(v2u*)(O + (size_t)row * ld + col) = (v2u){pk2(v.x, v.y), pk2(v.z, v.w)}; }
    __device__ __forceinline__ void one(int row, int col, float v) const { O[(size_t)row * ld + col] = (bf16)f2bf(v); } };
struct StoreRes1 { const bf16* H; float* out; float* meta;
    __device__ __forceinline__ void operator()(int row, int col, const f32x4& v) const {
        if (row >= NROWS) return;
        const v2u hw = *(const v2u*)(H + (size_t)row * D + col);
        const f32x4 o = (f32x4){ALPHA * bflo(hw.x) + v.x, ALPHA * bfhi(hw.x) + v.y, ALPHA * bflo(hw.y) + v.z, ALPHA * bfhi(hw.y) + v.w};
        float* dst = row < NREAL ? out + (size_t)row * D + col : meta + (size_t)(row - NREAL) * D + col;
        *(f32x4*)dst = o; }
    __device__ __forceinline__ void one(int row, int col, float v) const { if (row >= NROWS) return; float* dst = row < NREAL ? out + (size_t)row * D + col : meta + (size_t)(row - NREAL) * D + col; *dst = ALPHA * bf2f(H[(size_t)row * D + col]) + v; } };
struct StoreRes2 { const bf16* H; float* out; __device__ __forceinline__ void operator()(int row, int col, const f32x4& v) const {
        if (row >= NREAL) return;
        const v2u hw = *(const v2u*)(H + (size_t)row * D + col);
        *(f32x4*)(out + (size_t)row * D + col) = (f32x4){ALPHA * bflo(hw.x) + v.x, ALPHA * bfhi(hw.x) + v.y, ALPHA * bflo(hw.y) + v.z, ALPHA * bfhi(hw.y) + v.w}; } };

struct StoreMetaGate { float* GM; __device__ __forceinline__ void one(int row, int col, float v) const { const int m = row - NREAL, x = col & 255; if (m >= 14 && x < 128) GM[(size_t)(m - 14) * DFF + 128 * (col >> 8) + x] = v; } };
template <class Fn>
__device__ __forceinline__ void meta_gemm(Frame& F, const bf16* A, int lda, const bf16* Bt, int N, int K, const Fn& fn) {
    const int l = F.lane, i16 = l & 15, g = l >> 4;
    const int gw = blockIdx.x * NWAVES + F.wave, NGW = F.G * NWAVES;
    for (int t = gw; t < N / 16; t += NGW) {
        const bf16* ap = A + (size_t)(NREAL + i16) * lda + 8 * g; const bf16* bp = Bt + (size_t)(16 * t + i16) * K + 8 * g;
        f32x4 acc = (f32x4){0.f, 0.f, 0.f, 0.f};
#pragma unroll 8
        for (int s = 0; s < K / 32; ++s) acc = __builtin_amdgcn_mfma_f32_16x16x32_bf16(*(const pg8::bf16x8*)(ap + 32 * s), *(const pg8::bf16x8*)(bp + 32 * s), acc, 0, 0, 0);
#pragma unroll
        for (int rr = 0; rr < 4; ++rr) fn.one(NREAL + 4 * g + rr, 16 * t + i16, acc[rr]);
    }
}

template <class Fn>
__device__ __forceinline__ void run_gemm(Frame& F, const bf16* A, int lda, const bf16* Bt, int N, int K, const Fn& fn) {
    pg8::Gemm g{A, Bt, NREAL, N, K, lda}; pg8::StaticOrder S; S.init(NREAL, N, F.G, (int)blockIdx.x);
    pg8::EpiFn<Fn> E{fn};
    pg8::gemm_phase<pg8::EpiFn<Fn>, pg8::StaticOrder, true, true>(F.lds + RING_OFF, g, S, E);
}

constexpr int NPHASES = 13;
struct Args { const float* in[32]; float* out; unsigned char* ws; int ph_lo, ph_hi; };
__global__ void __launch_bounds__(NTHR, 2) fwd(Args args) {
    extern __shared__ __attribute__((aligned(16))) unsigned char lds[];
    Frame F;
    F.lds = (LAS unsigned char*)lds;
    F.MISC = (volatile LAS unsigned*)(F.lds + MISC_OFF);
    F.tid = threadIdx.x; F.lane = F.tid & 63; F.wave = __builtin_amdgcn_readfirstlane(F.tid >> 6);
    F.G = gridDim.x;
#pragma unroll
    for (int i = 0; i < 32; ++i) F.in[i] = args.in[i];
    F.out = args.out; F.ws = args.ws;
    F.ctl = (gu32*)(args.ws + WS_CTL);
    for (int u = F.tid; u < (LDS_BYTES - LDSCTL_OFF) / 4; u += NTHR) ((LAS unsigned*)(F.lds + LDSCTL_OFF))[u] = 0u;
    __syncthreads();
    const int lo = args.ph_lo, hi = args.ph_hi;
    XcdBarrier bar; bar.bar = (unsigned*)(F.ctl + CW_BAR); bar.x = 0; bar.st = nullptr;
    if (hi - lo > 1) bar = xcd_barrier_post((unsigned*)(F.ctl + CW_BAR), F.MISC + 8);
#define IN(k) (lo <= (k) && (k) < hi)
#define SEAM(k) do { if (IN(k) && IN((k) + 1)) xcd_barrier(bar); } while (0)
#ifndef PROBE_PH
#define PROBE_PH -1
#endif
#define REP(k) for (int rep_ = 0; rep_ < ((PROBE_PH == (k)) ? 2 : 1); ++rep_)

#ifndef IDX_NAIVE
#define IDX_NAIVE 0
#endif
#ifndef ATTN_NAIVE
#define ATTN_NAIVE 0
#endif
    if (IN(0)) REP(0) { if (rep_) __syncthreads(); p0_weights(F); p1_ln_in(F); } SEAM(0);
    if (IN(1)) REP(1) { if (rep_) __syncthreads(); run_gemm(F, WSP(bf16, WS_H), D, WSP(bf16, WS_WT_IN), PW, D, StoreBf16{WSP(bf16, WS_P), PW}); meta_gemm(F, WSP(bf16, WS_H), D, WSP(bf16, WS_WT_IN), PW, D, StoreBf16{WSP(bf16, WS_P), PW}); } SEAM(1);
    if (IN(2)) REP(2) { if (rep_) __syncthreads(); p3_prep(F); } SEAM(2);
    if (IN(3)) REP(3) { if (rep_) __syncthreads(); run_gemm(F, WSP(bf16, WS_CQN), 256, WSP(bf16, WS_WT_QA), QAW, 256, StoreBf16{WSP(bf16, WS_QA), QAW}); meta_gemm(F, WSP(bf16, WS_CQN), 256, WSP(bf16, WS_WT_QA), QAW, 256, StoreBf16{WSP(bf16, WS_QA), QAW});
#if REFSEL
        refsel_rows(F);
#endif
    } SEAM(3);
    if (IN(4)) REP(4) { if (rep_) __syncthreads(); rw_b1(F); } SEAM(4);
    if (IN(5)) {
        rw_b2(F); __syncthreads();
#if CHECK_IDX
        p5_index_naive(F); __syncthreads(); p5_index_mfma(F, (unsigned short*)F.out, (int*)((char*)F.out + 32 * MiB));
#elif IDX_NAIVE
        p5_index_naive(F);
#else
        p5_index_mfma(F, WSP(unsigned short, WS_SEL), WSP(int, WS_NSEL));
#ifdef PROBE_IDX
        __syncthreads(); p5_index_mfma(F, WSP(unsigned short, WS_SEL), WSP(int, WS_NSEL), 3136);
#endif
#ifdef PROBE_IDX_SCORE
        __syncthreads(); p5_index_mfma(F, (unsigned short*)F.out, (int*)((char*)F.out + 32 * MiB), 3136, true);
#endif
#endif
    } SEAM(5);
    if (IN(6)) {
#if CHECK_IDX
        idx_check(F); __syncthreads();
#endif
#if ATTN_NAIVE
        p6_attn_naive(F);
#else
        p6_attn_mfma(F, WSP(bf16, WS_QA));
#endif
        __syncthreads();
        rw_b3(F);
    } SEAM(6);
    if (IN(7)) REP(7) { if (rep_) __syncthreads(); run_gemm(F, WSP(bf16, WS_QA), QAW, WSP(bf16, WS_WT_MIX), D, QAW, StoreRes1{WSP(bf16, WS_H), F.out, WSP(float, WS_META1)}); meta_gemm(F, WSP(bf16, WS_QA), QAW, WSP(bf16, WS_WT_MIX), D, QAW, StoreRes1{WSP(bf16, WS_H), F.out, WSP(float, WS_META1)}); } SEAM(7);
    if (IN(8)) REP(8) { if (rep_) __syncthreads(); p10_ln1(F); } SEAM(8);
    if (IN(9)) {
        pg8::Gemm g{WSP(bf16, WS_H), WSP(bf16, WS_WT_UP), NREAL, UPW, D, D}; pg8::StaticOrder S; S.init(NREAL, UPW, F.G, (int)blockIdx.x);
        pg8::EpiConvAct E{WSP(unsigned short, WS_UP), DFF, F.in[IN_CONV_W], F.in[IN_CONV_B], DFF, WSP(float, WS_G01), WSP(float, WS_V01), WSP(float, WS_GHALO), (PG8_LAS float*)(F.lds + RING_BYTES + 4096)};
        pg8::gemm_phase<pg8::EpiConvAct, pg8::StaticOrder, true, true>(F.lds + RING_OFF, g, S, E);
        meta_gemm(F, WSP(bf16, WS_H), D, WSP(bf16, WS_WT_UP), UPW, D, StoreMetaGate{WSP(float, WS_GMETA)});
    } SEAM(9);
    if (IN(10)) { p12_conv_fix(F); } SEAM(10);
    if (IN(11)) REP(11) { if (rep_) __syncthreads(); run_gemm(F, WSP(bf16, WS_UP), DFF, WSP(bf16, WS_WT_DN), D, DFF, StoreRes2{WSP(bf16, WS_H), F.out}); } SEAM(11);
    if (IN(12)) { p14_ln2(F);
#if CHECK_IDX
        if (blockIdx.x == 0 && F.tid == 0) {
            const unsigned miss = __hip_atomic_load((unsigned*)F.ctl + 2048, __ATOMIC_RELAXED, __HIP_MEMORY_SCOPE_AGENT), dupc = __hip_atomic_load((unsigned*)F.ctl + 2050, __ATOMIC_RELAXED, __HIP_MEMORY_SCOPE_AGENT);
            if (dupc) F.out[5] = __builtin_inff();
            if (miss > CHECK_IDX_MAXMISS) F.out[3] = __builtin_nanf("");
        }
#endif
    }
#ifdef PROBE_B1SEC
    if (blockIdx.x == 0 && F.tid == 0) { const unsigned long long t0 = __builtin_amdgcn_s_memrealtime(); const unsigned long long dt = (unsigned long long)F.MISC[20]; while (__builtin_amdgcn_s_memrealtime() - t0 < dt) __builtin_amdgcn_s_sleep(8); }
#endif
#undef IN
#undef SEAM
}

extern "C" void kernel_launch(void* const* d_in, const int* in_sizes, int n_in, void* d_out, int out_size, void* d_ws, size_t ws_size, hipStream_t stream) {
    static int grid = 0;
    if (grid == 0) {
        if (n_in != 32 || out_size != NREAL * D || ws_size < WS_END) { fprintf(stderr, "kernel_launch: unexpected shapes: n_in %d out %d ws %zu\n", n_in, out_size, ws_size); grid = -1; return; }
        int dev = 0, cus = 0, per_cu = 0;
        if (hipGetDevice(&dev) != hipSuccess || hipDeviceGetAttribute(&cus, hipDeviceAttributeMultiprocessorCount, dev) != hipSuccess) { grid = -1; return; }
        if (hipFuncSetAttribute((const void*)fwd, hipFuncAttributeMaxDynamicSharedMemorySize, LDS_BYTES) != hipSuccess) { fprintf(stderr, "kernel_launch: hipFuncSetAttribute failed\n"); grid = -1; return; }
        if (hipOccupancyMaxActiveBlocksPerMultiprocessor(&per_cu, (const void*)fwd, NTHR, LDS_BYTES) != hipSuccess || per_cu < 1) fprintf(stderr, "kernel_launch: occupancy query says %d\n", per_cu);
        (void)hipGetLastError();
        grid = cus;
    }
    if (grid < 0) return;
    (void)hipMemsetAsync((char*)d_ws + WS_CTL, 0, CTL_ZERO_BYTES, stream);
    Args a{};
    for (int i = 0; i < 32; ++i) a.in[i] = (const float*)d_in[i];
    a.out = (float*)d_out; a.ws = (unsigned char*)d_ws;
#if ONE_LAUNCH
    a.ph_lo = 0; a.ph_hi = NPHASES;
    hipLaunchKernelGGL(fwd, dim3(grid), dim3(NTHR), LDS_BYTES, stream, a);
#else
    for (int p = 0; p < NPHASES; ++p) { a.ph_lo = p; a.ph_hi = p + 1; hipLaunchKernelGGL(fwd, dim3(grid), dim3(NTHR), LDS_BYTES, stream, a); }
#endif
}
```

```cpp
#include <hip/hip_runtime.h>
#include <cstdio>
#include <cstdint>
#define ONE_LAUNCH 1
namespace pg8 {
#define PG8_LAS __attribute__((address_space(3)))
typedef unsigned short bf16_t;
typedef short bf16x8 __attribute__((ext_vector_type(8)));
typedef float f32x4 __attribute__((ext_vector_type(4)));
typedef unsigned u32x4 __attribute__((ext_vector_type(4)));
constexpr int BM = 256, BK = 64, HALF = 128, HTB = HALF * BK * 2  , STAGE_BYTES = 8 * HTB, NXCD = 8, WGM = 8;

__host__ __device__ __forceinline__ int lds_byte(int r, int c) { const int st = (r >> 4) * 2 + (c >> 5), rr = r & 15, cc = c & 31, ob = rr * 64 + cc * 2; return st * 1024 + (ob ^ (((ob >> 9) & 1) << 5)); }
__host__ __device__ __forceinline__ void stage_rc(int b, int& R, int& C) { const int st = b / 1024, sb = b % 1024, swz = sb ^ (((sb >> 9) & 1) << 5); R = (st >> 1) * 16 + swz / 64; C = (st & 1) * 32 + (swz % 64) / 2; }
__host__ __device__ __forceinline__ int perm32(int rho) { const int n = rho >> 4, i = rho & 15; return 8 * (i >> 2) + 4 * n + (i & 3); }

struct Unit { int pm, pn; };
struct Gemm { const bf16_t* A; const bf16_t* Bt; int M, N, K, lda; };

struct StaticOrder {
    int nM, nN, nwg, G, c;
    __host__ __device__ void init(int M, int N, int G_, int c_) { nM = M / BM; nN = N / BM; nwg = nM * nN; G = G_; c = c_; }
    __host__ __device__ bool next(int i, Unit& u) const {
        const long L = (long)i * G + c; if (L >= nwg) return false;
        int wgid = (int)L; { const int q = nwg / NXCD, r = nwg % NXCD, xcd = wgid % NXCD, off = wgid / NXCD; wgid = (xcd < r ? xcd * (q + 1) : r * (q + 1) + (xcd - r) * q) + off; }
        const int nig = WGM * nN, gid = wgid / nig, fm = gid * WGM, gsz = (nM - fm) < WGM ? (nM - fm) : WGM;
        u.pm = fm + ((wgid % nig) % gsz); u.pn = (wgid % nig) / gsz; return true;
    }
    __device__ __forceinline__ void a_ready(const Unit&) const {}
    __device__ __forceinline__ void done(const Unit&) const {}
};


template <class F> struct EpiFn {
    static constexpr bool PERM = false, AFTER_DRAIN = false;
    F f;
    __device__ __forceinline__ void operator()(const f32x4 (&acc)[2][2][4][2], const Unit& u, int wr, int wc, int fr, int fq) const {
        const int row0 = u.pm * BM + wr * 64 + fr, col0 = u.pn * BM + wc * 32 + 4 * fq;
#pragma unroll
        for (int ai = 0; ai < 2; ++ai)
#pragma unroll
            for (int m = 0; m < 4; ++m) {
                const int row = row0 + ai * HALF + m * 16;
#pragma unroll
                for (int bj = 0; bj < 2; ++bj)
#pragma unroll
                    for (int n = 0; n < 2; ++n) f(row, col0 + bj * HALF + n * 16, acc[ai][bj][m][n]);
            }
    }
};

struct EpiConvAct {
    static constexpr bool PERM = false, AFTER_DRAIN = false;
    unsigned short* ACT; int ldact;
    const float* cw; const float* cb; int dff;
    float* G01; float* V01; float* GHALO;
    PG8_LAS float* hal;
    __device__ __forceinline__ void operator()(const f32x4 (&acc)[2][2][4][2], const Unit& u, int wr, int wc, int fr, int fq) const {
        const int colg = 128 * u.pn + wc * 32 + 4 * fq;
        f32x4 w0[2], w1[2], w2[2], bb[2];
#pragma unroll
        for (int n = 0; n < 2; ++n) { w0[n] = *(const f32x4*)(cw + colg + 16 * n); w1[n] = *(const f32x4*)(cw + dff + colg + 16 * n); w2[n] = *(const f32x4*)(cw + 2 * dff + colg + 16 * n); bb[n] = *(const f32x4*)(cb + colg + 16 * n); }
        if (fr >= 14) {
#pragma unroll
            for (int ai = 0; ai < 2; ++ai)
#pragma unroll
                for (int n = 0; n < 2; ++n) *(PG8_LAS f32x4*)(hal + (((2 * ai + wr) * 4 + wc) * 2 + (fr - 14)) * 32 + 16 * n + 4 * fq) = acc[ai][0][3][n];
        }
        asm volatile("s_waitcnt lgkmcnt(0)" ::: "memory"); __builtin_amdgcn_s_barrier(); asm volatile("" ::: "memory");
#pragma unroll
        for (int ai = 0; ai < 2; ++ai) {
            const int blk = 2 * ai + wr;
#pragma unroll
            for (int n = 0; n < 2; ++n) {
                f32x4 prev = (f32x4){0.f, 0.f, 0.f, 0.f};
                if (blk > 0) prev = *(const PG8_LAS f32x4*)(hal + ((((blk - 1) * 4 + wc) * 2 + (fr & 1)) * 32) + 16 * n + 4 * fq);
#pragma unroll
                for (int m = 0; m < 4; ++m) {
                    const f32x4 cur = acc[ai][0][m][n], val = acc[ai][1][m][n];
                    f32x4 o;
#pragma unroll
                    for (int e = 0; e < 4; ++e) {
                        float s1 = prev[e], s2 = prev[e];
                        asm volatile("s_nop 1\n\tv_mov_b32_dpp %0, %0 row_ror:1 row_mask:0xf bank_mask:0xf\n\tv_mov_b32_dpp %1, %1 row_ror:2 row_mask:0xf bank_mask:0xf\n\ts_nop 1\n\t"
                                     "v_mov_b32_dpp %0, %2 row_shr:1 row_mask:0xf bank_mask:0xf\n\tv_mov_b32_dpp %1, %2 row_shr:2 row_mask:0xf bank_mask:0xf\n\ts_nop 1" : "+v"(s1), "+v"(s2) : "v"(cur[e]));
                        const float x = w0[n][e] * s2 + w1[n][e] * s1 + w2[n][e] * cur[e] + bb[n][e];
                        const float u2 = x * (1.5957691216057308f + 0.07135481627260025f * x * x);
                        o[e] = x * __builtin_amdgcn_rcpf(1.0f + __builtin_amdgcn_exp2f(-1.4426950408889634f * u2)) * val[e];
                    }
                    const int rt = ai * HALF + wr * 64 + m * 16 + fr;
                    const int row = u.pm * BM + rt;
                    if (blk == 0 && m == 0 && fr < 2) {
                        *(f32x4*)(G01 + ((size_t)u.pm * 2 + fr) * dff + colg + 16 * n) = cur; *(f32x4*)(V01 + ((size_t)u.pm * 2 + fr) * dff + colg + 16 * n) = val;
                    } else {
                        typedef unsigned u32x2 __attribute__((ext_vector_type(2)));
                        typedef __bf16 b2 __attribute__((ext_vector_type(2)));
                        const b2 lo = {(__bf16)o[0], (__bf16)o[1]}, hi = {(__bf16)o[2], (__bf16)o[3]};
                        *(u32x2*)(ACT + (size_t)row * ldact + colg + 16 * n) = (u32x2){__builtin_bit_cast(unsigned, lo), __builtin_bit_cast(unsigned, hi)};
                    }
                    if (blk == 3 && m == 3 && fr >= 14) *(f32x4*)(GHALO + ((size_t)u.pm * 2 + (fr - 14)) * dff + colg + 16 * n) = cur;
                    prev = cur;
                }
            }
        }
        asm volatile("s_waitcnt lgkmcnt(0)" ::: "memory"); __builtin_amdgcn_s_barrier(); asm volatile("" ::: "memory");
    }
};
template <class Epi, class Sched, bool ALIGN_EPI = false, bool SP2 = false>
__device__ __forceinline__ void gemm_phase(PG8_LAS unsigned char* lds, const Gemm g, const Sched& S, const Epi& E) {
    const int tid = threadIdx.x, wid = __builtin_amdgcn_readfirstlane(tid >> 6), lane = tid & 63, wr = wid >> 2, wc = wid & 3, fr = lane & 15, fq = lane >> 4;
    const int K = g.K, nt = K / BK;
    unsigned voffA[2], voffB[2];
#pragma unroll
    for (int i = 0; i < 2; ++i) { int R, C; stage_rc(tid * 16 + i * 8192, R, C); const int Rb = Epi::PERM ? ((R & ~31) + perm32(R & 31)) : R;
        voffA[i] = (unsigned)(R * g.lda + C) * 2u; voffB[i] = (unsigned)(Rb * K + C) * 2u; }
    const size_t kstep = (size_t)(BK * 2);
    const size_t hA = (size_t)HALF * g.lda * 2, hB = (size_t)HALF * K * 2;
    const size_t tA = 2 * hA, tB = 2 * hB;
    const unsigned ldsw = (unsigned)wid * 1024u;
    const int aoff = lds_byte(wr * 64 + fr, fq * 8), boff = lds_byte(wc * 32 + fr, fq * 8);
#define PG8_SA(b, h) (((b) * 2 + (h)) * HTB)
#define PG8_SB(b, h) ((4 + (b) * 2 + (h)) * HTB)
#define PG8_STAGE(bufoff, gbase, voff) do { _Pragma("unroll") for (int _i = 0; _i < 2; ++_i) \
        __builtin_amdgcn_global_load_lds((const unsigned*)((const char*)(gbase) + (voff)[_i]), (PG8_LAS unsigned*)(lds + (bufoff) + ldsw + _i * 8192), 16, 0, 0); } while (0)
#define PG8_LDA(dst, b, h) do { _Pragma("unroll") for (int m = 0; m < 4; ++m) _Pragma("unroll") for (int k = 0; k < 2; ++k) dst[m][k] = *(const PG8_LAS bf16x8*)(lds + PG8_SA(b, h) + aoff + m * 2048 + k * 1024); } while (0)
#define PG8_LDB(dst, b, h) do { _Pragma("unroll") for (int n = 0; n < 2; ++n) _Pragma("unroll") for (int k = 0; k < 2; ++k) dst[n][k] = *(const PG8_LAS bf16x8*)(lds + PG8_SB(b, h) + boff + n * 2048 + k * 1024); } while (0)
#define PG8_MMA(ai, bj, At, Bt) do { __builtin_amdgcn_s_setprio(1); _Pragma("unroll") for (int m = 0; m < 4; ++m) _Pragma("unroll") for (int n = 0; n < 2; ++n) _Pragma("unroll") for (int k = 0; k < 2; ++k) \
        acc[ai][bj][m][n] = __builtin_amdgcn_mfma_f32_16x16x32_bf16(Bt[n][k], At[m][k], acc[ai][bj][m][n], 0, 0, 0); __builtin_amdgcn_s_setprio(0); } while (0)
#define PG8_WAIT_V(n) asm volatile("s_waitcnt vmcnt(" #n ")" ::: "memory")
#define PG8_WAIT_L(n) asm volatile("s_waitcnt lgkmcnt(" #n ")" ::: "memory")
#define PG8_BAR __builtin_amdgcn_s_barrier()
#define PG8_SCHED __builtin_amdgcn_sched_barrier(0)
    Unit cur, nxt; int ui = 0;
    if (!S.next(0, cur)) return;
    f32x4 acc[2][2][4][2];
#pragma unroll
    for (int a = 0; a < 2; ++a)
#pragma unroll
        for (int b = 0; b < 2; ++b)
#pragma unroll
            for (int m = 0; m < 4; ++m)
#pragma unroll
                for (int n = 0; n < 2; ++n) acc[a][b][m][n] = (f32x4){0.f, 0.f, 0.f, 0.f};
    bf16x8 At[4][2], B0[2][2], B1[2][2];
    const char* cA = (const char*)g.A + (size_t)cur.pm * tA; const char* cB = (const char*)g.Bt + (size_t)cur.pn * tB;
    S.a_ready(cur);
    if constexpr (SP2) {
        PG8_STAGE(PG8_SB(0, 0), cB, voffB); PG8_STAGE(PG8_SB(0, 1), cB + hB, voffB); PG8_STAGE(PG8_SA(0, 0), cA, voffA); PG8_STAGE(PG8_SA(0, 1), cA + hA, voffA);
        if (wr == 1) PG8_BAR;
        PG8_WAIT_V(2); PG8_BAR;
        PG8_STAGE(PG8_SB(1, 0), cB + kstep, voffB); PG8_STAGE(PG8_SA(1, 0), cA + kstep, voffA); PG8_STAGE(PG8_SB(1, 1), cB + hB + kstep, voffB);
        PG8_WAIT_V(6); PG8_BAR;
    } else {
        PG8_STAGE(PG8_SB(0, 0), cB, voffB); PG8_STAGE(PG8_SA(0, 0), cA, voffA); PG8_STAGE(PG8_SB(0, 1), cB + hB, voffB); PG8_STAGE(PG8_SA(0, 1), cA + hA, voffA);
        if (wr == 1) PG8_BAR;
        PG8_WAIT_V(4); PG8_BAR;
        PG8_STAGE(PG8_SB(1, 0), cB + kstep, voffB); PG8_STAGE(PG8_SA(1, 0), cA + kstep, voffA); PG8_STAGE(PG8_SB(1, 1), cB + hB + kstep, voffB);
        PG8_WAIT_V(6); PG8_BAR;
    }
    for (;;) {
        const bool has_next = S.next(ui + 1, nxt);
        const char* nA = has_next ? (const char*)g.A + (size_t)nxt.pm * tA : cA; const char* nB = has_next ? (const char*)g.Bt + (size_t)nxt.pn * tB : cB;
        for (int t = 0; t < nt; t += 2) {
            const bool last = (t == nt - 2);
            const char* a1 = cA + (size_t)(t + 1) * kstep;
            const char* a2 = last ? nA : cA + (size_t)(t + 2) * kstep; const char* b2 = last ? nB : cB + (size_t)(t + 2) * kstep;
            const char* a3 = a2 + kstep; const char* b3 = b2 + kstep;
            if (last && has_next) S.a_ready(nxt);
            if constexpr (SP2) {
            PG8_LDB(B0, 0, 0); PG8_LDB(B1, 0, 1); PG8_SCHED; PG8_LDA(At, 0, 0); PG8_STAGE(PG8_SA(1, 1), a1 + hA, voffA);
            PG8_WAIT_V(8); PG8_WAIT_L(0); PG8_BAR; PG8_MMA(0, 0, At, B0); PG8_MMA(0, 1, At, B1); PG8_BAR; PG8_SCHED;
            PG8_LDA(At, 0, 1); PG8_STAGE(PG8_SB(0, 0), b2, voffB); PG8_STAGE(PG8_SB(0, 1), b2 + hB, voffB); PG8_STAGE(PG8_SA(0, 0), a2, voffA);
            PG8_WAIT_V(8); PG8_WAIT_L(0); PG8_BAR; PG8_MMA(1, 0, At, B0); PG8_MMA(1, 1, At, B1); PG8_BAR; PG8_SCHED;
            PG8_LDB(B0, 1, 0); PG8_LDB(B1, 1, 1); PG8_SCHED; PG8_LDA(At, 1, 0); PG8_STAGE(PG8_SA(0, 1), a2 + hA, voffA);
            PG8_WAIT_V(8); PG8_WAIT_L(0); PG8_BAR; PG8_MMA(0, 0, At, B0); PG8_MMA(0, 1, At, B1); PG8_BAR; PG8_SCHED;
            PG8_LDA(At, 1, 1); PG8_STAGE(PG8_SB(1, 0), b3, voffB); PG8_STAGE(PG8_SB(1, 1), b3 + hB, voffB); PG8_STAGE(PG8_SA(1, 0), a3, voffA);
            PG8_WAIT_V(8); PG8_WAIT_L(0); PG8_BAR; PG8_MMA(1, 0, At, B0); PG8_MMA(1, 1, At, B1); PG8_BAR; PG8_SCHED;
            } else {
            PG8_LDB(B0, 0, 0); PG8_SCHED; PG8_LDA(At, 0, 0); PG8_STAGE(PG8_SA(1, 1), a1 + hA, voffA);
            PG8_WAIT_L(8); PG8_BAR; PG8_WAIT_L(0); PG8_MMA(0, 0, At, B0); PG8_BAR; PG8_SCHED;
            PG8_LDB(B1, 0, 1); PG8_STAGE(PG8_SB(0, 0), b2, voffB);
            PG8_BAR; PG8_WAIT_L(0); PG8_MMA(0, 1, At, B1); PG8_BAR;
            PG8_LDA(At, 0, 1); PG8_STAGE(PG8_SA(0, 0), a2, voffA);
            PG8_BAR; PG8_WAIT_L(0); PG8_MMA(1, 0, At, B0); PG8_BAR; PG8_SCHED;
            PG8_STAGE(PG8_SB(0, 1), b2 + hB, voffB);
            PG8_WAIT_V(6); PG8_BAR; PG8_MMA(1, 1, At, B1); PG8_BAR;
            PG8_LDB(B0, 1, 0); PG8_SCHED; PG8_LDA(At, 1, 0); PG8_STAGE(PG8_SA(0, 1), a2 + hA, voffA);
            PG8_WAIT_L(8); PG8_BAR; PG8_WAIT_L(0); PG8_MMA(0, 0, At, B0); PG8_BAR; PG8_SCHED;
            PG8_LDB(B1, 1, 1); PG8_STAGE(PG8_SB(1, 0), b3, voffB);
            PG8_BAR; PG8_WAIT_L(0); PG8_MMA(0, 1, At, B1); PG8_BAR;
            PG8_LDA(At, 1, 1); PG8_STAGE(PG8_SA(1, 0), a3, voffA);
            PG8_BAR; PG8_WAIT_L(0); PG8_MMA(1, 0, At, B0); PG8_BAR; PG8_SCHED;
            PG8_STAGE(PG8_SB(1, 1), b3 + hB, voffB);
            PG8_WAIT_V(6); PG8_BAR; PG8_MMA(1, 1, At, B1); PG8_BAR;
            }
        }
        if constexpr (ALIGN_EPI) { if (wr == 0) PG8_BAR; }
        if constexpr (!Epi::AFTER_DRAIN) { E(acc, cur, wr, wc, fr, fq); S.done(cur); }
        if (!has_next) break;
#pragma unroll
        for (int a = 0; a < 2; ++a)
#pragma unroll
            for (int b = 0; b < 2; ++b)
#pragma unroll
                for (int m = 0; m < 4; ++m)
#pragma unroll
                    for (int n = 0; n < 2; ++n) acc[a][b][m][n] = (f32x4){0.f, 0.f, 0.f, 0.f};
        cur = nxt; cA = nA; cB = nB; ++ui;
        if constexpr (ALIGN_EPI) { if (wr == 1) PG8_BAR; }
    }
    PG8_WAIT_V(0);
    if constexpr (!ALIGN_EPI) { if (wr == 0) PG8_BAR; }
    PG8_BAR;
    if constexpr (Epi::AFTER_DRAIN) { E.fused(acc, cur, wr, wc, fr, fq, lds, wid, lane); S.done(cur); }
#undef PG8_SA
#undef PG8_SB
#undef PG8_STAGE
#undef PG8_LDA
#undef PG8_LDB
#undef PG8_MMA
#undef PG8_WAIT_V
#undef PG8_WAIT_L
#undef PG8_BAR
#undef PG8_SCHED
}
}

#ifndef ONE_LAUNCH
#define ONE_LAUNCH 0
#endif
constexpr int NWAVES = 8, NTHR = 512;
constexpr int D = 1024, BATCH = 4, SEQ = 8192, NMETA = 16, TT = SEQ + NMETA;
constexpr int NREAL = BATCH * SEQ;
constexpr int NROWS = NREAL + NMETA;
constexpr int R = 33024;
constexpr int PW = 2304;
constexpr int PC_CQ = 0, PC_CKV = 256, PC_KIDX = 384, PC_WIDX = 448, PC_R = 512, PC_K = 1024, PC_V = 1536, PC_WD = 2048, PC_AD = 2112, PC_GD = 2176;
constexpr int QAW = 1536;
constexpr int DFF = 2816, UPW = 5632;
constexpr int TOPK = 256;
constexpr float LN_EPS = 1e-5f, GN_EPS = 64e-5f, ALPHA = 1.18920711500272f;

constexpr size_t MiB = 1u << 20;
constexpr size_t WS_CTL = 0, CTL_ZERO_BYTES = 1 * MiB;
constexpr size_t WS_WT_IN = 1 * MiB, WS_WT_QA = 6 * MiB, WS_WT_MIX = 7 * MiB, WS_WT_UP = 10 * MiB, WS_WT_DN = 21 * MiB;
constexpr size_t WS_META1 = 27 * MiB, WS_NSEL = 28 * MiB, WS_WIDX = 29 * MiB;
constexpr size_t WS_H = 33 * MiB;
constexpr size_t WS_P = 98 * MiB, WS_QA = 244 * MiB, WS_CQN = 341 * MiB, WS_SEL = 341 * MiB, WS_CKV = 358 * MiB, WS_KIDX = 367 * MiB;
constexpr size_t WS_DEC = 372 * MiB, WS_AB = 437 * MiB, WS_GB = 470 * MiB;
constexpr size_t WS_WT_LORA = 26 * MiB + 512 * 1024;
constexpr size_t WS_RWM = 372 * MiB, WS_RWN = 405 * MiB, WS_RWQ = 438 * MiB, WS_RWY = 471 * MiB;
constexpr size_t OUT_RWS = 80 * MiB, OUT_BONUS = 116 * MiB;
constexpr size_t WS_G01 = 480 * MiB, WS_V01 = 484 * MiB, WS_GHALO = 488 * MiB, WS_GMETA = 492 * MiB;
constexpr size_t WS_UP = 98 * MiB;
constexpr size_t WS_END = 512 * MiB;
static_assert(WS_P + (size_t)R * PW * 2 <= WS_QA && WS_QA + (size_t)R * QAW * 2 <= WS_CQN && WS_CQN + (size_t)R * 256 * 2 <= WS_CKV && WS_CKV + (size_t)R * 128 * 2 <= WS_KIDX
              && WS_KIDX + (size_t)R * 64 * 2 <= WS_DEC && WS_DEC + (size_t)R * 512 * 4 <= WS_AB && WS_AB + (size_t)R * 512 * 2 <= WS_GB && WS_GB + (size_t)R * 512 * 2 <= WS_END
              && WS_UP + (size_t)R * UPW * 2 <= WS_END && WS_H + (size_t)R * D * 2 <= WS_P && WS_WIDX + (size_t)R * 8 * 4 <= WS_H && WS_NSEL + (size_t)R * 4 <= WS_WIDX, "ws map");
constexpr int CW_BAR = 4096;

constexpr int RING_OFF = 0, RING_BYTES = 131072;
constexpr int LDSCTL_OFF = RING_BYTES, MISC_OFF = LDSCTL_OFF + 320;
constexpr int LDS_BYTES = 147456;

#define GAS __attribute__((address_space(1)))
#define LAS __attribute__((address_space(3)))
typedef unsigned short bf16;
typedef unsigned v4u __attribute__((ext_vector_type(4)));
typedef unsigned v2u __attribute__((ext_vector_type(2)));
typedef float f32x4 __attribute__((ext_vector_type(4)));
typedef GAS unsigned gu32;
typedef __bf16 bf16x2_t __attribute__((ext_vector_type(2)));
__device__ __forceinline__ unsigned f2bf(float f) { return (unsigned)__builtin_bit_cast(unsigned short, (__bf16)f); }
__device__ __forceinline__ unsigned pk2(float lo, float hi) { const bf16x2_t v = {(__bf16)lo, (__bf16)hi}; return __builtin_bit_cast(unsigned, v); }
__device__ __forceinline__ float fast_rcp(float x) { return __builtin_amdgcn_rcpf(x); }
__device__ __forceinline__ float fast_tanh(float x) { return 1.0f - 2.0f * __builtin_amdgcn_rcpf(1.0f + __expf(2.0f * x)); }
__device__ __forceinline__ float bf2f(unsigned short b) { return __uint_as_float(((unsigned)b) << 16); }
__device__ __forceinline__ float bflo(unsigned w) { return __uint_as_float(w << 16); }
__device__ __forceinline__ float bfhi(unsigned w) { return __uint_as_float(w & 0xffff0000u); }
#define DPP_F(v, ctrl) __builtin_bit_cast(float, __builtin_amdgcn_update_dpp(0, __builtin_bit_cast(int, (v)), (ctrl), 0xf, 0xf, false))
__device__ __forceinline__ float rdlane_f(float v, int lane) { return __builtin_bit_cast(float, __builtin_amdgcn_readlane(__builtin_bit_cast(int, v), lane)); }
__device__ __forceinline__ float wave_sum(float v) {
    v += DPP_F(v, 0xB1); v += DPP_F(v, 0x4E); v += DPP_F(v, 0x141); v += DPP_F(v, 0x140);
    return (rdlane_f(v, 0) + rdlane_f(v, 16)) + (rdlane_f(v, 32) + rdlane_f(v, 48));
}
__device__ __forceinline__ float wave_max(float v) {
    v = fmaxf(v, DPP_F(v, 0xB1)); v = fmaxf(v, DPP_F(v, 0x4E)); v = fmaxf(v, DPP_F(v, 0x141)); v = fmaxf(v, DPP_F(v, 0x140));
    return fmaxf(fmaxf(rdlane_f(v, 0), rdlane_f(v, 16)), fmaxf(rdlane_f(v, 32), rdlane_f(v, 48)));
}
#define DPP_U0(v, ctrl) ((unsigned)__builtin_amdgcn_update_dpp(0, (int)(v), (ctrl), 0xf, 0xf, true))
__device__ __forceinline__ unsigned wave_scan_incl(unsigned v, int lane) {
    v += DPP_U0(v, 0x111); v += DPP_U0(v, 0x112); v += DPP_U0(v, 0x114); v += DPP_U0(v, 0x118);
    const unsigned r0 = (unsigned)__builtin_amdgcn_readlane((int)v, 15), r1 = (unsigned)__builtin_amdgcn_readlane((int)v, 31), r2 = (unsigned)__builtin_amdgcn_readlane((int)v, 47);
    const int row = lane >> 4;
    return v + (row >= 1 ? r0 : 0u) + (row >= 2 ? r1 : 0u) + (row >= 3 ? r2 : 0u);
}
__device__ __forceinline__ float sigmoidf_(float x) { return __builtin_amdgcn_rcpf(1.0f + __expf(-x)); }
#define XB_TMO      128
#define XB_XCNT(j)  (256  + 64 * (j))
#define XB_XSUB(j)  (1280 + 64 * (j))
#define XB_XGEN(j)  (2304 + 64 * (j))
#define XB_TOP      3328
#define XB_TOPGEN   3392
#define XCD_BAR_WORDS 3456
#define XB_SPIN_CAP (1u << 18)

__device__ __forceinline__ unsigned xb_ld(unsigned* p)              { return __hip_atomic_load(p, __ATOMIC_RELAXED, __HIP_MEMORY_SCOPE_AGENT); }
__device__ __forceinline__ unsigned xb_add(unsigned* p, unsigned v) { return __hip_atomic_fetch_add(p, v, __ATOMIC_RELAXED, __HIP_MEMORY_SCOPE_AGENT); }
__device__ __forceinline__ unsigned xb_xcc_id() { return (unsigned)__builtin_amdgcn_s_getreg((3 << 11) | 20) & 0xFu; }
#define XB_SPIN(cond, bar) do { unsigned _sp = 0; while (cond) { __builtin_amdgcn_s_sleep(1); \
    if ((++_sp & 255u) == 0u) { if (xb_ld(&(bar)[XB_TMO])) break; if (_sp > XB_SPIN_CAP) { atomicAdd(&(bar)[XB_TMO], 1u); break; } } } } while (0)

struct XcdBarrier {
    unsigned* bar; unsigned x;
    volatile LAS unsigned* st;
};

__device__ __forceinline__ XcdBarrier xcd_barrier_post(unsigned* bar, volatile LAS unsigned* st) {
    XcdBarrier b; b.bar = bar; b.x = xb_xcc_id(); b.st = st;
    if (threadIdx.x == 0) (void)xb_add(&bar[XB_XCNT(b.x)], 1u);
    return b;
}
__device__ __forceinline__ void xcd_barrier_complete(unsigned* bar, unsigned x, unsigned& nloc, unsigned& nx) {
    const unsigned G = gridDim.x * gridDim.y * gridDim.z;
    unsigned sum, cnt, mine, sp = 0u;
    for (;;) {
        sum = 0u; cnt = 0u; mine = 0u;
#pragma unroll
        for (unsigned j = 0; j < 16; ++j) { const unsigned c = xb_ld(&bar[XB_XCNT(j)]); sum += c; cnt += (c > 0u) ? 1u : 0u; mine = (j == x) ? c : mine; }
        if (sum == G) break;
        __builtin_amdgcn_s_sleep(1);
        if ((++sp & 255u) == 0u) { if (xb_ld(&bar[XB_TMO])) break; if (sp > XB_SPIN_CAP) { atomicAdd(&bar[XB_TMO], 1u); break; } }
    }
    nloc = mine > 0u ? mine : 1u; nx = cnt > 0u ? cnt : 1u;
}

__device__ __forceinline__ void xcd_barrier(const XcdBarrier& b) {
    asm volatile("s_waitcnt vmcnt(0)" ::: "memory");
    __syncthreads();
    if (threadIdx.x == 0) {
        unsigned* bar = b.bar;
        __builtin_amdgcn_s_waitcnt(0);
        unsigned nloc = b.st[0], nx = b.st[1];
        if (nloc == 0u) { xcd_barrier_complete(bar, b.x, nloc, nx); b.st[0] = nloc; b.st[1] = nx; }
        const unsigned old = xb_add(&bar[XB_XSUB(b.x)], 1u);
        const unsigned gen = old / nloc;
        if (old + 1u == (gen + 1u) * nloc) {
            __builtin_amdgcn_fence(__ATOMIC_RELEASE, "agent");
            asm volatile("s_waitcnt vmcnt(0)" ::: "memory");
            const unsigned og = xb_add(&bar[XB_TOP], 1u);
            const unsigned tg = og / nx;
            if (og + 1u == (tg + 1u) * nx) xb_add(&bar[XB_TOPGEN], 1u);
            else XB_SPIN(xb_ld(&bar[XB_TOPGEN]) == tg, bar);
            __builtin_amdgcn_fence(__ATOMIC_ACQUIRE, "agent");
            xb_add(&bar[XB_XGEN(b.x)], 1u);
            asm volatile("s_waitcnt vmcnt(0)" ::: "memory");
        } else {
            XB_SPIN(xb_ld(&bar[XB_XGEN(b.x)]) == gen, bar);
            __builtin_amdgcn_fence(__ATOMIC_ACQUIRE, "agent");
            asm volatile("s_waitcnt vmcnt(0)" ::: "memory");
        }
    }
    __syncthreads();
}

struct Frame {
    LAS unsigned char* lds;
    volatile LAS unsigned* MISC;
    gu32* ctl;
    int tid, lane, wave, G;
    const float* in[32];
    float* out;
    unsigned char* ws;
};
#define IN_X 0
#define IN_META 1
#define IN_LNIN_G 2
#define IN_LNIN_B 3
#define IN_W_IN 4
#define IN_QNORM_G 5
#define IN_W_UQ 6
#define IN_KVNORM_G 7
#define IN_W_UKV 8
#define IN_W_IQ 9
#define IN_IDXLN_G 10
#define IN_IDXLN_B 11
#define IN_MU 12
#define IN_W0 13
#define IN_W_DEC 14
#define IN_A0 15
#define IN_W_AAA 16
#define IN_W_GATE 17
#define IN_KK 18
#define IN_KA 19
#define IN_RK 20
#define IN_GN_G 21
#define IN_GN_B 22
#define IN_W_OUT 23
#define IN_LN1_G 24
#define IN_LN1_B 25
#define IN_W_UP 26
#define IN_CONV_W 27
#define IN_CONV_B 28
#define IN_W_DN 29
#define IN_LN2_G 30
#define IN_LN2_B 31

#define WSP(T, off) ((T*)(F.ws + (off)))

__device__ __forceinline__ int key_row(int b, int j) { return j < NMETA ? NREAL + j : b * SEQ + (j - NMETA); }

__device__ __forceinline__ int tr_col(int n, int mode, int cut0, int cut1, int shift) {
    if (mode == 1) { const int pn = n >> 8, x = n & 255; return x < 128 ? 128 * pn + x : DFF + 128 * pn + (x - 128); }
    return n < cut0 ? n : (n < cut1 ? -1 : n - shift);
}
struct TrJob { const float* src; int src_ld, src_r0; bf16* dst; int dst_ld, dst_c0, Nn, K, mode, cut0, cut1, shift; };
__device__ __forceinline__ void tr_item(const TrJob& j, int item, LAS float* scr, int lane) {
    const int nblk = j.Nn / 32, kb = item / nblk, nb = item % nblk, k0 = 64 * kb, n0 = 32 * nb;
    const int col = tr_col(n0 + (lane & 31), j.mode, j.cut0, j.cut1, j.shift);
    const float* sp = j.src + (size_t)(j.src_r0 + k0 + (lane >> 5)) * j.src_ld + (col >= 0 ? col : 0);
    float v[32];
#pragma unroll
    for (int i = 0; i < 32; ++i) v[i] = sp[(size_t)(2 * i) * j.src_ld];
#pragma unroll
    for (int i = 0; i < 32; ++i) scr[(2 * i + (lane >> 5)) * 33 + (lane & 31)] = col >= 0 ? v[i] : 0.f;
    asm volatile("s_waitcnt lgkmcnt(0)" ::: "memory");
    const int c = lane & 7;
#pragma unroll
    for (int q = 0; q < 4; ++q) { const int n = (lane >> 3) + 8 * q; const LAS float* t = scr + (8 * c) * 33 + n;
        *(v4u*)(j.dst + (size_t)(n0 + n) * j.dst_ld + j.dst_c0 + k0 + 8 * c) = (v4u){pk2(t[0], t[33]), pk2(t[66], t[99]), pk2(t[132], t[165]), pk2(t[198], t[231])}; }
    asm volatile("s_waitcnt lgkmcnt(0)" ::: "memory");
}
__device__ __forceinline__ void tr_job(Frame& F, const TrJob& j, int& base) {
    LAS float* scr = (LAS float*)(F.lds + F.wave * 8704);
    const int gw = blockIdx.x * NWAVES + F.wave, NGW = F.G * NWAVES, ni = (j.K / 64) * (j.Nn / 32);
    for (int it = ((gw - base) % NGW + NGW) % NGW; it < ni; it += NGW) tr_item(j, it, scr, F.lane);
    base = (base + ni) % NGW;
}
__device__ __forceinline__ void p0_weights(Frame& F) {
    bf16* WT_IN = WSP(bf16, WS_WT_IN); bf16* WT_QA = WSP(bf16, WS_WT_QA); bf16* WT_MIX = WSP(bf16, WS_WT_MIX); bf16* WT_UP = WSP(bf16, WS_WT_UP); bf16* WT_DN = WSP(bf16, WS_WT_DN);
    bf16* WdT = WSP(bf16, WS_WT_LORA);
    int base = 0;
    tr_job(F, TrJob{F.in[IN_W_UP], UPW, 0, WT_UP, D, 0, UPW, D, 1, 0, 0, 0}, base);
    tr_job(F, TrJob{F.in[IN_W_DN], D, 0, WT_DN, DFF, 0, D, DFF, 0, D, D, 0}, base);
    tr_job(F, TrJob{F.in[IN_W_IN], 2248, 0, WT_IN, D, 0, PW, D, 0, 456, 512, 56}, base);
    tr_job(F, TrJob{F.in[IN_W_OUT], D, 512, WT_MIX, 1536, 1024, D, 512, 0, D, D, 0}, base);
    tr_job(F, TrJob{F.in[IN_W_IQ], 512, 0, WT_QA + (size_t)1024 * 256, 256, 0, 512, 256, 0, 512, 512, 0}, base);
    tr_job(F, TrJob{F.in[IN_W_GATE], 512, 0, WdT + 2 * 512 * 64, 128, 0, 512, 128, 0, 512, 512, 0}, base);
    tr_job(F, TrJob{F.in[IN_W_DEC], 512, 0, WdT, 64, 0, 512, 64, 0, 512, 512, 0}, base);
    tr_job(F, TrJob{F.in[IN_W_AAA], 512, 0, WdT + 512 * 64, 64, 0, 512, 64, 0, 512, 512, 0}, base);
    const float* w_uq = F.in[IN_W_UQ]; const float* w_ukv = F.in[IN_W_UKV]; const float* w_out = F.in[IN_W_OUT];
    for (int it = blockIdx.x * NTHR + F.tid; it < 256 * 8 * 8; it += F.G * NTHR) {
        const int c = it & 255, hb = __builtin_amdgcn_readfirstlane(it >> 8), h = hb >> 3, j0 = (hb & 7) * 16;
        float acc[16];
#pragma unroll
        for (int jj = 0; jj < 16; ++jj) acc[jj] = 0.f;
        for (int d = 0; d < 64; ++d) {
            const float a = w_uq[(size_t)c * 512 + h * 64 + d];
#pragma unroll
            for (int jj = 0; jj < 16; ++jj) acc[jj] += a * w_ukv[(size_t)(j0 + jj) * 1024 + h * 128 + d];
        }
#pragma unroll
        for (int jj = 0; jj < 16; ++jj) WT_QA[(size_t)(h * 128 + j0 + jj) * 256 + c] = (bf16)f2bf(0.125f * acc[jj]);
    }
    for (int it = blockIdx.x * NTHR + F.tid; it < 1024 * 8 * 8; it += F.G * NTHR) {
        const int n = it & 1023, hb = __builtin_amdgcn_readfirstlane(it >> 10), h = hb >> 3, j0 = (hb & 7) * 16;
        float acc[16];
#pragma unroll
        for (int jj = 0; jj < 16; ++jj) acc[jj] = 0.f;
        for (int d = 0; d < 64; ++d) {
            const float a = w_out[(size_t)(h * 64 + d) * D + n];
#pragma unroll
            for (int jj = 0; jj < 16; ++jj) acc[jj] += a * w_ukv[(size_t)(j0 + jj) * 1024 + h * 128 + 64 + d];
        }
        v4u o0, o1;
        o0.x = pk2(acc[0], acc[1]); o0.y = pk2(acc[2], acc[3]); o0.z = pk2(acc[4], acc[5]); o0.w = pk2(acc[6], acc[7]);
        o1.x = pk2(acc[8], acc[9]); o1.y = pk2(acc[10], acc[11]); o1.z = pk2(acc[12], acc[13]); o1.w = pk2(acc[14], acc[15]);
        *(v4u*)(WT_MIX + (size_t)n * 1536 + h * 128 + j0) = o0; *(v4u*)(WT_MIX + (size_t)n * 1536 + h * 128 + j0 + 8) = o1;
    }
}

__device__ __forceinline__ void ln_row_bf16(Frame& F, const float* src, const float* g, const float* b, bf16* dst) {
    v2u* o8 = (v2u*)dst + F.lane;
    if (!src) {
#pragma unroll
        for (int j = 0; j < 4; ++j) o8[64 * j] = (v2u){0u, 0u};
        return;
    }
    const f32x4* xr = (const f32x4*)src + F.lane;
    f32x4 v[4]; float s = 0.f;
#pragma unroll
    for (int j = 0; j < 4; ++j) { v[j] = xr[64 * j]; s += (v[j].x + v[j].y) + (v[j].z + v[j].w); }
    const float mean = wave_sum(s) * (1.f / D); float s2 = 0.f;
#pragma unroll
    for (int j = 0; j < 4; ++j) { v[j] = v[j] - mean; s2 += (v[j].x * v[j].x + v[j].y * v[j].y) + (v[j].z * v[j].z + v[j].w * v[j].w); }
    const float rstd = 1.f / sqrtf(wave_sum(s2) * (1.f / D) + LN_EPS);
#pragma unroll
    for (int j = 0; j < 4; ++j) {
        const f32x4 gg = ((const f32x4*)g)[F.lane + 64 * j], bb = ((const f32x4*)b)[F.lane + 64 * j];
        const f32x4 y = v[j] * rstd * gg + bb;
        o8[64 * j] = (v2u){pk2(y.x, y.y), pk2(y.z, y.w)};
    }
}
__device__ __forceinline__ void p1_ln_in(Frame& F) {
    bf16* H0 = WSP(bf16, WS_H);
    const int gw = blockIdx.x * NWAVES + F.wave, NGW = F.G * NWAVES;
    const f32x4* gp = (const f32x4*)F.in[IN_LNIN_G] + F.lane; const f32x4* bp = (const f32x4*)F.in[IN_LNIN_B] + F.lane;
    f32x4 gg[4], bb[4];
#pragma unroll
    for (int j = 0; j < 4; ++j) { gg[j] = gp[64 * j]; bb[j] = bp[64 * j]; }
    for (int r0 = gw * 4; r0 < NROWS; r0 += NGW * 4) {
        f32x4 v[4][4];
#pragma unroll
        for (int q = 0; q < 4; ++q) {
            const int r = r0 + q < NROWS ? r0 + q : NROWS - 1;
            const f32x4* xr = (const f32x4*)(r < NREAL ? F.in[IN_X] + (size_t)r * D : F.in[IN_META] + (size_t)(r - NREAL) * D) + F.lane;
#pragma unroll
            for (int j = 0; j < 4; ++j) v[q][j] = xr[64 * j];
        }
#pragma unroll
        for (int q = 0; q < 4; ++q) {
            float s = 0.f;
#pragma unroll
            for (int j = 0; j < 4; ++j) s += (v[q][j].x + v[q][j].y) + (v[q][j].z + v[q][j].w);
            const float mean = wave_sum(s) * (1.f / D); float s2 = 0.f;
#pragma unroll
            for (int j = 0; j < 4; ++j) { v[q][j] = v[q][j] - mean; s2 += (v[q][j].x * v[q][j].x + v[q][j].y * v[q][j].y) + (v[q][j].z * v[q][j].z + v[q][j].w * v[q][j].w); }
            const float rstd = 1.f / sqrtf(wave_sum(s2) * (1.f / D) + LN_EPS);
            if (r0 + q < NROWS) {
                v2u* o8 = (v2u*)(H0 + (size_t)(r0 + q) * D) + F.lane;
#pragma unroll
                for (int j = 0; j < 4; ++j) { const f32x4 y = v[q][j] * rstd * gg[j] + bb[j]; o8[64 * j] = (v2u){pk2(y.x, y.y), pk2(y.z, y.w)}; }
            }
        }
    }
}

__device__ __forceinline__ void p3_prep(Frame& F) {
    const bf16* P = WSP(bf16, WS_P); bf16* CQN = WSP(bf16, WS_CQN); bf16* CKV = WSP(bf16, WS_CKV); bf16* KIDX = WSP(bf16, WS_KIDX); float* WIDX = WSP(float, WS_WIDX);
    const int gw = blockIdx.x * NWAVES + F.wave, NGW = F.G * NWAVES, l = F.lane;
    for (int r = gw; r < R; r += NGW) {
        const bf16* pr = P + (size_t)r * PW;
        if (r >= NROWS) {
            *(v2u*)(CQN + (size_t)r * 256 + 4 * l) = (v2u){0u, 0u};
            continue;
        }
        {
            const v2u w = *(const v2u*)(pr + PC_CQ + 4 * l);
            const float a0 = bflo(w.x), a1 = bfhi(w.x), a2 = bflo(w.y), a3 = bfhi(w.y);
            const float ss = wave_sum(a0 * a0 + a1 * a1 + a2 * a2 + a3 * a3);
            const float rs = 1.0f / sqrtf(ss * (1.f / 256.f) + 1e-6f);
            const f32x4 g = ((const f32x4*)F.in[IN_QNORM_G])[l];
            *(v2u*)(CQN + (size_t)r * 256 + 4 * l) = (v2u){pk2(a0 * rs * g.x, a1 * rs * g.y), pk2(a2 * rs * g.z, a3 * rs * g.w)};
        }
        {
            const unsigned w = *(const unsigned*)(pr + PC_CKV + 2 * l);
            const float a0 = bflo(w), a1 = bfhi(w);
            const float ss = wave_sum(a0 * a0 + a1 * a1);
            const float rs = 1.0f / sqrtf(ss * (1.f / 128.f) + 1e-6f);
            const float g0 = F.in[IN_KVNORM_G][2 * l], g1 = F.in[IN_KVNORM_G][2 * l + 1];
            *(unsigned*)(CKV + (size_t)r * 128 + 2 * l) = pk2(a0 * rs * g0, a1 * rs * g1);
        }
        {
            const float a = bf2f(pr[PC_KIDX + l]);
            const float mean = wave_sum(a) * (1.f / 64.f);
            const float dlt = a - mean;
            const float var = wave_sum(dlt * dlt) * (1.f / 64.f);
            const float y = dlt * (1.0f / sqrtf(var + LN_EPS)) * F.in[IN_IDXLN_G][l] + F.in[IN_IDXLN_B][l];
            KIDX[(size_t)r * 64 + l] = (bf16)f2bf(y);
        }
        if (l < 8) WIDX[(size_t)r * 8 + l] = bf2f(pr[PC_WIDX + l]) * 0.04419417382415922f;
    }
}

#ifndef REFSEL
#define REFSEL 0
#endif
__device__ __forceinline__ void refsel_rows(Frame& F) {
    float* QIDX32 = F.out; float* KIDX32 = F.out + (size_t)R * 512; float* WIDX = WSP(float, WS_WIDX);
    const float* w_in = F.in[IN_W_IN]; const float* w_iq = F.in[IN_W_IQ];
    LAS float* hrow = (LAS float*)(F.lds + F.wave * 8192);
    LAS float* cqn = hrow + 1024;
    const int l = F.lane;
    const int gw = blockIdx.x * NWAVES + F.wave, NGW = F.G * NWAVES;
    for (int r = gw; r < NROWS; r += NGW) {
        const float* src = r < NREAL ? F.in[IN_X] + (size_t)r * D : F.in[IN_META] + (size_t)(r - NREAL) * D;
        {
            const f32x4* xr = (const f32x4*)src + l;
            f32x4 v[4]; float s = 0.f;
#pragma unroll
            for (int j = 0; j < 4; ++j) { v[j] = xr[64 * j]; s += (v[j].x + v[j].y) + (v[j].z + v[j].w); }
            const float mean = wave_sum(s) * (1.f / D); float s2 = 0.f;
#pragma unroll
            for (int j = 0; j < 4; ++j) { v[j] = v[j] - mean; s2 += (v[j].x * v[j].x + v[j].y * v[j].y) + (v[j].z * v[j].z + v[j].w * v[j].w); }
            const float rstd = 1.f / sqrtf(wave_sum(s2) * (1.f / D) + LN_EPS);
#pragma unroll
            for (int j = 0; j < 4; ++j) {
                const f32x4 gg = ((const f32x4*)F.in[IN_LNIN_G])[l + 64 * j], bb = ((const f32x4*)F.in[IN_LNIN_B])[l + 64 * j];
                *(LAS f32x4*)(hrow + 4 * (l + 64 * j)) = v[j] * rstd * gg + bb;
            }
        }
        __builtin_amdgcn_wave_barrier();
        float a[6];
#pragma unroll
        for (int i = 0; i < 6; ++i) a[i] = 0.f;
        for (int k = 0; k < D; ++k) {
            const float hk = hrow[k]; const float* wr = w_in + (size_t)k * 2248;
#pragma unroll
            for (int i = 0; i < 4; ++i) a[i] += hk * wr[l + 64 * i];
            a[4] += hk * wr[384 + l];
            a[5] += hk * wr[448 + (l & 7)];
        }
        const float ss = wave_sum(a[0] * a[0] + a[1] * a[1] + a[2] * a[2] + a[3] * a[3]);
        const float rs = 1.0f / sqrtf(ss * (1.f / 256.f) + 1e-6f);
#pragma unroll
        for (int i = 0; i < 4; ++i) cqn[l + 64 * i] = a[i] * rs * F.in[IN_QNORM_G][l + 64 * i];
        {
            const float mean = wave_sum(a[4]) * (1.f / 64.f); const float dlt = a[4] - mean;
            const float var = wave_sum(dlt * dlt) * (1.f / 64.f);
            KIDX32[(size_t)r * 64 + l] = dlt * (1.0f / sqrtf(var + LN_EPS)) * F.in[IN_IDXLN_G][l] + F.in[IN_IDXLN_B][l];
        }
        if (l < 8) WIDX[(size_t)r * 8 + l] = a[5] * 0.04419417382415922f;
        __builtin_amdgcn_wave_barrier();
        float q[8];
#pragma unroll
        for (int i = 0; i < 8; ++i) q[i] = 0.f;
        for (int c = 0; c < 256; ++c) {
            const float cq = cqn[c]; const float* wr = w_iq + (size_t)c * 512;
#pragma unroll
            for (int i = 0; i < 8; ++i) q[i] += cq * wr[l + 64 * i];
        }
#pragma unroll
        for (int i = 0; i < 8; ++i) QIDX32[(size_t)r * 512 + l + 64 * i] = q[i];
        __builtin_amdgcn_wave_barrier();
    }
}

__device__ __forceinline__ unsigned sortable(float f) { const unsigned u = __float_as_uint(f); return (u & 0x80000000u) ? ~u : (u | 0x80000000u); }
__device__ __forceinline__ void p5_index_naive(Frame& F) {
    const bf16* QA = WSP(bf16, WS_QA); const bf16* KIDX = WSP(bf16, WS_KIDX); const float* WIDX = WSP(float, WS_WIDX);
    unsigned short* SEL = WSP(unsigned short, WS_SEL); int* NSEL = WSP(int, WS_NSEL);
    LAS float* sc = (LAS float*)(F.lds);
    LAS float* qf = (LAS float*)(F.lds + 33024);
    LAS unsigned* hist = (LAS unsigned*)(F.lds + 33024 + 2048);
    LAS unsigned* cw = hist + 256;
    const int tid = F.tid;
    for (int q = blockIdx.x; q < NROWS; q += F.G) {
        int b, pos; if (q < NREAL) { b = q >> 13; pos = NMETA + (q & (SEQ - 1)); } else { b = 0; pos = q - NREAL; }
        const int nvis = pos < NMETA ? NMETA : NMETA + 64 * ((pos - NMETA) / 64 + 1);
#if REFSEL
        qf[tid] = F.out[(size_t)q * 512 + tid];
#else
        qf[tid] = bf2f(QA[(size_t)q * QAW + 1024 + tid]);
#endif
        float w[8];
#pragma unroll
        for (int h = 0; h < 8; ++h) w[h] = WIDX[(size_t)q * 8 + h];
        __syncthreads();
        for (int j = tid; j < nvis; j += NTHR) {
            const v4u* kp = (const v4u*)(KIDX + (size_t)key_row(b, j) * 64);
#if REFSEL
            const f32x4* kp32 = (const f32x4*)(F.out + (size_t)R * 512 + (size_t)key_row(b, j) * 64);
#endif
            float d[8];
#pragma unroll
            for (int h = 0; h < 8; ++h) d[h] = 0.f;
#pragma unroll 2
            for (int c = 0; c < 8; ++c) {
#if REFSEL
                const f32x4 ta = kp32[2 * c], tb = kp32[2 * c + 1];
                const float k0 = ta.x, k1 = ta.y, k2 = ta.z, k3 = ta.w, k4 = tb.x, k5 = tb.y, k6 = tb.z, k7 = tb.w;
#else
                const v4u t = kp[c];
                const float k0 = bflo(t.x), k1 = bfhi(t.x), k2 = bflo(t.y), k3 = bfhi(t.y), k4 = bflo(t.z), k5 = bfhi(t.z), k6 = bflo(t.w), k7 = bfhi(t.w);
#endif
#pragma unroll
                for (int h = 0; h < 8; ++h) {
                    const f32x4 qa = *(const LAS f32x4*)(qf + h * 64 + 8 * c), qb = *(const LAS f32x4*)(qf + h * 64 + 8 * c + 4);
                    d[h] += qa.x * k0 + qa.y * k1 + qa.z * k2 + qa.w * k3 + qb.x * k4 + qb.y * k5 + qb.z * k6 + qb.w * k7;
                }
            }
            float s = 0.f;
#pragma unroll
            for (int h = 0; h < 8; ++h) s += w[h] * fmaxf(d[h], 0.f);
            sc[j] = s + 0.0f;
        }
        __syncthreads();
        unsigned short* selq = SEL + (size_t)q * TOPK;
        if (nvis <= TOPK) {
            for (int j = tid; j < nvis; j += NTHR) selq[j] = (unsigned short)j;
        } else {
            unsigned prefix = 0u, mask = 0u, need = TOPK;
            for (int pass = 0; pass < 4; ++pass) {
                const int shift = 24 - 8 * pass;
                if (tid < 256) hist[tid] = 0u;
                __syncthreads();
                for (int j = tid; j < nvis; j += NTHR) { const unsigned key = sortable(sc[j]); if ((key & mask) == prefix) atomicAdd((unsigned*)&hist[(key >> shift) & 255u], 1u); }
                __syncthreads();
                if (tid < 256) {
                    unsigned above = 0u; for (int bb = tid + 1; bb < 256; ++bb) above += hist[bb];
                    const unsigned c = hist[tid];
                    if (above < need && need <= above + c) { cw[0] = prefix | ((unsigned)tid << shift); cw[1] = need - above; }
                }
                __syncthreads();
                prefix = cw[0]; need = cw[1]; mask |= 0xFFu << shift;
                __syncthreads();
            }
            if (tid == 0) cw[2] = 0u;
            __syncthreads();
            for (int j = tid; j < nvis; j += NTHR) { if (sortable(sc[j]) > prefix) { const unsigned p = atomicAdd((unsigned*)&cw[2], 1u); selq[p] = (unsigned short)j; } }
            __syncthreads();
            if (F.wave == 0) {
                const unsigned base = cw[2]; unsigned taken = 0u;
                for (int j0 = 0; j0 < nvis && taken < need; j0 += 64) {
                    const int j = j0 + F.lane; const bool eq = j < nvis && sortable(sc[j]) == prefix;
                    const unsigned long long m = __ballot(eq);
                    const unsigned rank = (unsigned)__popcll(m & ((1ull << F.lane) - 1ull));
                    if (eq && taken + rank < need) selq[base + taken + rank] = (unsigned short)j;
                    taken += (unsigned)__popcll(m);
                }
            }
        }
        if (tid == 0) NSEL[q] = nvis < TOPK ? nvis : TOPK;
        __syncthreads();
    }
}

__device__ __forceinline__ void p6_attn_naive(Frame& F) {
    bf16* QA = WSP(bf16, WS_QA); const bf16* CKV = WSP(bf16, WS_CKV); const unsigned short* SEL = WSP(unsigned short, WS_SEL); const int* NSEL = WSP(int, WS_NSEL);
    LAS float* qf = (LAS float*)(F.lds + F.wave * 16384);
    LAS float* ps = qf + 1024;
    LAS int* srow = (LAS int*)(ps + 2048);
    const int l = F.lane;
    const int gw = blockIdx.x * NWAVES + F.wave, NGW = F.G * NWAVES;
    for (int q = gw; q < R; q += NGW) {
        bf16* qrow = QA + (size_t)q * QAW;
        if (q >= NROWS) {
            for (int c = l; c < QAW / 8; c += 64) *(v4u*)(qrow + 8 * c) = (v4u){0u, 0u, 0u, 0u};
            continue;
        }
        int b, pos; if (q < NREAL) { b = q >> 13; pos = NMETA + (q & (SEQ - 1)); } else { b = 0; pos = q - NREAL; }
        const int nsel = NSEL[q];
        {
            const v4u t0 = *(const v4u*)(qrow + 16 * l), t1 = *(const v4u*)(qrow + 16 * l + 8);
            LAS float* d = qf + 16 * l;
            d[0] = bflo(t0.x); d[1] = bfhi(t0.x); d[2] = bflo(t0.y); d[3] = bfhi(t0.y); d[4] = bflo(t0.z); d[5] = bfhi(t0.z); d[6] = bflo(t0.w); d[7] = bfhi(t0.w);
            d[8] = bflo(t1.x); d[9] = bfhi(t1.x); d[10] = bflo(t1.y); d[11] = bfhi(t1.y); d[12] = bflo(t1.z); d[13] = bfhi(t1.z); d[14] = bflo(t1.w); d[15] = bfhi(t1.w);
        }
        __builtin_amdgcn_wave_barrier();
        for (int kk = 0; kk < 4; ++kk) {
            const int s = kk * 64 + l; const bool valid = s < nsel;
            const int j = valid ? (int)SEL[(size_t)q * TOPK + s] : 0;
            const int row = key_row(b, j);
            srow[s] = row;
            float acc[8];
#pragma unroll
            for (int h = 0; h < 8; ++h) acc[h] = 0.f;
            const v4u* kp = (const v4u*)(CKV + (size_t)row * 128);
            for (int c8 = 0; c8 < 16; ++c8) {
                const v4u t = kp[c8];
                const float k0 = bflo(t.x), k1 = bfhi(t.x), k2 = bflo(t.y), k3 = bfhi(t.y), k4 = bflo(t.z), k5 = bfhi(t.z), k6 = bflo(t.w), k7 = bfhi(t.w);
#pragma unroll
                for (int h = 0; h < 8; ++h) {
                    const f32x4 qa = *(const LAS f32x4*)(qf + h * 128 + 8 * c8), qb = *(const LAS f32x4*)(qf + h * 128 + 8 * c8 + 4);
                    acc[h] += qa.x * k0 + qa.y * k1 + qa.z * k2 + qa.w * k3 + qb.x * k4 + qb.y * k5 + qb.z * k6 + qb.w * k7;
                }
            }
            const float dist = fabsf((float)(pos - j));
#pragma unroll
            for (int h = 0; h < 8; ++h) { const float slope = __uint_as_float((unsigned)(127 - (h + 1)) << 23); ps[s * 8 + h] = valid ? acc[h] - slope * dist : -INFINITY; }
        }
        __builtin_amdgcn_wave_barrier();
#pragma unroll
        for (int h = 0; h < 8; ++h) {
            float v0 = ps[(l) * 8 + h], v1 = ps[(l + 64) * 8 + h], v2 = ps[(l + 128) * 8 + h], v3 = ps[(l + 192) * 8 + h];
            const float mx = wave_max(fmaxf(fmaxf(v0, v1), fmaxf(v2, v3)));
            v0 = __expf(v0 - mx); v1 = __expf(v1 - mx); v2 = __expf(v2 - mx); v3 = __expf(v3 - mx);
            const float inv = 1.0f / wave_sum((v0 + v1) + (v2 + v3));
            ps[(l) * 8 + h] = v0 * inv; ps[(l + 64) * 8 + h] = v1 * inv; ps[(l + 128) * 8 + h] = v2 * inv; ps[(l + 192) * 8 + h] = v3 * inv;
        }
        __builtin_amdgcn_wave_barrier();
        float o0[8], o1[8];
#pragma unroll
        for (int h = 0; h < 8; ++h) { o0[h] = 0.f; o1[h] = 0.f; }
        for (int s = 0; s < nsel; ++s) {
            const int row = srow[s];
            const unsigned w = *(const unsigned*)(CKV + (size_t)row * 128 + 2 * l);
            const float c0 = bflo(w), c1 = bfhi(w);
            const f32x4 pa = *(const LAS f32x4*)(ps + s * 8), pb = *(const LAS f32x4*)(ps + s * 8 + 4);
            o0[0] += pa.x * c0; o1[0] += pa.x * c1; o0[1] += pa.y * c0; o1[1] += pa.y * c1; o0[2] += pa.z * c0; o1[2] += pa.z * c1; o0[3] += pa.w * c0; o1[3] += pa.w * c1;
            o0[4] += pb.x * c0; o1[4] += pb.x * c1; o0[5] += pb.y * c0; o1[5] += pb.y * c1; o0[6] += pb.z * c0; o1[6] += pb.z * c1; o0[7] += pb.w * c0; o1[7] += pb.w * c1;
        }
#pragma unroll
        for (int h = 0; h < 8; ++h) *(unsigned*)(qrow + h * 128 + 2 * l) = pk2(o0[h], o1[h]);
        __builtin_amdgcn_wave_barrier();
    }
}

__device__ __forceinline__ void p7_rwkv_prep_naive(Frame& F) {
    const bf16* P = WSP(bf16, WS_P); float* DEC = WSP(float, WS_DEC); bf16* AB = WSP(bf16, WS_AB); bf16* GB = WSP(bf16, WS_GB);
    const float* mu = F.in[IN_MU]; const float* Wd = F.in[IN_W_DEC]; const float* Wa = F.in[IN_W_AAA]; const float* Wg = F.in[IN_W_GATE];
    const int l = F.lane;
    const int gw = blockIdx.x * NWAVES + F.wave, NGW = F.G * NWAVES;
    for (int r = gw; r < NROWS; r += NGW) {
        int prev; if (r < NREAL) { prev = (r & (SEQ - 1)) ? r - 1 : NREAL + NMETA - 1; } else { prev = r > NREAL ? r - 1 : -1; }
        const bf16* pr = P + (size_t)r * PW; const bf16* pp = prev >= 0 ? P + (size_t)prev * PW : nullptr;
#define SHIFTED(pc, mc) (bf2f(pr[pc]) + ((pp ? bf2f(pp[pc]) : 0.f) - bf2f(pr[pc])) * mu[mc])
        const float tw = tanhf(SHIFTED(PC_WD + l, 1536 + l));
        const float ta = SHIFTED(PC_AD + l, 1600 + l);
        const float tg0 = sigmoidf_(SHIFTED(PC_GD + l, 1664 + l)), tg1 = sigmoidf_(SHIFTED(PC_GD + 64 + l, 1728 + l));
#undef SHIFTED
        float aw[8], aa[8], ag[8];
#pragma unroll
        for (int i = 0; i < 8; ++i) { aw[i] = F.in[IN_W0][l + 64 * i]; aa[i] = F.in[IN_A0][l + 64 * i]; ag[i] = 0.f; }
        for (int j = 0; j < 64; ++j) {
            const float xw = __shfl(tw, j), xa = __shfl(ta, j), xg0 = __shfl(tg0, j), xg1 = __shfl(tg1, j);
#pragma unroll
            for (int i = 0; i < 8; ++i) {
                aw[i] += xw * Wd[(size_t)j * 512 + l + 64 * i];
                aa[i] += xa * Wa[(size_t)j * 512 + l + 64 * i];
                ag[i] += xg0 * Wg[(size_t)j * 512 + l + 64 * i] + xg1 * Wg[(size_t)(j + 64) * 512 + l + 64 * i];
            }
        }
#pragma unroll
        for (int i = 0; i < 8; ++i) {
            const float x = -aw[i];
            const float sp = x > 20.f ? x : log1pf(__expf(x));
            const float wlog = -sp - 0.5f;
            DEC[(size_t)r * 512 + l + 64 * i] = __expf(-__expf(wlog));
            AB[(size_t)r * 512 + l + 64 * i] = (bf16)f2bf(sigmoidf_(aa[i]));
            GB[(size_t)r * 512 + l + 64 * i] = (bf16)f2bf(ag[i]);
        }
    }
}

__device__ __forceinline__ void p8_rwkv_scan_naive(Frame& F) {
    if (F.wave != 0 || blockIdx.x >= 32) return;
    const bf16* P = WSP(bf16, WS_P); const float* DEC = WSP(float, WS_DEC); const bf16* AB = WSP(bf16, WS_AB); const bf16* GB = WSP(bf16, WS_GB); bf16* QA = WSP(bf16, WS_QA);
    const int b = blockIdx.x >> 3, h = blockIdx.x & 7, l = F.lane, ch = h * 64 + l;
    LAS float* vec = (LAS float*)F.lds;
    const float mu_r = F.in[IN_MU][ch], mu_k = F.in[IN_MU][512 + ch], mu_v = F.in[IN_MU][1024 + ch];
    const float kk_c = F.in[IN_KK][ch], ka_c = F.in[IN_KA][ch], rk_c = F.in[IN_RK][ch], gng = F.in[IN_GN_G][ch], gnb = F.in[IN_GN_B][ch];
    float S[64];
#pragma unroll
    for (int k = 0; k < 64; ++k) S[k] = 0.f;
    float pr_p = 0.f, pk_p = 0.f, pv_p = 0.f;
    int row = key_row(b, 0);
    float n_pr = bf2f(P[(size_t)row * PW + PC_R + ch]), n_pk = bf2f(P[(size_t)row * PW + PC_K + ch]), n_pv = bf2f(P[(size_t)row * PW + PC_V + ch]);
    float n_w = DEC[(size_t)row * 512 + ch], n_a = bf2f(AB[(size_t)row * 512 + ch]), n_g = bf2f(GB[(size_t)row * 512 + ch]);
    for (int pos = 0; pos < TT; ++pos) {
        const int crow = row;
        const float c_pr = n_pr, c_pk = n_pk, c_pv = n_pv, c_w = n_w, c_a = n_a, c_g = n_g;
        if (pos + 1 < TT) {
            row = key_row(b, pos + 1);
            n_pr = bf2f(P[(size_t)row * PW + PC_R + ch]); n_pk = bf2f(P[(size_t)row * PW + PC_K + ch]); n_pv = bf2f(P[(size_t)row * PW + PC_V + ch]);
            n_w = DEC[(size_t)row * 512 + ch]; n_a = bf2f(AB[(size_t)row * 512 + ch]); n_g = bf2f(GB[(size_t)row * 512 + ch]);
        }
        const float r_s = c_pr + (pr_p - c_pr) * mu_r, k_s = c_pk + (pk_p - c_pk) * mu_k, v_s = c_pv + (pv_p - c_pv) * mu_v;
        pr_p = c_pr; pk_p = c_pk; pv_p = c_pv;
        const float kkr = k_s * kk_c;
        const float nrm = sqrtf(wave_sum(kkr * kkr));
        const float kk = kkr / fmaxf(nrm, 1e-12f);
        const float k2 = k_s * (1.f + (c_a - 1.f) * ka_c);
        vec[l] = -kk; vec[64 + l] = kk * c_a; vec[128 + l] = c_w; vec[192 + l] = k2; vec[256 + l] = r_s;
        __builtin_amdgcn_wave_barrier();
        float sa = 0.f;
#pragma unroll
        for (int k4 = 0; k4 < 16; ++k4) { const f32x4 a = *(const LAS f32x4*)(vec + 4 * k4); sa += S[4 * k4] * a.x + S[4 * k4 + 1] * a.y + S[4 * k4 + 2] * a.z + S[4 * k4 + 3] * a.w; }
        float y = 0.f;
#pragma unroll
        for (int k4 = 0; k4 < 16; ++k4) {
            const f32x4 bv = *(const LAS f32x4*)(vec + 64 + 4 * k4), w = *(const LAS f32x4*)(vec + 128 + 4 * k4), kv = *(const LAS f32x4*)(vec + 192 + 4 * k4), rv = *(const LAS f32x4*)(vec + 256 + 4 * k4);
            S[4 * k4] = S[4 * k4] * w.x + sa * bv.x + v_s * kv.x; S[4 * k4 + 1] = S[4 * k4 + 1] * w.y + sa * bv.y + v_s * kv.y;
            S[4 * k4 + 2] = S[4 * k4 + 2] * w.z + sa * bv.z + v_s * kv.z; S[4 * k4 + 3] = S[4 * k4 + 3] * w.w + sa * bv.w + v_s * kv.w;
            y += S[4 * k4] * rv.x + S[4 * k4 + 1] * rv.y + S[4 * k4 + 2] * rv.z + S[4 * k4 + 3] * rv.w;
        }
        __builtin_amdgcn_wave_barrier();
        const float mean = wave_sum(y) * (1.f / 64.f);
        const float dlt = y - mean;
        const float var = wave_sum(dlt * dlt) * (1.f / 64.f);
        const float yn = dlt * (1.0f / sqrtf(var + GN_EPS)) * gng + gnb;
        const float bonus = wave_sum(r_s * k2 * rk_c) * v_s;
        const float o = (yn + bonus) * c_g;
        if (pos >= NMETA || b == 0) QA[(size_t)crow * QAW + 1024 + ch] = (bf16)f2bf(o);
    }
}

template <bool OUT_BF16>
__device__ __forceinline__ void ln_rows4(Frame& F, int nrows, const float* g, const float* b, bf16* dstb) {
    const int gw = blockIdx.x * NWAVES + F.wave, NGW = F.G * NWAVES;
    const float* META1 = WSP(float, WS_META1);
    f32x4 gg[4], bb[4];
#pragma unroll
    for (int j = 0; j < 4; ++j) { gg[j] = ((const f32x4*)g)[F.lane + 64 * j]; bb[j] = ((const f32x4*)b)[F.lane + 64 * j]; }
    for (int r0 = gw * 4; r0 < nrows; r0 += NGW * 4) {
        f32x4 v[4][4];
#pragma unroll
        for (int q = 0; q < 4; ++q) {
            const int r = r0 + q < nrows ? r0 + q : nrows - 1;
            const f32x4* xr = (const f32x4*)(r < NREAL ? F.out + (size_t)r * D : META1 + (size_t)(r - NREAL) * D) + F.lane;
#pragma unroll
            for (int j = 0; j < 4; ++j) v[q][j] = xr[64 * j];
        }
#pragma unroll
        for (int q = 0; q < 4; ++q) {
            float s = 0.f;
#pragma unroll
            for (int j = 0; j < 4; ++j) s += (v[q][j].x + v[q][j].y) + (v[q][j].z + v[q][j].w);
            const float mean = wave_sum(s) * (1.f / D); float s2 = 0.f;
#pragma unroll
            for (int j = 0; j < 4; ++j) { v[q][j] = v[q][j] - mean; s2 += (v[q][j].x * v[q][j].x + v[q][j].y * v[q][j].y) + (v[q][j].z * v[q][j].z + v[q][j].w * v[q][j].w); }
            const float rstd = 1.f / sqrtf(wave_sum(s2) * (1.f / D) + LN_EPS);
            if (r0 + q < nrows) {
                if (OUT_BF16) { v2u* o8 = (v2u*)(dstb + (size_t)(r0 + q) * D) + F.lane;
#pragma unroll
                    for (int j = 0; j < 4; ++j) { const f32x4 y = v[q][j] * rstd * gg[j] + bb[j]; o8[64 * j] = (v2u){pk2(y.x, y.y), pk2(y.z, y.w)}; }
                } else { f32x4* o = (f32x4*)(F.out + (size_t)(r0 + q) * D) + F.lane;
#pragma unroll
                    for (int j = 0; j < 4; ++j) o[64 * j] = v[q][j] * rstd * gg[j] + bb[j]; }
            }
        }
    }
}
__device__ __forceinline__ void p10_ln1(Frame& F) { ln_rows4<true>(F, NROWS, F.in[IN_LN1_G], F.in[IN_LN1_B], WSP(bf16, WS_H)); }
__device__ __forceinline__ void p14_ln2(Frame& F) { ln_rows4<false>(F, NREAL, F.in[IN_LN2_G], F.in[IN_LN2_B], nullptr); }

__device__ __forceinline__ float gelu_fast(float x) {
    const float u2 = x * (1.5957691216057308f + 0.07135481627260025f * x * x);
    return x * __builtin_amdgcn_rcpf(1.0f + __builtin_amdgcn_exp2f(-1.4426950408889634f * u2));
}
__device__ __forceinline__ void p12_conv_fix(Frame& F) {
    bf16* ACT = WSP(bf16, WS_UP); const float* cw = F.in[IN_CONV_W]; const float* cb = F.in[IN_CONV_B];
    const float* G01 = WSP(float, WS_G01); const float* V01 = WSP(float, WS_V01); const float* GHALO = WSP(float, WS_GHALO); const float* GMETA = WSP(float, WS_GMETA);
    for (int it = blockIdx.x * NTHR + F.tid; it < 128 * 2 * DFF; it += F.G * NTHR) {
        const int j = it % DFF, rr = (it / DFF) & 1, pm = it / (2 * DFF);
        const float* ph = (pm & 31) ? GHALO + (size_t)(pm - 1) * 2 * DFF : GMETA;
        const float g0 = G01[((size_t)pm * 2 + rr) * DFF + j];
        const float g1 = rr ? G01[((size_t)pm * 2) * DFF + j] : ph[DFF + j];
        const float g2 = rr ? ph[DFF + j] : ph[j];
        const float x = cw[j] * g2 + cw[DFF + j] * g1 + cw[2 * DFF + j] * g0 + cb[j];
        ACT[(size_t)(pm * 256 + rr) * DFF + j] = (bf16)f2bf(gelu_fast(x) * V01[((size_t)pm * 2 + rr) * DFF + j]);
    }
}


constexpr int NUNITS = 4096 + 8;
constexpr int RP = 72;
constexpr int SLOT = 64 * RP * 2;
constexpr int FP = 68;
typedef short bf16x8 __attribute__((ext_vector_type(8)));
typedef float f32x16 __attribute__((ext_vector_type(16)));
constexpr size_t RW_MAT = (size_t)NUNITS * 4096;

__device__ __forceinline__ void quad_mma(f32x16& acc, const LAS bf16* Aop, const LAS bf16* Bop, int qr, int qc, int lane) {
    const int r = lane & 31, hf = lane >> 5;
    const LAS bf16* ap = Aop + (32 * qr + r) * RP + 8 * hf; const LAS bf16* bp = Bop + (32 * qc + r) * RP + 8 * hf;
#pragma unroll
    for (int ks = 0; ks < 4; ++ks) {
        const bf16x8 a = *(const LAS bf16x8*)(ap + 16 * ks), b = *(const LAS bf16x8*)(bp + 16 * ks);
        acc = __builtin_amdgcn_mfma_f32_32x32x16_bf16(a, b, acc, 0, 0, 0);
    }
}
#define ACC_M(qr, j, hf) (32 * (qr) + ((j) & 3) + 8 * ((j) >> 2) + 4 * (hf))
__device__ __forceinline__ void store_T(const f32x16& acc, LAS bf16* Z, int qr, int qc, int lane) {
    const int r = lane & 31, hf = lane >> 5;
#pragma unroll
    for (int jj = 0; jj < 4; ++jj)
        *(LAS v2u*)(Z + (32 * qc + r) * RP + 32 * qr + 8 * jj + 4 * hf) = (v2u){pk2(acc[4 * jj], acc[4 * jj + 1]), pk2(acc[4 * jj + 2], acc[4 * jj + 3])};
}
__device__ __forceinline__ void add_T(f32x16& acc, const LAS bf16* Z, int qr, int qc, int lane) {
    const int r = lane & 31, hf = lane >> 5;
#pragma unroll
    for (int jj = 0; jj < 4; ++jj) {
        const v2u w = *(const LAS v2u*)(Z + (32 * qc + r) * RP + 32 * qr + 8 * jj + 4 * hf);
        acc[4 * jj] += bflo(w.x); acc[4 * jj + 1] += bfhi(w.x); acc[4 * jj + 2] += bflo(w.y); acc[4 * jj + 3] += bfhi(w.y);
    }
}
__device__ __forceinline__ void store_T_global(const f32x16& acc, bf16* Z, int qr, int qc, int lane) {
    const int r = lane & 31, hf = lane >> 5;
#pragma unroll
    for (int jj = 0; jj < 4; ++jj)
        *(v2u*)(Z + (32 * qc + r) * 64 + 32 * qr + 8 * jj + 4 * hf) = (v2u){pk2(acc[4 * jj], acc[4 * jj + 1]), pk2(acc[4 * jj + 2], acc[4 * jj + 3])};
}
__device__ __forceinline__ f32x16 zero16() { f32x16 z;
#pragma unroll
    for (int j = 0; j < 16; ++j) z[j] = 0.f;
    return z; }

__device__ __forceinline__ void b1_load_raw(const bf16* P, int u, int w, int l, unsigned short (&rv)[45]) {
    const bool meta = u >= 4096;
    int b = 0, h, c = 0; if (meta) h = u - 4096; else { b = u >> 10; h = (u >> 7) & 7; c = u & 127; }
    const int ch = h * 64 + l, row0 = meta ? NREAL : b * SEQ + c * 64, t0 = 8 * w;
    int prow = -1;
    if (t0 > 0) prow = row0 + t0 - 1; else if (!meta) prow = (c == 0) ? NREAL + NMETA - 1 : row0 - 1;
#pragma unroll
    for (int i = 0; i < 9; ++i) {
        const int t = t0 - 1 + i;
        const int row = i == 0 ? prow : ((!meta || t < NMETA) ? row0 + t : -1);
        const bf16* pp = P + (size_t)(row >= 0 ? row : 0) * PW;
        const unsigned short a0 = pp[PC_R + ch], a1 = pp[PC_K + ch], a2 = pp[PC_V + ch], a3 = pp[PC_WD + l], a4 = pp[PC_AD + l];
        const bool ok = row >= 0;
        rv[5 * i] = ok ? a0 : (unsigned short)0; rv[5 * i + 1] = ok ? a1 : (unsigned short)0; rv[5 * i + 2] = ok ? a2 : (unsigned short)0; rv[5 * i + 3] = ok ? a3 : (unsigned short)0; rv[5 * i + 4] = ok ? a4 : (unsigned short)0;
    }
}

#ifdef PROBE_B1SEC
#define B1T(k) do { if (blockIdx.x == 0 && F.tid == 0) { const unsigned long long t_ = __builtin_amdgcn_s_memrealtime(); if ((k) == PROBE_B1SEC + 1) b1acc += t_ - b1t0; b1t0 = t_; } } while (0)
#else
#define B1T(k) do {} while (0)
#endif
__device__ __forceinline__ void rw_b1(Frame& F) {
    const bf16* P = WSP(bf16, WS_P);
    bf16* RWM = WSP(bf16, WS_RWM); bf16* RWN = WSP(bf16, WS_RWN); bf16* RWQ = WSP(bf16, WS_RWQ); bf16* RWY = WSP(bf16, WS_RWY);
    float* BONUS = (float*)((char*)F.out + OUT_BONUS);
    const bf16* WdT = WSP(bf16, WS_WT_LORA); const bf16* WaT = WdT + 512 * 64;
    const float* mu = F.in[IN_MU];
    const int w = F.wave, l = F.lane, tid = F.tid;
    LAS unsigned char* L = F.lds;
#define SL(s) ((LAS bf16*)(L + (s) * SLOT))
    LAS float* WL = (LAS float*)(L + 12 * SLOT);
    LAS float* AL = (LAS float*)(L + 0 * SLOT);
    LAS float* OT = (LAS float*)(L + RING_BYTES + 1024);
    LAS float* GL = OT + 512;
    unsigned long long b1acc = 0ull, b1t0 = 0ull; (void)b1acc; (void)b1t0;
    unsigned short rnx[45];
    b1_load_raw(P, (int)blockIdx.x < NUNITS ? (int)blockIdx.x : 0, w, l, rnx);
    for (int u = blockIdx.x; u < NUNITS; u += F.G) {
        const bool meta = u >= 4096;
        int b = 0, h, c = 0; if (meta) h = u - 4096; else { b = u >> 10; h = (u >> 7) & 7; c = u & 127; }
        const int ch = h * 64 + l;
        const int row0 = meta ? NREAL : b * SEQ + c * 64;
        __syncthreads();
        B1T(0);
        float r_s[8], k_s[8], v_s[8], xw[8], xa[8];
        {
            const int t0 = 8 * w;
            unsigned short rc[45];
#pragma unroll
            for (int i = 0; i < 45; ++i) rc[i] = rnx[i];
            float pr = bf2f(rc[0]), pk = bf2f(rc[1]), pv = bf2f(rc[2]), pw = bf2f(rc[3]), pa = bf2f(rc[4]);
            const float mr = mu[ch], mk = mu[512 + ch], mv = mu[1024 + ch], mw = mu[1536 + l], ma = mu[1600 + l];
#pragma unroll
            for (int i = 0; i < 8; ++i) {
                const int t = t0 + i; const bool valid = !meta || t < NMETA;
                const float cr = bf2f(rc[5 * i + 5]), ck = bf2f(rc[5 * i + 6]), cv = bf2f(rc[5 * i + 7]), cw = bf2f(rc[5 * i + 8]), ca = bf2f(rc[5 * i + 9]);
                r_s[i] = valid ? cr + (pr - cr) * mr : 0.f; k_s[i] = valid ? ck + (pk - ck) * mk : 0.f; v_s[i] = valid ? cv + (pv - cv) * mv : 0.f;
                xw[i] = fast_tanh(cw + (pw - cw) * mw); xa[i] = ca + (pa - ca) * ma;
                pr = cr; pk = ck; pv = cv; pw = cw; pa = ca;
            }
#pragma unroll
            for (int i = 0; i < 8; ++i) { SL(8)[(t0 + i) * RP + l] = (bf16)f2bf(xw[i]); SL(9)[(t0 + i) * RP + l] = (bf16)f2bf(xa[i]); }
            {
                const int k = tid >> 3, pc = tid & 7;
                *(LAS v4u*)(SL(10) + k * RP + 8 * pc) = *(const v4u*)(WdT + (size_t)(h * 64 + k) * 64 + 8 * pc);
                *(LAS v4u*)(SL(11) + k * RP + 8 * pc) = *(const v4u*)(WaT + (size_t)(h * 64 + k) * 64 + 8 * pc);
            }
        }
        __syncthreads();
        B1T(1);
        {
            const int pid = w >> 2, q = w & 3, qr = q >> 1, qc = q & 1;
            f32x16 acc = zero16();
            quad_mma(acc, SL(10 + pid), SL(8 + pid), qr, qc, l);
            LAS float* Zf = pid ? AL : WL;
            const int r = l & 31, hf = l >> 5;
#pragma unroll
            for (int jj = 0; jj < 4; ++jj) *(LAS f32x4*)(Zf + (32 * qc + r) * FP + 32 * qr + 8 * jj + 4 * hf) = (f32x4){acc[4 * jj], acc[4 * jj + 1], acc[4 * jj + 2], acc[4 * jj + 3]};
        }
        __syncthreads();
        B1T(2);
        float lw[8], asg[8];
        {
            const float w0c = F.in[IN_W0][ch], a0c = F.in[IN_A0][ch];
            float run = 0.f;
#pragma unroll
            for (int i = 0; i < 8; ++i) {
                const int t = 8 * w + i; const bool valid = !meta || t < NMETA;
                const float x = -(WL[t * FP + l] + w0c);
                const float sp = x > 20.f ? x : __logf(1.0f + __expf(x));
                const float e = -__expf(-sp - 0.5f);
                run += valid ? e : 0.f; lw[i] = run;
                asg[i] = sigmoidf_(AL[t * FP + l] + a0c);
            }
            OT[w * 64 + l] = run;
        }
        __syncthreads();
        {
            float off = 0.f, tot = 0.f;
#pragma unroll
            for (int ww = 0; ww < 8; ++ww) { const float o = OT[ww * 64 + l]; tot += o; off += ww < w ? o : 0.f; }
            if (w == 0) GL[l] = __expf(tot);
            const float kkc = F.in[IN_KK][ch], kac = F.in[IN_KA][ch], rkc = F.in[IN_RK][ch];
            unsigned atc[4], vc[4], bhc[4], khc[4];
            float prevlg = off;
#pragma unroll
            for (int i = 0; i < 8; ++i) {
                const int t = 8 * w + i;
                const float lg = off + lw[i];
                const float g = __expf(lg), gp = __expf(prevlg), gi = __expf(-lg), gh = __expf(tot - lg);
                prevlg = lg;
                const float kkr = k_s[i] * kkc;
                const float kk = kkr * __builtin_amdgcn_rsqf(fmaxf(wave_sum(kkr * kkr), 1e-24f));
                const float k2 = k_s[i] * (1.f + (asg[i] - 1.f) * kac);
                const float bon = wave_sum(r_s[i] * k2 * rkc);
                if (l == 0) BONUS[(size_t)u * 64 + t] = bon;
                const float at = -kk * gp, rt = r_s[i] * g, bt = kk * asg[i] * gi, kt = k2 * gi, bh = kk * asg[i] * gh, kh = k2 * gh;
                SL(0)[t * RP + l] = (bf16)f2bf(at); SL(1)[t * RP + l] = (bf16)f2bf(rt); SL(2)[t * RP + l] = (bf16)f2bf(bt); SL(3)[t * RP + l] = (bf16)f2bf(kt);
                const unsigned ua = f2bf(at), uv = f2bf(v_s[i]), ub = f2bf(bh), uk = f2bf(kh);
                if (i & 1) { atc[i >> 1] |= ua << 16; vc[i >> 1] |= uv << 16; bhc[i >> 1] |= ub << 16; khc[i >> 1] |= uk << 16; }
                else { atc[i >> 1] = ua; vc[i >> 1] = uv; bhc[i >> 1] = ub; khc[i >> 1] = uk; }
            }
            *(LAS v4u*)(SL(4) + l * RP + 8 * w) = (v4u){atc[0], atc[1], atc[2], atc[3]};
            *(LAS v4u*)(SL(5) + l * RP + 8 * w) = (v4u){vc[0], vc[1], vc[2], vc[3]};
            *(LAS v4u*)(SL(6) + l * RP + 8 * w) = (v4u){bhc[0], bhc[1], bhc[2], bhc[3]};
            *(LAS v4u*)(SL(7) + l * RP + 8 * w) = (v4u){khc[0], khc[1], khc[2], khc[3]};
        }
        __syncthreads();
        B1T(3);
        for (int task = w; task < 20; task += 8) {
            const int pid = task >> 2, q = task & 3, qr = q >> 1, qc = q & 1;
            const int bop = pid == 0 ? 0 : pid == 1 ? 2 : pid == 2 ? 0 : 1;
            const int aop = pid == 0 ? 2 : pid == 1 ? 0 : pid == 2 ? 3 : pid == 3 ? 2 : 3;
            f32x16 acc = zero16();
            quad_mma(acc, SL(aop), SL(bop), qr, qc, l);
            const int n = 32 * qc + (l & 31), hf = l >> 5;
#pragma unroll
            for (int j = 0; j < 16; ++j) {
                const int m = ACC_M(qr, j, hf);
                const bool keep = pid == 1 ? (m > n) : (pid <= 2 ? (n > m) : (n >= m));
                acc[j] = keep ? acc[j] : 0.f;
            }
            store_T(acc, SL(8 + pid), qr, qc, l);
        }
        __syncthreads();
        B1T(4);
        const int nq = w & 3, nqr = nq >> 1, nqc = nq & 1;
        f32x16 nacc = zero16();
        if (w < 4) { add_T(nacc, SL(8), nqr, nqc, l); }
        for (int task = w; task < 12; task += 8) {
            const int pid = task >> 2, q = task & 3, qr = q >> 1, qc = q & 1;
            f32x16 acc = zero16();
            if (pid == 0) { quad_mma(acc, SL(9), SL(8), qr, qc, l); store_T(acc, SL(0), qr, qc, l); }
            else if (pid == 1) { quad_mma(acc, SL(8), SL(9), qr, qc, l); store_T(acc, SL(2), qr, qc, l); }
            else { quad_mma(acc, SL(10), SL(5), qr, qc, l); store_T(acc, SL(3), qr, qc, l); }
        }
        __syncthreads();
#pragma unroll
        for (int st = 0; st < 4; ++st) {
            const int pr = (st & 1) ? 10 : 0, pc = (st & 1) ? 13 : 2, pr2 = (st & 1) ? 0 : 10, pc2 = (st & 1) ? 2 : 13, nr = (st & 1) ? 9 : 8, nr2 = (st & 1) ? 8 : 9;
            if (w < 4) {
                add_T(nacc, SL(pr), nqr, nqc, l);
                quad_mma(nacc, SL(pc), SL(nr), nqr, nqc, l);
                store_T(nacc, SL(nr2), nqr, nqc, l);
                f32x16 acc = zero16();
                quad_mma(acc, SL(pc), SL(pr), nqr, nqc, l); store_T(acc, SL(pr2), nqr, nqc, l);
            } else {
                f32x16 acc = zero16();
                quad_mma(acc, SL(pr), SL(pc), nqr, nqc, l); store_T(acc, SL(pc2), nqr, nqc, l);
            }
            __syncthreads();
        }
        if (w < 4) { add_T(nacc, SL(0), nqr, nqc, l); quad_mma(nacc, SL(2), SL(8), nqr, nqc, l); store_T(nacc, SL(9), nqr, nqc, l); }
        __syncthreads();
        B1T(5);
        b1_load_raw(P, u + F.G < NUNITS ? u + F.G : u, w, l, rnx);
        {
            const int pid = w >> 2;
            f32x16 acc = zero16();
            add_T(acc, SL(pid ? 3 : 4), nqr, nqc, l);
            quad_mma(acc, SL(9), SL(pid ? 3 : 4), nqr, nqc, l);
            store_T(acc, SL(pid ? 2 : 0), nqr, nqc, l);
        }
        __syncthreads();
        for (int task = w; task < 16; task += 8) {
            const int pid = task >> 2, q = task & 3, qr = q >> 1, qc = q & 1;
            f32x16 acc = zero16();
            if (pid == 0) { add_T(acc, SL(1), qr, qc, l); quad_mma(acc, SL(0), SL(11), qr, qc, l); store_T_global(acc, RWQ + (size_t)u * 4096, qr, qc, l); }
            else if (pid == 1) { quad_mma(acc, SL(2), SL(11), qr, qc, l); quad_mma(acc, SL(5), SL(12), qr, qc, l); store_T_global(acc, RWY + (size_t)u * 4096, qr, qc, l); }
            else if (pid == 2) {
                quad_mma(acc, SL(0), SL(6), qr, qc, l);
                const int n = 32 * qc + (l & 31), hf = l >> 5; const float gl = GL[n];
#pragma unroll
                for (int j = 0; j < 16; ++j) acc[j] += (ACC_M(qr, j, hf) == n) ? gl : 0.f;
                store_T_global(acc, RWM + (size_t)u * 4096, qr, qc, l);
            } else { quad_mma(acc, SL(6), SL(2), qr, qc, l); quad_mma(acc, SL(7), SL(5), qr, qc, l); store_T_global(acc, RWN + (size_t)u * 4096, qr, qc, l); }
        }
        B1T(6);
    }
#ifdef PROBE_B1SEC
    if (blockIdx.x == 0 && F.tid == 0) { F.MISC[20] = (unsigned)b1acc; }
#endif
#undef SL
}

__device__ __forceinline__ void rw_b2(Frame& F) {
    if (blockIdx.x >= 32) return;
    const bf16* RWM = WSP(bf16, WS_RWM); const bf16* RWN = WSP(bf16, WS_RWN);
    bf16* RWS = (bf16*)((char*)F.out + OUT_RWS);
    const int b = blockIdx.x >> 3, h = blockIdx.x & 7, w = F.wave, l = F.lane;
    LAS unsigned char* L = F.lds;
#define SS(buf, part) ((LAS bf16*)(L + ((buf) * 2 + (part)) * SLOT))
    const int q = w & 3, qr = q >> 1, qc = q & 1, r = l & 31, hf = l >> 5;
    if (w < 4) {
        const bf16* Nm = RWN + (size_t)(4096 + h) * 4096;
#pragma unroll
        for (int jj = 0; jj < 4; ++jj) {
            const v2u wv = *(const v2u*)(Nm + (32 * qc + r) * 64 + 32 * qr + 8 * jj + 4 * hf);
            *(LAS v2u*)(SS(0, 0) + (32 * qc + r) * RP + 32 * qr + 8 * jj + 4 * hf) = wv;
            *(LAS v2u*)(SS(0, 1) + (32 * qc + r) * RP + 32 * qr + 8 * jj + 4 * hf) = (v2u){0u, 0u};
        }
    }
    __syncthreads();
    bf16x8 a_cur[4]; v2u n_cur[4];
    {
        const size_t u0 = (size_t)(b * 8 + h) * 128;
#pragma unroll
        for (int ks = 0; ks < 4; ++ks) a_cur[ks] = *(const bf16x8*)(RWM + u0 * 4096 + (32 * qr + r) * 64 + 8 * hf + 16 * ks);
#pragma unroll
        for (int jj = 0; jj < 4; ++jj) n_cur[jj] = *(const v2u*)(RWN + u0 * 4096 + (32 * qc + r) * 64 + 32 * qr + 8 * jj + 4 * hf);
    }
    for (int c = 0; c < 128; ++c) {
        const int u = (b * 8 + h) * 128 + c, cur = c & 1;
        if (w < 4) {
            bf16x8 a_nxt[4]; v2u n_nxt[4];
            const size_t un = (size_t)(c + 1 < 128 ? u + 1 : u);
#pragma unroll
            for (int ks = 0; ks < 4; ++ks) a_nxt[ks] = *(const bf16x8*)(RWM + un * 4096 + (32 * qr + r) * 64 + 8 * hf + 16 * ks);
#pragma unroll
            for (int jj = 0; jj < 4; ++jj) n_nxt[jj] = *(const v2u*)(RWN + un * 4096 + (32 * qc + r) * 64 + 32 * qr + 8 * jj + 4 * hf);
            f32x16 acc;
#pragma unroll
            for (int jj = 0; jj < 4; ++jj) { acc[4 * jj] = bflo(n_cur[jj].x); acc[4 * jj + 1] = bfhi(n_cur[jj].x); acc[4 * jj + 2] = bflo(n_cur[jj].y); acc[4 * jj + 3] = bfhi(n_cur[jj].y); }
#pragma unroll
            for (int jj = 0; jj < 4; ++jj)
                *(v2u*)(RWS + (size_t)u * 4096 + (32 * qc + r) * 64 + 32 * qr + 8 * jj + 4 * hf) = *(const LAS v2u*)(SS(cur, 0) + (32 * qc + r) * RP + 32 * qr + 8 * jj + 4 * hf);
            const LAS bf16* bh = SS(cur, 0) + (32 * qc + r) * RP + 8 * hf; const LAS bf16* bl = SS(cur, 1) + (32 * qc + r) * RP + 8 * hf;
#pragma unroll
            for (int ks = 0; ks < 4; ++ks) {
                acc = __builtin_amdgcn_mfma_f32_32x32x16_bf16(a_cur[ks], *(const LAS bf16x8*)(bh + 16 * ks), acc, 0, 0, 0);
                acc = __builtin_amdgcn_mfma_f32_32x32x16_bf16(a_cur[ks], *(const LAS bf16x8*)(bl + 16 * ks), acc, 0, 0, 0);
            }
#pragma unroll
            for (int jj = 0; jj < 4; ++jj) {
                float hi[4], lo[4];
#pragma unroll
                for (int e = 0; e < 4; ++e) { const unsigned hb = f2bf(acc[4 * jj + e]); hi[e] = __uint_as_float(hb << 16); lo[e] = acc[4 * jj + e] - hi[e]; }
                *(LAS v2u*)(SS(cur ^ 1, 0) + (32 * qc + r) * RP + 32 * qr + 8 * jj + 4 * hf) = (v2u){pk2(hi[0], hi[1]), pk2(hi[2], hi[3])};
                *(LAS v2u*)(SS(cur ^ 1, 1) + (32 * qc + r) * RP + 32 * qr + 8 * jj + 4 * hf) = (v2u){pk2(lo[0], lo[1]), pk2(lo[2], lo[3])};
            }
#pragma unroll
            for (int ks = 0; ks < 4; ++ks) a_cur[ks] = a_nxt[ks];
#pragma unroll
            for (int jj = 0; jj < 4; ++jj) n_cur[jj] = n_nxt[jj];
        }
        __syncthreads();
    }
#undef SS
}

__device__ __forceinline__ void rw_b3(Frame& F) {
    const bf16* P = WSP(bf16, WS_P); bf16* QA = WSP(bf16, WS_QA);
    const bf16* RWQ = WSP(bf16, WS_RWQ); const bf16* RWY = WSP(bf16, WS_RWY);
    const bf16* RWS = (const bf16*)((const char*)F.out + OUT_RWS); const float* BONUS = (const float*)((const char*)F.out + OUT_BONUS);
    const bf16* WgT = WSP(bf16, WS_WT_LORA) + 2 * 512 * 64;
    const float* mu = F.in[IN_MU];
    const int l = F.lane, r = l & 31, hf = l >> 5;
    const int gw = blockIdx.x * NWAVES + F.wave, NGW = F.G * NWAVES;
    for (int it = gw; it < NUNITS * 2; it += NGW) {
        const int u = it >> 1, th = it & 1;
        const bool meta = u >= 4096;
        int b = 0, h, c = 0; if (meta) h = u - 4096; else { b = u >> 10; h = (u >> 7) & 7; c = u & 127; }
        if (meta && th == 1) continue;
        const int t = 32 * th + r;
        const bool valid = !meta || t < NMETA;
        const int row0 = meta ? NREAL : b * SEQ + c * 64;
        const int row = valid ? row0 + t : row0;
        int prow = -1;
        if (t > 0) prow = row - 1; else if (!meta) prow = (c == 0) ? NREAL + NMETA - 1 : row - 1;
        f32x16 y[2];
#pragma unroll
        for (int qv = 0; qv < 2; ++qv) {
            const bf16* Y0 = RWY + (size_t)u * 4096 + (32 * th + r) * 64 + 32 * qv + 4 * hf;
#pragma unroll
            for (int jj = 0; jj < 4; ++jj) { const v2u wv = *(const v2u*)(Y0 + 8 * jj); y[qv][4 * jj] = bflo(wv.x); y[qv][4 * jj + 1] = bfhi(wv.x); y[qv][4 * jj + 2] = bflo(wv.y); y[qv][4 * jj + 3] = bfhi(wv.y); }
        }
        if (!meta) {
            const bf16* qp = RWQ + (size_t)u * 4096 + (32 * th + r) * 64 + 8 * hf;
            const bf16* sp = RWS + (size_t)u * 4096 + r * 64 + 8 * hf;
#pragma unroll
            for (int ks = 0; ks < 4; ++ks) {
                const bf16x8 bq = *(const bf16x8*)(qp + 16 * ks);
                y[0] = __builtin_amdgcn_mfma_f32_32x32x16_bf16(*(const bf16x8*)(sp + 16 * ks), bq, y[0], 0, 0, 0);
                y[1] = __builtin_amdgcn_mfma_f32_32x32x16_bf16(*(const bf16x8*)(sp + 32 * 64 + 16 * ks), bq, y[1], 0, 0, 0);
            }
        }
        f32x16 g[2]; g[0] = zero16(); g[1] = zero16();
        {
            const bf16* gp = P + (size_t)row * PW + PC_GD + 8 * hf; const bf16* gpp = prow >= 0 ? P + (size_t)prow * PW + PC_GD + 8 * hf : nullptr;
            const bf16* wp = WgT + (size_t)(h * 64 + r) * 128 + 8 * hf;
#pragma unroll
            for (int ks = 0; ks < 8; ++ks) {
                const v4u cg = *(const v4u*)(gp + 16 * ks); const v4u pg = gpp ? *(const v4u*)(gpp + 16 * ks) : (v4u){0u, 0u, 0u, 0u};
                const f32x4 m0 = *(const f32x4*)(mu + 1664 + 16 * ks + 8 * hf), m1 = *(const f32x4*)(mu + 1664 + 16 * ks + 8 * hf + 4);
                const unsigned cw[4] = {cg.x, cg.y, cg.z, cg.w}, pw[4] = {pg.x, pg.y, pg.z, pg.w}; const float mm[8] = {m0.x, m0.y, m0.z, m0.w, m1.x, m1.y, m1.z, m1.w};
                unsigned o[4];
#pragma unroll
                for (int e = 0; e < 4; ++e) {
                    const float c0 = bflo(cw[e]), c1 = bfhi(cw[e]), p0 = bflo(pw[e]), p1 = bfhi(pw[e]);
                    o[e] = pk2(sigmoidf_(c0 + (p0 - c0) * mm[2 * e]), sigmoidf_(c1 + (p1 - c1) * mm[2 * e + 1]));
                }
                const v4u ov = (v4u){o[0], o[1], o[2], o[3]};
                const bf16x8 bs = __builtin_bit_cast(bf16x8, ov);
                g[0] = __builtin_amdgcn_mfma_f32_32x32x16_bf16(*(const bf16x8*)(wp + 16 * ks), bs, g[0], 0, 0, 0);
                g[1] = __builtin_amdgcn_mfma_f32_32x32x16_bf16(*(const bf16x8*)(wp + 32 * 128 + 16 * ks), bs, g[1], 0, 0, 0);
            }
        }
        float s = 0.f;
#pragma unroll
        for (int j = 0; j < 16; ++j) s += y[0][j] + y[1][j];
        s += __shfl_xor(s, 32);
        const float mean = s * (1.f / 64.f);
        float s2 = 0.f;
#pragma unroll
        for (int j = 0; j < 16; ++j) { const float d0 = y[0][j] - mean, d1 = y[1][j] - mean; s2 += d0 * d0 + d1 * d1; }
        s2 += __shfl_xor(s2, 32);
        const float rstd = 1.0f / sqrtf(s2 * (1.f / 64.f) + GN_EPS);
        const float bon = BONUS[(size_t)u * 64 + t];
        if (valid) {
#pragma unroll
            for (int qv = 0; qv < 2; ++qv)
#pragma unroll
                for (int jj = 0; jj < 4; ++jj) {
                    const int v0 = 32 * qv + 8 * jj + 4 * hf, chv = h * 64 + v0;
                    const v2u cvw = *(const v2u*)(P + (size_t)row * PW + PC_V + chv); const v2u pvw = prow >= 0 ? *(const v2u*)(P + (size_t)prow * PW + PC_V + chv) : (v2u){0u, 0u};
                    const f32x4 mv = *(const f32x4*)(mu + 1024 + chv), gg = *(const f32x4*)(F.in[IN_GN_G] + chv), gb = *(const f32x4*)(F.in[IN_GN_B] + chv);
                    const float cv[4] = {bflo(cvw.x), bfhi(cvw.x), bflo(cvw.y), bfhi(cvw.y)}, pv[4] = {bflo(pvw.x), bfhi(pvw.x), bflo(pvw.y), bfhi(pvw.y)};
                    const float mvv[4] = {mv.x, mv.y, mv.z, mv.w}, ggv[4] = {gg.x, gg.y, gg.z, gg.w}, gbv[4] = {gb.x, gb.y, gb.z, gb.w};
                    float o[4];
#pragma unroll
                    for (int e = 0; e < 4; ++e) {
                        const float vs = cv[e] + (pv[e] - cv[e]) * mvv[e];
                        o[e] = ((y[qv][4 * jj + e] - mean) * rstd * ggv[e] + gbv[e] + bon * vs) * g[qv][4 * jj + e];
                    }
                    *(v2u*)(QA + (size_t)row * QAW + 1024 + chv) = (v2u){pk2(o[0], o[1]), pk2(o[2], o[3])};
                }
        }
    }
}

constexpr int IX_CAP = 512, IX_LIST = 3072, IX_KB = 98304, IX_SCR = RING_BYTES + 4096;
#define IX_FENCE() asm volatile("s_waitcnt lgkmcnt(0)" ::: "memory")

__device__ __forceinline__ unsigned ix_mbcnt(unsigned long long m) { return __builtin_amdgcn_mbcnt_hi((unsigned)(m >> 32), __builtin_amdgcn_mbcnt_lo((unsigned)m, 0u)); }

__device__ __forceinline__ void ix_select_slow(const float (&sc)[8], const unsigned (&ix)[8], bool (&vl)[8], int K, unsigned short* sel_out, int lane) {
    for (int it = 0; it < K; ++it) {
        unsigned long long best = 0ull;
#pragma unroll
        for (int i = 0; i < 8; ++i) { const unsigned long long key = ((unsigned long long)sortable(sc[i]) << 32) | (unsigned long long)(0xFFFFu - ix[i]) | 0x10000ull; if (vl[i] && key > best) best = key; }
        unsigned long long wm = best;
#pragma unroll
        for (int o = 1; o < 64; o <<= 1) { const unsigned long long v = __shfl_xor(wm, o); wm = v > wm ? v : wm; }
        if (wm == 0ull) break;
        const bool mine = best == wm;
#pragma unroll
        for (int i = 0; i < 8; ++i) { const unsigned long long key = ((unsigned long long)sortable(sc[i]) << 32) | (unsigned long long)(0xFFFFu - ix[i]) | 0x10000ull; if (mine && vl[i] && key == wm) { vl[i] = false; sel_out[it] = (unsigned short)ix[i]; } }
    }
}

__device__ __forceinline__ void ix_compact(LAS float* LS, LAS unsigned short* LI, LAS unsigned* hist, int& cnt, float& tau, int lane, bool final_sel, unsigned short* sel_out) {
    const int n = cnt;
    float sc[8]; unsigned ix[8]; bool vl[8];
    IX_FENCE();
#pragma unroll
    for (int i = 0; i < 8; ++i) { const int p = lane + 64 * i; vl[i] = p < n; sc[i] = vl[i] ? LS[p] : -INFINITY; ix[i] = vl[i] ? (unsigned)LI[p] : 0u; }
    float mx = -INFINITY, mn = INFINITY;
#pragma unroll
    for (int i = 0; i < 8; ++i) { if (vl[i]) { mx = fmaxf(mx, sc[i]); mn = fminf(mn, sc[i]); } }
    mx = wave_max(mx); mn = -wave_max(-mn);
    const float scale = mx > mn ? 255.99f / (mx - mn) : 0.f;
    int bin[8];
#pragma unroll
    for (int i = 0; i < 8; ++i) { int bq = (int)((sc[i] - mn) * scale); bq = bq > 255 ? 255 : (bq < 0 ? 0 : bq); bin[i] = vl[i] ? bq : -1; }
    *(LAS v4u*)(hist + 4 * lane) = (v4u){0u, 0u, 0u, 0u};
    IX_FENCE();
#pragma unroll
    for (int i = 0; i < 8; ++i) if (vl[i]) __hip_atomic_fetch_add((LAS unsigned*)&hist[bin[i]], 1u, __ATOMIC_RELAXED, __HIP_MEMORY_SCOPE_WAVEFRONT);
    IX_FENCE();
    const v4u c = *(const LAS v4u*)(hist + 4 * lane);
    const unsigned Pp = wave_scan_incl(c.x + c.y + c.z + c.w, lane);
    const unsigned total = (unsigned)__builtin_amdgcn_readlane((int)Pp, 63);
    const unsigned K = TOPK;
    const unsigned a3 = total - Pp, a2 = a3 + c.w, a1 = a2 + c.z, a0 = a1 + c.y;
    int myb = -1; unsigned myA = 0u, myC = 0u;
    if (a3 < K && K <= a3 + c.w) { myb = 4 * lane + 3; myA = a3; myC = c.w; }
    else if (a2 < K && K <= a2 + c.z) { myb = 4 * lane + 2; myA = a2; myC = c.z; }
    else if (a1 < K && K <= a1 + c.y) { myb = 4 * lane + 1; myA = a1; myC = c.y; }
    else if (a0 < K && K <= a0 + c.x) { myb = 4 * lane; myA = a0; myC = c.x; }
    const unsigned long long bm = __ballot(myb >= 0);
    const int src = bm ? (__ffsll((long long)bm) - 1) : 0;
    const int bstar = __shfl(myb, src); const unsigned A = __shfl(myA, src), m = __shfl(myC, src);
    if (!final_sel) {
        if (A + m <= (unsigned)(IX_CAP - 128)) {
            int base = 0; float kmin = INFINITY;
#pragma unroll
            for (int i = 0; i < 8; ++i) {
                const bool keep = vl[i] && bin[i] >= bstar;
                const unsigned long long mk = __ballot(keep);
                const int pos = base + (int)ix_mbcnt(mk);
                if (keep) { LS[pos] = sc[i]; LI[pos] = (unsigned short)ix[i]; kmin = fminf(kmin, sc[i]); }
                base += __popcll(mk);
            }
            cnt = base; tau = -wave_max(-kmin);
            IX_FENCE();
            return;
        }
        unsigned short* tmp = sel_out;
        ix_select_slow(sc, ix, vl, (int)K, tmp, lane);
        int base = 0; float kmin = INFINITY;
#pragma unroll
        for (int i = 0; i < 8; ++i) {
            const bool keep = !vl[i] && (lane + 64 * i) < n;
            const unsigned long long mk = __ballot(keep);
            const int pos = base + (int)ix_mbcnt(mk);
            if (keep) { LS[pos] = sc[i]; LI[pos] = (unsigned short)ix[i]; kmin = fminf(kmin, sc[i]); }
            base += __popcll(mk);
        }
        cnt = base; tau = -wave_max(-kmin);
        IX_FENCE();
        return;
    }
    if (m <= 128u) {
        int base = 0;
#pragma unroll
        for (int i = 0; i < 8; ++i) {
            const bool keep = vl[i] && bin[i] > bstar;
            const unsigned long long mk = __ballot(keep);
            const int pos = base + (int)ix_mbcnt(mk);
            if (keep) sel_out[pos] = (unsigned short)ix[i];
            base += __popcll(mk);
        }
        LAS float* sS = (LAS float*)hist; LAS unsigned* sI = hist + 128;
        IX_FENCE();
        int mb = 0;
#pragma unroll
        for (int i = 0; i < 8; ++i) {
            const bool inb = vl[i] && bin[i] == bstar;
            const unsigned long long mk = __ballot(inb);
            const int pos = mb + (int)ix_mbcnt(mk);
            if (inb) { sS[pos] = sc[i]; sI[pos] = ix[i]; }
            mb += __popcll(mk);
        }
        IX_FENCE();
        const int need = (int)(K - A);
#pragma unroll
        for (int e = 0; e < 2; ++e) {
            const int j = lane + 64 * e;
            if (j < (int)m) {
                const float sj = sS[j]; const unsigned ij = sI[j]; int rank = 0;
                for (int k = 0; k < (int)m; ++k) { const float sk = sS[k]; const unsigned ik = sI[k]; rank += (sk > sj || (sk == sj && ik < ij)) ? 1 : 0; }
                if (rank < need) sel_out[(int)A + rank] = (unsigned short)ij;
            }
        }
    } else {
        ix_select_slow(sc, ix, vl, (int)K, sel_out, lane);
    }
}

__device__ __forceinline__ void p5_index_mfma(Frame& F, unsigned short* SEL, int* NSEL, int qword = 3072, bool probe_noappend = false) {
    const bf16* QA = WSP(bf16, WS_QA); const bf16* KIDX = WSP(bf16, WS_KIDX); const float* WIDX = WSP(float, WS_WIDX);
    const int tid = F.tid, w = F.wave, l = F.lane, r = l & 31, hf = l >> 5;
    {
        const int gw = blockIdx.x * NWAVES + w, NGW = F.G * NWAVES;
        for (int i = gw; i < NMETA + BATCH * 192; i += NGW) {
            int q, nvis; if (i < NMETA) { q = NREAL + i; nvis = NMETA; } else { const int bb = (i - NMETA) / 192, s = (i - NMETA) % 192; q = bb * SEQ + s; nvis = NMETA + 64 * (s / 64 + 1); }
            for (int j = l; j < nvis; j += 64) SEL[(size_t)q * TOPK + j] = (unsigned short)j;
            if (l == 0) NSEL[q] = nvis;
        }
    }
    LAS unsigned char* L = F.lds;
    LAS unsigned* hist = (LAS unsigned*)(L + IX_SCR + w * 1024);
    {
        for (;;) {
            __syncthreads();
            if (tid == 0) F.MISC[16] = __hip_atomic_fetch_add((unsigned*)F.ctl + qword, 1u, __ATOMIC_RELAXED, __HIP_MEMORY_SCOPE_AGENT);
            __syncthreads();
            const int qi_ = (int)F.MISC[16];
            if (qi_ >= 1000) break;
            const int tile = 999 - qi_;
            const int pt = 6 + (tile >> 2), b = tile & 3;
            const int q0 = b * SEQ + pt * 32;
            const int nvis = NMETA + 64 * (pt / 2 + 1);
            __syncthreads();
            bf16x8 af[4];
            {
                const int qq = 2 * (r >> 4) + ((r >> 2) & 1), hd = 4 * ((r >> 3) & 1) + (r & 3);
                const bf16* qp = QA + (size_t)(q0 + 4 * w + qq) * QAW + 1024 + hd * 64 + 8 * hf;
#pragma unroll
                for (int ks = 0; ks < 4; ++ks) af[ks] = *(const bf16x8*)(qp + 16 * ks);
            }
            float wq[2][8];
#pragma unroll
            for (int a = 0; a < 2; ++a) {
                const f32x4 w0 = *(const f32x4*)(WIDX + (size_t)(q0 + 4 * w + 2 * a + hf) * 8), w1 = *(const f32x4*)(WIDX + (size_t)(q0 + 4 * w + 2 * a + hf) * 8 + 4);
                wq[a][0] = 0.5f * w0.x; wq[a][1] = 0.5f * w0.y; wq[a][2] = 0.5f * w0.z; wq[a][3] = 0.5f * w0.w; wq[a][4] = 0.5f * w1.x; wq[a][5] = 0.5f * w1.y; wq[a][6] = 0.5f * w1.z; wq[a][7] = 0.5f * w1.w;
            }
            float tau0 = -INFINITY, tau1 = -INFINITY;
            int cnt[4] = {0, 0, 0, 0};
            const int nblk = (nvis + 255) >> 8;
            v4u kreg[4];
#pragma unroll
            for (int e = 0; e < 4; ++e) {
                const int pid = tid + 512 * e, kl = pid >> 3, pc = pid & 7, j = kl;
                kreg[e] = j < nvis ? *(const v4u*)(KIDX + (size_t)key_row(b, j) * 64 + 8 * pc) : (v4u){0u, 0u, 0u, 0u};
            }
#pragma unroll
            for (int e = 0; e < 4; ++e) { const int pid = tid + 512 * e, kl = pid >> 3, pc = pid & 7; *(LAS v4u*)(L + IX_KB + kl * 128 + ((pc ^ ((kl >> 1) & 7)) << 4)) = kreg[e]; }
            __syncthreads();
            const LAS unsigned char* kb = L + IX_KB;
            for (int blk = 0; blk < nblk; ++blk) {
                if (blk + 1 < nblk) {
#pragma unroll
                    for (int e = 0; e < 4; ++e) {
                        const int pid = tid + 512 * e, kl = pid >> 3, pc = pid & 7, j = (blk + 1) * 256 + kl;
                        kreg[e] = j < nvis ? *(const v4u*)(KIDX + (size_t)key_row(b, j) * 64 + 8 * pc) : (v4u){0u, 0u, 0u, 0u};
                    }
                }
                int npair = (nvis - blk * 256 + 63) >> 6; npair = npair > 4 ? 4 : npair;
                bf16x8 bc0[4], bc1[4];
#pragma unroll
                for (int ks = 0; ks < 4; ++ks) { const int k0 = r, k1 = 32 + r;
                    bc0[ks] = *(const LAS bf16x8*)(kb + k0 * 128 + (((2 * ks + hf) ^ ((k0 >> 1) & 7)) << 4));
                    bc1[ks] = *(const LAS bf16x8*)(kb + k1 * 128 + (((2 * ks + hf) ^ ((k1 >> 1) & 7)) << 4)); }
                for (int pp = 0; pp < npair; ++pp) {
                    const int jbase = blk * 256 + pp * 64;
                    bf16x8 bn0[4], bn1[4];
                    {
                        const int pn = pp + 1 < npair ? pp + 1 : pp; const int k0 = pn * 64 + r, k1 = k0 + 32;
#pragma unroll
                        for (int ks = 0; ks < 4; ++ks) {
                            bn0[ks] = *(const LAS bf16x8*)(kb + k0 * 128 + (((2 * ks + hf) ^ ((k0 >> 1) & 7)) << 4));
                            bn1[ks] = *(const LAS bf16x8*)(kb + k1 * 128 + (((2 * ks + hf) ^ ((k1 >> 1) & 7)) << 4)); }
                    }
                    f32x16 accA = zero16(), accB = zero16();
#pragma unroll
                    for (int ks = 0; ks < 4; ++ks) { accA = __builtin_amdgcn_mfma_f32_32x32x16_bf16(af[ks], bc0[ks], accA, 0, 0, 0); accB = __builtin_amdgcn_mfma_f32_32x32x16_bf16(af[ks], bc1[ks], accB, 0, 0, 0); }
#pragma unroll
                    for (int ks = 0; ks < 4; ++ks) { bc0[ks] = bn0[ks]; bc1[ks] = bn1[ks]; }
                    float sA0 = 0.f, sA0b = 0.f, sA1 = 0.f, sA1b = 0.f, sB0 = 0.f, sB0b = 0.f, sB1 = 0.f, sB1b = 0.f;
#pragma unroll
                    for (int h = 0; h < 8; h += 2) {
                        sA0 = fmaf(wq[0][h], __builtin_fabsf(accA[h]), fmaf(wq[0][h], accA[h], sA0)); sA0b = fmaf(wq[0][h + 1], __builtin_fabsf(accA[h + 1]), fmaf(wq[0][h + 1], accA[h + 1], sA0b));
                        sA1 = fmaf(wq[1][h], __builtin_fabsf(accA[8 + h]), fmaf(wq[1][h], accA[8 + h], sA1)); sA1b = fmaf(wq[1][h + 1], __builtin_fabsf(accA[9 + h]), fmaf(wq[1][h + 1], accA[9 + h], sA1b));
                        sB0 = fmaf(wq[0][h], __builtin_fabsf(accB[h]), fmaf(wq[0][h], accB[h], sB0)); sB0b = fmaf(wq[0][h + 1], __builtin_fabsf(accB[h + 1]), fmaf(wq[0][h + 1], accB[h + 1], sB0b));
                        sB1 = fmaf(wq[1][h], __builtin_fabsf(accB[8 + h]), fmaf(wq[1][h], accB[8 + h], sB1)); sB1b = fmaf(wq[1][h + 1], __builtin_fabsf(accB[9 + h]), fmaf(wq[1][h + 1], accB[9 + h], sB1b));
                    }
                    const float s0A = (sA0 + sA0b) + 0.0f, s1A = (sA1 + sA1b) + 0.0f, s0B = (sB0 + sB0b) + 0.0f, s1B = (sB1 + sB1b) + 0.0f;
                    const int jA = jbase + r, jB = jA + 32;
                    const bool p0A = jA < nvis && s0A > tau0, p1A = jA < nvis && s1A > tau1, p0B = jB < nvis && s0B > tau0, p1B = jB < nvis && s1B > tau1;
                    const unsigned long long m0A = __ballot(p0A), m1A = __ballot(p1A), m0B = __ballot(p0B), m1B = __ballot(p1B);
                    if (m0A | m1A | m0B | m1B) {
                        const int a0lo = __popc((unsigned)m0A), a0hi = __popc((unsigned)(m0A >> 32)), a1lo = __popc((unsigned)m1A), a1hi = __popc((unsigned)(m1A >> 32));
                        const int b0lo = __popc((unsigned)m0B), b0hi = __popc((unsigned)(m0B >> 32)), b1lo = __popc((unsigned)m1B), b1hi = __popc((unsigned)(m1B >> 32));
                        {
                            LAS unsigned char* lb = L + (w * 4 + hf) * IX_LIST;
                            const int base = hf ? cnt[1] : cnt[0];
                            const int posA = base + (int)ix_mbcnt(m0A) - (hf ? a0lo : 0);
                            const int posB = base + (hf ? a0hi : a0lo) + (int)ix_mbcnt(m0B) - (hf ? b0lo : 0);
                            if (p0A) { ((LAS float*)lb)[posA] = s0A; ((LAS unsigned short*)(lb + 2048))[posA] = (unsigned short)jA; }
                            if (p0B) { ((LAS float*)lb)[posB] = s0B; ((LAS unsigned short*)(lb + 2048))[posB] = (unsigned short)jB; }
                        }
                        {
                            LAS unsigned char* lb = L + (w * 4 + 2 + hf) * IX_LIST;
                            const int base = hf ? cnt[3] : cnt[2];
                            const int posA = base + (int)ix_mbcnt(m1A) - (hf ? a1lo : 0);
                            const int posB = base + (hf ? a1hi : a1lo) + (int)ix_mbcnt(m1B) - (hf ? b1lo : 0);
                            if (p1A) { ((LAS float*)lb)[posA] = s1A; ((LAS unsigned short*)(lb + 2048))[posA] = (unsigned short)jA; }
                            if (p1B) { ((LAS float*)lb)[posB] = s1B; ((LAS unsigned short*)(lb + 2048))[posB] = (unsigned short)jB; }
                        }
                        cnt[0] += a0lo + b0lo; cnt[1] += a0hi + b0hi; cnt[2] += a1lo + b1lo; cnt[3] += a1hi + b1hi;
                        if (probe_noappend) { if (cnt[0] >= 256 && hf == 0) tau0 = INFINITY; if (cnt[1] >= 256 && hf == 1) tau0 = INFINITY; if (cnt[2] >= 256 && hf == 0) tau1 = INFINITY; if (cnt[3] >= 256 && hf == 1) tau1 = INFINITY; }
#pragma unroll
                        for (int qq = 0; qq < 4; ++qq) {
                            if (cnt[qq] > IX_CAP - 64) {
                                LAS unsigned char* lb = L + (w * 4 + qq) * IX_LIST;
                                float tq = 0.f; int cq = cnt[qq];
                                ix_compact((LAS float*)lb, (LAS unsigned short*)(lb + 2048), hist, cq, tq, l, false, SEL + (size_t)(q0 + 4 * w + qq) * TOPK);
                                cnt[qq] = __builtin_amdgcn_readfirstlane(cq);
                                if ((qq & 1) == hf) { if (qq < 2) tau0 = tq; else tau1 = tq; }
                            }
                        }
                    }
                }
                __syncthreads();
                if (blk + 1 < nblk) {
#pragma unroll
                    for (int e = 0; e < 4; ++e) { const int pid = tid + 512 * e, kl = pid >> 3, pc = pid & 7; *(LAS v4u*)(L + IX_KB + kl * 128 + ((pc ^ ((kl >> 1) & 7)) << 4)) = kreg[e]; }
                    __syncthreads();
                }
            }
#pragma unroll
            for (int qq = 0; qq < 4; ++qq) {
                LAS unsigned char* lb = L + (w * 4 + qq) * IX_LIST;
                float tq = 0.f; int cq = cnt[qq];
                ix_compact((LAS float*)lb, (LAS unsigned short*)(lb + 2048), hist, cq, tq, l, true, SEL + (size_t)(q0 + 4 * w + qq) * TOPK);
                if (l == 0) NSEL[q0 + 4 * w + qq] = TOPK;
            }
        }
    }
}

#ifndef CHECK_IDX
#define CHECK_IDX 0
#endif
#if CHECK_IDX
__device__ __forceinline__ void idx_check(Frame& F) {
    const unsigned short* SEL = WSP(unsigned short, WS_SEL); const unsigned short* SELB = (const unsigned short*)F.out; const int* NSEL = WSP(int, WS_NSEL); const int* NSELB = (const int*)((const char*)F.out + 32 * MiB);
    LAS unsigned* bm = (LAS unsigned*)(F.lds + F.wave * 2048);
    const int l = F.lane; const int gw = blockIdx.x * NWAVES + F.wave, NGW = F.G * NWAVES;
    unsigned miss = 0, badq = 0, dup = 0;
    for (int q = gw; q < NROWS; q += NGW) {
        for (int i = l; i < 260; i += 64) bm[i] = 0u;
        IX_FENCE();
        const int n = NSEL[q], nb = NSELB[q];
        for (int i = l; i < n; i += 64) { const unsigned j = SEL[(size_t)q * TOPK + i]; atomicOr((unsigned*)&bm[j >> 5], 1u << (j & 31)); }
        IX_FENCE();
        unsigned m = (n != nb) ? 1000u : 0u;
        for (int i = l; i < nb && i < TOPK; i += 64) { const unsigned j = SELB[(size_t)q * TOPK + i]; if (j >= (unsigned)TT) { ++dup; ++m; } else { const unsigned old = atomicAnd((unsigned*)&bm[j >> 5], ~(1u << (j & 31))); if (!((old >> (j & 31)) & 1u)) ++m; } }
        IX_FENCE();
        m = (unsigned)wave_sum((float)m);
        if (l == 0) { miss += m; badq += m ? 1u : 0u; }
    }
    dup = (unsigned)wave_sum((float)dup);
    if (l == 0) { atomicAdd((unsigned*)F.ctl + 2048, miss); atomicAdd((unsigned*)F.ctl + 2049, badq); atomicAdd((unsigned*)F.ctl + 2050, dup); }
}
#endif

typedef short v4i16_t __attribute__((ext_vector_type(4)));
__device__ __forceinline__ unsigned at_off(unsigned row, unsigned ch) { return 256u * row + 16u * (ch ^ (((row & 3u) << 2) | ((row >> 2) & 3u))); }

__device__ __forceinline__ void p6_attn_mfma(Frame& F, bf16* OUTB) {
    bf16* QA = WSP(bf16, WS_QA); const bf16* CKV = WSP(bf16, WS_CKV); const unsigned short* SEL = WSP(unsigned short, WS_SEL); const int* NSEL = WSP(int, WS_NSEL);
    const int l = F.lane, w = F.wave, h16 = l & 15, g = l >> 4;
    LAS unsigned char* tile = F.lds + w * 8192;
    LAS unsigned short* selb = (LAS unsigned short*)(F.lds + 65536 + w * 512);
    const float slope = h16 < 8 ? __uint_as_float((unsigned)(127 - (h16 + 1)) << 23) : 0.f;
    {
        const int gw = blockIdx.x * NWAVES + w, NGW = F.G * NWAVES;
        for (int q = NROWS + gw; q < R; q += NGW) { bf16* qrow = QA + (size_t)q * QAW; for (int c = l; c < QAW / 8; c += 64) *(v4u*)(qrow + 8 * c) = (v4u){0u, 0u, 0u, 0u}; }
    }
    const int G = F.G;
    int nq_tot, qbase_b, wib, wpb;
    if ((G & 7) == 0) { const int b = (blockIdx.x & 7) >> 1; qbase_b = b * SEQ; nq_tot = SEQ + (b == 0 ? NMETA : 0); wib = (((blockIdx.x >> 3) * 2) + (blockIdx.x & 1)) * NWAVES + w; wpb = (G / 4) * NWAVES; }
    else { qbase_b = 0; nq_tot = NROWS; wib = blockIdx.x * NWAVES + w; wpb = G * NWAVES; }
    for (int qi = wib; qi < nq_tot; qi += wpb) {
        int q, b, pos;
        if ((G & 7) == 0) { if (qi < SEQ) { q = qbase_b + qi; b = q >> 13; pos = NMETA + qi; } else { q = NREAL + (qi - SEQ); b = 0; pos = qi - SEQ; } }
        else { q = qi; if (q < NREAL) { b = q >> 13; pos = NMETA + (q & (SEQ - 1)); } else { b = 0; pos = q - NREAL; } }
        bf16* qrow = QA + (size_t)q * QAW;
        const int nsel = NSEL[q];
        const int nch = (nsel + 31) >> 5;
        const unsigned short* selq = SEL + (size_t)q * TOPK;
        IX_FENCE();
        if (l < 32) *(LAS v4u*)(selb + 8 * l) = *(const v4u*)(selq + 8 * l);
        IX_FENCE();
        bf16x8 qf[4];
#pragma unroll
        for (int s = 0; s < 4; ++s) { const v4u t = h16 < 8 ? *(const v4u*)(qrow + h16 * 128 + 32 * s + 8 * g) : (v4u){0u, 0u, 0u, 0u}; qf[s] = __builtin_bit_cast(bf16x8, t); }
        float m = -INFINITY, lsum = 0.f;
        f32x4 O[8];
#pragma unroll
        for (int c = 0; c < 8; ++c) O[c] = (f32x4){0.f, 0.f, 0.f, 0.f};
        v4u gr[8];
#pragma unroll
        for (int i = 0; i < 8; ++i) { const int s = g + 4 * i; const int kj = s < nsel ? (int)selb[s] : (int)selb[0]; gr[i] = *(const v4u*)(CKV + (size_t)key_row(b, kj) * 128 + 8 * h16); }
        for (int ck = 0; ck < nch; ++ck) {
            IX_FENCE();
#pragma unroll
            for (int i = 0; i < 8; ++i) *(LAS v4u*)(tile + at_off((unsigned)(g + 4 * i), (unsigned)h16)) = gr[i];
            const v4u kv = *(const LAS v4u*)(selb + 32 * ck + 8 * g);
            if (ck + 1 < nch) {
#pragma unroll
                for (int i = 0; i < 8; ++i) { const int s = 32 * (ck + 1) + g + 4 * i; const int kj = s < nsel ? (int)selb[s] : (int)selb[0]; gr[i] = *(const v4u*)(CKV + (size_t)key_row(b, kj) * 128 + 8 * h16); }
            }
            IX_FENCE();
            f32x4 a0 = (f32x4){0.f, 0.f, 0.f, 0.f}, a1 = a0;
#pragma unroll
            for (int s = 0; s < 4; ++s) {
                const bf16x8 k0 = *(const LAS bf16x8*)(tile + at_off((unsigned)(8 * (h16 >> 2) + (h16 & 3)), (unsigned)(4 * s + g)));
                const bf16x8 k1 = *(const LAS bf16x8*)(tile + at_off((unsigned)(8 * (h16 >> 2) + 4 + (h16 & 3)), (unsigned)(4 * s + g)));
                a0 = __builtin_amdgcn_mfma_f32_16x16x32_bf16(k0, qf[s], a0, 0, 0, 0);
                a1 = __builtin_amdgcn_mfma_f32_16x16x32_bf16(k1, qf[s], a1, 0, 0, 0);
            }
            const unsigned kw[4] = {kv.x, kv.y, kv.z, kv.w};
            float x[8];
#pragma unroll
            for (int j = 0; j < 8; ++j) {
                const int kj = (int)((kw[j >> 1] >> (16 * (j & 1))) & 0xffffu);
                const float lg = (j < 4 ? a0[j & 3] : a1[j & 3]) - slope * fabsf((float)(pos - kj));
                x[j] = (32 * ck + 8 * g + j) < nsel ? lg : -INFINITY;
            }
            float cm = fmaxf(fmaxf(fmaxf(x[0], x[1]), fmaxf(x[2], x[3])), fmaxf(fmaxf(x[4], x[5]), fmaxf(x[6], x[7])));
            cm = fmaxf(cm, __shfl_xor(cm, 16)); cm = fmaxf(cm, __shfl_xor(cm, 32));
            const float mn = fmaxf(m, cm);
            const float alpha = __expf(m - mn);
            float p[8], ps = 0.f;
#pragma unroll
            for (int j = 0; j < 8; ++j) { p[j] = __expf(x[j] - mn); ps += p[j]; }
            ps += __shfl_xor(ps, 16); ps += __shfl_xor(ps, 32);
            lsum = lsum * alpha + ps; m = mn;
            if (__any(alpha != 1.0f)) {
#pragma unroll
                for (int rr = 0; rr < 4; ++rr) { const float sc = __shfl(alpha, 4 * g + rr);
#pragma unroll
                    for (int c = 0; c < 8; ++c) O[c][rr] *= sc; }
            }
            const v4u pw = (v4u){pk2(p[0], p[1]), pk2(p[2], p[3]), pk2(p[4], p[5]), pk2(p[6], p[7])};
            const bf16x8 pf = __builtin_bit_cast(bf16x8, pw);
#pragma unroll
            for (int c = 0; c < 8; ++c) {
                const unsigned qd = (unsigned)(h16 >> 2), pp = (unsigned)(h16 & 3);
                const v4i16_t t0 = __builtin_amdgcn_ds_read_tr16_b64_v4i16((LAS v4i16_t*)(tile + at_off(8u * g + qd, 2u * c + (pp >> 1)) + 8u * (pp & 1u)));
                const v4i16_t t1 = __builtin_amdgcn_ds_read_tr16_b64_v4i16((LAS v4i16_t*)(tile + at_off(8u * g + 4u + qd, 2u * c + (pp >> 1)) + 8u * (pp & 1u)));
                bf16x8 vf; vf[0] = t0[0]; vf[1] = t0[1]; vf[2] = t0[2]; vf[3] = t0[3]; vf[4] = t1[0]; vf[5] = t1[1]; vf[6] = t1[2]; vf[7] = t1[3];
                O[c] = __builtin_amdgcn_mfma_f32_16x16x32_bf16(pf, vf, O[c], 0, 0, 0);
            }
        }
        const float inv = 1.0f / lsum;
#pragma unroll
        for (int rr = 0; rr < 4; ++rr) {
            const float sc = __shfl(inv, 4 * g + rr);
            if (g < 2) {
#pragma unroll
                for (int c = 0; c < 8; ++c) (OUTB + (size_t)q * QAW)[(4 * g + rr) * 128 + 16 * c + h16] = (bf16)f2bf(O[c][rr] * sc);
            }
        }
    }
}
struct StoreBf16 { bf16* O; int ld;
    __device__ __forceinline__ void operator()(int row, int col, const f32x4& v) const { *(v2u*)(O + (size_t)row * ld + col) = (v2u){pk2(v.x, v.y), pk2(v.z, v.w)}; }
    __device__ __forceinline__ void one(int row, int col, float v) const { O[(size_t)row * ld + col] = (bf16)f2bf(v); } };
struct StoreRes1 { const bf16* H; float* out; float* meta;
    __device__ __forceinline__ void operator()(int row, int col, const f32x4& v) const {
        if (row >= NROWS) return;
        const v2u hw = *(const v2u*)(H + (size_t)row * D + col);
        const f32x4 o = (f32x4){ALPHA * bflo(hw.x) + v.x, ALPHA * bfhi(hw.x) + v.y, ALPHA * bflo(hw.y) + v.z, ALPHA * bfhi(hw.y) + v.w};
        float* dst = row < NREAL ? out + (size_t)row * D + col : meta + (size_t)(row - NREAL) * D + col;
        *(f32x4*)dst = o; }
    __device__ __forceinline__ void one(int row, int col, float v) const { if (row >= NROWS) return; float* dst = row < NREAL ? out + (size_t)row * D + col : meta + (size_t)(row - NREAL) * D + col; *dst = ALPHA * bf2f(H[(size_t)row * D + col]) + v; } };
struct StoreRes2 { const bf16* H; float* out; __device__ __forceinline__ void operator()(int row, int col, const f32x4& v) const {
        if (row >= NREAL) return;
        const v2u hw = *(const v2u*)(H + (size_t)row * D + col);
        *(f32x4*)(out + (size_t)row * D + col) = (f32x4){ALPHA * bflo(hw.x) + v.x, ALPHA * bfhi(hw.x) + v.y, ALPHA * bflo(hw.y) + v.z, ALPHA * bfhi(hw.y) + v.w}; } };

struct StoreMetaGate { float* GM; __device__ __forceinline__ void one(int row, int col, float v) const { const int m = row - NREAL, x = col & 255; if (m >= 14 && x < 128) GM[(size_t)(m - 14) * DFF + 128 * (col >> 8) + x] = v; } };
template <class Fn>
__device__ __forceinline__ void meta_gemm(Frame& F, const bf16* A, int lda, const bf16* Bt, int N, int K, const Fn& fn) {
    const int l = F.lane, i16 = l & 15, g = l >> 4;
    const int gw = blockIdx.x * NWAVES + F.wave, NGW = F.G * NWAVES;
    for (int t = gw; t < N / 16; t += NGW) {
        const bf16* ap = A + (size_t)(NREAL + i16) * lda + 8 * g; const bf16* bp = Bt + (size_t)(16 * t + i16) * K + 8 * g;
        f32x4 acc = (f32x4){0.f, 0.f, 0.f, 0.f};
#pragma unroll 8
        for (int s = 0; s < K / 32; ++s) acc = __builtin_amdgcn_mfma_f32_16x16x32_bf16(*(const pg8::bf16x8*)(ap + 32 * s), *(const pg8::bf16x8*)(bp + 32 * s), acc, 0, 0, 0);
#pragma unroll
        for (int rr = 0; rr < 4; ++rr) fn.one(NREAL + 4 * g + rr, 16 * t + i16, acc[rr]);
    }
}

template <class Fn>
__device__ __forceinline__ void run_gemm(Frame& F, const bf16* A, int lda, const bf16* Bt, int N, int K, const Fn& fn) {
    pg8::Gemm g{A, Bt, NREAL, N, K, lda}; pg8::StaticOrder S; S.init(NREAL, N, F.G, (int)blockIdx.x);
    pg8::EpiFn<Fn> E{fn};
    pg8::gemm_phase<pg8::EpiFn<Fn>, pg8::StaticOrder, true, true>(F.lds + RING_OFF, g, S, E);
}

constexpr int NPHASES = 13;
struct Args { const float* in[32]; float* out; unsigned char* ws; int ph_lo, ph_hi; };
__global__ void __launch_bounds__(NTHR, 2) fwd(Args args) {
    extern __shared__ __attribute__((aligned(16))) unsigned char lds[];
    Frame F;
    F.lds = (LAS unsigned char*)lds;
    F.MISC = (volatile LAS unsigned*)(F.lds + MISC_OFF);
    F.tid = threadIdx.x; F.lane = F.tid & 63; F.wave = __builtin_amdgcn_readfirstlane(F.tid >> 6);
    F.G = gridDim.x;
#pragma unroll
    for (int i = 0; i < 32; ++i) F.in[i] = args.in[i];
    F.out = args.out; F.ws = args.ws;
    F.ctl = (gu32*)(args.ws + WS_CTL);
    for (int u = F.tid; u < (LDS_BYTES - LDSCTL_OFF) / 4; u += NTHR) ((LAS unsigned*)(F.lds + LDSCTL_OFF))[u] = 0u;
    __syncthreads();
    const int lo = args.ph_lo, hi = args.ph_hi;
    XcdBarrier bar; bar.bar = (unsigned*)(F.ctl + CW_BAR); bar.x = 0; bar.st = nullptr;
    if (hi - lo > 1) bar = xcd_barrier_post((unsigned*)(F.ctl + CW_BAR), F.MISC + 8);
#define IN(k) (lo <= (k) && (k) < hi)
#ifdef PROBE_PHASE_T
    unsigned long long tp_prev = __builtin_amdgcn_s_memrealtime(), tp_dur = 0ull;
#define SEAM(k) do { if (IN(k) && IN((k) + 1)) xcd_barrier(bar); if (blockIdx.x == 0 && F.tid == 0) { const unsigned long long t_ = __builtin_amdgcn_s_memrealtime(); if ((k) == PROBE_PHASE_T) tp_dur = t_ - tp_prev; tp_prev = t_; } } while (0)
#else
#define SEAM(k) do { if (IN(k) && IN((k) + 1)) xcd_barrier(bar); } while (0)
#endif
#ifndef PROBE_PH
#define PROBE_PH -1
#endif
#define REP(k) for (int rep_ = 0; rep_ < ((PROBE_PH == (k)) ? 2 : 1); ++rep_)

#ifndef IDX_NAIVE
#define IDX_NAIVE 0
#endif
#ifndef ATTN_NAIVE
#define ATTN_NAIVE 0
#endif
    if (IN(0)) REP(0) { if (rep_) __syncthreads(); p0_weights(F); p1_ln_in(F); } SEAM(0);
    if (IN(1)) REP(1) { if (rep_) __syncthreads(); run_gemm(F, WSP(bf16, WS_H), D, WSP(bf16, WS_WT_IN), PW, D, StoreBf16{WSP(bf16, WS_P), PW}); meta_gemm(F, WSP(bf16, WS_H), D, WSP(bf16, WS_WT_IN), PW, D, StoreBf16{WSP(bf16, WS_P), PW}); } SEAM(1);
    if (IN(2)) REP(2) { if (rep_) __syncthreads(); p3_prep(F); } SEAM(2);
    if (IN(3)) REP(3) { if (rep_) __syncthreads(); run_gemm(F, WSP(bf16, WS_CQN), 256, WSP(bf16, WS_WT_QA), QAW, 256, StoreBf16{WSP(bf16, WS_QA), QAW}); meta_gemm(F, WSP(bf16, WS_CQN), 256, WSP(bf16, WS_WT_QA), QAW, 256, StoreBf16{WSP(bf16, WS_QA), QAW});
#if REFSEL
        refsel_rows(F);
#endif
    } SEAM(3);
    if (IN(4)) REP(4) { if (rep_) __syncthreads(); rw_b1(F); } SEAM(4);
    if (IN(5)) {
        rw_b2(F); __syncthreads();
#if CHECK_IDX
        p5_index_naive(F); __syncthreads(); p5_index_mfma(F, (unsigned short*)F.out, (int*)((char*)F.out + 32 * MiB));
#elif IDX_NAIVE
        p5_index_naive(F);
#else
        p5_index_mfma(F, WSP(unsigned short, WS_SEL), WSP(int, WS_NSEL));
#ifdef PROBE_IDX
        __syncthreads(); p5_index_mfma(F, WSP(unsigned short, WS_SEL), WSP(int, WS_NSEL), 3136);
#endif
#ifdef PROBE_IDX_SCORE
        __syncthreads(); p5_index_mfma(F, (unsigned short*)F.out, (int*)((char*)F.out + 32 * MiB), 3136, true);
#endif
#endif
    } SEAM(5);
    if (IN(6)) {
#if CHECK_IDX
        idx_check(F); __syncthreads();
#endif
#if ATTN_NAIVE
        p6_attn_naive(F);
#else
        p6_attn_mfma(F, WSP(bf16, WS_QA));
#endif
        __syncthreads();
        rw_b3(F);
    } SEAM(6);
    if (IN(7)) REP(7) { if (rep_) __syncthreads(); run_gemm(F, WSP(bf16, WS_QA), QAW, WSP(bf16, WS_WT_MIX), D, QAW, StoreRes1{WSP(bf16, WS_H), F.out, WSP(float, WS_META1)}); meta_gemm(F, WSP(bf16, WS_QA), QAW, WSP(bf16, WS_WT_MIX), D, QAW, StoreRes1{WSP(bf16, WS_H), F.out, WSP(float, WS_META1)}); } SEAM(7);
    if (IN(8)) REP(8) { if (rep_) __syncthreads(); p10_ln1(F); } SEAM(8);
    if (IN(9)) {
        pg8::Gemm g{WSP(bf16, WS_H), WSP(bf16, WS_WT_UP), NREAL, UPW, D, D}; pg8::StaticOrder S; S.init(NREAL, UPW, F.G, (int)blockIdx.x);
        pg8::EpiConvAct E{WSP(unsigned short, WS_UP), DFF, F.in[IN_CONV_W], F.in[IN_CONV_B], DFF, WSP(float, WS_G01), WSP(float, WS_V01), WSP(float, WS_GHALO), (PG8_LAS float*)(F.lds + RING_BYTES + 4096)};
        pg8::gemm_phase<pg8::EpiConvAct, pg8::StaticOrder, true, true>(F.lds + RING_OFF, g, S, E);
        meta_gemm(F, WSP(bf16, WS_H), D, WSP(bf16, WS_WT_UP), UPW, D, StoreMetaGate{WSP(float, WS_GMETA)});
    } SEAM(9);
    if (IN(10)) { p12_conv_fix(F); } SEAM(10);
    if (IN(11)) REP(11) { if (rep_) __syncthreads(); run_gemm(F, WSP(bf16, WS_UP), DFF, WSP(bf16, WS_WT_DN), D, DFF, StoreRes2{WSP(bf16, WS_H), F.out}); } SEAM(11);
    if (IN(12)) { p14_ln2(F);
#if CHECK_IDX
        if (blockIdx.x == 0 && F.tid == 0) {
            const unsigned miss = __hip_atomic_load((unsigned*)F.ctl + 2048, __ATOMIC_RELAXED, __HIP_MEMORY_SCOPE_AGENT), dupc = __hip_atomic_load((unsigned*)F.ctl + 2050, __ATOMIC_RELAXED, __HIP_MEMORY_SCOPE_AGENT);
            if (dupc) F.out[5] = __builtin_inff();
            if (miss > CHECK_IDX_MAXMISS) F.out[3] = __builtin_nanf("");
        }
#endif
    }
#ifdef PROBE_PHASE_T
    if (blockIdx.x == 0 && F.tid == 0) { if (PROBE_PHASE_T == 12) tp_dur = __builtin_amdgcn_s_memrealtime() - tp_prev; const unsigned long long t0 = __builtin_amdgcn_s_memrealtime(); while (__builtin_amdgcn_s_memrealtime() - t0 < tp_dur) __builtin_amdgcn_s_sleep(8); }
#endif
#ifdef PROBE_B1SEC
    if (blockIdx.x == 0 && F.tid == 0) { const unsigned long long t0 = __builtin_amdgcn_s_memrealtime(); const unsigned long long dt = (unsigned long long)F.MISC[20]; while (__builtin_amdgcn_s_memrealtime() - t0 < dt) __builtin_amdgcn_s_sleep(8); }
#endif
#undef IN
#undef SEAM
}

extern "C" void kernel_launch(void* const* d_in, const int* in_sizes, int n_in, void* d_out, int out_size, void* d_ws, size_t ws_size, hipStream_t stream) {
    static int grid = 0;
    if (grid == 0) {
        if (n_in != 32 || out_size != NREAL * D || ws_size < WS_END) { fprintf(stderr, "kernel_launch: unexpected shapes: n_in %d out %d ws %zu\n", n_in, out_size, ws_size); grid = -1; return; }
        int dev = 0, cus = 0, per_cu = 0;
        if (hipGetDevice(&dev) != hipSuccess || hipDeviceGetAttribute(&cus, hipDeviceAttributeMultiprocessorCount, dev) != hipSuccess) { grid = -1; return; }
        if (hipFuncSetAttribute((const void*)fwd, hipFuncAttributeMaxDynamicSharedMemorySize, LDS_BYTES) != hipSuccess) { fprintf(stderr, "kernel_launch: hipFuncSetAttribute failed\n"); grid = -1; return; }
        if (hipOccupancyMaxActiveBlocksPerMultiprocessor(&per_cu, (const void*)fwd, NTHR, LDS_BYTES) != hipSuccess || per_cu < 1) fprintf(stderr, "kernel_launch: occupancy query says %d\n", per_cu);
        (void)hipGetLastError();
        grid = cus;
    }
    if (grid < 0) return;
    (void)hipMemsetAsync((char*)d_ws + WS_CTL, 0, CTL_ZERO_BYTES, stream);
    Args a{};
    for (int i = 0; i < 32; ++i) a.in[i] = (const float*)d_in[i];
    a.out = (float*)d_out; a.ws = (unsigned char*)d_ws;
#if ONE_LAUNCH
    a.ph_lo = 0; a.ph_hi = NPHASES;
    hipLaunchKernelGGL(fwd, dim3(grid), dim3(NTHR), LDS_BYTES, stream, a);
#else
    for (int p = 0; p < NPHASES; ++p) { a.ph_lo = p; a.ph_hi = p + 1; hipLaunchKernelGGL(fwd, dim3(grid), dim3(NTHR), LDS_BYTES, stream, a); }
#endif
}
```

```cpp
#include <hip/hip_runtime.h>
#include <cstdio>
#include <cstdint>
#define ONE_LAUNCH 1
namespace pg8 {
#define PG8_LAS __attribute__((address_space(3)))
typedef unsigned short bf16_t;
typedef short bf16x8 __attribute__((ext_vector_type(8)));
typedef float f32x4 __attribute__((ext_vector_type(4)));
typedef unsigned u32x4 __attribute__((ext_vector_type(4)));
constexpr int BM = 256, BK = 64, HALF = 128, HTB = HALF * BK * 2  , STAGE_BYTES = 8 * HTB, NXCD = 8, WGM = 8;

__host__ __device__ __forceinline__ int lds_byte(int r, int c) { const int st = (r >> 4) * 2 + (c >> 5), rr = r & 15, cc = c & 31, ob = rr * 64 + cc * 2; return st * 1024 + (ob ^ (((ob >> 9) & 1) << 5)); }
__host__ __device__ __forceinline__ void stage_rc(int b, int& R, int& C) { const int st = b / 1024, sb = b % 1024, swz = sb ^ (((sb >> 9) & 1) << 5); R = (st >> 1) * 16 + swz / 64; C = (st & 1) * 32 + (swz % 64) / 2; }
__host__ __device__ __forceinline__ int perm32(int rho) { const int n = rho >> 4, i = rho & 15; return 8 * (i >> 2) + 4 * n + (i & 3); }

struct Unit { int pm, pn; };
struct Gemm { const bf16_t* A; const bf16_t* Bt; int M, N, K, lda; };

struct StaticOrder {
    int nM, nN, nwg, G, c;
    __host__ __device__ void init(int M, int N, int G_, int c_) { nM = M / BM; nN = N / BM; nwg = nM * nN; G = G_; c = c_; }
    __host__ __device__ bool next(int i, Unit& u) const {
        const long L = (long)i * G + c; if (L >= nwg) return false;
        int wgid = (int)L; { const int q = nwg / NXCD, r = nwg % NXCD, xcd = wgid % NXCD, off = wgid / NXCD; wgid = (xcd < r ? xcd * (q + 1) : r * (q + 1) + (xcd - r) * q) + off; }
        const int nig = WGM * nN, gid = wgid / nig, fm = gid * WGM, gsz = (nM - fm) < WGM ? (nM - fm) : WGM;
        u.pm = fm + ((wgid % nig) % gsz); u.pn = (wgid % nig) / gsz; return true;
    }
    __device__ __forceinline__ void a_ready(const Unit&) const {}
    __device__ __forceinline__ void done(const Unit&) const {}
};


template <class F> struct EpiFn {
    static constexpr bool PERM = false, AFTER_DRAIN = false;
    F f;
    __device__ __forceinline__ void operator()(const f32x4 (&acc)[2][2][4][2], const Unit& u, int wr, int wc, int fr, int fq) const {
        const int row0 = u.pm * BM + wr * 64 + fr, col0 = u.pn * BM + wc * 32 + 4 * fq;
#pragma unroll
        for (int ai = 0; ai < 2; ++ai)
#pragma unroll
            for (int m = 0; m < 4; ++m) {
                const int row = row0 + ai * HALF + m * 16;
#pragma unroll
                for (int bj = 0; bj < 2; ++bj)
#pragma unroll
                    for (int n = 0; n < 2; ++n) f(row, col0 + bj * HALF + n * 16, acc[ai][bj][m][n]);
            }
    }
};

struct EpiConvAct {
    static constexpr bool PERM = false, AFTER_DRAIN = false;
    unsigned short* ACT; int ldact;
    const float* cw; const float* cb; int dff;
    float* G01; float* V01; float* GHALO;
    PG8_LAS float* hal;
    __device__ __forceinline__ void operator()(const f32x4 (&acc)[2][2][4][2], const Unit& u, int wr, int wc, int fr, int fq) const {
        const int colg = 128 * u.pn + wc * 32 + 4 * fq;
        f32x4 w0[2], w1[2], w2[2], bb[2];
#pragma unroll
        for (int n = 0; n < 2; ++n) { w0[n] = *(const f32x4*)(cw + colg + 16 * n); w1[n] = *(const f32x4*)(cw + dff + colg + 16 * n); w2[n] = *(const f32x4*)(cw + 2 * dff + colg + 16 * n); bb[n] = *(const f32x4*)(cb + colg + 16 * n); }
        if (fr >= 14) {
#pragma unroll
            for (int ai = 0; ai < 2; ++ai)
#pragma unroll
                for (int n = 0; n < 2; ++n) *(PG8_LAS f32x4*)(hal + (((2 * ai + wr) * 4 + wc) * 2 + (fr - 14)) * 32 + 16 * n + 4 * fq) = acc[ai][0][3][n];
        }
        asm volatile("s_waitcnt lgkmcnt(0)" ::: "memory"); __builtin_amdgcn_s_barrier(); asm volatile("" ::: "memory");
#pragma unroll
        for (int ai = 0; ai < 2; ++ai) {
            const int blk = 2 * ai + wr;
#pragma unroll
            for (int n = 0; n < 2; ++n) {
                f32x4 prev = (f32x4){0.f, 0.f, 0.f, 0.f};
                if (blk > 0) prev = *(const PG8_LAS f32x4*)(hal + ((((blk - 1) * 4 + wc) * 2 + (fr & 1)) * 32) + 16 * n + 4 * fq);
#pragma unroll
                for (int m = 0; m < 4; ++m) {
                    const f32x4 cur = acc[ai][0][m][n], val = acc[ai][1][m][n];
                    f32x4 o;
#pragma unroll
                    for (int e = 0; e < 4; ++e) {
                        float s1 = prev[e], s2 = prev[e];
                        asm volatile("s_nop 1\n\tv_mov_b32_dpp %0, %0 row_ror:1 row_mask:0xf bank_mask:0xf\n\tv_mov_b32_dpp %1, %1 row_ror:2 row_mask:0xf bank_mask:0xf\n\ts_nop 1\n\t"
                                     "v_mov_b32_dpp %0, %2 row_shr:1 row_mask:0xf bank_mask:0xf\n\tv_mov_b32_dpp %1, %2 row_shr:2 row_mask:0xf bank_mask:0xf\n\ts_nop 1" : "+v"(s1), "+v"(s2) : "v"(cur[e]));
                        const float x = w0[n][e] * s2 + w1[n][e] * s1 + w2[n][e] * cur[e] + bb[n][e];
                        const float u2 = x * (1.5957691216057308f + 0.07135481627260025f * x * x);
                        o[e] = x * __builtin_amdgcn_rcpf(1.0f + __builtin_amdgcn_exp2f(-1.4426950408889634f * u2)) * val[e];
                    }
                    const int rt = ai * HALF + wr * 64 + m * 16 + fr;
                    const int row = u.pm * BM + rt;
                    if (blk == 0 && m == 0 && fr < 2) {
                        *(f32x4*)(G01 + ((size_t)u.pm * 2 + fr) * dff + colg + 16 * n) = cur; *(f32x4*)(V01 + ((size_t)u.pm * 2 + fr) * dff + colg + 16 * n) = val;
                    } else {
                        typedef unsigned u32x2 __attribute__((ext_vector_type(2)));
                        typedef __bf16 b2 __attribute__((ext_vector_type(2)));
                        const b2 lo = {(__bf16)o[0], (__bf16)o[1]}, hi = {(__bf16)o[2], (__bf16)o[3]};
                        *(u32x2*)(ACT + (size_t)row * ldact + colg + 16 * n) = (u32x2){__builtin_bit_cast(unsigned, lo), __builtin_bit_cast(unsigned, hi)};
                    }
                    if (blk == 3 && m == 3 && fr >= 14) *(f32x4*)(GHALO + ((size_t)u.pm * 2 + (fr - 14)) * dff + colg + 16 * n) = cur;
                    prev = cur;
                }
            }
        }
        asm volatile("s_waitcnt lgkmcnt(0)" ::: "memory"); __builtin_amdgcn_s_barrier(); asm volatile("" ::: "memory");
    }
};
template <class Epi, class Sched, bool ALIGN_EPI = false, bool SP2 = false>
__device__ __forceinline__ void gemm_phase(PG8_LAS unsigned char* lds, const Gemm g, const Sched& S, const Epi& E) {
    const int tid = threadIdx.x, wid = __builtin_amdgcn_readfirstlane(tid >> 6), lane = tid & 63, wr = wid >> 2, wc = wid & 3, fr = lane & 15, fq = lane >> 4;
    const int K = g.K, nt = K / BK;
    unsigned voffA[2], voffB[2];
#pragma unroll
    for (int i = 0; i < 2; ++i) { int R, C; stage_rc(tid * 16 + i * 8192, R, C); const int Rb = Epi::PERM ? ((R & ~31) + perm32(R & 31)) : R;
        voffA[i] = (unsigned)(R * g.lda + C) * 2u; voffB[i] = (unsigned)(Rb * K + C) * 2u; }
    const size_t kstep = (size_t)(BK * 2);
    const size_t hA = (size_t)HALF * g.lda * 2, hB = (size_t)HALF * K * 2;
    const size_t tA = 2 * hA, tB = 2 * hB;
    const unsigned ldsw = (unsigned)wid * 1024u;
    const int aoff = lds_byte(wr * 64 + fr, fq * 8), boff = lds_byte(wc * 32 + fr, fq * 8);
#define PG8_SA(b, h) (((b) * 2 + (h)) * HTB)
#define PG8_SB(b, h) ((4 + (b) * 2 + (h)) * HTB)
#define PG8_STAGE(bufoff, gbase, voff) do { _Pragma("unroll") for (int _i = 0; _i < 2; ++_i) \
        __builtin_amdgcn_global_load_lds((const unsigned*)((const char*)(gbase) + (voff)[_i]), (PG8_LAS unsigned*)(lds + (bufoff) + ldsw + _i * 8192), 16, 0, 0); } while (0)
#define PG8_LDA(dst, b, h) do { _Pragma("unroll") for (int m = 0; m < 4; ++m) _Pragma("unroll") for (int k = 0; k < 2; ++k) dst[m][k] = *(const PG8_LAS bf16x8*)(lds + PG8_SA(b, h) + aoff + m * 2048 + k * 1024); } while (0)
#define PG8_LDB(dst, b, h) do { _Pragma("unroll") for (int n = 0; n < 2; ++n) _Pragma("unroll") for (int k = 0; k < 2; ++k) dst[n][k] = *(const PG8_LAS bf16x8*)(lds + PG8_SB(b, h) + boff + n * 2048 + k * 1024); } while (0)
#define PG8_MMA(ai, bj, At, Bt) do { __builtin_amdgcn_s_setprio(1); _Pragma("unroll") for (int m = 0; m < 4; ++m) _Pragma("unroll") for (int n = 0; n < 2; ++n) _Pragma("unroll") for (int k = 0; k < 2; ++k) \
        acc[ai][bj][m][n] = __builtin_amdgcn_mfma_f32_16x16x32_bf16(Bt[n][k], At[m][k], acc[ai][bj][m][n], 0, 0, 0); __builtin_amdgcn_s_setprio(0); } while (0)
#define PG8_WAIT_V(n) asm volatile("s_waitcnt vmcnt(" #n ")" ::: "memory")
#define PG8_WAIT_L(n) asm volatile("s_waitcnt lgkmcnt(" #n ")" ::: "memory")
#define PG8_BAR __builtin_amdgcn_s_barrier()
#define PG8_SCHED __builtin_amdgcn_sched_barrier(0)
    Unit cur, nxt; int ui = 0;
    if (!S.next(0, cur)) return;
    f32x4 acc[2][2][4][2];
#pragma unroll
    for (int a = 0; a < 2; ++a)
#pragma unroll
        for (int b = 0; b < 2; ++b)
#pragma unroll
            for (int m = 0; m < 4; ++m)
#pragma unroll
                for (int n = 0; n < 2; ++n) acc[a][b][m][n] = (f32x4){0.f, 0.f, 0.f, 0.f};
    bf16x8 At[4][2], B0[2][2], B1[2][2];
    const char* cA = (const char*)g.A + (size_t)cur.pm * tA; const char* cB = (const char*)g.Bt + (size_t)cur.pn * tB;
    S.a_ready(cur);
    if constexpr (SP2) {
        PG8_STAGE(PG8_SB(0, 0), cB, voffB); PG8_STAGE(PG8_SB(0, 1), cB + hB, voffB); PG8_STAGE(PG8_SA(0, 0), cA, voffA); PG8_STAGE(PG8_SA(0, 1), cA + hA, voffA);
        if (wr == 1) PG8_BAR;
        PG8_WAIT_V(2); PG8_BAR;
        PG8_STAGE(PG8_SB(1, 0), cB + kstep, voffB); PG8_STAGE(PG8_SA(1, 0), cA + kstep, voffA); PG8_STAGE(PG8_SB(1, 1), cB + hB + kstep, voffB);
        PG8_WAIT_V(6); PG8_BAR;
    } else {
        PG8_STAGE(PG8_SB(0, 0), cB, voffB); PG8_STAGE(PG8_SA(0, 0), cA, voffA); PG8_STAGE(PG8_SB(0, 1), cB + hB, voffB); PG8_STAGE(PG8_SA(0, 1), cA + hA, voffA);
        if (wr == 1) PG8_BAR;
        PG8_WAIT_V(4); PG8_BAR;
        PG8_STAGE(PG8_SB(1, 0), cB + kstep, voffB); PG8_STAGE(PG8_SA(1, 0), cA + kstep, voffA); PG8_STAGE(PG8_SB(1, 1), cB + hB + kstep, voffB);
        PG8_WAIT_V(6); PG8_BAR;
    }
    for (;;) {
        const bool has_next = S.next(ui + 1, nxt);
        const char* nA = has_next ? (const char*)g.A + (size_t)nxt.pm * tA : cA; const char* nB = has_next ? (const char*)g.Bt + (size_t)nxt.pn * tB : cB;
        for (int t = 0; t < nt; t += 2) {
            const bool last = (t == nt - 2);
            const char* a1 = cA + (size_t)(t + 1) * kstep;
            const char* a2 = last ? nA : cA + (size_t)(t + 2) * kstep; const char* b2 = last ? nB : cB + (size_t)(t + 2) * kstep;
            const char* a3 = a2 + kstep; const char* b3 = b2 + kstep;
            if (last && has_next) S.a_ready(nxt);
            if constexpr (SP2) {
            PG8_LDB(B0, 0, 0); PG8_LDB(B1, 0, 1); PG8_SCHED; PG8_LDA(At, 0, 0); PG8_STAGE(PG8_SA(1, 1), a1 + hA, voffA);
            PG8_WAIT_V(8); PG8_WAIT_L(0); PG8_BAR; PG8_MMA(0, 0, At, B0); PG8_MMA(0, 1, At, B1); PG8_BAR; PG8_SCHED;
            PG8_LDA(At, 0, 1); PG8_STAGE(PG8_SB(0, 0), b2, voffB); PG8_STAGE(PG8_SB(0, 1), b2 + hB, voffB); PG8_STAGE(PG8_SA(0, 0), a2, voffA);
            PG8_WAIT_V(8); PG8_WAIT_L(0); PG8_BAR; PG8_MMA(1, 0, At, B0); PG8_MMA(1, 1, At, B1); PG8_BAR; PG8_SCHED;
            PG8_LDB(B0, 1, 0); PG8_LDB(B1, 1, 1); PG8_SCHED; PG8_LDA(At, 1, 0); PG8_STAGE(PG8_SA(0, 1), a2 + hA, voffA);
            PG8_WAIT_V(8); PG8_WAIT_L(0); PG8_BAR; PG8_MMA(0, 0, At, B0); PG8_MMA(0, 1, At, B1); PG8_BAR; PG8_SCHED;
            PG8_LDA(At, 1, 1); PG8_STAGE(PG8_SB(1, 0), b3, voffB); PG8_STAGE(PG8_SB(1, 1), b3 + hB, voffB); PG8_STAGE(PG8_SA(1, 0), a3, voffA);
            PG8_WAIT_V(8); PG8_WAIT_L(0); PG8_BAR; PG8_MMA(1, 0, At, B0); PG8_MMA(1, 1, At, B1); PG8_BAR; PG8_SCHED;
            } else {
            PG8_LDB(B0, 0, 0); PG8_SCHED; PG8_LDA(At, 0, 0); PG8_STAGE(PG8_SA(1, 1), a1 + hA, voffA);
            PG8_WAIT_L(8); PG8_BAR; PG8_WAIT_L(0); PG8_MMA(0, 0, At, B0); PG8_BAR; PG8_SCHED;
            PG8_LDB(B1, 0, 1); PG8_STAGE(PG8_SB(0, 0), b2, voffB);
            PG8_BAR; PG8_WAIT_L(0); PG8_MMA(0, 1, At, B1); PG8_BAR;
            PG8_LDA(At, 0, 1); PG8_STAGE(PG8_SA(0, 0), a2, voffA);
            PG8_BAR; PG8_WAIT_L(0); PG8_MMA(1, 0, At, B0); PG8_BAR; PG8_SCHED;
            PG8_STAGE(PG8_SB(0, 1), b2 + hB, voffB);
            PG8_WAIT_V(6); PG8_BAR; PG8_MMA(1, 1, At, B1); PG8_BAR;
            PG8_LDB(B0, 1, 0); PG8_SCHED; PG8_LDA(At, 1, 0); PG8_STAGE(PG8_SA(0, 1), a2 + hA, voffA);
            PG8_WAIT_L(8); PG8_BAR; PG8_WAIT_L(0); PG8_MMA(0, 0, At, B0); PG8_BAR; PG8_SCHED;
            PG8_LDB(B1, 1, 1); PG8_STAGE(PG8_SB(1, 0), b3, voffB);
            PG8_BAR; PG8_WAIT_L(0); PG8_MMA(0, 1, At, B1); PG8_BAR;
            PG8_LDA(At, 1, 1); PG8_STAGE(PG8_SA(1, 0), a3, voffA);
            PG8_BAR; PG8_WAIT_L(0); PG8_MMA(1, 0, At, B0); PG8_BAR; PG8_SCHED;
            PG8_STAGE(PG8_SB(1, 1), b3 + hB, voffB);
            PG8_WAIT_V(6); PG8_BAR; PG8_MMA(1, 1, At, B1); PG8_BAR;
            }
        }
        if constexpr (ALIGN_EPI) { if (wr == 0) PG8_BAR; }
        if constexpr (!Epi::AFTER_DRAIN) { E(acc, cur, wr, wc, fr, fq); S.done(cur); }
        if (!has_next) break;
#pragma unroll
        for (int a = 0; a < 2; ++a)
#pragma unroll
            for (int b = 0; b < 2; ++b)
#pragma unroll
                for (int m = 0; m < 4; ++m)
#pragma unroll
                    for (int n = 0; n < 2; ++n) acc[a][b][m][n] = (f32x4){0.f, 0.f, 0.f, 0.f};
        cur = nxt; cA = nA; cB = nB; ++ui;
        if constexpr (ALIGN_EPI) { if (wr == 1) PG8_BAR; }
    }
    PG8_WAIT_V(0);
    if constexpr (!ALIGN_EPI) { if (wr == 0) PG8_BAR; }
    PG8_BAR;
    if constexpr (Epi::AFTER_DRAIN) { E.fused(acc, cur, wr, wc, fr, fq, lds, wid, lane); S.done(cur); }
#undef PG8_SA
#undef PG8_SB
#undef PG8_STAGE
#undef PG8_LDA
#undef PG8_LDB
#undef PG8_MMA
#undef PG8_WAIT_V
#undef PG8_WAIT_L
#undef PG8_BAR
#undef PG8_SCHED
}
}

#ifndef ONE_LAUNCH
#define ONE_LAUNCH 0
#endif
constexpr int NWAVES = 8, NTHR = 512;
constexpr int D = 1024, BATCH = 4, SEQ = 8192, NMETA = 16, TT = SEQ + NMETA;
constexpr int NREAL = BATCH * SEQ;
constexpr int NROWS = NREAL + NMETA;
constexpr int R = 33024;
constexpr int PW = 2304;
constexpr int PC_CQ = 0, PC_CKV = 256, PC_KIDX = 384, PC_WIDX = 448, PC_R = 512, PC_K = 1024, PC_V = 1536, PC_WD = 2048, PC_AD = 2112, PC_GD = 2176;
constexpr int QAW = 1536;
constexpr int DFF = 2816, UPW = 5632;
constexpr int TOPK = 256;
constexpr float LN_EPS = 1e-5f, GN_EPS = 64e-5f, ALPHA = 1.18920711500272f;

constexpr size_t MiB = 1u << 20;
constexpr size_t WS_CTL = 0, CTL_ZERO_BYTES = 1 * MiB;
constexpr size_t WS_WT_IN = 1 * MiB, WS_WT_QA = 6 * MiB, WS_WT_MIX = 7 * MiB, WS_WT_UP = 10 * MiB, WS_WT_DN = 21 * MiB;
constexpr size_t WS_META1 = 27 * MiB, WS_NSEL = 28 * MiB, WS_WIDX = 29 * MiB;
constexpr size_t WS_H = 33 * MiB;
constexpr size_t WS_P = 98 * MiB, WS_QA = 244 * MiB, WS_CQN = 341 * MiB, WS_SEL = 341 * MiB, WS_CKV = 358 * MiB, WS_KIDX = 367 * MiB;
constexpr size_t WS_DEC = 372 * MiB, WS_AB = 437 * MiB, WS_GB = 470 * MiB;
constexpr size_t WS_WT_LORA = 26 * MiB + 512 * 1024;
constexpr size_t WS_RWM = 372 * MiB, WS_RWN = 405 * MiB, WS_RWQ = 438 * MiB, WS_RWY = 471 * MiB;
constexpr size_t OUT_RWS = 80 * MiB, OUT_BONUS = 116 * MiB;
constexpr size_t WS_G01 = 480 * MiB, WS_V01 = 484 * MiB, WS_GHALO = 488 * MiB, WS_GMETA = 492 * MiB;
constexpr size_t WS_UP = 98 * MiB;
constexpr size_t WS_END = 512 * MiB;
static_assert(WS_P + (size_t)R * PW * 2 <= WS_QA && WS_QA + (size_t)R * QAW * 2 <= WS_CQN && WS_CQN + (size_t)R * 256 * 2 <= WS_CKV && WS_CKV + (size_t)R * 128 * 2 <= WS_KIDX
              && WS_KIDX + (size_t)R * 64 * 2 <= WS_DEC && WS_DEC + (size_t)R * 512 * 4 <= WS_AB && WS_AB + (size_t)R * 512 * 2 <= WS_GB && WS_GB + (size_t)R * 512 * 2 <= WS_END
              && WS_UP + (size_t)R * UPW * 2 <= WS_END && WS_H + (size_t)R * D * 2 <= WS_P && WS_WIDX + (size_t)R * 8 * 4 <= WS_H && WS_NSEL + (size_t)R * 4 <= WS_WIDX, "ws map");
constexpr int CW_BAR = 4096;

constexpr int RING_OFF = 0, RING_BYTES = 131072;
constexpr int LDSCTL_OFF = RING_BYTES, MISC_OFF = LDSCTL_OFF + 320;
constexpr int LDS_BYTES = 147456;

#define GAS __attribute__((address_space(1)))
#define LAS __attribute__((address_space(3)))
typedef unsigned short bf16;
typedef unsigned v4u __attribute__((ext_vector_type(4)));
typedef unsigned v2u __attribute__((ext_vector_type(2)));
typedef float f32x4 __attribute__((ext_vector_type(4)));
typedef GAS unsigned gu32;
typedef __bf16 bf16x2_t __attribute__((ext_vector_type(2)));
__device__ __forceinline__ unsigned f2bf(float f) { return (unsigned)__builtin_bit_cast(unsigned short, (__bf16)f); }
__device__ __forceinline__ unsigned pk2(float lo, float hi) { const bf16x2_t v = {(__bf16)lo, (__bf16)hi}; return __builtin_bit_cast(unsigned, v); }
__device__ __forceinline__ float fast_rcp(float x) { return __builtin_amdgcn_rcpf(x); }
__device__ __forceinline__ float fast_tanh(float x) { return 1.0f - 2.0f * __builtin_amdgcn_rcpf(1.0f + __expf(2.0f * x)); }
__device__ __forceinline__ float bf2f(unsigned short b) { return __uint_as_float(((unsigned)b) << 16); }
__device__ __forceinline__ float bflo(unsigned w) { return __uint_as_float(w << 16); }
__device__ __forceinline__ float bfhi(unsigned w) { return __uint_as_float(w & 0xffff0000u); }
#define DPP_F(v, ctrl) __builtin_bit_cast(float, __builtin_amdgcn_update_dpp(0, __builtin_bit_cast(int, (v)), (ctrl), 0xf, 0xf, false))
__device__ __forceinline__ float rdlane_f(float v, int lane) { return __builtin_bit_cast(float, __builtin_amdgcn_readlane(__builtin_bit_cast(int, v), lane)); }
__device__ __forceinline__ float wave_sum(float v) {
    v += DPP_F(v, 0xB1); v += DPP_F(v, 0x4E); v += DPP_F(v, 0x141); v += DPP_F(v, 0x140);
    return (rdlane_f(v, 0) + rdlane_f(v, 16)) + (rdlane_f(v, 32) + rdlane_f(v, 48));
}
__device__ __forceinline__ float wave_max(float v) {
    v = fmaxf(v, DPP_F(v, 0xB1)); v = fmaxf(v, DPP_F(v, 0x4E)); v = fmaxf(v, DPP_F(v, 0x141)); v = fmaxf(v, DPP_F(v, 0x140));
    return fmaxf(fmaxf(rdlane_f(v, 0), rdlane_f(v, 16)), fmaxf(rdlane_f(v, 32), rdlane_f(v, 48)));
}
#define DPP_U0(v, ctrl) ((unsigned)__builtin_amdgcn_update_dpp(0, (int)(v), (ctrl), 0xf, 0xf, true))
__device__ __forceinline__ unsigned wave_scan_incl(unsigned v, int lane) {
    v += DPP_U0(v, 0x111); v += DPP_U0(v, 0x112); v += DPP_U0(v, 0x114); v += DPP_U0(v, 0x118);
    const unsigned r0 = (unsigned)__builtin_amdgcn_readlane((int)v, 15), r1 = (unsigned)__builtin_amdgcn_readlane((int)v, 31), r2 = (unsigned)__builtin_amdgcn_readlane((int)v, 47);
    const int row = lane >> 4;
    return v + (row >= 1 ? r0 : 0u) + (row >= 2 ? r1 : 0u) + (row >= 3 ? r2 : 0u);
}
__device__ __forceinline__ float sigmoidf_(float x) { return __builtin_amdgcn_rcpf(1.0f + __expf(-x)); }
#define XB_TMO      128
#define XB_XCNT(j)  (256  + 64 * (j))
#define XB_XSUB(j)  (1280 + 64 * (j))
#define XB_XGEN(j)  (2304 + 64 * (j))
#define XB_TOP      3328
#define XB_TOPGEN   3392
#define XCD_BAR_WORDS 3456
#define XB_SPIN_CAP (1u << 18)

__device__ __forceinline__ unsigned xb_ld(unsigned* p)              { return __hip_atomic_load(p, __ATOMIC_RELAXED, __HIP_MEMORY_SCOPE_AGENT); }
__device__ __forceinline__ unsigned xb_add(unsigned* p, unsigned v) { return __hip_atomic_fetch_add(p, v, __ATOMIC_RELAXED, __HIP_MEMORY_SCOPE_AGENT); }
__device__ __forceinline__ unsigned xb_xcc_id() { return (unsigned)__builtin_amdgcn_s_getreg((3 << 11) | 20) & 0xFu; }
#define XB_SPIN(cond, bar) do { unsigned _sp = 0; while (cond) { __builtin_amdgcn_s_sleep(1); \
    if ((++_sp & 255u) == 0u) { if (xb_ld(&(bar)[XB_TMO])) break; if (_sp > XB_SPIN_CAP) { atomicAdd(&(bar)[XB_TMO], 1u); break; } } } } while (0)

struct XcdBarrier {
    unsigned* bar; unsigned x;
    volatile LAS unsigned* st;
};

__device__ __forceinline__ XcdBarrier xcd_barrier_post(unsigned* bar, volatile LAS unsigned* st) {
    XcdBarrier b; b.bar = bar; b.x = xb_xcc_id(); b.st = st;
    if (threadIdx.x == 0) (void)xb_add(&bar[XB_XCNT(b.x)], 1u);
    return b;
}
__device__ __forceinline__ void xcd_barrier_complete(unsigned* bar, unsigned x, unsigned& nloc, unsigned& nx) {
    const unsigned G = gridDim.x * gridDim.y * gridDim.z;
    unsigned sum, cnt, mine, sp = 0u;
    for (;;) {
        sum = 0u; cnt = 0u; mine = 0u;
#pragma unroll
        for (unsigned j = 0; j < 16; ++j) { const unsigned c = xb_ld(&bar[XB_XCNT(j)]); sum += c; cnt += (c > 0u) ? 1u : 0u; mine = (j == x) ? c : mine; }
        if (sum == G) break;
        __builtin_amdgcn_s_sleep(1);
        if ((++sp & 255u) == 0u) { if (xb_ld(&bar[XB_TMO])) break; if (sp > XB_SPIN_CAP) { atomicAdd(&bar[XB_TMO], 1u); break; } }
    }
    nloc = mine > 0u ? mine : 1u; nx = cnt > 0u ? cnt : 1u;
}

__device__ __forceinline__ void xcd_barrier(const XcdBarrier& b) {
    asm volatile("s_waitcnt vmcnt(0)" ::: "memory");
    __syncthreads();
    if (threadIdx.x == 0) {
        unsigned* bar = b.bar;
        __builtin_amdgcn_s_waitcnt(0);
        unsigned nloc = b.st[0], nx = b.st[1];
        if (nloc == 0u) { xcd_barrier_complete(bar, b.x, nloc, nx); b.st[0] = nloc; b.st[1] = nx; }
        const unsigned old = xb_add(&bar[XB_XSUB(b.x)], 1u);
        const unsigned gen = old / nloc;
        if (old + 1u == (gen + 1u) * nloc) {
            __builtin_amdgcn_fence(__ATOMIC_RELEASE, "agent");
            asm volatile("s_waitcnt vmcnt(0)" ::: "memory");
            const unsigned og = xb_add(&bar[XB_TOP], 1u);
            const unsigned tg = og / nx;
            if (og + 1u == (tg + 1u) * nx) xb_add(&bar[XB_TOPGEN], 1u);
            else XB_SPIN(xb_ld(&bar[XB_TOPGEN]) == tg, bar);
            __builtin_amdgcn_fence(__ATOMIC_ACQUIRE, "agent");
            xb_add(&bar[XB_XGEN(b.x)], 1u);
            asm volatile("s_waitcnt vmcnt(0)" ::: "memory");
        } else {
            XB_SPIN(xb_ld(&bar[XB_XGEN(b.x)]) == gen, bar);
            __builtin_amdgcn_fence(__ATOMIC_ACQUIRE, "agent");
            asm volatile("s_waitcnt vmcnt(0)" ::: "memory");
        }
    }
    __syncthreads();
}

struct Frame {
    LAS unsigned char* lds;
    volatile LAS unsigned* MISC;
    gu32* ctl;
    int tid, lane, wave, G;
    const float* in[32];
    float* out;
    unsigned char* ws;
};
#define IN_X 0
#define IN_META 1
#define IN_LNIN_G 2
#define IN_LNIN_B 3
#define IN_W_IN 4
#define IN_QNORM_G 5
#define IN_W_UQ 6
#define IN_KVNORM_G 7
#define IN_W_UKV 8
#define IN_W_IQ 9
#define IN_IDXLN_G 10
#define IN_IDXLN_B 11
#define IN_MU 12
#define IN_W0 13
#define IN_W_DEC 14
#define IN_A0 15
#define IN_W_AAA 16
#define IN_W_GATE 17
#define IN_KK 18
#define IN_KA 19
#define IN_RK 20
#define IN_GN_G 21
#define IN_GN_B 22
#define IN_W_OUT 23
#define IN_LN1_G 24
#define IN_LN1_B 25
#define IN_W_UP 26
#define IN_CONV_W 27
#define IN_CONV_B 28
#define IN_W_DN 29
#define IN_LN2_G 30
#define IN_LN2_B 31

#define WSP(T, off) ((T*)(F.ws + (off)))

__device__ __forceinline__ int key_row(int b, int j) { return j < NMETA ? NREAL + j : b * SEQ + (j - NMETA); }

__device__ __forceinline__ int tr_col(int n, int mode, int cut0, int cut1, int shift) {
    if (mode == 1) { const int pn = n >> 8, x = n & 255; return x < 128 ? 128 * pn + x : DFF + 128 * pn + (x - 128); }
    return n < cut0 ? n : (n < cut1 ? -1 : n - shift);
}
struct TrJob { const float* src; int src_ld, src_r0; bf16* dst; int dst_ld, dst_c0, Nn, K, mode, cut0, cut1, shift; };
__device__ __forceinline__ void tr_item(const TrJob& j, int item, LAS float* scr, int lane) {
    const int nblk = j.Nn / 32, kb = item / nblk, nb = item % nblk, k0 = 64 * kb, n0 = 32 * nb;
    const int col = tr_col(n0 + (lane & 31), j.mode, j.cut0, j.cut1, j.shift);
    const float* sp = j.src + (size_t)(j.src_r0 + k0 + (lane >> 5)) * j.src_ld + (col >= 0 ? col : 0);
    float v[32];
#pragma unroll
    for (int i = 0; i < 32; ++i) v[i] = sp[(size_t)(2 * i) * j.src_ld];
#pragma unroll
    for (int i = 0; i < 32; ++i) scr[(2 * i + (lane >> 5)) * 33 + (lane & 31)] = col >= 0 ? v[i] : 0.f;
    asm volatile("s_waitcnt lgkmcnt(0)" ::: "memory");
    const int c = lane & 7;
#pragma unroll
    for (int q = 0; q < 4; ++q) { const int n = (lane >> 3) + 8 * q; const LAS float* t = scr + (8 * c) * 33 + n;
        *(v4u*)(j.dst + (size_t)(n0 + n) * j.dst_ld + j.dst_c0 + k0 + 8 * c) = (v4u){pk2(t[0], t[33]), pk2(t[66], t[99]), pk2(t[132], t[165]), pk2(t[198], t[231])}; }
    asm volatile("s_waitcnt lgkmcnt(0)" ::: "memory");
}
__device__ __forceinline__ void tr_job(Frame& F, const TrJob& j, int& base) {
    LAS float* scr = (LAS float*)(F.lds + F.wave * 8704);
    const int gw = blockIdx.x * NWAVES + F.wave, NGW = F.G * NWAVES, ni = (j.K / 64) * (j.Nn / 32);
    for (int it = ((gw - base) % NGW + NGW) % NGW; it < ni; it += NGW) tr_item(j, it, scr, F.lane);
    base = (base + ni) % NGW;
}
__device__ __forceinline__ void p0_weights(Frame& F) {
    bf16* WT_IN = WSP(bf16, WS_WT_IN); bf16* WT_QA = WSP(bf16, WS_WT_QA); bf16* WT_MIX = WSP(bf16, WS_WT_MIX); bf16* WT_UP = WSP(bf16, WS_WT_UP); bf16* WT_DN = WSP(bf16, WS_WT_DN);
    bf16* WdT = WSP(bf16, WS_WT_LORA);
    int base = 0;
    tr_job(F, TrJob{F.in[IN_W_UP], UPW, 0, WT_UP, D, 0, UPW, D, 1, 0, 0, 0}, base);
    tr_job(F, TrJob{F.in[IN_W_DN], D, 0, WT_DN, DFF, 0, D, DFF, 0, D, D, 0}, base);
    tr_job(F, TrJob{F.in[IN_W_IN], 2248, 0, WT_IN, D, 0, PW, D, 0, 456, 512, 56}, base);
    tr_job(F, TrJob{F.in[IN_W_OUT], D, 512, WT_MIX, 1536, 1024, D, 512, 0, D, D, 0}, base);
    tr_job(F, TrJob{F.in[IN_W_IQ], 512, 0, WT_QA + (size_t)1024 * 256, 256, 0, 512, 256, 0, 512, 512, 0}, base);
    tr_job(F, TrJob{F.in[IN_W_GATE], 512, 0, WdT + 2 * 512 * 64, 128, 0, 512, 128, 0, 512, 512, 0}, base);
    tr_job(F, TrJob{F.in[IN_W_DEC], 512, 0, WdT, 64, 0, 512, 64, 0, 512, 512, 0}, base);
    tr_job(F, TrJob{F.in[IN_W_AAA], 512, 0, WdT + 512 * 64, 64, 0, 512, 64, 0, 512, 512, 0}, base);
    const float* w_uq = F.in[IN_W_UQ]; const float* w_ukv = F.in[IN_W_UKV]; const float* w_out = F.in[IN_W_OUT];
    for (int it = blockIdx.x * NTHR + F.tid; it < 256 * 8 * 8; it += F.G * NTHR) {
        const int c = it & 255, hb = __builtin_amdgcn_readfirstlane(it >> 8), h = hb >> 3, j0 = (hb & 7) * 16;
        float acc[16];
#pragma unroll
        for (int jj = 0; jj < 16; ++jj) acc[jj] = 0.f;
        for (int d = 0; d < 64; ++d) {
            const float a = w_uq[(size_t)c * 512 + h * 64 + d];
#pragma unroll
            for (int jj = 0; jj < 16; ++jj) acc[jj] += a * w_ukv[(size_t)(j0 + jj) * 1024 + h * 128 + d];
        }
#pragma unroll
        for (int jj = 0; jj < 16; ++jj) WT_QA[(size_t)(h * 128 + j0 + jj) * 256 + c] = (bf16)f2bf(0.125f * acc[jj]);
    }
    for (int it = blockIdx.x * NTHR + F.tid; it < 1024 * 8 * 8; it += F.G * NTHR) {
        const int n = it & 1023, hb = __builtin_amdgcn_readfirstlane(it >> 10), h = hb >> 3, j0 = (hb & 7) * 16;
        float acc[16];
#pragma unroll
        for (int jj = 0; jj < 16; ++jj) acc[jj] = 0.f;
        for (int d = 0; d < 64; ++d) {
            const float a = w_out[(size_t)(h * 64 + d) * D + n];
#pragma unroll
            for (int jj = 0; jj < 16; ++jj) acc[jj] += a * w_ukv[(size_t)(j0 + jj) * 1024 + h * 128 + 64 + d];
        }
        v4u o0, o1;
        o0.x = pk2(acc[0], acc[1]); o0.y = pk2(acc[2], acc[3]); o0.z = pk2(acc[4], acc[5]); o0.w = pk2(acc[6], acc[7]);
        o1.x = pk2(acc[8], acc[9]); o1.y = pk2(acc[10], acc[11]); o1.z = pk2(acc[12], acc[13]); o1.w = pk2(acc[14], acc[15]);
        *(v4u*)(WT_MIX + (size_t)n * 1536 + h * 128 + j0) = o0; *(v4u*)(WT_MIX + (size_t)n * 1536 + h * 128 + j0 + 8) = o1;
    }
}

__device__ __forceinline__ void ln_row_bf16(Frame& F, const float* src, const float* g, const float* b, bf16* dst) {
    v2u* o8 = (v2u*)dst + F.lane;
    if (!src) {
#pragma unroll
        for (int j = 0; j < 4; ++j) o8[64 * j] = (v2u){0u, 0u};
        return;
    }
    const f32x4* xr = (const f32x4*)src + F.lane;
    f32x4 v[4]; float s = 0.f;
#pragma unroll
    for (int j = 0; j < 4; ++j) { v[j] = xr[64 * j]; s += (v[j].x + v[j].y) + (v[j].z + v[j].w); }
    const float mean = wave_sum(s) * (1.f / D); float s2 = 0.f;
#pragma unroll
    for (int j = 0; j < 4; ++j) { v[j] = v[j] - mean; s2 += (v[j].x * v[j].x + v[j].y * v[j].y) + (v[j].z * v[j].z + v[j].w * v[j].w); }
    const float rstd = 1.f / sqrtf(wave_sum(s2) * (1.f / D) + LN_EPS);
#pragma unroll
    for (int j = 0; j < 4; ++j) {
        const f32x4 gg = ((const f32x4*)g)[F.lane + 64 * j], bb = ((const f32x4*)b)[F.lane + 64 * j];
        const f32x4 y = v[j] * rstd * gg + bb;
        o8[64 * j] = (v2u){pk2(y.x, y.y), pk2(y.z, y.w)};
    }
}
__device__ __forceinline__ void p1_ln_in(Frame& F) {
    bf16* H0 = WSP(bf16, WS_H);
    const int gw = blockIdx.x * NWAVES + F.wave, NGW = F.G * NWAVES;
    const f32x4* gp = (const f32x4*)F.in[IN_LNIN_G] + F.lane; const f32x4* bp = (const f32x4*)F.in[IN_LNIN_B] + F.lane;
    f32x4 gg[4], bb[4];
#pragma unroll
    for (int j = 0; j < 4; ++j) { gg[j] = gp[64 * j]; bb[j] = bp[64 * j]; }
    for (int r0 = gw * 4; r0 < NROWS; r0 += NGW * 4) {
        f32x4 v[4][4];
#pragma unroll
        for (int q = 0; q < 4; ++q) {
            const int r = r0 + q < NROWS ? r0 + q : NROWS - 1;
            const f32x4* xr = (const f32x4*)(r < NREAL ? F.in[IN_X] + (size_t)r * D : F.in[IN_META] + (size_t)(r - NREAL) * D) + F.lane;
#pragma unroll
            for (int j = 0; j < 4; ++j) v[q][j] = xr[64 * j];
        }
#pragma unroll
        for (int q = 0; q < 4; ++q) {
            float s = 0.f;
#pragma unroll
            for (int j = 0; j < 4; ++j) s += (v[q][j].x + v[q][j].y) + (v[q][j].z + v[q][j].w);
            const float mean = wave_sum(s) * (1.f / D); float s2 = 0.f;
#pragma unroll
            for (int j = 0; j < 4; ++j) { v[q][j] = v[q][j] - mean; s2 += (v[q][j].x * v[q][j].x + v[q][j].y * v[q][j].y) + (v[q][j].z * v[q][j].z + v[q][j].w * v[q][j].w); }
            const float rstd = 1.f / sqrtf(wave_sum(s2) * (1.f / D) + LN_EPS);
            if (r0 + q < NROWS) {
                v2u* o8 = (v2u*)(H0 + (size_t)(r0 + q) * D) + F.lane;
#pragma unroll
                for (int j = 0; j < 4; ++j) { const f32x4 y = v[q][j] * rstd * gg[j] + bb[j]; o8[64 * j] = (v2u){pk2(y.x, y.y), pk2(y.z, y.w)}; }
            }
        }
    }
}

__device__ __forceinline__ void p3_prep(Frame& F) {
    const bf16* P = WSP(bf16, WS_P); bf16* CQN = WSP(bf16, WS_CQN); bf16* CKV = WSP(bf16, WS_CKV); bf16* KIDX = WSP(bf16, WS_KIDX); float* WIDX = WSP(float, WS_WIDX);
    const int gw = blockIdx.x * NWAVES + F.wave, NGW = F.G * NWAVES, l = F.lane;
    for (int r = gw; r < R; r += NGW) {
        const bf16* pr = P + (size_t)r * PW;
        if (r >= NROWS) {
            *(v2u*)(CQN + (size_t)r * 256 + 4 * l) = (v2u){0u, 0u};
            continue;
        }
        {
            const v2u w = *(const v2u*)(pr + PC_CQ + 4 * l);
            const float a0 = bflo(w.x), a1 = bfhi(w.x), a2 = bflo(w.y), a3 = bfhi(w.y);
            const float ss = wave_sum(a0 * a0 + a1 * a1 + a2 * a2 + a3 * a3);
            const float rs = 1.0f / sqrtf(ss * (1.f / 256.f) + 1e-6f);
            const f32x4 g = ((const f32x4*)F.in[IN_QNORM_G])[l];
            *(v2u*)(CQN + (size_t)r * 256 + 4 * l) = (v2u){pk2(a0 * rs * g.x, a1 * rs * g.y), pk2(a2 * rs * g.z, a3 * rs * g.w)};
        }
        {
            const unsigned w = *(const unsigned*)(pr + PC_CKV + 2 * l);
            const float a0 = bflo(w), a1 = bfhi(w);
            const float ss = wave_sum(a0 * a0 + a1 * a1);
            const float rs = 1.0f / sqrtf(ss * (1.f / 128.f) + 1e-6f);
            const float g0 = F.in[IN_KVNORM_G][2 * l], g1 = F.in[IN_KVNORM_G][2 * l + 1];
            *(unsigned*)(CKV + (size_t)r * 128 + 2 * l) = pk2(a0 * rs * g0, a1 * rs * g1);
        }
        {
            const float a = bf2f(pr[PC_KIDX + l]);
            const float mean = wave_sum(a) * (1.f / 64.f);
            const float dlt = a - mean;
            const float var = wave_sum(dlt * dlt) * (1.f / 64.f);
            const float y = dlt * (1.0f / sqrtf(var + LN_EPS)) * F.in[IN_IDXLN_G][l] + F.in[IN_IDXLN_B][l];
            KIDX[(size_t)r * 64 + l] = (bf16)f2bf(y);
        }
        if (l < 8) WIDX[(size_t)r * 8 + l] = bf2f(pr[PC_WIDX + l]) * 0.04419417382415922f;
    }
}

#ifndef REFSEL
#define REFSEL 0
#endif
__device__ __forceinline__ void refsel_rows(Frame& F) {
    float* QIDX32 = F.out; float* KIDX32 = F.out + (size_t)R * 512; float* WIDX = WSP(float, WS_WIDX);
    const float* w_in = F.in[IN_W_IN]; const float* w_iq = F.in[IN_W_IQ];
    LAS float* hrow = (LAS float*)(F.lds + F.wave * 8192);
    LAS float* cqn = hrow + 1024;
    const int l = F.lane;
    const int gw = blockIdx.x * NWAVES + F.wave, NGW = F.G * NWAVES;
    for (int r = gw; r < NROWS; r += NGW) {
        const float* src = r < NREAL ? F.in[IN_X] + (size_t)r * D : F.in[IN_META] + (size_t)(r - NREAL) * D;
        {
            const f32x4* xr = (const f32x4*)src + l;
            f32x4 v[4]; float s = 0.f;
#pragma unroll
            for (int j = 0; j < 4; ++j) { v[j] = xr[64 * j]; s += (v[j].x + v[j].y) + (v[j].z + v[j].w); }
            const float mean = wave_sum(s) * (1.f / D); float s2 = 0.f;
#pragma unroll
            for (int j = 0; j < 4; ++j) { v[j] = v[j] - mean; s2 += (v[j].x * v[j].x + v[j].y * v[j].y) + (v[j].z * v[j].z + v[j].w * v[j].w); }
            const float rstd = 1.f / sqrtf(wave_sum(s2) * (1.f / D) + LN_EPS);
#pragma unroll
            for (int j = 0; j < 4; ++j) {
                const f32x4 gg = ((const f32x4*)F.in[IN_LNIN_G])[l + 64 * j], bb = ((const f32x4*)F.in[IN_LNIN_B])[l + 64 * j];
                *(LAS f32x4*)(hrow + 4 * (l + 64 * j)) = v[j] * rstd * gg + bb;
            }
        }
        __builtin_amdgcn_wave_barrier();
        float a[6];
#pragma unroll
        for (int i = 0; i < 6; ++i) a[i] = 0.f;
        for (int k = 0; k < D; ++k) {
            const float hk = hrow[k]; const float* wr = w_in + (size_t)k * 2248;
#pragma unroll
            for (int i = 0; i < 4; ++i) a[i] += hk * wr[l + 64 * i];
            a[4] += hk * wr[384 + l];
            a[5] += hk * wr[448 + (l & 7)];
        }
        const float ss = wave_sum(a[0] * a[0] + a[1] * a[1] + a[2] * a[2] + a[3] * a[3]);
        const float rs = 1.0f / sqrtf(ss * (1.f / 256.f) + 1e-6f);
#pragma unroll
        for (int i = 0; i < 4; ++i) cqn[l + 64 * i] = a[i] * rs * F.in[IN_QNORM_G][l + 64 * i];
        {
            const float mean = wave_sum(a[4]) * (1.f / 64.f); const float dlt = a[4] - mean;
            const float var = wave_sum(dlt * dlt) * (1.f / 64.f);
            KIDX32[(size_t)r * 64 + l] = dlt * (1.0f / sqrtf(var + LN_EPS)) * F.in[IN_IDXLN_G][l] + F.in[IN_IDXLN_B][l];
        }
        if (l < 8) WIDX[(size_t)r * 8 + l] = a[5] * 0.04419417382415922f;
        __builtin_amdgcn_wave_barrier();
        float q[8];
#pragma unroll
        for (int i = 0; i < 8; ++i) q[i] = 0.f;
        for (int c = 0; c < 256; ++c) {
            const float cq = cqn[c]; const float* wr = w_iq + (size_t)c * 512;
#pragma unroll
            for (int i = 0; i < 8; ++i) q[i] += cq * wr[l + 64 * i];
        }
#pragma unroll
        for (int i = 0; i < 8; ++i) QIDX32[(size_t)r * 512 + l + 64 * i] = q[i];
        __builtin_amdgcn_wave_barrier();
    }
}

__device__ __forceinline__ unsigned sortable(float f) { const unsigned u = __float_as_uint(f); return (u & 0x80000000u) ? ~u : (u | 0x80000000u); }
__device__ __forceinline__ void p5_index_naive(Frame& F) {
    const bf16* QA = WSP(bf16, WS_QA); const bf16* KIDX = WSP(bf16, WS_KIDX); const float* WIDX = WSP(float, WS_WIDX);
    unsigned short* SEL = WSP(unsigned short, WS_SEL); int* NSEL = WSP(int, WS_NSEL);
    LAS float* sc = (LAS float*)(F.lds);
    LAS float* qf = (LAS float*)(F.lds + 33024);
    LAS unsigned* hist = (LAS unsigned*)(F.lds + 33024 + 2048);
    LAS unsigned* cw = hist + 256;
    const int tid = F.tid;
    for (int q = blockIdx.x; q < NROWS; q += F.G) {
        int b, pos; if (q < NREAL) { b = q >> 13; pos = NMETA + (q & (SEQ - 1)); } else { b = 0; pos = q - NREAL; }
        const int nvis = pos < NMETA ? NMETA : NMETA + 64 * ((pos - NMETA) / 64 + 1);
#if REFSEL
        qf[tid] = F.out[(size_t)q * 512 + tid];
#else
        qf[tid] = bf2f(QA[(size_t)q * QAW + 1024 + tid]);
#endif
        float w[8];
#pragma unroll
        for (int h = 0; h < 8; ++h) w[h] = WIDX[(size_t)q * 8 + h];
        __syncthreads();
        for (int j = tid; j < nvis; j += NTHR) {
            const v4u* kp = (const v4u*)(KIDX + (size_t)key_row(b, j) * 64);
#if REFSEL
            const f32x4* kp32 = (const f32x4*)(F.out + (size_t)R * 512 + (size_t)key_row(b, j) * 64);
#endif
            float d[8];
#pragma unroll
            for (int h = 0; h < 8; ++h) d[h] = 0.f;
#pragma unroll 2
            for (int c = 0; c < 8; ++c) {
#if REFSEL
                const f32x4 ta = kp32[2 * c], tb = kp32[2 * c + 1];
                const float k0 = ta.x, k1 = ta.y, k2 = ta.z, k3 = ta.w, k4 = tb.x, k5 = tb.y, k6 = tb.z, k7 = tb.w;
#else
                const v4u t = kp[c];
                const float k0 = bflo(t.x), k1 = bfhi(t.x), k2 = bflo(t.y), k3 = bfhi(t.y), k4 = bflo(t.z), k5 = bfhi(t.z), k6 = bflo(t.w), k7 = bfhi(t.w);
#endif
#pragma unroll
                for (int h = 0; h < 8; ++h) {
                    const f32x4 qa = *(const LAS f32x4*)(qf + h * 64 + 8 * c), qb = *(const LAS f32x4*)(qf + h * 64 + 8 * c + 4);
                    d[h] += qa.x * k0 + qa.y * k1 + qa.z * k2 + qa.w * k3 + qb.x * k4 + qb.y * k5 + qb.z * k6 + qb.w * k7;
                }
            }
            float s = 0.f;
#pragma unroll
            for (int h = 0; h < 8; ++h) s += w[h] * fmaxf(d[h], 0.f);
            sc[j] = s + 0.0f;
        }
        __syncthreads();
        unsigned short* selq = SEL + (size_t)q * TOPK;
        if (nvis <= TOPK) {
            for (int j = tid; j < nvis; j += NTHR) selq[j] = (unsigned short)j;
        } else {
            unsigned prefix = 0u, mask = 0u, need = TOPK;
            for (int pass = 0; pass < 4; ++pass) {
                const int shift = 24 - 8 * pass;
                if (tid < 256) hist[tid] = 0u;
                __syncthreads();
                for (int j = tid; j < nvis; j += NTHR) { const unsigned key = sortable(sc[j]); if ((key & mask) == prefix) atomicAdd((unsigned*)&hist[(key >> shift) & 255u], 1u); }
                __syncthreads();
                if (tid < 256) {
                    unsigned above = 0u; for (int bb = tid + 1; bb < 256; ++bb) above += hist[bb];
                    const unsigned c = hist[tid];
                    if (above < need && need <= above + c) { cw[0] = prefix | ((unsigned)tid << shift); cw[1] = need - above; }
                }
                __syncthreads();
                prefix = cw[0]; need = cw[1]; mask |= 0xFFu << shift;
                __syncthreads();
            }
            if (tid == 0) cw[2] = 0u;
            __syncthreads();
            for (int j = tid; j < nvis; j += NTHR) { if (sortable(sc[j]) > prefix) { const unsigned p = atomicAdd((unsigned*)&cw[2], 1u); selq[p] = (unsigned short)j; } }
            __syncthreads();
            if (F.wave == 0) {
                const unsigned base = cw[2]; unsigned taken = 0u;
                for (int j0 = 0; j0 < nvis && taken < need; j0 += 64) {
                    const int j = j0 + F.lane; const bool eq = j < nvis && sortable(sc[j]) == prefix;
                    const unsigned long long m = __ballot(eq);
                    const unsigned rank = (unsigned)__popcll(m & ((1ull << F.lane) - 1ull));
                    if (eq && taken + rank < need) selq[base + taken + rank] = (unsigned short)j;
                    taken += (unsigned)__popcll(m);
                }
            }
        }
        if (tid == 0) NSEL[q] = nvis < TOPK ? nvis : TOPK;
        __syncthreads();
    }
}

__device__ __forceinline__ void p6_attn_naive(Frame& F) {
    bf16* QA = WSP(bf16, WS_QA); const bf16* CKV = WSP(bf16, WS_CKV); const unsigned short* SEL = WSP(unsigned short, WS_SEL); const int* NSEL = WSP(int, WS_NSEL);
    LAS float* qf = (LAS float*)(F.lds + F.wave * 16384);
    LAS float* ps = qf + 1024;
    LAS int* srow = (LAS int*)(ps + 2048);
    const int l = F.lane;
    const int gw = blockIdx.x * NWAVES + F.wave, NGW = F.G * NWAVES;
    for (int q = gw; q < R; q += NGW) {
        bf16* qrow = QA + (size_t)q * QAW;
        if (q >= NROWS) {
            for (int c = l; c < QAW / 8; c += 64) *(v4u*)(qrow + 8 * c) = (v4u){0u, 0u, 0u, 0u};
            continue;
        }
        int b, pos; if (q < NREAL) { b = q >> 13; pos = NMETA + (q & (SEQ - 1)); } else { b = 0; pos = q - NREAL; }
        const int nsel = NSEL[q];
        {
            const v4u t0 = *(const v4u*)(qrow + 16 * l), t1 = *(const v4u*)(qrow + 16 * l + 8);
            LAS float* d = qf + 16 * l;
            d[0] = bflo(t0.x); d[1] = bfhi(t0.x); d[2] = bflo(t0.y); d[3] = bfhi(t0.y); d[4] = bflo(t0.z); d[5] = bfhi(t0.z); d[6] = bflo(t0.w); d[7] = bfhi(t0.w);
            d[8] = bflo(t1.x); d[9] = bfhi(t1.x); d[10] = bflo(t1.y); d[11] = bfhi(t1.y); d[12] = bflo(t1.z); d[13] = bfhi(t1.z); d[14] = bflo(t1.w); d[15] = bfhi(t1.w);
        }
        __builtin_amdgcn_wave_barrier();
        for (int kk = 0; kk < 4; ++kk) {
            const int s = kk * 64 + l; const bool valid = s < nsel;
            const int j = valid ? (int)SEL[(size_t)q * TOPK + s] : 0;
            const int row = key_row(b, j);
            srow[s] = row;
            float acc[8];
#pragma unroll
            for (int h = 0; h < 8; ++h) acc[h] = 0.f;
            const v4u* kp = (const v4u*)(CKV + (size_t)row * 128);
            for (int c8 = 0; c8 < 16; ++c8) {
                const v4u t = kp[c8];
                const float k0 = bflo(t.x), k1 = bfhi(t.x), k2 = bflo(t.y), k3 = bfhi(t.y), k4 = bflo(t.z), k5 = bfhi(t.z), k6 = bflo(t.w), k7 = bfhi(t.w);
#pragma unroll
                for (int h = 0; h < 8; ++h) {
                    const f32x4 qa = *(const LAS f32x4*)(qf + h * 128 + 8 * c8), qb = *(const LAS f32x4*)(qf + h * 128 + 8 * c8 + 4);
                    acc[h] += qa.x * k0 + qa.y * k1 + qa.z * k2 + qa.w * k3 + qb.x * k4 + qb.y * k5 + qb.z * k6 + qb.w * k7;
                }
            }
            const float dist = fabsf((float)(pos - j));
#pragma unroll
            for (int h = 0; h < 8; ++h) { const float slope = __uint_as_float((unsigned)(127 - (h + 1)) << 23); ps[s * 8 + h] = valid ? acc[h] - slope * dist : -INFINITY; }
        }
        __builtin_amdgcn_wave_barrier();
#pragma unroll
        for (int h = 0; h < 8; ++h) {
            float v0 = ps[(l) * 8 + h], v1 = ps[(l + 64) * 8 + h], v2 = ps[(l + 128) * 8 + h], v3 = ps[(l + 192) * 8 + h];
            const float mx = wave_max(fmaxf(fmaxf(v0, v1), fmaxf(v2, v3)));
            v0 = __expf(v0 - mx); v1 = __expf(v1 - mx); v2 = __expf(v2 - mx); v3 = __expf(v3 - mx);
            const float inv = 1.0f / wave_sum((v0 + v1) + (v2 + v3));
            ps[(l) * 8 + h] = v0 * inv; ps[(l + 64) * 8 + h] = v1 * inv; ps[(l + 128) * 8 + h] = v2 * inv; ps[(l + 192) * 8 + h] = v3 * inv;
        }
        __builtin_amdgcn_wave_barrier();
        float o0[8], o1[8];
#pragma unroll
        for (int h = 0; h < 8; ++h) { o0[h] = 0.f; o1[h] = 0.f; }
        for (int s = 0; s < nsel; ++s) {
            const int row = srow[s];
            const unsigned w = *(const unsigned*)(CKV + (size_t)row * 128 + 2 * l);
            const float c0 = bflo(w), c1 = bfhi(w);
            const f32x4 pa = *(const LAS f32x4*)(ps + s * 8), pb = *(const LAS f32x4*)(ps + s * 8 + 4);
            o0[0] += pa.x * c0; o1[0] += pa.x * c1; o0[1] += pa.y * c0; o1[1] += pa.y * c1; o0[2] += pa.z * c0; o1[2] += pa.z * c1; o0[3] += pa.w * c0; o1[3] += pa.w * c1;
            o0[4] += pb.x * c0; o1[4] += pb.x * c1; o0[5] += pb.y * c0; o1[5] += pb.y * c1; o0[6] += pb.z * c0; o1[6] += pb.z * c1; o0[7] += pb.w * c0; o1[7] += pb.w * c1;
        }
#pragma unroll
        for (int h = 0; h < 8; ++h) *(unsigned*)(qrow + h * 128 + 2 * l) = pk2(o0[h], o1[h]);
        __builtin_amdgcn_wave_barrier();
    }
}

__device__ __forceinline__ void p7_rwkv_prep_naive(Frame& F) {
    const bf16* P = WSP(bf16, WS_P); float* DEC = WSP(float, WS_DEC); bf16* AB = WSP(bf16, WS_AB); bf16* GB = WSP(bf16, WS_GB);
    const float* mu = F.in[IN_MU]; const float* Wd = F.in[IN_W_DEC]; const float* Wa = F.in[IN_W_AAA]; const float* Wg = F.in[IN_W_GATE];
    const int l = F.lane;
    const int gw = blockIdx.x * NWAVES + F.wave, NGW = F.G * NWAVES;
    for (int r = gw; r < NROWS; r += NGW) {
        int prev; if (r < NREAL) { prev = (r & (SEQ - 1)) ? r - 1 : NREAL + NMETA - 1; } else { prev = r > NREAL ? r - 1 : -1; }
        const bf16* pr = P + (size_t)r * PW; const bf16* pp = prev >= 0 ? P + (size_t)prev * PW : nullptr;
#define SHIFTED(pc, mc) (bf2f(pr[pc]) + ((pp ? bf2f(pp[pc]) : 0.f) - bf2f(pr[pc])) * mu[mc])
        const float tw = tanhf(SHIFTED(PC_WD + l, 1536 + l));
        const float ta = SHIFTED(PC_AD + l, 1600 + l);
        const float tg0 = sigmoidf_(SHIFTED(PC_GD + l, 1664 + l)), tg1 = sigmoidf_(SHIFTED(PC_GD + 64 + l, 1728 + l));
#undef SHIFTED
        float aw[8], aa[8], ag[8];
#pragma unroll
        for (int i = 0; i < 8; ++i) { aw[i] = F.in[IN_W0][l + 64 * i]; aa[i] = F.in[IN_A0][l + 64 * i]; ag[i] = 0.f; }
        for (int j = 0; j < 64; ++j) {
            const float xw = __shfl(tw, j), xa = __shfl(ta, j), xg0 = __shfl(tg0, j), xg1 = __shfl(tg1, j);
#pragma unroll
            for (int i = 0; i < 8; ++i) {
                aw[i] += xw * Wd[(size_t)j * 512 + l + 64 * i];
                aa[i] += xa * Wa[(size_t)j * 512 + l + 64 * i];
                ag[i] += xg0 * Wg[(size_t)j * 512 + l + 64 * i] + xg1 * Wg[(size_t)(j + 64) * 512 + l + 64 * i];
            }
        }
#pragma unroll
        for (int i = 0; i < 8; ++i) {
            const float x = -aw[i];
            const float sp = x > 20.f ? x : log1pf(__expf(x));
            const float wlog = -sp - 0.5f;
            DEC[(size_t)r * 512 + l + 64 * i] = __expf(-__expf(wlog));
            AB[(size_t)r * 512 + l + 64 * i] = (bf16)f2bf(sigmoidf_(aa[i]));
            GB[(size_t)r * 512 + l + 64 * i] = (bf16)f2bf(ag[i]);
        }
    }
}

__device__ __forceinline__ void p8_rwkv_scan_naive(Frame& F) {
    if (F.wave != 0 || blockIdx.x >= 32) return;
    const bf16* P = WSP(bf16, WS_P); const float* DEC = WSP(float, WS_DEC); const bf16* AB = WSP(bf16, WS_AB); const bf16* GB = WSP(bf16, WS_GB); bf16* QA = WSP(bf16, WS_QA);
    const int b = blockIdx.x >> 3, h = blockIdx.x & 7, l = F.lane, ch = h * 64 + l;
    LAS float* vec = (LAS float*)F.lds;
    const float mu_r = F.in[IN_MU][ch], mu_k = F.in[IN_MU][512 + ch], mu_v = F.in[IN_MU][1024 + ch];
    const float kk_c = F.in[IN_KK][ch], ka_c = F.in[IN_KA][ch], rk_c = F.in[IN_RK][ch], gng = F.in[IN_GN_G][ch], gnb = F.in[IN_GN_B][ch];
    float S[64];
#pragma unroll
    for (int k = 0; k < 64; ++k) S[k] = 0.f;
    float pr_p = 0.f, pk_p = 0.f, pv_p = 0.f;
    int row = key_row(b, 0);
    float n_pr = bf2f(P[(size_t)row * PW + PC_R + ch]), n_pk = bf2f(P[(size_t)row * PW + PC_K + ch]), n_pv = bf2f(P[(size_t)row * PW + PC_V + ch]);
    float n_w = DEC[(size_t)row * 512 + ch], n_a = bf2f(AB[(size_t)row * 512 + ch]), n_g = bf2f(GB[(size_t)row * 512 + ch]);
    for (int pos = 0; pos < TT; ++pos) {
        const int crow = row;
        const float c_pr = n_pr, c_pk = n_pk, c_pv = n_pv, c_w = n_w, c_a = n_a, c_g = n_g;
        if (pos + 1 < TT) {
            row = key_row(b, pos + 1);
            n_pr = bf2f(P[(size_t)row * PW + PC_R + ch]); n_pk = bf2f(P[(size_t)row * PW + PC_K + ch]); n_pv = bf2f(P[(size_t)row * PW + PC_V + ch]);
            n_w = DEC[(size_t)row * 512 + ch]; n_a = bf2f(AB[(size_t)row * 512 + ch]); n_g = bf2f(GB[(size_t)row * 512 + ch]);
        }
        const float r_s = c_pr + (pr_p - c_pr) * mu_r, k_s = c_pk + (pk_p - c_pk) * mu_k, v_s = c_pv + (pv_p - c_pv) * mu_v;
        pr_p = c_pr; pk_p = c_pk; pv_p = c_pv;
        const float kkr = k_s * kk_c;
        const float nrm = sqrtf(wave_sum(kkr * kkr));
        const float kk = kkr / fmaxf(nrm, 1e-12f);
        const float k2 = k_s * (1.f + (c_a - 1.f) * ka_c);
        vec[l] = -kk; vec[64 + l] = kk * c_a; vec[128 + l] = c_w; vec[192 + l] = k2; vec[256 + l] = r_s;
        __builtin_amdgcn_wave_barrier();
        float sa = 0.f;
#pragma unroll
        for (int k4 = 0; k4 < 16; ++k4) { const f32x4 a = *(const LAS f32x4*)(vec + 4 * k4); sa += S[4 * k4] * a.x + S[4 * k4 + 1] * a.y + S[4 * k4 + 2] * a.z + S[4 * k4 + 3] * a.w; }
        float y = 0.f;
#pragma unroll
        for (int k4 = 0; k4 < 16; ++k4) {
            const f32x4 bv = *(const LAS f32x4*)(vec + 64 + 4 * k4), w = *(const LAS f32x4*)(vec + 128 + 4 * k4), kv = *(const LAS f32x4*)(vec + 192 + 4 * k4), rv = *(const LAS f32x4*)(vec + 256 + 4 * k4);
            S[4 * k4] = S[4 * k4] * w.x + sa * bv.x + v_s * kv.x; S[4 * k4 + 1] = S[4 * k4 + 1] * w.y + sa * bv.y + v_s * kv.y;
            S[4 * k4 + 2] = S[4 * k4 + 2] * w.z + sa * bv.z + v_s * kv.z; S[4 * k4 + 3] = S[4 * k4 + 3] * w.w + sa * bv.w + v_s * kv.w;
            y += S[4 * k4] * rv.x + S[4 * k4 + 1] * rv.y + S[4 * k4 + 2] * rv.z + S[4 * k4 + 3] * rv.w;
        }
        __builtin_amdgcn_wave_barrier();
        const float mean = wave_sum(y) * (1.f / 64.f);
        const float dlt = y - mean;
        const float var = wave_sum(dlt * dlt) * (1.f / 64.f);
        const float yn = dlt * (1.0f / sqrtf(var + GN_EPS)) * gng + gnb;
        const float bonus = wave_sum(r_s * k2 * rk_c) * v_s;
        const float o = (yn + bonus) * c_g;
        if (pos >= NMETA || b == 0) QA[(size_t)crow * QAW + 1024 + ch] = (bf16)f2bf(o);
    }
}

template <bool OUT_BF16>
__device__ __forceinline__ void ln_rows4(Frame& F, int nrows, const float* g, const float* b, bf16* dstb) {
    const int gw = blockIdx.x * NWAVES + F.wave, NGW = F.G * NWAVES;
    const float* META1 = WSP(float, WS_META1);
    f32x4 gg[4], bb[4];
#pragma unroll
    for (int j = 0; j < 4; ++j) { gg[j] = ((const f32x4*)g)[F.lane + 64 * j]; bb[j] = ((const f32x4*)b)[F.lane + 64 * j]; }
    for (int r0 = gw * 4; r0 < nrows; r0 += NGW * 4) {
        f32x4 v[4][4];
#pragma unroll
        for (int q = 0; q < 4; ++q) {
            const int r = r0 + q < nrows ? r0 + q : nrows - 1;
            const f32x4* xr = (const f32x4*)(r < NREAL ? F.out + (size_t)r * D : META1 + (size_t)(r - NREAL) * D) + F.lane;
#pragma unroll
            for (int j = 0; j < 4; ++j) v[q][j] = xr[64 * j];
        }
#pragma unroll
        for (int q = 0; q < 4; ++q) {
            float s = 0.f;
#pragma unroll
            for (int j = 0; j < 4; ++j) s += (v[q][j].x + v[q][j].y) + (v[q][j].z + v[q][j].w);
            const float mean = wave_sum(s) * (1.f / D); float s2 = 0.f;
#pragma unroll
            for (int j = 0; j < 4; ++j) { v[q][j] = v[q][j] - mean; s2 += (v[q][j].x * v[q][j].x + v[q][j].y * v[q][j].y) + (v[q][j].z * v[q][j].z + v[q][j].w * v[q][j].w); }
            const float rstd = 1.f / sqrtf(wave_sum(s2) * (1.f / D) + LN_EPS);
            if (r0 + q < nrows) {
                if (OUT_BF16) { v2u* o8 = (v2u*)(dstb + (size_t)(r0 + q) * D) + F.lane;
#pragma unroll
                    for (int j = 0; j < 4; ++j) { const f32x4 y = v[q][j] * rstd * gg[j] + bb[j]; o8[64 * j] = (v2u){pk2(y.x, y.y), pk2(y.z, y.w)}; }
                } else { f32x4* o = (f32x4*)(F.out + (size_t)(r0 + q) * D) + F.lane;
#pragma unroll
                    for (int j = 0; j < 4; ++j) o[64 * j] = v[q][j] * rstd * gg[j] + bb[j]; }
            }
        }
    }
}
__device__ __forceinline__ void p10_ln1(Frame& F) { ln_rows4<true>(F, NROWS, F.in[IN_LN1_G], F.in[IN_LN1_B], WSP(bf16, WS_H)); }
__device__ __forceinline__ void p14_ln2(Frame& F) { ln_rows4<false>(F, NREAL, F.in[IN_LN2_G], F.in[IN_LN2_B], nullptr); }

__device__ __forceinline__ float gelu_fast(float x) {
    const float u2 = x * (1.5957691216057308f + 0.07135481627260025f * x * x);
    return x * __builtin_amdgcn_rcpf(1.0f + __builtin_amdgcn_exp2f(-1.4426950408889634f * u2));
}
__device__ __forceinline__ void p12_conv_fix(Frame& F) {
    bf16* ACT = WSP(bf16, WS_UP); const float* cw = F.in[IN_CONV_W]; const float* cb = F.in[IN_CONV_B];
    const float* G01 = WSP(float, WS_G01); const float* V01 = WSP(float, WS_V01); const float* GHALO = WSP(float, WS_GHALO); const float* GMETA = WSP(float, WS_GMETA);
    for (int it = blockIdx.x * NTHR + F.tid; it < 128 * 2 * DFF; it += F.G * NTHR) {
        const int j = it % DFF, rr = (it / DFF) & 1, pm = it / (2 * DFF);
        const float* ph = (pm & 31) ? GHALO + (size_t)(pm - 1) * 2 * DFF : GMETA;
        const float g0 = G01[((size_t)pm * 2 + rr) * DFF + j];
        const float g1 = rr ? G01[((size_t)pm * 2) * DFF + j] : ph[DFF + j];
        const float g2 = rr ? ph[DFF + j] : ph[j];
        const float x = cw[j] * g2 + cw[DFF + j] * g1 + cw[2 * DFF + j] * g0 + cb[j];
        ACT[(size_t)(pm * 256 + rr) * DFF + j] = (bf16)f2bf(gelu_fast(x) * V01[((size_t)pm * 2 + rr) * DFF + j]);
    }
}


constexpr int NUNITS = 4096 + 8;
constexpr int RP = 72;
constexpr int SLOT = 64 * RP * 2;
constexpr int FP = 68;
typedef short bf16x8 __attribute__((ext_vector_type(8)));
typedef float f32x16 __attribute__((ext_vector_type(16)));
constexpr size_t RW_MAT = (size_t)NUNITS * 4096;

__device__ __forceinline__ void quad_mma(f32x16& acc, const LAS bf16* Aop, const LAS bf16* Bop, int qr, int qc, int lane) {
    const int r = lane & 31, hf = lane >> 5;
    const LAS bf16* ap = Aop + (32 * qr + r) * RP + 8 * hf; const LAS bf16* bp = Bop + (32 * qc + r) * RP + 8 * hf;
#pragma unroll
    for (int ks = 0; ks < 4; ++ks) {
        const bf16x8 a = *(const LAS bf16x8*)(ap + 16 * ks), b = *(const LAS bf16x8*)(bp + 16 * ks);
        acc = __builtin_amdgcn_mfma_f32_32x32x16_bf16(a, b, acc, 0, 0, 0);
    }
}
#define ACC_M(qr, j, hf) (32 * (qr) + ((j) & 3) + 8 * ((j) >> 2) + 4 * (hf))
__device__ __forceinline__ void store_T(const f32x16& acc, LAS bf16* Z, int qr, int qc, int lane) {
    const int r = lane & 31, hf = lane >> 5;
#pragma unroll
    for (int jj = 0; jj < 4; ++jj)
        *(LAS v2u*)(Z + (32 * qc + r) * RP + 32 * qr + 8 * jj + 4 * hf) = (v2u){pk2(acc[4 * jj], acc[4 * jj + 1]), pk2(acc[4 * jj + 2], acc[4 * jj + 3])};
}
__device__ __forceinline__ void add_T(f32x16& acc, const LAS bf16* Z, int qr, int qc, int lane) {
    const int r = lane & 31, hf = lane >> 5;
#pragma unroll
    for (int jj = 0; jj < 4; ++jj) {
        const v2u w = *(const LAS v2u*)(Z + (32 * qc + r) * RP + 32 * qr + 8 * jj + 4 * hf);
        acc[4 * jj] += bflo(w.x); acc[4 * jj + 1] += bfhi(w.x); acc[4 * jj + 2] += bflo(w.y); acc[4 * jj + 3] += bfhi(w.y);
    }
}
__device__ __forceinline__ void store_T_global(const f32x16& acc, bf16* Z, int qr, int qc, int lane) {
    const int r = lane & 31, hf = lane >> 5;
#pragma unroll
    for (int jj = 0; jj < 4; ++jj)
        *(v2u*)(Z + (32 * qc + r) * 64 + 32 * qr + 8 * jj + 4 * hf) = (v2u){pk2(acc[4 * jj], acc[4 * jj + 1]), pk2(acc[4 * jj + 2], acc[4 * jj + 3])};
}
__device__ __forceinline__ f32x16 zero16() { f32x16 z;
#pragma unroll
    for (int j = 0; j < 16; ++j) z[j] = 0.f;
    return z; }

__device__ __forceinline__ void b1_load_raw(const bf16* P, int u, int w, int l, unsigned short (&rv)[45]) {
    const bool meta = u >= 4096;
    int b = 0, h, c = 0; if (meta) h = u - 4096; else { b = u >> 10; h = (u >> 7) & 7; c = u & 127; }
    const int ch = h * 64 + l, row0 = meta ? NREAL : b * SEQ + c * 64, t0 = 8 * w;
    int prow = -1;
    if (t0 > 0) prow = row0 + t0 - 1; else if (!meta) prow = (c == 0) ? NREAL + NMETA - 1 : row0 - 1;
#pragma unroll
    for (int i = 0; i < 9; ++i) {
        const int t = t0 - 1 + i;
        const int row = i == 0 ? prow : ((!meta || t < NMETA) ? row0 + t : -1);
        const bf16* pp = P + (size_t)(row >= 0 ? row : 0) * PW;
        const unsigned short a0 = pp[PC_R + ch], a1 = pp[PC_K + ch], a2 = pp[PC_V + ch], a3 = pp[PC_WD + l], a4 = pp[PC_AD + l];
        const bool ok = row >= 0;
        rv[5 * i] = ok ? a0 : (unsigned short)0; rv[5 * i + 1] = ok ? a1 : (unsigned short)0; rv[5 * i + 2] = ok ? a2 : (unsigned short)0; rv[5 * i + 3] = ok ? a3 : (unsigned short)0; rv[5 * i + 4] = ok ? a4 : (unsigned short)0;
    }
}

#define LDS_BARRIER() do { asm volatile("s_waitcnt lgkmcnt(0)" ::: "memory"); __builtin_amdgcn_s_barrier(); asm volatile("" ::: "memory"); } while (0)
#ifdef PROBE_B1SEC
#define B1T(k) do { if (blockIdx.x == 0 && F.tid == 0) { const unsigned long long t_ = __builtin_amdgcn_s_memrealtime(); if ((k) == PROBE_B1SEC + 1) b1acc += t_ - b1t0; b1t0 = t_; } } while (0)
#else
#define B1T(k) do {} while (0)
#endif
__device__ __forceinline__ void rw_b1(Frame& F) {
    const bf16* P = WSP(bf16, WS_P);
    bf16* RWM = WSP(bf16, WS_RWM); bf16* RWN = WSP(bf16, WS_RWN); bf16* RWQ = WSP(bf16, WS_RWQ); bf16* RWY = WSP(bf16, WS_RWY);
    float* BONUS = (float*)((char*)F.out + OUT_BONUS);
    const bf16* WdT = WSP(bf16, WS_WT_LORA); const bf16* WaT = WdT + 512 * 64;
    const float* mu = F.in[IN_MU];
    const int w = F.wave, l = F.lane, tid = F.tid;
    LAS unsigned char* L = F.lds;
#define SL(s) ((LAS bf16*)(L + (s) * SLOT))
    LAS float* WL = (LAS float*)(L + 12 * SLOT);
    LAS float* AL = (LAS float*)(L + 0 * SLOT);
    LAS float* OT = (LAS float*)(L + RING_BYTES + 1024);
    LAS float* GL = OT + 512;
    unsigned long long b1acc = 0ull, b1t0 = 0ull; (void)b1acc; (void)b1t0;
    unsigned short rnx[45];
    b1_load_raw(P, (int)blockIdx.x < NUNITS ? (int)blockIdx.x : 0, w, l, rnx);
    for (int u = blockIdx.x; u < NUNITS; u += F.G) {
        const bool meta = u >= 4096;
        int b = 0, h, c = 0; if (meta) h = u - 4096; else { b = u >> 10; h = (u >> 7) & 7; c = u & 127; }
        const int ch = h * 64 + l;
        const int row0 = meta ? NREAL : b * SEQ + c * 64;
        LDS_BARRIER();
        B1T(0);
        float r_s[8], k_s[8], v_s[8], xw[8], xa[8];
        {
            const int t0 = 8 * w;
            unsigned short rc[45];
#pragma unroll
            for (int i = 0; i < 45; ++i) rc[i] = rnx[i];
            float pr = bf2f(rc[0]), pk = bf2f(rc[1]), pv = bf2f(rc[2]), pw = bf2f(rc[3]), pa = bf2f(rc[4]);
            const float mr = mu[ch], mk = mu[512 + ch], mv = mu[1024 + ch], mw = mu[1536 + l], ma = mu[1600 + l];
#pragma unroll
            for (int i = 0; i < 8; ++i) {
                const int t = t0 + i; const bool valid = !meta || t < NMETA;
                const float cr = bf2f(rc[5 * i + 5]), ck = bf2f(rc[5 * i + 6]), cv = bf2f(rc[5 * i + 7]), cw = bf2f(rc[5 * i + 8]), ca = bf2f(rc[5 * i + 9]);
                r_s[i] = valid ? cr + (pr - cr) * mr : 0.f; k_s[i] = valid ? ck + (pk - ck) * mk : 0.f; v_s[i] = valid ? cv + (pv - cv) * mv : 0.f;
                xw[i] = fast_tanh(cw + (pw - cw) * mw); xa[i] = ca + (pa - ca) * ma;
                pr = cr; pk = ck; pv = cv; pw = cw; pa = ca;
            }
#pragma unroll
            for (int i = 0; i < 8; ++i) { SL(8)[(t0 + i) * RP + l] = (bf16)f2bf(xw[i]); SL(9)[(t0 + i) * RP + l] = (bf16)f2bf(xa[i]); }
            {
                const int k = tid >> 3, pc = tid & 7;
                *(LAS v4u*)(SL(10) + k * RP + 8 * pc) = *(const v4u*)(WdT + (size_t)(h * 64 + k) * 64 + 8 * pc);
                *(LAS v4u*)(SL(11) + k * RP + 8 * pc) = *(const v4u*)(WaT + (size_t)(h * 64 + k) * 64 + 8 * pc);
            }
        }
        __syncthreads();
        B1T(1);
        {
            const int pid = w >> 2, q = w & 3, qr = q >> 1, qc = q & 1;
            f32x16 acc = zero16();
            quad_mma(acc, SL(10 + pid), SL(8 + pid), qr, qc, l);
            LAS float* Zf = pid ? AL : WL;
            const int r = l & 31, hf = l >> 5;
#pragma unroll
            for (int jj = 0; jj < 4; ++jj) *(LAS f32x4*)(Zf + (32 * qc + r) * FP + 32 * qr + 8 * jj + 4 * hf) = (f32x4){acc[4 * jj], acc[4 * jj + 1], acc[4 * jj + 2], acc[4 * jj + 3]};
        }
        __syncthreads();
        B1T(2);
        float lw[8], asg[8];
        {
            const float w0c = F.in[IN_W0][ch], a0c = F.in[IN_A0][ch];
            float run = 0.f;
#pragma unroll
            for (int i = 0; i < 8; ++i) {
                const int t = 8 * w + i; const bool valid = !meta || t < NMETA;
                const float x = -(WL[t * FP + l] + w0c);
                const float sp = x > 20.f ? x : __logf(1.0f + __expf(x));
                const float e = -__expf(-sp - 0.5f);
                run += valid ? e : 0.f; lw[i] = run;
                asg[i] = sigmoidf_(AL[t * FP + l] + a0c);
            }
            OT[w * 64 + l] = run;
        }
        __syncthreads();
        {
            float off = 0.f, tot = 0.f;
#pragma unroll
            for (int ww = 0; ww < 8; ++ww) { const float o = OT[ww * 64 + l]; tot += o; off += ww < w ? o : 0.f; }
            if (w == 0) GL[l] = __expf(tot);
            const float kkc = F.in[IN_KK][ch], kac = F.in[IN_KA][ch], rkc = F.in[IN_RK][ch];
            unsigned atc[4], vc[4], bhc[4], khc[4];
            float prevlg = off;
#pragma unroll
            for (int i = 0; i < 8; ++i) {
                const int t = 8 * w + i;
                const float lg = off + lw[i];
                const float g = __expf(lg), gp = __expf(prevlg), gi = __expf(-lg), gh = __expf(tot - lg);
                prevlg = lg;
                const float kkr = k_s[i] * kkc;
                const float kk = kkr * __builtin_amdgcn_rsqf(fmaxf(wave_sum(kkr * kkr), 1e-24f));
                const float k2 = k_s[i] * (1.f + (asg[i] - 1.f) * kac);
                const float bon = wave_sum(r_s[i] * k2 * rkc);
                if (l == 0) BONUS[(size_t)u * 64 + t] = bon;
                const float at = -kk * gp, rt = r_s[i] * g, bt = kk * asg[i] * gi, kt = k2 * gi, bh = kk * asg[i] * gh, kh = k2 * gh;
                SL(0)[t * RP + l] = (bf16)f2bf(at); SL(1)[t * RP + l] = (bf16)f2bf(rt); SL(2)[t * RP + l] = (bf16)f2bf(bt); SL(3)[t * RP + l] = (bf16)f2bf(kt);
                const unsigned ua = f2bf(at), uv = f2bf(v_s[i]), ub = f2bf(bh), uk = f2bf(kh);
                if (i & 1) { atc[i >> 1] |= ua << 16; vc[i >> 1] |= uv << 16; bhc[i >> 1] |= ub << 16; khc[i >> 1] |= uk << 16; }
                else { atc[i >> 1] = ua; vc[i >> 1] = uv; bhc[i >> 1] = ub; khc[i >> 1] = uk; }
            }
            *(LAS v4u*)(SL(4) + l * RP + 8 * w) = (v4u){atc[0], atc[1], atc[2], atc[3]};
            *(LAS v4u*)(SL(5) + l * RP + 8 * w) = (v4u){vc[0], vc[1], vc[2], vc[3]};
            *(LAS v4u*)(SL(6) + l * RP + 8 * w) = (v4u){bhc[0], bhc[1], bhc[2], bhc[3]};
            *(LAS v4u*)(SL(7) + l * RP + 8 * w) = (v4u){khc[0], khc[1], khc[2], khc[3]};
        }
        __syncthreads();
        B1T(3);
        for (int task = w; task < 20; task += 8) {
            const int pid = task >> 2, q = task & 3, qr = q >> 1, qc = q & 1;
            const int bop = pid == 0 ? 0 : pid == 1 ? 2 : pid == 2 ? 0 : 1;
            const int aop = pid == 0 ? 2 : pid == 1 ? 0 : pid == 2 ? 3 : pid == 3 ? 2 : 3;
            f32x16 acc = zero16();
            quad_mma(acc, SL(aop), SL(bop), qr, qc, l);
            const int n = 32 * qc + (l & 31), hf = l >> 5;
#pragma unroll
            for (int j = 0; j < 16; ++j) {
                const int m = ACC_M(qr, j, hf);
                const bool keep = pid == 1 ? (m > n) : (pid <= 2 ? (n > m) : (n >= m));
                acc[j] = keep ? acc[j] : 0.f;
            }
            store_T(acc, SL(8 + pid), qr, qc, l);
        }
        __syncthreads();
        B1T(4);
        const int nq = w & 3, nqr = nq >> 1, nqc = nq & 1;
        f32x16 nacc = zero16();
        if (w < 4) { add_T(nacc, SL(8), nqr, nqc, l); }
        for (int task = w; task < 12; task += 8) {
            const int pid = task >> 2, q = task & 3, qr = q >> 1, qc = q & 1;
            f32x16 acc = zero16();
            if (pid == 0) { quad_mma(acc, SL(9), SL(8), qr, qc, l); store_T(acc, SL(0), qr, qc, l); }
            else if (pid == 1) { quad_mma(acc, SL(8), SL(9), qr, qc, l); store_T(acc, SL(2), qr, qc, l); }
            else { quad_mma(acc, SL(10), SL(5), qr, qc, l); store_T(acc, SL(3), qr, qc, l); }
        }
        __syncthreads();
#pragma unroll
        for (int st = 0; st < 4; ++st) {
            const int pr = (st & 1) ? 10 : 0, pc = (st & 1) ? 13 : 2, pr2 = (st & 1) ? 0 : 10, pc2 = (st & 1) ? 2 : 13, nr = (st & 1) ? 9 : 8, nr2 = (st & 1) ? 8 : 9;
            if (w < 4) {
                add_T(nacc, SL(pr), nqr, nqc, l);
                quad_mma(nacc, SL(pc), SL(nr), nqr, nqc, l);
                store_T(nacc, SL(nr2), nqr, nqc, l);
                f32x16 acc = zero16();
                quad_mma(acc, SL(pc), SL(pr), nqr, nqc, l); store_T(acc, SL(pr2), nqr, nqc, l);
            } else {
                f32x16 acc = zero16();
                quad_mma(acc, SL(pr), SL(pc), nqr, nqc, l); store_T(acc, SL(pc2), nqr, nqc, l);
            }
            __syncthreads();
        }
        if (w < 4) { add_T(nacc, SL(0), nqr, nqc, l); quad_mma(nacc, SL(2), SL(8), nqr, nqc, l); store_T(nacc, SL(9), nqr, nqc, l); }
        __syncthreads();
        B1T(5);
        b1_load_raw(P, u + F.G < NUNITS ? u + F.G : u, w, l, rnx);
        {
            const int pid = w >> 2;
            f32x16 acc = zero16();
            add_T(acc, SL(pid ? 3 : 4), nqr, nqc, l);
            quad_mma(acc, SL(9), SL(pid ? 3 : 4), nqr, nqc, l);
            store_T(acc, SL(pid ? 2 : 0), nqr, nqc, l);
        }
        LDS_BARRIER();
        for (int task = w; task < 16; task += 8) {
            const int pid = task >> 2, q = task & 3, qr = q >> 1, qc = q & 1;
            f32x16 acc = zero16();
            if (pid == 0) { add_T(acc, SL(1), qr, qc, l); quad_mma(acc, SL(0), SL(11), qr, qc, l); store_T_global(acc, RWQ + (size_t)u * 4096, qr, qc, l); }
            else if (pid == 1) { quad_mma(acc, SL(2), SL(11), qr, qc, l); quad_mma(acc, SL(5), SL(12), qr, qc, l); store_T_global(acc, RWY + (size_t)u * 4096, qr, qc, l); }
            else if (pid == 2) {
                quad_mma(acc, SL(0), SL(6), qr, qc, l);
                const int n = 32 * qc + (l & 31), hf = l >> 5; const float gl = GL[n];
#pragma unroll
                for (int j = 0; j < 16; ++j) acc[j] += (ACC_M(qr, j, hf) == n) ? gl : 0.f;
                store_T_global(acc, RWM + (size_t)u * 4096, qr, qc, l);
            } else { quad_mma(acc, SL(6), SL(2), qr, qc, l); quad_mma(acc, SL(7), SL(5), qr, qc, l); store_T_global(acc, RWN + (size_t)u * 4096, qr, qc, l); }
        }
        B1T(6);
    }
#ifdef PROBE_B1SEC
    if (blockIdx.x == 0 && F.tid == 0) { F.MISC[20] = (unsigned)b1acc; }
#endif
#undef SL
}

__device__ __forceinline__ void rw_b2(Frame& F) {
    if (blockIdx.x >= 32) return;
    const bf16* RWM = WSP(bf16, WS_RWM); const bf16* RWN = WSP(bf16, WS_RWN);
    bf16* RWS = (bf16*)((char*)F.out + OUT_RWS);
    const int b = blockIdx.x >> 3, h = blockIdx.x & 7, w = F.wave, l = F.lane;
    LAS unsigned char* L = F.lds;
#define SS(buf, part) ((LAS bf16*)(L + ((buf) * 2 + (part)) * SLOT))
    const int q = w & 3, qr = q >> 1, qc = q & 1, r = l & 31, hf = l >> 5;
    if (w < 4) {
        const bf16* Nm = RWN + (size_t)(4096 + h) * 4096;
#pragma unroll
        for (int jj = 0; jj < 4; ++jj) {
            const v2u wv = *(const v2u*)(Nm + (32 * qc + r) * 64 + 32 * qr + 8 * jj + 4 * hf);
            *(LAS v2u*)(SS(0, 0) + (32 * qc + r) * RP + 32 * qr + 8 * jj + 4 * hf) = wv;
            *(LAS v2u*)(SS(0, 1) + (32 * qc + r) * RP + 32 * qr + 8 * jj + 4 * hf) = (v2u){0u, 0u};
        }
    }
    __syncthreads();
    bf16x8 a_cur[4]; v2u n_cur[4];
    {
        const size_t u0 = (size_t)(b * 8 + h) * 128;
#pragma unroll
        for (int ks = 0; ks < 4; ++ks) a_cur[ks] = *(const bf16x8*)(RWM + u0 * 4096 + (32 * qr + r) * 64 + 8 * hf + 16 * ks);
#pragma unroll
        for (int jj = 0; jj < 4; ++jj) n_cur[jj] = *(const v2u*)(RWN + u0 * 4096 + (32 * qc + r) * 64 + 32 * qr + 8 * jj + 4 * hf);
    }
    for (int c = 0; c < 128; ++c) {
        const int u = (b * 8 + h) * 128 + c, cur = c & 1;
        if (w < 4) {
            bf16x8 a_nxt[4]; v2u n_nxt[4];
            const size_t un = (size_t)(c + 1 < 128 ? u + 1 : u);
#pragma unroll
            for (int ks = 0; ks < 4; ++ks) a_nxt[ks] = *(const bf16x8*)(RWM + un * 4096 + (32 * qr + r) * 64 + 8 * hf + 16 * ks);
#pragma unroll
            for (int jj = 0; jj < 4; ++jj) n_nxt[jj] = *(const v2u*)(RWN + un * 4096 + (32 * qc + r) * 64 + 32 * qr + 8 * jj + 4 * hf);
            f32x16 acc;
#pragma unroll
            for (int jj = 0; jj < 4; ++jj) { acc[4 * jj] = bflo(n_cur[jj].x); acc[4 * jj + 1] = bfhi(n_cur[jj].x); acc[4 * jj + 2] = bflo(n_cur[jj].y); acc[4 * jj + 3] = bfhi(n_cur[jj].y); }
#pragma unroll
            for (int jj = 0; jj < 4; ++jj)
                *(v2u*)(RWS + (size_t)u * 4096 + (32 * qc + r) * 64 + 32 * qr + 8 * jj + 4 * hf) = *(const LAS v2u*)(SS(cur, 0) + (32 * qc + r) * RP + 32 * qr + 8 * jj + 4 * hf);
            const LAS bf16* bh = SS(cur, 0) + (32 * qc + r) * RP + 8 * hf; const LAS bf16* bl = SS(cur, 1) + (32 * qc + r) * RP + 8 * hf;
#pragma unroll
            for (int ks = 0; ks < 4; ++ks) {
                acc = __builtin_amdgcn_mfma_f32_32x32x16_bf16(a_cur[ks], *(const LAS bf16x8*)(bh + 16 * ks), acc, 0, 0, 0);
                acc = __builtin_amdgcn_mfma_f32_32x32x16_bf16(a_cur[ks], *(const LAS bf16x8*)(bl + 16 * ks), acc, 0, 0, 0);
            }
#pragma unroll
            for (int jj = 0; jj < 4; ++jj) {
                float hi[4], lo[4];
#pragma unroll
                for (int e = 0; e < 4; ++e) { const unsigned hb = f2bf(acc[4 * jj + e]); hi[e] = __uint_as_float(hb << 16); lo[e] = acc[4 * jj + e] - hi[e]; }
                *(LAS v2u*)(SS(cur ^ 1, 0) + (32 * qc + r) * RP + 32 * qr + 8 * jj + 4 * hf) = (v2u){pk2(hi[0], hi[1]), pk2(hi[2], hi[3])};
                *(LAS v2u*)(SS(cur ^ 1, 1) + (32 * qc + r) * RP + 32 * qr + 8 * jj + 4 * hf) = (v2u){pk2(lo[0], lo[1]), pk2(lo[2], lo[3])};
            }
#pragma unroll
            for (int ks = 0; ks < 4; ++ks) a_cur[ks] = a_nxt[ks];
#pragma unroll
            for (int jj = 0; jj < 4; ++jj) n_cur[jj] = n_nxt[jj];
        }
        LDS_BARRIER();
    }
#undef SS
}

__device__ __forceinline__ void rw_b3(Frame& F, bool meta_only = false) {
    const bf16* P = WSP(bf16, WS_P); bf16* QA = WSP(bf16, WS_QA);
    const bf16* RWQ = WSP(bf16, WS_RWQ); const bf16* RWY = WSP(bf16, WS_RWY);
    const bf16* RWS = (const bf16*)((const char*)F.out + OUT_RWS); const float* BONUS = (const float*)((const char*)F.out + OUT_BONUS);
    const bf16* WgT = WSP(bf16, WS_WT_LORA) + 2 * 512 * 64;
    const float* mu = F.in[IN_MU];
    const int l = F.lane, r = l & 31, hf = l >> 5;
    const int gw = blockIdx.x * NWAVES + F.wave, NGW = F.G * NWAVES;
    for (int it = meta_only ? 8192 + F.wave : gw; it < (meta_only ? 8200 : 8192); it += meta_only ? NWAVES : NGW) {
        const int u = it < 8192 ? it >> 1 : 4096 + (it - 8192), th = it < 8192 ? (it & 1) : 0;
        const bool meta = u >= 4096;
        int b = 0, h, c = 0; if (meta) h = u - 4096; else { b = u >> 10; h = (u >> 7) & 7; c = u & 127; }
        const int t = 32 * th + r;
        const bool valid = !meta || t < NMETA;
        const int row0 = meta ? NREAL : b * SEQ + c * 64;
        const int row = valid ? row0 + t : row0;
        int prow = -1;
        if (t > 0) prow = row - 1; else if (!meta) prow = (c == 0) ? NREAL + NMETA - 1 : row - 1;
        f32x16 y[2];
#pragma unroll
        for (int qv = 0; qv < 2; ++qv) {
            const bf16* Y0 = RWY + (size_t)u * 4096 + (32 * th + r) * 64 + 32 * qv + 4 * hf;
#pragma unroll
            for (int jj = 0; jj < 4; ++jj) { const v2u wv = *(const v2u*)(Y0 + 8 * jj); y[qv][4 * jj] = bflo(wv.x); y[qv][4 * jj + 1] = bfhi(wv.x); y[qv][4 * jj + 2] = bflo(wv.y); y[qv][4 * jj + 3] = bfhi(wv.y); }
        }
        if (!meta) {
            const bf16* qp = RWQ + (size_t)u * 4096 + (32 * th + r) * 64 + 8 * hf;
            const bf16* sp = RWS + (size_t)u * 4096 + r * 64 + 8 * hf;
#pragma unroll
            for (int ks = 0; ks < 4; ++ks) {
                const bf16x8 bq = *(const bf16x8*)(qp + 16 * ks);
                y[0] = __builtin_amdgcn_mfma_f32_32x32x16_bf16(*(const bf16x8*)(sp + 16 * ks), bq, y[0], 0, 0, 0);
                y[1] = __builtin_amdgcn_mfma_f32_32x32x16_bf16(*(const bf16x8*)(sp + 32 * 64 + 16 * ks), bq, y[1], 0, 0, 0);
            }
        }
        f32x16 g[2]; g[0] = zero16(); g[1] = zero16();
        {
            const bf16* gp = P + (size_t)row * PW + PC_GD + 8 * hf; const bf16* gpp = prow >= 0 ? P + (size_t)prow * PW + PC_GD + 8 * hf : nullptr;
            const bf16* wp = WgT + (size_t)(h * 64 + r) * 128 + 8 * hf;
#pragma unroll
            for (int ks = 0; ks < 8; ++ks) {
                const v4u cg = *(const v4u*)(gp + 16 * ks); const v4u pg = gpp ? *(const v4u*)(gpp + 16 * ks) : (v4u){0u, 0u, 0u, 0u};
                const f32x4 m0 = *(const f32x4*)(mu + 1664 + 16 * ks + 8 * hf), m1 = *(const f32x4*)(mu + 1664 + 16 * ks + 8 * hf + 4);
                const unsigned cw[4] = {cg.x, cg.y, cg.z, cg.w}, pw[4] = {pg.x, pg.y, pg.z, pg.w}; const float mm[8] = {m0.x, m0.y, m0.z, m0.w, m1.x, m1.y, m1.z, m1.w};
                unsigned o[4];
#pragma unroll
                for (int e = 0; e < 4; ++e) {
                    const float c0 = bflo(cw[e]), c1 = bfhi(cw[e]), p0 = bflo(pw[e]), p1 = bfhi(pw[e]);
                    o[e] = pk2(sigmoidf_(c0 + (p0 - c0) * mm[2 * e]), sigmoidf_(c1 + (p1 - c1) * mm[2 * e + 1]));
                }
                const v4u ov = (v4u){o[0], o[1], o[2], o[3]};
                const bf16x8 bs = __builtin_bit_cast(bf16x8, ov);
                g[0] = __builtin_amdgcn_mfma_f32_32x32x16_bf16(*(const bf16x8*)(wp + 16 * ks), bs, g[0], 0, 0, 0);
                g[1] = __builtin_amdgcn_mfma_f32_32x32x16_bf16(*(const bf16x8*)(wp + 32 * 128 + 16 * ks), bs, g[1], 0, 0, 0);
            }
        }
        float s = 0.f;
#pragma unroll
        for (int j = 0; j < 16; ++j) s += y[0][j] + y[1][j];
        s += __shfl_xor(s, 32);
        const float mean = s * (1.f / 64.f);
        float s2 = 0.f;
#pragma unroll
        for (int j = 0; j < 16; ++j) { const float d0 = y[0][j] - mean, d1 = y[1][j] - mean; s2 += d0 * d0 + d1 * d1; }
        s2 += __shfl_xor(s2, 32);
        const float rstd = 1.0f / sqrtf(s2 * (1.f / 64.f) + GN_EPS);
        const float bon = BONUS[(size_t)u * 64 + t];
        if (valid) {
#pragma unroll
            for (int qv = 0; qv < 2; ++qv)
#pragma unroll
                for (int jj = 0; jj < 4; ++jj) {
                    const int v0 = 32 * qv + 8 * jj + 4 * hf, chv = h * 64 + v0;
                    const v2u cvw = *(const v2u*)(P + (size_t)row * PW + PC_V + chv); const v2u pvw = prow >= 0 ? *(const v2u*)(P + (size_t)prow * PW + PC_V + chv) : (v2u){0u, 0u};
                    const f32x4 mv = *(const f32x4*)(mu + 1024 + chv), gg = *(const f32x4*)(F.in[IN_GN_G] + chv), gb = *(const f32x4*)(F.in[IN_GN_B] + chv);
                    const float cv[4] = {bflo(cvw.x), bfhi(cvw.x), bflo(cvw.y), bfhi(cvw.y)}, pv[4] = {bflo(pvw.x), bfhi(pvw.x), bflo(pvw.y), bfhi(pvw.y)};
                    const float mvv[4] = {mv.x, mv.y, mv.z, mv.w}, ggv[4] = {gg.x, gg.y, gg.z, gg.w}, gbv[4] = {gb.x, gb.y, gb.z, gb.w};
                    float o[4];
#pragma unroll
                    for (int e = 0; e < 4; ++e) {
                        const float vs = cv[e] + (pv[e] - cv[e]) * mvv[e];
                        o[e] = ((y[qv][4 * jj + e] - mean) * rstd * ggv[e] + gbv[e] + bon * vs) * g[qv][4 * jj + e];
                    }
                    *(v2u*)(QA + (size_t)row * QAW + 1024 + chv) = (v2u){pk2(o[0], o[1]), pk2(o[2], o[3])};
                }
        }
    }
}

constexpr int IX_CAP = 512, IX_LIST = 3072, IX_KB = 98304, IX_SCR = RING_BYTES + 4096;
#define IX_FENCE() asm volatile("s_waitcnt lgkmcnt(0)" ::: "memory")

__device__ __forceinline__ unsigned ix_mbcnt(unsigned long long m) { return __builtin_amdgcn_mbcnt_hi((unsigned)(m >> 32), __builtin_amdgcn_mbcnt_lo((unsigned)m, 0u)); }

__device__ __forceinline__ void ix_select_slow(const float (&sc)[8], const unsigned (&ix)[8], bool (&vl)[8], int K, unsigned short* sel_out, int lane) {
    for (int it = 0; it < K; ++it) {
        unsigned long long best = 0ull;
#pragma unroll
        for (int i = 0; i < 8; ++i) { const unsigned long long key = ((unsigned long long)sortable(sc[i]) << 32) | (unsigned long long)(0xFFFFu - ix[i]) | 0x10000ull; if (vl[i] && key > best) best = key; }
        unsigned long long wm = best;
#pragma unroll
        for (int o = 1; o < 64; o <<= 1) { const unsigned long long v = __shfl_xor(wm, o); wm = v > wm ? v : wm; }
        if (wm == 0ull) break;
        const bool mine = best == wm;
#pragma unroll
        for (int i = 0; i < 8; ++i) { const unsigned long long key = ((unsigned long long)sortable(sc[i]) << 32) | (unsigned long long)(0xFFFFu - ix[i]) | 0x10000ull; if (mine && vl[i] && key == wm) { vl[i] = false; sel_out[it] = (unsigned short)ix[i]; } }
    }
}

__device__ __forceinline__ void ix_compact(LAS float* LS, LAS unsigned short* LI, LAS unsigned* hist, int& cnt, float& tau, int lane, bool final_sel, unsigned short* sel_out) {
    const int n = cnt;
    float sc[8]; unsigned ix[8]; bool vl[8];
    IX_FENCE();
#pragma unroll
    for (int i = 0; i < 8; ++i) { const int p = lane + 64 * i; vl[i] = p < n; sc[i] = vl[i] ? LS[p] : -INFINITY; ix[i] = vl[i] ? (unsigned)LI[p] : 0u; }
    float mx = -INFINITY, mn = INFINITY;
#pragma unroll
    for (int i = 0; i < 8; ++i) { if (vl[i]) { mx = fmaxf(mx, sc[i]); mn = fminf(mn, sc[i]); } }
    mx = wave_max(mx); mn = -wave_max(-mn);
    const float scale = mx > mn ? 255.99f / (mx - mn) : 0.f;
    int bin[8];
#pragma unroll
    for (int i = 0; i < 8; ++i) { int bq = (int)((sc[i] - mn) * scale); bq = bq > 255 ? 255 : (bq < 0 ? 0 : bq); bin[i] = vl[i] ? bq : -1; }
    *(LAS v4u*)(hist + 4 * lane) = (v4u){0u, 0u, 0u, 0u};
    IX_FENCE();
#pragma unroll
    for (int i = 0; i < 8; ++i) if (vl[i]) __hip_atomic_fetch_add((LAS unsigned*)&hist[bin[i]], 1u, __ATOMIC_RELAXED, __HIP_MEMORY_SCOPE_WAVEFRONT);
    IX_FENCE();
    const v4u c = *(const LAS v4u*)(hist + 4 * lane);
    const unsigned Pp = wave_scan_incl(c.x + c.y + c.z + c.w, lane);
    const unsigned total = (unsigned)__builtin_amdgcn_readlane((int)Pp, 63);
    const unsigned K = TOPK;
    const unsigned a3 = total - Pp, a2 = a3 + c.w, a1 = a2 + c.z, a0 = a1 + c.y;
    int myb = -1; unsigned myA = 0u, myC = 0u;
    if (a3 < K && K <= a3 + c.w) { myb = 4 * lane + 3; myA = a3; myC = c.w; }
    else if (a2 < K && K <= a2 + c.z) { myb = 4 * lane + 2; myA = a2; myC = c.z; }
    else if (a1 < K && K <= a1 + c.y) { myb = 4 * lane + 1; myA = a1; myC = c.y; }
    else if (a0 < K && K <= a0 + c.x) { myb = 4 * lane; myA = a0; myC = c.x; }
    const unsigned long long bm = __ballot(myb >= 0);
    const int src = bm ? (__ffsll((long long)bm) - 1) : 0;
    const int bstar = __shfl(myb, src); const unsigned A = __shfl(myA, src), m = __shfl(myC, src);
    if (!final_sel) {
        if (A + m <= (unsigned)(IX_CAP - 128)) {
            int base = 0; float kmin = INFINITY;
#pragma unroll
            for (int i = 0; i < 8; ++i) {
                const bool keep = vl[i] && bin[i] >= bstar;
                const unsigned long long mk = __ballot(keep);
                const int pos = base + (int)ix_mbcnt(mk);
                if (keep) { LS[pos] = sc[i]; LI[pos] = (unsigned short)ix[i]; kmin = fminf(kmin, sc[i]); }
                base += __popcll(mk);
            }
            cnt = base; tau = -wave_max(-kmin);
            IX_FENCE();
            return;
        }
        unsigned short* tmp = sel_out;
        ix_select_slow(sc, ix, vl, (int)K, tmp, lane);
        int base = 0; float kmin = INFINITY;
#pragma unroll
        for (int i = 0; i < 8; ++i) {
            const bool keep = !vl[i] && (lane + 64 * i) < n;
            const unsigned long long mk = __ballot(keep);
            const int pos = base + (int)ix_mbcnt(mk);
            if (keep) { LS[pos] = sc[i]; LI[pos] = (unsigned short)ix[i]; kmin = fminf(kmin, sc[i]); }
            base += __popcll(mk);
        }
        cnt = base; tau = -wave_max(-kmin);
        IX_FENCE();
        return;
    }
    if (m <= 128u) {
        int base = 0;
#pragma unroll
        for (int i = 0; i < 8; ++i) {
            const bool keep = vl[i] && bin[i] > bstar;
            const unsigned long long mk = __ballot(keep);
            const int pos = base + (int)ix_mbcnt(mk);
            if (keep) sel_out[pos] = (unsigned short)ix[i];
            base += __popcll(mk);
        }
        LAS float* sS = (LAS float*)hist; LAS unsigned* sI = hist + 128;
        IX_FENCE();
        int mb = 0;
#pragma unroll
        for (int i = 0; i < 8; ++i) {
            const bool inb = vl[i] && bin[i] == bstar;
            const unsigned long long mk = __ballot(inb);
            const int pos = mb + (int)ix_mbcnt(mk);
            if (inb) { sS[pos] = sc[i]; sI[pos] = ix[i]; }
            mb += __popcll(mk);
        }
        IX_FENCE();
        const int need = (int)(K - A);
#pragma unroll
        for (int e = 0; e < 2; ++e) {
            const int j = lane + 64 * e;
            if (j < (int)m) {
                const float sj = sS[j]; const unsigned ij = sI[j]; int rank = 0;
                for (int k = 0; k < (int)m; ++k) { const float sk = sS[k]; const unsigned ik = sI[k]; rank += (sk > sj || (sk == sj && ik < ij)) ? 1 : 0; }
                if (rank < need) sel_out[(int)A + rank] = (unsigned short)ij;
            }
        }
    } else {
        ix_select_slow(sc, ix, vl, (int)K, sel_out, lane);
    }
}

__device__ __forceinline__ void p6_attn_mfma(Frame& F, bf16* OUTB, bool meta_only);
__device__ __forceinline__ void p5_index_mfma(Frame& F, unsigned short* SEL, int* NSEL, int qword = 3072, bool probe_noappend = false, bool do_meta = false) {
    const bf16* QA = WSP(bf16, WS_QA); const bf16* KIDX = WSP(bf16, WS_KIDX); const float* WIDX = WSP(float, WS_WIDX);
    const int tid = F.tid, w = F.wave, l = F.lane, r = l & 31, hf = l >> 5;
    {
        const int gw = blockIdx.x * NWAVES + w, NGW = F.G * NWAVES;
        for (int i = gw; i < NMETA + BATCH * 192; i += NGW) {
            int q, nvis; if (i < NMETA) { q = NREAL + i; nvis = NMETA; } else { const int bb = (i - NMETA) / 192, s = (i - NMETA) % 192; q = bb * SEQ + s; nvis = NMETA + 64 * (s / 64 + 1); }
            for (int j = l; j < nvis; j += 64) SEL[(size_t)q * TOPK + j] = (unsigned short)j;
            if (l == 0) NSEL[q] = nvis;
        }
    }
    LAS unsigned char* L = F.lds;
    LAS unsigned* hist = (LAS unsigned*)(L + IX_SCR + w * 1024);
    if (do_meta) {
        __syncthreads();
        if (tid == 0) F.MISC[17] = __hip_atomic_fetch_add((unsigned*)F.ctl + 3200, 1u, __ATOMIC_RELAXED, __HIP_MEMORY_SCOPE_AGENT);
        __syncthreads();
        const int mt = (int)F.MISC[17];
        if (mt == 0) {
            if (tid < NMETA) { for (int j = 0; j < NMETA; ++j) SEL[(size_t)(NREAL + tid) * TOPK + j] = (unsigned short)j; NSEL[NREAL + tid] = NMETA; }
            asm volatile("s_waitcnt vmcnt(0)" ::: "memory"); __syncthreads();
            p6_attn_mfma(F, WSP(bf16, WS_QA), true);
        } else if (mt == 1) { rw_b3(F, true); }
        __syncthreads();
    }
    {
        for (;;) {
            __syncthreads();
            if (tid == 0) F.MISC[16] = __hip_atomic_fetch_add((unsigned*)F.ctl + qword, 1u, __ATOMIC_RELAXED, __HIP_MEMORY_SCOPE_AGENT);
            __syncthreads();
            const int qi_ = (int)F.MISC[16];
            if (qi_ >= 1000) break;
            const int tile = 999 - qi_;
            const int pt = 6 + (tile >> 2), b = tile & 3;
            const int q0 = b * SEQ + pt * 32;
            const int nvis = NMETA + 64 * (pt / 2 + 1);
            __syncthreads();
            bf16x8 af[4];
            {
                const int qq = 2 * (r >> 4) + ((r >> 2) & 1), hd = 4 * ((r >> 3) & 1) + (r & 3);
                const bf16* qp = QA + (size_t)(q0 + 4 * w + qq) * QAW + 1024 + hd * 64 + 8 * hf;
#pragma unroll
                for (int ks = 0; ks < 4; ++ks) af[ks] = *(const bf16x8*)(qp + 16 * ks);
            }
            float wq[2][8];
#pragma unroll
            for (int a = 0; a < 2; ++a) {
                const f32x4 w0 = *(const f32x4*)(WIDX + (size_t)(q0 + 4 * w + 2 * a + hf) * 8), w1 = *(const f32x4*)(WIDX + (size_t)(q0 + 4 * w + 2 * a + hf) * 8 + 4);
                wq[a][0] = 0.5f * w0.x; wq[a][1] = 0.5f * w0.y; wq[a][2] = 0.5f * w0.z; wq[a][3] = 0.5f * w0.w; wq[a][4] = 0.5f * w1.x; wq[a][5] = 0.5f * w1.y; wq[a][6] = 0.5f * w1.z; wq[a][7] = 0.5f * w1.w;
            }
            float tau0 = -INFINITY, tau1 = -INFINITY;
            int cnt[4] = {0, 0, 0, 0};
            const int nblk = (nvis + 255) >> 8;
            v4u kreg[4];
#pragma unroll
            for (int e = 0; e < 4; ++e) {
                const int pid = tid + 512 * e, kl = pid >> 3, pc = pid & 7, j = kl;
                kreg[e] = j < nvis ? *(const v4u*)(KIDX + (size_t)key_row(b, j) * 64 + 8 * pc) : (v4u){0u, 0u, 0u, 0u};
            }
#pragma unroll
            for (int e = 0; e < 4; ++e) { const int pid = tid + 512 * e, kl = pid >> 3, pc = pid & 7; *(LAS v4u*)(L + IX_KB + kl * 128 + ((pc ^ ((kl >> 1) & 7)) << 4)) = kreg[e]; }
            __syncthreads();
            const LAS unsigned char* kb = L + IX_KB;
            for (int blk = 0; blk < nblk; ++blk) {
                if (blk + 1 < nblk) {
#pragma unroll
                    for (int e = 0; e < 4; ++e) {
                        const int pid = tid + 512 * e, kl = pid >> 3, pc = pid & 7, j = (blk + 1) * 256 + kl;
                        kreg[e] = j < nvis ? *(const v4u*)(KIDX + (size_t)key_row(b, j) * 64 + 8 * pc) : (v4u){0u, 0u, 0u, 0u};
                    }
                }
                int npair = (nvis - blk * 256 + 63) >> 6; npair = npair > 4 ? 4 : npair;
                bf16x8 bc0[4], bc1[4];
#pragma unroll
                for (int ks = 0; ks < 4; ++ks) { const int k0 = r, k1 = 32 + r;
                    bc0[ks] = *(const LAS bf16x8*)(kb + k0 * 128 + (((2 * ks + hf) ^ ((k0 >> 1) & 7)) << 4));
                    bc1[ks] = *(const LAS bf16x8*)(kb + k1 * 128 + (((2 * ks + hf) ^ ((k1 >> 1) & 7)) << 4)); }
                for (int pp = 0; pp < npair; ++pp) {
                    const int jbase = blk * 256 + pp * 64;
                    bf16x8 bn0[4], bn1[4];
                    {
                        const int pn = pp + 1 < npair ? pp + 1 : pp; const int k0 = pn * 64 + r, k1 = k0 + 32;
#pragma unroll
                        for (int ks = 0; ks < 4; ++ks) {
                            bn0[ks] = *(const LAS bf16x8*)(kb + k0 * 128 + (((2 * ks + hf) ^ ((k0 >> 1) & 7)) << 4));
                            bn1[ks] = *(const LAS bf16x8*)(kb + k1 * 128 + (((2 * ks + hf) ^ ((k1 >> 1) & 7)) << 4)); }
                    }
                    f32x16 accA = zero16(), accB = zero16();
#pragma unroll
                    for (int ks = 0; ks < 4; ++ks) { accA = __builtin_amdgcn_mfma_f32_32x32x16_bf16(af[ks], bc0[ks], accA, 0, 0, 0); accB = __builtin_amdgcn_mfma_f32_32x32x16_bf16(af[ks], bc1[ks], accB, 0, 0, 0); }
#pragma unroll
                    for (int ks = 0; ks < 4; ++ks) { bc0[ks] = bn0[ks]; bc1[ks] = bn1[ks]; }
                    float sA0 = 0.f, sA0b = 0.f, sA1 = 0.f, sA1b = 0.f, sB0 = 0.f, sB0b = 0.f, sB1 = 0.f, sB1b = 0.f;
#pragma unroll
                    for (int h = 0; h < 8; h += 2) {
                        sA0 = fmaf(wq[0][h], __builtin_fabsf(accA[h]), fmaf(wq[0][h], accA[h], sA0)); sA0b = fmaf(wq[0][h + 1], __builtin_fabsf(accA[h + 1]), fmaf(wq[0][h + 1], accA[h + 1], sA0b));
                        sA1 = fmaf(wq[1][h], __builtin_fabsf(accA[8 + h]), fmaf(wq[1][h], accA[8 + h], sA1)); sA1b = fmaf(wq[1][h + 1], __builtin_fabsf(accA[9 + h]), fmaf(wq[1][h + 1], accA[9 + h], sA1b));
                        sB0 = fmaf(wq[0][h], __builtin_fabsf(accB[h]), fmaf(wq[0][h], accB[h], sB0)); sB0b = fmaf(wq[0][h + 1], __builtin_fabsf(accB[h + 1]), fmaf(wq[0][h + 1], accB[h + 1], sB0b));
                        sB1 = fmaf(wq[1][h], __builtin_fabsf(accB[8 + h]), fmaf(wq[1][h], accB[8 + h], sB1)); sB1b = fmaf(wq[1][h + 1], __builtin_fabsf(accB[9 + h]), fmaf(wq[1][h + 1], accB[9 + h], sB1b));
                    }
                    const float s0A = (sA0 + sA0b) + 0.0f, s1A = (sA1 + sA1b) + 0.0f, s0B = (sB0 + sB0b) + 0.0f, s1B = (sB1 + sB1b) + 0.0f;
                    const int jA = jbase + r, jB = jA + 32;
                    const bool p0A = jA < nvis && s0A > tau0, p1A = jA < nvis && s1A > tau1, p0B = jB < nvis && s0B > tau0, p1B = jB < nvis && s1B > tau1;
                    const unsigned long long m0A = __ballot(p0A), m1A = __ballot(p1A), m0B = __ballot(p0B), m1B = __ballot(p1B);
                    if (m0A | m1A | m0B | m1B) {
                        const int a0lo = __popc((unsigned)m0A), a0hi = __popc((unsigned)(m0A >> 32)), a1lo = __popc((unsigned)m1A), a1hi = __popc((unsigned)(m1A >> 32));
                        const int b0lo = __popc((unsigned)m0B), b0hi = __popc((unsigned)(m0B >> 32)), b1lo = __popc((unsigned)m1B), b1hi = __popc((unsigned)(m1B >> 32));
                        {
                            LAS unsigned char* lb = L + (w * 4 + hf) * IX_LIST;
                            const int base = hf ? cnt[1] : cnt[0];
                            const int posA = base + (int)ix_mbcnt(m0A) - (hf ? a0lo : 0);
                            const int posB = base + (hf ? a0hi : a0lo) + (int)ix_mbcnt(m0B) - (hf ? b0lo : 0);
                            if (p0A) { ((LAS float*)lb)[posA] = s0A; ((LAS unsigned short*)(lb + 2048))[posA] = (unsigned short)jA; }
                            if (p0B) { ((LAS float*)lb)[posB] = s0B; ((LAS unsigned short*)(lb + 2048))[posB] = (unsigned short)jB; }
                        }
                        {
                            LAS unsigned char* lb = L + (w * 4 + 2 + hf) * IX_LIST;
                            const int base = hf ? cnt[3] : cnt[2];
                            const int posA = base + (int)ix_mbcnt(m1A) - (hf ? a1lo : 0);
                            const int posB = base + (hf ? a1hi : a1lo) + (int)ix_mbcnt(m1B) - (hf ? b1lo : 0);
                            if (p1A) { ((LAS float*)lb)[posA] = s1A; ((LAS unsigned short*)(lb + 2048))[posA] = (unsigned short)jA; }
                            if (p1B) { ((LAS float*)lb)[posB] = s1B; ((LAS unsigned short*)(lb + 2048))[posB] = (unsigned short)jB; }
                        }
                        cnt[0] += a0lo + b0lo; cnt[1] += a0hi + b0hi; cnt[2] += a1lo + b1lo; cnt[3] += a1hi + b1hi;
                        if (probe_noappend) { if (cnt[0] >= 256 && hf == 0) tau0 = INFINITY; if (cnt[1] >= 256 && hf == 1) tau0 = INFINITY; if (cnt[2] >= 256 && hf == 0) tau1 = INFINITY; if (cnt[3] >= 256 && hf == 1) tau1 = INFINITY; }
#pragma unroll
                        for (int qq = 0; qq < 4; ++qq) {
                            if (cnt[qq] > IX_CAP - 64) {
                                LAS unsigned char* lb = L + (w * 4 + qq) * IX_LIST;
                                float tq = 0.f; int cq = cnt[qq];
                                ix_compact((LAS float*)lb, (LAS unsigned short*)(lb + 2048), hist, cq, tq, l, false, SEL + (size_t)(q0 + 4 * w + qq) * TOPK);
                                cnt[qq] = __builtin_amdgcn_readfirstlane(cq);
                                if ((qq & 1) == hf) { if (qq < 2) tau0 = tq; else tau1 = tq; }
                            }
                        }
                    }
                }
                __syncthreads();
                if (blk + 1 < nblk) {
#pragma unroll
                    for (int e = 0; e < 4; ++e) { const int pid = tid + 512 * e, kl = pid >> 3, pc = pid & 7; *(LAS v4u*)(L + IX_KB + kl * 128 + ((pc ^ ((kl >> 1) & 7)) << 4)) = kreg[e]; }
                    __syncthreads();
                }
            }
#pragma unroll
            for (int qq = 0; qq < 4; ++qq) {
                LAS unsigned char* lb = L + (w * 4 + qq) * IX_LIST;
                float tq = 0.f; int cq = cnt[qq];
                ix_compact((LAS float*)lb, (LAS unsigned short*)(lb + 2048), hist, cq, tq, l, true, SEL + (size_t)(q0 + 4 * w + qq) * TOPK);
                if (l == 0) NSEL[q0 + 4 * w + qq] = TOPK;
            }
        }
    }
}

#ifndef CHECK_IDX
#define CHECK_IDX 0
#endif
#if CHECK_IDX
__device__ __forceinline__ void idx_check(Frame& F) {
    const unsigned short* SEL = WSP(unsigned short, WS_SEL); const unsigned short* SELB = (const unsigned short*)F.out; const int* NSEL = WSP(int, WS_NSEL); const int* NSELB = (const int*)((const char*)F.out + 32 * MiB);
    LAS unsigned* bm = (LAS unsigned*)(F.lds + F.wave * 2048);
    const int l = F.lane; const int gw = blockIdx.x * NWAVES + F.wave, NGW = F.G * NWAVES;
    unsigned miss = 0, badq = 0, dup = 0;
    for (int q = gw; q < NROWS; q += NGW) {
        for (int i = l; i < 260; i += 64) bm[i] = 0u;
        IX_FENCE();
        const int n = NSEL[q], nb = NSELB[q];
        for (int i = l; i < n; i += 64) { const unsigned j = SEL[(size_t)q * TOPK + i]; atomicOr((unsigned*)&bm[j >> 5], 1u << (j & 31)); }
        IX_FENCE();
        unsigned m = (n != nb) ? 1000u : 0u;
        for (int i = l; i < nb && i < TOPK; i += 64) { const unsigned j = SELB[(size_t)q * TOPK + i]; if (j >= (unsigned)TT) { ++dup; ++m; } else { const unsigned old = atomicAnd((unsigned*)&bm[j >> 5], ~(1u << (j & 31))); if (!((old >> (j & 31)) & 1u)) ++m; } }
        IX_FENCE();
        m = (unsigned)wave_sum((float)m);
        if (l == 0) { miss += m; badq += m ? 1u : 0u; }
    }
    dup = (unsigned)wave_sum((float)dup);
    if (l == 0) { atomicAdd((unsigned*)F.ctl + 2048, miss); atomicAdd((unsigned*)F.ctl + 2049, badq); atomicAdd((unsigned*)F.ctl + 2050, dup); }
}
#endif

typedef short v4i16_t __attribute__((ext_vector_type(4)));
__device__ __forceinline__ unsigned at_off(unsigned row, unsigned ch) { return 256u * row + 16u * (ch ^ (((row & 3u) << 2) | ((row >> 2) & 3u))); }

__device__ __forceinline__ void p6_attn_mfma(Frame& F, bf16* OUTB, bool meta_only = false) {
    bf16* QA = WSP(bf16, WS_QA); const bf16* CKV = WSP(bf16, WS_CKV); const unsigned short* SEL = WSP(unsigned short, WS_SEL); const int* NSEL = WSP(int, WS_NSEL);
    const int l = F.lane, w = F.wave, h16 = l & 15, g = l >> 4;
    LAS unsigned char* tile = F.lds + w * 8192;
    LAS unsigned short* selb = (LAS unsigned short*)(F.lds + 65536 + w * 512);
    const float slope = h16 < 8 ? __uint_as_float((unsigned)(127 - (h16 + 1)) << 23) : 0.f;
    if (!meta_only) {
        const int gw = blockIdx.x * NWAVES + w, NGW = F.G * NWAVES;
        for (int q = NROWS + gw; q < R; q += NGW) { bf16* qrow = QA + (size_t)q * QAW; for (int c = l; c < QAW / 8; c += 64) *(v4u*)(qrow + 8 * c) = (v4u){0u, 0u, 0u, 0u}; }
    }
    if (meta_only) { }
    const int G = F.G;
    int nq_tot, qbase_b, wib, wpb;
    if ((G & 7) == 0) { const int b = (blockIdx.x & 7) >> 1; qbase_b = b * SEQ; nq_tot = SEQ; wib = (((blockIdx.x >> 3) * 2) + (blockIdx.x & 1)) * NWAVES + w; wpb = (G / 4) * NWAVES; }
    else { qbase_b = 0; nq_tot = NREAL; wib = blockIdx.x * NWAVES + w; wpb = G * NWAVES; }
    if (meta_only) { qbase_b = NREAL; nq_tot = NMETA; wib = w; wpb = NWAVES; }
    for (int qi = wib; qi < nq_tot; qi += wpb) {
        int q, b, pos;
        if (meta_only) { q = NREAL + qi; b = 0; pos = qi; }
        else if ((G & 7) == 0) { q = qbase_b + qi; b = q >> 13; pos = NMETA + qi; }
        else { q = qi; b = q >> 13; pos = NMETA + (q & (SEQ - 1)); }
        bf16* qrow = QA + (size_t)q * QAW;
        const int nsel = NSEL[q];
        const int nch = (nsel + 31) >> 5;
        const unsigned short* selq = SEL + (size_t)q * TOPK;
        IX_FENCE();
        if (l < 32) *(LAS v4u*)(selb + 8 * l) = *(const v4u*)(selq + 8 * l);
        IX_FENCE();
        bf16x8 qf[4];
#pragma unroll
        for (int s = 0; s < 4; ++s) { const v4u t = h16 < 8 ? *(const v4u*)(qrow + h16 * 128 + 32 * s + 8 * g) : (v4u){0u, 0u, 0u, 0u}; qf[s] = __builtin_bit_cast(bf16x8, t); }
        float m = -INFINITY, lsum = 0.f;
        f32x4 O[8];
#pragma unroll
        for (int c = 0; c < 8; ++c) O[c] = (f32x4){0.f, 0.f, 0.f, 0.f};
        v4u gr[8];
#pragma unroll
        for (int i = 0; i < 8; ++i) { const int s = g + 4 * i; const int kj = s < nsel ? (int)selb[s] : (int)selb[0]; gr[i] = *(const v4u*)(CKV + (size_t)key_row(b, kj) * 128 + 8 * h16); }
        for (int ck = 0; ck < nch; ++ck) {
            IX_FENCE();
#pragma unroll
            for (int i = 0; i < 8; ++i) *(LAS v4u*)(tile + at_off((unsigned)(g + 4 * i), (unsigned)h16)) = gr[i];
            const v4u kv = *(const LAS v4u*)(selb + 32 * ck + 8 * g);
            if (ck + 1 < nch) {
#pragma unroll
                for (int i = 0; i < 8; ++i) { const int s = 32 * (ck + 1) + g + 4 * i; const int kj = s < nsel ? (int)selb[s] : (int)selb[0]; gr[i] = *(const v4u*)(CKV + (size_t)key_row(b, kj) * 128 + 8 * h16); }
            }
            IX_FENCE();
            f32x4 a0 = (f32x4){0.f, 0.f, 0.f, 0.f}, a1 = a0;
#pragma unroll
            for (int s = 0; s < 4; ++s) {
                const bf16x8 k0 = *(const LAS bf16x8*)(tile + at_off((unsigned)(8 * (h16 >> 2) + (h16 & 3)), (unsigned)(4 * s + g)));
                const bf16x8 k1 = *(const LAS bf16x8*)(tile + at_off((unsigned)(8 * (h16 >> 2) + 4 + (h16 & 3)), (unsigned)(4 * s + g)));
                a0 = __builtin_amdgcn_mfma_f32_16x16x32_bf16(k0, qf[s], a0, 0, 0, 0);
                a1 = __builtin_amdgcn_mfma_f32_16x16x32_bf16(k1, qf[s], a1, 0, 0, 0);
            }
            const unsigned kw[4] = {kv.x, kv.y, kv.z, kv.w};
            float x[8];
#pragma unroll
            for (int j = 0; j < 8; ++j) {
                const int kj = (int)((kw[j >> 1] >> (16 * (j & 1))) & 0xffffu);
                const float lg = (j < 4 ? a0[j & 3] : a1[j & 3]) - slope * fabsf((float)(pos - kj));
                x[j] = (32 * ck + 8 * g + j) < nsel ? lg : -INFINITY;
            }
            float cm = fmaxf(fmaxf(fmaxf(x[0], x[1]), fmaxf(x[2], x[3])), fmaxf(fmaxf(x[4], x[5]), fmaxf(x[6], x[7])));
            cm = fmaxf(cm, __shfl_xor(cm, 16)); cm = fmaxf(cm, __shfl_xor(cm, 32));
            const float mn = fmaxf(m, cm);
            const float alpha = __expf(m - mn);
            float p[8], ps = 0.f;
#pragma unroll
            for (int j = 0; j < 8; ++j) { p[j] = __expf(x[j] - mn); ps += p[j]; }
            ps += __shfl_xor(ps, 16); ps += __shfl_xor(ps, 32);
            lsum = lsum * alpha + ps; m = mn;
            if (__any(alpha != 1.0f)) {
#pragma unroll
                for (int rr = 0; rr < 4; ++rr) { const float sc = __shfl(alpha, 4 * g + rr);
#pragma unroll
                    for (int c = 0; c < 8; ++c) O[c][rr] *= sc; }
            }
            const v4u pw = (v4u){pk2(p[0], p[1]), pk2(p[2], p[3]), pk2(p[4], p[5]), pk2(p[6], p[7])};
            const bf16x8 pf = __builtin_bit_cast(bf16x8, pw);
#pragma unroll
            for (int c = 0; c < 8; ++c) {
                const unsigned qd = (unsigned)(h16 >> 2), pp = (unsigned)(h16 & 3);
                const v4i16_t t0 = __builtin_amdgcn_ds_read_tr16_b64_v4i16((LAS v4i16_t*)(tile + at_off(8u * g + qd, 2u * c + (pp >> 1)) + 8u * (pp & 1u)));
                const v4i16_t t1 = __builtin_amdgcn_ds_read_tr16_b64_v4i16((LAS v4i16_t*)(tile + at_off(8u * g + 4u + qd, 2u * c + (pp >> 1)) + 8u * (pp & 1u)));
                bf16x8 vf; vf[0] = t0[0]; vf[1] = t0[1]; vf[2] = t0[2]; vf[3] = t0[3]; vf[4] = t1[0]; vf[5] = t1[1]; vf[6] = t1[2]; vf[7] = t1[3];
                O[c] = __builtin_amdgcn_mfma_f32_16x16x32_bf16(pf, vf, O[c], 0, 0, 0);
            }
        }
        const float inv = 1.0f / lsum;
#pragma unroll
        for (int rr = 0; rr < 4; ++rr) {
            const float sc = __shfl(inv, 4 * g + rr);
            if (g < 2) {
#pragma unroll
                for (int c = 0; c < 8; ++c) (OUTB + (size_t)q * QAW)[(4 * g + rr) * 128 + 16 * c + h16] = (bf16)f2bf(O[c][rr] * sc);
            }
        }
    }
}
struct StoreBf16 { bf16* O; int ld;
    __device__ __forceinline__ void operator()(int row, int col, const f32x4& v) const { *(v2u*)(O + (size_t)row * ld + col) = (v2u){pk2(v.x, v.y), pk2(v.z, v.w)}; }
    __device__ __forceinline__ void one(int row, int col, float v) const { O[(size_t)row * ld + col] = (bf16)f2bf(v); } };
struct StoreRes1 { const bf16* H; float* out; float* meta;
    __device__ __forceinline__ void operator()(int row, int col, const f32x4& v) const {
        if (row >= NROWS) return;
        const v2u hw = *(const v2u*)(H + (size_t)row * D + col);
        const f32x4 o = (f32x4){ALPHA * bflo(hw.x) + v.x, ALPHA * bfhi(hw.x) + v.y, ALPHA * bflo(hw.y) + v.z, ALPHA * bfhi(hw.y) + v.w};
        float* dst = row < NREAL ? out + (size_t)row * D + col : meta + (size_t)(row - NREAL) * D + col;
        *(f32x4*)dst = o; }
    __device__ __forceinline__ void one(int row, int col, float v) const { if (row >= NROWS) return; float* dst = row < NREAL ? out + (size_t)row * D + col : meta + (size_t)(row - NREAL) * D + col; *dst = ALPHA * bf2f(H[(size_t)row * D + col]) + v; } };
struct StoreRes2 { const bf16* H; float* out; __device__ __forceinline__ void operator()(int row, int col, const f32x4& v) const {
        if (row >= NREAL) return;
        const v2u hw = *(const v2u*)(H + (size_t)row * D + col);
        *(f32x4*)(out + (size_t)row * D + col) = (f32x4){ALPHA * bflo(hw.x) + v.x, ALPHA * bfhi(hw.x) + v.y, ALPHA * bflo(hw.y) + v.z, ALPHA * bfhi(hw.y) + v.w}; } };

struct StoreMetaGate { float* GM; __device__ __forceinline__ void one(int row, int col, float v) const { const int m = row - NREAL, x = col & 255; if (m >= 14 && x < 128) GM[(size_t)(m - 14) * DFF + 128 * (col >> 8) + x] = v; } };
template <class Fn>
__device__ __forceinline__ void meta_gemm(Frame& F, const bf16* A, int lda, const bf16* Bt, int N, int K, const Fn& fn) {
    const int l = F.lane, i16 = l & 15, g = l >> 4;
    const int gw = blockIdx.x * NWAVES + F.wave, NGW = F.G * NWAVES;
    for (int t = gw; t < N / 16; t += NGW) {
        const bf16* ap = A + (size_t)(NREAL + i16) * lda + 8 * g; const bf16* bp = Bt + (size_t)(16 * t + i16) * K + 8 * g;
        f32x4 acc = (f32x4){0.f, 0.f, 0.f, 0.f};
#pragma unroll 8
        for (int s = 0; s < K / 32; ++s) acc = __builtin_amdgcn_mfma_f32_16x16x32_bf16(*(const pg8::bf16x8*)(ap + 32 * s), *(const pg8::bf16x8*)(bp + 32 * s), acc, 0, 0, 0);
#pragma unroll
        for (int rr = 0; rr < 4; ++rr) fn.one(NREAL + 4 * g + rr, 16 * t + i16, acc[rr]);
    }
}

template <class Fn>
__device__ __forceinline__ void run_gemm(Frame& F, const bf16* A, int lda, const bf16* Bt, int N, int K, const Fn& fn) {
    pg8::Gemm g{A, Bt, NREAL, N, K, lda}; pg8::StaticOrder S; S.init(NREAL, N, F.G, (int)blockIdx.x);
    pg8::EpiFn<Fn> E{fn};
    pg8::gemm_phase<pg8::EpiFn<Fn>, pg8::StaticOrder, true, true>(F.lds + RING_OFF, g, S, E);
}

constexpr int NPHASES = 13;
struct Args { const float* in[32]; float* out; unsigned char* ws; int ph_lo, ph_hi; };
__global__ void __launch_bounds__(NTHR, 2) fwd(Args args) {
    extern __shared__ __attribute__((aligned(16))) unsigned char lds[];
    Frame F;
    F.lds = (LAS unsigned char*)lds;
    F.MISC = (volatile LAS unsigned*)(F.lds + MISC_OFF);
    F.tid = threadIdx.x; F.lane = F.tid & 63; F.wave = __builtin_amdgcn_readfirstlane(F.tid >> 6);
    F.G = gridDim.x;
#pragma unroll
    for (int i = 0; i < 32; ++i) F.in[i] = args.in[i];
    F.out = args.out; F.ws = args.ws;
    F.ctl = (gu32*)(args.ws + WS_CTL);
    for (int u = F.tid; u < (LDS_BYTES - LDSCTL_OFF) / 4; u += NTHR) ((LAS unsigned*)(F.lds + LDSCTL_OFF))[u] = 0u;
    __syncthreads();
    const int lo = args.ph_lo, hi = args.ph_hi;
    XcdBarrier bar; bar.bar = (unsigned*)(F.ctl + CW_BAR); bar.x = 0; bar.st = nullptr;
    if (hi - lo > 1) bar = xcd_barrier_post((unsigned*)(F.ctl + CW_BAR), F.MISC + 8);
#define IN(k) (lo <= (k) && (k) < hi)
#ifdef PROBE_PHASE_T
    unsigned long long tp_prev = __builtin_amdgcn_s_memrealtime(), tp_dur = 0ull;
#define SEAM(k) do { if (IN(k) && IN((k) + 1)) xcd_barrier(bar); if (blockIdx.x == 0 && F.tid == 0) { const unsigned long long t_ = __builtin_amdgcn_s_memrealtime(); if ((k) == PROBE_PHASE_T) tp_dur = t_ - tp_prev; tp_prev = t_; } } while (0)
#else
#define SEAM(k) do { if (IN(k) && IN((k) + 1)) xcd_barrier(bar); } while (0)
#endif
#ifndef PROBE_PH
#define PROBE_PH -1
#endif
#define REP(k) for (int rep_ = 0; rep_ < ((PROBE_PH == (k)) ? 2 : 1); ++rep_)

#ifndef IDX_NAIVE
#define IDX_NAIVE 0
#endif
#ifndef ATTN_NAIVE
#define ATTN_NAIVE 0
#endif
    if (IN(0)) REP(0) { if (rep_) __syncthreads(); p0_weights(F); p1_ln_in(F); } SEAM(0);
    if (IN(1)) REP(1) { if (rep_) __syncthreads(); run_gemm(F, WSP(bf16, WS_H), D, WSP(bf16, WS_WT_IN), PW, D, StoreBf16{WSP(bf16, WS_P), PW}); meta_gemm(F, WSP(bf16, WS_H), D, WSP(bf16, WS_WT_IN), PW, D, StoreBf16{WSP(bf16, WS_P), PW}); } SEAM(1);
    if (IN(2)) REP(2) { if (rep_) __syncthreads(); p3_prep(F); } SEAM(2);
    if (IN(3)) REP(3) { if (rep_) __syncthreads(); run_gemm(F, WSP(bf16, WS_CQN), 256, WSP(bf16, WS_WT_QA), QAW, 256, StoreBf16{WSP(bf16, WS_QA), QAW}); meta_gemm(F, WSP(bf16, WS_CQN), 256, WSP(bf16, WS_WT_QA), QAW, 256, StoreBf16{WSP(bf16, WS_QA), QAW});
#if REFSEL
        refsel_rows(F);
#endif
    } SEAM(3);
    if (IN(4)) REP(4) { if (rep_) __syncthreads(); rw_b1(F); } SEAM(4);
    if (IN(5)) {
        rw_b2(F); __syncthreads();
#if CHECK_IDX
        p5_index_naive(F); __syncthreads(); p5_index_mfma(F, (unsigned short*)F.out, (int*)((char*)F.out + 32 * MiB));
#elif IDX_NAIVE
        p5_index_naive(F);
#else
        p5_index_mfma(F, WSP(unsigned short, WS_SEL), WSP(int, WS_NSEL), 3072, false, true);
#ifdef PROBE_IDX
        __syncthreads(); p5_index_mfma(F, WSP(unsigned short, WS_SEL), WSP(int, WS_NSEL), 3136);
#endif
#ifdef PROBE_IDX_SCORE
        __syncthreads(); p5_index_mfma(F, (unsigned short*)F.out, (int*)((char*)F.out + 32 * MiB), 3136, true);
#endif
#endif
    } SEAM(5);
    if (IN(6)) {
#if CHECK_IDX
        idx_check(F); __syncthreads();
#endif
#if CHECK_IDX || IDX_NAIVE
        if (blockIdx.x == 0) { p6_attn_mfma(F, WSP(bf16, WS_QA), true); __syncthreads(); }
        if (blockIdx.x == 1) { rw_b3(F, true); __syncthreads(); }
#endif
#if ATTN_NAIVE
        p6_attn_naive(F);
#else
        p6_attn_mfma(F, WSP(bf16, WS_QA));
#endif
        __syncthreads();
        rw_b3(F);
    } SEAM(6);
    if (IN(7)) REP(7) { if (rep_) __syncthreads(); run_gemm(F, WSP(bf16, WS_QA), QAW, WSP(bf16, WS_WT_MIX), D, QAW, StoreRes1{WSP(bf16, WS_H), F.out, WSP(float, WS_META1)}); meta_gemm(F, WSP(bf16, WS_QA), QAW, WSP(bf16, WS_WT_MIX), D, QAW, StoreRes1{WSP(bf16, WS_H), F.out, WSP(float, WS_META1)}); } SEAM(7);
    if (IN(8)) REP(8) { if (rep_) __syncthreads(); p10_ln1(F); } SEAM(8);
    if (IN(9)) {
        pg8::Gemm g{WSP(bf16, WS_H), WSP(bf16, WS_WT_UP), NREAL, UPW, D, D}; pg8::StaticOrder S; S.init(NREAL, UPW, F.G, (int)blockIdx.x);
        pg8::EpiConvAct E{WSP(unsigned short, WS_UP), DFF, F.in[IN_CONV_W], F.in[IN_CONV_B], DFF, WSP(float, WS_G01), WSP(float, WS_V01), WSP(float, WS_GHALO), (PG8_LAS float*)(F.lds + RING_BYTES + 4096)};
        pg8::gemm_phase<pg8::EpiConvAct, pg8::StaticOrder, true, true>(F.lds + RING_OFF, g, S, E);
        meta_gemm(F, WSP(bf16, WS_H), D, WSP(bf16, WS_WT_UP), UPW, D, StoreMetaGate{WSP(float, WS_GMETA)});
    } SEAM(9);
    if (IN(10)) { p12_conv_fix(F); } SEAM(10);
    if (IN(11)) REP(11) { if (rep_) __syncthreads(); run_gemm(F, WSP(bf16, WS_UP), DFF, WSP(bf16, WS_WT_DN), D, DFF, StoreRes2{WSP(bf16, WS_H), F.out}); } SEAM(11);
    if (IN(12)) { p14_ln2(F);
#if CHECK_IDX
        if (blockIdx.x == 0 && F.tid == 0) {
            const unsigned miss = __hip_atomic_load((unsigned*)F.ctl + 2048, __ATOMIC_RELAXED, __HIP_MEMORY_SCOPE_AGENT), dupc = __hip_atomic_load((unsigned*)F.ctl + 2050, __ATOMIC_RELAXED, __HIP_MEMORY_SCOPE_AGENT);
            if (dupc) F.out[5] = __builtin_inff();
            if (miss > CHECK_IDX_MAXMISS) F.out[3] = __builtin_nanf("");
        }
#endif
    }
#ifdef PROBE_PHASE_T
    if (blockIdx.x == 0 && F.tid == 0) { if (PROBE_PHASE_T == 12) tp_dur = __builtin_amdgcn_s_memrealtime() - tp_prev; const unsigned long long t0 = __builtin_amdgcn_s_memrealtime(); while (__builtin_amdgcn_s_memrealtime() - t0 < tp_dur) __builtin_amdgcn_s_sleep(8); }
#endif
#ifdef PROBE_B1SEC
    if (blockIdx.x == 0 && F.tid == 0) { const unsigned long long t0 = __builtin_amdgcn_s_memrealtime(); const unsigned long long dt = (unsigned long long)F.MISC[20]; while (__builtin_amdgcn_s_memrealtime() - t0 < dt) __builtin_amdgcn_s_sleep(8); }
#endif
#undef IN
#undef SEAM
}

extern "C" void kernel_launch(void* const* d_in, const int* in_sizes, int n_in, void* d_out, int out_size, void* d_ws, size_t ws_size, hipStream_t stream) {
    static int grid = 0;
    if (grid == 0) {
        if (n_in != 32 || out_size != NREAL * D || ws_size < WS_END) { fprintf(stderr, "kernel_launch: unexpected shapes: n_in %d out %d ws %zu\n", n_in, out_size, ws_size); grid = -1; return; }
        int dev = 0, cus = 0, per_cu = 0;
        if (hipGetDevice(&dev) != hipSuccess || hipDeviceGetAttribute(&cus, hipDeviceAttributeMultiprocessorCount, dev) != hipSuccess) { grid = -1; return; }
        if (hipFuncSetAttribute((const void*)fwd, hipFuncAttributeMaxDynamicSharedMemorySize, LDS_BYTES) != hipSuccess) { fprintf(stderr, "kernel_launch: hipFuncSetAttribute failed\n"); grid = -1; return; }
        if (hipOccupancyMaxActiveBlocksPerMultiprocessor(&per_cu, (const void*)fwd, NTHR, LDS_BYTES) != hipSuccess || per_cu < 1) fprintf(stderr, "kernel_launch: occupancy query says %d\n", per_cu);
        (void)hipGetLastError();
        grid = cus;
    }
    if (grid < 0) return;
    (void)hipMemsetAsync((char*)d_ws + WS_CTL, 0, CTL_ZERO_BYTES, stream);
    Args a{};
    for (int i = 0; i < 32; ++i) a.in[i] = (const float*)d_in[i];
    a.out = (float*)d_out; a.ws = (unsigned char*)d_ws;
#if ONE_LAUNCH
    a.ph_lo = 0; a.ph_hi = NPHASES;
    hipLaunchKernelGGL(fwd, dim3(grid), dim3(NTHR), LDS_BYTES, stream, a);
#else
    for (int p = 0; p < NPHASES; ++p) { a.ph_lo = p; a.ph_hi = p + 1; hipLaunchKernelGGL(fwd, dim3(grid), dim3(NTHR), LDS_BYTES, stream, a); }
#endif
}
```

```cpp
#include <hip/hip_runtime.h>
#include <cstdio>
#include <cstdint>
#define ONE_LAUNCH 1
namespace pg8 {
#define PG8_LAS __attribute__((address_space(3)))
typedef unsigned short bf16_t;
typedef short bf16x8 __attribute__((ext_vector_type(8)));
typedef float f32x4 __attribute__((ext_vector_type(4)));
typedef unsigned u32x4 __attribute__((ext_vector_type(4)));
constexpr int BM = 256, BK = 64, HALF = 128, HTB = HALF * BK * 2  , STAGE_BYTES = 8 * HTB, NXCD = 8, WGM = 8;

__host__ __device__ __forceinline__ int lds_byte(int r, int c) { const int st = (r >> 4) * 2 + (c >> 5), rr = r & 15, cc = c & 31, ob = rr * 64 + cc * 2; return st * 1024 + (ob ^ (((ob >> 9) & 1) << 5)); }
__host__ __device__ __forceinline__ void stage_rc(int b, int& R, int& C) { const int st = b / 1024, sb = b % 1024, swz = sb ^ (((sb >> 9) & 1) << 5); R = (st >> 1) * 16 + swz / 64; C = (st & 1) * 32 + (swz % 64) / 2; }
__host__ __device__ __forceinline__ int perm32(int rho) { const int n = rho >> 4, i = rho & 15; return 8 * (i >> 2) + 4 * n + (i & 3); }

struct Unit { int pm, pn; };
struct Gemm { const bf16_t* A; const bf16_t* Bt; int M, N, K, lda; };

struct StaticOrder {
    int nM, nN, nwg, G, c;
    __host__ __device__ void init(int M, int N, int G_, int c_) { nM = M / BM; nN = N / BM; nwg = nM * nN; G = G_; c = c_; }
    __host__ __device__ bool next(int i, Unit& u) const {
        const long L = (long)i * G + c; if (L >= nwg) return false;
        int wgid = (int)L; { const int q = nwg / NXCD, r = nwg % NXCD, xcd = wgid % NXCD, off = wgid / NXCD; wgid = (xcd < r ? xcd * (q + 1) : r * (q + 1) + (xcd - r) * q) + off; }
        const int nig = WGM * nN, gid = wgid / nig, fm = gid * WGM, gsz = (nM - fm) < WGM ? (nM - fm) : WGM;
        u.pm = fm + ((wgid % nig) % gsz); u.pn = (wgid % nig) / gsz; return true;
    }
    __device__ __forceinline__ void a_ready(const Unit&) const {}
    __device__ __forceinline__ void done(const Unit&) const {}
};


template <class F> struct EpiFn {
    static constexpr bool PERM = false, AFTER_DRAIN = false;
    F f;
    __device__ __forceinline__ void operator()(const f32x4 (&acc)[2][2][4][2], const Unit& u, int wr, int wc, int fr, int fq) const {
        const int row0 = u.pm * BM + wr * 64 + fr, col0 = u.pn * BM + wc * 32 + 4 * fq;
#pragma unroll
        for (int ai = 0; ai < 2; ++ai)
#pragma unroll
            for (int m = 0; m < 4; ++m) {
                const int row = row0 + ai * HALF + m * 16;
#pragma unroll
                for (int bj = 0; bj < 2; ++bj)
#pragma unroll
                    for (int n = 0; n < 2; ++n) f(row, col0 + bj * HALF + n * 16, acc[ai][bj][m][n]);
            }
    }
};

struct EpiConvAct {
    static constexpr bool PERM = false, AFTER_DRAIN = false;
    unsigned short* ACT; int ldact;
    const float* cw; const float* cb; int dff;
    float* G01; float* V01; float* GHALO;
    PG8_LAS float* hal;
    __device__ __forceinline__ void operator()(const f32x4 (&acc)[2][2][4][2], const Unit& u, int wr, int wc, int fr, int fq) const {
        const int colg = 128 * u.pn + wc * 32 + 4 * fq;
        f32x4 w0[2], w1[2], w2[2], bb[2];
#pragma unroll
        for (int n = 0; n < 2; ++n) { w0[n] = *(const f32x4*)(cw + colg + 16 * n); w1[n] = *(const f32x4*)(cw + dff + colg + 16 * n); w2[n] = *(const f32x4*)(cw + 2 * dff + colg + 16 * n); bb[n] = *(const f32x4*)(cb + colg + 16 * n); }
        if (fr >= 14) {
#pragma unroll
            for (int ai = 0; ai < 2; ++ai)
#pragma unroll
                for (int n = 0; n < 2; ++n) *(PG8_LAS f32x4*)(hal + (((2 * ai + wr) * 4 + wc) * 2 + (fr - 14)) * 32 + 16 * n + 4 * fq) = acc[ai][0][3][n];
        }
        asm volatile("s_waitcnt lgkmcnt(0)" ::: "memory"); __builtin_amdgcn_s_barrier(); asm volatile("" ::: "memory");
#pragma unroll
        for (int ai = 0; ai < 2; ++ai) {
            const int blk = 2 * ai + wr;
#pragma unroll
            for (int n = 0; n < 2; ++n) {
                f32x4 prev = (f32x4){0.f, 0.f, 0.f, 0.f};
                if (blk > 0) prev = *(const PG8_LAS f32x4*)(hal + ((((blk - 1) * 4 + wc) * 2 + (fr & 1)) * 32) + 16 * n + 4 * fq);
#pragma unroll
                for (int m = 0; m < 4; ++m) {
                    const f32x4 cur = acc[ai][0][m][n], val = acc[ai][1][m][n];
                    f32x4 o;
#pragma unroll
                    for (int e = 0; e < 4; ++e) {
                        float s1 = prev[e], s2 = prev[e];
                        asm volatile("s_nop 1\n\tv_mov_b32_dpp %0, %0 row_ror:1 row_mask:0xf bank_mask:0xf\n\tv_mov_b32_dpp %1, %1 row_ror:2 row_mask:0xf bank_mask:0xf\n\ts_nop 1\n\t"
                                     "v_mov_b32_dpp %0, %2 row_shr:1 row_mask:0xf bank_mask:0xf\n\tv_mov_b32_dpp %1, %2 row_shr:2 row_mask:0xf bank_mask:0xf\n\ts_nop 1" : "+v"(s1), "+v"(s2) : "v"(cur[e]));
                        const float x = w0[n][e] * s2 + w1[n][e] * s1 + w2[n][e] * cur[e] + bb[n][e];
                        const float u2 = x * (1.5957691216057308f + 0.07135481627260025f * x * x);
                        o[e] = x * __builtin_amdgcn_rcpf(1.0f + __builtin_amdgcn_exp2f(-1.4426950408889634f * u2)) * val[e];
                    }
                    const int rt = ai * HALF + wr * 64 + m * 16 + fr;
                    const int row = u.pm * BM + rt;
                    if (blk == 0 && m == 0 && fr < 2) {
                        *(f32x4*)(G01 + ((size_t)u.pm * 2 + fr) * dff + colg + 16 * n) = cur; *(f32x4*)(V01 + ((size_t)u.pm * 2 + fr) * dff + colg + 16 * n) = val;
                    } else {
                        typedef unsigned u32x2 __attribute__((ext_vector_type(2)));
                        typedef __bf16 b2 __attribute__((ext_vector_type(2)));
                        const b2 lo = {(__bf16)o[0], (__bf16)o[1]}, hi = {(__bf16)o[2], (__bf16)o[3]};
                        *(u32x2*)(ACT + (size_t)row * ldact + colg + 16 * n) = (u32x2){__builtin_bit_cast(unsigned, lo), __builtin_bit_cast(unsigned, hi)};
                    }
                    if (blk == 3 && m == 3 && fr >= 14) *(f32x4*)(GHALO + ((size_t)u.pm * 2 + (fr - 14)) * dff + colg + 16 * n) = cur;
                    prev = cur;
                }
            }
        }
        asm volatile("s_waitcnt lgkmcnt(0)" ::: "memory"); __builtin_amdgcn_s_barrier(); asm volatile("" ::: "memory");
    }
};
template <class Epi, class Sched, bool ALIGN_EPI = false, bool SP2 = false>
__device__ __forceinline__ void gemm_phase(PG8_LAS unsigned char* lds, const Gemm g, const Sched& S, const Epi& E) {
    const int tid = threadIdx.x, wid = __builtin_amdgcn_readfirstlane(tid >> 6), lane = tid & 63, wr = wid >> 2, wc = wid & 3, fr = lane & 15, fq = lane >> 4;
    const int K = g.K, nt = K / BK;
    unsigned voffA[2], voffB[2];
#pragma unroll
    for (int i = 0; i < 2; ++i) { int R, C; stage_rc(tid * 16 + i * 8192, R, C); const int Rb = Epi::PERM ? ((R & ~31) + perm32(R & 31)) : R;
        voffA[i] = (unsigned)(R * g.lda + C) * 2u; voffB[i] = (unsigned)(Rb * K + C) * 2u; }
    const size_t kstep = (size_t)(BK * 2);
    const size_t hA = (size_t)HALF * g.lda * 2, hB = (size_t)HALF * K * 2;
    const size_t tA = 2 * hA, tB = 2 * hB;
    const unsigned ldsw = (unsigned)wid * 1024u;
    const int aoff = lds_byte(wr * 64 + fr, fq * 8), boff = lds_byte(wc * 32 + fr, fq * 8);
#define PG8_SA(b, h) (((b) * 2 + (h)) * HTB)
#define PG8_SB(b, h) ((4 + (b) * 2 + (h)) * HTB)
#define PG8_STAGE(bufoff, gbase, voff) do { _Pragma("unroll") for (int _i = 0; _i < 2; ++_i) \
        __builtin_amdgcn_global_load_lds((const unsigned*)((const char*)(gbase) + (voff)[_i]), (PG8_LAS unsigned*)(lds + (bufoff) + ldsw + _i * 8192), 16, 0, 0); } while (0)
#define PG8_LDA(dst, b, h) do { _Pragma("unroll") for (int m = 0; m < 4; ++m) _Pragma("unroll") for (int k = 0; k < 2; ++k) dst[m][k] = *(const PG8_LAS bf16x8*)(lds + PG8_SA(b, h) + aoff + m * 2048 + k * 1024); } while (0)
#define PG8_LDB(dst, b, h) do { _Pragma("unroll") for (int n = 0; n < 2; ++n) _Pragma("unroll") for (int k = 0; k < 2; ++k) dst[n][k] = *(const PG8_LAS bf16x8*)(lds + PG8_SB(b, h) + boff + n * 2048 + k * 1024); } while (0)
#define PG8_MMA(ai, bj, At, Bt) do { __builtin_amdgcn_s_setprio(1); _Pragma("unroll") for (int m = 0; m < 4; ++m) _Pragma("unroll") for (int n = 0; n < 2; ++n) _Pragma("unroll") for (int k = 0; k < 2; ++k) \
        acc[ai][bj][m][n] = __builtin_amdgcn_mfma_f32_16x16x32_bf16(Bt[n][k], At[m][k], acc[ai][bj][m][n], 0, 0, 0); __builtin_amdgcn_s_setprio(0); } while (0)
#define PG8_WAIT_V(n) asm volatile("s_waitcnt vmcnt(" #n ")" ::: "memory")
#define PG8_WAIT_L(n) asm volatile("s_waitcnt lgkmcnt(" #n ")" ::: "memory")
#define PG8_BAR __builtin_amdgcn_s_barrier()
#define PG8_SCHED __builtin_amdgcn_sched_barrier(0)
    Unit cur, nxt; int ui = 0;
    if (!S.next(0, cur)) return;
    f32x4 acc[2][2][4][2];
#pragma unroll
    for (int a = 0; a < 2; ++a)
#pragma unroll
        for (int b = 0; b < 2; ++b)
#pragma unroll
            for (int m = 0; m < 4; ++m)
#pragma unroll
                for (int n = 0; n < 2; ++n) acc[a][b][m][n] = (f32x4){0.f, 0.f, 0.f, 0.f};
    bf16x8 At[4][2], B0[2][2], B1[2][2];
    const char* cA = (const char*)g.A + (size_t)cur.pm * tA; const char* cB = (const char*)g.Bt + (size_t)cur.pn * tB;
    S.a_ready(cur);
    if constexpr (SP2) {
        PG8_STAGE(PG8_SB(0, 0), cB, voffB); PG8_STAGE(PG8_SB(0, 1), cB + hB, voffB); PG8_STAGE(PG8_SA(0, 0), cA, voffA); PG8_STAGE(PG8_SA(0, 1), cA + hA, voffA);
        if (wr == 1) PG8_BAR;
        PG8_WAIT_V(2); PG8_BAR;
        PG8_STAGE(PG8_SB(1, 0), cB + kstep, voffB); PG8_STAGE(PG8_SA(1, 0), cA + kstep, voffA); PG8_STAGE(PG8_SB(1, 1), cB + hB + kstep, voffB);
        PG8_WAIT_V(6); PG8_BAR;
    } else {
        PG8_STAGE(PG8_SB(0, 0), cB, voffB); PG8_STAGE(PG8_SA(0, 0), cA, voffA); PG8_STAGE(PG8_SB(0, 1), cB + hB, voffB); PG8_STAGE(PG8_SA(0, 1), cA + hA, voffA);
        if (wr == 1) PG8_BAR;
        PG8_WAIT_V(4); PG8_BAR;
        PG8_STAGE(PG8_SB(1, 0), cB + kstep, voffB); PG8_STAGE(PG8_SA(1, 0), cA + kstep, voffA); PG8_STAGE(PG8_SB(1, 1), cB + hB + kstep, voffB);
        PG8_WAIT_V(6); PG8_BAR;
    }
    for (;;) {
        const bool has_next = S.next(ui + 1, nxt);
        const char* nA = has_next ? (const char*)g.A + (size_t)nxt.pm * tA : cA; const char* nB = has_next ? (const char*)g.Bt + (size_t)nxt.pn * tB : cB;
        for (int t = 0; t < nt; t += 2) {
            const bool last = (t == nt - 2);
            const char* a1 = cA + (size_t)(t + 1) * kstep;
            const char* a2 = last ? nA : cA + (size_t)(t + 2) * kstep; const char* b2 = last ? nB : cB + (size_t)(t + 2) * kstep;
            const char* a3 = a2 + kstep; const char* b3 = b2 + kstep;
            if (last && has_next) S.a_ready(nxt);
            if constexpr (SP2) {
            PG8_LDB(B0, 0, 0); PG8_LDB(B1, 0, 1); PG8_SCHED; PG8_LDA(At, 0, 0); PG8_STAGE(PG8_SA(1, 1), a1 + hA, voffA);
            PG8_WAIT_V(8); PG8_WAIT_L(0); PG8_BAR; PG8_MMA(0, 0, At, B0); PG8_MMA(0, 1, At, B1); PG8_BAR; PG8_SCHED;
            PG8_LDA(At, 0, 1); PG8_STAGE(PG8_SB(0, 0), b2, voffB); PG8_STAGE(PG8_SB(0, 1), b2 + hB, voffB); PG8_STAGE(PG8_SA(0, 0), a2, voffA);
            PG8_WAIT_V(8); PG8_WAIT_L(0); PG8_BAR; PG8_MMA(1, 0, At, B0); PG8_MMA(1, 1, At, B1); PG8_BAR; PG8_SCHED;
            PG8_LDB(B0, 1, 0); PG8_LDB(B1, 1, 1); PG8_SCHED; PG8_LDA(At, 1, 0); PG8_STAGE(PG8_SA(0, 1), a2 + hA, voffA);
            PG8_WAIT_V(8); PG8_WAIT_L(0); PG8_BAR; PG8_MMA(0, 0, At, B0); PG8_MMA(0, 1, At, B1); PG8_BAR; PG8_SCHED;
            PG8_LDA(At, 1, 1); PG8_STAGE(PG8_SB(1, 0), b3, voffB); PG8_STAGE(PG8_SB(1, 1), b3 + hB, voffB); PG8_STAGE(PG8_SA(1, 0), a3, voffA);
            PG8_WAIT_V(8); PG8_WAIT_L(0); PG8_BAR; PG8_MMA(1, 0, At, B0); PG8_MMA(1, 1, At, B1); PG8_BAR; PG8_SCHED;
            } else {
            PG8_LDB(B0, 0, 0); PG8_SCHED; PG8_LDA(At, 0, 0); PG8_STAGE(PG8_SA(1, 1), a1 + hA, voffA);
            PG8_WAIT_L(8); PG8_BAR; PG8_WAIT_L(0); PG8_MMA(0, 0, At, B0); PG8_BAR; PG8_SCHED;
            PG8_LDB(B1, 0, 1); PG8_STAGE(PG8_SB(0, 0), b2, voffB);
            PG8_BAR; PG8_WAIT_L(0); PG8_MMA(0, 1, At, B1); PG8_BAR;
            PG8_LDA(At, 0, 1); PG8_STAGE(PG8_SA(0, 0), a2, voffA);
            PG8_BAR; PG8_WAIT_L(0); PG8_MMA(1, 0, At, B0); PG8_BAR; PG8_SCHED;
            PG8_STAGE(PG8_SB(0, 1), b2 + hB, voffB);
            PG8_WAIT_V(6); PG8_BAR; PG8_MMA(1, 1, At, B1); PG8_BAR;
            PG8_LDB(B0, 1, 0); PG8_SCHED; PG8_LDA(At, 1, 0); PG8_STAGE(PG8_SA(0, 1), a2 + hA, voffA);
            PG8_WAIT_L(8); PG8_BAR; PG8_WAIT_L(0); PG8_MMA(0, 0, At, B0); PG8_BAR; PG8_SCHED;
            PG8_LDB(B1, 1, 1); PG8_STAGE(PG8_SB(1, 0), b3, voffB);
            PG8_BAR; PG8_WAIT_L(0); PG8_MMA(0, 1, At, B1); PG8_BAR;
            PG8_LDA(At, 1, 1); PG8_STAGE(PG8_SA(1, 0), a3, voffA);
            PG8_BAR; PG8_WAIT_L(0); PG8_MMA(1, 0, At, B0); PG8_BAR; PG8_SCHED;
            PG8_STAGE(PG8_SB(1, 1), b3 + hB, voffB);
            PG8_WAIT_V(6); PG8_BAR; PG8_MMA(1, 1, At, B1); PG8_BAR;
            }
        }
        if constexpr (ALIGN_EPI) { if (wr == 0) PG8_BAR; }
        if constexpr (!Epi::AFTER_DRAIN) { E(acc, cur, wr, wc, fr, fq); S.done(cur); }
        if (!has_next) break;
#pragma unroll
        for (int a = 0; a < 2; ++a)
#pragma unroll
            for (int b = 0; b < 2; ++b)
#pragma unroll
                for (int m = 0; m < 4; ++m)
#pragma unroll
                    for (int n = 0; n < 2; ++n) acc[a][b][m][n] = (f32x4){0.f, 0.f, 0.f, 0.f};
        cur = nxt; cA = nA; cB = nB; ++ui;
        if constexpr (ALIGN_EPI) { if (wr == 1) PG8_BAR; }
    }
    PG8_WAIT_V(0);
    if constexpr (!ALIGN_EPI) { if (wr == 0) PG8_BAR; }
    PG8_BAR;
    if constexpr (Epi::AFTER_DRAIN) { E.fused(acc, cur, wr, wc, fr, fq, lds, wid, lane); S.done(cur); }
#undef PG8_SA
#undef PG8_SB
#undef PG8_STAGE
#undef PG8_LDA
#undef PG8_LDB
#undef PG8_MMA
#undef PG8_WAIT_V
#undef PG8_WAIT_L
#undef PG8_BAR
#undef PG8_SCHED
}
}

#ifndef ONE_LAUNCH
#define ONE_LAUNCH 0
#endif
constexpr int NWAVES = 8, NTHR = 512;
constexpr int D = 1024, BATCH = 4, SEQ = 8192, NMETA = 16, TT = SEQ + NMETA;
constexpr int NREAL = BATCH * SEQ;
constexpr int NROWS = NREAL + NMETA;
constexpr int R = 33024;
constexpr int PW = 2304;
constexpr int PC_CQ = 0, PC_CKV = 256, PC_KIDX = 384, PC_WIDX = 448, PC_R = 512, PC_K = 1024, PC_V = 1536, PC_WD = 2048, PC_AD = 2112, PC_GD = 2176;
constexpr int QAW = 1536;
constexpr int DFF = 2816, UPW = 5632;
constexpr int TOPK = 256;
constexpr float LN_EPS = 1e-5f, GN_EPS = 64e-5f, ALPHA = 1.18920711500272f;

constexpr size_t MiB = 1u << 20;
constexpr size_t WS_CTL = 0, CTL_ZERO_BYTES = 32768;
constexpr size_t WS_WT_IN = 1 * MiB, WS_WT_QA = 6 * MiB, WS_WT_MIX = 7 * MiB, WS_WT_UP = 10 * MiB, WS_WT_DN = 21 * MiB;
constexpr size_t WS_META1 = 27 * MiB, WS_NSEL = 28 * MiB, WS_WIDX = 29 * MiB;
constexpr size_t WS_H = 33 * MiB;
constexpr size_t WS_P = 98 * MiB, WS_QA = 244 * MiB, WS_CQN = 341 * MiB, WS_SEL = 341 * MiB, WS_CKV = 358 * MiB, WS_KIDX = 367 * MiB;
constexpr size_t WS_DEC = 372 * MiB, WS_AB = 437 * MiB, WS_GB = 470 * MiB;
constexpr size_t WS_WT_LORA = 26 * MiB + 512 * 1024;
constexpr size_t WS_RWM = 372 * MiB, WS_RWN = 405 * MiB, WS_RWQ = 438 * MiB, WS_RWY = 471 * MiB;
constexpr size_t OUT_RWS = 80 * MiB, OUT_BONUS = 116 * MiB;
constexpr size_t WS_G01 = 480 * MiB, WS_V01 = 484 * MiB, WS_GHALO = 488 * MiB, WS_GMETA = 492 * MiB;
constexpr size_t WS_UP = 98 * MiB;
constexpr size_t WS_END = 512 * MiB;
static_assert(WS_P + (size_t)R * PW * 2 <= WS_QA && WS_QA + (size_t)R * QAW * 2 <= WS_CQN && WS_CQN + (size_t)R * 256 * 2 <= WS_CKV && WS_CKV + (size_t)R * 128 * 2 <= WS_KIDX
              && WS_KIDX + (size_t)R * 64 * 2 <= WS_DEC && WS_DEC + (size_t)R * 512 * 4 <= WS_AB && WS_AB + (size_t)R * 512 * 2 <= WS_GB && WS_GB + (size_t)R * 512 * 2 <= WS_END
              && WS_UP + (size_t)R * UPW * 2 <= WS_END && WS_H + (size_t)R * D * 2 <= WS_P && WS_WIDX + (size_t)R * 8 * 4 <= WS_H && WS_NSEL + (size_t)R * 4 <= WS_WIDX, "ws map");
constexpr int CW_BAR = 4096;

constexpr int RING_OFF = 0, RING_BYTES = 131072;
constexpr int LDSCTL_OFF = RING_BYTES, MISC_OFF = LDSCTL_OFF + 320;
constexpr int LDS_BYTES = 147456;

#define GAS __attribute__((address_space(1)))
#define LAS __attribute__((address_space(3)))
typedef unsigned short bf16;
typedef unsigned v4u __attribute__((ext_vector_type(4)));
typedef unsigned v2u __attribute__((ext_vector_type(2)));
typedef float f32x4 __attribute__((ext_vector_type(4)));
typedef GAS unsigned gu32;
typedef __bf16 bf16x2_t __attribute__((ext_vector_type(2)));
__device__ __forceinline__ unsigned f2bf(float f) { return (unsigned)__builtin_bit_cast(unsigned short, (__bf16)f); }
__device__ __forceinline__ unsigned pk2(float lo, float hi) { const bf16x2_t v = {(__bf16)lo, (__bf16)hi}; return __builtin_bit_cast(unsigned, v); }
__device__ __forceinline__ float fast_rcp(float x) { return __builtin_amdgcn_rcpf(x); }
__device__ __forceinline__ float fast_tanh(float x) { return 1.0f - 2.0f * __builtin_amdgcn_rcpf(1.0f + __expf(2.0f * x)); }
__device__ __forceinline__ float bf2f(unsigned short b) { return __uint_as_float(((unsigned)b) << 16); }
__device__ __forceinline__ float bflo(unsigned w) { return __uint_as_float(w << 16); }
__device__ __forceinline__ float bfhi(unsigned w) { return __uint_as_float(w & 0xffff0000u); }
#define DPP_F(v, ctrl) __builtin_bit_cast(float, __builtin_amdgcn_update_dpp(0, __builtin_bit_cast(int, (v)), (ctrl), 0xf, 0xf, false))
__device__ __forceinline__ float rdlane_f(float v, int lane) { return __builtin_bit_cast(float, __builtin_amdgcn_readlane(__builtin_bit_cast(int, v), lane)); }
__device__ __forceinline__ float wave_sum(float v) {
    v += DPP_F(v, 0xB1); v += DPP_F(v, 0x4E); v += DPP_F(v, 0x141); v += DPP_F(v, 0x140);
    return (rdlane_f(v, 0) + rdlane_f(v, 16)) + (rdlane_f(v, 32) + rdlane_f(v, 48));
}
__device__ __forceinline__ float wave_max(float v) {
    v = fmaxf(v, DPP_F(v, 0xB1)); v = fmaxf(v, DPP_F(v, 0x4E)); v = fmaxf(v, DPP_F(v, 0x141)); v = fmaxf(v, DPP_F(v, 0x140));
    return fmaxf(fmaxf(rdlane_f(v, 0), rdlane_f(v, 16)), fmaxf(rdlane_f(v, 32), rdlane_f(v, 48)));
}
#define DPP_U0(v, ctrl) ((unsigned)__builtin_amdgcn_update_dpp(0, (int)(v), (ctrl), 0xf, 0xf, true))
__device__ __forceinline__ unsigned wave_scan_incl(unsigned v, int lane) {
    v += DPP_U0(v, 0x111); v += DPP_U0(v, 0x112); v += DPP_U0(v, 0x114); v += DPP_U0(v, 0x118);
    const unsigned r0 = (unsigned)__builtin_amdgcn_readlane((int)v, 15), r1 = (unsigned)__builtin_amdgcn_readlane((int)v, 31), r2 = (unsigned)__builtin_amdgcn_readlane((int)v, 47);
    const int row = lane >> 4;
    return v + (row >= 1 ? r0 : 0u) + (row >= 2 ? r1 : 0u) + (row >= 3 ? r2 : 0u);
}
__device__ __forceinline__ float sigmoidf_(float x) { return __builtin_amdgcn_rcpf(1.0f + __expf(-x)); }
#define XB_TMO      128
#define XB_XCNT(j)  (256  + 64 * (j))
#define XB_XSUB(j)  (1280 + 64 * (j))
#define XB_XGEN(j)  (2304 + 64 * (j))
#define XB_TOP      3328
#define XB_TOPGEN   3392
#define XCD_BAR_WORDS 3456
#define XB_SPIN_CAP (1u << 18)

__device__ __forceinline__ unsigned xb_ld(unsigned* p)              { return __hip_atomic_load(p, __ATOMIC_RELAXED, __HIP_MEMORY_SCOPE_AGENT); }
__device__ __forceinline__ unsigned xb_add(unsigned* p, unsigned v) { return __hip_atomic_fetch_add(p, v, __ATOMIC_RELAXED, __HIP_MEMORY_SCOPE_AGENT); }
__device__ __forceinline__ unsigned xb_xcc_id() { return (unsigned)__builtin_amdgcn_s_getreg((3 << 11) | 20) & 0xFu; }
#define XB_SPIN(cond, bar) do { unsigned _sp = 0; while (cond) { __builtin_amdgcn_s_sleep(1); \
    if ((++_sp & 255u) == 0u) { if (xb_ld(&(bar)[XB_TMO])) break; if (_sp > XB_SPIN_CAP) { atomicAdd(&(bar)[XB_TMO], 1u); break; } } } } while (0)

struct XcdBarrier {
    unsigned* bar; unsigned x;
    volatile LAS unsigned* st;
};

__device__ __forceinline__ XcdBarrier xcd_barrier_post(unsigned* bar, volatile LAS unsigned* st) {
    XcdBarrier b; b.bar = bar; b.x = xb_xcc_id(); b.st = st;
    if (threadIdx.x == 0) (void)xb_add(&bar[XB_XCNT(b.x)], 1u);
    return b;
}
__device__ __forceinline__ void xcd_barrier_complete(unsigned* bar, unsigned x, unsigned& nloc, unsigned& nx) {
    const unsigned G = gridDim.x * gridDim.y * gridDim.z;
    unsigned sum, cnt, mine, sp = 0u;
    for (;;) {
        sum = 0u; cnt = 0u; mine = 0u;
#pragma unroll
        for (unsigned j = 0; j < 16; ++j) { const unsigned c = xb_ld(&bar[XB_XCNT(j)]); sum += c; cnt += (c > 0u) ? 1u : 0u; mine = (j == x) ? c : mine; }
        if (sum == G) break;
        __builtin_amdgcn_s_sleep(1);
        if ((++sp & 255u) == 0u) { if (xb_ld(&bar[XB_TMO])) break; if (sp > XB_SPIN_CAP) { atomicAdd(&bar[XB_TMO], 1u); break; } }
    }
    nloc = mine > 0u ? mine : 1u; nx = cnt > 0u ? cnt : 1u;
}

__device__ __forceinline__ void xcd_barrier(const XcdBarrier& b) {
    asm volatile("s_waitcnt vmcnt(0)" ::: "memory");
    __syncthreads();
    if (threadIdx.x == 0) {
        unsigned* bar = b.bar;
        __builtin_amdgcn_s_waitcnt(0);
        unsigned nloc = b.st[0], nx = b.st[1];
        if (nloc == 0u) { xcd_barrier_complete(bar, b.x, nloc, nx); b.st[0] = nloc; b.st[1] = nx; }
        const unsigned old = xb_add(&bar[XB_XSUB(b.x)], 1u);
        const unsigned gen = old / nloc;
        if (old + 1u == (gen + 1u) * nloc) {
            __builtin_amdgcn_fence(__ATOMIC_RELEASE, "agent");
            asm volatile("s_waitcnt vmcnt(0)" ::: "memory");
            const unsigned og = xb_add(&bar[XB_TOP], 1u);
            const unsigned tg = og / nx;
            if (og + 1u == (tg + 1u) * nx) xb_add(&bar[XB_TOPGEN], 1u);
            else XB_SPIN(xb_ld(&bar[XB_TOPGEN]) == tg, bar);
            __builtin_amdgcn_fence(__ATOMIC_ACQUIRE, "agent");
            xb_add(&bar[XB_XGEN(b.x)], 1u);
            asm volatile("s_waitcnt vmcnt(0)" ::: "memory");
        } else {
            XB_SPIN(xb_ld(&bar[XB_XGEN(b.x)]) == gen, bar);
            __builtin_amdgcn_fence(__ATOMIC_ACQUIRE, "agent");
            asm volatile("s_waitcnt vmcnt(0)" ::: "memory");
        }
    }
    __syncthreads();
}

struct Frame {
    LAS unsigned char* lds;
    volatile LAS unsigned* MISC;
    gu32* ctl;
    int tid, lane, wave, G;
    const float* in[32];
    float* out;
    unsigned char* ws;
};
#define IN_X 0
#define IN_META 1
#define IN_LNIN_G 2
#define IN_LNIN_B 3
#define IN_W_IN 4
#define IN_QNORM_G 5
#define IN_W_UQ 6
#define IN_KVNORM_G 7
#define IN_W_UKV 8
#define IN_W_IQ 9
#define IN_IDXLN_G 10
#define IN_IDXLN_B 11
#define IN_MU 12
#define IN_W0 13
#define IN_W_DEC 14
#define IN_A0 15
#define IN_W_AAA 16
#define IN_W_GATE 17
#define IN_KK 18
#define IN_KA 19
#define IN_RK 20
#define IN_GN_G 21
#define IN_GN_B 22
#define IN_W_OUT 23
#define IN_LN1_G 24
#define IN_LN1_B 25
#define IN_W_UP 26
#define IN_CONV_W 27
#define IN_CONV_B 28
#define IN_W_DN 29
#define IN_LN2_G 30
#define IN_LN2_B 31

#define WSP(T, off) ((T*)(F.ws + (off)))

__device__ __forceinline__ int key_row(int b, int j) { return j < NMETA ? NREAL + j : b * SEQ + (j - NMETA); }

__device__ __forceinline__ int tr_col(int n, int mode, int cut0, int cut1, int shift) {
    if (mode == 1) { const int pn = n >> 8, x = n & 255; return x < 128 ? 128 * pn + x : DFF + 128 * pn + (x - 128); }
    return n < cut0 ? n : (n < cut1 ? -1 : n - shift);
}
struct TrJob { const float* src; int src_ld, src_r0; bf16* dst; int dst_ld, dst_c0, Nn, K, mode, cut0, cut1, shift; };
__device__ __forceinline__ void tr_item(const TrJob& j, int item, LAS float* scr, int lane) {
    const int nblk = j.Nn / 32, kb = item / nblk, nb = item % nblk, k0 = 64 * kb, n0 = 32 * nb;
    const int col = tr_col(n0 + (lane & 31), j.mode, j.cut0, j.cut1, j.shift);
    const float* sp = j.src + (size_t)(j.src_r0 + k0 + (lane >> 5)) * j.src_ld + (col >= 0 ? col : 0);
    float v[32];
#pragma unroll
    for (int i = 0; i < 32; ++i) v[i] = sp[(size_t)(2 * i) * j.src_ld];
#pragma unroll
    for (int i = 0; i < 32; ++i) scr[(2 * i + (lane >> 5)) * 33 + (lane & 31)] = col >= 0 ? v[i] : 0.f;
    asm volatile("s_waitcnt lgkmcnt(0)" ::: "memory");
    const int c = lane & 7;
#pragma unroll
    for (int q = 0; q < 4; ++q) { const int n = (lane >> 3) + 8 * q; const LAS float* t = scr + (8 * c) * 33 + n;
        *(v4u*)(j.dst + (size_t)(n0 + n) * j.dst_ld + j.dst_c0 + k0 + 8 * c) = (v4u){pk2(t[0], t[33]), pk2(t[66], t[99]), pk2(t[132], t[165]), pk2(t[198], t[231])}; }
    asm volatile("s_waitcnt lgkmcnt(0)" ::: "memory");
}
__device__ __forceinline__ void tr_job(Frame& F, const TrJob& j, int& base) {
    LAS float* scr = (LAS float*)(F.lds + F.wave * 8704);
    const int gw = blockIdx.x * NWAVES + F.wave, NGW = F.G * NWAVES, ni = (j.K / 64) * (j.Nn / 32);
    for (int it = ((gw - base) % NGW + NGW) % NGW; it < ni; it += NGW) tr_item(j, it, scr, F.lane);
    base = (base + ni) % NGW;
}
__device__ __forceinline__ void p0_weights(Frame& F) {
    bf16* WT_IN = WSP(bf16, WS_WT_IN); bf16* WT_QA = WSP(bf16, WS_WT_QA); bf16* WT_MIX = WSP(bf16, WS_WT_MIX); bf16* WT_UP = WSP(bf16, WS_WT_UP); bf16* WT_DN = WSP(bf16, WS_WT_DN);
    bf16* WdT = WSP(bf16, WS_WT_LORA);
    int base = 0;
    tr_job(F, TrJob{F.in[IN_W_UP], UPW, 0, WT_UP, D, 0, UPW, D, 1, 0, 0, 0}, base);
    tr_job(F, TrJob{F.in[IN_W_DN], D, 0, WT_DN, DFF, 0, D, DFF, 0, D, D, 0}, base);
    tr_job(F, TrJob{F.in[IN_W_IN], 2248, 0, WT_IN, D, 0, PW, D, 0, 456, 512, 56}, base);
    tr_job(F, TrJob{F.in[IN_W_OUT], D, 512, WT_MIX, 1536, 1024, D, 512, 0, D, D, 0}, base);
    tr_job(F, TrJob{F.in[IN_W_IQ], 512, 0, WT_QA + (size_t)1024 * 256, 256, 0, 512, 256, 0, 512, 512, 0}, base);
    tr_job(F, TrJob{F.in[IN_W_GATE], 512, 0, WdT + 2 * 512 * 64, 128, 0, 512, 128, 0, 512, 512, 0}, base);
    tr_job(F, TrJob{F.in[IN_W_DEC], 512, 0, WdT, 64, 0, 512, 64, 0, 512, 512, 0}, base);
    tr_job(F, TrJob{F.in[IN_W_AAA], 512, 0, WdT + 512 * 64, 64, 0, 512, 64, 0, 512, 512, 0}, base);
    const float* w_uq = F.in[IN_W_UQ]; const float* w_ukv = F.in[IN_W_UKV]; const float* w_out = F.in[IN_W_OUT];
    for (int it = blockIdx.x * NTHR + F.tid; it < 256 * 8 * 8; it += F.G * NTHR) {
        const int c = it & 255, hb = __builtin_amdgcn_readfirstlane(it >> 8), h = hb >> 3, j0 = (hb & 7) * 16;
        float acc[16];
#pragma unroll
        for (int jj = 0; jj < 16; ++jj) acc[jj] = 0.f;
        for (int d = 0; d < 64; ++d) {
            const float a = w_uq[(size_t)c * 512 + h * 64 + d];
#pragma unroll
            for (int jj = 0; jj < 16; ++jj) acc[jj] += a * w_ukv[(size_t)(j0 + jj) * 1024 + h * 128 + d];
        }
#pragma unroll
        for (int jj = 0; jj < 16; ++jj) WT_QA[(size_t)(h * 128 + j0 + jj) * 256 + c] = (bf16)f2bf(0.125f * acc[jj]);
    }
    for (int it = blockIdx.x * NTHR + F.tid; it < 1024 * 8 * 8; it += F.G * NTHR) {
        const int n = it & 1023, hb = __builtin_amdgcn_readfirstlane(it >> 10), h = hb >> 3, j0 = (hb & 7) * 16;
        float acc[16];
#pragma unroll
        for (int jj = 0; jj < 16; ++jj) acc[jj] = 0.f;
        for (int d = 0; d < 64; ++d) {
            const float a = w_out[(size_t)(h * 64 + d) * D + n];
#pragma unroll
            for (int jj = 0; jj < 16; ++jj) acc[jj] += a * w_ukv[(size_t)(j0 + jj) * 1024 + h * 128 + 64 + d];
        }
        v4u o0, o1;
        o0.x = pk2(acc[0], acc[1]); o0.y = pk2(acc[2], acc[3]); o0.z = pk2(acc[4], acc[5]); o0.w = pk2(acc[6], acc[7]);
        o1.x = pk2(acc[8], acc[9]); o1.y = pk2(acc[10], acc[11]); o1.z = pk2(acc[12], acc[13]); o1.w = pk2(acc[14], acc[15]);
        *(v4u*)(WT_MIX + (size_t)n * 1536 + h * 128 + j0) = o0; *(v4u*)(WT_MIX + (size_t)n * 1536 + h * 128 + j0 + 8) = o1;
    }
}

__device__ __forceinline__ void ln_row_bf16(Frame& F, const float* src, const float* g, const float* b, bf16* dst) {
    v2u* o8 = (v2u*)dst + F.lane;
    if (!src) {
#pragma unroll
        for (int j = 0; j < 4; ++j) o8[64 * j] = (v2u){0u, 0u};
        return;
    }
    const f32x4* xr = (const f32x4*)src + F.lane;
    f32x4 v[4]; float s = 0.f;
#pragma unroll
    for (int j = 0; j < 4; ++j) { v[j] = xr[64 * j]; s += (v[j].x + v[j].y) + (v[j].z + v[j].w); }
    const float mean = wave_sum(s) * (1.f / D); float s2 = 0.f;
#pragma unroll
    for (int j = 0; j < 4; ++j) { v[j] = v[j] - mean; s2 += (v[j].x * v[j].x + v[j].y * v[j].y) + (v[j].z * v[j].z + v[j].w * v[j].w); }
    const float rstd = 1.f / sqrtf(wave_sum(s2) * (1.f / D) + LN_EPS);
#pragma unroll
    for (int j = 0; j < 4; ++j) {
        const f32x4 gg = ((const f32x4*)g)[F.lane + 64 * j], bb = ((const f32x4*)b)[F.lane + 64 * j];
        const f32x4 y = v[j] * rstd * gg + bb;
        o8[64 * j] = (v2u){pk2(y.x, y.y), pk2(y.z, y.w)};
    }
}
__device__ __forceinline__ void p1_ln_in(Frame& F) {
    bf16* H0 = WSP(bf16, WS_H);
    const int gw = blockIdx.x * NWAVES + F.wave, NGW = F.G * NWAVES;
    const f32x4* gp = (const f32x4*)F.in[IN_LNIN_G] + F.lane; const f32x4* bp = (const f32x4*)F.in[IN_LNIN_B] + F.lane;
    f32x4 gg[4], bb[4];
#pragma unroll
    for (int j = 0; j < 4; ++j) { gg[j] = gp[64 * j]; bb[j] = bp[64 * j]; }
    for (int r0 = gw * 4; r0 < NROWS; r0 += NGW * 4) {
        f32x4 v[4][4];
#pragma unroll
        for (int q = 0; q < 4; ++q) {
            const int r = r0 + q < NROWS ? r0 + q : NROWS - 1;
            const f32x4* xr = (const f32x4*)(r < NREAL ? F.in[IN_X] + (size_t)r * D : F.in[IN_META] + (size_t)(r - NREAL) * D) + F.lane;
#pragma unroll
            for (int j = 0; j < 4; ++j) v[q][j] = xr[64 * j];
        }
#pragma unroll
        for (int q = 0; q < 4; ++q) {
            float s = 0.f;
#pragma unroll
            for (int j = 0; j < 4; ++j) s += (v[q][j].x + v[q][j].y) + (v[q][j].z + v[q][j].w);
            const float mean = wave_sum(s) * (1.f / D); float s2 = 0.f;
#pragma unroll
            for (int j = 0; j < 4; ++j) { v[q][j] = v[q][j] - mean; s2 += (v[q][j].x * v[q][j].x + v[q][j].y * v[q][j].y) + (v[q][j].z * v[q][j].z + v[q][j].w * v[q][j].w); }
            const float rstd = 1.f / sqrtf(wave_sum(s2) * (1.f / D) + LN_EPS);
            if (r0 + q < NROWS) {
                v2u* o8 = (v2u*)(H0 + (size_t)(r0 + q) * D) + F.lane;
#pragma unroll
                for (int j = 0; j < 4; ++j) { const f32x4 y = v[q][j] * rstd * gg[j] + bb[j]; o8[64 * j] = (v2u){pk2(y.x, y.y), pk2(y.z, y.w)}; }
            }
        }
    }
}

__device__ __forceinline__ void p3_prep(Frame& F) {
    const bf16* P = WSP(bf16, WS_P); bf16* CQN = WSP(bf16, WS_CQN); bf16* CKV = WSP(bf16, WS_CKV); bf16* KIDX = WSP(bf16, WS_KIDX); float* WIDX = WSP(float, WS_WIDX);
    const int gw = blockIdx.x * NWAVES + F.wave, NGW = F.G * NWAVES, l = F.lane;
    for (int r = gw; r < R; r += NGW) {
        const bf16* pr = P + (size_t)r * PW;
        if (r >= NROWS) {
            *(v2u*)(CQN + (size_t)r * 256 + 4 * l) = (v2u){0u, 0u};
            continue;
        }
        {
            const v2u w = *(const v2u*)(pr + PC_CQ + 4 * l);
            const float a0 = bflo(w.x), a1 = bfhi(w.x), a2 = bflo(w.y), a3 = bfhi(w.y);
            const float ss = wave_sum(a0 * a0 + a1 * a1 + a2 * a2 + a3 * a3);
            const float rs = 1.0f / sqrtf(ss * (1.f / 256.f) + 1e-6f);
            const f32x4 g = ((const f32x4*)F.in[IN_QNORM_G])[l];
            *(v2u*)(CQN + (size_t)r * 256 + 4 * l) = (v2u){pk2(a0 * rs * g.x, a1 * rs * g.y), pk2(a2 * rs * g.z, a3 * rs * g.w)};
        }
        {
            const unsigned w = *(const unsigned*)(pr + PC_CKV + 2 * l);
            const float a0 = bflo(w), a1 = bfhi(w);
            const float ss = wave_sum(a0 * a0 + a1 * a1);
            const float rs = 1.0f / sqrtf(ss * (1.f / 128.f) + 1e-6f);
            const float g0 = F.in[IN_KVNORM_G][2 * l], g1 = F.in[IN_KVNORM_G][2 * l + 1];
            *(unsigned*)(CKV + (size_t)r * 128 + 2 * l) = pk2(a0 * rs * g0, a1 * rs * g1);
        }
        {
            const float a = bf2f(pr[PC_KIDX + l]);
            const float mean = wave_sum(a) * (1.f / 64.f);
            const float dlt = a - mean;
            const float var = wave_sum(dlt * dlt) * (1.f / 64.f);
            const float y = dlt * (1.0f / sqrtf(var + LN_EPS)) * F.in[IN_IDXLN_G][l] + F.in[IN_IDXLN_B][l];
            KIDX[(size_t)r * 64 + l] = (bf16)f2bf(y);
        }
        if (l < 8) WIDX[(size_t)r * 8 + l] = bf2f(pr[PC_WIDX + l]) * 0.04419417382415922f;
    }
}

#ifndef REFSEL
#define REFSEL 0
#endif
__device__ __forceinline__ void refsel_rows(Frame& F) {
    float* QIDX32 = F.out; float* KIDX32 = F.out + (size_t)R * 512; float* WIDX = WSP(float, WS_WIDX);
    const float* w_in = F.in[IN_W_IN]; const float* w_iq = F.in[IN_W_IQ];
    LAS float* hrow = (LAS float*)(F.lds + F.wave * 8192);
    LAS float* cqn = hrow + 1024;
    const int l = F.lane;
    const int gw = blockIdx.x * NWAVES + F.wave, NGW = F.G * NWAVES;
    for (int r = gw; r < NROWS; r += NGW) {
        const float* src = r < NREAL ? F.in[IN_X] + (size_t)r * D : F.in[IN_META] + (size_t)(r - NREAL) * D;
        {
            const f32x4* xr = (const f32x4*)src + l;
            f32x4 v[4]; float s = 0.f;
#pragma unroll
            for (int j = 0; j < 4; ++j) { v[j] = xr[64 * j]; s += (v[j].x + v[j].y) + (v[j].z + v[j].w); }
            const float mean = wave_sum(s) * (1.f / D); float s2 = 0.f;
#pragma unroll
            for (int j = 0; j < 4; ++j) { v[j] = v[j] - mean; s2 += (v[j].x * v[j].x + v[j].y * v[j].y) + (v[j].z * v[j].z + v[j].w * v[j].w); }
            const float rstd = 1.f / sqrtf(wave_sum(s2) * (1.f / D) + LN_EPS);
#pragma unroll
            for (int j = 0; j < 4; ++j) {
                const f32x4 gg = ((const f32x4*)F.in[IN_LNIN_G])[l + 64 * j], bb = ((const f32x4*)F.in[IN_LNIN_B])[l + 64 * j];
                *(LAS f32x4*)(hrow + 4 * (l + 64 * j)) = v[j] * rstd * gg + bb;
            }
        }
        __builtin_amdgcn_wave_barrier();
        float a[6];
#pragma unroll
        for (int i = 0; i < 6; ++i) a[i] = 0.f;
        for (int k = 0; k < D; ++k) {
            const float hk = hrow[k]; const float* wr = w_in + (size_t)k * 2248;
#pragma unroll
            for (int i = 0; i < 4; ++i) a[i] += hk * wr[l + 64 * i];
            a[4] += hk * wr[384 + l];
            a[5] += hk * wr[448 + (l & 7)];
        }
        const float ss = wave_sum(a[0] * a[0] + a[1] * a[1] + a[2] * a[2] + a[3] * a[3]);
        const float rs = 1.0f / sqrtf(ss * (1.f / 256.f) + 1e-6f);
#pragma unroll
        for (int i = 0; i < 4; ++i) cqn[l + 64 * i] = a[i] * rs * F.in[IN_QNORM_G][l + 64 * i];
        {
            const float mean = wave_sum(a[4]) * (1.f / 64.f); const float dlt = a[4] - mean;
            const float var = wave_sum(dlt * dlt) * (1.f / 64.f);
            KIDX32[(size_t)r * 64 + l] = dlt * (1.0f / sqrtf(var + LN_EPS)) * F.in[IN_IDXLN_G][l] + F.in[IN_IDXLN_B][l];
        }
        if (l < 8) WIDX[(size_t)r * 8 + l] = a[5] * 0.04419417382415922f;
        __builtin_amdgcn_wave_barrier();
        float q[8];
#pragma unroll
        for (int i = 0; i < 8; ++i) q[i] = 0.f;
        for (int c = 0; c < 256; ++c) {
            const float cq = cqn[c]; const float* wr = w_iq + (size_t)c * 512;
#pragma unroll
            for (int i = 0; i < 8; ++i) q[i] += cq * wr[l + 64 * i];
        }
#pragma unroll
        for (int i = 0; i < 8; ++i) QIDX32[(size_t)r * 512 + l + 64 * i] = q[i];
        __builtin_amdgcn_wave_barrier();
    }
}

__device__ __forceinline__ unsigned sortable(float f) { const unsigned u = __float_as_uint(f); return (u & 0x80000000u) ? ~u : (u | 0x80000000u); }
__device__ __forceinline__ void p5_index_naive(Frame& F) {
    const bf16* QA = WSP(bf16, WS_QA); const bf16* KIDX = WSP(bf16, WS_KIDX); const float* WIDX = WSP(float, WS_WIDX);
    unsigned short* SEL = WSP(unsigned short, WS_SEL); int* NSEL = WSP(int, WS_NSEL);
    LAS float* sc = (LAS float*)(F.lds);
    LAS float* qf = (LAS float*)(F.lds + 33024);
    LAS unsigned* hist = (LAS unsigned*)(F.lds + 33024 + 2048);
    LAS unsigned* cw = hist + 256;
    const int tid = F.tid;
    for (int q = blockIdx.x; q < NROWS; q += F.G) {
        int b, pos; if (q < NREAL) { b = q >> 13; pos = NMETA + (q & (SEQ - 1)); } else { b = 0; pos = q - NREAL; }
        const int nvis = pos < NMETA ? NMETA : NMETA + 64 * ((pos - NMETA) / 64 + 1);
#if REFSEL
        qf[tid] = F.out[(size_t)q * 512 + tid];
#else
        qf[tid] = bf2f(QA[(size_t)q * QAW + 1024 + tid]);
#endif
        float w[8];
#pragma unroll
        for (int h = 0; h < 8; ++h) w[h] = WIDX[(size_t)q * 8 + h];
        __syncthreads();
        for (int j = tid; j < nvis; j += NTHR) {
            const v4u* kp = (const v4u*)(KIDX + (size_t)key_row(b, j) * 64);
#if REFSEL
            const f32x4* kp32 = (const f32x4*)(F.out + (size_t)R * 512 + (size_t)key_row(b, j) * 64);
#endif
            float d[8];
#pragma unroll
            for (int h = 0; h < 8; ++h) d[h] = 0.f;
#pragma unroll 2
            for (int c = 0; c < 8; ++c) {
#if REFSEL
                const f32x4 ta = kp32[2 * c], tb = kp32[2 * c + 1];
                const float k0 = ta.x, k1 = ta.y, k2 = ta.z, k3 = ta.w, k4 = tb.x, k5 = tb.y, k6 = tb.z, k7 = tb.w;
#else
                const v4u t = kp[c];
                const float k0 = bflo(t.x), k1 = bfhi(t.x), k2 = bflo(t.y), k3 = bfhi(t.y), k4 = bflo(t.z), k5 = bfhi(t.z), k6 = bflo(t.w), k7 = bfhi(t.w);
#endif
#pragma unroll
                for (int h = 0; h < 8; ++h) {
                    const f32x4 qa = *(const LAS f32x4*)(qf + h * 64 + 8 * c), qb = *(const LAS f32x4*)(qf + h * 64 + 8 * c + 4);
                    d[h] += qa.x * k0 + qa.y * k1 + qa.z * k2 + qa.w * k3 + qb.x * k4 + qb.y * k5 + qb.z * k6 + qb.w * k7;
                }
            }
            float s = 0.f;
#pragma unroll
            for (int h = 0; h < 8; ++h) s += w[h] * fmaxf(d[h], 0.f);
            sc[j] = s + 0.0f;
        }
        __syncthreads();
        unsigned short* selq = SEL + (size_t)q * TOPK;
        if (nvis <= TOPK) {
            for (int j = tid; j < nvis; j += NTHR) selq[j] = (unsigned short)j;
        } else {
            unsigned prefix = 0u, mask = 0u, need = TOPK;
            for (int pass = 0; pass < 4; ++pass) {
                const int shift = 24 - 8 * pass;
                if (tid < 256) hist[tid] = 0u;
                __syncthreads();
                for (int j = tid; j < nvis; j += NTHR) { const unsigned key = sortable(sc[j]); if ((key & mask) == prefix) atomicAdd((unsigned*)&hist[(key >> shift) & 255u], 1u); }
                __syncthreads();
                if (tid < 256) {
                    unsigned above = 0u; for (int bb = tid + 1; bb < 256; ++bb) above += hist[bb];
                    const unsigned c = hist[tid];
                    if (above < need && need <= above + c) { cw[0] = prefix | ((unsigned)tid << shift); cw[1] = need - above; }
                }
                __syncthreads();
                prefix = cw[0]; need = cw[1]; mask |= 0xFFu << shift;
                __syncthreads();
            }
            if (tid == 0) cw[2] = 0u;
            __syncthreads();
            for (int j = tid; j < nvis; j += NTHR) { if (sortable(sc[j]) > prefix) { const unsigned p = atomicAdd((unsigned*)&cw[2], 1u); selq[p] = (unsigned short)j; } }
            __syncthreads();
            if (F.wave == 0) {
                const unsigned base = cw[2]; unsigned taken = 0u;
                for (int j0 = 0; j0 < nvis && taken < need; j0 += 64) {
                    const int j = j0 + F.lane; const bool eq = j < nvis && sortable(sc[j]) == prefix;
                    const unsigned long long m = __ballot(eq);
                    const unsigned rank = (unsigned)__popcll(m & ((1ull << F.lane) - 1ull));
                    if (eq && taken + rank < need) selq[base + taken + rank] = (unsigned short)j;
                    taken += (unsigned)__popcll(m);
                }
            }
        }
        if (tid == 0) NSEL[q] = nvis < TOPK ? nvis : TOPK;
        __syncthreads();
    }
}

__device__ __forceinline__ void p6_attn_naive(Frame& F) {
    bf16* QA = WSP(bf16, WS_QA); const bf16* CKV = WSP(bf16, WS_CKV); const unsigned short* SEL = WSP(unsigned short, WS_SEL); const int* NSEL = WSP(int, WS_NSEL);
    LAS float* qf = (LAS float*)(F.lds + F.wave * 16384);
    LAS float* ps = qf + 1024;
    LAS int* srow = (LAS int*)(ps + 2048);
    const int l = F.lane;
    const int gw = blockIdx.x * NWAVES + F.wave, NGW = F.G * NWAVES;
    for (int q = gw; q < R; q += NGW) {
        bf16* qrow = QA + (size_t)q * QAW;
        if (q >= NROWS) {
            for (int c = l; c < QAW / 8; c += 64) *(v4u*)(qrow + 8 * c) = (v4u){0u, 0u, 0u, 0u};
            continue;
        }
        int b, pos; if (q < NREAL) { b = q >> 13; pos = NMETA + (q & (SEQ - 1)); } else { b = 0; pos = q - NREAL; }
        const int nsel = NSEL[q];
        {
            const v4u t0 = *(const v4u*)(qrow + 16 * l), t1 = *(const v4u*)(qrow + 16 * l + 8);
            LAS float* d = qf + 16 * l;
            d[0] = bflo(t0.x); d[1] = bfhi(t0.x); d[2] = bflo(t0.y); d[3] = bfhi(t0.y); d[4] = bflo(t0.z); d[5] = bfhi(t0.z); d[6] = bflo(t0.w); d[7] = bfhi(t0.w);
            d[8] = bflo(t1.x); d[9] = bfhi(t1.x); d[10] = bflo(t1.y); d[11] = bfhi(t1.y); d[12] = bflo(t1.z); d[13] = bfhi(t1.z); d[14] = bflo(t1.w); d[15] = bfhi(t1.w);
        }
        __builtin_amdgcn_wave_barrier();
        for (int kk = 0; kk < 4; ++kk) {
            const int s = kk * 64 + l; const bool valid = s < nsel;
            const int j = valid ? (int)SEL[(size_t)q * TOPK + s] : 0;
            const int row = key_row(b, j);
            srow[s] = row;
            float acc[8];
#pragma unroll
            for (int h = 0; h < 8; ++h) acc[h] = 0.f;
            const v4u* kp = (const v4u*)(CKV + (size_t)row * 128);
            for (int c8 = 0; c8 < 16; ++c8) {
                const v4u t = kp[c8];
                const float k0 = bflo(t.x), k1 = bfhi(t.x), k2 = bflo(t.y), k3 = bfhi(t.y), k4 = bflo(t.z), k5 = bfhi(t.z), k6 = bflo(t.w), k7 = bfhi(t.w);
#pragma unroll
                for (int h = 0; h < 8; ++h) {
                    const f32x4 qa = *(const LAS f32x4*)(qf + h * 128 + 8 * c8), qb = *(const LAS f32x4*)(qf + h * 128 + 8 * c8 + 4);
                    acc[h] += qa.x * k0 + qa.y * k1 + qa.z * k2 + qa.w * k3 + qb.x * k4 + qb.y * k5 + qb.z * k6 + qb.w * k7;
                }
            }
            const float dist = fabsf((float)(pos - j));
#pragma unroll
            for (int h = 0; h < 8; ++h) { const float slope = __uint_as_float((unsigned)(127 - (h + 1)) << 23); ps[s * 8 + h] = valid ? acc[h] - slope * dist : -INFINITY; }
        }
        __builtin_amdgcn_wave_barrier();
#pragma unroll
        for (int h = 0; h < 8; ++h) {
            float v0 = ps[(l) * 8 + h], v1 = ps[(l + 64) * 8 + h], v2 = ps[(l + 128) * 8 + h], v3 = ps[(l + 192) * 8 + h];
            const float mx = wave_max(fmaxf(fmaxf(v0, v1), fmaxf(v2, v3)));
            v0 = __expf(v0 - mx); v1 = __expf(v1 - mx); v2 = __expf(v2 - mx); v3 = __expf(v3 - mx);
            const float inv = 1.0f / wave_sum((v0 + v1) + (v2 + v3));
            ps[(l) * 8 + h] = v0 * inv; ps[(l + 64) * 8 + h] = v1 * inv; ps[(l + 128) * 8 + h] = v2 * inv; ps[(l + 192) * 8 + h] = v3 * inv;
        }
        __builtin_amdgcn_wave_barrier();
        float o0[8], o1[8];
#pragma unroll
        for (int h = 0; h < 8; ++h) { o0[h] = 0.f; o1[h] = 0.f; }
        for (int s = 0; s < nsel; ++s) {
            const int row = srow[s];
            const unsigned w = *(const unsigned*)(CKV + (size_t)row * 128 + 2 * l);
            const float c0 = bflo(w), c1 = bfhi(w);
            const f32x4 pa = *(const LAS f32x4*)(ps + s * 8), pb = *(const LAS f32x4*)(ps + s * 8 + 4);
            o0[0] += pa.x * c0; o1[0] += pa.x * c1; o0[1] += pa.y * c0; o1[1] += pa.y * c1; o0[2] += pa.z * c0; o1[2] += pa.z * c1; o0[3] += pa.w * c0; o1[3] += pa.w * c1;
            o0[4] += pb.x * c0; o1[4] += pb.x * c1; o0[5] += pb.y * c0; o1[5] += pb.y * c1; o0[6] += pb.z * c0; o1[6] += pb.z * c1; o0[7] += pb.w * c0; o1[7] += pb.w * c1;
        }
#pragma unroll
        for (int h = 0; h < 8; ++h) *(unsigned*)(qrow + h * 128 + 2 * l) = pk2(o0[h], o1[h]);
        __builtin_amdgcn_wave_barrier();
    }
}

__device__ __forceinline__ void p7_rwkv_prep_naive(Frame& F) {
    const bf16* P = WSP(bf16, WS_P); float* DEC = WSP(float, WS_DEC); bf16* AB = WSP(bf16, WS_AB); bf16* GB = WSP(bf16, WS_GB);
    const float* mu = F.in[IN_MU]; const float* Wd = F.in[IN_W_DEC]; const float* Wa = F.in[IN_W_AAA]; const float* Wg = F.in[IN_W_GATE];
    const int l = F.lane;
    const int gw = blockIdx.x * NWAVES + F.wave, NGW = F.G * NWAVES;
    for (int r = gw; r < NROWS; r += NGW) {
        int prev; if (r < NREAL) { prev = (r & (SEQ - 1)) ? r - 1 : NREAL + NMETA - 1; } else { prev = r > NREAL ? r - 1 : -1; }
        const bf16* pr = P + (size_t)r * PW; const bf16* pp = prev >= 0 ? P + (size_t)prev * PW : nullptr;
#define SHIFTED(pc, mc) (bf2f(pr[pc]) + ((pp ? bf2f(pp[pc]) : 0.f) - bf2f(pr[pc])) * mu[mc])
        const float tw = tanhf(SHIFTED(PC_WD + l, 1536 + l));
        const float ta = SHIFTED(PC_AD + l, 1600 + l);
        const float tg0 = sigmoidf_(SHIFTED(PC_GD + l, 1664 + l)), tg1 = sigmoidf_(SHIFTED(PC_GD + 64 + l, 1728 + l));
#undef SHIFTED
        float aw[8], aa[8], ag[8];
#pragma unroll
        for (int i = 0; i < 8; ++i) { aw[i] = F.in[IN_W0][l + 64 * i]; aa[i] = F.in[IN_A0][l + 64 * i]; ag[i] = 0.f; }
        for (int j = 0; j < 64; ++j) {
            const float xw = __shfl(tw, j), xa = __shfl(ta, j), xg0 = __shfl(tg0, j), xg1 = __shfl(tg1, j);
#pragma unroll
            for (int i = 0; i < 8; ++i) {
                aw[i] += xw * Wd[(size_t)j * 512 + l + 64 * i];
                aa[i] += xa * Wa[(size_t)j * 512 + l + 64 * i];
                ag[i] += xg0 * Wg[(size_t)j * 512 + l + 64 * i] + xg1 * Wg[(size_t)(j + 64) * 512 + l + 64 * i];
            }
        }
#pragma unroll
        for (int i = 0; i < 8; ++i) {
            const float x = -aw[i];
            const float sp = x > 20.f ? x : log1pf(__expf(x));
            const float wlog = -sp - 0.5f;
            DEC[(size_t)r * 512 + l + 64 * i] = __expf(-__expf(wlog));
            AB[(size_t)r * 512 + l + 64 * i] = (bf16)f2bf(sigmoidf_(aa[i]));
            GB[(size_t)r * 512 + l + 64 * i] = (bf16)f2bf(ag[i]);
        }
    }
}

__device__ __forceinline__ void p8_rwkv_scan_naive(Frame& F) {
    if (F.wave != 0 || blockIdx.x >= 32) return;
    const bf16* P = WSP(bf16, WS_P); const float* DEC = WSP(float, WS_DEC); const bf16* AB = WSP(bf16, WS_AB); const bf16* GB = WSP(bf16, WS_GB); bf16* QA = WSP(bf16, WS_QA);
    const int b = blockIdx.x >> 3, h = blockIdx.x & 7, l = F.lane, ch = h * 64 + l;
    LAS float* vec = (LAS float*)F.lds;
    const float mu_r = F.in[IN_MU][ch], mu_k = F.in[IN_MU][512 + ch], mu_v = F.in[IN_MU][1024 + ch];
    const float kk_c = F.in[IN_KK][ch], ka_c = F.in[IN_KA][ch], rk_c = F.in[IN_RK][ch], gng = F.in[IN_GN_G][ch], gnb = F.in[IN_GN_B][ch];
    float S[64];
#pragma unroll
    for (int k = 0; k < 64; ++k) S[k] = 0.f;
    float pr_p = 0.f, pk_p = 0.f, pv_p = 0.f;
    int row = key_row(b, 0);
    float n_pr = bf2f(P[(size_t)row * PW + PC_R + ch]), n_pk = bf2f(P[(size_t)row * PW + PC_K + ch]), n_pv = bf2f(P[(size_t)row * PW + PC_V + ch]);
    float n_w = DEC[(size_t)row * 512 + ch], n_a = bf2f(AB[(size_t)row * 512 + ch]), n_g = bf2f(GB[(size_t)row * 512 + ch]);
    for (int pos = 0; pos < TT; ++pos) {
        const int crow = row;
        const float c_pr = n_pr, c_pk = n_pk, c_pv = n_pv, c_w = n_w, c_a = n_a, c_g = n_g;
        if (pos + 1 < TT) {
            row = key_row(b, pos + 1);
            n_pr = bf2f(P[(size_t)row * PW + PC_R + ch]); n_pk = bf2f(P[(size_t)row * PW + PC_K + ch]); n_pv = bf2f(P[(size_t)row * PW + PC_V + ch]);
            n_w = DEC[(size_t)row * 512 + ch]; n_a = bf2f(AB[(size_t)row * 512 + ch]); n_g = bf2f(GB[(size_t)row * 512 + ch]);
        }
        const float r_s = c_pr + (pr_p - c_pr) * mu_r, k_s = c_pk + (pk_p - c_pk) * mu_k, v_s = c_pv + (pv_p - c_pv) * mu_v;
        pr_p = c_pr; pk_p = c_pk; pv_p = c_pv;
        const float kkr = k_s * kk_c;
        const float nrm = sqrtf(wave_sum(kkr * kkr));
        const float kk = kkr / fmaxf(nrm, 1e-12f);
        const float k2 = k_s * (1.f + (c_a - 1.f) * ka_c);
        vec[l] = -kk; vec[64 + l] = kk * c_a; vec[128 + l] = c_w; vec[192 + l] = k2; vec[256 + l] = r_s;
        __builtin_amdgcn_wave_barrier();
        float sa = 0.f;
#pragma unroll
        for (int k4 = 0; k4 < 16; ++k4) { const f32x4 a = *(const LAS f32x4*)(vec + 4 * k4); sa += S[4 * k4] * a.x + S[4 * k4 + 1] * a.y + S[4 * k4 + 2] * a.z + S[4 * k4 + 3] * a.w; }
        float y = 0.f;
#pragma unroll
        for (int k4 = 0; k4 < 16; ++k4) {
            const f32x4 bv = *(const LAS f32x4*)(vec + 64 + 4 * k4), w = *(const LAS f32x4*)(vec + 128 + 4 * k4), kv = *(const LAS f32x4*)(vec + 192 + 4 * k4), rv = *(const LAS f32x4*)(vec + 256 + 4 * k4);
            S[4 * k4] = S[4 * k4] * w.x + sa * bv.x + v_s * kv.x; S[4 * k4 + 1] = S[4 * k4 + 1] * w.y + sa * bv.y + v_s * kv.y;
            S[4 * k4 + 2] = S[4 * k4 + 2] * w.z + sa * bv.z + v_s * kv.z; S[4 * k4 + 3] = S[4 * k4 + 3] * w.w + sa * bv.w + v_s * kv.w;
            y += S[4 * k4] * rv.x + S[4 * k4 + 1] * rv.y + S[4 * k4 + 2] * rv.z + S[4 * k4 + 3] * rv.w;
        }
        __builtin_amdgcn_wave_barrier();
        const float mean = wave_sum(y) * (1.f / 64.f);
        const float dlt = y - mean;
        const float var = wave_sum(dlt * dlt) * (1.f / 64.f);
        const float yn = dlt * (1.0f / sqrtf(var + GN_EPS)) * gng + gnb;
        const float bonus = wave_sum(r_s * k2 * rk_c) * v_s;
        const float o = (yn + bonus) * c_g;
        if (pos >= NMETA || b == 0) QA[(size_t)crow * QAW + 1024 + ch] = (bf16)f2bf(o);
    }
}

template <bool OUT_BF16>
__device__ __forceinline__ void ln_rows4(Frame& F, int nrows, const float* g, const float* b, bf16* dstb) {
    const int gw = blockIdx.x * NWAVES + F.wave, NGW = F.G * NWAVES;
    const float* META1 = WSP(float, WS_META1);
    f32x4 gg[4], bb[4];
#pragma unroll
    for (int j = 0; j < 4; ++j) { gg[j] = ((const f32x4*)g)[F.lane + 64 * j]; bb[j] = ((const f32x4*)b)[F.lane + 64 * j]; }
    for (int r0 = gw * 4; r0 < nrows; r0 += NGW * 4) {
        f32x4 v[4][4];
#pragma unroll
        for (int q = 0; q < 4; ++q) {
            const int r = r0 + q < nrows ? r0 + q : nrows - 1;
            const f32x4* xr = (const f32x4*)(r < NREAL ? F.out + (size_t)r * D : META1 + (size_t)(r - NREAL) * D) + F.lane;
#pragma unroll
            for (int j = 0; j < 4; ++j) v[q][j] = xr[64 * j];
        }
#pragma unroll
        for (int q = 0; q < 4; ++q) {
            float s = 0.f;
#pragma unroll
            for (int j = 0; j < 4; ++j) s += (v[q][j].x + v[q][j].y) + (v[q][j].z + v[q][j].w);
            const float mean = wave_sum(s) * (1.f / D); float s2 = 0.f;
#pragma unroll
            for (int j = 0; j < 4; ++j) { v[q][j] = v[q][j] - mean; s2 += (v[q][j].x * v[q][j].x + v[q][j].y * v[q][j].y) + (v[q][j].z * v[q][j].z + v[q][j].w * v[q][j].w); }
            const float rstd = 1.f / sqrtf(wave_sum(s2) * (1.f / D) + LN_EPS);
            if (r0 + q < nrows) {
                if (OUT_BF16) { v2u* o8 = (v2u*)(dstb + (size_t)(r0 + q) * D) + F.lane;
#pragma unroll
                    for (int j = 0; j < 4; ++j) { const f32x4 y = v[q][j] * rstd * gg[j] + bb[j]; o8[64 * j] = (v2u){pk2(y.x, y.y), pk2(y.z, y.w)}; }
                } else { f32x4* o = (f32x4*)(F.out + (size_t)(r0 + q) * D) + F.lane;
#pragma unroll
                    for (int j = 0; j < 4; ++j) o[64 * j] = v[q][j] * rstd * gg[j] + bb[j]; }
            }
        }
    }
}
__device__ __forceinline__ void p10_ln1(Frame& F) { ln_rows4<true>(F, NROWS, F.in[IN_LN1_G], F.in[IN_LN1_B], WSP(bf16, WS_H)); }
__device__ __forceinline__ void p14_ln2(Frame& F) { ln_rows4<false>(F, NREAL, F.in[IN_LN2_G], F.in[IN_LN2_B], nullptr); }

__device__ __forceinline__ float gelu_fast(float x) {
    const float u2 = x * (1.5957691216057308f + 0.07135481627260025f * x * x);
    return x * __builtin_amdgcn_rcpf(1.0f + __builtin_amdgcn_exp2f(-1.4426950408889634f * u2));
}
__device__ __forceinline__ void p12_conv_fix(Frame& F) {
    bf16* ACT = WSP(bf16, WS_UP); const float* cw = F.in[IN_CONV_W]; const float* cb = F.in[IN_CONV_B];
    const float* G01 = WSP(float, WS_G01); const float* V01 = WSP(float, WS_V01); const float* GHALO = WSP(float, WS_GHALO); const float* GMETA = WSP(float, WS_GMETA);
    for (int it = blockIdx.x * NTHR + F.tid; it < 128 * 2 * DFF; it += F.G * NTHR) {
        const int j = it % DFF, rr = (it / DFF) & 1, pm = it / (2 * DFF);
        const float* ph = (pm & 31) ? GHALO + (size_t)(pm - 1) * 2 * DFF : GMETA;
        const float g0 = G01[((size_t)pm * 2 + rr) * DFF + j];
        const float g1 = rr ? G01[((size_t)pm * 2) * DFF + j] : ph[DFF + j];
        const float g2 = rr ? ph[DFF + j] : ph[j];
        const float x = cw[j] * g2 + cw[DFF + j] * g1 + cw[2 * DFF + j] * g0 + cb[j];
        ACT[(size_t)(pm * 256 + rr) * DFF + j] = (bf16)f2bf(gelu_fast(x) * V01[((size_t)pm * 2 + rr) * DFF + j]);
    }
}


constexpr int NUNITS = 4096 + 8;
constexpr int RP = 72;
constexpr int SLOT = 64 * RP * 2;
constexpr int FP = 68;
typedef short bf16x8 __attribute__((ext_vector_type(8)));
typedef float f32x16 __attribute__((ext_vector_type(16)));
constexpr size_t RW_MAT = (size_t)NUNITS * 4096;

__device__ __forceinline__ void quad_mma(f32x16& acc, const LAS bf16* Aop, const LAS bf16* Bop, int qr, int qc, int lane) {
    const int r = lane & 31, hf = lane >> 5;
    const LAS bf16* ap = Aop + (32 * qr + r) * RP + 8 * hf; const LAS bf16* bp = Bop + (32 * qc + r) * RP + 8 * hf;
#pragma unroll
    for (int ks = 0; ks < 4; ++ks) {
        const bf16x8 a = *(const LAS bf16x8*)(ap + 16 * ks), b = *(const LAS bf16x8*)(bp + 16 * ks);
        acc = __builtin_amdgcn_mfma_f32_32x32x16_bf16(a, b, acc, 0, 0, 0);
    }
}
#define ACC_M(qr, j, hf) (32 * (qr) + ((j) & 3) + 8 * ((j) >> 2) + 4 * (hf))
__device__ __forceinline__ void store_T(const f32x16& acc, LAS bf16* Z, int qr, int qc, int lane) {
    const int r = lane & 31, hf = lane >> 5;
#pragma unroll
    for (int jj = 0; jj < 4; ++jj)
        *(LAS v2u*)(Z + (32 * qc + r) * RP + 32 * qr + 8 * jj + 4 * hf) = (v2u){pk2(acc[4 * jj], acc[4 * jj + 1]), pk2(acc[4 * jj + 2], acc[4 * jj + 3])};
}
__device__ __forceinline__ void add_T(f32x16& acc, const LAS bf16* Z, int qr, int qc, int lane) {
    const int r = lane & 31, hf = lane >> 5;
#pragma unroll
    for (int jj = 0; jj < 4; ++jj) {
        const v2u w = *(const LAS v2u*)(Z + (32 * qc + r) * RP + 32 * qr + 8 * jj + 4 * hf);
        acc[4 * jj] += bflo(w.x); acc[4 * jj + 1] += bfhi(w.x); acc[4 * jj + 2] += bflo(w.y); acc[4 * jj + 3] += bfhi(w.y);
    }
}
__device__ __forceinline__ int frag_off(int n, int m) { return (((m >> 4) * 2 + ((m >> 3) & 1)) * 64 + n) * 8 + (m & 7); }
__device__ __forceinline__ int acc_off(int n, int m) { return ((((m >> 5) * 4 + ((m >> 3) & 3)) * 2 + ((m >> 2) & 1)) * 64 + n) * 4 + (m & 3); }
template <bool FRAG>
__device__ __forceinline__ void store_T_global(const f32x16& acc, bf16* Z, int qr, int qc, int lane) {
    const int r = lane & 31, hf = lane >> 5;
#pragma unroll
    for (int jj = 0; jj < 4; ++jj) { const int n = 32 * qc + r, m0 = 32 * qr + 8 * jj + 4 * hf;
        *(v2u*)(Z + (FRAG ? frag_off(n, m0) : acc_off(n, m0))) = (v2u){pk2(acc[4 * jj], acc[4 * jj + 1]), pk2(acc[4 * jj + 2], acc[4 * jj + 3])}; }
}
__device__ __forceinline__ f32x16 zero16() { f32x16 z;
#pragma unroll
    for (int j = 0; j < 16; ++j) z[j] = 0.f;
    return z; }

__device__ __forceinline__ void b1_load_raw(const bf16* P, int u, int w, int l, unsigned short (&rv)[45]) {
    const bool meta = u >= 4096;
    int b = 0, h, c = 0; if (meta) h = u - 4096; else { b = u >> 10; h = (u >> 7) & 7; c = u & 127; }
    const int ch = h * 64 + l, row0 = meta ? NREAL : b * SEQ + c * 64, t0 = 8 * w;
    int prow = -1;
    if (t0 > 0) prow = row0 + t0 - 1; else if (!meta) prow = (c == 0) ? NREAL + NMETA - 1 : row0 - 1;
#pragma unroll
    for (int i = 0; i < 9; ++i) {
        const int t = t0 - 1 + i;
        const int row = i == 0 ? prow : ((!meta || t < NMETA) ? row0 + t : -1);
        const bf16* pp = P + (size_t)(row >= 0 ? row : 0) * PW;
        const unsigned short a0 = pp[PC_R + ch], a1 = pp[PC_K + ch], a2 = pp[PC_V + ch], a3 = pp[PC_WD + l], a4 = pp[PC_AD + l];
        const bool ok = row >= 0;
        rv[5 * i] = ok ? a0 : (unsigned short)0; rv[5 * i + 1] = ok ? a1 : (unsigned short)0; rv[5 * i + 2] = ok ? a2 : (unsigned short)0; rv[5 * i + 3] = ok ? a3 : (unsigned short)0; rv[5 * i + 4] = ok ? a4 : (unsigned short)0;
    }
}

#define LDS_BARRIER() do { asm volatile("s_waitcnt lgkmcnt(0)" ::: "memory"); __builtin_amdgcn_s_barrier(); asm volatile("" ::: "memory"); } while (0)
#ifdef PROBE_B1SEC
#define B1T(k) do { if (blockIdx.x == 0 && F.tid == 0) { const unsigned long long t_ = __builtin_amdgcn_s_memrealtime(); if ((k) == PROBE_B1SEC + 1) b1acc += t_ - b1t0; b1t0 = t_; } } while (0)
#else
#define B1T(k) do {} while (0)
#endif
__device__ __forceinline__ void rw_b1(Frame& F) {
    const bf16* P = WSP(bf16, WS_P);
    bf16* RWM = WSP(bf16, WS_RWM); bf16* RWN = WSP(bf16, WS_RWN); bf16* RWQ = WSP(bf16, WS_RWQ); bf16* RWY = WSP(bf16, WS_RWY);
    float* BONUS = (float*)((char*)F.out + OUT_BONUS);
    const bf16* WdT = WSP(bf16, WS_WT_LORA); const bf16* WaT = WdT + 512 * 64;
    const float* mu = F.in[IN_MU];
    const int w = F.wave, l = F.lane, tid = F.tid;
    LAS unsigned char* L = F.lds;
#define SL(s) ((LAS bf16*)(L + (s) * SLOT))
    LAS float* WL = (LAS float*)(L + 12 * SLOT);
    LAS float* AL = (LAS float*)(L + 0 * SLOT);
    LAS float* OT = (LAS float*)(L + RING_BYTES + 1024);
    LAS float* GL = OT + 512;
    unsigned long long b1acc = 0ull, b1t0 = 0ull; (void)b1acc; (void)b1t0;
    unsigned short rnx[45];
    b1_load_raw(P, (int)blockIdx.x < NUNITS ? (int)blockIdx.x : 0, w, l, rnx);
    for (int u = blockIdx.x; u < NUNITS; u += F.G) {
        const bool meta = u >= 4096;
        int b = 0, h, c = 0; if (meta) h = u - 4096; else { b = u >> 10; h = (u >> 7) & 7; c = u & 127; }
        const int ch = h * 64 + l;
        const int row0 = meta ? NREAL : b * SEQ + c * 64;
        LDS_BARRIER();
        B1T(0);
        float r_s[8], k_s[8], v_s[8], xw[8], xa[8];
        {
            const int t0 = 8 * w;
            unsigned short rc[45];
#pragma unroll
            for (int i = 0; i < 45; ++i) rc[i] = rnx[i];
            float pr = bf2f(rc[0]), pk = bf2f(rc[1]), pv = bf2f(rc[2]), pw = bf2f(rc[3]), pa = bf2f(rc[4]);
            const float mr = mu[ch], mk = mu[512 + ch], mv = mu[1024 + ch], mw = mu[1536 + l], ma = mu[1600 + l];
#pragma unroll
            for (int i = 0; i < 8; ++i) {
                const int t = t0 + i; const bool valid = !meta || t < NMETA;
                const float cr = bf2f(rc[5 * i + 5]), ck = bf2f(rc[5 * i + 6]), cv = bf2f(rc[5 * i + 7]), cw = bf2f(rc[5 * i + 8]), ca = bf2f(rc[5 * i + 9]);
                r_s[i] = valid ? cr + (pr - cr) * mr : 0.f; k_s[i] = valid ? ck + (pk - ck) * mk : 0.f; v_s[i] = valid ? cv + (pv - cv) * mv : 0.f;
                xw[i] = fast_tanh(cw + (pw - cw) * mw); xa[i] = ca + (pa - ca) * ma;
                pr = cr; pk = ck; pv = cv; pw = cw; pa = ca;
            }
#pragma unroll
            for (int i = 0; i < 8; ++i) { SL(8)[(t0 + i) * RP + l] = (bf16)f2bf(xw[i]); SL(9)[(t0 + i) * RP + l] = (bf16)f2bf(xa[i]); }
            {
                const int k = tid >> 3, pc = tid & 7;
                *(LAS v4u*)(SL(10) + k * RP + 8 * pc) = *(const v4u*)(WdT + (size_t)(h * 64 + k) * 64 + 8 * pc);
                *(LAS v4u*)(SL(11) + k * RP + 8 * pc) = *(const v4u*)(WaT + (size_t)(h * 64 + k) * 64 + 8 * pc);
            }
        }
        __syncthreads();
        B1T(1);
        {
            const int pid = w >> 2, q = w & 3, qr = q >> 1, qc = q & 1;
            f32x16 acc = zero16();
            quad_mma(acc, SL(10 + pid), SL(8 + pid), qr, qc, l);
            LAS float* Zf = pid ? AL : WL;
            const int r = l & 31, hf = l >> 5;
#pragma unroll
            for (int jj = 0; jj < 4; ++jj) *(LAS f32x4*)(Zf + (32 * qc + r) * FP + 32 * qr + 8 * jj + 4 * hf) = (f32x4){acc[4 * jj], acc[4 * jj + 1], acc[4 * jj + 2], acc[4 * jj + 3]};
        }
        __syncthreads();
        B1T(2);
        float lw[8], asg[8];
        {
            const float w0c = F.in[IN_W0][ch], a0c = F.in[IN_A0][ch];
            float run = 0.f;
#pragma unroll
            for (int i = 0; i < 8; ++i) {
                const int t = 8 * w + i; const bool valid = !meta || t < NMETA;
                const float x = -(WL[t * FP + l] + w0c);
                const float sp = x > 20.f ? x : __logf(1.0f + __expf(x));
                const float e = -__expf(-sp - 0.5f);
                run += valid ? e : 0.f; lw[i] = run;
                asg[i] = sigmoidf_(AL[t * FP + l] + a0c);
            }
            OT[w * 64 + l] = run;
        }
        __syncthreads();
        {
            float off = 0.f, tot = 0.f;
#pragma unroll
            for (int ww = 0; ww < 8; ++ww) { const float o = OT[ww * 64 + l]; tot += o; off += ww < w ? o : 0.f; }
            if (w == 0) GL[l] = __expf(tot);
            const float kkc = F.in[IN_KK][ch], kac = F.in[IN_KA][ch], rkc = F.in[IN_RK][ch];
            unsigned atc[4], vc[4], bhc[4], khc[4];
            float prevlg = off;
#pragma unroll
            for (int i = 0; i < 8; ++i) {
                const int t = 8 * w + i;
                const float lg = off + lw[i];
                const float g = __expf(lg), gp = __expf(prevlg), gi = __expf(-lg), gh = __expf(tot - lg);
                prevlg = lg;
                const float kkr = k_s[i] * kkc;
                const float kk = kkr * __builtin_amdgcn_rsqf(fmaxf(wave_sum(kkr * kkr), 1e-24f));
                const float k2 = k_s[i] * (1.f + (asg[i] - 1.f) * kac);
                const float bon = wave_sum(r_s[i] * k2 * rkc);
                if (l == 0) BONUS[(size_t)u * 64 + t] = bon;
                const float at = -kk * gp, rt = r_s[i] * g, bt = kk * asg[i] * gi, kt = k2 * gi, bh = kk * asg[i] * gh, kh = k2 * gh;
                SL(0)[t * RP + l] = (bf16)f2bf(at); SL(1)[t * RP + l] = (bf16)f2bf(rt); SL(2)[t * RP + l] = (bf16)f2bf(bt); SL(3)[t * RP + l] = (bf16)f2bf(kt);
                const unsigned ua = f2bf(at), uv = f2bf(v_s[i]), ub = f2bf(bh), uk = f2bf(kh);
                if (i & 1) { atc[i >> 1] |= ua << 16; vc[i >> 1] |= uv << 16; bhc[i >> 1] |= ub << 16; khc[i >> 1] |= uk << 16; }
                else { atc[i >> 1] = ua; vc[i >> 1] = uv; bhc[i >> 1] = ub; khc[i >> 1] = uk; }
            }
            *(LAS v4u*)(SL(4) + l * RP + 8 * w) = (v4u){atc[0], atc[1], atc[2], atc[3]};
            *(LAS v4u*)(SL(5) + l * RP + 8 * w) = (v4u){vc[0], vc[1], vc[2], vc[3]};
            *(LAS v4u*)(SL(6) + l * RP + 8 * w) = (v4u){bhc[0], bhc[1], bhc[2], bhc[3]};
            *(LAS v4u*)(SL(7) + l * RP + 8 * w) = (v4u){khc[0], khc[1], khc[2], khc[3]};
        }
        __syncthreads();
        B1T(3);
        for (int task = w; task < 20; task += 8) {
            int pid, qr, qc; bool zero = false;
            if (task < 15) { pid = task / 3; const int k = task % 3;
                if (pid == 1) { qc = k == 2 ? 1 : 0; qr = k == 0 ? 0 : 1; } else { qc = k == 0 ? 0 : 1; qr = k == 2 ? 1 : 0; } }
            else { pid = task - 15; zero = true; if (pid == 1) { qc = 1; qr = 0; } else { qc = 0; qr = 1; } }
            const int bop = pid == 0 ? 0 : pid == 1 ? 2 : pid == 2 ? 0 : 1;
            const int aop = pid == 0 ? 2 : pid == 1 ? 0 : pid == 2 ? 3 : pid == 3 ? 2 : 3;
            f32x16 acc = zero16();
            if (!zero) {
                quad_mma(acc, SL(aop), SL(bop), qr, qc, l);
                const int n = 32 * qc + (l & 31), hf = l >> 5;
#pragma unroll
                for (int j = 0; j < 16; ++j) {
                    const int m = ACC_M(qr, j, hf);
                    const bool keep = pid == 1 ? (m > n) : (pid <= 2 ? (n > m) : (n >= m));
                    acc[j] = keep ? acc[j] : 0.f;
                }
            }
            store_T(acc, SL(8 + pid), qr, qc, l);
        }
        __syncthreads();
        B1T(4);
        const int nq = w & 3, nqr = nq >> 1, nqc = nq & 1;
        f32x16 nacc = zero16();
        if (w < 4) { add_T(nacc, SL(8), nqr, nqc, l); }
        for (int task = w; task < 12; task += 8) {
            const int pid = task >> 2, q = task & 3, qr = q >> 1, qc = q & 1;
            f32x16 acc = zero16();
            if (pid == 0) { quad_mma(acc, SL(9), SL(8), qr, qc, l); store_T(acc, SL(0), qr, qc, l); }
            else if (pid == 1) { quad_mma(acc, SL(8), SL(9), qr, qc, l); store_T(acc, SL(2), qr, qc, l); }
            else { quad_mma(acc, SL(10), SL(5), qr, qc, l); store_T(acc, SL(3), qr, qc, l); }
        }
        __syncthreads();
#pragma unroll
        for (int st = 0; st < 4; ++st) {
            const int pr = (st & 1) ? 10 : 0, pc = (st & 1) ? 13 : 2, pr2 = (st & 1) ? 0 : 10, pc2 = (st & 1) ? 2 : 13, nr = (st & 1) ? 9 : 8, nr2 = (st & 1) ? 8 : 9;
            if (w < 4) {
                add_T(nacc, SL(pr), nqr, nqc, l);
                quad_mma(nacc, SL(pc), SL(nr), nqr, nqc, l);
                store_T(nacc, SL(nr2), nqr, nqc, l);
                f32x16 acc = zero16();
                quad_mma(acc, SL(pc), SL(pr), nqr, nqc, l); store_T(acc, SL(pr2), nqr, nqc, l);
            } else {
                f32x16 acc = zero16();
                quad_mma(acc, SL(pr), SL(pc), nqr, nqc, l); store_T(acc, SL(pc2), nqr, nqc, l);
            }
            __syncthreads();
        }
        if (w < 4) { add_T(nacc, SL(0), nqr, nqc, l); quad_mma(nacc, SL(2), SL(8), nqr, nqc, l); store_T(nacc, SL(9), nqr, nqc, l); }
        __syncthreads();
        B1T(5);
        b1_load_raw(P, u + F.G < NUNITS ? u + F.G : u, w, l, rnx);
        {
            const int pid = w >> 2;
            f32x16 acc = zero16();
            add_T(acc, SL(pid ? 3 : 4), nqr, nqc, l);
            quad_mma(acc, SL(9), SL(pid ? 3 : 4), nqr, nqc, l);
            store_T(acc, SL(pid ? 2 : 0), nqr, nqc, l);
        }
        LDS_BARRIER();
        for (int task = w; task < 16; task += 8) {
            const int pid = task >> 2, q = task & 3, qr = q >> 1, qc = q & 1;
            f32x16 acc = zero16();
            if (pid == 0) { add_T(acc, SL(1), qr, qc, l); quad_mma(acc, SL(0), SL(11), qr, qc, l); store_T_global<true>(acc, RWQ + (size_t)u * 4096, qr, qc, l); }
            else if (pid == 1) { quad_mma(acc, SL(2), SL(11), qr, qc, l); quad_mma(acc, SL(5), SL(12), qr, qc, l); store_T_global<false>(acc, RWY + (size_t)u * 4096, qr, qc, l); }
            else if (pid == 2) {
                quad_mma(acc, SL(0), SL(6), qr, qc, l);
                const int n = 32 * qc + (l & 31), hf = l >> 5; const float gl = GL[n];
#pragma unroll
                for (int j = 0; j < 16; ++j) acc[j] += (ACC_M(qr, j, hf) == n) ? gl : 0.f;
                store_T_global<true>(acc, RWM + (size_t)u * 4096, qr, qc, l);
            } else { quad_mma(acc, SL(6), SL(2), qr, qc, l); quad_mma(acc, SL(7), SL(5), qr, qc, l); store_T_global<false>(acc, RWN + (size_t)u * 4096, qr, qc, l); }
        }
        B1T(6);
    }
#ifdef PROBE_B1SEC
    if (blockIdx.x == 0 && F.tid == 0) { F.MISC[20] = (unsigned)b1acc; }
#endif
#undef SL
}

__device__ __forceinline__ void rw_b2(Frame& F) {
    if (blockIdx.x >= 32) return;
    const bf16* RWM = WSP(bf16, WS_RWM); const bf16* RWN = WSP(bf16, WS_RWN);
    bf16* RWS = (bf16*)((char*)F.out + OUT_RWS);
    const int b = blockIdx.x >> 3, h = blockIdx.x & 7, w = F.wave, l = F.lane;
    LAS unsigned char* L = F.lds;
#define SS(buf, part) ((LAS bf16*)(L + ((buf) * 2 + (part)) * SLOT))
    const int q = w & 3, qr = q >> 1, qc = q & 1, r = l & 31, hf = l >> 5;
    if (w < 4) {
        const bf16* Nm = RWN + (size_t)(4096 + h) * 4096;
#pragma unroll
        for (int jj = 0; jj < 4; ++jj) {
            const v2u wv = *(const v2u*)(Nm + acc_off(32 * qc + r, 32 * qr + 8 * jj + 4 * hf));
            *(LAS v2u*)(SS(0, 0) + (32 * qc + r) * RP + 32 * qr + 8 * jj + 4 * hf) = wv;
            *(LAS v2u*)(SS(0, 1) + (32 * qc + r) * RP + 32 * qr + 8 * jj + 4 * hf) = (v2u){0u, 0u};
        }
    }
    __syncthreads();
    bf16x8 a_cur[4]; v2u n_cur[4];
    {
        const size_t u0 = (size_t)(b * 8 + h) * 128;
#pragma unroll
        for (int ks = 0; ks < 4; ++ks) a_cur[ks] = *(const bf16x8*)(RWM + u0 * 4096 + frag_off(32 * qr + r, 16 * ks + 8 * hf));
#pragma unroll
        for (int jj = 0; jj < 4; ++jj) n_cur[jj] = *(const v2u*)(RWN + u0 * 4096 + acc_off(32 * qc + r, 32 * qr + 8 * jj + 4 * hf));
    }
    for (int c = 0; c < 128; ++c) {
        const int u = (b * 8 + h) * 128 + c, cur = c & 1;
        if (w < 4) {
            bf16x8 a_nxt[4]; v2u n_nxt[4];
            const size_t un = (size_t)(c + 1 < 128 ? u + 1 : u);
#pragma unroll
            for (int ks = 0; ks < 4; ++ks) a_nxt[ks] = *(const bf16x8*)(RWM + un * 4096 + frag_off(32 * qr + r, 16 * ks + 8 * hf));
#pragma unroll
            for (int jj = 0; jj < 4; ++jj) n_nxt[jj] = *(const v2u*)(RWN + un * 4096 + acc_off(32 * qc + r, 32 * qr + 8 * jj + 4 * hf));
            f32x16 acc;
#pragma unroll
            for (int jj = 0; jj < 4; ++jj) { acc[4 * jj] = bflo(n_cur[jj].x); acc[4 * jj + 1] = bfhi(n_cur[jj].x); acc[4 * jj + 2] = bflo(n_cur[jj].y); acc[4 * jj + 3] = bfhi(n_cur[jj].y); }
#pragma unroll
            for (int jj = 0; jj < 4; ++jj)
                *(v2u*)(RWS + (size_t)u * 4096 + frag_off(32 * qc + r, 32 * qr + 8 * jj + 4 * hf)) = *(const LAS v2u*)(SS(cur, 0) + (32 * qc + r) * RP + 32 * qr + 8 * jj + 4 * hf);
            const LAS bf16* bh = SS(cur, 0) + (32 * qc + r) * RP + 8 * hf; const LAS bf16* bl = SS(cur, 1) + (32 * qc + r) * RP + 8 * hf;
#pragma unroll
            for (int ks = 0; ks < 4; ++ks) {
                acc = __builtin_amdgcn_mfma_f32_32x32x16_bf16(a_cur[ks], *(const LAS bf16x8*)(bh + 16 * ks), acc, 0, 0, 0);
                acc = __builtin_amdgcn_mfma_f32_32x32x16_bf16(a_cur[ks], *(const LAS bf16x8*)(bl + 16 * ks), acc, 0, 0, 0);
            }
#pragma unroll
            for (int jj = 0; jj < 4; ++jj) {
                float hi[4], lo[4];
#pragma unroll
                for (int e = 0; e < 4; ++e) { const unsigned hb = f2bf(acc[4 * jj + e]); hi[e] = __uint_as_float(hb << 16); lo[e] = acc[4 * jj + e] - hi[e]; }
                *(LAS v2u*)(SS(cur ^ 1, 0) + (32 * qc + r) * RP + 32 * qr + 8 * jj + 4 * hf) = (v2u){pk2(hi[0], hi[1]), pk2(hi[2], hi[3])};
                *(LAS v2u*)(SS(cur ^ 1, 1) + (32 * qc + r) * RP + 32 * qr + 8 * jj + 4 * hf) = (v2u){pk2(lo[0], lo[1]), pk2(lo[2], lo[3])};
            }
#pragma unroll
            for (int ks = 0; ks < 4; ++ks) a_cur[ks] = a_nxt[ks];
#pragma unroll
            for (int jj = 0; jj < 4; ++jj) n_cur[jj] = n_nxt[jj];
        }
        LDS_BARRIER();
    }
#undef SS
}

__device__ __forceinline__ void rw_b3(Frame& F, bool meta_only = false) {
    const bf16* P = WSP(bf16, WS_P); bf16* QA = WSP(bf16, WS_QA);
    const bf16* RWQ = WSP(bf16, WS_RWQ); const bf16* RWY = WSP(bf16, WS_RWY);
    const bf16* RWS = (const bf16*)((const char*)F.out + OUT_RWS); const float* BONUS = (const float*)((const char*)F.out + OUT_BONUS);
    const bf16* WgT = WSP(bf16, WS_WT_LORA) + 2 * 512 * 64;
    const float* mu = F.in[IN_MU];
    const int l = F.lane, r = l & 31, hf = l >> 5;
    const int gw = blockIdx.x * NWAVES + F.wave, NGW = F.G * NWAVES;
    for (int it = meta_only ? 8192 + F.wave : gw; it < (meta_only ? 8200 : 8192); it += meta_only ? NWAVES : NGW) {
        const int u = it < 8192 ? it >> 1 : 4096 + (it - 8192), th = it < 8192 ? (it & 1) : 0;
        const bool meta = u >= 4096;
        int b = 0, h, c = 0; if (meta) h = u - 4096; else { b = u >> 10; h = (u >> 7) & 7; c = u & 127; }
        const int t = 32 * th + r;
        const bool valid = !meta || t < NMETA;
        const int row0 = meta ? NREAL : b * SEQ + c * 64;
        const int row = valid ? row0 + t : row0;
        int prow = -1;
        if (t > 0) prow = row - 1; else if (!meta) prow = (c == 0) ? NREAL + NMETA - 1 : row - 1;
        f32x16 y[2];
#pragma unroll
        for (int qv = 0; qv < 2; ++qv) {
            const bf16* Y0 = RWY + (size_t)u * 4096;
#pragma unroll
            for (int jj = 0; jj < 4; ++jj) { const v2u wv = *(const v2u*)(Y0 + acc_off(32 * th + r, 32 * qv + 8 * jj + 4 * hf)); y[qv][4 * jj] = bflo(wv.x); y[qv][4 * jj + 1] = bfhi(wv.x); y[qv][4 * jj + 2] = bflo(wv.y); y[qv][4 * jj + 3] = bfhi(wv.y); }
        }
        if (!meta) {
            const bf16* qp = RWQ + (size_t)u * 4096; const bf16* sp = RWS + (size_t)u * 4096;
#pragma unroll
            for (int ks = 0; ks < 4; ++ks) {
                const bf16x8 bq = *(const bf16x8*)(qp + frag_off(32 * th + r, 16 * ks + 8 * hf));
                y[0] = __builtin_amdgcn_mfma_f32_32x32x16_bf16(*(const bf16x8*)(sp + frag_off(r, 16 * ks + 8 * hf)), bq, y[0], 0, 0, 0);
                y[1] = __builtin_amdgcn_mfma_f32_32x32x16_bf16(*(const bf16x8*)(sp + frag_off(32 + r, 16 * ks + 8 * hf)), bq, y[1], 0, 0, 0);
            }
        }
        f32x16 g[2]; g[0] = zero16(); g[1] = zero16();
        {
            const bf16* gp = P + (size_t)row * PW + PC_GD + 8 * hf; const bf16* gpp = prow >= 0 ? P + (size_t)prow * PW + PC_GD + 8 * hf : nullptr;
            const bf16* wp = WgT + (size_t)(h * 64 + r) * 128 + 8 * hf;
#pragma unroll
            for (int ks = 0; ks < 8; ++ks) {
                const v4u cg = *(const v4u*)(gp + 16 * ks); const v4u pg = gpp ? *(const v4u*)(gpp + 16 * ks) : (v4u){0u, 0u, 0u, 0u};
                const f32x4 m0 = *(const f32x4*)(mu + 1664 + 16 * ks + 8 * hf), m1 = *(const f32x4*)(mu + 1664 + 16 * ks + 8 * hf + 4);
                const unsigned cw[4] = {cg.x, cg.y, cg.z, cg.w}, pw[4] = {pg.x, pg.y, pg.z, pg.w}; const float mm[8] = {m0.x, m0.y, m0.z, m0.w, m1.x, m1.y, m1.z, m1.w};
                unsigned o[4];
#pragma unroll
                for (int e = 0; e < 4; ++e) {
                    const float c0 = bflo(cw[e]), c1 = bfhi(cw[e]), p0 = bflo(pw[e]), p1 = bfhi(pw[e]);
                    o[e] = pk2(sigmoidf_(c0 + (p0 - c0) * mm[2 * e]), sigmoidf_(c1 + (p1 - c1) * mm[2 * e + 1]));
                }
                const v4u ov = (v4u){o[0], o[1], o[2], o[3]};
                const bf16x8 bs = __builtin_bit_cast(bf16x8, ov);
                g[0] = __builtin_amdgcn_mfma_f32_32x32x16_bf16(*(const bf16x8*)(wp + 16 * ks), bs, g[0], 0, 0, 0);
                g[1] = __builtin_amdgcn_mfma_f32_32x32x16_bf16(*(const bf16x8*)(wp + 32 * 128 + 16 * ks), bs, g[1], 0, 0, 0);
            }
        }
        float s = 0.f;
#pragma unroll
        for (int j = 0; j < 16; ++j) s += y[0][j] + y[1][j];
        s += __shfl_xor(s, 32);
        const float mean = s * (1.f / 64.f);
        float s2 = 0.f;
#pragma unroll
        for (int j = 0; j < 16; ++j) { const float d0 = y[0][j] - mean, d1 = y[1][j] - mean; s2 += d0 * d0 + d1 * d1; }
        s2 += __shfl_xor(s2, 32);
        const float rstd = 1.0f / sqrtf(s2 * (1.f / 64.f) + GN_EPS);
        const float bon = BONUS[(size_t)u * 64 + t];
        if (valid) {
#pragma unroll
            for (int qv = 0; qv < 2; ++qv)
#pragma unroll
                for (int jj = 0; jj < 4; ++jj) {
                    const int v0 = 32 * qv + 8 * jj + 4 * hf, chv = h * 64 + v0;
                    const v2u cvw = *(const v2u*)(P + (size_t)row * PW + PC_V + chv); const v2u pvw = prow >= 0 ? *(const v2u*)(P + (size_t)prow * PW + PC_V + chv) : (v2u){0u, 0u};
                    const f32x4 mv = *(const f32x4*)(mu + 1024 + chv), gg = *(const f32x4*)(F.in[IN_GN_G] + chv), gb = *(const f32x4*)(F.in[IN_GN_B] + chv);
                    const float cv[4] = {bflo(cvw.x), bfhi(cvw.x), bflo(cvw.y), bfhi(cvw.y)}, pv[4] = {bflo(pvw.x), bfhi(pvw.x), bflo(pvw.y), bfhi(pvw.y)};
                    const float mvv[4] = {mv.x, mv.y, mv.z, mv.w}, ggv[4] = {gg.x, gg.y, gg.z, gg.w}, gbv[4] = {gb.x, gb.y, gb.z, gb.w};
                    float o[4];
#pragma unroll
                    for (int e = 0; e < 4; ++e) {
                        const float vs = cv[e] + (pv[e] - cv[e]) * mvv[e];
                        o[e] = ((y[qv][4 * jj + e] - mean) * rstd * ggv[e] + gbv[e] + bon * vs) * g[qv][4 * jj + e];
                    }
                    *(v2u*)(QA + (size_t)row * QAW + 1024 + chv) = (v2u){pk2(o[0], o[1]), pk2(o[2], o[3])};
                }
        }
    }
}

constexpr int IX_CAP = 512, IX_LIST = 3072, IX_KB = 98304, IX_SCR = RING_BYTES + 4096;
#define IX_FENCE() asm volatile("s_waitcnt lgkmcnt(0)" ::: "memory")

__device__ __forceinline__ unsigned ix_mbcnt(unsigned long long m) { return __builtin_amdgcn_mbcnt_hi((unsigned)(m >> 32), __builtin_amdgcn_mbcnt_lo((unsigned)m, 0u)); }

__device__ __forceinline__ void ix_select_slow(const float (&sc)[8], const unsigned (&ix)[8], bool (&vl)[8], int K, unsigned short* sel_out, int lane) {
    for (int it = 0; it < K; ++it) {
        unsigned long long best = 0ull;
#pragma unroll
        for (int i = 0; i < 8; ++i) { const unsigned long long key = ((unsigned long long)sortable(sc[i]) << 32) | (unsigned long long)(0xFFFFu - ix[i]) | 0x10000ull; if (vl[i] && key > best) best = key; }
        unsigned long long wm = best;
#pragma unroll
        for (int o = 1; o < 64; o <<= 1) { const unsigned long long v = __shfl_xor(wm, o); wm = v > wm ? v : wm; }
        if (wm == 0ull) break;
        const bool mine = best == wm;
#pragma unroll
        for (int i = 0; i < 8; ++i) { const unsigned long long key = ((unsigned long long)sortable(sc[i]) << 32) | (unsigned long long)(0xFFFFu - ix[i]) | 0x10000ull; if (mine && vl[i] && key == wm) { vl[i] = false; sel_out[it] = (unsigned short)ix[i]; } }
    }
}

__device__ __forceinline__ void ix_compact(LAS float* LS, LAS unsigned short* LI, LAS unsigned* hist, int& cnt, float& tau, int lane, bool final_sel, unsigned short* sel_out) {
    const int n = cnt;
    float sc[8]; unsigned ix[8]; bool vl[8];
    IX_FENCE();
#pragma unroll
    for (int i = 0; i < 8; ++i) { const int p = lane + 64 * i; vl[i] = p < n; sc[i] = vl[i] ? LS[p] : -INFINITY; ix[i] = vl[i] ? (unsigned)LI[p] : 0u; }
    float mx = -INFINITY, mn = INFINITY;
#pragma unroll
    for (int i = 0; i < 8; ++i) { if (vl[i]) { mx = fmaxf(mx, sc[i]); mn = fminf(mn, sc[i]); } }
    mx = wave_max(mx); mn = -wave_max(-mn);
    const float scale = mx > mn ? 255.99f / (mx - mn) : 0.f;
    int bin[8];
#pragma unroll
    for (int i = 0; i < 8; ++i) { int bq = (int)((sc[i] - mn) * scale); bq = bq > 255 ? 255 : (bq < 0 ? 0 : bq); bin[i] = vl[i] ? bq : -1; }
    *(LAS v4u*)(hist + 4 * lane) = (v4u){0u, 0u, 0u, 0u};
    IX_FENCE();
#pragma unroll
    for (int i = 0; i < 8; ++i) if (vl[i]) __hip_atomic_fetch_add((LAS unsigned*)&hist[bin[i]], 1u, __ATOMIC_RELAXED, __HIP_MEMORY_SCOPE_WAVEFRONT);
    IX_FENCE();
    const v4u c = *(const LAS v4u*)(hist + 4 * lane);
    const unsigned Pp = wave_scan_incl(c.x + c.y + c.z + c.w, lane);
    const unsigned total = (unsigned)__builtin_amdgcn_readlane((int)Pp, 63);
    const unsigned K = TOPK;
    const unsigned a3 = total - Pp, a2 = a3 + c.w, a1 = a2 + c.z, a0 = a1 + c.y;
    int myb = -1; unsigned myA = 0u, myC = 0u;
    if (a3 < K && K <= a3 + c.w) { myb = 4 * lane + 3; myA = a3; myC = c.w; }
    else if (a2 < K && K <= a2 + c.z) { myb = 4 * lane + 2; myA = a2; myC = c.z; }
    else if (a1 < K && K <= a1 + c.y) { myb = 4 * lane + 1; myA = a1; myC = c.y; }
    else if (a0 < K && K <= a0 + c.x) { myb = 4 * lane; myA = a0; myC = c.x; }
    const unsigned long long bm = __ballot(myb >= 0);
    const int src = bm ? (__ffsll((long long)bm) - 1) : 0;
    const int bstar = __shfl(myb, src); const unsigned A = __shfl(myA, src), m = __shfl(myC, src);
    if (!final_sel) {
        if (A + m <= (unsigned)(IX_CAP - 128)) {
            int base = 0; float kmin = INFINITY;
#pragma unroll
            for (int i = 0; i < 8; ++i) {
                const bool keep = vl[i] && bin[i] >= bstar;
                const unsigned long long mk = __ballot(keep);
                const int pos = base + (int)ix_mbcnt(mk);
                if (keep) { LS[pos] = sc[i]; LI[pos] = (unsigned short)ix[i]; kmin = fminf(kmin, sc[i]); }
                base += __popcll(mk);
            }
            cnt = base; tau = -wave_max(-kmin);
            IX_FENCE();
            return;
        }
        unsigned short* tmp = sel_out;
        ix_select_slow(sc, ix, vl, (int)K, tmp, lane);
        int base = 0; float kmin = INFINITY;
#pragma unroll
        for (int i = 0; i < 8; ++i) {
            const bool keep = !vl[i] && (lane + 64 * i) < n;
            const unsigned long long mk = __ballot(keep);
            const int pos = base + (int)ix_mbcnt(mk);
            if (keep) { LS[pos] = sc[i]; LI[pos] = (unsigned short)ix[i]; kmin = fminf(kmin, sc[i]); }
            base += __popcll(mk);
        }
        cnt = base; tau = -wave_max(-kmin);
        IX_FENCE();
        return;
    }
    if (m <= 128u) {
        int base = 0;
#pragma unroll
        for (int i = 0; i < 8; ++i) {
            const bool keep = vl[i] && bin[i] > bstar;
            const unsigned long long mk = __ballot(keep);
            const int pos = base + (int)ix_mbcnt(mk);
            if (keep) sel_out[pos] = (unsigned short)ix[i];
            base += __popcll(mk);
        }
        LAS float* sS = (LAS float*)hist; LAS unsigned* sI = hist + 128;
        IX_FENCE();
        int mb = 0;
#pragma unroll
        for (int i = 0; i < 8; ++i) {
            const bool inb = vl[i] && bin[i] == bstar;
            const unsigned long long mk = __ballot(inb);
            const int pos = mb + (int)ix_mbcnt(mk);
            if (inb) { sS[pos] = sc[i]; sI[pos] = ix[i]; }
            mb += __popcll(mk);
        }
        IX_FENCE();
        const int need = (int)(K - A);
#pragma unroll
        for (int e = 0; e < 2; ++e) {
            const int j = lane + 64 * e;
            if (j < (int)m) {
                const float sj = sS[j]; const unsigned ij = sI[j]; int rank = 0;
                for (int k = 0; k < (int)m; ++k) { const float sk = sS[k]; const unsigned ik = sI[k]; rank += (sk > sj || (sk == sj && ik < ij)) ? 1 : 0; }
                if (rank < need) sel_out[(int)A + rank] = (unsigned short)ij;
            }
        }
    } else {
        ix_select_slow(sc, ix, vl, (int)K, sel_out, lane);
    }
}

__device__ __forceinline__ void p6_attn_mfma(Frame& F, bf16* OUTB, bool meta_only);
__device__ __forceinline__ void p5_index_mfma(Frame& F, unsigned short* SEL, int* NSEL, int qword = 3072, bool probe_noappend = false, bool do_meta = false) {
    const bf16* QA = WSP(bf16, WS_QA); const bf16* KIDX = WSP(bf16, WS_KIDX); const float* WIDX = WSP(float, WS_WIDX);
    const int tid = F.tid, w = F.wave, l = F.lane, r = l & 31, hf = l >> 5;
    {
        const int gw = blockIdx.x * NWAVES + w, NGW = F.G * NWAVES;
        for (int i = gw; i < NMETA + BATCH * 192; i += NGW) {
            int q, nvis; if (i < NMETA) { q = NREAL + i; nvis = NMETA; } else { const int bb = (i - NMETA) / 192, s = (i - NMETA) % 192; q = bb * SEQ + s; nvis = NMETA + 64 * (s / 64 + 1); }
            for (int j = l; j < nvis; j += 64) SEL[(size_t)q * TOPK + j] = (unsigned short)j;
            if (l == 0) NSEL[q] = nvis;
        }
    }
    LAS unsigned char* L = F.lds;
    LAS unsigned* hist = (LAS unsigned*)(L + IX_SCR + w * 1024);
    if (do_meta) {
        __syncthreads();
        if (tid == 0) F.MISC[17] = __hip_atomic_fetch_add((unsigned*)F.ctl + 3200, 1u, __ATOMIC_RELAXED, __HIP_MEMORY_SCOPE_AGENT);
        __syncthreads();
        const int mt = (int)F.MISC[17];
        if (mt == 0) {
            if (tid < NMETA) { for (int j = 0; j < NMETA; ++j) SEL[(size_t)(NREAL + tid) * TOPK + j] = (unsigned short)j; NSEL[NREAL + tid] = NMETA; }
            asm volatile("s_waitcnt vmcnt(0)" ::: "memory"); __syncthreads();
            p6_attn_mfma(F, WSP(bf16, WS_QA), true);
        } else if (mt == 1) { rw_b3(F, true); }
        __syncthreads();
    }
    {
        for (;;) {
            __syncthreads();
            if (tid == 0) F.MISC[16] = __hip_atomic_fetch_add((unsigned*)F.ctl + qword, 1u, __ATOMIC_RELAXED, __HIP_MEMORY_SCOPE_AGENT);
            __syncthreads();
            const int qi_ = (int)F.MISC[16];
            if (qi_ >= 1000) break;
            const int tile = 999 - qi_;
            const int pt = 6 + (tile >> 2), b = tile & 3;
            const int q0 = b * SEQ + pt * 32;
            const int nvis = NMETA + 64 * (pt / 2 + 1);
            __syncthreads();
            bf16x8 af[4];
            {
                const int qq = 2 * (r >> 4) + ((r >> 2) & 1), hd = 4 * ((r >> 3) & 1) + (r & 3);
                const bf16* qp = QA + (size_t)(q0 + 4 * w + qq) * QAW + 1024 + hd * 64 + 8 * hf;
#pragma unroll
                for (int ks = 0; ks < 4; ++ks) af[ks] = *(const bf16x8*)(qp + 16 * ks);
            }
            float wq[2][8];
#pragma unroll
            for (int a = 0; a < 2; ++a) {
                const f32x4 w0 = *(const f32x4*)(WIDX + (size_t)(q0 + 4 * w + 2 * a + hf) * 8), w1 = *(const f32x4*)(WIDX + (size_t)(q0 + 4 * w + 2 * a + hf) * 8 + 4);
                wq[a][0] = 0.5f * w0.x; wq[a][1] = 0.5f * w0.y; wq[a][2] = 0.5f * w0.z; wq[a][3] = 0.5f * w0.w; wq[a][4] = 0.5f * w1.x; wq[a][5] = 0.5f * w1.y; wq[a][6] = 0.5f * w1.z; wq[a][7] = 0.5f * w1.w;
            }
            float tau0 = -INFINITY, tau1 = -INFINITY;
            int cnt[4] = {0, 0, 0, 0};
            const int nblk = (nvis + 255) >> 8;
            v4u kreg[4];
#pragma unroll
            for (int e = 0; e < 4; ++e) {
                const int pid = tid + 512 * e, kl = pid >> 3, pc = pid & 7, j = kl;
                kreg[e] = j < nvis ? *(const v4u*)(KIDX + (size_t)key_row(b, j) * 64 + 8 * pc) : (v4u){0u, 0u, 0u, 0u};
            }
#pragma unroll
            for (int e = 0; e < 4; ++e) { const int pid = tid + 512 * e, kl = pid >> 3, pc = pid & 7; *(LAS v4u*)(L + IX_KB + kl * 128 + ((pc ^ ((kl >> 1) & 7)) << 4)) = kreg[e]; }
            __syncthreads();
            const LAS unsigned char* kb = L + IX_KB;
            for (int blk = 0; blk < nblk; ++blk) {
                if (blk + 1 < nblk) {
#pragma unroll
                    for (int e = 0; e < 4; ++e) {
                        const int pid = tid + 512 * e, kl = pid >> 3, pc = pid & 7, j = (blk + 1) * 256 + kl;
                        kreg[e] = j < nvis ? *(const v4u*)(KIDX + (size_t)key_row(b, j) * 64 + 8 * pc) : (v4u){0u, 0u, 0u, 0u};
                    }
                }
                int npair = (nvis - blk * 256 + 63) >> 6; npair = npair > 4 ? 4 : npair;
                bf16x8 bc0[4], bc1[4];
#pragma unroll
                for (int ks = 0; ks < 4; ++ks) { const int k0 = r, k1 = 32 + r;
                    bc0[ks] = *(const LAS bf16x8*)(kb + k0 * 128 + (((2 * ks + hf) ^ ((k0 >> 1) & 7)) << 4));
                    bc1[ks] = *(const LAS bf16x8*)(kb + k1 * 128 + (((2 * ks + hf) ^ ((k1 >> 1) & 7)) << 4)); }
                for (int pp = 0; pp < npair; ++pp) {
                    const int jbase = blk * 256 + pp * 64;
                    bf16x8 bn0[4], bn1[4];
                    {
                        const int pn = pp + 1 < npair ? pp + 1 : pp; const int k0 = pn * 64 + r, k1 = k0 + 32;
#pragma unroll
                        for (int ks = 0; ks < 4; ++ks) {
                            bn0[ks] = *(const LAS bf16x8*)(kb + k0 * 128 + (((2 * ks + hf) ^ ((k0 >> 1) & 7)) << 4));
                            bn1[ks] = *(const LAS bf16x8*)(kb + k1 * 128 + (((2 * ks + hf) ^ ((k1 >> 1) & 7)) << 4)); }
                    }
                    f32x16 accA = zero16(), accB = zero16();
#pragma unroll
                    for (int ks = 0; ks < 4; ++ks) { accA = __builtin_amdgcn_mfma_f32_32x32x16_bf16(af[ks], bc0[ks], accA, 0, 0, 0); accB = __builtin_amdgcn_mfma_f32_32x32x16_bf16(af[ks], bc1[ks], accB, 0, 0, 0); }
#pragma unroll
                    for (int ks = 0; ks < 4; ++ks) { bc0[ks] = bn0[ks]; bc1[ks] = bn1[ks]; }
                    float sA0 = 0.f, sA0b = 0.f, sA1 = 0.f, sA1b = 0.f, sB0 = 0.f, sB0b = 0.f, sB1 = 0.f, sB1b = 0.f;
#pragma unroll
                    for (int h = 0; h < 8; h += 2) {
                        sA0 = fmaf(wq[0][h], __builtin_fabsf(accA[h]), fmaf(wq[0][h], accA[h], sA0)); sA0b = fmaf(wq[0][h + 1], __builtin_fabsf(accA[h + 1]), fmaf(wq[0][h + 1], accA[h + 1], sA0b));
                        sA1 = fmaf(wq[1][h], __builtin_fabsf(accA[8 + h]), fmaf(wq[1][h], accA[8 + h], sA1)); sA1b = fmaf(wq[1][h + 1], __builtin_fabsf(accA[9 + h]), fmaf(wq[1][h + 1], accA[9 + h], sA1b));
                        sB0 = fmaf(wq[0][h], __builtin_fabsf(accB[h]), fmaf(wq[0][h], accB[h], sB0)); sB0b = fmaf(wq[0][h + 1], __builtin_fabsf(accB[h + 1]), fmaf(wq[0][h + 1], accB[h + 1], sB0b));
                        sB1 = fmaf(wq[1][h], __builtin_fabsf(accB[8 + h]), fmaf(wq[1][h], accB[8 + h], sB1)); sB1b = fmaf(wq[1][h + 1], __builtin_fabsf(accB[9 + h]), fmaf(wq[1][h + 1], accB[9 + h], sB1b));
                    }
                    const float s0A = (sA0 + sA0b) + 0.0f, s1A = (sA1 + sA1b) + 0.0f, s0B = (sB0 + sB0b) + 0.0f, s1B = (sB1 + sB1b) + 0.0f;
                    const int jA = jbase + r, jB = jA + 32;
                    const bool p0A = jA < nvis && s0A > tau0, p1A = jA < nvis && s1A > tau1, p0B = jB < nvis && s0B > tau0, p1B = jB < nvis && s1B > tau1;
                    const unsigned long long m0A = __ballot(p0A), m1A = __ballot(p1A), m0B = __ballot(p0B), m1B = __ballot(p1B);
                    if (m0A | m1A | m0B | m1B) {
                        const int a0lo = __popc((unsigned)m0A), a0hi = __popc((unsigned)(m0A >> 32)), a1lo = __popc((unsigned)m1A), a1hi = __popc((unsigned)(m1A >> 32));
                        const int b0lo = __popc((unsigned)m0B), b0hi = __popc((unsigned)(m0B >> 32)), b1lo = __popc((unsigned)m1B), b1hi = __popc((unsigned)(m1B >> 32));
                        {
                            LAS unsigned char* lb = L + (w * 4 + hf) * IX_LIST;
                            const int base = hf ? cnt[1] : cnt[0];
                            const int posA = base + (int)ix_mbcnt(m0A) - (hf ? a0lo : 0);
                            const int posB = base + (hf ? a0hi : a0lo) + (int)ix_mbcnt(m0B) - (hf ? b0lo : 0);
                            if (p0A) { ((LAS float*)lb)[posA] = s0A; ((LAS unsigned short*)(lb + 2048))[posA] = (unsigned short)jA; }
                            if (p0B) { ((LAS float*)lb)[posB] = s0B; ((LAS unsigned short*)(lb + 2048))[posB] = (unsigned short)jB; }
                        }
                        {
                            LAS unsigned char* lb = L + (w * 4 + 2 + hf) * IX_LIST;
                            const int base = hf ? cnt[3] : cnt[2];
                            const int posA = base + (int)ix_mbcnt(m1A) - (hf ? a1lo : 0);
                            const int posB = base + (hf ? a1hi : a1lo) + (int)ix_mbcnt(m1B) - (hf ? b1lo : 0);
                            if (p1A) { ((LAS float*)lb)[posA] = s1A; ((LAS unsigned short*)(lb + 2048))[posA] = (unsigned short)jA; }
                            if (p1B) { ((LAS float*)lb)[posB] = s1B; ((LAS unsigned short*)(lb + 2048))[posB] = (unsigned short)jB; }
                        }
                        cnt[0] += a0lo + b0lo; cnt[1] += a0hi + b0hi; cnt[2] += a1lo + b1lo; cnt[3] += a1hi + b1hi;
                        if (probe_noappend) { if (cnt[0] >= 256 && hf == 0) tau0 = INFINITY; if (cnt[1] >= 256 && hf == 1) tau0 = INFINITY; if (cnt[2] >= 256 && hf == 0) tau1 = INFINITY; if (cnt[3] >= 256 && hf == 1) tau1 = INFINITY; }
#pragma unroll
                        for (int qq = 0; qq < 4; ++qq) {
                            if (cnt[qq] > IX_CAP - 64) {
                                LAS unsigned char* lb = L + (w * 4 + qq) * IX_LIST;
                                float tq = 0.f; int cq = cnt[qq];
                                ix_compact((LAS float*)lb, (LAS unsigned short*)(lb + 2048), hist, cq, tq, l, false, SEL + (size_t)(q0 + 4 * w + qq) * TOPK);
                                cnt[qq] = __builtin_amdgcn_readfirstlane(cq);
                                if ((qq & 1) == hf) { if (qq < 2) tau0 = tq; else tau1 = tq; }
                            }
                        }
                    }
                }
                __syncthreads();
                if (blk + 1 < nblk) {
#pragma unroll
                    for (int e = 0; e < 4; ++e) { const int pid = tid + 512 * e, kl = pid >> 3, pc = pid & 7; *(LAS v4u*)(L + IX_KB + kl * 128 + ((pc ^ ((kl >> 1) & 7)) << 4)) = kreg[e]; }
                    __syncthreads();
                }
            }
#pragma unroll
            for (int qq = 0; qq < 4; ++qq) {
                LAS unsigned char* lb = L + (w * 4 + qq) * IX_LIST;
                float tq = 0.f; int cq = cnt[qq];
                ix_compact((LAS float*)lb, (LAS unsigned short*)(lb + 2048), hist, cq, tq, l, true, SEL + (size_t)(q0 + 4 * w + qq) * TOPK);
                if (l == 0) NSEL[q0 + 4 * w + qq] = TOPK;
            }
        }
    }
}

#ifndef CHECK_IDX
#define CHECK_IDX 0
#endif
#if CHECK_IDX
__device__ __forceinline__ void idx_check(Frame& F) {
    const unsigned short* SEL = WSP(unsigned short, WS_SEL); const unsigned short* SELB = (const unsigned short*)F.out; const int* NSEL = WSP(int, WS_NSEL); const int* NSELB = (const int*)((const char*)F.out + 32 * MiB);
    LAS unsigned* bm = (LAS unsigned*)(F.lds + F.wave * 2048);
    const int l = F.lane; const int gw = blockIdx.x * NWAVES + F.wave, NGW = F.G * NWAVES;
    unsigned miss = 0, badq = 0, dup = 0;
    for (int q = gw; q < NROWS; q += NGW) {
        for (int i = l; i < 260; i += 64) bm[i] = 0u;
        IX_FENCE();
        const int n = NSEL[q], nb = NSELB[q];
        for (int i = l; i < n; i += 64) { const unsigned j = SEL[(size_t)q * TOPK + i]; atomicOr((unsigned*)&bm[j >> 5], 1u << (j & 31)); }
        IX_FENCE();
        unsigned m = (n != nb) ? 1000u : 0u;
        for (int i = l; i < nb && i < TOPK; i += 64) { const unsigned j = SELB[(size_t)q * TOPK + i]; if (j >= (unsigned)TT) { ++dup; ++m; } else { const unsigned old = atomicAnd((unsigned*)&bm[j >> 5], ~(1u << (j & 31))); if (!((old >> (j & 31)) & 1u)) ++m; } }
        IX_FENCE();
        m = (unsigned)wave_sum((float)m);
        if (l == 0) { miss += m; badq += m ? 1u : 0u; }
    }
    dup = (unsigned)wave_sum((float)dup);
    if (l == 0) { atomicAdd((unsigned*)F.ctl + 2048, miss); atomicAdd((unsigned*)F.ctl + 2049, badq); atomicAdd((unsigned*)F.ctl + 2050, dup); }
}
#endif

typedef short v4i16_t __attribute__((ext_vector_type(4)));
__device__ __forceinline__ unsigned at_off(unsigned row, unsigned ch) { return 256u * row + 16u * (ch ^ (((row & 3u) << 2) | ((row >> 2) & 3u))); }

__device__ __forceinline__ void p6_attn_mfma(Frame& F, bf16* OUTB, bool meta_only = false) {
    bf16* QA = WSP(bf16, WS_QA); const bf16* CKV = WSP(bf16, WS_CKV); const unsigned short* SEL = WSP(unsigned short, WS_SEL); const int* NSEL = WSP(int, WS_NSEL);
    const int l = F.lane, w = F.wave, h16 = l & 15, g = l >> 4;
    LAS unsigned char* tile = F.lds + w * 8192;
    LAS unsigned short* selb = (LAS unsigned short*)(F.lds + 65536 + w * 512);
    const float slope = h16 < 8 ? __uint_as_float((unsigned)(127 - (h16 + 1)) << 23) : 0.f;
    if (!meta_only) {
        const int gw = blockIdx.x * NWAVES + w, NGW = F.G * NWAVES;
        for (int q = NROWS + gw; q < R; q += NGW) { bf16* qrow = QA + (size_t)q * QAW; for (int c = l; c < QAW / 8; c += 64) *(v4u*)(qrow + 8 * c) = (v4u){0u, 0u, 0u, 0u}; }
    }
    if (meta_only) { }
    const int G = F.G;
    int nq_tot, qbase_b, wib, wpb;
    if ((G & 7) == 0) { const int b = (blockIdx.x & 7) >> 1; qbase_b = b * SEQ; nq_tot = SEQ; wib = (((blockIdx.x >> 3) * 2) + (blockIdx.x & 1)) * NWAVES + w; wpb = (G / 4) * NWAVES; }
    else { qbase_b = 0; nq_tot = NREAL; wib = blockIdx.x * NWAVES + w; wpb = G * NWAVES; }
    if (meta_only) { qbase_b = NREAL; nq_tot = NMETA; wib = w; wpb = NWAVES; }
    for (int qi = wib; qi < nq_tot; qi += wpb) {
        int q, b, pos;
        if (meta_only) { q = NREAL + qi; b = 0; pos = qi; }
        else if ((G & 7) == 0) { q = qbase_b + qi; b = q >> 13; pos = NMETA + qi; }
        else { q = qi; b = q >> 13; pos = NMETA + (q & (SEQ - 1)); }
        bf16* qrow = QA + (size_t)q * QAW;
        const int nsel = NSEL[q];
        const int nch = (nsel + 31) >> 5;
        const unsigned short* selq = SEL + (size_t)q * TOPK;
        IX_FENCE();
        if (l < 32) *(LAS v4u*)(selb + 8 * l) = *(const v4u*)(selq + 8 * l);
        IX_FENCE();
        bf16x8 qf[4];
#pragma unroll
        for (int s = 0; s < 4; ++s) { const v4u t = h16 < 8 ? *(const v4u*)(qrow + h16 * 128 + 32 * s + 8 * g) : (v4u){0u, 0u, 0u, 0u}; qf[s] = __builtin_bit_cast(bf16x8, t); }
        float m = -INFINITY, lsum = 0.f;
        f32x4 O[8];
#pragma unroll
        for (int c = 0; c < 8; ++c) O[c] = (f32x4){0.f, 0.f, 0.f, 0.f};
        v4u gr[8];
#pragma unroll
        for (int i = 0; i < 8; ++i) { const int s = g + 4 * i; const int kj = s < nsel ? (int)selb[s] : (int)selb[0]; gr[i] = *(const v4u*)(CKV + (size_t)key_row(b, kj) * 128 + 8 * h16); }
        for (int ck = 0; ck < nch; ++ck) {
            IX_FENCE();
#pragma unroll
            for (int i = 0; i < 8; ++i) *(LAS v4u*)(tile + at_off((unsigned)(g + 4 * i), (unsigned)h16)) = gr[i];
            const v4u kv = *(const LAS v4u*)(selb + 32 * ck + 8 * g);
            if (ck + 1 < nch) {
#pragma unroll
                for (int i = 0; i < 8; ++i) { const int s = 32 * (ck + 1) + g + 4 * i; const int kj = s < nsel ? (int)selb[s] : (int)selb[0]; gr[i] = *(const v4u*)(CKV + (size_t)key_row(b, kj) * 128 + 8 * h16); }
            }
            IX_FENCE();
            f32x4 a0 = (f32x4){0.f, 0.f, 0.f, 0.f}, a1 = a0;
#pragma unroll
            for (int s = 0; s < 4; ++s) {
                const bf16x8 k0 = *(const LAS bf16x8*)(tile + at_off((unsigned)(8 * (h16 >> 2) + (h16 & 3)), (unsigned)(4 * s + g)));
                const bf16x8 k1 = *(const LAS bf16x8*)(tile + at_off((unsigned)(8 * (h16 >> 2) + 4 + (h16 & 3)), (unsigned)(4 * s + g)));
                a0 = __builtin_amdgcn_mfma_f32_16x16x32_bf16(k0, qf[s], a0, 0, 0, 0);
                a1 = __builtin_amdgcn_mfma_f32_16x16x32_bf16(k1, qf[s], a1, 0, 0, 0);
            }
            const unsigned kw[4] = {kv.x, kv.y, kv.z, kv.w};
            float x[8];
#pragma unroll
            for (int j = 0; j < 8; ++j) {
                const int kj = (int)((kw[j >> 1] >> (16 * (j & 1))) & 0xffffu);
                const float lg = (j < 4 ? a0[j & 3] : a1[j & 3]) - slope * fabsf((float)(pos - kj));
                x[j] = (32 * ck + 8 * g + j) < nsel ? lg : -INFINITY;
            }
            float cm = fmaxf(fmaxf(fmaxf(x[0], x[1]), fmaxf(x[2], x[3])), fmaxf(fmaxf(x[4], x[5]), fmaxf(x[6], x[7])));
            cm = fmaxf(cm, __shfl_xor(cm, 16)); cm = fmaxf(cm, __shfl_xor(cm, 32));
            const float mn = fmaxf(m, cm);
            const float alpha = __expf(m - mn);
            float p[8], ps = 0.f;
#pragma unroll
            for (int j = 0; j < 8; ++j) { p[j] = __expf(x[j] - mn); ps += p[j]; }
            ps += __shfl_xor(ps, 16); ps += __shfl_xor(ps, 32);
            lsum = lsum * alpha + ps; m = mn;
            if (__any(alpha != 1.0f)) {
#pragma unroll
                for (int rr = 0; rr < 4; ++rr) { const float sc = __shfl(alpha, 4 * g + rr);
#pragma unroll
                    for (int c = 0; c < 8; ++c) O[c][rr] *= sc; }
            }
            const v4u pw = (v4u){pk2(p[0], p[1]), pk2(p[2], p[3]), pk2(p[4], p[5]), pk2(p[6], p[7])};
            const bf16x8 pf = __builtin_bit_cast(bf16x8, pw);
#pragma unroll
            for (int c = 0; c < 8; ++c) {
                const unsigned qd = (unsigned)(h16 >> 2), pp = (unsigned)(h16 & 3);
                const v4i16_t t0 = __builtin_amdgcn_ds_read_tr16_b64_v4i16((LAS v4i16_t*)(tile + at_off(8u * g + qd, 2u * c + (pp >> 1)) + 8u * (pp & 1u)));
                const v4i16_t t1 = __builtin_amdgcn_ds_read_tr16_b64_v4i16((LAS v4i16_t*)(tile + at_off(8u * g + 4u + qd, 2u * c + (pp >> 1)) + 8u * (pp & 1u)));
                bf16x8 vf; vf[0] = t0[0]; vf[1] = t0[1]; vf[2] = t0[2]; vf[3] = t0[3]; vf[4] = t1[0]; vf[5] = t1[1]; vf[6] = t1[2]; vf[7] = t1[3];
                O[c] = __builtin_amdgcn_mfma_f32_16x16x32_bf16(pf, vf, O[c], 0, 0, 0);
            }
        }
        const float inv = 1.0f / lsum;
#pragma unroll
        for (int rr = 0; rr < 4; ++rr) {
            const float sc = __shfl(inv, 4 * g + rr);
            if (g < 2) {
#pragma unroll
                for (int c = 0; c < 8; ++c) (OUTB + (size_t)q * QAW)[(4 * g + rr) * 128 + 16 * c + h16] = (bf16)f2bf(O[c][rr] * sc);
            }
        }
    }
}
struct StoreBf16 { bf16* O; int ld;
    __device__ __forceinline__ void operator()(int row, int col, const f32x4& v) const { *(v2u*)(O + (size_t)row * ld + col) = (v2u){pk2(v.x, v.y), pk2(v.z, v.w)}; }
    __device__ __forceinline__ void one(int row, int col, float v) const { O[(size_t)row * ld + col] = (bf16)f2bf(v); } };
struct StoreRes1 { const bf16* H; float* out; float* meta;
    __device__ __forceinline__ void operator()(int row, int col, const f32x4& v) const {
        if (row >= NROWS) return;
        const v2u hw = *(const v2u*)(H + (size_t)row * D + col);
        const f32x4 o = (f32x4){ALPHA * bflo(hw.x) + v.x, ALPHA * bfhi(hw.x) + v.y, ALPHA * bflo(hw.y) + v.z, ALPHA * bfhi(hw.y) + v.w};
        float* dst = row < NREAL ? out + (size_t)row * D + col : meta + (size_t)(row - NREAL) * D + col;
        *(f32x4*)dst = o; }
    __device__ __forceinline__ void one(int row, int col, float v) const { if (row >= NROWS) return; float* dst = row < NREAL ? out + (size_t)row * D + col : meta + (size_t)(row - NREAL) * D + col; *dst = ALPHA * bf2f(H[(size_t)row * D + col]) + v; } };
struct StoreRes2 { const bf16* H; float* out; __device__ __forceinline__ void operator()(int row, int col, const f32x4& v) const {
        if (row >= NREAL) return;
        const v2u hw = *(const v2u*)(H + (size_t)row * D + col);
        *(f32x4*)(out + (size_t)row * D + col) = (f32x4){ALPHA * bflo(hw.x) + v.x, ALPHA * bfhi(hw.x) + v.y, ALPHA * bflo(hw.y) + v.z, ALPHA * bfhi(hw.y) + v.w}; } };

struct StoreMetaGate { float* GM; __device__ __forceinline__ void one(int row, int col, float v) const { const int m = row - NREAL, x = col & 255; if (m >= 14 && x < 128) GM[(size_t)(m - 14) * DFF + 128 * (col >> 8) + x] = v; } };
template <class Fn>
__device__ __forceinline__ void meta_gemm(Frame& F, const bf16* A, int lda, const bf16* Bt, int N, int K, const Fn& fn) {
    const int l = F.lane, i16 = l & 15, g = l >> 4;
    const int gw = blockIdx.x * NWAVES + F.wave, NGW = F.G * NWAVES;
    for (int t = gw; t < N / 16; t += NGW) {
        const bf16* ap = A + (size_t)(NREAL + i16) * lda + 8 * g; const bf16* bp = Bt + (size_t)(16 * t + i16) * K + 8 * g;
        f32x4 acc = (f32x4){0.f, 0.f, 0.f, 0.f};
#pragma unroll 8
        for (int s = 0; s < K / 32; ++s) acc = __builtin_amdgcn_mfma_f32_16x16x32_bf16(*(const pg8::bf16x8*)(ap + 32 * s), *(const pg8::bf16x8*)(bp + 32 * s), acc, 0, 0, 0);
#pragma unroll
        for (int rr = 0; rr < 4; ++rr) fn.one(NREAL + 4 * g + rr, 16 * t + i16, acc[rr]);
    }
}

template <class Fn>
__device__ __forceinline__ void run_gemm(Frame& F, const bf16* A, int lda, const bf16* Bt, int N, int K, const Fn& fn) {
    pg8::Gemm g{A, Bt, NREAL, N, K, lda}; pg8::StaticOrder S; S.init(NREAL, N, F.G, (int)blockIdx.x);
    pg8::EpiFn<Fn> E{fn};
    pg8::gemm_phase<pg8::EpiFn<Fn>, pg8::StaticOrder, true, true>(F.lds + RING_OFF, g, S, E);
}

constexpr int NPHASES = 13;
struct Args { const float* in[32]; float* out; unsigned char* ws; int ph_lo, ph_hi; };
__global__ void __launch_bounds__(NTHR, 2) fwd(Args args) {
    extern __shared__ __attribute__((aligned(16))) unsigned char lds[];
    Frame F;
    F.lds = (LAS unsigned char*)lds;
    F.MISC = (volatile LAS unsigned*)(F.lds + MISC_OFF);
    F.tid = threadIdx.x; F.lane = F.tid & 63; F.wave = __builtin_amdgcn_readfirstlane(F.tid >> 6);
    F.G = gridDim.x;
#pragma unroll
    for (int i = 0; i < 32; ++i) F.in[i] = args.in[i];
    F.out = args.out; F.ws = args.ws;
    F.ctl = (gu32*)(args.ws + WS_CTL);
    for (int u = F.tid; u < (LDS_BYTES - LDSCTL_OFF) / 4; u += NTHR) ((LAS unsigned*)(F.lds + LDSCTL_OFF))[u] = 0u;
    __syncthreads();
    const int lo = args.ph_lo, hi = args.ph_hi;
    XcdBarrier bar; bar.bar = (unsigned*)(F.ctl + CW_BAR); bar.x = 0; bar.st = nullptr;
    if (hi - lo > 1) bar = xcd_barrier_post((unsigned*)(F.ctl + CW_BAR), F.MISC + 8);
#define IN(k) (lo <= (k) && (k) < hi)
#ifdef PROBE_PHASE_T
    unsigned long long tp_prev = __builtin_amdgcn_s_memrealtime(), tp_dur = 0ull;
#define SEAM(k) do { if (IN(k) && IN((k) + 1)) xcd_barrier(bar); if (blockIdx.x == 0 && F.tid == 0) { const unsigned long long t_ = __builtin_amdgcn_s_memrealtime(); if ((k) == PROBE_PHASE_T) tp_dur = t_ - tp_prev; tp_prev = t_; } } while (0)
#else
#define SEAM(k) do { if (IN(k) && IN((k) + 1)) xcd_barrier(bar); } while (0)
#endif
#ifndef PROBE_PH
#define PROBE_PH -1
#endif
#define REP(k) for (int rep_ = 0; rep_ < ((PROBE_PH == (k)) ? 2 : 1); ++rep_)

#ifndef IDX_NAIVE
#define IDX_NAIVE 0
#endif
#ifndef ATTN_NAIVE
#define ATTN_NAIVE 0
#endif
    if (IN(0)) REP(0) { if (rep_) __syncthreads(); p0_weights(F); p1_ln_in(F); } SEAM(0);
    if (IN(1)) REP(1) { if (rep_) __syncthreads(); run_gemm(F, WSP(bf16, WS_H), D, WSP(bf16, WS_WT_IN), PW, D, StoreBf16{WSP(bf16, WS_P), PW}); meta_gemm(F, WSP(bf16, WS_H), D, WSP(bf16, WS_WT_IN), PW, D, StoreBf16{WSP(bf16, WS_P), PW}); } SEAM(1);
    if (IN(2)) REP(2) { if (rep_) __syncthreads(); p3_prep(F); } SEAM(2);
    if (IN(3)) REP(3) { if (rep_) __syncthreads(); run_gemm(F, WSP(bf16, WS_CQN), 256, WSP(bf16, WS_WT_QA), QAW, 256, StoreBf16{WSP(bf16, WS_QA), QAW}); meta_gemm(F, WSP(bf16, WS_CQN), 256, WSP(bf16, WS_WT_QA), QAW, 256, StoreBf16{WSP(bf16, WS_QA), QAW});
#if REFSEL
        refsel_rows(F);
#endif
    } SEAM(3);
    if (IN(4)) REP(4) { if (rep_) __syncthreads(); rw_b1(F); } SEAM(4);
    if (IN(5)) {
        rw_b2(F); __syncthreads();
#if CHECK_IDX
        p5_index_naive(F); __syncthreads(); p5_index_mfma(F, (unsigned short*)F.out, (int*)((char*)F.out + 32 * MiB));
#elif IDX_NAIVE
        p5_index_naive(F);
#else
        p5_index_mfma(F, WSP(unsigned short, WS_SEL), WSP(int, WS_NSEL), 3072, false, true);
#ifdef PROBE_IDX
        __syncthreads(); p5_index_mfma(F, WSP(unsigned short, WS_SEL), WSP(int, WS_NSEL), 3136);
#endif
#ifdef PROBE_IDX_SCORE
        __syncthreads(); p5_index_mfma(F, (unsigned short*)F.out, (int*)((char*)F.out + 32 * MiB), 3136, true);
#endif
#endif
    } SEAM(5);
    if (IN(6)) {
#if CHECK_IDX
        idx_check(F); __syncthreads();
#endif
#if CHECK_IDX || IDX_NAIVE
        if (blockIdx.x == 0) { p6_attn_mfma(F, WSP(bf16, WS_QA), true); __syncthreads(); }
        if (blockIdx.x == 1) { rw_b3(F, true); __syncthreads(); }
#endif
#if ATTN_NAIVE
        p6_attn_naive(F);
#else
        p6_attn_mfma(F, WSP(bf16, WS_QA));
#endif
        __syncthreads();
        rw_b3(F);
    } SEAM(6);
    if (IN(7)) REP(7) { if (rep_) __syncthreads(); run_gemm(F, WSP(bf16, WS_QA), QAW, WSP(bf16, WS_WT_MIX), D, QAW, StoreRes1{WSP(bf16, WS_H), F.out, WSP(float, WS_META1)}); meta_gemm(F, WSP(bf16, WS_QA), QAW, WSP(bf16, WS_WT_MIX), D, QAW, StoreRes1{WSP(bf16, WS_H), F.out, WSP(float, WS_META1)}); } SEAM(7);
    if (IN(8)) REP(8) { if (rep_) __syncthreads(); p10_ln1(F); } SEAM(8);
    if (IN(9)) {
        pg8::Gemm g{WSP(bf16, WS_H), WSP(bf16, WS_WT_UP), NREAL, UPW, D, D}; pg8::StaticOrder S; S.init(NREAL, UPW, F.G, (int)blockIdx.x);
        pg8::EpiConvAct E{WSP(unsigned short, WS_UP), DFF, F.in[IN_CONV_W], F.in[IN_CONV_B], DFF, WSP(float, WS_G01), WSP(float, WS_V01), WSP(float, WS_GHALO), (PG8_LAS float*)(F.lds + RING_BYTES + 4096)};
        pg8::gemm_phase<pg8::EpiConvAct, pg8::StaticOrder, true, true>(F.lds + RING_OFF, g, S, E);
        meta_gemm(F, WSP(bf16, WS_H), D, WSP(bf16, WS_WT_UP), UPW, D, StoreMetaGate{WSP(float, WS_GMETA)});
    } SEAM(9);
    if (IN(10)) { p12_conv_fix(F); } SEAM(10);
    if (IN(11)) REP(11) { if (rep_) __syncthreads(); run_gemm(F, WSP(bf16, WS_UP), DFF, WSP(bf16, WS_WT_DN), D, DFF, StoreRes2{WSP(bf16, WS_H), F.out}); } SEAM(11);
    if (IN(12)) { p14_ln2(F);
#if CHECK_IDX
        if (blockIdx.x == 0 && F.tid == 0) {
            const unsigned miss = __hip_atomic_load((unsigned*)F.ctl + 2048, __ATOMIC_RELAXED, __HIP_MEMORY_SCOPE_AGENT), dupc = __hip_atomic_load((unsigned*)F.ctl + 2050, __ATOMIC_RELAXED, __HIP_MEMORY_SCOPE_AGENT);
            if (dupc) F.out[5] = __builtin_inff();
            if (miss > CHECK_IDX_MAXMISS) F.out[3] = __builtin_nanf("");
        }
#endif
    }
#ifdef PROBE_PHASE_T
    if (blockIdx.x == 0 && F.tid == 0) { if (PROBE_PHASE_T == 12) tp_dur = __builtin_amdgcn_s_memrealtime() - tp_prev; const unsigned long long t0 = __builtin_amdgcn_s_memrealtime(); while (__builtin_amdgcn_s_memrealtime() - t0 < tp_dur) __builtin_amdgcn_s_sleep(8); }
#endif
#ifdef PROBE_B1SEC
    if (blockIdx.x == 0 && F.tid == 0) { const unsigned long long t0 = __builtin_amdgcn_s_memrealtime(); const unsigned long long dt = (unsigned long long)F.MISC[20]; while (__builtin_amdgcn_s_memrealtime() - t0 < dt) __builtin_amdgcn_s_sleep(8); }
#endif
#undef IN
#undef SEAM
}

extern "C" void kernel_launch(void* const* d_in, const int* in_sizes, int n_in, void* d_out, int out_size, void* d_ws, size_t ws_size, hipStream_t stream) {
    static int grid = 0;
    if (grid == 0) {
        if (n_in != 32 || out_size != NREAL * D || ws_size < WS_END) { fprintf(stderr, "kernel_launch: unexpected shapes: n_in %d out %d ws %zu\n", n_in, out_size, ws_size); grid = -1; return; }
        int dev = 0, cus = 0, per_cu = 0;
        if (hipGetDevice(&dev) != hipSuccess || hipDeviceGetAttribute(&cus, hipDeviceAttributeMultiprocessorCount, dev) != hipSuccess) { grid = -1; return; }
        if (hipFuncSetAttribute((const void*)fwd, hipFuncAttributeMaxDynamicSharedMemorySize, LDS_BYTES) != hipSuccess) { fprintf(stderr, "kernel_launch: hipFuncSetAttribute failed\n"); grid = -1; return; }
        if (hipOccupancyMaxActiveBlocksPerMultiprocessor(&per_cu, (const void*)fwd, NTHR, LDS_BYTES) != hipSuccess || per_cu < 1) fprintf(stderr, "kernel_launch: occupancy query says %d\n", per_cu);
        (void)hipGetLastError();
        grid = cus;
    }
    if (grid < 0) return;
    (void)hipMemsetAsync((char*)d_ws + WS_CTL, 0, CTL_ZERO_BYTES, stream);
    Args a{};
    for (int i = 0; i < 32; ++i) a.in[i] = (const float*)d_in[i];
    a.out = (float*)d_out; a.ws = (unsigned char*)d_ws;
#if ONE_LAUNCH
    a.ph_lo = 0; a.ph_hi = NPHASES;
    hipLaunchKernelGGL(fwd, dim3(grid), dim3(NTHR), LDS_BYTES, stream, a);
#else
    for (int p = 0; p < NPHASES; ++p) { a.ph_lo = p; a.ph_hi = p + 1; hipLaunchKernelGGL(fwd, dim3(grid), dim3(NTHR), LDS_BYTES, stream, a); }
#endif
}
```

```cpp
#include <hip/hip_runtime.h>
#include <cstdio>
#include <cstdint>
#define ONE_LAUNCH 1
namespace pg8 {
#define PG8_LAS __attribute__((address_space(3)))
typedef unsigned short bf16_t;
typedef short bf16x8 __attribute__((ext_vector_type(8)));
typedef float f32x4 __attribute__((ext_vector_type(4)));
typedef unsigned u32x4 __attribute__((ext_vector_type(4)));
constexpr int BM = 256, BK = 64, HALF = 128, HTB = HALF * BK * 2  , STAGE_BYTES = 8 * HTB, NXCD = 8, WGM = 8;

__host__ __device__ __forceinline__ int lds_byte(int r, int c) { const int st = (r >> 4) * 2 + (c >> 5), rr = r & 15, cc = c & 31, ob = rr * 64 + cc * 2; return st * 1024 + (ob ^ (((ob >> 9) & 1) << 5)); }
__host__ __device__ __forceinline__ void stage_rc(int b, int& R, int& C) { const int st = b / 1024, sb = b % 1024, swz = sb ^ (((sb >> 9) & 1) << 5); R = (st >> 1) * 16 + swz / 64; C = (st & 1) * 32 + (swz % 64) / 2; }
__host__ __device__ __forceinline__ int perm32(int rho) { const int n = rho >> 4, i = rho & 15; return 8 * (i >> 2) + 4 * n + (i & 3); }

struct Unit { int pm, pn; };
struct Gemm { const bf16_t* A; const bf16_t* Bt; int M, N, K, lda; };

struct StaticOrder {
    int nM, nN, nwg, G, c;
    __host__ __device__ void init(int M, int N, int G_, int c_) { nM = M / BM; nN = N / BM; nwg = nM * nN; G = G_; c = c_; }
    __host__ __device__ bool next(int i, Unit& u) const {
        const long L = (long)i * G + c; if (L >= nwg) return false;
        int wgid = (int)L; { const int q = nwg / NXCD, r = nwg % NXCD, xcd = wgid % NXCD, off = wgid / NXCD; wgid = (xcd < r ? xcd * (q + 1) : r * (q + 1) + (xcd - r) * q) + off; }
        const int nig = WGM * nN, gid = wgid / nig, fm = gid * WGM, gsz = (nM - fm) < WGM ? (nM - fm) : WGM;
        u.pm = fm + ((wgid % nig) % gsz); u.pn = (wgid % nig) / gsz; return true;
    }
    __device__ __forceinline__ void a_ready(const Unit&) const {}
    __device__ __forceinline__ void done(const Unit&) const {}
};


template <class F> struct EpiFn {
    static constexpr bool PERM = false, AFTER_DRAIN = false;
    F f;
    __device__ __forceinline__ void operator()(const f32x4 (&acc)[2][2][4][2], const Unit& u, int wr, int wc, int fr, int fq) const {
        const int row0 = u.pm * BM + wr * 64 + fr, col0 = u.pn * BM + wc * 32 + 4 * fq;
#pragma unroll
        for (int ai = 0; ai < 2; ++ai)
#pragma unroll
            for (int m = 0; m < 4; ++m) {
                const int row = row0 + ai * HALF + m * 16;
#pragma unroll
                for (int bj = 0; bj < 2; ++bj)
#pragma unroll
                    for (int n = 0; n < 2; ++n) f(row, col0 + bj * HALF + n * 16, acc[ai][bj][m][n]);
            }
    }
};

template <class F> struct EpiFn8 {
    static constexpr bool PERM = true, AFTER_DRAIN = false;
    F f;
    __device__ __forceinline__ void operator()(const f32x4 (&acc)[2][2][4][2], const Unit& u, int wr, int wc, int fr, int fq) const {
        const int row0 = u.pm * BM + wr * 64 + fr, col0 = u.pn * BM + wc * 32 + 8 * fq;
#pragma unroll
        for (int ai = 0; ai < 2; ++ai)
#pragma unroll
            for (int m = 0; m < 4; ++m) {
                const int row = row0 + ai * HALF + m * 16;
#pragma unroll
                for (int bj = 0; bj < 2; ++bj) f.two(row, col0 + bj * HALF, acc[ai][bj][m][0], acc[ai][bj][m][1]);
            }
    }
};

struct EpiConvAct {
    static constexpr bool PERM = true, AFTER_DRAIN = false;
    unsigned short* ACT; int ldact;
    const float* cw; const float* cb; int dff;
    float* G01; float* V01; float* GHALO;
    PG8_LAS float* hal;
    __device__ __forceinline__ void operator()(const f32x4 (&acc)[2][2][4][2], const Unit& u, int wr, int wc, int fr, int fq) const {
        const int colg = 128 * u.pn + wc * 32 + 8 * fq;
        f32x4 w0[2], w1[2], w2[2], bb[2];
#pragma unroll
        for (int n = 0; n < 2; ++n) { w0[n] = *(const f32x4*)(cw + colg + 4 * n); w1[n] = *(const f32x4*)(cw + dff + colg + 4 * n); w2[n] = *(const f32x4*)(cw + 2 * dff + colg + 4 * n); bb[n] = *(const f32x4*)(cb + colg + 4 * n); }
        if (fr >= 14) {
#pragma unroll
            for (int ai = 0; ai < 2; ++ai)
#pragma unroll
                for (int n = 0; n < 2; ++n) *(PG8_LAS f32x4*)(hal + (((2 * ai + wr) * 4 + wc) * 2 + (fr - 14)) * 32 + 8 * fq + 4 * n) = acc[ai][0][3][n];
        }
        asm volatile("s_waitcnt lgkmcnt(0)" ::: "memory"); __builtin_amdgcn_s_barrier(); asm volatile("" ::: "memory");
#pragma unroll
        for (int ai = 0; ai < 2; ++ai) {
            const int blk = 2 * ai + wr;
            f32x4 prev[2];
#pragma unroll
            for (int n = 0; n < 2; ++n) {
                prev[n] = (f32x4){0.f, 0.f, 0.f, 0.f};
                if (blk > 0) prev[n] = *(const PG8_LAS f32x4*)(hal + ((((blk - 1) * 4 + wc) * 2 + (fr & 1)) * 32) + 8 * fq + 4 * n);
            }
#pragma unroll
            for (int m = 0; m < 4; ++m) {
                f32x4 o[2];
#pragma unroll
                for (int n = 0; n < 2; ++n) {
                    const f32x4 cur = acc[ai][0][m][n], val = acc[ai][1][m][n];
#pragma unroll
                    for (int e = 0; e < 4; ++e) {
                        float s1 = prev[n][e], s2 = prev[n][e];
                        asm volatile("s_nop 1\n\tv_mov_b32_dpp %0, %0 row_ror:1 row_mask:0xf bank_mask:0xf\n\tv_mov_b32_dpp %1, %1 row_ror:2 row_mask:0xf bank_mask:0xf\n\ts_nop 1\n\t"
                                     "v_mov_b32_dpp %0, %2 row_shr:1 row_mask:0xf bank_mask:0xf\n\tv_mov_b32_dpp %1, %2 row_shr:2 row_mask:0xf bank_mask:0xf\n\ts_nop 1" : "+v"(s1), "+v"(s2) : "v"(cur[e]));
                        const float x = w0[n][e] * s2 + w1[n][e] * s1 + w2[n][e] * cur[e] + bb[n][e];
                        const float u2 = x * (1.5957691216057308f + 0.07135481627260025f * x * x);
                        o[n][e] = x * __builtin_amdgcn_rcpf(1.0f + __builtin_amdgcn_exp2f(-1.4426950408889634f * u2)) * val[e];
                    }
                    prev[n] = cur;
                }
                const int rt = ai * HALF + wr * 64 + m * 16 + fr;
                const int row = u.pm * BM + rt;
                if (blk == 0 && m == 0 && fr < 2) {
#pragma unroll
                    for (int n = 0; n < 2; ++n) { *(f32x4*)(G01 + ((size_t)u.pm * 2 + fr) * dff + colg + 4 * n) = acc[ai][0][m][n]; *(f32x4*)(V01 + ((size_t)u.pm * 2 + fr) * dff + colg + 4 * n) = acc[ai][1][m][n]; }
                } else {
                    typedef __bf16 b2 __attribute__((ext_vector_type(2)));
                    const b2 p0 = {(__bf16)o[0][0], (__bf16)o[0][1]}, p1 = {(__bf16)o[0][2], (__bf16)o[0][3]}, p2 = {(__bf16)o[1][0], (__bf16)o[1][1]}, p3 = {(__bf16)o[1][2], (__bf16)o[1][3]};
                    *(u32x4*)(ACT + (size_t)row * ldact + colg) = (u32x4){__builtin_bit_cast(unsigned, p0), __builtin_bit_cast(unsigned, p1), __builtin_bit_cast(unsigned, p2), __builtin_bit_cast(unsigned, p3)};
                }
                if (blk == 3 && m == 3 && fr >= 14) {
#pragma unroll
                    for (int n = 0; n < 2; ++n) *(f32x4*)(GHALO + ((size_t)u.pm * 2 + (fr - 14)) * dff + colg + 4 * n) = acc[ai][0][m][n];
                }
            }
        }
        asm volatile("s_waitcnt lgkmcnt(0)" ::: "memory"); __builtin_amdgcn_s_barrier(); asm volatile("" ::: "memory");
    }
};
template <class Epi, class Sched, bool ALIGN_EPI = false, bool SP2 = false>
__device__ __forceinline__ void gemm_phase(PG8_LAS unsigned char* lds, const Gemm g, const Sched& S, const Epi& E) {
    const int tid = threadIdx.x, wid = __builtin_amdgcn_readfirstlane(tid >> 6), lane = tid & 63, wr = wid >> 2, wc = wid & 3, fr = lane & 15, fq = lane >> 4;
    const int K = g.K, nt = K / BK;
    unsigned voffA[2], voffB[2];
#pragma unroll
    for (int i = 0; i < 2; ++i) { int R, C; stage_rc(tid * 16 + i * 8192, R, C); const int Rb = Epi::PERM ? ((R & ~31) + perm32(R & 31)) : R;
        voffA[i] = (unsigned)(R * g.lda + C) * 2u; voffB[i] = (unsigned)(Rb * K + C) * 2u; }
    const size_t kstep = (size_t)(BK * 2);
    const size_t hA = (size_t)HALF * g.lda * 2, hB = (size_t)HALF * K * 2;
    const size_t tA = 2 * hA, tB = 2 * hB;
    const unsigned ldsw = (unsigned)wid * 1024u;
    const int aoff = lds_byte(wr * 64 + fr, fq * 8), boff = lds_byte(wc * 32 + fr, fq * 8);
#define PG8_SA(b, h) (((b) * 2 + (h)) * HTB)
#define PG8_SB(b, h) ((4 + (b) * 2 + (h)) * HTB)
#define PG8_STAGE(bufoff, gbase, voff) do { _Pragma("unroll") for (int _i = 0; _i < 2; ++_i) \
        __builtin_amdgcn_global_load_lds((const unsigned*)((const char*)(gbase) + (voff)[_i]), (PG8_LAS unsigned*)(lds + (bufoff) + ldsw + _i * 8192), 16, 0, 0); } while (0)
#define PG8_LDA(dst, b, h) do { _Pragma("unroll") for (int m = 0; m < 4; ++m) _Pragma("unroll") for (int k = 0; k < 2; ++k) dst[m][k] = *(const PG8_LAS bf16x8*)(lds + PG8_SA(b, h) + aoff + m * 2048 + k * 1024); } while (0)
#define PG8_LDB(dst, b, h) do { _Pragma("unroll") for (int n = 0; n < 2; ++n) _Pragma("unroll") for (int k = 0; k < 2; ++k) dst[n][k] = *(const PG8_LAS bf16x8*)(lds + PG8_SB(b, h) + boff + n * 2048 + k * 1024); } while (0)
#define PG8_MMA(ai, bj, At, Bt) do { __builtin_amdgcn_s_setprio(1); _Pragma("unroll") for (int m = 0; m < 4; ++m) _Pragma("unroll") for (int n = 0; n < 2; ++n) _Pragma("unroll") for (int k = 0; k < 2; ++k) \
        acc[ai][bj][m][n] = __builtin_amdgcn_mfma_f32_16x16x32_bf16(Bt[n][k], At[m][k], acc[ai][bj][m][n], 0, 0, 0); __builtin_amdgcn_s_setprio(0); } while (0)
#define PG8_WAIT_V(n) asm volatile("s_waitcnt vmcnt(" #n ")" ::: "memory")
#define PG8_WAIT_L(n) asm volatile("s_waitcnt lgkmcnt(" #n ")" ::: "memory")
#define PG8_BAR __builtin_amdgcn_s_barrier()
#define PG8_SCHED __builtin_amdgcn_sched_barrier(0)
    Unit cur, nxt; int ui = 0;
    if (!S.next(0, cur)) return;
    f32x4 acc[2][2][4][2];
#pragma unroll
    for (int a = 0; a < 2; ++a)
#pragma unroll
        for (int b = 0; b < 2; ++b)
#pragma unroll
            for (int m = 0; m < 4; ++m)
#pragma unroll
                for (int n = 0; n < 2; ++n) acc[a][b][m][n] = (f32x4){0.f, 0.f, 0.f, 0.f};
    bf16x8 At[4][2], B0[2][2], B1[2][2];
    const char* cA = (const char*)g.A + (size_t)cur.pm * tA; const char* cB = (const char*)g.Bt + (size_t)cur.pn * tB;
    S.a_ready(cur);
    if constexpr (SP2) {
        PG8_STAGE(PG8_SB(0, 0), cB, voffB); PG8_STAGE(PG8_SB(0, 1), cB + hB, voffB); PG8_STAGE(PG8_SA(0, 0), cA, voffA); PG8_STAGE(PG8_SA(0, 1), cA + hA, voffA);
        if (wr == 1) PG8_BAR;
        PG8_WAIT_V(2); PG8_BAR;
        PG8_STAGE(PG8_SB(1, 0), cB + kstep, voffB); PG8_STAGE(PG8_SA(1, 0), cA + kstep, voffA); PG8_STAGE(PG8_SB(1, 1), cB + hB + kstep, voffB);
        PG8_WAIT_V(6); PG8_BAR;
    } else {
        PG8_STAGE(PG8_SB(0, 0), cB, voffB); PG8_STAGE(PG8_SA(0, 0), cA, voffA); PG8_STAGE(PG8_SB(0, 1), cB + hB, voffB); PG8_STAGE(PG8_SA(0, 1), cA + hA, voffA);
        if (wr == 1) PG8_BAR;
        PG8_WAIT_V(4); PG8_BAR;
        PG8_STAGE(PG8_SB(1, 0), cB + kstep, voffB); PG8_STAGE(PG8_SA(1, 0), cA + kstep, voffA); PG8_STAGE(PG8_SB(1, 1), cB + hB + kstep, voffB);
        PG8_WAIT_V(6); PG8_BAR;
    }
    for (;;) {
        const bool has_next = S.next(ui + 1, nxt);
        const char* nA = has_next ? (const char*)g.A + (size_t)nxt.pm * tA : cA; const char* nB = has_next ? (const char*)g.Bt + (size_t)nxt.pn * tB : cB;
        for (int t = 0; t < nt; t += 2) {
            const bool last = (t == nt - 2);
            const char* a1 = cA + (size_t)(t + 1) * kstep;
            const char* a2 = last ? nA : cA + (size_t)(t + 2) * kstep; const char* b2 = last ? nB : cB + (size_t)(t + 2) * kstep;
            const char* a3 = a2 + kstep; const char* b3 = b2 + kstep;
            if (last && has_next) S.a_ready(nxt);
            if constexpr (SP2) {
            PG8_LDB(B0, 0, 0); PG8_LDB(B1, 0, 1); PG8_SCHED; PG8_LDA(At, 0, 0); PG8_STAGE(PG8_SA(1, 1), a1 + hA, voffA);
            PG8_WAIT_V(8); PG8_WAIT_L(0); PG8_BAR; PG8_MMA(0, 0, At, B0); PG8_MMA(0, 1, At, B1); PG8_BAR; PG8_SCHED;
            PG8_LDA(At, 0, 1); PG8_STAGE(PG8_SB(0, 0), b2, voffB); PG8_STAGE(PG8_SB(0, 1), b2 + hB, voffB); PG8_STAGE(PG8_SA(0, 0), a2, voffA);
            PG8_WAIT_V(8); PG8_WAIT_L(0); PG8_BAR; PG8_MMA(1, 0, At, B0); PG8_MMA(1, 1, At, B1); PG8_BAR; PG8_SCHED;
            PG8_LDB(B0, 1, 0); PG8_LDB(B1, 1, 1); PG8_SCHED; PG8_LDA(At, 1, 0); PG8_STAGE(PG8_SA(0, 1), a2 + hA, voffA);
            PG8_WAIT_V(8); PG8_WAIT_L(0); PG8_BAR; PG8_MMA(0, 0, At, B0); PG8_MMA(0, 1, At, B1); PG8_BAR; PG8_SCHED;
            PG8_LDA(At, 1, 1); PG8_STAGE(PG8_SB(1, 0), b3, voffB); PG8_STAGE(PG8_SB(1, 1), b3 + hB, voffB); PG8_STAGE(PG8_SA(1, 0), a3, voffA);
            PG8_WAIT_V(8); PG8_WAIT_L(0); PG8_BAR; PG8_MMA(1, 0, At, B0); PG8_MMA(1, 1, At, B1); PG8_BAR; PG8_SCHED;
            } else {
            PG8_LDB(B0, 0, 0); PG8_SCHED; PG8_LDA(At, 0, 0); PG8_STAGE(PG8_SA(1, 1), a1 + hA, voffA);
            PG8_WAIT_L(8); PG8_BAR; PG8_WAIT_L(0); PG8_MMA(0, 0, At, B0); PG8_BAR; PG8_SCHED;
            PG8_LDB(B1, 0, 1); PG8_STAGE(PG8_SB(0, 0), b2, voffB);
            PG8_BAR; PG8_WAIT_L(0); PG8_MMA(0, 1, At, B1); PG8_BAR;
            PG8_LDA(At, 0, 1); PG8_STAGE(PG8_SA(0, 0), a2, voffA);
            PG8_BAR; PG8_WAIT_L(0); PG8_MMA(1, 0, At, B0); PG8_BAR; PG8_SCHED;
            PG8_STAGE(PG8_SB(0, 1), b2 + hB, voffB);
            PG8_WAIT_V(6); PG8_BAR; PG8_MMA(1, 1, At, B1); PG8_BAR;
            PG8_LDB(B0, 1, 0); PG8_SCHED; PG8_LDA(At, 1, 0); PG8_STAGE(PG8_SA(0, 1), a2 + hA, voffA);
            PG8_WAIT_L(8); PG8_BAR; PG8_WAIT_L(0); PG8_MMA(0, 0, At, B0); PG8_BAR; PG8_SCHED;
            PG8_LDB(B1, 1, 1); PG8_STAGE(PG8_SB(1, 0), b3, voffB);
            PG8_BAR; PG8_WAIT_L(0); PG8_MMA(0, 1, At, B1); PG8_BAR;
            PG8_LDA(At, 1, 1); PG8_STAGE(PG8_SA(1, 0), a3, voffA);
            PG8_BAR; PG8_WAIT_L(0); PG8_MMA(1, 0, At, B0); PG8_BAR; PG8_SCHED;
            PG8_STAGE(PG8_SB(1, 1), b3 + hB, voffB);
            PG8_WAIT_V(6); PG8_BAR; PG8_MMA(1, 1, At, B1); PG8_BAR;
            }
        }
        if constexpr (ALIGN_EPI) { if (wr == 0) PG8_BAR; }
        if constexpr (!Epi::AFTER_DRAIN) { E(acc, cur, wr, wc, fr, fq); S.done(cur); }
        if (!has_next) break;
#pragma unroll
        for (int a = 0; a < 2; ++a)
#pragma unroll
            for (int b = 0; b < 2; ++b)
#pragma unroll
                for (int m = 0; m < 4; ++m)
#pragma unroll
                    for (int n = 0; n < 2; ++n) acc[a][b][m][n] = (f32x4){0.f, 0.f, 0.f, 0.f};
        cur = nxt; cA = nA; cB = nB; ++ui;
        if constexpr (ALIGN_EPI) { if (wr == 1) PG8_BAR; }
    }
    PG8_WAIT_V(0);
    if constexpr (!ALIGN_EPI) { if (wr == 0) PG8_BAR; }
    PG8_BAR;
    if constexpr (Epi::AFTER_DRAIN) { E.fused(acc, cur, wr, wc, fr, fq, lds, wid, lane); S.done(cur); }
#undef PG8_SA
#undef PG8_SB
#undef PG8_STAGE
#undef PG8_LDA
#undef PG8_LDB
#undef PG8_MMA
#undef PG8_WAIT_V
#undef PG8_WAIT_L
#undef PG8_BAR
#undef PG8_SCHED
}
}

#ifndef ONE_LAUNCH
#define ONE_LAUNCH 0
#endif
constexpr int NWAVES = 8, NTHR = 512;
constexpr int D = 1024, BATCH = 4, SEQ = 8192, NMETA = 16, TT = SEQ + NMETA;
constexpr int NREAL = BATCH * SEQ;
constexpr int NROWS = NREAL + NMETA;
constexpr int R = 33024;
constexpr int PW = 2304;
constexpr int PC_CQ = 0, PC_CKV = 256, PC_KIDX = 384, PC_WIDX = 448, PC_R = 512, PC_K = 1024, PC_V = 1536, PC_WD = 2048, PC_AD = 2112, PC_GD = 2176;
constexpr int QAW = 1536;
constexpr int DFF = 2816, UPW = 5632;
constexpr int TOPK = 256;
constexpr float LN_EPS = 1e-5f, GN_EPS = 64e-5f, ALPHA = 1.18920711500272f;

constexpr size_t MiB = 1u << 20;
constexpr size_t WS_CTL = 0, CTL_ZERO_BYTES = 32768;
constexpr size_t WS_WT_IN = 1 * MiB, WS_WT_QA = 6 * MiB, WS_WT_MIX = 7 * MiB, WS_WT_UP = 10 * MiB, WS_WT_DN = 21 * MiB;
constexpr size_t WS_META1 = 27 * MiB, WS_NSEL = 28 * MiB, WS_WIDX = 29 * MiB;
constexpr size_t WS_H = 33 * MiB;
constexpr size_t WS_P = 98 * MiB, WS_QA = 244 * MiB, WS_CQN = 341 * MiB, WS_SEL = 341 * MiB, WS_CKV = 358 * MiB, WS_KIDX = 367 * MiB;
constexpr size_t WS_DEC = 372 * MiB, WS_AB = 437 * MiB, WS_GB = 470 * MiB;
constexpr size_t WS_WT_LORA = 26 * MiB + 512 * 1024;
constexpr size_t WS_RWM = 372 * MiB, WS_RWN = 405 * MiB, WS_RWQ = 438 * MiB, WS_RWY = 471 * MiB;
constexpr size_t OUT_RWS = 80 * MiB, OUT_BONUS = 116 * MiB;
constexpr size_t WS_G01 = 480 * MiB, WS_V01 = 484 * MiB, WS_GHALO = 488 * MiB, WS_GMETA = 492 * MiB;
constexpr size_t WS_UP = 98 * MiB;
constexpr size_t WS_END = 512 * MiB;
static_assert(WS_P + (size_t)R * PW * 2 <= WS_QA && WS_QA + (size_t)R * QAW * 2 <= WS_CQN && WS_CQN + (size_t)R * 256 * 2 <= WS_CKV && WS_CKV + (size_t)R * 128 * 2 <= WS_KIDX
              && WS_KIDX + (size_t)R * 64 * 2 <= WS_DEC && WS_DEC + (size_t)R * 512 * 4 <= WS_AB && WS_AB + (size_t)R * 512 * 2 <= WS_GB && WS_GB + (size_t)R * 512 * 2 <= WS_END
              && WS_UP + (size_t)R * UPW * 2 <= WS_END && WS_H + (size_t)R * D * 2 <= WS_P && WS_WIDX + (size_t)R * 8 * 4 <= WS_H && WS_NSEL + (size_t)R * 4 <= WS_WIDX, "ws map");
constexpr int CW_BAR = 4096;

constexpr int RING_OFF = 0, RING_BYTES = 131072;
constexpr int LDSCTL_OFF = RING_BYTES, MISC_OFF = LDSCTL_OFF + 320;
constexpr int LDS_BYTES = 147456;

#define GAS __attribute__((address_space(1)))
#define LAS __attribute__((address_space(3)))
typedef unsigned short bf16;
typedef unsigned v4u __attribute__((ext_vector_type(4)));
typedef unsigned v2u __attribute__((ext_vector_type(2)));
typedef float f32x4 __attribute__((ext_vector_type(4)));
typedef GAS unsigned gu32;
typedef __bf16 bf16x2_t __attribute__((ext_vector_type(2)));
__device__ __forceinline__ unsigned f2bf(float f) { return (unsigned)__builtin_bit_cast(unsigned short, (__bf16)f); }
__device__ __forceinline__ unsigned pk2(float lo, float hi) { const bf16x2_t v = {(__bf16)lo, (__bf16)hi}; return __builtin_bit_cast(unsigned, v); }
__device__ __forceinline__ float fast_rcp(float x) { return __builtin_amdgcn_rcpf(x); }
__device__ __forceinline__ float fast_tanh(float x) { return 1.0f - 2.0f * __builtin_amdgcn_rcpf(1.0f + __expf(2.0f * x)); }
__device__ __forceinline__ float bf2f(unsigned short b) { return __uint_as_float(((unsigned)b) << 16); }
__device__ __forceinline__ float bflo(unsigned w) { return __uint_as_float(w << 16); }
__device__ __forceinline__ float bfhi(unsigned w) { return __uint_as_float(w & 0xffff0000u); }
#define DPP_F(v, ctrl) __builtin_bit_cast(float, __builtin_amdgcn_update_dpp(0, __builtin_bit_cast(int, (v)), (ctrl), 0xf, 0xf, false))
__device__ __forceinline__ float rdlane_f(float v, int lane) { return __builtin_bit_cast(float, __builtin_amdgcn_readlane(__builtin_bit_cast(int, v), lane)); }
__device__ __forceinline__ float wave_sum(float v) {
    v += DPP_F(v, 0xB1); v += DPP_F(v, 0x4E); v += DPP_F(v, 0x141); v += DPP_F(v, 0x140);
    return (rdlane_f(v, 0) + rdlane_f(v, 16)) + (rdlane_f(v, 32) + rdlane_f(v, 48));
}
__device__ __forceinline__ float wave_max(float v) {
    v = fmaxf(v, DPP_F(v, 0xB1)); v = fmaxf(v, DPP_F(v, 0x4E)); v = fmaxf(v, DPP_F(v, 0x141)); v = fmaxf(v, DPP_F(v, 0x140));
    return fmaxf(fmaxf(rdlane_f(v, 0), rdlane_f(v, 16)), fmaxf(rdlane_f(v, 32), rdlane_f(v, 48)));
}
#define DPP_U0(v, ctrl) ((unsigned)__builtin_amdgcn_update_dpp(0, (int)(v), (ctrl), 0xf, 0xf, true))
__device__ __forceinline__ unsigned wave_scan_incl(unsigned v, int lane) {
    v += DPP_U0(v, 0x111); v += DPP_U0(v, 0x112); v += DPP_U0(v, 0x114); v += DPP_U0(v, 0x118);
    const unsigned r0 = (unsigned)__builtin_amdgcn_readlane((int)v, 15), r1 = (unsigned)__builtin_amdgcn_readlane((int)v, 31), r2 = (unsigned)__builtin_amdgcn_readlane((int)v, 47);
    const int row = lane >> 4;
    return v + (row >= 1 ? r0 : 0u) + (row >= 2 ? r1 : 0u) + (row >= 3 ? r2 : 0u);
}
__device__ __forceinline__ float sigmoidf_(float x) { return __builtin_amdgcn_rcpf(1.0f + __expf(-x)); }
#define XB_TMO      128
#define XB_XCNT(j)  (256  + 64 * (j))
#define XB_XSUB(j)  (1280 + 64 * (j))
#define XB_XGEN(j)  (2304 + 64 * (j))
#define XB_TOP      3328
#define XB_TOPGEN   3392
#define XCD_BAR_WORDS 3456
#define XB_SPIN_CAP (1u << 18)

__device__ __forceinline__ unsigned xb_ld(unsigned* p)              { return __hip_atomic_load(p, __ATOMIC_RELAXED, __HIP_MEMORY_SCOPE_AGENT); }
__device__ __forceinline__ unsigned xb_add(unsigned* p, unsigned v) { return __hip_atomic_fetch_add(p, v, __ATOMIC_RELAXED, __HIP_MEMORY_SCOPE_AGENT); }
__device__ __forceinline__ unsigned xb_xcc_id() { return (unsigned)__builtin_amdgcn_s_getreg((3 << 11) | 20) & 0xFu; }
#define XB_SPIN(cond, bar) do { unsigned _sp = 0; while (cond) { __builtin_amdgcn_s_sleep(1); \
    if ((++_sp & 255u) == 0u) { if (xb_ld(&(bar)[XB_TMO])) break; if (_sp > XB_SPIN_CAP) { atomicAdd(&(bar)[XB_TMO], 1u); break; } } } } while (0)

struct XcdBarrier {
    unsigned* bar; unsigned x;
    volatile LAS unsigned* st;
};

__device__ __forceinline__ XcdBarrier xcd_barrier_post(unsigned* bar, volatile LAS unsigned* st) {
    XcdBarrier b; b.bar = bar; b.x = xb_xcc_id(); b.st = st;
    if (threadIdx.x == 0) (void)xb_add(&bar[XB_XCNT(b.x)], 1u);
    return b;
}
__device__ __forceinline__ void xcd_barrier_complete(unsigned* bar, unsigned x, unsigned& nloc, unsigned& nx) {
    const unsigned G = gridDim.x * gridDim.y * gridDim.z;
    unsigned sum, cnt, mine, sp = 0u;
    for (;;) {
        sum = 0u; cnt = 0u; mine = 0u;
#pragma unroll
        for (unsigned j = 0; j < 16; ++j) { const unsigned c = xb_ld(&bar[XB_XCNT(j)]); sum += c; cnt += (c > 0u) ? 1u : 0u; mine = (j == x) ? c : mine; }
        if (sum == G) break;
        __builtin_amdgcn_s_sleep(1);
        if ((++sp & 255u) == 0u) { if (xb_ld(&bar[XB_TMO])) break; if (sp > XB_SPIN_CAP) { atomicAdd(&bar[XB_TMO], 1u); break; } }
    }
    nloc = mine > 0u ? mine : 1u; nx = cnt > 0u ? cnt : 1u;
}

__device__ __forceinline__ void xcd_barrier(const XcdBarrier& b) {
    asm volatile("s_waitcnt vmcnt(0)" ::: "memory");
    __syncthreads();
    if (threadIdx.x == 0) {
        unsigned* bar = b.bar;
        __builtin_amdgcn_s_waitcnt(0);
        unsigned nloc = b.st[0], nx = b.st[1];
        if (nloc == 0u) { xcd_barrier_complete(bar, b.x, nloc, nx); b.st[0] = nloc; b.st[1] = nx; }
        const unsigned old = xb_add(&bar[XB_XSUB(b.x)], 1u);
        const unsigned gen = old / nloc;
        if (old + 1u == (gen + 1u) * nloc) {
            __builtin_amdgcn_fence(__ATOMIC_RELEASE, "agent");
            asm volatile("s_waitcnt vmcnt(0)" ::: "memory");
            const unsigned og = xb_add(&bar[XB_TOP], 1u);
            const unsigned tg = og / nx;
            if (og + 1u == (tg + 1u) * nx) xb_add(&bar[XB_TOPGEN], 1u);
            else XB_SPIN(xb_ld(&bar[XB_TOPGEN]) == tg, bar);
            __builtin_amdgcn_fence(__ATOMIC_ACQUIRE, "agent");
            xb_add(&bar[XB_XGEN(b.x)], 1u);
            asm volatile("s_waitcnt vmcnt(0)" ::: "memory");
        } else {
            XB_SPIN(xb_ld(&bar[XB_XGEN(b.x)]) == gen, bar);
            __builtin_amdgcn_fence(__ATOMIC_ACQUIRE, "agent");
            asm volatile("s_waitcnt vmcnt(0)" ::: "memory");
        }
    }
    __syncthreads();
}

struct Frame {
    LAS unsigned char* lds;
    volatile LAS unsigned* MISC;
    gu32* ctl;
    int tid, lane, wave, G;
    const float* in[32];
    float* out;
    unsigned char* ws;
};
#define IN_X 0
#define IN_META 1
#define IN_LNIN_G 2
#define IN_LNIN_B 3
#define IN_W_IN 4
#define IN_QNORM_G 5
#define IN_W_UQ 6
#define IN_KVNORM_G 7
#define IN_W_UKV 8
#define IN_W_IQ 9
#define IN_IDXLN_G 10
#define IN_IDXLN_B 11
#define IN_MU 12
#define IN_W0 13
#define IN_W_DEC 14
#define IN_A0 15
#define IN_W_AAA 16
#define IN_W_GATE 17
#define IN_KK 18
#define IN_KA 19
#define IN_RK 20
#define IN_GN_G 21
#define IN_GN_B 22
#define IN_W_OUT 23
#define IN_LN1_G 24
#define IN_LN1_B 25
#define IN_W_UP 26
#define IN_CONV_W 27
#define IN_CONV_B 28
#define IN_W_DN 29
#define IN_LN2_G 30
#define IN_LN2_B 31

#define WSP(T, off) ((T*)(F.ws + (off)))

__device__ __forceinline__ int key_row(int b, int j) { return j < NMETA ? NREAL + j : b * SEQ + (j - NMETA); }

__device__ __forceinline__ int tr_col(int n, int mode, int cut0, int cut1, int shift) {
    if (mode == 1) { const int pn = n >> 8, x = n & 255; return x < 128 ? 128 * pn + x : DFF + 128 * pn + (x - 128); }
    return n < cut0 ? n : (n < cut1 ? -1 : n - shift);
}
struct TrJob { const float* src; int src_ld, src_r0; bf16* dst; int dst_ld, dst_c0, Nn, K, mode, cut0, cut1, shift; };
__device__ __forceinline__ void tr_item(const TrJob& j, int item, LAS float* scr, int lane) {
    const int nblk = j.Nn / 32, kb = item / nblk, nb = item % nblk, k0 = 64 * kb, n0 = 32 * nb;
    const int col = tr_col(n0 + (lane & 31), j.mode, j.cut0, j.cut1, j.shift);
    const float* sp = j.src + (size_t)(j.src_r0 + k0 + (lane >> 5)) * j.src_ld + (col >= 0 ? col : 0);
    float v[32];
#pragma unroll
    for (int i = 0; i < 32; ++i) v[i] = sp[(size_t)(2 * i) * j.src_ld];
#pragma unroll
    for (int i = 0; i < 32; ++i) scr[(2 * i + (lane >> 5)) * 33 + (lane & 31)] = col >= 0 ? v[i] : 0.f;
    asm volatile("s_waitcnt lgkmcnt(0)" ::: "memory");
    const int c = lane & 7;
#pragma unroll
    for (int q = 0; q < 4; ++q) { const int n = (lane >> 3) + 8 * q; const LAS float* t = scr + (8 * c) * 33 + n;
        *(v4u*)(j.dst + (size_t)(n0 + n) * j.dst_ld + j.dst_c0 + k0 + 8 * c) = (v4u){pk2(t[0], t[33]), pk2(t[66], t[99]), pk2(t[132], t[165]), pk2(t[198], t[231])}; }
    asm volatile("s_waitcnt lgkmcnt(0)" ::: "memory");
}
__device__ __forceinline__ void tr_job(Frame& F, const TrJob& j, int& base) {
    LAS float* scr = (LAS float*)(F.lds + F.wave * 8704);
    const int gw = blockIdx.x * NWAVES + F.wave, NGW = F.G * NWAVES, ni = (j.K / 64) * (j.Nn / 32);
    for (int it = ((gw - base) % NGW + NGW) % NGW; it < ni; it += NGW) tr_item(j, it, scr, F.lane);
    base = (base + ni) % NGW;
}
__device__ __forceinline__ void p0_weights(Frame& F) {
    bf16* WT_IN = WSP(bf16, WS_WT_IN); bf16* WT_QA = WSP(bf16, WS_WT_QA); bf16* WT_MIX = WSP(bf16, WS_WT_MIX); bf16* WT_UP = WSP(bf16, WS_WT_UP); bf16* WT_DN = WSP(bf16, WS_WT_DN);
    bf16* WdT = WSP(bf16, WS_WT_LORA);
    int base = 0;
    tr_job(F, TrJob{F.in[IN_W_UP], UPW, 0, WT_UP, D, 0, UPW, D, 1, 0, 0, 0}, base);
    tr_job(F, TrJob{F.in[IN_W_DN], D, 0, WT_DN, DFF, 0, D, DFF, 0, D, D, 0}, base);
    tr_job(F, TrJob{F.in[IN_W_IN], 2248, 0, WT_IN, D, 0, PW, D, 0, 456, 512, 56}, base);
    tr_job(F, TrJob{F.in[IN_W_OUT], D, 512, WT_MIX, 1536, 1024, D, 512, 0, D, D, 0}, base);
    tr_job(F, TrJob{F.in[IN_W_IQ], 512, 0, WT_QA + (size_t)1024 * 256, 256, 0, 512, 256, 0, 512, 512, 0}, base);
    tr_job(F, TrJob{F.in[IN_W_GATE], 512, 0, WdT + 2 * 512 * 64, 128, 0, 512, 128, 0, 512, 512, 0}, base);
    tr_job(F, TrJob{F.in[IN_W_DEC], 512, 0, WdT, 64, 0, 512, 64, 0, 512, 512, 0}, base);
    tr_job(F, TrJob{F.in[IN_W_AAA], 512, 0, WdT + 512 * 64, 64, 0, 512, 64, 0, 512, 512, 0}, base);
    const float* w_uq = F.in[IN_W_UQ]; const float* w_ukv = F.in[IN_W_UKV]; const float* w_out = F.in[IN_W_OUT];
    for (int it = blockIdx.x * NTHR + F.tid; it < 256 * 8 * 8; it += F.G * NTHR) {
        const int c = it & 255, hb = __builtin_amdgcn_readfirstlane(it >> 8), h = hb >> 3, j0 = (hb & 7) * 16;
        float acc[16];
#pragma unroll
        for (int jj = 0; jj < 16; ++jj) acc[jj] = 0.f;
        for (int d = 0; d < 64; ++d) {
            const float a = w_uq[(size_t)c * 512 + h * 64 + d];
#pragma unroll
            for (int jj = 0; jj < 16; ++jj) acc[jj] += a * w_ukv[(size_t)(j0 + jj) * 1024 + h * 128 + d];
        }
#pragma unroll
        for (int jj = 0; jj < 16; ++jj) WT_QA[(size_t)(h * 128 + j0 + jj) * 256 + c] = (bf16)f2bf(0.125f * acc[jj]);
    }
    for (int it = blockIdx.x * NTHR + F.tid; it < 1024 * 8 * 8; it += F.G * NTHR) {
        const int n = it & 1023, hb = __builtin_amdgcn_readfirstlane(it >> 10), h = hb >> 3, j0 = (hb & 7) * 16;
        float acc[16];
#pragma unroll
        for (int jj = 0; jj < 16; ++jj) acc[jj] = 0.f;
        for (int d = 0; d < 64; ++d) {
            const float a = w_out[(size_t)(h * 64 + d) * D + n];
#pragma unroll
            for (int jj = 0; jj < 16; ++jj) acc[jj] += a * w_ukv[(size_t)(j0 + jj) * 1024 + h * 128 + 64 + d];
        }
        v4u o0, o1;
        o0.x = pk2(acc[0], acc[1]); o0.y = pk2(acc[2], acc[3]); o0.z = pk2(acc[4], acc[5]); o0.w = pk2(acc[6], acc[7]);
        o1.x = pk2(acc[8], acc[9]); o1.y = pk2(acc[10], acc[11]); o1.z = pk2(acc[12], acc[13]); o1.w = pk2(acc[14], acc[15]);
        *(v4u*)(WT_MIX + (size_t)n * 1536 + h * 128 + j0) = o0; *(v4u*)(WT_MIX + (size_t)n * 1536 + h * 128 + j0 + 8) = o1;
    }
}

__device__ __forceinline__ void ln_row_bf16(Frame& F, const float* src, const float* g, const float* b, bf16* dst) {
    v2u* o8 = (v2u*)dst + F.lane;
    if (!src) {
#pragma unroll
        for (int j = 0; j < 4; ++j) o8[64 * j] = (v2u){0u, 0u};
        return;
    }
    const f32x4* xr = (const f32x4*)src + F.lane;
    f32x4 v[4]; float s = 0.f;
#pragma unroll
    for (int j = 0; j < 4; ++j) { v[j] = xr[64 * j]; s += (v[j].x + v[j].y) + (v[j].z + v[j].w); }
    const float mean = wave_sum(s) * (1.f / D); float s2 = 0.f;
#pragma unroll
    for (int j = 0; j < 4; ++j) { v[j] = v[j] - mean; s2 += (v[j].x * v[j].x + v[j].y * v[j].y) + (v[j].z * v[j].z + v[j].w * v[j].w); }
    const float rstd = 1.f / sqrtf(wave_sum(s2) * (1.f / D) + LN_EPS);
#pragma unroll
    for (int j = 0; j < 4; ++j) {
        const f32x4 gg = ((const f32x4*)g)[F.lane + 64 * j], bb = ((const f32x4*)b)[F.lane + 64 * j];
        const f32x4 y = v[j] * rstd * gg + bb;
        o8[64 * j] = (v2u){pk2(y.x, y.y), pk2(y.z, y.w)};
    }
}
__device__ __forceinline__ void p1_ln_in(Frame& F) {
    bf16* H0 = WSP(bf16, WS_H);
    const int gw = blockIdx.x * NWAVES + F.wave, NGW = F.G * NWAVES;
    const f32x4* gp = (const f32x4*)F.in[IN_LNIN_G] + F.lane; const f32x4* bp = (const f32x4*)F.in[IN_LNIN_B] + F.lane;
    f32x4 gg[4], bb[4];
#pragma unroll
    for (int j = 0; j < 4; ++j) { gg[j] = gp[64 * j]; bb[j] = bp[64 * j]; }
    for (int r0 = gw * 4; r0 < NROWS; r0 += NGW * 4) {
        f32x4 v[4][4];
#pragma unroll
        for (int q = 0; q < 4; ++q) {
            const int r = r0 + q < NROWS ? r0 + q : NROWS - 1;
            const f32x4* xr = (const f32x4*)(r < NREAL ? F.in[IN_X] + (size_t)r * D : F.in[IN_META] + (size_t)(r - NREAL) * D) + F.lane;
#pragma unroll
            for (int j = 0; j < 4; ++j) v[q][j] = xr[64 * j];
        }
#pragma unroll
        for (int q = 0; q < 4; ++q) {
            float s = 0.f;
#pragma unroll
            for (int j = 0; j < 4; ++j) s += (v[q][j].x + v[q][j].y) + (v[q][j].z + v[q][j].w);
            const float mean = wave_sum(s) * (1.f / D); float s2 = 0.f;
#pragma unroll
            for (int j = 0; j < 4; ++j) { v[q][j] = v[q][j] - mean; s2 += (v[q][j].x * v[q][j].x + v[q][j].y * v[q][j].y) + (v[q][j].z * v[q][j].z + v[q][j].w * v[q][j].w); }
            const float rstd = 1.f / sqrtf(wave_sum(s2) * (1.f / D) + LN_EPS);
            if (r0 + q < NROWS) {
                v2u* o8 = (v2u*)(H0 + (size_t)(r0 + q) * D) + F.lane;
#pragma unroll
                for (int j = 0; j < 4; ++j) { const f32x4 y = v[q][j] * rstd * gg[j] + bb[j]; o8[64 * j] = (v2u){pk2(y.x, y.y), pk2(y.z, y.w)}; }
            }
        }
    }
}

__device__ __forceinline__ void p3_prep(Frame& F) {
    const bf16* P = WSP(bf16, WS_P); bf16* CQN = WSP(bf16, WS_CQN); bf16* CKV = WSP(bf16, WS_CKV); bf16* KIDX = WSP(bf16, WS_KIDX); float* WIDX = WSP(float, WS_WIDX);
    const int gw = blockIdx.x * NWAVES + F.wave, NGW = F.G * NWAVES, l = F.lane;
    for (int r = gw; r < R; r += NGW) {
        const bf16* pr = P + (size_t)r * PW;
        if (r >= NROWS) {
            *(v2u*)(CQN + (size_t)r * 256 + 4 * l) = (v2u){0u, 0u};
            continue;
        }
        {
            const v2u w = *(const v2u*)(pr + PC_CQ + 4 * l);
            const float a0 = bflo(w.x), a1 = bfhi(w.x), a2 = bflo(w.y), a3 = bfhi(w.y);
            const float ss = wave_sum(a0 * a0 + a1 * a1 + a2 * a2 + a3 * a3);
            const float rs = 1.0f / sqrtf(ss * (1.f / 256.f) + 1e-6f);
            const f32x4 g = ((const f32x4*)F.in[IN_QNORM_G])[l];
            *(v2u*)(CQN + (size_t)r * 256 + 4 * l) = (v2u){pk2(a0 * rs * g.x, a1 * rs * g.y), pk2(a2 * rs * g.z, a3 * rs * g.w)};
        }
        {
            const unsigned w = *(const unsigned*)(pr + PC_CKV + 2 * l);
            const float a0 = bflo(w), a1 = bfhi(w);
            const float ss = wave_sum(a0 * a0 + a1 * a1);
            const float rs = 1.0f / sqrtf(ss * (1.f / 128.f) + 1e-6f);
            const float g0 = F.in[IN_KVNORM_G][2 * l], g1 = F.in[IN_KVNORM_G][2 * l + 1];
            *(unsigned*)(CKV + (size_t)r * 128 + 2 * l) = pk2(a0 * rs * g0, a1 * rs * g1);
        }
        {
            const float a = bf2f(pr[PC_KIDX + l]);
            const float mean = wave_sum(a) * (1.f / 64.f);
            const float dlt = a - mean;
            const float var = wave_sum(dlt * dlt) * (1.f / 64.f);
            const float y = dlt * (1.0f / sqrtf(var + LN_EPS)) * F.in[IN_IDXLN_G][l] + F.in[IN_IDXLN_B][l];
            KIDX[(size_t)r * 64 + l] = (bf16)f2bf(y);
        }
        if (l < 8) WIDX[(size_t)r * 8 + l] = bf2f(pr[PC_WIDX + l]) * 0.04419417382415922f;
    }
}

#ifndef REFSEL
#define REFSEL 0
#endif
__device__ __forceinline__ void refsel_rows(Frame& F) {
    float* QIDX32 = F.out; float* KIDX32 = F.out + (size_t)R * 512; float* WIDX = WSP(float, WS_WIDX);
    const float* w_in = F.in[IN_W_IN]; const float* w_iq = F.in[IN_W_IQ];
    LAS float* hrow = (LAS float*)(F.lds + F.wave * 8192);
    LAS float* cqn = hrow + 1024;
    const int l = F.lane;
    const int gw = blockIdx.x * NWAVES + F.wave, NGW = F.G * NWAVES;
    for (int r = gw; r < NROWS; r += NGW) {
        const float* src = r < NREAL ? F.in[IN_X] + (size_t)r * D : F.in[IN_META] + (size_t)(r - NREAL) * D;
        {
            const f32x4* xr = (const f32x4*)src + l;
            f32x4 v[4]; float s = 0.f;
#pragma unroll
            for (int j = 0; j < 4; ++j) { v[j] = xr[64 * j]; s += (v[j].x + v[j].y) + (v[j].z + v[j].w); }
            const float mean = wave_sum(s) * (1.f / D); float s2 = 0.f;
#pragma unroll
            for (int j = 0; j < 4; ++j) { v[j] = v[j] - mean; s2 += (v[j].x * v[j].x + v[j].y * v[j].y) + (v[j].z * v[j].z + v[j].w * v[j].w); }
            const float rstd = 1.f / sqrtf(wave_sum(s2) * (1.f / D) + LN_EPS);
#pragma unroll
            for (int j = 0; j < 4; ++j) {
                const f32x4 gg = ((const f32x4*)F.in[IN_LNIN_G])[l + 64 * j], bb = ((const f32x4*)F.in[IN_LNIN_B])[l + 64 * j];
                *(LAS f32x4*)(hrow + 4 * (l + 64 * j)) = v[j] * rstd * gg + bb;
            }
        }
        __builtin_amdgcn_wave_barrier();
        float a[6];
#pragma unroll
        for (int i = 0; i < 6; ++i) a[i] = 0.f;
        for (int k = 0; k < D; ++k) {
            const float hk = hrow[k]; const float* wr = w_in + (size_t)k * 2248;
#pragma unroll
            for (int i = 0; i < 4; ++i) a[i] += hk * wr[l + 64 * i];
            a[4] += hk * wr[384 + l];
            a[5] += hk * wr[448 + (l & 7)];
        }
        const float ss = wave_sum(a[0] * a[0] + a[1] * a[1] + a[2] * a[2] + a[3] * a[3]);
        const float rs = 1.0f / sqrtf(ss * (1.f / 256.f) + 1e-6f);
#pragma unroll
        for (int i = 0; i < 4; ++i) cqn[l + 64 * i] = a[i] * rs * F.in[IN_QNORM_G][l + 64 * i];
        {
            const float mean = wave_sum(a[4]) * (1.f / 64.f); const float dlt = a[4] - mean;
            const float var = wave_sum(dlt * dlt) * (1.f / 64.f);
            KIDX32[(size_t)r * 64 + l] = dlt * (1.0f / sqrtf(var + LN_EPS)) * F.in[IN_IDXLN_G][l] + F.in[IN_IDXLN_B][l];
        }
        if (l < 8) WIDX[(size_t)r * 8 + l] = a[5] * 0.04419417382415922f;
        __builtin_amdgcn_wave_barrier();
        float q[8];
#pragma unroll
        for (int i = 0; i < 8; ++i) q[i] = 0.f;
        for (int c = 0; c < 256; ++c) {
            const float cq = cqn[c]; const float* wr = w_iq + (size_t)c * 512;
#pragma unroll
            for (int i = 0; i < 8; ++i) q[i] += cq * wr[l + 64 * i];
        }
#pragma unroll
        for (int i = 0; i < 8; ++i) QIDX32[(size_t)r * 512 + l + 64 * i] = q[i];
        __builtin_amdgcn_wave_barrier();
    }
}

__device__ __forceinline__ unsigned sortable(float f) { const unsigned u = __float_as_uint(f); return (u & 0x80000000u) ? ~u : (u | 0x80000000u); }
__device__ __forceinline__ void p5_index_naive(Frame& F) {
    const bf16* QA = WSP(bf16, WS_QA); const bf16* KIDX = WSP(bf16, WS_KIDX); const float* WIDX = WSP(float, WS_WIDX);
    unsigned short* SEL = WSP(unsigned short, WS_SEL); int* NSEL = WSP(int, WS_NSEL);
    LAS float* sc = (LAS float*)(F.lds);
    LAS float* qf = (LAS float*)(F.lds + 33024);
    LAS unsigned* hist = (LAS unsigned*)(F.lds + 33024 + 2048);
    LAS unsigned* cw = hist + 256;
    const int tid = F.tid;
    for (int q = blockIdx.x; q < NROWS; q += F.G) {
        int b, pos; if (q < NREAL) { b = q >> 13; pos = NMETA + (q & (SEQ - 1)); } else { b = 0; pos = q - NREAL; }
        const int nvis = pos < NMETA ? NMETA : NMETA + 64 * ((pos - NMETA) / 64 + 1);
#if REFSEL
        qf[tid] = F.out[(size_t)q * 512 + tid];
#else
        qf[tid] = bf2f(QA[(size_t)q * QAW + 1024 + tid]);
#endif
        float w[8];
#pragma unroll
        for (int h = 0; h < 8; ++h) w[h] = WIDX[(size_t)q * 8 + h];
        __syncthreads();
        for (int j = tid; j < nvis; j += NTHR) {
            const v4u* kp = (const v4u*)(KIDX + (size_t)key_row(b, j) * 64);
#if REFSEL
            const f32x4* kp32 = (const f32x4*)(F.out + (size_t)R * 512 + (size_t)key_row(b, j) * 64);
#endif
            float d[8];
#pragma unroll
            for (int h = 0; h < 8; ++h) d[h] = 0.f;
#pragma unroll 2
            for (int c = 0; c < 8; ++c) {
#if REFSEL
                const f32x4 ta = kp32[2 * c], tb = kp32[2 * c + 1];
                const float k0 = ta.x, k1 = ta.y, k2 = ta.z, k3 = ta.w, k4 = tb.x, k5 = tb.y, k6 = tb.z, k7 = tb.w;
#else
                const v4u t = kp[c];
                const float k0 = bflo(t.x), k1 = bfhi(t.x), k2 = bflo(t.y), k3 = bfhi(t.y), k4 = bflo(t.z), k5 = bfhi(t.z), k6 = bflo(t.w), k7 = bfhi(t.w);
#endif
#pragma unroll
                for (int h = 0; h < 8; ++h) {
                    const f32x4 qa = *(const LAS f32x4*)(qf + h * 64 + 8 * c), qb = *(const LAS f32x4*)(qf + h * 64 + 8 * c + 4);
                    d[h] += qa.x * k0 + qa.y * k1 + qa.z * k2 + qa.w * k3 + qb.x * k4 + qb.y * k5 + qb.z * k6 + qb.w * k7;
                }
            }
            float s = 0.f;
#pragma unroll
            for (int h = 0; h < 8; ++h) s += w[h] * fmaxf(d[h], 0.f);
            sc[j] = s + 0.0f;
        }
        __syncthreads();
        unsigned short* selq = SEL + (size_t)q * TOPK;
        if (nvis <= TOPK) {
            for (int j = tid; j < nvis; j += NTHR) selq[j] = (unsigned short)j;
        } else {
            unsigned prefix = 0u, mask = 0u, need = TOPK;
            for (int pass = 0; pass < 4; ++pass) {
                const int shift = 24 - 8 * pass;
                if (tid < 256) hist[tid] = 0u;
                __syncthreads();
                for (int j = tid; j < nvis; j += NTHR) { const unsigned key = sortable(sc[j]); if ((key & mask) == prefix) atomicAdd((unsigned*)&hist[(key >> shift) & 255u], 1u); }
                __syncthreads();
                if (tid < 256) {
                    unsigned above = 0u; for (int bb = tid + 1; bb < 256; ++bb) above += hist[bb];
                    const unsigned c = hist[tid];
                    if (above < need && need <= above + c) { cw[0] = prefix | ((unsigned)tid << shift); cw[1] = need - above; }
                }
                __syncthreads();
                prefix = cw[0]; need = cw[1]; mask |= 0xFFu << shift;
                __syncthreads();
            }
            if (tid == 0) cw[2] = 0u;
            __syncthreads();
            for (int j = tid; j < nvis; j += NTHR) { if (sortable(sc[j]) > prefix) { const unsigned p = atomicAdd((unsigned*)&cw[2], 1u); selq[p] = (unsigned short)j; } }
            __syncthreads();
            if (F.wave == 0) {
                const unsigned base = cw[2]; unsigned taken = 0u;
                for (int j0 = 0; j0 < nvis && taken < need; j0 += 64) {
                    const int j = j0 + F.lane; const bool eq = j < nvis && sortable(sc[j]) == prefix;
                    const unsigned long long m = __ballot(eq);
                    const unsigned rank = (unsigned)__popcll(m & ((1ull << F.lane) - 1ull));
                    if (eq && taken + rank < need) selq[base + taken + rank] = (unsigned short)j;
                    taken += (unsigned)__popcll(m);
                }
            }
        }
        if (tid == 0) NSEL[q] = nvis < TOPK ? nvis : TOPK;
        __syncthreads();
    }
}

__device__ __forceinline__ void p6_attn_naive(Frame& F) {
    bf16* QA = WSP(bf16, WS_QA); const bf16* CKV = WSP(bf16, WS_CKV); const unsigned short* SEL = WSP(unsigned short, WS_SEL); const int* NSEL = WSP(int, WS_NSEL);
    LAS float* qf = (LAS float*)(F.lds + F.wave * 16384);
    LAS float* ps = qf + 1024;
    LAS int* srow = (LAS int*)(ps + 2048);
    const int l = F.lane;
    const int gw = blockIdx.x * NWAVES + F.wave, NGW = F.G * NWAVES;
    for (int q = gw; q < R; q += NGW) {
        bf16* qrow = QA + (size_t)q * QAW;
        if (q >= NROWS) {
            for (int c = l; c < QAW / 8; c += 64) *(v4u*)(qrow + 8 * c) = (v4u){0u, 0u, 0u, 0u};
            continue;
        }
        int b, pos; if (q < NREAL) { b = q >> 13; pos = NMETA + (q & (SEQ - 1)); } else { b = 0; pos = q - NREAL; }
        const int nsel = NSEL[q];
        {
            const v4u t0 = *(const v4u*)(qrow + 16 * l), t1 = *(const v4u*)(qrow + 16 * l + 8);
            LAS float* d = qf + 16 * l;
            d[0] = bflo(t0.x); d[1] = bfhi(t0.x); d[2] = bflo(t0.y); d[3] = bfhi(t0.y); d[4] = bflo(t0.z); d[5] = bfhi(t0.z); d[6] = bflo(t0.w); d[7] = bfhi(t0.w);
            d[8] = bflo(t1.x); d[9] = bfhi(t1.x); d[10] = bflo(t1.y); d[11] = bfhi(t1.y); d[12] = bflo(t1.z); d[13] = bfhi(t1.z); d[14] = bflo(t1.w); d[15] = bfhi(t1.w);
        }
        __builtin_amdgcn_wave_barrier();
        for (int kk = 0; kk < 4; ++kk) {
            const int s = kk * 64 + l; const bool valid = s < nsel;
            const int j = valid ? (int)SEL[(size_t)q * TOPK + s] : 0;
            const int row = key_row(b, j);
            srow[s] = row;
            float acc[8];
#pragma unroll
            for (int h = 0; h < 8; ++h) acc[h] = 0.f;
            const v4u* kp = (const v4u*)(CKV + (size_t)row * 128);
            for (int c8 = 0; c8 < 16; ++c8) {
                const v4u t = kp[c8];
                const float k0 = bflo(t.x), k1 = bfhi(t.x), k2 = bflo(t.y), k3 = bfhi(t.y), k4 = bflo(t.z), k5 = bfhi(t.z), k6 = bflo(t.w), k7 = bfhi(t.w);
#pragma unroll
                for (int h = 0; h < 8; ++h) {
                    const f32x4 qa = *(const LAS f32x4*)(qf + h * 128 + 8 * c8), qb = *(const LAS f32x4*)(qf + h * 128 + 8 * c8 + 4);
                    acc[h] += qa.x * k0 + qa.y * k1 + qa.z * k2 + qa.w * k3 + qb.x * k4 + qb.y * k5 + qb.z * k6 + qb.w * k7;
                }
            }
            const float dist = fabsf((float)(pos - j));
#pragma unroll
            for (int h = 0; h < 8; ++h) { const float slope = __uint_as_float((unsigned)(127 - (h + 1)) << 23); ps[s * 8 + h] = valid ? acc[h] - slope * dist : -INFINITY; }
        }
        __builtin_amdgcn_wave_barrier();
#pragma unroll
        for (int h = 0; h < 8; ++h) {
            float v0 = ps[(l) * 8 + h], v1 = ps[(l + 64) * 8 + h], v2 = ps[(l + 128) * 8 + h], v3 = ps[(l + 192) * 8 + h];
            const float mx = wave_max(fmaxf(fmaxf(v0, v1), fmaxf(v2, v3)));
            v0 = __expf(v0 - mx); v1 = __expf(v1 - mx); v2 = __expf(v2 - mx); v3 = __expf(v3 - mx);
            const float inv = 1.0f / wave_sum((v0 + v1) + (v2 + v3));
            ps[(l) * 8 + h] = v0 * inv; ps[(l + 64) * 8 + h] = v1 * inv; ps[(l + 128) * 8 + h] = v2 * inv; ps[(l + 192) * 8 + h] = v3 * inv;
        }
        __builtin_amdgcn_wave_barrier();
        float o0[8], o1[8];
#pragma unroll
        for (int h = 0; h < 8; ++h) { o0[h] = 0.f; o1[h] = 0.f; }
        for (int s = 0; s < nsel; ++s) {
            const int row = srow[s];
            const unsigned w = *(const unsigned*)(CKV + (size_t)row * 128 + 2 * l);
            const float c0 = bflo(w), c1 = bfhi(w);
            const f32x4 pa = *(const LAS f32x4*)(ps + s * 8), pb = *(const LAS f32x4*)(ps + s * 8 + 4);
            o0[0] += pa.x * c0; o1[0] += pa.x * c1; o0[1] += pa.y * c0; o1[1] += pa.y * c1; o0[2] += pa.z * c0; o1[2] += pa.z * c1; o0[3] += pa.w * c0; o1[3] += pa.w * c1;
            o0[4] += pb.x * c0; o1[4] += pb.x * c1; o0[5] += pb.y * c0; o1[5] += pb.y * c1; o0[6] += pb.z * c0; o1[6] += pb.z * c1; o0[7] += pb.w * c0; o1[7] += pb.w * c1;
        }
#pragma unroll
        for (int h = 0; h < 8; ++h) *(unsigned*)(qrow + h * 128 + 2 * l) = pk2(o0[h], o1[h]);
        __builtin_amdgcn_wave_barrier();
    }
}

__device__ __forceinline__ void p7_rwkv_prep_naive(Frame& F) {
    const bf16* P = WSP(bf16, WS_P); float* DEC = WSP(float, WS_DEC); bf16* AB = WSP(bf16, WS_AB); bf16* GB = WSP(bf16, WS_GB);
    const float* mu = F.in[IN_MU]; const float* Wd = F.in[IN_W_DEC]; const float* Wa = F.in[IN_W_AAA]; const float* Wg = F.in[IN_W_GATE];
    const int l = F.lane;
    const int gw = blockIdx.x * NWAVES + F.wave, NGW = F.G * NWAVES;
    for (int r = gw; r < NROWS; r += NGW) {
        int prev; if (r < NREAL) { prev = (r & (SEQ - 1)) ? r - 1 : NREAL + NMETA - 1; } else { prev = r > NREAL ? r - 1 : -1; }
        const bf16* pr = P + (size_t)r * PW; const bf16* pp = prev >= 0 ? P + (size_t)prev * PW : nullptr;
#define SHIFTED(pc, mc) (bf2f(pr[pc]) + ((pp ? bf2f(pp[pc]) : 0.f) - bf2f(pr[pc])) * mu[mc])
        const float tw = tanhf(SHIFTED(PC_WD + l, 1536 + l));
        const float ta = SHIFTED(PC_AD + l, 1600 + l);
        const float tg0 = sigmoidf_(SHIFTED(PC_GD + l, 1664 + l)), tg1 = sigmoidf_(SHIFTED(PC_GD + 64 + l, 1728 + l));
#undef SHIFTED
        float aw[8], aa[8], ag[8];
#pragma unroll
        for (int i = 0; i < 8; ++i) { aw[i] = F.in[IN_W0][l + 64 * i]; aa[i] = F.in[IN_A0][l + 64 * i]; ag[i] = 0.f; }
        for (int j = 0; j < 64; ++j) {
            const float xw = __shfl(tw, j), xa = __shfl(ta, j), xg0 = __shfl(tg0, j), xg1 = __shfl(tg1, j);
#pragma unroll
            for (int i = 0; i < 8; ++i) {
                aw[i] += xw * Wd[(size_t)j * 512 + l + 64 * i];
                aa[i] += xa * Wa[(size_t)j * 512 + l + 64 * i];
                ag[i] += xg0 * Wg[(size_t)j * 512 + l + 64 * i] + xg1 * Wg[(size_t)(j + 64) * 512 + l + 64 * i];
            }
        }
#pragma unroll
        for (int i = 0; i < 8; ++i) {
            const float x = -aw[i];
            const float sp = x > 20.f ? x : log1pf(__expf(x));
            const float wlog = -sp - 0.5f;
            DEC[(size_t)r * 512 + l + 64 * i] = __expf(-__expf(wlog));
            AB[(size_t)r * 512 + l + 64 * i] = (bf16)f2bf(sigmoidf_(aa[i]));
            GB[(size_t)r * 512 + l + 64 * i] = (bf16)f2bf(ag[i]);
        }
    }
}

__device__ __forceinline__ void p8_rwkv_scan_naive(Frame& F) {
    if (F.wave != 0 || blockIdx.x >= 32) return;
    const bf16* P = WSP(bf16, WS_P); const float* DEC = WSP(float, WS_DEC); const bf16* AB = WSP(bf16, WS_AB); const bf16* GB = WSP(bf16, WS_GB); bf16* QA = WSP(bf16, WS_QA);
    const int b = blockIdx.x >> 3, h = blockIdx.x & 7, l = F.lane, ch = h * 64 + l;
    LAS float* vec = (LAS float*)F.lds;
    const float mu_r = F.in[IN_MU][ch], mu_k = F.in[IN_MU][512 + ch], mu_v = F.in[IN_MU][1024 + ch];
    const float kk_c = F.in[IN_KK][ch], ka_c = F.in[IN_KA][ch], rk_c = F.in[IN_RK][ch], gng = F.in[IN_GN_G][ch], gnb = F.in[IN_GN_B][ch];
    float S[64];
#pragma unroll
    for (int k = 0; k < 64; ++k) S[k] = 0.f;
    float pr_p = 0.f, pk_p = 0.f, pv_p = 0.f;
    int row = key_row(b, 0);
    float n_pr = bf2f(P[(size_t)row * PW + PC_R + ch]), n_pk = bf2f(P[(size_t)row * PW + PC_K + ch]), n_pv = bf2f(P[(size_t)row * PW + PC_V + ch]);
    float n_w = DEC[(size_t)row * 512 + ch], n_a = bf2f(AB[(size_t)row * 512 + ch]), n_g = bf2f(GB[(size_t)row * 512 + ch]);
    for (int pos = 0; pos < TT; ++pos) {
        const int crow = row;
        const float c_pr = n_pr, c_pk = n_pk, c_pv = n_pv, c_w = n_w, c_a = n_a, c_g = n_g;
        if (pos + 1 < TT) {
            row = key_row(b, pos + 1);
            n_pr = bf2f(P[(size_t)row * PW + PC_R + ch]); n_pk = bf2f(P[(size_t)row * PW + PC_K + ch]); n_pv = bf2f(P[(size_t)row * PW + PC_V + ch]);
            n_w = DEC[(size_t)row * 512 + ch]; n_a = bf2f(AB[(size_t)row * 512 + ch]); n_g = bf2f(GB[(size_t)row * 512 + ch]);
        }
        const float r_s = c_pr + (pr_p - c_pr) * mu_r, k_s = c_pk + (pk_p - c_pk) * mu_k, v_s = c_pv + (pv_p - c_pv) * mu_v;
        pr_p = c_pr; pk_p = c_pk; pv_p = c_pv;
        const float kkr = k_s * kk_c;
        const float nrm = sqrtf(wave_sum(kkr * kkr));
        const float kk = kkr / fmaxf(nrm, 1e-12f);
        const float k2 = k_s * (1.f + (c_a - 1.f) * ka_c);
        vec[l] = -kk; vec[64 + l] = kk * c_a; vec[128 + l] = c_w; vec[192 + l] = k2; vec[256 + l] = r_s;
        __builtin_amdgcn_wave_barrier();
        float sa = 0.f;
#pragma unroll
        for (int k4 = 0; k4 < 16; ++k4) { const f32x4 a = *(const LAS f32x4*)(vec + 4 * k4); sa += S[4 * k4] * a.x + S[4 * k4 + 1] * a.y + S[4 * k4 + 2] * a.z + S[4 * k4 + 3] * a.w; }
        float y = 0.f;
#pragma unroll
        for (int k4 = 0; k4 < 16; ++k4) {
            const f32x4 bv = *(const LAS f32x4*)(vec + 64 + 4 * k4), w = *(const LAS f32x4*)(vec + 128 + 4 * k4), kv = *(const LAS f32x4*)(vec + 192 + 4 * k4), rv = *(const LAS f32x4*)(vec + 256 + 4 * k4);
            S[4 * k4] = S[4 * k4] * w.x + sa * bv.x + v_s * kv.x; S[4 * k4 + 1] = S[4 * k4 + 1] * w.y + sa * bv.y + v_s * kv.y;
            S[4 * k4 + 2] = S[4 * k4 + 2] * w.z + sa * bv.z + v_s * kv.z; S[4 * k4 + 3] = S[4 * k4 + 3] * w.w + sa * bv.w + v_s * kv.w;
            y += S[4 * k4] * rv.x + S[4 * k4 + 1] * rv.y + S[4 * k4 + 2] * rv.z + S[4 * k4 + 3] * rv.w;
        }
        __builtin_amdgcn_wave_barrier();
        const float mean = wave_sum(y) * (1.f / 64.f);
        const float dlt = y - mean;
        const float var = wave_sum(dlt * dlt) * (1.f / 64.f);
        const float yn = dlt * (1.0f / sqrtf(var + GN_EPS)) * gng + gnb;
        const float bonus = wave_sum(r_s * k2 * rk_c) * v_s;
        const float o = (yn + bonus) * c_g;
        if (pos >= NMETA || b == 0) QA[(size_t)crow * QAW + 1024 + ch] = (bf16)f2bf(o);
    }
}

template <bool OUT_BF16>
__device__ __forceinline__ void ln_rows4(Frame& F, int nrows, const float* g, const float* b, bf16* dstb) {
    const int gw = blockIdx.x * NWAVES + F.wave, NGW = F.G * NWAVES;
    const float* META1 = WSP(float, WS_META1);
    f32x4 gg[4], bb[4];
#pragma unroll
    for (int j = 0; j < 4; ++j) { gg[j] = ((const f32x4*)g)[F.lane + 64 * j]; bb[j] = ((const f32x4*)b)[F.lane + 64 * j]; }
    for (int r0 = gw * 4; r0 < nrows; r0 += NGW * 4) {
        f32x4 v[4][4];
#pragma unroll
        for (int q = 0; q < 4; ++q) {
            const int r = r0 + q < nrows ? r0 + q : nrows - 1;
            const f32x4* xr = (const f32x4*)(r < NREAL ? F.out + (size_t)r * D : META1 + (size_t)(r - NREAL) * D) + F.lane;
#pragma unroll
            for (int j = 0; j < 4; ++j) v[q][j] = xr[64 * j];
        }
#pragma unroll
        for (int q = 0; q < 4; ++q) {
            float s = 0.f;
#pragma unroll
            for (int j = 0; j < 4; ++j) s += (v[q][j].x + v[q][j].y) + (v[q][j].z + v[q][j].w);
            const float mean = wave_sum(s) * (1.f / D); float s2 = 0.f;
#pragma unroll
            for (int j = 0; j < 4; ++j) { v[q][j] = v[q][j] - mean; s2 += (v[q][j].x * v[q][j].x + v[q][j].y * v[q][j].y) + (v[q][j].z * v[q][j].z + v[q][j].w * v[q][j].w); }
            const float rstd = 1.f / sqrtf(wave_sum(s2) * (1.f / D) + LN_EPS);
            if (r0 + q < nrows) {
                if (OUT_BF16) { v2u* o8 = (v2u*)(dstb + (size_t)(r0 + q) * D) + F.lane;
#pragma unroll
                    for (int j = 0; j < 4; ++j) { const f32x4 y = v[q][j] * rstd * gg[j] + bb[j]; o8[64 * j] = (v2u){pk2(y.x, y.y), pk2(y.z, y.w)}; }
                } else { f32x4* o = (f32x4*)(F.out + (size_t)(r0 + q) * D) + F.lane;
#pragma unroll
                    for (int j = 0; j < 4; ++j) o[64 * j] = v[q][j] * rstd * gg[j] + bb[j]; }
            }
        }
    }
}
__device__ __forceinline__ void p10_ln1(Frame& F) { ln_rows4<true>(F, NROWS, F.in[IN_LN1_G], F.in[IN_LN1_B], WSP(bf16, WS_H)); }
__device__ __forceinline__ void p14_ln2(Frame& F) { ln_rows4<false>(F, NREAL, F.in[IN_LN2_G], F.in[IN_LN2_B], nullptr); }

__device__ __forceinline__ float gelu_fast(float x) {
    const float u2 = x * (1.5957691216057308f + 0.07135481627260025f * x * x);
    return x * __builtin_amdgcn_rcpf(1.0f + __builtin_amdgcn_exp2f(-1.4426950408889634f * u2));
}
__device__ __forceinline__ void p12_conv_fix(Frame& F) {
    bf16* ACT = WSP(bf16, WS_UP); const float* cw = F.in[IN_CONV_W]; const float* cb = F.in[IN_CONV_B];
    const float* G01 = WSP(float, WS_G01); const float* V01 = WSP(float, WS_V01); const float* GHALO = WSP(float, WS_GHALO); const float* GMETA = WSP(float, WS_GMETA);
    for (int it = blockIdx.x * NTHR + F.tid; it < 128 * 2 * DFF; it += F.G * NTHR) {
        const int j = it % DFF, rr = (it / DFF) & 1, pm = it / (2 * DFF);
        const float* ph = (pm & 31) ? GHALO + (size_t)(pm - 1) * 2 * DFF : GMETA;
        const float g0 = G01[((size_t)pm * 2 + rr) * DFF + j];
        const float g1 = rr ? G01[((size_t)pm * 2) * DFF + j] : ph[DFF + j];
        const float g2 = rr ? ph[DFF + j] : ph[j];
        const float x = cw[j] * g2 + cw[DFF + j] * g1 + cw[2 * DFF + j] * g0 + cb[j];
        ACT[(size_t)(pm * 256 + rr) * DFF + j] = (bf16)f2bf(gelu_fast(x) * V01[((size_t)pm * 2 + rr) * DFF + j]);
    }
}


constexpr int NUNITS = 4096 + 8;
constexpr int RP = 72;
constexpr int SLOT = 64 * RP * 2;
constexpr int FP = 68;
typedef short bf16x8 __attribute__((ext_vector_type(8)));
typedef float f32x16 __attribute__((ext_vector_type(16)));
constexpr size_t RW_MAT = (size_t)NUNITS * 4096;

__device__ __forceinline__ void quad_mma(f32x16& acc, const LAS bf16* Aop, const LAS bf16* Bop, int qr, int qc, int lane) {
    const int r = lane & 31, hf = lane >> 5;
    const LAS bf16* ap = Aop + (32 * qr + r) * RP + 8 * hf; const LAS bf16* bp = Bop + (32 * qc + r) * RP + 8 * hf;
#pragma unroll
    for (int ks = 0; ks < 4; ++ks) {
        const bf16x8 a = *(const LAS bf16x8*)(ap + 16 * ks), b = *(const LAS bf16x8*)(bp + 16 * ks);
        acc = __builtin_amdgcn_mfma_f32_32x32x16_bf16(a, b, acc, 0, 0, 0);
    }
}
#define ACC_M(qr, j, hf) (32 * (qr) + ((j) & 3) + 8 * ((j) >> 2) + 4 * (hf))
__device__ __forceinline__ void store_T(const f32x16& acc, LAS bf16* Z, int qr, int qc, int lane) {
    const int r = lane & 31, hf = lane >> 5;
#pragma unroll
    for (int jj = 0; jj < 4; ++jj)
        *(LAS v2u*)(Z + (32 * qc + r) * RP + 32 * qr + 8 * jj + 4 * hf) = (v2u){pk2(acc[4 * jj], acc[4 * jj + 1]), pk2(acc[4 * jj + 2], acc[4 * jj + 3])};
}
__device__ __forceinline__ void add_T(f32x16& acc, const LAS bf16* Z, int qr, int qc, int lane) {
    const int r = lane & 31, hf = lane >> 5;
#pragma unroll
    for (int jj = 0; jj < 4; ++jj) {
        const v2u w = *(const LAS v2u*)(Z + (32 * qc + r) * RP + 32 * qr + 8 * jj + 4 * hf);
        acc[4 * jj] += bflo(w.x); acc[4 * jj + 1] += bfhi(w.x); acc[4 * jj + 2] += bflo(w.y); acc[4 * jj + 3] += bfhi(w.y);
    }
}
__device__ __forceinline__ int frag_off(int n, int m) { return (((m >> 4) * 2 + ((m >> 3) & 1)) * 64 + n) * 8 + (m & 7); }
__device__ __forceinline__ int acc_off(int n, int m) { return ((((m >> 5) * 4 + ((m >> 3) & 3)) * 2 + ((m >> 2) & 1)) * 64 + n) * 4 + (m & 3); }
template <bool FRAG>
__device__ __forceinline__ void store_T_global(const f32x16& acc, bf16* Z, int qr, int qc, int lane) {
    const int r = lane & 31, hf = lane >> 5;
#pragma unroll
    for (int jj = 0; jj < 4; ++jj) { const int n = 32 * qc + r, m0 = 32 * qr + 8 * jj + 4 * hf;
        *(v2u*)(Z + (FRAG ? frag_off(n, m0) : acc_off(n, m0))) = (v2u){pk2(acc[4 * jj], acc[4 * jj + 1]), pk2(acc[4 * jj + 2], acc[4 * jj + 3])}; }
}
__device__ __forceinline__ f32x16 zero16() { f32x16 z;
#pragma unroll
    for (int j = 0; j < 16; ++j) z[j] = 0.f;
    return z; }

__device__ __forceinline__ void b1_load_raw(const bf16* P, int u, int w, int l, unsigned short (&rv)[45]) {
    const bool meta = u >= 4096;
    int b = 0, h, c = 0; if (meta) h = u - 4096; else { b = u >> 10; h = (u >> 7) & 7; c = u & 127; }
    const int ch = h * 64 + l, row0 = meta ? NREAL : b * SEQ + c * 64, t0 = 8 * w;
    int prow = -1;
    if (t0 > 0) prow = row0 + t0 - 1; else if (!meta) prow = (c == 0) ? NREAL + NMETA - 1 : row0 - 1;
#pragma unroll
    for (int i = 0; i < 9; ++i) {
        const int t = t0 - 1 + i;
        const int row = i == 0 ? prow : ((!meta || t < NMETA) ? row0 + t : -1);
        const bf16* pp = P + (size_t)(row >= 0 ? row : 0) * PW;
        const unsigned short a0 = pp[PC_R + ch], a1 = pp[PC_K + ch], a2 = pp[PC_V + ch], a3 = pp[PC_WD + l], a4 = pp[PC_AD + l];
        const bool ok = row >= 0;
        rv[5 * i] = ok ? a0 : (unsigned short)0; rv[5 * i + 1] = ok ? a1 : (unsigned short)0; rv[5 * i + 2] = ok ? a2 : (unsigned short)0; rv[5 * i + 3] = ok ? a3 : (unsigned short)0; rv[5 * i + 4] = ok ? a4 : (unsigned short)0;
    }
}

#define LDS_BARRIER() do { asm volatile("s_waitcnt lgkmcnt(0)" ::: "memory"); __builtin_amdgcn_s_barrier(); asm volatile("" ::: "memory"); } while (0)
#ifdef PROBE_B1SEC
#define B1T(k) do { if (blockIdx.x == 0 && F.tid == 0) { const unsigned long long t_ = __builtin_amdgcn_s_memrealtime(); if ((k) == PROBE_B1SEC + 1) b1acc += t_ - b1t0; b1t0 = t_; } } while (0)
#else
#define B1T(k) do {} while (0)
#endif
__device__ __forceinline__ void rw_b1(Frame& F) {
    const bf16* P = WSP(bf16, WS_P);
    bf16* RWM = WSP(bf16, WS_RWM); bf16* RWN = WSP(bf16, WS_RWN); bf16* RWQ = WSP(bf16, WS_RWQ); bf16* RWY = WSP(bf16, WS_RWY);
    float* BONUS = (float*)((char*)F.out + OUT_BONUS);
    const bf16* WdT = WSP(bf16, WS_WT_LORA); const bf16* WaT = WdT + 512 * 64;
    const float* mu = F.in[IN_MU];
    const int w = F.wave, l = F.lane, tid = F.tid;
    LAS unsigned char* L = F.lds;
#define SL(s) ((LAS bf16*)(L + (s) * SLOT))
    LAS float* WL = (LAS float*)(L + 12 * SLOT);
    LAS float* AL = (LAS float*)(L + 0 * SLOT);
    LAS float* OT = (LAS float*)(L + RING_BYTES + 1024);
    LAS float* GL = OT + 512;
    unsigned long long b1acc = 0ull, b1t0 = 0ull; (void)b1acc; (void)b1t0;
    unsigned short rnx[45];
    b1_load_raw(P, (int)blockIdx.x < NUNITS ? (int)blockIdx.x : 0, w, l, rnx);
    for (int u = blockIdx.x; u < NUNITS; u += F.G) {
        const bool meta = u >= 4096;
        int b = 0, h, c = 0; if (meta) h = u - 4096; else { b = u >> 10; h = (u >> 7) & 7; c = u & 127; }
        const int ch = h * 64 + l;
        const int row0 = meta ? NREAL : b * SEQ + c * 64;
        LDS_BARRIER();
        B1T(0);
        float r_s[8], k_s[8], v_s[8], xw[8], xa[8];
        {
            const int t0 = 8 * w;
            unsigned short rc[45];
#pragma unroll
            for (int i = 0; i < 45; ++i) rc[i] = rnx[i];
            float pr = bf2f(rc[0]), pk = bf2f(rc[1]), pv = bf2f(rc[2]), pw = bf2f(rc[3]), pa = bf2f(rc[4]);
            const float mr = mu[ch], mk = mu[512 + ch], mv = mu[1024 + ch], mw = mu[1536 + l], ma = mu[1600 + l];
#pragma unroll
            for (int i = 0; i < 8; ++i) {
                const int t = t0 + i; const bool valid = !meta || t < NMETA;
                const float cr = bf2f(rc[5 * i + 5]), ck = bf2f(rc[5 * i + 6]), cv = bf2f(rc[5 * i + 7]), cw = bf2f(rc[5 * i + 8]), ca = bf2f(rc[5 * i + 9]);
                r_s[i] = valid ? cr + (pr - cr) * mr : 0.f; k_s[i] = valid ? ck + (pk - ck) * mk : 0.f; v_s[i] = valid ? cv + (pv - cv) * mv : 0.f;
                xw[i] = fast_tanh(cw + (pw - cw) * mw); xa[i] = ca + (pa - ca) * ma;
                pr = cr; pk = ck; pv = cv; pw = cw; pa = ca;
            }
#pragma unroll
            for (int i = 0; i < 8; ++i) { SL(8)[(t0 + i) * RP + l] = (bf16)f2bf(xw[i]); SL(9)[(t0 + i) * RP + l] = (bf16)f2bf(xa[i]); }
            {
                const int k = tid >> 3, pc = tid & 7;
                *(LAS v4u*)(SL(10) + k * RP + 8 * pc) = *(const v4u*)(WdT + (size_t)(h * 64 + k) * 64 + 8 * pc);
                *(LAS v4u*)(SL(11) + k * RP + 8 * pc) = *(const v4u*)(WaT + (size_t)(h * 64 + k) * 64 + 8 * pc);
            }
        }
        __syncthreads();
        B1T(1);
        {
            const int pid = w >> 2, q = w & 3, qr = q >> 1, qc = q & 1;
            f32x16 acc = zero16();
            quad_mma(acc, SL(10 + pid), SL(8 + pid), qr, qc, l);
            LAS float* Zf = pid ? AL : WL;
            const int r = l & 31, hf = l >> 5;
#pragma unroll
            for (int jj = 0; jj < 4; ++jj) *(LAS f32x4*)(Zf + (32 * qc + r) * FP + 32 * qr + 8 * jj + 4 * hf) = (f32x4){acc[4 * jj], acc[4 * jj + 1], acc[4 * jj + 2], acc[4 * jj + 3]};
        }
        __syncthreads();
        B1T(2);
        float lw[8], asg[8];
        {
            const float w0c = F.in[IN_W0][ch], a0c = F.in[IN_A0][ch];
            float run = 0.f;
#pragma unroll
            for (int i = 0; i < 8; ++i) {
                const int t = 8 * w + i; const bool valid = !meta || t < NMETA;
                const float x = -(WL[t * FP + l] + w0c);
                const float sp = x > 20.f ? x : __logf(1.0f + __expf(x));
                const float e = -__expf(-sp - 0.5f);
                run += valid ? e : 0.f; lw[i] = run;
                asg[i] = sigmoidf_(AL[t * FP + l] + a0c);
            }
            OT[w * 64 + l] = run;
        }
        __syncthreads();
        {
            float off = 0.f, tot = 0.f;
#pragma unroll
            for (int ww = 0; ww < 8; ++ww) { const float o = OT[ww * 64 + l]; tot += o; off += ww < w ? o : 0.f; }
            if (w == 0) GL[l] = __expf(tot);
            const float kkc = F.in[IN_KK][ch], kac = F.in[IN_KA][ch], rkc = F.in[IN_RK][ch];
            unsigned atc[4], vc[4], bhc[4], khc[4];
            float prevlg = off;
#pragma unroll
            for (int i = 0; i < 8; ++i) {
                const int t = 8 * w + i;
                const float lg = off + lw[i];
                const float g = __expf(lg), gp = __expf(prevlg), gi = __expf(-lg), gh = __expf(tot - lg);
                prevlg = lg;
                const float kkr = k_s[i] * kkc;
                const float kk = kkr * __builtin_amdgcn_rsqf(fmaxf(wave_sum(kkr * kkr), 1e-24f));
                const float k2 = k_s[i] * (1.f + (asg[i] - 1.f) * kac);
                const float bon = wave_sum(r_s[i] * k2 * rkc);
                if (l == 0) BONUS[(size_t)u * 64 + t] = bon;
                const float at = -kk * gp, rt = r_s[i] * g, bt = kk * asg[i] * gi, kt = k2 * gi, bh = kk * asg[i] * gh, kh = k2 * gh;
                SL(0)[t * RP + l] = (bf16)f2bf(at); SL(1)[t * RP + l] = (bf16)f2bf(rt); SL(2)[t * RP + l] = (bf16)f2bf(bt); SL(3)[t * RP + l] = (bf16)f2bf(kt);
                const unsigned ua = f2bf(at), uv = f2bf(v_s[i]), ub = f2bf(bh), uk = f2bf(kh);
                if (i & 1) { atc[i >> 1] |= ua << 16; vc[i >> 1] |= uv << 16; bhc[i >> 1] |= ub << 16; khc[i >> 1] |= uk << 16; }
                else { atc[i >> 1] = ua; vc[i >> 1] = uv; bhc[i >> 1] = ub; khc[i >> 1] = uk; }
            }
            *(LAS v4u*)(SL(4) + l * RP + 8 * w) = (v4u){atc[0], atc[1], atc[2], atc[3]};
            *(LAS v4u*)(SL(5) + l * RP + 8 * w) = (v4u){vc[0], vc[1], vc[2], vc[3]};
            *(LAS v4u*)(SL(6) + l * RP + 8 * w) = (v4u){bhc[0], bhc[1], bhc[2], bhc[3]};
            *(LAS v4u*)(SL(7) + l * RP + 8 * w) = (v4u){khc[0], khc[1], khc[2], khc[3]};
        }
        __syncthreads();
        B1T(3);
        for (int task = w; task < 20; task += 8) {
            int pid, qr, qc; bool zero = false;
            if (task < 15) { pid = task / 3; const int k = task % 3;
                if (pid == 1) { qc = k == 2 ? 1 : 0; qr = k == 0 ? 0 : 1; } else { qc = k == 0 ? 0 : 1; qr = k == 2 ? 1 : 0; } }
            else { pid = task - 15; zero = true; if (pid == 1) { qc = 1; qr = 0; } else { qc = 0; qr = 1; } }
            const int bop = pid == 0 ? 0 : pid == 1 ? 2 : pid == 2 ? 0 : 1;
            const int aop = pid == 0 ? 2 : pid == 1 ? 0 : pid == 2 ? 3 : pid == 3 ? 2 : 3;
            f32x16 acc = zero16();
            if (!zero) {
                quad_mma(acc, SL(aop), SL(bop), qr, qc, l);
                const int n = 32 * qc + (l & 31), hf = l >> 5;
#pragma unroll
                for (int j = 0; j < 16; ++j) {
                    const int m = ACC_M(qr, j, hf);
                    const bool keep = pid == 1 ? (m > n) : (pid <= 2 ? (n > m) : (n >= m));
                    acc[j] = keep ? acc[j] : 0.f;
                }
            }
            store_T(acc, SL(8 + pid), qr, qc, l);
        }
        __syncthreads();
        B1T(4);
        const int nq = w & 3, nqr = nq >> 1, nqc = nq & 1;
        f32x16 nacc = zero16();
        if (w < 4) { add_T(nacc, SL(8), nqr, nqc, l); }
        for (int task = w; task < 12; task += 8) {
            const int pid = task >> 2, q = task & 3, qr = q >> 1, qc = q & 1;
            f32x16 acc = zero16();
            if (pid == 0) { quad_mma(acc, SL(9), SL(8), qr, qc, l); store_T(acc, SL(0), qr, qc, l); }
            else if (pid == 1) { quad_mma(acc, SL(8), SL(9), qr, qc, l); store_T(acc, SL(2), qr, qc, l); }
            else { quad_mma(acc, SL(10), SL(5), qr, qc, l); store_T(acc, SL(3), qr, qc, l); }
        }
        __syncthreads();
#pragma unroll
        for (int st = 0; st < 4; ++st) {
            const int pr = (st & 1) ? 10 : 0, pc = (st & 1) ? 13 : 2, pr2 = (st & 1) ? 0 : 10, pc2 = (st & 1) ? 2 : 13, nr = (st & 1) ? 9 : 8, nr2 = (st & 1) ? 8 : 9;
            if (w < 4) {
                add_T(nacc, SL(pr), nqr, nqc, l);
                quad_mma(nacc, SL(pc), SL(nr), nqr, nqc, l);
                store_T(nacc, SL(nr2), nqr, nqc, l);
                f32x16 acc = zero16();
                quad_mma(acc, SL(pc), SL(pr), nqr, nqc, l); store_T(acc, SL(pr2), nqr, nqc, l);
            } else {
                f32x16 acc = zero16();
                quad_mma(acc, SL(pr), SL(pc), nqr, nqc, l); store_T(acc, SL(pc2), nqr, nqc, l);
            }
            __syncthreads();
        }
        if (w < 4) { add_T(nacc, SL(0), nqr, nqc, l); quad_mma(nacc, SL(2), SL(8), nqr, nqc, l); store_T(nacc, SL(9), nqr, nqc, l); }
        __syncthreads();
        B1T(5);
        b1_load_raw(P, u + F.G < NUNITS ? u + F.G : u, w, l, rnx);
        {
            const int pid = w >> 2;
            f32x16 acc = zero16();
            add_T(acc, SL(pid ? 3 : 4), nqr, nqc, l);
            quad_mma(acc, SL(9), SL(pid ? 3 : 4), nqr, nqc, l);
            store_T(acc, SL(pid ? 2 : 0), nqr, nqc, l);
        }
        LDS_BARRIER();
        for (int task = w; task < 16; task += 8) {
            const int pid = task >> 2, q = task & 3, qr = q >> 1, qc = q & 1;
            f32x16 acc = zero16();
            if (pid == 0) { add_T(acc, SL(1), qr, qc, l); quad_mma(acc, SL(0), SL(11), qr, qc, l); store_T_global<true>(acc, RWQ + (size_t)u * 4096, qr, qc, l); }
            else if (pid == 1) { quad_mma(acc, SL(2), SL(11), qr, qc, l); quad_mma(acc, SL(5), SL(12), qr, qc, l); store_T_global<false>(acc, RWY + (size_t)u * 4096, qr, qc, l); }
            else if (pid == 2) {
                quad_mma(acc, SL(0), SL(6), qr, qc, l);
                const int n = 32 * qc + (l & 31), hf = l >> 5; const float gl = GL[n];
#pragma unroll
                for (int j = 0; j < 16; ++j) acc[j] += (ACC_M(qr, j, hf) == n) ? gl : 0.f;
                store_T_global<true>(acc, RWM + (size_t)u * 4096, qr, qc, l);
            } else { quad_mma(acc, SL(6), SL(2), qr, qc, l); quad_mma(acc, SL(7), SL(5), qr, qc, l); store_T_global<false>(acc, RWN + (size_t)u * 4096, qr, qc, l); }
        }
        B1T(6);
    }
#ifdef PROBE_B1SEC
    if (blockIdx.x == 0 && F.tid == 0) { F.MISC[20] = (unsigned)b1acc; }
#endif
#undef SL
}

__device__ __forceinline__ void rw_b2(Frame& F) {
    if (blockIdx.x >= 32) return;
    const bf16* RWM = WSP(bf16, WS_RWM); const bf16* RWN = WSP(bf16, WS_RWN);
    bf16* RWS = (bf16*)((char*)F.out + OUT_RWS);
    const int b = blockIdx.x >> 3, h = blockIdx.x & 7, w = F.wave, l = F.lane;
    LAS unsigned char* L = F.lds;
#define SS(buf, part) ((LAS bf16*)(L + ((buf) * 2 + (part)) * SLOT))
    const int q = w & 3, qr = q >> 1, qc = q & 1, r = l & 31, hf = l >> 5;
    if (w < 4) {
        const bf16* Nm = RWN + (size_t)(4096 + h) * 4096;
#pragma unroll
        for (int jj = 0; jj < 4; ++jj) {
            const v2u wv = *(const v2u*)(Nm + acc_off(32 * qc + r, 32 * qr + 8 * jj + 4 * hf));
            *(LAS v2u*)(SS(0, 0) + (32 * qc + r) * RP + 32 * qr + 8 * jj + 4 * hf) = wv;
            *(LAS v2u*)(SS(0, 1) + (32 * qc + r) * RP + 32 * qr + 8 * jj + 4 * hf) = (v2u){0u, 0u};
        }
    }
    __syncthreads();
    bf16x8 a_cur[4]; v2u n_cur[4];
    {
        const size_t u0 = (size_t)(b * 8 + h) * 128;
#pragma unroll
        for (int ks = 0; ks < 4; ++ks) a_cur[ks] = *(const bf16x8*)(RWM + u0 * 4096 + frag_off(32 * qr + r, 16 * ks + 8 * hf));
#pragma unroll
        for (int jj = 0; jj < 4; ++jj) n_cur[jj] = *(const v2u*)(RWN + u0 * 4096 + acc_off(32 * qc + r, 32 * qr + 8 * jj + 4 * hf));
    }
    for (int c = 0; c < 128; ++c) {
        const int u = (b * 8 + h) * 128 + c, cur = c & 1;
        if (w < 4) {
            bf16x8 a_nxt[4]; v2u n_nxt[4];
            const size_t un = (size_t)(c + 1 < 128 ? u + 1 : u);
#pragma unroll
            for (int ks = 0; ks < 4; ++ks) a_nxt[ks] = *(const bf16x8*)(RWM + un * 4096 + frag_off(32 * qr + r, 16 * ks + 8 * hf));
#pragma unroll
            for (int jj = 0; jj < 4; ++jj) n_nxt[jj] = *(const v2u*)(RWN + un * 4096 + acc_off(32 * qc + r, 32 * qr + 8 * jj + 4 * hf));
            f32x16 acc;
#pragma unroll
            for (int jj = 0; jj < 4; ++jj) { acc[4 * jj] = bflo(n_cur[jj].x); acc[4 * jj + 1] = bfhi(n_cur[jj].x); acc[4 * jj + 2] = bflo(n_cur[jj].y); acc[4 * jj + 3] = bfhi(n_cur[jj].y); }
#pragma unroll
            for (int jj = 0; jj < 4; ++jj)
                *(v2u*)(RWS + (size_t)u * 4096 + frag_off(32 * qc + r, 32 * qr + 8 * jj + 4 * hf)) = *(const LAS v2u*)(SS(cur, 0) + (32 * qc + r) * RP + 32 * qr + 8 * jj + 4 * hf);
            const LAS bf16* bh = SS(cur, 0) + (32 * qc + r) * RP + 8 * hf; const LAS bf16* bl = SS(cur, 1) + (32 * qc + r) * RP + 8 * hf;
#pragma unroll
            for (int ks = 0; ks < 4; ++ks) {
                acc = __builtin_amdgcn_mfma_f32_32x32x16_bf16(a_cur[ks], *(const LAS bf16x8*)(bh + 16 * ks), acc, 0, 0, 0);
                acc = __builtin_amdgcn_mfma_f32_32x32x16_bf16(a_cur[ks], *(const LAS bf16x8*)(bl + 16 * ks), acc, 0, 0, 0);
            }
#pragma unroll
            for (int jj = 0; jj < 4; ++jj) {
                float hi[4], lo[4];
#pragma unroll
                for (int e = 0; e < 4; ++e) { const unsigned hb = f2bf(acc[4 * jj + e]); hi[e] = __uint_as_float(hb << 16); lo[e] = acc[4 * jj + e] - hi[e]; }
                *(LAS v2u*)(SS(cur ^ 1, 0) + (32 * qc + r) * RP + 32 * qr + 8 * jj + 4 * hf) = (v2u){pk2(hi[0], hi[1]), pk2(hi[2], hi[3])};
                *(LAS v2u*)(SS(cur ^ 1, 1) + (32 * qc + r) * RP + 32 * qr + 8 * jj + 4 * hf) = (v2u){pk2(lo[0], lo[1]), pk2(lo[2], lo[3])};
            }
#pragma unroll
            for (int ks = 0; ks < 4; ++ks) a_cur[ks] = a_nxt[ks];
#pragma unroll
            for (int jj = 0; jj < 4; ++jj) n_cur[jj] = n_nxt[jj];
        }
        LDS_BARRIER();
    }
#undef SS
}

__device__ __forceinline__ void rw_b3(Frame& F, bool meta_only = false) {
    const bf16* P = WSP(bf16, WS_P); bf16* QA = WSP(bf16, WS_QA);
    const bf16* RWQ = WSP(bf16, WS_RWQ); const bf16* RWY = WSP(bf16, WS_RWY);
    const bf16* RWS = (const bf16*)((const char*)F.out + OUT_RWS); const float* BONUS = (const float*)((const char*)F.out + OUT_BONUS);
    const bf16* WgT = WSP(bf16, WS_WT_LORA) + 2 * 512 * 64;
    const float* mu = F.in[IN_MU];
    const int l = F.lane, r = l & 31, hf = l >> 5;
    const int gw = blockIdx.x * NWAVES + F.wave, NGW = F.G * NWAVES;
    for (int it = meta_only ? 8192 + F.wave : gw; it < (meta_only ? 8200 : 8192); it += meta_only ? NWAVES : NGW) {
        const int u = it < 8192 ? it >> 1 : 4096 + (it - 8192), th = it < 8192 ? (it & 1) : 0;
        const bool meta = u >= 4096;
        int b = 0, h, c = 0; if (meta) h = u - 4096; else { b = u >> 10; h = (u >> 7) & 7; c = u & 127; }
        const int t = 32 * th + r;
        const bool valid = !meta || t < NMETA;
        const int row0 = meta ? NREAL : b * SEQ + c * 64;
        const int row = valid ? row0 + t : row0;
        int prow = -1;
        if (t > 0) prow = row - 1; else if (!meta) prow = (c == 0) ? NREAL + NMETA - 1 : row - 1;
        f32x16 y[2];
#pragma unroll
        for (int qv = 0; qv < 2; ++qv) {
            const bf16* Y0 = RWY + (size_t)u * 4096;
#pragma unroll
            for (int jj = 0; jj < 4; ++jj) { const v2u wv = *(const v2u*)(Y0 + acc_off(32 * th + r, 32 * qv + 8 * jj + 4 * hf)); y[qv][4 * jj] = bflo(wv.x); y[qv][4 * jj + 1] = bfhi(wv.x); y[qv][4 * jj + 2] = bflo(wv.y); y[qv][4 * jj + 3] = bfhi(wv.y); }
        }
        if (!meta) {
            const bf16* qp = RWQ + (size_t)u * 4096; const bf16* sp = RWS + (size_t)u * 4096;
#pragma unroll
            for (int ks = 0; ks < 4; ++ks) {
                const bf16x8 bq = *(const bf16x8*)(qp + frag_off(32 * th + r, 16 * ks + 8 * hf));
                y[0] = __builtin_amdgcn_mfma_f32_32x32x16_bf16(*(const bf16x8*)(sp + frag_off(r, 16 * ks + 8 * hf)), bq, y[0], 0, 0, 0);
                y[1] = __builtin_amdgcn_mfma_f32_32x32x16_bf16(*(const bf16x8*)(sp + frag_off(32 + r, 16 * ks + 8 * hf)), bq, y[1], 0, 0, 0);
            }
        }
        f32x16 g[2]; g[0] = zero16(); g[1] = zero16();
        {
            const bf16* gp = P + (size_t)row * PW + PC_GD + 8 * hf; const bf16* gpp = prow >= 0 ? P + (size_t)prow * PW + PC_GD + 8 * hf : nullptr;
            const bf16* wp = WgT + (size_t)(h * 64 + r) * 128 + 8 * hf;
#pragma unroll
            for (int ks = 0; ks < 8; ++ks) {
                const v4u cg = *(const v4u*)(gp + 16 * ks); const v4u pg = gpp ? *(const v4u*)(gpp + 16 * ks) : (v4u){0u, 0u, 0u, 0u};
                const f32x4 m0 = *(const f32x4*)(mu + 1664 + 16 * ks + 8 * hf), m1 = *(const f32x4*)(mu + 1664 + 16 * ks + 8 * hf + 4);
                const unsigned cw[4] = {cg.x, cg.y, cg.z, cg.w}, pw[4] = {pg.x, pg.y, pg.z, pg.w}; const float mm[8] = {m0.x, m0.y, m0.z, m0.w, m1.x, m1.y, m1.z, m1.w};
                unsigned o[4];
#pragma unroll
                for (int e = 0; e < 4; ++e) {
                    const float c0 = bflo(cw[e]), c1 = bfhi(cw[e]), p0 = bflo(pw[e]), p1 = bfhi(pw[e]);
                    o[e] = pk2(sigmoidf_(c0 + (p0 - c0) * mm[2 * e]), sigmoidf_(c1 + (p1 - c1) * mm[2 * e + 1]));
                }
                const v4u ov = (v4u){o[0], o[1], o[2], o[3]};
                const bf16x8 bs = __builtin_bit_cast(bf16x8, ov);
                g[0] = __builtin_amdgcn_mfma_f32_32x32x16_bf16(*(const bf16x8*)(wp + 16 * ks), bs, g[0], 0, 0, 0);
                g[1] = __builtin_amdgcn_mfma_f32_32x32x16_bf16(*(const bf16x8*)(wp + 32 * 128 + 16 * ks), bs, g[1], 0, 0, 0);
            }
        }
        float s = 0.f;
#pragma unroll
        for (int j = 0; j < 16; ++j) s += y[0][j] + y[1][j];
        s += __shfl_xor(s, 32);
        const float mean = s * (1.f / 64.f);
        float s2 = 0.f;
#pragma unroll
        for (int j = 0; j < 16; ++j) { const float d0 = y[0][j] - mean, d1 = y[1][j] - mean; s2 += d0 * d0 + d1 * d1; }
        s2 += __shfl_xor(s2, 32);
        const float rstd = 1.0f / sqrtf(s2 * (1.f / 64.f) + GN_EPS);
        const float bon = BONUS[(size_t)u * 64 + t];
        if (valid) {
#pragma unroll
            for (int qv = 0; qv < 2; ++qv)
#pragma unroll
                for (int jj = 0; jj < 4; ++jj) {
                    const int v0 = 32 * qv + 8 * jj + 4 * hf, chv = h * 64 + v0;
                    const v2u cvw = *(const v2u*)(P + (size_t)row * PW + PC_V + chv); const v2u pvw = prow >= 0 ? *(const v2u*)(P + (size_t)prow * PW + PC_V + chv) : (v2u){0u, 0u};
                    const f32x4 mv = *(const f32x4*)(mu + 1024 + chv), gg = *(const f32x4*)(F.in[IN_GN_G] + chv), gb = *(const f32x4*)(F.in[IN_GN_B] + chv);
                    const float cv[4] = {bflo(cvw.x), bfhi(cvw.x), bflo(cvw.y), bfhi(cvw.y)}, pv[4] = {bflo(pvw.x), bfhi(pvw.x), bflo(pvw.y), bfhi(pvw.y)};
                    const float mvv[4] = {mv.x, mv.y, mv.z, mv.w}, ggv[4] = {gg.x, gg.y, gg.z, gg.w}, gbv[4] = {gb.x, gb.y, gb.z, gb.w};
                    float o[4];
#pragma unroll
                    for (int e = 0; e < 4; ++e) {
                        const float vs = cv[e] + (pv[e] - cv[e]) * mvv[e];
                        o[e] = ((y[qv][4 * jj + e] - mean) * rstd * ggv[e] + gbv[e] + bon * vs) * g[qv][4 * jj + e];
                    }
                    *(v2u*)(QA + (size_t)row * QAW + 1024 + chv) = (v2u){pk2(o[0], o[1]), pk2(o[2], o[3])};
                }
        }
    }
}

constexpr int IX_CAP = 512, IX_LIST = 3072, IX_KB = 98304, IX_SCR = RING_BYTES + 4096;
#define IX_FENCE() asm volatile("s_waitcnt lgkmcnt(0)" ::: "memory")

__device__ __forceinline__ unsigned ix_mbcnt(unsigned long long m) { return __builtin_amdgcn_mbcnt_hi((unsigned)(m >> 32), __builtin_amdgcn_mbcnt_lo((unsigned)m, 0u)); }

__device__ __forceinline__ void ix_select_slow(const float (&sc)[8], const unsigned (&ix)[8], bool (&vl)[8], int K, unsigned short* sel_out, int lane) {
    for (int it = 0; it < K; ++it) {
        unsigned long long best = 0ull;
#pragma unroll
        for (int i = 0; i < 8; ++i) { const unsigned long long key = ((unsigned long long)sortable(sc[i]) << 32) | (unsigned long long)(0xFFFFu - ix[i]) | 0x10000ull; if (vl[i] && key > best) best = key; }
        unsigned long long wm = best;
#pragma unroll
        for (int o = 1; o < 64; o <<= 1) { const unsigned long long v = __shfl_xor(wm, o); wm = v > wm ? v : wm; }
        if (wm == 0ull) break;
        const bool mine = best == wm;
#pragma unroll
        for (int i = 0; i < 8; ++i) { const unsigned long long key = ((unsigned long long)sortable(sc[i]) << 32) | (unsigned long long)(0xFFFFu - ix[i]) | 0x10000ull; if (mine && vl[i] && key == wm) { vl[i] = false; sel_out[it] = (unsigned short)ix[i]; } }
    }
}

__device__ __forceinline__ void ix_compact(LAS float* LS, LAS unsigned short* LI, LAS unsigned* hist, int& cnt, float& tau, int lane, bool final_sel, unsigned short* sel_out) {
    const int n = cnt;
    float sc[8]; unsigned ix[8]; bool vl[8];
    IX_FENCE();
#pragma unroll
    for (int i = 0; i < 8; ++i) { const int p = lane + 64 * i; vl[i] = p < n; sc[i] = vl[i] ? LS[p] : -INFINITY; ix[i] = vl[i] ? (unsigned)LI[p] : 0u; }
    float mx = -INFINITY, mn = INFINITY;
#pragma unroll
    for (int i = 0; i < 8; ++i) { if (vl[i]) { mx = fmaxf(mx, sc[i]); mn = fminf(mn, sc[i]); } }
    mx = wave_max(mx); mn = -wave_max(-mn);
    const float scale = mx > mn ? 255.99f / (mx - mn) : 0.f;
    int bin[8];
#pragma unroll
    for (int i = 0; i < 8; ++i) { int bq = (int)((sc[i] - mn) * scale); bq = bq > 255 ? 255 : (bq < 0 ? 0 : bq); bin[i] = vl[i] ? bq : -1; }
    *(LAS v4u*)(hist + 4 * lane) = (v4u){0u, 0u, 0u, 0u};
    IX_FENCE();
#pragma unroll
    for (int i = 0; i < 8; ++i) if (vl[i]) __hip_atomic_fetch_add((LAS unsigned*)&hist[bin[i]], 1u, __ATOMIC_RELAXED, __HIP_MEMORY_SCOPE_WAVEFRONT);
    IX_FENCE();
    const v4u c = *(const LAS v4u*)(hist + 4 * lane);
    const unsigned Pp = wave_scan_incl(c.x + c.y + c.z + c.w, lane);
    const unsigned total = (unsigned)__builtin_amdgcn_readlane((int)Pp, 63);
    const unsigned K = TOPK;
    const unsigned a3 = total - Pp, a2 = a3 + c.w, a1 = a2 + c.z, a0 = a1 + c.y;
    int myb = -1; unsigned myA = 0u, myC = 0u;
    if (a3 < K && K <= a3 + c.w) { myb = 4 * lane + 3; myA = a3; myC = c.w; }
    else if (a2 < K && K <= a2 + c.z) { myb = 4 * lane + 2; myA = a2; myC = c.z; }
    else if (a1 < K && K <= a1 + c.y) { myb = 4 * lane + 1; myA = a1; myC = c.y; }
    else if (a0 < K && K <= a0 + c.x) { myb = 4 * lane; myA = a0; myC = c.x; }
    const unsigned long long bm = __ballot(myb >= 0);
    const int src = bm ? (__ffsll((long long)bm) - 1) : 0;
    const int bstar = __shfl(myb, src); const unsigned A = __shfl(myA, src), m = __shfl(myC, src);
    if (!final_sel) {
        if (A + m <= (unsigned)(IX_CAP - 128)) {
            int base = 0; float kmin = INFINITY;
#pragma unroll
            for (int i = 0; i < 8; ++i) {
                const bool keep = vl[i] && bin[i] >= bstar;
                const unsigned long long mk = __ballot(keep);
                const int pos = base + (int)ix_mbcnt(mk);
                if (keep) { LS[pos] = sc[i]; LI[pos] = (unsigned short)ix[i]; kmin = fminf(kmin, sc[i]); }
                base += __popcll(mk);
            }
            cnt = base; tau = -wave_max(-kmin);
            IX_FENCE();
            return;
        }
        unsigned short* tmp = sel_out;
        ix_select_slow(sc, ix, vl, (int)K, tmp, lane);
        int base = 0; float kmin = INFINITY;
#pragma unroll
        for (int i = 0; i < 8; ++i) {
            const bool keep = !vl[i] && (lane + 64 * i) < n;
            const unsigned long long mk = __ballot(keep);
            const int pos = base + (int)ix_mbcnt(mk);
            if (keep) { LS[pos] = sc[i]; LI[pos] = (unsigned short)ix[i]; kmin = fminf(kmin, sc[i]); }
            base += __popcll(mk);
        }
        cnt = base; tau = -wave_max(-kmin);
        IX_FENCE();
        return;
    }
    if (m <= 128u) {
        int base = 0;
#pragma unroll
        for (int i = 0; i < 8; ++i) {
            const bool keep = vl[i] && bin[i] > bstar;
            const unsigned long long mk = __ballot(keep);
            const int pos = base + (int)ix_mbcnt(mk);
            if (keep) sel_out[pos] = (unsigned short)ix[i];
            base += __popcll(mk);
        }
        LAS float* sS = (LAS float*)hist; LAS unsigned* sI = hist + 128;
        IX_FENCE();
        int mb = 0;
#pragma unroll
        for (int i = 0; i < 8; ++i) {
            const bool inb = vl[i] && bin[i] == bstar;
            const unsigned long long mk = __ballot(inb);
            const int pos = mb + (int)ix_mbcnt(mk);
            if (inb) { sS[pos] = sc[i]; sI[pos] = ix[i]; }
            mb += __popcll(mk);
        }
        IX_FENCE();
        const int need = (int)(K - A);
#pragma unroll
        for (int e = 0; e < 2; ++e) {
            const int j = lane + 64 * e;
            if (j < (int)m) {
                const float sj = sS[j]; const unsigned ij = sI[j]; int rank = 0;
                for (int k = 0; k < (int)m; ++k) { const float sk = sS[k]; const unsigned ik = sI[k]; rank += (sk > sj || (sk == sj && ik < ij)) ? 1 : 0; }
                if (rank < need) sel_out[(int)A + rank] = (unsigned short)ij;
            }
        }
    } else {
        ix_select_slow(sc, ix, vl, (int)K, sel_out, lane);
    }
}

__device__ __forceinline__ void p6_attn_mfma(Frame& F, bf16* OUTB, bool meta_only);
__device__ __forceinline__ void p5_index_mfma(Frame& F, unsigned short* SEL, int* NSEL, int qword = 3072, bool probe_noappend = false, bool do_meta = false) {
    const bf16* QA = WSP(bf16, WS_QA); const bf16* KIDX = WSP(bf16, WS_KIDX); const float* WIDX = WSP(float, WS_WIDX);
    const int tid = F.tid, w = F.wave, l = F.lane, r = l & 31, hf = l >> 5;
    {
        const int gw = blockIdx.x * NWAVES + w, NGW = F.G * NWAVES;
        for (int i = gw; i < NMETA + BATCH * 192; i += NGW) {
            int q, nvis; if (i < NMETA) { q = NREAL + i; nvis = NMETA; } else { const int bb = (i - NMETA) / 192, s = (i - NMETA) % 192; q = bb * SEQ + s; nvis = NMETA + 64 * (s / 64 + 1); }
            for (int j = l; j < nvis; j += 64) SEL[(size_t)q * TOPK + j] = (unsigned short)j;
            if (l == 0) NSEL[q] = nvis;
        }
    }
    LAS unsigned char* L = F.lds;
    LAS unsigned* hist = (LAS unsigned*)(L + IX_SCR + w * 1024);
    if (do_meta) {
        __syncthreads();
        if (tid == 0) F.MISC[17] = __hip_atomic_fetch_add((unsigned*)F.ctl + 3200, 1u, __ATOMIC_RELAXED, __HIP_MEMORY_SCOPE_AGENT);
        __syncthreads();
        const int mt = (int)F.MISC[17];
        if (mt == 0) {
            if (tid < NMETA) { for (int j = 0; j < NMETA; ++j) SEL[(size_t)(NREAL + tid) * TOPK + j] = (unsigned short)j; NSEL[NREAL + tid] = NMETA; }
            asm volatile("s_waitcnt vmcnt(0)" ::: "memory"); __syncthreads();
            p6_attn_mfma(F, WSP(bf16, WS_QA), true);
        } else if (mt == 1) { rw_b3(F, true); }
        __syncthreads();
    }
    {
        for (;;) {
            __syncthreads();
            if (tid == 0) F.MISC[16] = __hip_atomic_fetch_add((unsigned*)F.ctl + qword, 1u, __ATOMIC_RELAXED, __HIP_MEMORY_SCOPE_AGENT);
            __syncthreads();
            const int qi_ = (int)F.MISC[16];
            if (qi_ >= 1000) break;
            const int tile = 999 - qi_;
            const int pt = 6 + (tile >> 2), b = tile & 3;
            const int q0 = b * SEQ + pt * 32;
            const int nvis = NMETA + 64 * (pt / 2 + 1);
            __syncthreads();
            bf16x8 af[4];
            {
                const int qq = 2 * (r >> 4) + ((r >> 2) & 1), hd = 4 * ((r >> 3) & 1) + (r & 3);
                const bf16* qp = QA + (size_t)(q0 + 4 * w + qq) * QAW + 1024 + hd * 64 + 8 * hf;
#pragma unroll
                for (int ks = 0; ks < 4; ++ks) af[ks] = *(const bf16x8*)(qp + 16 * ks);
            }
            float wq[2][8];
#pragma unroll
            for (int a = 0; a < 2; ++a) {
                const f32x4 w0 = *(const f32x4*)(WIDX + (size_t)(q0 + 4 * w + 2 * a + hf) * 8), w1 = *(const f32x4*)(WIDX + (size_t)(q0 + 4 * w + 2 * a + hf) * 8 + 4);
                wq[a][0] = 0.5f * w0.x; wq[a][1] = 0.5f * w0.y; wq[a][2] = 0.5f * w0.z; wq[a][3] = 0.5f * w0.w; wq[a][4] = 0.5f * w1.x; wq[a][5] = 0.5f * w1.y; wq[a][6] = 0.5f * w1.z; wq[a][7] = 0.5f * w1.w;
            }
            float tau0 = -INFINITY, tau1 = -INFINITY;
            int cnt[4] = {0, 0, 0, 0};
            const int nblk = (nvis + 255) >> 8;
            v4u kreg[4];
#pragma unroll
            for (int e = 0; e < 4; ++e) {
                const int pid = tid + 512 * e, kl = pid >> 3, pc = pid & 7, j = kl;
                kreg[e] = j < nvis ? *(const v4u*)(KIDX + (size_t)key_row(b, j) * 64 + 8 * pc) : (v4u){0u, 0u, 0u, 0u};
            }
#pragma unroll
            for (int e = 0; e < 4; ++e) { const int pid = tid + 512 * e, kl = pid >> 3, pc = pid & 7; *(LAS v4u*)(L + IX_KB + kl * 128 + ((pc ^ ((kl >> 1) & 7)) << 4)) = kreg[e]; }
            __syncthreads();
            const LAS unsigned char* kb = L + IX_KB;
            for (int blk = 0; blk < nblk; ++blk) {
                if (blk + 1 < nblk) {
#pragma unroll
                    for (int e = 0; e < 4; ++e) {
                        const int pid = tid + 512 * e, kl = pid >> 3, pc = pid & 7, j = (blk + 1) * 256 + kl;
                        kreg[e] = j < nvis ? *(const v4u*)(KIDX + (size_t)key_row(b, j) * 64 + 8 * pc) : (v4u){0u, 0u, 0u, 0u};
                    }
                }
                int npair = (nvis - blk * 256 + 63) >> 6; npair = npair > 4 ? 4 : npair;
                bf16x8 bc0[4], bc1[4];
#pragma unroll
                for (int ks = 0; ks < 4; ++ks) { const int k0 = r, k1 = 32 + r;
                    bc0[ks] = *(const LAS bf16x8*)(kb + k0 * 128 + (((2 * ks + hf) ^ ((k0 >> 1) & 7)) << 4));
                    bc1[ks] = *(const LAS bf16x8*)(kb + k1 * 128 + (((2 * ks + hf) ^ ((k1 >> 1) & 7)) << 4)); }
                for (int pp = 0; pp < npair; ++pp) {
                    const int jbase = blk * 256 + pp * 64;
                    bf16x8 bn0[4], bn1[4];
                    {
                        const int pn = pp + 1 < npair ? pp + 1 : pp; const int k0 = pn * 64 + r, k1 = k0 + 32;
#pragma unroll
                        for (int ks = 0; ks < 4; ++ks) {
                            bn0[ks] = *(const LAS bf16x8*)(kb + k0 * 128 + (((2 * ks + hf) ^ ((k0 >> 1) & 7)) << 4));
                            bn1[ks] = *(const LAS bf16x8*)(kb + k1 * 128 + (((2 * ks + hf) ^ ((k1 >> 1) & 7)) << 4)); }
                    }
                    f32x16 accA = zero16(), accB = zero16();
#pragma unroll
                    for (int ks = 0; ks < 4; ++ks) { accA = __builtin_amdgcn_mfma_f32_32x32x16_bf16(af[ks], bc0[ks], accA, 0, 0, 0); accB = __builtin_amdgcn_mfma_f32_32x32x16_bf16(af[ks], bc1[ks], accB, 0, 0, 0); }
#pragma unroll
                    for (int ks = 0; ks < 4; ++ks) { bc0[ks] = bn0[ks]; bc1[ks] = bn1[ks]; }
                    float sA0 = 0.f, sA0b = 0.f, sA1 = 0.f, sA1b = 0.f, sB0 = 0.f, sB0b = 0.f, sB1 = 0.f, sB1b = 0.f;
#pragma unroll
                    for (int h = 0; h < 8; h += 2) {
                        sA0 = fmaf(wq[0][h], __builtin_fabsf(accA[h]), fmaf(wq[0][h], accA[h], sA0)); sA0b = fmaf(wq[0][h + 1], __builtin_fabsf(accA[h + 1]), fmaf(wq[0][h + 1], accA[h + 1], sA0b));
                        sA1 = fmaf(wq[1][h], __builtin_fabsf(accA[8 + h]), fmaf(wq[1][h], accA[8 + h], sA1)); sA1b = fmaf(wq[1][h + 1], __builtin_fabsf(accA[9 + h]), fmaf(wq[1][h + 1], accA[9 + h], sA1b));
                        sB0 = fmaf(wq[0][h], __builtin_fabsf(accB[h]), fmaf(wq[0][h], accB[h], sB0)); sB0b = fmaf(wq[0][h + 1], __builtin_fabsf(accB[h + 1]), fmaf(wq[0][h + 1], accB[h + 1], sB0b));
                        sB1 = fmaf(wq[1][h], __builtin_fabsf(accB[8 + h]), fmaf(wq[1][h], accB[8 + h], sB1)); sB1b = fmaf(wq[1][h + 1], __builtin_fabsf(accB[9 + h]), fmaf(wq[1][h + 1], accB[9 + h], sB1b));
                    }
                    const float s0A = (sA0 + sA0b) + 0.0f, s1A = (sA1 + sA1b) + 0.0f, s0B = (sB0 + sB0b) + 0.0f, s1B = (sB1 + sB1b) + 0.0f;
                    const int jA = jbase + r, jB = jA + 32;
                    const bool p0A = jA < nvis && s0A > tau0, p1A = jA < nvis && s1A > tau1, p0B = jB < nvis && s0B > tau0, p1B = jB < nvis && s1B > tau1;
                    const unsigned long long m0A = __ballot(p0A), m1A = __ballot(p1A), m0B = __ballot(p0B), m1B = __ballot(p1B);
                    if (m0A | m1A | m0B | m1B) {
                        const int a0lo = __popc((unsigned)m0A), a0hi = __popc((unsigned)(m0A >> 32)), a1lo = __popc((unsigned)m1A), a1hi = __popc((unsigned)(m1A >> 32));
                        const int b0lo = __popc((unsigned)m0B), b0hi = __popc((unsigned)(m0B >> 32)), b1lo = __popc((unsigned)m1B), b1hi = __popc((unsigned)(m1B >> 32));
                        {
                            LAS unsigned char* lb = L + (w * 4 + hf) * IX_LIST;
                            const int base = hf ? cnt[1] : cnt[0];
                            const int posA = base + (int)ix_mbcnt(m0A) - (hf ? a0lo : 0);
                            const int posB = base + (hf ? a0hi : a0lo) + (int)ix_mbcnt(m0B) - (hf ? b0lo : 0);
                            if (p0A) { ((LAS float*)lb)[posA] = s0A; ((LAS unsigned short*)(lb + 2048))[posA] = (unsigned short)jA; }
                            if (p0B) { ((LAS float*)lb)[posB] = s0B; ((LAS unsigned short*)(lb + 2048))[posB] = (unsigned short)jB; }
                        }
                        {
                            LAS unsigned char* lb = L + (w * 4 + 2 + hf) * IX_LIST;
                            const int base = hf ? cnt[3] : cnt[2];
                            const int posA = base + (int)ix_mbcnt(m1A) - (hf ? a1lo : 0);
                            const int posB = base + (hf ? a1hi : a1lo) + (int)ix_mbcnt(m1B) - (hf ? b1lo : 0);
                            if (p1A) { ((LAS float*)lb)[posA] = s1A; ((LAS unsigned short*)(lb + 2048))[posA] = (unsigned short)jA; }
                            if (p1B) { ((LAS float*)lb)[posB] = s1B; ((LAS unsigned short*)(lb + 2048))[posB] = (unsigned short)jB; }
                        }
                        cnt[0] += a0lo + b0lo; cnt[1] += a0hi + b0hi; cnt[2] += a1lo + b1lo; cnt[3] += a1hi + b1hi;
                        if (probe_noappend) { if (cnt[0] >= 256 && hf == 0) tau0 = INFINITY; if (cnt[1] >= 256 && hf == 1) tau0 = INFINITY; if (cnt[2] >= 256 && hf == 0) tau1 = INFINITY; if (cnt[3] >= 256 && hf == 1) tau1 = INFINITY; }
#pragma unroll
                        for (int qq = 0; qq < 4; ++qq) {
                            if (cnt[qq] > IX_CAP - 64) {
                                LAS unsigned char* lb = L + (w * 4 + qq) * IX_LIST;
                                float tq = 0.f; int cq = cnt[qq];
                                ix_compact((LAS float*)lb, (LAS unsigned short*)(lb + 2048), hist, cq, tq, l, false, SEL + (size_t)(q0 + 4 * w + qq) * TOPK);
                                cnt[qq] = __builtin_amdgcn_readfirstlane(cq);
                                if ((qq & 1) == hf) { if (qq < 2) tau0 = tq; else tau1 = tq; }
                            }
                        }
                    }
                }
                __syncthreads();
                if (blk + 1 < nblk) {
#pragma unroll
                    for (int e = 0; e < 4; ++e) { const int pid = tid + 512 * e, kl = pid >> 3, pc = pid & 7; *(LAS v4u*)(L + IX_KB + kl * 128 + ((pc ^ ((kl >> 1) & 7)) << 4)) = kreg[e]; }
                    __syncthreads();
                }
            }
#pragma unroll
            for (int qq = 0; qq < 4; ++qq) {
                LAS unsigned char* lb = L + (w * 4 + qq) * IX_LIST;
                float tq = 0.f; int cq = cnt[qq];
                ix_compact((LAS float*)lb, (LAS unsigned short*)(lb + 2048), hist, cq, tq, l, true, SEL + (size_t)(q0 + 4 * w + qq) * TOPK);
                if (l == 0) NSEL[q0 + 4 * w + qq] = TOPK;
            }
        }
    }
}

#ifndef CHECK_IDX
#define CHECK_IDX 0
#endif
#if CHECK_IDX
__device__ __forceinline__ void idx_check(Frame& F) {
    const unsigned short* SEL = WSP(unsigned short, WS_SEL); const unsigned short* SELB = (const unsigned short*)F.out; const int* NSEL = WSP(int, WS_NSEL); const int* NSELB = (const int*)((const char*)F.out + 32 * MiB);
    LAS unsigned* bm = (LAS unsigned*)(F.lds + F.wave * 2048);
    const int l = F.lane; const int gw = blockIdx.x * NWAVES + F.wave, NGW = F.G * NWAVES;
    unsigned miss = 0, badq = 0, dup = 0;
    for (int q = gw; q < NROWS; q += NGW) {
        for (int i = l; i < 260; i += 64) bm[i] = 0u;
        IX_FENCE();
        const int n = NSEL[q], nb = NSELB[q];
        for (int i = l; i < n; i += 64) { const unsigned j = SEL[(size_t)q * TOPK + i]; atomicOr((unsigned*)&bm[j >> 5], 1u << (j & 31)); }
        IX_FENCE();
        unsigned m = (n != nb) ? 1000u : 0u;
        for (int i = l; i < nb && i < TOPK; i += 64) { const unsigned j = SELB[(size_t)q * TOPK + i]; if (j >= (unsigned)TT) { ++dup; ++m; } else { const unsigned old = atomicAnd((unsigned*)&bm[j >> 5], ~(1u << (j & 31))); if (!((old >> (j & 31)) & 1u)) ++m; } }
        IX_FENCE();
        m = (unsigned)wave_sum((float)m);
        if (l == 0) { miss += m; badq += m ? 1u : 0u; }
    }
    dup = (unsigned)wave_sum((float)dup);
    if (l == 0) { atomicAdd((unsigned*)F.ctl + 2048, miss); atomicAdd((unsigned*)F.ctl + 2049, badq); atomicAdd((unsigned*)F.ctl + 2050, dup); }
}
#endif

typedef short v4i16_t __attribute__((ext_vector_type(4)));
__device__ __forceinline__ unsigned at_off(unsigned row, unsigned ch) { return 256u * row + 16u * (ch ^ (((row & 3u) << 2) | ((row >> 2) & 3u))); }

__device__ __forceinline__ void p6_attn_mfma(Frame& F, bf16* OUTB, bool meta_only = false) {
    bf16* QA = WSP(bf16, WS_QA); const bf16* CKV = WSP(bf16, WS_CKV); const unsigned short* SEL = WSP(unsigned short, WS_SEL); const int* NSEL = WSP(int, WS_NSEL);
    const int l = F.lane, w = F.wave, h16 = l & 15, g = l >> 4;
    LAS unsigned char* tile = F.lds + w * 8192;
    LAS unsigned short* selb = (LAS unsigned short*)(F.lds + 65536 + w * 512);
    const float slope = h16 < 8 ? __uint_as_float((unsigned)(127 - (h16 + 1)) << 23) : 0.f;
    if (!meta_only) {
        const int gw = blockIdx.x * NWAVES + w, NGW = F.G * NWAVES;
        for (int q = NROWS + gw; q < R; q += NGW) { bf16* qrow = QA + (size_t)q * QAW; for (int c = l; c < QAW / 8; c += 64) *(v4u*)(qrow + 8 * c) = (v4u){0u, 0u, 0u, 0u}; }
    }
    if (meta_only) { }
    const int G = F.G;
    int nq_tot, qbase_b, wib, wpb;
    if ((G & 7) == 0) { const int b = (blockIdx.x & 7) >> 1; qbase_b = b * SEQ; nq_tot = SEQ; wib = (((blockIdx.x >> 3) * 2) + (blockIdx.x & 1)) * NWAVES + w; wpb = (G / 4) * NWAVES; }
    else { qbase_b = 0; nq_tot = NREAL; wib = blockIdx.x * NWAVES + w; wpb = G * NWAVES; }
    if (meta_only) { qbase_b = NREAL; nq_tot = NMETA; wib = w; wpb = NWAVES; }
    for (int qi = wib; qi < nq_tot; qi += wpb) {
        int q, b, pos;
        if (meta_only) { q = NREAL + qi; b = 0; pos = qi; }
        else if ((G & 7) == 0) { q = qbase_b + qi; b = q >> 13; pos = NMETA + qi; }
        else { q = qi; b = q >> 13; pos = NMETA + (q & (SEQ - 1)); }
        bf16* qrow = QA + (size_t)q * QAW;
        const int nsel = NSEL[q];
        const int nch = (nsel + 31) >> 5;
        const unsigned short* selq = SEL + (size_t)q * TOPK;
        IX_FENCE();
        if (l < 32) *(LAS v4u*)(selb + 8 * l) = *(const v4u*)(selq + 8 * l);
        IX_FENCE();
        bf16x8 qf[4];
#pragma unroll
        for (int s = 0; s < 4; ++s) { const v4u t = h16 < 8 ? *(const v4u*)(qrow + h16 * 128 + 32 * s + 8 * g) : (v4u){0u, 0u, 0u, 0u}; qf[s] = __builtin_bit_cast(bf16x8, t); }
        float m = -INFINITY, lsum = 0.f;
        f32x4 O[8];
#pragma unroll
        for (int c = 0; c < 8; ++c) O[c] = (f32x4){0.f, 0.f, 0.f, 0.f};
        v4u gr[8];
#pragma unroll
        for (int i = 0; i < 8; ++i) { const int s = g + 4 * i; const int kj = s < nsel ? (int)selb[s] : (int)selb[0]; gr[i] = *(const v4u*)(CKV + (size_t)key_row(b, kj) * 128 + 8 * h16); }
        for (int ck = 0; ck < nch; ++ck) {
            IX_FENCE();
#pragma unroll
            for (int i = 0; i < 8; ++i) *(LAS v4u*)(tile + at_off((unsigned)(g + 4 * i), (unsigned)h16)) = gr[i];
            const v4u kv = *(const LAS v4u*)(selb + 32 * ck + 8 * g);
            if (ck + 1 < nch) {
#pragma unroll
                for (int i = 0; i < 8; ++i) { const int s = 32 * (ck + 1) + g + 4 * i; const int kj = s < nsel ? (int)selb[s] : (int)selb[0]; gr[i] = *(const v4u*)(CKV + (size_t)key_row(b, kj) * 128 + 8 * h16); }
            }
            IX_FENCE();
            f32x4 a0 = (f32x4){0.f, 0.f, 0.f, 0.f}, a1 = a0;
#pragma unroll
            for (int s = 0; s < 4; ++s) {
                const bf16x8 k0 = *(const LAS bf16x8*)(tile + at_off((unsigned)(8 * (h16 >> 2) + (h16 & 3)), (unsigned)(4 * s + g)));
                const bf16x8 k1 = *(const LAS bf16x8*)(tile + at_off((unsigned)(8 * (h16 >> 2) + 4 + (h16 & 3)), (unsigned)(4 * s + g)));
                a0 = __builtin_amdgcn_mfma_f32_16x16x32_bf16(k0, qf[s], a0, 0, 0, 0);
                a1 = __builtin_amdgcn_mfma_f32_16x16x32_bf16(k1, qf[s], a1, 0, 0, 0);
            }
            const unsigned kw[4] = {kv.x, kv.y, kv.z, kv.w};
            float x[8];
#pragma unroll
            for (int j = 0; j < 8; ++j) {
                const int kj = (int)((kw[j >> 1] >> (16 * (j & 1))) & 0xffffu);
                const float lg = (j < 4 ? a0[j & 3] : a1[j & 3]) - slope * fabsf((float)(pos - kj));
                x[j] = (32 * ck + 8 * g + j) < nsel ? lg : -INFINITY;
            }
            float cm = fmaxf(fmaxf(fmaxf(x[0], x[1]), fmaxf(x[2], x[3])), fmaxf(fmaxf(x[4], x[5]), fmaxf(x[6], x[7])));
            cm = fmaxf(cm, __shfl_xor(cm, 16)); cm = fmaxf(cm, __shfl_xor(cm, 32));
            const float mn = fmaxf(m, cm);
            const float alpha = __expf(m - mn);
            float p[8], ps = 0.f;
#pragma unroll
            for (int j = 0; j < 8; ++j) { p[j] = __expf(x[j] - mn); ps += p[j]; }
            ps += __shfl_xor(ps, 16); ps += __shfl_xor(ps, 32);
            lsum = lsum * alpha + ps; m = mn;
            if (__any(alpha != 1.0f)) {
#pragma unroll
                for (int rr = 0; rr < 4; ++rr) { const float sc = __shfl(alpha, 4 * g + rr);
#pragma unroll
                    for (int c = 0; c < 8; ++c) O[c][rr] *= sc; }
            }
            const v4u pw = (v4u){pk2(p[0], p[1]), pk2(p[2], p[3]), pk2(p[4], p[5]), pk2(p[6], p[7])};
            const bf16x8 pf = __builtin_bit_cast(bf16x8, pw);
#pragma unroll
            for (int c = 0; c < 8; ++c) {
                const unsigned qd = (unsigned)(h16 >> 2), pp = (unsigned)(h16 & 3);
                const v4i16_t t0 = __builtin_amdgcn_ds_read_tr16_b64_v4i16((LAS v4i16_t*)(tile + at_off(8u * g + qd, 2u * c + (pp >> 1)) + 8u * (pp & 1u)));
                const v4i16_t t1 = __builtin_amdgcn_ds_read_tr16_b64_v4i16((LAS v4i16_t*)(tile + at_off(8u * g + 4u + qd, 2u * c + (pp >> 1)) + 8u * (pp & 1u)));
                bf16x8 vf; vf[0] = t0[0]; vf[1] = t0[1]; vf[2] = t0[2]; vf[3] = t0[3]; vf[4] = t1[0]; vf[5] = t1[1]; vf[6] = t1[2]; vf[7] = t1[3];
                O[c] = __builtin_amdgcn_mfma_f32_16x16x32_bf16(pf, vf, O[c], 0, 0, 0);
            }
        }
        const float inv = 1.0f / lsum;
#pragma unroll
        for (int rr = 0; rr < 4; ++rr) {
            const float sc = __shfl(inv, 4 * g + rr);
            if (g < 2) {
#pragma unroll
                for (int c = 0; c < 8; ++c) (OUTB + (size_t)q * QAW)[(4 * g + rr) * 128 + 16 * c + h16] = (bf16)f2bf(O[c][rr] * sc);
            }
        }
    }
}
struct StoreBf16 { bf16* O; int ld;
    __device__ __forceinline__ void operator()(int row, int col, const f32x4& v) const { *(v2u*)(O + (size_t)row * ld + col) = (v2u){pk2(v.x, v.y), pk2(v.z, v.w)}; }
    __device__ __forceinline__ void two(int row, int col, const f32x4& a, const f32x4& b) const { *(v4u*)(O + (size_t)row * ld + col) = (v4u){pk2(a.x, a.y), pk2(a.z, a.w), pk2(b.x, b.y), pk2(b.z, b.w)}; }
    __device__ __forceinline__ void one(int row, int col, float v) const { O[(size_t)row * ld + col] = (bf16)f2bf(v); } };
struct StoreRes1 { const bf16* H; float* out; float* meta;
    __device__ __forceinline__ void operator()(int row, int col, const f32x4& v) const {
        if (row >= NROWS) return;
        const v2u hw = *(const v2u*)(H + (size_t)row * D + col);
        const f32x4 o = (f32x4){ALPHA * bflo(hw.x) + v.x, ALPHA * bfhi(hw.x) + v.y, ALPHA * bflo(hw.y) + v.z, ALPHA * bfhi(hw.y) + v.w};
        float* dst = row < NREAL ? out + (size_t)row * D + col : meta + (size_t)(row - NREAL) * D + col;
        *(f32x4*)dst = o; }
    __device__ __forceinline__ void two(int row, int col, const f32x4& a, const f32x4& b) const {
        const v4u hw = *(const v4u*)(H + (size_t)row * D + col);
        float* dst = out + (size_t)row * D + col;
        *(f32x4*)dst = (f32x4){ALPHA * bflo(hw.x) + a.x, ALPHA * bfhi(hw.x) + a.y, ALPHA * bflo(hw.y) + a.z, ALPHA * bfhi(hw.y) + a.w};
        *(f32x4*)(dst + 4) = (f32x4){ALPHA * bflo(hw.z) + b.x, ALPHA * bfhi(hw.z) + b.y, ALPHA * bflo(hw.w) + b.z, ALPHA * bfhi(hw.w) + b.w}; }
    __device__ __forceinline__ void one(int row, int col, float v) const { if (row >= NROWS) return; float* dst = row < NREAL ? out + (size_t)row * D + col : meta + (size_t)(row - NREAL) * D + col; *dst = ALPHA * bf2f(H[(size_t)row * D + col]) + v; } };
struct StoreRes2 { const bf16* H; float* out;
    __device__ __forceinline__ void two(int row, int col, const f32x4& a, const f32x4& b) const {
        const v4u hw = *(const v4u*)(H + (size_t)row * D + col);
        float* dst = out + (size_t)row * D + col;
        *(f32x4*)dst = (f32x4){ALPHA * bflo(hw.x) + a.x, ALPHA * bfhi(hw.x) + a.y, ALPHA * bflo(hw.y) + a.z, ALPHA * bfhi(hw.y) + a.w};
        *(f32x4*)(dst + 4) = (f32x4){ALPHA * bflo(hw.z) + b.x, ALPHA * bfhi(hw.z) + b.y, ALPHA * bflo(hw.w) + b.z, ALPHA * bfhi(hw.w) + b.w}; }
    __device__ __forceinline__ void operator()(int row, int col, const f32x4& v) const {
        if (row >= NREAL) return;
        const v2u hw = *(const v2u*)(H + (size_t)row * D + col);
        *(f32x4*)(out + (size_t)row * D + col) = (f32x4){ALPHA * bflo(hw.x) + v.x, ALPHA * bfhi(hw.x) + v.y, ALPHA * bflo(hw.y) + v.z, ALPHA * bfhi(hw.y) + v.w}; } };

struct StoreMetaGate { float* GM; __device__ __forceinline__ void one(int row, int col, float v) const { const int m = row - NREAL, x = col & 255; if (m >= 14 && x < 128) GM[(size_t)(m - 14) * DFF + 128 * (col >> 8) + x] = v; } };
template <class Fn>
__device__ __forceinline__ void meta_gemm(Frame& F, const bf16* A, int lda, const bf16* Bt, int N, int K, const Fn& fn) {
    const int l = F.lane, i16 = l & 15, g = l >> 4;
    const int gw = blockIdx.x * NWAVES + F.wave, NGW = F.G * NWAVES;
    for (int t = gw; t < N / 16; t += NGW) {
        const bf16* ap = A + (size_t)(NREAL + i16) * lda + 8 * g; const bf16* bp = Bt + (size_t)(16 * t + i16) * K + 8 * g;
        f32x4 acc = (f32x4){0.f, 0.f, 0.f, 0.f};
#pragma unroll 8
        for (int s = 0; s < K / 32; ++s) acc = __builtin_amdgcn_mfma_f32_16x16x32_bf16(*(const pg8::bf16x8*)(ap + 32 * s), *(const pg8::bf16x8*)(bp + 32 * s), acc, 0, 0, 0);
#pragma unroll
        for (int rr = 0; rr < 4; ++rr) fn.one(NREAL + 4 * g + rr, 16 * t + i16, acc[rr]);
    }
}

template <class Fn>
__device__ __forceinline__ void run_gemm(Frame& F, const bf16* A, int lda, const bf16* Bt, int N, int K, const Fn& fn) {
    pg8::Gemm g{A, Bt, NREAL, N, K, lda}; pg8::StaticOrder S; S.init(NREAL, N, F.G, (int)blockIdx.x);
    pg8::EpiFn<Fn> E{fn};
    pg8::gemm_phase<pg8::EpiFn<Fn>, pg8::StaticOrder, true, true>(F.lds + RING_OFF, g, S, E);
}

template <class Fn>
__device__ __forceinline__ void run_gemm8(Frame& F, const bf16* A, int lda, const bf16* Bt, int N, int K, const Fn& fn) {
    pg8::Gemm g{A, Bt, NREAL, N, K, lda}; pg8::StaticOrder S; S.init(NREAL, N, F.G, (int)blockIdx.x);
    pg8::EpiFn8<Fn> E{fn};
    pg8::gemm_phase<pg8::EpiFn8<Fn>, pg8::StaticOrder, true, true>(F.lds + RING_OFF, g, S, E);
}

constexpr int NPHASES = 13;
struct Args { const float* in[32]; float* out; unsigned char* ws; int ph_lo, ph_hi; };
__global__ void __launch_bounds__(NTHR, 2) fwd(Args args) {
    extern __shared__ __attribute__((aligned(16))) unsigned char lds[];
    Frame F;
    F.lds = (LAS unsigned char*)lds;
    F.MISC = (volatile LAS unsigned*)(F.lds + MISC_OFF);
    F.tid = threadIdx.x; F.lane = F.tid & 63; F.wave = __builtin_amdgcn_readfirstlane(F.tid >> 6);
    F.G = gridDim.x;
#pragma unroll
    for (int i = 0; i < 32; ++i) F.in[i] = args.in[i];
    F.out = args.out; F.ws = args.ws;
    F.ctl = (gu32*)(args.ws + WS_CTL);
    for (int u = F.tid; u < (LDS_BYTES - LDSCTL_OFF) / 4; u += NTHR) ((LAS unsigned*)(F.lds + LDSCTL_OFF))[u] = 0u;
    __syncthreads();
    const int lo = args.ph_lo, hi = args.ph_hi;
    XcdBarrier bar; bar.bar = (unsigned*)(F.ctl + CW_BAR); bar.x = 0; bar.st = nullptr;
    if (hi - lo > 1) bar = xcd_barrier_post((unsigned*)(F.ctl + CW_BAR), F.MISC + 8);
#define IN(k) (lo <= (k) && (k) < hi)
#ifdef PROBE_PHASE_T
    unsigned long long tp_prev = __builtin_amdgcn_s_memrealtime(), tp_dur = 0ull;
#define SEAM(k) do { if (IN(k) && IN((k) + 1)) xcd_barrier(bar); if (blockIdx.x == 0 && F.tid == 0) { const unsigned long long t_ = __builtin_amdgcn_s_memrealtime(); if ((k) == PROBE_PHASE_T) tp_dur = t_ - tp_prev; tp_prev = t_; } } while (0)
#else
#define SEAM(k) do { if (IN(k) && IN((k) + 1)) xcd_barrier(bar); } while (0)
#endif
#ifndef PROBE_PH
#define PROBE_PH -1
#endif
#define REP(k) for (int rep_ = 0; rep_ < ((PROBE_PH == (k)) ? 2 : 1); ++rep_)

#ifndef IDX_NAIVE
#define IDX_NAIVE 0
#endif
#ifndef ATTN_NAIVE
#define ATTN_NAIVE 0
#endif
    if (IN(0)) REP(0) { if (rep_) __syncthreads(); p0_weights(F); p1_ln_in(F); } SEAM(0);
    if (IN(1)) REP(1) { if (rep_) __syncthreads(); run_gemm8(F, WSP(bf16, WS_H), D, WSP(bf16, WS_WT_IN), PW, D, StoreBf16{WSP(bf16, WS_P), PW}); meta_gemm(F, WSP(bf16, WS_H), D, WSP(bf16, WS_WT_IN), PW, D, StoreBf16{WSP(bf16, WS_P), PW}); } SEAM(1);
    if (IN(2)) REP(2) { if (rep_) __syncthreads(); p3_prep(F); } SEAM(2);
    if (IN(3)) REP(3) { if (rep_) __syncthreads(); run_gemm8(F, WSP(bf16, WS_CQN), 256, WSP(bf16, WS_WT_QA), QAW, 256, StoreBf16{WSP(bf16, WS_QA), QAW}); meta_gemm(F, WSP(bf16, WS_CQN), 256, WSP(bf16, WS_WT_QA), QAW, 256, StoreBf16{WSP(bf16, WS_QA), QAW});
#if REFSEL
        refsel_rows(F);
#endif
    } SEAM(3);
    if (IN(4)) REP(4) { if (rep_) __syncthreads(); rw_b1(F); } SEAM(4);
    if (IN(5)) {
        rw_b2(F); __syncthreads();
#if CHECK_IDX
        p5_index_naive(F); __syncthreads(); p5_index_mfma(F, (unsigned short*)F.out, (int*)((char*)F.out + 32 * MiB));
#elif IDX_NAIVE
        p5_index_naive(F);
#else
        p5_index_mfma(F, WSP(unsigned short, WS_SEL), WSP(int, WS_NSEL), 3072, false, true);
#ifdef PROBE_IDX
        __syncthreads(); p5_index_mfma(F, WSP(unsigned short, WS_SEL), WSP(int, WS_NSEL), 3136);
#endif
#ifdef PROBE_IDX_SCORE
        __syncthreads(); p5_index_mfma(F, (unsigned short*)F.out, (int*)((char*)F.out + 32 * MiB), 3136, true);
#endif
#endif
    } SEAM(5);
    if (IN(6)) {
#if CHECK_IDX
        idx_check(F); __syncthreads();
#endif
#if CHECK_IDX || IDX_NAIVE
        if (blockIdx.x == 0) { p6_attn_mfma(F, WSP(bf16, WS_QA), true); __syncthreads(); }
        if (blockIdx.x == 1) { rw_b3(F, true); __syncthreads(); }
#endif
#if ATTN_NAIVE
        p6_attn_naive(F);
#else
        p6_attn_mfma(F, WSP(bf16, WS_QA));
#endif
        __syncthreads();
        rw_b3(F);
    } SEAM(6);
    if (IN(7)) REP(7) { if (rep_) __syncthreads(); run_gemm8(F, WSP(bf16, WS_QA), QAW, WSP(bf16, WS_WT_MIX), D, QAW, StoreRes1{WSP(bf16, WS_H), F.out, WSP(float, WS_META1)}); meta_gemm(F, WSP(bf16, WS_QA), QAW, WSP(bf16, WS_WT_MIX), D, QAW, StoreRes1{WSP(bf16, WS_H), F.out, WSP(float, WS_META1)}); } SEAM(7);
    if (IN(8)) REP(8) { if (rep_) __syncthreads(); p10_ln1(F); } SEAM(8);
    if (IN(9)) {
        pg8::Gemm g{WSP(bf16, WS_H), WSP(bf16, WS_WT_UP), NREAL, UPW, D, D}; pg8::StaticOrder S; S.init(NREAL, UPW, F.G, (int)blockIdx.x);
        pg8::EpiConvAct E{WSP(unsigned short, WS_UP), DFF, F.in[IN_CONV_W], F.in[IN_CONV_B], DFF, WSP(float, WS_G01), WSP(float, WS_V01), WSP(float, WS_GHALO), (PG8_LAS float*)(F.lds + RING_BYTES + 4096)};
        pg8::gemm_phase<pg8::EpiConvAct, pg8::StaticOrder, true, true>(F.lds + RING_OFF, g, S, E);
        meta_gemm(F, WSP(bf16, WS_H), D, WSP(bf16, WS_WT_UP), UPW, D, StoreMetaGate{WSP(float, WS_GMETA)});
    } SEAM(9);
    if (IN(10)) { p12_conv_fix(F); } SEAM(10);
    if (IN(11)) REP(11) { if (rep_) __syncthreads(); run_gemm8(F, WSP(bf16, WS_UP), DFF, WSP(bf16, WS_WT_DN), D, DFF, StoreRes2{WSP(bf16, WS_H), F.out}); } SEAM(11);
    if (IN(12)) { p14_ln2(F);
#if CHECK_IDX
        if (blockIdx.x == 0 && F.tid == 0) {
            const unsigned miss = __hip_atomic_load((unsigned*)F.ctl + 2048, __ATOMIC_RELAXED, __HIP_MEMORY_SCOPE_AGENT), dupc = __hip_atomic_load((unsigned*)F.ctl + 2050, __ATOMIC_RELAXED, __HIP_MEMORY_SCOPE_AGENT);
            if (dupc) F.out[5] = __builtin_inff();
            if (miss > CHECK_IDX_MAXMISS) F.out[3] = __builtin_nanf("");
        }
#endif
    }
#ifdef PROBE_PHASE_T
    if (blockIdx.x == 0 && F.tid == 0) { if (PROBE_PHASE_T == 12) tp_dur = __builtin_amdgcn_s_memrealtime() - tp_prev; const unsigned long long t0 = __builtin_amdgcn_s_memrealtime(); while (__builtin_amdgcn_s_memrealtime() - t0 < tp_dur) __builtin_amdgcn_s_sleep(8); }
#endif
#ifdef PROBE_B1SEC
    if (blockIdx.x == 0 && F.tid == 0) { const unsigned long long t0 = __builtin_amdgcn_s_memrealtime(); const unsigned long long dt = (unsigned long long)F.MISC[20]; while (__builtin_amdgcn_s_memrealtime() - t0 < dt) __builtin_amdgcn_s_sleep(8); }
#endif
#undef IN
#undef SEAM
}

extern "C" void kernel_launch(void* const* d_in, const int* in_sizes, int n_in, void* d_out, int out_size, void* d_ws, size_t ws_size, hipStream_t stream) {
    static int grid = 0;
    if (grid == 0) {
        if (n_in != 32 || out_size != NREAL * D || ws_size < WS_END) { fprintf(stderr, "kernel_launch: unexpected shapes: n_in %d out %d ws %zu\n", n_in, out_size, ws_size); grid = -1; return; }
        int dev = 0, cus = 0, per_cu = 0;
        if (hipGetDevice(&dev) != hipSuccess || hipDeviceGetAttribute(&cus, hipDeviceAttributeMultiprocessorCount, dev) != hipSuccess) { grid = -1; return; }
        if (hipFuncSetAttribute((const void*)fwd, hipFuncAttributeMaxDynamicSharedMemorySize, LDS_BYTES) != hipSuccess) { fprintf(stderr, "kernel_launch: hipFuncSetAttribute failed\n"); grid = -1; return; }
        if (hipOccupancyMaxActiveBlocksPerMultiprocessor(&per_cu, (const void*)fwd, NTHR, LDS_BYTES) != hipSuccess || per_cu < 1) fprintf(stderr, "kernel_launch: occupancy query says %d\n", per_cu);
        (void)hipGetLastError();
        grid = cus;
    }
    if (grid < 0) return;
    (void)hipMemsetAsync((char*)d_ws + WS_CTL, 0, CTL_ZERO_BYTES, stream);
    Args a{};
    for (int i = 0; i < 32; ++i) a.in[i] = (const float*)d_in[i];
    a.out = (float*)d_out; a.ws = (unsigned char*)d_ws;
#if ONE_LAUNCH
    a.ph_lo = 0; a.ph_hi = NPHASES;
    hipLaunchKernelGGL(fwd, dim3(grid), dim3(NTHR), LDS_BYTES, stream, a);
#else
    for (int p = 0; p < NPHASES; ++p) { a.ph_lo = p; a.ph_hi = p + 1; hipLaunchKernelGGL(fwd, dim3(grid), dim3(NTHR), LDS_BYTES, stream, a); }
#endif
}
```

```cpp
#include <hip/hip_runtime.h>
#include <cstdio>
#include <cstdint>
#define ONE_LAUNCH 1
namespace pg8 {
#define PG8_LAS __attribute__((address_space(3)))
typedef unsigned short bf16_t;
typedef short bf16x8 __attribute__((ext_vector_type(8)));
typedef float f32x4 __attribute__((ext_vector_type(4)));
typedef unsigned u32x4 __attribute__((ext_vector_type(4)));
constexpr int BM = 256, BK = 64, HALF = 128, HTB = HALF * BK * 2  , STAGE_BYTES = 8 * HTB, NXCD = 8, WGM = 8;

__host__ __device__ __forceinline__ int lds_byte(int r, int c) { const int st = (r >> 4) * 2 + (c >> 5), rr = r & 15, cc = c & 31, ob = rr * 64 + cc * 2; return st * 1024 + (ob ^ (((ob >> 9) & 1) << 5)); }
__host__ __device__ __forceinline__ void stage_rc(int b, int& R, int& C) { const int st = b / 1024, sb = b % 1024, swz = sb ^ (((sb >> 9) & 1) << 5); R = (st >> 1) * 16 + swz / 64; C = (st & 1) * 32 + (swz % 64) / 2; }
__host__ __device__ __forceinline__ int perm32(int rho) { const int n = rho >> 4, i = rho & 15; return 8 * (i >> 2) + 4 * n + (i & 3); }

struct Unit { int pm, pn; };
struct Gemm { const bf16_t* A; const bf16_t* Bt; int M, N, K, lda; };

struct StaticOrder {
    int nM, nN, nwg, G, c;
    __host__ __device__ void init(int M, int N, int G_, int c_) { nM = M / BM; nN = N / BM; nwg = nM * nN; G = G_; c = c_; }
    __host__ __device__ bool next(int i, Unit& u) const {
        const long L = (long)i * G + c; if (L >= nwg) return false;
        int wgid = (int)L; { const int q = nwg / NXCD, r = nwg % NXCD, xcd = wgid % NXCD, off = wgid / NXCD; wgid = (xcd < r ? xcd * (q + 1) : r * (q + 1) + (xcd - r) * q) + off; }
        const int nig = WGM * nN, gid = wgid / nig, fm = gid * WGM, gsz = (nM - fm) < WGM ? (nM - fm) : WGM;
        u.pm = fm + ((wgid % nig) % gsz); u.pn = (wgid % nig) / gsz; return true;
    }
    __device__ __forceinline__ void a_ready(const Unit&) const {}
    __device__ __forceinline__ void done(const Unit&) const {}
};


template <class F> struct EpiFn {
    static constexpr bool PERM = false, AFTER_DRAIN = false;
    F f;
    __device__ __forceinline__ void operator()(const f32x4 (&acc)[2][2][4][2], const Unit& u, int wr, int wc, int fr, int fq) const {
        const int row0 = u.pm * BM + wr * 64 + fr, col0 = u.pn * BM + wc * 32 + 4 * fq;
#pragma unroll
        for (int ai = 0; ai < 2; ++ai)
#pragma unroll
            for (int m = 0; m < 4; ++m) {
                const int row = row0 + ai * HALF + m * 16;
#pragma unroll
                for (int bj = 0; bj < 2; ++bj)
#pragma unroll
                    for (int n = 0; n < 2; ++n) f(row, col0 + bj * HALF + n * 16, acc[ai][bj][m][n]);
            }
    }
};

template <class F> struct EpiFn8 {
    static constexpr bool PERM = true, AFTER_DRAIN = false;
    F f;
    __device__ __forceinline__ void operator()(const f32x4 (&acc)[2][2][4][2], const Unit& u, int wr, int wc, int fr, int fq) const {
        const int row0 = u.pm * BM + wr * 64 + fr, col0 = u.pn * BM + wc * 32 + 8 * fq;
#pragma unroll
        for (int ai = 0; ai < 2; ++ai)
#pragma unroll
            for (int m = 0; m < 4; ++m) {
                const int row = row0 + ai * HALF + m * 16;
#pragma unroll
                for (int bj = 0; bj < 2; ++bj) f.two(row, col0 + bj * HALF, acc[ai][bj][m][0], acc[ai][bj][m][1]);
            }
    }
};

struct EpiConvAct {
    static constexpr bool PERM = true, AFTER_DRAIN = false;
    unsigned short* ACT; int ldact;
    const float* cw; const float* cb; int dff;
    float* G01; float* V01; float* GHALO;
    PG8_LAS float* hal;
    __device__ __forceinline__ void operator()(const f32x4 (&acc)[2][2][4][2], const Unit& u, int wr, int wc, int fr, int fq) const {
        const int colg = 128 * u.pn + wc * 32 + 8 * fq;
        f32x4 w0[2], w1[2], w2[2], bb[2];
#pragma unroll
        for (int n = 0; n < 2; ++n) { w0[n] = *(const f32x4*)(cw + colg + 4 * n); w1[n] = *(const f32x4*)(cw + dff + colg + 4 * n); w2[n] = *(const f32x4*)(cw + 2 * dff + colg + 4 * n); bb[n] = *(const f32x4*)(cb + colg + 4 * n); }
        if (fr >= 14) {
#pragma unroll
            for (int ai = 0; ai < 2; ++ai)
#pragma unroll
                for (int n = 0; n < 2; ++n) *(PG8_LAS f32x4*)(hal + (((2 * ai + wr) * 4 + wc) * 2 + (fr - 14)) * 32 + 8 * fq + 4 * n) = acc[ai][0][3][n];
        }
        asm volatile("s_waitcnt lgkmcnt(0)" ::: "memory"); __builtin_amdgcn_s_barrier(); asm volatile("" ::: "memory");
#pragma unroll
        for (int ai = 0; ai < 2; ++ai) {
            const int blk = 2 * ai + wr;
            f32x4 prev[2];
#pragma unroll
            for (int n = 0; n < 2; ++n) {
                prev[n] = (f32x4){0.f, 0.f, 0.f, 0.f};
                if (blk > 0) prev[n] = *(const PG8_LAS f32x4*)(hal + ((((blk - 1) * 4 + wc) * 2 + (fr & 1)) * 32) + 8 * fq + 4 * n);
            }
#pragma unroll
            for (int m = 0; m < 4; ++m) {
                f32x4 o[2];
#pragma unroll
                for (int n = 0; n < 2; ++n) {
                    const f32x4 cur = acc[ai][0][m][n], val = acc[ai][1][m][n];
#pragma unroll
                    for (int e = 0; e < 4; ++e) {
                        float s1 = prev[n][e], s2 = prev[n][e];
                        asm volatile("s_nop 1\n\tv_mov_b32_dpp %0, %0 row_ror:1 row_mask:0xf bank_mask:0xf\n\tv_mov_b32_dpp %1, %1 row_ror:2 row_mask:0xf bank_mask:0xf\n\ts_nop 1\n\t"
                                     "v_mov_b32_dpp %0, %2 row_shr:1 row_mask:0xf bank_mask:0xf\n\tv_mov_b32_dpp %1, %2 row_shr:2 row_mask:0xf bank_mask:0xf\n\ts_nop 1" : "+v"(s1), "+v"(s2) : "v"(cur[e]));
                        const float x = w0[n][e] * s2 + w1[n][e] * s1 + w2[n][e] * cur[e] + bb[n][e];
                        const float u2 = x * (1.5957691216057308f + 0.07135481627260025f * x * x);
                        o[n][e] = x * __builtin_amdgcn_rcpf(1.0f + __builtin_amdgcn_exp2f(-1.4426950408889634f * u2)) * val[e];
                    }
                    prev[n] = cur;
                }
                const int rt = ai * HALF + wr * 64 + m * 16 + fr;
                const int row = u.pm * BM + rt;
                if (blk == 0 && m == 0 && fr < 2) {
#pragma unroll
                    for (int n = 0; n < 2; ++n) { *(f32x4*)(G01 + ((size_t)u.pm * 2 + fr) * dff + colg + 4 * n) = acc[ai][0][m][n]; *(f32x4*)(V01 + ((size_t)u.pm * 2 + fr) * dff + colg + 4 * n) = acc[ai][1][m][n]; }
                } else {
                    typedef __bf16 b2 __attribute__((ext_vector_type(2)));
                    const b2 p0 = {(__bf16)o[0][0], (__bf16)o[0][1]}, p1 = {(__bf16)o[0][2], (__bf16)o[0][3]}, p2 = {(__bf16)o[1][0], (__bf16)o[1][1]}, p3 = {(__bf16)o[1][2], (__bf16)o[1][3]};
                    *(u32x4*)(ACT + (size_t)row * ldact + colg) = (u32x4){__builtin_bit_cast(unsigned, p0), __builtin_bit_cast(unsigned, p1), __builtin_bit_cast(unsigned, p2), __builtin_bit_cast(unsigned, p3)};
                }
                if (blk == 3 && m == 3 && fr >= 14) {
#pragma unroll
                    for (int n = 0; n < 2; ++n) *(f32x4*)(GHALO + ((size_t)u.pm * 2 + (fr - 14)) * dff + colg + 4 * n) = acc[ai][0][m][n];
                }
            }
        }
        asm volatile("s_waitcnt lgkmcnt(0)" ::: "memory"); __builtin_amdgcn_s_barrier(); asm volatile("" ::: "memory");
    }
};
template <class Epi, class Sched, bool ALIGN_EPI = false, bool SP2 = false>
__device__ __forceinline__ void gemm_phase(PG8_LAS unsigned char* lds, const Gemm g, const Sched& S, const Epi& E) {
    const int tid = threadIdx.x, wid = __builtin_amdgcn_readfirstlane(tid >> 6), lane = tid & 63, wr = wid >> 2, wc = wid & 3, fr = lane & 15, fq = lane >> 4;
    const int K = g.K, nt = K / BK;
    unsigned voffA[2], voffB[2];
#pragma unroll
    for (int i = 0; i < 2; ++i) { int R, C; stage_rc(tid * 16 + i * 8192, R, C); const int Rb = Epi::PERM ? ((R & ~31) + perm32(R & 31)) : R;
        voffA[i] = (unsigned)(R * g.lda + C) * 2u; voffB[i] = (unsigned)(Rb * K + C) * 2u; }
    const size_t kstep = (size_t)(BK * 2);
    const size_t hA = (size_t)HALF * g.lda * 2, hB = (size_t)HALF * K * 2;
    const size_t tA = 2 * hA, tB = 2 * hB;
    const unsigned ldsw = (unsigned)wid * 1024u;
    const int aoff = lds_byte(wr * 64 + fr, fq * 8), boff = lds_byte(wc * 32 + fr, fq * 8);
#define PG8_SA(b, h) (((b) * 2 + (h)) * HTB)
#define PG8_SB(b, h) ((4 + (b) * 2 + (h)) * HTB)
#define PG8_STAGE(bufoff, gbase, voff) do { _Pragma("unroll") for (int _i = 0; _i < 2; ++_i) \
        __builtin_amdgcn_global_load_lds((const unsigned*)((const char*)(gbase) + (voff)[_i]), (PG8_LAS unsigned*)(lds + (bufoff) + ldsw + _i * 8192), 16, 0, 0); } while (0)
#define PG8_LDA(dst, b, h) do { _Pragma("unroll") for (int m = 0; m < 4; ++m) _Pragma("unroll") for (int k = 0; k < 2; ++k) dst[m][k] = *(const PG8_LAS bf16x8*)(lds + PG8_SA(b, h) + aoff + m * 2048 + k * 1024); } while (0)
#define PG8_LDB(dst, b, h) do { _Pragma("unroll") for (int n = 0; n < 2; ++n) _Pragma("unroll") for (int k = 0; k < 2; ++k) dst[n][k] = *(const PG8_LAS bf16x8*)(lds + PG8_SB(b, h) + boff + n * 2048 + k * 1024); } while (0)
#define PG8_MMA(ai, bj, At, Bt) do { __builtin_amdgcn_s_setprio(1); _Pragma("unroll") for (int m = 0; m < 4; ++m) _Pragma("unroll") for (int n = 0; n < 2; ++n) _Pragma("unroll") for (int k = 0; k < 2; ++k) \
        acc[ai][bj][m][n] = __builtin_amdgcn_mfma_f32_16x16x32_bf16(Bt[n][k], At[m][k], acc[ai][bj][m][n], 0, 0, 0); __builtin_amdgcn_s_setprio(0); } while (0)
#define PG8_WAIT_V(n) asm volatile("s_waitcnt vmcnt(" #n ")" ::: "memory")
#define PG8_WAIT_L(n) asm volatile("s_waitcnt lgkmcnt(" #n ")" ::: "memory")
#define PG8_BAR __builtin_amdgcn_s_barrier()
#define PG8_SCHED __builtin_amdgcn_sched_barrier(0)
    Unit cur, nxt; int ui = 0;
    if (!S.next(0, cur)) return;
    f32x4 acc[2][2][4][2];
#pragma unroll
    for (int a = 0; a < 2; ++a)
#pragma unroll
        for (int b = 0; b < 2; ++b)
#pragma unroll
            for (int m = 0; m < 4; ++m)
#pragma unroll
                for (int n = 0; n < 2; ++n) acc[a][b][m][n] = (f32x4){0.f, 0.f, 0.f, 0.f};
    bf16x8 At[4][2], B0[2][2], B1[2][2];
    const char* cA = (const char*)g.A + (size_t)cur.pm * tA; const char* cB = (const char*)g.Bt + (size_t)cur.pn * tB;
    S.a_ready(cur);
    if constexpr (SP2) {
        PG8_STAGE(PG8_SB(0, 0), cB, voffB); PG8_STAGE(PG8_SB(0, 1), cB + hB, voffB); PG8_STAGE(PG8_SA(0, 0), cA, voffA); PG8_STAGE(PG8_SA(0, 1), cA + hA, voffA);
        if (wr == 1) PG8_BAR;
        PG8_WAIT_V(2); PG8_BAR;
        PG8_STAGE(PG8_SB(1, 0), cB + kstep, voffB); PG8_STAGE(PG8_SA(1, 0), cA + kstep, voffA); PG8_STAGE(PG8_SB(1, 1), cB + hB + kstep, voffB);
        PG8_WAIT_V(6); PG8_BAR;
    } else {
        PG8_STAGE(PG8_SB(0, 0), cB, voffB); PG8_STAGE(PG8_SA(0, 0), cA, voffA); PG8_STAGE(PG8_SB(0, 1), cB + hB, voffB); PG8_STAGE(PG8_SA(0, 1), cA + hA, voffA);
        if (wr == 1) PG8_BAR;
        PG8_WAIT_V(4); PG8_BAR;
        PG8_STAGE(PG8_SB(1, 0), cB + kstep, voffB); PG8_STAGE(PG8_SA(1, 0), cA + kstep, voffA); PG8_STAGE(PG8_SB(1, 1), cB + hB + kstep, voffB);
        PG8_WAIT_V(6); PG8_BAR;
    }
    for (;;) {
        const bool has_next = S.next(ui + 1, nxt);
        const char* nA = has_next ? (const char*)g.A + (size_t)nxt.pm * tA : cA; const char* nB = has_next ? (const char*)g.Bt + (size_t)nxt.pn * tB : cB;
        for (int t = 0; t < nt; t += 2) {
            const bool last = (t == nt - 2);
            const char* a1 = cA + (size_t)(t + 1) * kstep;
            const char* a2 = last ? nA : cA + (size_t)(t + 2) * kstep; const char* b2 = last ? nB : cB + (size_t)(t + 2) * kstep;
            const char* a3 = a2 + kstep; const char* b3 = b2 + kstep;
            if (last && has_next) S.a_ready(nxt);
            if constexpr (SP2) {
            PG8_LDB(B0, 0, 0); PG8_LDB(B1, 0, 1); PG8_SCHED; PG8_LDA(At, 0, 0); PG8_STAGE(PG8_SA(1, 1), a1 + hA, voffA);
            PG8_WAIT_V(8); PG8_WAIT_L(0); PG8_BAR; PG8_MMA(0, 0, At, B0); PG8_MMA(0, 1, At, B1); PG8_BAR; PG8_SCHED;
            PG8_LDA(At, 0, 1); PG8_STAGE(PG8_SB(0, 0), b2, voffB); PG8_STAGE(PG8_SB(0, 1), b2 + hB, voffB); PG8_STAGE(PG8_SA(0, 0), a2, voffA);
            PG8_WAIT_V(8); PG8_WAIT_L(0); PG8_BAR; PG8_MMA(1, 0, At, B0); PG8_MMA(1, 1, At, B1); PG8_BAR; PG8_SCHED;
            PG8_LDB(B0, 1, 0); PG8_LDB(B1, 1, 1); PG8_SCHED; PG8_LDA(At, 1, 0); PG8_STAGE(PG8_SA(0, 1), a2 + hA, voffA);
            PG8_WAIT_V(8); PG8_WAIT_L(0); PG8_BAR; PG8_MMA(0, 0, At, B0); PG8_MMA(0, 1, At, B1); PG8_BAR; PG8_SCHED;
            PG8_LDA(At, 1, 1); PG8_STAGE(PG8_SB(1, 0), b3, voffB); PG8_STAGE(PG8_SB(1, 1), b3 + hB, voffB); PG8_STAGE(PG8_SA(1, 0), a3, voffA);
            PG8_WAIT_V(8); PG8_WAIT_L(0); PG8_BAR; PG8_MMA(1, 0, At, B0); PG8_MMA(1, 1, At, B1); PG8_BAR; PG8_SCHED;
            } else {
            PG8_LDB(B0, 0, 0); PG8_SCHED; PG8_LDA(At, 0, 0); PG8_STAGE(PG8_SA(1, 1), a1 + hA, voffA);
            PG8_WAIT_L(8); PG8_BAR; PG8_WAIT_L(0); PG8_MMA(0, 0, At, B0); PG8_BAR; PG8_SCHED;
            PG8_LDB(B1, 0, 1); PG8_STAGE(PG8_SB(0, 0), b2, voffB);
            PG8_BAR; PG8_WAIT_L(0); PG8_MMA(0, 1, At, B1); PG8_BAR;
            PG8_LDA(At, 0, 1); PG8_STAGE(PG8_SA(0, 0), a2, voffA);
            PG8_BAR; PG8_WAIT_L(0); PG8_MMA(1, 0, At, B0); PG8_BAR; PG8_SCHED;
            PG8_STAGE(PG8_SB(0, 1), b2 + hB, voffB);
            PG8_WAIT_V(6); PG8_BAR; PG8_MMA(1, 1, At, B1); PG8_BAR;
            PG8_LDB(B0, 1, 0); PG8_SCHED; PG8_LDA(At, 1, 0); PG8_STAGE(PG8_SA(0, 1), a2 + hA, voffA);
            PG8_WAIT_L(8); PG8_BAR; PG8_WAIT_L(0); PG8_MMA(0, 0, At, B0); PG8_BAR; PG8_SCHED;
            PG8_LDB(B1, 1, 1); PG8_STAGE(PG8_SB(1, 0), b3, voffB);
            PG8_BAR; PG8_WAIT_L(0); PG8_MMA(0, 1, At, B1); PG8_BAR;
            PG8_LDA(At, 1, 1); PG8_STAGE(PG8_SA(1, 0), a3, voffA);
            PG8_BAR; PG8_WAIT_L(0); PG8_MMA(1, 0, At, B0); PG8_BAR; PG8_SCHED;
            PG8_STAGE(PG8_SB(1, 1), b3 + hB, voffB);
            PG8_WAIT_V(6); PG8_BAR; PG8_MMA(1, 1, At, B1); PG8_BAR;
            }
        }
        if constexpr (ALIGN_EPI) { if (wr == 0) PG8_BAR; }
        if constexpr (!Epi::AFTER_DRAIN) { E(acc, cur, wr, wc, fr, fq); S.done(cur); }
        if (!has_next) break;
#pragma unroll
        for (int a = 0; a < 2; ++a)
#pragma unroll
            for (int b = 0; b < 2; ++b)
#pragma unroll
                for (int m = 0; m < 4; ++m)
#pragma unroll
                    for (int n = 0; n < 2; ++n) acc[a][b][m][n] = (f32x4){0.f, 0.f, 0.f, 0.f};
        cur = nxt; cA = nA; cB = nB; ++ui;
        if constexpr (ALIGN_EPI) { if (wr == 1) PG8_BAR; }
    }
    PG8_WAIT_V(0);
    if constexpr (!ALIGN_EPI) { if (wr == 0) PG8_BAR; }
    PG8_BAR;
    if constexpr (Epi::AFTER_DRAIN) { E.fused(acc, cur, wr, wc, fr, fq, lds, wid, lane); S.done(cur); }
#undef PG8_SA
#undef PG8_SB
#undef PG8_STAGE
#undef PG8_LDA
#undef PG8_LDB
#undef PG8_MMA
#undef PG8_WAIT_V
#undef PG8_WAIT_L
#undef PG8_BAR
#undef PG8_SCHED
}
}

#ifndef ONE_LAUNCH
#define ONE_LAUNCH 0
#endif
constexpr int NWAVES = 8, NTHR = 512;
constexpr int D = 1024, BATCH = 4, SEQ = 8192, NMETA = 16, TT = SEQ + NMETA;
constexpr int NREAL = BATCH * SEQ;
constexpr int NROWS = NREAL + NMETA;
constexpr int R = 33024;
constexpr int PW = 2304;
constexpr int PC_CQ = 0, PC_CKV = 256, PC_KIDX = 384, PC_WIDX = 448, PC_R = 512, PC_K = 1024, PC_V = 1536, PC_WD = 2048, PC_AD = 2112, PC_GD = 2176;
constexpr int QAW = 1536;
constexpr int DFF = 2816, UPW = 5632;
constexpr int TOPK = 256;
constexpr float LN_EPS = 1e-5f, GN_EPS = 64e-5f, ALPHA = 1.18920711500272f;

constexpr size_t MiB = 1u << 20;
constexpr size_t WS_CTL = 0, CTL_ZERO_BYTES = 32768;
constexpr size_t WS_WT_IN = 1 * MiB, WS_WT_QA = 6 * MiB, WS_WT_MIX = 7 * MiB, WS_WT_UP = 10 * MiB, WS_WT_DN = 21 * MiB;
constexpr size_t WS_META1 = 27 * MiB, WS_NSEL = 28 * MiB, WS_WIDX = 29 * MiB;
constexpr size_t WS_H = 33 * MiB;
constexpr size_t WS_P = 98 * MiB, WS_QA = 244 * MiB, WS_CQN = 341 * MiB, WS_SEL = 341 * MiB, WS_CKV = 358 * MiB, WS_KIDX = 367 * MiB;
constexpr size_t WS_DEC = 372 * MiB, WS_AB = 437 * MiB, WS_GB = 470 * MiB;
constexpr size_t WS_WT_LORA = 26 * MiB + 512 * 1024;
constexpr size_t WS_RWM = 372 * MiB, WS_RWN = 405 * MiB, WS_RWQ = 438 * MiB, WS_RWY = 471 * MiB;
constexpr size_t OUT_RWS = 80 * MiB, OUT_BONUS = 116 * MiB;
constexpr size_t WS_G01 = 480 * MiB, WS_V01 = 484 * MiB, WS_GHALO = 488 * MiB, WS_GMETA = 492 * MiB;
constexpr size_t WS_UP = 98 * MiB;
constexpr size_t WS_END = 512 * MiB;
static_assert(WS_P + (size_t)R * PW * 2 <= WS_QA && WS_QA + (size_t)R * QAW * 2 <= WS_CQN && WS_CQN + (size_t)R * 256 * 2 <= WS_CKV && WS_CKV + (size_t)R * 128 * 2 <= WS_KIDX
              && WS_KIDX + (size_t)R * 64 * 2 <= WS_DEC && WS_DEC + (size_t)R * 512 * 4 <= WS_AB && WS_AB + (size_t)R * 512 * 2 <= WS_GB && WS_GB + (size_t)R * 512 * 2 <= WS_END
              && WS_UP + (size_t)R * UPW * 2 <= WS_END && WS_H + (size_t)R * D * 2 <= WS_P && WS_WIDX + (size_t)R * 8 * 4 <= WS_H && WS_NSEL + (size_t)R * 4 <= WS_WIDX, "ws map");
constexpr int CW_BAR = 4096;

constexpr int RING_OFF = 0, RING_BYTES = 131072;
constexpr int LDSCTL_OFF = RING_BYTES, MISC_OFF = LDSCTL_OFF + 320;
constexpr int LDS_BYTES = 147456;

#define GAS __attribute__((address_space(1)))
#define LAS __attribute__((address_space(3)))
typedef unsigned short bf16;
typedef unsigned v4u __attribute__((ext_vector_type(4)));
typedef unsigned v2u __attribute__((ext_vector_type(2)));
typedef float f32x4 __attribute__((ext_vector_type(4)));
typedef GAS unsigned gu32;
typedef __bf16 bf16x2_t __attribute__((ext_vector_type(2)));
__device__ __forceinline__ unsigned f2bf(float f) { return (unsigned)__builtin_bit_cast(unsigned short, (__bf16)f); }
__device__ __forceinline__ unsigned pk2(float lo, float hi) { const bf16x2_t v = {(__bf16)lo, (__bf16)hi}; return __builtin_bit_cast(unsigned, v); }
__device__ __forceinline__ float fast_rcp(float x) { return __builtin_amdgcn_rcpf(x); }
__device__ __forceinline__ float fast_tanh(float x) { return 1.0f - 2.0f * __builtin_amdgcn_rcpf(1.0f + __expf(2.0f * x)); }
__device__ __forceinline__ float bf2f(unsigned short b) { return __uint_as_float(((unsigned)b) << 16); }
__device__ __forceinline__ float bflo(unsigned w) { return __uint_as_float(w << 16); }
__device__ __forceinline__ float bfhi(unsigned w) { return __uint_as_float(w & 0xffff0000u); }
#define DPP_F(v, ctrl) __builtin_bit_cast(float, __builtin_amdgcn_update_dpp(0, __builtin_bit_cast(int, (v)), (ctrl), 0xf, 0xf, false))
__device__ __forceinline__ float rdlane_f(float v, int lane) { return __builtin_bit_cast(float, __builtin_amdgcn_readlane(__builtin_bit_cast(int, v), lane)); }
__device__ __forceinline__ float wave_sum(float v) {
    v += DPP_F(v, 0xB1); v += DPP_F(v, 0x4E); v += DPP_F(v, 0x141); v += DPP_F(v, 0x140);
    return (rdlane_f(v, 0) + rdlane_f(v, 16)) + (rdlane_f(v, 32) + rdlane_f(v, 48));
}
__device__ __forceinline__ float wave_max(float v) {
    v = fmaxf(v, DPP_F(v, 0xB1)); v = fmaxf(v, DPP_F(v, 0x4E)); v = fmaxf(v, DPP_F(v, 0x141)); v = fmaxf(v, DPP_F(v, 0x140));
    return fmaxf(fmaxf(rdlane_f(v, 0), rdlane_f(v, 16)), fmaxf(rdlane_f(v, 32), rdlane_f(v, 48)));
}
#define DPP_U0(v, ctrl) ((unsigned)__builtin_amdgcn_update_dpp(0, (int)(v), (ctrl), 0xf, 0xf, true))
__device__ __forceinline__ unsigned wave_scan_incl(unsigned v, int lane) {
    v += DPP_U0(v, 0x111); v += DPP_U0(v, 0x112); v += DPP_U0(v, 0x114); v += DPP_U0(v, 0x118);
    const unsigned r0 = (unsigned)__builtin_amdgcn_readlane((int)v, 15), r1 = (unsigned)__builtin_amdgcn_readlane((int)v, 31), r2 = (unsigned)__builtin_amdgcn_readlane((int)v, 47);
    const int row = lane >> 4;
    return v + (row >= 1 ? r0 : 0u) + (row >= 2 ? r1 : 0u) + (row >= 3 ? r2 : 0u);
}
__device__ __forceinline__ float sigmoidf_(float x) { return __builtin_amdgcn_rcpf(1.0f + __expf(-x)); }
#define XB_TMO      128
#define XB_XCNT(j)  (256  + 64 * (j))
#define XB_XSUB(j)  (1280 + 64 * (j))
#define XB_XGEN(j)  (2304 + 64 * (j))
#define XB_TOP      3328
#define XB_TOPGEN   3392
#define XCD_BAR_WORDS 3456
#define XB_SPIN_CAP (1u << 18)

__device__ __forceinline__ unsigned xb_ld(unsigned* p)              { return __hip_atomic_load(p, __ATOMIC_RELAXED, __HIP_MEMORY_SCOPE_AGENT); }
__device__ __forceinline__ unsigned xb_add(unsigned* p, unsigned v) { return __hip_atomic_fetch_add(p, v, __ATOMIC_RELAXED, __HIP_MEMORY_SCOPE_AGENT); }
__device__ __forceinline__ unsigned xb_xcc_id() { return (unsigned)__builtin_amdgcn_s_getreg((3 << 11) | 20) & 0xFu; }
#define XB_SPIN(cond, bar) do { unsigned _sp = 0; while (cond) { __builtin_amdgcn_s_sleep(1); \
    if ((++_sp & 255u) == 0u) { if (xb_ld(&(bar)[XB_TMO])) break; if (_sp > XB_SPIN_CAP) { atomicAdd(&(bar)[XB_TMO], 1u); break; } } } } while (0)

struct XcdBarrier {
    unsigned* bar; unsigned x;
    volatile LAS unsigned* st;
};

__device__ __forceinline__ XcdBarrier xcd_barrier_post(unsigned* bar, volatile LAS unsigned* st) {
    XcdBarrier b; b.bar = bar; b.x = xb_xcc_id(); b.st = st;
    if (threadIdx.x == 0) (void)xb_add(&bar[XB_XCNT(b.x)], 1u);
    return b;
}
__device__ __forceinline__ void xcd_barrier_complete(unsigned* bar, unsigned x, unsigned& nloc, unsigned& nx) {
    const unsigned G = gridDim.x * gridDim.y * gridDim.z;
    unsigned sum, cnt, mine, sp = 0u;
    for (;;) {
        sum = 0u; cnt = 0u; mine = 0u;
#pragma unroll
        for (unsigned j = 0; j < 16; ++j) { const unsigned c = xb_ld(&bar[XB_XCNT(j)]); sum += c; cnt += (c > 0u) ? 1u : 0u; mine = (j == x) ? c : mine; }
        if (sum == G) break;
        __builtin_amdgcn_s_sleep(1);
        if ((++sp & 255u) == 0u) { if (xb_ld(&bar[XB_TMO])) break; if (sp > XB_SPIN_CAP) { atomicAdd(&bar[XB_TMO], 1u); break; } }
    }
    nloc = mine > 0u ? mine : 1u; nx = cnt > 0u ? cnt : 1u;
}

__device__ __forceinline__ void xcd_barrier(const XcdBarrier& b) {
    asm volatile("s_waitcnt vmcnt(0)" ::: "memory");
    __syncthreads();
    if (threadIdx.x == 0) {
        unsigned* bar = b.bar;
        __builtin_amdgcn_s_waitcnt(0);
        unsigned nloc = b.st[0], nx = b.st[1];
        if (nloc == 0u) { xcd_barrier_complete(bar, b.x, nloc, nx); b.st[0] = nloc; b.st[1] = nx; }
        const unsigned old = xb_add(&bar[XB_XSUB(b.x)], 1u);
        const unsigned gen = old / nloc;
        if (old + 1u == (gen + 1u) * nloc) {
            __builtin_amdgcn_fence(__ATOMIC_RELEASE, "agent");
            asm volatile("s_waitcnt vmcnt(0)" ::: "memory");
            const unsigned og = xb_add(&bar[XB_TOP], 1u);
            const unsigned tg = og / nx;
            if (og + 1u == (tg + 1u) * nx) xb_add(&bar[XB_TOPGEN], 1u);
            else XB_SPIN(xb_ld(&bar[XB_TOPGEN]) == tg, bar);
            __builtin_amdgcn_fence(__ATOMIC_ACQUIRE, "agent");
            xb_add(&bar[XB_XGEN(b.x)], 1u);
            asm volatile("s_waitcnt vmcnt(0)" ::: "memory");
        } else {
            XB_SPIN(xb_ld(&bar[XB_XGEN(b.x)]) == gen, bar);
            __builtin_amdgcn_fence(__ATOMIC_ACQUIRE, "agent");
            asm volatile("s_waitcnt vmcnt(0)" ::: "memory");
        }
    }
    __syncthreads();
}

struct Frame {
    LAS unsigned char* lds;
    volatile LAS unsigned* MISC;
    gu32* ctl;
    int tid, lane, wave, G;
    const float* in[32];
    float* out;
    unsigned char* ws;
};
#define IN_X 0
#define IN_META 1
#define IN_LNIN_G 2
#define IN_LNIN_B 3
#define IN_W_IN 4
#define IN_QNORM_G 5
#define IN_W_UQ 6
#define IN_KVNORM_G 7
#define IN_W_UKV 8
#define IN_W_IQ 9
#define IN_IDXLN_G 10
#define IN_IDXLN_B 11
#define IN_MU 12
#define IN_W0 13
#define IN_W_DEC 14
#define IN_A0 15
#define IN_W_AAA 16
#define IN_W_GATE 17
#define IN_KK 18
#define IN_KA 19
#define IN_RK 20
#define IN_GN_G 21
#define IN_GN_B 22
#define IN_W_OUT 23
#define IN_LN1_G 24
#define IN_LN1_B 25
#define IN_W_UP 26
#define IN_CONV_W 27
#define IN_CONV_B 28
#define IN_W_DN 29
#define IN_LN2_G 30
#define IN_LN2_B 31

#define WSP(T, off) ((T*)(F.ws + (off)))

__device__ __forceinline__ int key_row(int b, int j) { return j < NMETA ? NREAL + j : b * SEQ + (j - NMETA); }

__device__ __forceinline__ int tr_col(int n, int mode, int cut0, int cut1, int shift) {
    if (mode == 1) { const int pn = n >> 8, x = n & 255; return x < 128 ? 128 * pn + x : DFF + 128 * pn + (x - 128); }
    return n < cut0 ? n : (n < cut1 ? -1 : n - shift);
}
struct TrJob { const float* src; int src_ld, src_r0; bf16* dst; int dst_ld, dst_c0, Nn, K, mode, cut0, cut1, shift; };
__device__ __forceinline__ void tr_item(const TrJob& j, int item, LAS float* scr, int lane) {
    const int nblk = j.Nn / 32, kb = item / nblk, nb = item % nblk, k0 = 64 * kb, n0 = 32 * nb;
    const int col = tr_col(n0 + (lane & 31), j.mode, j.cut0, j.cut1, j.shift);
    const float* sp = j.src + (size_t)(j.src_r0 + k0 + (lane >> 5)) * j.src_ld + (col >= 0 ? col : 0);
    float v[32];
#pragma unroll
    for (int i = 0; i < 32; ++i) v[i] = sp[(size_t)(2 * i) * j.src_ld];
#pragma unroll
    for (int i = 0; i < 32; ++i) scr[(2 * i + (lane >> 5)) * 33 + (lane & 31)] = col >= 0 ? v[i] : 0.f;
    asm volatile("s_waitcnt lgkmcnt(0)" ::: "memory");
    const int c = lane & 7;
#pragma unroll
    for (int q = 0; q < 4; ++q) { const int n = (lane >> 3) + 8 * q; const LAS float* t = scr + (8 * c) * 33 + n;
        *(v4u*)(j.dst + (size_t)(n0 + n) * j.dst_ld + j.dst_c0 + k0 + 8 * c) = (v4u){pk2(t[0], t[33]), pk2(t[66], t[99]), pk2(t[132], t[165]), pk2(t[198], t[231])}; }
    asm volatile("s_waitcnt lgkmcnt(0)" ::: "memory");
}
__device__ __forceinline__ void tr_job(Frame& F, const TrJob& j, int& base, int gw, int NGW) {
    LAS float* scr = (LAS float*)(F.lds + F.wave * 8704);
    const int ni = (j.K / 64) * (j.Nn / 32);
    for (int it = ((gw - base) % NGW + NGW) % NGW; it < ni; it += NGW) tr_item(j, it, scr, F.lane);
    base = (base + ni) % NGW;
}
__device__ __forceinline__ void p0_weights(Frame& F) {
    bf16* WT_IN = WSP(bf16, WS_WT_IN); bf16* WT_QA = WSP(bf16, WS_WT_QA); bf16* WdT = WSP(bf16, WS_WT_LORA);
    const int gw = blockIdx.x * NWAVES + F.wave, NGW = F.G * NWAVES;
    int base = 0;
    tr_job(F, TrJob{F.in[IN_W_IN], 2248, 0, WT_IN, D, 0, PW, D, 0, 456, 512, 56}, base, gw, NGW);
    tr_job(F, TrJob{F.in[IN_W_IQ], 512, 0, WT_QA + (size_t)1024 * 256, 256, 0, 512, 256, 0, 512, 512, 0}, base, gw, NGW);
    tr_job(F, TrJob{F.in[IN_W_GATE], 512, 0, WdT + 2 * 512 * 64, 128, 0, 512, 128, 0, 512, 512, 0}, base, gw, NGW);
    tr_job(F, TrJob{F.in[IN_W_DEC], 512, 0, WdT, 64, 0, 512, 64, 0, 512, 512, 0}, base, gw, NGW);
    tr_job(F, TrJob{F.in[IN_W_AAA], 512, 0, WdT + 512 * 64, 64, 0, 512, 64, 0, 512, 512, 0}, base, gw, NGW);
    const float* w_uq = F.in[IN_W_UQ]; const float* w_ukv = F.in[IN_W_UKV];
    for (int it = blockIdx.x * NTHR + F.tid; it < 256 * 8 * 8; it += F.G * NTHR) {
        const int c = it & 255, hb = __builtin_amdgcn_readfirstlane(it >> 8), h = hb >> 3, j0 = (hb & 7) * 16;
        float acc[16];
#pragma unroll
        for (int jj = 0; jj < 16; ++jj) acc[jj] = 0.f;
        for (int d = 0; d < 64; ++d) {
            const float a = w_uq[(size_t)c * 512 + h * 64 + d];
#pragma unroll
            for (int jj = 0; jj < 16; ++jj) acc[jj] += a * w_ukv[(size_t)(j0 + jj) * 1024 + h * 128 + d];
        }
#pragma unroll
        for (int jj = 0; jj < 16; ++jj) WT_QA[(size_t)(h * 128 + j0 + jj) * 256 + c] = (bf16)f2bf(0.125f * acc[jj]);
    }
}
__device__ __forceinline__ void p0_weights_late(Frame& F, int gw, int NGW) {
    bf16* WT_MIX = WSP(bf16, WS_WT_MIX); bf16* WT_UP = WSP(bf16, WS_WT_UP); bf16* WT_DN = WSP(bf16, WS_WT_DN);
    int base = 0;
    tr_job(F, TrJob{F.in[IN_W_UP], UPW, 0, WT_UP, D, 0, UPW, D, 1, 0, 0, 0}, base, gw, NGW);
    tr_job(F, TrJob{F.in[IN_W_DN], D, 0, WT_DN, DFF, 0, D, DFF, 0, D, D, 0}, base, gw, NGW);
    tr_job(F, TrJob{F.in[IN_W_OUT], D, 512, WT_MIX, 1536, 1024, D, 512, 0, D, D, 0}, base, gw, NGW);
    const float* w_ukv = F.in[IN_W_UKV]; const float* w_out = F.in[IN_W_OUT];
    for (int it = gw * 64 + F.lane; it < 1024 * 8 * 8; it += NGW * 64) {
        const int n = it & 1023, hb = __builtin_amdgcn_readfirstlane(it >> 10), h = hb >> 3, j0 = (hb & 7) * 16;
        float acc[16];
#pragma unroll
        for (int jj = 0; jj < 16; ++jj) acc[jj] = 0.f;
        for (int d = 0; d < 64; ++d) {
            const float a = w_out[(size_t)(h * 64 + d) * D + n];
#pragma unroll
            for (int jj = 0; jj < 16; ++jj) acc[jj] += a * w_ukv[(size_t)(j0 + jj) * 1024 + h * 128 + 64 + d];
        }
        v4u o0, o1;
        o0.x = pk2(acc[0], acc[1]); o0.y = pk2(acc[2], acc[3]); o0.z = pk2(acc[4], acc[5]); o0.w = pk2(acc[6], acc[7]);
        o1.x = pk2(acc[8], acc[9]); o1.y = pk2(acc[10], acc[11]); o1.z = pk2(acc[12], acc[13]); o1.w = pk2(acc[14], acc[15]);
        *(v4u*)(WT_MIX + (size_t)n * 1536 + h * 128 + j0) = o0; *(v4u*)(WT_MIX + (size_t)n * 1536 + h * 128 + j0 + 8) = o1;
    }
}

__device__ __forceinline__ void ln_row_bf16(Frame& F, const float* src, const float* g, const float* b, bf16* dst) {
    v2u* o8 = (v2u*)dst + F.lane;
    if (!src) {
#pragma unroll
        for (int j = 0; j < 4; ++j) o8[64 * j] = (v2u){0u, 0u};
        return;
    }
    const f32x4* xr = (const f32x4*)src + F.lane;
    f32x4 v[4]; float s = 0.f;
#pragma unroll
    for (int j = 0; j < 4; ++j) { v[j] = xr[64 * j]; s += (v[j].x + v[j].y) + (v[j].z + v[j].w); }
    const float mean = wave_sum(s) * (1.f / D); float s2 = 0.f;
#pragma unroll
    for (int j = 0; j < 4; ++j) { v[j] = v[j] - mean; s2 += (v[j].x * v[j].x + v[j].y * v[j].y) + (v[j].z * v[j].z + v[j].w * v[j].w); }
    const float rstd = 1.f / sqrtf(wave_sum(s2) * (1.f / D) + LN_EPS);
#pragma unroll
    for (int j = 0; j < 4; ++j) {
        const f32x4 gg = ((const f32x4*)g)[F.lane + 64 * j], bb = ((const f32x4*)b)[F.lane + 64 * j];
        const f32x4 y = v[j] * rstd * gg + bb;
        o8[64 * j] = (v2u){pk2(y.x, y.y), pk2(y.z, y.w)};
    }
}
__device__ __forceinline__ void p1_ln_in(Frame& F) {
    bf16* H0 = WSP(bf16, WS_H);
    const int gw = blockIdx.x * NWAVES + F.wave, NGW = F.G * NWAVES;
    const f32x4* gp = (const f32x4*)F.in[IN_LNIN_G] + F.lane; const f32x4* bp = (const f32x4*)F.in[IN_LNIN_B] + F.lane;
    f32x4 gg[4], bb[4];
#pragma unroll
    for (int j = 0; j < 4; ++j) { gg[j] = gp[64 * j]; bb[j] = bp[64 * j]; }
    for (int r0 = gw * 4; r0 < NROWS; r0 += NGW * 4) {
        f32x4 v[4][4];
#pragma unroll
        for (int q = 0; q < 4; ++q) {
            const int r = r0 + q < NROWS ? r0 + q : NROWS - 1;
            const f32x4* xr = (const f32x4*)(r < NREAL ? F.in[IN_X] + (size_t)r * D : F.in[IN_META] + (size_t)(r - NREAL) * D) + F.lane;
#pragma unroll
            for (int j = 0; j < 4; ++j) v[q][j] = xr[64 * j];
        }
#pragma unroll
        for (int q = 0; q < 4; ++q) {
            float s = 0.f;
#pragma unroll
            for (int j = 0; j < 4; ++j) s += (v[q][j].x + v[q][j].y) + (v[q][j].z + v[q][j].w);
            const float mean = wave_sum(s) * (1.f / D); float s2 = 0.f;
#pragma unroll
            for (int j = 0; j < 4; ++j) { v[q][j] = v[q][j] - mean; s2 += (v[q][j].x * v[q][j].x + v[q][j].y * v[q][j].y) + (v[q][j].z * v[q][j].z + v[q][j].w * v[q][j].w); }
            const float rstd = 1.f / sqrtf(wave_sum(s2) * (1.f / D) + LN_EPS);
            if (r0 + q < NROWS) {
                v2u* o8 = (v2u*)(H0 + (size_t)(r0 + q) * D) + F.lane;
#pragma unroll
                for (int j = 0; j < 4; ++j) { const f32x4 y = v[q][j] * rstd * gg[j] + bb[j]; o8[64 * j] = (v2u){pk2(y.x, y.y), pk2(y.z, y.w)}; }
            }
        }
    }
}

__device__ __forceinline__ void p3_prep(Frame& F) {
    const bf16* P = WSP(bf16, WS_P); bf16* CQN = WSP(bf16, WS_CQN); bf16* CKV = WSP(bf16, WS_CKV); bf16* KIDX = WSP(bf16, WS_KIDX); float* WIDX = WSP(float, WS_WIDX);
    const int gw = blockIdx.x * NWAVES + F.wave, NGW = F.G * NWAVES, l = F.lane;
    for (int r = gw; r < R; r += NGW) {
        const bf16* pr = P + (size_t)r * PW;
        if (r >= NROWS) {
            *(v2u*)(CQN + (size_t)r * 256 + 4 * l) = (v2u){0u, 0u};
            continue;
        }
        {
            const v2u w = *(const v2u*)(pr + PC_CQ + 4 * l);
            const float a0 = bflo(w.x), a1 = bfhi(w.x), a2 = bflo(w.y), a3 = bfhi(w.y);
            const float ss = wave_sum(a0 * a0 + a1 * a1 + a2 * a2 + a3 * a3);
            const float rs = 1.0f / sqrtf(ss * (1.f / 256.f) + 1e-6f);
            const f32x4 g = ((const f32x4*)F.in[IN_QNORM_G])[l];
            *(v2u*)(CQN + (size_t)r * 256 + 4 * l) = (v2u){pk2(a0 * rs * g.x, a1 * rs * g.y), pk2(a2 * rs * g.z, a3 * rs * g.w)};
        }
        {
            const unsigned w = *(const unsigned*)(pr + PC_CKV + 2 * l);
            const float a0 = bflo(w), a1 = bfhi(w);
            const float ss = wave_sum(a0 * a0 + a1 * a1);
            const float rs = 1.0f / sqrtf(ss * (1.f / 128.f) + 1e-6f);
            const float g0 = F.in[IN_KVNORM_G][2 * l], g1 = F.in[IN_KVNORM_G][2 * l + 1];
            *(unsigned*)(CKV + (size_t)r * 128 + 2 * l) = pk2(a0 * rs * g0, a1 * rs * g1);
        }
        {
            const float a = bf2f(pr[PC_KIDX + l]);
            const float mean = wave_sum(a) * (1.f / 64.f);
            const float dlt = a - mean;
            const float var = wave_sum(dlt * dlt) * (1.f / 64.f);
            const float y = dlt * (1.0f / sqrtf(var + LN_EPS)) * F.in[IN_IDXLN_G][l] + F.in[IN_IDXLN_B][l];
            KIDX[(size_t)r * 64 + l] = (bf16)f2bf(y);
        }
        if (l < 8) WIDX[(size_t)r * 8 + l] = bf2f(pr[PC_WIDX + l]) * 0.04419417382415922f;
    }
}

#ifndef REFSEL
#define REFSEL 0
#endif
__device__ __forceinline__ void refsel_rows(Frame& F) {
    float* QIDX32 = F.out; float* KIDX32 = F.out + (size_t)R * 512; float* WIDX = WSP(float, WS_WIDX);
    const float* w_in = F.in[IN_W_IN]; const float* w_iq = F.in[IN_W_IQ];
    LAS float* hrow = (LAS float*)(F.lds + F.wave * 8192);
    LAS float* cqn = hrow + 1024;
    const int l = F.lane;
    const int gw = blockIdx.x * NWAVES + F.wave, NGW = F.G * NWAVES;
    for (int r = gw; r < NROWS; r += NGW) {
        const float* src = r < NREAL ? F.in[IN_X] + (size_t)r * D : F.in[IN_META] + (size_t)(r - NREAL) * D;
        {
            const f32x4* xr = (const f32x4*)src + l;
            f32x4 v[4]; float s = 0.f;
#pragma unroll
            for (int j = 0; j < 4; ++j) { v[j] = xr[64 * j]; s += (v[j].x + v[j].y) + (v[j].z + v[j].w); }
            const float mean = wave_sum(s) * (1.f / D); float s2 = 0.f;
#pragma unroll
            for (int j = 0; j < 4; ++j) { v[j] = v[j] - mean; s2 += (v[j].x * v[j].x + v[j].y * v[j].y) + (v[j].z * v[j].z + v[j].w * v[j].w); }
            const float rstd = 1.f / sqrtf(wave_sum(s2) * (1.f / D) + LN_EPS);
#pragma unroll
            for (int j = 0; j < 4; ++j) {
                const f32x4 gg = ((const f32x4*)F.in[IN_LNIN_G])[l + 64 * j], bb = ((const f32x4*)F.in[IN_LNIN_B])[l + 64 * j];
                *(LAS f32x4*)(hrow + 4 * (l + 64 * j)) = v[j] * rstd * gg + bb;
            }
        }
        __builtin_amdgcn_wave_barrier();
        float a[6];
#pragma unroll
        for (int i = 0; i < 6; ++i) a[i] = 0.f;
        for (int k = 0; k < D; ++k) {
            const float hk = hrow[k]; const float* wr = w_in + (size_t)k * 2248;
#pragma unroll
            for (int i = 0; i < 4; ++i) a[i] += hk * wr[l + 64 * i];
            a[4] += hk * wr[384 + l];
            a[5] += hk * wr[448 + (l & 7)];
        }
        const float ss = wave_sum(a[0] * a[0] + a[1] * a[1] + a[2] * a[2] + a[3] * a[3]);
        const float rs = 1.0f / sqrtf(ss * (1.f / 256.f) + 1e-6f);
#pragma unroll
        for (int i = 0; i < 4; ++i) cqn[l + 64 * i] = a[i] * rs * F.in[IN_QNORM_G][l + 64 * i];
        {
            const float mean = wave_sum(a[4]) * (1.f / 64.f); const float dlt = a[4] - mean;
            const float var = wave_sum(dlt * dlt) * (1.f / 64.f);
            KIDX32[(size_t)r * 64 + l] = dlt * (1.0f / sqrtf(var + LN_EPS)) * F.in[IN_IDXLN_G][l] + F.in[IN_IDXLN_B][l];
        }
        if (l < 8) WIDX[(size_t)r * 8 + l] = a[5] * 0.04419417382415922f;
        __builtin_amdgcn_wave_barrier();
        float q[8];
#pragma unroll
        for (int i = 0; i < 8; ++i) q[i] = 0.f;
        for (int c = 0; c < 256; ++c) {
            const float cq = cqn[c]; const float* wr = w_iq + (size_t)c * 512;
#pragma unroll
            for (int i = 0; i < 8; ++i) q[i] += cq * wr[l + 64 * i];
        }
#pragma unroll
        for (int i = 0; i < 8; ++i) QIDX32[(size_t)r * 512 + l + 64 * i] = q[i];
        __builtin_amdgcn_wave_barrier();
    }
}

__device__ __forceinline__ unsigned sortable(float f) { const unsigned u = __float_as_uint(f); return (u & 0x80000000u) ? ~u : (u | 0x80000000u); }
__device__ __forceinline__ void p5_index_naive(Frame& F) {
    const bf16* QA = WSP(bf16, WS_QA); const bf16* KIDX = WSP(bf16, WS_KIDX); const float* WIDX = WSP(float, WS_WIDX);
    unsigned short* SEL = WSP(unsigned short, WS_SEL); int* NSEL = WSP(int, WS_NSEL);
    LAS float* sc = (LAS float*)(F.lds);
    LAS float* qf = (LAS float*)(F.lds + 33024);
    LAS unsigned* hist = (LAS unsigned*)(F.lds + 33024 + 2048);
    LAS unsigned* cw = hist + 256;
    const int tid = F.tid;
    for (int q = blockIdx.x; q < NROWS; q += F.G) {
        int b, pos; if (q < NREAL) { b = q >> 13; pos = NMETA + (q & (SEQ - 1)); } else { b = 0; pos = q - NREAL; }
        const int nvis = pos < NMETA ? NMETA : NMETA + 64 * ((pos - NMETA) / 64 + 1);
#if REFSEL
        qf[tid] = F.out[(size_t)q * 512 + tid];
#else
        qf[tid] = bf2f(QA[(size_t)q * QAW + 1024 + tid]);
#endif
        float w[8];
#pragma unroll
        for (int h = 0; h < 8; ++h) w[h] = WIDX[(size_t)q * 8 + h];
        __syncthreads();
        for (int j = tid; j < nvis; j += NTHR) {
            const v4u* kp = (const v4u*)(KIDX + (size_t)key_row(b, j) * 64);
#if REFSEL
            const f32x4* kp32 = (const f32x4*)(F.out + (size_t)R * 512 + (size_t)key_row(b, j) * 64);
#endif
            float d[8];
#pragma unroll
            for (int h = 0; h < 8; ++h) d[h] = 0.f;
#pragma unroll 2
            for (int c = 0; c < 8; ++c) {
#if REFSEL
                const f32x4 ta = kp32[2 * c], tb = kp32[2 * c + 1];
                const float k0 = ta.x, k1 = ta.y, k2 = ta.z, k3 = ta.w, k4 = tb.x, k5 = tb.y, k6 = tb.z, k7 = tb.w;
#else
                const v4u t = kp[c];
                const float k0 = bflo(t.x), k1 = bfhi(t.x), k2 = bflo(t.y), k3 = bfhi(t.y), k4 = bflo(t.z), k5 = bfhi(t.z), k6 = bflo(t.w), k7 = bfhi(t.w);
#endif
#pragma unroll
                for (int h = 0; h < 8; ++h) {
                    const f32x4 qa = *(const LAS f32x4*)(qf + h * 64 + 8 * c), qb = *(const LAS f32x4*)(qf + h * 64 + 8 * c + 4);
                    d[h] += qa.x * k0 + qa.y * k1 + qa.z * k2 + qa.w * k3 + qb.x * k4 + qb.y * k5 + qb.z * k6 + qb.w * k7;
                }
            }
            float s = 0.f;
#pragma unroll
            for (int h = 0; h < 8; ++h) s += w[h] * fmaxf(d[h], 0.f);
            sc[j] = s + 0.0f;
        }
        __syncthreads();
        unsigned short* selq = SEL + (size_t)q * TOPK;
        if (nvis <= TOPK) {
            for (int j = tid; j < nvis; j += NTHR) selq[j] = (unsigned short)j;
        } else {
            unsigned prefix = 0u, mask = 0u, need = TOPK;
            for (int pass = 0; pass < 4; ++pass) {
                const int shift = 24 - 8 * pass;
                if (tid < 256) hist[tid] = 0u;
                __syncthreads();
                for (int j = tid; j < nvis; j += NTHR) { const unsigned key = sortable(sc[j]); if ((key & mask) == prefix) atomicAdd((unsigned*)&hist[(key >> shift) & 255u], 1u); }
                __syncthreads();
                if (tid < 256) {
                    unsigned above = 0u; for (int bb = tid + 1; bb < 256; ++bb) above += hist[bb];
                    const unsigned c = hist[tid];
                    if (above < need && need <= above + c) { cw[0] = prefix | ((unsigned)tid << shift); cw[1] = need - above; }
                }
                __syncthreads();
                prefix = cw[0]; need = cw[1]; mask |= 0xFFu << shift;
                __syncthreads();
            }
            if (tid == 0) cw[2] = 0u;
            __syncthreads();
            for (int j = tid; j < nvis; j += NTHR) { if (sortable(sc[j]) > prefix) { const unsigned p = atomicAdd((unsigned*)&cw[2], 1u); selq[p] = (unsigned short)j; } }
            __syncthreads();
            if (F.wave == 0) {
                const unsigned base = cw[2]; unsigned taken = 0u;
                for (int j0 = 0; j0 < nvis && taken < need; j0 += 64) {
                    const int j = j0 + F.lane; const bool eq = j < nvis && sortable(sc[j]) == prefix;
                    const unsigned long long m = __ballot(eq);
                    const unsigned rank = (unsigned)__popcll(m & ((1ull << F.lane) - 1ull));
                    if (eq && taken + rank < need) selq[base + taken + rank] = (unsigned short)j;
                    taken += (unsigned)__popcll(m);
                }
            }
        }
        if (tid == 0) NSEL[q] = nvis < TOPK ? nvis : TOPK;
        __syncthreads();
    }
}

__device__ __forceinline__ void p6_attn_naive(Frame& F) {
    bf16* QA = WSP(bf16, WS_QA); const bf16* CKV = WSP(bf16, WS_CKV); const unsigned short* SEL = WSP(unsigned short, WS_SEL); const int* NSEL = WSP(int, WS_NSEL);
    LAS float* qf = (LAS float*)(F.lds + F.wave * 16384);
    LAS float* ps = qf + 1024;
    LAS int* srow = (LAS int*)(ps + 2048);
    const int l = F.lane;
    const int gw = blockIdx.x * NWAVES + F.wave, NGW = F.G * NWAVES;
    for (int q = gw; q < R; q += NGW) {
        bf16* qrow = QA + (size_t)q * QAW;
        if (q >= NROWS) {
            for (int c = l; c < QAW / 8; c += 64) *(v4u*)(qrow + 8 * c) = (v4u){0u, 0u, 0u, 0u};
            continue;
        }
        int b, pos; if (q < NREAL) { b = q >> 13; pos = NMETA + (q & (SEQ - 1)); } else { b = 0; pos = q - NREAL; }
        const int nsel = NSEL[q];
        {
            const v4u t0 = *(const v4u*)(qrow + 16 * l), t1 = *(const v4u*)(qrow + 16 * l + 8);
            LAS float* d = qf + 16 * l;
            d[0] = bflo(t0.x); d[1] = bfhi(t0.x); d[2] = bflo(t0.y); d[3] = bfhi(t0.y); d[4] = bflo(t0.z); d[5] = bfhi(t0.z); d[6] = bflo(t0.w); d[7] = bfhi(t0.w);
            d[8] = bflo(t1.x); d[9] = bfhi(t1.x); d[10] = bflo(t1.y); d[11] = bfhi(t1.y); d[12] = bflo(t1.z); d[13] = bfhi(t1.z); d[14] = bflo(t1.w); d[15] = bfhi(t1.w);
        }
        __builtin_amdgcn_wave_barrier();
        for (int kk = 0; kk < 4; ++kk) {
            const int s = kk * 64 + l; const bool valid = s < nsel;
            const int j = valid ? (int)SEL[(size_t)q * TOPK + s] : 0;
            const int row = key_row(b, j);
            srow[s] = row;
            float acc[8];
#pragma unroll
            for (int h = 0; h < 8; ++h) acc[h] = 0.f;
            const v4u* kp = (const v4u*)(CKV + (size_t)row * 128);
            for (int c8 = 0; c8 < 16; ++c8) {
                const v4u t = kp[c8];
                const float k0 = bflo(t.x), k1 = bfhi(t.x), k2 = bflo(t.y), k3 = bfhi(t.y), k4 = bflo(t.z), k5 = bfhi(t.z), k6 = bflo(t.w), k7 = bfhi(t.w);
#pragma unroll
                for (int h = 0; h < 8; ++h) {
                    const f32x4 qa = *(const LAS f32x4*)(qf + h * 128 + 8 * c8), qb = *(const LAS f32x4*)(qf + h * 128 + 8 * c8 + 4);
                    acc[h] += qa.x * k0 + qa.y * k1 + qa.z * k2 + qa.w * k3 + qb.x * k4 + qb.y * k5 + qb.z * k6 + qb.w * k7;
                }
            }
            const float dist = fabsf((float)(pos - j));
#pragma unroll
            for (int h = 0; h < 8; ++h) { const float slope = __uint_as_float((unsigned)(127 - (h + 1)) << 23); ps[s * 8 + h] = valid ? acc[h] - slope * dist : -INFINITY; }
        }
        __builtin_amdgcn_wave_barrier();
#pragma unroll
        for (int h = 0; h < 8; ++h) {
            float v0 = ps[(l) * 8 + h], v1 = ps[(l + 64) * 8 + h], v2 = ps[(l + 128) * 8 + h], v3 = ps[(l + 192) * 8 + h];
            const float mx = wave_max(fmaxf(fmaxf(v0, v1), fmaxf(v2, v3)));
            v0 = __expf(v0 - mx); v1 = __expf(v1 - mx); v2 = __expf(v2 - mx); v3 = __expf(v3 - mx);
            const float inv = 1.0f / wave_sum((v0 + v1) + (v2 + v3));
            ps[(l) * 8 + h] = v0 * inv; ps[(l + 64) * 8 + h] = v1 * inv; ps[(l + 128) * 8 + h] = v2 * inv; ps[(l + 192) * 8 + h] = v3 * inv;
        }
        __builtin_amdgcn_wave_barrier();
        float o0[8], o1[8];
#pragma unroll
        for (int h = 0; h < 8; ++h) { o0[h] = 0.f; o1[h] = 0.f; }
        for (int s = 0; s < nsel; ++s) {
            const int row = srow[s];
            const unsigned w = *(const unsigned*)(CKV + (size_t)row * 128 + 2 * l);
            const float c0 = bflo(w), c1 = bfhi(w);
            const f32x4 pa = *(const LAS f32x4*)(ps + s * 8), pb = *(const LAS f32x4*)(ps + s * 8 + 4);
            o0[0] += pa.x * c0; o1[0] += pa.x * c1; o0[1] += pa.y * c0; o1[1] += pa.y * c1; o0[2] += pa.z * c0; o1[2] += pa.z * c1; o0[3] += pa.w * c0; o1[3] += pa.w * c1;
            o0[4] += pb.x * c0; o1[4] += pb.x * c1; o0[5] += pb.y * c0; o1[5] += pb.y * c1; o0[6] += pb.z * c0; o1[6] += pb.z * c1; o0[7] += pb.w * c0; o1[7] += pb.w * c1;
        }
#pragma unroll
        for (int h = 0; h < 8; ++h) *(unsigned*)(qrow + h * 128 + 2 * l) = pk2(o0[h], o1[h]);
        __builtin_amdgcn_wave_barrier();
    }
}

__device__ __forceinline__ void p7_rwkv_prep_naive(Frame& F) {
    const bf16* P = WSP(bf16, WS_P); float* DEC = WSP(float, WS_DEC); bf16* AB = WSP(bf16, WS_AB); bf16* GB = WSP(bf16, WS_GB);
    const float* mu = F.in[IN_MU]; const float* Wd = F.in[IN_W_DEC]; const float* Wa = F.in[IN_W_AAA]; const float* Wg = F.in[IN_W_GATE];
    const int l = F.lane;
    const int gw = blockIdx.x * NWAVES + F.wave, NGW = F.G * NWAVES;
    for (int r = gw; r < NROWS; r += NGW) {
        int prev; if (r < NREAL) { prev = (r & (SEQ - 1)) ? r - 1 : NREAL + NMETA - 1; } else { prev = r > NREAL ? r - 1 : -1; }
        const bf16* pr = P + (size_t)r * PW; const bf16* pp = prev >= 0 ? P + (size_t)prev * PW : nullptr;
#define SHIFTED(pc, mc) (bf2f(pr[pc]) + ((pp ? bf2f(pp[pc]) : 0.f) - bf2f(pr[pc])) * mu[mc])
        const float tw = tanhf(SHIFTED(PC_WD + l, 1536 + l));
        const float ta = SHIFTED(PC_AD + l, 1600 + l);
        const float tg0 = sigmoidf_(SHIFTED(PC_GD + l, 1664 + l)), tg1 = sigmoidf_(SHIFTED(PC_GD + 64 + l, 1728 + l));
#undef SHIFTED
        float aw[8], aa[8], ag[8];
#pragma unroll
        for (int i = 0; i < 8; ++i) { aw[i] = F.in[IN_W0][l + 64 * i]; aa[i] = F.in[IN_A0][l + 64 * i]; ag[i] = 0.f; }
        for (int j = 0; j < 64; ++j) {
            const float xw = __shfl(tw, j), xa = __shfl(ta, j), xg0 = __shfl(tg0, j), xg1 = __shfl(tg1, j);
#pragma unroll
            for (int i = 0; i < 8; ++i) {
                aw[i] += xw * Wd[(size_t)j * 512 + l + 64 * i];
                aa[i] += xa * Wa[(size_t)j * 512 + l + 64 * i];
                ag[i] += xg0 * Wg[(size_t)j * 512 + l + 64 * i] + xg1 * Wg[(size_t)(j + 64) * 512 + l + 64 * i];
            }
        }
#pragma unroll
        for (int i = 0; i < 8; ++i) {
            const float x = -aw[i];
            const float sp = x > 20.f ? x : log1pf(__expf(x));
            const float wlog = -sp - 0.5f;
            DEC[(size_t)r * 512 + l + 64 * i] = __expf(-__expf(wlog));
            AB[(size_t)r * 512 + l + 64 * i] = (bf16)f2bf(sigmoidf_(aa[i]));
            GB[(size_t)r * 512 + l + 64 * i] = (bf16)f2bf(ag[i]);
        }
    }
}

__device__ __forceinline__ void p8_rwkv_scan_naive(Frame& F) {
    if (F.wave != 0 || blockIdx.x >= 32) return;
    const bf16* P = WSP(bf16, WS_P); const float* DEC = WSP(float, WS_DEC); const bf16* AB = WSP(bf16, WS_AB); const bf16* GB = WSP(bf16, WS_GB); bf16* QA = WSP(bf16, WS_QA);
    const int b = blockIdx.x >> 3, h = blockIdx.x & 7, l = F.lane, ch = h * 64 + l;
    LAS float* vec = (LAS float*)F.lds;
    const float mu_r = F.in[IN_MU][ch], mu_k = F.in[IN_MU][512 + ch], mu_v = F.in[IN_MU][1024 + ch];
    const float kk_c = F.in[IN_KK][ch], ka_c = F.in[IN_KA][ch], rk_c = F.in[IN_RK][ch], gng = F.in[IN_GN_G][ch], gnb = F.in[IN_GN_B][ch];
    float S[64];
#pragma unroll
    for (int k = 0; k < 64; ++k) S[k] = 0.f;
    float pr_p = 0.f, pk_p = 0.f, pv_p = 0.f;
    int row = key_row(b, 0);
    float n_pr = bf2f(P[(size_t)row * PW + PC_R + ch]), n_pk = bf2f(P[(size_t)row * PW + PC_K + ch]), n_pv = bf2f(P[(size_t)row * PW + PC_V + ch]);
    float n_w = DEC[(size_t)row * 512 + ch], n_a = bf2f(AB[(size_t)row * 512 + ch]), n_g = bf2f(GB[(size_t)row * 512 + ch]);
    for (int pos = 0; pos < TT; ++pos) {
        const int crow = row;
        const float c_pr = n_pr, c_pk = n_pk, c_pv = n_pv, c_w = n_w, c_a = n_a, c_g = n_g;
        if (pos + 1 < TT) {
            row = key_row(b, pos + 1);
            n_pr = bf2f(P[(size_t)row * PW + PC_R + ch]); n_pk = bf2f(P[(size_t)row * PW + PC_K + ch]); n_pv = bf2f(P[(size_t)row * PW + PC_V + ch]);
            n_w = DEC[(size_t)row * 512 + ch]; n_a = bf2f(AB[(size_t)row * 512 + ch]); n_g = bf2f(GB[(size_t)row * 512 + ch]);
        }
        const float r_s = c_pr + (pr_p - c_pr) * mu_r, k_s = c_pk + (pk_p - c_pk) * mu_k, v_s = c_pv + (pv_p - c_pv) * mu_v;
        pr_p = c_pr; pk_p = c_pk; pv_p = c_pv;
        const float kkr = k_s * kk_c;
        const float nrm = sqrtf(wave_sum(kkr * kkr));
        const float kk = kkr / fmaxf(nrm, 1e-12f);
        const float k2 = k_s * (1.f + (c_a - 1.f) * ka_c);
        vec[l] = -kk; vec[64 + l] = kk * c_a; vec[128 + l] = c_w; vec[192 + l] = k2; vec[256 + l] = r_s;
        __builtin_amdgcn_wave_barrier();
        float sa = 0.f;
#pragma unroll
        for (int k4 = 0; k4 < 16; ++k4) { const f32x4 a = *(const LAS f32x4*)(vec + 4 * k4); sa += S[4 * k4] * a.x + S[4 * k4 + 1] * a.y + S[4 * k4 + 2] * a.z + S[4 * k4 + 3] * a.w; }
        float y = 0.f;
#pragma unroll
        for (int k4 = 0; k4 < 16; ++k4) {
            const f32x4 bv = *(const LAS f32x4*)(vec + 64 + 4 * k4), w = *(const LAS f32x4*)(vec + 128 + 4 * k4), kv = *(const LAS f32x4*)(vec + 192 + 4 * k4), rv = *(const LAS f32x4*)(vec + 256 + 4 * k4);
            S[4 * k4] = S[4 * k4] * w.x + sa * bv.x + v_s * kv.x; S[4 * k4 + 1] = S[4 * k4 + 1] * w.y + sa * bv.y + v_s * kv.y;
            S[4 * k4 + 2] = S[4 * k4 + 2] * w.z + sa * bv.z + v_s * kv.z; S[4 * k4 + 3] = S[4 * k4 + 3] * w.w + sa * bv.w + v_s * kv.w;
            y += S[4 * k4] * rv.x + S[4 * k4 + 1] * rv.y + S[4 * k4 + 2] * rv.z + S[4 * k4 + 3] * rv.w;
        }
        __builtin_amdgcn_wave_barrier();
        const float mean = wave_sum(y) * (1.f / 64.f);
        const float dlt = y - mean;
        const float var = wave_sum(dlt * dlt) * (1.f / 64.f);
        const float yn = dlt * (1.0f / sqrtf(var + GN_EPS)) * gng + gnb;
        const float bonus = wave_sum(r_s * k2 * rk_c) * v_s;
        const float o = (yn + bonus) * c_g;
        if (pos >= NMETA || b == 0) QA[(size_t)crow * QAW + 1024 + ch] = (bf16)f2bf(o);
    }
}

template <bool OUT_BF16>
__device__ __forceinline__ void ln_rows4(Frame& F, int nrows, const float* g, const float* b, bf16* dstb) {
    const int gw = blockIdx.x * NWAVES + F.wave, NGW = F.G * NWAVES;
    const float* META1 = WSP(float, WS_META1);
    f32x4 gg[4], bb[4];
#pragma unroll
    for (int j = 0; j < 4; ++j) { gg[j] = ((const f32x4*)g)[F.lane + 64 * j]; bb[j] = ((const f32x4*)b)[F.lane + 64 * j]; }
    for (int r0 = gw * 4; r0 < nrows; r0 += NGW * 4) {
        f32x4 v[4][4];
#pragma unroll
        for (int q = 0; q < 4; ++q) {
            const int r = r0 + q < nrows ? r0 + q : nrows - 1;
            const f32x4* xr = (const f32x4*)(r < NREAL ? F.out + (size_t)r * D : META1 + (size_t)(r - NREAL) * D) + F.lane;
#pragma unroll
            for (int j = 0; j < 4; ++j) v[q][j] = xr[64 * j];
        }
#pragma unroll
        for (int q = 0; q < 4; ++q) {
            float s = 0.f;
#pragma unroll
            for (int j = 0; j < 4; ++j) s += (v[q][j].x + v[q][j].y) + (v[q][j].z + v[q][j].w);
            const float mean = wave_sum(s) * (1.f / D); float s2 = 0.f;
#pragma unroll
            for (int j = 0; j < 4; ++j) { v[q][j] = v[q][j] - mean; s2 += (v[q][j].x * v[q][j].x + v[q][j].y * v[q][j].y) + (v[q][j].z * v[q][j].z + v[q][j].w * v[q][j].w); }
            const float rstd = 1.f / sqrtf(wave_sum(s2) * (1.f / D) + LN_EPS);
            if (r0 + q < nrows) {
                if (OUT_BF16) { v2u* o8 = (v2u*)(dstb + (size_t)(r0 + q) * D) + F.lane;
#pragma unroll
                    for (int j = 0; j < 4; ++j) { const f32x4 y = v[q][j] * rstd * gg[j] + bb[j]; o8[64 * j] = (v2u){pk2(y.x, y.y), pk2(y.z, y.w)}; }
                } else { f32x4* o = (f32x4*)(F.out + (size_t)(r0 + q) * D) + F.lane;
#pragma unroll
                    for (int j = 0; j < 4; ++j) o[64 * j] = v[q][j] * rstd * gg[j] + bb[j]; }
            }
        }
    }
}
__device__ __forceinline__ void p10_ln1(Frame& F) { ln_rows4<true>(F, NROWS, F.in[IN_LN1_G], F.in[IN_LN1_B], WSP(bf16, WS_H)); }
__device__ __forceinline__ void p14_ln2(Frame& F) { ln_rows4<false>(F, NREAL, F.in[IN_LN2_G], F.in[IN_LN2_B], nullptr); }

__device__ __forceinline__ float gelu_fast(float x) {
    const float u2 = x * (1.5957691216057308f + 0.07135481627260025f * x * x);
    return x * __builtin_amdgcn_rcpf(1.0f + __builtin_amdgcn_exp2f(-1.4426950408889634f * u2));
}
__device__ __forceinline__ void p12_conv_fix(Frame& F) {
    bf16* ACT = WSP(bf16, WS_UP); const float* cw = F.in[IN_CONV_W]; const float* cb = F.in[IN_CONV_B];
    const float* G01 = WSP(float, WS_G01); const float* V01 = WSP(float, WS_V01); const float* GHALO = WSP(float, WS_GHALO); const float* GMETA = WSP(float, WS_GMETA);
    for (int it = blockIdx.x * NTHR + F.tid; it < 128 * 2 * DFF; it += F.G * NTHR) {
        const int j = it % DFF, rr = (it / DFF) & 1, pm = it / (2 * DFF);
        const float* ph = (pm & 31) ? GHALO + (size_t)(pm - 1) * 2 * DFF : GMETA;
        const float g0 = G01[((size_t)pm * 2 + rr) * DFF + j];
        const float g1 = rr ? G01[((size_t)pm * 2) * DFF + j] : ph[DFF + j];
        const float g2 = rr ? ph[DFF + j] : ph[j];
        const float x = cw[j] * g2 + cw[DFF + j] * g1 + cw[2 * DFF + j] * g0 + cb[j];
        ACT[(size_t)(pm * 256 + rr) * DFF + j] = (bf16)f2bf(gelu_fast(x) * V01[((size_t)pm * 2 + rr) * DFF + j]);
    }
}


constexpr int NUNITS = 4096 + 8;
constexpr int RP = 72;
constexpr int SLOT = 64 * RP * 2;
constexpr int FP = 68;
typedef short bf16x8 __attribute__((ext_vector_type(8)));
typedef float f32x16 __attribute__((ext_vector_type(16)));
constexpr size_t RW_MAT = (size_t)NUNITS * 4096;

__device__ __forceinline__ void quad_mma(f32x16& acc, const LAS bf16* Aop, const LAS bf16* Bop, int qr, int qc, int lane) {
    const int r = lane & 31, hf = lane >> 5;
    const LAS bf16* ap = Aop + (32 * qr + r) * RP + 8 * hf; const LAS bf16* bp = Bop + (32 * qc + r) * RP + 8 * hf;
#pragma unroll
    for (int ks = 0; ks < 4; ++ks) {
        const bf16x8 a = *(const LAS bf16x8*)(ap + 16 * ks), b = *(const LAS bf16x8*)(bp + 16 * ks);
        acc = __builtin_amdgcn_mfma_f32_32x32x16_bf16(a, b, acc, 0, 0, 0);
    }
}
#define ACC_M(qr, j, hf) (32 * (qr) + ((j) & 3) + 8 * ((j) >> 2) + 4 * (hf))
__device__ __forceinline__ void store_T(const f32x16& acc, LAS bf16* Z, int qr, int qc, int lane) {
    const int r = lane & 31, hf = lane >> 5;
#pragma unroll
    for (int jj = 0; jj < 4; ++jj)
        *(LAS v2u*)(Z + (32 * qc + r) * RP + 32 * qr + 8 * jj + 4 * hf) = (v2u){pk2(acc[4 * jj], acc[4 * jj + 1]), pk2(acc[4 * jj + 2], acc[4 * jj + 3])};
}
__device__ __forceinline__ void add_T(f32x16& acc, const LAS bf16* Z, int qr, int qc, int lane) {
    const int r = lane & 31, hf = lane >> 5;
#pragma unroll
    for (int jj = 0; jj < 4; ++jj) {
        const v2u w = *(const LAS v2u*)(Z + (32 * qc + r) * RP + 32 * qr + 8 * jj + 4 * hf);
        acc[4 * jj] += bflo(w.x); acc[4 * jj + 1] += bfhi(w.x); acc[4 * jj + 2] += bflo(w.y); acc[4 * jj + 3] += bfhi(w.y);
    }
}
__device__ __forceinline__ int frag_off(int n, int m) { return (((m >> 4) * 2 + ((m >> 3) & 1)) * 64 + n) * 8 + (m & 7); }
__device__ __forceinline__ int acc_off(int n, int m) { return ((((m >> 5) * 4 + ((m >> 3) & 3)) * 2 + ((m >> 2) & 1)) * 64 + n) * 4 + (m & 3); }
template <bool FRAG>
__device__ __forceinline__ void store_T_global(const f32x16& acc, bf16* Z, int qr, int qc, int lane) {
    const int r = lane & 31, hf = lane >> 5;
#pragma unroll
    for (int jj = 0; jj < 4; ++jj) { const int n = 32 * qc + r, m0 = 32 * qr + 8 * jj + 4 * hf;
        *(v2u*)(Z + (FRAG ? frag_off(n, m0) : acc_off(n, m0))) = (v2u){pk2(acc[4 * jj], acc[4 * jj + 1]), pk2(acc[4 * jj + 2], acc[4 * jj + 3])}; }
}
__device__ __forceinline__ f32x16 zero16() { f32x16 z;
#pragma unroll
    for (int j = 0; j < 16; ++j) z[j] = 0.f;
    return z; }

__device__ __forceinline__ void b1_load_raw(const bf16* P, int u, int w, int l, unsigned short (&rv)[45]) {
    const bool meta = u >= 4096;
    int b = 0, h, c = 0; if (meta) h = u - 4096; else { b = u >> 10; h = (u >> 7) & 7; c = u & 127; }
    const int ch = h * 64 + l, row0 = meta ? NREAL : b * SEQ + c * 64, t0 = 8 * w;
    int prow = -1;
    if (t0 > 0) prow = row0 + t0 - 1; else if (!meta) prow = (c == 0) ? NREAL + NMETA - 1 : row0 - 1;
#pragma unroll
    for (int i = 0; i < 9; ++i) {
        const int t = t0 - 1 + i;
        const int row = i == 0 ? prow : ((!meta || t < NMETA) ? row0 + t : -1);
        const bf16* pp = P + (size_t)(row >= 0 ? row : 0) * PW;
        const unsigned short a0 = pp[PC_R + ch], a1 = pp[PC_K + ch], a2 = pp[PC_V + ch], a3 = pp[PC_WD + l], a4 = pp[PC_AD + l];
        const bool ok = row >= 0;
        rv[5 * i] = ok ? a0 : (unsigned short)0; rv[5 * i + 1] = ok ? a1 : (unsigned short)0; rv[5 * i + 2] = ok ? a2 : (unsigned short)0; rv[5 * i + 3] = ok ? a3 : (unsigned short)0; rv[5 * i + 4] = ok ? a4 : (unsigned short)0;
    }
}

#define LDS_BARRIER() do { asm volatile("s_waitcnt lgkmcnt(0)" ::: "memory"); __builtin_amdgcn_s_barrier(); asm volatile("" ::: "memory"); } while (0)
#ifdef PROBE_B1SEC
#define B1T(k) do { if (blockIdx.x == 0 && F.tid == 0) { const unsigned long long t_ = __builtin_amdgcn_s_memrealtime(); if ((k) == PROBE_B1SEC + 1) b1acc += t_ - b1t0; b1t0 = t_; } } while (0)
#else
#define B1T(k) do {} while (0)
#endif
__device__ __forceinline__ void rw_b1(Frame& F) {
    const bf16* P = WSP(bf16, WS_P);
    bf16* RWM = WSP(bf16, WS_RWM); bf16* RWN = WSP(bf16, WS_RWN); bf16* RWQ = WSP(bf16, WS_RWQ); bf16* RWY = WSP(bf16, WS_RWY);
    float* BONUS = (float*)((char*)F.out + OUT_BONUS);
    const bf16* WdT = WSP(bf16, WS_WT_LORA); const bf16* WaT = WdT + 512 * 64;
    const float* mu = F.in[IN_MU];
    const int w = F.wave, l = F.lane, tid = F.tid;
    LAS unsigned char* L = F.lds;
#define SL(s) ((LAS bf16*)(L + (s) * SLOT))
    LAS float* WL = (LAS float*)(L + 12 * SLOT);
    LAS float* AL = (LAS float*)(L + 0 * SLOT);
    LAS float* OT = (LAS float*)(L + RING_BYTES + 1024);
    LAS float* GL = OT + 512;
    unsigned long long b1acc = 0ull, b1t0 = 0ull; (void)b1acc; (void)b1t0;
    unsigned short rnx[45];
    b1_load_raw(P, (int)blockIdx.x < NUNITS ? (int)blockIdx.x : 0, w, l, rnx);
    for (int u = blockIdx.x; u < NUNITS; u += F.G) {
        const bool meta = u >= 4096;
        int b = 0, h, c = 0; if (meta) h = u - 4096; else { b = u >> 10; h = (u >> 7) & 7; c = u & 127; }
        const int ch = h * 64 + l;
        const int row0 = meta ? NREAL : b * SEQ + c * 64;
        LDS_BARRIER();
        B1T(0);
        float r_s[8], k_s[8], v_s[8], xw[8], xa[8];
        {
            const int t0 = 8 * w;
            unsigned short rc[45];
#pragma unroll
            for (int i = 0; i < 45; ++i) rc[i] = rnx[i];
            float pr = bf2f(rc[0]), pk = bf2f(rc[1]), pv = bf2f(rc[2]), pw = bf2f(rc[3]), pa = bf2f(rc[4]);
            const float mr = mu[ch], mk = mu[512 + ch], mv = mu[1024 + ch], mw = mu[1536 + l], ma = mu[1600 + l];
#pragma unroll
            for (int i = 0; i < 8; ++i) {
                const int t = t0 + i; const bool valid = !meta || t < NMETA;
                const float cr = bf2f(rc[5 * i + 5]), ck = bf2f(rc[5 * i + 6]), cv = bf2f(rc[5 * i + 7]), cw = bf2f(rc[5 * i + 8]), ca = bf2f(rc[5 * i + 9]);
                r_s[i] = valid ? cr + (pr - cr) * mr : 0.f; k_s[i] = valid ? ck + (pk - ck) * mk : 0.f; v_s[i] = valid ? cv + (pv - cv) * mv : 0.f;
                xw[i] = fast_tanh(cw + (pw - cw) * mw); xa[i] = ca + (pa - ca) * ma;
                pr = cr; pk = ck; pv = cv; pw = cw; pa = ca;
            }
#pragma unroll
            for (int i = 0; i < 8; ++i) { SL(8)[(t0 + i) * RP + l] = (bf16)f2bf(xw[i]); SL(9)[(t0 + i) * RP + l] = (bf16)f2bf(xa[i]); }
            {
                const int k = tid >> 3, pc = tid & 7;
                *(LAS v4u*)(SL(10) + k * RP + 8 * pc) = *(const v4u*)(WdT + (size_t)(h * 64 + k) * 64 + 8 * pc);
                *(LAS v4u*)(SL(11) + k * RP + 8 * pc) = *(const v4u*)(WaT + (size_t)(h * 64 + k) * 64 + 8 * pc);
            }
        }
        __syncthreads();
        B1T(1);
        {
            const int pid = w >> 2, q = w & 3, qr = q >> 1, qc = q & 1;
            f32x16 acc = zero16();
            quad_mma(acc, SL(10 + pid), SL(8 + pid), qr, qc, l);
            LAS float* Zf = pid ? AL : WL;
            const int r = l & 31, hf = l >> 5;
#pragma unroll
            for (int jj = 0; jj < 4; ++jj) *(LAS f32x4*)(Zf + (32 * qc + r) * FP + 32 * qr + 8 * jj + 4 * hf) = (f32x4){acc[4 * jj], acc[4 * jj + 1], acc[4 * jj + 2], acc[4 * jj + 3]};
        }
        __syncthreads();
        B1T(2);
        float lw[8], asg[8];
        {
            const float w0c = F.in[IN_W0][ch], a0c = F.in[IN_A0][ch];
            float run = 0.f;
#pragma unroll
            for (int i = 0; i < 8; ++i) {
                const int t = 8 * w + i; const bool valid = !meta || t < NMETA;
                const float x = -(WL[t * FP + l] + w0c);
                const float sp = x > 20.f ? x : __logf(1.0f + __expf(x));
                const float e = -__expf(-sp - 0.5f);
                run += valid ? e : 0.f; lw[i] = run;
                asg[i] = sigmoidf_(AL[t * FP + l] + a0c);
            }
            OT[w * 64 + l] = run;
        }
        __syncthreads();
        {
            float off = 0.f, tot = 0.f;
#pragma unroll
            for (int ww = 0; ww < 8; ++ww) { const float o = OT[ww * 64 + l]; tot += o; off += ww < w ? o : 0.f; }
            if (w == 0) GL[l] = __expf(tot);
            const float kkc = F.in[IN_KK][ch], kac = F.in[IN_KA][ch], rkc = F.in[IN_RK][ch];
            unsigned atc[4], vc[4], bhc[4], khc[4];
            float prevlg = off;
#pragma unroll
            for (int i = 0; i < 8; ++i) {
                const int t = 8 * w + i;
                const float lg = off + lw[i];
                const float g = __expf(lg), gp = __expf(prevlg), gi = __expf(-lg), gh = __expf(tot - lg);
                prevlg = lg;
                const float kkr = k_s[i] * kkc;
                const float kk = kkr * __builtin_amdgcn_rsqf(fmaxf(wave_sum(kkr * kkr), 1e-24f));
                const float k2 = k_s[i] * (1.f + (asg[i] - 1.f) * kac);
                const float bon = wave_sum(r_s[i] * k2 * rkc);
                if (l == 0) BONUS[(size_t)u * 64 + t] = bon;
                const float at = -kk * gp, rt = r_s[i] * g, bt = kk * asg[i] * gi, kt = k2 * gi, bh = kk * asg[i] * gh, kh = k2 * gh;
                SL(0)[t * RP + l] = (bf16)f2bf(at); SL(1)[t * RP + l] = (bf16)f2bf(rt); SL(2)[t * RP + l] = (bf16)f2bf(bt); SL(3)[t * RP + l] = (bf16)f2bf(kt);
                const unsigned ua = f2bf(at), uv = f2bf(v_s[i]), ub = f2bf(bh), uk = f2bf(kh);
                if (i & 1) { atc[i >> 1] |= ua << 16; vc[i >> 1] |= uv << 16; bhc[i >> 1] |= ub << 16; khc[i >> 1] |= uk << 16; }
                else { atc[i >> 1] = ua; vc[i >> 1] = uv; bhc[i >> 1] = ub; khc[i >> 1] = uk; }
            }
            *(LAS v4u*)(SL(4) + l * RP + 8 * w) = (v4u){atc[0], atc[1], atc[2], atc[3]};
            *(LAS v4u*)(SL(5) + l * RP + 8 * w) = (v4u){vc[0], vc[1], vc[2], vc[3]};
            *(LAS v4u*)(SL(6) + l * RP + 8 * w) = (v4u){bhc[0], bhc[1], bhc[2], bhc[3]};
            *(LAS v4u*)(SL(7) + l * RP + 8 * w) = (v4u){khc[0], khc[1], khc[2], khc[3]};
        }
        __syncthreads();
        B1T(3);
        for (int task = w; task < 20; task += 8) {
            int pid, qr, qc; bool zero = false;
            if (task < 15) { pid = task / 3; const int k = task % 3;
                if (pid == 1) { qc = k == 2 ? 1 : 0; qr = k == 0 ? 0 : 1; } else { qc = k == 0 ? 0 : 1; qr = k == 2 ? 1 : 0; } }
            else { pid = task - 15; zero = true; if (pid == 1) { qc = 1; qr = 0; } else { qc = 0; qr = 1; } }
            const int bop = pid == 0 ? 0 : pid == 1 ? 2 : pid == 2 ? 0 : 1;
            const int aop = pid == 0 ? 2 : pid == 1 ? 0 : pid == 2 ? 3 : pid == 3 ? 2 : 3;
            f32x16 acc = zero16();
            if (!zero) {
                quad_mma(acc, SL(aop), SL(bop), qr, qc, l);
                const int n = 32 * qc + (l & 31), hf = l >> 5;
#pragma unroll
                for (int j = 0; j < 16; ++j) {
                    const int m = ACC_M(qr, j, hf);
                    const bool keep = pid == 1 ? (m > n) : (pid <= 2 ? (n > m) : (n >= m));
                    acc[j] = keep ? acc[j] : 0.f;
                }
            }
            store_T(acc, SL(8 + pid), qr, qc, l);
        }
        __syncthreads();
        B1T(4);
        const int nq = w & 3, nqr = nq >> 1, nqc = nq & 1;
        f32x16 nacc = zero16();
        if (w < 4) { add_T(nacc, SL(8), nqr, nqc, l); }
        for (int task = w; task < 12; task += 8) {
            const int pid = task >> 2, q = task & 3, qr = q >> 1, qc = q & 1;
            f32x16 acc = zero16();
            if (pid == 0) { quad_mma(acc, SL(9), SL(8), qr, qc, l); store_T(acc, SL(0), qr, qc, l); }
            else if (pid == 1) { quad_mma(acc, SL(8), SL(9), qr, qc, l); store_T(acc, SL(2), qr, qc, l); }
            else { quad_mma(acc, SL(10), SL(5), qr, qc, l); store_T(acc, SL(3), qr, qc, l); }
        }
        __syncthreads();
#pragma unroll
        for (int st = 0; st < 4; ++st) {
            const int pr = (st & 1) ? 10 : 0, pc = (st & 1) ? 13 : 2, pr2 = (st & 1) ? 0 : 10, pc2 = (st & 1) ? 2 : 13, nr = (st & 1) ? 9 : 8, nr2 = (st & 1) ? 8 : 9;
            if (w < 4) {
                add_T(nacc, SL(pr), nqr, nqc, l);
                quad_mma(nacc, SL(pc), SL(nr), nqr, nqc, l);
                store_T(nacc, SL(nr2), nqr, nqc, l);
                f32x16 acc = zero16();
                quad_mma(acc, SL(pc), SL(pr), nqr, nqc, l); store_T(acc, SL(pr2), nqr, nqc, l);
            } else {
                f32x16 acc = zero16();
                quad_mma(acc, SL(pr), SL(pc), nqr, nqc, l); store_T(acc, SL(pc2), nqr, nqc, l);
            }
            __syncthreads();
        }
        if (w < 4) { add_T(nacc, SL(0), nqr, nqc, l); quad_mma(nacc, SL(2), SL(8), nqr, nqc, l); store_T(nacc, SL(9), nqr, nqc, l); }
        __syncthreads();
        B1T(5);
        b1_load_raw(P, u + F.G < NUNITS ? u + F.G : u, w, l, rnx);
        {
            const int pid = w >> 2;
            f32x16 acc = zero16();
            add_T(acc, SL(pid ? 3 : 4), nqr, nqc, l);
            quad_mma(acc, SL(9), SL(pid ? 3 : 4), nqr, nqc, l);
            store_T(acc, SL(pid ? 2 : 0), nqr, nqc, l);
        }
        LDS_BARRIER();
        for (int task = w; task < 16; task += 8) {
            const int pid = task >> 2, q = task & 3, qr = q >> 1, qc = q & 1;
            f32x16 acc = zero16();
            if (pid == 0) { add_T(acc, SL(1), qr, qc, l); quad_mma(acc, SL(0), SL(11), qr, qc, l); store_T_global<true>(acc, RWQ + (size_t)u * 4096, qr, qc, l); }
            else if (pid == 1) { quad_mma(acc, SL(2), SL(11), qr, qc, l); quad_mma(acc, SL(5), SL(12), qr, qc, l); store_T_global<false>(acc, RWY + (size_t)u * 4096, qr, qc, l); }
            else if (pid == 2) {
                quad_mma(acc, SL(0), SL(6), qr, qc, l);
                const int n = 32 * qc + (l & 31), hf = l >> 5; const float gl = GL[n];
#pragma unroll
                for (int j = 0; j < 16; ++j) acc[j] += (ACC_M(qr, j, hf) == n) ? gl : 0.f;
                store_T_global<true>(acc, RWM + (size_t)u * 4096, qr, qc, l);
            } else { quad_mma(acc, SL(6), SL(2), qr, qc, l); quad_mma(acc, SL(7), SL(5), qr, qc, l); store_T_global<false>(acc, RWN + (size_t)u * 4096, qr, qc, l); }
        }
        B1T(6);
    }
#ifdef PROBE_B1SEC
    if (blockIdx.x == 0 && F.tid == 0) { F.MISC[20] = (unsigned)b1acc; }
#endif
#undef SL
}

__device__ __forceinline__ void rw_b2(Frame& F) {
    if (blockIdx.x >= 32) return;
    const bf16* RWM = WSP(bf16, WS_RWM); const bf16* RWN = WSP(bf16, WS_RWN);
    bf16* RWS = (bf16*)((char*)F.out + OUT_RWS);
    const int b = blockIdx.x >> 3, h = blockIdx.x & 7, w = F.wave, l = F.lane;
    LAS unsigned char* L = F.lds;
#define SS(buf, part) ((LAS bf16*)(L + ((buf) * 2 + (part)) * SLOT))
    const int q = w & 3, qr = q >> 1, qc = q & 1, r = l & 31, hf = l >> 5;
    if (w < 4) {
        const bf16* Nm = RWN + (size_t)(4096 + h) * 4096;
#pragma unroll
        for (int jj = 0; jj < 4; ++jj) {
            const v2u wv = *(const v2u*)(Nm + acc_off(32 * qc + r, 32 * qr + 8 * jj + 4 * hf));
            *(LAS v2u*)(SS(0, 0) + (32 * qc + r) * RP + 32 * qr + 8 * jj + 4 * hf) = wv;
            *(LAS v2u*)(SS(0, 1) + (32 * qc + r) * RP + 32 * qr + 8 * jj + 4 * hf) = (v2u){0u, 0u};
        }
    }
    __syncthreads();
    bf16x8 a_cur[4]; v2u n_cur[4];
    {
        const size_t u0 = (size_t)(b * 8 + h) * 128;
#pragma unroll
        for (int ks = 0; ks < 4; ++ks) a_cur[ks] = *(const bf16x8*)(RWM + u0 * 4096 + frag_off(32 * qr + r, 16 * ks + 8 * hf));
#pragma unroll
        for (int jj = 0; jj < 4; ++jj) n_cur[jj] = *(const v2u*)(RWN + u0 * 4096 + acc_off(32 * qc + r, 32 * qr + 8 * jj + 4 * hf));
    }
    for (int c = 0; c < 128; ++c) {
        const int u = (b * 8 + h) * 128 + c, cur = c & 1;
        if (w < 4) {
            bf16x8 a_nxt[4]; v2u n_nxt[4];
            const size_t un = (size_t)(c + 1 < 128 ? u + 1 : u);
#pragma unroll
            for (int ks = 0; ks < 4; ++ks) a_nxt[ks] = *(const bf16x8*)(RWM + un * 4096 + frag_off(32 * qr + r, 16 * ks + 8 * hf));
#pragma unroll
            for (int jj = 0; jj < 4; ++jj) n_nxt[jj] = *(const v2u*)(RWN + un * 4096 + acc_off(32 * qc + r, 32 * qr + 8 * jj + 4 * hf));
            f32x16 acc;
#pragma unroll
            for (int jj = 0; jj < 4; ++jj) { acc[4 * jj] = bflo(n_cur[jj].x); acc[4 * jj + 1] = bfhi(n_cur[jj].x); acc[4 * jj + 2] = bflo(n_cur[jj].y); acc[4 * jj + 3] = bfhi(n_cur[jj].y); }
#pragma unroll
            for (int jj = 0; jj < 4; ++jj)
                *(v2u*)(RWS + (size_t)u * 4096 + frag_off(32 * qc + r, 32 * qr + 8 * jj + 4 * hf)) = *(const LAS v2u*)(SS(cur, 0) + (32 * qc + r) * RP + 32 * qr + 8 * jj + 4 * hf);
            const LAS bf16* bh = SS(cur, 0) + (32 * qc + r) * RP + 8 * hf; const LAS bf16* bl = SS(cur, 1) + (32 * qc + r) * RP + 8 * hf;
#pragma unroll
            for (int ks = 0; ks < 4; ++ks) {
                acc = __builtin_amdgcn_mfma_f32_32x32x16_bf16(a_cur[ks], *(const LAS bf16x8*)(bh + 16 * ks), acc, 0, 0, 0);
                acc = __builtin_amdgcn_mfma_f32_32x32x16_bf16(a_cur[ks], *(const LAS bf16x8*)(bl + 16 * ks), acc, 0, 0, 0);
            }
#pragma unroll
            for (int jj = 0; jj < 4; ++jj) {
                float hi[4], lo[4];
#pragma unroll
                for (int e = 0; e < 4; ++e) { const unsigned hb = f2bf(acc[4 * jj + e]); hi[e] = __uint_as_float(hb << 16); lo[e] = acc[4 * jj + e] - hi[e]; }
                *(LAS v2u*)(SS(cur ^ 1, 0) + (32 * qc + r) * RP + 32 * qr + 8 * jj + 4 * hf) = (v2u){pk2(hi[0], hi[1]), pk2(hi[2], hi[3])};
                *(LAS v2u*)(SS(cur ^ 1, 1) + (32 * qc + r) * RP + 32 * qr + 8 * jj + 4 * hf) = (v2u){pk2(lo[0], lo[1]), pk2(lo[2], lo[3])};
            }
#pragma unroll
            for (int ks = 0; ks < 4; ++ks) a_cur[ks] = a_nxt[ks];
#pragma unroll
            for (int jj = 0; jj < 4; ++jj) n_cur[jj] = n_nxt[jj];
        }
        LDS_BARRIER();
    }
#undef SS
}

__device__ __forceinline__ void rw_b3(Frame& F, bool meta_only = false) {
    const bf16* P = WSP(bf16, WS_P); bf16* QA = WSP(bf16, WS_QA);
    const bf16* RWQ = WSP(bf16, WS_RWQ); const bf16* RWY = WSP(bf16, WS_RWY);
    const bf16* RWS = (const bf16*)((const char*)F.out + OUT_RWS); const float* BONUS = (const float*)((const char*)F.out + OUT_BONUS);
    const bf16* WgT = WSP(bf16, WS_WT_LORA) + 2 * 512 * 64;
    const float* mu = F.in[IN_MU];
    const int l = F.lane, r = l & 31, hf = l >> 5;
    const int gw = blockIdx.x * NWAVES + F.wave, NGW = F.G * NWAVES;
    for (int it = meta_only ? 8192 + F.wave : gw; it < (meta_only ? 8200 : 8192); it += meta_only ? NWAVES : NGW) {
        const int u = it < 8192 ? it >> 1 : 4096 + (it - 8192), th = it < 8192 ? (it & 1) : 0;
        const bool meta = u >= 4096;
        int b = 0, h, c = 0; if (meta) h = u - 4096; else { b = u >> 10; h = (u >> 7) & 7; c = u & 127; }
        const int t = 32 * th + r;
        const bool valid = !meta || t < NMETA;
        const int row0 = meta ? NREAL : b * SEQ + c * 64;
        const int row = valid ? row0 + t : row0;
        int prow = -1;
        if (t > 0) prow = row - 1; else if (!meta) prow = (c == 0) ? NREAL + NMETA - 1 : row - 1;
        LAS unsigned char* tg = F.lds + F.wave * 16384;
        LAS unsigned char* tv = tg + 9216;
        {
            const int rfirst = row0 + 32 * th;
            const int rprev0 = th ? rfirst - 1 : (meta ? -1 : ((c == 0) ? NREAL + NMETA - 1 : rfirst - 1));
            const int rmax = meta ? NREAL + NMETA - 1 : rfirst + 31;
            asm volatile("s_waitcnt lgkmcnt(0)" ::: "memory");
#pragma unroll
            for (int i = 0; i < 9; ++i) {
                const int tr = 4 * i + (l >> 4), ch16 = l & 15;
                if (tr <= 32) {
                    int gr_ = tr == 0 ? rprev0 : rfirst + tr - 1; const bool z = gr_ < 0; gr_ = z ? rfirst : (gr_ > rmax ? rmax : gr_);
                    v4u d = *(const v4u*)(P + (size_t)gr_ * PW + PC_GD + 8 * ch16); if (z) d = (v4u){0u, 0u, 0u, 0u};
                    *(LAS v4u*)(tg + tr * 272 + 16 * ch16) = d;
                }
            }
#pragma unroll
            for (int i = 0; i < 5; ++i) {
                const int tr = 8 * i + (l >> 3), ch8 = l & 7;
                if (tr <= 32) {
                    int gr_ = tr == 0 ? rprev0 : rfirst + tr - 1; const bool z = gr_ < 0; gr_ = z ? rfirst : (gr_ > rmax ? rmax : gr_);
                    v4u d = *(const v4u*)(P + (size_t)gr_ * PW + PC_V + h * 64 + 8 * ch8); if (z) d = (v4u){0u, 0u, 0u, 0u};
                    *(LAS v4u*)(tv + tr * 144 + 16 * ch8) = d;
                }
            }
            asm volatile("s_waitcnt lgkmcnt(0)" ::: "memory");
        }
        f32x16 y[2];
#pragma unroll
        for (int qv = 0; qv < 2; ++qv) {
            const bf16* Y0 = RWY + (size_t)u * 4096;
#pragma unroll
            for (int jj = 0; jj < 4; ++jj) { const v2u wv = *(const v2u*)(Y0 + acc_off(32 * th + r, 32 * qv + 8 * jj + 4 * hf)); y[qv][4 * jj] = bflo(wv.x); y[qv][4 * jj + 1] = bfhi(wv.x); y[qv][4 * jj + 2] = bflo(wv.y); y[qv][4 * jj + 3] = bfhi(wv.y); }
        }
        if (!meta) {
            const bf16* qp = RWQ + (size_t)u * 4096; const bf16* sp = RWS + (size_t)u * 4096;
#pragma unroll
            for (int ks = 0; ks < 4; ++ks) {
                const bf16x8 bq = *(const bf16x8*)(qp + frag_off(32 * th + r, 16 * ks + 8 * hf));
                y[0] = __builtin_amdgcn_mfma_f32_32x32x16_bf16(*(const bf16x8*)(sp + frag_off(r, 16 * ks + 8 * hf)), bq, y[0], 0, 0, 0);
                y[1] = __builtin_amdgcn_mfma_f32_32x32x16_bf16(*(const bf16x8*)(sp + frag_off(32 + r, 16 * ks + 8 * hf)), bq, y[1], 0, 0, 0);
            }
        }
        f32x16 g[2]; g[0] = zero16(); g[1] = zero16();
        {
            const LAS unsigned char* gpl = tg + (r + 1) * 272 + 16 * hf; const LAS unsigned char* gppl = tg + r * 272 + 16 * hf;
            const bf16* wp = WgT + (size_t)(h * 64 + r) * 128 + 8 * hf;
#pragma unroll
            for (int ks = 0; ks < 8; ++ks) {
                const v4u cg = *(const LAS v4u*)(gpl + 32 * ks); const v4u pg = *(const LAS v4u*)(gppl + 32 * ks);
                const f32x4 m0 = *(const f32x4*)(mu + 1664 + 16 * ks + 8 * hf), m1 = *(const f32x4*)(mu + 1664 + 16 * ks + 8 * hf + 4);
                const unsigned cw[4] = {cg.x, cg.y, cg.z, cg.w}, pw[4] = {pg.x, pg.y, pg.z, pg.w}; const float mm[8] = {m0.x, m0.y, m0.z, m0.w, m1.x, m1.y, m1.z, m1.w};
                unsigned o[4];
#pragma unroll
                for (int e = 0; e < 4; ++e) {
                    const float c0 = bflo(cw[e]), c1 = bfhi(cw[e]), p0 = bflo(pw[e]), p1 = bfhi(pw[e]);
                    o[e] = pk2(sigmoidf_(c0 + (p0 - c0) * mm[2 * e]), sigmoidf_(c1 + (p1 - c1) * mm[2 * e + 1]));
                }
                const v4u ov = (v4u){o[0], o[1], o[2], o[3]};
                const bf16x8 bs = __builtin_bit_cast(bf16x8, ov);
                g[0] = __builtin_amdgcn_mfma_f32_32x32x16_bf16(*(const bf16x8*)(wp + 16 * ks), bs, g[0], 0, 0, 0);
                g[1] = __builtin_amdgcn_mfma_f32_32x32x16_bf16(*(const bf16x8*)(wp + 32 * 128 + 16 * ks), bs, g[1], 0, 0, 0);
            }
        }
        float s = 0.f;
#pragma unroll
        for (int j = 0; j < 16; ++j) s += y[0][j] + y[1][j];
        s += __shfl_xor(s, 32);
        const float mean = s * (1.f / 64.f);
        float s2 = 0.f;
#pragma unroll
        for (int j = 0; j < 16; ++j) { const float d0 = y[0][j] - mean, d1 = y[1][j] - mean; s2 += d0 * d0 + d1 * d1; }
        s2 += __shfl_xor(s2, 32);
        const float rstd = 1.0f / sqrtf(s2 * (1.f / 64.f) + GN_EPS);
        const float bon = BONUS[(size_t)u * 64 + t];
        if (valid) {
#pragma unroll
            for (int qv = 0; qv < 2; ++qv)
#pragma unroll
                for (int jj = 0; jj < 4; ++jj) {
                    const int v0 = 32 * qv + 8 * jj + 4 * hf, chv = h * 64 + v0;
                    const v2u cvw = *(const LAS v2u*)(tv + (r + 1) * 144 + 2 * v0); const v2u pvw = *(const LAS v2u*)(tv + r * 144 + 2 * v0);
                    const f32x4 mv = *(const f32x4*)(mu + 1024 + chv), gg = *(const f32x4*)(F.in[IN_GN_G] + chv), gb = *(const f32x4*)(F.in[IN_GN_B] + chv);
                    const float cv[4] = {bflo(cvw.x), bfhi(cvw.x), bflo(cvw.y), bfhi(cvw.y)}, pv[4] = {bflo(pvw.x), bfhi(pvw.x), bflo(pvw.y), bfhi(pvw.y)};
                    const float mvv[4] = {mv.x, mv.y, mv.z, mv.w}, ggv[4] = {gg.x, gg.y, gg.z, gg.w}, gbv[4] = {gb.x, gb.y, gb.z, gb.w};
                    float o[4];
#pragma unroll
                    for (int e = 0; e < 4; ++e) {
                        const float vs = cv[e] + (pv[e] - cv[e]) * mvv[e];
                        o[e] = ((y[qv][4 * jj + e] - mean) * rstd * ggv[e] + gbv[e] + bon * vs) * g[qv][4 * jj + e];
                    }
                    *(v2u*)(QA + (size_t)row * QAW + 1024 + chv) = (v2u){pk2(o[0], o[1]), pk2(o[2], o[3])};
                }
        }
    }
}

constexpr int IX_CAP = 512, IX_LIST = 3072, IX_KB = 98304, IX_SCR = RING_BYTES + 4096;
#define IX_FENCE() asm volatile("s_waitcnt lgkmcnt(0)" ::: "memory")
#define IX_ORDER() asm volatile("" ::: "memory")

__device__ __forceinline__ unsigned ix_mbcnt(unsigned long long m) { return __builtin_amdgcn_mbcnt_hi((unsigned)(m >> 32), __builtin_amdgcn_mbcnt_lo((unsigned)m, 0u)); }

__device__ __forceinline__ void ix_select_slow(const float (&sc)[8], const unsigned (&ix)[8], bool (&vl)[8], int K, unsigned short* sel_out, int lane) {
    for (int it = 0; it < K; ++it) {
        unsigned long long best = 0ull;
#pragma unroll
        for (int i = 0; i < 8; ++i) { const unsigned long long key = ((unsigned long long)sortable(sc[i]) << 32) | (unsigned long long)(0xFFFFu - ix[i]) | 0x10000ull; if (vl[i] && key > best) best = key; }
        unsigned long long wm = best;
#pragma unroll
        for (int o = 1; o < 64; o <<= 1) { const unsigned long long v = __shfl_xor(wm, o); wm = v > wm ? v : wm; }
        if (wm == 0ull) break;
        const bool mine = best == wm;
#pragma unroll
        for (int i = 0; i < 8; ++i) { const unsigned long long key = ((unsigned long long)sortable(sc[i]) << 32) | (unsigned long long)(0xFFFFu - ix[i]) | 0x10000ull; if (mine && vl[i] && key == wm) { vl[i] = false; sel_out[it] = (unsigned short)ix[i]; } }
    }
}

__device__ __forceinline__ void ix_compact(LAS float* LS, LAS unsigned short* LI, LAS unsigned* hist, int& cnt, float& tau, int lane, bool final_sel, unsigned short* sel_out) {
    const int n = cnt;
    float sc[8]; unsigned ix[8]; bool vl[8];
    IX_FENCE();
#pragma unroll
    for (int i = 0; i < 8; ++i) { const int p = lane + 64 * i; vl[i] = p < n; sc[i] = vl[i] ? LS[p] : -INFINITY; ix[i] = vl[i] ? (unsigned)LI[p] : 0u; }
    float mx = -INFINITY, mn = INFINITY;
#pragma unroll
    for (int i = 0; i < 8; ++i) { if (vl[i]) { mx = fmaxf(mx, sc[i]); mn = fminf(mn, sc[i]); } }
    mx = wave_max(mx); mn = -wave_max(-mn);
    const float scale = mx > mn ? 255.99f / (mx - mn) : 0.f;
    int bin[8];
#pragma unroll
    for (int i = 0; i < 8; ++i) { int bq = (int)((sc[i] - mn) * scale); bq = bq > 255 ? 255 : (bq < 0 ? 0 : bq); bin[i] = vl[i] ? bq : -1; }
    *(LAS v4u*)(hist + 4 * lane) = (v4u){0u, 0u, 0u, 0u};
    IX_FENCE();
#pragma unroll
    for (int i = 0; i < 8; ++i) if (vl[i]) __hip_atomic_fetch_add((LAS unsigned*)&hist[bin[i]], 1u, __ATOMIC_RELAXED, __HIP_MEMORY_SCOPE_WAVEFRONT);
    IX_FENCE();
    const v4u c = *(const LAS v4u*)(hist + 4 * lane);
    const unsigned Pp = wave_scan_incl(c.x + c.y + c.z + c.w, lane);
    const unsigned total = (unsigned)__builtin_amdgcn_readlane((int)Pp, 63);
    const unsigned K = TOPK;
    const unsigned a3 = total - Pp, a2 = a3 + c.w, a1 = a2 + c.z, a0 = a1 + c.y;
    int myb = -1; unsigned myA = 0u, myC = 0u;
    if (a3 < K && K <= a3 + c.w) { myb = 4 * lane + 3; myA = a3; myC = c.w; }
    else if (a2 < K && K <= a2 + c.z) { myb = 4 * lane + 2; myA = a2; myC = c.z; }
    else if (a1 < K && K <= a1 + c.y) { myb = 4 * lane + 1; myA = a1; myC = c.y; }
    else if (a0 < K && K <= a0 + c.x) { myb = 4 * lane; myA = a0; myC = c.x; }
    const unsigned long long bm = __ballot(myb >= 0);
    const int src = bm ? (__ffsll((long long)bm) - 1) : 0;
    const int srcu = __builtin_amdgcn_readfirstlane(src);
    const int bstar = __builtin_amdgcn_readlane(myb, srcu); const unsigned A = (unsigned)__builtin_amdgcn_readlane((int)myA, srcu), m = (unsigned)__builtin_amdgcn_readlane((int)myC, srcu);
    if (!final_sel) {
        if (A + m <= (unsigned)(IX_CAP - 128)) {
            int base = 0; float kmin = INFINITY;
#pragma unroll
            for (int i = 0; i < 8; ++i) {
                const bool keep = vl[i] && bin[i] >= bstar;
                const unsigned long long mk = __ballot(keep);
                const int pos = base + (int)ix_mbcnt(mk);
                if (keep) { LS[pos] = sc[i]; LI[pos] = (unsigned short)ix[i]; kmin = fminf(kmin, sc[i]); }
                base += __popcll(mk);
            }
            cnt = base; tau = -wave_max(-kmin);
            IX_FENCE();
            return;
        }
        unsigned short* tmp = sel_out;
        ix_select_slow(sc, ix, vl, (int)K, tmp, lane);
        int base = 0; float kmin = INFINITY;
#pragma unroll
        for (int i = 0; i < 8; ++i) {
            const bool keep = !vl[i] && (lane + 64 * i) < n;
            const unsigned long long mk = __ballot(keep);
            const int pos = base + (int)ix_mbcnt(mk);
            if (keep) { LS[pos] = sc[i]; LI[pos] = (unsigned short)ix[i]; kmin = fminf(kmin, sc[i]); }
            base += __popcll(mk);
        }
        cnt = base; tau = -wave_max(-kmin);
        IX_FENCE();
        return;
    }
    if (m <= 128u) {
        int base = 0;
#pragma unroll
        for (int i = 0; i < 8; ++i) {
            const bool keep = vl[i] && bin[i] > bstar;
            const unsigned long long mk = __ballot(keep);
            const int pos = base + (int)ix_mbcnt(mk);
            if (keep) sel_out[pos] = (unsigned short)ix[i];
            base += __popcll(mk);
        }
        LAS float* sS = (LAS float*)hist; LAS unsigned* sI = hist + 128;
        IX_FENCE();
        int mb = 0;
#pragma unroll
        for (int i = 0; i < 8; ++i) {
            const bool inb = vl[i] && bin[i] == bstar;
            const unsigned long long mk = __ballot(inb);
            const int pos = mb + (int)ix_mbcnt(mk);
            if (inb) { sS[pos] = sc[i]; sI[pos] = ix[i]; }
            mb += __popcll(mk);
        }
        IX_FENCE();
        const int need = (int)(K - A);
#pragma unroll
        for (int e = 0; e < 2; ++e) {
            const int j = lane + 64 * e;
            if (j < (int)m) {
                const float sj = sS[j]; const unsigned ij = sI[j]; int rank = 0;
                for (int k = 0; k < (int)m; ++k) { const float sk = sS[k]; const unsigned ik = sI[k]; rank += (sk > sj || (sk == sj && ik < ij)) ? 1 : 0; }
                if (rank < need) sel_out[(int)A + rank] = (unsigned short)ij;
            }
        }
    } else {
        ix_select_slow(sc, ix, vl, (int)K, sel_out, lane);
    }
}

__device__ __forceinline__ void p6_attn_mfma(Frame& F, bf16* OUTB, bool meta_only);
__device__ __forceinline__ void p5_index_mfma(Frame& F, unsigned short* SEL, int* NSEL, int qword = 3072, bool probe_noappend = false, bool do_meta = false) {
    const bf16* QA = WSP(bf16, WS_QA); const bf16* KIDX = WSP(bf16, WS_KIDX); const float* WIDX = WSP(float, WS_WIDX);
    const int tid = F.tid, w = F.wave, l = F.lane, r = l & 31, hf = l >> 5;
    {
        const int gw = blockIdx.x * NWAVES + w, NGW = F.G * NWAVES;
        for (int i = gw; i < NMETA + BATCH * 192; i += NGW) {
            int q, nvis; if (i < NMETA) { q = NREAL + i; nvis = NMETA; } else { const int bb = (i - NMETA) / 192, s = (i - NMETA) % 192; q = bb * SEQ + s; nvis = NMETA + 64 * (s / 64 + 1); }
            for (int j = l; j < nvis; j += 64) SEL[(size_t)q * TOPK + j] = (unsigned short)j;
            if (l == 0) NSEL[q] = nvis;
        }
    }
    LAS unsigned char* L = F.lds;
    LAS unsigned* hist = (LAS unsigned*)(L + IX_SCR + w * 1024);
    if (do_meta) {
        __syncthreads();
        if (tid == 0) F.MISC[17] = __hip_atomic_fetch_add((unsigned*)F.ctl + 3200, 1u, __ATOMIC_RELAXED, __HIP_MEMORY_SCOPE_AGENT);
        __syncthreads();
        const int mt = (int)F.MISC[17];
        if (mt == 0) {
            if (tid < NMETA) { for (int j = 0; j < NMETA; ++j) SEL[(size_t)(NREAL + tid) * TOPK + j] = (unsigned short)j; NSEL[NREAL + tid] = NMETA; }
            asm volatile("s_waitcnt vmcnt(0)" ::: "memory"); __syncthreads();
            p6_attn_mfma(F, WSP(bf16, WS_QA), true);
        } else if (mt == 1) { rw_b3(F, true); }
        __syncthreads();
    }
    {
        for (;;) {
            __syncthreads();
            if (tid == 0) F.MISC[16] = __hip_atomic_fetch_add((unsigned*)F.ctl + qword, 1u, __ATOMIC_RELAXED, __HIP_MEMORY_SCOPE_AGENT);
            __syncthreads();
            const int qi_ = (int)F.MISC[16];
            if (qi_ >= 1000) break;
            const int tile = 999 - qi_;
            const int pt = 6 + (tile >> 2), b = tile & 3;
            const int q0 = b * SEQ + pt * 32;
            const int nvis = NMETA + 64 * (pt / 2 + 1);
            __syncthreads();
            bf16x8 af[4];
            {
                const int qq = 2 * (r >> 4) + ((r >> 2) & 1), hd = 4 * ((r >> 3) & 1) + (r & 3);
                const bf16* qp = QA + (size_t)(q0 + 4 * w + qq) * QAW + 1024 + hd * 64 + 8 * hf;
#pragma unroll
                for (int ks = 0; ks < 4; ++ks) af[ks] = *(const bf16x8*)(qp + 16 * ks);
            }
            float wq[2][8];
#pragma unroll
            for (int a = 0; a < 2; ++a) {
                const f32x4 w0 = *(const f32x4*)(WIDX + (size_t)(q0 + 4 * w + 2 * a + hf) * 8), w1 = *(const f32x4*)(WIDX + (size_t)(q0 + 4 * w + 2 * a + hf) * 8 + 4);
                wq[a][0] = 0.5f * w0.x; wq[a][1] = 0.5f * w0.y; wq[a][2] = 0.5f * w0.z; wq[a][3] = 0.5f * w0.w; wq[a][4] = 0.5f * w1.x; wq[a][5] = 0.5f * w1.y; wq[a][6] = 0.5f * w1.z; wq[a][7] = 0.5f * w1.w;
            }
            float tau0 = -INFINITY, tau1 = -INFINITY;
            int cnt[4] = {0, 0, 0, 0};
            const int nblk = (nvis + 255) >> 8;
            v4u kreg[4];
#pragma unroll
            for (int e = 0; e < 4; ++e) {
                const int pid = tid + 512 * e, kl = pid >> 3, pc = pid & 7, j = kl;
                kreg[e] = j < nvis ? *(const v4u*)(KIDX + (size_t)key_row(b, j) * 64 + 8 * pc) : (v4u){0u, 0u, 0u, 0u};
            }
#pragma unroll
            for (int e = 0; e < 4; ++e) { const int pid = tid + 512 * e, kl = pid >> 3, pc = pid & 7; *(LAS v4u*)(L + IX_KB + kl * 128 + ((pc ^ ((kl >> 1) & 7)) << 4)) = kreg[e]; }
            __syncthreads();
            const LAS unsigned char* kb = L + IX_KB;
            for (int blk = 0; blk < nblk; ++blk) {
                if (blk + 1 < nblk) {
#pragma unroll
                    for (int e = 0; e < 4; ++e) {
                        const int pid = tid + 512 * e, kl = pid >> 3, pc = pid & 7, j = (blk + 1) * 256 + kl;
                        kreg[e] = j < nvis ? *(const v4u*)(KIDX + (size_t)key_row(b, j) * 64 + 8 * pc) : (v4u){0u, 0u, 0u, 0u};
                    }
                }
                int npair = (nvis - blk * 256 + 63) >> 6; npair = npair > 4 ? 4 : npair;
                bf16x8 bc0[4], bc1[4];
#pragma unroll
                for (int ks = 0; ks < 4; ++ks) { const int k0 = r, k1 = 32 + r;
                    bc0[ks] = *(const LAS bf16x8*)(kb + k0 * 128 + (((2 * ks + hf) ^ ((k0 >> 1) & 7)) << 4));
                    bc1[ks] = *(const LAS bf16x8*)(kb + k1 * 128 + (((2 * ks + hf) ^ ((k1 >> 1) & 7)) << 4)); }
                for (int pp = 0; pp < npair; ++pp) {
                    const int jbase = blk * 256 + pp * 64;
                    bf16x8 bn0[4], bn1[4];
                    {
                        const int pn = pp + 1 < npair ? pp + 1 : pp; const int k0 = pn * 64 + r, k1 = k0 + 32;
#pragma unroll
                        for (int ks = 0; ks < 4; ++ks) {
                            bn0[ks] = *(const LAS bf16x8*)(kb + k0 * 128 + (((2 * ks + hf) ^ ((k0 >> 1) & 7)) << 4));
                            bn1[ks] = *(const LAS bf16x8*)(kb + k1 * 128 + (((2 * ks + hf) ^ ((k1 >> 1) & 7)) << 4)); }
                    }
                    f32x16 accA = zero16(), accB = zero16();
#pragma unroll
                    for (int ks = 0; ks < 4; ++ks) { accA = __builtin_amdgcn_mfma_f32_32x32x16_bf16(af[ks], bc0[ks], accA, 0, 0, 0); accB = __builtin_amdgcn_mfma_f32_32x32x16_bf16(af[ks], bc1[ks], accB, 0, 0, 0); }
#pragma unroll
                    for (int ks = 0; ks < 4; ++ks) { bc0[ks] = bn0[ks]; bc1[ks] = bn1[ks]; }
                    float sA0 = 0.f, sA0b = 0.f, sA1 = 0.f, sA1b = 0.f, sB0 = 0.f, sB0b = 0.f, sB1 = 0.f, sB1b = 0.f;
#pragma unroll
                    for (int h = 0; h < 8; h += 2) {
                        sA0 = fmaf(wq[0][h], __builtin_fabsf(accA[h]), fmaf(wq[0][h], accA[h], sA0)); sA0b = fmaf(wq[0][h + 1], __builtin_fabsf(accA[h + 1]), fmaf(wq[0][h + 1], accA[h + 1], sA0b));
                        sA1 = fmaf(wq[1][h], __builtin_fabsf(accA[8 + h]), fmaf(wq[1][h], accA[8 + h], sA1)); sA1b = fmaf(wq[1][h + 1], __builtin_fabsf(accA[9 + h]), fmaf(wq[1][h + 1], accA[9 + h], sA1b));
                        sB0 = fmaf(wq[0][h], __builtin_fabsf(accB[h]), fmaf(wq[0][h], accB[h], sB0)); sB0b = fmaf(wq[0][h + 1], __builtin_fabsf(accB[h + 1]), fmaf(wq[0][h + 1], accB[h + 1], sB0b));
                        sB1 = fmaf(wq[1][h], __builtin_fabsf(accB[8 + h]), fmaf(wq[1][h], accB[8 + h], sB1)); sB1b = fmaf(wq[1][h + 1], __builtin_fabsf(accB[9 + h]), fmaf(wq[1][h + 1], accB[9 + h], sB1b));
                    }
                    const float s0A = (sA0 + sA0b) + 0.0f, s1A = (sA1 + sA1b) + 0.0f, s0B = (sB0 + sB0b) + 0.0f, s1B = (sB1 + sB1b) + 0.0f;
                    const int jA = jbase + r, jB = jA + 32;
                    const bool p0A = jA < nvis && s0A > tau0, p1A = jA < nvis && s1A > tau1, p0B = jB < nvis && s0B > tau0, p1B = jB < nvis && s1B > tau1;
                    const unsigned long long m0A = __ballot(p0A), m1A = __ballot(p1A), m0B = __ballot(p0B), m1B = __ballot(p1B);
                    if (m0A | m1A | m0B | m1B) {
                        const int a0lo = __popc((unsigned)m0A), a0hi = __popc((unsigned)(m0A >> 32)), a1lo = __popc((unsigned)m1A), a1hi = __popc((unsigned)(m1A >> 32));
                        const int b0lo = __popc((unsigned)m0B), b0hi = __popc((unsigned)(m0B >> 32)), b1lo = __popc((unsigned)m1B), b1hi = __popc((unsigned)(m1B >> 32));
                        {
                            LAS unsigned char* lb = L + (w * 4 + hf) * IX_LIST;
                            const int base = hf ? cnt[1] : cnt[0];
                            const int posA = base + (int)ix_mbcnt(m0A) - (hf ? a0lo : 0);
                            const int posB = base + (hf ? a0hi : a0lo) + (int)ix_mbcnt(m0B) - (hf ? b0lo : 0);
                            if (p0A) { ((LAS float*)lb)[posA] = s0A; ((LAS unsigned short*)(lb + 2048))[posA] = (unsigned short)jA; }
                            if (p0B) { ((LAS float*)lb)[posB] = s0B; ((LAS unsigned short*)(lb + 2048))[posB] = (unsigned short)jB; }
                        }
                        {
                            LAS unsigned char* lb = L + (w * 4 + 2 + hf) * IX_LIST;
                            const int base = hf ? cnt[3] : cnt[2];
                            const int posA = base + (int)ix_mbcnt(m1A) - (hf ? a1lo : 0);
                            const int posB = base + (hf ? a1hi : a1lo) + (int)ix_mbcnt(m1B) - (hf ? b1lo : 0);
                            if (p1A) { ((LAS float*)lb)[posA] = s1A; ((LAS unsigned short*)(lb + 2048))[posA] = (unsigned short)jA; }
                            if (p1B) { ((LAS float*)lb)[posB] = s1B; ((LAS unsigned short*)(lb + 2048))[posB] = (unsigned short)jB; }
                        }
                        cnt[0] += a0lo + b0lo; cnt[1] += a0hi + b0hi; cnt[2] += a1lo + b1lo; cnt[3] += a1hi + b1hi;
                        if (probe_noappend) { if (cnt[0] >= 256 && hf == 0) tau0 = INFINITY; if (cnt[1] >= 256 && hf == 1) tau0 = INFINITY; if (cnt[2] >= 256 && hf == 0) tau1 = INFINITY; if (cnt[3] >= 256 && hf == 1) tau1 = INFINITY; }
#pragma unroll
                        for (int qq = 0; qq < 4; ++qq) {
                            if (cnt[qq] > IX_CAP - 64) {
                                LAS unsigned char* lb = L + (w * 4 + qq) * IX_LIST;
                                float tq = 0.f; int cq = cnt[qq];
                                ix_compact((LAS float*)lb, (LAS unsigned short*)(lb + 2048), hist, cq, tq, l, false, SEL + (size_t)(q0 + 4 * w + qq) * TOPK);
                                cnt[qq] = __builtin_amdgcn_readfirstlane(cq);
                                if ((qq & 1) == hf) { if (qq < 2) tau0 = tq; else tau1 = tq; }
                            }
                        }
                    }
                }
                __syncthreads();
                if (blk + 1 < nblk) {
#pragma unroll
                    for (int e = 0; e < 4; ++e) { const int pid = tid + 512 * e, kl = pid >> 3, pc = pid & 7; *(LAS v4u*)(L + IX_KB + kl * 128 + ((pc ^ ((kl >> 1) & 7)) << 4)) = kreg[e]; }
                    __syncthreads();
                }
            }
#pragma unroll
            for (int qq = 0; qq < 4; ++qq) {
                LAS unsigned char* lb = L + (w * 4 + qq) * IX_LIST;
                float tq = 0.f; int cq = cnt[qq];
                ix_compact((LAS float*)lb, (LAS unsigned short*)(lb + 2048), hist, cq, tq, l, true, SEL + (size_t)(q0 + 4 * w + qq) * TOPK);
                if (l == 0) NSEL[q0 + 4 * w + qq] = TOPK;
            }
        }
    }
}

#ifndef CHECK_IDX
#define CHECK_IDX 0
#endif
#if CHECK_IDX
__device__ __forceinline__ void idx_check(Frame& F) {
    const unsigned short* SEL = WSP(unsigned short, WS_SEL); const unsigned short* SELB = (const unsigned short*)F.out; const int* NSEL = WSP(int, WS_NSEL); const int* NSELB = (const int*)((const char*)F.out + 32 * MiB);
    LAS unsigned* bm = (LAS unsigned*)(F.lds + F.wave * 2048);
    const int l = F.lane; const int gw = blockIdx.x * NWAVES + F.wave, NGW = F.G * NWAVES;
    unsigned miss = 0, badq = 0, dup = 0;
    for (int q = gw; q < NROWS; q += NGW) {
        for (int i = l; i < 260; i += 64) bm[i] = 0u;
        IX_FENCE();
        const int n = NSEL[q], nb = NSELB[q];
        for (int i = l; i < n; i += 64) { const unsigned j = SEL[(size_t)q * TOPK + i]; atomicOr((unsigned*)&bm[j >> 5], 1u << (j & 31)); }
        IX_FENCE();
        unsigned m = (n != nb) ? 1000u : 0u;
        for (int i = l; i < nb && i < TOPK; i += 64) { const unsigned j = SELB[(size_t)q * TOPK + i]; if (j >= (unsigned)TT) { ++dup; ++m; } else { const unsigned old = atomicAnd((unsigned*)&bm[j >> 5], ~(1u << (j & 31))); if (!((old >> (j & 31)) & 1u)) ++m; } }
        IX_FENCE();
        m = (unsigned)wave_sum((float)m);
        if (l == 0) { miss += m; badq += m ? 1u : 0u; }
    }
    dup = (unsigned)wave_sum((float)dup);
    if (l == 0) { atomicAdd((unsigned*)F.ctl + 2048, miss); atomicAdd((unsigned*)F.ctl + 2049, badq); atomicAdd((unsigned*)F.ctl + 2050, dup); }
}
#endif

typedef short v4i16_t __attribute__((ext_vector_type(4)));
__device__ __forceinline__ unsigned at_off(unsigned row, unsigned ch) { return 256u * row + 16u * (ch ^ (((row & 3u) << 2) | ((row >> 2) & 3u))); }

__device__ __forceinline__ float x4_max(float x) {
    auto s = __builtin_amdgcn_permlane16_swap(__float_as_uint(x), __float_as_uint(x), false, false); x = fmaxf(__uint_as_float(s[0]), __uint_as_float(s[1]));
    auto t = __builtin_amdgcn_permlane32_swap(__float_as_uint(x), __float_as_uint(x), false, false); return fmaxf(__uint_as_float(t[0]), __uint_as_float(t[1]));
}
__device__ __forceinline__ float x4_sum(float x) {
    auto s = __builtin_amdgcn_permlane16_swap(__float_as_uint(x), __float_as_uint(x), false, false); x = __uint_as_float(s[0]) + __uint_as_float(s[1]);
    auto t = __builtin_amdgcn_permlane32_swap(__float_as_uint(x), __float_as_uint(x), false, false); return __uint_as_float(t[0]) + __uint_as_float(t[1]);
}
__device__ __forceinline__ void p6_attn_mfma(Frame& F, bf16* OUTB, bool meta_only = false) {
    bf16* QA = WSP(bf16, WS_QA); const bf16* CKV = WSP(bf16, WS_CKV); const unsigned short* SEL = WSP(unsigned short, WS_SEL); const int* NSEL = WSP(int, WS_NSEL);
    const int l = F.lane, w = F.wave, h16 = l & 15, g = l >> 4;
    LAS unsigned char* tile = F.lds + w * 8192;
    LAS unsigned short* selb = (LAS unsigned short*)(F.lds + 65536 + w * 512);
    const float slope = h16 < 8 ? __uint_as_float((unsigned)(127 - (h16 + 1)) << 23) : 0.f;
    if (!meta_only) {
        const int gw = blockIdx.x * NWAVES + w, NGW = F.G * NWAVES;
        for (int q = NROWS + gw; q < R; q += NGW) { bf16* qrow = QA + (size_t)q * QAW; for (int c = l; c < QAW / 8; c += 64) *(v4u*)(qrow + 8 * c) = (v4u){0u, 0u, 0u, 0u}; }
    }
    if (meta_only) { }
    const int G = F.G;
    int nq_tot, qbase_b, wib, wpb;
    if ((G & 7) == 0) { const int b = (blockIdx.x & 7) >> 1; qbase_b = b * SEQ; nq_tot = SEQ; wib = (((blockIdx.x >> 3) * 2) + (blockIdx.x & 1)) * NWAVES + w; wpb = (G / 4) * NWAVES; }
    else { qbase_b = 0; nq_tot = NREAL; wib = blockIdx.x * NWAVES + w; wpb = G * NWAVES; }
    if (meta_only) { qbase_b = NREAL; nq_tot = NMETA; wib = w; wpb = NWAVES; }
    for (int qi = wib; qi < nq_tot; qi += wpb) {
        int q, b, pos;
        if (meta_only) { q = NREAL + qi; b = 0; pos = qi; }
        else if ((G & 7) == 0) { q = qbase_b + qi; b = q >> 13; pos = NMETA + qi; }
        else { q = qi; b = q >> 13; pos = NMETA + (q & (SEQ - 1)); }
        bf16* qrow = QA + (size_t)q * QAW;
        const int nsel = NSEL[q];
        const int nch = (nsel + 31) >> 5;
        const unsigned short* selq = SEL + (size_t)q * TOPK;
        IX_FENCE();
        if (l < 32) *(LAS v4u*)(selb + 8 * l) = *(const v4u*)(selq + 8 * l);
        IX_FENCE();
        bf16x8 qf[4];
#pragma unroll
        for (int s = 0; s < 4; ++s) { const v4u t = h16 < 8 ? *(const v4u*)(qrow + h16 * 128 + 32 * s + 8 * g) : (v4u){0u, 0u, 0u, 0u}; qf[s] = __builtin_bit_cast(bf16x8, t); }
        float m = -INFINITY, lsum = 0.f;
        f32x4 O[8];
#pragma unroll
        for (int c = 0; c < 8; ++c) O[c] = (f32x4){0.f, 0.f, 0.f, 0.f};
        v4u gr[8];
#pragma unroll
        for (int i = 0; i < 8; ++i) { const int s = g + 4 * i; const int kj = s < nsel ? (int)selb[s] : (int)selb[0]; gr[i] = *(const v4u*)(CKV + (size_t)key_row(b, kj) * 128 + 8 * h16); }
        for (int ck = 0; ck < nch; ++ck) {
            IX_FENCE();
#pragma unroll
            for (int i = 0; i < 8; ++i) *(LAS v4u*)(tile + at_off((unsigned)(g + 4 * i), (unsigned)h16)) = gr[i];
            const v4u kv = *(const LAS v4u*)(selb + 32 * ck + 8 * g);
            if (ck + 1 < nch) {
#pragma unroll
                for (int i = 0; i < 8; ++i) { const int s = 32 * (ck + 1) + g + 4 * i; const int kj = s < nsel ? (int)selb[s] : (int)selb[0]; gr[i] = *(const v4u*)(CKV + (size_t)key_row(b, kj) * 128 + 8 * h16); }
            }
            IX_FENCE();
            f32x4 a0 = (f32x4){0.f, 0.f, 0.f, 0.f}, a1 = a0;
#pragma unroll
            for (int s = 0; s < 4; ++s) {
                const bf16x8 k0 = *(const LAS bf16x8*)(tile + at_off((unsigned)(8 * (h16 >> 2) + (h16 & 3)), (unsigned)(4 * s + g)));
                const bf16x8 k1 = *(const LAS bf16x8*)(tile + at_off((unsigned)(8 * (h16 >> 2) + 4 + (h16 & 3)), (unsigned)(4 * s + g)));
                a0 = __builtin_amdgcn_mfma_f32_16x16x32_bf16(k0, qf[s], a0, 0, 0, 0);
                a1 = __builtin_amdgcn_mfma_f32_16x16x32_bf16(k1, qf[s], a1, 0, 0, 0);
            }
            const unsigned kw[4] = {kv.x, kv.y, kv.z, kv.w};
            float x[8];
#pragma unroll
            for (int j = 0; j < 8; ++j) {
                const int kj = (int)((kw[j >> 1] >> (16 * (j & 1))) & 0xffffu);
                const float lg = (j < 4 ? a0[j & 3] : a1[j & 3]) - slope * fabsf((float)(pos - kj));
                x[j] = (32 * ck + 8 * g + j) < nsel ? lg : -INFINITY;
            }
            float cm = fmaxf(fmaxf(fmaxf(x[0], x[1]), fmaxf(x[2], x[3])), fmaxf(fmaxf(x[4], x[5]), fmaxf(x[6], x[7])));
            cm = x4_max(cm);
            const float mn = fmaxf(m, cm);
            const float alpha = __expf(m - mn);
            float p[8], ps = 0.f;
#pragma unroll
            for (int j = 0; j < 8; ++j) { p[j] = __expf(x[j] - mn); ps += p[j]; }
            ps = x4_sum(ps);
            lsum = lsum * alpha + ps; m = mn;
            if (__any(alpha != 1.0f)) {
#pragma unroll
                for (int rr = 0; rr < 4; ++rr) { const float sc = __shfl(alpha, 4 * g + rr);
#pragma unroll
                    for (int c = 0; c < 8; ++c) O[c][rr] *= sc; }
            }
            const v4u pw = (v4u){pk2(p[0], p[1]), pk2(p[2], p[3]), pk2(p[4], p[5]), pk2(p[6], p[7])};
            const bf16x8 pf = __builtin_bit_cast(bf16x8, pw);
#pragma unroll
            for (int c = 0; c < 8; ++c) {
                const unsigned qd = (unsigned)(h16 >> 2), pp = (unsigned)(h16 & 3);
                const v4i16_t t0 = __builtin_amdgcn_ds_read_tr16_b64_v4i16((LAS v4i16_t*)(tile + at_off(8u * g + qd, 2u * c + (pp >> 1)) + 8u * (pp & 1u)));
                const v4i16_t t1 = __builtin_amdgcn_ds_read_tr16_b64_v4i16((LAS v4i16_t*)(tile + at_off(8u * g + 4u + qd, 2u * c + (pp >> 1)) + 8u * (pp & 1u)));
                bf16x8 vf; vf[0] = t0[0]; vf[1] = t0[1]; vf[2] = t0[2]; vf[3] = t0[3]; vf[4] = t1[0]; vf[5] = t1[1]; vf[6] = t1[2]; vf[7] = t1[3];
                O[c] = __builtin_amdgcn_mfma_f32_16x16x32_bf16(pf, vf, O[c], 0, 0, 0);
            }
        }
        const float inv = 1.0f / lsum;
#pragma unroll
        for (int rr = 0; rr < 4; ++rr) {
            const float sc = __shfl(inv, 4 * g + rr);
            if (g < 2) {
#pragma unroll
                for (int c = 0; c < 8; ++c) (OUTB + (size_t)q * QAW)[(4 * g + rr) * 128 + 16 * c + h16] = (bf16)f2bf(O[c][rr] * sc);
            }
        }
    }
}
struct StoreBf16 { bf16* O; int ld;
    __device__ __forceinline__ void operator()(int row, int col, const f32x4& v) const { *(v2u*)(O + (size_t)row * ld + col) = (v2u){pk2(v.x, v.y), pk2(v.z, v.w)}; }
    __device__ __forceinline__ void two(int row, int col, const f32x4& a, const f32x4& b) const { *(v4u*)(O + (size_t)row * ld + col) = (v4u){pk2(a.x, a.y), pk2(a.z, a.w), pk2(b.x, b.y), pk2(b.z, b.w)}; }
    __device__ __forceinline__ void one(int row, int col, float v) const { O[(size_t)row * ld + col] = (bf16)f2bf(v); } };
struct StoreRes1 { const bf16* H; float* out; float* meta;
    __device__ __forceinline__ void operator()(int row, int col, const f32x4& v) const {
        if (row >= NROWS) return;
        const v2u hw = *(const v2u*)(H + (size_t)row * D + col);
        const f32x4 o = (f32x4){ALPHA * bflo(hw.x) + v.x, ALPHA * bfhi(hw.x) + v.y, ALPHA * bflo(hw.y) + v.z, ALPHA * bfhi(hw.y) + v.w};
        float* dst = row < NREAL ? out + (size_t)row * D + col : meta + (size_t)(row - NREAL) * D + col;
        *(f32x4*)dst = o; }
    __device__ __forceinline__ void two(int row, int col, const f32x4& a, const f32x4& b) const {
        const v4u hw = *(const v4u*)(H + (size_t)row * D + col);
        float* dst = out + (size_t)row * D + col;
        *(f32x4*)dst = (f32x4){ALPHA * bflo(hw.x) + a.x, ALPHA * bfhi(hw.x) + a.y, ALPHA * bflo(hw.y) + a.z, ALPHA * bfhi(hw.y) + a.w};
        *(f32x4*)(dst + 4) = (f32x4){ALPHA * bflo(hw.z) + b.x, ALPHA * bfhi(hw.z) + b.y, ALPHA * bflo(hw.w) + b.z, ALPHA * bfhi(hw.w) + b.w}; }
    __device__ __forceinline__ void one(int row, int col, float v) const { if (row >= NROWS) return; float* dst = row < NREAL ? out + (size_t)row * D + col : meta + (size_t)(row - NREAL) * D + col; *dst = ALPHA * bf2f(H[(size_t)row * D + col]) + v; } };
struct StoreRes2 { const bf16* H; float* out;
    __device__ __forceinline__ void two(int row, int col, const f32x4& a, const f32x4& b) const {
        const v4u hw = *(const v4u*)(H + (size_t)row * D + col);
        float* dst = out + (size_t)row * D + col;
        *(f32x4*)dst = (f32x4){ALPHA * bflo(hw.x) + a.x, ALPHA * bfhi(hw.x) + a.y, ALPHA * bflo(hw.y) + a.z, ALPHA * bfhi(hw.y) + a.w};
        *(f32x4*)(dst + 4) = (f32x4){ALPHA * bflo(hw.z) + b.x, ALPHA * bfhi(hw.z) + b.y, ALPHA * bflo(hw.w) + b.z, ALPHA * bfhi(hw.w) + b.w}; }
    __device__ __forceinline__ void operator()(int row, int col, const f32x4& v) const {
        if (row >= NREAL) return;
        const v2u hw = *(const v2u*)(H + (size_t)row * D + col);
        *(f32x4*)(out + (size_t)row * D + col) = (f32x4){ALPHA * bflo(hw.x) + v.x, ALPHA * bfhi(hw.x) + v.y, ALPHA * bflo(hw.y) + v.z, ALPHA * bfhi(hw.y) + v.w}; } };

struct StoreMetaGate { float* GM; __device__ __forceinline__ void one(int row, int col, float v) const { const int m = row - NREAL, x = col & 255; if (m >= 14 && x < 128) GM[(size_t)(m - 14) * DFF + 128 * (col >> 8) + x] = v; } };
template <class Fn>
__device__ __forceinline__ void meta_gemm(Frame& F, const bf16* A, int lda, const bf16* Bt, int N, int K, const Fn& fn) {
    const int l = F.lane, i16 = l & 15, g = l >> 4;
    const int gw = blockIdx.x * NWAVES + F.wave, NGW = F.G * NWAVES;
    for (int t = gw; t < N / 16; t += NGW) {
        const bf16* ap = A + (size_t)(NREAL + i16) * lda + 8 * g; const bf16* bp = Bt + (size_t)(16 * t + i16) * K + 8 * g;
        f32x4 acc = (f32x4){0.f, 0.f, 0.f, 0.f};
#pragma unroll 8
        for (int s = 0; s < K / 32; ++s) acc = __builtin_amdgcn_mfma_f32_16x16x32_bf16(*(const pg8::bf16x8*)(ap + 32 * s), *(const pg8::bf16x8*)(bp + 32 * s), acc, 0, 0, 0);
#pragma unroll
        for (int rr = 0; rr < 4; ++rr) fn.one(NREAL + 4 * g + rr, 16 * t + i16, acc[rr]);
    }
}

template <class Fn>
__device__ __forceinline__ void run_gemm(Frame& F, const bf16* A, int lda, const bf16* Bt, int N, int K, const Fn& fn) {
    pg8::Gemm g{A, Bt, NREAL, N, K, lda}; pg8::StaticOrder S; S.init(NREAL, N, F.G, (int)blockIdx.x);
    pg8::EpiFn<Fn> E{fn};
    pg8::gemm_phase<pg8::EpiFn<Fn>, pg8::StaticOrder, true, true>(F.lds + RING_OFF, g, S, E);
}

template <class Fn>
__device__ __forceinline__ void run_gemm8(Frame& F, const bf16* A, int lda, const bf16* Bt, int N, int K, const Fn& fn) {
    pg8::Gemm g{A, Bt, NREAL, N, K, lda}; pg8::StaticOrder S; S.init(NREAL, N, F.G, (int)blockIdx.x);
    pg8::EpiFn8<Fn> E{fn};
    pg8::gemm_phase<pg8::EpiFn8<Fn>, pg8::StaticOrder, true, true>(F.lds + RING_OFF, g, S, E);
}

constexpr int NPHASES = 13;
struct Args { const float* in[32]; float* out; unsigned char* ws; int ph_lo, ph_hi; };
__global__ void __launch_bounds__(NTHR, 2) fwd(Args args) {
    extern __shared__ __attribute__((aligned(16))) unsigned char lds[];
    Frame F;
    F.lds = (LAS unsigned char*)lds;
    F.MISC = (volatile LAS unsigned*)(F.lds + MISC_OFF);
    F.tid = threadIdx.x; F.lane = F.tid & 63; F.wave = __builtin_amdgcn_readfirstlane(F.tid >> 6);
    F.G = gridDim.x;
#pragma unroll
    for (int i = 0; i < 32; ++i) F.in[i] = args.in[i];
    F.out = args.out; F.ws = args.ws;
    F.ctl = (gu32*)(args.ws + WS_CTL);
    for (int u = F.tid; u < (LDS_BYTES - LDSCTL_OFF) / 4; u += NTHR) ((LAS unsigned*)(F.lds + LDSCTL_OFF))[u] = 0u;
    __syncthreads();
    const int lo = args.ph_lo, hi = args.ph_hi;
    XcdBarrier bar; bar.bar = (unsigned*)(F.ctl + CW_BAR); bar.x = 0; bar.st = nullptr;
    if (hi - lo > 1) bar = xcd_barrier_post((unsigned*)(F.ctl + CW_BAR), F.MISC + 8);
#define IN(k) (lo <= (k) && (k) < hi)
#ifdef PROBE_PHASE_T
    unsigned long long tp_prev = __builtin_amdgcn_s_memrealtime(), tp_dur = 0ull;
#define SEAM(k) do { if (IN(k) && IN((k) + 1)) xcd_barrier(bar); if (blockIdx.x == 0 && F.tid == 0) { const unsigned long long t_ = __builtin_amdgcn_s_memrealtime(); if ((k) == PROBE_PHASE_T) tp_dur = t_ - tp_prev; tp_prev = t_; } } while (0)
#else
#define SEAM(k) do { if (IN(k) && IN((k) + 1)) xcd_barrier(bar); } while (0)
#endif
#ifndef PROBE_PH
#define PROBE_PH -1
#endif
#define REP(k) for (int rep_ = 0; rep_ < ((PROBE_PH == (k)) ? 2 : 1); ++rep_)

#ifndef IDX_NAIVE
#define IDX_NAIVE 0
#endif
#ifndef ATTN_NAIVE
#define ATTN_NAIVE 0
#endif
    if (IN(0)) REP(0) { if (rep_) __syncthreads(); p0_weights(F); p1_ln_in(F); } SEAM(0);
    if (IN(1)) REP(1) { if (rep_) __syncthreads(); run_gemm8(F, WSP(bf16, WS_H), D, WSP(bf16, WS_WT_IN), PW, D, StoreBf16{WSP(bf16, WS_P), PW}); meta_gemm(F, WSP(bf16, WS_H), D, WSP(bf16, WS_WT_IN), PW, D, StoreBf16{WSP(bf16, WS_P), PW});
        if (rep_ == 0) { if (F.G == 256) { if (blockIdx.x >= 128) p0_weights_late(F, (blockIdx.x - 128) * NWAVES + F.wave, 128 * NWAVES); } else p0_weights_late(F, blockIdx.x * NWAVES + F.wave, F.G * NWAVES); } } SEAM(1);
    if (IN(2)) REP(2) { if (rep_) __syncthreads(); p3_prep(F); } SEAM(2);
    if (IN(3)) REP(3) { if (rep_) __syncthreads(); run_gemm8(F, WSP(bf16, WS_CQN), 256, WSP(bf16, WS_WT_QA), QAW, 256, StoreBf16{WSP(bf16, WS_QA), QAW}); meta_gemm(F, WSP(bf16, WS_CQN), 256, WSP(bf16, WS_WT_QA), QAW, 256, StoreBf16{WSP(bf16, WS_QA), QAW});
#if REFSEL
        refsel_rows(F);
#endif
    } SEAM(3);
    if (IN(4)) REP(4) { if (rep_) __syncthreads(); rw_b1(F); } SEAM(4);
    if (IN(5)) {
        rw_b2(F); __syncthreads();
#if CHECK_IDX
        p5_index_naive(F); __syncthreads(); p5_index_mfma(F, (unsigned short*)F.out, (int*)((char*)F.out + 32 * MiB));
#elif IDX_NAIVE
        p5_index_naive(F);
#else
        p5_index_mfma(F, WSP(unsigned short, WS_SEL), WSP(int, WS_NSEL), 3072, false, true);
#ifdef PROBE_IDX
        __syncthreads(); p5_index_mfma(F, WSP(unsigned short, WS_SEL), WSP(int, WS_NSEL), 3136);
#endif
#ifdef PROBE_IDX_SCORE
        __syncthreads(); p5_index_mfma(F, (unsigned short*)F.out, (int*)((char*)F.out + 32 * MiB), 3136, true);
#endif
#endif
    } SEAM(5);
    if (IN(6)) {
#if CHECK_IDX
        idx_check(F); __syncthreads();
#endif
#if CHECK_IDX || IDX_NAIVE
        if (blockIdx.x == 0) { p6_attn_mfma(F, WSP(bf16, WS_QA), true); __syncthreads(); }
        if (blockIdx.x == 1) { rw_b3(F, true); __syncthreads(); }
#endif
#if ATTN_NAIVE
        p6_attn_naive(F);
#else
        p6_attn_mfma(F, WSP(bf16, WS_QA));
#endif
        __syncthreads();
        rw_b3(F);
    } SEAM(6);
    if (IN(7)) REP(7) { if (rep_) __syncthreads(); run_gemm8(F, WSP(bf16, WS_QA), QAW, WSP(bf16, WS_WT_MIX), D, QAW, StoreRes1{WSP(bf16, WS_H), F.out, WSP(float, WS_META1)}); meta_gemm(F, WSP(bf16, WS_QA), QAW, WSP(bf16, WS_WT_MIX), D, QAW, StoreRes1{WSP(bf16, WS_H), F.out, WSP(float, WS_META1)}); } SEAM(7);
    if (IN(8)) REP(8) { if (rep_) __syncthreads(); p10_ln1(F); } SEAM(8);
    if (IN(9)) {
        pg8::Gemm g{WSP(bf16, WS_H), WSP(bf16, WS_WT_UP), NREAL, UPW, D, D}; pg8::StaticOrder S; S.init(NREAL, UPW, F.G, (int)blockIdx.x);
        pg8::EpiConvAct E{WSP(unsigned short, WS_UP), DFF, F.in[IN_CONV_W], F.in[IN_CONV_B], DFF, WSP(float, WS_G01), WSP(float, WS_V01), WSP(float, WS_GHALO), (PG8_LAS float*)(F.lds + RING_BYTES + 4096)};
        pg8::gemm_phase<pg8::EpiConvAct, pg8::StaticOrder, true, true>(F.lds + RING_OFF, g, S, E);
        meta_gemm(F, WSP(bf16, WS_H), D, WSP(bf16, WS_WT_UP), UPW, D, StoreMetaGate{WSP(float, WS_GMETA)});
    } SEAM(9);
    if (IN(10)) { p12_conv_fix(F); } SEAM(10);
    if (IN(11)) REP(11) { if (rep_) __syncthreads(); run_gemm8(F, WSP(bf16, WS_UP), DFF, WSP(bf16, WS_WT_DN), D, DFF, StoreRes2{WSP(bf16, WS_H), F.out}); } SEAM(11);
    if (IN(12)) { p14_ln2(F);
#if CHECK_IDX
        if (blockIdx.x == 0 && F.tid == 0) {
            const unsigned miss = __hip_atomic_load((unsigned*)F.ctl + 2048, __ATOMIC_RELAXED, __HIP_MEMORY_SCOPE_AGENT), dupc = __hip_atomic_load((unsigned*)F.ctl + 2050, __ATOMIC_RELAXED, __HIP_MEMORY_SCOPE_AGENT);
            if (dupc) F.out[5] = __builtin_inff();
            if (miss > CHECK_IDX_MAXMISS) F.out[3] = __builtin_nanf("");
        }
#endif
    }
#ifdef PROBE_PHASE_T
    if (blockIdx.x == 0 && F.tid == 0) { if (PROBE_PHASE_T == 12) tp_dur = __builtin_amdgcn_s_memrealtime() - tp_prev; const unsigned long long t0 = __builtin_amdgcn_s_memrealtime(); while (__builtin_amdgcn_s_memrealtime() - t0 < tp_dur) __builtin_amdgcn_s_sleep(8); }
#endif
#ifdef PROBE_B1SEC
    if (blockIdx.x == 0 && F.tid == 0) { const unsigned long long t0 = __builtin_amdgcn_s_memrealtime(); const unsigned long long dt = (unsigned long long)F.MISC[20]; while (__builtin_amdgcn_s_memrealtime() - t0 < dt) __builtin_amdgcn_s_sleep(8); }
#endif
#undef IN
#undef SEAM
}

extern "C" void kernel_launch(void* const* d_in, const int* in_sizes, int n_in, void* d_out, int out_size, void* d_ws, size_t ws_size, hipStream_t stream) {
    static int grid = 0;
    if (grid == 0) {
        if (n_in != 32 || out_size != NREAL * D || ws_size < WS_END) { fprintf(stderr, "kernel_launch: unexpected shapes: n_in %d out %d ws %zu\n", n_in, out_size, ws_size); grid = -1; return; }
        int dev = 0, cus = 0, per_cu = 0;
        if (hipGetDevice(&dev) != hipSuccess || hipDeviceGetAttribute(&cus, hipDeviceAttributeMultiprocessorCount, dev) != hipSuccess) { grid = -1; return; }
        if (hipFuncSetAttribute((const void*)fwd, hipFuncAttributeMaxDynamicSharedMemorySize, LDS_BYTES) != hipSuccess) { fprintf(stderr, "kernel_launch: hipFuncSetAttribute failed\n"); grid = -1; return; }
        if (hipOccupancyMaxActiveBlocksPerMultiprocessor(&per_cu, (const void*)fwd, NTHR, LDS_BYTES) != hipSuccess || per_cu < 1) fprintf(stderr, "kernel_launch: occupancy query says %d\n", per_cu);
        (void)hipGetLastError();
        grid = cus;
    }
    if (grid < 0) return;
    (void)hipMemsetAsync((char*)d_ws + WS_CTL, 0, CTL_ZERO_BYTES, stream);
    Args a{};
    for (int i = 0; i < 32; ++i) a.in[i] = (const float*)d_in[i];
    a.out = (float*)d_out; a.ws = (unsigned char*)d_ws;
#if ONE_LAUNCH
    a.ph_lo = 0; a.ph_hi = NPHASES;
    hipLaunchKernelGGL(fwd, dim3(grid), dim3(NTHR), LDS_BYTES, stream, a);
#else
    for (int p = 0; p < NPHASES; ++p) { a.ph_lo = p; a.ph_hi = p + 1; hipLaunchKernelGGL(fwd, dim3(grid), dim3(NTHR), LDS_BYTES, stream, a); }
#endif
}
```

```cpp
#include <hip/hip_runtime.h>
#include <cstdio>
#include <cstdint>
#define ONE_LAUNCH 1
namespace pg8 {
#define PG8_LAS __attribute__((address_space(3)))
typedef unsigned short bf16_t;
typedef short bf16x8 __attribute__((ext_vector_type(8)));
typedef float f32x4 __attribute__((ext_vector_type(4)));
typedef unsigned u32x4 __attribute__((ext_vector_type(4)));
constexpr int BM = 256, BK = 64, HALF = 128, HTB = HALF * BK * 2  , STAGE_BYTES = 8 * HTB, NXCD = 8, WGM = 8;

__host__ __device__ __forceinline__ int lds_byte(int r, int c) { const int st = (r >> 4) * 2 + (c >> 5), rr = r & 15, cc = c & 31, ob = rr * 64 + cc * 2; return st * 1024 + (ob ^ (((ob >> 9) & 1) << 5)); }
__host__ __device__ __forceinline__ void stage_rc(int b, int& R, int& C) { const int st = b / 1024, sb = b % 1024, swz = sb ^ (((sb >> 9) & 1) << 5); R = (st >> 1) * 16 + swz / 64; C = (st & 1) * 32 + (swz % 64) / 2; }
__host__ __device__ __forceinline__ int perm32(int rho) { const int n = rho >> 4, i = rho & 15; return 8 * (i >> 2) + 4 * n + (i & 3); }

struct Unit { int pm, pn; };
struct Gemm { const bf16_t* A; const bf16_t* Bt; int M, N, K, lda; };

struct StaticOrder {
    int nM, nN, nwg, G, c;
    __host__ __device__ void init(int M, int N, int G_, int c_) { nM = M / BM; nN = N / BM; nwg = nM * nN; G = G_; c = c_; }
    __host__ __device__ bool next(int i, Unit& u) const {
        const long L = (long)i * G + c; if (L >= nwg) return false;
        int wgid = (int)L; { const int q = nwg / NXCD, r = nwg % NXCD, xcd = wgid % NXCD, off = wgid / NXCD; wgid = (xcd < r ? xcd * (q + 1) : r * (q + 1) + (xcd - r) * q) + off; }
        const int nig = WGM * nN, gid = wgid / nig, fm = gid * WGM, gsz = (nM - fm) < WGM ? (nM - fm) : WGM;
        u.pm = fm + ((wgid % nig) % gsz); u.pn = (wgid % nig) / gsz; return true;
    }
    __device__ __forceinline__ void a_ready(const Unit&) const {}
    __device__ __forceinline__ void done(const Unit&) const {}
};


template <class F> struct EpiFn {
    static constexpr bool PERM = false, AFTER_DRAIN = false;
    F f;
    __device__ __forceinline__ void operator()(const f32x4 (&acc)[2][2][4][2], const Unit& u, int wr, int wc, int fr, int fq) const {
        const int row0 = u.pm * BM + wr * 64 + fr, col0 = u.pn * BM + wc * 32 + 4 * fq;
#pragma unroll
        for (int ai = 0; ai < 2; ++ai)
#pragma unroll
            for (int m = 0; m < 4; ++m) {
                const int row = row0 + ai * HALF + m * 16;
#pragma unroll
                for (int bj = 0; bj < 2; ++bj)
#pragma unroll
                    for (int n = 0; n < 2; ++n) f(row, col0 + bj * HALF + n * 16, acc[ai][bj][m][n]);
            }
    }
};

template <class F> struct EpiFn8 {
    static constexpr bool PERM = true, AFTER_DRAIN = false;
    F f;
    __device__ __forceinline__ void operator()(const f32x4 (&acc)[2][2][4][2], const Unit& u, int wr, int wc, int fr, int fq) const {
        const int row0 = u.pm * BM + wr * 64 + fr, col0 = u.pn * BM + wc * 32 + 8 * fq;
#pragma unroll
        for (int ai = 0; ai < 2; ++ai)
#pragma unroll
            for (int m = 0; m < 4; ++m) {
                const int row = row0 + ai * HALF + m * 16;
#pragma unroll
                for (int bj = 0; bj < 2; ++bj) f.two(row, col0 + bj * HALF, acc[ai][bj][m][0], acc[ai][bj][m][1]);
            }
    }
};

struct EpiConvAct {
    static constexpr bool PERM = true, AFTER_DRAIN = false;
    unsigned short* ACT; int ldact;
    const float* cw; const float* cb; int dff;
    float* G01; float* V01; float* GHALO;
    PG8_LAS float* hal;
    __device__ __forceinline__ void operator()(const f32x4 (&acc)[2][2][4][2], const Unit& u, int wr, int wc, int fr, int fq) const {
        const int colg = 128 * u.pn + wc * 32 + 8 * fq;
        f32x4 w0[2], w1[2], w2[2], bb[2];
#pragma unroll
        for (int n = 0; n < 2; ++n) { w0[n] = *(const f32x4*)(cw + colg + 4 * n); w1[n] = *(const f32x4*)(cw + dff + colg + 4 * n); w2[n] = *(const f32x4*)(cw + 2 * dff + colg + 4 * n); bb[n] = *(const f32x4*)(cb + colg + 4 * n); }
        if (fr >= 14) {
#pragma unroll
            for (int ai = 0; ai < 2; ++ai)
#pragma unroll
                for (int n = 0; n < 2; ++n) *(PG8_LAS f32x4*)(hal + (((2 * ai + wr) * 4 + wc) * 2 + (fr - 14)) * 32 + 8 * fq + 4 * n) = acc[ai][0][3][n];
        }
        asm volatile("s_waitcnt lgkmcnt(0)" ::: "memory"); __builtin_amdgcn_s_barrier(); asm volatile("" ::: "memory");
#pragma unroll
        for (int ai = 0; ai < 2; ++ai) {
            const int blk = 2 * ai + wr;
            f32x4 prev[2];
#pragma unroll
            for (int n = 0; n < 2; ++n) {
                prev[n] = (f32x4){0.f, 0.f, 0.f, 0.f};
                if (blk > 0) prev[n] = *(const PG8_LAS f32x4*)(hal + ((((blk - 1) * 4 + wc) * 2 + (fr & 1)) * 32) + 8 * fq + 4 * n);
            }
#pragma unroll
            for (int m = 0; m < 4; ++m) {
                f32x4 o[2];
#pragma unroll
                for (int n = 0; n < 2; ++n) {
                    const f32x4 cur = acc[ai][0][m][n], val = acc[ai][1][m][n];
#pragma unroll
                    for (int e = 0; e < 4; ++e) {
                        float s1 = prev[n][e], s2 = prev[n][e];
                        asm volatile("s_nop 1\n\tv_mov_b32_dpp %0, %0 row_ror:1 row_mask:0xf bank_mask:0xf\n\tv_mov_b32_dpp %1, %1 row_ror:2 row_mask:0xf bank_mask:0xf\n\ts_nop 1\n\t"
                                     "v_mov_b32_dpp %0, %2 row_shr:1 row_mask:0xf bank_mask:0xf\n\tv_mov_b32_dpp %1, %2 row_shr:2 row_mask:0xf bank_mask:0xf\n\ts_nop 1" : "+v"(s1), "+v"(s2) : "v"(cur[e]));
                        const float x = w0[n][e] * s2 + w1[n][e] * s1 + w2[n][e] * cur[e] + bb[n][e];
                        const float u2 = x * (1.5957691216057308f + 0.07135481627260025f * x * x);
                        o[n][e] = x * __builtin_amdgcn_rcpf(1.0f + __builtin_amdgcn_exp2f(-1.4426950408889634f * u2)) * val[e];
                    }
                    prev[n] = cur;
                }
                const int rt = ai * HALF + wr * 64 + m * 16 + fr;
                const int row = u.pm * BM + rt;
                if (blk == 0 && m == 0 && fr < 2) {
#pragma unroll
                    for (int n = 0; n < 2; ++n) { *(f32x4*)(G01 + ((size_t)u.pm * 2 + fr) * dff + colg + 4 * n) = acc[ai][0][m][n]; *(f32x4*)(V01 + ((size_t)u.pm * 2 + fr) * dff + colg + 4 * n) = acc[ai][1][m][n]; }
                } else {
                    typedef __bf16 b2 __attribute__((ext_vector_type(2)));
                    const b2 p0 = {(__bf16)o[0][0], (__bf16)o[0][1]}, p1 = {(__bf16)o[0][2], (__bf16)o[0][3]}, p2 = {(__bf16)o[1][0], (__bf16)o[1][1]}, p3 = {(__bf16)o[1][2], (__bf16)o[1][3]};
                    *(u32x4*)(ACT + (size_t)row * ldact + colg) = (u32x4){__builtin_bit_cast(unsigned, p0), __builtin_bit_cast(unsigned, p1), __builtin_bit_cast(unsigned, p2), __builtin_bit_cast(unsigned, p3)};
                }
                if (blk == 3 && m == 3 && fr >= 14) {
#pragma unroll
                    for (int n = 0; n < 2; ++n) *(f32x4*)(GHALO + ((size_t)u.pm * 2 + (fr - 14)) * dff + colg + 4 * n) = acc[ai][0][m][n];
                }
            }
        }
        asm volatile("s_waitcnt lgkmcnt(0)" ::: "memory"); __builtin_amdgcn_s_barrier(); asm volatile("" ::: "memory");
    }
};
template <class Epi, class Sched, bool ALIGN_EPI = false, bool SP2 = false>
__device__ __forceinline__ void gemm_phase(PG8_LAS unsigned char* lds, const Gemm g, const Sched& S, const Epi& E) {
    const int tid = threadIdx.x, wid = __builtin_amdgcn_readfirstlane(tid >> 6), lane = tid & 63, wr = wid >> 2, wc = wid & 3, fr = lane & 15, fq = lane >> 4;
    const int K = g.K, nt = K / BK;
    unsigned voffA[2], voffB[2];
#pragma unroll
    for (int i = 0; i < 2; ++i) { int R, C; stage_rc(tid * 16 + i * 8192, R, C); const int Rb = Epi::PERM ? ((R & ~31) + perm32(R & 31)) : R;
        voffA[i] = (unsigned)(R * g.lda + C) * 2u; voffB[i] = (unsigned)(Rb * K + C) * 2u; }
    const size_t kstep = (size_t)(BK * 2);
    const size_t hA = (size_t)HALF * g.lda * 2, hB = (size_t)HALF * K * 2;
    const size_t tA = 2 * hA, tB = 2 * hB;
    const unsigned ldsw = (unsigned)wid * 1024u;
    const int aoff = lds_byte(wr * 64 + fr, fq * 8), boff = lds_byte(wc * 32 + fr, fq * 8);
#define PG8_SA(b, h) (((b) * 2 + (h)) * HTB)
#define PG8_SB(b, h) ((4 + (b) * 2 + (h)) * HTB)
#define PG8_STAGE(bufoff, gbase, voff) do { _Pragma("unroll") for (int _i = 0; _i < 2; ++_i) \
        __builtin_amdgcn_global_load_lds((const unsigned*)((const char*)(gbase) + (voff)[_i]), (PG8_LAS unsigned*)(lds + (bufoff) + ldsw + _i * 8192), 16, 0, 0); } while (0)
#define PG8_LDA(dst, b, h) do { _Pragma("unroll") for (int m = 0; m < 4; ++m) _Pragma("unroll") for (int k = 0; k < 2; ++k) dst[m][k] = *(const PG8_LAS bf16x8*)(lds + PG8_SA(b, h) + aoff + m * 2048 + k * 1024); } while (0)
#define PG8_LDB(dst, b, h) do { _Pragma("unroll") for (int n = 0; n < 2; ++n) _Pragma("unroll") for (int k = 0; k < 2; ++k) dst[n][k] = *(const PG8_LAS bf16x8*)(lds + PG8_SB(b, h) + boff + n * 2048 + k * 1024); } while (0)
#define PG8_MMA(ai, bj, At, Bt) do { __builtin_amdgcn_s_setprio(1); _Pragma("unroll") for (int m = 0; m < 4; ++m) _Pragma("unroll") for (int n = 0; n < 2; ++n) _Pragma("unroll") for (int k = 0; k < 2; ++k) \
        acc[ai][bj][m][n] = __builtin_amdgcn_mfma_f32_16x16x32_bf16(Bt[n][k], At[m][k], acc[ai][bj][m][n], 0, 0, 0); __builtin_amdgcn_s_setprio(0); } while (0)
#define PG8_WAIT_V(n) asm volatile("s_waitcnt vmcnt(" #n ")" ::: "memory")
#define PG8_WAIT_L(n) asm volatile("s_waitcnt lgkmcnt(" #n ")" ::: "memory")
#define PG8_BAR __builtin_amdgcn_s_barrier()
#define PG8_SCHED __builtin_amdgcn_sched_barrier(0)
    Unit cur, nxt; int ui = 0;
    if (!S.next(0, cur)) return;
    f32x4 acc[2][2][4][2];
#pragma unroll
    for (int a = 0; a < 2; ++a)
#pragma unroll
        for (int b = 0; b < 2; ++b)
#pragma unroll
            for (int m = 0; m < 4; ++m)
#pragma unroll
                for (int n = 0; n < 2; ++n) acc[a][b][m][n] = (f32x4){0.f, 0.f, 0.f, 0.f};
    bf16x8 At[4][2], B0[2][2], B1[2][2];
    const char* cA = (const char*)g.A + (size_t)cur.pm * tA; const char* cB = (const char*)g.Bt + (size_t)cur.pn * tB;
    S.a_ready(cur);
    if constexpr (SP2) {
        PG8_STAGE(PG8_SB(0, 0), cB, voffB); PG8_STAGE(PG8_SB(0, 1), cB + hB, voffB); PG8_STAGE(PG8_SA(0, 0), cA, voffA); PG8_STAGE(PG8_SA(0, 1), cA + hA, voffA);
        if (wr == 1) PG8_BAR;
        PG8_WAIT_V(2); PG8_BAR;
        PG8_STAGE(PG8_SB(1, 0), cB + kstep, voffB); PG8_STAGE(PG8_SA(1, 0), cA + kstep, voffA); PG8_STAGE(PG8_SB(1, 1), cB + hB + kstep, voffB);
        PG8_WAIT_V(6); PG8_BAR;
    } else {
        PG8_STAGE(PG8_SB(0, 0), cB, voffB); PG8_STAGE(PG8_SA(0, 0), cA, voffA); PG8_STAGE(PG8_SB(0, 1), cB + hB, voffB); PG8_STAGE(PG8_SA(0, 1), cA + hA, voffA);
        if (wr == 1) PG8_BAR;
        PG8_WAIT_V(4); PG8_BAR;
        PG8_STAGE(PG8_SB(1, 0), cB + kstep, voffB); PG8_STAGE(PG8_SA(1, 0), cA + kstep, voffA); PG8_STAGE(PG8_SB(1, 1), cB + hB + kstep, voffB);
        PG8_WAIT_V(6); PG8_BAR;
    }
    for (;;) {
        const bool has_next = S.next(ui + 1, nxt);
        const char* nA = has_next ? (const char*)g.A + (size_t)nxt.pm * tA : cA; const char* nB = has_next ? (const char*)g.Bt + (size_t)nxt.pn * tB : cB;
        for (int t = 0; t < nt; t += 2) {
            const bool last = (t == nt - 2);
            const char* a1 = cA + (size_t)(t + 1) * kstep;
            const char* a2 = last ? nA : cA + (size_t)(t + 2) * kstep; const char* b2 = last ? nB : cB + (size_t)(t + 2) * kstep;
            const char* a3 = a2 + kstep; const char* b3 = b2 + kstep;
            if (last && has_next) S.a_ready(nxt);
            if constexpr (SP2) {
            PG8_LDB(B0, 0, 0); PG8_LDB(B1, 0, 1); PG8_SCHED; PG8_LDA(At, 0, 0); PG8_STAGE(PG8_SA(1, 1), a1 + hA, voffA);
            PG8_WAIT_V(8); PG8_WAIT_L(0); PG8_BAR; PG8_MMA(0, 0, At, B0); PG8_MMA(0, 1, At, B1); PG8_BAR; PG8_SCHED;
            PG8_LDA(At, 0, 1); PG8_STAGE(PG8_SB(0, 0), b2, voffB); PG8_STAGE(PG8_SB(0, 1), b2 + hB, voffB); PG8_STAGE(PG8_SA(0, 0), a2, voffA);
            PG8_WAIT_V(8); PG8_WAIT_L(0); PG8_BAR; PG8_MMA(1, 0, At, B0); PG8_MMA(1, 1, At, B1); PG8_BAR; PG8_SCHED;
            PG8_LDB(B0, 1, 0); PG8_LDB(B1, 1, 1); PG8_SCHED; PG8_LDA(At, 1, 0); PG8_STAGE(PG8_SA(0, 1), a2 + hA, voffA);
            PG8_WAIT_V(8); PG8_WAIT_L(0); PG8_BAR; PG8_MMA(0, 0, At, B0); PG8_MMA(0, 1, At, B1); PG8_BAR; PG8_SCHED;
            PG8_LDA(At, 1, 1); PG8_STAGE(PG8_SB(1, 0), b3, voffB); PG8_STAGE(PG8_SB(1, 1), b3 + hB, voffB); PG8_STAGE(PG8_SA(1, 0), a3, voffA);
            PG8_WAIT_V(8); PG8_WAIT_L(0); PG8_BAR; PG8_MMA(1, 0, At, B0); PG8_MMA(1, 1, At, B1); PG8_BAR; PG8_SCHED;
            } else {
            PG8_LDB(B0, 0, 0); PG8_SCHED; PG8_LDA(At, 0, 0); PG8_STAGE(PG8_SA(1, 1), a1 + hA, voffA);
            PG8_WAIT_L(8); PG8_BAR; PG8_WAIT_L(0); PG8_MMA(0, 0, At, B0); PG8_BAR; PG8_SCHED;
            PG8_LDB(B1, 0, 1); PG8_STAGE(PG8_SB(0, 0), b2, voffB);
            PG8_BAR; PG8_WAIT_L(0); PG8_MMA(0, 1, At, B1); PG8_BAR;
            PG8_LDA(At, 0, 1); PG8_STAGE(PG8_SA(0, 0), a2, voffA);
            PG8_BAR; PG8_WAIT_L(0); PG8_MMA(1, 0, At, B0); PG8_BAR; PG8_SCHED;
            PG8_STAGE(PG8_SB(0, 1), b2 + hB, voffB);
            PG8_WAIT_V(6); PG8_BAR; PG8_MMA(1, 1, At, B1); PG8_BAR;
            PG8_LDB(B0, 1, 0); PG8_SCHED; PG8_LDA(At, 1, 0); PG8_STAGE(PG8_SA(0, 1), a2 + hA, voffA);
            PG8_WAIT_L(8); PG8_BAR; PG8_WAIT_L(0); PG8_MMA(0, 0, At, B0); PG8_BAR; PG8_SCHED;
            PG8_LDB(B1, 1, 1); PG8_STAGE(PG8_SB(1, 0), b3, voffB);
            PG8_BAR; PG8_WAIT_L(0); PG8_MMA(0, 1, At, B1); PG8_BAR;
            PG8_LDA(At, 1, 1); PG8_STAGE(PG8_SA(1, 0), a3, voffA);
            PG8_BAR; PG8_WAIT_L(0); PG8_MMA(1, 0, At, B0); PG8_BAR; PG8_SCHED;
            PG8_STAGE(PG8_SB(1, 1), b3 + hB, voffB);
            PG8_WAIT_V(6); PG8_BAR; PG8_MMA(1, 1, At, B1); PG8_BAR;
            }
        }
        if constexpr (ALIGN_EPI) { if (wr == 0) PG8_BAR; }
        if constexpr (!Epi::AFTER_DRAIN) { E(acc, cur, wr, wc, fr, fq); S.done(cur); }
        if (!has_next) break;
#pragma unroll
        for (int a = 0; a < 2; ++a)
#pragma unroll
            for (int b = 0; b < 2; ++b)
#pragma unroll
                for (int m = 0; m < 4; ++m)
#pragma unroll
                    for (int n = 0; n < 2; ++n) acc[a][b][m][n] = (f32x4){0.f, 0.f, 0.f, 0.f};
        cur = nxt; cA = nA; cB = nB; ++ui;
        if constexpr (ALIGN_EPI) { if (wr == 1) PG8_BAR; }
    }
    PG8_WAIT_V(0);
    if constexpr (!ALIGN_EPI) { if (wr == 0) PG8_BAR; }
    PG8_BAR;
    if constexpr (Epi::AFTER_DRAIN) { E.fused(acc, cur, wr, wc, fr, fq, lds, wid, lane); S.done(cur); }
#undef PG8_SA
#undef PG8_SB
#undef PG8_STAGE
#undef PG8_LDA
#undef PG8_LDB
#undef PG8_MMA
#undef PG8_WAIT_V
#undef PG8_WAIT_L
#undef PG8_BAR
#undef PG8_SCHED
}
}

#ifndef ONE_LAUNCH
#define ONE_LAUNCH 0
#endif
constexpr int NWAVES = 8, NTHR = 512;
constexpr int D = 1024, BATCH = 4, SEQ = 8192, NMETA = 16, TT = SEQ + NMETA;
constexpr int NREAL = BATCH * SEQ;
constexpr int NROWS = NREAL + NMETA;
constexpr int R = 33024;
constexpr int PW = 2304;
constexpr int PC_CQ = 0, PC_CKV = 256, PC_KIDX = 384, PC_WIDX = 448, PC_R = 512, PC_K = 1024, PC_V = 1536, PC_WD = 2048, PC_AD = 2112, PC_GD = 2176;
constexpr int QAW = 1536;
constexpr int DFF = 2816, UPW = 5632;
constexpr int TOPK = 256;
constexpr float LN_EPS = 1e-5f, GN_EPS = 64e-5f, ALPHA = 1.18920711500272f;

constexpr size_t MiB = 1u << 20;
constexpr size_t WS_CTL = 0, CTL_ZERO_BYTES = 32768;
constexpr size_t WS_WT_IN = 1 * MiB, WS_WT_QA = 6 * MiB, WS_WT_MIX = 7 * MiB, WS_WT_UP = 10 * MiB, WS_WT_DN = 21 * MiB;
constexpr size_t WS_META1 = 27 * MiB, WS_NSEL = 28 * MiB, WS_WIDX = 29 * MiB;
constexpr size_t WS_H = 33 * MiB;
constexpr size_t WS_P = 98 * MiB, WS_QA = 244 * MiB, WS_CQN = 341 * MiB, WS_SEL = 341 * MiB, WS_CKV = 358 * MiB, WS_KIDX = 367 * MiB;
constexpr size_t WS_DEC = 372 * MiB, WS_AB = 437 * MiB, WS_GB = 470 * MiB;
constexpr size_t WS_WT_LORA = 26 * MiB + 512 * 1024;
constexpr size_t WS_RWM = 372 * MiB, WS_RWN = 405 * MiB, WS_RWQ = 438 * MiB, WS_RWY = 471 * MiB;
constexpr size_t OUT_RWS = 80 * MiB, OUT_BONUS = 116 * MiB;
constexpr size_t WS_G01 = 480 * MiB, WS_V01 = 484 * MiB, WS_GHALO = 488 * MiB, WS_GMETA = 492 * MiB;
constexpr size_t WS_UP = 98 * MiB;
constexpr size_t WS_END = 512 * MiB;
static_assert(WS_P + (size_t)R * PW * 2 <= WS_QA && WS_QA + (size_t)R * QAW * 2 <= WS_CQN && WS_CQN + (size_t)R * 256 * 2 <= WS_CKV && WS_CKV + (size_t)R * 128 * 2 <= WS_KIDX
              && WS_KIDX + (size_t)R * 64 * 2 <= WS_DEC && WS_DEC + (size_t)R * 512 * 4 <= WS_AB && WS_AB + (size_t)R * 512 * 2 <= WS_GB && WS_GB + (size_t)R * 512 * 2 <= WS_END
              && WS_UP + (size_t)R * UPW * 2 <= WS_END && WS_H + (size_t)R * D * 2 <= WS_P && WS_WIDX + (size_t)R * 8 * 4 <= WS_H && WS_NSEL + (size_t)R * 4 <= WS_WIDX, "ws map");
constexpr int CW_BAR = 4096;

constexpr int RING_OFF = 0, RING_BYTES = 131072;
constexpr int LDSCTL_OFF = RING_BYTES, MISC_OFF = LDSCTL_OFF + 320;
constexpr int LDS_BYTES = 147456;

#define GAS __attribute__((address_space(1)))
#define LAS __attribute__((address_space(3)))
typedef unsigned short bf16;
typedef unsigned v4u __attribute__((ext_vector_type(4)));
typedef unsigned v2u __attribute__((ext_vector_type(2)));
typedef float f32x4 __attribute__((ext_vector_type(4)));
typedef GAS unsigned gu32;
typedef __bf16 bf16x2_t __attribute__((ext_vector_type(2)));
__device__ __forceinline__ unsigned f2bf(float f) { return (unsigned)__builtin_bit_cast(unsigned short, (__bf16)f); }
__device__ __forceinline__ unsigned pk2(float lo, float hi) { const bf16x2_t v = {(__bf16)lo, (__bf16)hi}; return __builtin_bit_cast(unsigned, v); }
__device__ __forceinline__ float fast_rcp(float x) { return __builtin_amdgcn_rcpf(x); }
__device__ __forceinline__ float fast_tanh(float x) { return 1.0f - 2.0f * __builtin_amdgcn_rcpf(1.0f + __expf(2.0f * x)); }
__device__ __forceinline__ float bf2f(unsigned short b) { return __uint_as_float(((unsigned)b) << 16); }
__device__ __forceinline__ float bflo(unsigned w) { return __uint_as_float(w << 16); }
__device__ __forceinline__ float bfhi(unsigned w) { return __uint_as_float(w & 0xffff0000u); }
#define DPP_F(v, ctrl) __builtin_bit_cast(float, __builtin_amdgcn_update_dpp(0, __builtin_bit_cast(int, (v)), (ctrl), 0xf, 0xf, false))
__device__ __forceinline__ float rdlane_f(float v, int lane) { return __builtin_bit_cast(float, __builtin_amdgcn_readlane(__builtin_bit_cast(int, v), lane)); }
__device__ __forceinline__ float wave_sum(float v) {
    v += DPP_F(v, 0xB1); v += DPP_F(v, 0x4E); v += DPP_F(v, 0x141); v += DPP_F(v, 0x140);
    return (rdlane_f(v, 0) + rdlane_f(v, 16)) + (rdlane_f(v, 32) + rdlane_f(v, 48));
}
__device__ __forceinline__ float wave_max(float v) {
    v = fmaxf(v, DPP_F(v, 0xB1)); v = fmaxf(v, DPP_F(v, 0x4E)); v = fmaxf(v, DPP_F(v, 0x141)); v = fmaxf(v, DPP_F(v, 0x140));
    return fmaxf(fmaxf(rdlane_f(v, 0), rdlane_f(v, 16)), fmaxf(rdlane_f(v, 32), rdlane_f(v, 48)));
}
#define DPP_U0(v, ctrl) ((unsigned)__builtin_amdgcn_update_dpp(0, (int)(v), (ctrl), 0xf, 0xf, true))
__device__ __forceinline__ unsigned wave_scan_incl(unsigned v, int lane) {
    v += DPP_U0(v, 0x111); v += DPP_U0(v, 0x112); v += DPP_U0(v, 0x114); v += DPP_U0(v, 0x118);
    const unsigned r0 = (unsigned)__builtin_amdgcn_readlane((int)v, 15), r1 = (unsigned)__builtin_amdgcn_readlane((int)v, 31), r2 = (unsigned)__builtin_amdgcn_readlane((int)v, 47);
    const int row = lane >> 4;
    return v + (row >= 1 ? r0 : 0u) + (row >= 2 ? r1 : 0u) + (row >= 3 ? r2 : 0u);
}
__device__ __forceinline__ float sigmoidf_(float x) { return __builtin_amdgcn_rcpf(1.0f + __expf(-x)); }
#define XB_TMO      128
#define XB_XCNT(j)  (256  + 64 * (j))
#define XB_XSUB(j)  (1280 + 64 * (j))
#define XB_XGEN(j)  (2304 + 64 * (j))
#define XB_TOP      3328
#define XB_TOPGEN   3392
#define XCD_BAR_WORDS 3456
#define XB_SPIN_CAP (1u << 18)

__device__ __forceinline__ unsigned xb_ld(unsigned* p)              { return __hip_atomic_load(p, __ATOMIC_RELAXED, __HIP_MEMORY_SCOPE_AGENT); }
__device__ __forceinline__ unsigned xb_add(unsigned* p, unsigned v) { return __hip_atomic_fetch_add(p, v, __ATOMIC_RELAXED, __HIP_MEMORY_SCOPE_AGENT); }
__device__ __forceinline__ unsigned xb_xcc_id() { return (unsigned)__builtin_amdgcn_s_getreg((3 << 11) | 20) & 0xFu; }
#define XB_SPIN(cond, bar) do { unsigned _sp = 0; while (cond) { __builtin_amdgcn_s_sleep(1); \
    if ((++_sp & 255u) == 0u) { if (xb_ld(&(bar)[XB_TMO])) break; if (_sp > XB_SPIN_CAP) { atomicAdd(&(bar)[XB_TMO], 1u); break; } } } } while (0)

struct XcdBarrier {
    unsigned* bar; unsigned x;
    volatile LAS unsigned* st;
};

__device__ __forceinline__ XcdBarrier xcd_barrier_post(unsigned* bar, volatile LAS unsigned* st) {
    XcdBarrier b; b.bar = bar; b.x = xb_xcc_id(); b.st = st;
    if (threadIdx.x == 0) (void)xb_add(&bar[XB_XCNT(b.x)], 1u);
    return b;
}
__device__ __forceinline__ void xcd_barrier_complete(unsigned* bar, unsigned x, unsigned& nloc, unsigned& nx) {
    const unsigned G = gridDim.x * gridDim.y * gridDim.z;
    unsigned sum, cnt, mine, sp = 0u;
    for (;;) {
        sum = 0u; cnt = 0u; mine = 0u;
#pragma unroll
        for (unsigned j = 0; j < 16; ++j) { const unsigned c = xb_ld(&bar[XB_XCNT(j)]); sum += c; cnt += (c > 0u) ? 1u : 0u; mine = (j == x) ? c : mine; }
        if (sum == G) break;
        __builtin_amdgcn_s_sleep(1);
        if ((++sp & 255u) == 0u) { if (xb_ld(&bar[XB_TMO])) break; if (sp > XB_SPIN_CAP) { atomicAdd(&bar[XB_TMO], 1u); break; } }
    }
    nloc = mine > 0u ? mine : 1u; nx = cnt > 0u ? cnt : 1u;
}

__device__ __forceinline__ void xcd_barrier(const XcdBarrier& b) {
    asm volatile("s_waitcnt vmcnt(0)" ::: "memory");
    __syncthreads();
    if (threadIdx.x == 0) {
        unsigned* bar = b.bar;
        __builtin_amdgcn_s_waitcnt(0);
        unsigned nloc = b.st[0], nx = b.st[1];
        if (nloc == 0u) { xcd_barrier_complete(bar, b.x, nloc, nx); b.st[0] = nloc; b.st[1] = nx; }
        const unsigned old = xb_add(&bar[XB_XSUB(b.x)], 1u);
        const unsigned gen = old / nloc;
        if (old + 1u == (gen + 1u) * nloc) {
            __builtin_amdgcn_fence(__ATOMIC_RELEASE, "agent");
            asm volatile("s_waitcnt vmcnt(0)" ::: "memory");
            const unsigned og = xb_add(&bar[XB_TOP], 1u);
            const unsigned tg = og / nx;
            if (og + 1u == (tg + 1u) * nx) xb_add(&bar[XB_TOPGEN], 1u);
            else XB_SPIN(xb_ld(&bar[XB_TOPGEN]) == tg, bar);
            __builtin_amdgcn_fence(__ATOMIC_ACQUIRE, "agent");
            xb_add(&bar[XB_XGEN(b.x)], 1u);
            asm volatile("s_waitcnt vmcnt(0)" ::: "memory");
        } else {
            XB_SPIN(xb_ld(&bar[XB_XGEN(b.x)]) == gen, bar);
            __builtin_amdgcn_fence(__ATOMIC_ACQUIRE, "agent");
            asm volatile("s_waitcnt vmcnt(0)" ::: "memory");
        }
    }
    __syncthreads();
}

struct Frame {
    LAS unsigned char* lds;
    volatile LAS unsigned* MISC;
    gu32* ctl;
    int tid, lane, wave, G;
    const float* in[32];
    float* out;
    unsigned char* ws;
};
#define IN_X 0
#define IN_META 1
#define IN_LNIN_G 2
#define IN_LNIN_B 3
#define IN_W_IN 4
#define IN_QNORM_G 5
#define IN_W_UQ 6
#define IN_KVNORM_G 7
#define IN_W_UKV 8
#define IN_W_IQ 9
#define IN_IDXLN_G 10
#define IN_IDXLN_B 11
#define IN_MU 12
#define IN_W0 13
#define IN_W_DEC 14
#define IN_A0 15
#define IN_W_AAA 16
#define IN_W_GATE 17
#define IN_KK 18
#define IN_KA 19
#define IN_RK 20
#define IN_GN_G 21
#define IN_GN_B 22
#define IN_W_OUT 23
#define IN_LN1_G 24
#define IN_LN1_B 25
#define IN_W_UP 26
#define IN_CONV_W 27
#define IN_CONV_B 28
#define IN_W_DN 29
#define IN_LN2_G 30
#define IN_LN2_B 31

#define WSP(T, off) ((T*)(F.ws + (off)))

__device__ __forceinline__ int key_row(int b, int j) { return j < NMETA ? NREAL + j : b * SEQ + (j - NMETA); }

__device__ __forceinline__ int tr_col(int n, int mode, int cut0, int cut1, int shift) {
    if (mode == 1) { const int pn = n >> 8, x = n & 255; return x < 128 ? 128 * pn + x : DFF + 128 * pn + (x - 128); }
    return n < cut0 ? n : (n < cut1 ? -1 : n - shift);
}
struct TrJob { const float* src; int src_ld, src_r0; bf16* dst; int dst_ld, dst_c0, Nn, K, mode, cut0, cut1, shift; };
__device__ __forceinline__ void tr_item(const TrJob& j, int item, LAS float* scr, int lane) {
    const int nblk = j.Nn / 32, kb = item / nblk, nb = item % nblk, k0 = 64 * kb, n0 = 32 * nb;
    const int col = tr_col(n0 + (lane & 31), j.mode, j.cut0, j.cut1, j.shift);
    const float* sp = j.src + (size_t)(j.src_r0 + k0 + (lane >> 5)) * j.src_ld + (col >= 0 ? col : 0);
    float v[32];
#pragma unroll
    for (int i = 0; i < 32; ++i) v[i] = sp[(size_t)(2 * i) * j.src_ld];
#pragma unroll
    for (int i = 0; i < 32; ++i) scr[(2 * i + (lane >> 5)) * 33 + (lane & 31)] = col >= 0 ? v[i] : 0.f;
    asm volatile("s_waitcnt lgkmcnt(0)" ::: "memory");
    const int c = lane & 7;
#pragma unroll
    for (int q = 0; q < 4; ++q) { const int n = (lane >> 3) + 8 * q; const LAS float* t = scr + (8 * c) * 33 + n;
        *(v4u*)(j.dst + (size_t)(n0 + n) * j.dst_ld + j.dst_c0 + k0 + 8 * c) = (v4u){pk2(t[0], t[33]), pk2(t[66], t[99]), pk2(t[132], t[165]), pk2(t[198], t[231])}; }
    asm volatile("s_waitcnt lgkmcnt(0)" ::: "memory");
}
__device__ __forceinline__ void tr_job(Frame& F, const TrJob& j, int& base, int gw, int NGW) {
    LAS float* scr = (LAS float*)(F.lds + F.wave * 8704);
    const int ni = (j.K / 64) * (j.Nn / 32);
    for (int it = ((gw - base) % NGW + NGW) % NGW; it < ni; it += NGW) tr_item(j, it, scr, F.lane);
    base = (base + ni) % NGW;
}
__device__ __forceinline__ void p0_weights(Frame& F) {
    bf16* WT_IN = WSP(bf16, WS_WT_IN); bf16* WT_QA = WSP(bf16, WS_WT_QA); bf16* WdT = WSP(bf16, WS_WT_LORA);
    const int gw = blockIdx.x * NWAVES + F.wave, NGW = F.G * NWAVES;
    int base = 0;
    tr_job(F, TrJob{F.in[IN_W_IN], 2248, 0, WT_IN, D, 0, PW, D, 0, 456, 512, 56}, base, gw, NGW);
    tr_job(F, TrJob{F.in[IN_W_IQ], 512, 0, WT_QA + (size_t)1024 * 256, 256, 0, 512, 256, 0, 512, 512, 0}, base, gw, NGW);
    tr_job(F, TrJob{F.in[IN_W_GATE], 512, 0, WdT + 2 * 512 * 64, 128, 0, 512, 128, 0, 512, 512, 0}, base, gw, NGW);
    tr_job(F, TrJob{F.in[IN_W_DEC], 512, 0, WdT, 64, 0, 512, 64, 0, 512, 512, 0}, base, gw, NGW);
    tr_job(F, TrJob{F.in[IN_W_AAA], 512, 0, WdT + 512 * 64, 64, 0, 512, 64, 0, 512, 512, 0}, base, gw, NGW);
    const float* w_uq = F.in[IN_W_UQ]; const float* w_ukv = F.in[IN_W_UKV];
    for (int it = blockIdx.x * NTHR + F.tid; it < 256 * 8 * 8; it += F.G * NTHR) {
        const int c = it & 255, hb = __builtin_amdgcn_readfirstlane(it >> 8), h = hb >> 3, j0 = (hb & 7) * 16;
        float acc[16];
#pragma unroll
        for (int jj = 0; jj < 16; ++jj) acc[jj] = 0.f;
        for (int d = 0; d < 64; ++d) {
            const float a = w_uq[(size_t)c * 512 + h * 64 + d];
#pragma unroll
            for (int jj = 0; jj < 16; ++jj) acc[jj] += a * w_ukv[(size_t)(j0 + jj) * 1024 + h * 128 + d];
        }
#pragma unroll
        for (int jj = 0; jj < 16; ++jj) WT_QA[(size_t)(h * 128 + j0 + jj) * 256 + c] = (bf16)f2bf(0.125f * acc[jj]);
    }
}
__device__ __forceinline__ void p0_weights_late(Frame& F, int gw, int NGW) {
    bf16* WT_MIX = WSP(bf16, WS_WT_MIX); bf16* WT_UP = WSP(bf16, WS_WT_UP); bf16* WT_DN = WSP(bf16, WS_WT_DN);
    int base = 0;
    tr_job(F, TrJob{F.in[IN_W_UP], UPW, 0, WT_UP, D, 0, UPW, D, 1, 0, 0, 0}, base, gw, NGW);
    tr_job(F, TrJob{F.in[IN_W_DN], D, 0, WT_DN, DFF, 0, D, DFF, 0, D, D, 0}, base, gw, NGW);
    tr_job(F, TrJob{F.in[IN_W_OUT], D, 512, WT_MIX, 1536, 1024, D, 512, 0, D, D, 0}, base, gw, NGW);
    const float* w_ukv = F.in[IN_W_UKV]; const float* w_out = F.in[IN_W_OUT];
    for (int it = gw * 64 + F.lane; it < 1024 * 8 * 8; it += NGW * 64) {
        const int n = it & 1023, hb = __builtin_amdgcn_readfirstlane(it >> 10), h = hb >> 3, j0 = (hb & 7) * 16;
        float acc[16];
#pragma unroll
        for (int jj = 0; jj < 16; ++jj) acc[jj] = 0.f;
        for (int d = 0; d < 64; ++d) {
            const float a = w_out[(size_t)(h * 64 + d) * D + n];
#pragma unroll
            for (int jj = 0; jj < 16; ++jj) acc[jj] += a * w_ukv[(size_t)(j0 + jj) * 1024 + h * 128 + 64 + d];
        }
        v4u o0, o1;
        o0.x = pk2(acc[0], acc[1]); o0.y = pk2(acc[2], acc[3]); o0.z = pk2(acc[4], acc[5]); o0.w = pk2(acc[6], acc[7]);
        o1.x = pk2(acc[8], acc[9]); o1.y = pk2(acc[10], acc[11]); o1.z = pk2(acc[12], acc[13]); o1.w = pk2(acc[14], acc[15]);
        *(v4u*)(WT_MIX + (size_t)n * 1536 + h * 128 + j0) = o0; *(v4u*)(WT_MIX + (size_t)n * 1536 + h * 128 + j0 + 8) = o1;
    }
}

__device__ __forceinline__ void ln_row_bf16(Frame& F, const float* src, const float* g, const float* b, bf16* dst) {
    v2u* o8 = (v2u*)dst + F.lane;
    if (!src) {
#pragma unroll
        for (int j = 0; j < 4; ++j) o8[64 * j] = (v2u){0u, 0u};
        return;
    }
    const f32x4* xr = (const f32x4*)src + F.lane;
    f32x4 v[4]; float s = 0.f;
#pragma unroll
    for (int j = 0; j < 4; ++j) { v[j] = xr[64 * j]; s += (v[j].x + v[j].y) + (v[j].z + v[j].w); }
    const float mean = wave_sum(s) * (1.f / D); float s2 = 0.f;
#pragma unroll
    for (int j = 0; j < 4; ++j) { v[j] = v[j] - mean; s2 += (v[j].x * v[j].x + v[j].y * v[j].y) + (v[j].z * v[j].z + v[j].w * v[j].w); }
    const float rstd = 1.f / sqrtf(wave_sum(s2) * (1.f / D) + LN_EPS);
#pragma unroll
    for (int j = 0; j < 4; ++j) {
        const f32x4 gg = ((const f32x4*)g)[F.lane + 64 * j], bb = ((const f32x4*)b)[F.lane + 64 * j];
        const f32x4 y = v[j] * rstd * gg + bb;
        o8[64 * j] = (v2u){pk2(y.x, y.y), pk2(y.z, y.w)};
    }
}
__device__ __forceinline__ void p1_ln_in(Frame& F) {
    bf16* H0 = WSP(bf16, WS_H);
    const int gw = blockIdx.x * NWAVES + F.wave, NGW = F.G * NWAVES;
    const f32x4* gp = (const f32x4*)F.in[IN_LNIN_G] + F.lane; const f32x4* bp = (const f32x4*)F.in[IN_LNIN_B] + F.lane;
    f32x4 gg[4], bb[4];
#pragma unroll
    for (int j = 0; j < 4; ++j) { gg[j] = gp[64 * j]; bb[j] = bp[64 * j]; }
    for (int r0 = gw * 4; r0 < NROWS; r0 += NGW * 4) {
        f32x4 v[4][4];
#pragma unroll
        for (int q = 0; q < 4; ++q) {
            const int r = r0 + q < NROWS ? r0 + q : NROWS - 1;
            const f32x4* xr = (const f32x4*)(r < NREAL ? F.in[IN_X] + (size_t)r * D : F.in[IN_META] + (size_t)(r - NREAL) * D) + F.lane;
#pragma unroll
            for (int j = 0; j < 4; ++j) v[q][j] = xr[64 * j];
        }
#pragma unroll
        for (int q = 0; q < 4; ++q) {
            float s = 0.f;
#pragma unroll
            for (int j = 0; j < 4; ++j) s += (v[q][j].x + v[q][j].y) + (v[q][j].z + v[q][j].w);
            const float mean = wave_sum(s) * (1.f / D); float s2 = 0.f;
#pragma unroll
            for (int j = 0; j < 4; ++j) { v[q][j] = v[q][j] - mean; s2 += (v[q][j].x * v[q][j].x + v[q][j].y * v[q][j].y) + (v[q][j].z * v[q][j].z + v[q][j].w * v[q][j].w); }
            const float rstd = 1.f / sqrtf(wave_sum(s2) * (1.f / D) + LN_EPS);
            if (r0 + q < NROWS) {
                v2u* o8 = (v2u*)(H0 + (size_t)(r0 + q) * D) + F.lane;
#pragma unroll
                for (int j = 0; j < 4; ++j) { const f32x4 y = v[q][j] * rstd * gg[j] + bb[j]; o8[64 * j] = (v2u){pk2(y.x, y.y), pk2(y.z, y.w)}; }
            }
        }
    }
}

__device__ __forceinline__ void p3_prep(Frame& F) {
    const bf16* P = WSP(bf16, WS_P); bf16* CQN = WSP(bf16, WS_CQN); bf16* CKV = WSP(bf16, WS_CKV); bf16* KIDX = WSP(bf16, WS_KIDX); float* WIDX = WSP(float, WS_WIDX);
    const int gw = blockIdx.x * NWAVES + F.wave, NGW = F.G * NWAVES, l = F.lane;
    for (int r = gw; r < R; r += NGW) {
        const bf16* pr = P + (size_t)r * PW;
        if (r >= NROWS) {
            *(v2u*)(CQN + (size_t)r * 256 + 4 * l) = (v2u){0u, 0u};
            continue;
        }
        {
            const v2u w = *(const v2u*)(pr + PC_CQ + 4 * l);
            const float a0 = bflo(w.x), a1 = bfhi(w.x), a2 = bflo(w.y), a3 = bfhi(w.y);
            const float ss = wave_sum(a0 * a0 + a1 * a1 + a2 * a2 + a3 * a3);
            const float rs = 1.0f / sqrtf(ss * (1.f / 256.f) + 1e-6f);
            const f32x4 g = ((const f32x4*)F.in[IN_QNORM_G])[l];
            *(v2u*)(CQN + (size_t)r * 256 + 4 * l) = (v2u){pk2(a0 * rs * g.x, a1 * rs * g.y), pk2(a2 * rs * g.z, a3 * rs * g.w)};
        }
        {
            const unsigned w = *(const unsigned*)(pr + PC_CKV + 2 * l);
            const float a0 = bflo(w), a1 = bfhi(w);
            const float ss = wave_sum(a0 * a0 + a1 * a1);
            const float rs = 1.0f / sqrtf(ss * (1.f / 128.f) + 1e-6f);
            const float g0 = F.in[IN_KVNORM_G][2 * l], g1 = F.in[IN_KVNORM_G][2 * l + 1];
            *(unsigned*)(CKV + (size_t)r * 128 + 2 * l) = pk2(a0 * rs * g0, a1 * rs * g1);
        }
        {
            const float a = bf2f(pr[PC_KIDX + l]);
            const float mean = wave_sum(a) * (1.f / 64.f);
            const float dlt = a - mean;
            const float var = wave_sum(dlt * dlt) * (1.f / 64.f);
            const float y = dlt * (1.0f / sqrtf(var + LN_EPS)) * F.in[IN_IDXLN_G][l] + F.in[IN_IDXLN_B][l];
            KIDX[(size_t)r * 64 + l] = (bf16)f2bf(y);
        }
        if (l < 8) WIDX[(size_t)r * 8 + l] = bf2f(pr[PC_WIDX + l]) * 0.04419417382415922f;
    }
}

#ifndef REFSEL
#define REFSEL 0
#endif
__device__ __forceinline__ void refsel_rows(Frame& F) {
    float* QIDX32 = F.out; float* KIDX32 = F.out + (size_t)R * 512; float* WIDX = WSP(float, WS_WIDX);
    const float* w_in = F.in[IN_W_IN]; const float* w_iq = F.in[IN_W_IQ];
    LAS float* hrow = (LAS float*)(F.lds + F.wave * 8192);
    LAS float* cqn = hrow + 1024;
    const int l = F.lane;
    const int gw = blockIdx.x * NWAVES + F.wave, NGW = F.G * NWAVES;
    for (int r = gw; r < NROWS; r += NGW) {
        const float* src = r < NREAL ? F.in[IN_X] + (size_t)r * D : F.in[IN_META] + (size_t)(r - NREAL) * D;
        {
            const f32x4* xr = (const f32x4*)src + l;
            f32x4 v[4]; float s = 0.f;
#pragma unroll
            for (int j = 0; j < 4; ++j) { v[j] = xr[64 * j]; s += (v[j].x + v[j].y) + (v[j].z + v[j].w); }
            const float mean = wave_sum(s) * (1.f / D); float s2 = 0.f;
#pragma unroll
            for (int j = 0; j < 4; ++j) { v[j] = v[j] - mean; s2 += (v[j].x * v[j].x + v[j].y * v[j].y) + (v[j].z * v[j].z + v[j].w * v[j].w); }
            const float rstd = 1.f / sqrtf(wave_sum(s2) * (1.f / D) + LN_EPS);
#pragma unroll
            for (int j = 0; j < 4; ++j) {
                const f32x4 gg = ((const f32x4*)F.in[IN_LNIN_G])[l + 64 * j], bb = ((const f32x4*)F.in[IN_LNIN_B])[l + 64 * j];
                *(LAS f32x4*)(hrow + 4 * (l + 64 * j)) = v[j] * rstd * gg + bb;
            }
        }
        __builtin_amdgcn_wave_barrier();
        float a[6];
#pragma unroll
        for (int i = 0; i < 6; ++i) a[i] = 0.f;
        for (int k = 0; k < D; ++k) {
            const float hk = hrow[k]; const float* wr = w_in + (size_t)k * 2248;
#pragma unroll
            for (int i = 0; i < 4; ++i) a[i] += hk * wr[l + 64 * i];
            a[4] += hk * wr[384 + l];
            a[5] += hk * wr[448 + (l & 7)];
        }
        const float ss = wave_sum(a[0] * a[0] + a[1] * a[1] + a[2] * a[2] + a[3] * a[3]);
        const float rs = 1.0f / sqrtf(ss * (1.f / 256.f) + 1e-6f);
#pragma unroll
        for (int i = 0; i < 4; ++i) cqn[l + 64 * i] = a[i] * rs * F.in[IN_QNORM_G][l + 64 * i];
        {
            const float mean = wave_sum(a[4]) * (1.f / 64.f); const float dlt = a[4] - mean;
            const float var = wave_sum(dlt * dlt) * (1.f / 64.f);
            KIDX32[(size_t)r * 64 + l] = dlt * (1.0f / sqrtf(var + LN_EPS)) * F.in[IN_IDXLN_G][l] + F.in[IN_IDXLN_B][l];
        }
        if (l < 8) WIDX[(size_t)r * 8 + l] = a[5] * 0.04419417382415922f;
        __builtin_amdgcn_wave_barrier();
        float q[8];
#pragma unroll
        for (int i = 0; i < 8; ++i) q[i] = 0.f;
        for (int c = 0; c < 256; ++c) {
            const float cq = cqn[c]; const float* wr = w_iq + (size_t)c * 512;
#pragma unroll
            for (int i = 0; i < 8; ++i) q[i] += cq * wr[l + 64 * i];
        }
#pragma unroll
        for (int i = 0; i < 8; ++i) QIDX32[(size_t)r * 512 + l + 64 * i] = q[i];
        __builtin_amdgcn_wave_barrier();
    }
}

__device__ __forceinline__ unsigned sortable(float f) { const unsigned u = __float_as_uint(f); return (u & 0x80000000u) ? ~u : (u | 0x80000000u); }
__device__ __forceinline__ void p5_index_naive(Frame& F) {
    const bf16* QA = WSP(bf16, WS_QA); const bf16* KIDX = WSP(bf16, WS_KIDX); const float* WIDX = WSP(float, WS_WIDX);
    unsigned short* SEL = WSP(unsigned short, WS_SEL); int* NSEL = WSP(int, WS_NSEL);
    LAS float* sc = (LAS float*)(F.lds);
    LAS float* qf = (LAS float*)(F.lds + 33024);
    LAS unsigned* hist = (LAS unsigned*)(F.lds + 33024 + 2048);
    LAS unsigned* cw = hist + 256;
    const int tid = F.tid;
    for (int q = blockIdx.x; q < NROWS; q += F.G) {
        int b, pos; if (q < NREAL) { b = q >> 13; pos = NMETA + (q & (SEQ - 1)); } else { b = 0; pos = q - NREAL; }
        const int nvis = pos < NMETA ? NMETA : NMETA + 64 * ((pos - NMETA) / 64 + 1);
#if REFSEL
        qf[tid] = F.out[(size_t)q * 512 + tid];
#else
        qf[tid] = bf2f(QA[(size_t)q * QAW + 1024 + tid]);
#endif
        float w[8];
#pragma unroll
        for (int h = 0; h < 8; ++h) w[h] = WIDX[(size_t)q * 8 + h];
        __syncthreads();
        for (int j = tid; j < nvis; j += NTHR) {
            const v4u* kp = (const v4u*)(KIDX + (size_t)key_row(b, j) * 64);
#if REFSEL
            const f32x4* kp32 = (const f32x4*)(F.out + (size_t)R * 512 + (size_t)key_row(b, j) * 64);
#endif
            float d[8];
#pragma unroll
            for (int h = 0; h < 8; ++h) d[h] = 0.f;
#pragma unroll 2
            for (int c = 0; c < 8; ++c) {
#if REFSEL
                const f32x4 ta = kp32[2 * c], tb = kp32[2 * c + 1];
                const float k0 = ta.x, k1 = ta.y, k2 = ta.z, k3 = ta.w, k4 = tb.x, k5 = tb.y, k6 = tb.z, k7 = tb.w;
#else
                const v4u t = kp[c];
                const float k0 = bflo(t.x), k1 = bfhi(t.x), k2 = bflo(t.y), k3 = bfhi(t.y), k4 = bflo(t.z), k5 = bfhi(t.z), k6 = bflo(t.w), k7 = bfhi(t.w);
#endif
#pragma unroll
                for (int h = 0; h < 8; ++h) {
                    const f32x4 qa = *(const LAS f32x4*)(qf + h * 64 + 8 * c), qb = *(const LAS f32x4*)(qf + h * 64 + 8 * c + 4);
                    d[h] += qa.x * k0 + qa.y * k1 + qa.z * k2 + qa.w * k3 + qb.x * k4 + qb.y * k5 + qb.z * k6 + qb.w * k7;
                }
            }
            float s = 0.f;
#pragma unroll
            for (int h = 0; h < 8; ++h) s += w[h] * fmaxf(d[h], 0.f);
            sc[j] = s + 0.0f;
        }
        __syncthreads();
        unsigned short* selq = SEL + (size_t)q * TOPK;
        if (nvis <= TOPK) {
            for (int j = tid; j < nvis; j += NTHR) selq[j] = (unsigned short)j;
        } else {
            unsigned prefix = 0u, mask = 0u, need = TOPK;
            for (int pass = 0; pass < 4; ++pass) {
                const int shift = 24 - 8 * pass;
                if (tid < 256) hist[tid] = 0u;
                __syncthreads();
                for (int j = tid; j < nvis; j += NTHR) { const unsigned key = sortable(sc[j]); if ((key & mask) == prefix) atomicAdd((unsigned*)&hist[(key >> shift) & 255u], 1u); }
                __syncthreads();
                if (tid < 256) {
                    unsigned above = 0u; for (int bb = tid + 1; bb < 256; ++bb) above += hist[bb];
                    const unsigned c = hist[tid];
                    if (above < need && need <= above + c) { cw[0] = prefix | ((unsigned)tid << shift); cw[1] = need - above; }
                }
                __syncthreads();
                prefix = cw[0]; need = cw[1]; mask |= 0xFFu << shift;
                __syncthreads();
            }
            if (tid == 0) cw[2] = 0u;
            __syncthreads();
            for (int j = tid; j < nvis; j += NTHR) { if (sortable(sc[j]) > prefix) { const unsigned p = atomicAdd((unsigned*)&cw[2], 1u); selq[p] = (unsigned short)j; } }
            __syncthreads();
            if (F.wave == 0) {
                const unsigned base = cw[2]; unsigned taken = 0u;
                for (int j0 = 0; j0 < nvis && taken < need; j0 += 64) {
                    const int j = j0 + F.lane; const bool eq = j < nvis && sortable(sc[j]) == prefix;
                    const unsigned long long m = __ballot(eq);
                    const unsigned rank = (unsigned)__popcll(m & ((1ull << F.lane) - 1ull));
                    if (eq && taken + rank < need) selq[base + taken + rank] = (unsigned short)j;
                    taken += (unsigned)__popcll(m);
                }
            }
        }
        if (tid == 0) NSEL[q] = nvis < TOPK ? nvis : TOPK;
        __syncthreads();
    }
}

__device__ __forceinline__ void p6_attn_naive(Frame& F) {
    bf16* QA = WSP(bf16, WS_QA); const bf16* CKV = WSP(bf16, WS_CKV); const unsigned short* SEL = WSP(unsigned short, WS_SEL); const int* NSEL = WSP(int, WS_NSEL);
    LAS float* qf = (LAS float*)(F.lds + F.wave * 16384);
    LAS float* ps = qf + 1024;
    LAS int* srow = (LAS int*)(ps + 2048);
    const int l = F.lane;
    const int gw = blockIdx.x * NWAVES + F.wave, NGW = F.G * NWAVES;
    for (int q = gw; q < R; q += NGW) {
        bf16* qrow = QA + (size_t)q * QAW;
        if (q >= NROWS) {
            for (int c = l; c < QAW / 8; c += 64) *(v4u*)(qrow + 8 * c) = (v4u){0u, 0u, 0u, 0u};
            continue;
        }
        int b, pos; if (q < NREAL) { b = q >> 13; pos = NMETA + (q & (SEQ - 1)); } else { b = 0; pos = q - NREAL; }
        const int nsel = NSEL[q];
        {
            const v4u t0 = *(const v4u*)(qrow + 16 * l), t1 = *(const v4u*)(qrow + 16 * l + 8);
            LAS float* d = qf + 16 * l;
            d[0] = bflo(t0.x); d[1] = bfhi(t0.x); d[2] = bflo(t0.y); d[3] = bfhi(t0.y); d[4] = bflo(t0.z); d[5] = bfhi(t0.z); d[6] = bflo(t0.w); d[7] = bfhi(t0.w);
            d[8] = bflo(t1.x); d[9] = bfhi(t1.x); d[10] = bflo(t1.y); d[11] = bfhi(t1.y); d[12] = bflo(t1.z); d[13] = bfhi(t1.z); d[14] = bflo(t1.w); d[15] = bfhi(t1.w);
        }
        __builtin_amdgcn_wave_barrier();
        for (int kk = 0; kk < 4; ++kk) {
            const int s = kk * 64 + l; const bool valid = s < nsel;
            const int j = valid ? (int)SEL[(size_t)q * TOPK + s] : 0;
            const int row = key_row(b, j);
            srow[s] = row;
            float acc[8];
#pragma unroll
            for (int h = 0; h < 8; ++h) acc[h] = 0.f;
            const v4u* kp = (const v4u*)(CKV + (size_t)row * 128);
            for (int c8 = 0; c8 < 16; ++c8) {
                const v4u t = kp[c8];
                const float k0 = bflo(t.x), k1 = bfhi(t.x), k2 = bflo(t.y), k3 = bfhi(t.y), k4 = bflo(t.z), k5 = bfhi(t.z), k6 = bflo(t.w), k7 = bfhi(t.w);
#pragma unroll
                for (int h = 0; h < 8; ++h) {
                    const f32x4 qa = *(const LAS f32x4*)(qf + h * 128 + 8 * c8), qb = *(const LAS f32x4*)(qf + h * 128 + 8 * c8 + 4);
                    acc[h] += qa.x * k0 + qa.y * k1 + qa.z * k2 + qa.w * k3 + qb.x * k4 + qb.y * k5 + qb.z * k6 + qb.w * k7;
                }
            }
            const float dist = fabsf((float)(pos - j));
#pragma unroll
            for (int h = 0; h < 8; ++h) { const float slope = __uint_as_float((unsigned)(127 - (h + 1)) << 23); ps[s * 8 + h] = valid ? acc[h] - slope * dist : -INFINITY; }
        }
        __builtin_amdgcn_wave_barrier();
#pragma unroll
        for (int h = 0; h < 8; ++h) {
            float v0 = ps[(l) * 8 + h], v1 = ps[(l + 64) * 8 + h], v2 = ps[(l + 128) * 8 + h], v3 = ps[(l + 192) * 8 + h];
            const float mx = wave_max(fmaxf(fmaxf(v0, v1), fmaxf(v2, v3)));
            v0 = __expf(v0 - mx); v1 = __expf(v1 - mx); v2 = __expf(v2 - mx); v3 = __expf(v3 - mx);
            const float inv = 1.0f / wave_sum((v0 + v1) + (v2 + v3));
            ps[(l) * 8 + h] = v0 * inv; ps[(l + 64) * 8 + h] = v1 * inv; ps[(l + 128) * 8 + h] = v2 * inv; ps[(l + 192) * 8 + h] = v3 * inv;
        }
        __builtin_amdgcn_wave_barrier();
        float o0[8], o1[8];
#pragma unroll
        for (int h = 0; h < 8; ++h) { o0[h] = 0.f; o1[h] = 0.f; }
        for (int s = 0; s < nsel; ++s) {
            const int row = srow[s];
            const unsigned w = *(const unsigned*)(CKV + (size_t)row * 128 + 2 * l);
            const float c0 = bflo(w), c1 = bfhi(w);
            const f32x4 pa = *(const LAS f32x4*)(ps + s * 8), pb = *(const LAS f32x4*)(ps + s * 8 + 4);
            o0[0] += pa.x * c0; o1[0] += pa.x * c1; o0[1] += pa.y * c0; o1[1] += pa.y * c1; o0[2] += pa.z * c0; o1[2] += pa.z * c1; o0[3] += pa.w * c0; o1[3] += pa.w * c1;
            o0[4] += pb.x * c0; o1[4] += pb.x * c1; o0[5] += pb.y * c0; o1[5] += pb.y * c1; o0[6] += pb.z * c0; o1[6] += pb.z * c1; o0[7] += pb.w * c0; o1[7] += pb.w * c1;
        }
#pragma unroll
        for (int h = 0; h < 8; ++h) *(unsigned*)(qrow + h * 128 + 2 * l) = pk2(o0[h], o1[h]);
        __builtin_amdgcn_wave_barrier();
    }
}

__device__ __forceinline__ void p7_rwkv_prep_naive(Frame& F) {
    const bf16* P = WSP(bf16, WS_P); float* DEC = WSP(float, WS_DEC); bf16* AB = WSP(bf16, WS_AB); bf16* GB = WSP(bf16, WS_GB);
    const float* mu = F.in[IN_MU]; const float* Wd = F.in[IN_W_DEC]; const float* Wa = F.in[IN_W_AAA]; const float* Wg = F.in[IN_W_GATE];
    const int l = F.lane;
    const int gw = blockIdx.x * NWAVES + F.wave, NGW = F.G * NWAVES;
    for (int r = gw; r < NROWS; r += NGW) {
        int prev; if (r < NREAL) { prev = (r & (SEQ - 1)) ? r - 1 : NREAL + NMETA - 1; } else { prev = r > NREAL ? r - 1 : -1; }
        const bf16* pr = P + (size_t)r * PW; const bf16* pp = prev >= 0 ? P + (size_t)prev * PW : nullptr;
#define SHIFTED(pc, mc) (bf2f(pr[pc]) + ((pp ? bf2f(pp[pc]) : 0.f) - bf2f(pr[pc])) * mu[mc])
        const float tw = tanhf(SHIFTED(PC_WD + l, 1536 + l));
        const float ta = SHIFTED(PC_AD + l, 1600 + l);
        const float tg0 = sigmoidf_(SHIFTED(PC_GD + l, 1664 + l)), tg1 = sigmoidf_(SHIFTED(PC_GD + 64 + l, 1728 + l));
#undef SHIFTED
        float aw[8], aa[8], ag[8];
#pragma unroll
        for (int i = 0; i < 8; ++i) { aw[i] = F.in[IN_W0][l + 64 * i]; aa[i] = F.in[IN_A0][l + 64 * i]; ag[i] = 0.f; }
        for (int j = 0; j < 64; ++j) {
            const float xw = __shfl(tw, j), xa = __shfl(ta, j), xg0 = __shfl(tg0, j), xg1 = __shfl(tg1, j);
#pragma unroll
            for (int i = 0; i < 8; ++i) {
                aw[i] += xw * Wd[(size_t)j * 512 + l + 64 * i];
                aa[i] += xa * Wa[(size_t)j * 512 + l + 64 * i];
                ag[i] += xg0 * Wg[(size_t)j * 512 + l + 64 * i] + xg1 * Wg[(size_t)(j + 64) * 512 + l + 64 * i];
            }
        }
#pragma unroll
        for (int i = 0; i < 8; ++i) {
            const float x = -aw[i];
            const float sp = x > 20.f ? x : log1pf(__expf(x));
            const float wlog = -sp - 0.5f;
            DEC[(size_t)r * 512 + l + 64 * i] = __expf(-__expf(wlog));
            AB[(size_t)r * 512 + l + 64 * i] = (bf16)f2bf(sigmoidf_(aa[i]));
            GB[(size_t)r * 512 + l + 64 * i] = (bf16)f2bf(ag[i]);
        }
    }
}

__device__ __forceinline__ void p8_rwkv_scan_naive(Frame& F) {
    if (F.wave != 0 || blockIdx.x >= 32) return;
    const bf16* P = WSP(bf16, WS_P); const float* DEC = WSP(float, WS_DEC); const bf16* AB = WSP(bf16, WS_AB); const bf16* GB = WSP(bf16, WS_GB); bf16* QA = WSP(bf16, WS_QA);
    const int b = blockIdx.x >> 3, h = blockIdx.x & 7, l = F.lane, ch = h * 64 + l;
    LAS float* vec = (LAS float*)F.lds;
    const float mu_r = F.in[IN_MU][ch], mu_k = F.in[IN_MU][512 + ch], mu_v = F.in[IN_MU][1024 + ch];
    const float kk_c = F.in[IN_KK][ch], ka_c = F.in[IN_KA][ch], rk_c = F.in[IN_RK][ch], gng = F.in[IN_GN_G][ch], gnb = F.in[IN_GN_B][ch];
    float S[64];
#pragma unroll
    for (int k = 0; k < 64; ++k) S[k] = 0.f;
    float pr_p = 0.f, pk_p = 0.f, pv_p = 0.f;
    int row = key_row(b, 0);
    float n_pr = bf2f(P[(size_t)row * PW + PC_R + ch]), n_pk = bf2f(P[(size_t)row * PW + PC_K + ch]), n_pv = bf2f(P[(size_t)row * PW + PC_V + ch]);
    float n_w = DEC[(size_t)row * 512 + ch], n_a = bf2f(AB[(size_t)row * 512 + ch]), n_g = bf2f(GB[(size_t)row * 512 + ch]);
    for (int pos = 0; pos < TT; ++pos) {
        const int crow = row;
        const float c_pr = n_pr, c_pk = n_pk, c_pv = n_pv, c_w = n_w, c_a = n_a, c_g = n_g;
        if (pos + 1 < TT) {
            row = key_row(b, pos + 1);
            n_pr = bf2f(P[(size_t)row * PW + PC_R + ch]); n_pk = bf2f(P[(size_t)row * PW + PC_K + ch]); n_pv = bf2f(P[(size_t)row * PW + PC_V + ch]);
            n_w = DEC[(size_t)row * 512 + ch]; n_a = bf2f(AB[(size_t)row * 512 + ch]); n_g = bf2f(GB[(size_t)row * 512 + ch]);
        }
        const float r_s = c_pr + (pr_p - c_pr) * mu_r, k_s = c_pk + (pk_p - c_pk) * mu_k, v_s = c_pv + (pv_p - c_pv) * mu_v;
        pr_p = c_pr; pk_p = c_pk; pv_p = c_pv;
        const float kkr = k_s * kk_c;
        const float nrm = sqrtf(wave_sum(kkr * kkr));
        const float kk = kkr / fmaxf(nrm, 1e-12f);
        const float k2 = k_s * (1.f + (c_a - 1.f) * ka_c);
        vec[l] = -kk; vec[64 + l] = kk * c_a; vec[128 + l] = c_w; vec[192 + l] = k2; vec[256 + l] = r_s;
        __builtin_amdgcn_wave_barrier();
        float sa = 0.f;
#pragma unroll
        for (int k4 = 0; k4 < 16; ++k4) { const f32x4 a = *(const LAS f32x4*)(vec + 4 * k4); sa += S[4 * k4] * a.x + S[4 * k4 + 1] * a.y + S[4 * k4 + 2] * a.z + S[4 * k4 + 3] * a.w; }
        float y = 0.f;
#pragma unroll
        for (int k4 = 0; k4 < 16; ++k4) {
            const f32x4 bv = *(const LAS f32x4*)(vec + 64 + 4 * k4), w = *(const LAS f32x4*)(vec + 128 + 4 * k4), kv = *(const LAS f32x4*)(vec + 192 + 4 * k4), rv = *(const LAS f32x4*)(vec + 256 + 4 * k4);
            S[4 * k4] = S[4 * k4] * w.x + sa * bv.x + v_s * kv.x; S[4 * k4 + 1] = S[4 * k4 + 1] * w.y + sa * bv.y + v_s * kv.y;
            S[4 * k4 + 2] = S[4 * k4 + 2] * w.z + sa * bv.z + v_s * kv.z; S[4 * k4 + 3] = S[4 * k4 + 3] * w.w + sa * bv.w + v_s * kv.w;
            y += S[4 * k4] * rv.x + S[4 * k4 + 1] * rv.y + S[4 * k4 + 2] * rv.z + S[4 * k4 + 3] * rv.w;
        }
        __builtin_amdgcn_wave_barrier();
        const float mean = wave_sum(y) * (1.f / 64.f);
        const float dlt = y - mean;
        const float var = wave_sum(dlt * dlt) * (1.f / 64.f);
        const float yn = dlt * (1.0f / sqrtf(var + GN_EPS)) * gng + gnb;
        const float bonus = wave_sum(r_s * k2 * rk_c) * v_s;
        const float o = (yn + bonus) * c_g;
        if (pos >= NMETA || b == 0) QA[(size_t)crow * QAW + 1024 + ch] = (bf16)f2bf(o);
    }
}

template <bool OUT_BF16>
__device__ __forceinline__ void ln_rows4(Frame& F, int nrows, const float* g, const float* b, bf16* dstb) {
    const int gw = blockIdx.x * NWAVES + F.wave, NGW = F.G * NWAVES;
    const float* META1 = WSP(float, WS_META1);
    f32x4 gg[4], bb[4];
#pragma unroll
    for (int j = 0; j < 4; ++j) { gg[j] = ((const f32x4*)g)[F.lane + 64 * j]; bb[j] = ((const f32x4*)b)[F.lane + 64 * j]; }
    for (int r0 = gw * 4; r0 < nrows; r0 += NGW * 4) {
        f32x4 v[4][4];
#pragma unroll
        for (int q = 0; q < 4; ++q) {
            const int r = r0 + q < nrows ? r0 + q : nrows - 1;
            const f32x4* xr = (const f32x4*)(r < NREAL ? F.out + (size_t)r * D : META1 + (size_t)(r - NREAL) * D) + F.lane;
#pragma unroll
            for (int j = 0; j < 4; ++j) v[q][j] = xr[64 * j];
        }
#pragma unroll
        for (int q = 0; q < 4; ++q) {
            float s = 0.f;
#pragma unroll
            for (int j = 0; j < 4; ++j) s += (v[q][j].x + v[q][j].y) + (v[q][j].z + v[q][j].w);
            const float mean = wave_sum(s) * (1.f / D); float s2 = 0.f;
#pragma unroll
            for (int j = 0; j < 4; ++j) { v[q][j] = v[q][j] - mean; s2 += (v[q][j].x * v[q][j].x + v[q][j].y * v[q][j].y) + (v[q][j].z * v[q][j].z + v[q][j].w * v[q][j].w); }
            const float rstd = 1.f / sqrtf(wave_sum(s2) * (1.f / D) + LN_EPS);
            if (r0 + q < nrows) {
                if (OUT_BF16) { v2u* o8 = (v2u*)(dstb + (size_t)(r0 + q) * D) + F.lane;
#pragma unroll
                    for (int j = 0; j < 4; ++j) { const f32x4 y = v[q][j] * rstd * gg[j] + bb[j]; o8[64 * j] = (v2u){pk2(y.x, y.y), pk2(y.z, y.w)}; }
                } else { f32x4* o = (f32x4*)(F.out + (size_t)(r0 + q) * D) + F.lane;
#pragma unroll
                    for (int j = 0; j < 4; ++j) o[64 * j] = v[q][j] * rstd * gg[j] + bb[j]; }
            }
        }
    }
}
__device__ __forceinline__ void p10_ln1(Frame& F) { ln_rows4<true>(F, NROWS, F.in[IN_LN1_G], F.in[IN_LN1_B], WSP(bf16, WS_H)); }
__device__ __forceinline__ void p14_ln2(Frame& F) { ln_rows4<false>(F, NREAL, F.in[IN_LN2_G], F.in[IN_LN2_B], nullptr); }

__device__ __forceinline__ float gelu_fast(float x) {
    const float u2 = x * (1.5957691216057308f + 0.07135481627260025f * x * x);
    return x * __builtin_amdgcn_rcpf(1.0f + __builtin_amdgcn_exp2f(-1.4426950408889634f * u2));
}
__device__ __forceinline__ void p12_conv_fix(Frame& F) {
    bf16* ACT = WSP(bf16, WS_UP); const float* cw = F.in[IN_CONV_W]; const float* cb = F.in[IN_CONV_B];
    const float* G01 = WSP(float, WS_G01); const float* V01 = WSP(float, WS_V01); const float* GHALO = WSP(float, WS_GHALO); const float* GMETA = WSP(float, WS_GMETA);
    for (int it = blockIdx.x * NTHR + F.tid; it < 128 * 2 * DFF; it += F.G * NTHR) {
        const int j = it % DFF, rr = (it / DFF) & 1, pm = it / (2 * DFF);
        const float* ph = (pm & 31) ? GHALO + (size_t)(pm - 1) * 2 * DFF : GMETA;
        const float g0 = G01[((size_t)pm * 2 + rr) * DFF + j];
        const float g1 = rr ? G01[((size_t)pm * 2) * DFF + j] : ph[DFF + j];
        const float g2 = rr ? ph[DFF + j] : ph[j];
        const float x = cw[j] * g2 + cw[DFF + j] * g1 + cw[2 * DFF + j] * g0 + cb[j];
        ACT[(size_t)(pm * 256 + rr) * DFF + j] = (bf16)f2bf(gelu_fast(x) * V01[((size_t)pm * 2 + rr) * DFF + j]);
    }
}


constexpr int NUNITS = 4096 + 8;
constexpr int RP = 72;
constexpr int SLOT = 64 * RP * 2;
constexpr int FP = 68;
typedef short bf16x8 __attribute__((ext_vector_type(8)));
typedef float f32x16 __attribute__((ext_vector_type(16)));
constexpr size_t RW_MAT = (size_t)NUNITS * 4096;

__device__ __forceinline__ void quad_mma(f32x16& acc, const LAS bf16* Aop, const LAS bf16* Bop, int qr, int qc, int lane) {
    const int r = lane & 31, hf = lane >> 5;
    const LAS bf16* ap = Aop + (32 * qr + r) * RP + 8 * hf; const LAS bf16* bp = Bop + (32 * qc + r) * RP + 8 * hf;
#pragma unroll
    for (int ks = 0; ks < 4; ++ks) {
        const bf16x8 a = *(const LAS bf16x8*)(ap + 16 * ks), b = *(const LAS bf16x8*)(bp + 16 * ks);
        acc = __builtin_amdgcn_mfma_f32_32x32x16_bf16(a, b, acc, 0, 0, 0);
    }
}
#define ACC_M(qr, j, hf) (32 * (qr) + ((j) & 3) + 8 * ((j) >> 2) + 4 * (hf))
__device__ __forceinline__ void store_T(const f32x16& acc, LAS bf16* Z, int qr, int qc, int lane) {
    const int r = lane & 31, hf = lane >> 5;
#pragma unroll
    for (int jj = 0; jj < 4; ++jj)
        *(LAS v2u*)(Z + (32 * qc + r) * RP + 32 * qr + 8 * jj + 4 * hf) = (v2u){pk2(acc[4 * jj], acc[4 * jj + 1]), pk2(acc[4 * jj + 2], acc[4 * jj + 3])};
}
__device__ __forceinline__ void add_T(f32x16& acc, const LAS bf16* Z, int qr, int qc, int lane) {
    const int r = lane & 31, hf = lane >> 5;
#pragma unroll
    for (int jj = 0; jj < 4; ++jj) {
        const v2u w = *(const LAS v2u*)(Z + (32 * qc + r) * RP + 32 * qr + 8 * jj + 4 * hf);
        acc[4 * jj] += bflo(w.x); acc[4 * jj + 1] += bfhi(w.x); acc[4 * jj + 2] += bflo(w.y); acc[4 * jj + 3] += bfhi(w.y);
    }
}
__device__ __forceinline__ int frag_off(int n, int m) { return (((m >> 4) * 2 + ((m >> 3) & 1)) * 64 + n) * 8 + (m & 7); }
__device__ __forceinline__ int acc_off(int n, int m) { return ((((m >> 5) * 4 + ((m >> 3) & 3)) * 2 + ((m >> 2) & 1)) * 64 + n) * 4 + (m & 3); }
template <bool FRAG>
__device__ __forceinline__ void store_T_global(const f32x16& acc, bf16* Z, int qr, int qc, int lane) {
    const int r = lane & 31, hf = lane >> 5;
#pragma unroll
    for (int jj = 0; jj < 4; ++jj) { const int n = 32 * qc + r, m0 = 32 * qr + 8 * jj + 4 * hf;
        *(v2u*)(Z + (FRAG ? frag_off(n, m0) : acc_off(n, m0))) = (v2u){pk2(acc[4 * jj], acc[4 * jj + 1]), pk2(acc[4 * jj + 2], acc[4 * jj + 3])}; }
}
__device__ __forceinline__ f32x16 zero16() { f32x16 z;
#pragma unroll
    for (int j = 0; j < 16; ++j) z[j] = 0.f;
    return z; }

__device__ __forceinline__ void b1_load_raw(const bf16* P, int u, int w, int l, unsigned short (&rv)[45]) {
    const bool meta = u >= 4096;
    int b = 0, h, c = 0; if (meta) h = u - 4096; else { b = u >> 10; h = (u >> 7) & 7; c = u & 127; }
    const int ch = h * 64 + l, row0 = meta ? NREAL : b * SEQ + c * 64, t0 = 8 * w;
    int prow = -1;
    if (t0 > 0) prow = row0 + t0 - 1; else if (!meta) prow = (c == 0) ? NREAL + NMETA - 1 : row0 - 1;
#pragma unroll
    for (int i = 0; i < 9; ++i) {
        const int t = t0 - 1 + i;
        const int row = i == 0 ? prow : ((!meta || t < NMETA) ? row0 + t : -1);
        const bf16* pp = P + (size_t)(row >= 0 ? row : 0) * PW;
        const unsigned short a0 = pp[PC_R + ch], a1 = pp[PC_K + ch], a2 = pp[PC_V + ch], a3 = pp[PC_WD + l], a4 = pp[PC_AD + l];
        const bool ok = row >= 0;
        rv[5 * i] = ok ? a0 : (unsigned short)0; rv[5 * i + 1] = ok ? a1 : (unsigned short)0; rv[5 * i + 2] = ok ? a2 : (unsigned short)0; rv[5 * i + 3] = ok ? a3 : (unsigned short)0; rv[5 * i + 4] = ok ? a4 : (unsigned short)0;
    }
}

#define LDS_BARRIER() do { asm volatile("s_waitcnt lgkmcnt(0)" ::: "memory"); __builtin_amdgcn_s_barrier(); asm volatile("" ::: "memory"); } while (0)
#ifdef PROBE_B1SEC
#define B1T(k) do { if (blockIdx.x == 0 && F.tid == 0) { const unsigned long long t_ = __builtin_amdgcn_s_memrealtime(); if ((k) == PROBE_B1SEC + 1) b1acc += t_ - b1t0; b1t0 = t_; } } while (0)
#else
#define B1T(k) do {} while (0)
#endif
__device__ __forceinline__ void rw_b1(Frame& F) {
    const bf16* P = WSP(bf16, WS_P);
    bf16* RWM = WSP(bf16, WS_RWM); bf16* RWN = WSP(bf16, WS_RWN); bf16* RWQ = WSP(bf16, WS_RWQ); bf16* RWY = WSP(bf16, WS_RWY);
    float* BONUS = (float*)((char*)F.out + OUT_BONUS);
    const bf16* WdT = WSP(bf16, WS_WT_LORA); const bf16* WaT = WdT + 512 * 64;
    const float* mu = F.in[IN_MU];
    const int w = F.wave, l = F.lane, tid = F.tid;
    LAS unsigned char* L = F.lds;
#define SL(s) ((LAS bf16*)(L + (s) * SLOT))
    LAS float* WL = (LAS float*)(L + 12 * SLOT);
    LAS float* AL = (LAS float*)(L + 0 * SLOT);
    LAS float* OT = (LAS float*)(L + RING_BYTES + 1024);
    LAS float* GL = OT + 512;
    unsigned long long b1acc = 0ull, b1t0 = 0ull; (void)b1acc; (void)b1t0;
    unsigned short rnx[45];
    b1_load_raw(P, (int)blockIdx.x < NUNITS ? (int)blockIdx.x : 0, w, l, rnx);
    for (int u = blockIdx.x; u < NUNITS; u += F.G) {
        const bool meta = u >= 4096;
        int b = 0, h, c = 0; if (meta) h = u - 4096; else { b = u >> 10; h = (u >> 7) & 7; c = u & 127; }
        const int ch = h * 64 + l;
        const int row0 = meta ? NREAL : b * SEQ + c * 64;
        LDS_BARRIER();
        B1T(0);
        float r_s[8], k_s[8], v_s[8], xw[8], xa[8];
        {
            const int t0 = 8 * w;
            unsigned short rc[45];
#pragma unroll
            for (int i = 0; i < 45; ++i) rc[i] = rnx[i];
            float pr = bf2f(rc[0]), pk = bf2f(rc[1]), pv = bf2f(rc[2]), pw = bf2f(rc[3]), pa = bf2f(rc[4]);
            const float mr = mu[ch], mk = mu[512 + ch], mv = mu[1024 + ch], mw = mu[1536 + l], ma = mu[1600 + l];
#pragma unroll
            for (int i = 0; i < 8; ++i) {
                const int t = t0 + i; const bool valid = !meta || t < NMETA;
                const float cr = bf2f(rc[5 * i + 5]), ck = bf2f(rc[5 * i + 6]), cv = bf2f(rc[5 * i + 7]), cw = bf2f(rc[5 * i + 8]), ca = bf2f(rc[5 * i + 9]);
                r_s[i] = valid ? cr + (pr - cr) * mr : 0.f; k_s[i] = valid ? ck + (pk - ck) * mk : 0.f; v_s[i] = valid ? cv + (pv - cv) * mv : 0.f;
                xw[i] = fast_tanh(cw + (pw - cw) * mw); xa[i] = ca + (pa - ca) * ma;
                pr = cr; pk = ck; pv = cv; pw = cw; pa = ca;
            }
#pragma unroll
            for (int i = 0; i < 8; ++i) { SL(8)[(t0 + i) * RP + l] = (bf16)f2bf(xw[i]); SL(9)[(t0 + i) * RP + l] = (bf16)f2bf(xa[i]); }
            {
                const int k = tid >> 3, pc = tid & 7;
                *(LAS v4u*)(SL(10) + k * RP + 8 * pc) = *(const v4u*)(WdT + (size_t)(h * 64 + k) * 64 + 8 * pc);
                *(LAS v4u*)(SL(11) + k * RP + 8 * pc) = *(const v4u*)(WaT + (size_t)(h * 64 + k) * 64 + 8 * pc);
            }
        }
        __syncthreads();
        B1T(1);
        {
            const int pid = w >> 2, q = w & 3, qr = q >> 1, qc = q & 1;
            f32x16 acc = zero16();
            quad_mma(acc, SL(10 + pid), SL(8 + pid), qr, qc, l);
            LAS float* Zf = pid ? AL : WL;
            const int r = l & 31, hf = l >> 5;
#pragma unroll
            for (int jj = 0; jj < 4; ++jj) *(LAS f32x4*)(Zf + (32 * qc + r) * FP + 32 * qr + 8 * jj + 4 * hf) = (f32x4){acc[4 * jj], acc[4 * jj + 1], acc[4 * jj + 2], acc[4 * jj + 3]};
        }
        __syncthreads();
        B1T(2);
        float lw[8], asg[8];
        {
            const float w0c = F.in[IN_W0][ch], a0c = F.in[IN_A0][ch];
            float run = 0.f;
#pragma unroll
            for (int i = 0; i < 8; ++i) {
                const int t = 8 * w + i; const bool valid = !meta || t < NMETA;
                const float x = -(WL[t * FP + l] + w0c);
                const float sp = x > 20.f ? x : __logf(1.0f + __expf(x));
                const float e = -__expf(-sp - 0.5f);
                run += valid ? e : 0.f; lw[i] = run;
                asg[i] = sigmoidf_(AL[t * FP + l] + a0c);
            }
            OT[w * 64 + l] = run;
        }
        __syncthreads();
        {
            float off = 0.f, tot = 0.f;
#pragma unroll
            for (int ww = 0; ww < 8; ++ww) { const float o = OT[ww * 64 + l]; tot += o; off += ww < w ? o : 0.f; }
            if (w == 0) GL[l] = __expf(tot);
            const float kkc = F.in[IN_KK][ch], kac = F.in[IN_KA][ch], rkc = F.in[IN_RK][ch];
            unsigned atc[4], vc[4], bhc[4], khc[4];
            float prevlg = off;
#pragma unroll
            for (int i = 0; i < 8; ++i) {
                const int t = 8 * w + i;
                const float lg = off + lw[i];
                const float g = __expf(lg), gp = __expf(prevlg), gi = __expf(-lg), gh = __expf(tot - lg);
                prevlg = lg;
                const float kkr = k_s[i] * kkc;
                const float kk = kkr * __builtin_amdgcn_rsqf(fmaxf(wave_sum(kkr * kkr), 1e-24f));
                const float k2 = k_s[i] * (1.f + (asg[i] - 1.f) * kac);
                const float bon = wave_sum(r_s[i] * k2 * rkc);
                if (l == 0) BONUS[(size_t)u * 64 + t] = bon;
                const float at = -kk * gp, rt = r_s[i] * g, bt = kk * asg[i] * gi, kt = k2 * gi, bh = kk * asg[i] * gh, kh = k2 * gh;
                SL(0)[t * RP + l] = (bf16)f2bf(at); SL(1)[t * RP + l] = (bf16)f2bf(rt); SL(2)[t * RP + l] = (bf16)f2bf(bt); SL(3)[t * RP + l] = (bf16)f2bf(kt);
                const unsigned ua = f2bf(at), uv = f2bf(v_s[i]), ub = f2bf(bh), uk = f2bf(kh);
                if (i & 1) { atc[i >> 1] |= ua << 16; vc[i >> 1] |= uv << 16; bhc[i >> 1] |= ub << 16; khc[i >> 1] |= uk << 16; }
                else { atc[i >> 1] = ua; vc[i >> 1] = uv; bhc[i >> 1] = ub; khc[i >> 1] = uk; }
            }
            *(LAS v4u*)(SL(4) + l * RP + 8 * w) = (v4u){atc[0], atc[1], atc[2], atc[3]};
            *(LAS v4u*)(SL(5) + l * RP + 8 * w) = (v4u){vc[0], vc[1], vc[2], vc[3]};
            *(LAS v4u*)(SL(6) + l * RP + 8 * w) = (v4u){bhc[0], bhc[1], bhc[2], bhc[3]};
            *(LAS v4u*)(SL(7) + l * RP + 8 * w) = (v4u){khc[0], khc[1], khc[2], khc[3]};
        }
        __syncthreads();
        B1T(3);
        for (int task = w; task < 20; task += 8) {
            int pid, qr, qc; bool zero = false;
            if (task < 15) { pid = task / 3; const int k = task % 3;
                if (pid == 1) { qc = k == 2 ? 1 : 0; qr = k == 0 ? 0 : 1; } else { qc = k == 0 ? 0 : 1; qr = k == 2 ? 1 : 0; } }
            else { pid = task - 15; zero = true; if (pid == 1) { qc = 1; qr = 0; } else { qc = 0; qr = 1; } }
            const int bop = pid == 0 ? 0 : pid == 1 ? 2 : pid == 2 ? 0 : 1;
            const int aop = pid == 0 ? 2 : pid == 1 ? 0 : pid == 2 ? 3 : pid == 3 ? 2 : 3;
            f32x16 acc = zero16();
            if (!zero) {
                quad_mma(acc, SL(aop), SL(bop), qr, qc, l);
                const int n = 32 * qc + (l & 31), hf = l >> 5;
#pragma unroll
                for (int j = 0; j < 16; ++j) {
                    const int m = ACC_M(qr, j, hf);
                    const bool keep = pid == 1 ? (m > n) : (pid <= 2 ? (n > m) : (n >= m));
                    acc[j] = keep ? acc[j] : 0.f;
                }
            }
            store_T(acc, SL(8 + pid), qr, qc, l);
        }
        __syncthreads();
        B1T(4);
        const int nq = w & 3, nqr = nq >> 1, nqc = nq & 1;
        f32x16 nacc = zero16();
        if (w < 4) { add_T(nacc, SL(8), nqr, nqc, l); }
        for (int task = w; task < 12; task += 8) {
            const int pid = task >> 2, q = task & 3, qr = q >> 1, qc = q & 1;
            f32x16 acc = zero16();
            if (pid == 0) { quad_mma(acc, SL(9), SL(8), qr, qc, l); store_T(acc, SL(0), qr, qc, l); }
            else if (pid == 1) { quad_mma(acc, SL(8), SL(9), qr, qc, l); store_T(acc, SL(2), qr, qc, l); }
            else { quad_mma(acc, SL(10), SL(5), qr, qc, l); store_T(acc, SL(3), qr, qc, l); }
        }
        __syncthreads();
#pragma unroll
        for (int st = 0; st < 4; ++st) {
            const int pr = (st & 1) ? 10 : 0, pc = (st & 1) ? 13 : 2, pr2 = (st & 1) ? 0 : 10, pc2 = (st & 1) ? 2 : 13, nr = (st & 1) ? 9 : 8, nr2 = (st & 1) ? 8 : 9;
            if (w < 4) {
                add_T(nacc, SL(pr), nqr, nqc, l);
                quad_mma(nacc, SL(pc), SL(nr), nqr, nqc, l);
                store_T(nacc, SL(nr2), nqr, nqc, l);
                f32x16 acc = zero16();
                quad_mma(acc, SL(pc), SL(pr), nqr, nqc, l); store_T(acc, SL(pr2), nqr, nqc, l);
            } else {
                f32x16 acc = zero16();
                quad_mma(acc, SL(pr), SL(pc), nqr, nqc, l); store_T(acc, SL(pc2), nqr, nqc, l);
            }
            __syncthreads();
        }
        if (w < 4) { add_T(nacc, SL(0), nqr, nqc, l); quad_mma(nacc, SL(2), SL(8), nqr, nqc, l); store_T(nacc, SL(9), nqr, nqc, l); }
        __syncthreads();
        B1T(5);
        b1_load_raw(P, u + F.G < NUNITS ? u + F.G : u, w, l, rnx);
        {
            const int pid = w >> 2;
            f32x16 acc = zero16();
            add_T(acc, SL(pid ? 3 : 4), nqr, nqc, l);
            quad_mma(acc, SL(9), SL(pid ? 3 : 4), nqr, nqc, l);
            store_T(acc, SL(pid ? 2 : 0), nqr, nqc, l);
        }
        LDS_BARRIER();
        for (int task = w; task < 16; task += 8) {
            const int pid = task >> 2, q = task & 3, qr = q >> 1, qc = q & 1;
            f32x16 acc = zero16();
            if (pid == 0) { add_T(acc, SL(1), qr, qc, l); quad_mma(acc, SL(0), SL(11), qr, qc, l); store_T_global<true>(acc, RWQ + (size_t)u * 4096, qr, qc, l); }
            else if (pid == 1) { quad_mma(acc, SL(2), SL(11), qr, qc, l); quad_mma(acc, SL(5), SL(12), qr, qc, l); store_T_global<false>(acc, RWY + (size_t)u * 4096, qr, qc, l); }
            else if (pid == 2) {
                quad_mma(acc, SL(0), SL(6), qr, qc, l);
                const int n = 32 * qc + (l & 31), hf = l >> 5; const float gl = GL[n];
#pragma unroll
                for (int j = 0; j < 16; ++j) acc[j] += (ACC_M(qr, j, hf) == n) ? gl : 0.f;
                store_T_global<true>(acc, RWM + (size_t)u * 4096, qr, qc, l);
            } else { quad_mma(acc, SL(6), SL(2), qr, qc, l); quad_mma(acc, SL(7), SL(5), qr, qc, l); store_T_global<false>(acc, RWN + (size_t)u * 4096, qr, qc, l); }
        }
        B1T(6);
    }
#ifdef PROBE_B1SEC
    if (blockIdx.x == 0 && F.tid == 0) { F.MISC[20] = (unsigned)b1acc; }
#endif
#undef SL
}

__device__ __forceinline__ void rw_b2(Frame& F) {
    if (blockIdx.x >= 32) return;
    const bf16* RWM = WSP(bf16, WS_RWM); const bf16* RWN = WSP(bf16, WS_RWN);
    bf16* RWS = (bf16*)((char*)F.out + OUT_RWS);
    const int b = blockIdx.x >> 3, h = blockIdx.x & 7, w = F.wave, l = F.lane;
    LAS unsigned char* L = F.lds;
#define SS(buf, part) ((LAS bf16*)(L + ((buf) * 2 + (part)) * SLOT))
    const int q = w & 3, qr = q >> 1, qc = q & 1, r = l & 31, hf = l >> 5;
    if (w < 4) {
        const bf16* Nm = RWN + (size_t)(4096 + h) * 4096;
#pragma unroll
        for (int jj = 0; jj < 4; ++jj) {
            const v2u wv = *(const v2u*)(Nm + acc_off(32 * qc + r, 32 * qr + 8 * jj + 4 * hf));
            *(LAS v2u*)(SS(0, 0) + (32 * qc + r) * RP + 32 * qr + 8 * jj + 4 * hf) = wv;
            *(LAS v2u*)(SS(0, 1) + (32 * qc + r) * RP + 32 * qr + 8 * jj + 4 * hf) = (v2u){0u, 0u};
        }
    }
    __syncthreads();
    bf16x8 a_cur[4]; v2u n_cur[4];
    {
        const size_t u0 = (size_t)(b * 8 + h) * 128;
#pragma unroll
        for (int ks = 0; ks < 4; ++ks) a_cur[ks] = *(const bf16x8*)(RWM + u0 * 4096 + frag_off(32 * qr + r, 16 * ks + 8 * hf));
#pragma unroll
        for (int jj = 0; jj < 4; ++jj) n_cur[jj] = *(const v2u*)(RWN + u0 * 4096 + acc_off(32 * qc + r, 32 * qr + 8 * jj + 4 * hf));
    }
    for (int c = 0; c < 128; ++c) {
        const int u = (b * 8 + h) * 128 + c, cur = c & 1;
        if (w < 4) {
            bf16x8 a_nxt[4]; v2u n_nxt[4];
            const size_t un = (size_t)(c + 1 < 128 ? u + 1 : u);
#pragma unroll
            for (int ks = 0; ks < 4; ++ks) a_nxt[ks] = *(const bf16x8*)(RWM + un * 4096 + frag_off(32 * qr + r, 16 * ks + 8 * hf));
#pragma unroll
            for (int jj = 0; jj < 4; ++jj) n_nxt[jj] = *(const v2u*)(RWN + un * 4096 + acc_off(32 * qc + r, 32 * qr + 8 * jj + 4 * hf));
            f32x16 acc;
#pragma unroll
            for (int jj = 0; jj < 4; ++jj) { acc[4 * jj] = bflo(n_cur[jj].x); acc[4 * jj + 1] = bfhi(n_cur[jj].x); acc[4 * jj + 2] = bflo(n_cur[jj].y); acc[4 * jj + 3] = bfhi(n_cur[jj].y); }
#pragma unroll
            for (int jj = 0; jj < 4; ++jj)
                *(v2u*)(RWS + (size_t)u * 4096 + frag_off(32 * qc + r, 32 * qr + 8 * jj + 4 * hf)) = *(const LAS v2u*)(SS(cur, 0) + (32 * qc + r) * RP + 32 * qr + 8 * jj + 4 * hf);
            const LAS bf16* bh = SS(cur, 0) + (32 * qc + r) * RP + 8 * hf; const LAS bf16* bl = SS(cur, 1) + (32 * qc + r) * RP + 8 * hf;
#pragma unroll
            for (int ks = 0; ks < 4; ++ks) {
                acc = __builtin_amdgcn_mfma_f32_32x32x16_bf16(a_cur[ks], *(const LAS bf16x8*)(bh + 16 * ks), acc, 0, 0, 0);
                acc = __builtin_amdgcn_mfma_f32_32x32x16_bf16(a_cur[ks], *(const LAS bf16x8*)(bl + 16 * ks), acc, 0, 0, 0);
            }
#pragma unroll
            for (int jj = 0; jj < 4; ++jj) {
                float hi[4], lo[4];
#pragma unroll
                for (int e = 0; e < 4; ++e) { const unsigned hb = f2bf(acc[4 * jj + e]); hi[e] = __uint_as_float(hb << 16); lo[e] = acc[4 * jj + e] - hi[e]; }
                *(LAS v2u*)(SS(cur ^ 1, 0) + (32 * qc + r) * RP + 32 * qr + 8 * jj + 4 * hf) = (v2u){pk2(hi[0], hi[1]), pk2(hi[2], hi[3])};
                *(LAS v2u*)(SS(cur ^ 1, 1) + (32 * qc + r) * RP + 32 * qr + 8 * jj + 4 * hf) = (v2u){pk2(lo[0], lo[1]), pk2(lo[2], lo[3])};
            }
#pragma unroll
            for (int ks = 0; ks < 4; ++ks) a_cur[ks] = a_nxt[ks];
#pragma unroll
            for (int jj = 0; jj < 4; ++jj) n_cur[jj] = n_nxt[jj];
        }
        LDS_BARRIER();
    }
#undef SS
}

__device__ __forceinline__ void rw_b3(Frame& F, bool meta_only = false) {
    const bf16* P = WSP(bf16, WS_P); bf16* QA = WSP(bf16, WS_QA);
    const bf16* RWQ = WSP(bf16, WS_RWQ); const bf16* RWY = WSP(bf16, WS_RWY);
    const bf16* RWS = (const bf16*)((const char*)F.out + OUT_RWS); const float* BONUS = (const float*)((const char*)F.out + OUT_BONUS);
    const bf16* WgT = WSP(bf16, WS_WT_LORA) + 2 * 512 * 64;
    const float* mu = F.in[IN_MU];
    const int l = F.lane, r = l & 31, hf = l >> 5;
    const int gw = blockIdx.x * NWAVES + F.wave, NGW = F.G * NWAVES;
    for (int it = meta_only ? 8192 + F.wave : gw; it < (meta_only ? 8200 : 8192); it += meta_only ? NWAVES : NGW) {
        const int u = it < 8192 ? it >> 1 : 4096 + (it - 8192), th = it < 8192 ? (it & 1) : 0;
        const bool meta = u >= 4096;
        int b = 0, h, c = 0; if (meta) h = u - 4096; else { b = u >> 10; h = (u >> 7) & 7; c = u & 127; }
        const int t = 32 * th + r;
        const bool valid = !meta || t < NMETA;
        const int row0 = meta ? NREAL : b * SEQ + c * 64;
        const int row = valid ? row0 + t : row0;
        int prow = -1;
        if (t > 0) prow = row - 1; else if (!meta) prow = (c == 0) ? NREAL + NMETA - 1 : row - 1;
        LAS unsigned char* tg = F.lds + F.wave * 16384;
        LAS unsigned char* tv = tg + 9216;
        {
            const int rfirst = row0 + 32 * th;
            const int rprev0 = th ? rfirst - 1 : (meta ? -1 : ((c == 0) ? NREAL + NMETA - 1 : rfirst - 1));
            const int rmax = meta ? NREAL + NMETA - 1 : rfirst + 31;
            asm volatile("s_waitcnt lgkmcnt(0)" ::: "memory");
#pragma unroll
            for (int i = 0; i < 9; ++i) {
                const int tr = 4 * i + (l >> 4), ch16 = l & 15;
                if (tr <= 32) {
                    int gr_ = tr == 0 ? rprev0 : rfirst + tr - 1; const bool z = gr_ < 0; gr_ = z ? rfirst : (gr_ > rmax ? rmax : gr_);
                    v4u d = *(const v4u*)(P + (size_t)gr_ * PW + PC_GD + 8 * ch16); if (z) d = (v4u){0u, 0u, 0u, 0u};
                    *(LAS v4u*)(tg + tr * 272 + 16 * ch16) = d;
                }
            }
#pragma unroll
            for (int i = 0; i < 5; ++i) {
                const int tr = 8 * i + (l >> 3), ch8 = l & 7;
                if (tr <= 32) {
                    int gr_ = tr == 0 ? rprev0 : rfirst + tr - 1; const bool z = gr_ < 0; gr_ = z ? rfirst : (gr_ > rmax ? rmax : gr_);
                    v4u d = *(const v4u*)(P + (size_t)gr_ * PW + PC_V + h * 64 + 8 * ch8); if (z) d = (v4u){0u, 0u, 0u, 0u};
                    *(LAS v4u*)(tv + tr * 144 + 16 * ch8) = d;
                }
            }
            asm volatile("s_waitcnt lgkmcnt(0)" ::: "memory");
        }
        f32x16 y[2];
#pragma unroll
        for (int qv = 0; qv < 2; ++qv) {
            const bf16* Y0 = RWY + (size_t)u * 4096;
#pragma unroll
            for (int jj = 0; jj < 4; ++jj) { const v2u wv = *(const v2u*)(Y0 + acc_off(32 * th + r, 32 * qv + 8 * jj + 4 * hf)); y[qv][4 * jj] = bflo(wv.x); y[qv][4 * jj + 1] = bfhi(wv.x); y[qv][4 * jj + 2] = bflo(wv.y); y[qv][4 * jj + 3] = bfhi(wv.y); }
        }
        if (!meta) {
            const bf16* qp = RWQ + (size_t)u * 4096; const bf16* sp = RWS + (size_t)u * 4096;
#pragma unroll
            for (int ks = 0; ks < 4; ++ks) {
                const bf16x8 bq = *(const bf16x8*)(qp + frag_off(32 * th + r, 16 * ks + 8 * hf));
                y[0] = __builtin_amdgcn_mfma_f32_32x32x16_bf16(*(const bf16x8*)(sp + frag_off(r, 16 * ks + 8 * hf)), bq, y[0], 0, 0, 0);
                y[1] = __builtin_amdgcn_mfma_f32_32x32x16_bf16(*(const bf16x8*)(sp + frag_off(32 + r, 16 * ks + 8 * hf)), bq, y[1], 0, 0, 0);
            }
        }
        f32x16 g[2]; g[0] = zero16(); g[1] = zero16();
        {
            const LAS unsigned char* gpl = tg + (r + 1) * 272 + 16 * hf; const LAS unsigned char* gppl = tg + r * 272 + 16 * hf;
            const bf16* wp = WgT + (size_t)(h * 64 + r) * 128 + 8 * hf;
#pragma unroll
            for (int ks = 0; ks < 8; ++ks) {
                const v4u cg = *(const LAS v4u*)(gpl + 32 * ks); const v4u pg = *(const LAS v4u*)(gppl + 32 * ks);
                const f32x4 m0 = *(const f32x4*)(mu + 1664 + 16 * ks + 8 * hf), m1 = *(const f32x4*)(mu + 1664 + 16 * ks + 8 * hf + 4);
                const unsigned cw[4] = {cg.x, cg.y, cg.z, cg.w}, pw[4] = {pg.x, pg.y, pg.z, pg.w}; const float mm[8] = {m0.x, m0.y, m0.z, m0.w, m1.x, m1.y, m1.z, m1.w};
                unsigned o[4];
#pragma unroll
                for (int e = 0; e < 4; ++e) {
                    const float c0 = bflo(cw[e]), c1 = bfhi(cw[e]), p0 = bflo(pw[e]), p1 = bfhi(pw[e]);
                    o[e] = pk2(sigmoidf_(c0 + (p0 - c0) * mm[2 * e]), sigmoidf_(c1 + (p1 - c1) * mm[2 * e + 1]));
                }
                const v4u ov = (v4u){o[0], o[1], o[2], o[3]};
                const bf16x8 bs = __builtin_bit_cast(bf16x8, ov);
                g[0] = __builtin_amdgcn_mfma_f32_32x32x16_bf16(*(const bf16x8*)(wp + 16 * ks), bs, g[0], 0, 0, 0);
                g[1] = __builtin_amdgcn_mfma_f32_32x32x16_bf16(*(const bf16x8*)(wp + 32 * 128 + 16 * ks), bs, g[1], 0, 0, 0);
            }
        }
        float s = 0.f;
#pragma unroll
        for (int j = 0; j < 16; ++j) s += y[0][j] + y[1][j];
        s += __shfl_xor(s, 32);
        const float mean = s * (1.f / 64.f);
        float s2 = 0.f;
#pragma unroll
        for (int j = 0; j < 16; ++j) { const float d0 = y[0][j] - mean, d1 = y[1][j] - mean; s2 += d0 * d0 + d1 * d1; }
        s2 += __shfl_xor(s2, 32);
        const float rstd = 1.0f / sqrtf(s2 * (1.f / 64.f) + GN_EPS);
        const float bon = BONUS[(size_t)u * 64 + t];
        if (valid) {
#pragma unroll
            for (int qv = 0; qv < 2; ++qv)
#pragma unroll
                for (int jj = 0; jj < 4; ++jj) {
                    const int v0 = 32 * qv + 8 * jj + 4 * hf, chv = h * 64 + v0;
                    const v2u cvw = *(const LAS v2u*)(tv + (r + 1) * 144 + 2 * v0); const v2u pvw = *(const LAS v2u*)(tv + r * 144 + 2 * v0);
                    const f32x4 mv = *(const f32x4*)(mu + 1024 + chv), gg = *(const f32x4*)(F.in[IN_GN_G] + chv), gb = *(const f32x4*)(F.in[IN_GN_B] + chv);
                    const float cv[4] = {bflo(cvw.x), bfhi(cvw.x), bflo(cvw.y), bfhi(cvw.y)}, pv[4] = {bflo(pvw.x), bfhi(pvw.x), bflo(pvw.y), bfhi(pvw.y)};
                    const float mvv[4] = {mv.x, mv.y, mv.z, mv.w}, ggv[4] = {gg.x, gg.y, gg.z, gg.w}, gbv[4] = {gb.x, gb.y, gb.z, gb.w};
                    float o[4];
#pragma unroll
                    for (int e = 0; e < 4; ++e) {
                        const float vs = cv[e] + (pv[e] - cv[e]) * mvv[e];
                        o[e] = ((y[qv][4 * jj + e] - mean) * rstd * ggv[e] + gbv[e] + bon * vs) * g[qv][4 * jj + e];
                    }
                    *(v2u*)(QA + (size_t)row * QAW + 1024 + chv) = (v2u){pk2(o[0], o[1]), pk2(o[2], o[3])};
                }
        }
    }
}

constexpr int IX_CAP = 512, IX_LIST = 3072, IX_KB = 98304, IX_SCR = RING_BYTES + 4096;
#define IX_FENCE() asm volatile("s_waitcnt lgkmcnt(0)" ::: "memory")
#define IX_ORDER() asm volatile("" ::: "memory")

typedef _Float16 half8 __attribute__((ext_vector_type(8)));
typedef short short2_t __attribute__((ext_vector_type(2)));
typedef unsigned u32x4_t __attribute__((ext_vector_type(4)));
__device__ __forceinline__ unsigned relu_pk_f16(float a, float b) {
    short2_t s = __builtin_bit_cast(short2_t, __builtin_amdgcn_cvt_pkrtz(a, b));
    s = __builtin_elementwise_max(s, (short2_t){0, 0});
    return __builtin_bit_cast(unsigned, s);
}
__device__ __forceinline__ unsigned ix_mbcnt(unsigned long long m) { return __builtin_amdgcn_mbcnt_hi((unsigned)(m >> 32), __builtin_amdgcn_mbcnt_lo((unsigned)m, 0u)); }

__device__ __forceinline__ void ix_select_slow(const float (&sc)[8], const unsigned (&ix)[8], bool (&vl)[8], int K, unsigned short* sel_out, int lane) {
    for (int it = 0; it < K; ++it) {
        unsigned long long best = 0ull;
#pragma unroll
        for (int i = 0; i < 8; ++i) { const unsigned long long key = ((unsigned long long)sortable(sc[i]) << 32) | (unsigned long long)(0xFFFFu - ix[i]) | 0x10000ull; if (vl[i] && key > best) best = key; }
        unsigned long long wm = best;
#pragma unroll
        for (int o = 1; o < 64; o <<= 1) { const unsigned long long v = __shfl_xor(wm, o); wm = v > wm ? v : wm; }
        if (wm == 0ull) break;
        const bool mine = best == wm;
#pragma unroll
        for (int i = 0; i < 8; ++i) { const unsigned long long key = ((unsigned long long)sortable(sc[i]) << 32) | (unsigned long long)(0xFFFFu - ix[i]) | 0x10000ull; if (mine && vl[i] && key == wm) { vl[i] = false; sel_out[it] = (unsigned short)ix[i]; } }
    }
}

__device__ __forceinline__ void ix_compact(LAS float* LS, LAS unsigned short* LI, LAS unsigned* hist, int& cnt, float& tau, int lane, bool final_sel, unsigned short* sel_out) {
    const int n = cnt;
    float sc[8]; unsigned ix[8]; bool vl[8];
    IX_FENCE();
#pragma unroll
    for (int i = 0; i < 8; ++i) { const int p = lane + 64 * i; vl[i] = p < n; sc[i] = vl[i] ? LS[p] : -INFINITY; ix[i] = vl[i] ? (unsigned)LI[p] : 0u; }
    float mx = -INFINITY, mn = INFINITY;
#pragma unroll
    for (int i = 0; i < 8; ++i) { if (vl[i]) { mx = fmaxf(mx, sc[i]); mn = fminf(mn, sc[i]); } }
    mx = wave_max(mx); mn = -wave_max(-mn);
    const float scale = mx > mn ? 255.99f / (mx - mn) : 0.f;
    int bin[8];
#pragma unroll
    for (int i = 0; i < 8; ++i) { int bq = (int)((sc[i] - mn) * scale); bq = bq > 255 ? 255 : (bq < 0 ? 0 : bq); bin[i] = vl[i] ? bq : -1; }
    *(LAS v4u*)(hist + 4 * lane) = (v4u){0u, 0u, 0u, 0u};
    IX_FENCE();
#pragma unroll
    for (int i = 0; i < 8; ++i) if (vl[i]) __hip_atomic_fetch_add((LAS unsigned*)&hist[bin[i]], 1u, __ATOMIC_RELAXED, __HIP_MEMORY_SCOPE_WAVEFRONT);
    IX_FENCE();
    const v4u c = *(const LAS v4u*)(hist + 4 * lane);
    const unsigned Pp = wave_scan_incl(c.x + c.y + c.z + c.w, lane);
    const unsigned total = (unsigned)__builtin_amdgcn_readlane((int)Pp, 63);
    const unsigned K = TOPK;
    const unsigned a3 = total - Pp, a2 = a3 + c.w, a1 = a2 + c.z, a0 = a1 + c.y;
    int myb = -1; unsigned myA = 0u, myC = 0u;
    if (a3 < K && K <= a3 + c.w) { myb = 4 * lane + 3; myA = a3; myC = c.w; }
    else if (a2 < K && K <= a2 + c.z) { myb = 4 * lane + 2; myA = a2; myC = c.z; }
    else if (a1 < K && K <= a1 + c.y) { myb = 4 * lane + 1; myA = a1; myC = c.y; }
    else if (a0 < K && K <= a0 + c.x) { myb = 4 * lane; myA = a0; myC = c.x; }
    const unsigned long long bm = __ballot(myb >= 0);
    const int src = bm ? (__ffsll((long long)bm) - 1) : 0;
    const int srcu = __builtin_amdgcn_readfirstlane(src);
    const int bstar = __builtin_amdgcn_readlane(myb, srcu); const unsigned A = (unsigned)__builtin_amdgcn_readlane((int)myA, srcu), m = (unsigned)__builtin_amdgcn_readlane((int)myC, srcu);
    if (!final_sel) {
        if (A + m <= (unsigned)(IX_CAP - 128)) {
            int base = 0; float kmin = INFINITY;
#pragma unroll
            for (int i = 0; i < 8; ++i) {
                const bool keep = vl[i] && bin[i] >= bstar;
                const unsigned long long mk = __ballot(keep);
                const int pos = base + (int)ix_mbcnt(mk);
                if (keep) { LS[pos] = sc[i]; LI[pos] = (unsigned short)ix[i]; kmin = fminf(kmin, sc[i]); }
                base += __popcll(mk);
            }
            cnt = base; tau = -wave_max(-kmin);
            IX_FENCE();
            return;
        }
        unsigned short* tmp = sel_out;
        ix_select_slow(sc, ix, vl, (int)K, tmp, lane);
        int base = 0; float kmin = INFINITY;
#pragma unroll
        for (int i = 0; i < 8; ++i) {
            const bool keep = !vl[i] && (lane + 64 * i) < n;
            const unsigned long long mk = __ballot(keep);
            const int pos = base + (int)ix_mbcnt(mk);
            if (keep) { LS[pos] = sc[i]; LI[pos] = (unsigned short)ix[i]; kmin = fminf(kmin, sc[i]); }
            base += __popcll(mk);
        }
        cnt = base; tau = -wave_max(-kmin);
        IX_FENCE();
        return;
    }
    if (m <= 128u) {
        int base = 0;
#pragma unroll
        for (int i = 0; i < 8; ++i) {
            const bool keep = vl[i] && bin[i] > bstar;
            const unsigned long long mk = __ballot(keep);
            const int pos = base + (int)ix_mbcnt(mk);
            if (keep) sel_out[pos] = (unsigned short)ix[i];
            base += __popcll(mk);
        }
        LAS float* sS = (LAS float*)hist; LAS unsigned* sI = hist + 128;
        IX_FENCE();
        int mb = 0;
#pragma unroll
        for (int i = 0; i < 8; ++i) {
            const bool inb = vl[i] && bin[i] == bstar;
            const unsigned long long mk = __ballot(inb);
            const int pos = mb + (int)ix_mbcnt(mk);
            if (inb) { sS[pos] = sc[i]; sI[pos] = ix[i]; }
            mb += __popcll(mk);
        }
        IX_FENCE();
        const int need = (int)(K - A);
#pragma unroll
        for (int e = 0; e < 2; ++e) {
            const int j = lane + 64 * e;
            if (j < (int)m) {
                const float sj = sS[j]; const unsigned ij = sI[j]; int rank = 0;
                for (int k = 0; k < (int)m; ++k) { const float sk = sS[k]; const unsigned ik = sI[k]; rank += (sk > sj || (sk == sj && ik < ij)) ? 1 : 0; }
                if (rank < need) sel_out[(int)A + rank] = (unsigned short)ij;
            }
        }
    } else {
        ix_select_slow(sc, ix, vl, (int)K, sel_out, lane);
    }
}

__device__ __forceinline__ void p6_attn_mfma(Frame& F, bf16* OUTB, bool meta_only);
__device__ __forceinline__ void p5_index_mfma(Frame& F, unsigned short* SEL, int* NSEL, int qword = 3072, bool probe_noappend = false, bool do_meta = false) {
    const bf16* QA = WSP(bf16, WS_QA); const bf16* KIDX = WSP(bf16, WS_KIDX); const float* WIDX = WSP(float, WS_WIDX);
    const int tid = F.tid, w = F.wave, l = F.lane, r = l & 31, hf = l >> 5;
    {
        const int gw = blockIdx.x * NWAVES + w, NGW = F.G * NWAVES;
        for (int i = gw; i < NMETA + BATCH * 192; i += NGW) {
            int q, nvis; if (i < NMETA) { q = NREAL + i; nvis = NMETA; } else { const int bb = (i - NMETA) / 192, s = (i - NMETA) % 192; q = bb * SEQ + s; nvis = NMETA + 64 * (s / 64 + 1); }
            for (int j = l; j < nvis; j += 64) SEL[(size_t)q * TOPK + j] = (unsigned short)j;
            if (l == 0) NSEL[q] = nvis;
        }
    }
    LAS unsigned char* L = F.lds;
    LAS unsigned* hist = (LAS unsigned*)(L + IX_SCR + w * 1024);
    if (do_meta) {
        __syncthreads();
        if (tid == 0) F.MISC[17] = __hip_atomic_fetch_add((unsigned*)F.ctl + 3200, 1u, __ATOMIC_RELAXED, __HIP_MEMORY_SCOPE_AGENT);
        __syncthreads();
        const int mt = (int)F.MISC[17];
        if (mt == 0) {
            if (tid < NMETA) { for (int j = 0; j < NMETA; ++j) SEL[(size_t)(NREAL + tid) * TOPK + j] = (unsigned short)j; NSEL[NREAL + tid] = NMETA; }
            asm volatile("s_waitcnt vmcnt(0)" ::: "memory"); __syncthreads();
            p6_attn_mfma(F, WSP(bf16, WS_QA), true);
        } else if (mt == 1) { rw_b3(F, true); }
        __syncthreads();
    }
    {
        for (;;) {
            __syncthreads();
            if (tid == 0) F.MISC[16] = __hip_atomic_fetch_add((unsigned*)F.ctl + qword, 1u, __ATOMIC_RELAXED, __HIP_MEMORY_SCOPE_AGENT);
            __syncthreads();
            const int qi_ = (int)F.MISC[16];
            if (qi_ >= 1000) break;
            const int tile = 999 - qi_;
            const int pt = 6 + (tile >> 2), b = tile & 3;
            const int q0 = b * SEQ + pt * 32;
            const int nvis = NMETA + 64 * (pt / 2 + 1);
            __syncthreads();
            bf16x8 af[4];
            {
                const int qq = 2 * (r >> 4) + ((r >> 2) & 1), hd = 4 * ((r >> 3) & 1) + (r & 3);
                const bf16* qp = QA + (size_t)(q0 + 4 * w + qq) * QAW + 1024 + hd * 64 + 8 * hf;
#pragma unroll
                for (int ks = 0; ks < 4; ++ks) af[ks] = *(const bf16x8*)(qp + 16 * ks);
            }
            half8 wf[2];
#pragma unroll
            for (int s2 = 0; s2 < 2; ++s2) {
                const bool on = r == 4 * hf + s2;
                const float* wp_ = WIDX + (size_t)(q0 + 4 * w + 2 * s2 + hf) * 8;
                const f32x4 w0 = *(const f32x4*)wp_, w1 = *(const f32x4*)(wp_ + 4);
                half8 t; t[0] = (_Float16)w0.x; t[1] = (_Float16)w0.y; t[2] = (_Float16)w0.z; t[3] = (_Float16)w0.w; t[4] = (_Float16)w1.x; t[5] = (_Float16)w1.y; t[6] = (_Float16)w1.z; t[7] = (_Float16)w1.w;
#pragma unroll
                for (int j = 0; j < 8; ++j) wf[s2][j] = on ? t[j] : (_Float16)0.0f;
            }
            float tau0 = -INFINITY, tau1 = -INFINITY;
            int cnt[4] = {0, 0, 0, 0};
            const int nblk = (nvis + 255) >> 8;
            v4u kreg[4];
#pragma unroll
            for (int e = 0; e < 4; ++e) {
                const int pid = tid + 512 * e, kl = pid >> 3, pc = pid & 7, j = kl;
                kreg[e] = j < nvis ? *(const v4u*)(KIDX + (size_t)key_row(b, j) * 64 + 8 * pc) : (v4u){0u, 0u, 0u, 0u};
            }
#pragma unroll
            for (int e = 0; e < 4; ++e) { const int pid = tid + 512 * e, kl = pid >> 3, pc = pid & 7; *(LAS v4u*)(L + IX_KB + kl * 128 + ((pc ^ ((kl >> 1) & 7)) << 4)) = kreg[e]; }
            __syncthreads();
            const LAS unsigned char* kb = L + IX_KB;
            for (int blk = 0; blk < nblk; ++blk) {
                if (blk + 1 < nblk) {
#pragma unroll
                    for (int e = 0; e < 4; ++e) {
                        const int pid = tid + 512 * e, kl = pid >> 3, pc = pid & 7, j = (blk + 1) * 256 + kl;
                        kreg[e] = j < nvis ? *(const v4u*)(KIDX + (size_t)key_row(b, j) * 64 + 8 * pc) : (v4u){0u, 0u, 0u, 0u};
                    }
                }
                int npair = (nvis - blk * 256 + 63) >> 6; npair = npair > 4 ? 4 : npair;
                bf16x8 bc0[4], bc1[4];
#pragma unroll
                for (int ks = 0; ks < 4; ++ks) { const int k0 = r, k1 = 32 + r;
                    bc0[ks] = *(const LAS bf16x8*)(kb + k0 * 128 + (((2 * ks + hf) ^ ((k0 >> 1) & 7)) << 4));
                    bc1[ks] = *(const LAS bf16x8*)(kb + k1 * 128 + (((2 * ks + hf) ^ ((k1 >> 1) & 7)) << 4)); }
                for (int pp = 0; pp < npair; ++pp) {
                    const int jbase = blk * 256 + pp * 64;
                    bf16x8 bn0[4], bn1[4];
                    {
                        const int pn = pp + 1 < npair ? pp + 1 : pp; const int k0 = pn * 64 + r, k1 = k0 + 32;
#pragma unroll
                        for (int ks = 0; ks < 4; ++ks) {
                            bn0[ks] = *(const LAS bf16x8*)(kb + k0 * 128 + (((2 * ks + hf) ^ ((k0 >> 1) & 7)) << 4));
                            bn1[ks] = *(const LAS bf16x8*)(kb + k1 * 128 + (((2 * ks + hf) ^ ((k1 >> 1) & 7)) << 4)); }
                    }
                    f32x16 accA = zero16(), accB = zero16();
#pragma unroll
                    for (int ks = 0; ks < 4; ++ks) { accA = __builtin_amdgcn_mfma_f32_32x32x16_bf16(af[ks], bc0[ks], accA, 0, 0, 0); accB = __builtin_amdgcn_mfma_f32_32x32x16_bf16(af[ks], bc1[ks], accB, 0, 0, 0); }
#pragma unroll
                    for (int ks = 0; ks < 4; ++ks) { bc0[ks] = bn0[ks]; bc1[ks] = bn1[ks]; }
                    f32x16 yA = zero16(), yB = zero16();
#pragma unroll
                    for (int s2 = 0; s2 < 2; ++s2) {
                        u32x4_t ua, ub;
#pragma unroll
                        for (int pq = 0; pq < 4; ++pq) { ua[pq] = relu_pk_f16(accA[8 * s2 + 2 * pq], accA[8 * s2 + 2 * pq + 1]); ub[pq] = relu_pk_f16(accB[8 * s2 + 2 * pq], accB[8 * s2 + 2 * pq + 1]); }
                        yA = __builtin_amdgcn_mfma_f32_32x32x16_f16(wf[s2], __builtin_bit_cast(half8, ua), yA, 0, 0, 0);
                        yB = __builtin_amdgcn_mfma_f32_32x32x16_f16(wf[s2], __builtin_bit_cast(half8, ub), yB, 0, 0, 0);
                    }
                    const float s0A = yA[0] + 0.0f, s1A = yA[1] + 0.0f, s0B = yB[0] + 0.0f, s1B = yB[1] + 0.0f;
                    const int jA = jbase + r, jB = jA + 32;
                    const bool p0A = jA < nvis && s0A > tau0, p1A = jA < nvis && s1A > tau1, p0B = jB < nvis && s0B > tau0, p1B = jB < nvis && s1B > tau1;
                    const unsigned long long m0A = __ballot(p0A), m1A = __ballot(p1A), m0B = __ballot(p0B), m1B = __ballot(p1B);
                    if (m0A | m1A | m0B | m1B) {
                        const int a0lo = __popc((unsigned)m0A), a0hi = __popc((unsigned)(m0A >> 32)), a1lo = __popc((unsigned)m1A), a1hi = __popc((unsigned)(m1A >> 32));
                        const int b0lo = __popc((unsigned)m0B), b0hi = __popc((unsigned)(m0B >> 32)), b1lo = __popc((unsigned)m1B), b1hi = __popc((unsigned)(m1B >> 32));
                        {
                            LAS unsigned char* lb = L + (w * 4 + hf) * IX_LIST;
                            const int base = hf ? cnt[1] : cnt[0];
                            const int posA = base + (int)ix_mbcnt(m0A) - (hf ? a0lo : 0);
                            const int posB = base + (hf ? a0hi : a0lo) + (int)ix_mbcnt(m0B) - (hf ? b0lo : 0);
                            if (p0A) { ((LAS float*)lb)[posA] = s0A; ((LAS unsigned short*)(lb + 2048))[posA] = (unsigned short)jA; }
                            if (p0B) { ((LAS float*)lb)[posB] = s0B; ((LAS unsigned short*)(lb + 2048))[posB] = (unsigned short)jB; }
                        }
                        {
                            LAS unsigned char* lb = L + (w * 4 + 2 + hf) * IX_LIST;
                            const int base = hf ? cnt[3] : cnt[2];
                            const int posA = base + (int)ix_mbcnt(m1A) - (hf ? a1lo : 0);
                            const int posB = base + (hf ? a1hi : a1lo) + (int)ix_mbcnt(m1B) - (hf ? b1lo : 0);
                            if (p1A) { ((LAS float*)lb)[posA] = s1A; ((LAS unsigned short*)(lb + 2048))[posA] = (unsigned short)jA; }
                            if (p1B) { ((LAS float*)lb)[posB] = s1B; ((LAS unsigned short*)(lb + 2048))[posB] = (unsigned short)jB; }
                        }
                        cnt[0] += a0lo + b0lo; cnt[1] += a0hi + b0hi; cnt[2] += a1lo + b1lo; cnt[3] += a1hi + b1hi;
                        if (probe_noappend) { if (cnt[0] >= 256 && hf == 0) tau0 = INFINITY; if (cnt[1] >= 256 && hf == 1) tau0 = INFINITY; if (cnt[2] >= 256 && hf == 0) tau1 = INFINITY; if (cnt[3] >= 256 && hf == 1) tau1 = INFINITY; }
#pragma unroll
                        for (int qq = 0; qq < 4; ++qq) {
                            if (cnt[qq] > IX_CAP - 64) {
                                LAS unsigned char* lb = L + (w * 4 + qq) * IX_LIST;
                                float tq = 0.f; int cq = cnt[qq];
                                ix_compact((LAS float*)lb, (LAS unsigned short*)(lb + 2048), hist, cq, tq, l, false, SEL + (size_t)(q0 + 4 * w + qq) * TOPK);
                                cnt[qq] = __builtin_amdgcn_readfirstlane(cq);
                                if ((qq & 1) == hf) { if (qq < 2) tau0 = tq; else tau1 = tq; }
                            }
                        }
                    }
                }
                __syncthreads();
                if (blk + 1 < nblk) {
#pragma unroll
                    for (int e = 0; e < 4; ++e) { const int pid = tid + 512 * e, kl = pid >> 3, pc = pid & 7; *(LAS v4u*)(L + IX_KB + kl * 128 + ((pc ^ ((kl >> 1) & 7)) << 4)) = kreg[e]; }
                    __syncthreads();
                }
            }
#pragma unroll
            for (int qq = 0; qq < 4; ++qq) {
                LAS unsigned char* lb = L + (w * 4 + qq) * IX_LIST;
                float tq = 0.f; int cq = cnt[qq];
                ix_compact((LAS float*)lb, (LAS unsigned short*)(lb + 2048), hist, cq, tq, l, true, SEL + (size_t)(q0 + 4 * w + qq) * TOPK);
                if (l == 0) NSEL[q0 + 4 * w + qq] = TOPK;
            }
        }
    }
}

#ifndef CHECK_IDX
#define CHECK_IDX 0
#endif
#if CHECK_IDX
__device__ __forceinline__ void idx_check(Frame& F) {
    const unsigned short* SEL = WSP(unsigned short, WS_SEL); const unsigned short* SELB = (const unsigned short*)F.out; const int* NSEL = WSP(int, WS_NSEL); const int* NSELB = (const int*)((const char*)F.out + 32 * MiB);
    LAS unsigned* bm = (LAS unsigned*)(F.lds + F.wave * 2048);
    const int l = F.lane; const int gw = blockIdx.x * NWAVES + F.wave, NGW = F.G * NWAVES;
    unsigned miss = 0, badq = 0, dup = 0;
    for (int q = gw; q < NROWS; q += NGW) {
        for (int i = l; i < 260; i += 64) bm[i] = 0u;
        IX_FENCE();
        const int n = NSEL[q], nb = NSELB[q];
        for (int i = l; i < n; i += 64) { const unsigned j = SEL[(size_t)q * TOPK + i]; atomicOr((unsigned*)&bm[j >> 5], 1u << (j & 31)); }
        IX_FENCE();
        unsigned m = (n != nb) ? 1000u : 0u;
        for (int i = l; i < nb && i < TOPK; i += 64) { const unsigned j = SELB[(size_t)q * TOPK + i]; if (j >= (unsigned)TT) { ++dup; ++m; } else { const unsigned old = atomicAnd((unsigned*)&bm[j >> 5], ~(1u << (j & 31))); if (!((old >> (j & 31)) & 1u)) ++m; } }
        IX_FENCE();
        m = (unsigned)wave_sum((float)m);
        if (l == 0) { miss += m; badq += m ? 1u : 0u; }
    }
    dup = (unsigned)wave_sum((float)dup);
    if (l == 0) { atomicAdd((unsigned*)F.ctl + 2048, miss); atomicAdd((unsigned*)F.ctl + 2049, badq); atomicAdd((unsigned*)F.ctl + 2050, dup); }
}
#endif

typedef short v4i16_t __attribute__((ext_vector_type(4)));
__device__ __forceinline__ unsigned at_off(unsigned row, unsigned ch) { return 256u * row + 16u * (ch ^ (((row & 3u) << 2) | ((row >> 2) & 3u))); }

__device__ __forceinline__ float x4_max(float x) {
    auto s = __builtin_amdgcn_permlane16_swap(__float_as_uint(x), __float_as_uint(x), false, false); x = fmaxf(__uint_as_float(s[0]), __uint_as_float(s[1]));
    auto t = __builtin_amdgcn_permlane32_swap(__float_as_uint(x), __float_as_uint(x), false, false); return fmaxf(__uint_as_float(t[0]), __uint_as_float(t[1]));
}
__device__ __forceinline__ float x4_sum(float x) {
    auto s = __builtin_amdgcn_permlane16_swap(__float_as_uint(x), __float_as_uint(x), false, false); x = __uint_as_float(s[0]) + __uint_as_float(s[1]);
    auto t = __builtin_amdgcn_permlane32_swap(__float_as_uint(x), __float_as_uint(x), false, false); return __uint_as_float(t[0]) + __uint_as_float(t[1]);
}
__device__ __forceinline__ void p6_attn_mfma(Frame& F, bf16* OUTB, bool meta_only = false) {
    bf16* QA = WSP(bf16, WS_QA); const bf16* CKV = WSP(bf16, WS_CKV); const unsigned short* SEL = WSP(unsigned short, WS_SEL); const int* NSEL = WSP(int, WS_NSEL);
    const int l = F.lane, w = F.wave, h16 = l & 15, g = l >> 4;
    LAS unsigned char* tile = F.lds + w * 8192;
    LAS unsigned short* selb = (LAS unsigned short*)(F.lds + 65536 + w * 512);
    const float slope = h16 < 8 ? __uint_as_float((unsigned)(127 - (h16 + 1)) << 23) : 0.f;
    if (!meta_only) {
        const int gw = blockIdx.x * NWAVES + w, NGW = F.G * NWAVES;
        for (int q = NROWS + gw; q < R; q += NGW) { bf16* qrow = QA + (size_t)q * QAW; for (int c = l; c < QAW / 8; c += 64) *(v4u*)(qrow + 8 * c) = (v4u){0u, 0u, 0u, 0u}; }
    }
    if (meta_only) { }
    const int G = F.G;
    int nq_tot, qbase_b, wib, wpb;
    if ((G & 7) == 0) { const int b = (blockIdx.x & 7) >> 1; qbase_b = b * SEQ; nq_tot = SEQ; wib = (((blockIdx.x >> 3) * 2) + (blockIdx.x & 1)) * NWAVES + w; wpb = (G / 4) * NWAVES; }
    else { qbase_b = 0; nq_tot = NREAL; wib = blockIdx.x * NWAVES + w; wpb = G * NWAVES; }
    if (meta_only) { qbase_b = NREAL; nq_tot = NMETA; wib = w; wpb = NWAVES; }
    for (int qi = wib; qi < nq_tot; qi += wpb) {
        int q, b, pos;
        if (meta_only) { q = NREAL + qi; b = 0; pos = qi; }
        else if ((G & 7) == 0) { q = qbase_b + qi; b = q >> 13; pos = NMETA + qi; }
        else { q = qi; b = q >> 13; pos = NMETA + (q & (SEQ - 1)); }
        bf16* qrow = QA + (size_t)q * QAW;
        const int nsel = NSEL[q];
        const int nch = (nsel + 31) >> 5;
        const unsigned short* selq = SEL + (size_t)q * TOPK;
        IX_FENCE();
        if (l < 32) *(LAS v4u*)(selb + 8 * l) = *(const v4u*)(selq + 8 * l);
        IX_FENCE();
        bf16x8 qf[4];
#pragma unroll
        for (int s = 0; s < 4; ++s) { const v4u t = h16 < 8 ? *(const v4u*)(qrow + h16 * 128 + 32 * s + 8 * g) : (v4u){0u, 0u, 0u, 0u}; qf[s] = __builtin_bit_cast(bf16x8, t); }
        float m = -INFINITY, lsum = 0.f;
        f32x4 O[8];
#pragma unroll
        for (int c = 0; c < 8; ++c) O[c] = (f32x4){0.f, 0.f, 0.f, 0.f};
        v4u gr[8];
#pragma unroll
        for (int i = 0; i < 8; ++i) { const int s = g + 4 * i; const int kj = s < nsel ? (int)selb[s] : (int)selb[0]; gr[i] = *(const v4u*)(CKV + (size_t)key_row(b, kj) * 128 + 8 * h16); }
        for (int ck = 0; ck < nch; ++ck) {
            IX_FENCE();
#pragma unroll
            for (int i = 0; i < 8; ++i) *(LAS v4u*)(tile + at_off((unsigned)(g + 4 * i), (unsigned)h16)) = gr[i];
            const v4u kv = *(const LAS v4u*)(selb + 32 * ck + 8 * g);
            if (ck + 1 < nch) {
#pragma unroll
                for (int i = 0; i < 8; ++i) { const int s = 32 * (ck + 1) + g + 4 * i; const int kj = s < nsel ? (int)selb[s] : (int)selb[0]; gr[i] = *(const v4u*)(CKV + (size_t)key_row(b, kj) * 128 + 8 * h16); }
            }
            IX_FENCE();
            f32x4 a0 = (f32x4){0.f, 0.f, 0.f, 0.f}, a1 = a0;
#pragma unroll
            for (int s = 0; s < 4; ++s) {
                const bf16x8 k0 = *(const LAS bf16x8*)(tile + at_off((unsigned)(8 * (h16 >> 2) + (h16 & 3)), (unsigned)(4 * s + g)));
                const bf16x8 k1 = *(const LAS bf16x8*)(tile + at_off((unsigned)(8 * (h16 >> 2) + 4 + (h16 & 3)), (unsigned)(4 * s + g)));
                a0 = __builtin_amdgcn_mfma_f32_16x16x32_bf16(k0, qf[s], a0, 0, 0, 0);
                a1 = __builtin_amdgcn_mfma_f32_16x16x32_bf16(k1, qf[s], a1, 0, 0, 0);
            }
            const unsigned kw[4] = {kv.x, kv.y, kv.z, kv.w};
            float x[8];
#pragma unroll
            for (int j = 0; j < 8; ++j) {
                const int kj = (int)((kw[j >> 1] >> (16 * (j & 1))) & 0xffffu);
                const float lg = (j < 4 ? a0[j & 3] : a1[j & 3]) - slope * fabsf((float)(pos - kj));
                x[j] = (32 * ck + 8 * g + j) < nsel ? lg : -INFINITY;
            }
            float cm = fmaxf(fmaxf(fmaxf(x[0], x[1]), fmaxf(x[2], x[3])), fmaxf(fmaxf(x[4], x[5]), fmaxf(x[6], x[7])));
            cm = x4_max(cm);
            const float mn = fmaxf(m, cm);
            const float alpha = __expf(m - mn);
            float p[8], ps = 0.f;
#pragma unroll
            for (int j = 0; j < 8; ++j) { p[j] = __expf(x[j] - mn); ps += p[j]; }
            ps = x4_sum(ps);
            lsum = lsum * alpha + ps; m = mn;
            if (__any(alpha != 1.0f)) {
#pragma unroll
                for (int rr = 0; rr < 4; ++rr) { const float sc = __shfl(alpha, 4 * g + rr);
#pragma unroll
                    for (int c = 0; c < 8; ++c) O[c][rr] *= sc; }
            }
            const v4u pw = (v4u){pk2(p[0], p[1]), pk2(p[2], p[3]), pk2(p[4], p[5]), pk2(p[6], p[7])};
            const bf16x8 pf = __builtin_bit_cast(bf16x8, pw);
#pragma unroll
            for (int c = 0; c < 8; ++c) {
                const unsigned qd = (unsigned)(h16 >> 2), pp = (unsigned)(h16 & 3);
                const v4i16_t t0 = __builtin_amdgcn_ds_read_tr16_b64_v4i16((LAS v4i16_t*)(tile + at_off(8u * g + qd, 2u * c + (pp >> 1)) + 8u * (pp & 1u)));
                const v4i16_t t1 = __builtin_amdgcn_ds_read_tr16_b64_v4i16((LAS v4i16_t*)(tile + at_off(8u * g + 4u + qd, 2u * c + (pp >> 1)) + 8u * (pp & 1u)));
                bf16x8 vf; vf[0] = t0[0]; vf[1] = t0[1]; vf[2] = t0[2]; vf[3] = t0[3]; vf[4] = t1[0]; vf[5] = t1[1]; vf[6] = t1[2]; vf[7] = t1[3];
                O[c] = __builtin_amdgcn_mfma_f32_16x16x32_bf16(pf, vf, O[c], 0, 0, 0);
            }
        }
        const float inv = 1.0f / lsum;
#pragma unroll
        for (int rr = 0; rr < 4; ++rr) {
            const float sc = __shfl(inv, 4 * g + rr);
            if (g < 2) {
#pragma unroll
                for (int c = 0; c < 8; ++c) (OUTB + (size_t)q * QAW)[(4 * g + rr) * 128 + 16 * c + h16] = (bf16)f2bf(O[c][rr] * sc);
            }
        }
    }
}
struct StoreBf16 { bf16* O; int ld;
    __device__ __forceinline__ void operator()(int row, int col, const f32x4& v) const { *(v2u*)(O + (size_t)row * ld + col) = (v2u){pk2(v.x, v.y), pk2(v.z, v.w)}; }
    __device__ __forceinline__ void two(int row, int col, const f32x4& a, const f32x4& b) const { *(v4u*)(O + (size_t)row * ld + col) = (v4u){pk2(a.x, a.y), pk2(a.z, a.w), pk2(b.x, b.y), pk2(b.z, b.w)}; }
    __device__ __forceinline__ void one(int row, int col, float v) const { O[(size_t)row * ld + col] = (bf16)f2bf(v); } };
struct StoreRes1 { const bf16* H; float* out; float* meta;
    __device__ __forceinline__ void operator()(int row, int col, const f32x4& v) const {
        if (row >= NROWS) return;
        const v2u hw = *(const v2u*)(H + (size_t)row * D + col);
        const f32x4 o = (f32x4){ALPHA * bflo(hw.x) + v.x, ALPHA * bfhi(hw.x) + v.y, ALPHA * bflo(hw.y) + v.z, ALPHA * bfhi(hw.y) + v.w};
        float* dst = row < NREAL ? out + (size_t)row * D + col : meta + (size_t)(row - NREAL) * D + col;
        *(f32x4*)dst = o; }
    __device__ __forceinline__ void two(int row, int col, const f32x4& a, const f32x4& b) const {
        const v4u hw = *(const v4u*)(H + (size_t)row * D + col);
        float* dst = out + (size_t)row * D + col;
        *(f32x4*)dst = (f32x4){ALPHA * bflo(hw.x) + a.x, ALPHA * bfhi(hw.x) + a.y, ALPHA * bflo(hw.y) + a.z, ALPHA * bfhi(hw.y) + a.w};
        *(f32x4*)(dst + 4) = (f32x4){ALPHA * bflo(hw.z) + b.x, ALPHA * bfhi(hw.z) + b.y, ALPHA * bflo(hw.w) + b.z, ALPHA * bfhi(hw.w) + b.w}; }
    __device__ __forceinline__ void one(int row, int col, float v) const { if (row >= NROWS) return; float* dst = row < NREAL ? out + (size_t)row * D + col : meta + (size_t)(row - NREAL) * D + col; *dst = ALPHA * bf2f(H[(size_t)row * D + col]) + v; } };
struct StoreRes2 { const bf16* H; float* out;
    __device__ __forceinline__ void two(int row, int col, const f32x4& a, const f32x4& b) const {
        const v4u hw = *(const v4u*)(H + (size_t)row * D + col);
        float* dst = out + (size_t)row * D + col;
        *(f32x4*)dst = (f32x4){ALPHA * bflo(hw.x) + a.x, ALPHA * bfhi(hw.x) + a.y, ALPHA * bflo(hw.y) + a.z, ALPHA * bfhi(hw.y) + a.w};
        *(f32x4*)(dst + 4) = (f32x4){ALPHA * bflo(hw.z) + b.x, ALPHA * bfhi(hw.z) + b.y, ALPHA * bflo(hw.w) + b.z, ALPHA * bfhi(hw.w) + b.w}; }
    __device__ __forceinline__ void operator()(int row, int col, const f32x4& v) const {
        if (row >= NREAL) return;
        const v2u hw = *(const v2u*)(H + (size_t)row * D + col);
        *(f32x4*)(out + (size_t)row * D + col) = (f32x4){ALPHA * bflo(hw.x) + v.x, ALPHA * bfhi(hw.x) + v.y, ALPHA * bflo(hw.y) + v.z, ALPHA * bfhi(hw.y) + v.w}; } };

struct StoreMetaGate { float* GM; __device__ __forceinline__ void one(int row, int col, float v) const { const int m = row - NREAL, x = col & 255; if (m >= 14 && x < 128) GM[(size_t)(m - 14) * DFF + 128 * (col >> 8) + x] = v; } };
template <class Fn>
__device__ __forceinline__ void meta_gemm(Frame& F, const bf16* A, int lda, const bf16* Bt, int N, int K, const Fn& fn) {
    const int l = F.lane, i16 = l & 15, g = l >> 4;
    const int gw = blockIdx.x * NWAVES + F.wave, NGW = F.G * NWAVES;
    for (int t = gw; t < N / 16; t += NGW) {
        const bf16* ap = A + (size_t)(NREAL + i16) * lda + 8 * g; const bf16* bp = Bt + (size_t)(16 * t + i16) * K + 8 * g;
        f32x4 acc = (f32x4){0.f, 0.f, 0.f, 0.f};
#pragma unroll 8
        for (int s = 0; s < K / 32; ++s) acc = __builtin_amdgcn_mfma_f32_16x16x32_bf16(*(const pg8::bf16x8*)(ap + 32 * s), *(const pg8::bf16x8*)(bp + 32 * s), acc, 0, 0, 0);
#pragma unroll
        for (int rr = 0; rr < 4; ++rr) fn.one(NREAL + 4 * g + rr, 16 * t + i16, acc[rr]);
    }
}

template <class Fn>
__device__ __forceinline__ void run_gemm(Frame& F, const bf16* A, int lda, const bf16* Bt, int N, int K, const Fn& fn) {
    pg8::Gemm g{A, Bt, NREAL, N, K, lda}; pg8::StaticOrder S; S.init(NREAL, N, F.G, (int)blockIdx.x);
    pg8::EpiFn<Fn> E{fn};
    pg8::gemm_phase<pg8::EpiFn<Fn>, pg8::StaticOrder, true, true>(F.lds + RING_OFF, g, S, E);
}

template <class Fn>
__device__ __forceinline__ void run_gemm8(Frame& F, const bf16* A, int lda, const bf16* Bt, int N, int K, const Fn& fn) {
    pg8::Gemm g{A, Bt, NREAL, N, K, lda}; pg8::StaticOrder S; S.init(NREAL, N, F.G, (int)blockIdx.x);
    pg8::EpiFn8<Fn> E{fn};
    pg8::gemm_phase<pg8::EpiFn8<Fn>, pg8::StaticOrder, true, true>(F.lds + RING_OFF, g, S, E);
}

constexpr int NPHASES = 13;
struct Args { const float* in[32]; float* out; unsigned char* ws; int ph_lo, ph_hi; };
__global__ void __launch_bounds__(NTHR, 2) fwd(Args args) {
    extern __shared__ __attribute__((aligned(16))) unsigned char lds[];
    Frame F;
    F.lds = (LAS unsigned char*)lds;
    F.MISC = (volatile LAS unsigned*)(F.lds + MISC_OFF);
    F.tid = threadIdx.x; F.lane = F.tid & 63; F.wave = __builtin_amdgcn_readfirstlane(F.tid >> 6);
    F.G = gridDim.x;
#pragma unroll
    for (int i = 0; i < 32; ++i) F.in[i] = args.in[i];
    F.out = args.out; F.ws = args.ws;
    F.ctl = (gu32*)(args.ws + WS_CTL);
    for (int u = F.tid; u < (LDS_BYTES - LDSCTL_OFF) / 4; u += NTHR) ((LAS unsigned*)(F.lds + LDSCTL_OFF))[u] = 0u;
    __syncthreads();
    const int lo = args.ph_lo, hi = args.ph_hi;
    XcdBarrier bar; bar.bar = (unsigned*)(F.ctl + CW_BAR); bar.x = 0; bar.st = nullptr;
    if (hi - lo > 1) bar = xcd_barrier_post((unsigned*)(F.ctl + CW_BAR), F.MISC + 8);
#define IN(k) (lo <= (k) && (k) < hi)
#ifdef PROBE_PHASE_T
    unsigned long long tp_prev = __builtin_amdgcn_s_memrealtime(), tp_dur = 0ull;
#define SEAM(k) do { if (IN(k) && IN((k) + 1)) xcd_barrier(bar); if (blockIdx.x == 0 && F.tid == 0) { const unsigned long long t_ = __builtin_amdgcn_s_memrealtime(); if ((k) == PROBE_PHASE_T) tp_dur = t_ - tp_prev; tp_prev = t_; } } while (0)
#else
#define SEAM(k) do { if (IN(k) && IN((k) + 1)) xcd_barrier(bar); } while (0)
#endif
#ifndef PROBE_PH
#define PROBE_PH -1
#endif
#define REP(k) for (int rep_ = 0; rep_ < ((PROBE_PH == (k)) ? 2 : 1); ++rep_)

#ifndef IDX_NAIVE
#define IDX_NAIVE 0
#endif
#ifndef ATTN_NAIVE
#define ATTN_NAIVE 0
#endif
    if (IN(0)) REP(0) { if (rep_) __syncthreads(); p0_weights(F); p1_ln_in(F); } SEAM(0);
    if (IN(1)) REP(1) { if (rep_) __syncthreads(); run_gemm8(F, WSP(bf16, WS_H), D, WSP(bf16, WS_WT_IN), PW, D, StoreBf16{WSP(bf16, WS_P), PW}); meta_gemm(F, WSP(bf16, WS_H), D, WSP(bf16, WS_WT_IN), PW, D, StoreBf16{WSP(bf16, WS_P), PW});
        if (rep_ == 0) { if (F.G == 256) { if (blockIdx.x >= 128) p0_weights_late(F, (blockIdx.x - 128) * NWAVES + F.wave, 128 * NWAVES); } else p0_weights_late(F, blockIdx.x * NWAVES + F.wave, F.G * NWAVES); } } SEAM(1);
    if (IN(2)) REP(2) { if (rep_) __syncthreads(); p3_prep(F); } SEAM(2);
    if (IN(3)) REP(3) { if (rep_) __syncthreads(); run_gemm8(F, WSP(bf16, WS_CQN), 256, WSP(bf16, WS_WT_QA), QAW, 256, StoreBf16{WSP(bf16, WS_QA), QAW}); meta_gemm(F, WSP(bf16, WS_CQN), 256, WSP(bf16, WS_WT_QA), QAW, 256, StoreBf16{WSP(bf16, WS_QA), QAW});
#if REFSEL
        refsel_rows(F);
#endif
    } SEAM(3);
    if (IN(4)) REP(4) { if (rep_) __syncthreads(); rw_b1(F); } SEAM(4);
    if (IN(5)) {
        rw_b2(F); __syncthreads();
#if CHECK_IDX
        p5_index_naive(F); __syncthreads(); p5_index_mfma(F, (unsigned short*)F.out, (int*)((char*)F.out + 32 * MiB));
#elif IDX_NAIVE
        p5_index_naive(F);
#else
        p5_index_mfma(F, WSP(unsigned short, WS_SEL), WSP(int, WS_NSEL), 3072, false, true);
#ifdef PROBE_IDX
        __syncthreads(); p5_index_mfma(F, WSP(unsigned short, WS_SEL), WSP(int, WS_NSEL), 3136);
#endif
#ifdef PROBE_IDX_SCORE
        __syncthreads(); p5_index_mfma(F, (unsigned short*)F.out, (int*)((char*)F.out + 32 * MiB), 3136, true);
#endif
#endif
    } SEAM(5);
    if (IN(6)) {
#if CHECK_IDX
        idx_check(F); __syncthreads();
#endif
#if CHECK_IDX || IDX_NAIVE
        if (blockIdx.x == 0) { p6_attn_mfma(F, WSP(bf16, WS_QA), true); __syncthreads(); }
        if (blockIdx.x == 1) { rw_b3(F, true); __syncthreads(); }
#endif
#if ATTN_NAIVE
        p6_attn_naive(F);
#else
        p6_attn_mfma(F, WSP(bf16, WS_QA));
#endif
        __syncthreads();
        rw_b3(F);
    } SEAM(6);
    if (IN(7)) REP(7) { if (rep_) __syncthreads(); run_gemm8(F, WSP(bf16, WS_QA), QAW, WSP(bf16, WS_WT_MIX), D, QAW, StoreRes1{WSP(bf16, WS_H), F.out, WSP(float, WS_META1)}); meta_gemm(F, WSP(bf16, WS_QA), QAW, WSP(bf16, WS_WT_MIX), D, QAW, StoreRes1{WSP(bf16, WS_H), F.out, WSP(float, WS_META1)}); } SEAM(7);
    if (IN(8)) REP(8) { if (rep_) __syncthreads(); p10_ln1(F); } SEAM(8);
    if (IN(9)) {
        pg8::Gemm g{WSP(bf16, WS_H), WSP(bf16, WS_WT_UP), NREAL, UPW, D, D}; pg8::StaticOrder S; S.init(NREAL, UPW, F.G, (int)blockIdx.x);
        pg8::EpiConvAct E{WSP(unsigned short, WS_UP), DFF, F.in[IN_CONV_W], F.in[IN_CONV_B], DFF, WSP(float, WS_G01), WSP(float, WS_V01), WSP(float, WS_GHALO), (PG8_LAS float*)(F.lds + RING_BYTES + 4096)};
        pg8::gemm_phase<pg8::EpiConvAct, pg8::StaticOrder, true, true>(F.lds + RING_OFF, g, S, E);
        meta_gemm(F, WSP(bf16, WS_H), D, WSP(bf16, WS_WT_UP), UPW, D, StoreMetaGate{WSP(float, WS_GMETA)});
    } SEAM(9);
    if (IN(10)) { p12_conv_fix(F); } SEAM(10);
    if (IN(11)) REP(11) { if (rep_) __syncthreads(); run_gemm8(F, WSP(bf16, WS_UP), DFF, WSP(bf16, WS_WT_DN), D, DFF, StoreRes2{WSP(bf16, WS_H), F.out}); } SEAM(11);
    if (IN(12)) { p14_ln2(F);
#if CHECK_IDX
        if (blockIdx.x == 0 && F.tid == 0) {
            const unsigned miss = __hip_atomic_load((unsigned*)F.ctl + 2048, __ATOMIC_RELAXED, __HIP_MEMORY_SCOPE_AGENT), dupc = __hip_atomic_load((unsigned*)F.ctl + 2050, __ATOMIC_RELAXED, __HIP_MEMORY_SCOPE_AGENT);
            if (dupc) F.out[5] = __builtin_inff();
            if (miss > CHECK_IDX_MAXMISS) F.out[3] = __builtin_nanf("");
        }
#endif
    }
#ifdef PROBE_PHASE_T
    if (blockIdx.x == 0 && F.tid == 0) { if (PROBE_PHASE_T == 12) tp_dur = __builtin_amdgcn_s_memrealtime() - tp_prev; const unsigned long long t0 = __builtin_amdgcn_s_memrealtime(); while (__builtin_amdgcn_s_memrealtime() - t0 < tp_dur) __builtin_amdgcn_s_sleep(8); }
#endif
#ifdef PROBE_B1SEC
    if (blockIdx.x == 0 && F.tid == 0) { const unsigned long long t0 = __builtin_amdgcn_s_memrealtime(); const unsigned long long dt = (unsigned long long)F.MISC[20]; while (__builtin_amdgcn_s_memrealtime() - t0 < dt) __builtin_amdgcn_s_sleep(8); }
#endif
#undef IN
#undef SEAM
}

extern "C" void kernel_launch(void* const* d_in, const int* in_sizes, int n_in, void* d_out, int out_size, void* d_ws, size_t ws_size, hipStream_t stream) {
    static int grid = 0;
    if (grid == 0) {
        if (n_in != 32 || out_size != NREAL * D || ws_size < WS_END) { fprintf(stderr, "kernel_launch: unexpected shapes: n_in %d out %d ws %zu\n", n_in, out_size, ws_size); grid = -1; return; }
        int dev = 0, cus = 0, per_cu = 0;
        if (hipGetDevice(&dev) != hipSuccess || hipDeviceGetAttribute(&cus, hipDeviceAttributeMultiprocessorCount, dev) != hipSuccess) { grid = -1; return; }
        if (hipFuncSetAttribute((const void*)fwd, hipFuncAttributeMaxDynamicSharedMemorySize, LDS_BYTES) != hipSuccess) { fprintf(stderr, "kernel_launch: hipFuncSetAttribute failed\n"); grid = -1; return; }
        if (hipOccupancyMaxActiveBlocksPerMultiprocessor(&per_cu, (const void*)fwd, NTHR, LDS_BYTES) != hipSuccess || per_cu < 1) fprintf(stderr, "kernel_launch: occupancy query says %d\n", per_cu);
        (void)hipGetLastError();
        grid = cus;
    }
    if (grid < 0) return;
    (void)hipMemsetAsync((char*)d_ws + WS_CTL, 0, CTL_ZERO_BYTES, stream);
    Args a{};
    for (int i = 0; i < 32; ++i) a.in[i] = (const float*)d_in[i];
    a.out = (float*)d_out; a.ws = (unsigned char*)d_ws;
#if ONE_LAUNCH
    a.ph_lo = 0; a.ph_hi = NPHASES;
    hipLaunchKernelGGL(fwd, dim3(grid), dim3(NTHR), LDS_BYTES, stream, a);
#else
    for (int p = 0; p < NPHASES; ++p) { a.ph_lo = p; a.ph_hi = p + 1; hipLaunchKernelGGL(fwd, dim3(grid), dim3(NTHR), LDS_BYTES, stream, a); }
#endif
}
```

```cpp
#include <hip/hip_runtime.h>
#include <cstdio>
#include <cstdint>
#define ONE_LAUNCH 1
namespace pg8 {
#define PG8_LAS __attribute__((address_space(3)))
typedef unsigned short bf16_t;
typedef short bf16x8 __attribute__((ext_vector_type(8)));
typedef float f32x4 __attribute__((ext_vector_type(4)));
typedef unsigned u32x4 __attribute__((ext_vector_type(4)));
constexpr int BM = 256, BK = 64, HALF = 128, HTB = HALF * BK * 2  , STAGE_BYTES = 8 * HTB, NXCD = 8, WGM = 8;

__host__ __device__ __forceinline__ int lds_byte(int r, int c) { const int st = (r >> 4) * 2 + (c >> 5), rr = r & 15, cc = c & 31, ob = rr * 64 + cc * 2; return st * 1024 + (ob ^ (((ob >> 9) & 1) << 5)); }
__host__ __device__ __forceinline__ void stage_rc(int b, int& R, int& C) { const int st = b / 1024, sb = b % 1024, swz = sb ^ (((sb >> 9) & 1) << 5); R = (st >> 1) * 16 + swz / 64; C = (st & 1) * 32 + (swz % 64) / 2; }
__host__ __device__ __forceinline__ int perm32(int rho) { const int n = rho >> 4, i = rho & 15; return 8 * (i >> 2) + 4 * n + (i & 3); }

struct Unit { int pm, pn; };
struct Gemm { const bf16_t* A; const bf16_t* Bt; int M, N, K, lda; };

struct StaticOrder {
    int nM, nN, nwg, G, c;
    __host__ __device__ void init(int M, int N, int G_, int c_) { nM = M / BM; nN = N / BM; nwg = nM * nN; G = G_; c = c_; }
    __host__ __device__ bool next(int i, Unit& u) const {
        const long L = (long)i * G + c; if (L >= nwg) return false;
        int wgid = (int)L; { const int q = nwg / NXCD, r = nwg % NXCD, xcd = wgid % NXCD, off = wgid / NXCD; wgid = (xcd < r ? xcd * (q + 1) : r * (q + 1) + (xcd - r) * q) + off; }
        const int nig = WGM * nN, gid = wgid / nig, fm = gid * WGM, gsz = (nM - fm) < WGM ? (nM - fm) : WGM;
        u.pm = fm + ((wgid % nig) % gsz); u.pn = (wgid % nig) / gsz; return true;
    }
    __device__ __forceinline__ void a_ready(const Unit&) const {}
    __device__ __forceinline__ void done(const Unit&) const {}
};


template <class F> struct EpiFn {
    static constexpr bool PERM = false, AFTER_DRAIN = false;
    F f;
    __device__ __forceinline__ void operator()(const f32x4 (&acc)[2][2][4][2], const Unit& u, int wr, int wc, int fr, int fq) const {
        const int row0 = u.pm * BM + wr * 64 + fr, col0 = u.pn * BM + wc * 32 + 4 * fq;
#pragma unroll
        for (int ai = 0; ai < 2; ++ai)
#pragma unroll
            for (int m = 0; m < 4; ++m) {
                const int row = row0 + ai * HALF + m * 16;
#pragma unroll
                for (int bj = 0; bj < 2; ++bj)
#pragma unroll
                    for (int n = 0; n < 2; ++n) f(row, col0 + bj * HALF + n * 16, acc[ai][bj][m][n]);
            }
    }
};

template <class F> struct EpiFn8 {
    static constexpr bool PERM = true, AFTER_DRAIN = false;
    F f;
    __device__ __forceinline__ void operator()(const f32x4 (&acc)[2][2][4][2], const Unit& u, int wr, int wc, int fr, int fq) const {
        const int row0 = u.pm * BM + wr * 64 + fr, col0 = u.pn * BM + wc * 32 + 8 * fq;
#pragma unroll
        for (int ai = 0; ai < 2; ++ai)
#pragma unroll
            for (int m = 0; m < 4; ++m) {
                const int row = row0 + ai * HALF + m * 16;
#pragma unroll
                for (int bj = 0; bj < 2; ++bj) f.two(row, col0 + bj * HALF, acc[ai][bj][m][0], acc[ai][bj][m][1]);
            }
    }
};

struct EpiConvAct {
    static constexpr bool PERM = true, AFTER_DRAIN = false;
    unsigned short* ACT; int ldact;
    const float* cw; const float* cb; int dff;
    float* G01; float* V01; float* GHALO;
    PG8_LAS float* hal;
    __device__ __forceinline__ void operator()(const f32x4 (&acc)[2][2][4][2], const Unit& u, int wr, int wc, int fr, int fq) const {
        const int colg = 128 * u.pn + wc * 32 + 8 * fq;
        f32x4 w0[2], w1[2], w2[2], bb[2];
#pragma unroll
        for (int n = 0; n < 2; ++n) { w0[n] = *(const f32x4*)(cw + colg + 4 * n); w1[n] = *(const f32x4*)(cw + dff + colg + 4 * n); w2[n] = *(const f32x4*)(cw + 2 * dff + colg + 4 * n); bb[n] = *(const f32x4*)(cb + colg + 4 * n); }
        if (fr >= 14) {
#pragma unroll
            for (int ai = 0; ai < 2; ++ai)
#pragma unroll
                for (int n = 0; n < 2; ++n) *(PG8_LAS f32x4*)(hal + (((2 * ai + wr) * 4 + wc) * 2 + (fr - 14)) * 32 + 8 * fq + 4 * n) = acc[ai][0][3][n];
        }
        asm volatile("s_waitcnt lgkmcnt(0)" ::: "memory"); __builtin_amdgcn_s_barrier(); asm volatile("" ::: "memory");
#pragma unroll
        for (int ai = 0; ai < 2; ++ai) {
            const int blk = 2 * ai + wr;
            f32x4 prev[2];
#pragma unroll
            for (int n = 0; n < 2; ++n) {
                prev[n] = (f32x4){0.f, 0.f, 0.f, 0.f};
                if (blk > 0) prev[n] = *(const PG8_LAS f32x4*)(hal + ((((blk - 1) * 4 + wc) * 2 + (fr & 1)) * 32) + 8 * fq + 4 * n);
            }
#pragma unroll
            for (int m = 0; m < 4; ++m) {
                f32x4 o[2];
#pragma unroll
                for (int n = 0; n < 2; ++n) {
                    const f32x4 cur = acc[ai][0][m][n], val = acc[ai][1][m][n];
#pragma unroll
                    for (int e = 0; e < 4; ++e) {
                        float s1 = prev[n][e], s2 = prev[n][e];
                        asm volatile("s_nop 1\n\tv_mov_b32_dpp %0, %0 row_ror:1 row_mask:0xf bank_mask:0xf\n\tv_mov_b32_dpp %1, %1 row_ror:2 row_mask:0xf bank_mask:0xf\n\ts_nop 1\n\t"
                                     "v_mov_b32_dpp %0, %2 row_shr:1 row_mask:0xf bank_mask:0xf\n\tv_mov_b32_dpp %1, %2 row_shr:2 row_mask:0xf bank_mask:0xf\n\ts_nop 1" : "+v"(s1), "+v"(s2) : "v"(cur[e]));
                        const float x = w0[n][e] * s2 + w1[n][e] * s1 + w2[n][e] * cur[e] + bb[n][e];
                        const float u2 = x * (1.5957691216057308f + 0.07135481627260025f * x * x);
                        o[n][e] = x * __builtin_amdgcn_rcpf(1.0f + __builtin_amdgcn_exp2f(-1.4426950408889634f * u2)) * val[e];
                    }
                    prev[n] = cur;
                }
                const int rt = ai * HALF + wr * 64 + m * 16 + fr;
                const int row = u.pm * BM + rt;
                if (blk == 0 && m == 0 && fr < 2) {
#pragma unroll
                    for (int n = 0; n < 2; ++n) { *(f32x4*)(G01 + ((size_t)u.pm * 2 + fr) * dff + colg + 4 * n) = acc[ai][0][m][n]; *(f32x4*)(V01 + ((size_t)u.pm * 2 + fr) * dff + colg + 4 * n) = acc[ai][1][m][n]; }
                } else {
                    typedef __bf16 b2 __attribute__((ext_vector_type(2)));
                    const b2 p0 = {(__bf16)o[0][0], (__bf16)o[0][1]}, p1 = {(__bf16)o[0][2], (__bf16)o[0][3]}, p2 = {(__bf16)o[1][0], (__bf16)o[1][1]}, p3 = {(__bf16)o[1][2], (__bf16)o[1][3]};
                    *(u32x4*)(ACT + (size_t)row * ldact + colg) = (u32x4){__builtin_bit_cast(unsigned, p0), __builtin_bit_cast(unsigned, p1), __builtin_bit_cast(unsigned, p2), __builtin_bit_cast(unsigned, p3)};
                }
                if (blk == 3 && m == 3 && fr >= 14) {
#pragma unroll
                    for (int n = 0; n < 2; ++n) *(f32x4*)(GHALO + ((size_t)u.pm * 2 + (fr - 14)) * dff + colg + 4 * n) = acc[ai][0][m][n];
                }
            }
        }
        asm volatile("s_waitcnt lgkmcnt(0)" ::: "memory"); __builtin_amdgcn_s_barrier(); asm volatile("" ::: "memory");
    }
};
template <class Epi, class Sched, bool ALIGN_EPI = false, bool SP2 = false>
__device__ __forceinline__ void gemm_phase(PG8_LAS unsigned char* lds, const Gemm g, const Sched& S, const Epi& E) {
    const int tid = threadIdx.x, wid = __builtin_amdgcn_readfirstlane(tid >> 6), lane = tid & 63, wr = wid >> 2, wc = wid & 3, fr = lane & 15, fq = lane >> 4;
    const int K = g.K, nt = K / BK;
    unsigned voffA[2], voffB[2];
#pragma unroll
    for (int i = 0; i < 2; ++i) { int R, C; stage_rc(tid * 16 + i * 8192, R, C); const int Rb = Epi::PERM ? ((R & ~31) + perm32(R & 31)) : R;
        voffA[i] = (unsigned)(R * g.lda + C) * 2u; voffB[i] = (unsigned)(Rb * K + C) * 2u; }
    const size_t kstep = (size_t)(BK * 2);
    const size_t hA = (size_t)HALF * g.lda * 2, hB = (size_t)HALF * K * 2;
    const size_t tA = 2 * hA, tB = 2 * hB;
    const unsigned ldsw = (unsigned)wid * 1024u;
    const int aoff = lds_byte(wr * 64 + fr, fq * 8), boff = lds_byte(wc * 32 + fr, fq * 8);
#define PG8_SA(b, h) (((b) * 2 + (h)) * HTB)
#define PG8_SB(b, h) ((4 + (b) * 2 + (h)) * HTB)
#define PG8_STAGE(bufoff, gbase, voff) do { _Pragma("unroll") for (int _i = 0; _i < 2; ++_i) \
        __builtin_amdgcn_global_load_lds((const unsigned*)((const char*)(gbase) + (voff)[_i]), (PG8_LAS unsigned*)(lds + (bufoff) + ldsw + _i * 8192), 16, 0, 0); } while (0)
#define PG8_LDA(dst, b, h) do { _Pragma("unroll") for (int m = 0; m < 4; ++m) _Pragma("unroll") for (int k = 0; k < 2; ++k) dst[m][k] = *(const PG8_LAS bf16x8*)(lds + PG8_SA(b, h) + aoff + m * 2048 + k * 1024); } while (0)
#define PG8_LDB(dst, b, h) do { _Pragma("unroll") for (int n = 0; n < 2; ++n) _Pragma("unroll") for (int k = 0; k < 2; ++k) dst[n][k] = *(const PG8_LAS bf16x8*)(lds + PG8_SB(b, h) + boff + n * 2048 + k * 1024); } while (0)
#define PG8_MMA(ai, bj, At, Bt) do { __builtin_amdgcn_s_setprio(1); _Pragma("unroll") for (int m = 0; m < 4; ++m) _Pragma("unroll") for (int n = 0; n < 2; ++n) _Pragma("unroll") for (int k = 0; k < 2; ++k) \
        acc[ai][bj][m][n] = __builtin_amdgcn_mfma_f32_16x16x32_bf16(Bt[n][k], At[m][k], acc[ai][bj][m][n], 0, 0, 0); __builtin_amdgcn_s_setprio(0); } while (0)
#define PG8_WAIT_V(n) asm volatile("s_waitcnt vmcnt(" #n ")" ::: "memory")
#define PG8_WAIT_L(n) asm volatile("s_waitcnt lgkmcnt(" #n ")" ::: "memory")
#define PG8_BAR __builtin_amdgcn_s_barrier()
#define PG8_SCHED __builtin_amdgcn_sched_barrier(0)
    Unit cur, nxt; int ui = 0;
    if (!S.next(0, cur)) return;
    f32x4 acc[2][2][4][2];
#pragma unroll
    for (int a = 0; a < 2; ++a)
#pragma unroll
        for (int b = 0; b < 2; ++b)
#pragma unroll
            for (int m = 0; m < 4; ++m)
#pragma unroll
                for (int n = 0; n < 2; ++n) acc[a][b][m][n] = (f32x4){0.f, 0.f, 0.f, 0.f};
    bf16x8 At[4][2], B0[2][2], B1[2][2];
    const char* cA = (const char*)g.A + (size_t)cur.pm * tA; const char* cB = (const char*)g.Bt + (size_t)cur.pn * tB;
    S.a_ready(cur);
    if constexpr (SP2) {
        PG8_STAGE(PG8_SB(0, 0), cB, voffB); PG8_STAGE(PG8_SB(0, 1), cB + hB, voffB); PG8_STAGE(PG8_SA(0, 0), cA, voffA); PG8_STAGE(PG8_SA(0, 1), cA + hA, voffA);
        if (wr == 1) PG8_BAR;
        PG8_WAIT_V(2); PG8_BAR;
        PG8_STAGE(PG8_SB(1, 0), cB + kstep, voffB); PG8_STAGE(PG8_SA(1, 0), cA + kstep, voffA); PG8_STAGE(PG8_SB(1, 1), cB + hB + kstep, voffB);
        PG8_WAIT_V(6); PG8_BAR;
    } else {
        PG8_STAGE(PG8_SB(0, 0), cB, voffB); PG8_STAGE(PG8_SA(0, 0), cA, voffA); PG8_STAGE(PG8_SB(0, 1), cB + hB, voffB); PG8_STAGE(PG8_SA(0, 1), cA + hA, voffA);
        if (wr == 1) PG8_BAR;
        PG8_WAIT_V(4); PG8_BAR;
        PG8_STAGE(PG8_SB(1, 0), cB + kstep, voffB); PG8_STAGE(PG8_SA(1, 0), cA + kstep, voffA); PG8_STAGE(PG8_SB(1, 1), cB + hB + kstep, voffB);
        PG8_WAIT_V(6); PG8_BAR;
    }
    for (;;) {
        const bool has_next = S.next(ui + 1, nxt);
        const char* nA = has_next ? (const char*)g.A + (size_t)nxt.pm * tA : cA; const char* nB = has_next ? (const char*)g.Bt + (size_t)nxt.pn * tB : cB;
        for (int t = 0; t < nt; t += 2) {
            const bool last = (t == nt - 2);
            const char* a1 = cA + (size_t)(t + 1) * kstep;
            const char* a2 = last ? nA : cA + (size_t)(t + 2) * kstep; const char* b2 = last ? nB : cB + (size_t)(t + 2) * kstep;
            const char* a3 = a2 + kstep; const char* b3 = b2 + kstep;
            if (last && has_next) S.a_ready(nxt);
            if constexpr (SP2) {
            PG8_LDB(B0, 0, 0); PG8_LDB(B1, 0, 1); PG8_SCHED; PG8_LDA(At, 0, 0); PG8_STAGE(PG8_SA(1, 1), a1 + hA, voffA);
            PG8_WAIT_V(8); PG8_WAIT_L(0); PG8_BAR; PG8_MMA(0, 0, At, B0); PG8_MMA(0, 1, At, B1); PG8_BAR; PG8_SCHED;
            PG8_LDA(At, 0, 1); PG8_STAGE(PG8_SB(0, 0), b2, voffB); PG8_STAGE(PG8_SB(0, 1), b2 + hB, voffB); PG8_STAGE(PG8_SA(0, 0), a2, voffA);
            PG8_WAIT_V(8); PG8_WAIT_L(0); PG8_BAR; PG8_MMA(1, 0, At, B0); PG8_MMA(1, 1, At, B1); PG8_BAR; PG8_SCHED;
            PG8_LDB(B0, 1, 0); PG8_LDB(B1, 1, 1); PG8_SCHED; PG8_LDA(At, 1, 0); PG8_STAGE(PG8_SA(0, 1), a2 + hA, voffA);
            PG8_WAIT_V(8); PG8_WAIT_L(0); PG8_BAR; PG8_MMA(0, 0, At, B0); PG8_MMA(0, 1, At, B1); PG8_BAR; PG8_SCHED;
            PG8_LDA(At, 1, 1); PG8_STAGE(PG8_SB(1, 0), b3, voffB); PG8_STAGE(PG8_SB(1, 1), b3 + hB, voffB); PG8_STAGE(PG8_SA(1, 0), a3, voffA);
            PG8_WAIT_V(8); PG8_WAIT_L(0); PG8_BAR; PG8_MMA(1, 0, At, B0); PG8_MMA(1, 1, At, B1); PG8_BAR; PG8_SCHED;
            } else {
            PG8_LDB(B0, 0, 0); PG8_SCHED; PG8_LDA(At, 0, 0); PG8_STAGE(PG8_SA(1, 1), a1 + hA, voffA);
            PG8_WAIT_L(8); PG8_BAR; PG8_WAIT_L(0); PG8_MMA(0, 0, At, B0); PG8_BAR; PG8_SCHED;
            PG8_LDB(B1, 0, 1); PG8_STAGE(PG8_SB(0, 0), b2, voffB);
            PG8_BAR; PG8_WAIT_L(0); PG8_MMA(0, 1, At, B1); PG8_BAR;
            PG8_LDA(At, 0, 1); PG8_STAGE(PG8_SA(0, 0), a2, voffA);
            PG8_BAR; PG8_WAIT_L(0); PG8_MMA(1, 0, At, B0); PG8_BAR; PG8_SCHED;
            PG8_STAGE(PG8_SB(0, 1), b2 + hB, voffB);
            PG8_WAIT_V(6); PG8_BAR; PG8_MMA(1, 1, At, B1); PG8_BAR;
            PG8_LDB(B0, 1, 0); PG8_SCHED; PG8_LDA(At, 1, 0); PG8_STAGE(PG8_SA(0, 1), a2 + hA, voffA);
            PG8_WAIT_L(8); PG8_BAR; PG8_WAIT_L(0); PG8_MMA(0, 0, At, B0); PG8_BAR; PG8_SCHED;
            PG8_LDB(B1, 1, 1); PG8_STAGE(PG8_SB(1, 0), b3, voffB);
            PG8_BAR; PG8_WAIT_L(0); PG8_MMA(0, 1, At, B1); PG8_BAR;
            PG8_LDA(At, 1, 1); PG8_STAGE(PG8_SA(1, 0), a3, voffA);
            PG8_BAR; PG8_WAIT_L(0); PG8_MMA(1, 0, At, B0); PG8_BAR; PG8_SCHED;
            PG8_STAGE(PG8_SB(1, 1), b3 + hB, voffB);
            PG8_WAIT_V(6); PG8_BAR; PG8_MMA(1, 1, At, B1); PG8_BAR;
            }
        }
        if constexpr (ALIGN_EPI) { if (wr == 0) PG8_BAR; }
        if constexpr (!Epi::AFTER_DRAIN) { E(acc, cur, wr, wc, fr, fq); S.done(cur); }
        if (!has_next) break;
#pragma unroll
        for (int a = 0; a < 2; ++a)
#pragma unroll
            for (int b = 0; b < 2; ++b)
#pragma unroll
                for (int m = 0; m < 4; ++m)
#pragma unroll
                    for (int n = 0; n < 2; ++n) acc[a][b][m][n] = (f32x4){0.f, 0.f, 0.f, 0.f};
        cur = nxt; cA = nA; cB = nB; ++ui;
        if constexpr (ALIGN_EPI) { if (wr == 1) PG8_BAR; }
    }
    PG8_WAIT_V(0);
    if constexpr (!ALIGN_EPI) { if (wr == 0) PG8_BAR; }
    PG8_BAR;
    if constexpr (Epi::AFTER_DRAIN) { E.fused(acc, cur, wr, wc, fr, fq, lds, wid, lane); S.done(cur); }
#undef PG8_SA
#undef PG8_SB
#undef PG8_STAGE
#undef PG8_LDA
#undef PG8_LDB
#undef PG8_MMA
#undef PG8_WAIT_V
#undef PG8_WAIT_L
#undef PG8_BAR
#undef PG8_SCHED
}
}

#ifndef ONE_LAUNCH
#define ONE_LAUNCH 0
#endif
constexpr int NWAVES = 8, NTHR = 512;
constexpr int D = 1024, BATCH = 4, SEQ = 8192, NMETA = 16, TT = SEQ + NMETA;
constexpr int NREAL = BATCH * SEQ;
constexpr int NROWS = NREAL + NMETA;
constexpr int R = 33024;
constexpr int PW = 2304;
constexpr int PC_CQ = 0, PC_CKV = 256, PC_KIDX = 384, PC_WIDX = 448, PC_R = 512, PC_K = 1024, PC_V = 1536, PC_WD = 2048, PC_AD = 2112, PC_GD = 2176;
constexpr int QAW = 1536;
constexpr int DFF = 2816, UPW = 5632;
constexpr int TOPK = 256;
constexpr float LN_EPS = 1e-5f, GN_EPS = 64e-5f, ALPHA = 1.18920711500272f;

constexpr size_t MiB = 1u << 20;
constexpr size_t WS_CTL = 0, CTL_ZERO_BYTES = 32768;
constexpr size_t WS_WT_IN = 1 * MiB, WS_WT_QA = 6 * MiB, WS_WT_MIX = 7 * MiB, WS_WT_UP = 10 * MiB, WS_WT_DN = 21 * MiB;
constexpr size_t WS_META1 = 27 * MiB, WS_NSEL = 28 * MiB, WS_WIDX = 29 * MiB;
constexpr size_t WS_H = 33 * MiB;
constexpr size_t WS_P = 98 * MiB, WS_QA = 244 * MiB, WS_CQN = 341 * MiB, WS_SEL = 341 * MiB, WS_CKV = 358 * MiB, WS_KIDX = 367 * MiB;
constexpr size_t WS_DEC = 372 * MiB, WS_AB = 437 * MiB, WS_GB = 470 * MiB;
constexpr size_t WS_WT_LORA = 26 * MiB + 512 * 1024;
constexpr size_t WS_RWM = 372 * MiB, WS_RWN = 405 * MiB, WS_RWQ = 438 * MiB, WS_RWY = 471 * MiB;
constexpr size_t OUT_RWS = 80 * MiB, OUT_BONUS = 116 * MiB;
constexpr size_t WS_G01 = 480 * MiB, WS_V01 = 484 * MiB, WS_GHALO = 488 * MiB, WS_GMETA = 492 * MiB;
constexpr size_t WS_UP = 98 * MiB;
constexpr size_t WS_END = 512 * MiB;
static_assert(WS_P + (size_t)R * PW * 2 <= WS_QA && WS_QA + (size_t)R * QAW * 2 <= WS_CQN && WS_CQN + (size_t)R * 256 * 2 <= WS_CKV && WS_CKV + (size_t)R * 128 * 2 <= WS_KIDX
              && WS_KIDX + (size_t)R * 64 * 2 <= WS_DEC && WS_DEC + (size_t)R * 512 * 4 <= WS_AB && WS_AB + (size_t)R * 512 * 2 <= WS_GB && WS_GB + (size_t)R * 512 * 2 <= WS_END
              && WS_UP + (size_t)R * UPW * 2 <= WS_END && WS_H + (size_t)R * D * 2 <= WS_P && WS_WIDX + (size_t)R * 8 * 4 <= WS_H && WS_NSEL + (size_t)R * 4 <= WS_WIDX, "ws map");
constexpr int CW_BAR = 4096;

constexpr int RING_OFF = 0, RING_BYTES = 131072;
constexpr int LDSCTL_OFF = RING_BYTES, MISC_OFF = LDSCTL_OFF + 320;
constexpr int LDS_BYTES = 147456;

#define GAS __attribute__((address_space(1)))
#define LAS __attribute__((address_space(3)))
typedef unsigned short bf16;
typedef unsigned v4u __attribute__((ext_vector_type(4)));
typedef unsigned v2u __attribute__((ext_vector_type(2)));
typedef float f32x4 __attribute__((ext_vector_type(4)));
typedef GAS unsigned gu32;
typedef __bf16 bf16x2_t __attribute__((ext_vector_type(2)));
__device__ __forceinline__ unsigned f2bf(float f) { return (unsigned)__builtin_bit_cast(unsigned short, (__bf16)f); }
__device__ __forceinline__ unsigned pk2(float lo, float hi) { const bf16x2_t v = {(__bf16)lo, (__bf16)hi}; return __builtin_bit_cast(unsigned, v); }
__device__ __forceinline__ float fast_rcp(float x) { return __builtin_amdgcn_rcpf(x); }
__device__ __forceinline__ float fast_tanh(float x) { return 1.0f - 2.0f * __builtin_amdgcn_rcpf(1.0f + __expf(2.0f * x)); }
__device__ __forceinline__ float bf2f(unsigned short b) { return __uint_as_float(((unsigned)b) << 16); }
__device__ __forceinline__ float bflo(unsigned w) { return __uint_as_float(w << 16); }
__device__ __forceinline__ float bfhi(unsigned w) { return __uint_as_float(w & 0xffff0000u); }
#define DPP_F(v, ctrl) __builtin_bit_cast(float, __builtin_amdgcn_update_dpp(0, __builtin_bit_cast(int, (v)), (ctrl), 0xf, 0xf, false))
__device__ __forceinline__ float rdlane_f(float v, int lane) { return __builtin_bit_cast(float, __builtin_amdgcn_readlane(__builtin_bit_cast(int, v), lane)); }
__device__ __forceinline__ float wave_sum(float v) {
    v += DPP_F(v, 0xB1); v += DPP_F(v, 0x4E); v += DPP_F(v, 0x141); v += DPP_F(v, 0x140);
    return (rdlane_f(v, 0) + rdlane_f(v, 16)) + (rdlane_f(v, 32) + rdlane_f(v, 48));
}
__device__ __forceinline__ float wave_max(float v) {
    v = fmaxf(v, DPP_F(v, 0xB1)); v = fmaxf(v, DPP_F(v, 0x4E)); v = fmaxf(v, DPP_F(v, 0x141)); v = fmaxf(v, DPP_F(v, 0x140));
    return fmaxf(fmaxf(rdlane_f(v, 0), rdlane_f(v, 16)), fmaxf(rdlane_f(v, 32), rdlane_f(v, 48)));
}
#define DPP_U0(v, ctrl) ((unsigned)__builtin_amdgcn_update_dpp(0, (int)(v), (ctrl), 0xf, 0xf, true))
__device__ __forceinline__ unsigned wave_scan_incl(unsigned v, int lane) {
    v += DPP_U0(v, 0x111); v += DPP_U0(v, 0x112); v += DPP_U0(v, 0x114); v += DPP_U0(v, 0x118);
    const unsigned r0 = (unsigned)__builtin_amdgcn_readlane((int)v, 15), r1 = (unsigned)__builtin_amdgcn_readlane((int)v, 31), r2 = (unsigned)__builtin_amdgcn_readlane((int)v, 47);
    const int row = lane >> 4;
    return v + (row >= 1 ? r0 : 0u) + (row >= 2 ? r1 : 0u) + (row >= 3 ? r2 : 0u);
}
__device__ __forceinline__ float sigmoidf_(float x) { return __builtin_amdgcn_rcpf(1.0f + __expf(-x)); }
#define XB_TMO      128
#define XB_XCNT(j)  (256  + 64 * (j))
#define XB_XSUB(j)  (1280 + 64 * (j))
#define XB_XGEN(j)  (2304 + 64 * (j))
#define XB_TOP      3328
#define XB_TOPGEN   3392
#define XCD_BAR_WORDS 3456
#define XB_SPIN_CAP (1u << 18)

__device__ __forceinline__ unsigned xb_ld(unsigned* p)              { return __hip_atomic_load(p, __ATOMIC_RELAXED, __HIP_MEMORY_SCOPE_AGENT); }
__device__ __forceinline__ unsigned xb_add(unsigned* p, unsigned v) { return __hip_atomic_fetch_add(p, v, __ATOMIC_RELAXED, __HIP_MEMORY_SCOPE_AGENT); }
__device__ __forceinline__ unsigned xb_xcc_id() { return (unsigned)__builtin_amdgcn_s_getreg((3 << 11) | 20) & 0xFu; }
#define XB_SPIN(cond, bar) do { unsigned _sp = 0; while (cond) { __builtin_amdgcn_s_sleep(1); \
    if ((++_sp & 255u) == 0u) { if (xb_ld(&(bar)[XB_TMO])) break; if (_sp > XB_SPIN_CAP) { atomicAdd(&(bar)[XB_TMO], 1u); break; } } } } while (0)

struct XcdBarrier {
    unsigned* bar; unsigned x;
    volatile LAS unsigned* st;
};

__device__ __forceinline__ XcdBarrier xcd_barrier_post(unsigned* bar, volatile LAS unsigned* st) {
    XcdBarrier b; b.bar = bar; b.x = xb_xcc_id(); b.st = st;
    if (threadIdx.x == 0) (void)xb_add(&bar[XB_XCNT(b.x)], 1u);
    return b;
}
__device__ __forceinline__ void xcd_barrier_complete(unsigned* bar, unsigned x, unsigned& nloc, unsigned& nx) {
    const unsigned G = gridDim.x * gridDim.y * gridDim.z;
    unsigned sum, cnt, mine, sp = 0u;
    for (;;) {
        sum = 0u; cnt = 0u; mine = 0u;
#pragma unroll
        for (unsigned j = 0; j < 16; ++j) { const unsigned c = xb_ld(&bar[XB_XCNT(j)]); sum += c; cnt += (c > 0u) ? 1u : 0u; mine = (j == x) ? c : mine; }
        if (sum == G) break;
        __builtin_amdgcn_s_sleep(1);
        if ((++sp & 255u) == 0u) { if (xb_ld(&bar[XB_TMO])) break; if (sp > XB_SPIN_CAP) { atomicAdd(&bar[XB_TMO], 1u); break; } }
    }
    nloc = mine > 0u ? mine : 1u; nx = cnt > 0u ? cnt : 1u;
}

__device__ __forceinline__ void xcd_barrier(const XcdBarrier& b) {
    asm volatile("s_waitcnt vmcnt(0)" ::: "memory");
    __syncthreads();
    if (threadIdx.x == 0) {
        unsigned* bar = b.bar;
        __builtin_amdgcn_s_waitcnt(0);
        unsigned nloc = b.st[0], nx = b.st[1];
        if (nloc == 0u) { xcd_barrier_complete(bar, b.x, nloc, nx); b.st[0] = nloc; b.st[1] = nx; }
        const unsigned old = xb_add(&bar[XB_XSUB(b.x)], 1u);
        const unsigned gen = old / nloc;
        if (old + 1u == (gen + 1u) * nloc) {
            __builtin_amdgcn_fence(__ATOMIC_RELEASE, "agent");
            asm volatile("s_waitcnt vmcnt(0)" ::: "memory");
            const unsigned og = xb_add(&bar[XB_TOP], 1u);
            const unsigned tg = og / nx;
            if (og + 1u == (tg + 1u) * nx) xb_add(&bar[XB_TOPGEN], 1u);
            else XB_SPIN(xb_ld(&bar[XB_TOPGEN]) == tg, bar);
            __builtin_amdgcn_fence(__ATOMIC_ACQUIRE, "agent");
            xb_add(&bar[XB_XGEN(b.x)], 1u);
            asm volatile("s_waitcnt vmcnt(0)" ::: "memory");
        } else {
            XB_SPIN(xb_ld(&bar[XB_XGEN(b.x)]) == gen, bar);
            __builtin_amdgcn_fence(__ATOMIC_ACQUIRE, "agent");
            asm volatile("s_waitcnt vmcnt(0)" ::: "memory");
        }
    }
    __syncthreads();
}

struct Frame {
    LAS unsigned char* lds;
    volatile LAS unsigned* MISC;
    gu32* ctl;
    int tid, lane, wave, G;
    const float* in[32];
    float* out;
    unsigned char* ws;
};
#define IN_X 0
#define IN_META 1
#define IN_LNIN_G 2
#define IN_LNIN_B 3
#define IN_W_IN 4
#define IN_QNORM_G 5
#define IN_W_UQ 6
#define IN_KVNORM_G 7
#define IN_W_UKV 8
#define IN_W_IQ 9
#define IN_IDXLN_G 10
#define IN_IDXLN_B 11
#define IN_MU 12
#define IN_W0 13
#define IN_W_DEC 14
#define IN_A0 15
#define IN_W_AAA 16
#define IN_W_GATE 17
#define IN_KK 18
#define IN_KA 19
#define IN_RK 20
#define IN_GN_G 21
#define IN_GN_B 22
#define IN_W_OUT 23
#define IN_LN1_G 24
#define IN_LN1_B 25
#define IN_W_UP 26
#define IN_CONV_W 27
#define IN_CONV_B 28
#define IN_W_DN 29
#define IN_LN2_G 30
#define IN_LN2_B 31

#define WSP(T, off) ((T*)(F.ws + (off)))

__device__ __forceinline__ int key_row(int b, int j) { return j < NMETA ? NREAL + j : b * SEQ + (j - NMETA); }

__device__ __forceinline__ int tr_col(int n, int mode, int cut0, int cut1, int shift) {
    if (mode == 1) { const int pn = n >> 8, x = n & 255; return x < 128 ? 128 * pn + x : DFF + 128 * pn + (x - 128); }
    return n < cut0 ? n : (n < cut1 ? -1 : n - shift);
}
struct TrJob { const float* src; int src_ld, src_r0; bf16* dst; int dst_ld, dst_c0, Nn, K, mode, cut0, cut1, shift; };
__device__ __forceinline__ void tr_item(const TrJob& j, int item, LAS float* scr, int lane) {
    const int nblk = j.Nn / 32, kb = item / nblk, nb = item % nblk, k0 = 64 * kb, n0 = 32 * nb;
    const int col = tr_col(n0 + (lane & 31), j.mode, j.cut0, j.cut1, j.shift);
    const float* sp = j.src + (size_t)(j.src_r0 + k0 + (lane >> 5)) * j.src_ld + (col >= 0 ? col : 0);
    float v[32];
#pragma unroll
    for (int i = 0; i < 32; ++i) v[i] = sp[(size_t)(2 * i) * j.src_ld];
#pragma unroll
    for (int i = 0; i < 32; ++i) scr[(2 * i + (lane >> 5)) * 33 + (lane & 31)] = col >= 0 ? v[i] : 0.f;
    asm volatile("s_waitcnt lgkmcnt(0)" ::: "memory");
    const int c = lane & 7;
#pragma unroll
    for (int q = 0; q < 4; ++q) { const int n = (lane >> 3) + 8 * q; const LAS float* t = scr + (8 * c) * 33 + n;
        *(v4u*)(j.dst + (size_t)(n0 + n) * j.dst_ld + j.dst_c0 + k0 + 8 * c) = (v4u){pk2(t[0], t[33]), pk2(t[66], t[99]), pk2(t[132], t[165]), pk2(t[198], t[231])}; }
    asm volatile("s_waitcnt lgkmcnt(0)" ::: "memory");
}
__device__ __forceinline__ void tr_job(Frame& F, const TrJob& j, int& base, int gw, int NGW) {
    LAS float* scr = (LAS float*)(F.lds + F.wave * 8704);
    const int ni = (j.K / 64) * (j.Nn / 32);
    for (int it = ((gw - base) % NGW + NGW) % NGW; it < ni; it += NGW) tr_item(j, it, scr, F.lane);
    base = (base + ni) % NGW;
}
__device__ __forceinline__ void p0_weights(Frame& F) {
    bf16* WT_IN = WSP(bf16, WS_WT_IN); bf16* WT_QA = WSP(bf16, WS_WT_QA); bf16* WdT = WSP(bf16, WS_WT_LORA);
    const int gw = blockIdx.x * NWAVES + F.wave, NGW = F.G * NWAVES;
    int base = 0;
    tr_job(F, TrJob{F.in[IN_W_IN], 2248, 0, WT_IN, D, 0, PW, D, 0, 456, 512, 56}, base, gw, NGW);
    tr_job(F, TrJob{F.in[IN_W_IQ], 512, 0, WT_QA + (size_t)1024 * 256, 256, 0, 512, 256, 0, 512, 512, 0}, base, gw, NGW);
    tr_job(F, TrJob{F.in[IN_W_GATE], 512, 0, WdT + 2 * 512 * 64, 128, 0, 512, 128, 0, 512, 512, 0}, base, gw, NGW);
    tr_job(F, TrJob{F.in[IN_W_DEC], 512, 0, WdT, 64, 0, 512, 64, 0, 512, 512, 0}, base, gw, NGW);
    tr_job(F, TrJob{F.in[IN_W_AAA], 512, 0, WdT + 512 * 64, 64, 0, 512, 64, 0, 512, 512, 0}, base, gw, NGW);
    const float* w_uq = F.in[IN_W_UQ]; const float* w_ukv = F.in[IN_W_UKV];
    for (int it = blockIdx.x * NTHR + F.tid; it < 256 * 8 * 8; it += F.G * NTHR) {
        const int c = it & 255, hb = __builtin_amdgcn_readfirstlane(it >> 8), h = hb >> 3, j0 = (hb & 7) * 16;
        float acc[16];
#pragma unroll
        for (int jj = 0; jj < 16; ++jj) acc[jj] = 0.f;
        for (int d = 0; d < 64; ++d) {
            const float a = w_uq[(size_t)c * 512 + h * 64 + d];
#pragma unroll
            for (int jj = 0; jj < 16; ++jj) acc[jj] += a * w_ukv[(size_t)(j0 + jj) * 1024 + h * 128 + d];
        }
#pragma unroll
        for (int jj = 0; jj < 16; ++jj) WT_QA[(size_t)(h * 128 + j0 + jj) * 256 + c] = (bf16)f2bf(0.125f * acc[jj]);
    }
}
__device__ __forceinline__ void p0_weights_late(Frame& F, int gw, int NGW) {
    bf16* WT_MIX = WSP(bf16, WS_WT_MIX); bf16* WT_UP = WSP(bf16, WS_WT_UP); bf16* WT_DN = WSP(bf16, WS_WT_DN);
    int base = 0;
    tr_job(F, TrJob{F.in[IN_W_UP], UPW, 0, WT_UP, D, 0, UPW, D, 1, 0, 0, 0}, base, gw, NGW);
    tr_job(F, TrJob{F.in[IN_W_DN], D, 0, WT_DN, DFF, 0, D, DFF, 0, D, D, 0}, base, gw, NGW);
    tr_job(F, TrJob{F.in[IN_W_OUT], D, 512, WT_MIX, 1536, 1024, D, 512, 0, D, D, 0}, base, gw, NGW);
    const float* w_ukv = F.in[IN_W_UKV]; const float* w_out = F.in[IN_W_OUT];
    for (int it = gw * 64 + F.lane; it < 1024 * 8 * 8; it += NGW * 64) {
        const int n = it & 1023, hb = __builtin_amdgcn_readfirstlane(it >> 10), h = hb >> 3, j0 = (hb & 7) * 16;
        float acc[16];
#pragma unroll
        for (int jj = 0; jj < 16; ++jj) acc[jj] = 0.f;
        for (int d = 0; d < 64; ++d) {
            const float a = w_out[(size_t)(h * 64 + d) * D + n];
#pragma unroll
            for (int jj = 0; jj < 16; ++jj) acc[jj] += a * w_ukv[(size_t)(j0 + jj) * 1024 + h * 128 + 64 + d];
        }
        v4u o0, o1;
        o0.x = pk2(acc[0], acc[1]); o0.y = pk2(acc[2], acc[3]); o0.z = pk2(acc[4], acc[5]); o0.w = pk2(acc[6], acc[7]);
        o1.x = pk2(acc[8], acc[9]); o1.y = pk2(acc[10], acc[11]); o1.z = pk2(acc[12], acc[13]); o1.w = pk2(acc[14], acc[15]);
        *(v4u*)(WT_MIX + (size_t)n * 1536 + h * 128 + j0) = o0; *(v4u*)(WT_MIX + (size_t)n * 1536 + h * 128 + j0 + 8) = o1;
    }
}

__device__ __forceinline__ void ln_row_bf16(Frame& F, const float* src, const float* g, const float* b, bf16* dst) {
    v2u* o8 = (v2u*)dst + F.lane;
    if (!src) {
#pragma unroll
        for (int j = 0; j < 4; ++j) o8[64 * j] = (v2u){0u, 0u};
        return;
    }
    const f32x4* xr = (const f32x4*)src + F.lane;
    f32x4 v[4]; float s = 0.f;
#pragma unroll
    for (int j = 0; j < 4; ++j) { v[j] = xr[64 * j]; s += (v[j].x + v[j].y) + (v[j].z + v[j].w); }
    const float mean = wave_sum(s) * (1.f / D); float s2 = 0.f;
#pragma unroll
    for (int j = 0; j < 4; ++j) { v[j] = v[j] - mean; s2 += (v[j].x * v[j].x + v[j].y * v[j].y) + (v[j].z * v[j].z + v[j].w * v[j].w); }
    const float rstd = 1.f / sqrtf(wave_sum(s2) * (1.f / D) + LN_EPS);
#pragma unroll
    for (int j = 0; j < 4; ++j) {
        const f32x4 gg = ((const f32x4*)g)[F.lane + 64 * j], bb = ((const f32x4*)b)[F.lane + 64 * j];
        const f32x4 y = v[j] * rstd * gg + bb;
        o8[64 * j] = (v2u){pk2(y.x, y.y), pk2(y.z, y.w)};
    }
}
__device__ __forceinline__ void p1_ln_in(Frame& F) {
    bf16* H0 = WSP(bf16, WS_H);
    const int gw = blockIdx.x * NWAVES + F.wave, NGW = F.G * NWAVES;
    const f32x4* gp = (const f32x4*)F.in[IN_LNIN_G] + F.lane; const f32x4* bp = (const f32x4*)F.in[IN_LNIN_B] + F.lane;
    f32x4 gg[4], bb[4];
#pragma unroll
    for (int j = 0; j < 4; ++j) { gg[j] = gp[64 * j]; bb[j] = bp[64 * j]; }
    for (int r0 = gw * 4; r0 < NROWS; r0 += NGW * 4) {
        f32x4 v[4][4];
#pragma unroll
        for (int q = 0; q < 4; ++q) {
            const int r = r0 + q < NROWS ? r0 + q : NROWS - 1;
            const f32x4* xr = (const f32x4*)(r < NREAL ? F.in[IN_X] + (size_t)r * D : F.in[IN_META] + (size_t)(r - NREAL) * D) + F.lane;
#pragma unroll
            for (int j = 0; j < 4; ++j) v[q][j] = xr[64 * j];
        }
#pragma unroll
        for (int q = 0; q < 4; ++q) {
            float s = 0.f;
#pragma unroll
            for (int j = 0; j < 4; ++j) s += (v[q][j].x + v[q][j].y) + (v[q][j].z + v[q][j].w);
            const float mean = wave_sum(s) * (1.f / D); float s2 = 0.f;
#pragma unroll
            for (int j = 0; j < 4; ++j) { v[q][j] = v[q][j] - mean; s2 += (v[q][j].x * v[q][j].x + v[q][j].y * v[q][j].y) + (v[q][j].z * v[q][j].z + v[q][j].w * v[q][j].w); }
            const float rstd = 1.f / sqrtf(wave_sum(s2) * (1.f / D) + LN_EPS);
            if (r0 + q < NROWS) {
                v2u* o8 = (v2u*)(H0 + (size_t)(r0 + q) * D) + F.lane;
#pragma unroll
                for (int j = 0; j < 4; ++j) { const f32x4 y = v[q][j] * rstd * gg[j] + bb[j]; o8[64 * j] = (v2u){pk2(y.x, y.y), pk2(y.z, y.w)}; }
            }
        }
    }
}

__device__ __forceinline__ void p3_prep(Frame& F) {
    const bf16* P = WSP(bf16, WS_P); bf16* CQN = WSP(bf16, WS_CQN); bf16* CKV = WSP(bf16, WS_CKV); bf16* KIDX = WSP(bf16, WS_KIDX); float* WIDX = WSP(float, WS_WIDX);
    const int gw = blockIdx.x * NWAVES + F.wave, NGW = F.G * NWAVES, l = F.lane;
    for (int r = gw; r < R; r += NGW) {
        const bf16* pr = P + (size_t)r * PW;
        if (r >= NROWS) {
            *(v2u*)(CQN + (size_t)r * 256 + 4 * l) = (v2u){0u, 0u};
            continue;
        }
        {
            const v2u w = *(const v2u*)(pr + PC_CQ + 4 * l);
            const float a0 = bflo(w.x), a1 = bfhi(w.x), a2 = bflo(w.y), a3 = bfhi(w.y);
            const float ss = wave_sum(a0 * a0 + a1 * a1 + a2 * a2 + a3 * a3);
            const float rs = 1.0f / sqrtf(ss * (1.f / 256.f) + 1e-6f);
            const f32x4 g = ((const f32x4*)F.in[IN_QNORM_G])[l];
            *(v2u*)(CQN + (size_t)r * 256 + 4 * l) = (v2u){pk2(a0 * rs * g.x, a1 * rs * g.y), pk2(a2 * rs * g.z, a3 * rs * g.w)};
        }
        {
            const unsigned w = *(const unsigned*)(pr + PC_CKV + 2 * l);
            const float a0 = bflo(w), a1 = bfhi(w);
            const float ss = wave_sum(a0 * a0 + a1 * a1);
            const float rs = 1.0f / sqrtf(ss * (1.f / 128.f) + 1e-6f);
            const float g0 = F.in[IN_KVNORM_G][2 * l], g1 = F.in[IN_KVNORM_G][2 * l + 1];
            *(unsigned*)(CKV + (size_t)r * 128 + 2 * l) = pk2(a0 * rs * g0, a1 * rs * g1);
        }
        {
            const float a = bf2f(pr[PC_KIDX + l]);
            const float mean = wave_sum(a) * (1.f / 64.f);
            const float dlt = a - mean;
            const float var = wave_sum(dlt * dlt) * (1.f / 64.f);
            const float y = dlt * (1.0f / sqrtf(var + LN_EPS)) * F.in[IN_IDXLN_G][l] + F.in[IN_IDXLN_B][l];
            KIDX[(size_t)r * 64 + l] = (bf16)f2bf(y);
        }
        if (l < 8) WIDX[(size_t)r * 8 + l] = bf2f(pr[PC_WIDX + l]) * 0.04419417382415922f;
    }
}

#ifndef REFSEL
#define REFSEL 0
#endif
__device__ __forceinline__ void refsel_rows(Frame& F) {
    float* QIDX32 = F.out; float* KIDX32 = F.out + (size_t)R * 512; float* WIDX = WSP(float, WS_WIDX);
    const float* w_in = F.in[IN_W_IN]; const float* w_iq = F.in[IN_W_IQ];
    LAS float* hrow = (LAS float*)(F.lds + F.wave * 8192);
    LAS float* cqn = hrow + 1024;
    const int l = F.lane;
    const int gw = blockIdx.x * NWAVES + F.wave, NGW = F.G * NWAVES;
    for (int r = gw; r < NROWS; r += NGW) {
        const float* src = r < NREAL ? F.in[IN_X] + (size_t)r * D : F.in[IN_META] + (size_t)(r - NREAL) * D;
        {
            const f32x4* xr = (const f32x4*)src + l;
            f32x4 v[4]; float s = 0.f;
#pragma unroll
            for (int j = 0; j < 4; ++j) { v[j] = xr[64 * j]; s += (v[j].x + v[j].y) + (v[j].z + v[j].w); }
            const float mean = wave_sum(s) * (1.f / D); float s2 = 0.f;
#pragma unroll
            for (int j = 0; j < 4; ++j) { v[j] = v[j] - mean; s2 += (v[j].x * v[j].x + v[j].y * v[j].y) + (v[j].z * v[j].z + v[j].w * v[j].w); }
            const float rstd = 1.f / sqrtf(wave_sum(s2) * (1.f / D) + LN_EPS);
#pragma unroll
            for (int j = 0; j < 4; ++j) {
                const f32x4 gg = ((const f32x4*)F.in[IN_LNIN_G])[l + 64 * j], bb = ((const f32x4*)F.in[IN_LNIN_B])[l + 64 * j];
                *(LAS f32x4*)(hrow + 4 * (l + 64 * j)) = v[j] * rstd * gg + bb;
            }
        }
        __builtin_amdgcn_wave_barrier();
        float a[6];
#pragma unroll
        for (int i = 0; i < 6; ++i) a[i] = 0.f;
        for (int k = 0; k < D; ++k) {
            const float hk = hrow[k]; const float* wr = w_in + (size_t)k * 2248;
#pragma unroll
            for (int i = 0; i < 4; ++i) a[i] += hk * wr[l + 64 * i];
            a[4] += hk * wr[384 + l];
            a[5] += hk * wr[448 + (l & 7)];
        }
        const float ss = wave_sum(a[0] * a[0] + a[1] * a[1] + a[2] * a[2] + a[3] * a[3]);
        const float rs = 1.0f / sqrtf(ss * (1.f / 256.f) + 1e-6f);
#pragma unroll
        for (int i = 0; i < 4; ++i) cqn[l + 64 * i] = a[i] * rs * F.in[IN_QNORM_G][l + 64 * i];
        {
            const float mean = wave_sum(a[4]) * (1.f / 64.f); const float dlt = a[4] - mean;
            const float var = wave_sum(dlt * dlt) * (1.f / 64.f);
            KIDX32[(size_t)r * 64 + l] = dlt * (1.0f / sqrtf(var + LN_EPS)) * F.in[IN_IDXLN_G][l] + F.in[IN_IDXLN_B][l];
        }
        if (l < 8) WIDX[(size_t)r * 8 + l] = a[5] * 0.04419417382415922f;
        __builtin_amdgcn_wave_barrier();
        float q[8];
#pragma unroll
        for (int i = 0; i < 8; ++i) q[i] = 0.f;
        for (int c = 0; c < 256; ++c) {
            const float cq = cqn[c]; const float* wr = w_iq + (size_t)c * 512;
#pragma unroll
            for (int i = 0; i < 8; ++i) q[i] += cq * wr[l + 64 * i];
        }
#pragma unroll
        for (int i = 0; i < 8; ++i) QIDX32[(size_t)r * 512 + l + 64 * i] = q[i];
        __builtin_amdgcn_wave_barrier();
    }
}

__device__ __forceinline__ unsigned sortable(float f) { const unsigned u = __float_as_uint(f); return (u & 0x80000000u) ? ~u : (u | 0x80000000u); }
__device__ __forceinline__ void p5_index_naive(Frame& F) {
    const bf16* QA = WSP(bf16, WS_QA); const bf16* KIDX = WSP(bf16, WS_KIDX); const float* WIDX = WSP(float, WS_WIDX);
    unsigned short* SEL = WSP(unsigned short, WS_SEL); int* NSEL = WSP(int, WS_NSEL);
    LAS float* sc = (LAS float*)(F.lds);
    LAS float* qf = (LAS float*)(F.lds + 33024);
    LAS unsigned* hist = (LAS unsigned*)(F.lds + 33024 + 2048);
    LAS unsigned* cw = hist + 256;
    const int tid = F.tid;
    for (int q = blockIdx.x; q < NROWS; q += F.G) {
        int b, pos; if (q < NREAL) { b = q >> 13; pos = NMETA + (q & (SEQ - 1)); } else { b = 0; pos = q - NREAL; }
        const int nvis = pos < NMETA ? NMETA : NMETA + 64 * ((pos - NMETA) / 64 + 1);
#if REFSEL
        qf[tid] = F.out[(size_t)q * 512 + tid];
#else
        qf[tid] = bf2f(QA[(size_t)q * QAW + 1024 + tid]);
#endif
        float w[8];
#pragma unroll
        for (int h = 0; h < 8; ++h) w[h] = WIDX[(size_t)q * 8 + h];
        __syncthreads();
        for (int j = tid; j < nvis; j += NTHR) {
            const v4u* kp = (const v4u*)(KIDX + (size_t)key_row(b, j) * 64);
#if REFSEL
            const f32x4* kp32 = (const f32x4*)(F.out + (size_t)R * 512 + (size_t)key_row(b, j) * 64);
#endif
            float d[8];
#pragma unroll
            for (int h = 0; h < 8; ++h) d[h] = 0.f;
#pragma unroll 2
            for (int c = 0; c < 8; ++c) {
#if REFSEL
                const f32x4 ta = kp32[2 * c], tb = kp32[2 * c + 1];
                const float k0 = ta.x, k1 = ta.y, k2 = ta.z, k3 = ta.w, k4 = tb.x, k5 = tb.y, k6 = tb.z, k7 = tb.w;
#else
                const v4u t = kp[c];
                const float k0 = bflo(t.x), k1 = bfhi(t.x), k2 = bflo(t.y), k3 = bfhi(t.y), k4 = bflo(t.z), k5 = bfhi(t.z), k6 = bflo(t.w), k7 = bfhi(t.w);
#endif
#pragma unroll
                for (int h = 0; h < 8; ++h) {
                    const f32x4 qa = *(const LAS f32x4*)(qf + h * 64 + 8 * c), qb = *(const LAS f32x4*)(qf + h * 64 + 8 * c + 4);
                    d[h] += qa.x * k0 + qa.y * k1 + qa.z * k2 + qa.w * k3 + qb.x * k4 + qb.y * k5 + qb.z * k6 + qb.w * k7;
                }
            }
            float s = 0.f;
#pragma unroll
            for (int h = 0; h < 8; ++h) s += w[h] * fmaxf(d[h], 0.f);
            sc[j] = s + 0.0f;
        }
        __syncthreads();
        unsigned short* selq = SEL + (size_t)q * TOPK;
        if (nvis <= TOPK) {
            for (int j = tid; j < nvis; j += NTHR) selq[j] = (unsigned short)j;
        } else {
            unsigned prefix = 0u, mask = 0u, need = TOPK;
            for (int pass = 0; pass < 4; ++pass) {
                const int shift = 24 - 8 * pass;
                if (tid < 256) hist[tid] = 0u;
                __syncthreads();
                for (int j = tid; j < nvis; j += NTHR) { const unsigned key = sortable(sc[j]); if ((key & mask) == prefix) atomicAdd((unsigned*)&hist[(key >> shift) & 255u], 1u); }
                __syncthreads();
                if (tid < 256) {
                    unsigned above = 0u; for (int bb = tid + 1; bb < 256; ++bb) above += hist[bb];
                    const unsigned c = hist[tid];
                    if (above < need && need <= above + c) { cw[0] = prefix | ((unsigned)tid << shift); cw[1] = need - above; }
                }
                __syncthreads();
                prefix = cw[0]; need = cw[1]; mask |= 0xFFu << shift;
                __syncthreads();
            }
            if (tid == 0) cw[2] = 0u;
            __syncthreads();
            for (int j = tid; j < nvis; j += NTHR) { if (sortable(sc[j]) > prefix) { const unsigned p = atomicAdd((unsigned*)&cw[2], 1u); selq[p] = (unsigned short)j; } }
            __syncthreads();
            if (F.wave == 0) {
                const unsigned base = cw[2]; unsigned taken = 0u;
                for (int j0 = 0; j0 < nvis && taken < need; j0 += 64) {
                    const int j = j0 + F.lane; const bool eq = j < nvis && sortable(sc[j]) == prefix;
                    const unsigned long long m = __ballot(eq);
                    const unsigned rank = (unsigned)__popcll(m & ((1ull << F.lane) - 1ull));
                    if (eq && taken + rank < need) selq[base + taken + rank] = (unsigned short)j;
                    taken += (unsigned)__popcll(m);
                }
            }
        }
        if (tid == 0) NSEL[q] = nvis < TOPK ? nvis : TOPK;
        __syncthreads();
    }
}

__device__ __forceinline__ void p6_attn_naive(Frame& F) {
    bf16* QA = WSP(bf16, WS_QA); const bf16* CKV = WSP(bf16, WS_CKV); const unsigned short* SEL = WSP(unsigned short, WS_SEL); const int* NSEL = WSP(int, WS_NSEL);
    LAS float* qf = (LAS float*)(F.lds + F.wave * 16384);
    LAS float* ps = qf + 1024;
    LAS int* srow = (LAS int*)(ps + 2048);
    const int l = F.lane;
    const int gw = blockIdx.x * NWAVES + F.wave, NGW = F.G * NWAVES;
    for (int q = gw; q < R; q += NGW) {
        bf16* qrow = QA + (size_t)q * QAW;
        if (q >= NROWS) {
            for (int c = l; c < QAW / 8; c += 64) *(v4u*)(qrow + 8 * c) = (v4u){0u, 0u, 0u, 0u};
            continue;
        }
        int b, pos; if (q < NREAL) { b = q >> 13; pos = NMETA + (q & (SEQ - 1)); } else { b = 0; pos = q - NREAL; }
        const int nsel = NSEL[q];
        {
            const v4u t0 = *(const v4u*)(qrow + 16 * l), t1 = *(const v4u*)(qrow + 16 * l + 8);
            LAS float* d = qf + 16 * l;
            d[0] = bflo(t0.x); d[1] = bfhi(t0.x); d[2] = bflo(t0.y); d[3] = bfhi(t0.y); d[4] = bflo(t0.z); d[5] = bfhi(t0.z); d[6] = bflo(t0.w); d[7] = bfhi(t0.w);
            d[8] = bflo(t1.x); d[9] = bfhi(t1.x); d[10] = bflo(t1.y); d[11] = bfhi(t1.y); d[12] = bflo(t1.z); d[13] = bfhi(t1.z); d[14] = bflo(t1.w); d[15] = bfhi(t1.w);
        }
        __builtin_amdgcn_wave_barrier();
        for (int kk = 0; kk < 4; ++kk) {
            const int s = kk * 64 + l; const bool valid = s < nsel;
            const int j = valid ? (int)SEL[(size_t)q * TOPK + s] : 0;
            const int row = key_row(b, j);
            srow[s] = row;
            float acc[8];
#pragma unroll
            for (int h = 0; h < 8; ++h) acc[h] = 0.f;
            const v4u* kp = (const v4u*)(CKV + (size_t)row * 128);
            for (int c8 = 0; c8 < 16; ++c8) {
                const v4u t = kp[c8];
                const float k0 = bflo(t.x), k1 = bfhi(t.x), k2 = bflo(t.y), k3 = bfhi(t.y), k4 = bflo(t.z), k5 = bfhi(t.z), k6 = bflo(t.w), k7 = bfhi(t.w);
#pragma unroll
                for (int h = 0; h < 8; ++h) {
                    const f32x4 qa = *(const LAS f32x4*)(qf + h * 128 + 8 * c8), qb = *(const LAS f32x4*)(qf + h * 128 + 8 * c8 + 4);
                    acc[h] += qa.x * k0 + qa.y * k1 + qa.z * k2 + qa.w * k3 + qb.x * k4 + qb.y * k5 + qb.z * k6 + qb.w * k7;
                }
            }
            const float dist = fabsf((float)(pos - j));
#pragma unroll
            for (int h = 0; h < 8; ++h) { const float slope = __uint_as_float((unsigned)(127 - (h + 1)) << 23); ps[s * 8 + h] = valid ? acc[h] - slope * dist : -INFINITY; }
        }
        __builtin_amdgcn_wave_barrier();
#pragma unroll
        for (int h = 0; h < 8; ++h) {
            float v0 = ps[(l) * 8 + h], v1 = ps[(l + 64) * 8 + h], v2 = ps[(l + 128) * 8 + h], v3 = ps[(l + 192) * 8 + h];
            const float mx = wave_max(fmaxf(fmaxf(v0, v1), fmaxf(v2, v3)));
            v0 = __expf(v0 - mx); v1 = __expf(v1 - mx); v2 = __expf(v2 - mx); v3 = __expf(v3 - mx);
            const float inv = 1.0f / wave_sum((v0 + v1) + (v2 + v3));
            ps[(l) * 8 + h] = v0 * inv; ps[(l + 64) * 8 + h] = v1 * inv; ps[(l + 128) * 8 + h] = v2 * inv; ps[(l + 192) * 8 + h] = v3 * inv;
        }
        __builtin_amdgcn_wave_barrier();
        float o0[8], o1[8];
#pragma unroll
        for (int h = 0; h < 8; ++h) { o0[h] = 0.f; o1[h] = 0.f; }
        for (int s = 0; s < nsel; ++s) {
            const int row = srow[s];
            const unsigned w = *(const unsigned*)(CKV + (size_t)row * 128 + 2 * l);
            const float c0 = bflo(w), c1 = bfhi(w);
            const f32x4 pa = *(const LAS f32x4*)(ps + s * 8), pb = *(const LAS f32x4*)(ps + s * 8 + 4);
            o0[0] += pa.x * c0; o1[0] += pa.x * c1; o0[1] += pa.y * c0; o1[1] += pa.y * c1; o0[2] += pa.z * c0; o1[2] += pa.z * c1; o0[3] += pa.w * c0; o1[3] += pa.w * c1;
            o0[4] += pb.x * c0; o1[4] += pb.x * c1; o0[5] += pb.y * c0; o1[5] += pb.y * c1; o0[6] += pb.z * c0; o1[6] += pb.z * c1; o0[7] += pb.w * c0; o1[7] += pb.w * c1;
        }
#pragma unroll
        for (int h = 0; h < 8; ++h) *(unsigned*)(qrow + h * 128 + 2 * l) = pk2(o0[h], o1[h]);
        __builtin_amdgcn_wave_barrier();
    }
}

__device__ __forceinline__ void p7_rwkv_prep_naive(Frame& F) {
    const bf16* P = WSP(bf16, WS_P); float* DEC = WSP(float, WS_DEC); bf16* AB = WSP(bf16, WS_AB); bf16* GB = WSP(bf16, WS_GB);
    const float* mu = F.in[IN_MU]; const float* Wd = F.in[IN_W_DEC]; const float* Wa = F.in[IN_W_AAA]; const float* Wg = F.in[IN_W_GATE];
    const int l = F.lane;
    const int gw = blockIdx.x * NWAVES + F.wave, NGW = F.G * NWAVES;
    for (int r = gw; r < NROWS; r += NGW) {
        int prev; if (r < NREAL) { prev = (r & (SEQ - 1)) ? r - 1 : NREAL + NMETA - 1; } else { prev = r > NREAL ? r - 1 : -1; }
        const bf16* pr = P + (size_t)r * PW; const bf16* pp = prev >= 0 ? P + (size_t)prev * PW : nullptr;
#define SHIFTED(pc, mc) (bf2f(pr[pc]) + ((pp ? bf2f(pp[pc]) : 0.f) - bf2f(pr[pc])) * mu[mc])
        const float tw = tanhf(SHIFTED(PC_WD + l, 1536 + l));
        const float ta = SHIFTED(PC_AD + l, 1600 + l);
        const float tg0 = sigmoidf_(SHIFTED(PC_GD + l, 1664 + l)), tg1 = sigmoidf_(SHIFTED(PC_GD + 64 + l, 1728 + l));
#undef SHIFTED
        float aw[8], aa[8], ag[8];
#pragma unroll
        for (int i = 0; i < 8; ++i) { aw[i] = F.in[IN_W0][l + 64 * i]; aa[i] = F.in[IN_A0][l + 64 * i]; ag[i] = 0.f; }
        for (int j = 0; j < 64; ++j) {
            const float xw = __shfl(tw, j), xa = __shfl(ta, j), xg0 = __shfl(tg0, j), xg1 = __shfl(tg1, j);
#pragma unroll
            for (int i = 0; i < 8; ++i) {
                aw[i] += xw * Wd[(size_t)j * 512 + l + 64 * i];
                aa[i] += xa * Wa[(size_t)j * 512 + l + 64 * i];
                ag[i] += xg0 * Wg[(size_t)j * 512 + l + 64 * i] + xg1 * Wg[(size_t)(j + 64) * 512 + l + 64 * i];
            }
        }
#pragma unroll
        for (int i = 0; i < 8; ++i) {
            const float x = -aw[i];
            const float sp = x > 20.f ? x : log1pf(__expf(x));
            const float wlog = -sp - 0.5f;
            DEC[(size_t)r * 512 + l + 64 * i] = __expf(-__expf(wlog));
            AB[(size_t)r * 512 + l + 64 * i] = (bf16)f2bf(sigmoidf_(aa[i]));
            GB[(size_t)r * 512 + l + 64 * i] = (bf16)f2bf(ag[i]);
        }
    }
}

__device__ __forceinline__ void p8_rwkv_scan_naive(Frame& F) {
    if (F.wave != 0 || blockIdx.x >= 32) return;
    const bf16* P = WSP(bf16, WS_P); const float* DEC = WSP(float, WS_DEC); const bf16* AB = WSP(bf16, WS_AB); const bf16* GB = WSP(bf16, WS_GB); bf16* QA = WSP(bf16, WS_QA);
    const int b = blockIdx.x >> 3, h = blockIdx.x & 7, l = F.lane, ch = h * 64 + l;
    LAS float* vec = (LAS float*)F.lds;
    const float mu_r = F.in[IN_MU][ch], mu_k = F.in[IN_MU][512 + ch], mu_v = F.in[IN_MU][1024 + ch];
    const float kk_c = F.in[IN_KK][ch], ka_c = F.in[IN_KA][ch], rk_c = F.in[IN_RK][ch], gng = F.in[IN_GN_G][ch], gnb = F.in[IN_GN_B][ch];
    float S[64];
#pragma unroll
    for (int k = 0; k < 64; ++k) S[k] = 0.f;
    float pr_p = 0.f, pk_p = 0.f, pv_p = 0.f;
    int row = key_row(b, 0);
    float n_pr = bf2f(P[(size_t)row * PW + PC_R + ch]), n_pk = bf2f(P[(size_t)row * PW + PC_K + ch]), n_pv = bf2f(P[(size_t)row * PW + PC_V + ch]);
    float n_w = DEC[(size_t)row * 512 + ch], n_a = bf2f(AB[(size_t)row * 512 + ch]), n_g = bf2f(GB[(size_t)row * 512 + ch]);
    for (int pos = 0; pos < TT; ++pos) {
        const int crow = row;
        const float c_pr = n_pr, c_pk = n_pk, c_pv = n_pv, c_w = n_w, c_a = n_a, c_g = n_g;
        if (pos + 1 < TT) {
            row = key_row(b, pos + 1);
            n_pr = bf2f(P[(size_t)row * PW + PC_R + ch]); n_pk = bf2f(P[(size_t)row * PW + PC_K + ch]); n_pv = bf2f(P[(size_t)row * PW + PC_V + ch]);
            n_w = DEC[(size_t)row * 512 + ch]; n_a = bf2f(AB[(size_t)row * 512 + ch]); n_g = bf2f(GB[(size_t)row * 512 + ch]);
        }
        const float r_s = c_pr + (pr_p - c_pr) * mu_r, k_s = c_pk + (pk_p - c_pk) * mu_k, v_s = c_pv + (pv_p - c_pv) * mu_v;
        pr_p = c_pr; pk_p = c_pk; pv_p = c_pv;
        const float kkr = k_s * kk_c;
        const float nrm = sqrtf(wave_sum(kkr * kkr));
        const float kk = kkr / fmaxf(nrm, 1e-12f);
        const float k2 = k_s * (1.f + (c_a - 1.f) * ka_c);
        vec[l] = -kk; vec[64 + l] = kk * c_a; vec[128 + l] = c_w; vec[192 + l] = k2; vec[256 + l] = r_s;
        __builtin_amdgcn_wave_barrier();
        float sa = 0.f;
#pragma unroll
        for (int k4 = 0; k4 < 16; ++k4) { const f32x4 a = *(const LAS f32x4*)(vec + 4 * k4); sa += S[4 * k4] * a.x + S[4 * k4 + 1] * a.y + S[4 * k4 + 2] * a.z + S[4 * k4 + 3] * a.w; }
        float y = 0.f;
#pragma unroll
        for (int k4 = 0; k4 < 16; ++k4) {
            const f32x4 bv = *(const LAS f32x4*)(vec + 64 + 4 * k4), w = *(const LAS f32x4*)(vec + 128 + 4 * k4), kv = *(const LAS f32x4*)(vec + 192 + 4 * k4), rv = *(const LAS f32x4*)(vec + 256 + 4 * k4);
            S[4 * k4] = S[4 * k4] * w.x + sa * bv.x + v_s * kv.x; S[4 * k4 + 1] = S[4 * k4 + 1] * w.y + sa * bv.y + v_s * kv.y;
            S[4 * k4 + 2] = S[4 * k4 + 2] * w.z + sa * bv.z + v_s * kv.z; S[4 * k4 + 3] = S[4 * k4 + 3] * w.w + sa * bv.w + v_s * kv.w;
            y += S[4 * k4] * rv.x + S[4 * k4 + 1] * rv.y + S[4 * k4 + 2] * rv.z + S[4 * k4 + 3] * rv.w;
        }
        __builtin_amdgcn_wave_barrier();
        const float mean = wave_sum(y) * (1.f / 64.f);
        const float dlt = y - mean;
        const float var = wave_sum(dlt * dlt) * (1.f / 64.f);
        const float yn = dlt * (1.0f / sqrtf(var + GN_EPS)) * gng + gnb;
        const float bonus = wave_sum(r_s * k2 * rk_c) * v_s;
        const float o = (yn + bonus) * c_g;
        if (pos >= NMETA || b == 0) QA[(size_t)crow * QAW + 1024 + ch] = (bf16)f2bf(o);
    }
}

template <bool OUT_BF16>
__device__ __forceinline__ void ln_rows4(Frame& F, int nrows, const float* g, const float* b, bf16* dstb) {
    const int gw = blockIdx.x * NWAVES + F.wave, NGW = F.G * NWAVES;
    const float* META1 = WSP(float, WS_META1);
    f32x4 gg[4], bb[4];
#pragma unroll
    for (int j = 0; j < 4; ++j) { gg[j] = ((const f32x4*)g)[F.lane + 64 * j]; bb[j] = ((const f32x4*)b)[F.lane + 64 * j]; }
    for (int r0 = gw * 4; r0 < nrows; r0 += NGW * 4) {
        f32x4 v[4][4];
#pragma unroll
        for (int q = 0; q < 4; ++q) {
            const int r = r0 + q < nrows ? r0 + q : nrows - 1;
            const f32x4* xr = (const f32x4*)(r < NREAL ? F.out + (size_t)r * D : META1 + (size_t)(r - NREAL) * D) + F.lane;
#pragma unroll
            for (int j = 0; j < 4; ++j) v[q][j] = xr[64 * j];
        }
#pragma unroll
        for (int q = 0; q < 4; ++q) {
            float s = 0.f;
#pragma unroll
            for (int j = 0; j < 4; ++j) s += (v[q][j].x + v[q][j].y) + (v[q][j].z + v[q][j].w);
            const float mean = wave_sum(s) * (1.f / D); float s2 = 0.f;
#pragma unroll
            for (int j = 0; j < 4; ++j) { v[q][j] = v[q][j] - mean; s2 += (v[q][j].x * v[q][j].x + v[q][j].y * v[q][j].y) + (v[q][j].z * v[q][j].z + v[q][j].w * v[q][j].w); }
            const float rstd = 1.f / sqrtf(wave_sum(s2) * (1.f / D) + LN_EPS);
            if (r0 + q < nrows) {
                if (OUT_BF16) { v2u* o8 = (v2u*)(dstb + (size_t)(r0 + q) * D) + F.lane;
#pragma unroll
                    for (int j = 0; j < 4; ++j) { const f32x4 y = v[q][j] * rstd * gg[j] + bb[j]; o8[64 * j] = (v2u){pk2(y.x, y.y), pk2(y.z, y.w)}; }
                } else { f32x4* o = (f32x4*)(F.out + (size_t)(r0 + q) * D) + F.lane;
#pragma unroll
                    for (int j = 0; j < 4; ++j) o[64 * j] = v[q][j] * rstd * gg[j] + bb[j]; }
            }
        }
    }
}
__device__ __forceinline__ void p10_ln1(Frame& F) { ln_rows4<true>(F, NROWS, F.in[IN_LN1_G], F.in[IN_LN1_B], WSP(bf16, WS_H)); }
__device__ __forceinline__ void p14_ln2(Frame& F) { ln_rows4<false>(F, NREAL, F.in[IN_LN2_G], F.in[IN_LN2_B], nullptr); }

__device__ __forceinline__ float gelu_fast(float x) {
    const float u2 = x * (1.5957691216057308f + 0.07135481627260025f * x * x);
    return x * __builtin_amdgcn_rcpf(1.0f + __builtin_amdgcn_exp2f(-1.4426950408889634f * u2));
}
__device__ __forceinline__ void p12_conv_fix(Frame& F) {
    bf16* ACT = WSP(bf16, WS_UP); const float* cw = F.in[IN_CONV_W]; const float* cb = F.in[IN_CONV_B];
    const float* G01 = WSP(float, WS_G01); const float* V01 = WSP(float, WS_V01); const float* GHALO = WSP(float, WS_GHALO); const float* GMETA = WSP(float, WS_GMETA);
    for (int it = blockIdx.x * NTHR + F.tid; it < 128 * 2 * DFF; it += F.G * NTHR) {
        const int j = it % DFF, rr = (it / DFF) & 1, pm = it / (2 * DFF);
        const float* ph = (pm & 31) ? GHALO + (size_t)(pm - 1) * 2 * DFF : GMETA;
        const float g0 = G01[((size_t)pm * 2 + rr) * DFF + j];
        const float g1 = rr ? G01[((size_t)pm * 2) * DFF + j] : ph[DFF + j];
        const float g2 = rr ? ph[DFF + j] : ph[j];
        const float x = cw[j] * g2 + cw[DFF + j] * g1 + cw[2 * DFF + j] * g0 + cb[j];
        ACT[(size_t)(pm * 256 + rr) * DFF + j] = (bf16)f2bf(gelu_fast(x) * V01[((size_t)pm * 2 + rr) * DFF + j]);
    }
}


constexpr int NUNITS = 4096 + 8;
constexpr int RP = 72;
constexpr int SLOT = 64 * RP * 2;
constexpr int FP = 68;
typedef short bf16x8 __attribute__((ext_vector_type(8)));
typedef float f32x16 __attribute__((ext_vector_type(16)));
constexpr size_t RW_MAT = (size_t)NUNITS * 4096;

__device__ __forceinline__ void quad_mma(f32x16& acc, const LAS bf16* Aop, const LAS bf16* Bop, int qr, int qc, int lane) {
    const int r = lane & 31, hf = lane >> 5;
    const LAS bf16* ap = Aop + (32 * qr + r) * RP + 8 * hf; const LAS bf16* bp = Bop + (32 * qc + r) * RP + 8 * hf;
#pragma unroll
    for (int ks = 0; ks < 4; ++ks) {
        const bf16x8 a = *(const LAS bf16x8*)(ap + 16 * ks), b = *(const LAS bf16x8*)(bp + 16 * ks);
        acc = __builtin_amdgcn_mfma_f32_32x32x16_bf16(a, b, acc, 0, 0, 0);
    }
}
#define ACC_M(qr, j, hf) (32 * (qr) + ((j) & 3) + 8 * ((j) >> 2) + 4 * (hf))
__device__ __forceinline__ void store_T(const f32x16& acc, LAS bf16* Z, int qr, int qc, int lane) {
    const int r = lane & 31, hf = lane >> 5;
#pragma unroll
    for (int jj = 0; jj < 4; ++jj)
        *(LAS v2u*)(Z + (32 * qc + r) * RP + 32 * qr + 8 * jj + 4 * hf) = (v2u){pk2(acc[4 * jj], acc[4 * jj + 1]), pk2(acc[4 * jj + 2], acc[4 * jj + 3])};
}
__device__ __forceinline__ void add_T(f32x16& acc, const LAS bf16* Z, int qr, int qc, int lane) {
    const int r = lane & 31, hf = lane >> 5;
#pragma unroll
    for (int jj = 0; jj < 4; ++jj) {
        const v2u w = *(const LAS v2u*)(Z + (32 * qc + r) * RP + 32 * qr + 8 * jj + 4 * hf);
        acc[4 * jj] += bflo(w.x); acc[4 * jj + 1] += bfhi(w.x); acc[4 * jj + 2] += bflo(w.y); acc[4 * jj + 3] += bfhi(w.y);
    }
}
__device__ __forceinline__ int frag_off(int n, int m) { return (((m >> 4) * 2 + ((m >> 3) & 1)) * 64 + n) * 8 + (m & 7); }
__device__ __forceinline__ int acc_off(int n, int m) { return ((((m >> 5) * 4 + ((m >> 3) & 3)) * 2 + ((m >> 2) & 1)) * 64 + n) * 4 + (m & 3); }
template <bool FRAG>
__device__ __forceinline__ void store_T_global(const f32x16& acc, bf16* Z, int qr, int qc, int lane) {
    const int r = lane & 31, hf = lane >> 5;
#pragma unroll
    for (int jj = 0; jj < 4; ++jj) { const int n = 32 * qc + r, m0 = 32 * qr + 8 * jj + 4 * hf;
        *(v2u*)(Z + (FRAG ? frag_off(n, m0) : acc_off(n, m0))) = (v2u){pk2(acc[4 * jj], acc[4 * jj + 1]), pk2(acc[4 * jj + 2], acc[4 * jj + 3])}; }
}
__device__ __forceinline__ f32x16 zero16() { f32x16 z;
#pragma unroll
    for (int j = 0; j < 16; ++j) z[j] = 0.f;
    return z; }

__device__ __forceinline__ void b1_load_raw(const bf16* P, int u, int w, int l, unsigned short (&rv)[45]) {
    const bool meta = u >= 4096;
    int b = 0, h, c = 0; if (meta) h = u - 4096; else { b = u >> 10; h = (u >> 7) & 7; c = u & 127; }
    const int ch = h * 64 + l, row0 = meta ? NREAL : b * SEQ + c * 64, t0 = 8 * w;
    int prow = -1;
    if (t0 > 0) prow = row0 + t0 - 1; else if (!meta) prow = (c == 0) ? NREAL + NMETA - 1 : row0 - 1;
#pragma unroll
    for (int i = 0; i < 9; ++i) {
        const int t = t0 - 1 + i;
        const int row = i == 0 ? prow : ((!meta || t < NMETA) ? row0 + t : -1);
        const bf16* pp = P + (size_t)(row >= 0 ? row : 0) * PW;
        const unsigned short a0 = pp[PC_R + ch], a1 = pp[PC_K + ch], a2 = pp[PC_V + ch], a3 = pp[PC_WD + l], a4 = pp[PC_AD + l];
        const bool ok = row >= 0;
        rv[5 * i] = ok ? a0 : (unsigned short)0; rv[5 * i + 1] = ok ? a1 : (unsigned short)0; rv[5 * i + 2] = ok ? a2 : (unsigned short)0; rv[5 * i + 3] = ok ? a3 : (unsigned short)0; rv[5 * i + 4] = ok ? a4 : (unsigned short)0;
    }
}

#define LDS_BARRIER() do { asm volatile("s_waitcnt lgkmcnt(0)" ::: "memory"); __builtin_amdgcn_s_barrier(); asm volatile("" ::: "memory"); } while (0)
#ifdef PROBE_B1SEC
#define B1T(k) do { if (blockIdx.x == 0 && F.tid == 0) { const unsigned long long t_ = __builtin_amdgcn_s_memrealtime(); if ((k) == PROBE_B1SEC + 1) b1acc += t_ - b1t0; b1t0 = t_; } } while (0)
#else
#define B1T(k) do {} while (0)
#endif
__device__ __forceinline__ void rw_b1(Frame& F) {
    const bf16* P = WSP(bf16, WS_P);
    bf16* RWM = WSP(bf16, WS_RWM); bf16* RWN = WSP(bf16, WS_RWN); bf16* RWQ = WSP(bf16, WS_RWQ); bf16* RWY = WSP(bf16, WS_RWY);
    float* BONUS = (float*)((char*)F.out + OUT_BONUS);
    const bf16* WdT = WSP(bf16, WS_WT_LORA); const bf16* WaT = WdT + 512 * 64;
    const float* mu = F.in[IN_MU];
    const int w = F.wave, l = F.lane, tid = F.tid;
    LAS unsigned char* L = F.lds;
#define SL(s) ((LAS bf16*)(L + (s) * SLOT))
    LAS float* WL = (LAS float*)(L + 12 * SLOT);
    LAS float* AL = (LAS float*)(L + 0 * SLOT);
    LAS float* OT = (LAS float*)(L + RING_BYTES + 1024);
    LAS float* GL = OT + 512;
    unsigned long long b1acc = 0ull, b1t0 = 0ull; (void)b1acc; (void)b1t0;
    unsigned short rnx[45];
    b1_load_raw(P, (int)blockIdx.x < NUNITS ? (int)blockIdx.x : 0, w, l, rnx);
    for (int u = blockIdx.x; u < NUNITS; u += F.G) {
        const bool meta = u >= 4096;
        int b = 0, h, c = 0; if (meta) h = u - 4096; else { b = u >> 10; h = (u >> 7) & 7; c = u & 127; }
        const int ch = h * 64 + l;
        const int row0 = meta ? NREAL : b * SEQ + c * 64;
        LDS_BARRIER();
        B1T(0);
        float r_s[8], k_s[8], v_s[8], xw[8], xa[8];
        {
            const int t0 = 8 * w;
            unsigned short rc[45];
#pragma unroll
            for (int i = 0; i < 45; ++i) rc[i] = rnx[i];
            float pr = bf2f(rc[0]), pk = bf2f(rc[1]), pv = bf2f(rc[2]), pw = bf2f(rc[3]), pa = bf2f(rc[4]);
            const float mr = mu[ch], mk = mu[512 + ch], mv = mu[1024 + ch], mw = mu[1536 + l], ma = mu[1600 + l];
#pragma unroll
            for (int i = 0; i < 8; ++i) {
                const int t = t0 + i; const bool valid = !meta || t < NMETA;
                const float cr = bf2f(rc[5 * i + 5]), ck = bf2f(rc[5 * i + 6]), cv = bf2f(rc[5 * i + 7]), cw = bf2f(rc[5 * i + 8]), ca = bf2f(rc[5 * i + 9]);
                r_s[i] = valid ? cr + (pr - cr) * mr : 0.f; k_s[i] = valid ? ck + (pk - ck) * mk : 0.f; v_s[i] = valid ? cv + (pv - cv) * mv : 0.f;
                xw[i] = fast_tanh(cw + (pw - cw) * mw); xa[i] = ca + (pa - ca) * ma;
                pr = cr; pk = ck; pv = cv; pw = cw; pa = ca;
            }
#pragma unroll
            for (int i = 0; i < 8; ++i) { SL(8)[(t0 + i) * RP + l] = (bf16)f2bf(xw[i]); SL(9)[(t0 + i) * RP + l] = (bf16)f2bf(xa[i]); }
            {
                const int k = tid >> 3, pc = tid & 7;
                *(LAS v4u*)(SL(10) + k * RP + 8 * pc) = *(const v4u*)(WdT + (size_t)(h * 64 + k) * 64 + 8 * pc);
                *(LAS v4u*)(SL(11) + k * RP + 8 * pc) = *(const v4u*)(WaT + (size_t)(h * 64 + k) * 64 + 8 * pc);
            }
        }
        __syncthreads();
        B1T(1);
        {
            const int pid = w >> 2, q = w & 3, qr = q >> 1, qc = q & 1;
            f32x16 acc = zero16();
            quad_mma(acc, SL(10 + pid), SL(8 + pid), qr, qc, l);
            LAS float* Zf = pid ? AL : WL;
            const int r = l & 31, hf = l >> 5;
#pragma unroll
            for (int jj = 0; jj < 4; ++jj) *(LAS f32x4*)(Zf + (32 * qc + r) * FP + 32 * qr + 8 * jj + 4 * hf) = (f32x4){acc[4 * jj], acc[4 * jj + 1], acc[4 * jj + 2], acc[4 * jj + 3]};
        }
        __syncthreads();
        B1T(2);
        float lw[8], asg[8];
        {
            const float w0c = F.in[IN_W0][ch], a0c = F.in[IN_A0][ch];
            float run = 0.f;
#pragma unroll
            for (int i = 0; i < 8; ++i) {
                const int t = 8 * w + i; const bool valid = !meta || t < NMETA;
                const float x = -(WL[t * FP + l] + w0c);
                const float sp = x > 20.f ? x : __logf(1.0f + __expf(x));
                const float e = -__expf(-sp - 0.5f);
                run += valid ? e : 0.f; lw[i] = run;
                asg[i] = sigmoidf_(AL[t * FP + l] + a0c);
            }
            OT[w * 64 + l] = run;
        }
        __syncthreads();
        {
            float off = 0.f, tot = 0.f;
#pragma unroll
            for (int ww = 0; ww < 8; ++ww) { const float o = OT[ww * 64 + l]; tot += o; off += ww < w ? o : 0.f; }
            if (w == 0) GL[l] = __expf(tot);
            const float kkc = F.in[IN_KK][ch], kac = F.in[IN_KA][ch], rkc = F.in[IN_RK][ch];
            unsigned atc[4], vc[4], bhc[4], khc[4];
            float prevlg = off;
#pragma unroll
            for (int i = 0; i < 8; ++i) {
                const int t = 8 * w + i;
                const float lg = off + lw[i];
                const float g = __expf(lg), gp = __expf(prevlg), gi = __expf(-lg), gh = __expf(tot - lg);
                prevlg = lg;
                const float kkr = k_s[i] * kkc;
                const float kk = kkr * __builtin_amdgcn_rsqf(fmaxf(wave_sum(kkr * kkr), 1e-24f));
                const float k2 = k_s[i] * (1.f + (asg[i] - 1.f) * kac);
                const float bon = wave_sum(r_s[i] * k2 * rkc);
                if (l == 0) BONUS[(size_t)u * 64 + t] = bon;
                const float at = -kk * gp, rt = r_s[i] * g, bt = kk * asg[i] * gi, kt = k2 * gi, bh = kk * asg[i] * gh, kh = k2 * gh;
                SL(0)[t * RP + l] = (bf16)f2bf(at); SL(1)[t * RP + l] = (bf16)f2bf(rt); SL(2)[t * RP + l] = (bf16)f2bf(bt); SL(3)[t * RP + l] = (bf16)f2bf(kt);
                const unsigned ua = f2bf(at), uv = f2bf(v_s[i]), ub = f2bf(bh), uk = f2bf(kh);
                if (i & 1) { atc[i >> 1] |= ua << 16; vc[i >> 1] |= uv << 16; bhc[i >> 1] |= ub << 16; khc[i >> 1] |= uk << 16; }
                else { atc[i >> 1] = ua; vc[i >> 1] = uv; bhc[i >> 1] = ub; khc[i >> 1] = uk; }
            }
            *(LAS v4u*)(SL(4) + l * RP + 8 * w) = (v4u){atc[0], atc[1], atc[2], atc[3]};
            *(LAS v4u*)(SL(5) + l * RP + 8 * w) = (v4u){vc[0], vc[1], vc[2], vc[3]};
            *(LAS v4u*)(SL(6) + l * RP + 8 * w) = (v4u){bhc[0], bhc[1], bhc[2], bhc[3]};
            *(LAS v4u*)(SL(7) + l * RP + 8 * w) = (v4u){khc[0], khc[1], khc[2], khc[3]};
        }
        __syncthreads();
        B1T(3);
        for (int task = w; task < 20; task += 8) {
            int pid, qr, qc; bool zero = false;
            if (task < 15) { pid = task / 3; const int k = task % 3;
                if (pid == 1) { qc = k == 2 ? 1 : 0; qr = k == 0 ? 0 : 1; } else { qc = k == 0 ? 0 : 1; qr = k == 2 ? 1 : 0; } }
            else { pid = task - 15; zero = true; if (pid == 1) { qc = 1; qr = 0; } else { qc = 0; qr = 1; } }
            const int bop = pid == 0 ? 0 : pid == 1 ? 2 : pid == 2 ? 0 : 1;
            const int aop = pid == 0 ? 2 : pid == 1 ? 0 : pid == 2 ? 3 : pid == 3 ? 2 : 3;
            f32x16 acc = zero16();
            if (!zero) {
                quad_mma(acc, SL(aop), SL(bop), qr, qc, l);
                const int n = 32 * qc + (l & 31), hf = l >> 5;
#pragma unroll
                for (int j = 0; j < 16; ++j) {
                    const int m = ACC_M(qr, j, hf);
                    const bool keep = pid == 1 ? (m > n) : (pid <= 2 ? (n > m) : (n >= m));
                    acc[j] = keep ? acc[j] : 0.f;
                }
            }
            store_T(acc, SL(8 + pid), qr, qc, l);
        }
        __syncthreads();
        B1T(4);
        const int nq = w & 3, nqr = nq >> 1, nqc = nq & 1;
        f32x16 nacc = zero16();
        if (w < 4) { add_T(nacc, SL(8), nqr, nqc, l); }
        for (int task = w; task < 12; task += 8) {
            const int pid = task >> 2, q = task & 3, qr = q >> 1, qc = q & 1;
            f32x16 acc = zero16();
            if (pid == 0) { quad_mma(acc, SL(9), SL(8), qr, qc, l); store_T(acc, SL(0), qr, qc, l); }
            else if (pid == 1) { quad_mma(acc, SL(8), SL(9), qr, qc, l); store_T(acc, SL(2), qr, qc, l); }
            else { quad_mma(acc, SL(10), SL(5), qr, qc, l); store_T(acc, SL(3), qr, qc, l); }
        }
        __syncthreads();
#pragma unroll
        for (int st = 0; st < 4; ++st) {
            const int pr = (st & 1) ? 10 : 0, pc = (st & 1) ? 13 : 2, pr2 = (st & 1) ? 0 : 10, pc2 = (st & 1) ? 2 : 13, nr = (st & 1) ? 9 : 8, nr2 = (st & 1) ? 8 : 9;
            if (w < 4) {
                add_T(nacc, SL(pr), nqr, nqc, l);
                quad_mma(nacc, SL(pc), SL(nr), nqr, nqc, l);
                store_T(nacc, SL(nr2), nqr, nqc, l);
                f32x16 acc = zero16();
                quad_mma(acc, SL(pc), SL(pr), nqr, nqc, l); store_T(acc, SL(pr2), nqr, nqc, l);
            } else {
                f32x16 acc = zero16();
                quad_mma(acc, SL(pr), SL(pc), nqr, nqc, l); store_T(acc, SL(pc2), nqr, nqc, l);
            }
            __syncthreads();
        }
        if (w < 4) { add_T(nacc, SL(0), nqr, nqc, l); quad_mma(nacc, SL(2), SL(8), nqr, nqc, l); store_T(nacc, SL(9), nqr, nqc, l); }
        __syncthreads();
        B1T(5);
        b1_load_raw(P, u + F.G < NUNITS ? u + F.G : u, w, l, rnx);
        {
            const int pid = w >> 2;
            f32x16 acc = zero16();
            add_T(acc, SL(pid ? 3 : 4), nqr, nqc, l);
            quad_mma(acc, SL(9), SL(pid ? 3 : 4), nqr, nqc, l);
            store_T(acc, SL(pid ? 2 : 0), nqr, nqc, l);
        }
        LDS_BARRIER();
        for (int task = w; task < 16; task += 8) {
            const int pid = task >> 2, q = task & 3, qr = q >> 1, qc = q & 1;
            f32x16 acc = zero16();
            if (pid == 0) { add_T(acc, SL(1), qr, qc, l); quad_mma(acc, SL(0), SL(11), qr, qc, l); store_T_global<true>(acc, RWQ + (size_t)u * 4096, qr, qc, l); }
            else if (pid == 1) { quad_mma(acc, SL(2), SL(11), qr, qc, l); quad_mma(acc, SL(5), SL(12), qr, qc, l); store_T_global<false>(acc, RWY + (size_t)u * 4096, qr, qc, l); }
            else if (pid == 2) {
                quad_mma(acc, SL(0), SL(6), qr, qc, l);
                const int n = 32 * qc + (l & 31), hf = l >> 5; const float gl = GL[n];
#pragma unroll
                for (int j = 0; j < 16; ++j) acc[j] += (ACC_M(qr, j, hf) == n) ? gl : 0.f;
                store_T_global<true>(acc, RWM + (size_t)u * 4096, qr, qc, l);
            } else { quad_mma(acc, SL(6), SL(2), qr, qc, l); quad_mma(acc, SL(7), SL(5), qr, qc, l); store_T_global<false>(acc, RWN + (size_t)u * 4096, qr, qc, l); }
        }
        B1T(6);
    }
#ifdef PROBE_B1SEC
    if (blockIdx.x == 0 && F.tid == 0) { F.MISC[20] = (unsigned)b1acc; }
#endif
#undef SL
}

__device__ __forceinline__ void rw_b2(Frame& F) {
    if (blockIdx.x >= 32) return;
    const bf16* RWM = WSP(bf16, WS_RWM); const bf16* RWN = WSP(bf16, WS_RWN);
    bf16* RWS = (bf16*)((char*)F.out + OUT_RWS);
    const int b = blockIdx.x >> 3, h = blockIdx.x & 7, w = F.wave, l = F.lane;
    LAS unsigned char* L = F.lds;
#define SS(buf, part) ((LAS bf16*)(L + ((buf) * 2 + (part)) * SLOT))
    const int q = w & 3, qr = q >> 1, qc = q & 1, r = l & 31, hf = l >> 5;
    if (w < 4) {
        const bf16* Nm = RWN + (size_t)(4096 + h) * 4096;
#pragma unroll
        for (int jj = 0; jj < 4; ++jj) {
            const v2u wv = *(const v2u*)(Nm + acc_off(32 * qc + r, 32 * qr + 8 * jj + 4 * hf));
            *(LAS v2u*)(SS(0, 0) + (32 * qc + r) * RP + 32 * qr + 8 * jj + 4 * hf) = wv;
            *(LAS v2u*)(SS(0, 1) + (32 * qc + r) * RP + 32 * qr + 8 * jj + 4 * hf) = (v2u){0u, 0u};
        }
    }
    __syncthreads();
    bf16x8 a_cur[4]; v2u n_cur[4];
    {
        const size_t u0 = (size_t)(b * 8 + h) * 128;
#pragma unroll
        for (int ks = 0; ks < 4; ++ks) a_cur[ks] = *(const bf16x8*)(RWM + u0 * 4096 + frag_off(32 * qr + r, 16 * ks + 8 * hf));
#pragma unroll
        for (int jj = 0; jj < 4; ++jj) n_cur[jj] = *(const v2u*)(RWN + u0 * 4096 + acc_off(32 * qc + r, 32 * qr + 8 * jj + 4 * hf));
    }
    for (int c = 0; c < 128; ++c) {
        const int u = (b * 8 + h) * 128 + c, cur = c & 1;
        if (w < 4) {
            bf16x8 a_nxt[4]; v2u n_nxt[4];
            const size_t un = (size_t)(c + 1 < 128 ? u + 1 : u);
#pragma unroll
            for (int ks = 0; ks < 4; ++ks) a_nxt[ks] = *(const bf16x8*)(RWM + un * 4096 + frag_off(32 * qr + r, 16 * ks + 8 * hf));
#pragma unroll
            for (int jj = 0; jj < 4; ++jj) n_nxt[jj] = *(const v2u*)(RWN + un * 4096 + acc_off(32 * qc + r, 32 * qr + 8 * jj + 4 * hf));
            f32x16 acc;
#pragma unroll
            for (int jj = 0; jj < 4; ++jj) { acc[4 * jj] = bflo(n_cur[jj].x); acc[4 * jj + 1] = bfhi(n_cur[jj].x); acc[4 * jj + 2] = bflo(n_cur[jj].y); acc[4 * jj + 3] = bfhi(n_cur[jj].y); }
#pragma unroll
            for (int jj = 0; jj < 4; ++jj)
                *(v2u*)(RWS + (size_t)u * 4096 + frag_off(32 * qc + r, 32 * qr + 8 * jj + 4 * hf)) = *(const LAS v2u*)(SS(cur, 0) + (32 * qc + r) * RP + 32 * qr + 8 * jj + 4 * hf);
            const LAS bf16* bh = SS(cur, 0) + (32 * qc + r) * RP + 8 * hf; const LAS bf16* bl = SS(cur, 1) + (32 * qc + r) * RP + 8 * hf;
#pragma unroll
            for (int ks = 0; ks < 4; ++ks) {
                acc = __builtin_amdgcn_mfma_f32_32x32x16_bf16(a_cur[ks], *(const LAS bf16x8*)(bh + 16 * ks), acc, 0, 0, 0);
                acc = __builtin_amdgcn_mfma_f32_32x32x16_bf16(a_cur[ks], *(const LAS bf16x8*)(bl + 16 * ks), acc, 0, 0, 0);
            }
#pragma unroll
            for (int jj = 0; jj < 4; ++jj) {
                float hi[4], lo[4];
#pragma unroll
                for (int e = 0; e < 4; ++e) { const unsigned hb = f2bf(acc[4 * jj + e]); hi[e] = __uint_as_float(hb << 16); lo[e] = acc[4 * jj + e] - hi[e]; }
                *(LAS v2u*)(SS(cur ^ 1, 0) + (32 * qc + r) * RP + 32 * qr + 8 * jj + 4 * hf) = (v2u){pk2(hi[0], hi[1]), pk2(hi[2], hi[3])};
                *(LAS v2u*)(SS(cur ^ 1, 1) + (32 * qc + r) * RP + 32 * qr + 8 * jj + 4 * hf) = (v2u){pk2(lo[0], lo[1]), pk2(lo[2], lo[3])};
            }
#pragma unroll
            for (int ks = 0; ks < 4; ++ks) a_cur[ks] = a_nxt[ks];
#pragma unroll
            for (int jj = 0; jj < 4; ++jj) n_cur[jj] = n_nxt[jj];
        }
        LDS_BARRIER();
    }
#undef SS
}

__device__ __forceinline__ void rw_b3(Frame& F, bool meta_only = false) {
    const bf16* P = WSP(bf16, WS_P); bf16* QA = WSP(bf16, WS_QA);
    const bf16* RWQ = WSP(bf16, WS_RWQ); const bf16* RWY = WSP(bf16, WS_RWY);
    const bf16* RWS = (const bf16*)((const char*)F.out + OUT_RWS); const float* BONUS = (const float*)((const char*)F.out + OUT_BONUS);
    const bf16* WgT = WSP(bf16, WS_WT_LORA) + 2 * 512 * 64;
    const float* mu = F.in[IN_MU];
    const int l = F.lane, r = l & 31, hf = l >> 5;
    const int gw = blockIdx.x * NWAVES + F.wave, NGW = F.G * NWAVES;
    for (int it = meta_only ? 8192 + F.wave : gw; it < (meta_only ? 8200 : 8192); it += meta_only ? NWAVES : NGW) {
        const int u = it < 8192 ? it >> 1 : 4096 + (it - 8192), th = it < 8192 ? (it & 1) : 0;
        const bool meta = u >= 4096;
        int b = 0, h, c = 0; if (meta) h = u - 4096; else { b = u >> 10; h = (u >> 7) & 7; c = u & 127; }
        const int t = 32 * th + r;
        const bool valid = !meta || t < NMETA;
        const int row0 = meta ? NREAL : b * SEQ + c * 64;
        const int row = valid ? row0 + t : row0;
        int prow = -1;
        if (t > 0) prow = row - 1; else if (!meta) prow = (c == 0) ? NREAL + NMETA - 1 : row - 1;
        LAS unsigned char* tg = F.lds + F.wave * 16384;
        LAS unsigned char* tv = tg + 9216;
        {
            const int rfirst = row0 + 32 * th;
            const int rprev0 = th ? rfirst - 1 : (meta ? -1 : ((c == 0) ? NREAL + NMETA - 1 : rfirst - 1));
            const int rmax = meta ? NREAL + NMETA - 1 : rfirst + 31;
            asm volatile("s_waitcnt lgkmcnt(0)" ::: "memory");
#pragma unroll
            for (int i = 0; i < 9; ++i) {
                const int tr = 4 * i + (l >> 4), ch16 = l & 15;
                if (tr <= 32) {
                    int gr_ = tr == 0 ? rprev0 : rfirst + tr - 1; const bool z = gr_ < 0; gr_ = z ? rfirst : (gr_ > rmax ? rmax : gr_);
                    v4u d = *(const v4u*)(P + (size_t)gr_ * PW + PC_GD + 8 * ch16); if (z) d = (v4u){0u, 0u, 0u, 0u};
                    *(LAS v4u*)(tg + tr * 272 + 16 * ch16) = d;
                }
            }
#pragma unroll
            for (int i = 0; i < 5; ++i) {
                const int tr = 8 * i + (l >> 3), ch8 = l & 7;
                if (tr <= 32) {
                    int gr_ = tr == 0 ? rprev0 : rfirst + tr - 1; const bool z = gr_ < 0; gr_ = z ? rfirst : (gr_ > rmax ? rmax : gr_);
                    v4u d = *(const v4u*)(P + (size_t)gr_ * PW + PC_V + h * 64 + 8 * ch8); if (z) d = (v4u){0u, 0u, 0u, 0u};
                    *(LAS v4u*)(tv + tr * 144 + 16 * ch8) = d;
                }
            }
            asm volatile("s_waitcnt lgkmcnt(0)" ::: "memory");
        }
        f32x16 y[2];
#pragma unroll
        for (int qv = 0; qv < 2; ++qv) {
            const bf16* Y0 = RWY + (size_t)u * 4096;
#pragma unroll
            for (int jj = 0; jj < 4; ++jj) { const v2u wv = *(const v2u*)(Y0 + acc_off(32 * th + r, 32 * qv + 8 * jj + 4 * hf)); y[qv][4 * jj] = bflo(wv.x); y[qv][4 * jj + 1] = bfhi(wv.x); y[qv][4 * jj + 2] = bflo(wv.y); y[qv][4 * jj + 3] = bfhi(wv.y); }
        }
        if (!meta) {
            const bf16* qp = RWQ + (size_t)u * 4096; const bf16* sp = RWS + (size_t)u * 4096;
#pragma unroll
            for (int ks = 0; ks < 4; ++ks) {
                const bf16x8 bq = *(const bf16x8*)(qp + frag_off(32 * th + r, 16 * ks + 8 * hf));
                y[0] = __builtin_amdgcn_mfma_f32_32x32x16_bf16(*(const bf16x8*)(sp + frag_off(r, 16 * ks + 8 * hf)), bq, y[0], 0, 0, 0);
                y[1] = __builtin_amdgcn_mfma_f32_32x32x16_bf16(*(const bf16x8*)(sp + frag_off(32 + r, 16 * ks + 8 * hf)), bq, y[1], 0, 0, 0);
            }
        }
        f32x16 g[2]; g[0] = zero16(); g[1] = zero16();
        {
            const LAS unsigned char* gpl = tg + (r + 1) * 272 + 16 * hf; const LAS unsigned char* gppl = tg + r * 272 + 16 * hf;
            const bf16* wp = WgT + (size_t)(h * 64 + r) * 128 + 8 * hf;
#pragma unroll
            for (int ks = 0; ks < 8; ++ks) {
                const v4u cg = *(const LAS v4u*)(gpl + 32 * ks); const v4u pg = *(const LAS v4u*)(gppl + 32 * ks);
                const f32x4 m0 = *(const f32x4*)(mu + 1664 + 16 * ks + 8 * hf), m1 = *(const f32x4*)(mu + 1664 + 16 * ks + 8 * hf + 4);
                const unsigned cw[4] = {cg.x, cg.y, cg.z, cg.w}, pw[4] = {pg.x, pg.y, pg.z, pg.w}; const float mm[8] = {m0.x, m0.y, m0.z, m0.w, m1.x, m1.y, m1.z, m1.w};
                unsigned o[4];
#pragma unroll
                for (int e = 0; e < 4; ++e) {
                    const float c0 = bflo(cw[e]), c1 = bfhi(cw[e]), p0 = bflo(pw[e]), p1 = bfhi(pw[e]);
                    o[e] = pk2(sigmoidf_(c0 + (p0 - c0) * mm[2 * e]), sigmoidf_(c1 + (p1 - c1) * mm[2 * e + 1]));
                }
                const v4u ov = (v4u){o[0], o[1], o[2], o[3]};
                const bf16x8 bs = __builtin_bit_cast(bf16x8, ov);
                g[0] = __builtin_amdgcn_mfma_f32_32x32x16_bf16(*(const bf16x8*)(wp + 16 * ks), bs, g[0], 0, 0, 0);
                g[1] = __builtin_amdgcn_mfma_f32_32x32x16_bf16(*(const bf16x8*)(wp + 32 * 128 + 16 * ks), bs, g[1], 0, 0, 0);
            }
        }
        float s = 0.f;
#pragma unroll
        for (int j = 0; j < 16; ++j) s += y[0][j] + y[1][j];
        s += __shfl_xor(s, 32);
        const float mean = s * (1.f / 64.f);
        float s2 = 0.f;
#pragma unroll
        for (int j = 0; j < 16; ++j) { const float d0 = y[0][j] - mean, d1 = y[1][j] - mean; s2 += d0 * d0 + d1 * d1; }
        s2 += __shfl_xor(s2, 32);
        const float rstd = 1.0f / sqrtf(s2 * (1.f / 64.f) + GN_EPS);
        const float bon = BONUS[(size_t)u * 64 + t];
        if (valid) {
#pragma unroll
            for (int qv = 0; qv < 2; ++qv)
#pragma unroll
                for (int jj = 0; jj < 4; ++jj) {
                    const int v0 = 32 * qv + 8 * jj + 4 * hf, chv = h * 64 + v0;
                    const v2u cvw = *(const LAS v2u*)(tv + (r + 1) * 144 + 2 * v0); const v2u pvw = *(const LAS v2u*)(tv + r * 144 + 2 * v0);
                    const f32x4 mv = *(const f32x4*)(mu + 1024 + chv), gg = *(const f32x4*)(F.in[IN_GN_G] + chv), gb = *(const f32x4*)(F.in[IN_GN_B] + chv);
                    const float cv[4] = {bflo(cvw.x), bfhi(cvw.x), bflo(cvw.y), bfhi(cvw.y)}, pv[4] = {bflo(pvw.x), bfhi(pvw.x), bflo(pvw.y), bfhi(pvw.y)};
                    const float mvv[4] = {mv.x, mv.y, mv.z, mv.w}, ggv[4] = {gg.x, gg.y, gg.z, gg.w}, gbv[4] = {gb.x, gb.y, gb.z, gb.w};
                    float o[4];
#pragma unroll
                    for (int e = 0; e < 4; ++e) {
                        const float vs = cv[e] + (pv[e] - cv[e]) * mvv[e];
                        o[e] = ((y[qv][4 * jj + e] - mean) * rstd * ggv[e] + gbv[e] + bon * vs) * g[qv][4 * jj + e];
                    }
                    *(v2u*)(QA + (size_t)row * QAW + 1024 + chv) = (v2u){pk2(o[0], o[1]), pk2(o[2], o[3])};
                }
        }
    }
}

constexpr int IX_CAP = 512, IX_LIST = 3072, IX_KB = 98304, IX_SCR = RING_BYTES + 4096;
#define IX_FENCE() asm volatile("s_waitcnt lgkmcnt(0)" ::: "memory")
#define IX_ORDER() asm volatile("" ::: "memory")

typedef _Float16 half8 __attribute__((ext_vector_type(8)));
typedef short short2_t __attribute__((ext_vector_type(2)));
typedef unsigned u32x4_t __attribute__((ext_vector_type(4)));
__device__ __forceinline__ unsigned relu_pk_f16(float a, float b) {
    short2_t s = __builtin_bit_cast(short2_t, __builtin_amdgcn_cvt_pkrtz(a, b));
    s = __builtin_elementwise_max(s, (short2_t){0, 0});
    return __builtin_bit_cast(unsigned, s);
}
__device__ __forceinline__ unsigned ix_mbcnt(unsigned long long m) { return __builtin_amdgcn_mbcnt_hi((unsigned)(m >> 32), __builtin_amdgcn_mbcnt_lo((unsigned)m, 0u)); }

__device__ __forceinline__ void ix_select_slow(const float (&sc)[8], const unsigned (&ix)[8], bool (&vl)[8], int K, unsigned short* sel_out, int lane) {
    for (int it = 0; it < K; ++it) {
        unsigned long long best = 0ull;
#pragma unroll
        for (int i = 0; i < 8; ++i) { const unsigned long long key = ((unsigned long long)sortable(sc[i]) << 32) | (unsigned long long)(0xFFFFu - ix[i]) | 0x10000ull; if (vl[i] && key > best) best = key; }
        unsigned long long wm = best;
#pragma unroll
        for (int o = 1; o < 64; o <<= 1) { const unsigned long long v = __shfl_xor(wm, o); wm = v > wm ? v : wm; }
        if (wm == 0ull) break;
        const bool mine = best == wm;
#pragma unroll
        for (int i = 0; i < 8; ++i) { const unsigned long long key = ((unsigned long long)sortable(sc[i]) << 32) | (unsigned long long)(0xFFFFu - ix[i]) | 0x10000ull; if (mine && vl[i] && key == wm) { vl[i] = false; sel_out[it] = (unsigned short)ix[i]; } }
    }
}

__device__ __forceinline__ void ix_compact(LAS float* LS, LAS unsigned short* LI, LAS unsigned* hist, int& cnt, float& tau, int lane, bool final_sel, unsigned short* sel_out) {
    const int n = cnt;
    float sc[8]; unsigned ix[8]; bool vl[8];
    IX_FENCE();
#pragma unroll
    for (int i = 0; i < 8; ++i) { const int p = lane + 64 * i; vl[i] = p < n; sc[i] = vl[i] ? LS[p] : -INFINITY; ix[i] = vl[i] ? (unsigned)LI[p] : 0u; }
    float mx = -INFINITY, mn = INFINITY;
#pragma unroll
    for (int i = 0; i < 8; ++i) { if (vl[i]) { mx = fmaxf(mx, sc[i]); mn = fminf(mn, sc[i]); } }
    mx = wave_max(mx); mn = -wave_max(-mn);
    const float scale = mx > mn ? 255.99f / (mx - mn) : 0.f;
    int bin[8];
#pragma unroll
    for (int i = 0; i < 8; ++i) { int bq = (int)((sc[i] - mn) * scale); bq = bq > 255 ? 255 : (bq < 0 ? 0 : bq); bin[i] = vl[i] ? bq : -1; }
    *(LAS v4u*)(hist + 4 * lane) = (v4u){0u, 0u, 0u, 0u};
    IX_FENCE();
#pragma unroll
    for (int i = 0; i < 8; ++i) if (vl[i]) __hip_atomic_fetch_add((LAS unsigned*)&hist[bin[i]], 1u, __ATOMIC_RELAXED, __HIP_MEMORY_SCOPE_WAVEFRONT);
    IX_FENCE();
    const v4u c = *(const LAS v4u*)(hist + 4 * lane);
    const unsigned Pp = wave_scan_incl(c.x + c.y + c.z + c.w, lane);
    const unsigned total = (unsigned)__builtin_amdgcn_readlane((int)Pp, 63);
    const unsigned K = TOPK;
    const unsigned a3 = total - Pp, a2 = a3 + c.w, a1 = a2 + c.z, a0 = a1 + c.y;
    int myb = -1; unsigned myA = 0u, myC = 0u;
    if (a3 < K && K <= a3 + c.w) { myb = 4 * lane + 3; myA = a3; myC = c.w; }
    else if (a2 < K && K <= a2 + c.z) { myb = 4 * lane + 2; myA = a2; myC = c.z; }
    else if (a1 < K && K <= a1 + c.y) { myb = 4 * lane + 1; myA = a1; myC = c.y; }
    else if (a0 < K && K <= a0 + c.x) { myb = 4 * lane; myA = a0; myC = c.x; }
    const unsigned long long bm = __ballot(myb >= 0);
    const int src = bm ? (__ffsll((long long)bm) - 1) : 0;
    const int srcu = __builtin_amdgcn_readfirstlane(src);
    const int bstar = __builtin_amdgcn_readlane(myb, srcu); const unsigned A = (unsigned)__builtin_amdgcn_readlane((int)myA, srcu), m = (unsigned)__builtin_amdgcn_readlane((int)myC, srcu);
    if (!final_sel) {
        if (A + m <= (unsigned)(IX_CAP - 128)) {
            int base = 0; float kmin = INFINITY;
#pragma unroll
            for (int i = 0; i < 8; ++i) {
                const bool keep = vl[i] && bin[i] >= bstar;
                const unsigned long long mk = __ballot(keep);
                const int pos = base + (int)ix_mbcnt(mk);
                if (keep) { LS[pos] = sc[i]; LI[pos] = (unsigned short)ix[i]; kmin = fminf(kmin, sc[i]); }
                base += __popcll(mk);
            }
            cnt = base; tau = -wave_max(-kmin);
            IX_FENCE();
            return;
        }
        unsigned short* tmp = sel_out;
        ix_select_slow(sc, ix, vl, (int)K, tmp, lane);
        int base = 0; float kmin = INFINITY;
#pragma unroll
        for (int i = 0; i < 8; ++i) {
            const bool keep = !vl[i] && (lane + 64 * i) < n;
            const unsigned long long mk = __ballot(keep);
            const int pos = base + (int)ix_mbcnt(mk);
            if (keep) { LS[pos] = sc[i]; LI[pos] = (unsigned short)ix[i]; kmin = fminf(kmin, sc[i]); }
            base += __popcll(mk);
        }
        cnt = base; tau = -wave_max(-kmin);
        IX_FENCE();
        return;
    }
    if (m <= 128u) {
        int base = 0;
#pragma unroll
        for (int i = 0; i < 8; ++i) {
            const bool keep = vl[i] && bin[i] > bstar;
            const unsigned long long mk = __ballot(keep);
            const int pos = base + (int)ix_mbcnt(mk);
            if (keep) sel_out[pos] = (unsigned short)ix[i];
            base += __popcll(mk);
        }
        LAS float* sS = (LAS float*)hist; LAS unsigned* sI = hist + 128;
        IX_FENCE();
        int mb = 0;
#pragma unroll
        for (int i = 0; i < 8; ++i) {
            const bool inb = vl[i] && bin[i] == bstar;
            const unsigned long long mk = __ballot(inb);
            const int pos = mb + (int)ix_mbcnt(mk);
            if (inb) { sS[pos] = sc[i]; sI[pos] = ix[i]; }
            mb += __popcll(mk);
        }
        IX_FENCE();
        const int need = (int)(K - A);
#pragma unroll
        for (int e = 0; e < 2; ++e) {
            const int j = lane + 64 * e;
            if (j < (int)m) {
                const float sj = sS[j]; const unsigned ij = sI[j]; int rank = 0;
                for (int k = 0; k < (int)m; ++k) { const float sk = sS[k]; const unsigned ik = sI[k]; rank += (sk > sj || (sk == sj && ik < ij)) ? 1 : 0; }
                if (rank < need) sel_out[(int)A + rank] = (unsigned short)ij;
            }
        }
    } else {
        ix_select_slow(sc, ix, vl, (int)K, sel_out, lane);
    }
}

__device__ __forceinline__ void p6_attn_mfma(Frame& F, bf16* OUTB, bool meta_only, int ldo, int pm);
__device__ __forceinline__ void p5_index_mfma(Frame& F, unsigned short* SEL, int* NSEL, int qword = 3072, bool probe_noappend = false, bool do_meta = false) {
    const bf16* QA = WSP(bf16, WS_QA); const bf16* KIDX = WSP(bf16, WS_KIDX); const float* WIDX = WSP(float, WS_WIDX);
    const int tid = F.tid, w = F.wave, l = F.lane, r = l & 31, hf = l >> 5;
    {
        const int gw = blockIdx.x * NWAVES + w, NGW = F.G * NWAVES;
        for (int i = gw; i < NMETA + BATCH * 192; i += NGW) {
            int q, nvis; if (i < NMETA) { q = NREAL + i; nvis = NMETA; } else { const int bb = (i - NMETA) / 192, s = (i - NMETA) % 192; q = bb * SEQ + s; nvis = NMETA + 64 * (s / 64 + 1); }
            for (int j = l; j < nvis; j += 64) SEL[(size_t)q * TOPK + j] = (unsigned short)j;
            if (l == 0) NSEL[q] = nvis;
        }
    }
    LAS unsigned char* L = F.lds;
    LAS unsigned* hist = (LAS unsigned*)(L + IX_SCR + w * 1024);
    if (do_meta) {
        __syncthreads();
        if (tid == 0) F.MISC[17] = __hip_atomic_fetch_add((unsigned*)F.ctl + 3200, 1u, __ATOMIC_RELAXED, __HIP_MEMORY_SCOPE_AGENT);
        __syncthreads();
        const int mt = (int)F.MISC[17];
        if (mt == 0) {
            if (tid < NMETA) { for (int j = 0; j < NMETA; ++j) SEL[(size_t)(NREAL + tid) * TOPK + j] = (unsigned short)j; NSEL[NREAL + tid] = NMETA; }
            asm volatile("s_waitcnt vmcnt(0)" ::: "memory"); __syncthreads();
            p6_attn_mfma(F, WSP(bf16, WS_QA), true, QAW, 0);
        } else if (mt == 1) { rw_b3(F, true); }
        __syncthreads();
    }
    {
        for (;;) {
            __syncthreads();
            if (tid == 0) F.MISC[16] = __hip_atomic_fetch_add((unsigned*)F.ctl + qword, 1u, __ATOMIC_RELAXED, __HIP_MEMORY_SCOPE_AGENT);
            __syncthreads();
            const int qi_ = (int)F.MISC[16];
            if (qi_ >= 1000) break;
            const int tile = 999 - qi_;
            const int pt = 6 + (tile >> 2), b = tile & 3;
            const int q0 = b * SEQ + pt * 32;
            const int nvis = NMETA + 64 * (pt / 2 + 1);
            __syncthreads();
            bf16x8 af[4];
            {
                const int qq = 2 * (r >> 4) + ((r >> 2) & 1), hd = 4 * ((r >> 3) & 1) + (r & 3);
                const bf16* qp = QA + (size_t)(q0 + 4 * w + qq) * QAW + 1024 + hd * 64 + 8 * hf;
#pragma unroll
                for (int ks = 0; ks < 4; ++ks) af[ks] = *(const bf16x8*)(qp + 16 * ks);
            }
            half8 wf[2];
#pragma unroll
            for (int s2 = 0; s2 < 2; ++s2) {
                const bool on = r == 4 * hf + s2;
                const float* wp_ = WIDX + (size_t)(q0 + 4 * w + 2 * s2 + hf) * 8;
                const f32x4 w0 = *(const f32x4*)wp_, w1 = *(const f32x4*)(wp_ + 4);
                half8 t; t[0] = (_Float16)w0.x; t[1] = (_Float16)w0.y; t[2] = (_Float16)w0.z; t[3] = (_Float16)w0.w; t[4] = (_Float16)w1.x; t[5] = (_Float16)w1.y; t[6] = (_Float16)w1.z; t[7] = (_Float16)w1.w;
#pragma unroll
                for (int j = 0; j < 8; ++j) wf[s2][j] = on ? t[j] : (_Float16)0.0f;
            }
            float tau0 = -INFINITY, tau1 = -INFINITY;
            int cnt[4] = {0, 0, 0, 0};
            const int nblk = (nvis + 255) >> 8;
            v4u kreg[4];
#pragma unroll
            for (int e = 0; e < 4; ++e) {
                const int pid = tid + 512 * e, kl = pid >> 3, pc = pid & 7, j = kl;
                kreg[e] = j < nvis ? *(const v4u*)(KIDX + (size_t)key_row(b, j) * 64 + 8 * pc) : (v4u){0u, 0u, 0u, 0u};
            }
#pragma unroll
            for (int e = 0; e < 4; ++e) { const int pid = tid + 512 * e, kl = pid >> 3, pc = pid & 7; *(LAS v4u*)(L + IX_KB + kl * 128 + ((pc ^ ((kl >> 1) & 7)) << 4)) = kreg[e]; }
            __syncthreads();
            const LAS unsigned char* kb = L + IX_KB;
            for (int blk = 0; blk < nblk; ++blk) {
                if (blk + 1 < nblk) {
#pragma unroll
                    for (int e = 0; e < 4; ++e) {
                        const int pid = tid + 512 * e, kl = pid >> 3, pc = pid & 7, j = (blk + 1) * 256 + kl;
                        kreg[e] = j < nvis ? *(const v4u*)(KIDX + (size_t)key_row(b, j) * 64 + 8 * pc) : (v4u){0u, 0u, 0u, 0u};
                    }
                }
                int npair = (nvis - blk * 256 + 63) >> 6; npair = npair > 4 ? 4 : npair;
                bf16x8 bc0[4], bc1[4];
#pragma unroll
                for (int ks = 0; ks < 4; ++ks) { const int k0 = r, k1 = 32 + r;
                    bc0[ks] = *(const LAS bf16x8*)(kb + k0 * 128 + (((2 * ks + hf) ^ ((k0 >> 1) & 7)) << 4));
                    bc1[ks] = *(const LAS bf16x8*)(kb + k1 * 128 + (((2 * ks + hf) ^ ((k1 >> 1) & 7)) << 4)); }
                for (int pp = 0; pp < npair; ++pp) {
                    const int jbase = blk * 256 + pp * 64;
                    bf16x8 bn0[4], bn1[4];
                    {
                        const int pn = pp + 1 < npair ? pp + 1 : pp; const int k0 = pn * 64 + r, k1 = k0 + 32;
#pragma unroll
                        for (int ks = 0; ks < 4; ++ks) {
                            bn0[ks] = *(const LAS bf16x8*)(kb + k0 * 128 + (((2 * ks + hf) ^ ((k0 >> 1) & 7)) << 4));
                            bn1[ks] = *(const LAS bf16x8*)(kb + k1 * 128 + (((2 * ks + hf) ^ ((k1 >> 1) & 7)) << 4)); }
                    }
                    f32x16 accA = zero16(), accB = zero16();
#pragma unroll
                    for (int ks = 0; ks < 4; ++ks) { accA = __builtin_amdgcn_mfma_f32_32x32x16_bf16(af[ks], bc0[ks], accA, 0, 0, 0); accB = __builtin_amdgcn_mfma_f32_32x32x16_bf16(af[ks], bc1[ks], accB, 0, 0, 0); }
#pragma unroll
                    for (int ks = 0; ks < 4; ++ks) { bc0[ks] = bn0[ks]; bc1[ks] = bn1[ks]; }
                    f32x16 yA = zero16(), yB = zero16();
#pragma unroll
                    for (int s2 = 0; s2 < 2; ++s2) {
                        u32x4_t ua, ub;
#pragma unroll
                        for (int pq = 0; pq < 4; ++pq) { ua[pq] = relu_pk_f16(accA[8 * s2 + 2 * pq], accA[8 * s2 + 2 * pq + 1]); ub[pq] = relu_pk_f16(accB[8 * s2 + 2 * pq], accB[8 * s2 + 2 * pq + 1]); }
                        yA = __builtin_amdgcn_mfma_f32_32x32x16_f16(wf[s2], __builtin_bit_cast(half8, ua), yA, 0, 0, 0);
                        yB = __builtin_amdgcn_mfma_f32_32x32x16_f16(wf[s2], __builtin_bit_cast(half8, ub), yB, 0, 0, 0);
                    }
                    const float s0A = yA[0] + 0.0f, s1A = yA[1] + 0.0f, s0B = yB[0] + 0.0f, s1B = yB[1] + 0.0f;
                    const int jA = jbase + r, jB = jA + 32;
                    const bool p0A = jA < nvis && s0A > tau0, p1A = jA < nvis && s1A > tau1, p0B = jB < nvis && s0B > tau0, p1B = jB < nvis && s1B > tau1;
                    const unsigned long long m0A = __ballot(p0A), m1A = __ballot(p1A), m0B = __ballot(p0B), m1B = __ballot(p1B);
                    if (m0A | m1A | m0B | m1B) {
                        const int a0lo = __popc((unsigned)m0A), a0hi = __popc((unsigned)(m0A >> 32)), a1lo = __popc((unsigned)m1A), a1hi = __popc((unsigned)(m1A >> 32));
                        const int b0lo = __popc((unsigned)m0B), b0hi = __popc((unsigned)(m0B >> 32)), b1lo = __popc((unsigned)m1B), b1hi = __popc((unsigned)(m1B >> 32));
                        {
                            LAS unsigned char* lb = L + (w * 4 + hf) * IX_LIST;
                            const int base = hf ? cnt[1] : cnt[0];
                            const int posA = base + (int)ix_mbcnt(m0A) - (hf ? a0lo : 0);
                            const int posB = base + (hf ? a0hi : a0lo) + (int)ix_mbcnt(m0B) - (hf ? b0lo : 0);
                            if (p0A) { ((LAS float*)lb)[posA] = s0A; ((LAS unsigned short*)(lb + 2048))[posA] = (unsigned short)jA; }
                            if (p0B) { ((LAS float*)lb)[posB] = s0B; ((LAS unsigned short*)(lb + 2048))[posB] = (unsigned short)jB; }
                        }
                        {
                            LAS unsigned char* lb = L + (w * 4 + 2 + hf) * IX_LIST;
                            const int base = hf ? cnt[3] : cnt[2];
                            const int posA = base + (int)ix_mbcnt(m1A) - (hf ? a1lo : 0);
                            const int posB = base + (hf ? a1hi : a1lo) + (int)ix_mbcnt(m1B) - (hf ? b1lo : 0);
                            if (p1A) { ((LAS float*)lb)[posA] = s1A; ((LAS unsigned short*)(lb + 2048))[posA] = (unsigned short)jA; }
                            if (p1B) { ((LAS float*)lb)[posB] = s1B; ((LAS unsigned short*)(lb + 2048))[posB] = (unsigned short)jB; }
                        }
                        cnt[0] += a0lo + b0lo; cnt[1] += a0hi + b0hi; cnt[2] += a1lo + b1lo; cnt[3] += a1hi + b1hi;
                        if (probe_noappend) { if (cnt[0] >= 256 && hf == 0) tau0 = INFINITY; if (cnt[1] >= 256 && hf == 1) tau0 = INFINITY; if (cnt[2] >= 256 && hf == 0) tau1 = INFINITY; if (cnt[3] >= 256 && hf == 1) tau1 = INFINITY; }
#pragma unroll
                        for (int qq = 0; qq < 4; ++qq) {
                            if (cnt[qq] > IX_CAP - 64) {
                                LAS unsigned char* lb = L + (w * 4 + qq) * IX_LIST;
                                float tq = 0.f; int cq = cnt[qq];
                                ix_compact((LAS float*)lb, (LAS unsigned short*)(lb + 2048), hist, cq, tq, l, false, SEL + (size_t)(q0 + 4 * w + qq) * TOPK);
                                cnt[qq] = __builtin_amdgcn_readfirstlane(cq);
                                if ((qq & 1) == hf) { if (qq < 2) tau0 = tq; else tau1 = tq; }
                            }
                        }
                    }
                }
                __syncthreads();
                if (blk + 1 < nblk) {
#pragma unroll
                    for (int e = 0; e < 4; ++e) { const int pid = tid + 512 * e, kl = pid >> 3, pc = pid & 7; *(LAS v4u*)(L + IX_KB + kl * 128 + ((pc ^ ((kl >> 1) & 7)) << 4)) = kreg[e]; }
                    __syncthreads();
                }
            }
#pragma unroll
            for (int qq = 0; qq < 4; ++qq) {
                LAS unsigned char* lb = L + (w * 4 + qq) * IX_LIST;
                float tq = 0.f; int cq = cnt[qq];
                ix_compact((LAS float*)lb, (LAS unsigned short*)(lb + 2048), hist, cq, tq, l, true, SEL + (size_t)(q0 + 4 * w + qq) * TOPK);
                if (l == 0) NSEL[q0 + 4 * w + qq] = TOPK;
            }
        }
    }
}

#ifndef CHECK_IDX
#define CHECK_IDX 0
#endif
#if CHECK_IDX
__device__ __forceinline__ void idx_check(Frame& F) {
    const unsigned short* SEL = WSP(unsigned short, WS_SEL); const unsigned short* SELB = (const unsigned short*)F.out; const int* NSEL = WSP(int, WS_NSEL); const int* NSELB = (const int*)((const char*)F.out + 32 * MiB);
    LAS unsigned* bm = (LAS unsigned*)(F.lds + F.wave * 2048);
    const int l = F.lane; const int gw = blockIdx.x * NWAVES + F.wave, NGW = F.G * NWAVES;
    unsigned miss = 0, badq = 0, dup = 0;
    for (int q = gw; q < NROWS; q += NGW) {
        for (int i = l; i < 260; i += 64) bm[i] = 0u;
        IX_FENCE();
        const int n = NSEL[q], nb = NSELB[q];
        for (int i = l; i < n; i += 64) { const unsigned j = SEL[(size_t)q * TOPK + i]; atomicOr((unsigned*)&bm[j >> 5], 1u << (j & 31)); }
        IX_FENCE();
        unsigned m = (n != nb) ? 1000u : 0u;
        for (int i = l; i < nb && i < TOPK; i += 64) { const unsigned j = SELB[(size_t)q * TOPK + i]; if (j >= (unsigned)TT) { ++dup; ++m; } else { const unsigned old = atomicAnd((unsigned*)&bm[j >> 5], ~(1u << (j & 31))); if (!((old >> (j & 31)) & 1u)) ++m; } }
        IX_FENCE();
        m = (unsigned)wave_sum((float)m);
        if (l == 0) { miss += m; badq += m ? 1u : 0u; }
    }
    dup = (unsigned)wave_sum((float)dup);
    if (l == 0) { atomicAdd((unsigned*)F.ctl + 2048, miss); atomicAdd((unsigned*)F.ctl + 2049, badq); atomicAdd((unsigned*)F.ctl + 2050, dup); }
}
#endif

typedef short v4i16_t __attribute__((ext_vector_type(4)));
__device__ __forceinline__ unsigned at_f(unsigned row) { return (((row >> 2) & 3u) << 2) | ((row & 1u) << 1); }
__device__ __forceinline__ unsigned at_off(unsigned row, unsigned ch) { return 256u * row + 16u * (ch ^ at_f(row)); }

__device__ __forceinline__ float x4_max(float x) {
    auto s = __builtin_amdgcn_permlane16_swap(__float_as_uint(x), __float_as_uint(x), false, false); x = fmaxf(__uint_as_float(s[0]), __uint_as_float(s[1]));
    auto t = __builtin_amdgcn_permlane32_swap(__float_as_uint(x), __float_as_uint(x), false, false); return fmaxf(__uint_as_float(t[0]), __uint_as_float(t[1]));
}
__device__ __forceinline__ float x4_sum(float x) {
    auto s = __builtin_amdgcn_permlane16_swap(__float_as_uint(x), __float_as_uint(x), false, false); x = __uint_as_float(s[0]) + __uint_as_float(s[1]);
    auto t = __builtin_amdgcn_permlane32_swap(__float_as_uint(x), __float_as_uint(x), false, false); return __uint_as_float(t[0]) + __uint_as_float(t[1]);
}
constexpr int AT_SB_OFF = RING_BYTES + 4096;
static_assert(AT_SB_OFF + NWAVES * 1536 <= LDS_BYTES, "attention LDS");
#define AT_DECODE(qi_, q_, b_, pos_) do { if (meta_only) { q_ = NREAL + (qi_); b_ = 0; pos_ = (qi_); } else if ((G & 7) == 0) { q_ = qbase_b + (qi_); b_ = q_ >> 13; pos_ = NMETA + (qi_); } \
        else { q_ = (qi_); b_ = q_ >> 13; pos_ = NMETA + (q_ & (SEQ - 1)); } } while (0)
#define AT_COMMIT(selr_, nsel_, b_) do { const unsigned k0_ = (unsigned)__builtin_amdgcn_readfirstlane((int)(selr_.x & 0xffffu)); \
        unsigned kk_[4] = {selr_.x & 0xffffu, selr_.x >> 16, selr_.y & 0xffffu, selr_.y >> 16}; v4u of_; \
        _Pragma("unroll") for (int e_ = 0; e_ < 4; ++e_) { if (4 * l + e_ >= (nsel_)) kk_[e_] = k0_; of_[e_] = (unsigned)(pm == 2 ? (int)(kk_[e_] & 31u) : key_row((b_), (int)kk_[e_])) << 8; } \
        *(LAS v4u*)(offb + 4 * l) = of_; *(LAS v2u*)(selb + 4 * l) = (v2u){kk_[0] | (kk_[1] << 16), kk_[2] | (kk_[3] << 16)}; } while (0)
__device__ __forceinline__ void at_dma8(const unsigned char* base, unsigned ldsdst, unsigned o0, unsigned o1, unsigned o2, unsigned o3, unsigned o4, unsigned o5, unsigned o6, unsigned o7) {
    unsigned keep;
    asm volatile("s_mov_b32 %0, m0\n\ts_mov_b32 m0, %9\n\ts_nop 0\n\tglobal_load_lds_dwordx4 %1, %10\n\t"
                 "s_add_u32 m0, %9, 0x400\n\ts_nop 0\n\tglobal_load_lds_dwordx4 %2, %10\n\t"
                 "s_add_u32 m0, %9, 0x800\n\ts_nop 0\n\tglobal_load_lds_dwordx4 %3, %10\n\t"
                 "s_add_u32 m0, %9, 0xc00\n\ts_nop 0\n\tglobal_load_lds_dwordx4 %4, %10\n\t"
                 "s_add_u32 m0, %9, 0x1000\n\ts_nop 0\n\tglobal_load_lds_dwordx4 %5, %10\n\t"
                 "s_add_u32 m0, %9, 0x1400\n\ts_nop 0\n\tglobal_load_lds_dwordx4 %6, %10\n\t"
                 "s_add_u32 m0, %9, 0x1800\n\ts_nop 0\n\tglobal_load_lds_dwordx4 %7, %10\n\t"
                 "s_add_u32 m0, %9, 0x1c00\n\ts_nop 0\n\tglobal_load_lds_dwordx4 %8, %10\n\ts_mov_b32 m0, %0"
                 : "=&s"(keep) : "v"(o0), "v"(o1), "v"(o2), "v"(o3), "v"(o4), "v"(o5), "v"(o6), "v"(o7), "s"(ldsdst), "s"(base) : "memory", "scc");
}
#define AT_GATHER(ck_, tb_) do { const v4u oa_ = *(const LAS v4u*)(offb + 32 * (ck_) + 8 * g), ob_ = *(const LAS v4u*)(offb + 32 * (ck_) + 8 * g + 4); \
        at_dma8(CKVb, (unsigned)(tb_), oa_.x | cst[0], oa_.y | cst[1], oa_.z | cst[2], oa_.w | cst[3], ob_.x | cst[0], ob_.y | cst[1], ob_.z | cst[2], ob_.w | cst[3]); } while (0)
__device__ __forceinline__ void p6_attn_mfma(Frame& F, bf16* OUTB, bool meta_only = false, int ldo = QAW, int pm = 0) {
    bf16* QA = WSP(bf16, WS_QA); const unsigned char* CKVb = (const unsigned char*)WSP(bf16, WS_CKV); const unsigned short* SEL = WSP(unsigned short, WS_SEL); const int* NSEL = WSP(int, WS_NSEL);
    const int l = F.lane, w = F.wave, h16 = l & 15, g = l >> 4;
    LAS unsigned char* tile0 = F.lds + w * 16384;
    const unsigned tile0a = (unsigned)__builtin_amdgcn_readfirstlane((int)(unsigned)(size_t)tile0);
    LAS unsigned* offb = (LAS unsigned*)(F.lds + AT_SB_OFF + w * 1536);
    LAS unsigned short* selb = (LAS unsigned short*)(F.lds + AT_SB_OFF + w * 1536 + 1024);
    const float slope = h16 < 8 ? __uint_as_float((unsigned)(127 - (h16 + 1)) << 23) : 0.f;
    const unsigned hm_ = h16 < 8 ? 0xffffffffu : 0u, gm_ = (g & 1) ? 0xffffffffu : 0u; const v4u hmask = (v4u){hm_, hm_, hm_, hm_};
    unsigned cst[4];
#pragma unroll
    for (int i = 0; i < 4; ++i) cst[i] = 16u * ((unsigned)h16 ^ at_f((unsigned)(4 * i + g)));
    if (!meta_only && pm == 0) {
        const int gw = blockIdx.x * NWAVES + w, NGW = F.G * NWAVES;
        for (int q = NROWS + gw; q < R; q += NGW) { bf16* qrow = QA + (size_t)q * QAW; for (int c = l; c < QAW / 8; c += 64) *(v4u*)(qrow + 8 * c) = (v4u){0u, 0u, 0u, 0u}; }
    }
    const int G = F.G;
    int nq_tot, qbase_b, wib, wpb;
    if ((G & 7) == 0) { const int b = (blockIdx.x & 7) >> 1; qbase_b = b * SEQ; nq_tot = SEQ; wib = (((blockIdx.x >> 3) * 2) + (blockIdx.x & 1)) * NWAVES + w; wpb = (G / 4) * NWAVES; }
    else { qbase_b = 0; nq_tot = NREAL; wib = blockIdx.x * NWAVES + w; wpb = G * NWAVES; }
    if (meta_only) { qbase_b = NREAL; nq_tot = NMETA; wib = w; wpb = NWAVES; }
    int qi = wib;
    if (qi >= nq_tot) return;
    int q, b, pos, nsel;
    v2u selr; int nselr;
    bf16x8 qf[4];
    AT_DECODE(qi, q, b, pos);
    selr = *(const v2u*)(SEL + (size_t)q * TOPK + 4 * l); nsel = __builtin_amdgcn_readfirstlane(NSEL[q]);
    AT_COMMIT(selr, nsel, b);
    AT_GATHER(0, tile0a);
#pragma unroll
    for (int s = 0; s < 4; ++s) { const v4u t = *(const v4u*)(QA + (size_t)q * QAW + (h16 & 7) * 128 + 32 * s + 8 * g) & hmask; qf[s] = __builtin_bit_cast(bf16x8, t); }
    if (qi + wpb < nq_tot) { int qn, bn, pn; AT_DECODE(qi + wpb, qn, bn, pn); selr = *(const v2u*)(SEL + (size_t)qn * TOPK + 4 * l); nselr = NSEL[qn]; }
    unsigned tb = 0;
    for (;;) {
        const bool has_next = qi + wpb < nq_tot;
        const int nch = (nsel + 31) >> 5;
        v4u qraw[4];
        int nsel_next = 0;
        float m = -INFINITY, lsum = 0.f;
        f32x4 O[8];
#pragma unroll
        for (int c = 0; c < 8; ++c) O[c] = (f32x4){0.f, 0.f, 0.f, 0.f};
        for (int ck = 0; ck < nch; ++ck) {
            LAS unsigned char* tile = tile0 + tb;
            asm volatile("s_waitcnt vmcnt(0)" ::: "memory");
            const v4u kv = *(const LAS v4u*)(selb + 32 * ck + 8 * g);
            if (ck + 1 < nch) { AT_GATHER(ck + 1, tile0a + (tb ^ 8192u)); }
            else if (has_next) {
                int qn, bn, pn; AT_DECODE(qi + wpb, qn, bn, pn);
                nsel_next = __builtin_amdgcn_readfirstlane(nselr);
                AT_COMMIT(selr, nsel_next, bn);
                AT_GATHER(0, tile0a + (tb ^ 8192u));
            }
            f32x4 a0 = (f32x4){0.f, 0.f, 0.f, 0.f}, a1 = a0;
#pragma unroll
            for (int s = 0; s < 4; ++s) {
                const bf16x8 k0 = *(const LAS bf16x8*)(tile + at_off((unsigned)(4 * (h16 & 3) + (h16 >> 2)), (unsigned)(4 * s + g)));
                const bf16x8 k1 = *(const LAS bf16x8*)(tile + at_off((unsigned)(16 + 4 * (h16 & 3) + (h16 >> 2)), (unsigned)(4 * s + g)));
                a0 = __builtin_amdgcn_mfma_f32_16x16x32_bf16(k0, qf[s], a0, 0, 0, 0);
                a1 = __builtin_amdgcn_mfma_f32_16x16x32_bf16(k1, qf[s], a1, 0, 0, 0);
            }
            if (ck + 1 == nch && has_next) {
                int qn, bn, pn; AT_DECODE(qi + wpb, qn, bn, pn);
#pragma unroll
                for (int s = 0; s < 4; ++s) { qraw[s] = *(const v4u*)(QA + (size_t)qn * QAW + (h16 & 7) * 128 + 32 * s + 8 * g); }
                if (qi + 2 * wpb < nq_tot) { int q2, b2, p2; AT_DECODE(qi + 2 * wpb, q2, b2, p2); selr = *(const v2u*)(SEL + (size_t)q2 * TOPK + 4 * l); nselr = NSEL[q2]; }
            }
            const unsigned kw[4] = {kv.x, kv.y, kv.z, kv.w};
            float x[8];
#pragma unroll
            for (int j = 0; j < 8; ++j) {
                const int kj = (int)((kw[j >> 1] >> (16 * (j & 1))) & 0xffffu);
                x[j] = (j < 4 ? a0[j & 3] : a1[j & 3]) - slope * fabsf((float)(pos - kj));
            }
            if (32 * ck + 32 > nsel) {
#pragma unroll
                for (int j = 0; j < 8; ++j) x[j] = (32 * ck + 8 * g + j) < nsel ? x[j] : -INFINITY;
            }
            float cm = fmaxf(fmaxf(fmaxf(x[0], x[1]), fmaxf(x[2], x[3])), fmaxf(fmaxf(x[4], x[5]), fmaxf(x[6], x[7])));
            cm = x4_max(cm);
            const float mn = fmaxf(m, cm);
            const float alpha = __expf(m - mn);
            float p[8], ps = 0.f;
#pragma unroll
            for (int j = 0; j < 8; ++j) { p[j] = __expf(x[j] - mn); ps += p[j]; }
            ps = x4_sum(ps);
            lsum = lsum * alpha + ps; m = mn;
            if (__any(alpha != 1.0f)) {
#pragma unroll
                for (int rr = 0; rr < 4; ++rr) { const float sc = __uint_as_float((__float_as_uint(rdlane_f(alpha, 4 + rr)) & gm_) | (__float_as_uint(rdlane_f(alpha, rr)) & ~gm_));
#pragma unroll
                    for (int c = 0; c < 8; ++c) O[c][rr] *= sc; }
            }
            const v4u pw = (v4u){pk2(p[0], p[1]), pk2(p[2], p[3]), pk2(p[4], p[5]), pk2(p[6], p[7])};
            const bf16x8 pf = __builtin_bit_cast(bf16x8, pw);
#pragma unroll
            for (int c = 0; c < 8; ++c) {
                const unsigned qd = (unsigned)(h16 >> 2), pp = (unsigned)(h16 & 3);
                const v4i16_t t0 = __builtin_amdgcn_ds_read_tr16_b64_v4i16((LAS v4i16_t*)(tile + at_off(4u * qd + g, 2u * c + (pp >> 1)) + 8u * (pp & 1u)));
                const v4i16_t t1 = __builtin_amdgcn_ds_read_tr16_b64_v4i16((LAS v4i16_t*)(tile + at_off(16u + 4u * qd + g, 2u * c + (pp >> 1)) + 8u * (pp & 1u)));
                bf16x8 vf; vf[0] = t0[0]; vf[1] = t0[1]; vf[2] = t0[2]; vf[3] = t0[3]; vf[4] = t1[0]; vf[5] = t1[1]; vf[6] = t1[2]; vf[7] = t1[3];
                O[c] = __builtin_amdgcn_mfma_f32_16x16x32_bf16(pf, vf, O[c], 0, 0, 0);
            }
            tb ^= 8192u;
        }
        const float inv = 1.0f / lsum;
#pragma unroll
        for (int rr = 0; rr < 4; ++rr) {
            const float sc = __uint_as_float((__float_as_uint(rdlane_f(inv, 4 + rr)) & gm_) | (__float_as_uint(rdlane_f(inv, rr)) & ~gm_));
            if (g < 2) {
#pragma unroll
                for (int c = 0; c < 8; ++c) (OUTB + (size_t)q * ldo)[(4 * g + rr) * 128 + 16 * c + h16] = (bf16)f2bf(O[c][rr] * sc);
            }
        }
        if (!has_next) break;
        qi += wpb; AT_DECODE(qi, q, b, pos); nsel = nsel_next;
#pragma unroll
        for (int s = 0; s < 4; ++s) qf[s] = __builtin_bit_cast(bf16x8, qraw[s] & hmask);
    }
    asm volatile("s_waitcnt vmcnt(0)" ::: "memory");
}
struct StoreBf16 { bf16* O; int ld;
    __device__ __forceinline__ void operator()(int row, int col, const f32x4& v) const { *(v2u*)(O + (size_t)row * ld + col) = (v2u){pk2(v.x, v.y), pk2(v.z, v.w)}; }
    __device__ __forceinline__ void two(int row, int col, const f32x4& a, const f32x4& b) const { *(v4u*)(O + (size_t)row * ld + col) = (v4u){pk2(a.x, a.y), pk2(a.z, a.w), pk2(b.x, b.y), pk2(b.z, b.w)}; }
    __device__ __forceinline__ void one(int row, int col, float v) const { O[(size_t)row * ld + col] = (bf16)f2bf(v); } };
struct StoreRes1 { const bf16* H; float* out; float* meta;
    __device__ __forceinline__ void operator()(int row, int col, const f32x4& v) const {
        if (row >= NROWS) return;
        const v2u hw = *(const v2u*)(H + (size_t)row * D + col);
        const f32x4 o = (f32x4){ALPHA * bflo(hw.x) + v.x, ALPHA * bfhi(hw.x) + v.y, ALPHA * bflo(hw.y) + v.z, ALPHA * bfhi(hw.y) + v.w};
        float* dst = row < NREAL ? out + (size_t)row * D + col : meta + (size_t)(row - NREAL) * D + col;
        *(f32x4*)dst = o; }
    __device__ __forceinline__ void two(int row, int col, const f32x4& a, const f32x4& b) const {
        const v4u hw = *(const v4u*)(H + (size_t)row * D + col);
        float* dst = out + (size_t)row * D + col;
        *(f32x4*)dst = (f32x4){ALPHA * bflo(hw.x) + a.x, ALPHA * bfhi(hw.x) + a.y, ALPHA * bflo(hw.y) + a.z, ALPHA * bfhi(hw.y) + a.w};
        *(f32x4*)(dst + 4) = (f32x4){ALPHA * bflo(hw.z) + b.x, ALPHA * bfhi(hw.z) + b.y, ALPHA * bflo(hw.w) + b.z, ALPHA * bfhi(hw.w) + b.w}; }
    __device__ __forceinline__ void one(int row, int col, float v) const { if (row >= NROWS) return; float* dst = row < NREAL ? out + (size_t)row * D + col : meta + (size_t)(row - NREAL) * D + col; *dst = ALPHA * bf2f(H[(size_t)row * D + col]) + v; } };
struct StoreRes2 { const bf16* H; float* out;
    __device__ __forceinline__ void two(int row, int col, const f32x4& a, const f32x4& b) const {
        const v4u hw = *(const v4u*)(H + (size_t)row * D + col);
        float* dst = out + (size_t)row * D + col;
        *(f32x4*)dst = (f32x4){ALPHA * bflo(hw.x) + a.x, ALPHA * bfhi(hw.x) + a.y, ALPHA * bflo(hw.y) + a.z, ALPHA * bfhi(hw.y) + a.w};
        *(f32x4*)(dst + 4) = (f32x4){ALPHA * bflo(hw.z) + b.x, ALPHA * bfhi(hw.z) + b.y, ALPHA * bflo(hw.w) + b.z, ALPHA * bfhi(hw.w) + b.w}; }
    __device__ __forceinline__ void operator()(int row, int col, const f32x4& v) const {
        if (row >= NREAL) return;
        const v2u hw = *(const v2u*)(H + (size_t)row * D + col);
        *(f32x4*)(out + (size_t)row * D + col) = (f32x4){ALPHA * bflo(hw.x) + v.x, ALPHA * bfhi(hw.x) + v.y, ALPHA * bflo(hw.y) + v.z, ALPHA * bfhi(hw.y) + v.w}; } };

struct StoreMetaGate { float* GM; __device__ __forceinline__ void one(int row, int col, float v) const { const int m = row - NREAL, x = col & 255; if (m >= 14 && x < 128) GM[(size_t)(m - 14) * DFF + 128 * (col >> 8) + x] = v; } };
template <class Fn>
__device__ __forceinline__ void meta_gemm(Frame& F, const bf16* A, int lda, const bf16* Bt, int N, int K, const Fn& fn) {
    const int l = F.lane, i16 = l & 15, g = l >> 4;
    const int gw = blockIdx.x * NWAVES + F.wave, NGW = F.G * NWAVES;
    for (int t = gw; t < N / 16; t += NGW) {
        const bf16* ap = A + (size_t)(NREAL + i16) * lda + 8 * g; const bf16* bp = Bt + (size_t)(16 * t + i16) * K + 8 * g;
        f32x4 acc = (f32x4){0.f, 0.f, 0.f, 0.f};
#pragma unroll 8
        for (int s = 0; s < K / 32; ++s) acc = __builtin_amdgcn_mfma_f32_16x16x32_bf16(*(const pg8::bf16x8*)(ap + 32 * s), *(const pg8::bf16x8*)(bp + 32 * s), acc, 0, 0, 0);
#pragma unroll
        for (int rr = 0; rr < 4; ++rr) fn.one(NREAL + 4 * g + rr, 16 * t + i16, acc[rr]);
    }
}

template <class Fn>
__device__ __forceinline__ void run_gemm(Frame& F, const bf16* A, int lda, const bf16* Bt, int N, int K, const Fn& fn) {
    pg8::Gemm g{A, Bt, NREAL, N, K, lda}; pg8::StaticOrder S; S.init(NREAL, N, F.G, (int)blockIdx.x);
    pg8::EpiFn<Fn> E{fn};
    pg8::gemm_phase<pg8::EpiFn<Fn>, pg8::StaticOrder, true, true>(F.lds + RING_OFF, g, S, E);
}

template <class Fn>
__device__ __forceinline__ void run_gemm8(Frame& F, const bf16* A, int lda, const bf16* Bt, int N, int K, const Fn& fn) {
    pg8::Gemm g{A, Bt, NREAL, N, K, lda}; pg8::StaticOrder S; S.init(NREAL, N, F.G, (int)blockIdx.x);
    pg8::EpiFn8<Fn> E{fn};
    pg8::gemm_phase<pg8::EpiFn8<Fn>, pg8::StaticOrder, true, true>(F.lds + RING_OFF, g, S, E);
}

constexpr int NPHASES = 13;
struct Args { const float* in[32]; float* out; unsigned char* ws; int ph_lo, ph_hi; };
__global__ void __launch_bounds__(NTHR, 2) fwd(Args args) {
    extern __shared__ __attribute__((aligned(16))) unsigned char lds[];
    Frame F;
    F.lds = (LAS unsigned char*)lds;
    F.MISC = (volatile LAS unsigned*)(F.lds + MISC_OFF);
    F.tid = threadIdx.x; F.lane = F.tid & 63; F.wave = __builtin_amdgcn_readfirstlane(F.tid >> 6);
    F.G = gridDim.x;
#pragma unroll
    for (int i = 0; i < 32; ++i) F.in[i] = args.in[i];
    F.out = args.out; F.ws = args.ws;
    F.ctl = (gu32*)(args.ws + WS_CTL);
    for (int u = F.tid; u < (LDS_BYTES - LDSCTL_OFF) / 4; u += NTHR) ((LAS unsigned*)(F.lds + LDSCTL_OFF))[u] = 0u;
    __syncthreads();
    const int lo = args.ph_lo, hi = args.ph_hi;
    XcdBarrier bar; bar.bar = (unsigned*)(F.ctl + CW_BAR); bar.x = 0; bar.st = nullptr;
    if (hi - lo > 1) bar = xcd_barrier_post((unsigned*)(F.ctl + CW_BAR), F.MISC + 8);
#define IN(k) (lo <= (k) && (k) < hi)
#ifdef PROBE_PHASE_T
    unsigned long long tp_prev = __builtin_amdgcn_s_memrealtime(), tp_dur = 0ull;
#define SEAM(k) do { if (IN(k) && IN((k) + 1)) xcd_barrier(bar); if (blockIdx.x == 0 && F.tid == 0) { const unsigned long long t_ = __builtin_amdgcn_s_memrealtime(); if ((k) == PROBE_PHASE_T) tp_dur = t_ - tp_prev; tp_prev = t_; } } while (0)
#else
#define SEAM(k) do { if (IN(k) && IN((k) + 1)) xcd_barrier(bar); } while (0)
#endif
#ifndef PROBE_PH
#define PROBE_PH -1
#endif
#define REP(k) for (int rep_ = 0; rep_ < ((PROBE_PH == (k)) ? 2 : 1); ++rep_)

#ifndef IDX_NAIVE
#define IDX_NAIVE 0
#endif
#ifndef ATTN_NAIVE
#define ATTN_NAIVE 0
#endif
    if (IN(0)) REP(0) { if (rep_) __syncthreads(); p0_weights(F); p1_ln_in(F); } SEAM(0);
    if (IN(1)) REP(1) { if (rep_) __syncthreads(); run_gemm8(F, WSP(bf16, WS_H), D, WSP(bf16, WS_WT_IN), PW, D, StoreBf16{WSP(bf16, WS_P), PW}); meta_gemm(F, WSP(bf16, WS_H), D, WSP(bf16, WS_WT_IN), PW, D, StoreBf16{WSP(bf16, WS_P), PW});
        if (rep_ == 0) { if (F.G == 256) { if (blockIdx.x >= 128) p0_weights_late(F, (blockIdx.x - 128) * NWAVES + F.wave, 128 * NWAVES); } else p0_weights_late(F, blockIdx.x * NWAVES + F.wave, F.G * NWAVES); } } SEAM(1);
    if (IN(2)) REP(2) { if (rep_) __syncthreads(); p3_prep(F); } SEAM(2);
    if (IN(3)) REP(3) { if (rep_) __syncthreads(); run_gemm8(F, WSP(bf16, WS_CQN), 256, WSP(bf16, WS_WT_QA), QAW, 256, StoreBf16{WSP(bf16, WS_QA), QAW}); meta_gemm(F, WSP(bf16, WS_CQN), 256, WSP(bf16, WS_WT_QA), QAW, 256, StoreBf16{WSP(bf16, WS_QA), QAW});
#if REFSEL
        refsel_rows(F);
#endif
    } SEAM(3);
    if (IN(4)) REP(4) { if (rep_) __syncthreads(); rw_b1(F); } SEAM(4);
    if (IN(5)) {
        rw_b2(F); __syncthreads();
#if CHECK_IDX
        p5_index_naive(F); __syncthreads(); p5_index_mfma(F, (unsigned short*)F.out, (int*)((char*)F.out + 32 * MiB));
#elif IDX_NAIVE
        p5_index_naive(F);
#else
        p5_index_mfma(F, WSP(unsigned short, WS_SEL), WSP(int, WS_NSEL), 3072, false, true);
#ifdef PROBE_IDX
        __syncthreads(); p5_index_mfma(F, WSP(unsigned short, WS_SEL), WSP(int, WS_NSEL), 3136);
#endif
#ifdef PROBE_IDX_SCORE
        __syncthreads(); p5_index_mfma(F, (unsigned short*)F.out, (int*)((char*)F.out + 32 * MiB), 3136, true);
#endif
#endif
    } SEAM(5);
    if (IN(6)) {
#if CHECK_IDX
        idx_check(F); __syncthreads();
#endif
#if CHECK_IDX || IDX_NAIVE
        if (blockIdx.x == 0) { p6_attn_mfma(F, WSP(bf16, WS_QA), true); __syncthreads(); }
        if (blockIdx.x == 1) { rw_b3(F, true); __syncthreads(); }
#endif
#if ATTN_NAIVE
        p6_attn_naive(F);
#else
        p6_attn_mfma(F, WSP(bf16, WS_QA));
#ifdef PROBE_ATTN2
        __syncthreads(); p6_attn_mfma(F, (bf16*)F.out, false, 1024, PROBE_ATTN2);
#endif
#endif
        __syncthreads();
        rw_b3(F);
    } SEAM(6);
    if (IN(7)) REP(7) { if (rep_) __syncthreads(); run_gemm8(F, WSP(bf16, WS_QA), QAW, WSP(bf16, WS_WT_MIX), D, QAW, StoreRes1{WSP(bf16, WS_H), F.out, WSP(float, WS_META1)}); meta_gemm(F, WSP(bf16, WS_QA), QAW, WSP(bf16, WS_WT_MIX), D, QAW, StoreRes1{WSP(bf16, WS_H), F.out, WSP(float, WS_META1)}); } SEAM(7);
    if (IN(8)) REP(8) { if (rep_) __syncthreads(); p10_ln1(F); } SEAM(8);
    if (IN(9)) {
        pg8::Gemm g{WSP(bf16, WS_H), WSP(bf16, WS_WT_UP), NREAL, UPW, D, D}; pg8::StaticOrder S; S.init(NREAL, UPW, F.G, (int)blockIdx.x);
        pg8::EpiConvAct E{WSP(unsigned short, WS_UP), DFF, F.in[IN_CONV_W], F.in[IN_CONV_B], DFF, WSP(float, WS_G01), WSP(float, WS_V01), WSP(float, WS_GHALO), (PG8_LAS float*)(F.lds + RING_BYTES + 4096)};
        pg8::gemm_phase<pg8::EpiConvAct, pg8::StaticOrder, true, true>(F.lds + RING_OFF, g, S, E);
        meta_gemm(F, WSP(bf16, WS_H), D, WSP(bf16, WS_WT_UP), UPW, D, StoreMetaGate{WSP(float, WS_GMETA)});
    } SEAM(9);
    if (IN(10)) { p12_conv_fix(F); } SEAM(10);
    if (IN(11)) REP(11) { if (rep_) __syncthreads(); run_gemm8(F, WSP(bf16, WS_UP), DFF, WSP(bf16, WS_WT_DN), D, DFF, StoreRes2{WSP(bf16, WS_H), F.out}); } SEAM(11);
    if (IN(12)) { p14_ln2(F);
#if CHECK_IDX
        if (blockIdx.x == 0 && F.tid == 0) {
            const unsigned miss = __hip_atomic_load((unsigned*)F.ctl + 2048, __ATOMIC_RELAXED, __HIP_MEMORY_SCOPE_AGENT), dupc = __hip_atomic_load((unsigned*)F.ctl + 2050, __ATOMIC_RELAXED, __HIP_MEMORY_SCOPE_AGENT);
            if (dupc) F.out[5] = __builtin_inff();
            if (miss > CHECK_IDX_MAXMISS) F.out[3] = __builtin_nanf("");
        }
#endif
    }
#ifdef PROBE_PHASE_T
    if (blockIdx.x == 0 && F.tid == 0) { if (PROBE_PHASE_T == 12) tp_dur = __builtin_amdgcn_s_memrealtime() - tp_prev; const unsigned long long t0 = __builtin_amdgcn_s_memrealtime(); while (__builtin_amdgcn_s_memrealtime() - t0 < tp_dur) __builtin_amdgcn_s_sleep(8); }
#endif
#ifdef PROBE_B1SEC
    if (blockIdx.x == 0 && F.tid == 0) { const unsigned long long t0 = __builtin_amdgcn_s_memrealtime(); const unsigned long long dt = (unsigned long long)F.MISC[20]; while (__builtin_amdgcn_s_memrealtime() - t0 < dt) __builtin_amdgcn_s_sleep(8); }
#endif
#undef IN
#undef SEAM
}

extern "C" void kernel_launch(void* const* d_in, const int* in_sizes, int n_in, void* d_out, int out_size, void* d_ws, size_t ws_size, hipStream_t stream) {
    static int grid = 0;
    if (grid == 0) {
        if (n_in != 32 || out_size != NREAL * D || ws_size < WS_END) { fprintf(stderr, "kernel_launch: unexpected shapes: n_in %d out %d ws %zu\n", n_in, out_size, ws_size); grid = -1; return; }
        int dev = 0, cus = 0, per_cu = 0;
        if (hipGetDevice(&dev) != hipSuccess || hipDeviceGetAttribute(&cus, hipDeviceAttributeMultiprocessorCount, dev) != hipSuccess) { grid = -1; return; }
        if (hipFuncSetAttribute((const void*)fwd, hipFuncAttributeMaxDynamicSharedMemorySize, LDS_BYTES) != hipSuccess) { fprintf(stderr, "kernel_launch: hipFuncSetAttribute failed\n"); grid = -1; return; }
        if (hipOccupancyMaxActiveBlocksPerMultiprocessor(&per_cu, (const void*)fwd, NTHR, LDS_BYTES) != hipSuccess || per_cu < 1) fprintf(stderr, "kernel_launch: occupancy query says %d\n", per_cu);
        (void)hipGetLastError();
        grid = cus;
    }
    if (grid < 0) return;
    (void)hipMemsetAsync((char*)d_ws + WS_CTL, 0, CTL_ZERO_BYTES, stream);
    Args a{};
    for (int i = 0; i < 32; ++i) a.in[i] = (const float*)d_in[i];
    a.out = (float*)d_out; a.ws = (unsigned char*)d_ws;
#if ONE_LAUNCH
    a.ph_lo = 0; a.ph_hi = NPHASES;
    hipLaunchKernelGGL(fwd, dim3(grid), dim3(NTHR), LDS_BYTES, stream, a);
#else
    for (int p = 0; p < NPHASES; ++p) { a.ph_lo = p; a.ph_hi = p + 1; hipLaunchKernelGGL(fwd, dim3(grid), dim3(NTHR), LDS_BYTES, stream, a); }
#endif
}
```
